# Optimizing an MI355X kernel written in HIP

```python
import math
import jax, jax.numpy as jnp
from jax import lax
import numpy as np

D_MODEL = 2048
BATCH = 1
SEQ = 16384
DEPTH = 2

GRID_W = 64
CTX_LEN = 256
HEAD_DIM = 128
ROPE_THETA = 10000.0
Q_BLOCK = 128
EPS = 1e-6
D_MIX = D_MODEL
A_HEADS = D_MIX // 2 // HEAD_DIM
A_KV_HEADS = 2
C_CONV = D_MIX // 2
CONV_W = 31
IN_EVEN = A_HEADS * HEAD_DIM + 2 * A_KV_HEADS * HEAD_DIM + 2 * C_CONV
DIFF_HEADS = D_MIX // (2 * HEAD_DIM)
IN_ODD = 3 * D_MIX
LAMBDA_STD = 0.1
N_EXPERTS = 64
TOP_K = 8
N_GROUPS = 8
TOPK_GROUPS = 4
EXPERT_FF = D_MODEL // 4
ROUTED_SCALE = 2.5
MOE_BLOCK = 128

N_EVEN = (DEPTH + 1) // 2
N_ODD = DEPTH // 2

kernel_name = 'hybrid_diffusion_gqa_conformer_diffattn_moe'


def rms_norm(x, g):
    xf = x.astype(jnp.float32)
    y = xf * lax.rsqrt(jnp.mean(xf * xf, axis=-1, keepdims=True) + EPS)
    return (y * g.astype(jnp.float32)).astype(x.dtype)


def layer_norm(x, g, b):
    xf = x.astype(jnp.float32)
    mu = jnp.mean(xf, axis=-1, keepdims=True)
    var = jnp.mean(jnp.square(xf - mu), axis=-1, keepdims=True)
    y = (xf - mu) * lax.rsqrt(var + EPS)
    return (y * g.astype(jnp.float32) + b.astype(jnp.float32)).astype(x.dtype)


def modulate(x, g, shift, scale):
    return rms_norm(x, g) * (1 + scale) + shift


def axial_rope_tables(n_tokens, dtype):
    rows = n_tokens // GRID_W
    nf = HEAD_DIM // 4
    inv = ROPE_THETA ** (-jnp.arange(nf, dtype=jnp.float32) / nf)
    row_ang = jnp.arange(rows, dtype=jnp.float32)[:, None] * inv
    col_ang = jnp.arange(GRID_W, dtype=jnp.float32)[:, None] * inv
    ang = jnp.stack([jnp.broadcast_to(row_ang[:, None, :], (rows, GRID_W, nf)),
                     jnp.broadcast_to(col_ang[None, :, :], (rows, GRID_W, nf))], axis=2)
    ang = ang.reshape(rows * GRID_W, 2, nf)
    return jnp.cos(ang).astype(dtype), jnp.sin(ang).astype(dtype)


def apply_rope(x, cos, sin):
    b, l, h, d = x.shape
    xr = x.reshape(b, l, h, 2, 2, d // 4)
    x1, x2 = xr[..., 0, :], xr[..., 1, :]
    cs, sn = cos[None, :, None], sin[None, :, None]
    out = jnp.stack([x1 * cs - x2 * sn, x2 * cs + x1 * sn], axis=-2)
    return out.reshape(b, l, h, d)


def to_blocks(q):
    b, l = q.shape[:2]
    q = q.reshape((b, l // Q_BLOCK, Q_BLOCK) + q.shape[2:])
    return jnp.moveaxis(q, 1, 0)


def from_blocks(o):
    o = jnp.moveaxis(o, 0, 1)
    return o.reshape((o.shape[0], o.shape[1] * o.shape[2]) + o.shape[3:])


def gqa_attention(q, k, v):
    b, lq = q.shape[:2]
    g = A_HEADS // A_KV_HEADS
    qb = to_blocks(q.reshape(b, lq, A_KV_HEADS, g, HEAD_DIM))
    scale = HEAD_DIM ** -0.5

    def block(qi):
        s = jnp.einsum('bqhgd,bkhd->bhgqk', qi, k, preferred_element_type=jnp.float32) * scale
        p = jax.nn.softmax(s, axis=-1).astype(v.dtype)
        return jnp.einsum('bhgqk,bkhd->bqhgd', p, v)

    o = from_blocks(lax.map(block, qb))
    return o.reshape(b, lq, A_HEADS * HEAD_DIM)


def diff_attention(q, k, v, lam):
    qb = to_blocks(q)
    scale = HEAD_DIM ** -0.5

    def block(qi):
        s = jnp.einsum('bqhcd,bkhcd->bhcqk', qi, k, preferred_element_type=jnp.float32) * scale
        p = jax.nn.softmax(s, axis=-1)
        a = (p[:, :, 0] - lam * p[:, :, 1]).astype(v.dtype)
        return jnp.einsum('bhqk,bkhe->bqhe', a, v)

    return from_blocks(lax.map(block, qb))


def conformer_conv(u, dw_w, dw_b, ln_g, ln_b):
    a, gt = jnp.split(u, 2, axis=-1)
    h = a * jax.nn.sigmoid(gt)
    h = lax.conv_general_dilated(h, dw_w[:, None, :].astype(h.dtype), window_strides=(1,),
                                 padding=[(CONV_W // 2, CONV_W // 2)],
                                 dimension_numbers=('NWC', 'WIO', 'NWC'),
                                 feature_group_count=C_CONV) + dw_b
    return jax.nn.silu(layer_norm(h, ln_g, ln_b))


def even_mixer(h_ctx, h_lat, cos, sin, w_in, w_out, q_g, k_g, dw_w, dw_b, ln_g, ln_b, need_ctx_out):
    splits = [A_HEADS * HEAD_DIM, (A_HEADS + A_KV_HEADS) * HEAD_DIM, (A_HEADS + 2 * A_KV_HEADS) * HEAD_DIM]

    def project(h, rope):
        b, l = h.shape[:2]
        q, k, v, u = jnp.split(h @ w_in, splits, axis=-1)
        q = rms_norm(q.reshape(b, l, A_HEADS, HEAD_DIM), q_g)
        k = rms_norm(k.reshape(b, l, A_KV_HEADS, HEAD_DIM), k_g)
        v = v.reshape(b, l, A_KV_HEADS, HEAD_DIM)
        if rope:
            q, k = apply_rope(q, cos, sin), apply_rope(k, cos, sin)
        return q, k, v, u

    qc, kc, vc, uc = project(h_ctx, False)
    ql, kl, vl, ul = project(h_lat, True)
    k_all = jnp.concatenate([kc, kl], axis=1)
    v_all = jnp.concatenate([vc, vl], axis=1)
    out_lat = jnp.concatenate([gqa_attention(ql, k_all, v_all),
                               conformer_conv(ul, dw_w, dw_b, ln_g, ln_b)], axis=-1) @ w_out
    out_ctx = None
    if need_ctx_out:
        out_ctx = jnp.concatenate([gqa_attention(qc, kc, vc),
                                   conformer_conv(uc, dw_w, dw_b, ln_g, ln_b)], axis=-1) @ w_out
    return out_ctx, out_lat


def odd_mixer(h_ctx, h_lat, cos, sin, w_in, w_out, lam_p, subln_g, lam_init, need_ctx_out):
    lp = lam_p.astype(jnp.float32)
    lam = jnp.exp(jnp.sum(lp[0] * lp[1])) - jnp.exp(jnp.sum(lp[2] * lp[3])) + lam_init

    def project(h, rope):
        b, l = h.shape[:2]
        q, k, v = jnp.split(h @ w_in, 3, axis=-1)
        q = q.reshape(b, l, 2 * DIFF_HEADS, HEAD_DIM)
        k = k.reshape(b, l, 2 * DIFF_HEADS, HEAD_DIM)
        if rope:
            q, k = apply_rope(q, cos, sin), apply_rope(k, cos, sin)
        return (q.reshape(b, l, DIFF_HEADS, 2, HEAD_DIM), k.reshape(b, l, DIFF_HEADS, 2, HEAD_DIM),
                v.reshape(b, l, DIFF_HEADS, 2 * HEAD_DIM))

    def finish(o):
        b, l = o.shape[:2]
        o = rms_norm(o, subln_g) * (1 - lam_init)
        return o.reshape(b, l, D_MIX) @ w_out

    qc, kc, vc = project(h_ctx, False)
    ql, kl, vl = project(h_lat, True)
    k_all = jnp.concatenate([kc, kl], axis=1)
    v_all = jnp.concatenate([vc, vl], axis=1)
    out_lat = finish(diff_attention(ql, k_all, v_all, lam))
    out_ctx = finish(diff_attention(qc, kc, vc, lam)) if need_ctx_out else None
    return out_ctx, out_lat


def swiglu(h, wg, wu, wd):
    return (jax.nn.silu(h @ wg) * (h @ wu)) @ wd


def moe_ffn(h, router, bias, wg, wu, wd, sg, su, sd):
    n, d = h.shape
    scores = jax.nn.sigmoid(jnp.einsum('nd,de->ne', h, router, preferred_element_type=jnp.float32))
    choice = scores + bias.astype(jnp.float32)
    grp = lax.top_k(choice.reshape(n, N_GROUPS, N_EXPERTS // N_GROUPS), 2)[0].sum(-1)
    _, top_g = lax.top_k(grp, TOPK_GROUPS)
    gmask = jnp.any(top_g[..., None] == jnp.arange(N_GROUPS), axis=1)
    emask = jnp.repeat(gmask, N_EXPERTS // N_GROUPS, axis=1)
    _, top_e = lax.top_k(jnp.where(emask, choice, -jnp.inf), TOP_K)
    w = jnp.take_along_axis(scores, top_e, axis=1)
    w = w / jnp.sum(w, axis=-1, keepdims=True) * ROUTED_SCALE
    a = n * TOP_K
    e_flat = top_e.reshape(a)
    tok_flat = jnp.repeat(jnp.arange(n, dtype=jnp.int32), TOP_K)
    w_flat = w.reshape(a)
    counts = jnp.zeros((N_EXPERTS,), jnp.int32).at[e_flat].add(1)
    padded = (counts + MOE_BLOCK - 1) // MOE_BLOCK * MOE_BLOCK
    pad_end = jnp.cumsum(padded)
    pad_start = pad_end - padded
    start = jnp.cumsum(counts) - counts
    order = jnp.argsort(e_flat)
    se = e_flat[order]
    dest = pad_start[se] + jnp.arange(a, dtype=jnp.int32) - start[se]
    cap = a + N_EXPERTS * MOE_BLOCK
    nb = cap // MOE_BLOCK
    slot_tok = jnp.full((cap,), n, jnp.int32).at[dest].set(tok_flat[order])
    slot_w = jnp.zeros((cap,), h.dtype).at[dest].set(w_flat[order].astype(h.dtype))
    block_e = jnp.minimum(jnp.searchsorted(pad_end, jnp.arange(nb, dtype=jnp.int32) * MOE_BLOCK, side='right'),
                          N_EXPERTS - 1)
    h_pad = jnp.concatenate([h, jnp.zeros((1, d), h.dtype)], axis=0)

    def expert_block(args):
        toks, e = args
        return swiglu(h_pad[toks], wg[e], wu[e], wd[e])

    y = lax.map(expert_block, (slot_tok.reshape(nb, MOE_BLOCK), block_e)).reshape(cap, d)
    routed = jax.ops.segment_sum(y * slot_w[:, None], slot_tok, num_segments=n + 1)[:n]
    return routed + swiglu(h, sg, su, sd)


def setup_inputs(seed: int = 0) -> dict:
    key = jax.random.key(seed)
    ks = iter(jax.random.split(key, 40))

    def nrm(shape, scale):
        return jax.random.normal(next(ks), shape, jnp.float32) * scale

    def gain(shape):
        return 1.0 + nrm(shape, 0.02)

    d = D_MODEL
    return {
        'x': nrm((BATCH, SEQ, d), 1.0),
        'c': nrm((BATCH, d), 1.0),
        'ctx': nrm((BATCH, CTX_LEN, d), 1.0),
        'c_ctx': nrm((d,), 1.0),
        'ada_w': nrm((DEPTH, d, 6 * d), 0.5 * d ** -0.5),
        'ada_b': nrm((DEPTH, 6 * d), 0.02),
        'norm_g': gain((DEPTH, 4, d)),
        'ev_w_in': nrm((N_EVEN, d, IN_EVEN), d ** -0.5),
        'ev_w_out': nrm((N_EVEN, D_MIX, d), D_MIX ** -0.5),
        'ev_q_norm': gain((N_EVEN, HEAD_DIM)),
        'ev_k_norm': gain((N_EVEN, HEAD_DIM)),
        'ev_dw_w': nrm((N_EVEN, CONV_W, C_CONV), CONV_W ** -0.5),
        'ev_dw_b': nrm((N_EVEN, C_CONV), 0.02),
        'ev_ln_g': gain((N_EVEN, C_CONV)),
        'ev_ln_b': nrm((N_EVEN, C_CONV), 0.02),
        'od_w_in': nrm((N_ODD, d, IN_ODD), d ** -0.5),
        'od_w_out': nrm((N_ODD, D_MIX, d), D_MIX ** -0.5),
        'od_lambda': nrm((N_ODD, 4, HEAD_DIM), LAMBDA_STD),
        'od_subln_g': gain((N_ODD, 2 * HEAD_DIM)),
        'moe_router': nrm((DEPTH, d, N_EXPERTS), d ** -0.5),
        'moe_bias': nrm((DEPTH, N_EXPERTS), 0.01),
        'moe_w_gate': nrm((DEPTH, N_EXPERTS, d, EXPERT_FF), d ** -0.5),
        'moe_w_up': nrm((DEPTH, N_EXPERTS, d, EXPERT_FF), d ** -0.5),
        'moe_w_down': nrm((DEPTH, N_EXPERTS, EXPERT_FF, d), EXPERT_FF ** -0.5),
        'sh_w_gate': nrm((DEPTH, d, EXPERT_FF), d ** -0.5),
        'sh_w_up': nrm((DEPTH, d, EXPERT_FF), d ** -0.5),
        'sh_w_down': nrm((DEPTH, EXPERT_FF, d), EXPERT_FF ** -0.5),
    }


def reference(x, c, ctx, c_ctx, ada_w, ada_b, norm_g, ev_w_in, ev_w_out, ev_q_norm, ev_k_norm, ev_dw_w, ev_dw_b,
              ev_ln_g, ev_ln_b, od_w_in, od_w_out, od_lambda, od_subln_g, moe_router, moe_bias, moe_w_gate,
              moe_w_up, moe_w_down, sh_w_gate, sh_w_up, sh_w_down):
    b, seq, d = x.shape
    ctx_len = ctx.shape[1]
    cos, sin = axial_rope_tables(seq, x.dtype)
    silu_c = jax.nn.silu(c)
    silu_cc = jax.nn.silu(c_ctx)[None, :]
    h_lat, h_ctx = x, ctx
    for layer in range(DEPTH):
        last = layer == DEPTH - 1
        i = layer // 2
        mod_l = jnp.split((silu_c @ ada_w[layer] + ada_b[layer])[:, None, :], 6, axis=-1)
        mod_c = jnp.split((silu_cc @ ada_w[layer] + ada_b[layer])[:, None, :], 6, axis=-1)
        a_lat = modulate(h_lat, norm_g[layer, 0], mod_l[0], mod_l[1])
        a_ctx = modulate(h_ctx, norm_g[layer, 0], mod_c[0], mod_c[1])
        if layer % 2 == 0:
            out_ctx, out_lat = even_mixer(a_ctx, a_lat, cos, sin, ev_w_in[i], ev_w_out[i], ev_q_norm[i],
                                          ev_k_norm[i], ev_dw_w[i], ev_dw_b[i], ev_ln_g[i], ev_ln_b[i],
                                          need_ctx_out=not last)
        else:
            out_ctx, out_lat = odd_mixer(a_ctx, a_lat, cos, sin, od_w_in[i], od_w_out[i], od_lambda[i],
                                         od_subln_g[i], 0.8 - 0.6 * math.exp(-0.3 * layer),
                                         need_ctx_out=not last)
        h_lat = h_lat + mod_l[2] * rms_norm(out_lat, norm_g[layer, 1])
        f_lat = modulate(h_lat, norm_g[layer, 2], mod_l[3], mod_l[4])
        moe_args = (moe_router[layer], moe_bias[layer], moe_w_gate[layer], moe_w_up[layer], moe_w_down[layer],
                    sh_w_gate[layer], sh_w_up[layer], sh_w_down[layer])
        if last:
            y_lat = moe_ffn(f_lat.reshape(-1, d), *moe_args).reshape(b, seq, d)
        else:
            h_ctx = h_ctx + mod_c[2] * rms_norm(out_ctx, norm_g[layer, 1])
            f_ctx = modulate(h_ctx, norm_g[layer, 2], mod_c[3], mod_c[4])
            n_ctx = b * ctx_len
            y = moe_ffn(jnp.concatenate([f_ctx.reshape(-1, d), f_lat.reshape(-1, d)], axis=0), *moe_args)
            h_ctx = h_ctx + mod_c[5] * rms_norm(y[:n_ctx].reshape(b, ctx_len, d), norm_g[layer, 3])
            y_lat = y[n_ctx:].reshape(b, seq, d)
        h_lat = h_lat + mod_l[5] * rms_norm(y_lat, norm_g[layer, 3])
    return h_lat
```

```cpp
#include <hip/hip_runtime.h>
#include <cstdio>
#include <cstdint>

#define MK_DIAG 0
#ifndef MK_MULTI
#define MK_MULTI 0
#endif

#define LAS __attribute__((address_space(3)))
typedef unsigned short bf16_t;
typedef short bf16x8 __attribute__((ext_vector_type(8)));
typedef short s16x4 __attribute__((ext_vector_type(4)));
typedef float f32x4 __attribute__((ext_vector_type(4)));
typedef float f32x2 __attribute__((ext_vector_type(2)));
typedef float f32x16 __attribute__((ext_vector_type(16)));
typedef unsigned u32x4 __attribute__((ext_vector_type(4)));
typedef unsigned u32x2 __attribute__((ext_vector_type(2)));

constexpr int D = 2048, SEQ = 16384, CTXL = 256, MT = SEQ + CTXL;
constexpr int NE = 64, TOPK = 8, EFF = 512;
constexpr int N_IN0 = 3584, N_QKV0 = 1536, N_IN1 = 6144;
constexpr float EPS = 1e-6f;
constexpr float LAM_INIT = 0.35550907f;
constexpr int SH_BASE = SEQ * 0 + (MT * TOPK) + NE * 256;
constexpr int NSLOT = SH_BASE + MT;
constexpr int NTHREADS = 512;
constexpr int LDS_BYTES = 131072 + 1024;
constexpr int LDS_CTL = 131072;

constexpr size_t al256(size_t x) { return (x + 255) & ~(size_t)255; }
constexpr size_t WS_CTL   = 0;
constexpr size_t CTL_BYTES = 32768;
constexpr size_t CTL_CNT  = 16384;
constexpr size_t CTL_KMAX = 16384 + 2048;
constexpr size_t WS_MOD   = CTL_BYTES;
constexpr size_t WS_WIN0  = al256(WS_MOD + 2 * 2 * 12288 * 4);
constexpr size_t WS_WOUT0 = al256(WS_WIN0 + (size_t)N_IN0 * D * 2);
constexpr size_t WS_WIN1  = al256(WS_WOUT0 + (size_t)D * D * 2);
constexpr size_t WS_WOUT1 = al256(WS_WIN1 + (size_t)N_IN1 * D * 2);
constexpr size_t WMOE_E   = (size_t)1024 * D + (size_t)D * EFF;
constexpr size_t WS_WMOE  = al256(WS_WOUT1 + (size_t)D * D * 2);
constexpr size_t WS_HRES  = al256(WS_WMOE + 65 * WMOE_E * 2);
constexpr size_t WS_ABUF  = al256(WS_HRES + (size_t)MT * D * 4);
constexpr size_t WS_QKVU  = al256(WS_ABUF + (size_t)MT * D * 2);
constexpr size_t WS_HG    = al256(WS_QKVU + (size_t)MT * N_IN1 * 2);
constexpr size_t WS_X2    = al256(WS_HG + (size_t)MT * 1024 * 2);
constexpr size_t WS_OUT   = al256(WS_X2 + (size_t)MT * D * 2);
constexpr size_t WS_ACT   = al256(WS_OUT + (size_t)MT * D * 2);
constexpr size_t WS_Y     = al256(WS_ACT + (size_t)NSLOT * EFF * 2);
constexpr size_t WS_TOPE  = al256(WS_Y + (size_t)NSLOT * D * 2);
constexpr size_t WS_TOPW  = al256(WS_TOPE + (size_t)MT * TOPK * 4);
constexpr size_t WS_TOPP  = al256(WS_TOPW + (size_t)MT * TOPK * 4);
constexpr size_t WS_TSLOT = al256(WS_TOPP + (size_t)MT * TOPK * 4);
constexpr size_t WS_STOK  = al256(WS_TSLOT + (size_t)MT * TOPK * 4);
constexpr size_t WS_END   = al256(WS_STOK + (size_t)NSLOT * 4);

struct Args { const float* in[27]; float* out; unsigned char* ws; int ph_lo, ph_hi; };

__device__ __forceinline__ float bflo(unsigned x) { return __uint_as_float(x << 16); }
__device__ __forceinline__ float bfhi(unsigned x) { return __uint_as_float(x & 0xffff0000u); }
__device__ __forceinline__ float bf2f(bf16_t b) { return __uint_as_float(((unsigned)b) << 16); }
__device__ __forceinline__ unsigned cvtpk(float lo, float hi) { unsigned r; asm("v_cvt_pk_bf16_f32 %0, %1, %2" : "=v"(r) : "v"(lo), "v"(hi)); return r; }
__device__ __forceinline__ bf16_t f2bf(float x) { return (bf16_t)(cvtpk(x, 0.f) & 0xffffu); }
__device__ __forceinline__ float wave_sum(float v) {
#pragma unroll
  for (int o = 32; o; o >>= 1) v += __shfl_xor(v, o);
  return v;
}
__device__ __forceinline__ float sigmoidf_(float x) { return 1.f / (1.f + expf(-x)); }

#define XB_TMO      128
#define XB_XCNT(j)  (256  + 64 * (j))
#define XB_XSUB(j)  (1280 + 64 * (j))
#define XB_XGEN(j)  (2304 + 64 * (j))
#define XB_TOP      3328
#define XB_TOPGEN   3392
#define XCD_BAR_WORDS 3456
#define XB_SPIN_CAP (1u << 22)
__device__ __forceinline__ unsigned xb_ld(unsigned* p)              { return __hip_atomic_load(p, __ATOMIC_RELAXED, __HIP_MEMORY_SCOPE_AGENT); }
__device__ __forceinline__ unsigned xb_add(unsigned* p, unsigned v) { return __hip_atomic_fetch_add(p, v, __ATOMIC_RELAXED, __HIP_MEMORY_SCOPE_AGENT); }
__device__ __forceinline__ unsigned xb_xcc_id() { return (unsigned)__builtin_amdgcn_s_getreg((3 << 11) | 20) & 0xFu; }
#define XB_SPIN(cond, bar) do { unsigned _sp = 0; while (cond) { __builtin_amdgcn_s_sleep(1); \
    if ((++_sp & 255u) == 0u) { if (xb_ld(&(bar)[XB_TMO])) break; if (_sp > XB_SPIN_CAP) { atomicAdd(&(bar)[XB_TMO], 1u); break; } } } } while (0)
struct XcdBarrier { unsigned* bar; unsigned x; volatile LAS unsigned* st; };
__device__ __forceinline__ XcdBarrier xcd_barrier_post(unsigned* bar, volatile LAS unsigned* st) {
    XcdBarrier b; b.bar = bar; b.x = xb_xcc_id(); b.st = st;
    if (threadIdx.x == 0) (void)xb_add(&bar[XB_XCNT(b.x)], 1u);
    return b;
}
__device__ __forceinline__ void xcd_barrier_complete(unsigned* bar, unsigned x, unsigned& nloc, unsigned& nx) {
    const unsigned G = gridDim.x * gridDim.y * gridDim.z;
    unsigned sum, cnt, mine, sp = 0u;
    for (;;) {
        sum = 0u; cnt = 0u; mine = 0u;
#pragma unroll
        for (unsigned j = 0; j < 16; ++j) { const unsigned c = xb_ld(&bar[XB_XCNT(j)]); sum += c; cnt += (c > 0u) ? 1u : 0u; mine = (j == x) ? c : mine; }
        if (sum == G) break;
        __builtin_amdgcn_s_sleep(1);
        if ((++sp & 255u) == 0u) { if (xb_ld(&bar[XB_TMO])) break; if (sp > XB_SPIN_CAP) { atomicAdd(&bar[XB_TMO], 1u); break; } }
    }
    nloc = mine > 0u ? mine : 1u; nx = cnt > 0u ? cnt : 1u;
}
__device__ __forceinline__ void xcd_barrier(const XcdBarrier& b) {
    asm volatile("s_waitcnt vmcnt(0)" ::: "memory");
    __syncthreads();
    if (threadIdx.x == 0) {
        unsigned* bar = b.bar;
        __builtin_amdgcn_s_waitcnt(0);
        unsigned nloc = b.st[0], nx = b.st[1];
        if (nloc == 0u) { xcd_barrier_complete(bar, b.x, nloc, nx); b.st[0] = nloc; b.st[1] = nx; }
        const unsigned old = xb_add(&bar[XB_XSUB(b.x)], 1u);
        const unsigned gen = old / nloc;
        if (old + 1u == (gen + 1u) * nloc) {
            __builtin_amdgcn_fence(__ATOMIC_RELEASE, "agent");
            asm volatile("s_waitcnt vmcnt(0)" ::: "memory");
            const unsigned og = xb_add(&bar[XB_TOP], 1u);
            const unsigned tg = og / nx;
            if (og + 1u == (tg + 1u) * nx) xb_add(&bar[XB_TOPGEN], 1u);
            else XB_SPIN(xb_ld(&bar[XB_TOPGEN]) == tg, bar);
            __builtin_amdgcn_fence(__ATOMIC_ACQUIRE, "agent");
            xb_add(&bar[XB_XGEN(b.x)], 1u);
            asm volatile("s_waitcnt vmcnt(0)" ::: "memory");
        } else {
            XB_SPIN(xb_ld(&bar[XB_XGEN(b.x)]) == gen, bar);
            __builtin_amdgcn_fence(__ATOMIC_ACQUIRE, "agent");
            asm volatile("s_waitcnt vmcnt(0)" ::: "memory");
        }
    }
    __syncthreads();
}

__device__ __forceinline__ int lds_byte(int r, int c) {
  int st = (r >> 4) * 2 + (c >> 5), rr = r & 15, cc = c & 31, ob = rr * 64 + cc * 2;
  return st * 1024 + (ob ^ (((ob >> 9) & 1) << 5));
}
#define GLDS(gp, lp) __builtin_amdgcn_global_load_lds((const unsigned*)(gp), (LAS unsigned*)(lp), 16, 0, 0)
#define WAIT_V(n) asm volatile("s_waitcnt vmcnt(" #n ")" ::: "memory")
#define WAIT_L(n) asm volatile("s_waitcnt lgkmcnt(" #n ")" ::: "memory")
#define BAR __builtin_amdgcn_s_barrier()
#define SCHED __builtin_amdgcn_sched_barrier(0)

template <bool GATHER, class Epi>
__device__ __forceinline__ void gemm_tile(const bf16_t* __restrict__ A, const int lda, const int* __restrict__ tok, const int brow,
                                          const bf16_t* __restrict__ Bt, const int ldb, const int bcol, const int K,
                                          LAS char* shm, const Epi& epi) {
#define G_SA(b, h) (shm + ((b) * 2 + (h)) * 16384)
#define G_SB(b, h) (shm + (4 + (b) * 2 + (h)) * 16384)
  int tid = threadIdx.x; asm volatile("" : "+v"(tid)); tid &= 511;
  int wid = tid >> 6, lane = tid & 63, wr = wid >> 2, wc = wid & 3, fr = lane & 15, fq = lane >> 4;
  int ao0, ao1, ao2, ao3, bo;
  {
    const int sb = (tid & 63) * 16, swz = sb ^ (((sb >> 9) & 1) << 5);
    const int R0 = ((tid >> 6) >> 1) * 16 + (swz >> 6), C0 = ((tid >> 6) & 1) * 32 + ((swz & 63) >> 1);
    if (GATHER) { ao0 = tok[R0] * lda + C0; ao1 = tok[R0 + 64] * lda + C0; ao2 = tok[R0 + 128] * lda + C0; ao3 = tok[R0 + 192] * lda + C0; }
    else { ao0 = (brow + R0) * lda + C0; ao1 = ao0 + 64 * lda; ao2 = ao0 + 128 * lda; ao3 = ao0 + 192 * lda; }
    bo = (bcol + R0) * ldb + C0;
  }
  const int lo = tid * 16;
#define STAGE_A0(P, kt) do { GLDS(A + ao0 + (kt) * 64, (P) + lo); GLDS(A + ao1 + (kt) * 64, (P) + lo + 8192); } while (0)
#define STAGE_A1(P, kt) do { GLDS(A + ao2 + (kt) * 64, (P) + lo); GLDS(A + ao3 + (kt) * 64, (P) + lo + 8192); } while (0)
#define STAGE_B0(P, kt) do { GLDS(Bt + bo + (kt) * 64, (P) + lo); GLDS(Bt + bo + 64 * ldb + (kt) * 64, (P) + lo + 8192); } while (0)
#define STAGE_B1(P, kt) do { GLDS(Bt + bo + 128 * ldb + (kt) * 64, (P) + lo); GLDS(Bt + bo + 192 * ldb + (kt) * 64, (P) + lo + 8192); } while (0)
#define LDA(dst, b, h) _Pragma("unroll") for (int m = 0; m < 4; ++m) _Pragma("unroll") for (int k = 0; k < 2; ++k) \
    dst[m][k] = *(LAS const bf16x8*)(G_SA(b, h) + lds_byte(wr * 64 + m * 16 + fr, k * 32 + fq * 8))
#define LDB(dst, b, h) _Pragma("unroll") for (int n = 0; n < 2; ++n) _Pragma("unroll") for (int k = 0; k < 2; ++k) \
    dst[n][k] = *(LAS const bf16x8*)(G_SB(b, h) + lds_byte(wc * 32 + n * 16 + fr, k * 32 + fq * 8))
#define MMA(ai, bj, At_, Bt_) do { __builtin_amdgcn_s_setprio(1); \
    _Pragma("unroll") for (int m = 0; m < 4; ++m) _Pragma("unroll") for (int n = 0; n < 2; ++n) _Pragma("unroll") for (int k = 0; k < 2; ++k) \
      acc[ai][bj][m][n] = __builtin_amdgcn_mfma_f32_16x16x32_bf16(Bt_[n][k], At_[m][k], acc[ai][bj][m][n], 0, 0, 0); \
    __builtin_amdgcn_s_setprio(0); } while (0)

  f32x4 acc[2][2][4][2] = {};
  bf16x8 At[4][2], B0[2][2], B1[2][2];
  const int nt = K / 64;
  STAGE_B0(G_SB(0, 0), 0); STAGE_A0(G_SA(0, 0), 0);
  STAGE_B1(G_SB(0, 1), 0); STAGE_A1(G_SA(0, 1), 0);
  if (wr == 1) BAR;
  WAIT_V(4); BAR;
  STAGE_B0(G_SB(1, 0), 1); STAGE_A0(G_SA(1, 0), 1); STAGE_B1(G_SB(1, 1), 1);
  WAIT_V(6); BAR;
  for (int t = 0; t < nt - 2; t += 2) {
    LDB(B0, 0, 0); SCHED; LDA(At, 0, 0); STAGE_A1(G_SA(1, 1), t + 1);
    WAIT_L(8); BAR; WAIT_L(0); MMA(0, 0, At, B0); BAR; SCHED;
    LDB(B1, 0, 1); STAGE_B0(G_SB(0, 0), t + 2);
    BAR; WAIT_L(0); MMA(0, 1, At, B1); BAR;
    LDA(At, 0, 1); STAGE_A0(G_SA(0, 0), t + 2);
    BAR; WAIT_L(0); MMA(1, 0, At, B0); BAR; SCHED;
    STAGE_B1(G_SB(0, 1), t + 2);
    WAIT_V(6); BAR; MMA(1, 1, At, B1); BAR;
    LDB(B0, 1, 0); SCHED; LDA(At, 1, 0); STAGE_A1(G_SA(0, 1), t + 2);
    WAIT_L(8); BAR; WAIT_L(0); MMA(0, 0, At, B0); BAR; SCHED;
    LDB(B1, 1, 1); STAGE_B0(G_SB(1, 0), t + 3);
    BAR; WAIT_L(0); MMA(0, 1, At, B1); BAR;
    LDA(At, 1, 1); STAGE_A0(G_SA(1, 0), t + 3);
    BAR; WAIT_L(0); MMA(1, 0, At, B0); BAR; SCHED;
    STAGE_B1(G_SB(1, 1), t + 3);
    WAIT_V(6); BAR; MMA(1, 1, At, B1); BAR;
  }
  { LDB(B0, 0, 0); WAIT_V(0); LDA(At, 0, 0); STAGE_A1(G_SA(1, 1), nt - 1);
    BAR; WAIT_L(0); MMA(0, 0, At, B0); BAR;
    LDB(B1, 0, 1); BAR; WAIT_L(0); MMA(0, 1, At, B1); BAR;
    LDA(At, 0, 1); WAIT_V(4); BAR; WAIT_L(0); MMA(1, 0, At, B0); MMA(1, 1, At, B1); BAR; }
  { LDB(B0, 1, 0); LDA(At, 1, 0); WAIT_V(2); BAR; WAIT_L(0); MMA(0, 0, At, B0); BAR;
    LDB(B1, 1, 1); WAIT_V(0); BAR; WAIT_L(0); MMA(0, 1, At, B1); BAR;
    LDA(At, 1, 1); BAR; WAIT_L(0); MMA(1, 0, At, B0); MMA(1, 1, At, B1); BAR; }
  if (wr == 0) BAR;
  int tz = threadIdx.x; asm volatile("" : "+v"(tz)); wid = tz >> 6; lane = tz & 63; wr = wid >> 2; wc = wid & 3; fr = lane & 15; fq = lane >> 4;
  epi(acc, brow, bcol, wr, wc, fr, fq);
#undef G_SA
#undef G_SB
#undef STAGE_A0
#undef STAGE_A1
#undef STAGE_B0
#undef STAGE_B1
#undef LDA
#undef LDB
#undef MMA
}

struct EpiPlain {
  bf16_t* C; int ldc;
  __device__ __forceinline__ void operator()(const f32x4 (&acc)[2][2][4][2], int brow, int bcol, int wr, int wc, int fr, int fq) const {
#pragma unroll
    for (int ai = 0; ai < 2; ++ai)
#pragma unroll
      for (int m = 0; m < 4; ++m) {
        bf16_t* rp = C + (size_t)(brow + ai * 128 + wr * 64 + m * 16 + fr) * ldc + bcol + wc * 32 + fq * 8;
#pragma unroll
        for (int bj = 0; bj < 2; ++bj) {
          u32x4 v = {cvtpk(acc[ai][bj][m][0][0], acc[ai][bj][m][0][1]), cvtpk(acc[ai][bj][m][0][2], acc[ai][bj][m][0][3]),
                     cvtpk(acc[ai][bj][m][1][0], acc[ai][bj][m][1][1]), cvtpk(acc[ai][bj][m][1][2], acc[ai][bj][m][1][3])};
          *(u32x4*)(rp + bj * 128) = v;
        }
      }
  }
};
template <int MODE>
struct EpiPair {
  bf16_t* C; int ldc; int colbase;
  __device__ __forceinline__ void operator()(const f32x4 (&acc)[2][2][4][2], int brow, int bcol, int wr, int wc, int fr, int fq) const {
#pragma unroll
    for (int ai = 0; ai < 2; ++ai)
#pragma unroll
      for (int m = 0; m < 4; ++m) {
        bf16_t* rp = C + (size_t)(brow + ai * 128 + wr * 64 + m * 16 + fr) * ldc + ((bcol - colbase) >> 1) + wc * 16 + fq * 4;
#pragma unroll
        for (int bj = 0; bj < 2; ++bj) {
          float r[4];
#pragma unroll
          for (int j = 0; j < 4; ++j) {
            const float x0 = acc[ai][bj][m][0][j], x1 = acc[ai][bj][m][1][j];
            r[j] = MODE == 0 ? x0 * sigmoidf_(x1) : x0 * sigmoidf_(x0) * x1;
          }
          u32x2 v = {cvtpk(r[0], r[1]), cvtpk(r[2], r[3])};
          *(u32x2*)(rp + bj * 64) = v;
        }
      }
  }
};
struct EpiG1 {
  EpiPlain p; EpiPair<0> g; int nplain;
  __device__ __forceinline__ void operator()(const f32x4 (&acc)[2][2][4][2], int brow, int bcol, int wr, int wc, int fr, int fq) const {
    if (bcol < nplain) p(acc, brow, bcol, wr, wc, fr, fq); else g(acc, brow, bcol, wr, wc, fr, fq);
  }
};

typedef int v8i __attribute__((ext_vector_type(8)));
typedef int v4i __attribute__((ext_vector_type(4)));
__device__ __forceinline__ int lds8(int r, int c) { return r * 128 + ((c ^ ((r >> 1) & 7)) << 4); }
template <bool GATHER, int lda, int ldb, int K, class Epi, class S>
__device__ __forceinline__ void gemm8_run(const unsigned char* __restrict__ A, const int* __restrict__ stok,
                                          LAS char* shm, const Epi& epi, const S& sched) {
#define G_SA(b, h) (shm + ((b) * 2 + (h)) * 16384)
#define G_SB(b, h) (shm + (4 + (b) * 2 + (h)) * 16384)
  int tid = threadIdx.x; asm volatile("" : "+v"(tid)); tid &= 511;
  int wid = tid >> 6, lane = tid & 63, wr = wid >> 2, wc = wid & 3, fr = lane & 15, fq = lane >> 4;
  unsigned ao0, ao1, ao2, ao3, bo;
  int R0 = 8 * wid + (lane >> 3), C0 = ((lane & 7) ^ ((R0 >> 1) & 7)) << 4;
  const int lo = __builtin_amdgcn_readfirstlane(tid >> 6) * 1024;
  int brow, bcol; const unsigned char* Bt;
  int ui = 0;
  if (!sched.unit(ui, brow, Bt, bcol)) return;
#define SETOFF(br, bc) do { if (GATHER) { const int* _t = stok + (br); ao0 = (unsigned)(_t[R0] * lda + C0); ao1 = (unsigned)(_t[R0 + 64] * lda + C0); ao2 = (unsigned)(_t[R0 + 128] * lda + C0); ao3 = (unsigned)(_t[R0 + 192] * lda + C0); } \
    else { ao0 = (unsigned)(((br) + R0) * lda + C0); ao1 = ao0 + 64u * lda; ao2 = ao0 + 128u * lda; ao3 = ao0 + 192u * lda; } \
    bo = (unsigned)(((bc) + R0) * ldb + C0); } while (0)
#define STAGE_A0(P, kt) do { GLDS((A + (kt) * 128) + ao0, (P) + lo); GLDS((A + (kt) * 128) + ao1, (P) + lo + 8192); } while (0)
#define STAGE_A1(P, kt) do { GLDS((A + (kt) * 128) + ao2, (P) + lo); GLDS((A + (kt) * 128) + ao3, (P) + lo + 8192); } while (0)
#define STAGE_B0(P, kt) do { GLDS((Bt + (kt) * 128) + bo, (P) + lo); GLDS((Bt + 64 * ldb + (kt) * 128) + bo, (P) + lo + 8192); } while (0)
#define STAGE_B1(P, kt) do { GLDS((Bt + 128 * ldb + (kt) * 128) + bo, (P) + lo); GLDS((Bt + 192 * ldb + (kt) * 128) + bo, (P) + lo + 8192); } while (0)
#define PRO() do { STAGE_B0(G_SB(0, 0), 0); STAGE_A0(G_SA(0, 0), 0); STAGE_B1(G_SB(0, 1), 0); STAGE_A1(G_SA(0, 1), 0); } while (0)
  const int fx = (fq ^ ((fr >> 1) & 7)) << 4;
  const int fa0 = (wr * 64 + fr) * 128 + fx, fb0 = (wc * 32 + fr) * 128 + fx;
#define FRAG8(dst, p0, p1) do { const v4i _x = *(LAS const v4i*)(p0); const v4i _y = *(LAS const v4i*)(p1); \
    dst = (v8i){_x[0], _x[1], _x[2], _x[3], _y[0], _y[1], _y[2], _y[3]}; } while (0)
#define LDA(dst, b, h) do { int fa1 = fa0; asm volatile("v_xor_b32 %0, 64, %0" : "+v"(fa1)); \
    _Pragma("unroll") for (int m = 0; m < 4; ++m) FRAG8(dst[m], G_SA(b, h) + fa0 + m * 2048, G_SA(b, h) + fa1 + m * 2048); } while (0)
#define LDB(dst, b, h) do { int fb1 = fb0; asm volatile("v_xor_b32 %0, 64, %0" : "+v"(fb1)); \
    _Pragma("unroll") for (int n = 0; n < 2; ++n) FRAG8(dst[n], G_SB(b, h) + fb0 + n * 2048, G_SB(b, h) + fb1 + n * 2048); } while (0)
#define MMA(ai, bj, At_, Bt_) do { __builtin_amdgcn_s_setprio(1); \
    _Pragma("unroll") for (int m = 0; m < 4; ++m) _Pragma("unroll") for (int n = 0; n < 2; ++n) \
      asm volatile("v_mfma_scale_f32_16x16x128_f8f6f4 %0, %1, %2, %0, %3, %3 op_sel_hi:[0,0,0]" : "+v"(acc[ai][bj][m][n]) : "v"(Bt_[n]), "v"(At_[m]), "v"(sc1)); \
    __builtin_amdgcn_s_setprio(0); } while (0)
  int sc1; asm volatile("v_mov_b32 %0, 0x7f7f7f7f" : "=v"(sc1));
  const int nt = K / 128;
  SETOFF(brow, bcol); PRO();
  bool first = true;
  for (;;) {
    f32x4 acc[2][2][4][2] = {};
    v8i At[4], B0[2], B1[2];
    if (wr == 1) BAR;
    if (first) WAIT_V(4); else WAIT_V(0);
    BAR;
    STAGE_B0(G_SB(1, 0), 1); STAGE_A0(G_SA(1, 0), 1); STAGE_B1(G_SB(1, 1), 1);
    WAIT_V(6); BAR;
    for (int t = 0; t < nt - 2; t += 2) {
      LDB(B0, 0, 0); SCHED; LDA(At, 0, 0); STAGE_A1(G_SA(1, 1), t + 1);
      WAIT_L(8); BAR; WAIT_L(0); MMA(0, 0, At, B0); BAR; SCHED;
      LDB(B1, 0, 1); STAGE_B0(G_SB(0, 0), t + 2);
      BAR; WAIT_L(0); MMA(0, 1, At, B1); BAR;
      LDA(At, 0, 1); STAGE_A0(G_SA(0, 0), t + 2);
      BAR; WAIT_L(0); MMA(1, 0, At, B0); BAR; SCHED;
      STAGE_B1(G_SB(0, 1), t + 2);
      WAIT_V(6); BAR; MMA(1, 1, At, B1); BAR;
      LDB(B0, 1, 0); SCHED; LDA(At, 1, 0); STAGE_A1(G_SA(0, 1), t + 2);
      WAIT_L(8); BAR; WAIT_L(0); MMA(0, 0, At, B0); BAR; SCHED;
      LDB(B1, 1, 1); STAGE_B0(G_SB(1, 0), t + 3);
      BAR; WAIT_L(0); MMA(0, 1, At, B1); BAR;
      LDA(At, 1, 1); STAGE_A0(G_SA(1, 0), t + 3);
      BAR; WAIT_L(0); MMA(1, 0, At, B0); BAR; SCHED;
      STAGE_B1(G_SB(1, 1), t + 3);
      WAIT_V(6); BAR; MMA(1, 1, At, B1); BAR;
    }
    { LDB(B0, 0, 0); WAIT_V(0); LDA(At, 0, 0); STAGE_A1(G_SA(1, 1), nt - 1);
      BAR; WAIT_L(0); MMA(0, 0, At, B0); BAR;
      LDB(B1, 0, 1); BAR; WAIT_L(0); MMA(0, 1, At, B1); BAR;
      LDA(At, 0, 1); WAIT_V(4); BAR; WAIT_L(0); MMA(1, 0, At, B0); MMA(1, 1, At, B1); BAR; }
    { LDB(B0, 1, 0); LDA(At, 1, 0); WAIT_V(2); BAR; WAIT_L(0); MMA(0, 0, At, B0); BAR;
      LDB(B1, 1, 1); WAIT_V(0); BAR; WAIT_L(0); MMA(0, 1, At, B1); BAR;
      LDA(At, 1, 1); BAR; WAIT_L(0); MMA(1, 0, At, B0); MMA(1, 1, At, B1); BAR; }
    if (wr == 0) BAR;
    const int cbrow = brow, cbcol = bcol;
    { int tz = threadIdx.x; asm volatile("" : "+v"(tz)); tz &= 511; wid = tz >> 6; lane = tz & 63; wr = wid >> 2; wc = wid & 3; fr = lane & 15; fq = lane >> 4;
      R0 = 8 * wid + (lane >> 3); C0 = ((lane & 7) ^ ((R0 >> 1) & 7)) << 4; }
    ++ui;
    const bool more = sched.unit(ui, brow, Bt, bcol);
    if (more) { SETOFF(brow, bcol); asm volatile("" ::: "memory"); PRO(); asm volatile("" ::: "memory"); }
    asm volatile("s_nop 15\n\ts_nop 15\n\ts_nop 7" ::: "memory");
    epi(acc, cbrow, cbcol, wr, wc, fr, fq);
    if (!more) break;
    first = false;
  }
#undef G_SA
#undef G_SB
#undef SETOFF
#undef STAGE_A0
#undef STAGE_A1
#undef STAGE_B0
#undef STAGE_B1
#undef PRO
#undef FRAG8
#undef LDA
#undef LDB
#undef MMA
}
__device__ __forceinline__ float clamp8(float x) { return fminf(fmaxf(x, -448.f), 448.f); }
__device__ __forceinline__ unsigned pack_fp8x4(float a, float b, float c, float d) {
  int p = __builtin_amdgcn_cvt_pk_fp8_f32(clamp8(a), clamp8(b), 0, false); p = __builtin_amdgcn_cvt_pk_fp8_f32(clamp8(c), clamp8(d), p, true); return (unsigned)p; }
struct EpiSwiGLU8 {
  unsigned char* C; int ldc;
  __device__ __forceinline__ void operator()(const f32x4 (&acc)[2][2][4][2], int brow, int bcol, int wr, int wc, int fr, int fq) const {
    constexpr float S = 1.f / 256.f;
#pragma unroll
    for (int ai = 0; ai < 2; ++ai)
#pragma unroll
      for (int m = 0; m < 4; ++m) {
        unsigned char* rp = C + (size_t)(brow + ai * 128 + wr * 64 + m * 16 + fr) * ldc + (bcol >> 1) + wc * 16 + fq * 4;
#pragma unroll
        for (int bj = 0; bj < 2; ++bj) {
          float r[4];
#pragma unroll
          for (int j = 0; j < 4; ++j) { const float g = acc[ai][bj][m][0][j] * S, u = acc[ai][bj][m][1][j] * S; r[j] = g * sigmoidf_(g) * u; }
          *(unsigned*)(rp + bj * 64) = pack_fp8x4(r[0], r[1], r[2], r[3]);
        }
      }
  }
};
struct EpiPlainS {
  bf16_t* C; int ldc; float sc;
  __device__ __forceinline__ void operator()(const f32x4 (&acc)[2][2][4][2], int brow, int bcol, int wr, int wc, int fr, int fq) const {
#pragma unroll
    for (int ai = 0; ai < 2; ++ai)
#pragma unroll
      for (int m = 0; m < 4; ++m) {
        bf16_t* rp = C + (size_t)(brow + ai * 128 + wr * 64 + m * 16 + fr) * ldc + bcol + wc * 32 + fq * 8;
#pragma unroll
        for (int bj = 0; bj < 2; ++bj) {
          u32x4 v = {cvtpk(acc[ai][bj][m][0][0] * sc, acc[ai][bj][m][0][1] * sc), cvtpk(acc[ai][bj][m][0][2] * sc, acc[ai][bj][m][0][3] * sc),
                     cvtpk(acc[ai][bj][m][1][0] * sc, acc[ai][bj][m][1][1] * sc), cvtpk(acc[ai][bj][m][1][2] * sc, acc[ai][bj][m][1][3] * sc)};
          *(u32x4*)(rp + bj * 128) = v;
        }
      }
  }
};

__device__ __forceinline__ void dense_unit(int u, int nM, int nN, int& pm, int& pn) {
  const int nwg = nM * nN, NX = 8, WGM = 8;
  int wgid = u;
  { const int q = nwg / NX, r = nwg % NX, xcd = wgid % NX, off = wgid / NX; wgid = (xcd < r ? xcd * (q + 1) : r * (q + 1) + (xcd - r) * q) + off; }
  const int nig = WGM * nN, gid = wgid / nig, fm = gid * WGM, gsz = min(nM - fm, WGM);
  pm = fm + ((wgid % nig) % gsz); pn = (wgid % nig) / gsz;
}

namespace at {
constexpr int DH = 128, NW = 8, QBLK = 32, KVBLK = 64;
constexpr float SCALE = 0.088388347648318440f;
constexpr float QC = SCALE * 1.4426950408889634f;
constexpr int SHM_V = KVBLK * DH * 2, SHM_K = KVBLK * DH * 2;
#define KSWZ(row, colB) ((row) * 256 + ((colB) ^ (((row) & 7) << 4)))
__device__ __forceinline__ int crow(int r, int hi) { return (r & 3) + 8 * (r >> 2) + 4 * hi; }
__device__ __forceinline__ unsigned cvtpkv(float lo, float hi) { unsigned r; asm volatile("v_cvt_pk_bf16_f32 %0, %1, %2" : "=v"(r) : "v"(lo), "v"(hi)); return r; }
#define PK4(P, BASE, OUT) do { unsigned a0 = cvtpkv(P[BASE + 0], P[BASE + 1]), a1 = cvtpkv(P[BASE + 2], P[BASE + 3]);   \
    unsigned b0 = cvtpkv(P[BASE + 4], P[BASE + 5]), b1 = cvtpkv(P[BASE + 6], P[BASE + 7]);                              \
    auto r0 = __builtin_amdgcn_permlane32_swap(a0, b0, false, false); auto r1 = __builtin_amdgcn_permlane32_swap(a1, b1, false, false); \
    u32x4 w = {r0[0], r1[0], r0[1], r1[1]}; OUT = *reinterpret_cast<bf16x8*>(&w); } while (0)
__device__ __forceinline__ float load_q(const bf16_t* __restrict__ Qw, bf16x8 (&qr)[8], float kmax2) {
  float ss = 0;
#pragma unroll
  for (int d0 = 0; d0 < 8; ++d0) {
    const u32x4 raw = *reinterpret_cast<const u32x4*>(Qw + d0 * 16); u32x4 o;
#pragma unroll
    for (int i = 0; i < 4; ++i) { const unsigned pk = cvtpk(bflo(raw[i]) * QC, bfhi(raw[i]) * QC); o[i] = pk; const float a = bflo(pk), b = bfhi(pk); ss += a * a + b * b; }
    qr[d0] = *reinterpret_cast<bf16x8*>(&o);
  }
  { auto rr = __builtin_amdgcn_permlane32_swap(__float_as_uint(ss), __float_as_uint(ss), false, false); ss = __uint_as_float(rr[0]) + __uint_as_float(rr[1]); }
  return -(sqrtf(ss * kmax2) * 1.01f + 1e-3f);
}
__device__ __forceinline__ void exp16(f32x16& p) {
#pragma unroll
  for (int r = 0; r < 16; ++r) p[r] = __builtin_amdgcn_exp2f(p[r]);
}
__device__ __forceinline__ float sum16(const f32x16& p) { float s = 0;
#pragma unroll
  for (int r = 0; r < 16; ++r) s += p[r];
  return s; }
__device__ __forceinline__ void qkt(f32x16& p0, f32x16& p1, LAS const char* Ks, const bf16x8* qr, int r32, int hi, float nmc) {
#pragma unroll
  for (int r = 0; r < 16; ++r) { p0[r] = nmc; p1[r] = nmc; }
#pragma unroll
  for (int d0 = 0; d0 < 8; ++d0) { int cb = (d0 * 16 + hi * 8) * 2;
    bf16x8 b0 = *(LAS const bf16x8*)(Ks + KSWZ(r32, cb));
    bf16x8 b1 = *(LAS const bf16x8*)(Ks + KSWZ(32 + r32, cb));
    p0 = __builtin_amdgcn_mfma_f32_32x32x16_bf16(b0, qr[d0], p0, 0, 0, 0);
    p1 = __builtin_amdgcn_mfma_f32_32x32x16_bf16(b1, qr[d0], p1, 0, 0, 0); }
}
__device__ __forceinline__ int v_st(int k, int c) { const int kk = (k & ~0xC) | ((k & 4) << 1) | ((k & 8) >> 1); return ((kk >> 3) * 4 + (c >> 5)) * 512 + ((kk & 7) * 32 + (c & 31)) * 2; }
__device__ __forceinline__ int v_st256(int k, int c) { const int kk = (k & ~0xC) | ((k & 4) << 1) | ((k & 8) >> 1); return ((kk >> 3) * 8 + (c >> 5)) * 512 + ((kk & 7) * 32 + (c & 31)) * 2; }
__device__ __forceinline__ int v_rd_base(int lane) { return ((lane & 3) << 3) | (((lane >> 2) & 3) << 6) | (((lane >> 4) & 1) << 5) | (((lane >> 5) & 1) << 8); }
template <int OFF> __device__ __forceinline__ s16x4 tr_read(int vb) {
  s16x4 r; asm volatile("ds_read_b64_tr_b16 %0, %1 offset:%2" : "=&v"(r) : "v"(vb), "i"(OFF) : "memory"); return r;
}
template <int BASE, int KS, int HS> __device__ __forceinline__ void pv_one(f32x16& od, int vb, bf16x8 pa0, bf16x8 pa1, bf16x8 pa2, bf16x8 pa3) {
  const s16x4 l0 = tr_read<BASE>(vb), h0 = tr_read<BASE + HS>(vb), l1 = tr_read<BASE + KS>(vb), h1 = tr_read<BASE + KS + HS>(vb);
  const s16x4 l2 = tr_read<BASE + 2 * KS>(vb), h2 = tr_read<BASE + 2 * KS + HS>(vb), l3 = tr_read<BASE + 3 * KS>(vb), h3 = tr_read<BASE + 3 * KS + HS>(vb);
  asm volatile("s_waitcnt lgkmcnt(0)" ::: "memory"); SCHED;
#define PK(L, H) (bf16x8){L[0], L[1], L[2], L[3], H[0], H[1], H[2], H[3]}
  od = __builtin_amdgcn_mfma_f32_32x32x16_bf16(pa0, PK(l0, h0), od, 0, 0, 0);
  od = __builtin_amdgcn_mfma_f32_32x32x16_bf16(pa1, PK(l1, h1), od, 0, 0, 0);
  od = __builtin_amdgcn_mfma_f32_32x32x16_bf16(pa2, PK(l2, h2), od, 0, 0, 0);
  od = __builtin_amdgcn_mfma_f32_32x32x16_bf16(pa3, PK(l3, h3), od, 0, 0, 0);
#undef PK
}
__device__ __forceinline__ void pv_d0(f32x16* o, int vb, bf16x8 pa0, bf16x8 pa1, bf16x8 pa2, bf16x8 pa3) {
  pv_one<0, 4096, 2048>(o[0], vb, pa0, pa1, pa2, pa3); pv_one<512, 4096, 2048>(o[1], vb, pa0, pa1, pa2, pa3);
  pv_one<1024, 4096, 2048>(o[2], vb, pa0, pa1, pa2, pa3); pv_one<1536, 4096, 2048>(o[3], vb, pa0, pa1, pa2, pa3);
}
__device__ __forceinline__ void pv_d0_256(f32x16* o, int vb, bf16x8 pa0, bf16x8 pa1, bf16x8 pa2, bf16x8 pa3) {
  pv_one<0, 8192, 4096>(o[0], vb, pa0, pa1, pa2, pa3); pv_one<512, 8192, 4096>(o[1], vb, pa0, pa1, pa2, pa3);
  pv_one<1024, 8192, 4096>(o[2], vb, pa0, pa1, pa2, pa3); pv_one<1536, 8192, 4096>(o[3], vb, pa0, pa1, pa2, pa3);
}
__device__ __forceinline__ void store_o(const f32x16* o, float l_tot, LAS float* li, bf16_t* __restrict__ Ow, int ldo, int r32, int hi) {
  if (hi == 0) li[r32] = l_tot; asm volatile("s_waitcnt lgkmcnt(0)" ::: "memory");
  float rli[16];
#pragma unroll
  for (int r = 0; r < 16; ++r) rli[r] = __builtin_amdgcn_rcpf(li[crow(r, hi)]);
#pragma unroll
  for (int r = 0; r < 16; ++r) { const int orow = crow(r, hi);
#pragma unroll
    for (int d0 = 0; d0 < 4; ++d0) Ow[(long)orow * ldo + d0 * 32 + r32] = f2bf(o[d0][r] * rli[r]); }
}

__device__ __forceinline__ int unswap23(int kk) { return (kk & ~0xC) | ((kk & 4) << 1) | ((kk & 8) >> 1); }
__device__ __forceinline__ int k_dma_voff(int wid, int lane, int ldk) {
  const int row = 4 * wid + (lane >> 4); return row * ldk * 2 + (((lane & 15) * 16) ^ ((row & 7) << 4)); }
#define DMA16(rs, ldsp, voff, soff) __builtin_amdgcn_raw_ptr_buffer_load_lds(rs, (LAS void*)(ldsp), 16, voff, soff, 0, 0)

constexpr int SHM_T = SHM_K + SHM_V;
__device__ __forceinline__ void attn_body(const bf16_t* __restrict__ Qb, const int ldq, const bf16_t* __restrict__ Kh, const bf16_t* __restrict__ Vh, const int ldk,
                                          bf16_t* __restrict__ Ob, const int ldo, const int seq, const float kmax2, LAS char* lds) {
  int tid = threadIdx.x; asm volatile("" : "+v"(tid)); tid &= 511;
  const int wid = tid >> 6, lane = tid & 63, r32 = lane & 31, hi = lane >> 5;
  LAS float* li_l = (LAS float*)(lds + 3 * SHM_T) + wid * 64;
  float l_reg = 0; f32x16 o[4] = {}; bf16x8 qr[8];
  const float nmc = load_q(Qb + (long)(wid * QBLK + r32) * ldq + hi * 8, qr, kmax2);
  const int vrb = v_rd_base(lane);
  const int kvo = k_dma_voff(wid, lane, ldk);
  const int vvo = unswap23(8 * (wid >> 1) + ((lane & 31) >> 2)) * ldk * 2 + ((2 * (wid & 1) + (lane >> 5)) * 32 + (lane & 3) * 8) * 2;
  const int l32 = 64 * ldk, pz = wid * 1024;
  const __amdgpu_buffer_rsrc_t krs = __builtin_amdgcn_make_buffer_rsrc((void*)Kh, 0, 0x7ffffff0, 0x00020000);
  const __amdgpu_buffer_rsrc_t vrs = __builtin_amdgcn_make_buffer_rsrc((void*)Vh, 0, 0x7ffffff0, 0x00020000);
#define TDMA(slot, k0) do { const int _o = (k0) * ldk * 2; LAS char* _b = lds + (slot) * SHM_T + pz; \
    DMA16(krs, _b, kvo, _o); DMA16(krs, _b + 8192, kvo, _o + l32); DMA16(vrs, _b + SHM_K, vvo, _o); DMA16(vrs, _b + SHM_K + 8192, vvo, _o + l32); } while (0)
#define VM0() asm volatile("s_waitcnt vmcnt(0)" ::: "memory")
#define FINISH(P0, P1) do { exp16(P1); l_reg += sum16(P0) + sum16(P1); PK4(P0, 0, pa0); PK4(P0, 8, pa1); PK4(P1, 0, pa2); PK4(P1, 8, pa3); } while (0)
  f32x16 pA0, pA1, pB0, pB1; bf16x8 pa0, pa1, pa2, pa3; const int NT = seq / KVBLK;
  TDMA(0, 0); VM0(); __syncthreads();
  TDMA(1, KVBLK);
  qkt(pA0, pA1, lds, qr, r32, hi, nmc); exp16(pA0);
  VM0(); __syncthreads();
  int sk = 1, sv = 0, sd = 2;
  for (int j = 1; j + 1 < NT; j += 2) {
    TDMA(sd, (j + 1) * KVBLK);
    SCHED; qkt(pB0, pB1, lds + sk * SHM_T, qr, r32, hi, nmc);
    FINISH(pA0, pA1); SCHED;
    pv_d0(o, (int)(uintptr_t)(lds + sv * SHM_T + SHM_K) + vrb, pa0, pa1, pa2, pa3); exp16(pB0);
    VM0(); __syncthreads();
    { const int t = sv; sv = sk; sk = sd; sd = t; }
    if (j + 2 < NT) TDMA(sd, (j + 2) * KVBLK);
    SCHED; qkt(pA0, pA1, lds + sk * SHM_T, qr, r32, hi, nmc);
    FINISH(pB0, pB1); SCHED;
    pv_d0(o, (int)(uintptr_t)(lds + sv * SHM_T + SHM_K) + vrb, pa0, pa1, pa2, pa3); exp16(pA0);
    VM0(); __syncthreads();
    { const int t = sv; sv = sk; sk = sd; sd = t; }
  }
  SCHED; qkt(pB0, pB1, lds + sk * SHM_T, qr, r32, hi, nmc);
  FINISH(pA0, pA1); SCHED;
  pv_d0(o, (int)(uintptr_t)(lds + sv * SHM_T + SHM_K) + vrb, pa0, pa1, pa2, pa3); exp16(pB0);
  FINISH(pB0, pB1); SCHED;
  pv_d0(o, (int)(uintptr_t)(lds + sk * SHM_T + SHM_K) + vrb, pa0, pa1, pa2, pa3);
  { auto rr = __builtin_amdgcn_permlane32_swap(__float_as_uint(l_reg), __float_as_uint(l_reg), false, false); l_reg = __uint_as_float(rr[0]) + __uint_as_float(rr[1]); }
  store_o(o, l_reg, li_l, Ob + (long)(wid * QBLK) * ldo, ldo, r32, hi);
  VM0();
  __syncthreads();
#undef TDMA
#undef FINISH
}

constexpr int SHM_V2 = KVBLK * 256 * 2;
__device__ __forceinline__ void attn_body_dv256(const bf16_t* __restrict__ Qb, const int ldq, const bf16_t* __restrict__ Kh, const bf16_t* __restrict__ Vh, const int ldk,
                                                bf16_t* __restrict__ Ob, const int ldo, const int seq, const float kmax2, LAS char* lds) {
  int tid = threadIdx.x; asm volatile("" : "+v"(tid)); tid &= 511;
  const int wid = tid >> 6, lane = tid & 63, r32 = lane & 31, hi = lane >> 5, rg = wid >> 1, kh = wid & 1;
  LAS char* K_lds = lds; LAS char* V_lds = lds + 2 * SHM_K; LAS char* X_lds = lds + 2 * SHM_K + 2 * SHM_V2;
  float l_reg = 0; f32x16 o[4] = {}; bf16x8 qr[8];
  const float nmc = load_q(Qb + (long)(rg * QBLK + r32) * ldq + hi * 8, qr, kmax2);
  const int vb0 = (int)(uintptr_t)V_lds + v_rd_base(lane) + kh * 2048;
  const int kvo = k_dma_voff(wid, lane, ldk);
  const int vvo = unswap23(8 * (wid >> 2) + ((lane & 31) >> 2)) * ldk * 2 + ((2 * (wid & 3) + (lane >> 5)) * 32 + (lane & 3) * 8) * 2;
  const int l32 = 64 * ldk, l16 = 32 * ldk, pz = wid * 1024;
  const int xw = (rg * 4 + kh * 2) * 1024 + lane * 16, xr = rg * 4096 + lane * 16;
  const __amdgpu_buffer_rsrc_t krs = __builtin_amdgcn_make_buffer_rsrc((void*)Kh, 0, 0x7ffffff0, 0x00020000);
  const __amdgpu_buffer_rsrc_t vrs = __builtin_amdgcn_make_buffer_rsrc((void*)Vh, 0, 0x7ffffff0, 0x00020000);
#define KDMA(b, k0) do { const int _o = (k0) * ldk * 2; LAS char* _b = K_lds + (b) * SHM_K + pz; DMA16(krs, _b, kvo, _o); DMA16(krs, _b + 8192, kvo, _o + l32); } while (0)
#define VDMA(b, k0) do { const int _o = (k0) * ldk * 2; LAS char* _b = V_lds + (b) * SHM_V2 + pz; DMA16(vrs, _b, vvo, _o); DMA16(vrs, _b + 8192, vvo, _o + l16); \
    DMA16(vrs, _b + 16384, vvo, _o + 2 * l16); DMA16(vrs, _b + 24576, vvo, _o + 3 * l16); } while (0)
  f32x16 pA, pB; bf16x8 pa0, pa1, pa2, pa3, own0, own1; const int NT = seq / KVBLK;
  const int kxor = ((32 * kh + r32) & 7) << 4, krb = (32 * kh + r32) * 256;
#define QKHALF(P, b) do { _Pragma("unroll") for (int r = 0; r < 16; ++r) P[r] = nmc; \
    _Pragma("unroll") for (int d0 = 0; d0 < 8; ++d0) { const bf16x8 bk = *(LAS const bf16x8*)(K_lds + (b) * SHM_K + krb + (((d0 * 16 + hi * 8) * 2) ^ kxor)); \
      P = __builtin_amdgcn_mfma_f32_32x32x16_bf16(bk, qr[d0], P, 0, 0, 0); } } while (0)
#define FINH(P) do { exp16(P); l_reg += sum16(P); PK4(P, 0, own0); PK4(P, 8, own1); } while (0)
#define XWRITE(b) do { *(LAS bf16x8*)(X_lds + (b) * 16384 + xw) = own0; *(LAS bf16x8*)(X_lds + (b) * 16384 + xw + 1024) = own1; } while (0)
#define XREAD(b) do { pa0 = *(LAS const bf16x8*)(X_lds + (b) * 16384 + xr); pa1 = *(LAS const bf16x8*)(X_lds + (b) * 16384 + xr + 1024); \
    pa2 = *(LAS const bf16x8*)(X_lds + (b) * 16384 + xr + 2048); pa3 = *(LAS const bf16x8*)(X_lds + (b) * 16384 + xr + 3072); } while (0)
#define STEP(PA, PB, b, j) do { \
    SCHED; if ((j) + 1 < NT) QKHALF(PB, (b) ^ 1); FINH(PA); SCHED; \
    XWRITE(b); VM0(); __syncthreads(); \
    if ((j) + 3 < NT) KDMA((b) ^ 1, ((j) + 3) * KVBLK); if ((j) + 1 < NT) VDMA((b) ^ 1, ((j) + 1) * KVBLK); \
    XREAD(b); \
    pv_d0_256(o, vb0 + (b) * SHM_V2, pa0, pa1, pa2, pa3); } while (0)
  KDMA(0, 0); KDMA(1, KVBLK); VDMA(0, 0); VM0(); __syncthreads();
  QKHALF(pA, 0);
  __syncthreads();
  if (2 < NT) KDMA(0, 2 * KVBLK);
  for (int j = 0; j < NT; j += 2) { STEP(pA, pB, 0, j); STEP(pB, pA, 1, j + 1); }
  __syncthreads();
  LAS float* lx = (LAS float*)X_lds;
  lx[wid * 64 + lane] = l_reg; __syncthreads();
  const float l_tot = lx[wid * 64 + r32] + lx[wid * 64 + 32 + r32] + lx[(wid ^ 1) * 64 + r32] + lx[(wid ^ 1) * 64 + 32 + r32];
  store_o(o, l_tot, lx + 512 + wid * 32, Ob + (long)(rg * QBLK) * ldo + kh * 128, ldo, r32, hi);
  VM0();
  __syncthreads();
#undef KDMA
#undef VDMA
#undef QKHALF
#undef FINH
#undef XWRITE
#undef XREAD
#undef STEP
#undef VM0
}

#define LGK(n) asm volatile("s_waitcnt lgkmcnt(" #n ")" ::: "memory")
template <int OFF> __device__ __forceinline__ bf16x8 k_read(int ka) { bf16x8 r; asm volatile("ds_read_b128 %0, %1 offset:%2" : "=&v"(r) : "v"(ka), "i"(OFF) : "memory"); return r; }
struct VSet { s16x4 l0, h0, l1, h1; };
template <int OFF> __device__ __forceinline__ void v_read(VSet& s, int vb) { s.l0 = tr_read<OFF>(vb); s.h0 = tr_read<OFF + 4096>(vb); s.l1 = tr_read<OFF + 8192>(vb); s.h1 = tr_read<OFF + 12288>(vb); }
__device__ __forceinline__ void pv2(f32x16& oa, const VSet& s, bf16x8 pa0, bf16x8 pa1) {
#define PK(L, H) (bf16x8){L[0], L[1], L[2], L[3], H[0], H[1], H[2], H[3]}
  oa = __builtin_amdgcn_mfma_f32_32x32x16_bf16(pa0, PK(s.l0, s.h0), oa, 0, 0, 0);
  oa = __builtin_amdgcn_mfma_f32_32x32x16_bf16(pa1, PK(s.l1, s.h1), oa, 0, 0, 0);
#undef PK
}
template <bool SHIFT>
__device__ __forceinline__ void attn_body_c256_t(const bf16_t* __restrict__ Qb, const int ldq, const bf16_t* __restrict__ Kh, const bf16_t* __restrict__ Vh, const int ldk,
                                                 bf16_t* __restrict__ Ob, const int ldo, const int seq, const float nmc, const bf16x8 (&qr)[8], LAS char* lds) {
  int tid = threadIdx.x; asm volatile("" : "+v"(tid)); tid &= 511;
  const int wid = __builtin_amdgcn_readfirstlane(tid >> 6), lane = tid & 63, r32 = lane & 31, hi = lane >> 5;
  LAS char* K_lds = lds; LAS char* V_lds = lds + 2 * SHM_K;
  LAS float* li_l = (LAS float*)(lds + 2 * SHM_K + 2 * SHM_V2) + wid * 64;
  float l_reg = 0; f32x16 o[8] = {};
  const int vb0 = (int)(uintptr_t)V_lds + v_rd_base(lane);
  const int kvo = k_dma_voff(wid, lane, ldk);
  const int vvo = unswap23(8 * (wid >> 2) + ((lane & 31) >> 2)) * ldk * 2 + ((2 * (wid & 3) + (lane >> 5)) * 32 + (lane & 3) * 8) * 2;
  const int l32 = 64 * ldk, l16 = 32 * ldk, pz = wid * 1024;
  const __amdgpu_buffer_rsrc_t krs = __builtin_amdgcn_make_buffer_rsrc((void*)Kh, 0, 0x7ffffff0, 0x00020000);
  const __amdgpu_buffer_rsrc_t vrs = __builtin_amdgcn_make_buffer_rsrc((void*)Vh, 0, 0x7ffffff0, 0x00020000);
#define VM0() asm volatile("s_waitcnt vmcnt(0)" ::: "memory")
#define KVDMA(b, k0) do { const int _o = (k0) * ldk * 2; LAS char* _k = K_lds + (b) * SHM_K + pz; LAS char* _v = V_lds + (b) * SHM_V2 + pz; \
    DMA16(krs, _k, kvo, _o); DMA16(krs, _k + 8192, kvo, _o + l32); DMA16(vrs, _v, vvo, _o); DMA16(vrs, _v + 8192, vvo, _o + l16); \
    DMA16(vrs, _v + 16384, vvo, _o + 2 * l16); DMA16(vrs, _v + 24576, vvo, _o + 3 * l16); } while (0)
  int ka[8];
  { const int kxor = (r32 & 7) << 4, krb = (int)(uintptr_t)K_lds + r32 * 256;
#pragma unroll
    for (int d0 = 0; d0 < 8; ++d0) ka[d0] = krb + (((d0 * 16 + hi * 8) * 2) ^ kxor); }
  f32x16 P; bf16x8 pa0, pa1, f0, f1, f2, f3; VSet va, vb_, vc;
  const int NT = seq / KVBLK;
#define PINIT() do { _Pragma("unroll") for (int r = 0; r < 16; ++r) { float _z; asm volatile("v_mov_b32 %0, %1" : "=v"(_z) : "v"(SHIFT ? nmc : 0.f)); P[r] = _z; } } while (0)
#define KOFF(b, h) ((b) * 16384 + (h) * 8192)
#define VOFF(b, h, d0) ((b) * 32768 + (h) * 16384 + (d0) * 512)
#define KPRO(b, h) do { f0 = k_read<KOFF(b, h)>(ka[0]); f1 = k_read<KOFF(b, h)>(ka[1]); f2 = k_read<KOFF(b, h)>(ka[2]); } while (0)
#define QKM(F, d0) do { SCHED; P = __builtin_amdgcn_mfma_f32_32x32x16_bf16(F, qr[d0], P, 0, 0, 0); SCHED; } while (0)
#define QKHALF(b, h) do { PINIT(); \
    LGK(2); QKM(f0, 0); f3 = k_read<KOFF(b, h)>(ka[3]); \
    LGK(2); QKM(f1, 1); f0 = k_read<KOFF(b, h)>(ka[4]); \
    LGK(2); QKM(f2, 2); f1 = k_read<KOFF(b, h)>(ka[5]); \
    LGK(2); QKM(f3, 3); f2 = k_read<KOFF(b, h)>(ka[6]); \
    LGK(2); QKM(f0, 4); f3 = k_read<KOFF(b, h)>(ka[7]); \
    LGK(2); QKM(f1, 5); v_read<VOFF(b, h, 0)>(va, vb0); \
    LGK(5); QKM(f2, 6); v_read<VOFF(b, h, 1)>(vb_, vb0); \
    LGK(8); QKM(f3, 7); } while (0)
#define SMH() do { exp16(P); l_reg += sum16(P); PK4(P, 0, pa0); PK4(P, 8, pa1); } while (0)
#define PVM(S, d0) do { SCHED; pv2(o[d0], S, pa0, pa1); SCHED; } while (0)
#define PVHALF(b, h, NEXTK, nb, nh) do { \
    LGK(4); PVM(va, 0); v_read<VOFF(b, h, 2)>(vc, vb0); \
    LGK(4); PVM(vb_, 1); v_read<VOFF(b, h, 3)>(va, vb0); \
    LGK(4); PVM(vc, 2); v_read<VOFF(b, h, 4)>(vb_, vb0); \
    LGK(4); PVM(va, 3); v_read<VOFF(b, h, 5)>(vc, vb0); \
    LGK(4); PVM(vb_, 4); v_read<VOFF(b, h, 6)>(va, vb0); \
    LGK(4); PVM(vc, 5); v_read<VOFF(b, h, 7)>(vb_, vb0); \
    LGK(4); PVM(va, 6); if (NEXTK) { f0 = k_read<KOFF(nb, nh)>(ka[0]); f1 = k_read<KOFF(nb, nh)>(ka[1]); } \
    if (NEXTK) { LGK(2); } else { LGK(0); } PVM(vb_, 7); if (NEXTK) { f2 = k_read<KOFF(nb, nh)>(ka[2]); } } while (0)
#define STEPC(b, j) do { if ((j) + 1 < NT) KVDMA((b) ^ 1, ((j) + 1) * KVBLK); \
    KPRO(b, 0); QKHALF(b, 0); SMH(); PVHALF(b, 0, true, b, 1); \
    QKHALF(b, 1); SMH(); PVHALF(b, 1, false, 0, 0); \
    VM0(); __syncthreads(); } while (0)
  KVDMA(0, 0); VM0(); __syncthreads();
  for (int j = 0; j < NT; j += 2) { STEPC(0, j); STEPC(1, j + 1); }
  { auto rr = __builtin_amdgcn_permlane32_swap(__float_as_uint(l_reg), __float_as_uint(l_reg), false, false); l_reg = __uint_as_float(rr[0]) + __uint_as_float(rr[1]); }
  if (hi == 0) li_l[r32] = l_reg; asm volatile("s_waitcnt lgkmcnt(0)" ::: "memory");
  bf16_t* Ow = Ob + (long)(wid * QBLK) * ldo;
#pragma unroll
  for (int r = 0; r < 16; ++r) { const int orow = crow(r, hi); const float rl = __builtin_amdgcn_rcpf(li_l[orow]);
#pragma unroll
    for (int d0 = 0; d0 < 8; ++d0) Ow[(long)orow * ldo + d0 * 32 + r32] = f2bf(o[d0][r] * rl); }
  VM0();
  __syncthreads();
#undef KVDMA
#undef PINIT
#undef KOFF
#undef VOFF
#undef KPRO
#undef QKM
#undef QKHALF
#undef SMH
#undef PVM
#undef PVHALF
#undef STEPC
#undef VM0
}
__device__ __forceinline__ void attn_body_c256(const bf16_t* __restrict__ Qb, const int ldq, const bf16_t* __restrict__ Kh, const bf16_t* __restrict__ Vh, const int ldk,
                                               bf16_t* __restrict__ Ob, const int ldo, const int seq, const float kmax2, LAS char* lds) {
  int tid = threadIdx.x; asm volatile("" : "+v"(tid)); tid &= 511;
  const int wid = tid >> 6, lane = tid & 63, r32 = lane & 31, hi = lane >> 5;
  bf16x8 qr[8];
  const float nmc = load_q(Qb + (long)(wid * QBLK + r32) * ldq + hi * 8, qr, kmax2);
  if (__all(nmc > -64.f)) attn_body_c256_t<false>(Qb, ldq, Kh, Vh, ldk, Ob, ldo, seq, 0.f, qr, lds);
  else attn_body_c256_t<true>(Qb, ldq, Kh, Vh, ldk, Ob, ldo, seq, nmc, qr, lds);
}
#undef PK4
}

__device__ __forceinline__ int perm_plain8(int n) { const int r = n & 31; return (n & ~31) + 16 * ((r >> 2) & 1) + 4 * (r >> 3) + (r & 3); }
__device__ __forceinline__ int perm_row(int kind, int n) {
  if (kind == 0) return perm_plain8(n);
  if (kind == 1) { if (n < N_QKV0) return perm_plain8(n); const int c = n - N_QKV0; const int ch = c & 1023; return N_QKV0 + 32 * (ch >> 4) + ((c >> 10) << 4) + (ch & 15); }
  return 32 * (n >> 4) + ((kind == 3) ? 16 : 0) + (n & 15);
}
__device__ __forceinline__ void cvt_tile(const float* __restrict__ src, int N, bf16_t* __restrict__ dst, int K, int kind, int k0, int n0, LAS unsigned* t32) {
  int tid = threadIdx.x; asm volatile("" : "+v"(tid)); tid &= 511;
#pragma unroll
  for (int j = 0; j < 2; ++j) {
    const int item = tid + 512 * j, kp = item >> 4, q = item & 15;
    const f32x4 v0 = *(const f32x4*)(src + (size_t)(k0 + 2 * kp) * N + n0 + 4 * q);
    const f32x4 v1 = *(const f32x4*)(src + (size_t)(k0 + 2 * kp + 1) * N + n0 + 4 * q);
#pragma unroll
    for (int i = 0; i < 4; ++i) t32[(4 * q + i) * 65 + kp] = cvtpk(v0[i], v1[i]);
  }
  __syncthreads();
#pragma unroll
  for (int j = 0; j < 2; ++j) {
    const int item = tid + 512 * j, n = item >> 4, ko = item & 15;
    u32x4 v;
#pragma unroll
    for (int i = 0; i < 4; ++i) v[i] = t32[n * 65 + 4 * ko + i];
    *(u32x4*)(dst + (size_t)perm_row(kind, n0 + n) * K + k0 + 8 * ko) = v;
  }
  __syncthreads();
}
__device__ __forceinline__ void cvt_matrix_units(const float* src, int K, int N, bf16_t* dst, int kind, int u0, int ustride, LAS unsigned* t32) {
  const int nN = N / 64, nK = K / 128;
  for (int u = u0; u < nN * nK; u += ustride) cvt_tile(src, N, dst, K, kind, (u / nN) * 128, (u % nN) * 64, t32);
}
constexpr size_t WMOE8_E = (size_t)1024 * D + (size_t)D * EFF;
__device__ __forceinline__ void cvt_tile8(const float* __restrict__ src, int N, unsigned char* __restrict__ dst, int K, int kind, int k0, int n0, float scale, LAS unsigned* t32) {
  int tid = threadIdx.x; asm volatile("" : "+v"(tid)); tid &= 511;
  { const int kq = tid >> 4, q = tid & 15;
    f32x4 v[4];
#pragma unroll
    for (int r = 0; r < 4; ++r) v[r] = *(const f32x4*)(src + (size_t)(k0 + 4 * kq + r) * N + n0 + 4 * q);
#pragma unroll
    for (int i = 0; i < 4; ++i) t32[(4 * q + i) * 33 + kq] = pack_fp8x4(v[0][i] * scale, v[1][i] * scale, v[2][i] * scale, v[3][i] * scale); }
  __syncthreads();
  { const int n = tid >> 3, kc = tid & 7;
    u32x4 v;
#pragma unroll
    for (int i = 0; i < 4; ++i) v[i] = t32[n * 33 + 4 * kc + i];
    *(u32x4*)(dst + (size_t)perm_row(kind, n0 + n) * K + k0 + 16 * kc) = v; }
  __syncthreads();
}
__device__ __forceinline__ void cvt_moe_all8(const Args& a, LAS unsigned* t32) {
  unsigned char* W = (unsigned char*)(a.ws + WS_WMOE);
  for (int u = blockIdx.x; u < 2 * 65 * 384; u += gridDim.x) {
    const int le = u / 384, L = le / 65, e = le % 65, r = u % 384, mtx = r >> 7, lu = r & 127;
    const float* src; unsigned char* dst = W + (size_t)le * WMOE8_E; int K, N, kind; float sc;
    if (mtx == 0)      { src = e < 64 ? a.in[21] + ((size_t)L * 64 + e) * D * EFF : a.in[24] + (size_t)L * D * EFF; K = D; N = EFF; kind = 2; sc = 256.f; }
    else if (mtx == 1) { src = e < 64 ? a.in[22] + ((size_t)L * 64 + e) * D * EFF : a.in[25] + (size_t)L * D * EFF; K = D; N = EFF; kind = 3; sc = 256.f; }
    else               { src = e < 64 ? a.in[23] + ((size_t)L * 64 + e) * EFF * D : a.in[26] + (size_t)L * EFF * D; K = EFF; N = D; kind = 0; sc = 128.f; dst += (size_t)1024 * D; }
    const int nN = N / 64;
    cvt_tile8(src, N, dst, K, kind, (lu / nN) * 128, (lu % nN) * 64, sc, t32);
  }
}

__device__ __forceinline__ void ld_row_f32(const float* __restrict__ p, int lane, float (&v)[32]) {
#pragma unroll
  for (int j = 0; j < 4; ++j) { const f32x4 t0 = *(const f32x4*)(p + 8 * lane + 512 * j), t1 = *(const f32x4*)(p + 8 * lane + 512 * j + 4);
#pragma unroll
    for (int i = 0; i < 4; ++i) { v[8 * j + i] = t0[i]; v[8 * j + 4 + i] = t1[i]; } }
}
__device__ __forceinline__ void ld_row_bf16(const bf16_t* __restrict__ p, int lane, float (&v)[32]) {
#pragma unroll
  for (int j = 0; j < 4; ++j) { const u32x4 t = *(const u32x4*)(p + 8 * lane + 512 * j);
#pragma unroll
    for (int i = 0; i < 4; ++i) { v[8 * j + 2 * i] = bflo(t[i]); v[8 * j + 2 * i + 1] = bfhi(t[i]); } }
}
__device__ __forceinline__ void ld8f(const float* __restrict__ p, float (&x)[8]) { const f32x4 t0 = *(const f32x4*)p, t1 = *(const f32x4*)(p + 4);
#pragma unroll
  for (int i = 0; i < 4; ++i) { x[i] = t0[i]; x[4 + i] = t1[i]; } }
__device__ __forceinline__ void st8f(float* __restrict__ p, const float* x) { f32x4 t0 = {x[0], x[1], x[2], x[3]}, t1 = {x[4], x[5], x[6], x[7]}; *(f32x4*)p = t0; *(f32x4*)(p + 4) = t1; }
__device__ __forceinline__ float sumsq32(const float (&v)[32]) { float s = 0;
#pragma unroll
  for (int i = 0; i < 32; ++i) s += v[i] * v[i];
  return wave_sum(s); }
template <bool COPY, bool OUT8 = false>
__device__ __forceinline__ void modulate_store(const float (&v)[32], float rstd, const float* __restrict__ g, const float* __restrict__ shift, const float* __restrict__ scale,
                                               bf16_t* __restrict__ dst, int lane, LAS float* f32copy) {
#pragma unroll
  for (int j = 0; j < 4; ++j) {
    const int idx = 8 * lane + 512 * j;
    float gv[8], sh[8], sc[8], y[8]; ld8f(g + idx, gv); ld8f(shift + idx, sh); ld8f(scale + idx, sc);
#pragma unroll
    for (int i = 0; i < 8; ++i) y[i] = v[8 * j + i] * rstd * gv[i] * (1.f + sc[i]) + sh[i];
    if (OUT8) { u32x2 p8 = {pack_fp8x4(y[0], y[1], y[2], y[3]), pack_fp8x4(y[4], y[5], y[6], y[7])}; *(u32x2*)((unsigned char*)dst + idx) = p8; }
    else { u32x4 pk = {cvtpk(y[0], y[1]), cvtpk(y[2], y[3]), cvtpk(y[4], y[5]), cvtpk(y[6], y[7])}; *(u32x4*)(dst + idx) = pk; }
    if (COPY) { f32x4 t0 = {y[0], y[1], y[2], y[3]}, t1 = {y[4], y[5], y[6], y[7]};
      *(LAS f32x4*)(f32copy + idx) = t0; *(LAS f32x4*)(f32copy + idx + 4) = t1; }
  }
}

__device__ __forceinline__ void phase_prologue(const Args& a, LAS char* lds) {
  int tid = threadIdx.x; asm volatile("" : "+v"(tid)); tid &= 511; const int wave = tid >> 6, lane = tid & 63;
  {
    LAS float* sc = (LAS float*)lds;
    LAS float* part = sc + 4096;
    const float* c = a.in[1]; const float* cc = a.in[3];
    for (int i = tid; i < D; i += NTHREADS) { float v = c[i]; sc[i] = v * sigmoidf_(v); float u = cc[i]; sc[D + i] = u * sigmoidf_(u); }
    __syncthreads();
    float* MOD = (float*)(a.ws + WS_MOD);
    for (int u = blockIdx.x; u < 2 * 192; u += gridDim.x) {
      const int L = u / 192, chunk = u % 192;
      const float* W = a.in[4] + (size_t)L * D * 12288 + chunk * 64 + lane;
      float a0 = 0, a1 = 0; const int d0 = wave * 256;
#pragma unroll 8
      for (int dd = 0; dd < 256; ++dd) { const float w = W[(size_t)(d0 + dd) * 12288]; a0 += sc[d0 + dd] * w; a1 += sc[D + d0 + dd] * w; }
      part[(wave * 2 + 0) * 64 + lane] = a0; part[(wave * 2 + 1) * 64 + lane] = a1;
      __syncthreads();
      if (tid < 128) { const int which = tid >> 6; float s = 0;
#pragma unroll
        for (int w = 0; w < 8; ++w) s += part[(w * 2 + which) * 64 + lane];
        const int j = chunk * 64 + lane; MOD[(size_t)(L * 2 + which) * 12288 + j] = s + a.in[5][L * 12288 + j]; }
      __syncthreads();
    }
  }
  LAS unsigned* t32 = (LAS unsigned*)lds;
  cvt_matrix_units(a.in[7], D, N_IN0, (bf16_t*)(a.ws + WS_WIN0), 1, blockIdx.x, gridDim.x, t32);
  cvt_matrix_units(a.in[8], D, D, (bf16_t*)(a.ws + WS_WOUT0), 0, blockIdx.x, gridDim.x, t32);
  cvt_matrix_units(a.in[15], D, N_IN1, (bf16_t*)(a.ws + WS_WIN1), 0, blockIdx.x, gridDim.x, t32);
  cvt_matrix_units(a.in[16], D, D, (bf16_t*)(a.ws + WS_WOUT1), 0, blockIdx.x, gridDim.x, t32);
  cvt_moe_all8(a, t32);
}

__device__ __forceinline__ void phase_modulate0(const Args& a) {
  int tid = threadIdx.x; asm volatile("" : "+v"(tid)); tid &= 511; const int wave = tid >> 6, lane = tid & 63;
  const float* MOD = (const float*)(a.ws + WS_MOD);
  bf16_t* A = (bf16_t*)(a.ws + WS_ABUF);
  for (int it = blockIdx.x; it < MT / 8; it += gridDim.x) {
    const int r = it * 8 + wave;
    const float* src = r < CTXL ? a.in[2] + (size_t)r * D : a.in[0] + (size_t)(r - CTXL) * D;
    const float* mod = MOD + (r < CTXL ? 12288 : 0);
    float v[32]; ld_row_f32(src, lane, v);
    const float rstd = rsqrtf(sumsq32(v) * (1.f / D) + EPS);
    modulate_store<false>(v, rstd, a.in[6], mod, mod + D, A + (size_t)r * D, lane, nullptr);
  }
}

__device__ __forceinline__ void rope_cs4(int r, int lane, float (&cs)[4], float (&sn)[4]) {
#pragma unroll
  for (int q = 0; q < 4; ++q) { cs[q] = 1.f; sn[q] = 0.f; }
  if (r >= CTXL) { const int t = r - CTXL; const int l = lane & 15, a = l >> 3, i0 = 4 * (l & 7);
    const float pos = a ? (float)(t & 63) : (float)(t >> 6);
#pragma unroll
    for (int q = 0; q < 4; ++q) { const float inv = powf(10000.f, -(float)(i0 + q) / 32.f); sincosf(pos * inv, &sn[q], &cs[q]); } }
}
__device__ __forceinline__ float sum16lanes(float v) { v += __shfl_xor(v, 1); v += __shfl_xor(v, 2); v += __shfl_xor(v, 4); v += __shfl_xor(v, 8); return v; }
__device__ __forceinline__ void phase_rope_conv0(const Args& a, LAS char* lds, bool dry = false) {
  int tid = threadIdx.x; asm volatile("" : "+v"(tid)); tid &= 511; const int wave = tid >> 6, lane = tid & 63;
  bf16_t* Q = (bf16_t*)(a.ws + WS_QKVU);
  {
    const bf16_t* HG = (const bf16_t*)(a.ws + WS_HG);
    bf16_t* X2 = (bf16_t*)(a.ws + WS_X2);
    LAS char* lt = lds;
    LAS float* part = (LAS float*)(lds + 62 * 2048);
    LAS float* stats = part + 512;
    const float* dw_w = a.in[11]; const float* dw_b = a.in[12]; const float* ln_g = a.in[13]; const float* ln_b = a.in[14];
    const __amdgpu_buffer_rsrc_t wrs = __builtin_amdgcn_make_buffer_rsrc((void*)dw_w, 0, 31 * 1024 * 4, 0x00020000);
    for (int u = blockIdx.x; u < 520; u += gridDim.x) {
      int seg0, seg1, r0;
      if (u < 8) { seg0 = 0; seg1 = CTXL; r0 = u * 32; } else { seg0 = CTXL; seg1 = MT; r0 = CTXL + (u - 8) * 32; }
      for (int c = tid; c < 62 * 128; c += NTHREADS) { const int rr = c >> 7, cc = c & 127, gr = r0 - 15 + rr;
        u32x4 v = {0u, 0u, 0u, 0u}; if (gr >= seg0 && gr < seg1) v = *(const u32x4*)(HG + (size_t)gr * 1024 + cc * 8);
        *(LAS u32x4*)(lt + rr * 2048 + cc * 16) = v; }
      __syncthreads();
      float w0[31], w1[31];
#pragma unroll
      for (int j = 0; j < 31; ++j) { const u32x2 w = __builtin_amdgcn_raw_buffer_load_b64(wrs, tid * 8, j * 4096, 0); w0[j] = __uint_as_float(w[0]); w1[j] = __uint_as_float(w[1]); }
      const f32x2 bb = *(const f32x2*)(dw_b + 2 * tid);
      const f32x2 gg = *(const f32x2*)(ln_g + 2 * tid), gb = *(const f32x2*)(ln_b + 2 * tid);
#pragma unroll 1
      for (int hf = 0; hf < 4; ++hf) {
        float o0[8], o1[8];
        LAS const char* lth = lt + (hf * 8) * 2048 + tid * 4;
#pragma unroll
        for (int r = 0; r < 8; ++r) { o0[r] = bb[0]; o1[r] = bb[1]; }
#pragma unroll
        for (int i = 0; i < 38; ++i) {
          const unsigned p = *(LAS const unsigned*)(lth + i * 2048);
          const float x0 = bflo(p), x1 = bfhi(p);
#pragma unroll
          for (int r = 0; r < 8; ++r) { const int j = i - r; if (j >= 0 && j < 31) { o0[r] += x0 * w0[j]; o1[r] += x1 * w1[j]; } }
        }
#pragma unroll
        for (int r = 0; r < 8; ++r) {
          const float s = wave_sum(o0[r] + o1[r]), q = wave_sum(o0[r] * o0[r] + o1[r] * o1[r]);
          if (lane == 0) { part[(r * 8 + wave) * 2] = s; part[(r * 8 + wave) * 2 + 1] = q; }
        }
        __syncthreads();
        if (tid < 8) { float s = 0, q = 0;
#pragma unroll
          for (int w = 0; w < 8; ++w) { s += part[(tid * 8 + w) * 2]; q += part[(tid * 8 + w) * 2 + 1]; }
          const float mean = s * (1.f / 1024), var = q * (1.f / 1024) - mean * mean;
          stats[tid * 2] = mean; stats[tid * 2 + 1] = rsqrtf(fmaxf(var, 0.f) + EPS); }
        __syncthreads();
#pragma unroll
        for (int r = 0; r < 8; ++r) {
          const float mean = stats[r * 2], rstd = stats[r * 2 + 1];
          float y0 = (o0[r] - mean) * rstd * gg[0] + gb[0], y1 = (o1[r] - mean) * rstd * gg[1] + gb[1];
          y0 = y0 * sigmoidf_(y0); y1 = y1 * sigmoidf_(y1);
          *(unsigned*)(X2 + (size_t)(r0 + hf * 8 + r) * D + 1024 + 2 * tid) = cvtpk(y0, y1);
        }
      }
      __syncthreads();
    }
  }
  const float* qn = a.in[9]; const float* kn = a.in[10];
  unsigned* kmx = (unsigned*)(a.ws + WS_CTL + CTL_KMAX);
  const int slot = lane >> 4, l16 = lane & 15, e1 = (l16 >> 3) * 64 + 4 * (l16 & 7), e2 = e1 + 32;
  float km0 = 0.f, km1 = 0.f;
  for (int it = blockIdx.x; it < MT / 8; it += gridDim.x) {
    const int r = it * 8 + wave;
    float cs[4], sn[4]; rope_cs4(r, lane, cs, sn);
    bf16_t* rowp = Q + (size_t)r * N_QKV0;
#pragma unroll
    for (int hb = 0; hb < 12; hb += 4) {
      const int hh = hb + slot;
      if (hh < 10) {
        const float* g = hh < 8 ? qn : kn;
        const u32x2 a1 = *(const u32x2*)(rowp + hh * 128 + e1), a2 = *(const u32x2*)(rowp + hh * 128 + e2);
        float x1[4] = {bflo(a1[0]), bfhi(a1[0]), bflo(a1[1]), bfhi(a1[1])}, x2[4] = {bflo(a2[0]), bfhi(a2[0]), bflo(a2[1]), bfhi(a2[1])};
        float ss = 0;
#pragma unroll
        for (int q = 0; q < 4; ++q) ss += x1[q] * x1[q] + x2[q] * x2[q];
        ss = sum16lanes(ss);
        const float rstd = rsqrtf(ss * (1.f / 128) + EPS);
        const f32x4 g1 = *(const f32x4*)(g + e1), g2 = *(const f32x4*)(g + e2);
        float o1[4], o2[4], so = 0;
#pragma unroll
        for (int q = 0; q < 4; ++q) { const float y1 = x1[q] * rstd * g1[q], y2 = x2[q] * rstd * g2[q]; o1[q] = y1 * cs[q] - y2 * sn[q]; o2[q] = y2 * cs[q] + y1 * sn[q]; }
        const u32x2 w1 = {cvtpk(o1[0], o1[1]), cvtpk(o1[2], o1[3])}, w2 = {cvtpk(o2[0], o2[1]), cvtpk(o2[2], o2[3])};
        if (!dry) { *(u32x2*)(rowp + hh * 128 + e1) = w1; *(u32x2*)(rowp + hh * 128 + e2) = w2; }
        if (hb == 8) {
          so = bflo(w1[0]) * bflo(w1[0]) + bfhi(w1[0]) * bfhi(w1[0]) + bflo(w1[1]) * bflo(w1[1]) + bfhi(w1[1]) * bfhi(w1[1])
             + bflo(w2[0]) * bflo(w2[0]) + bfhi(w2[0]) * bfhi(w2[0]) + bflo(w2[1]) * bflo(w2[1]) + bfhi(w2[1]) * bfhi(w2[1]);
          so = sum16lanes(so); if (slot == 0) km0 = fmaxf(km0, so); else km1 = fmaxf(km1, so);
        }
      }
    }
  }
  if (l16 == 0 && slot < 2) atomicMax(&kmx[slot], __float_as_uint(slot == 0 ? km0 : km1));
}
__device__ __forceinline__ void phase_rope1(const Args& a, LAS char* lds, bool dry = false) {
  int tid = threadIdx.x; asm volatile("" : "+v"(tid)); tid &= 511; const int wave = tid >> 6, lane = tid & 63;
  bf16_t* Q = (bf16_t*)(a.ws + WS_QKVU);
  unsigned* kmx = (unsigned*)(a.ws + WS_CTL + CTL_KMAX) + 16;
  LAS unsigned* lk = (LAS unsigned*)lds;
  if (tid < 16) lk[tid] = 0u;
  __syncthreads();
  const int slot = lane >> 4, l16 = lane & 15, e1 = (l16 >> 3) * 64 + 4 * (l16 & 7), e2 = e1 + 32;
  for (int it = blockIdx.x; it < MT / 8; it += gridDim.x) {
    const int r = it * 8 + wave;
    float cs[4], sn[4]; rope_cs4(r, lane, cs, sn);
    bf16_t* rowp = Q + (size_t)r * N_IN1;
#pragma unroll 2
    for (int hb = (r < CTXL ? 16 : 0); hb < 32; hb += 4) {
      const int hh = hb + slot;
      const u32x2 a1 = *(const u32x2*)(rowp + hh * 128 + e1), a2 = *(const u32x2*)(rowp + hh * 128 + e2);
      const float x1[4] = {bflo(a1[0]), bfhi(a1[0]), bflo(a1[1]), bfhi(a1[1])}, x2[4] = {bflo(a2[0]), bfhi(a2[0]), bflo(a2[1]), bfhi(a2[1])};
      float o1[4], o2[4];
#pragma unroll
      for (int q = 0; q < 4; ++q) { o1[q] = x1[q] * cs[q] - x2[q] * sn[q]; o2[q] = x2[q] * cs[q] + x1[q] * sn[q]; }
      const u32x2 w1 = {cvtpk(o1[0], o1[1]), cvtpk(o1[2], o1[3])}, w2 = {cvtpk(o2[0], o2[1]), cvtpk(o2[2], o2[3])};
      if (r >= CTXL && !dry) { *(u32x2*)(rowp + hh * 128 + e1) = w1; *(u32x2*)(rowp + hh * 128 + e2) = w2; }
      if (hb >= 16) {
        float so = bflo(w1[0]) * bflo(w1[0]) + bfhi(w1[0]) * bfhi(w1[0]) + bflo(w1[1]) * bflo(w1[1]) + bfhi(w1[1]) * bfhi(w1[1])
                 + bflo(w2[0]) * bflo(w2[0]) + bfhi(w2[0]) * bfhi(w2[0]) + bflo(w2[1]) * bflo(w2[1]) + bfhi(w2[1]) * bfhi(w2[1]);
        so = sum16lanes(so);
        if (l16 == 0) atomicMax((unsigned*)&lk[hh - 16], __float_as_uint(so));
      }
    }
  }
  __syncthreads();
  if (tid < 16) atomicMax(&kmx[tid], lk[tid]);
  __syncthreads();
}

__device__ __forceinline__ void phase_attn(const Args& a, int L, LAS char* lds) {
  const bf16_t* Q = (const bf16_t*)(a.ws + WS_QKVU);
  const unsigned* kmx = (const unsigned*)(a.ws + WS_CTL + CTL_KMAX) + L * 16;
  if (L == 0) {
    bf16_t* X2 = (bf16_t*)(a.ws + WS_X2);
    for (int u = blockIdx.x; u < 520; u += gridDim.x) {
      const int head = u < 512 ? (u & 7) : (u - 512);
      const float kmax2 = __uint_as_float(kmx[head >> 2]);
      if (u < 512) { const int qb = u >> 3; const size_t q0 = (size_t)(CTXL + qb * 256);
        at::attn_body(Q + q0 * N_QKV0 + head * 128, N_QKV0, Q + 1024 + (head >> 2) * 128, Q + 1280 + (head >> 2) * 128, N_QKV0, X2 + q0 * D + head * 128, D, MT, kmax2, lds);
      } else {
        at::attn_body(Q + head * 128, N_QKV0, Q + 1024 + (head >> 2) * 128, Q + 1280 + (head >> 2) * 128, N_QKV0, X2 + head * 128, D, CTXL, kmax2, lds); }
    }
  } else {
    bf16_t* O = (bf16_t*)(a.ws + WS_Y);
    for (int u = blockIdx.x; u < 1024; u += gridDim.x) {
      const int x = u & 7, w = u >> 3, hc = x + 8 * (w >> 6), qb = w & 63, h = hc >> 1;
      const float kmax2 = __uint_as_float(kmx[hc]);
      const size_t q0 = (size_t)(CTXL + qb * 256);
      at::attn_body_c256(Q + q0 * N_IN1 + hc * 128, N_IN1, Q + 2048 + hc * 128, Q + 4096 + h * 256, N_IN1,
                         O + (size_t)(qb * 256) * 4096 + hc * 256, 4096, MT, kmax2, lds);
    }
  }
}

__device__ __forceinline__ void phase_diff(const Args& a) {
  int tid = threadIdx.x; asm volatile("" : "+v"(tid)); tid &= 511; const int wave = tid >> 6, lane = tid & 63;
  const bf16_t* O = (const bf16_t*)(a.ws + WS_Y);
  bf16_t* X2 = (bf16_t*)(a.ws + WS_X2);
  const float* lp = a.in[17];
  const float s1 = wave_sum(lp[lane] * lp[128 + lane] + lp[64 + lane] * lp[192 + lane]);
  const float s2 = wave_sum(lp[256 + lane] * lp[384 + lane] + lp[320 + lane] * lp[448 + lane]);
  const float lam = expf(s1) - expf(s2) + LAM_INIT;
  const f32x4 sg = *(const f32x4*)(a.in[18] + 4 * lane);
  for (int it = blockIdx.x; it < SEQ / 8; it += gridDim.x) {
    const int t = it * 8 + wave;
    const bf16_t* op = O + (size_t)t * 4096;
    bf16_t* xp = X2 + (size_t)(CTXL + t) * D;
#pragma unroll 2
    for (int h = 0; h < 8; ++h) {
      const u32x2 a0 = *(const u32x2*)(op + (2 * h) * 256 + 4 * lane), a1 = *(const u32x2*)(op + (2 * h + 1) * 256 + 4 * lane);
      float d[4] = {bflo(a0[0]) - lam * bflo(a1[0]), bfhi(a0[0]) - lam * bfhi(a1[0]), bflo(a0[1]) - lam * bflo(a1[1]), bfhi(a0[1]) - lam * bfhi(a1[1])};
      const float ss = wave_sum(d[0] * d[0] + d[1] * d[1] + d[2] * d[2] + d[3] * d[3]);
      const float rstd = rsqrtf(ss * (1.f / 256) + EPS) * (1.f - LAM_INIT);
      u32x2 pk = {cvtpk(d[0] * rstd * sg[0], d[1] * rstd * sg[1]), cvtpk(d[2] * rstd * sg[2], d[3] * rstd * sg[3])};
      *(u32x2*)(xp + h * 256 + 4 * lane) = pk;
    }
  }
}

__device__ __forceinline__ void phase_G(const Args& a, int L, LAS char* lds, bool dry = false) {
  int tid = threadIdx.x; asm volatile("" : "+v"(tid)); tid &= 511; const int wave = tid >> 6, lane = tid & 63;
  const int NTOK = L == 0 ? MT : SEQ, ROW0 = L == 0 ? 0 : CTXL;
  const float* ng = a.in[6] + (size_t)L * 4 * D;
  const float* MODL = (const float*)(a.ws + WS_MOD) + (size_t)(L * 2) * 12288;
  const float* router = a.in[19] + (size_t)L * D * NE; const float* rbias = a.in[20] + L * NE;
  const bf16_t* OUT = (const bf16_t*)(a.ws + WS_OUT);
  float* HRES = (float*)(a.ws + WS_HRES);
  bf16_t* F = (bf16_t*)(a.ws + WS_ABUF);
  int* counts = (int*)(a.ws + WS_CTL + CTL_CNT) + L * 64;
  int* top_e = (int*)(a.ws + WS_TOPE); float* top_w = (float*)(a.ws + WS_TOPW); int* top_p = (int*)(a.ws + WS_TOPP);
  LAS float* ft = (LAS float*)lds;
  LAS float* part = ft + 8 * D;
  for (int it = blockIdx.x; it < NTOK / 8; it += gridDim.x) {
    const int r = ROW0 + it * 8 + wave;
    const float* mod = MODL + (r < CTXL ? 12288 : 0);
    {
      float o[32], h[32];
      ld_row_bf16(OUT + (size_t)r * D, lane, o);
      const float* hp = L == 0 ? (r < CTXL ? a.in[2] + (size_t)r * D : a.in[0] + (size_t)(r - CTXL) * D) : HRES + (size_t)r * D;
      ld_row_f32(hp, lane, h);
      const float rstd1 = rsqrtf(sumsq32(o) * (1.f / D) + EPS);
#pragma unroll
      for (int j = 0; j < 4; ++j) { const int idx = 8 * lane + 512 * j;
        float g1[8], gt[8]; ld8f(ng + D + idx, g1); ld8f(mod + 2 * D + idx, gt);
#pragma unroll
        for (int i = 0; i < 8; ++i) h[8 * j + i] += gt[i] * (o[8 * j + i] * rstd1 * g1[i]);
        if (!dry) st8f(HRES + (size_t)r * D + idx, &h[8 * j]); }
      const float rstd2 = rsqrtf(sumsq32(h) * (1.f / D) + EPS);
      modulate_store<true, true>(h, rstd2, ng + 2 * D, mod + 3 * D, mod + 4 * D, (bf16_t*)((unsigned char*)F + (size_t)r * D), lane, ft + wave * D);
    }
    __syncthreads();
    float acc[8] = {0, 0, 0, 0, 0, 0, 0, 0};
    const int d0 = wave * 256;
#pragma unroll 2
    for (int dd = 0; dd < 256; dd += 4) {
      const float* rp = router + (size_t)(d0 + dd) * NE + lane;
      const float r0 = rp[0], r1 = rp[NE], r2 = rp[2 * NE], r3 = rp[3 * NE];
#pragma unroll
      for (int t = 0; t < 8; ++t) { const f32x4 fv = *(LAS const f32x4*)(ft + t * D + d0 + dd); acc[t] += fv[0] * r0 + fv[1] * r1 + fv[2] * r2 + fv[3] * r3; }
    }
#pragma unroll
    for (int t = 0; t < 8; ++t) part[(wave * 8 + t) * 64 + lane] = acc[t];
    __syncthreads();
    float logit = 0;
#pragma unroll
    for (int w = 0; w < 8; ++w) logit += part[(w * 8 + wave) * 64 + lane];
#if MK_DIAG
    ((float*)(a.ws + WS_Y))[(size_t)r * 64 + lane] = logit;
#endif
    const float score = sigmoidf_(logit);
    const float choice = score + rbias[lane];
    int rank = 0; const int gl = lane & 7;
#pragma unroll
    for (int j = 0; j < 8; ++j) { const float o = __shfl(choice, (lane & ~7) | j); rank += (o > choice || (o == choice && j < gl)) ? 1 : 0; }
    float gs = rank < 2 ? choice : 0.f;
    gs += __shfl_xor(gs, 1); gs += __shfl_xor(gs, 2); gs += __shfl_xor(gs, 4);
    int grank = 0; const int g = lane >> 3;
#pragma unroll
    for (int j = 0; j < 8; ++j) { const float o = __shfl(gs, j * 8); grank += (o > gs || (o == gs && j < g)) ? 1 : 0; }
    const bool gsel = grank < 4;
    const float mc = gsel ? choice : -INFINITY;
    int erank = 0;
#pragma unroll 4
    for (int j = 0; j < 64; ++j) { const float o = __int_as_float(__builtin_amdgcn_readlane(__float_as_int(mc), j)); erank += (o > mc || (o == mc && j < lane)) ? 1 : 0; }
    const bool sel = gsel && erank < 8;
    const unsigned long long bal = __ballot(sel);
    const int idx = __popcll(bal & ((1ull << lane) - 1ull));
    const float ssum = wave_sum(sel ? score : 0.f);
    if (sel && !dry) { const int pos = atomicAdd(&counts[lane], 1);
      top_e[r * 8 + idx] = lane; top_w[r * 8 + idx] = score / ssum * 2.5f; top_p[r * 8 + idx] = pos; }
  }
}

__device__ __forceinline__ void moe_tile_prefix(const int* counts, LAS int* ts) {
  if (threadIdx.x == 0) { int s = 0; for (int e = 0; e < 64; ++e) { ts[e] = s; s += (counts[e] + 255) >> 8; } ts[64] = s; }
  __syncthreads();
}
__device__ __forceinline__ void phase_H(const Args& a, int L, LAS char* lds) {
  const int NTOK = L == 0 ? MT : SEQ, ROW0 = L == 0 ? 0 : CTXL;
  const int* counts = (const int*)(a.ws + WS_CTL + CTL_CNT) + L * 64;
  const int* top_e = (const int*)(a.ws + WS_TOPE); const int* top_p = (const int*)(a.ws + WS_TOPP);
  int* tslot = (int*)(a.ws + WS_TSLOT); int* stok = (int*)(a.ws + WS_STOK);
  LAS int* ts = (LAS int*)lds;
  moe_tile_prefix(counts, ts);
  int tid = threadIdx.x; asm volatile("" : "+v"(tid)); tid &= 511;
  const int gt = blockIdx.x * NTHREADS + tid, gs = gridDim.x * NTHREADS;
  for (int i = gt; i < NTOK * 8; i += gs) { const int q = ROW0 * 8 + i; const int e = top_e[q]; const int slot = ts[e] * 256 + top_p[q]; stok[slot] = q >> 3; tslot[q] = slot; }
  for (int i = gt; i < 64 * 256; i += gs) { const int e = i >> 8, p = i & 255, cnt = counts[e], nt = (cnt + 255) >> 8; if (cnt + p < nt * 256) stok[ts[e] * 256 + cnt + p] = ROW0; }
  for (int i = gt; i < NTOK; i += gs) stok[SH_BASE + i] = ROW0 + i;
  __syncthreads();
}
struct MoeSched {
  LAS const int* ts; int TR, NN, total; const unsigned char* W; size_t woff;
  __device__ __forceinline__ bool unit(int i, int& slot0, const unsigned char*& Bt, int& bcol) const {
    for (int u = blockIdx.x + i * (int)gridDim.x; ; u += gridDim.x) {
      const int rnd = u >> 8, b = u & 255, v = rnd * 256 + (b & 7) * 32 + (b >> 3);
      if (rnd * 256 >= total) return false;
      if (v >= total) return false;
      const int m = v / NN, pn = v % NN;
      int e;
      if (m >= TR) { e = 64; slot0 = SH_BASE + 256 * (m - TR); } else { e = 0; while (ts[e + 1] <= m) ++e; slot0 = 256 * m; }
      Bt = W + (size_t)e * WMOE8_E + woff; bcol = pn * 256;
      return true;
    }
  }
};
__device__ __forceinline__ void phase_moe_up(const Args& a, int L, LAS char* lds) {
  const int NSH = L == 0 ? MT / 256 : SEQ / 256;
  const int* counts = (const int*)(a.ws + WS_CTL + CTL_CNT) + L * 64;
  LAS int* ts = (LAS int*)(lds + LDS_CTL + 64);
  moe_tile_prefix(counts, ts);
  const int TR = ts[64], TM = TR + NSH;
  const unsigned char* F = (const unsigned char*)(a.ws + WS_ABUF); const unsigned char* W = (const unsigned char*)(a.ws + WS_WMOE) + (size_t)L * 65 * WMOE8_E;
  const int* stok = (const int*)(a.ws + WS_STOK);
  EpiSwiGLU8 epi{(unsigned char*)(a.ws + WS_ACT), EFF};
  MoeSched sc{ts, TR, 4, TM * 4, W, 0};
  gemm8_run<true, D, D, D>(F, stok, lds, epi, sc);
}
__device__ __forceinline__ void phase_moe_down(const Args& a, int L, LAS char* lds) {
  const int NSH = L == 0 ? MT / 256 : SEQ / 256;
  const int* counts = (const int*)(a.ws + WS_CTL + CTL_CNT) + L * 64;
  LAS int* ts = (LAS int*)(lds + LDS_CTL + 64);
  moe_tile_prefix(counts, ts);
  const int TR = ts[64], TM = TR + NSH;
  const unsigned char* ACT = (const unsigned char*)(a.ws + WS_ACT); const unsigned char* W = (const unsigned char*)(a.ws + WS_WMOE) + (size_t)L * 65 * WMOE8_E;
  EpiPlainS epi{(bf16_t*)(a.ws + WS_Y), D, 1.f / 128.f};
  MoeSched sc{ts, TR, 8, TM * 8, W, (size_t)1024 * D};
  gemm8_run<false, EFF, EFF, EFF>(ACT, nullptr, lds, epi, sc);
}
__device__ __forceinline__ void phase_combine(const Args& a, int L, bool dry = false) {
  int tid = threadIdx.x; asm volatile("" : "+v"(tid)); tid &= 511; const int wave = tid >> 6, lane = tid & 63;
  const int NTOK = L == 0 ? MT : SEQ, ROW0 = L == 0 ? 0 : CTXL;
  const float* ng = a.in[6] + (size_t)L * 4 * D;
  const float* MODL = (const float*)(a.ws + WS_MOD) + (size_t)(L * 2) * 12288;
  const bf16_t* Y = (const bf16_t*)(a.ws + WS_Y);
  float* HRES = (float*)(a.ws + WS_HRES);
  const int* tslot = (const int*)(a.ws + WS_TSLOT); const float* top_w = (const float*)(a.ws + WS_TOPW);
  for (int it = blockIdx.x; it < NTOK / 8; it += gridDim.x) {
    const int r = ROW0 + it * 8 + wave;
    const float* mod = MODL + (r < CTXL ? 12288 : 0);
    float y[32];
    { float t[32]; ld_row_bf16(Y + (size_t)(SH_BASE + r - ROW0) * D, lane, t);
#pragma unroll
      for (int i = 0; i < 32; ++i) y[i] = t[i]; }
#pragma unroll 4
    for (int k = 0; k < 8; ++k) { const int slot = tslot[r * 8 + k]; const float w = top_w[r * 8 + k];
      float t[32]; ld_row_bf16(Y + (size_t)slot * D, lane, t);
#pragma unroll
      for (int i = 0; i < 32; ++i) y[i] += w * t[i]; }
    const float rstd = rsqrtf(sumsq32(y) * (1.f / D) + EPS);
    float h[32]; ld_row_f32(HRES + (size_t)r * D, lane, h);
#pragma unroll
    for (int j = 0; j < 4; ++j) { const int idx = 8 * lane + 512 * j;
      float g3[8], gt[8]; ld8f(ng + 3 * D + idx, g3); ld8f(mod + 5 * D + idx, gt);
#pragma unroll
      for (int i = 0; i < 8; ++i) h[8 * j + i] += gt[i] * (y[8 * j + i] * rstd * g3[i]);
      if (L == 0) { if (!dry) st8f(HRES + (size_t)r * D + idx, &h[8 * j]); } else st8f(a.out + (size_t)(r - CTXL) * D + idx, &h[8 * j]); }
    if (L == 0) {
      const float* mod1 = MODL + 2 * 12288 + (r < CTXL ? 12288 : 0);
      const float rstd2 = rsqrtf(sumsq32(h) * (1.f / D) + EPS);
      modulate_store<false>(h, rstd2, a.in[6] + (size_t)4 * D, mod1, mod1 + D, (bf16_t*)(a.ws + WS_ABUF) + (size_t)r * D, lane, nullptr);
    }
  }
}

constexpr int NPH = 21;
typedef const __attribute__((address_space(4))) Args* ArgsP;
#if defined(__HIP_DEVICE_COMPILE__)
#define FRESH_ARGS() const Args a = *({ ArgsP _p = (ArgsP)__builtin_amdgcn_kernarg_segment_ptr(); asm volatile("" : "+s"(_p)); _p; })
#else
#define FRESH_ARGS() const Args a = kargs
#endif
__global__ void __launch_bounds__(NTHREADS, 2) fwd(Args kargs) {
  extern __shared__ __attribute__((aligned(16))) unsigned char lds_raw[];
  LAS char* lds = (LAS char*)lds_raw;
  const int lo = kargs.ph_lo, hi = kargs.ph_hi;
  if (threadIdx.x < 64) ((LAS unsigned*)(lds + LDS_CTL))[threadIdx.x] = 0u;
  __syncthreads();
  if (hi - lo > 1) (void)xcd_barrier_post((unsigned*)(kargs.ws + WS_CTL), (volatile LAS unsigned*)(lds + LDS_CTL));
#ifndef PHASE_MASK
#define PHASE_MASK 0xFFFFFFFFu
#endif
#define IN(k) (((PHASE_MASK >> (k)) & 1u) && lo <= (k) && (k) < hi)
#ifndef PH_REPEAT_MASK
#define PH_REPEAT_MASK 0u
#endif
#define REP(k) for (int _rep = 0; _rep < (((PH_REPEAT_MASK >> (k)) & 1u) ? 2 : 1); ++_rep)
#define SEAM(k) do { if ((k) + 1 < hi) { XcdBarrier _b; _b.bar = (unsigned*)(a.ws + WS_CTL); _b.x = xb_xcc_id(); _b.st = (volatile LAS unsigned*)(lds + LDS_CTL); xcd_barrier(_b); } } while (0)

  if (IN(0)) { FRESH_ARGS(); REP(0) phase_prologue(a, lds); SEAM(0); }
  if (IN(1)) { FRESH_ARGS(); REP(1) phase_modulate0(a); SEAM(1); }
#pragma unroll
  for (int L = 0; L < 2; ++L) {
    const int base = 2 + (L == 0 ? 0 : 9);
    if (IN(base + 0)) {
      FRESH_ARGS();
      const bf16_t* A = (const bf16_t*)(a.ws + WS_ABUF);
      const bf16_t* Bt = (const bf16_t*)(a.ws + (L == 0 ? WS_WIN0 : WS_WIN1));
      const int nN = L == 0 ? N_IN0 / 256 : N_IN1 / 256, nM = MT / 256;
      EpiG1 epi{EpiPlain{(bf16_t*)(a.ws + WS_QKVU), L == 0 ? N_QKV0 : N_IN1}, EpiPair<0>{(bf16_t*)(a.ws + WS_HG), 1024, N_QKV0}, L == 0 ? N_QKV0 : N_IN1};
      REP(2) for (int u = blockIdx.x; u < nM * nN; u += gridDim.x) { int pm, pn; dense_unit(u, nM, nN, pm, pn);
        gemm_tile<false>(A, D, nullptr, pm * 256, Bt, D, pn * 256, D, lds, epi); }
      SEAM(base + 0);
    }
    if (L == 0) {
      if (IN(3)) { FRESH_ARGS(); if ((PH_REPEAT_MASK >> 3) & 1u) { phase_rope_conv0(a, lds, true); __syncthreads(); } phase_rope_conv0(a, lds); SEAM(3); }
      if (IN(4)) { FRESH_ARGS(); REP(4) phase_attn(a, 0, lds); SEAM(4); }
    } else {
      if (IN(12)) { FRESH_ARGS(); if ((PH_REPEAT_MASK >> 12) & 1u) { phase_rope1(a, lds, true); __syncthreads(); } phase_rope1(a, lds); SEAM(12); }
      if (IN(13)) { FRESH_ARGS(); REP(13) phase_attn(a, 1, lds); SEAM(13); }
      if (IN(14)) { FRESH_ARGS(); REP(14) phase_diff(a); SEAM(14); }
    }
    const int b2 = L == 0 ? 5 : 15;
    if (IN(b2 + 0)) {
      FRESH_ARGS();
      const bf16_t* A = (const bf16_t*)(a.ws + WS_X2);
      const bf16_t* Bt = (const bf16_t*)(a.ws + (L == 0 ? WS_WOUT0 : WS_WOUT1));
      const int nN = D / 256, nM = L == 0 ? MT / 256 : SEQ / 256, r0 = L == 0 ? 0 : CTXL;
      EpiPlain epi{(bf16_t*)(a.ws + WS_OUT), D};
      REP(5) for (int u = blockIdx.x; u < nM * nN; u += gridDim.x) { int pm, pn; dense_unit(u, nM, nN, pm, pn);
        gemm_tile<false>(A, D, nullptr, r0 + pm * 256, Bt, D, pn * 256, D, lds, epi); }
      SEAM(b2 + 0);
    }
    if (IN(b2 + 1)) { FRESH_ARGS(); if ((PH_REPEAT_MASK >> 6) & 1u) { phase_G(a, L, lds, true); __syncthreads(); } phase_G(a, L, lds); SEAM(b2 + 1); }
    if (IN(b2 + 2)) { FRESH_ARGS(); REP(7) phase_H(a, L, lds); SEAM(b2 + 2); }
    if (IN(b2 + 3)) { FRESH_ARGS(); REP(8) phase_moe_up(a, L, lds); SEAM(b2 + 3); }
    if (IN(b2 + 4)) { FRESH_ARGS(); REP(9) phase_moe_down(a, L, lds); SEAM(b2 + 4); }
    if (IN(b2 + 5)) { FRESH_ARGS(); if ((PH_REPEAT_MASK >> 10) & 1u) phase_combine(a, L, true); phase_combine(a, L); SEAM(b2 + 5); }
  }
#undef IN
#undef SEAM
}

#ifndef MK_DIAG
#define MK_DIAG 0
#endif
#if MK_DIAG
__device__ __forceinline__ void rope_cs(int r, int lane, float& cs, float& sn) {
  cs = 1.f; sn = 0.f;
  if (r >= CTXL) { const int t = r - CTXL; const int a = lane >> 5, i = lane & 31;
    const float pos = a ? (float)(t & 63) : (float)(t >> 6);
    const float inv = powf(10000.f, -(float)i / 32.f);
    sincosf(pos * inv, &sn, &cs); }
}
__device__ __forceinline__ bool dclose(float got, float ref, float rtol, float atol) { return fabsf(got - ref) <= rtol * fabsf(ref) + atol; }
__device__ __forceinline__ unsigned dhash(unsigned x) { x ^= x >> 16; x *= 0x7feb352du; x ^= x >> 15; x *= 0x846ca68bu; x ^= x >> 16; return x; }
__device__ float wdot(const bf16_t* arow, const float* W, int ldw, int col, int K, int lane) {
  float s = 0; for (int k = lane; k < K; k += 64) s += bf2f(arow[k]) * W[(size_t)k * ldw + col]; return wave_sum(s); }
__device__ void dflag(int* dg, int s, int bad, int lane) { if (lane == 0 && bad) atomicAdd(&dg[s], bad); }
__device__ const float* h0row(const Args& a, int r) { return r < CTXL ? a.in[2] + (size_t)r * D : a.in[0] + (size_t)(r - CTXL) * D; }
__device__ int pick_row(unsigned h, int lo, int n) { const unsigned m = h % 8; if (m == 0) return lo; if (m == 1) return lo + n - 1; if (m == 2) return lo + 255 < lo + n ? lo + 255 : lo; if (m == 3) return lo + 256 < lo + n ? lo + 256 : lo; return lo + (int)((h >> 3) % (unsigned)n); }
__device__ void naive_attn(const bf16_t* q, const bf16_t* K, const bf16_t* V, int ld, int nkeys, int lane, float& o0, float& o1) {
  const float q0 = bf2f(q[lane]), q1 = bf2f(q[lane + 64]);
  float m = -1e30f, l = 0; o0 = 0; o1 = 0;
  for (int k = 0; k < nkeys; ++k) {
    const float s = wave_sum(q0 * bf2f(K[(size_t)k * ld + lane]) + q1 * bf2f(K[(size_t)k * ld + lane + 64])) * 0.088388347648318440f;
    const float mn = fmaxf(m, s), al = expf(m - mn), p = expf(s - mn);
    l = l * al + p; o0 = o0 * al + p * bf2f(V[(size_t)k * ld + lane]); o1 = o1 * al + p * bf2f(V[(size_t)k * ld + lane + 64]); m = mn;
  }
  o0 /= l; o1 /= l;
}
__global__ void __launch_bounds__(256) diag(Args a, int k) {
  __shared__ float fsh[4][2048];
  __shared__ float csh[4][64];
  const int lane = threadIdx.x & 63, wv = threadIdx.x >> 6, gw = blockIdx.x * 4 + wv;
  int* dg = (int*)(a.ws + WS_CTL + CTL_CNT + 512);
  const float* MOD = (const float*)(a.ws + WS_MOD);
  const bf16_t* AB = (const bf16_t*)(a.ws + WS_ABUF);
  const bf16_t* QK = (const bf16_t*)(a.ws + WS_QKVU);
  const bf16_t* HG = (const bf16_t*)(a.ws + WS_HG);
  const bf16_t* X2 = (const bf16_t*)(a.ws + WS_X2);
  const bf16_t* OUT = (const bf16_t*)(a.ws + WS_OUT);
  const bf16_t* ACT = (const bf16_t*)(a.ws + WS_ACT);
  const bf16_t* Y = (const bf16_t*)(a.ws + WS_Y);
  const float* HRES = (const float*)(a.ws + WS_HRES);
  const int* top_e = (const int*)(a.ws + WS_TOPE); const float* top_w = (const float*)(a.ws + WS_TOPW); const int* top_p = (const int*)(a.ws + WS_TOPP);
  const int* tslot = (const int*)(a.ws + WS_TSLOT); const int* stok = (const int*)(a.ws + WS_STOK);
  const unsigned h = dhash(gw * 7919u + k * 104729u + 17u), h2 = dhash(h + 12345u);
  int bad = 0;
  const int L = k >= 11 ? 1 : 0;
  const int NTOK = L == 0 ? MT : SEQ, ROW0 = L == 0 ? 0 : CTXL;
  const int* counts = (const int*)(a.ws + WS_CTL + CTL_CNT) + L * 64;
  if (k == 0) {
    const int LL = gw & 1, which = (gw >> 1) & 1, j = h % 12288;
    const float* v = which ? a.in[3] : a.in[1];
    float s = 0; for (int d = lane; d < D; d += 64) { const float x = v[d]; s += x * sigmoidf_(x) * a.in[4][((size_t)LL * D + d) * 12288 + j]; }
    s = wave_sum(s) + a.in[5][LL * 12288 + j];
    bad = !dclose(MOD[(LL * 2 + which) * 12288 + j], s, 1e-3f, 1e-3f); dflag(dg, 1, bad, lane);
  } else if (k == 1) {
    const int r = pick_row(h, 0, MT); const float* x = h0row(a, r); const float* mod = MOD + (r < CTXL ? 12288 : 0);
    float ss = 0; for (int d = lane; d < D; d += 64) ss += x[d] * x[d]; ss = wave_sum(ss); const float rstd = rsqrtf(ss / D + EPS);
    for (int d = lane; d < D; d += 64) { const float ref = x[d] * rstd * a.in[6][d] * (1.f + mod[D + d]) + mod[d]; bad += !dclose(bf2f(AB[(size_t)r * D + d]), ref, 0.01f, 0.01f); }
    bad = (int)wave_sum((float)bad); dflag(dg, 2, bad, lane);
  } else if (k == 2 || k == 11) {
    const int r = pick_row(h, 0, MT);
    if (L == 0) {
      const int c = h2 % N_QKV0; const float ref = wdot(AB + (size_t)r * D, a.in[7], N_IN0, c, D, lane);
      bad = !dclose(bf2f(QK[(size_t)r * N_QKV0 + c]), ref, 0.02f, 0.05f); dflag(dg, 3, bad, lane);
      const int ch = (h2 >> 11) % 1024; const float av = wdot(AB + (size_t)r * D, a.in[7], N_IN0, N_QKV0 + ch, D, lane), gv = wdot(AB + (size_t)r * D, a.in[7], N_IN0, N_QKV0 + 1024 + ch, D, lane);
      bad = !dclose(bf2f(HG[(size_t)r * 1024 + ch]), av * sigmoidf_(gv), 0.03f, 0.05f); dflag(dg, 4, bad, lane);
    } else {
      const int c = h2 % N_IN1; const float ref = wdot(AB + (size_t)r * D, a.in[15], N_IN1, c, D, lane);
      bad = !dclose(bf2f(QK[(size_t)r * N_IN1 + c]), ref, 0.02f, 0.05f); dflag(dg, 15, bad, lane);
    }
  } else if (k == 3) {
    { const int r = pick_row(h, 0, MT), hh = h2 % 10; const float* g = hh < 8 ? a.in[9] : a.in[10];
      float raw0 = 0, raw1 = 0;
      for (int d = 0; d < 128; ++d) { const float v = wdot(AB + (size_t)r * D, a.in[7], N_IN0, hh * 128 + d, D, lane); if (d == lane) raw0 = v; if (d == lane + 64) raw1 = v; }
      const float rstd = rsqrtf(wave_sum(raw0 * raw0 + raw1 * raw1) / 128.f + EPS);
      const float y0 = raw0 * rstd * g[lane], y1 = raw1 * rstd * g[lane + 64];
      float cs, sn; rope_cs(r, lane, cs, sn);
      const float cs0 = __shfl(cs, lane & 31), sn0 = __shfl(sn, lane & 31), cs1 = __shfl(cs, 32 + (lane & 31)), sn1 = __shfl(sn, 32 + (lane & 31));
      const float p0 = __shfl_xor(y0, 32), p1 = __shfl_xor(y1, 32);
      const float o0 = (lane < 32) ? y0 * cs0 - p0 * sn0 : y0 * cs0 + p0 * sn0;
      const float o1 = (lane < 32) ? y1 * cs1 - p1 * sn1 : y1 * cs1 + p1 * sn1;
      bad = !dclose(bf2f(QK[(size_t)r * N_QKV0 + hh * 128 + lane]), o0, 0.03f, 0.05f) + !dclose(bf2f(QK[(size_t)r * N_QKV0 + hh * 128 + 64 + lane]), o1, 0.03f, 0.05f);
      bad = (int)wave_sum((float)bad); dflag(dg, 5, bad, lane); }
    { const int r = pick_row(h2, 0, MT); const int seg0 = r < CTXL ? 0 : CTXL, seg1 = r < CTXL ? CTXL : MT;
      float cv[16]; float s1 = 0, s2 = 0;
      for (int q = 0; q < 16; ++q) { const int c = lane + 64 * q; float acc = a.in[12][c];
        for (int j = 0; j < 31; ++j) { const int rr = r + j - 15; if (rr >= seg0 && rr < seg1) acc += bf2f(HG[(size_t)rr * 1024 + c]) * a.in[11][j * 1024 + c]; }
        cv[q] = acc; s1 += acc; s2 += acc * acc; }
      s1 = wave_sum(s1); s2 = wave_sum(s2); const float mean = s1 / 1024.f, rstd = rsqrtf(s2 / 1024.f - mean * mean + EPS);
      bad = 0;
      for (int q = 0; q < 16; ++q) { const int c = lane + 64 * q; float y = (cv[q] - mean) * rstd * a.in[13][c] + a.in[14][c]; y = y * sigmoidf_(y);
        bad += !dclose(bf2f(X2[(size_t)r * D + 1024 + c]), y, 0.03f, 0.03f); }
      bad = (int)wave_sum((float)bad); dflag(dg, 6, bad, lane); }
  } else if (k == 4) {
    if (gw < 64) { const int r = pick_row(h, 0, MT), head = h2 % 8; const int nkeys = r < CTXL ? CTXL : MT;
      float o0, o1; naive_attn(QK + (size_t)r * N_QKV0 + head * 128, QK + 1024 + (head >> 2) * 128, QK + 1280 + (head >> 2) * 128, N_QKV0, nkeys, lane, o0, o1);
      bad = !dclose(bf2f(X2[(size_t)r * D + head * 128 + lane]), o0, 0.05f, 0.01f) + !dclose(bf2f(X2[(size_t)r * D + head * 128 + 64 + lane]), o1, 0.05f, 0.01f);
      bad = (int)wave_sum((float)bad); dflag(dg, 7, bad, lane); }
  } else if (k == 5 || k == 15) {
    const int r = pick_row(h, ROW0, NTOK), c = h2 % D; const float ref = wdot(X2 + (size_t)r * D, L == 0 ? a.in[8] : a.in[16], D, c, D, lane);
    bad = !dclose(bf2f(OUT[(size_t)r * D + c]), ref, 0.02f, 0.05f); dflag(dg, L == 0 ? 8 : 19, bad, lane);
  } else if (k == 6 || k == 16) {
    const int r = pick_row(h, ROW0, NTOK); const float* mod = MOD + (size_t)(L * 2) * 12288 + (r < CTXL ? 12288 : 0); const float* ng = a.in[6] + (size_t)L * 4 * D;
    float ss = 0; for (int d = lane; d < D; d += 64) { const float o = bf2f(OUT[(size_t)r * D + d]); ss += o * o; } ss = wave_sum(ss); const float rstd1 = rsqrtf(ss / D + EPS);
    bad = 0;
    if (L == 0) { const float* x = h0row(a, r); for (int d = lane; d < D; d += 64) { const float ref = x[d] + mod[2 * D + d] * (bf2f(OUT[(size_t)r * D + d]) * rstd1 * ng[D + d]); bad += !dclose(HRES[(size_t)r * D + d], ref, 1e-3f, 1e-3f); } }
    float s2 = 0; for (int d = lane; d < D; d += 64) { const float x = HRES[(size_t)r * D + d]; s2 += x * x; } s2 = wave_sum(s2); const float rstd2 = rsqrtf(s2 / D + EPS);
    for (int d = lane; d < D; d += 64) { const float f = HRES[(size_t)r * D + d] * rstd2 * ng[2 * D + d] * (1.f + mod[4 * D + d]) + mod[3 * D + d]; fsh[wv][d] = f; bad += !dclose(bf2f(AB[(size_t)r * D + d]), f, 0.01f, 0.01f); }
    bad = (int)wave_sum((float)bad); dflag(dg, L == 0 ? 9 : 20, bad, lane);
    __syncthreads();
    float lg = 0; for (int d = 0; d < D; ++d) lg += fsh[wv][d] * a.in[19][((size_t)L * D + d) * NE + lane];
    const float sc = sigmoidf_(lg); csh[wv][lane] = sc + a.in[20][L * NE + lane];
    __syncthreads();
    { const float plg = ((const float*)(a.ws + WS_Y))[(size_t)r * 64 + lane]; int lb = !dclose(plg, lg, 1e-3f, 1e-3f); lb = (int)wave_sum((float)lb); if (lane == 0 && lb) { atomicAdd(&dg[32 + (L == 0 ? 10 : 21) + 3], 1); atomicOr(&dg[60], 1 << (r & 7)); } }
    unsigned long long wsel;
    { const float choice = csh[wv][lane]; int rank = 0; const int gl = lane & 7;
      for (int j = 0; j < 8; ++j) { const float o = __shfl(choice, (lane & ~7) | j); rank += (o > choice || (o == choice && j < gl)) ? 1 : 0; }
      float gs = rank < 2 ? choice : 0.f; gs += __shfl_xor(gs, 1); gs += __shfl_xor(gs, 2); gs += __shfl_xor(gs, 4);
      int grank = 0; const int g = lane >> 3;
      for (int j = 0; j < 8; ++j) { const float o = __shfl(gs, j * 8); grank += (o > gs || (o == gs && j < g)) ? 1 : 0; }
      const bool gsel = grank < 4; const float mc = gsel ? choice : -INFINITY; int erank = 0;
      for (int j = 0; j < 64; ++j) { const float o = __shfl(mc, j); erank += (o > mc || (o == mc && j < lane)) ? 1 : 0; }
      wsel = __ballot(gsel && erank < 8); }
    int setbad = 0;
    if (lane == 0) {
      float gsc[8]; for (int g = 0; g < 8; ++g) { float m1 = -1e30f, m2 = -1e30f; for (int j = 0; j < 8; ++j) { const float v = csh[wv][g * 8 + j]; if (v > m1) { m2 = m1; m1 = v; } else if (v > m2) m2 = v; } gsc[g] = m1 + m2; }
      bool gs[8] = {false, false, false, false, false, false, false, false};
      for (int t = 0; t < 4; ++t) { int bi = 0; float bv = -1e30f; for (int g = 0; g < 8; ++g) if (!gs[g] && gsc[g] > bv) { bv = gsc[g]; bi = g; } gs[bi] = true; }
      unsigned long long selm = 0; for (int t = 0; t < 8; ++t) { int bi = 0; float bv = -1e30f; for (int e = 0; e < 64; ++e) if (gs[e >> 3] && !((selm >> e) & 1ull) && csh[wv][e] > bv) { bv = csh[wv][e]; bi = e; } selm |= 1ull << bi; }
      unsigned long long got = 0; for (int t = 0; t < 8; ++t) { const int e = top_e[r * 8 + t]; if (e < 0 || e > 63) setbad = 1000; else got |= 1ull << e; }
      if (setbad == 0 && got != selm) setbad = 1;
      if (wsel != selm) atomicAdd(&dg[32 + (L == 0 ? 10 : 21) + 4], 1);
    }
    setbad = __shfl(setbad, 0);
    { float wgot = -1.f; int mine = 0; for (int t = 0; t < 8; ++t) if (top_e[r * 8 + t] == lane) { mine = 1; wgot = top_w[r * 8 + t]; }
      const float ssum = wave_sum(mine ? sc : 0.f);
      int wbad = (mine && !dclose(wgot, sc / ssum * 2.5f, 0.01f, 1e-3f)) ? 1 : 0; wbad = (int)wave_sum((float)wbad);
      if (lane == 0) { int* q = &dg[32 + (L == 0 ? 10 : 21)]; if (setbad >= 1000) atomicAdd(q + 1, 1); else if (setbad) atomicAdd(q, 1); else if (wbad) atomicAdd(q + 2, 1); } }
  } else if (k == 7 || k == 17) {
    const int r = pick_row(h, ROW0, NTOK), t = h2 % 8, q = r * 8 + t; const int slot = tslot[q], e = top_e[q];
    int ts0 = 0; for (int j = 0; j < e; ++j) ts0 += (counts[j] + 255) >> 8;
    bad = (slot < ts0 * 256 || slot >= ts0 * 256 + counts[e] || stok[slot] != r || top_p[q] != slot - ts0 * 256) ? 1 : 0;
    bad += (stok[SH_BASE + r - ROW0] != r) ? 1 : 0;
    dflag(dg, L == 0 ? 11 : 22, bad, lane);
  } else if (k == 8 || k == 18 || k == 9 || k == 19) {
    int TR = 0; for (int j = 0; j < 64; ++j) TR += (counts[j] + 255) >> 8;
    int slot, e;
    if ((h & 3) == 0) { slot = SH_BASE + (int)((h >> 2) % (unsigned)NTOK); e = 64; }
    else { e = (h >> 2) % 64; int guard = 0; while (counts[e] == 0 && guard++ < 64) e = (e + 1) % 64; int ts0 = 0; for (int j = 0; j < e; ++j) ts0 += (counts[j] + 255) >> 8;
      const unsigned m = (h >> 8) % 4; const int cnt = counts[e]; const int p = m == 0 ? 0 : m == 1 ? cnt - 1 : (int)((h >> 10) % (unsigned)cnt); slot = ts0 * 256 + p; }
    const int tok = stok[slot];
    if (k == 8 || k == 18) {
      const int ch = h2 % EFF;
      const float* Wg = e < 64 ? a.in[21] + ((size_t)L * 64 + e) * D * EFF : a.in[24] + (size_t)L * D * EFF;
      const float* Wu = e < 64 ? a.in[22] + ((size_t)L * 64 + e) * D * EFF : a.in[25] + (size_t)L * D * EFF;
      const float gv = wdot(AB + (size_t)tok * D, Wg, EFF, ch, D, lane), uv = wdot(AB + (size_t)tok * D, Wu, EFF, ch, D, lane);
      bad = !dclose(bf2f(ACT[(size_t)slot * EFF + ch]), gv * sigmoidf_(gv) * uv, 0.03f, 0.03f); dflag(dg, L == 0 ? 12 : 23, bad, lane);
    } else {
      const int c = h2 % D; const float* Wd = e < 64 ? a.in[23] + ((size_t)L * 64 + e) * EFF * D : a.in[26] + (size_t)L * EFF * D;
      const float ref = wdot(ACT + (size_t)slot * EFF, Wd, D, c, EFF, lane);
      bad = !dclose(bf2f(Y[(size_t)slot * D + c]), ref, 0.02f, 0.03f); dflag(dg, L == 0 ? 13 : 24, bad, lane);
    }
  } else if (k == 10 || k == 20) {
    const int r = pick_row(h, ROW0, NTOK); const float* mod = MOD + (size_t)(L * 2) * 12288 + (r < CTXL ? 12288 : 0); const float* ng = a.in[6] + (size_t)L * 4 * D;
    float ss = 0; for (int d = lane; d < D; d += 64) { float y = bf2f(Y[(size_t)(SH_BASE + r - ROW0) * D + d]); for (int t = 0; t < 8; ++t) y += top_w[r * 8 + t] * bf2f(Y[(size_t)tslot[r * 8 + t] * D + d]); fsh[wv][d] = y; ss += y * y; }
    ss = wave_sum(ss); const float rstd = rsqrtf(ss / D + EPS);
    bad = 0;
    if (L == 0) { float s2 = 0; for (int d = lane; d < D; d += 64) { const float x = HRES[(size_t)r * D + d]; s2 += x * x; } s2 = wave_sum(s2); const float rstd2 = rsqrtf(s2 / D + EPS);
      const float* mod1 = MOD + (size_t)2 * 12288 + (r < CTXL ? 12288 : 0);
      for (int d = lane; d < D; d += 64) { const float ref = HRES[(size_t)r * D + d] * rstd2 * a.in[6][4 * D + d] * (1.f + mod1[D + d]) + mod1[d]; bad += !dclose(bf2f(AB[(size_t)r * D + d]), ref, 0.01f, 0.01f); } }
    else { for (int d = lane; d < D; d += 64) { const float ref = HRES[(size_t)r * D + d] + mod[5 * D + d] * (fsh[wv][d] * rstd * ng[3 * D + d]); bad += !dclose(a.out[(size_t)(r - CTXL) * D + d], ref, 1e-3f, 1e-3f); } }
    bad = (int)wave_sum((float)bad); dflag(dg, L == 0 ? 14 : 25, bad, lane);
  } else if (k == 12) {
    const int r = pick_row(h, CTXL, SEQ), hh = h2 % 32;
    float raw0 = 0, raw1 = 0;
    for (int d = 0; d < 128; ++d) { const float v = wdot(AB + (size_t)r * D, a.in[15], N_IN1, hh * 128 + d, D, lane); if (d == lane) raw0 = v; if (d == lane + 64) raw1 = v; }
    float cs, sn; rope_cs(r, lane, cs, sn);
    const float cs0 = __shfl(cs, lane & 31), sn0 = __shfl(sn, lane & 31), cs1 = __shfl(cs, 32 + (lane & 31)), sn1 = __shfl(sn, 32 + (lane & 31));
    const float p0 = __shfl_xor(raw0, 32), p1 = __shfl_xor(raw1, 32);
    const float o0 = (lane < 32) ? raw0 * cs0 - p0 * sn0 : raw0 * cs0 + p0 * sn0;
    const float o1 = (lane < 32) ? raw1 * cs1 - p1 * sn1 : raw1 * cs1 + p1 * sn1;
    bad = !dclose(bf2f(QK[(size_t)r * N_IN1 + hh * 128 + lane]), o0, 0.03f, 0.05f) + !dclose(bf2f(QK[(size_t)r * N_IN1 + hh * 128 + 64 + lane]), o1, 0.03f, 0.05f);
    bad = (int)wave_sum((float)bad); dflag(dg, 16, bad, lane);
  } else if (k == 13) {
    if (gw < 64) { const int r = pick_row(h, CTXL, SEQ), hc = h2 % 16, vh = (h2 >> 4) & 1, hd = hc >> 1;
      float o0, o1; naive_attn(QK + (size_t)r * N_IN1 + hc * 128, QK + 2048 + hc * 128, QK + 4096 + hd * 256 + vh * 128, N_IN1, MT, lane, o0, o1);
      const bf16_t* O = Y + (size_t)(r - CTXL) * 4096 + hc * 256 + vh * 128;
      bad = !dclose(bf2f(O[lane]), o0, 0.05f, 0.01f) + !dclose(bf2f(O[64 + lane]), o1, 0.05f, 0.01f);
      bad = (int)wave_sum((float)bad); dflag(dg, 17, bad, lane); }
  } else if (k == 14) {
    const int r = pick_row(h, CTXL, SEQ), hd = h2 % 8; const float* lp = a.in[17];
    float s1 = 0, s2 = 0; for (int i = lane; i < 128; i += 64) { s1 += lp[i] * lp[128 + i]; s2 += lp[256 + i] * lp[384 + i]; } s1 = wave_sum(s1); s2 = wave_sum(s2);
    const float lam = expf(s1) - expf(s2) + LAM_INIT; const bf16_t* O = Y + (size_t)(r - CTXL) * 4096;
    float dv[4], ss = 0; for (int i = 0; i < 4; ++i) { const int d = lane + 64 * i; dv[i] = bf2f(O[(2 * hd) * 256 + d]) - lam * bf2f(O[(2 * hd + 1) * 256 + d]); ss += dv[i] * dv[i]; }
    ss = wave_sum(ss); const float rstd = rsqrtf(ss / 256.f + EPS) * (1.f - LAM_INIT); bad = 0;
    for (int i = 0; i < 4; ++i) { const int d = lane + 64 * i; bad += !dclose(bf2f(X2[(size_t)r * D + hd * 256 + d]), dv[i] * rstd * a.in[18][d], 0.02f, 0.01f); }
    bad = (int)wave_sum((float)bad); dflag(dg, 18, bad, lane);
  }
}
__global__ void diag_encode(Args a) {
  const int* dg = (const int*)(a.ws + WS_CTL + CTL_CNT + 512);
  int s = 0;
  int sub = 0;
  for (int i = 1; i < 32; ++i) { int v = dg[i]; if (i == 10 || i == 21) { v = (dg[32 + i] > 25 ? 1 : 0) + (dg[33 + i] > 0 ? 2 : 0) + (dg[34 + i] > 0 ? 4 : 0) + (dg[35 + i] > 0 ? 8 : 0) + (dg[36 + i] > 0 ? 16 : 0); sub = v; } if (v) { s = i; break; } }
  if (s == 0) return;
  const float c = sub ? 30.f + 8.f * sub : 10.f * s;
  for (size_t i = (size_t)blockIdx.x * blockDim.x + threadIdx.x; i < (size_t)SEQ * D; i += (size_t)gridDim.x * blockDim.x) a.out[i] = c;
}
#endif

extern "C" void kernel_launch(void* const* d_in, const int* in_sizes, int n_in, void* d_out, int out_size, void* d_ws, size_t ws_size, hipStream_t stream) {
  static int grid = 0;
  if (grid == 0) {
    if (n_in != 27 || out_size != SEQ * D || ws_size < WS_END) { fprintf(stderr, "kernel_launch: unexpected shapes (n_in %d out %d ws %zu need %zu)\n", n_in, out_size, ws_size, (size_t)WS_END); grid = -1; return; }
    if (hipFuncSetAttribute((const void*)fwd, hipFuncAttributeMaxDynamicSharedMemorySize, LDS_BYTES) != hipSuccess) { fprintf(stderr, "kernel_launch: hipFuncSetAttribute failed\n"); grid = -1; return; }
    int dev = 0, cus = 0, per_cu = 0;
    hipGetDevice(&dev); hipDeviceGetAttribute(&cus, hipDeviceAttributeMultiprocessorCount, dev);
    if (hipOccupancyMaxActiveBlocksPerMultiprocessor(&per_cu, (const void*)fwd, NTHREADS, LDS_BYTES) != hipSuccess || per_cu < 1) fprintf(stderr, "kernel_launch: occupancy query says %d\n", per_cu);
    (void)hipGetLastError();
    grid = cus < 256 ? cus : 256;
    if (grid != 256) fprintf(stderr, "kernel_launch: %d CUs (expected 256)\n", cus);
  }
  if (grid < 0) return;
  hipMemsetAsync((char*)d_ws + WS_CTL, 0, CTL_BYTES, stream);
  Args a{};
  for (int i = 0; i < 27; ++i) a.in[i] = (const float*)d_in[i];
  a.out = (float*)d_out; a.ws = (unsigned char*)d_ws;
#if MK_MULTI
  for (int k = 0; k < NPH; ++k) { a.ph_lo = k; a.ph_hi = k + 1; hipLaunchKernelGGL(fwd, dim3(grid), dim3(NTHREADS), LDS_BYTES, stream, a);
#if MK_DIAG
    hipLaunchKernelGGL(diag, dim3(64), dim3(256), 0, stream, a, k);
#endif
  }
#if MK_DIAG
  hipLaunchKernelGGL(diag_encode, dim3(1024), dim3(256), 0, stream, a);
#endif
#else
  a.ph_lo = 0; a.ph_hi = NPH;
  hipLaunchKernelGGL(fwd, dim3(grid), dim3(NTHREADS), LDS_BYTES, stream, a);
#endif
  const hipError_t le = hipPeekAtLastError();
  if (le != hipSuccess) fprintf(stderr, "kernel_launch: launch failed: %s\n", hipGetErrorName(le));
}
```

```cpp
#include <hip/hip_runtime.h>
#include <cstdio>
#include <cstdint>

#define MK_DIAG 0
#ifndef MK_MULTI
#define MK_MULTI 0
#endif

#define LAS __attribute__((address_space(3)))
typedef unsigned short bf16_t;
typedef short bf16x8 __attribute__((ext_vector_type(8)));
typedef short s16x4 __attribute__((ext_vector_type(4)));
typedef float f32x4 __attribute__((ext_vector_type(4)));
typedef float f32x2 __attribute__((ext_vector_type(2)));
typedef float f32x16 __attribute__((ext_vector_type(16)));
typedef unsigned u32x4 __attribute__((ext_vector_type(4)));
typedef unsigned u32x2 __attribute__((ext_vector_type(2)));

constexpr int D = 2048, SEQ = 16384, CTXL = 256, MT = SEQ + CTXL;
constexpr int NE = 64, TOPK = 8, EFF = 512;
constexpr int N_IN0 = 3584, N_QKV0 = 1536, N_IN1 = 6144;
constexpr float EPS = 1e-6f;
constexpr float LAM_INIT = 0.35550907f;
constexpr int SH_BASE = SEQ * 0 + (MT * TOPK) + NE * 256;
constexpr int NSLOT = SH_BASE + MT;
constexpr int NTHREADS = 512;
constexpr int LDS_BYTES = 131072 + 1024;
constexpr int LDS_CTL = 131072;

constexpr size_t al256(size_t x) { return (x + 255) & ~(size_t)255; }
constexpr size_t WS_CTL   = 0;
constexpr size_t CTL_BYTES = 32768;
constexpr size_t CTL_CNT  = 16384;
constexpr size_t CTL_KMAX = 16384 + 2048;
constexpr size_t WS_MOD   = CTL_BYTES;
constexpr size_t WS_WIN0  = al256(WS_MOD + 2 * 2 * 12288 * 4);
constexpr size_t WS_WOUT0 = al256(WS_WIN0 + (size_t)N_IN0 * D * 2);
constexpr size_t WS_WIN1  = al256(WS_WOUT0 + (size_t)D * D * 2);
constexpr size_t WS_WOUT1 = al256(WS_WIN1 + (size_t)N_IN1 * D * 2);
constexpr size_t WMOE_E   = (size_t)1024 * D + (size_t)D * EFF;
constexpr size_t WS_WMOE  = al256(WS_WOUT1 + (size_t)D * D * 2);
constexpr size_t WS_HRES  = al256(WS_WMOE + 65 * WMOE_E * 2);
constexpr size_t WS_ABUF  = al256(WS_HRES + (size_t)MT * D * 4);
constexpr size_t WS_QKVU  = al256(WS_ABUF + (size_t)MT * D * 2);
constexpr size_t WS_HG    = al256(WS_QKVU + (size_t)MT * N_IN1 * 2);
constexpr size_t WS_X2    = al256(WS_HG + (size_t)MT * 1024 * 2);
constexpr size_t WS_OUT   = al256(WS_X2 + (size_t)MT * D * 2);
constexpr size_t WS_ACT   = al256(WS_OUT + (size_t)MT * D * 2);
constexpr size_t WS_Y     = al256(WS_ACT + (size_t)NSLOT * EFF * 2);
constexpr size_t WS_TOPE  = al256(WS_Y + (size_t)NSLOT * D * 2);
constexpr size_t WS_TOPW  = al256(WS_TOPE + (size_t)MT * TOPK * 4);
constexpr size_t WS_TOPP  = al256(WS_TOPW + (size_t)MT * TOPK * 4);
constexpr size_t WS_TSLOT = al256(WS_TOPP + (size_t)MT * TOPK * 4);
constexpr size_t WS_STOK  = al256(WS_TSLOT + (size_t)MT * TOPK * 4);
constexpr size_t WS_END   = al256(WS_STOK + (size_t)NSLOT * 4);

struct Args { const float* in[27]; float* out; unsigned char* ws; int ph_lo, ph_hi; };

__device__ __forceinline__ float bflo(unsigned x) { return __uint_as_float(x << 16); }
__device__ __forceinline__ float bfhi(unsigned x) { return __uint_as_float(x & 0xffff0000u); }
__device__ __forceinline__ float bf2f(bf16_t b) { return __uint_as_float(((unsigned)b) << 16); }
__device__ __forceinline__ unsigned cvtpk(float lo, float hi) { unsigned r; asm("v_cvt_pk_bf16_f32 %0, %1, %2" : "=v"(r) : "v"(lo), "v"(hi)); return r; }
__device__ __forceinline__ bf16_t f2bf(float x) { return (bf16_t)(cvtpk(x, 0.f) & 0xffffu); }
__device__ __forceinline__ float wave_sum(float v) {
#pragma unroll
  for (int o = 32; o; o >>= 1) v += __shfl_xor(v, o);
  return v;
}
__device__ __forceinline__ float sigmoidf_(float x) { return 1.f / (1.f + expf(-x)); }

#define XB_TMO      128
#define XB_XCNT(j)  (256  + 64 * (j))
#define XB_XSUB(j)  (1280 + 64 * (j))
#define XB_XGEN(j)  (2304 + 64 * (j))
#define XB_TOP      3328
#define XB_TOPGEN   3392
#define XCD_BAR_WORDS 3456
#define XB_SPIN_CAP (1u << 22)
__device__ __forceinline__ unsigned xb_ld(unsigned* p)              { return __hip_atomic_load(p, __ATOMIC_RELAXED, __HIP_MEMORY_SCOPE_AGENT); }
__device__ __forceinline__ unsigned xb_add(unsigned* p, unsigned v) { return __hip_atomic_fetch_add(p, v, __ATOMIC_RELAXED, __HIP_MEMORY_SCOPE_AGENT); }
__device__ __forceinline__ unsigned xb_xcc_id() { return (unsigned)__builtin_amdgcn_s_getreg((3 << 11) | 20) & 0xFu; }
#define XB_SPIN(cond, bar) do { unsigned _sp = 0; while (cond) { __builtin_amdgcn_s_sleep(1); \
    if ((++_sp & 255u) == 0u) { if (xb_ld(&(bar)[XB_TMO])) break; if (_sp > XB_SPIN_CAP) { atomicAdd(&(bar)[XB_TMO], 1u); break; } } } } while (0)
struct XcdBarrier { unsigned* bar; unsigned x; volatile LAS unsigned* st; };
__device__ __forceinline__ XcdBarrier xcd_barrier_post(unsigned* bar, volatile LAS unsigned* st) {
    XcdBarrier b; b.bar = bar; b.x = xb_xcc_id(); b.st = st;
    if (threadIdx.x == 0) (void)xb_add(&bar[XB_XCNT(b.x)], 1u);
    return b;
}
__device__ __forceinline__ void xcd_barrier_complete(unsigned* bar, unsigned x, unsigned& nloc, unsigned& nx) {
    const unsigned G = gridDim.x * gridDim.y * gridDim.z;
    unsigned sum, cnt, mine, sp = 0u;
    for (;;) {
        sum = 0u; cnt = 0u; mine = 0u;
#pragma unroll
        for (unsigned j = 0; j < 16; ++j) { const unsigned c = xb_ld(&bar[XB_XCNT(j)]); sum += c; cnt += (c > 0u) ? 1u : 0u; mine = (j == x) ? c : mine; }
        if (sum == G) break;
        __builtin_amdgcn_s_sleep(1);
        if ((++sp & 255u) == 0u) { if (xb_ld(&bar[XB_TMO])) break; if (sp > XB_SPIN_CAP) { atomicAdd(&bar[XB_TMO], 1u); break; } }
    }
    nloc = mine > 0u ? mine : 1u; nx = cnt > 0u ? cnt : 1u;
}
__device__ __forceinline__ void xcd_barrier(const XcdBarrier& b) {
    asm volatile("s_waitcnt vmcnt(0)" ::: "memory");
    __syncthreads();
    if (threadIdx.x == 0) {
        unsigned* bar = b.bar;
        __builtin_amdgcn_s_waitcnt(0);
        unsigned nloc = b.st[0], nx = b.st[1];
        if (nloc == 0u) { xcd_barrier_complete(bar, b.x, nloc, nx); b.st[0] = nloc; b.st[1] = nx; }
        const unsigned old = xb_add(&bar[XB_XSUB(b.x)], 1u);
        const unsigned gen = old / nloc;
        if (old + 1u == (gen + 1u) * nloc) {
            __builtin_amdgcn_fence(__ATOMIC_RELEASE, "agent");
            asm volatile("s_waitcnt vmcnt(0)" ::: "memory");
            const unsigned og = xb_add(&bar[XB_TOP], 1u);
            const unsigned tg = og / nx;
            if (og + 1u == (tg + 1u) * nx) xb_add(&bar[XB_TOPGEN], 1u);
            else XB_SPIN(xb_ld(&bar[XB_TOPGEN]) == tg, bar);
            __builtin_amdgcn_fence(__ATOMIC_ACQUIRE, "agent");
            xb_add(&bar[XB_XGEN(b.x)], 1u);
            asm volatile("s_waitcnt vmcnt(0)" ::: "memory");
        } else {
            XB_SPIN(xb_ld(&bar[XB_XGEN(b.x)]) == gen, bar);
            __builtin_amdgcn_fence(__ATOMIC_ACQUIRE, "agent");
            asm volatile("s_waitcnt vmcnt(0)" ::: "memory");
        }
    }
    __syncthreads();
}

__device__ __forceinline__ int lds_byte(int r, int c) {
  int st = (r >> 4) * 2 + (c >> 5), rr = r & 15, cc = c & 31, ob = rr * 64 + cc * 2;
  return st * 1024 + (ob ^ (((ob >> 9) & 1) << 5));
}
#define GLDS(gp, lp) __builtin_amdgcn_global_load_lds((const unsigned*)(gp), (LAS unsigned*)(lp), 16, 0, 0)
#define WAIT_V(n) asm volatile("s_waitcnt vmcnt(" #n ")" ::: "memory")
#define WAIT_L(n) asm volatile("s_waitcnt lgkmcnt(" #n ")" ::: "memory")
#define BAR __builtin_amdgcn_s_barrier()
#define SCHED __builtin_amdgcn_sched_barrier(0)

template <bool GATHER, class Epi>
__device__ __forceinline__ void gemm_tile(const bf16_t* __restrict__ A, const int lda, const int* __restrict__ tok, const int brow,
                                          const bf16_t* __restrict__ Bt, const int ldb, const int bcol, const int K,
                                          LAS char* shm, const Epi& epi) {
#define G_SA(b, h) (shm + ((b) * 2 + (h)) * 16384)
#define G_SB(b, h) (shm + (4 + (b) * 2 + (h)) * 16384)
  int tid = threadIdx.x; asm volatile("" : "+v"(tid)); tid &= 511;
  int wid = tid >> 6, lane = tid & 63, wr = wid >> 2, wc = wid & 3, fr = lane & 15, fq = lane >> 4;
  int ao0, ao1, ao2, ao3, bo;
  {
    const int sb = (tid & 63) * 16, swz = sb ^ (((sb >> 9) & 1) << 5);
    const int R0 = ((tid >> 6) >> 1) * 16 + (swz >> 6), C0 = ((tid >> 6) & 1) * 32 + ((swz & 63) >> 1);
    if (GATHER) { ao0 = tok[R0] * lda + C0; ao1 = tok[R0 + 64] * lda + C0; ao2 = tok[R0 + 128] * lda + C0; ao3 = tok[R0 + 192] * lda + C0; }
    else { ao0 = (brow + R0) * lda + C0; ao1 = ao0 + 64 * lda; ao2 = ao0 + 128 * lda; ao3 = ao0 + 192 * lda; }
    bo = (bcol + R0) * ldb + C0;
  }
  const int lo = tid * 16;
#define STAGE_A0(P, kt) do { GLDS(A + ao0 + (kt) * 64, (P) + lo); GLDS(A + ao1 + (kt) * 64, (P) + lo + 8192); } while (0)
#define STAGE_A1(P, kt) do { GLDS(A + ao2 + (kt) * 64, (P) + lo); GLDS(A + ao3 + (kt) * 64, (P) + lo + 8192); } while (0)
#define STAGE_B0(P, kt) do { GLDS(Bt + bo + (kt) * 64, (P) + lo); GLDS(Bt + bo + 64 * ldb + (kt) * 64, (P) + lo + 8192); } while (0)
#define STAGE_B1(P, kt) do { GLDS(Bt + bo + 128 * ldb + (kt) * 64, (P) + lo); GLDS(Bt + bo + 192 * ldb + (kt) * 64, (P) + lo + 8192); } while (0)
#define LDA(dst, b, h) _Pragma("unroll") for (int m = 0; m < 4; ++m) _Pragma("unroll") for (int k = 0; k < 2; ++k) \
    dst[m][k] = *(LAS const bf16x8*)(G_SA(b, h) + lds_byte(wr * 64 + m * 16 + fr, k * 32 + fq * 8))
#define LDB(dst, b, h) _Pragma("unroll") for (int n = 0; n < 2; ++n) _Pragma("unroll") for (int k = 0; k < 2; ++k) \
    dst[n][k] = *(LAS const bf16x8*)(G_SB(b, h) + lds_byte(wc * 32 + n * 16 + fr, k * 32 + fq * 8))
#define MMA(ai, bj, At_, Bt_) do { __builtin_amdgcn_s_setprio(1); \
    _Pragma("unroll") for (int m = 0; m < 4; ++m) _Pragma("unroll") for (int n = 0; n < 2; ++n) _Pragma("unroll") for (int k = 0; k < 2; ++k) \
      acc[ai][bj][m][n] = __builtin_amdgcn_mfma_f32_16x16x32_bf16(Bt_[n][k], At_[m][k], acc[ai][bj][m][n], 0, 0, 0); \
    __builtin_amdgcn_s_setprio(0); } while (0)

  f32x4 acc[2][2][4][2] = {};
  bf16x8 At[4][2], B0[2][2], B1[2][2];
  const int nt = K / 64;
  STAGE_B0(G_SB(0, 0), 0); STAGE_A0(G_SA(0, 0), 0);
  STAGE_B1(G_SB(0, 1), 0); STAGE_A1(G_SA(0, 1), 0);
  if (wr == 1) BAR;
  WAIT_V(4); BAR;
  STAGE_B0(G_SB(1, 0), 1); STAGE_A0(G_SA(1, 0), 1); STAGE_B1(G_SB(1, 1), 1);
  WAIT_V(6); BAR;
  for (int t = 0; t < nt - 2; t += 2) {
    LDB(B0, 0, 0); SCHED; LDA(At, 0, 0); STAGE_A1(G_SA(1, 1), t + 1);
    WAIT_L(8); BAR; WAIT_L(0); MMA(0, 0, At, B0); BAR; SCHED;
    LDB(B1, 0, 1); STAGE_B0(G_SB(0, 0), t + 2);
    BAR; WAIT_L(0); MMA(0, 1, At, B1); BAR;
    LDA(At, 0, 1); STAGE_A0(G_SA(0, 0), t + 2);
    BAR; WAIT_L(0); MMA(1, 0, At, B0); BAR; SCHED;
    STAGE_B1(G_SB(0, 1), t + 2);
    WAIT_V(6); BAR; MMA(1, 1, At, B1); BAR;
    LDB(B0, 1, 0); SCHED; LDA(At, 1, 0); STAGE_A1(G_SA(0, 1), t + 2);
    WAIT_L(8); BAR; WAIT_L(0); MMA(0, 0, At, B0); BAR; SCHED;
    LDB(B1, 1, 1); STAGE_B0(G_SB(1, 0), t + 3);
    BAR; WAIT_L(0); MMA(0, 1, At, B1); BAR;
    LDA(At, 1, 1); STAGE_A0(G_SA(1, 0), t + 3);
    BAR; WAIT_L(0); MMA(1, 0, At, B0); BAR; SCHED;
    STAGE_B1(G_SB(1, 1), t + 3);
    WAIT_V(6); BAR; MMA(1, 1, At, B1); BAR;
  }
  { LDB(B0, 0, 0); WAIT_V(0); LDA(At, 0, 0); STAGE_A1(G_SA(1, 1), nt - 1);
    BAR; WAIT_L(0); MMA(0, 0, At, B0); BAR;
    LDB(B1, 0, 1); BAR; WAIT_L(0); MMA(0, 1, At, B1); BAR;
    LDA(At, 0, 1); WAIT_V(4); BAR; WAIT_L(0); MMA(1, 0, At, B0); MMA(1, 1, At, B1); BAR; }
  { LDB(B0, 1, 0); LDA(At, 1, 0); WAIT_V(2); BAR; WAIT_L(0); MMA(0, 0, At, B0); BAR;
    LDB(B1, 1, 1); WAIT_V(0); BAR; WAIT_L(0); MMA(0, 1, At, B1); BAR;
    LDA(At, 1, 1); BAR; WAIT_L(0); MMA(1, 0, At, B0); MMA(1, 1, At, B1); BAR; }
  if (wr == 0) BAR;
  int tz = threadIdx.x; asm volatile("" : "+v"(tz)); wid = tz >> 6; lane = tz & 63; wr = wid >> 2; wc = wid & 3; fr = lane & 15; fq = lane >> 4;
  epi(acc, brow, bcol, wr, wc, fr, fq);
#undef G_SA
#undef G_SB
#undef STAGE_A0
#undef STAGE_A1
#undef STAGE_B0
#undef STAGE_B1
#undef LDA
#undef LDB
#undef MMA
}

struct EpiPlain {
  bf16_t* C; int ldc;
  __device__ __forceinline__ void operator()(const f32x4 (&acc)[2][2][4][2], int brow, int bcol, int wr, int wc, int fr, int fq) const {
#pragma unroll
    for (int ai = 0; ai < 2; ++ai)
#pragma unroll
      for (int m = 0; m < 4; ++m) {
        bf16_t* rp = C + (size_t)(brow + ai * 128 + wr * 64 + m * 16 + fr) * ldc + bcol + wc * 32 + fq * 8;
#pragma unroll
        for (int bj = 0; bj < 2; ++bj) {
          u32x4 v = {cvtpk(acc[ai][bj][m][0][0], acc[ai][bj][m][0][1]), cvtpk(acc[ai][bj][m][0][2], acc[ai][bj][m][0][3]),
                     cvtpk(acc[ai][bj][m][1][0], acc[ai][bj][m][1][1]), cvtpk(acc[ai][bj][m][1][2], acc[ai][bj][m][1][3])};
          *(u32x4*)(rp + bj * 128) = v;
        }
      }
  }
};
template <int MODE>
struct EpiPair {
  bf16_t* C; int ldc; int colbase;
  __device__ __forceinline__ void operator()(const f32x4 (&acc)[2][2][4][2], int brow, int bcol, int wr, int wc, int fr, int fq) const {
#pragma unroll
    for (int ai = 0; ai < 2; ++ai)
#pragma unroll
      for (int m = 0; m < 4; ++m) {
        bf16_t* rp = C + (size_t)(brow + ai * 128 + wr * 64 + m * 16 + fr) * ldc + ((bcol - colbase) >> 1) + wc * 16 + fq * 4;
#pragma unroll
        for (int bj = 0; bj < 2; ++bj) {
          float r[4];
#pragma unroll
          for (int j = 0; j < 4; ++j) {
            const float x0 = acc[ai][bj][m][0][j], x1 = acc[ai][bj][m][1][j];
            r[j] = MODE == 0 ? x0 * sigmoidf_(x1) : x0 * sigmoidf_(x0) * x1;
          }
          u32x2 v = {cvtpk(r[0], r[1]), cvtpk(r[2], r[3])};
          *(u32x2*)(rp + bj * 64) = v;
        }
      }
  }
};
struct EpiG1 {
  EpiPlain p; EpiPair<0> g; int nplain;
  __device__ __forceinline__ void operator()(const f32x4 (&acc)[2][2][4][2], int brow, int bcol, int wr, int wc, int fr, int fq) const {
    if (bcol < nplain) p(acc, brow, bcol, wr, wc, fr, fq); else g(acc, brow, bcol, wr, wc, fr, fq);
  }
};

typedef int v8i __attribute__((ext_vector_type(8)));
typedef int v4i __attribute__((ext_vector_type(4)));
__device__ __forceinline__ int lds8(int r, int c) { return r * 128 + ((c ^ ((r >> 1) & 7)) << 4); }
template <bool GATHER, int lda, int ldb, int K, class Epi, class S>
__device__ __forceinline__ void gemm8_run(const unsigned char* __restrict__ A, const int* __restrict__ stok,
                                          LAS char* shm, const Epi& epi, const S& sched) {
#define G_SA(b, h) (shm + ((b) * 2 + (h)) * 16384)
#define G_SB(b, h) (shm + (4 + (b) * 2 + (h)) * 16384)
  int tid = threadIdx.x; asm volatile("" : "+v"(tid)); tid &= 511;
  int wid = tid >> 6, lane = tid & 63, wr = wid >> 2, wc = wid & 3, fr = lane & 15, fq = lane >> 4;
  unsigned ao0, ao1, ao2, ao3, bo;
  int R0 = 8 * wid + (lane >> 3), C0 = ((lane & 7) ^ ((R0 >> 1) & 7)) << 4;
  const int lo = __builtin_amdgcn_readfirstlane(tid >> 6) * 1024;
  int brow, bcol; const unsigned char* Bt;
  int ui = 0;
  if (!sched.unit(ui, brow, Bt, bcol)) return;
#define SETOFF(br, bc) do { if (GATHER) { const int* _t = stok + (br); ao0 = (unsigned)(_t[R0] * lda + C0); ao1 = (unsigned)(_t[R0 + 64] * lda + C0); ao2 = (unsigned)(_t[R0 + 128] * lda + C0); ao3 = (unsigned)(_t[R0 + 192] * lda + C0); } \
    else { ao0 = (unsigned)(((br) + R0) * lda + C0); ao1 = ao0 + 64u * lda; ao2 = ao0 + 128u * lda; ao3 = ao0 + 192u * lda; } \
    bo = (unsigned)(((bc) + R0) * ldb + C0); } while (0)
#define STAGE_A0(P, kt) do { GLDS((A + (kt) * 128) + ao0, (P) + lo); GLDS((A + (kt) * 128) + ao1, (P) + lo + 8192); } while (0)
#define STAGE_A1(P, kt) do { GLDS((A + (kt) * 128) + ao2, (P) + lo); GLDS((A + (kt) * 128) + ao3, (P) + lo + 8192); } while (0)
#define STAGE_B0(P, kt) do { GLDS((Bt + (kt) * 128) + bo, (P) + lo); GLDS((Bt + 64 * ldb + (kt) * 128) + bo, (P) + lo + 8192); } while (0)
#define STAGE_B1(P, kt) do { GLDS((Bt + 128 * ldb + (kt) * 128) + bo, (P) + lo); GLDS((Bt + 192 * ldb + (kt) * 128) + bo, (P) + lo + 8192); } while (0)
#define PRO() do { STAGE_B0(G_SB(0, 0), 0); STAGE_A0(G_SA(0, 0), 0); STAGE_B1(G_SB(0, 1), 0); STAGE_A1(G_SA(0, 1), 0); } while (0)
  const int fx = (fq ^ ((fr >> 1) & 7)) << 4;
  const int fa0 = (wr * 64 + fr) * 128 + fx, fb0 = (wc * 32 + fr) * 128 + fx;
#define FRAG8(dst, p0, p1) do { const v4i _x = *(LAS const v4i*)(p0); const v4i _y = *(LAS const v4i*)(p1); \
    dst = (v8i){_x[0], _x[1], _x[2], _x[3], _y[0], _y[1], _y[2], _y[3]}; } while (0)
#define LDA(dst, b, h) do { int fa1 = fa0; asm volatile("v_xor_b32 %0, 64, %0" : "+v"(fa1)); \
    _Pragma("unroll") for (int m = 0; m < 4; ++m) FRAG8(dst[m], G_SA(b, h) + fa0 + m * 2048, G_SA(b, h) + fa1 + m * 2048); } while (0)
#define LDB(dst, b, h) do { int fb1 = fb0; asm volatile("v_xor_b32 %0, 64, %0" : "+v"(fb1)); \
    _Pragma("unroll") for (int n = 0; n < 2; ++n) FRAG8(dst[n], G_SB(b, h) + fb0 + n * 2048, G_SB(b, h) + fb1 + n * 2048); } while (0)
#define MMA(ai, bj, At_, Bt_) do { __builtin_amdgcn_s_setprio(1); \
    _Pragma("unroll") for (int m = 0; m < 4; ++m) _Pragma("unroll") for (int n = 0; n < 2; ++n) \
      asm volatile("v_mfma_scale_f32_16x16x128_f8f6f4 %0, %1, %2, %0, %3, %3 op_sel_hi:[0,0,0]" : "+v"(acc[ai][bj][m][n]) : "v"(Bt_[n]), "v"(At_[m]), "v"(sc1)); \
    __builtin_amdgcn_s_setprio(0); } while (0)
  int sc1; asm volatile("v_mov_b32 %0, 0x7f7f7f7f" : "=v"(sc1));
  const int nt = K / 128;
  SETOFF(brow, bcol); PRO();
  bool first = true;
  for (;;) {
    f32x4 acc[2][2][4][2] = {};
    v8i At[4], B0[2], B1[2];
    if (wr == 1) BAR;
    if (first) WAIT_V(4); else WAIT_V(16);
    BAR;
    STAGE_B0(G_SB(1, 0), 1); STAGE_A0(G_SA(1, 0), 1); STAGE_B1(G_SB(1, 1), 1);
    WAIT_V(6); BAR;
    for (int t = 0; t < nt - 2; t += 2) {
      LDB(B0, 0, 0); SCHED; LDA(At, 0, 0); STAGE_A1(G_SA(1, 1), t + 1);
      WAIT_L(8); BAR; WAIT_L(0); MMA(0, 0, At, B0); BAR; SCHED;
      LDB(B1, 0, 1); STAGE_B0(G_SB(0, 0), t + 2);
      BAR; WAIT_L(0); MMA(0, 1, At, B1); BAR;
      LDA(At, 0, 1); STAGE_A0(G_SA(0, 0), t + 2);
      BAR; WAIT_L(0); MMA(1, 0, At, B0); BAR; SCHED;
      STAGE_B1(G_SB(0, 1), t + 2);
      WAIT_V(6); BAR; MMA(1, 1, At, B1); BAR;
      LDB(B0, 1, 0); SCHED; LDA(At, 1, 0); STAGE_A1(G_SA(0, 1), t + 2);
      WAIT_L(8); BAR; WAIT_L(0); MMA(0, 0, At, B0); BAR; SCHED;
      LDB(B1, 1, 1); STAGE_B0(G_SB(1, 0), t + 3);
      BAR; WAIT_L(0); MMA(0, 1, At, B1); BAR;
      LDA(At, 1, 1); STAGE_A0(G_SA(1, 0), t + 3);
      BAR; WAIT_L(0); MMA(1, 0, At, B0); BAR; SCHED;
      STAGE_B1(G_SB(1, 1), t + 3);
      WAIT_V(6); BAR; MMA(1, 1, At, B1); BAR;
    }
    { LDB(B0, 0, 0); WAIT_V(0); LDA(At, 0, 0); STAGE_A1(G_SA(1, 1), nt - 1);
      BAR; WAIT_L(0); MMA(0, 0, At, B0); BAR;
      LDB(B1, 0, 1); BAR; WAIT_L(0); MMA(0, 1, At, B1); BAR;
      LDA(At, 0, 1); WAIT_V(4); BAR; WAIT_L(0); MMA(1, 0, At, B0); MMA(1, 1, At, B1); BAR; }
    { LDB(B0, 1, 0); LDA(At, 1, 0); WAIT_V(2); BAR; WAIT_L(0); MMA(0, 0, At, B0); BAR;
      LDB(B1, 1, 1); WAIT_V(0); BAR; WAIT_L(0); MMA(0, 1, At, B1); BAR;
      LDA(At, 1, 1); BAR; WAIT_L(0); MMA(1, 0, At, B0); MMA(1, 1, At, B1); BAR; }
    if (wr == 0) BAR;
    const int cbrow = brow, cbcol = bcol;
    { int tz = threadIdx.x; asm volatile("" : "+v"(tz)); tz &= 511; wid = tz >> 6; lane = tz & 63; wr = wid >> 2; wc = wid & 3; fr = lane & 15; fq = lane >> 4;
      R0 = 8 * wid + (lane >> 3); C0 = ((lane & 7) ^ ((R0 >> 1) & 7)) << 4; }
    ++ui;
    const bool more = sched.unit(ui, brow, Bt, bcol);
    if (more) { SETOFF(brow, bcol); asm volatile("" ::: "memory"); PRO(); asm volatile("" ::: "memory"); }
    asm volatile("s_nop 15\n\ts_nop 15\n\ts_nop 7" ::: "memory");
    epi(acc, cbrow, cbcol, wr, wc, fr, fq);
    if (!more) break;
    first = false;
  }
#undef G_SA
#undef G_SB
#undef SETOFF
#undef STAGE_A0
#undef STAGE_A1
#undef STAGE_B0
#undef STAGE_B1
#undef PRO
#undef FRAG8
#undef LDA
#undef LDB
#undef MMA
}
__device__ __forceinline__ float clamp8(float x) { return fminf(fmaxf(x, -448.f), 448.f); }
__device__ __forceinline__ unsigned pack_fp8x4(float a, float b, float c, float d) {
  int p = __builtin_amdgcn_cvt_pk_fp8_f32(clamp8(a), clamp8(b), 0, false); p = __builtin_amdgcn_cvt_pk_fp8_f32(clamp8(c), clamp8(d), p, true); return (unsigned)p; }
struct EpiSwiGLU8 {
  unsigned char* C; int ldc;
  __device__ __forceinline__ void operator()(const f32x4 (&acc)[2][2][4][2], int brow, int bcol, int wr, int wc, int fr, int fq) const {
    constexpr float S = 1.f / 256.f;
#pragma unroll
    for (int ai = 0; ai < 2; ++ai)
#pragma unroll
      for (int m = 0; m < 4; ++m) {
        unsigned char* rp = C + (size_t)(brow + ai * 128 + wr * 64 + m * 16 + fr) * ldc + (bcol >> 1) + wc * 16 + fq * 4;
#pragma unroll
        for (int bj = 0; bj < 2; ++bj) {
          float r[4];
#pragma unroll
          for (int j = 0; j < 4; ++j) { const float g = acc[ai][bj][m][0][j] * S, u = acc[ai][bj][m][1][j] * S; r[j] = g * sigmoidf_(g) * u; }
          *(unsigned*)(rp + bj * 64) = pack_fp8x4(r[0], r[1], r[2], r[3]);
        }
      }
  }
};
struct EpiPlainS {
  bf16_t* C; int ldc; float sc;
  __device__ __forceinline__ void operator()(const f32x4 (&acc)[2][2][4][2], int brow, int bcol, int wr, int wc, int fr, int fq) const {
#pragma unroll
    for (int ai = 0; ai < 2; ++ai)
#pragma unroll
      for (int m = 0; m < 4; ++m) {
        bf16_t* rp = C + (size_t)(brow + ai * 128 + wr * 64 + m * 16 + fr) * ldc + bcol + wc * 32 + fq * 8;
#pragma unroll
        for (int bj = 0; bj < 2; ++bj) {
          u32x4 v = {cvtpk(acc[ai][bj][m][0][0] * sc, acc[ai][bj][m][0][1] * sc), cvtpk(acc[ai][bj][m][0][2] * sc, acc[ai][bj][m][0][3] * sc),
                     cvtpk(acc[ai][bj][m][1][0] * sc, acc[ai][bj][m][1][1] * sc), cvtpk(acc[ai][bj][m][1][2] * sc, acc[ai][bj][m][1][3] * sc)};
          *(u32x4*)(rp + bj * 128) = v;
        }
      }
  }
};

__device__ __forceinline__ void dense_unit(int u, int nM, int nN, int& pm, int& pn) {
  const int nwg = nM * nN, NX = 8, WGM = 8;
  int wgid = u;
  { const int q = nwg / NX, r = nwg % NX, xcd = wgid % NX, off = wgid / NX; wgid = (xcd < r ? xcd * (q + 1) : r * (q + 1) + (xcd - r) * q) + off; }
  const int nig = WGM * nN, gid = wgid / nig, fm = gid * WGM, gsz = min(nM - fm, WGM);
  pm = fm + ((wgid % nig) % gsz); pn = (wgid % nig) / gsz;
}

namespace at {
constexpr int DH = 128, NW = 8, QBLK = 32, KVBLK = 64;
constexpr float SCALE = 0.088388347648318440f;
constexpr float QC = SCALE * 1.4426950408889634f;
constexpr int SHM_V = KVBLK * DH * 2, SHM_K = KVBLK * DH * 2;
#define KSWZ(row, colB) ((row) * 256 + ((colB) ^ (((row) & 7) << 4)))
__device__ __forceinline__ int crow(int r, int hi) { return (r & 3) + 8 * (r >> 2) + 4 * hi; }
__device__ __forceinline__ unsigned cvtpkv(float lo, float hi) { unsigned r; asm volatile("v_cvt_pk_bf16_f32 %0, %1, %2" : "=v"(r) : "v"(lo), "v"(hi)); return r; }
#define PK4(P, BASE, OUT) do { unsigned a0 = cvtpkv(P[BASE + 0], P[BASE + 1]), a1 = cvtpkv(P[BASE + 2], P[BASE + 3]);   \
    unsigned b0 = cvtpkv(P[BASE + 4], P[BASE + 5]), b1 = cvtpkv(P[BASE + 6], P[BASE + 7]);                              \
    auto r0 = __builtin_amdgcn_permlane32_swap(a0, b0, false, false); auto r1 = __builtin_amdgcn_permlane32_swap(a1, b1, false, false); \
    u32x4 w = {r0[0], r1[0], r0[1], r1[1]}; OUT = *reinterpret_cast<bf16x8*>(&w); } while (0)
__device__ __forceinline__ float load_q(const bf16_t* __restrict__ Qw, bf16x8 (&qr)[8], float kmax2) {
  float ss = 0;
#pragma unroll
  for (int d0 = 0; d0 < 8; ++d0) {
    const u32x4 raw = *reinterpret_cast<const u32x4*>(Qw + d0 * 16); u32x4 o;
#pragma unroll
    for (int i = 0; i < 4; ++i) { const unsigned pk = cvtpk(bflo(raw[i]) * QC, bfhi(raw[i]) * QC); o[i] = pk; const float a = bflo(pk), b = bfhi(pk); ss += a * a + b * b; }
    qr[d0] = *reinterpret_cast<bf16x8*>(&o);
  }
  { auto rr = __builtin_amdgcn_permlane32_swap(__float_as_uint(ss), __float_as_uint(ss), false, false); ss = __uint_as_float(rr[0]) + __uint_as_float(rr[1]); }
  return -(sqrtf(ss * kmax2) * 1.01f + 1e-3f);
}
__device__ __forceinline__ void exp16(f32x16& p) {
#pragma unroll
  for (int r = 0; r < 16; ++r) p[r] = __builtin_amdgcn_exp2f(p[r]);
}
__device__ __forceinline__ float sum16(const f32x16& p) { float s = 0;
#pragma unroll
  for (int r = 0; r < 16; ++r) s += p[r];
  return s; }
__device__ __forceinline__ void qkt(f32x16& p0, f32x16& p1, LAS const char* Ks, const bf16x8* qr, int r32, int hi, float nmc) {
#pragma unroll
  for (int r = 0; r < 16; ++r) { p0[r] = nmc; p1[r] = nmc; }
#pragma unroll
  for (int d0 = 0; d0 < 8; ++d0) { int cb = (d0 * 16 + hi * 8) * 2;
    bf16x8 b0 = *(LAS const bf16x8*)(Ks + KSWZ(r32, cb));
    bf16x8 b1 = *(LAS const bf16x8*)(Ks + KSWZ(32 + r32, cb));
    p0 = __builtin_amdgcn_mfma_f32_32x32x16_bf16(b0, qr[d0], p0, 0, 0, 0);
    p1 = __builtin_amdgcn_mfma_f32_32x32x16_bf16(b1, qr[d0], p1, 0, 0, 0); }
}
__device__ __forceinline__ int v_st(int k, int c) { const int kk = (k & ~0xC) | ((k & 4) << 1) | ((k & 8) >> 1); return ((kk >> 3) * 4 + (c >> 5)) * 512 + ((kk & 7) * 32 + (c & 31)) * 2; }
__device__ __forceinline__ int v_st256(int k, int c) { const int kk = (k & ~0xC) | ((k & 4) << 1) | ((k & 8) >> 1); return ((kk >> 3) * 8 + (c >> 5)) * 512 + ((kk & 7) * 32 + (c & 31)) * 2; }
__device__ __forceinline__ int v_rd_base(int lane) { return ((lane & 3) << 3) | (((lane >> 2) & 3) << 6) | (((lane >> 4) & 1) << 5) | (((lane >> 5) & 1) << 8); }
template <int OFF> __device__ __forceinline__ s16x4 tr_read(int vb) {
  s16x4 r; asm volatile("ds_read_b64_tr_b16 %0, %1 offset:%2" : "=&v"(r) : "v"(vb), "i"(OFF) : "memory"); return r;
}
template <int BASE, int KS, int HS> __device__ __forceinline__ void pv_one(f32x16& od, int vb, bf16x8 pa0, bf16x8 pa1, bf16x8 pa2, bf16x8 pa3) {
  const s16x4 l0 = tr_read<BASE>(vb), h0 = tr_read<BASE + HS>(vb), l1 = tr_read<BASE + KS>(vb), h1 = tr_read<BASE + KS + HS>(vb);
  const s16x4 l2 = tr_read<BASE + 2 * KS>(vb), h2 = tr_read<BASE + 2 * KS + HS>(vb), l3 = tr_read<BASE + 3 * KS>(vb), h3 = tr_read<BASE + 3 * KS + HS>(vb);
  asm volatile("s_waitcnt lgkmcnt(0)" ::: "memory"); SCHED;
#define PK(L, H) (bf16x8){L[0], L[1], L[2], L[3], H[0], H[1], H[2], H[3]}
  od = __builtin_amdgcn_mfma_f32_32x32x16_bf16(pa0, PK(l0, h0), od, 0, 0, 0);
  od = __builtin_amdgcn_mfma_f32_32x32x16_bf16(pa1, PK(l1, h1), od, 0, 0, 0);
  od = __builtin_amdgcn_mfma_f32_32x32x16_bf16(pa2, PK(l2, h2), od, 0, 0, 0);
  od = __builtin_amdgcn_mfma_f32_32x32x16_bf16(pa3, PK(l3, h3), od, 0, 0, 0);
#undef PK
}
__device__ __forceinline__ void pv_d0(f32x16* o, int vb, bf16x8 pa0, bf16x8 pa1, bf16x8 pa2, bf16x8 pa3) {
  pv_one<0, 4096, 2048>(o[0], vb, pa0, pa1, pa2, pa3); pv_one<512, 4096, 2048>(o[1], vb, pa0, pa1, pa2, pa3);
  pv_one<1024, 4096, 2048>(o[2], vb, pa0, pa1, pa2, pa3); pv_one<1536, 4096, 2048>(o[3], vb, pa0, pa1, pa2, pa3);
}
__device__ __forceinline__ void pv_d0_256(f32x16* o, int vb, bf16x8 pa0, bf16x8 pa1, bf16x8 pa2, bf16x8 pa3) {
  pv_one<0, 8192, 4096>(o[0], vb, pa0, pa1, pa2, pa3); pv_one<512, 8192, 4096>(o[1], vb, pa0, pa1, pa2, pa3);
  pv_one<1024, 8192, 4096>(o[2], vb, pa0, pa1, pa2, pa3); pv_one<1536, 8192, 4096>(o[3], vb, pa0, pa1, pa2, pa3);
}
__device__ __forceinline__ void store_o(const f32x16* o, float l_tot, LAS float* li, bf16_t* __restrict__ Ow, int ldo, int r32, int hi) {
  if (hi == 0) li[r32] = l_tot; asm volatile("s_waitcnt lgkmcnt(0)" ::: "memory");
  float rli[16];
#pragma unroll
  for (int r = 0; r < 16; ++r) rli[r] = __builtin_amdgcn_rcpf(li[crow(r, hi)]);
#pragma unroll
  for (int r = 0; r < 16; ++r) { const int orow = crow(r, hi);
#pragma unroll
    for (int d0 = 0; d0 < 4; ++d0) Ow[(long)orow * ldo + d0 * 32 + r32] = f2bf(o[d0][r] * rli[r]); }
}

__device__ __forceinline__ int unswap23(int kk) { return (kk & ~0xC) | ((kk & 4) << 1) | ((kk & 8) >> 1); }
__device__ __forceinline__ int k_dma_voff(int wid, int lane, int ldk) {
  const int row = 4 * wid + (lane >> 4); return row * ldk * 2 + (((lane & 15) * 16) ^ ((row & 7) << 4)); }
#define DMA16(rs, ldsp, voff, soff) __builtin_amdgcn_raw_ptr_buffer_load_lds(rs, (LAS void*)(ldsp), 16, voff, soff, 0, 0)

constexpr int SHM_T = SHM_K + SHM_V;
__device__ __forceinline__ void attn_body(const bf16_t* __restrict__ Qb, const int ldq, const bf16_t* __restrict__ Kh, const bf16_t* __restrict__ Vh, const int ldk,
                                          bf16_t* __restrict__ Ob, const int ldo, const int seq, const float kmax2, LAS char* lds) {
  int tid = threadIdx.x; asm volatile("" : "+v"(tid)); tid &= 511;
  const int wid = tid >> 6, lane = tid & 63, r32 = lane & 31, hi = lane >> 5;
  LAS float* li_l = (LAS float*)(lds + 3 * SHM_T) + wid * 64;
  float l_reg = 0; f32x16 o[4] = {}; bf16x8 qr[8];
  const float nmc = load_q(Qb + (long)(wid * QBLK + r32) * ldq + hi * 8, qr, kmax2);
  const int vrb = v_rd_base(lane);
  const int kvo = k_dma_voff(wid, lane, ldk);
  const int vvo = unswap23(8 * (wid >> 1) + ((lane & 31) >> 2)) * ldk * 2 + ((2 * (wid & 1) + (lane >> 5)) * 32 + (lane & 3) * 8) * 2;
  const int l32 = 64 * ldk, pz = wid * 1024;
  const __amdgpu_buffer_rsrc_t krs = __builtin_amdgcn_make_buffer_rsrc((void*)Kh, 0, 0x7ffffff0, 0x00020000);
  const __amdgpu_buffer_rsrc_t vrs = __builtin_amdgcn_make_buffer_rsrc((void*)Vh, 0, 0x7ffffff0, 0x00020000);
#define TDMA(slot, k0) do { const int _o = (k0) * ldk * 2; LAS char* _b = lds + (slot) * SHM_T + pz; \
    DMA16(krs, _b, kvo, _o); DMA16(krs, _b + 8192, kvo, _o + l32); DMA16(vrs, _b + SHM_K, vvo, _o); DMA16(vrs, _b + SHM_K + 8192, vvo, _o + l32); } while (0)
#define VM0() asm volatile("s_waitcnt vmcnt(0)" ::: "memory")
#define FINISH(P0, P1) do { exp16(P1); l_reg += sum16(P0) + sum16(P1); PK4(P0, 0, pa0); PK4(P0, 8, pa1); PK4(P1, 0, pa2); PK4(P1, 8, pa3); } while (0)
  f32x16 pA0, pA1, pB0, pB1; bf16x8 pa0, pa1, pa2, pa3; const int NT = seq / KVBLK;
  TDMA(0, 0); VM0(); __syncthreads();
  TDMA(1, KVBLK);
  qkt(pA0, pA1, lds, qr, r32, hi, nmc); exp16(pA0);
  VM0(); __syncthreads();
  int sk = 1, sv = 0, sd = 2;
  for (int j = 1; j + 1 < NT; j += 2) {
    TDMA(sd, (j + 1) * KVBLK);
    SCHED; qkt(pB0, pB1, lds + sk * SHM_T, qr, r32, hi, nmc);
    FINISH(pA0, pA1); SCHED;
    pv_d0(o, (int)(uintptr_t)(lds + sv * SHM_T + SHM_K) + vrb, pa0, pa1, pa2, pa3); exp16(pB0);
    VM0(); __syncthreads();
    { const int t = sv; sv = sk; sk = sd; sd = t; }
    if (j + 2 < NT) TDMA(sd, (j + 2) * KVBLK);
    SCHED; qkt(pA0, pA1, lds + sk * SHM_T, qr, r32, hi, nmc);
    FINISH(pB0, pB1); SCHED;
    pv_d0(o, (int)(uintptr_t)(lds + sv * SHM_T + SHM_K) + vrb, pa0, pa1, pa2, pa3); exp16(pA0);
    VM0(); __syncthreads();
    { const int t = sv; sv = sk; sk = sd; sd = t; }
  }
  SCHED; qkt(pB0, pB1, lds + sk * SHM_T, qr, r32, hi, nmc);
  FINISH(pA0, pA1); SCHED;
  pv_d0(o, (int)(uintptr_t)(lds + sv * SHM_T + SHM_K) + vrb, pa0, pa1, pa2, pa3); exp16(pB0);
  FINISH(pB0, pB1); SCHED;
  pv_d0(o, (int)(uintptr_t)(lds + sk * SHM_T + SHM_K) + vrb, pa0, pa1, pa2, pa3);
  { auto rr = __builtin_amdgcn_permlane32_swap(__float_as_uint(l_reg), __float_as_uint(l_reg), false, false); l_reg = __uint_as_float(rr[0]) + __uint_as_float(rr[1]); }
  store_o(o, l_reg, li_l, Ob + (long)(wid * QBLK) * ldo, ldo, r32, hi);
  VM0();
  __syncthreads();
#undef TDMA
#undef FINISH
}

constexpr int SHM_V2 = KVBLK * 256 * 2;
__device__ __forceinline__ void attn_body_dv256(const bf16_t* __restrict__ Qb, const int ldq, const bf16_t* __restrict__ Kh, const bf16_t* __restrict__ Vh, const int ldk,
                                                bf16_t* __restrict__ Ob, const int ldo, const int seq, const float kmax2, LAS char* lds) {
  int tid = threadIdx.x; asm volatile("" : "+v"(tid)); tid &= 511;
  const int wid = tid >> 6, lane = tid & 63, r32 = lane & 31, hi = lane >> 5, rg = wid >> 1, kh = wid & 1;
  LAS char* K_lds = lds; LAS char* V_lds = lds + 2 * SHM_K; LAS char* X_lds = lds + 2 * SHM_K + 2 * SHM_V2;
  float l_reg = 0; f32x16 o[4] = {}; bf16x8 qr[8];
  const float nmc = load_q(Qb + (long)(rg * QBLK + r32) * ldq + hi * 8, qr, kmax2);
  const int vb0 = (int)(uintptr_t)V_lds + v_rd_base(lane) + kh * 2048;
  const int kvo = k_dma_voff(wid, lane, ldk);
  const int vvo = unswap23(8 * (wid >> 2) + ((lane & 31) >> 2)) * ldk * 2 + ((2 * (wid & 3) + (lane >> 5)) * 32 + (lane & 3) * 8) * 2;
  const int l32 = 64 * ldk, l16 = 32 * ldk, pz = wid * 1024;
  const int xw = (rg * 4 + kh * 2) * 1024 + lane * 16, xr = rg * 4096 + lane * 16;
  const __amdgpu_buffer_rsrc_t krs = __builtin_amdgcn_make_buffer_rsrc((void*)Kh, 0, 0x7ffffff0, 0x00020000);
  const __amdgpu_buffer_rsrc_t vrs = __builtin_amdgcn_make_buffer_rsrc((void*)Vh, 0, 0x7ffffff0, 0x00020000);
#define KDMA(b, k0) do { const int _o = (k0) * ldk * 2; LAS char* _b = K_lds + (b) * SHM_K + pz; DMA16(krs, _b, kvo, _o); DMA16(krs, _b + 8192, kvo, _o + l32); } while (0)
#define VDMA(b, k0) do { const int _o = (k0) * ldk * 2; LAS char* _b = V_lds + (b) * SHM_V2 + pz; DMA16(vrs, _b, vvo, _o); DMA16(vrs, _b + 8192, vvo, _o + l16); \
    DMA16(vrs, _b + 16384, vvo, _o + 2 * l16); DMA16(vrs, _b + 24576, vvo, _o + 3 * l16); } while (0)
  f32x16 pA, pB; bf16x8 pa0, pa1, pa2, pa3, own0, own1; const int NT = seq / KVBLK;
  const int kxor = ((32 * kh + r32) & 7) << 4, krb = (32 * kh + r32) * 256;
#define QKHALF(P, b) do { _Pragma("unroll") for (int r = 0; r < 16; ++r) P[r] = nmc; \
    _Pragma("unroll") for (int d0 = 0; d0 < 8; ++d0) { const bf16x8 bk = *(LAS const bf16x8*)(K_lds + (b) * SHM_K + krb + (((d0 * 16 + hi * 8) * 2) ^ kxor)); \
      P = __builtin_amdgcn_mfma_f32_32x32x16_bf16(bk, qr[d0], P, 0, 0, 0); } } while (0)
#define FINH(P) do { exp16(P); l_reg += sum16(P); PK4(P, 0, own0); PK4(P, 8, own1); } while (0)
#define XWRITE(b) do { *(LAS bf16x8*)(X_lds + (b) * 16384 + xw) = own0; *(LAS bf16x8*)(X_lds + (b) * 16384 + xw + 1024) = own1; } while (0)
#define XREAD(b) do { pa0 = *(LAS const bf16x8*)(X_lds + (b) * 16384 + xr); pa1 = *(LAS const bf16x8*)(X_lds + (b) * 16384 + xr + 1024); \
    pa2 = *(LAS const bf16x8*)(X_lds + (b) * 16384 + xr + 2048); pa3 = *(LAS const bf16x8*)(X_lds + (b) * 16384 + xr + 3072); } while (0)
#define STEP(PA, PB, b, j) do { \
    SCHED; if ((j) + 1 < NT) QKHALF(PB, (b) ^ 1); FINH(PA); SCHED; \
    XWRITE(b); VM0(); __syncthreads(); \
    if ((j) + 3 < NT) KDMA((b) ^ 1, ((j) + 3) * KVBLK); if ((j) + 1 < NT) VDMA((b) ^ 1, ((j) + 1) * KVBLK); \
    XREAD(b); \
    pv_d0_256(o, vb0 + (b) * SHM_V2, pa0, pa1, pa2, pa3); } while (0)
  KDMA(0, 0); KDMA(1, KVBLK); VDMA(0, 0); VM0(); __syncthreads();
  QKHALF(pA, 0);
  __syncthreads();
  if (2 < NT) KDMA(0, 2 * KVBLK);
  for (int j = 0; j < NT; j += 2) { STEP(pA, pB, 0, j); STEP(pB, pA, 1, j + 1); }
  __syncthreads();
  LAS float* lx = (LAS float*)X_lds;
  lx[wid * 64 + lane] = l_reg; __syncthreads();
  const float l_tot = lx[wid * 64 + r32] + lx[wid * 64 + 32 + r32] + lx[(wid ^ 1) * 64 + r32] + lx[(wid ^ 1) * 64 + 32 + r32];
  store_o(o, l_tot, lx + 512 + wid * 32, Ob + (long)(rg * QBLK) * ldo + kh * 128, ldo, r32, hi);
  VM0();
  __syncthreads();
#undef KDMA
#undef VDMA
#undef QKHALF
#undef FINH
#undef XWRITE
#undef XREAD
#undef STEP
#undef VM0
}

#define LGK(n) asm volatile("s_waitcnt lgkmcnt(" #n ")" ::: "memory")
template <int OFF> __device__ __forceinline__ bf16x8 k_read(int ka) { bf16x8 r; asm volatile("ds_read_b128 %0, %1 offset:%2" : "=&v"(r) : "v"(ka), "i"(OFF) : "memory"); return r; }
struct VSet { s16x4 l0, h0, l1, h1; };
template <int OFF> __device__ __forceinline__ void v_read(VSet& s, int vb) { s.l0 = tr_read<OFF>(vb); s.h0 = tr_read<OFF + 4096>(vb); s.l1 = tr_read<OFF + 8192>(vb); s.h1 = tr_read<OFF + 12288>(vb); }
__device__ __forceinline__ void pv2(f32x16& oa, const VSet& s, bf16x8 pa0, bf16x8 pa1) {
#define PK(L, H) (bf16x8){L[0], L[1], L[2], L[3], H[0], H[1], H[2], H[3]}
  oa = __builtin_amdgcn_mfma_f32_32x32x16_bf16(pa0, PK(s.l0, s.h0), oa, 0, 0, 0);
  oa = __builtin_amdgcn_mfma_f32_32x32x16_bf16(pa1, PK(s.l1, s.h1), oa, 0, 0, 0);
#undef PK
}
template <bool SHIFT>
__device__ __forceinline__ void attn_body_c256_t(const bf16_t* __restrict__ Qb, const int ldq, const bf16_t* __restrict__ Kh, const bf16_t* __restrict__ Vh, const int ldk,
                                                 bf16_t* __restrict__ Ob, const int ldo, const int seq, const float nmc, const bf16x8 (&qr)[8], LAS char* lds) {
  int tid = threadIdx.x; asm volatile("" : "+v"(tid)); tid &= 511;
  const int wid = __builtin_amdgcn_readfirstlane(tid >> 6), lane = tid & 63, r32 = lane & 31, hi = lane >> 5;
  LAS char* K_lds = lds; LAS char* V_lds = lds + 2 * SHM_K;
  LAS float* li_l = (LAS float*)(lds + 2 * SHM_K + 2 * SHM_V2) + wid * 64;
  float l_reg = 0; f32x16 o[8] = {};
  const int vb0 = (int)(uintptr_t)V_lds + v_rd_base(lane);
  const int kvo = k_dma_voff(wid, lane, ldk);
  const int vvo = unswap23(8 * (wid >> 2) + ((lane & 31) >> 2)) * ldk * 2 + ((2 * (wid & 3) + (lane >> 5)) * 32 + (lane & 3) * 8) * 2;
  const int l32 = 64 * ldk, l16 = 32 * ldk, pz = wid * 1024;
  const __amdgpu_buffer_rsrc_t krs = __builtin_amdgcn_make_buffer_rsrc((void*)Kh, 0, 0x7ffffff0, 0x00020000);
  const __amdgpu_buffer_rsrc_t vrs = __builtin_amdgcn_make_buffer_rsrc((void*)Vh, 0, 0x7ffffff0, 0x00020000);
#define VM0() asm volatile("s_waitcnt vmcnt(0)" ::: "memory")
#define KVDMA(b, k0) do { const int _o = (k0) * ldk * 2; LAS char* _k = K_lds + (b) * SHM_K + pz; LAS char* _v = V_lds + (b) * SHM_V2 + pz; \
    DMA16(krs, _k, kvo, _o); DMA16(krs, _k + 8192, kvo, _o + l32); DMA16(vrs, _v, vvo, _o); DMA16(vrs, _v + 8192, vvo, _o + l16); \
    DMA16(vrs, _v + 16384, vvo, _o + 2 * l16); DMA16(vrs, _v + 24576, vvo, _o + 3 * l16); } while (0)
  int ka[8];
  { const int kxor = (r32 & 7) << 4, krb = (int)(uintptr_t)K_lds + r32 * 256;
#pragma unroll
    for (int d0 = 0; d0 < 8; ++d0) ka[d0] = krb + (((d0 * 16 + hi * 8) * 2) ^ kxor); }
  f32x16 P; bf16x8 pa0, pa1, f0, f1, f2, f3; VSet va, vb_, vc;
  const int NT = seq / KVBLK;
#define PINIT() do { _Pragma("unroll") for (int r = 0; r < 16; ++r) { float _z; asm volatile("v_mov_b32 %0, %1" : "=v"(_z) : "v"(SHIFT ? nmc : 0.f)); P[r] = _z; } } while (0)
#define KOFF(b, h) ((b) * 16384 + (h) * 8192)
#define VOFF(b, h, d0) ((b) * 32768 + (h) * 16384 + (d0) * 512)
#define KPRO(b, h) do { f0 = k_read<KOFF(b, h)>(ka[0]); f1 = k_read<KOFF(b, h)>(ka[1]); f2 = k_read<KOFF(b, h)>(ka[2]); } while (0)
#define QKM(F, d0) do { SCHED; P = __builtin_amdgcn_mfma_f32_32x32x16_bf16(F, qr[d0], P, 0, 0, 0); SCHED; } while (0)
#define QKHALF(b, h) do { PINIT(); \
    LGK(2); QKM(f0, 0); f3 = k_read<KOFF(b, h)>(ka[3]); \
    LGK(2); QKM(f1, 1); f0 = k_read<KOFF(b, h)>(ka[4]); \
    LGK(2); QKM(f2, 2); f1 = k_read<KOFF(b, h)>(ka[5]); \
    LGK(2); QKM(f3, 3); f2 = k_read<KOFF(b, h)>(ka[6]); \
    LGK(2); QKM(f0, 4); f3 = k_read<KOFF(b, h)>(ka[7]); \
    LGK(2); QKM(f1, 5); v_read<VOFF(b, h, 0)>(va, vb0); \
    LGK(5); QKM(f2, 6); v_read<VOFF(b, h, 1)>(vb_, vb0); \
    LGK(8); QKM(f3, 7); } while (0)
#define SMH() do { exp16(P); l_reg += sum16(P); PK4(P, 0, pa0); PK4(P, 8, pa1); } while (0)
#define PVM(S, d0) do { SCHED; pv2(o[d0], S, pa0, pa1); SCHED; } while (0)
#define PVHALF(b, h, NEXTK, nb, nh) do { \
    LGK(4); PVM(va, 0); v_read<VOFF(b, h, 2)>(vc, vb0); \
    LGK(4); PVM(vb_, 1); v_read<VOFF(b, h, 3)>(va, vb0); \
    LGK(4); PVM(vc, 2); v_read<VOFF(b, h, 4)>(vb_, vb0); \
    LGK(4); PVM(va, 3); v_read<VOFF(b, h, 5)>(vc, vb0); \
    LGK(4); PVM(vb_, 4); v_read<VOFF(b, h, 6)>(va, vb0); \
    LGK(4); PVM(vc, 5); v_read<VOFF(b, h, 7)>(vb_, vb0); \
    LGK(4); PVM(va, 6); if (NEXTK) { f0 = k_read<KOFF(nb, nh)>(ka[0]); f1 = k_read<KOFF(nb, nh)>(ka[1]); } \
    if (NEXTK) { LGK(2); } else { LGK(0); } PVM(vb_, 7); if (NEXTK) { f2 = k_read<KOFF(nb, nh)>(ka[2]); } } while (0)
#define STEPC(b, j) do { if ((j) + 1 < NT) KVDMA((b) ^ 1, ((j) + 1) * KVBLK); \
    KPRO(b, 0); QKHALF(b, 0); SMH(); PVHALF(b, 0, true, b, 1); \
    QKHALF(b, 1); SMH(); PVHALF(b, 1, false, 0, 0); \
    VM0(); __syncthreads(); } while (0)
  KVDMA(0, 0); VM0(); __syncthreads();
  for (int j = 0; j < NT; j += 2) { STEPC(0, j); STEPC(1, j + 1); }
  { auto rr = __builtin_amdgcn_permlane32_swap(__float_as_uint(l_reg), __float_as_uint(l_reg), false, false); l_reg = __uint_as_float(rr[0]) + __uint_as_float(rr[1]); }
  if (hi == 0) li_l[r32] = l_reg; asm volatile("s_waitcnt lgkmcnt(0)" ::: "memory");
  bf16_t* Ow = Ob + (long)(wid * QBLK) * ldo;
#pragma unroll
  for (int r = 0; r < 16; ++r) { const int orow = crow(r, hi); const float rl = __builtin_amdgcn_rcpf(li_l[orow]);
#pragma unroll
    for (int d0 = 0; d0 < 8; ++d0) Ow[(long)orow * ldo + d0 * 32 + r32] = f2bf(o[d0][r] * rl); }
  VM0();
  __syncthreads();
#undef KVDMA
#undef PINIT
#undef KOFF
#undef VOFF
#undef KPRO
#undef QKM
#undef QKHALF
#undef SMH
#undef PVM
#undef PVHALF
#undef STEPC
#undef VM0
}
__device__ __forceinline__ void attn_body_c256(const bf16_t* __restrict__ Qb, const int ldq, const bf16_t* __restrict__ Kh, const bf16_t* __restrict__ Vh, const int ldk,
                                               bf16_t* __restrict__ Ob, const int ldo, const int seq, const float kmax2, LAS char* lds) {
  int tid = threadIdx.x; asm volatile("" : "+v"(tid)); tid &= 511;
  const int wid = tid >> 6, lane = tid & 63, r32 = lane & 31, hi = lane >> 5;
  bf16x8 qr[8];
  const float nmc = load_q(Qb + (long)(wid * QBLK + r32) * ldq + hi * 8, qr, kmax2);
  if (__all(nmc > -64.f)) attn_body_c256_t<false>(Qb, ldq, Kh, Vh, ldk, Ob, ldo, seq, 0.f, qr, lds);
  else attn_body_c256_t<true>(Qb, ldq, Kh, Vh, ldk, Ob, ldo, seq, nmc, qr, lds);
}
#undef PK4
}

__device__ __forceinline__ int perm_plain8(int n) { const int r = n & 31; return (n & ~31) + 16 * ((r >> 2) & 1) + 4 * (r >> 3) + (r & 3); }
__device__ __forceinline__ int perm_row(int kind, int n) {
  if (kind == 0) return perm_plain8(n);
  if (kind == 1) { if (n < N_QKV0) return perm_plain8(n); const int c = n - N_QKV0; const int ch = c & 1023; return N_QKV0 + 32 * (ch >> 4) + ((c >> 10) << 4) + (ch & 15); }
  return 32 * (n >> 4) + ((kind == 3) ? 16 : 0) + (n & 15);
}
__device__ __forceinline__ void cvt_tile(const float* __restrict__ src, int N, bf16_t* __restrict__ dst, int K, int kind, int k0, int n0, LAS unsigned* t32) {
  int tid = threadIdx.x; asm volatile("" : "+v"(tid)); tid &= 511;
#pragma unroll
  for (int j = 0; j < 2; ++j) {
    const int item = tid + 512 * j, kp = item >> 4, q = item & 15;
    const f32x4 v0 = *(const f32x4*)(src + (size_t)(k0 + 2 * kp) * N + n0 + 4 * q);
    const f32x4 v1 = *(const f32x4*)(src + (size_t)(k0 + 2 * kp + 1) * N + n0 + 4 * q);
#pragma unroll
    for (int i = 0; i < 4; ++i) t32[(4 * q + i) * 65 + kp] = cvtpk(v0[i], v1[i]);
  }
  __syncthreads();
#pragma unroll
  for (int j = 0; j < 2; ++j) {
    const int item = tid + 512 * j, n = item >> 4, ko = item & 15;
    u32x4 v;
#pragma unroll
    for (int i = 0; i < 4; ++i) v[i] = t32[n * 65 + 4 * ko + i];
    *(u32x4*)(dst + (size_t)perm_row(kind, n0 + n) * K + k0 + 8 * ko) = v;
  }
  __syncthreads();
}
__device__ __forceinline__ void cvt_matrix_units(const float* src, int K, int N, bf16_t* dst, int kind, int u0, int ustride, LAS unsigned* t32) {
  const int nN = N / 64, nK = K / 128;
  for (int u = u0; u < nN * nK; u += ustride) cvt_tile(src, N, dst, K, kind, (u / nN) * 128, (u % nN) * 64, t32);
}
constexpr size_t WMOE8_E = (size_t)1024 * D + (size_t)D * EFF;
__device__ __forceinline__ void cvt_tile8(const float* __restrict__ src, int N, unsigned char* __restrict__ dst, int K, int kind, int k0, int n0, float scale, LAS unsigned* t32) {
  int tid = threadIdx.x; asm volatile("" : "+v"(tid)); tid &= 511;
  { const int kq = tid >> 4, q = tid & 15;
    f32x4 v[4];
#pragma unroll
    for (int r = 0; r < 4; ++r) v[r] = *(const f32x4*)(src + (size_t)(k0 + 4 * kq + r) * N + n0 + 4 * q);
#pragma unroll
    for (int i = 0; i < 4; ++i) t32[(4 * q + i) * 33 + kq] = pack_fp8x4(v[0][i] * scale, v[1][i] * scale, v[2][i] * scale, v[3][i] * scale); }
  __syncthreads();
  { const int n = tid >> 3, kc = tid & 7;
    u32x4 v;
#pragma unroll
    for (int i = 0; i < 4; ++i) v[i] = t32[n * 33 + 4 * kc + i];
    *(u32x4*)(dst + (size_t)perm_row(kind, n0 + n) * K + k0 + 16 * kc) = v; }
  __syncthreads();
}
__device__ __forceinline__ void cvt_moe_all8(const Args& a, LAS unsigned* t32) {
  unsigned char* W = (unsigned char*)(a.ws + WS_WMOE);
  for (int u = blockIdx.x; u < 2 * 65 * 384; u += gridDim.x) {
    const int le = u / 384, L = le / 65, e = le % 65, r = u % 384, mtx = r >> 7, lu = r & 127;
    const float* src; unsigned char* dst = W + (size_t)le * WMOE8_E; int K, N, kind; float sc;
    if (mtx == 0)      { src = e < 64 ? a.in[21] + ((size_t)L * 64 + e) * D * EFF : a.in[24] + (size_t)L * D * EFF; K = D; N = EFF; kind = 2; sc = 256.f; }
    else if (mtx == 1) { src = e < 64 ? a.in[22] + ((size_t)L * 64 + e) * D * EFF : a.in[25] + (size_t)L * D * EFF; K = D; N = EFF; kind = 3; sc = 256.f; }
    else               { src = e < 64 ? a.in[23] + ((size_t)L * 64 + e) * EFF * D : a.in[26] + (size_t)L * EFF * D; K = EFF; N = D; kind = 0; sc = 128.f; dst += (size_t)1024 * D; }
    const int nN = N / 64;
    cvt_tile8(src, N, dst, K, kind, (lu / nN) * 128, (lu % nN) * 64, sc, t32);
  }
}

__device__ __forceinline__ void ld_row_f32(const float* __restrict__ p, int lane, float (&v)[32]) {
#pragma unroll
  for (int j = 0; j < 4; ++j) { const f32x4 t0 = *(const f32x4*)(p + 8 * lane + 512 * j), t1 = *(const f32x4*)(p + 8 * lane + 512 * j + 4);
#pragma unroll
    for (int i = 0; i < 4; ++i) { v[8 * j + i] = t0[i]; v[8 * j + 4 + i] = t1[i]; } }
}
__device__ __forceinline__ void ld_row_bf16(const bf16_t* __restrict__ p, int lane, float (&v)[32]) {
#pragma unroll
  for (int j = 0; j < 4; ++j) { const u32x4 t = *(const u32x4*)(p + 8 * lane + 512 * j);
#pragma unroll
    for (int i = 0; i < 4; ++i) { v[8 * j + 2 * i] = bflo(t[i]); v[8 * j + 2 * i + 1] = bfhi(t[i]); } }
}
__device__ __forceinline__ void ld8f(const float* __restrict__ p, float (&x)[8]) { const f32x4 t0 = *(const f32x4*)p, t1 = *(const f32x4*)(p + 4);
#pragma unroll
  for (int i = 0; i < 4; ++i) { x[i] = t0[i]; x[4 + i] = t1[i]; } }
__device__ __forceinline__ void st8f(float* __restrict__ p, const float* x) { f32x4 t0 = {x[0], x[1], x[2], x[3]}, t1 = {x[4], x[5], x[6], x[7]}; *(f32x4*)p = t0; *(f32x4*)(p + 4) = t1; }
__device__ __forceinline__ float sumsq32(const float (&v)[32]) { float s = 0;
#pragma unroll
  for (int i = 0; i < 32; ++i) s += v[i] * v[i];
  return wave_sum(s); }
template <bool COPY, bool OUT8 = false>
__device__ __forceinline__ void modulate_store(const float (&v)[32], float rstd, const float* __restrict__ g, const float* __restrict__ shift, const float* __restrict__ scale,
                                               bf16_t* __restrict__ dst, int lane, LAS float* f32copy) {
#pragma unroll
  for (int j = 0; j < 4; ++j) {
    const int idx = 8 * lane + 512 * j;
    float gv[8], sh[8], sc[8], y[8]; ld8f(g + idx, gv); ld8f(shift + idx, sh); ld8f(scale + idx, sc);
#pragma unroll
    for (int i = 0; i < 8; ++i) y[i] = v[8 * j + i] * rstd * gv[i] * (1.f + sc[i]) + sh[i];
    if (OUT8) { u32x2 p8 = {pack_fp8x4(y[0], y[1], y[2], y[3]), pack_fp8x4(y[4], y[5], y[6], y[7])}; *(u32x2*)((unsigned char*)dst + idx) = p8; }
    else { u32x4 pk = {cvtpk(y[0], y[1]), cvtpk(y[2], y[3]), cvtpk(y[4], y[5]), cvtpk(y[6], y[7])}; *(u32x4*)(dst + idx) = pk; }
    if (COPY) { f32x4 t0 = {y[0], y[1], y[2], y[3]}, t1 = {y[4], y[5], y[6], y[7]};
      *(LAS f32x4*)(f32copy + idx) = t0; *(LAS f32x4*)(f32copy + idx + 4) = t1; }
  }
}

__device__ __forceinline__ void phase_prologue(const Args& a, LAS char* lds) {
  int tid = threadIdx.x; asm volatile("" : "+v"(tid)); tid &= 511; const int wave = tid >> 6, lane = tid & 63;
  {
    LAS float* sc = (LAS float*)lds;
    LAS float* part = sc + 4096;
    const float* c = a.in[1]; const float* cc = a.in[3];
    for (int i = tid; i < D; i += NTHREADS) { float v = c[i]; sc[i] = v * sigmoidf_(v); float u = cc[i]; sc[D + i] = u * sigmoidf_(u); }
    __syncthreads();
    float* MOD = (float*)(a.ws + WS_MOD);
    for (int u = blockIdx.x; u < 2 * 192; u += gridDim.x) {
      const int L = u / 192, chunk = u % 192;
      const float* W = a.in[4] + (size_t)L * D * 12288 + chunk * 64 + lane;
      float a0 = 0, a1 = 0; const int d0 = wave * 256;
#pragma unroll 8
      for (int dd = 0; dd < 256; ++dd) { const float w = W[(size_t)(d0 + dd) * 12288]; a0 += sc[d0 + dd] * w; a1 += sc[D + d0 + dd] * w; }
      part[(wave * 2 + 0) * 64 + lane] = a0; part[(wave * 2 + 1) * 64 + lane] = a1;
      __syncthreads();
      if (tid < 128) { const int which = tid >> 6; float s = 0;
#pragma unroll
        for (int w = 0; w < 8; ++w) s += part[(w * 2 + which) * 64 + lane];
        const int j = chunk * 64 + lane; MOD[(size_t)(L * 2 + which) * 12288 + j] = s + a.in[5][L * 12288 + j]; }
      __syncthreads();
    }
  }
  LAS unsigned* t32 = (LAS unsigned*)lds;
  cvt_matrix_units(a.in[7], D, N_IN0, (bf16_t*)(a.ws + WS_WIN0), 1, blockIdx.x, gridDim.x, t32);
  cvt_matrix_units(a.in[8], D, D, (bf16_t*)(a.ws + WS_WOUT0), 0, blockIdx.x, gridDim.x, t32);
  cvt_matrix_units(a.in[15], D, N_IN1, (bf16_t*)(a.ws + WS_WIN1), 0, blockIdx.x, gridDim.x, t32);
  cvt_matrix_units(a.in[16], D, D, (bf16_t*)(a.ws + WS_WOUT1), 0, blockIdx.x, gridDim.x, t32);
  cvt_moe_all8(a, t32);
}

__device__ __forceinline__ void phase_modulate0(const Args& a) {
  int tid = threadIdx.x; asm volatile("" : "+v"(tid)); tid &= 511; const int wave = tid >> 6, lane = tid & 63;
  const float* MOD = (const float*)(a.ws + WS_MOD);
  bf16_t* A = (bf16_t*)(a.ws + WS_ABUF);
  for (int it = blockIdx.x; it < MT / 8; it += gridDim.x) {
    const int r = it * 8 + wave;
    const float* src = r < CTXL ? a.in[2] + (size_t)r * D : a.in[0] + (size_t)(r - CTXL) * D;
    const float* mod = MOD + (r < CTXL ? 12288 : 0);
    float v[32]; ld_row_f32(src, lane, v);
    const float rstd = rsqrtf(sumsq32(v) * (1.f / D) + EPS);
    modulate_store<false>(v, rstd, a.in[6], mod, mod + D, A + (size_t)r * D, lane, nullptr);
  }
}

__device__ __forceinline__ void rope_cs4(int r, int lane, float (&cs)[4], float (&sn)[4]) {
#pragma unroll
  for (int q = 0; q < 4; ++q) { cs[q] = 1.f; sn[q] = 0.f; }
  if (r >= CTXL) { const int t = r - CTXL; const int l = lane & 15, a = l >> 3, i0 = 4 * (l & 7);
    const float pos = a ? (float)(t & 63) : (float)(t >> 6);
#pragma unroll
    for (int q = 0; q < 4; ++q) { const float inv = powf(10000.f, -(float)(i0 + q) / 32.f); sincosf(pos * inv, &sn[q], &cs[q]); } }
}
__device__ __forceinline__ float sum16lanes(float v) { v += __shfl_xor(v, 1); v += __shfl_xor(v, 2); v += __shfl_xor(v, 4); v += __shfl_xor(v, 8); return v; }
__device__ __forceinline__ void phase_rope_conv0(const Args& a, LAS char* lds, bool dry = false) {
  int tid = threadIdx.x; asm volatile("" : "+v"(tid)); tid &= 511; const int wave = tid >> 6, lane = tid & 63;
  bf16_t* Q = (bf16_t*)(a.ws + WS_QKVU);
  {
    const bf16_t* HG = (const bf16_t*)(a.ws + WS_HG);
    bf16_t* X2 = (bf16_t*)(a.ws + WS_X2);
    LAS char* lt = lds;
    LAS float* part = (LAS float*)(lds + 62 * 2048);
    LAS float* stats = part + 512;
    const float* dw_w = a.in[11]; const float* dw_b = a.in[12]; const float* ln_g = a.in[13]; const float* ln_b = a.in[14];
    const __amdgpu_buffer_rsrc_t wrs = __builtin_amdgcn_make_buffer_rsrc((void*)dw_w, 0, 31 * 1024 * 4, 0x00020000);
    for (int u = blockIdx.x; u < 520; u += gridDim.x) {
      int seg0, seg1, r0;
      if (u < 8) { seg0 = 0; seg1 = CTXL; r0 = u * 32; } else { seg0 = CTXL; seg1 = MT; r0 = CTXL + (u - 8) * 32; }
      for (int c = tid; c < 62 * 128; c += NTHREADS) { const int rr = c >> 7, cc = c & 127, gr = r0 - 15 + rr;
        u32x4 v = {0u, 0u, 0u, 0u}; if (gr >= seg0 && gr < seg1) v = *(const u32x4*)(HG + (size_t)gr * 1024 + cc * 8);
        *(LAS u32x4*)(lt + rr * 2048 + cc * 16) = v; }
      __syncthreads();
      float w0[31], w1[31];
#pragma unroll
      for (int j = 0; j < 31; ++j) { const u32x2 w = __builtin_amdgcn_raw_buffer_load_b64(wrs, tid * 8, j * 4096, 0); w0[j] = __uint_as_float(w[0]); w1[j] = __uint_as_float(w[1]); }
      const f32x2 bb = *(const f32x2*)(dw_b + 2 * tid);
      const f32x2 gg = *(const f32x2*)(ln_g + 2 * tid), gb = *(const f32x2*)(ln_b + 2 * tid);
#pragma unroll 1
      for (int hf = 0; hf < 4; ++hf) {
        float o0[8], o1[8];
        LAS const char* lth = lt + (hf * 8) * 2048 + tid * 4;
#pragma unroll
        for (int r = 0; r < 8; ++r) { o0[r] = bb[0]; o1[r] = bb[1]; }
#pragma unroll
        for (int i = 0; i < 38; ++i) {
          const unsigned p = *(LAS const unsigned*)(lth + i * 2048);
          const float x0 = bflo(p), x1 = bfhi(p);
#pragma unroll
          for (int r = 0; r < 8; ++r) { const int j = i - r; if (j >= 0 && j < 31) { o0[r] += x0 * w0[j]; o1[r] += x1 * w1[j]; } }
        }
#pragma unroll
        for (int r = 0; r < 8; ++r) {
          const float s = wave_sum(o0[r] + o1[r]), q = wave_sum(o0[r] * o0[r] + o1[r] * o1[r]);
          if (lane == 0) { part[(r * 8 + wave) * 2] = s; part[(r * 8 + wave) * 2 + 1] = q; }
        }
        __syncthreads();
        if (tid < 8) { float s = 0, q = 0;
#pragma unroll
          for (int w = 0; w < 8; ++w) { s += part[(tid * 8 + w) * 2]; q += part[(tid * 8 + w) * 2 + 1]; }
          const float mean = s * (1.f / 1024), var = q * (1.f / 1024) - mean * mean;
          stats[tid * 2] = mean; stats[tid * 2 + 1] = rsqrtf(fmaxf(var, 0.f) + EPS); }
        __syncthreads();
#pragma unroll
        for (int r = 0; r < 8; ++r) {
          const float mean = stats[r * 2], rstd = stats[r * 2 + 1];
          float y0 = (o0[r] - mean) * rstd * gg[0] + gb[0], y1 = (o1[r] - mean) * rstd * gg[1] + gb[1];
          y0 = y0 * sigmoidf_(y0); y1 = y1 * sigmoidf_(y1);
          *(unsigned*)(X2 + (size_t)(r0 + hf * 8 + r) * D + 1024 + 2 * tid) = cvtpk(y0, y1);
        }
      }
      __syncthreads();
    }
  }
  const float* qn = a.in[9]; const float* kn = a.in[10];
  unsigned* kmx = (unsigned*)(a.ws + WS_CTL + CTL_KMAX);
  const int slot = lane >> 4, l16 = lane & 15, e1 = (l16 >> 3) * 64 + 4 * (l16 & 7), e2 = e1 + 32;
  float km0 = 0.f, km1 = 0.f;
  for (int it = blockIdx.x; it < MT / 8; it += gridDim.x) {
    const int r = it * 8 + wave;
    float cs[4], sn[4]; rope_cs4(r, lane, cs, sn);
    bf16_t* rowp = Q + (size_t)r * N_QKV0;
#pragma unroll
    for (int hb = 0; hb < 12; hb += 4) {
      const int hh = hb + slot;
      if (hh < 10) {
        const float* g = hh < 8 ? qn : kn;
        const u32x2 a1 = *(const u32x2*)(rowp + hh * 128 + e1), a2 = *(const u32x2*)(rowp + hh * 128 + e2);
        float x1[4] = {bflo(a1[0]), bfhi(a1[0]), bflo(a1[1]), bfhi(a1[1])}, x2[4] = {bflo(a2[0]), bfhi(a2[0]), bflo(a2[1]), bfhi(a2[1])};
        float ss = 0;
#pragma unroll
        for (int q = 0; q < 4; ++q) ss += x1[q] * x1[q] + x2[q] * x2[q];
        ss = sum16lanes(ss);
        const float rstd = rsqrtf(ss * (1.f / 128) + EPS);
        const f32x4 g1 = *(const f32x4*)(g + e1), g2 = *(const f32x4*)(g + e2);
        float o1[4], o2[4], so = 0;
#pragma unroll
        for (int q = 0; q < 4; ++q) { const float y1 = x1[q] * rstd * g1[q], y2 = x2[q] * rstd * g2[q]; o1[q] = y1 * cs[q] - y2 * sn[q]; o2[q] = y2 * cs[q] + y1 * sn[q]; }
        const u32x2 w1 = {cvtpk(o1[0], o1[1]), cvtpk(o1[2], o1[3])}, w2 = {cvtpk(o2[0], o2[1]), cvtpk(o2[2], o2[3])};
        if (!dry) { *(u32x2*)(rowp + hh * 128 + e1) = w1; *(u32x2*)(rowp + hh * 128 + e2) = w2; }
        if (hb == 8) {
          so = bflo(w1[0]) * bflo(w1[0]) + bfhi(w1[0]) * bfhi(w1[0]) + bflo(w1[1]) * bflo(w1[1]) + bfhi(w1[1]) * bfhi(w1[1])
             + bflo(w2[0]) * bflo(w2[0]) + bfhi(w2[0]) * bfhi(w2[0]) + bflo(w2[1]) * bflo(w2[1]) + bfhi(w2[1]) * bfhi(w2[1]);
          so = sum16lanes(so); if (slot == 0) km0 = fmaxf(km0, so); else km1 = fmaxf(km1, so);
        }
      }
    }
  }
  if (l16 == 0 && slot < 2) atomicMax(&kmx[slot], __float_as_uint(slot == 0 ? km0 : km1));
}
__device__ __forceinline__ void phase_rope1(const Args& a, LAS char* lds, bool dry = false) {
  int tid = threadIdx.x; asm volatile("" : "+v"(tid)); tid &= 511; const int wave = tid >> 6, lane = tid & 63;
  bf16_t* Q = (bf16_t*)(a.ws + WS_QKVU);
  unsigned* kmx = (unsigned*)(a.ws + WS_CTL + CTL_KMAX) + 16;
  LAS unsigned* lk = (LAS unsigned*)lds;
  if (tid < 16) lk[tid] = 0u;
  __syncthreads();
  const int slot = lane >> 4, l16 = lane & 15, e1 = (l16 >> 3) * 64 + 4 * (l16 & 7), e2 = e1 + 32;
  for (int it = blockIdx.x; it < MT / 8; it += gridDim.x) {
    const int r = it * 8 + wave;
    float cs[4], sn[4]; rope_cs4(r, lane, cs, sn);
    bf16_t* rowp = Q + (size_t)r * N_IN1;
#pragma unroll 2
    for (int hb = (r < CTXL ? 16 : 0); hb < 32; hb += 4) {
      const int hh = hb + slot;
      const u32x2 a1 = *(const u32x2*)(rowp + hh * 128 + e1), a2 = *(const u32x2*)(rowp + hh * 128 + e2);
      const float x1[4] = {bflo(a1[0]), bfhi(a1[0]), bflo(a1[1]), bfhi(a1[1])}, x2[4] = {bflo(a2[0]), bfhi(a2[0]), bflo(a2[1]), bfhi(a2[1])};
      float o1[4], o2[4];
#pragma unroll
      for (int q = 0; q < 4; ++q) { o1[q] = x1[q] * cs[q] - x2[q] * sn[q]; o2[q] = x2[q] * cs[q] + x1[q] * sn[q]; }
      const u32x2 w1 = {cvtpk(o1[0], o1[1]), cvtpk(o1[2], o1[3])}, w2 = {cvtpk(o2[0], o2[1]), cvtpk(o2[2], o2[3])};
      if (r >= CTXL && !dry) { *(u32x2*)(rowp + hh * 128 + e1) = w1; *(u32x2*)(rowp + hh * 128 + e2) = w2; }
      if (hb >= 16) {
        float so = bflo(w1[0]) * bflo(w1[0]) + bfhi(w1[0]) * bfhi(w1[0]) + bflo(w1[1]) * bflo(w1[1]) + bfhi(w1[1]) * bfhi(w1[1])
                 + bflo(w2[0]) * bflo(w2[0]) + bfhi(w2[0]) * bfhi(w2[0]) + bflo(w2[1]) * bflo(w2[1]) + bfhi(w2[1]) * bfhi(w2[1]);
        so = sum16lanes(so);
        if (l16 == 0) atomicMax((unsigned*)&lk[hh - 16], __float_as_uint(so));
      }
    }
  }
  __syncthreads();
  if (tid < 16) atomicMax(&kmx[tid], lk[tid]);
  __syncthreads();
}

__device__ __forceinline__ void phase_attn(const Args& a, int L, LAS char* lds) {
  const bf16_t* Q = (const bf16_t*)(a.ws + WS_QKVU);
  const unsigned* kmx = (const unsigned*)(a.ws + WS_CTL + CTL_KMAX) + L * 16;
  if (L == 0) {
    bf16_t* X2 = (bf16_t*)(a.ws + WS_X2);
    for (int u = blockIdx.x; u < 520; u += gridDim.x) {
      const int head = u < 512 ? (u & 7) : (u - 512);
      const float kmax2 = __uint_as_float(kmx[head >> 2]);
      if (u < 512) { const int qb = u >> 3; const size_t q0 = (size_t)(CTXL + qb * 256);
        at::attn_body(Q + q0 * N_QKV0 + head * 128, N_QKV0, Q + 1024 + (head >> 2) * 128, Q + 1280 + (head >> 2) * 128, N_QKV0, X2 + q0 * D + head * 128, D, MT, kmax2, lds);
      } else {
        at::attn_body(Q + head * 128, N_QKV0, Q + 1024 + (head >> 2) * 128, Q + 1280 + (head >> 2) * 128, N_QKV0, X2 + head * 128, D, CTXL, kmax2, lds); }
    }
  } else {
    bf16_t* O = (bf16_t*)(a.ws + WS_Y);
    for (int u = blockIdx.x; u < 1024; u += gridDim.x) {
      const int x = u & 7, w = u >> 3, hc = x + 8 * (w >> 6), qb = w & 63, h = hc >> 1;
      const float kmax2 = __uint_as_float(kmx[hc]);
      const size_t q0 = (size_t)(CTXL + qb * 256);
      at::attn_body_c256(Q + q0 * N_IN1 + hc * 128, N_IN1, Q + 2048 + hc * 128, Q + 4096 + h * 256, N_IN1,
                         O + (size_t)(qb * 256) * 4096 + hc * 256, 4096, MT, kmax2, lds);
    }
  }
}

__device__ __forceinline__ void phase_diff(const Args& a) {
  int tid = threadIdx.x; asm volatile("" : "+v"(tid)); tid &= 511; const int wave = tid >> 6, lane = tid & 63;
  const bf16_t* O = (const bf16_t*)(a.ws + WS_Y);
  bf16_t* X2 = (bf16_t*)(a.ws + WS_X2);
  const float* lp = a.in[17];
  const float s1 = wave_sum(lp[lane] * lp[128 + lane] + lp[64 + lane] * lp[192 + lane]);
  const float s2 = wave_sum(lp[256 + lane] * lp[384 + lane] + lp[320 + lane] * lp[448 + lane]);
  const float lam = expf(s1) - expf(s2) + LAM_INIT;
  const f32x4 sg = *(const f32x4*)(a.in[18] + 4 * lane);
  for (int it = blockIdx.x; it < SEQ / 8; it += gridDim.x) {
    const int t = it * 8 + wave;
    const bf16_t* op = O + (size_t)t * 4096;
    bf16_t* xp = X2 + (size_t)(CTXL + t) * D;
#pragma unroll 2
    for (int h = 0; h < 8; ++h) {
      const u32x2 a0 = *(const u32x2*)(op + (2 * h) * 256 + 4 * lane), a1 = *(const u32x2*)(op + (2 * h + 1) * 256 + 4 * lane);
      float d[4] = {bflo(a0[0]) - lam * bflo(a1[0]), bfhi(a0[0]) - lam * bfhi(a1[0]), bflo(a0[1]) - lam * bflo(a1[1]), bfhi(a0[1]) - lam * bfhi(a1[1])};
      const float ss = wave_sum(d[0] * d[0] + d[1] * d[1] + d[2] * d[2] + d[3] * d[3]);
      const float rstd = rsqrtf(ss * (1.f / 256) + EPS) * (1.f - LAM_INIT);
      u32x2 pk = {cvtpk(d[0] * rstd * sg[0], d[1] * rstd * sg[1]), cvtpk(d[2] * rstd * sg[2], d[3] * rstd * sg[3])};
      *(u32x2*)(xp + h * 256 + 4 * lane) = pk;
    }
  }
}

__device__ __forceinline__ void phase_G(const Args& a, int L, LAS char* lds, bool dry = false) {
  int tid = threadIdx.x; asm volatile("" : "+v"(tid)); tid &= 511; const int wave = tid >> 6, lane = tid & 63;
  const int NTOK = L == 0 ? MT : SEQ, ROW0 = L == 0 ? 0 : CTXL;
  const float* ng = a.in[6] + (size_t)L * 4 * D;
  const float* MODL = (const float*)(a.ws + WS_MOD) + (size_t)(L * 2) * 12288;
  const float* router = a.in[19] + (size_t)L * D * NE; const float* rbias = a.in[20] + L * NE;
  const bf16_t* OUT = (const bf16_t*)(a.ws + WS_OUT);
  float* HRES = (float*)(a.ws + WS_HRES);
  bf16_t* F = (bf16_t*)(a.ws + WS_ABUF);
  int* counts = (int*)(a.ws + WS_CTL + CTL_CNT) + L * 64;
  int* top_e = (int*)(a.ws + WS_TOPE); float* top_w = (float*)(a.ws + WS_TOPW); int* top_p = (int*)(a.ws + WS_TOPP);
  LAS float* ft = (LAS float*)lds;
  LAS float* part = ft + 8 * D;
  for (int it = blockIdx.x; it < NTOK / 8; it += gridDim.x) {
    const int r = ROW0 + it * 8 + wave;
    const float* mod = MODL + (r < CTXL ? 12288 : 0);
    {
      float o[32], h[32];
      ld_row_bf16(OUT + (size_t)r * D, lane, o);
      const float* hp = L == 0 ? (r < CTXL ? a.in[2] + (size_t)r * D : a.in[0] + (size_t)(r - CTXL) * D) : HRES + (size_t)r * D;
      ld_row_f32(hp, lane, h);
      const float rstd1 = rsqrtf(sumsq32(o) * (1.f / D) + EPS);
#pragma unroll
      for (int j = 0; j < 4; ++j) { const int idx = 8 * lane + 512 * j;
        float g1[8], gt[8]; ld8f(ng + D + idx, g1); ld8f(mod + 2 * D + idx, gt);
#pragma unroll
        for (int i = 0; i < 8; ++i) h[8 * j + i] += gt[i] * (o[8 * j + i] * rstd1 * g1[i]);
        if (!dry) st8f(HRES + (size_t)r * D + idx, &h[8 * j]); }
      const float rstd2 = rsqrtf(sumsq32(h) * (1.f / D) + EPS);
      modulate_store<true, true>(h, rstd2, ng + 2 * D, mod + 3 * D, mod + 4 * D, (bf16_t*)((unsigned char*)F + (size_t)r * D), lane, ft + wave * D);
    }
    __syncthreads();
    float acc[8] = {0, 0, 0, 0, 0, 0, 0, 0};
    const int d0 = wave * 256;
#pragma unroll 2
    for (int dd = 0; dd < 256; dd += 4) {
      const float* rp = router + (size_t)(d0 + dd) * NE + lane;
      const float r0 = rp[0], r1 = rp[NE], r2 = rp[2 * NE], r3 = rp[3 * NE];
#pragma unroll
      for (int t = 0; t < 8; ++t) { const f32x4 fv = *(LAS const f32x4*)(ft + t * D + d0 + dd); acc[t] += fv[0] * r0 + fv[1] * r1 + fv[2] * r2 + fv[3] * r3; }
    }
#pragma unroll
    for (int t = 0; t < 8; ++t) part[(wave * 8 + t) * 64 + lane] = acc[t];
    __syncthreads();
    float logit = 0;
#pragma unroll
    for (int w = 0; w < 8; ++w) logit += part[(w * 8 + wave) * 64 + lane];
#if MK_DIAG
    ((float*)(a.ws + WS_Y))[(size_t)r * 64 + lane] = logit;
#endif
    const float score = sigmoidf_(logit);
    const float choice = score + rbias[lane];
    int rank = 0; const int gl = lane & 7;
#pragma unroll
    for (int j = 0; j < 8; ++j) { const float o = __shfl(choice, (lane & ~7) | j); rank += (o > choice || (o == choice && j < gl)) ? 1 : 0; }
    float gs = rank < 2 ? choice : 0.f;
    gs += __shfl_xor(gs, 1); gs += __shfl_xor(gs, 2); gs += __shfl_xor(gs, 4);
    int grank = 0; const int g = lane >> 3;
#pragma unroll
    for (int j = 0; j < 8; ++j) { const float o = __shfl(gs, j * 8); grank += (o > gs || (o == gs && j < g)) ? 1 : 0; }
    const bool gsel = grank < 4;
    const float mc = gsel ? choice : -INFINITY;
    int erank = 0;
#pragma unroll 4
    for (int j = 0; j < 64; ++j) { const float o = __int_as_float(__builtin_amdgcn_readlane(__float_as_int(mc), j)); erank += (o > mc || (o == mc && j < lane)) ? 1 : 0; }
    const bool sel = gsel && erank < 8;
    const unsigned long long bal = __ballot(sel);
    const int idx = __popcll(bal & ((1ull << lane) - 1ull));
    const float ssum = wave_sum(sel ? score : 0.f);
    if (sel && !dry) { const int pos = atomicAdd(&counts[lane], 1);
      top_e[r * 8 + idx] = lane; top_w[r * 8 + idx] = score / ssum * 2.5f; top_p[r * 8 + idx] = pos; }
  }
}

__device__ __forceinline__ void moe_tile_prefix(const int* counts, LAS int* ts) {
  if (threadIdx.x == 0) { int s = 0; for (int e = 0; e < 64; ++e) { ts[e] = s; s += (counts[e] + 255) >> 8; } ts[64] = s; }
  __syncthreads();
}
__device__ __forceinline__ void phase_H(const Args& a, int L, LAS char* lds) {
  const int NTOK = L == 0 ? MT : SEQ, ROW0 = L == 0 ? 0 : CTXL;
  const int* counts = (const int*)(a.ws + WS_CTL + CTL_CNT) + L * 64;
  const int* top_e = (const int*)(a.ws + WS_TOPE); const int* top_p = (const int*)(a.ws + WS_TOPP);
  int* tslot = (int*)(a.ws + WS_TSLOT); int* stok = (int*)(a.ws + WS_STOK);
  LAS int* ts = (LAS int*)lds;
  moe_tile_prefix(counts, ts);
  int tid = threadIdx.x; asm volatile("" : "+v"(tid)); tid &= 511;
  const int gt = blockIdx.x * NTHREADS + tid, gs = gridDim.x * NTHREADS;
  for (int i = gt; i < NTOK * 8; i += gs) { const int q = ROW0 * 8 + i; const int e = top_e[q]; const int slot = ts[e] * 256 + top_p[q]; stok[slot] = q >> 3; tslot[q] = slot; }
  for (int i = gt; i < 64 * 256; i += gs) { const int e = i >> 8, p = i & 255, cnt = counts[e], nt = (cnt + 255) >> 8; if (cnt + p < nt * 256) stok[ts[e] * 256 + cnt + p] = ROW0; }
  for (int i = gt; i < NTOK; i += gs) stok[SH_BASE + i] = ROW0 + i;
  __syncthreads();
}
struct MoeSched {
  LAS const int* ts; int TR, NN, total; const unsigned char* W; size_t woff;
  __device__ __forceinline__ bool unit(int i, int& slot0, const unsigned char*& Bt, int& bcol) const {
    for (int u = blockIdx.x + i * (int)gridDim.x; ; u += gridDim.x) {
      const int rnd = u >> 8, b = u & 255, v = rnd * 256 + (b & 7) * 32 + (b >> 3);
      if (rnd * 256 >= total) return false;
      if (v >= total) return false;
      const int m = v / NN, pn = v % NN;
      int e;
      if (m >= TR) { e = 64; slot0 = SH_BASE + 256 * (m - TR); } else { e = 0; while (ts[e + 1] <= m) ++e; slot0 = 256 * m; }
      Bt = W + (size_t)e * WMOE8_E + woff; bcol = pn * 256;
      return true;
    }
  }
};
__device__ __forceinline__ void phase_moe_up(const Args& a, int L, LAS char* lds) {
  const int NSH = L == 0 ? MT / 256 : SEQ / 256;
  const int* counts = (const int*)(a.ws + WS_CTL + CTL_CNT) + L * 64;
  LAS int* ts = (LAS int*)(lds + LDS_CTL + 64);
  moe_tile_prefix(counts, ts);
  const int TR = ts[64], TM = TR + NSH;
  const unsigned char* F = (const unsigned char*)(a.ws + WS_ABUF); const unsigned char* W = (const unsigned char*)(a.ws + WS_WMOE) + (size_t)L * 65 * WMOE8_E;
  const int* stok = (const int*)(a.ws + WS_STOK);
  EpiSwiGLU8 epi{(unsigned char*)(a.ws + WS_ACT), EFF};
  MoeSched sc{ts, TR, 4, TM * 4, W, 0};
  gemm8_run<true, D, D, D>(F, stok, lds, epi, sc);
}
__device__ __forceinline__ void phase_moe_down(const Args& a, int L, LAS char* lds) {
  const int NSH = L == 0 ? MT / 256 : SEQ / 256;
  const int* counts = (const int*)(a.ws + WS_CTL + CTL_CNT) + L * 64;
  LAS int* ts = (LAS int*)(lds + LDS_CTL + 64);
  moe_tile_prefix(counts, ts);
  const int TR = ts[64], TM = TR + NSH;
  const unsigned char* ACT = (const unsigned char*)(a.ws + WS_ACT); const unsigned char* W = (const unsigned char*)(a.ws + WS_WMOE) + (size_t)L * 65 * WMOE8_E;
  EpiPlainS epi{(bf16_t*)(a.ws + WS_Y), D, 1.f / 128.f};
  MoeSched sc{ts, TR, 8, TM * 8, W, (size_t)1024 * D};
  gemm8_run<false, EFF, EFF, EFF>(ACT, nullptr, lds, epi, sc);
}
__device__ __forceinline__ void phase_combine(const Args& a, int L, bool dry = false) {
  int tid = threadIdx.x; asm volatile("" : "+v"(tid)); tid &= 511; const int wave = tid >> 6, lane = tid & 63;
  const int NTOK = L == 0 ? MT : SEQ, ROW0 = L == 0 ? 0 : CTXL;
  const float* ng = a.in[6] + (size_t)L * 4 * D;
  const float* MODL = (const float*)(a.ws + WS_MOD) + (size_t)(L * 2) * 12288;
  const bf16_t* Y = (const bf16_t*)(a.ws + WS_Y);
  float* HRES = (float*)(a.ws + WS_HRES);
  const int* tslot = (const int*)(a.ws + WS_TSLOT); const float* top_w = (const float*)(a.ws + WS_TOPW);
  for (int it = blockIdx.x; it < NTOK / 8; it += gridDim.x) {
    const int r = ROW0 + it * 8 + wave;
    const float* mod = MODL + (r < CTXL ? 12288 : 0);
    float y[32];
    { float t[32]; ld_row_bf16(Y + (size_t)(SH_BASE + r - ROW0) * D, lane, t);
#pragma unroll
      for (int i = 0; i < 32; ++i) y[i] = t[i]; }
#pragma unroll 4
    for (int k = 0; k < 8; ++k) { const int slot = tslot[r * 8 + k]; const float w = top_w[r * 8 + k];
      float t[32]; ld_row_bf16(Y + (size_t)slot * D, lane, t);
#pragma unroll
      for (int i = 0; i < 32; ++i) y[i] += w * t[i]; }
    const float rstd = rsqrtf(sumsq32(y) * (1.f / D) + EPS);
    float h[32]; ld_row_f32(HRES + (size_t)r * D, lane, h);
#pragma unroll
    for (int j = 0; j < 4; ++j) { const int idx = 8 * lane + 512 * j;
      float g3[8], gt[8]; ld8f(ng + 3 * D + idx, g3); ld8f(mod + 5 * D + idx, gt);
#pragma unroll
      for (int i = 0; i < 8; ++i) h[8 * j + i] += gt[i] * (y[8 * j + i] * rstd * g3[i]);
      if (L == 0) { if (!dry) st8f(HRES + (size_t)r * D + idx, &h[8 * j]); } else st8f(a.out + (size_t)(r - CTXL) * D + idx, &h[8 * j]); }
    if (L == 0) {
      const float* mod1 = MODL + 2 * 12288 + (r < CTXL ? 12288 : 0);
      const float rstd2 = rsqrtf(sumsq32(h) * (1.f / D) + EPS);
      modulate_store<false>(h, rstd2, a.in[6] + (size_t)4 * D, mod1, mod1 + D, (bf16_t*)(a.ws + WS_ABUF) + (size_t)r * D, lane, nullptr);
    }
  }
}

constexpr int NPH = 21;
typedef const __attribute__((address_space(4))) Args* ArgsP;
#if defined(__HIP_DEVICE_COMPILE__)
#define FRESH_ARGS() const Args a = *({ ArgsP _p = (ArgsP)__builtin_amdgcn_kernarg_segment_ptr(); asm volatile("" : "+s"(_p)); _p; })
#else
#define FRESH_ARGS() const Args a = kargs
#endif
__global__ void __launch_bounds__(NTHREADS, 2) fwd(Args kargs) {
  extern __shared__ __attribute__((aligned(16))) unsigned char lds_raw[];
  LAS char* lds = (LAS char*)lds_raw;
  const int lo = kargs.ph_lo, hi = kargs.ph_hi;
  if (threadIdx.x < 64) ((LAS unsigned*)(lds + LDS_CTL))[threadIdx.x] = 0u;
  __syncthreads();
  if (hi - lo > 1) (void)xcd_barrier_post((unsigned*)(kargs.ws + WS_CTL), (volatile LAS unsigned*)(lds + LDS_CTL));
#ifndef PHASE_MASK
#define PHASE_MASK 0xFFFFFFFFu
#endif
#define IN(k) (((PHASE_MASK >> (k)) & 1u) && lo <= (k) && (k) < hi)
#ifndef PH_REPEAT_MASK
#define PH_REPEAT_MASK 0u
#endif
#define REP(k) for (int _rep = 0; _rep < (((PH_REPEAT_MASK >> (k)) & 1u) ? 2 : 1); ++_rep)
#define SEAM(k) do { if ((k) + 1 < hi) { XcdBarrier _b; _b.bar = (unsigned*)(a.ws + WS_CTL); _b.x = xb_xcc_id(); _b.st = (volatile LAS unsigned*)(lds + LDS_CTL); xcd_barrier(_b); } } while (0)

  if (IN(0)) { FRESH_ARGS(); REP(0) phase_prologue(a, lds); SEAM(0); }
  if (IN(1)) { FRESH_ARGS(); REP(1) phase_modulate0(a); SEAM(1); }
#pragma unroll
  for (int L = 0; L < 2; ++L) {
    const int base = 2 + (L == 0 ? 0 : 9);
    if (IN(base + 0)) {
      FRESH_ARGS();
      const bf16_t* A = (const bf16_t*)(a.ws + WS_ABUF);
      const bf16_t* Bt = (const bf16_t*)(a.ws + (L == 0 ? WS_WIN0 : WS_WIN1));
      const int nN = L == 0 ? N_IN0 / 256 : N_IN1 / 256, nM = MT / 256;
      EpiG1 epi{EpiPlain{(bf16_t*)(a.ws + WS_QKVU), L == 0 ? N_QKV0 : N_IN1}, EpiPair<0>{(bf16_t*)(a.ws + WS_HG), 1024, N_QKV0}, L == 0 ? N_QKV0 : N_IN1};
      REP(2) for (int u = blockIdx.x; u < nM * nN; u += gridDim.x) { int pm, pn; dense_unit(u, nM, nN, pm, pn);
        gemm_tile<false>(A, D, nullptr, pm * 256, Bt, D, pn * 256, D, lds, epi); }
      SEAM(base + 0);
    }
    if (L == 0) {
      if (IN(3)) { FRESH_ARGS(); if ((PH_REPEAT_MASK >> 3) & 1u) { phase_rope_conv0(a, lds, true); __syncthreads(); } phase_rope_conv0(a, lds); SEAM(3); }
      if (IN(4)) { FRESH_ARGS(); REP(4) phase_attn(a, 0, lds); SEAM(4); }
    } else {
      if (IN(12)) { FRESH_ARGS(); if ((PH_REPEAT_MASK >> 12) & 1u) { phase_rope1(a, lds, true); __syncthreads(); } phase_rope1(a, lds); SEAM(12); }
      if (IN(13)) { FRESH_ARGS(); REP(13) phase_attn(a, 1, lds); SEAM(13); }
      if (IN(14)) { FRESH_ARGS(); REP(14) phase_diff(a); SEAM(14); }
    }
    const int b2 = L == 0 ? 5 : 15;
    if (IN(b2 + 0)) {
      FRESH_ARGS();
      const bf16_t* A = (const bf16_t*)(a.ws + WS_X2);
      const bf16_t* Bt = (const bf16_t*)(a.ws + (L == 0 ? WS_WOUT0 : WS_WOUT1));
      const int nN = D / 256, nM = L == 0 ? MT / 256 : SEQ / 256, r0 = L == 0 ? 0 : CTXL;
      EpiPlain epi{(bf16_t*)(a.ws + WS_OUT), D};
      REP(5) for (int u = blockIdx.x; u < nM * nN; u += gridDim.x) { int pm, pn; dense_unit(u, nM, nN, pm, pn);
        gemm_tile<false>(A, D, nullptr, r0 + pm * 256, Bt, D, pn * 256, D, lds, epi); }
      SEAM(b2 + 0);
    }
    if (IN(b2 + 1)) { FRESH_ARGS(); if ((PH_REPEAT_MASK >> 6) & 1u) { phase_G(a, L, lds, true); __syncthreads(); } phase_G(a, L, lds); SEAM(b2 + 1); }
    if (IN(b2 + 2)) { FRESH_ARGS(); REP(7) phase_H(a, L, lds); SEAM(b2 + 2); }
    if (IN(b2 + 3)) { FRESH_ARGS(); REP(8) phase_moe_up(a, L, lds); SEAM(b2 + 3); }
    if (IN(b2 + 4)) { FRESH_ARGS(); REP(9) phase_moe_down(a, L, lds); SEAM(b2 + 4); }
    if (IN(b2 + 5)) { FRESH_ARGS(); if ((PH_REPEAT_MASK >> 10) & 1u) phase_combine(a, L, true); phase_combine(a, L); SEAM(b2 + 5); }
  }
#undef IN
#undef SEAM
}

#ifndef MK_DIAG
#define MK_DIAG 0
#endif
#if MK_DIAG
__device__ __forceinline__ void rope_cs(int r, int lane, float& cs, float& sn) {
  cs = 1.f; sn = 0.f;
  if (r >= CTXL) { const int t = r - CTXL; const int a = lane >> 5, i = lane & 31;
    const float pos = a ? (float)(t & 63) : (float)(t >> 6);
    const float inv = powf(10000.f, -(float)i / 32.f);
    sincosf(pos * inv, &sn, &cs); }
}
__device__ __forceinline__ bool dclose(float got, float ref, float rtol, float atol) { return fabsf(got - ref) <= rtol * fabsf(ref) + atol; }
__device__ __forceinline__ unsigned dhash(unsigned x) { x ^= x >> 16; x *= 0x7feb352du; x ^= x >> 15; x *= 0x846ca68bu; x ^= x >> 16; return x; }
__device__ float wdot(const bf16_t* arow, const float* W, int ldw, int col, int K, int lane) {
  float s = 0; for (int k = lane; k < K; k += 64) s += bf2f(arow[k]) * W[(size_t)k * ldw + col]; return wave_sum(s); }
__device__ void dflag(int* dg, int s, int bad, int lane) { if (lane == 0 && bad) atomicAdd(&dg[s], bad); }
__device__ const float* h0row(const Args& a, int r) { return r < CTXL ? a.in[2] + (size_t)r * D : a.in[0] + (size_t)(r - CTXL) * D; }
__device__ int pick_row(unsigned h, int lo, int n) { const unsigned m = h % 8; if (m == 0) return lo; if (m == 1) return lo + n - 1; if (m == 2) return lo + 255 < lo + n ? lo + 255 : lo; if (m == 3) return lo + 256 < lo + n ? lo + 256 : lo; return lo + (int)((h >> 3) % (unsigned)n); }
__device__ void naive_attn(const bf16_t* q, const bf16_t* K, const bf16_t* V, int ld, int nkeys, int lane, float& o0, float& o1) {
  const float q0 = bf2f(q[lane]), q1 = bf2f(q[lane + 64]);
  float m = -1e30f, l = 0; o0 = 0; o1 = 0;
  for (int k = 0; k < nkeys; ++k) {
    const float s = wave_sum(q0 * bf2f(K[(size_t)k * ld + lane]) + q1 * bf2f(K[(size_t)k * ld + lane + 64])) * 0.088388347648318440f;
    const float mn = fmaxf(m, s), al = expf(m - mn), p = expf(s - mn);
    l = l * al + p; o0 = o0 * al + p * bf2f(V[(size_t)k * ld + lane]); o1 = o1 * al + p * bf2f(V[(size_t)k * ld + lane + 64]); m = mn;
  }
  o0 /= l; o1 /= l;
}
__global__ void __launch_bounds__(256) diag(Args a, int k) {
  __shared__ float fsh[4][2048];
  __shared__ float csh[4][64];
  const int lane = threadIdx.x & 63, wv = threadIdx.x >> 6, gw = blockIdx.x * 4 + wv;
  int* dg = (int*)(a.ws + WS_CTL + CTL_CNT + 512);
  const float* MOD = (const float*)(a.ws + WS_MOD);
  const bf16_t* AB = (const bf16_t*)(a.ws + WS_ABUF);
  const bf16_t* QK = (const bf16_t*)(a.ws + WS_QKVU);
  const bf16_t* HG = (const bf16_t*)(a.ws + WS_HG);
  const bf16_t* X2 = (const bf16_t*)(a.ws + WS_X2);
  const bf16_t* OUT = (const bf16_t*)(a.ws + WS_OUT);
  const bf16_t* ACT = (const bf16_t*)(a.ws + WS_ACT);
  const bf16_t* Y = (const bf16_t*)(a.ws + WS_Y);
  const float* HRES = (const float*)(a.ws + WS_HRES);
  const int* top_e = (const int*)(a.ws + WS_TOPE); const float* top_w = (const float*)(a.ws + WS_TOPW); const int* top_p = (const int*)(a.ws + WS_TOPP);
  const int* tslot = (const int*)(a.ws + WS_TSLOT); const int* stok = (const int*)(a.ws + WS_STOK);
  const unsigned h = dhash(gw * 7919u + k * 104729u + 17u), h2 = dhash(h + 12345u);
  int bad = 0;
  const int L = k >= 11 ? 1 : 0;
  const int NTOK = L == 0 ? MT : SEQ, ROW0 = L == 0 ? 0 : CTXL;
  const int* counts = (const int*)(a.ws + WS_CTL + CTL_CNT) + L * 64;
  if (k == 0) {
    const int LL = gw & 1, which = (gw >> 1) & 1, j = h % 12288;
    const float* v = which ? a.in[3] : a.in[1];
    float s = 0; for (int d = lane; d < D; d += 64) { const float x = v[d]; s += x * sigmoidf_(x) * a.in[4][((size_t)LL * D + d) * 12288 + j]; }
    s = wave_sum(s) + a.in[5][LL * 12288 + j];
    bad = !dclose(MOD[(LL * 2 + which) * 12288 + j], s, 1e-3f, 1e-3f); dflag(dg, 1, bad, lane);
  } else if (k == 1) {
    const int r = pick_row(h, 0, MT); const float* x = h0row(a, r); const float* mod = MOD + (r < CTXL ? 12288 : 0);
    float ss = 0; for (int d = lane; d < D; d += 64) ss += x[d] * x[d]; ss = wave_sum(ss); const float rstd = rsqrtf(ss / D + EPS);
    for (int d = lane; d < D; d += 64) { const float ref = x[d] * rstd * a.in[6][d] * (1.f + mod[D + d]) + mod[d]; bad += !dclose(bf2f(AB[(size_t)r * D + d]), ref, 0.01f, 0.01f); }
    bad = (int)wave_sum((float)bad); dflag(dg, 2, bad, lane);
  } else if (k == 2 || k == 11) {
    const int r = pick_row(h, 0, MT);
    if (L == 0) {
      const int c = h2 % N_QKV0; const float ref = wdot(AB + (size_t)r * D, a.in[7], N_IN0, c, D, lane);
      bad = !dclose(bf2f(QK[(size_t)r * N_QKV0 + c]), ref, 0.02f, 0.05f); dflag(dg, 3, bad, lane);
      const int ch = (h2 >> 11) % 1024; const float av = wdot(AB + (size_t)r * D, a.in[7], N_IN0, N_QKV0 + ch, D, lane), gv = wdot(AB + (size_t)r * D, a.in[7], N_IN0, N_QKV0 + 1024 + ch, D, lane);
      bad = !dclose(bf2f(HG[(size_t)r * 1024 + ch]), av * sigmoidf_(gv), 0.03f, 0.05f); dflag(dg, 4, bad, lane);
    } else {
      const int c = h2 % N_IN1; const float ref = wdot(AB + (size_t)r * D, a.in[15], N_IN1, c, D, lane);
      bad = !dclose(bf2f(QK[(size_t)r * N_IN1 + c]), ref, 0.02f, 0.05f); dflag(dg, 15, bad, lane);
    }
  } else if (k == 3) {
    { const int r = pick_row(h, 0, MT), hh = h2 % 10; const float* g = hh < 8 ? a.in[9] : a.in[10];
      float raw0 = 0, raw1 = 0;
      for (int d = 0; d < 128; ++d) { const float v = wdot(AB + (size_t)r * D, a.in[7], N_IN0, hh * 128 + d, D, lane); if (d == lane) raw0 = v; if (d == lane + 64) raw1 = v; }
      const float rstd = rsqrtf(wave_sum(raw0 * raw0 + raw1 * raw1) / 128.f + EPS);
      const float y0 = raw0 * rstd * g[lane], y1 = raw1 * rstd * g[lane + 64];
      float cs, sn; rope_cs(r, lane, cs, sn);
      const float cs0 = __shfl(cs, lane & 31), sn0 = __shfl(sn, lane & 31), cs1 = __shfl(cs, 32 + (lane & 31)), sn1 = __shfl(sn, 32 + (lane & 31));
      const float p0 = __shfl_xor(y0, 32), p1 = __shfl_xor(y1, 32);
      const float o0 = (lane < 32) ? y0 * cs0 - p0 * sn0 : y0 * cs0 + p0 * sn0;
      const float o1 = (lane < 32) ? y1 * cs1 - p1 * sn1 : y1 * cs1 + p1 * sn1;
      bad = !dclose(bf2f(QK[(size_t)r * N_QKV0 + hh * 128 + lane]), o0, 0.03f, 0.05f) + !dclose(bf2f(QK[(size_t)r * N_QKV0 + hh * 128 + 64 + lane]), o1, 0.03f, 0.05f);
      bad = (int)wave_sum((float)bad); dflag(dg, 5, bad, lane); }
    { const int r = pick_row(h2, 0, MT); const int seg0 = r < CTXL ? 0 : CTXL, seg1 = r < CTXL ? CTXL : MT;
      float cv[16]; float s1 = 0, s2 = 0;
      for (int q = 0; q < 16; ++q) { const int c = lane + 64 * q; float acc = a.in[12][c];
        for (int j = 0; j < 31; ++j) { const int rr = r + j - 15; if (rr >= seg0 && rr < seg1) acc += bf2f(HG[(size_t)rr * 1024 + c]) * a.in[11][j * 1024 + c]; }
        cv[q] = acc; s1 += acc; s2 += acc * acc; }
      s1 = wave_sum(s1); s2 = wave_sum(s2); const float mean = s1 / 1024.f, rstd = rsqrtf(s2 / 1024.f - mean * mean + EPS);
      bad = 0;
      for (int q = 0; q < 16; ++q) { const int c = lane + 64 * q; float y = (cv[q] - mean) * rstd * a.in[13][c] + a.in[14][c]; y = y * sigmoidf_(y);
        bad += !dclose(bf2f(X2[(size_t)r * D + 1024 + c]), y, 0.03f, 0.03f); }
      bad = (int)wave_sum((float)bad); dflag(dg, 6, bad, lane); }
  } else if (k == 4) {
    if (gw < 64) { const int r = pick_row(h, 0, MT), head = h2 % 8; const int nkeys = r < CTXL ? CTXL : MT;
      float o0, o1; naive_attn(QK + (size_t)r * N_QKV0 + head * 128, QK + 1024 + (head >> 2) * 128, QK + 1280 + (head >> 2) * 128, N_QKV0, nkeys, lane, o0, o1);
      bad = !dclose(bf2f(X2[(size_t)r * D + head * 128 + lane]), o0, 0.05f, 0.01f) + !dclose(bf2f(X2[(size_t)r * D + head * 128 + 64 + lane]), o1, 0.05f, 0.01f);
      bad = (int)wave_sum((float)bad); dflag(dg, 7, bad, lane); }
  } else if (k == 5 || k == 15) {
    const int r = pick_row(h, ROW0, NTOK), c = h2 % D; const float ref = wdot(X2 + (size_t)r * D, L == 0 ? a.in[8] : a.in[16], D, c, D, lane);
    bad = !dclose(bf2f(OUT[(size_t)r * D + c]), ref, 0.02f, 0.05f); dflag(dg, L == 0 ? 8 : 19, bad, lane);
  } else if (k == 6 || k == 16) {
    const int r = pick_row(h, ROW0, NTOK); const float* mod = MOD + (size_t)(L * 2) * 12288 + (r < CTXL ? 12288 : 0); const float* ng = a.in[6] + (size_t)L * 4 * D;
    float ss = 0; for (int d = lane; d < D; d += 64) { const float o = bf2f(OUT[(size_t)r * D + d]); ss += o * o; } ss = wave_sum(ss); const float rstd1 = rsqrtf(ss / D + EPS);
    bad = 0;
    if (L == 0) { const float* x = h0row(a, r); for (int d = lane; d < D; d += 64) { const float ref = x[d] + mod[2 * D + d] * (bf2f(OUT[(size_t)r * D + d]) * rstd1 * ng[D + d]); bad += !dclose(HRES[(size_t)r * D + d], ref, 1e-3f, 1e-3f); } }
    float s2 = 0; for (int d = lane; d < D; d += 64) { const float x = HRES[(size_t)r * D + d]; s2 += x * x; } s2 = wave_sum(s2); const float rstd2 = rsqrtf(s2 / D + EPS);
    for (int d = lane; d < D; d += 64) { const float f = HRES[(size_t)r * D + d] * rstd2 * ng[2 * D + d] * (1.f + mod[4 * D + d]) + mod[3 * D + d]; fsh[wv][d] = f; bad += !dclose(bf2f(AB[(size_t)r * D + d]), f, 0.01f, 0.01f); }
    bad = (int)wave_sum((float)bad); dflag(dg, L == 0 ? 9 : 20, bad, lane);
    __syncthreads();
    float lg = 0; for (int d = 0; d < D; ++d) lg += fsh[wv][d] * a.in[19][((size_t)L * D + d) * NE + lane];
    const float sc = sigmoidf_(lg); csh[wv][lane] = sc + a.in[20][L * NE + lane];
    __syncthreads();
    { const float plg = ((const float*)(a.ws + WS_Y))[(size_t)r * 64 + lane]; int lb = !dclose(plg, lg, 1e-3f, 1e-3f); lb = (int)wave_sum((float)lb); if (lane == 0 && lb) { atomicAdd(&dg[32 + (L == 0 ? 10 : 21) + 3], 1); atomicOr(&dg[60], 1 << (r & 7)); } }
    unsigned long long wsel;
    { const float choice = csh[wv][lane]; int rank = 0; const int gl = lane & 7;
      for (int j = 0; j < 8; ++j) { const float o = __shfl(choice, (lane & ~7) | j); rank += (o > choice || (o == choice && j < gl)) ? 1 : 0; }
      float gs = rank < 2 ? choice : 0.f; gs += __shfl_xor(gs, 1); gs += __shfl_xor(gs, 2); gs += __shfl_xor(gs, 4);
      int grank = 0; const int g = lane >> 3;
      for (int j = 0; j < 8; ++j) { const float o = __shfl(gs, j * 8); grank += (o > gs || (o == gs && j < g)) ? 1 : 0; }
      const bool gsel = grank < 4; const float mc = gsel ? choice : -INFINITY; int erank = 0;
      for (int j = 0; j < 64; ++j) { const float o = __shfl(mc, j); erank += (o > mc || (o == mc && j < lane)) ? 1 : 0; }
      wsel = __ballot(gsel && erank < 8); }
    int setbad = 0;
    if (lane == 0) {
      float gsc[8]; for (int g = 0; g < 8; ++g) { float m1 = -1e30f, m2 = -1e30f; for (int j = 0; j < 8; ++j) { const float v = csh[wv][g * 8 + j]; if (v > m1) { m2 = m1; m1 = v; } else if (v > m2) m2 = v; } gsc[g] = m1 + m2; }
      bool gs[8] = {false, false, false, false, false, false, false, false};
      for (int t = 0; t < 4; ++t) { int bi = 0; float bv = -1e30f; for (int g = 0; g < 8; ++g) if (!gs[g] && gsc[g] > bv) { bv = gsc[g]; bi = g; } gs[bi] = true; }
      unsigned long long selm = 0; for (int t = 0; t < 8; ++t) { int bi = 0; float bv = -1e30f; for (int e = 0; e < 64; ++e) if (gs[e >> 3] && !((selm >> e) & 1ull) && csh[wv][e] > bv) { bv = csh[wv][e]; bi = e; } selm |= 1ull << bi; }
      unsigned long long got = 0; for (int t = 0; t < 8; ++t) { const int e = top_e[r * 8 + t]; if (e < 0 || e > 63) setbad = 1000; else got |= 1ull << e; }
      if (setbad == 0 && got != selm) setbad = 1;
      if (wsel != selm) atomicAdd(&dg[32 + (L == 0 ? 10 : 21) + 4], 1);
    }
    setbad = __shfl(setbad, 0);
    { float wgot = -1.f; int mine = 0; for (int t = 0; t < 8; ++t) if (top_e[r * 8 + t] == lane) { mine = 1; wgot = top_w[r * 8 + t]; }
      const float ssum = wave_sum(mine ? sc : 0.f);
      int wbad = (mine && !dclose(wgot, sc / ssum * 2.5f, 0.01f, 1e-3f)) ? 1 : 0; wbad = (int)wave_sum((float)wbad);
      if (lane == 0) { int* q = &dg[32 + (L == 0 ? 10 : 21)]; if (setbad >= 1000) atomicAdd(q + 1, 1); else if (setbad) atomicAdd(q, 1); else if (wbad) atomicAdd(q + 2, 1); } }
  } else if (k == 7 || k == 17) {
    const int r = pick_row(h, ROW0, NTOK), t = h2 % 8, q = r * 8 + t; const int slot = tslot[q], e = top_e[q];
    int ts0 = 0; for (int j = 0; j < e; ++j) ts0 += (counts[j] + 255) >> 8;
    bad = (slot < ts0 * 256 || slot >= ts0 * 256 + counts[e] || stok[slot] != r || top_p[q] != slot - ts0 * 256) ? 1 : 0;
    bad += (stok[SH_BASE + r - ROW0] != r) ? 1 : 0;
    dflag(dg, L == 0 ? 11 : 22, bad, lane);
  } else if (k == 8 || k == 18 || k == 9 || k == 19) {
    int TR = 0; for (int j = 0; j < 64; ++j) TR += (counts[j] + 255) >> 8;
    int slot, e;
    if ((h & 3) == 0) { slot = SH_BASE + (int)((h >> 2) % (unsigned)NTOK); e = 64; }
    else { e = (h >> 2) % 64; int guard = 0; while (counts[e] == 0 && guard++ < 64) e = (e + 1) % 64; int ts0 = 0; for (int j = 0; j < e; ++j) ts0 += (counts[j] + 255) >> 8;
      const unsigned m = (h >> 8) % 4; const int cnt = counts[e]; const int p = m == 0 ? 0 : m == 1 ? cnt - 1 : (int)((h >> 10) % (unsigned)cnt); slot = ts0 * 256 + p; }
    const int tok = stok[slot];
    if (k == 8 || k == 18) {
      const int ch = h2 % EFF;
      const float* Wg = e < 64 ? a.in[21] + ((size_t)L * 64 + e) * D * EFF : a.in[24] + (size_t)L * D * EFF;
      const float* Wu = e < 64 ? a.in[22] + ((size_t)L * 64 + e) * D * EFF : a.in[25] + (size_t)L * D * EFF;
      const float gv = wdot(AB + (size_t)tok * D, Wg, EFF, ch, D, lane), uv = wdot(AB + (size_t)tok * D, Wu, EFF, ch, D, lane);
      bad = !dclose(bf2f(ACT[(size_t)slot * EFF + ch]), gv * sigmoidf_(gv) * uv, 0.03f, 0.03f); dflag(dg, L == 0 ? 12 : 23, bad, lane);
    } else {
      const int c = h2 % D; const float* Wd = e < 64 ? a.in[23] + ((size_t)L * 64 + e) * EFF * D : a.in[26] + (size_t)L * EFF * D;
      const float ref = wdot(ACT + (size_t)slot * EFF, Wd, D, c, EFF, lane);
      bad = !dclose(bf2f(Y[(size_t)slot * D + c]), ref, 0.02f, 0.03f); dflag(dg, L == 0 ? 13 : 24, bad, lane);
    }
  } else if (k == 10 || k == 20) {
    const int r = pick_row(h, ROW0, NTOK); const float* mod = MOD + (size_t)(L * 2) * 12288 + (r < CTXL ? 12288 : 0); const float* ng = a.in[6] + (size_t)L * 4 * D;
    float ss = 0; for (int d = lane; d < D; d += 64) { float y = bf2f(Y[(size_t)(SH_BASE + r - ROW0) * D + d]); for (int t = 0; t < 8; ++t) y += top_w[r * 8 + t] * bf2f(Y[(size_t)tslot[r * 8 + t] * D + d]); fsh[wv][d] = y; ss += y * y; }
    ss = wave_sum(ss); const float rstd = rsqrtf(ss / D + EPS);
    bad = 0;
    if (L == 0) { float s2 = 0; for (int d = lane; d < D; d += 64) { const float x = HRES[(size_t)r * D + d]; s2 += x * x; } s2 = wave_sum(s2); const float rstd2 = rsqrtf(s2 / D + EPS);
      const float* mod1 = MOD + (size_t)2 * 12288 + (r < CTXL ? 12288 : 0);
      for (int d = lane; d < D; d += 64) { const float ref = HRES[(size_t)r * D + d] * rstd2 * a.in[6][4 * D + d] * (1.f + mod1[D + d]) + mod1[d]; bad += !dclose(bf2f(AB[(size_t)r * D + d]), ref, 0.01f, 0.01f); } }
    else { for (int d = lane; d < D; d += 64) { const float ref = HRES[(size_t)r * D + d] + mod[5 * D + d] * (fsh[wv][d] * rstd * ng[3 * D + d]); bad += !dclose(a.out[(size_t)(r - CTXL) * D + d], ref, 1e-3f, 1e-3f); } }
    bad = (int)wave_sum((float)bad); dflag(dg, L == 0 ? 14 : 25, bad, lane);
  } else if (k == 12) {
    const int r = pick_row(h, CTXL, SEQ), hh = h2 % 32;
    float raw0 = 0, raw1 = 0;
    for (int d = 0; d < 128; ++d) { const float v = wdot(AB + (size_t)r * D, a.in[15], N_IN1, hh * 128 + d, D, lane); if (d == lane) raw0 = v; if (d == lane + 64) raw1 = v; }
    float cs, sn; rope_cs(r, lane, cs, sn);
    const float cs0 = __shfl(cs, lane & 31), sn0 = __shfl(sn, lane & 31), cs1 = __shfl(cs, 32 + (lane & 31)), sn1 = __shfl(sn, 32 + (lane & 31));
    const float p0 = __shfl_xor(raw0, 32), p1 = __shfl_xor(raw1, 32);
    const float o0 = (lane < 32) ? raw0 * cs0 - p0 * sn0 : raw0 * cs0 + p0 * sn0;
    const float o1 = (lane < 32) ? raw1 * cs1 - p1 * sn1 : raw1 * cs1 + p1 * sn1;
    bad = !dclose(bf2f(QK[(size_t)r * N_IN1 + hh * 128 + lane]), o0, 0.03f, 0.05f) + !dclose(bf2f(QK[(size_t)r * N_IN1 + hh * 128 + 64 + lane]), o1, 0.03f, 0.05f);
    bad = (int)wave_sum((float)bad); dflag(dg, 16, bad, lane);
  } else if (k == 13) {
    if (gw < 64) { const int r = pick_row(h, CTXL, SEQ), hc = h2 % 16, vh = (h2 >> 4) & 1, hd = hc >> 1;
      float o0, o1; naive_attn(QK + (size_t)r * N_IN1 + hc * 128, QK + 2048 + hc * 128, QK + 4096 + hd * 256 + vh * 128, N_IN1, MT, lane, o0, o1);
      const bf16_t* O = Y + (size_t)(r - CTXL) * 4096 + hc * 256 + vh * 128;
      bad = !dclose(bf2f(O[lane]), o0, 0.05f, 0.01f) + !dclose(bf2f(O[64 + lane]), o1, 0.05f, 0.01f);
      bad = (int)wave_sum((float)bad); dflag(dg, 17, bad, lane); }
  } else if (k == 14) {
    const int r = pick_row(h, CTXL, SEQ), hd = h2 % 8; const float* lp = a.in[17];
    float s1 = 0, s2 = 0; for (int i = lane; i < 128; i += 64) { s1 += lp[i] * lp[128 + i]; s2 += lp[256 + i] * lp[384 + i]; } s1 = wave_sum(s1); s2 = wave_sum(s2);
    const float lam = expf(s1) - expf(s2) + LAM_INIT; const bf16_t* O = Y + (size_t)(r - CTXL) * 4096;
    float dv[4], ss = 0; for (int i = 0; i < 4; ++i) { const int d = lane + 64 * i; dv[i] = bf2f(O[(2 * hd) * 256 + d]) - lam * bf2f(O[(2 * hd + 1) * 256 + d]); ss += dv[i] * dv[i]; }
    ss = wave_sum(ss); const float rstd = rsqrtf(ss / 256.f + EPS) * (1.f - LAM_INIT); bad = 0;
    for (int i = 0; i < 4; ++i) { const int d = lane + 64 * i; bad += !dclose(bf2f(X2[(size_t)r * D + hd * 256 + d]), dv[i] * rstd * a.in[18][d], 0.02f, 0.01f); }
    bad = (int)wave_sum((float)bad); dflag(dg, 18, bad, lane);
  }
}
__global__ void diag_encode(Args a) {
  const int* dg = (const int*)(a.ws + WS_CTL + CTL_CNT + 512);
  int s = 0;
  int sub = 0;
  for (int i = 1; i < 32; ++i) { int v = dg[i]; if (i == 10 || i == 21) { v = (dg[32 + i] > 25 ? 1 : 0) + (dg[33 + i] > 0 ? 2 : 0) + (dg[34 + i] > 0 ? 4 : 0) + (dg[35 + i] > 0 ? 8 : 0) + (dg[36 + i] > 0 ? 16 : 0); sub = v; } if (v) { s = i; break; } }
  if (s == 0) return;
  const float c = sub ? 30.f + 8.f * sub : 10.f * s;
  for (size_t i = (size_t)blockIdx.x * blockDim.x + threadIdx.x; i < (size_t)SEQ * D; i += (size_t)gridDim.x * blockDim.x) a.out[i] = c;
}
#endif

extern "C" void kernel_launch(void* const* d_in, const int* in_sizes, int n_in, void* d_out, int out_size, void* d_ws, size_t ws_size, hipStream_t stream) {
  static int grid = 0;
  if (grid == 0) {
    if (n_in != 27 || out_size != SEQ * D || ws_size < WS_END) { fprintf(stderr, "kernel_launch: unexpected shapes (n_in %d out %d ws %zu need %zu)\n", n_in, out_size, ws_size, (size_t)WS_END); grid = -1; return; }
    if (hipFuncSetAttribute((const void*)fwd, hipFuncAttributeMaxDynamicSharedMemorySize, LDS_BYTES) != hipSuccess) { fprintf(stderr, "kernel_launch: hipFuncSetAttribute failed\n"); grid = -1; return; }
    int dev = 0, cus = 0, per_cu = 0;
    hipGetDevice(&dev); hipDeviceGetAttribute(&cus, hipDeviceAttributeMultiprocessorCount, dev);
    if (hipOccupancyMaxActiveBlocksPerMultiprocessor(&per_cu, (const void*)fwd, NTHREADS, LDS_BYTES) != hipSuccess || per_cu < 1) fprintf(stderr, "kernel_launch: occupancy query says %d\n", per_cu);
    (void)hipGetLastError();
    grid = cus < 256 ? cus : 256;
    if (grid != 256) fprintf(stderr, "kernel_launch: %d CUs (expected 256)\n", cus);
  }
  if (grid < 0) return;
  hipMemsetAsync((char*)d_ws + WS_CTL, 0, CTL_BYTES, stream);
  Args a{};
  for (int i = 0; i < 27; ++i) a.in[i] = (const float*)d_in[i];
  a.out = (float*)d_out; a.ws = (unsigned char*)d_ws;
#if MK_MULTI
  for (int k = 0; k < NPH; ++k) { a.ph_lo = k; a.ph_hi = k + 1; hipLaunchKernelGGL(fwd, dim3(grid), dim3(NTHREADS), LDS_BYTES, stream, a);
#if MK_DIAG
    hipLaunchKernelGGL(diag, dim3(64), dim3(256), 0, stream, a, k);
#endif
  }
#if MK_DIAG
  hipLaunchKernelGGL(diag_encode, dim3(1024), dim3(256), 0, stream, a);
#endif
#else
  a.ph_lo = 0; a.ph_hi = NPH;
  hipLaunchKernelGGL(fwd, dim3(grid), dim3(NTHREADS), LDS_BYTES, stream, a);
#endif
  const hipError_t le = hipPeekAtLastError();
  if (le != hipSuccess) fprintf(stderr, "kernel_launch: launch failed: %s\n", hipGetErrorName(le));
}
```

```cpp
#include <hip/hip_runtime.h>
#include <cstdio>
#include <cstdint>

#define MK_DIAG 0
#ifndef MK_MULTI
#define MK_MULTI 0
#endif

#define LAS __attribute__((address_space(3)))
typedef unsigned short bf16_t;
typedef short bf16x8 __attribute__((ext_vector_type(8)));
typedef short s16x4 __attribute__((ext_vector_type(4)));
typedef float f32x4 __attribute__((ext_vector_type(4)));
typedef float f32x2 __attribute__((ext_vector_type(2)));
typedef float f32x16 __attribute__((ext_vector_type(16)));
typedef unsigned u32x4 __attribute__((ext_vector_type(4)));
typedef unsigned u32x2 __attribute__((ext_vector_type(2)));

constexpr int D = 2048, SEQ = 16384, CTXL = 256, MT = SEQ + CTXL;
constexpr int NE = 64, TOPK = 8, EFF = 512;
constexpr int N_IN0 = 3584, N_QKV0 = 1536, N_IN1 = 6144;
constexpr float EPS = 1e-6f;
constexpr float LAM_INIT = 0.35550907f;
constexpr int SH_BASE = SEQ * 0 + (MT * TOPK) + NE * 256;
constexpr int NSLOT = SH_BASE + MT;
constexpr int NTHREADS = 512;
constexpr int LDS_BYTES = 131072 + 1024;
constexpr int LDS_CTL = 131072;

constexpr size_t al256(size_t x) { return (x + 255) & ~(size_t)255; }
constexpr size_t WS_CTL   = 0;
constexpr size_t CTL_BYTES = 32768;
constexpr size_t CTL_CNT  = 16384;
constexpr size_t CTL_KMAX = 16384 + 2048;
constexpr size_t WS_MOD   = CTL_BYTES;
constexpr size_t WS_WIN0  = al256(WS_MOD + 2 * 2 * 12288 * 4);
constexpr size_t WS_WOUT0 = al256(WS_WIN0 + (size_t)N_IN0 * D * 2);
constexpr size_t WS_WIN1  = al256(WS_WOUT0 + (size_t)D * D * 2);
constexpr size_t WS_WOUT1 = al256(WS_WIN1 + (size_t)N_IN1 * D * 2);
constexpr size_t WMOE_E   = (size_t)1024 * D + (size_t)D * EFF;
constexpr size_t WS_WMOE  = al256(WS_WOUT1 + (size_t)D * D * 2);
constexpr size_t WS_HRES  = al256(WS_WMOE + 65 * WMOE_E * 2);
constexpr size_t WS_ABUF  = al256(WS_HRES + (size_t)MT * D * 4);
constexpr size_t WS_QKVU  = al256(WS_ABUF + (size_t)MT * D * 2);
constexpr size_t WS_HG    = al256(WS_QKVU + (size_t)MT * N_IN1 * 2);
constexpr size_t WS_X2    = al256(WS_HG + (size_t)MT * 1024 * 2);
constexpr size_t WS_OUT   = al256(WS_X2 + (size_t)MT * D * 2);
constexpr size_t WS_ACT   = al256(WS_OUT + (size_t)MT * D * 2);
constexpr size_t WS_Y     = al256(WS_ACT + (size_t)NSLOT * EFF * 2);
constexpr size_t WS_TOPE  = al256(WS_Y + (size_t)NSLOT * D * 2);
constexpr size_t WS_TOPW  = al256(WS_TOPE + (size_t)MT * TOPK * 4);
constexpr size_t WS_TOPP  = al256(WS_TOPW + (size_t)MT * TOPK * 4);
constexpr size_t WS_TSLOT = al256(WS_TOPP + (size_t)MT * TOPK * 4);
constexpr size_t WS_STOK  = al256(WS_TSLOT + (size_t)MT * TOPK * 4);
constexpr size_t WS_END   = al256(WS_STOK + (size_t)NSLOT * 4);

struct Args { const float* in[27]; float* out; unsigned char* ws; int ph_lo, ph_hi; };

__device__ __forceinline__ float bflo(unsigned x) { return __uint_as_float(x << 16); }
__device__ __forceinline__ float bfhi(unsigned x) { return __uint_as_float(x & 0xffff0000u); }
__device__ __forceinline__ float bf2f(bf16_t b) { return __uint_as_float(((unsigned)b) << 16); }
__device__ __forceinline__ unsigned cvtpk(float lo, float hi) { unsigned r; asm("v_cvt_pk_bf16_f32 %0, %1, %2" : "=v"(r) : "v"(lo), "v"(hi)); return r; }
__device__ __forceinline__ bf16_t f2bf(float x) { return (bf16_t)(cvtpk(x, 0.f) & 0xffffu); }
__device__ __forceinline__ float wave_sum(float v) {
#pragma unroll
  for (int o = 32; o; o >>= 1) v += __shfl_xor(v, o);
  return v;
}
__device__ __forceinline__ float sigmoidf_(float x) { return 1.f / (1.f + expf(-x)); }

#define XB_TMO      128
#define XB_XCNT(j)  (256  + 64 * (j))
#define XB_XSUB(j)  (1280 + 64 * (j))
#define XB_XGEN(j)  (2304 + 64 * (j))
#define XB_TOP      3328
#define XB_TOPGEN   3392
#define XCD_BAR_WORDS 3456
#define XB_SPIN_CAP (1u << 22)
__device__ __forceinline__ unsigned xb_ld(unsigned* p)              { return __hip_atomic_load(p, __ATOMIC_RELAXED, __HIP_MEMORY_SCOPE_AGENT); }
__device__ __forceinline__ unsigned xb_add(unsigned* p, unsigned v) { return __hip_atomic_fetch_add(p, v, __ATOMIC_RELAXED, __HIP_MEMORY_SCOPE_AGENT); }
__device__ __forceinline__ unsigned xb_xcc_id() { return (unsigned)__builtin_amdgcn_s_getreg((3 << 11) | 20) & 0xFu; }
#define XB_SPIN(cond, bar) do { unsigned _sp = 0; while (cond) { __builtin_amdgcn_s_sleep(1); \
    if ((++_sp & 255u) == 0u) { if (xb_ld(&(bar)[XB_TMO])) break; if (_sp > XB_SPIN_CAP) { atomicAdd(&(bar)[XB_TMO], 1u); break; } } } } while (0)
struct XcdBarrier { unsigned* bar; unsigned x; volatile LAS unsigned* st; };
__device__ __forceinline__ XcdBarrier xcd_barrier_post(unsigned* bar, volatile LAS unsigned* st) {
    XcdBarrier b; b.bar = bar; b.x = xb_xcc_id(); b.st = st;
    if (threadIdx.x == 0) (void)xb_add(&bar[XB_XCNT(b.x)], 1u);
    return b;
}
__device__ __forceinline__ void xcd_barrier_complete(unsigned* bar, unsigned x, unsigned& nloc, unsigned& nx) {
    const unsigned G = gridDim.x * gridDim.y * gridDim.z;
    unsigned sum, cnt, mine, sp = 0u;
    for (;;) {
        sum = 0u; cnt = 0u; mine = 0u;
#pragma unroll
        for (unsigned j = 0; j < 16; ++j) { const unsigned c = xb_ld(&bar[XB_XCNT(j)]); sum += c; cnt += (c > 0u) ? 1u : 0u; mine = (j == x) ? c : mine; }
        if (sum == G) break;
        __builtin_amdgcn_s_sleep(1);
        if ((++sp & 255u) == 0u) { if (xb_ld(&bar[XB_TMO])) break; if (sp > XB_SPIN_CAP) { atomicAdd(&bar[XB_TMO], 1u); break; } }
    }
    nloc = mine > 0u ? mine : 1u; nx = cnt > 0u ? cnt : 1u;
}
__device__ __forceinline__ void xcd_barrier(const XcdBarrier& b) {
    asm volatile("s_waitcnt vmcnt(0)" ::: "memory");
    __syncthreads();
    if (threadIdx.x == 0) {
        unsigned* bar = b.bar;
        __builtin_amdgcn_s_waitcnt(0);
        unsigned nloc = b.st[0], nx = b.st[1];
        if (nloc == 0u) { xcd_barrier_complete(bar, b.x, nloc, nx); b.st[0] = nloc; b.st[1] = nx; }
        const unsigned old = xb_add(&bar[XB_XSUB(b.x)], 1u);
        const unsigned gen = old / nloc;
        if (old + 1u == (gen + 1u) * nloc) {
            __builtin_amdgcn_fence(__ATOMIC_RELEASE, "agent");
            asm volatile("s_waitcnt vmcnt(0)" ::: "memory");
            const unsigned og = xb_add(&bar[XB_TOP], 1u);
            const unsigned tg = og / nx;
            if (og + 1u == (tg + 1u) * nx) xb_add(&bar[XB_TOPGEN], 1u);
            else XB_SPIN(xb_ld(&bar[XB_TOPGEN]) == tg, bar);
            __builtin_amdgcn_fence(__ATOMIC_ACQUIRE, "agent");
            xb_add(&bar[XB_XGEN(b.x)], 1u);
            asm volatile("s_waitcnt vmcnt(0)" ::: "memory");
        } else {
            XB_SPIN(xb_ld(&bar[XB_XGEN(b.x)]) == gen, bar);
            __builtin_amdgcn_fence(__ATOMIC_ACQUIRE, "agent");
            asm volatile("s_waitcnt vmcnt(0)" ::: "memory");
        }
    }
    __syncthreads();
}

__device__ __forceinline__ int lds_byte(int r, int c) {
  int st = (r >> 4) * 2 + (c >> 5), rr = r & 15, cc = c & 31, ob = rr * 64 + cc * 2;
  return st * 1024 + (ob ^ (((ob >> 9) & 1) << 5));
}
#define GLDS(gp, lp) __builtin_amdgcn_global_load_lds((const unsigned*)(gp), (LAS unsigned*)(lp), 16, 0, 0)
#define WAIT_V(n) asm volatile("s_waitcnt vmcnt(" #n ")" ::: "memory")
#define WAIT_L(n) asm volatile("s_waitcnt lgkmcnt(" #n ")" ::: "memory")
#define BAR __builtin_amdgcn_s_barrier()
#define SCHED __builtin_amdgcn_sched_barrier(0)

template <bool GATHER, class Epi>
__device__ __forceinline__ void gemm_tile(const bf16_t* __restrict__ A, const int lda, const int* __restrict__ tok, const int brow,
                                          const bf16_t* __restrict__ Bt, const int ldb, const int bcol, const int K,
                                          LAS char* shm, const Epi& epi) {
#define G_SA(b, h) (shm + ((b) * 2 + (h)) * 16384)
#define G_SB(b, h) (shm + (4 + (b) * 2 + (h)) * 16384)
  int tid = threadIdx.x; asm volatile("" : "+v"(tid)); tid &= 511;
  int wid = tid >> 6, lane = tid & 63, wr = wid >> 2, wc = wid & 3, fr = lane & 15, fq = lane >> 4;
  unsigned ao0, ao1, ao2, ao3, bo;
  {
    const int sb = (tid & 63) * 16, swz = sb ^ (((sb >> 9) & 1) << 5);
    const int R0 = ((tid >> 6) >> 1) * 16 + (swz >> 6), C0 = ((tid >> 6) & 1) * 32 + ((swz & 63) >> 1);
    if (GATHER) { ao0 = (unsigned)(tok[R0] * lda + C0); ao1 = (unsigned)(tok[R0 + 64] * lda + C0); ao2 = (unsigned)(tok[R0 + 128] * lda + C0); ao3 = (unsigned)(tok[R0 + 192] * lda + C0); }
    else { ao0 = (unsigned)((brow + R0) * lda + C0); ao1 = ao0 + 64u * lda; ao2 = ao0 + 128u * lda; ao3 = ao0 + 192u * lda; }
    bo = (unsigned)((bcol + R0) * ldb + C0);
  }
  const int lo = __builtin_amdgcn_readfirstlane(tid >> 6) * 1024;
#define STAGE_A0(P, kt) do { GLDS((A + (kt) * 64) + ao0, (P) + lo); GLDS((A + (kt) * 64) + ao1, (P) + lo + 8192); } while (0)
#define STAGE_A1(P, kt) do { GLDS((A + (kt) * 64) + ao2, (P) + lo); GLDS((A + (kt) * 64) + ao3, (P) + lo + 8192); } while (0)
#define STAGE_B0(P, kt) do { GLDS((Bt + (kt) * 64) + bo, (P) + lo); GLDS((Bt + 64 * ldb + (kt) * 64) + bo, (P) + lo + 8192); } while (0)
#define STAGE_B1(P, kt) do { GLDS((Bt + 128 * ldb + (kt) * 64) + bo, (P) + lo); GLDS((Bt + 192 * ldb + (kt) * 64) + bo, (P) + lo + 8192); } while (0)
#define LDA(dst, b, h) _Pragma("unroll") for (int m = 0; m < 4; ++m) _Pragma("unroll") for (int k = 0; k < 2; ++k) \
    dst[m][k] = *(LAS const bf16x8*)(G_SA(b, h) + lds_byte(wr * 64 + m * 16 + fr, k * 32 + fq * 8))
#define LDB(dst, b, h) _Pragma("unroll") for (int n = 0; n < 2; ++n) _Pragma("unroll") for (int k = 0; k < 2; ++k) \
    dst[n][k] = *(LAS const bf16x8*)(G_SB(b, h) + lds_byte(wc * 32 + n * 16 + fr, k * 32 + fq * 8))
#define MMA(ai, bj, At_, Bt_) do { __builtin_amdgcn_s_setprio(1); \
    _Pragma("unroll") for (int m = 0; m < 4; ++m) _Pragma("unroll") for (int n = 0; n < 2; ++n) _Pragma("unroll") for (int k = 0; k < 2; ++k) \
      acc[ai][bj][m][n] = __builtin_amdgcn_mfma_f32_16x16x32_bf16(Bt_[n][k], At_[m][k], acc[ai][bj][m][n], 0, 0, 0); \
    __builtin_amdgcn_s_setprio(0); } while (0)

  f32x4 acc[2][2][4][2] = {};
  bf16x8 At[4][2], B0[2][2], B1[2][2];
  const int nt = K / 64;
  STAGE_B0(G_SB(0, 0), 0); STAGE_A0(G_SA(0, 0), 0);
  STAGE_B1(G_SB(0, 1), 0); STAGE_A1(G_SA(0, 1), 0);
  if (wr == 1) BAR;
  WAIT_V(4); BAR;
  STAGE_B0(G_SB(1, 0), 1); STAGE_A0(G_SA(1, 0), 1); STAGE_B1(G_SB(1, 1), 1);
  WAIT_V(6); BAR;
  for (int t = 0; t < nt - 2; t += 2) {
    LDB(B0, 0, 0); SCHED; LDA(At, 0, 0); STAGE_A1(G_SA(1, 1), t + 1);
    WAIT_L(8); BAR; WAIT_L(0); MMA(0, 0, At, B0); BAR; SCHED;
    LDB(B1, 0, 1); STAGE_B0(G_SB(0, 0), t + 2);
    BAR; WAIT_L(0); MMA(0, 1, At, B1); BAR;
    LDA(At, 0, 1); STAGE_A0(G_SA(0, 0), t + 2);
    BAR; WAIT_L(0); MMA(1, 0, At, B0); BAR; SCHED;
    STAGE_B1(G_SB(0, 1), t + 2);
    WAIT_V(6); BAR; MMA(1, 1, At, B1); BAR;
    LDB(B0, 1, 0); SCHED; LDA(At, 1, 0); STAGE_A1(G_SA(0, 1), t + 2);
    WAIT_L(8); BAR; WAIT_L(0); MMA(0, 0, At, B0); BAR; SCHED;
    LDB(B1, 1, 1); STAGE_B0(G_SB(1, 0), t + 3);
    BAR; WAIT_L(0); MMA(0, 1, At, B1); BAR;
    LDA(At, 1, 1); STAGE_A0(G_SA(1, 0), t + 3);
    BAR; WAIT_L(0); MMA(1, 0, At, B0); BAR; SCHED;
    STAGE_B1(G_SB(1, 1), t + 3);
    WAIT_V(6); BAR; MMA(1, 1, At, B1); BAR;
  }
  { LDB(B0, 0, 0); WAIT_V(0); LDA(At, 0, 0); STAGE_A1(G_SA(1, 1), nt - 1);
    BAR; WAIT_L(0); MMA(0, 0, At, B0); BAR;
    LDB(B1, 0, 1); BAR; WAIT_L(0); MMA(0, 1, At, B1); BAR;
    LDA(At, 0, 1); WAIT_V(4); BAR; WAIT_L(0); MMA(1, 0, At, B0); MMA(1, 1, At, B1); BAR; }
  { LDB(B0, 1, 0); LDA(At, 1, 0); WAIT_V(2); BAR; WAIT_L(0); MMA(0, 0, At, B0); BAR;
    LDB(B1, 1, 1); WAIT_V(0); BAR; WAIT_L(0); MMA(0, 1, At, B1); BAR;
    LDA(At, 1, 1); BAR; WAIT_L(0); MMA(1, 0, At, B0); MMA(1, 1, At, B1); BAR; }
  if (wr == 0) BAR;
  int tz = threadIdx.x; asm volatile("" : "+v"(tz)); wid = tz >> 6; lane = tz & 63; wr = wid >> 2; wc = wid & 3; fr = lane & 15; fq = lane >> 4;
  epi(acc, brow, bcol, wr, wc, fr, fq);
#undef G_SA
#undef G_SB
#undef STAGE_A0
#undef STAGE_A1
#undef STAGE_B0
#undef STAGE_B1
#undef LDA
#undef LDB
#undef MMA
}

struct EpiPlain {
  bf16_t* C; int ldc;
  __device__ __forceinline__ void operator()(const f32x4 (&acc)[2][2][4][2], int brow, int bcol, int wr, int wc, int fr, int fq) const {
#pragma unroll
    for (int ai = 0; ai < 2; ++ai)
#pragma unroll
      for (int m = 0; m < 4; ++m) {
        bf16_t* rp = C + (size_t)(brow + ai * 128 + wr * 64 + m * 16 + fr) * ldc + bcol + wc * 32 + fq * 8;
#pragma unroll
        for (int bj = 0; bj < 2; ++bj) {
          u32x4 v = {cvtpk(acc[ai][bj][m][0][0], acc[ai][bj][m][0][1]), cvtpk(acc[ai][bj][m][0][2], acc[ai][bj][m][0][3]),
                     cvtpk(acc[ai][bj][m][1][0], acc[ai][bj][m][1][1]), cvtpk(acc[ai][bj][m][1][2], acc[ai][bj][m][1][3])};
          *(u32x4*)(rp + bj * 128) = v;
        }
      }
  }
};
template <int MODE>
struct EpiPair {
  bf16_t* C; int ldc; int colbase;
  __device__ __forceinline__ void operator()(const f32x4 (&acc)[2][2][4][2], int brow, int bcol, int wr, int wc, int fr, int fq) const {
#pragma unroll
    for (int ai = 0; ai < 2; ++ai)
#pragma unroll
      for (int m = 0; m < 4; ++m) {
        bf16_t* rp = C + (size_t)(brow + ai * 128 + wr * 64 + m * 16 + fr) * ldc + ((bcol - colbase) >> 1) + wc * 16 + fq * 4;
#pragma unroll
        for (int bj = 0; bj < 2; ++bj) {
          float r[4];
#pragma unroll
          for (int j = 0; j < 4; ++j) {
            const float x0 = acc[ai][bj][m][0][j], x1 = acc[ai][bj][m][1][j];
            r[j] = MODE == 0 ? x0 * sigmoidf_(x1) : x0 * sigmoidf_(x0) * x1;
          }
          u32x2 v = {cvtpk(r[0], r[1]), cvtpk(r[2], r[3])};
          *(u32x2*)(rp + bj * 64) = v;
        }
      }
  }
};
struct EpiG1 {
  EpiPlain p; EpiPair<0> g; int nplain;
  __device__ __forceinline__ void operator()(const f32x4 (&acc)[2][2][4][2], int brow, int bcol, int wr, int wc, int fr, int fq) const {
    if (bcol < nplain) p(acc, brow, bcol, wr, wc, fr, fq); else g(acc, brow, bcol, wr, wc, fr, fq);
  }
};

typedef int v8i __attribute__((ext_vector_type(8)));
typedef int v4i __attribute__((ext_vector_type(4)));
__device__ __forceinline__ int lds8(int r, int c) { return r * 128 + ((c ^ ((r >> 1) & 7)) << 4); }
template <bool GATHER, int lda, int ldb, int K, class Epi, class S>
__device__ __forceinline__ void gemm8_run(const unsigned char* __restrict__ A, const int* __restrict__ stok,
                                          LAS char* shm, const Epi& epi, const S& sched) {
#define G_SA(b, h) (shm + ((b) * 2 + (h)) * 16384)
#define G_SB(b, h) (shm + (4 + (b) * 2 + (h)) * 16384)
  int tid = threadIdx.x; asm volatile("" : "+v"(tid)); tid &= 511;
  int wid = tid >> 6, lane = tid & 63, wr = wid >> 2, wc = wid & 3, fr = lane & 15, fq = lane >> 4;
  unsigned ao0, ao1, ao2, ao3, bo;
  int R0 = 8 * wid + (lane >> 3), C0 = ((lane & 7) ^ ((R0 >> 1) & 7)) << 4;
  const int lo = __builtin_amdgcn_readfirstlane(tid >> 6) * 1024;
  int brow, bcol; const unsigned char* Bt;
  int ui = 0;
  if (!sched.unit(ui, brow, Bt, bcol)) return;
#define SETOFF(br, bc) do { if (GATHER) { const int* _t = stok + (br); ao0 = (unsigned)(_t[R0] * lda + C0); ao1 = (unsigned)(_t[R0 + 64] * lda + C0); ao2 = (unsigned)(_t[R0 + 128] * lda + C0); ao3 = (unsigned)(_t[R0 + 192] * lda + C0); } \
    else { ao0 = (unsigned)(((br) + R0) * lda + C0); ao1 = ao0 + 64u * lda; ao2 = ao0 + 128u * lda; ao3 = ao0 + 192u * lda; } \
    bo = (unsigned)(((bc) + R0) * ldb + C0); } while (0)
#define STAGE_A0(P, kt) do { GLDS((A + (kt) * 128) + ao0, (P) + lo); GLDS((A + (kt) * 128) + ao1, (P) + lo + 8192); } while (0)
#define STAGE_A1(P, kt) do { GLDS((A + (kt) * 128) + ao2, (P) + lo); GLDS((A + (kt) * 128) + ao3, (P) + lo + 8192); } while (0)
#define STAGE_B0(P, kt) do { GLDS((Bt + (kt) * 128) + bo, (P) + lo); GLDS((Bt + 64 * ldb + (kt) * 128) + bo, (P) + lo + 8192); } while (0)
#define STAGE_B1(P, kt) do { GLDS((Bt + 128 * ldb + (kt) * 128) + bo, (P) + lo); GLDS((Bt + 192 * ldb + (kt) * 128) + bo, (P) + lo + 8192); } while (0)
#define PRO() do { STAGE_B0(G_SB(0, 0), 0); STAGE_A0(G_SA(0, 0), 0); STAGE_B1(G_SB(0, 1), 0); STAGE_A1(G_SA(0, 1), 0); } while (0)
  const int fx = (fq ^ ((fr >> 1) & 7)) << 4;
  const int fa0 = (wr * 64 + fr) * 128 + fx, fb0 = (wc * 32 + fr) * 128 + fx;
#define FRAG8(dst, p0, p1) do { const v4i _x = *(LAS const v4i*)(p0); const v4i _y = *(LAS const v4i*)(p1); \
    dst = (v8i){_x[0], _x[1], _x[2], _x[3], _y[0], _y[1], _y[2], _y[3]}; } while (0)
#define LDA(dst, b, h) do { int fa1 = fa0; asm volatile("v_xor_b32 %0, 64, %0" : "+v"(fa1)); \
    _Pragma("unroll") for (int m = 0; m < 4; ++m) FRAG8(dst[m], G_SA(b, h) + fa0 + m * 2048, G_SA(b, h) + fa1 + m * 2048); } while (0)
#define LDB(dst, b, h) do { int fb1 = fb0; asm volatile("v_xor_b32 %0, 64, %0" : "+v"(fb1)); \
    _Pragma("unroll") for (int n = 0; n < 2; ++n) FRAG8(dst[n], G_SB(b, h) + fb0 + n * 2048, G_SB(b, h) + fb1 + n * 2048); } while (0)
#define MMA(ai, bj, At_, Bt_) do { __builtin_amdgcn_s_setprio(1); \
    _Pragma("unroll") for (int m = 0; m < 4; ++m) _Pragma("unroll") for (int n = 0; n < 2; ++n) \
      asm volatile("v_mfma_scale_f32_16x16x128_f8f6f4 %0, %1, %2, %0, %3, %3 op_sel_hi:[0,0,0]" : "+v"(acc[ai][bj][m][n]) : "v"(Bt_[n]), "v"(At_[m]), "v"(sc1)); \
    __builtin_amdgcn_s_setprio(0); } while (0)
  int sc1; asm volatile("v_mov_b32 %0, 0x7f7f7f7f" : "=v"(sc1));
  const int nt = K / 128;
  SETOFF(brow, bcol); PRO();
  bool first = true;
  for (;;) {
    f32x4 acc[2][2][4][2] = {};
    v8i At[4], B0[2], B1[2];
    if (wr == 1) BAR;
    if (first) WAIT_V(4); else WAIT_V(0);
    BAR;
    STAGE_B0(G_SB(1, 0), 1); STAGE_A0(G_SA(1, 0), 1); STAGE_B1(G_SB(1, 1), 1);
    WAIT_V(6); BAR;
    for (int t = 0; t < nt - 2; t += 2) {
      LDB(B0, 0, 0); SCHED; LDA(At, 0, 0); STAGE_A1(G_SA(1, 1), t + 1);
      WAIT_L(8); BAR; WAIT_L(0); MMA(0, 0, At, B0); BAR; SCHED;
      LDB(B1, 0, 1); STAGE_B0(G_SB(0, 0), t + 2);
      BAR; WAIT_L(0); MMA(0, 1, At, B1); BAR;
      LDA(At, 0, 1); STAGE_A0(G_SA(0, 0), t + 2);
      BAR; WAIT_L(0); MMA(1, 0, At, B0); BAR; SCHED;
      STAGE_B1(G_SB(0, 1), t + 2);
      WAIT_V(6); BAR; MMA(1, 1, At, B1); BAR;
      LDB(B0, 1, 0); SCHED; LDA(At, 1, 0); STAGE_A1(G_SA(0, 1), t + 2);
      WAIT_L(8); BAR; WAIT_L(0); MMA(0, 0, At, B0); BAR; SCHED;
      LDB(B1, 1, 1); STAGE_B0(G_SB(1, 0), t + 3);
      BAR; WAIT_L(0); MMA(0, 1, At, B1); BAR;
      LDA(At, 1, 1); STAGE_A0(G_SA(1, 0), t + 3);
      BAR; WAIT_L(0); MMA(1, 0, At, B0); BAR; SCHED;
      STAGE_B1(G_SB(1, 1), t + 3);
      WAIT_V(6); BAR; MMA(1, 1, At, B1); BAR;
    }
    { LDB(B0, 0, 0); WAIT_V(0); LDA(At, 0, 0); STAGE_A1(G_SA(1, 1), nt - 1);
      BAR; WAIT_L(0); MMA(0, 0, At, B0); BAR;
      LDB(B1, 0, 1); BAR; WAIT_L(0); MMA(0, 1, At, B1); BAR;
      LDA(At, 0, 1); WAIT_V(4); BAR; WAIT_L(0); MMA(1, 0, At, B0); MMA(1, 1, At, B1); BAR; }
    { LDB(B0, 1, 0); LDA(At, 1, 0); WAIT_V(2); BAR; WAIT_L(0); MMA(0, 0, At, B0); BAR;
      LDB(B1, 1, 1); WAIT_V(0); BAR; WAIT_L(0); MMA(0, 1, At, B1); BAR;
      LDA(At, 1, 1); BAR; WAIT_L(0); MMA(1, 0, At, B0); MMA(1, 1, At, B1); BAR; }
    if (wr == 0) BAR;
    const int cbrow = brow, cbcol = bcol;
    { int tz = threadIdx.x; asm volatile("" : "+v"(tz)); tz &= 511; wid = tz >> 6; lane = tz & 63; wr = wid >> 2; wc = wid & 3; fr = lane & 15; fq = lane >> 4;
      R0 = 8 * wid + (lane >> 3); C0 = ((lane & 7) ^ ((R0 >> 1) & 7)) << 4; }
    ++ui;
    const bool more = sched.unit(ui, brow, Bt, bcol);
    if (more) { SETOFF(brow, bcol); asm volatile("" ::: "memory"); PRO(); asm volatile("" ::: "memory"); }
    asm volatile("s_nop 15\n\ts_nop 15\n\ts_nop 7" ::: "memory");
    epi(acc, cbrow, cbcol, wr, wc, fr, fq);
    if (!more) break;
    first = false;
  }
#undef G_SA
#undef G_SB
#undef SETOFF
#undef STAGE_A0
#undef STAGE_A1
#undef STAGE_B0
#undef STAGE_B1
#undef PRO
#undef FRAG8
#undef LDA
#undef LDB
#undef MMA
}
__device__ __forceinline__ float clamp8(float x) { return fminf(fmaxf(x, -448.f), 448.f); }
__device__ __forceinline__ unsigned pack_fp8x4(float a, float b, float c, float d) {
  int p = __builtin_amdgcn_cvt_pk_fp8_f32(clamp8(a), clamp8(b), 0, false); p = __builtin_amdgcn_cvt_pk_fp8_f32(clamp8(c), clamp8(d), p, true); return (unsigned)p; }
struct EpiSwiGLU8 {
  unsigned char* C; int ldc;
  __device__ __forceinline__ void operator()(const f32x4 (&acc)[2][2][4][2], int brow, int bcol, int wr, int wc, int fr, int fq) const {
    constexpr float S = 1.f / 256.f;
#pragma unroll
    for (int ai = 0; ai < 2; ++ai)
#pragma unroll
      for (int m = 0; m < 4; ++m) {
        unsigned char* rp = C + (size_t)(brow + ai * 128 + wr * 64 + m * 16 + fr) * ldc + (bcol >> 1) + wc * 16 + fq * 4;
#pragma unroll
        for (int bj = 0; bj < 2; ++bj) {
          float r[4];
#pragma unroll
          for (int j = 0; j < 4; ++j) { const float g = acc[ai][bj][m][0][j] * S, u = acc[ai][bj][m][1][j] * S; r[j] = g * sigmoidf_(g) * u; }
          *(unsigned*)(rp + bj * 64) = pack_fp8x4(r[0], r[1], r[2], r[3]);
        }
      }
  }
};
struct EpiPlainS {
  bf16_t* C; int ldc; float sc;
  __device__ __forceinline__ void operator()(const f32x4 (&acc)[2][2][4][2], int brow, int bcol, int wr, int wc, int fr, int fq) const {
#pragma unroll
    for (int ai = 0; ai < 2; ++ai)
#pragma unroll
      for (int m = 0; m < 4; ++m) {
        bf16_t* rp = C + (size_t)(brow + ai * 128 + wr * 64 + m * 16 + fr) * ldc + bcol + wc * 32 + fq * 8;
#pragma unroll
        for (int bj = 0; bj < 2; ++bj) {
          u32x4 v = {cvtpk(acc[ai][bj][m][0][0] * sc, acc[ai][bj][m][0][1] * sc), cvtpk(acc[ai][bj][m][0][2] * sc, acc[ai][bj][m][0][3] * sc),
                     cvtpk(acc[ai][bj][m][1][0] * sc, acc[ai][bj][m][1][1] * sc), cvtpk(acc[ai][bj][m][1][2] * sc, acc[ai][bj][m][1][3] * sc)};
          *(u32x4*)(rp + bj * 128) = v;
        }
      }
  }
};

__device__ __forceinline__ void dense_unit(int u, int nM, int nN, int& pm, int& pn) {
  const int nwg = nM * nN, NX = 8, WGM = 8;
  int wgid = u;
  { const int q = nwg / NX, r = nwg % NX, xcd = wgid % NX, off = wgid / NX; wgid = (xcd < r ? xcd * (q + 1) : r * (q + 1) + (xcd - r) * q) + off; }
  const int nig = WGM * nN, gid = wgid / nig, fm = gid * WGM, gsz = min(nM - fm, WGM);
  pm = fm + ((wgid % nig) % gsz); pn = (wgid % nig) / gsz;
}

namespace at {
constexpr int DH = 128, NW = 8, QBLK = 32, KVBLK = 64;
constexpr float SCALE = 0.088388347648318440f;
constexpr float QC = SCALE * 1.4426950408889634f;
constexpr int SHM_V = KVBLK * DH * 2, SHM_K = KVBLK * DH * 2;
#define KSWZ(row, colB) ((row) * 256 + ((colB) ^ (((row) & 7) << 4)))
__device__ __forceinline__ int crow(int r, int hi) { return (r & 3) + 8 * (r >> 2) + 4 * hi; }
__device__ __forceinline__ unsigned cvtpkv(float lo, float hi) { unsigned r; asm volatile("v_cvt_pk_bf16_f32 %0, %1, %2" : "=v"(r) : "v"(lo), "v"(hi)); return r; }
#define PK4(P, BASE, OUT) do { unsigned a0 = cvtpkv(P[BASE + 0], P[BASE + 1]), a1 = cvtpkv(P[BASE + 2], P[BASE + 3]);   \
    unsigned b0 = cvtpkv(P[BASE + 4], P[BASE + 5]), b1 = cvtpkv(P[BASE + 6], P[BASE + 7]);                              \
    auto r0 = __builtin_amdgcn_permlane32_swap(a0, b0, false, false); auto r1 = __builtin_amdgcn_permlane32_swap(a1, b1, false, false); \
    u32x4 w = {r0[0], r1[0], r0[1], r1[1]}; OUT = *reinterpret_cast<bf16x8*>(&w); } while (0)
__device__ __forceinline__ float load_q(const bf16_t* __restrict__ Qw, bf16x8 (&qr)[8], float kmax2) {
  float ss = 0;
#pragma unroll
  for (int d0 = 0; d0 < 8; ++d0) {
    const u32x4 raw = *reinterpret_cast<const u32x4*>(Qw + d0 * 16); u32x4 o;
#pragma unroll
    for (int i = 0; i < 4; ++i) { const unsigned pk = cvtpk(bflo(raw[i]) * QC, bfhi(raw[i]) * QC); o[i] = pk; const float a = bflo(pk), b = bfhi(pk); ss += a * a + b * b; }
    qr[d0] = *reinterpret_cast<bf16x8*>(&o);
  }
  { auto rr = __builtin_amdgcn_permlane32_swap(__float_as_uint(ss), __float_as_uint(ss), false, false); ss = __uint_as_float(rr[0]) + __uint_as_float(rr[1]); }
  return -(sqrtf(ss * kmax2) * 1.01f + 1e-3f);
}
__device__ __forceinline__ void exp16(f32x16& p) {
#pragma unroll
  for (int r = 0; r < 16; ++r) p[r] = __builtin_amdgcn_exp2f(p[r]);
}
__device__ __forceinline__ float sum16(const f32x16& p) { float s = 0;
#pragma unroll
  for (int r = 0; r < 16; ++r) s += p[r];
  return s; }
__device__ __forceinline__ void qkt(f32x16& p0, f32x16& p1, LAS const char* Ks, const bf16x8* qr, int r32, int hi, float nmc) {
#pragma unroll
  for (int r = 0; r < 16; ++r) { p0[r] = nmc; p1[r] = nmc; }
#pragma unroll
  for (int d0 = 0; d0 < 8; ++d0) { int cb = (d0 * 16 + hi * 8) * 2;
    bf16x8 b0 = *(LAS const bf16x8*)(Ks + KSWZ(r32, cb));
    bf16x8 b1 = *(LAS const bf16x8*)(Ks + KSWZ(32 + r32, cb));
    p0 = __builtin_amdgcn_mfma_f32_32x32x16_bf16(b0, qr[d0], p0, 0, 0, 0);
    p1 = __builtin_amdgcn_mfma_f32_32x32x16_bf16(b1, qr[d0], p1, 0, 0, 0); }
}
__device__ __forceinline__ int v_st(int k, int c) { const int kk = (k & ~0xC) | ((k & 4) << 1) | ((k & 8) >> 1); return ((kk >> 3) * 4 + (c >> 5)) * 512 + ((kk & 7) * 32 + (c & 31)) * 2; }
__device__ __forceinline__ int v_st256(int k, int c) { const int kk = (k & ~0xC) | ((k & 4) << 1) | ((k & 8) >> 1); return ((kk >> 3) * 8 + (c >> 5)) * 512 + ((kk & 7) * 32 + (c & 31)) * 2; }
__device__ __forceinline__ int v_rd_base(int lane) { return ((lane & 3) << 3) | (((lane >> 2) & 3) << 6) | (((lane >> 4) & 1) << 5) | (((lane >> 5) & 1) << 8); }
template <int OFF> __device__ __forceinline__ s16x4 tr_read(int vb) {
  s16x4 r; asm volatile("ds_read_b64_tr_b16 %0, %1 offset:%2" : "=&v"(r) : "v"(vb), "i"(OFF) : "memory"); return r;
}
template <int BASE, int KS, int HS> __device__ __forceinline__ void pv_one(f32x16& od, int vb, bf16x8 pa0, bf16x8 pa1, bf16x8 pa2, bf16x8 pa3) {
  const s16x4 l0 = tr_read<BASE>(vb), h0 = tr_read<BASE + HS>(vb), l1 = tr_read<BASE + KS>(vb), h1 = tr_read<BASE + KS + HS>(vb);
  const s16x4 l2 = tr_read<BASE + 2 * KS>(vb), h2 = tr_read<BASE + 2 * KS + HS>(vb), l3 = tr_read<BASE + 3 * KS>(vb), h3 = tr_read<BASE + 3 * KS + HS>(vb);
  asm volatile("s_waitcnt lgkmcnt(0)" ::: "memory"); SCHED;
#define PK(L, H) (bf16x8){L[0], L[1], L[2], L[3], H[0], H[1], H[2], H[3]}
  od = __builtin_amdgcn_mfma_f32_32x32x16_bf16(pa0, PK(l0, h0), od, 0, 0, 0);
  od = __builtin_amdgcn_mfma_f32_32x32x16_bf16(pa1, PK(l1, h1), od, 0, 0, 0);
  od = __builtin_amdgcn_mfma_f32_32x32x16_bf16(pa2, PK(l2, h2), od, 0, 0, 0);
  od = __builtin_amdgcn_mfma_f32_32x32x16_bf16(pa3, PK(l3, h3), od, 0, 0, 0);
#undef PK
}
__device__ __forceinline__ void pv_d0(f32x16* o, int vb, bf16x8 pa0, bf16x8 pa1, bf16x8 pa2, bf16x8 pa3) {
  pv_one<0, 4096, 2048>(o[0], vb, pa0, pa1, pa2, pa3); pv_one<512, 4096, 2048>(o[1], vb, pa0, pa1, pa2, pa3);
  pv_one<1024, 4096, 2048>(o[2], vb, pa0, pa1, pa2, pa3); pv_one<1536, 4096, 2048>(o[3], vb, pa0, pa1, pa2, pa3);
}
__device__ __forceinline__ void pv_d0_256(f32x16* o, int vb, bf16x8 pa0, bf16x8 pa1, bf16x8 pa2, bf16x8 pa3) {
  pv_one<0, 8192, 4096>(o[0], vb, pa0, pa1, pa2, pa3); pv_one<512, 8192, 4096>(o[1], vb, pa0, pa1, pa2, pa3);
  pv_one<1024, 8192, 4096>(o[2], vb, pa0, pa1, pa2, pa3); pv_one<1536, 8192, 4096>(o[3], vb, pa0, pa1, pa2, pa3);
}
__device__ __forceinline__ void store_o(const f32x16* o, float l_tot, LAS float* li, bf16_t* __restrict__ Ow, int ldo, int r32, int hi) {
  if (hi == 0) li[r32] = l_tot; asm volatile("s_waitcnt lgkmcnt(0)" ::: "memory");
  float rli[16];
#pragma unroll
  for (int r = 0; r < 16; ++r) rli[r] = __builtin_amdgcn_rcpf(li[crow(r, hi)]);
#pragma unroll
  for (int r = 0; r < 16; ++r) { const int orow = crow(r, hi);
#pragma unroll
    for (int d0 = 0; d0 < 4; ++d0) Ow[(long)orow * ldo + d0 * 32 + r32] = f2bf(o[d0][r] * rli[r]); }
}

__device__ __forceinline__ int unswap23(int kk) { return (kk & ~0xC) | ((kk & 4) << 1) | ((kk & 8) >> 1); }
__device__ __forceinline__ int k_dma_voff(int wid, int lane, int ldk) {
  const int row = 4 * wid + (lane >> 4); return row * ldk * 2 + (((lane & 15) * 16) ^ ((row & 7) << 4)); }
#define DMA16(rs, ldsp, voff, soff) __builtin_amdgcn_raw_ptr_buffer_load_lds(rs, (LAS void*)(ldsp), 16, voff, soff, 0, 0)

constexpr int SHM_T = SHM_K + SHM_V;
__device__ __forceinline__ void attn_body(const bf16_t* __restrict__ Qb, const int ldq, const bf16_t* __restrict__ Kh, const bf16_t* __restrict__ Vh, const int ldk,
                                          bf16_t* __restrict__ Ob, const int ldo, const int seq, const float kmax2, LAS char* lds) {
  int tid = threadIdx.x; asm volatile("" : "+v"(tid)); tid &= 511;
  const int wid = tid >> 6, lane = tid & 63, r32 = lane & 31, hi = lane >> 5;
  LAS float* li_l = (LAS float*)(lds + 3 * SHM_T) + wid * 64;
  float l_reg = 0; f32x16 o[4] = {}; bf16x8 qr[8];
  const float nmc = load_q(Qb + (long)(wid * QBLK + r32) * ldq + hi * 8, qr, kmax2);
  const int vrb = v_rd_base(lane);
  const int kvo = k_dma_voff(wid, lane, ldk);
  const int vvo = unswap23(8 * (wid >> 1) + ((lane & 31) >> 2)) * ldk * 2 + ((2 * (wid & 1) + (lane >> 5)) * 32 + (lane & 3) * 8) * 2;
  const int l32 = 64 * ldk, pz = wid * 1024;
  const __amdgpu_buffer_rsrc_t krs = __builtin_amdgcn_make_buffer_rsrc((void*)Kh, 0, 0x7ffffff0, 0x00020000);
  const __amdgpu_buffer_rsrc_t vrs = __builtin_amdgcn_make_buffer_rsrc((void*)Vh, 0, 0x7ffffff0, 0x00020000);
#define TDMA(slot, k0) do { const int _o = (k0) * ldk * 2; LAS char* _b = lds + (slot) * SHM_T + pz; \
    DMA16(krs, _b, kvo, _o); DMA16(krs, _b + 8192, kvo, _o + l32); DMA16(vrs, _b + SHM_K, vvo, _o); DMA16(vrs, _b + SHM_K + 8192, vvo, _o + l32); } while (0)
#define VM0() asm volatile("s_waitcnt vmcnt(0)" ::: "memory")
#define FINISH(P0, P1) do { exp16(P1); l_reg += sum16(P0) + sum16(P1); PK4(P0, 0, pa0); PK4(P0, 8, pa1); PK4(P1, 0, pa2); PK4(P1, 8, pa3); } while (0)
  f32x16 pA0, pA1, pB0, pB1; bf16x8 pa0, pa1, pa2, pa3; const int NT = seq / KVBLK;
  TDMA(0, 0); VM0(); __syncthreads();
  TDMA(1, KVBLK);
  qkt(pA0, pA1, lds, qr, r32, hi, nmc); exp16(pA0);
  VM0(); __syncthreads();
  int sk = 1, sv = 0, sd = 2;
  for (int j = 1; j + 1 < NT; j += 2) {
    TDMA(sd, (j + 1) * KVBLK);
    SCHED; qkt(pB0, pB1, lds + sk * SHM_T, qr, r32, hi, nmc);
    FINISH(pA0, pA1); SCHED;
    pv_d0(o, (int)(uintptr_t)(lds + sv * SHM_T + SHM_K) + vrb, pa0, pa1, pa2, pa3); exp16(pB0);
    VM0(); __syncthreads();
    { const int t = sv; sv = sk; sk = sd; sd = t; }
    if (j + 2 < NT) TDMA(sd, (j + 2) * KVBLK);
    SCHED; qkt(pA0, pA1, lds + sk * SHM_T, qr, r32, hi, nmc);
    FINISH(pB0, pB1); SCHED;
    pv_d0(o, (int)(uintptr_t)(lds + sv * SHM_T + SHM_K) + vrb, pa0, pa1, pa2, pa3); exp16(pA0);
    VM0(); __syncthreads();
    { const int t = sv; sv = sk; sk = sd; sd = t; }
  }
  SCHED; qkt(pB0, pB1, lds + sk * SHM_T, qr, r32, hi, nmc);
  FINISH(pA0, pA1); SCHED;
  pv_d0(o, (int)(uintptr_t)(lds + sv * SHM_T + SHM_K) + vrb, pa0, pa1, pa2, pa3); exp16(pB0);
  FINISH(pB0, pB1); SCHED;
  pv_d0(o, (int)(uintptr_t)(lds + sk * SHM_T + SHM_K) + vrb, pa0, pa1, pa2, pa3);
  { auto rr = __builtin_amdgcn_permlane32_swap(__float_as_uint(l_reg), __float_as_uint(l_reg), false, false); l_reg = __uint_as_float(rr[0]) + __uint_as_float(rr[1]); }
  store_o(o, l_reg, li_l, Ob + (long)(wid * QBLK) * ldo, ldo, r32, hi);
  VM0();
  __syncthreads();
#undef TDMA
#undef FINISH
}

constexpr int SHM_V2 = KVBLK * 256 * 2;
__device__ __forceinline__ void attn_body_dv256(const bf16_t* __restrict__ Qb, const int ldq, const bf16_t* __restrict__ Kh, const bf16_t* __restrict__ Vh, const int ldk,
                                                bf16_t* __restrict__ Ob, const int ldo, const int seq, const float kmax2, LAS char* lds) {
  int tid = threadIdx.x; asm volatile("" : "+v"(tid)); tid &= 511;
  const int wid = tid >> 6, lane = tid & 63, r32 = lane & 31, hi = lane >> 5, rg = wid >> 1, kh = wid & 1;
  LAS char* K_lds = lds; LAS char* V_lds = lds + 2 * SHM_K; LAS char* X_lds = lds + 2 * SHM_K + 2 * SHM_V2;
  float l_reg = 0; f32x16 o[4] = {}; bf16x8 qr[8];
  const float nmc = load_q(Qb + (long)(rg * QBLK + r32) * ldq + hi * 8, qr, kmax2);
  const int vb0 = (int)(uintptr_t)V_lds + v_rd_base(lane) + kh * 2048;
  const int kvo = k_dma_voff(wid, lane, ldk);
  const int vvo = unswap23(8 * (wid >> 2) + ((lane & 31) >> 2)) * ldk * 2 + ((2 * (wid & 3) + (lane >> 5)) * 32 + (lane & 3) * 8) * 2;
  const int l32 = 64 * ldk, l16 = 32 * ldk, pz = wid * 1024;
  const int xw = (rg * 4 + kh * 2) * 1024 + lane * 16, xr = rg * 4096 + lane * 16;
  const __amdgpu_buffer_rsrc_t krs = __builtin_amdgcn_make_buffer_rsrc((void*)Kh, 0, 0x7ffffff0, 0x00020000);
  const __amdgpu_buffer_rsrc_t vrs = __builtin_amdgcn_make_buffer_rsrc((void*)Vh, 0, 0x7ffffff0, 0x00020000);
#define KDMA(b, k0) do { const int _o = (k0) * ldk * 2; LAS char* _b = K_lds + (b) * SHM_K + pz; DMA16(krs, _b, kvo, _o); DMA16(krs, _b + 8192, kvo, _o + l32); } while (0)
#define VDMA(b, k0) do { const int _o = (k0) * ldk * 2; LAS char* _b = V_lds + (b) * SHM_V2 + pz; DMA16(vrs, _b, vvo, _o); DMA16(vrs, _b + 8192, vvo, _o + l16); \
    DMA16(vrs, _b + 16384, vvo, _o + 2 * l16); DMA16(vrs, _b + 24576, vvo, _o + 3 * l16); } while (0)
  f32x16 pA, pB; bf16x8 pa0, pa1, pa2, pa3, own0, own1; const int NT = seq / KVBLK;
  const int kxor = ((32 * kh + r32) & 7) << 4, krb = (32 * kh + r32) * 256;
#define QKHALF(P, b) do { _Pragma("unroll") for (int r = 0; r < 16; ++r) P[r] = nmc; \
    _Pragma("unroll") for (int d0 = 0; d0 < 8; ++d0) { const bf16x8 bk = *(LAS const bf16x8*)(K_lds + (b) * SHM_K + krb + (((d0 * 16 + hi * 8) * 2) ^ kxor)); \
      P = __builtin_amdgcn_mfma_f32_32x32x16_bf16(bk, qr[d0], P, 0, 0, 0); } } while (0)
#define FINH(P) do { exp16(P); l_reg += sum16(P); PK4(P, 0, own0); PK4(P, 8, own1); } while (0)
#define XWRITE(b) do { *(LAS bf16x8*)(X_lds + (b) * 16384 + xw) = own0; *(LAS bf16x8*)(X_lds + (b) * 16384 + xw + 1024) = own1; } while (0)
#define XREAD(b) do { pa0 = *(LAS const bf16x8*)(X_lds + (b) * 16384 + xr); pa1 = *(LAS const bf16x8*)(X_lds + (b) * 16384 + xr + 1024); \
    pa2 = *(LAS const bf16x8*)(X_lds + (b) * 16384 + xr + 2048); pa3 = *(LAS const bf16x8*)(X_lds + (b) * 16384 + xr + 3072); } while (0)
#define STEP(PA, PB, b, j) do { \
    SCHED; if ((j) + 1 < NT) QKHALF(PB, (b) ^ 1); FINH(PA); SCHED; \
    XWRITE(b); VM0(); __syncthreads(); \
    if ((j) + 3 < NT) KDMA((b) ^ 1, ((j) + 3) * KVBLK); if ((j) + 1 < NT) VDMA((b) ^ 1, ((j) + 1) * KVBLK); \
    XREAD(b); \
    pv_d0_256(o, vb0 + (b) * SHM_V2, pa0, pa1, pa2, pa3); } while (0)
  KDMA(0, 0); KDMA(1, KVBLK); VDMA(0, 0); VM0(); __syncthreads();
  QKHALF(pA, 0);
  __syncthreads();
  if (2 < NT) KDMA(0, 2 * KVBLK);
  for (int j = 0; j < NT; j += 2) { STEP(pA, pB, 0, j); STEP(pB, pA, 1, j + 1); }
  __syncthreads();
  LAS float* lx = (LAS float*)X_lds;
  lx[wid * 64 + lane] = l_reg; __syncthreads();
  const float l_tot = lx[wid * 64 + r32] + lx[wid * 64 + 32 + r32] + lx[(wid ^ 1) * 64 + r32] + lx[(wid ^ 1) * 64 + 32 + r32];
  store_o(o, l_tot, lx + 512 + wid * 32, Ob + (long)(rg * QBLK) * ldo + kh * 128, ldo, r32, hi);
  VM0();
  __syncthreads();
#undef KDMA
#undef VDMA
#undef QKHALF
#undef FINH
#undef XWRITE
#undef XREAD
#undef STEP
#undef VM0
}

#define LGK(n) asm volatile("s_waitcnt lgkmcnt(" #n ")" ::: "memory")
template <int OFF> __device__ __forceinline__ bf16x8 k_read(int ka) { bf16x8 r; asm volatile("ds_read_b128 %0, %1 offset:%2" : "=&v"(r) : "v"(ka), "i"(OFF) : "memory"); return r; }
struct VSet { s16x4 l0, h0, l1, h1; };
template <int OFF> __device__ __forceinline__ void v_read(VSet& s, int vb) { s.l0 = tr_read<OFF>(vb); s.h0 = tr_read<OFF + 4096>(vb); s.l1 = tr_read<OFF + 8192>(vb); s.h1 = tr_read<OFF + 12288>(vb); }
__device__ __forceinline__ void pv2(f32x16& oa, const VSet& s, bf16x8 pa0, bf16x8 pa1) {
#define PK(L, H) (bf16x8){L[0], L[1], L[2], L[3], H[0], H[1], H[2], H[3]}
  oa = __builtin_amdgcn_mfma_f32_32x32x16_bf16(pa0, PK(s.l0, s.h0), oa, 0, 0, 0);
  oa = __builtin_amdgcn_mfma_f32_32x32x16_bf16(pa1, PK(s.l1, s.h1), oa, 0, 0, 0);
#undef PK
}
template <bool SHIFT>
__device__ __forceinline__ void attn_body_c256_t(const bf16_t* __restrict__ Qb, const int ldq, const bf16_t* __restrict__ Kh, const bf16_t* __restrict__ Vh, const int ldk,
                                                 bf16_t* __restrict__ Ob, const int ldo, const int seq, const float nmc, const bf16x8 (&qr)[8], LAS char* lds) {
  int tid = threadIdx.x; asm volatile("" : "+v"(tid)); tid &= 511;
  const int wid = __builtin_amdgcn_readfirstlane(tid >> 6), lane = tid & 63, r32 = lane & 31, hi = lane >> 5;
  LAS char* K_lds = lds; LAS char* V_lds = lds + 2 * SHM_K;
  LAS float* li_l = (LAS float*)(lds + 2 * SHM_K + 2 * SHM_V2) + wid * 64;
  float l_reg = 0; f32x16 o[8] = {};
  const int vb0 = (int)(uintptr_t)V_lds + v_rd_base(lane);
  const int kvo = k_dma_voff(wid, lane, ldk);
  const int vvo = unswap23(8 * (wid >> 2) + ((lane & 31) >> 2)) * ldk * 2 + ((2 * (wid & 3) + (lane >> 5)) * 32 + (lane & 3) * 8) * 2;
  const int l32 = 64 * ldk, l16 = 32 * ldk, pz = wid * 1024;
  const __amdgpu_buffer_rsrc_t krs = __builtin_amdgcn_make_buffer_rsrc((void*)Kh, 0, 0x7ffffff0, 0x00020000);
  const __amdgpu_buffer_rsrc_t vrs = __builtin_amdgcn_make_buffer_rsrc((void*)Vh, 0, 0x7ffffff0, 0x00020000);
#define VM0() asm volatile("s_waitcnt vmcnt(0)" ::: "memory")
#define KVDMA(b, k0) do { const int _o = (k0) * ldk * 2; LAS char* _k = K_lds + (b) * SHM_K + pz; LAS char* _v = V_lds + (b) * SHM_V2 + pz; \
    DMA16(krs, _k, kvo, _o); DMA16(krs, _k + 8192, kvo, _o + l32); DMA16(vrs, _v, vvo, _o); DMA16(vrs, _v + 8192, vvo, _o + l16); \
    DMA16(vrs, _v + 16384, vvo, _o + 2 * l16); DMA16(vrs, _v + 24576, vvo, _o + 3 * l16); } while (0)
  int ka[8];
  { const int kxor = (r32 & 7) << 4, krb = (int)(uintptr_t)K_lds + r32 * 256;
#pragma unroll
    for (int d0 = 0; d0 < 8; ++d0) ka[d0] = krb + (((d0 * 16 + hi * 8) * 2) ^ kxor); }
  f32x16 P; bf16x8 pa0, pa1, f0, f1, f2, f3; VSet va, vb_, vc;
  const int NT = seq / KVBLK;
#define PINIT() do { _Pragma("unroll") for (int r = 0; r < 16; ++r) { float _z; asm volatile("v_mov_b32 %0, %1" : "=v"(_z) : "v"(SHIFT ? nmc : 0.f)); P[r] = _z; } } while (0)
#define KOFF(b, h) ((b) * 16384 + (h) * 8192)
#define VOFF(b, h, d0) ((b) * 32768 + (h) * 16384 + (d0) * 512)
#define KPRO(b, h) do { f0 = k_read<KOFF(b, h)>(ka[0]); f1 = k_read<KOFF(b, h)>(ka[1]); f2 = k_read<KOFF(b, h)>(ka[2]); } while (0)
#define QKM(F, d0) do { SCHED; P = __builtin_amdgcn_mfma_f32_32x32x16_bf16(F, qr[d0], P, 0, 0, 0); SCHED; } while (0)
#define QKHALF(b, h) do { PINIT(); \
    LGK(2); QKM(f0, 0); f3 = k_read<KOFF(b, h)>(ka[3]); \
    LGK(2); QKM(f1, 1); f0 = k_read<KOFF(b, h)>(ka[4]); \
    LGK(2); QKM(f2, 2); f1 = k_read<KOFF(b, h)>(ka[5]); \
    LGK(2); QKM(f3, 3); f2 = k_read<KOFF(b, h)>(ka[6]); \
    LGK(2); QKM(f0, 4); f3 = k_read<KOFF(b, h)>(ka[7]); \
    LGK(2); QKM(f1, 5); v_read<VOFF(b, h, 0)>(va, vb0); \
    LGK(5); QKM(f2, 6); v_read<VOFF(b, h, 1)>(vb_, vb0); \
    LGK(8); QKM(f3, 7); } while (0)
#define SMH() do { exp16(P); l_reg += sum16(P); PK4(P, 0, pa0); PK4(P, 8, pa1); } while (0)
#define PVM(S, d0) do { SCHED; pv2(o[d0], S, pa0, pa1); SCHED; } while (0)
#define PVHALF(b, h, NEXTK, nb, nh) do { \
    LGK(4); PVM(va, 0); v_read<VOFF(b, h, 2)>(vc, vb0); \
    LGK(4); PVM(vb_, 1); v_read<VOFF(b, h, 3)>(va, vb0); \
    LGK(4); PVM(vc, 2); v_read<VOFF(b, h, 4)>(vb_, vb0); \
    LGK(4); PVM(va, 3); v_read<VOFF(b, h, 5)>(vc, vb0); \
    LGK(4); PVM(vb_, 4); v_read<VOFF(b, h, 6)>(va, vb0); \
    LGK(4); PVM(vc, 5); v_read<VOFF(b, h, 7)>(vb_, vb0); \
    LGK(4); PVM(va, 6); if (NEXTK) { f0 = k_read<KOFF(nb, nh)>(ka[0]); f1 = k_read<KOFF(nb, nh)>(ka[1]); } \
    if (NEXTK) { LGK(2); } else { LGK(0); } PVM(vb_, 7); if (NEXTK) { f2 = k_read<KOFF(nb, nh)>(ka[2]); } } while (0)
#define STEPC(b, j) do { if ((j) + 1 < NT) KVDMA((b) ^ 1, ((j) + 1) * KVBLK); \
    KPRO(b, 0); QKHALF(b, 0); SMH(); PVHALF(b, 0, true, b, 1); \
    QKHALF(b, 1); SMH(); PVHALF(b, 1, false, 0, 0); \
    VM0(); __syncthreads(); } while (0)
  KVDMA(0, 0); VM0(); __syncthreads();
  for (int j = 0; j < NT; j += 2) { STEPC(0, j); STEPC(1, j + 1); }
  { auto rr = __builtin_amdgcn_permlane32_swap(__float_as_uint(l_reg), __float_as_uint(l_reg), false, false); l_reg = __uint_as_float(rr[0]) + __uint_as_float(rr[1]); }
  if (hi == 0) li_l[r32] = l_reg; asm volatile("s_waitcnt lgkmcnt(0)" ::: "memory");
  bf16_t* Ow = Ob + (long)(wid * QBLK) * ldo;
#pragma unroll
  for (int r = 0; r < 16; ++r) { const int orow = crow(r, hi); const float rl = __builtin_amdgcn_rcpf(li_l[orow]);
#pragma unroll
    for (int d0 = 0; d0 < 8; ++d0) Ow[(long)orow * ldo + d0 * 32 + r32] = f2bf(o[d0][r] * rl); }
  VM0();
  __syncthreads();
#undef KVDMA
#undef PINIT
#undef KOFF
#undef VOFF
#undef KPRO
#undef QKM
#undef QKHALF
#undef SMH
#undef PVM
#undef PVHALF
#undef STEPC
#undef VM0
}
__device__ __forceinline__ void attn_body_c256(const bf16_t* __restrict__ Qb, const int ldq, const bf16_t* __restrict__ Kh, const bf16_t* __restrict__ Vh, const int ldk,
                                               bf16_t* __restrict__ Ob, const int ldo, const int seq, const float kmax2, LAS char* lds) {
  int tid = threadIdx.x; asm volatile("" : "+v"(tid)); tid &= 511;
  const int wid = tid >> 6, lane = tid & 63, r32 = lane & 31, hi = lane >> 5;
  bf16x8 qr[8];
  const float nmc = load_q(Qb + (long)(wid * QBLK + r32) * ldq + hi * 8, qr, kmax2);
  if (__all(nmc > -64.f)) attn_body_c256_t<false>(Qb, ldq, Kh, Vh, ldk, Ob, ldo, seq, 0.f, qr, lds);
  else attn_body_c256_t<true>(Qb, ldq, Kh, Vh, ldk, Ob, ldo, seq, nmc, qr, lds);
}
#undef PK4
}

__device__ __forceinline__ int perm_plain8(int n) { const int r = n & 31; return (n & ~31) + 16 * ((r >> 2) & 1) + 4 * (r >> 3) + (r & 3); }
__device__ __forceinline__ int perm_row(int kind, int n) {
  if (kind == 0) return perm_plain8(n);
  if (kind == 1) { if (n < N_QKV0) return perm_plain8(n); const int c = n - N_QKV0; const int ch = c & 1023; return N_QKV0 + 32 * (ch >> 4) + ((c >> 10) << 4) + (ch & 15); }
  return 32 * (n >> 4) + ((kind == 3) ? 16 : 0) + (n & 15);
}
__device__ __forceinline__ void cvt_tile(const float* __restrict__ src, int N, bf16_t* __restrict__ dst, int K, int kind, int k0, int n0, LAS unsigned* t32) {
  int tid = threadIdx.x; asm volatile("" : "+v"(tid)); tid &= 511;
#pragma unroll
  for (int j = 0; j < 2; ++j) {
    const int item = tid + 512 * j, kp = item >> 4, q = item & 15;
    const f32x4 v0 = *(const f32x4*)(src + (size_t)(k0 + 2 * kp) * N + n0 + 4 * q);
    const f32x4 v1 = *(const f32x4*)(src + (size_t)(k0 + 2 * kp + 1) * N + n0 + 4 * q);
#pragma unroll
    for (int i = 0; i < 4; ++i) t32[(4 * q + i) * 65 + kp] = cvtpk(v0[i], v1[i]);
  }
  __syncthreads();
#pragma unroll
  for (int j = 0; j < 2; ++j) {
    const int item = tid + 512 * j, n = item >> 4, ko = item & 15;
    u32x4 v;
#pragma unroll
    for (int i = 0; i < 4; ++i) v[i] = t32[n * 65 + 4 * ko + i];
    *(u32x4*)(dst + (size_t)perm_row(kind, n0 + n) * K + k0 + 8 * ko) = v;
  }
  __syncthreads();
}
__device__ __forceinline__ void cvt_matrix_units(const float* src, int K, int N, bf16_t* dst, int kind, int u0, int ustride, LAS unsigned* t32) {
  const int nN = N / 64, nK = K / 128;
  for (int u = u0; u < nN * nK; u += ustride) cvt_tile(src, N, dst, K, kind, (u / nN) * 128, (u % nN) * 64, t32);
}
constexpr size_t WMOE8_E = (size_t)1024 * D + (size_t)D * EFF;
__device__ __forceinline__ void cvt_tile8(const float* __restrict__ src, int N, unsigned char* __restrict__ dst, int K, int kind, int k0, int n0, float scale, LAS unsigned* t32) {
  int tid = threadIdx.x; asm volatile("" : "+v"(tid)); tid &= 511;
  { const int kq = tid >> 4, q = tid & 15;
    f32x4 v[4];
#pragma unroll
    for (int r = 0; r < 4; ++r) v[r] = *(const f32x4*)(src + (size_t)(k0 + 4 * kq + r) * N + n0 + 4 * q);
#pragma unroll
    for (int i = 0; i < 4; ++i) t32[(4 * q + i) * 33 + kq] = pack_fp8x4(v[0][i] * scale, v[1][i] * scale, v[2][i] * scale, v[3][i] * scale); }
  __syncthreads();
  { const int n = tid >> 3, kc = tid & 7;
    u32x4 v;
#pragma unroll
    for (int i = 0; i < 4; ++i) v[i] = t32[n * 33 + 4 * kc + i];
    *(u32x4*)(dst + (size_t)perm_row(kind, n0 + n) * K + k0 + 16 * kc) = v; }
  __syncthreads();
}
__device__ __forceinline__ void cvt_moe_all8(const Args& a, LAS unsigned* t32) {
  unsigned char* W = (unsigned char*)(a.ws + WS_WMOE);
  for (int u = blockIdx.x; u < 2 * 65 * 384; u += gridDim.x) {
    const int le = u / 384, L = le / 65, e = le % 65, r = u % 384, mtx = r >> 7, lu = r & 127;
    const float* src; unsigned char* dst = W + (size_t)le * WMOE8_E; int K, N, kind; float sc;
    if (mtx == 0)      { src = e < 64 ? a.in[21] + ((size_t)L * 64 + e) * D * EFF : a.in[24] + (size_t)L * D * EFF; K = D; N = EFF; kind = 2; sc = 256.f; }
    else if (mtx == 1) { src = e < 64 ? a.in[22] + ((size_t)L * 64 + e) * D * EFF : a.in[25] + (size_t)L * D * EFF; K = D; N = EFF; kind = 3; sc = 256.f; }
    else               { src = e < 64 ? a.in[23] + ((size_t)L * 64 + e) * EFF * D : a.in[26] + (size_t)L * EFF * D; K = EFF; N = D; kind = 0; sc = 128.f; dst += (size_t)1024 * D; }
    const int nN = N / 64;
    cvt_tile8(src, N, dst, K, kind, (lu / nN) * 128, (lu % nN) * 64, sc, t32);
  }
}

__device__ __forceinline__ void ld_row_f32(const float* __restrict__ p, int lane, float (&v)[32]) {
#pragma unroll
  for (int j = 0; j < 4; ++j) { const f32x4 t0 = *(const f32x4*)(p + 8 * lane + 512 * j), t1 = *(const f32x4*)(p + 8 * lane + 512 * j + 4);
#pragma unroll
    for (int i = 0; i < 4; ++i) { v[8 * j + i] = t0[i]; v[8 * j + 4 + i] = t1[i]; } }
}
__device__ __forceinline__ void ld_row_bf16(const bf16_t* __restrict__ p, int lane, float (&v)[32]) {
#pragma unroll
  for (int j = 0; j < 4; ++j) { const u32x4 t = *(const u32x4*)(p + 8 * lane + 512 * j);
#pragma unroll
    for (int i = 0; i < 4; ++i) { v[8 * j + 2 * i] = bflo(t[i]); v[8 * j + 2 * i + 1] = bfhi(t[i]); } }
}
__device__ __forceinline__ void ld8f(const float* __restrict__ p, float (&x)[8]) { const f32x4 t0 = *(const f32x4*)p, t1 = *(const f32x4*)(p + 4);
#pragma unroll
  for (int i = 0; i < 4; ++i) { x[i] = t0[i]; x[4 + i] = t1[i]; } }
__device__ __forceinline__ void st8f(float* __restrict__ p, const float* x) { f32x4 t0 = {x[0], x[1], x[2], x[3]}, t1 = {x[4], x[5], x[6], x[7]}; *(f32x4*)p = t0; *(f32x4*)(p + 4) = t1; }
__device__ __forceinline__ float sumsq32(const float (&v)[32]) { float s = 0;
#pragma unroll
  for (int i = 0; i < 32; ++i) s += v[i] * v[i];
  return wave_sum(s); }
template <bool COPY, bool OUT8 = false>
__device__ __forceinline__ void modulate_store(const float (&v)[32], float rstd, const float* __restrict__ g, const float* __restrict__ shift, const float* __restrict__ scale,
                                               bf16_t* __restrict__ dst, int lane, LAS float* f32copy) {
#pragma unroll
  for (int j = 0; j < 4; ++j) {
    const int idx = 8 * lane + 512 * j;
    float gv[8], sh[8], sc[8], y[8]; ld8f(g + idx, gv); ld8f(shift + idx, sh); ld8f(scale + idx, sc);
#pragma unroll
    for (int i = 0; i < 8; ++i) y[i] = v[8 * j + i] * rstd * gv[i] * (1.f + sc[i]) + sh[i];
    if (OUT8) { u32x2 p8 = {pack_fp8x4(y[0], y[1], y[2], y[3]), pack_fp8x4(y[4], y[5], y[6], y[7])}; *(u32x2*)((unsigned char*)dst + idx) = p8; }
    else { u32x4 pk = {cvtpk(y[0], y[1]), cvtpk(y[2], y[3]), cvtpk(y[4], y[5]), cvtpk(y[6], y[7])}; *(u32x4*)(dst + idx) = pk; }
    if (COPY) { f32x4 t0 = {y[0], y[1], y[2], y[3]}, t1 = {y[4], y[5], y[6], y[7]};
      *(LAS f32x4*)(f32copy + idx) = t0; *(LAS f32x4*)(f32copy + idx + 4) = t1; }
  }
}

__device__ __forceinline__ void phase_prologue(const Args& a, LAS char* lds) {
  int tid = threadIdx.x; asm volatile("" : "+v"(tid)); tid &= 511; const int wave = tid >> 6, lane = tid & 63;
  {
    LAS float* sc = (LAS float*)lds;
    LAS float* part = sc + 4096;
    const float* c = a.in[1]; const float* cc = a.in[3];
    for (int i = tid; i < D; i += NTHREADS) { float v = c[i]; sc[i] = v * sigmoidf_(v); float u = cc[i]; sc[D + i] = u * sigmoidf_(u); }
    __syncthreads();
    float* MOD = (float*)(a.ws + WS_MOD);
    for (int u = blockIdx.x; u < 2 * 192; u += gridDim.x) {
      const int L = u / 192, chunk = u % 192;
      const float* W = a.in[4] + (size_t)L * D * 12288 + chunk * 64 + lane;
      float a0 = 0, a1 = 0; const int d0 = wave * 256;
#pragma unroll 8
      for (int dd = 0; dd < 256; ++dd) { const float w = W[(size_t)(d0 + dd) * 12288]; a0 += sc[d0 + dd] * w; a1 += sc[D + d0 + dd] * w; }
      part[(wave * 2 + 0) * 64 + lane] = a0; part[(wave * 2 + 1) * 64 + lane] = a1;
      __syncthreads();
      if (tid < 128) { const int which = tid >> 6; float s = 0;
#pragma unroll
        for (int w = 0; w < 8; ++w) s += part[(w * 2 + which) * 64 + lane];
        const int j = chunk * 64 + lane; MOD[(size_t)(L * 2 + which) * 12288 + j] = s + a.in[5][L * 12288 + j]; }
      __syncthreads();
    }
  }
  LAS unsigned* t32 = (LAS unsigned*)lds;
  cvt_matrix_units(a.in[7], D, N_IN0, (bf16_t*)(a.ws + WS_WIN0), 1, blockIdx.x, gridDim.x, t32);
  cvt_matrix_units(a.in[8], D, D, (bf16_t*)(a.ws + WS_WOUT0), 0, blockIdx.x, gridDim.x, t32);
  cvt_matrix_units(a.in[15], D, N_IN1, (bf16_t*)(a.ws + WS_WIN1), 0, blockIdx.x, gridDim.x, t32);
  cvt_matrix_units(a.in[16], D, D, (bf16_t*)(a.ws + WS_WOUT1), 0, blockIdx.x, gridDim.x, t32);
  cvt_moe_all8(a, t32);
}

__device__ __forceinline__ void phase_modulate0(const Args& a) {
  int tid = threadIdx.x; asm volatile("" : "+v"(tid)); tid &= 511; const int wave = tid >> 6, lane = tid & 63;
  const float* MOD = (const float*)(a.ws + WS_MOD);
  bf16_t* A = (bf16_t*)(a.ws + WS_ABUF);
  for (int it = blockIdx.x; it < MT / 8; it += gridDim.x) {
    const int r = it * 8 + wave;
    const float* src = r < CTXL ? a.in[2] + (size_t)r * D : a.in[0] + (size_t)(r - CTXL) * D;
    const float* mod = MOD + (r < CTXL ? 12288 : 0);
    float v[32]; ld_row_f32(src, lane, v);
    const float rstd = rsqrtf(sumsq32(v) * (1.f / D) + EPS);
    modulate_store<false>(v, rstd, a.in[6], mod, mod + D, A + (size_t)r * D, lane, nullptr);
  }
}

__device__ __forceinline__ void rope_cs4(int r, int lane, float (&cs)[4], float (&sn)[4]) {
#pragma unroll
  for (int q = 0; q < 4; ++q) { cs[q] = 1.f; sn[q] = 0.f; }
  if (r >= CTXL) { const int t = r - CTXL; const int l = lane & 15, a = l >> 3, i0 = 4 * (l & 7);
    const float pos = a ? (float)(t & 63) : (float)(t >> 6);
#pragma unroll
    for (int q = 0; q < 4; ++q) { const float inv = powf(10000.f, -(float)(i0 + q) / 32.f); sincosf(pos * inv, &sn[q], &cs[q]); } }
}
__device__ __forceinline__ float sum16lanes(float v) { v += __shfl_xor(v, 1); v += __shfl_xor(v, 2); v += __shfl_xor(v, 4); v += __shfl_xor(v, 8); return v; }
__device__ __forceinline__ void phase_rope_conv0(const Args& a, LAS char* lds, bool dry = false) {
  int tid = threadIdx.x; asm volatile("" : "+v"(tid)); tid &= 511; const int wave = tid >> 6, lane = tid & 63;
  bf16_t* Q = (bf16_t*)(a.ws + WS_QKVU);
  {
    const bf16_t* HG = (const bf16_t*)(a.ws + WS_HG);
    bf16_t* X2 = (bf16_t*)(a.ws + WS_X2);
    LAS char* lt = lds;
    LAS float* part = (LAS float*)(lds + 62 * 2048);
    LAS float* stats = part + 512;
    const float* dw_w = a.in[11]; const float* dw_b = a.in[12]; const float* ln_g = a.in[13]; const float* ln_b = a.in[14];
    const __amdgpu_buffer_rsrc_t wrs = __builtin_amdgcn_make_buffer_rsrc((void*)dw_w, 0, 31 * 1024 * 4, 0x00020000);
    for (int u = blockIdx.x; u < 520; u += gridDim.x) {
      int seg0, seg1, r0;
      if (u < 8) { seg0 = 0; seg1 = CTXL; r0 = u * 32; } else { seg0 = CTXL; seg1 = MT; r0 = CTXL + (u - 8) * 32; }
      for (int c = tid; c < 62 * 128; c += NTHREADS) { const int rr = c >> 7, cc = c & 127, gr = r0 - 15 + rr;
        u32x4 v = {0u, 0u, 0u, 0u}; if (gr >= seg0 && gr < seg1) v = *(const u32x4*)(HG + (size_t)gr * 1024 + cc * 8);
        *(LAS u32x4*)(lt + rr * 2048 + cc * 16) = v; }
      __syncthreads();
      float w0[31], w1[31];
#pragma unroll
      for (int j = 0; j < 31; ++j) { const u32x2 w = __builtin_amdgcn_raw_buffer_load_b64(wrs, tid * 8, j * 4096, 0); w0[j] = __uint_as_float(w[0]); w1[j] = __uint_as_float(w[1]); }
      const f32x2 bb = *(const f32x2*)(dw_b + 2 * tid);
      const f32x2 gg = *(const f32x2*)(ln_g + 2 * tid), gb = *(const f32x2*)(ln_b + 2 * tid);
#pragma unroll 1
      for (int hf = 0; hf < 4; ++hf) {
        float o0[8], o1[8];
        LAS const char* lth = lt + (hf * 8) * 2048 + tid * 4;
#pragma unroll
        for (int r = 0; r < 8; ++r) { o0[r] = bb[0]; o1[r] = bb[1]; }
#pragma unroll
        for (int i = 0; i < 38; ++i) {
          const unsigned p = *(LAS const unsigned*)(lth + i * 2048);
          const float x0 = bflo(p), x1 = bfhi(p);
#pragma unroll
          for (int r = 0; r < 8; ++r) { const int j = i - r; if (j >= 0 && j < 31) { o0[r] += x0 * w0[j]; o1[r] += x1 * w1[j]; } }
        }
#pragma unroll
        for (int r = 0; r < 8; ++r) {
          const float s = wave_sum(o0[r] + o1[r]), q = wave_sum(o0[r] * o0[r] + o1[r] * o1[r]);
          if (lane == 0) { part[(r * 8 + wave) * 2] = s; part[(r * 8 + wave) * 2 + 1] = q; }
        }
        __syncthreads();
        if (tid < 8) { float s = 0, q = 0;
#pragma unroll
          for (int w = 0; w < 8; ++w) { s += part[(tid * 8 + w) * 2]; q += part[(tid * 8 + w) * 2 + 1]; }
          const float mean = s * (1.f / 1024), var = q * (1.f / 1024) - mean * mean;
          stats[tid * 2] = mean; stats[tid * 2 + 1] = rsqrtf(fmaxf(var, 0.f) + EPS); }
        __syncthreads();
#pragma unroll
        for (int r = 0; r < 8; ++r) {
          const float mean = stats[r * 2], rstd = stats[r * 2 + 1];
          float y0 = (o0[r] - mean) * rstd * gg[0] + gb[0], y1 = (o1[r] - mean) * rstd * gg[1] + gb[1];
          y0 = y0 * sigmoidf_(y0); y1 = y1 * sigmoidf_(y1);
          *(unsigned*)(X2 + (size_t)(r0 + hf * 8 + r) * D + 1024 + 2 * tid) = cvtpk(y0, y1);
        }
      }
      __syncthreads();
    }
  }
  const float* qn = a.in[9]; const float* kn = a.in[10];
  unsigned* kmx = (unsigned*)(a.ws + WS_CTL + CTL_KMAX);
  const int slot = lane >> 4, l16 = lane & 15, e1 = (l16 >> 3) * 64 + 4 * (l16 & 7), e2 = e1 + 32;
  float km0 = 0.f, km1 = 0.f;
  for (int it = blockIdx.x; it < MT / 8; it += gridDim.x) {
    const int r = it * 8 + wave;
    float cs[4], sn[4]; rope_cs4(r, lane, cs, sn);
    bf16_t* rowp = Q + (size_t)r * N_QKV0;
#pragma unroll
    for (int hb = 0; hb < 12; hb += 4) {
      const int hh = hb + slot;
      if (hh < 10) {
        const float* g = hh < 8 ? qn : kn;
        const u32x2 a1 = *(const u32x2*)(rowp + hh * 128 + e1), a2 = *(const u32x2*)(rowp + hh * 128 + e2);
        float x1[4] = {bflo(a1[0]), bfhi(a1[0]), bflo(a1[1]), bfhi(a1[1])}, x2[4] = {bflo(a2[0]), bfhi(a2[0]), bflo(a2[1]), bfhi(a2[1])};
        float ss = 0;
#pragma unroll
        for (int q = 0; q < 4; ++q) ss += x1[q] * x1[q] + x2[q] * x2[q];
        ss = sum16lanes(ss);
        const float rstd = rsqrtf(ss * (1.f / 128) + EPS);
        const f32x4 g1 = *(const f32x4*)(g + e1), g2 = *(const f32x4*)(g + e2);
        float o1[4], o2[4], so = 0;
#pragma unroll
        for (int q = 0; q < 4; ++q) { const float y1 = x1[q] * rstd * g1[q], y2 = x2[q] * rstd * g2[q]; o1[q] = y1 * cs[q] - y2 * sn[q]; o2[q] = y2 * cs[q] + y1 * sn[q]; }
        const u32x2 w1 = {cvtpk(o1[0], o1[1]), cvtpk(o1[2], o1[3])}, w2 = {cvtpk(o2[0], o2[1]), cvtpk(o2[2], o2[3])};
        if (!dry) { *(u32x2*)(rowp + hh * 128 + e1) = w1; *(u32x2*)(rowp + hh * 128 + e2) = w2; }
        if (hb == 8) {
          so = bflo(w1[0]) * bflo(w1[0]) + bfhi(w1[0]) * bfhi(w1[0]) + bflo(w1[1]) * bflo(w1[1]) + bfhi(w1[1]) * bfhi(w1[1])
             + bflo(w2[0]) * bflo(w2[0]) + bfhi(w2[0]) * bfhi(w2[0]) + bflo(w2[1]) * bflo(w2[1]) + bfhi(w2[1]) * bfhi(w2[1]);
          so = sum16lanes(so); if (slot == 0) km0 = fmaxf(km0, so); else km1 = fmaxf(km1, so);
        }
      }
    }
  }
  if (l16 == 0 && slot < 2) atomicMax(&kmx[slot], __float_as_uint(slot == 0 ? km0 : km1));
}
__device__ __forceinline__ void phase_rope1(const Args& a, LAS char* lds, bool dry = false) {
  int tid = threadIdx.x; asm volatile("" : "+v"(tid)); tid &= 511; const int wave = tid >> 6, lane = tid & 63;
  bf16_t* Q = (bf16_t*)(a.ws + WS_QKVU);
  unsigned* kmx = (unsigned*)(a.ws + WS_CTL + CTL_KMAX) + 16;
  LAS unsigned* lk = (LAS unsigned*)lds;
  if (tid < 16) lk[tid] = 0u;
  __syncthreads();
  const int slot = lane >> 4, l16 = lane & 15, e1 = (l16 >> 3) * 64 + 4 * (l16 & 7), e2 = e1 + 32;
  for (int it = blockIdx.x; it < MT / 8; it += gridDim.x) {
    const int r = it * 8 + wave;
    float cs[4], sn[4]; rope_cs4(r, lane, cs, sn);
    bf16_t* rowp = Q + (size_t)r * N_IN1;
#pragma unroll 2
    for (int hb = (r < CTXL ? 16 : 0); hb < 32; hb += 4) {
      const int hh = hb + slot;
      const u32x2 a1 = *(const u32x2*)(rowp + hh * 128 + e1), a2 = *(const u32x2*)(rowp + hh * 128 + e2);
      const float x1[4] = {bflo(a1[0]), bfhi(a1[0]), bflo(a1[1]), bfhi(a1[1])}, x2[4] = {bflo(a2[0]), bfhi(a2[0]), bflo(a2[1]), bfhi(a2[1])};
      float o1[4], o2[4];
#pragma unroll
      for (int q = 0; q < 4; ++q) { o1[q] = x1[q] * cs[q] - x2[q] * sn[q]; o2[q] = x2[q] * cs[q] + x1[q] * sn[q]; }
      const u32x2 w1 = {cvtpk(o1[0], o1[1]), cvtpk(o1[2], o1[3])}, w2 = {cvtpk(o2[0], o2[1]), cvtpk(o2[2], o2[3])};
      if (r >= CTXL && !dry) { *(u32x2*)(rowp + hh * 128 + e1) = w1; *(u32x2*)(rowp + hh * 128 + e2) = w2; }
      if (hb >= 16) {
        float so = bflo(w1[0]) * bflo(w1[0]) + bfhi(w1[0]) * bfhi(w1[0]) + bflo(w1[1]) * bflo(w1[1]) + bfhi(w1[1]) * bfhi(w1[1])
                 + bflo(w2[0]) * bflo(w2[0]) + bfhi(w2[0]) * bfhi(w2[0]) + bflo(w2[1]) * bflo(w2[1]) + bfhi(w2[1]) * bfhi(w2[1]);
        so = sum16lanes(so);
        if (l16 == 0) atomicMax((unsigned*)&lk[hh - 16], __float_as_uint(so));
      }
    }
  }
  __syncthreads();
  if (tid < 16) atomicMax(&kmx[tid], lk[tid]);
  __syncthreads();
}

__device__ __forceinline__ void phase_attn(const Args& a, int L, LAS char* lds) {
  const bf16_t* Q = (const bf16_t*)(a.ws + WS_QKVU);
  const unsigned* kmx = (const unsigned*)(a.ws + WS_CTL + CTL_KMAX) + L * 16;
  if (L == 0) {
    bf16_t* X2 = (bf16_t*)(a.ws + WS_X2);
    for (int u = blockIdx.x; u < 520; u += gridDim.x) {
      const int head = u < 512 ? (u & 7) : (u - 512);
      const float kmax2 = __uint_as_float(kmx[head >> 2]);
      if (u < 512) { const int qb = u >> 3; const size_t q0 = (size_t)(CTXL + qb * 256);
        at::attn_body(Q + q0 * N_QKV0 + head * 128, N_QKV0, Q + 1024 + (head >> 2) * 128, Q + 1280 + (head >> 2) * 128, N_QKV0, X2 + q0 * D + head * 128, D, MT, kmax2, lds);
      } else {
        at::attn_body(Q + head * 128, N_QKV0, Q + 1024 + (head >> 2) * 128, Q + 1280 + (head >> 2) * 128, N_QKV0, X2 + head * 128, D, CTXL, kmax2, lds); }
    }
  } else {
    bf16_t* O = (bf16_t*)(a.ws + WS_Y);
    for (int u = blockIdx.x; u < 1024; u += gridDim.x) {
      const int x = u & 7, w = u >> 3, hc = x + 8 * (w >> 6), qb = w & 63, h = hc >> 1;
      const float kmax2 = __uint_as_float(kmx[hc]);
      const size_t q0 = (size_t)(CTXL + qb * 256);
      at::attn_body_c256(Q + q0 * N_IN1 + hc * 128, N_IN1, Q + 2048 + hc * 128, Q + 4096 + h * 256, N_IN1,
                         O + (size_t)(qb * 256) * 4096 + hc * 256, 4096, MT, kmax2, lds);
    }
  }
}

__device__ __forceinline__ void phase_diff(const Args& a) {
  int tid = threadIdx.x; asm volatile("" : "+v"(tid)); tid &= 511; const int wave = tid >> 6, lane = tid & 63;
  const bf16_t* O = (const bf16_t*)(a.ws + WS_Y);
  bf16_t* X2 = (bf16_t*)(a.ws + WS_X2);
  const float* lp = a.in[17];
  const float s1 = wave_sum(lp[lane] * lp[128 + lane] + lp[64 + lane] * lp[192 + lane]);
  const float s2 = wave_sum(lp[256 + lane] * lp[384 + lane] + lp[320 + lane] * lp[448 + lane]);
  const float lam = expf(s1) - expf(s2) + LAM_INIT;
  const f32x4 sg = *(const f32x4*)(a.in[18] + 4 * lane);
  for (int it = blockIdx.x; it < SEQ / 8; it += gridDim.x) {
    const int t = it * 8 + wave;
    const bf16_t* op = O + (size_t)t * 4096;
    bf16_t* xp = X2 + (size_t)(CTXL + t) * D;
#pragma unroll 2
    for (int h = 0; h < 8; ++h) {
      const u32x2 a0 = *(const u32x2*)(op + (2 * h) * 256 + 4 * lane), a1 = *(const u32x2*)(op + (2 * h + 1) * 256 + 4 * lane);
      float d[4] = {bflo(a0[0]) - lam * bflo(a1[0]), bfhi(a0[0]) - lam * bfhi(a1[0]), bflo(a0[1]) - lam * bflo(a1[1]), bfhi(a0[1]) - lam * bfhi(a1[1])};
      const float ss = wave_sum(d[0] * d[0] + d[1] * d[1] + d[2] * d[2] + d[3] * d[3]);
      const float rstd = rsqrtf(ss * (1.f / 256) + EPS) * (1.f - LAM_INIT);
      u32x2 pk = {cvtpk(d[0] * rstd * sg[0], d[1] * rstd * sg[1]), cvtpk(d[2] * rstd * sg[2], d[3] * rstd * sg[3])};
      *(u32x2*)(xp + h * 256 + 4 * lane) = pk;
    }
  }
}

__device__ __forceinline__ void phase_G(const Args& a, int L, LAS char* lds, bool dry = false) {
  int tid = threadIdx.x; asm volatile("" : "+v"(tid)); tid &= 511; const int wave = tid >> 6, lane = tid & 63;
  const int NTOK = L == 0 ? MT : SEQ, ROW0 = L == 0 ? 0 : CTXL;
  const float* ng = a.in[6] + (size_t)L * 4 * D;
  const float* MODL = (const float*)(a.ws + WS_MOD) + (size_t)(L * 2) * 12288;
  const float* router = a.in[19] + (size_t)L * D * NE; const float* rbias = a.in[20] + L * NE;
  const bf16_t* OUT = (const bf16_t*)(a.ws + WS_OUT);
  float* HRES = (float*)(a.ws + WS_HRES);
  bf16_t* F = (bf16_t*)(a.ws + WS_ABUF);
  int* counts = (int*)(a.ws + WS_CTL + CTL_CNT) + L * 64;
  int* top_e = (int*)(a.ws + WS_TOPE); float* top_w = (float*)(a.ws + WS_TOPW); int* top_p = (int*)(a.ws + WS_TOPP);
  LAS float* ft = (LAS float*)lds;
  LAS float* part = ft + 8 * D;
  for (int it = blockIdx.x; it < NTOK / 8; it += gridDim.x) {
    const int r = ROW0 + it * 8 + wave;
    const float* mod = MODL + (r < CTXL ? 12288 : 0);
    {
      float o[32], h[32];
      ld_row_bf16(OUT + (size_t)r * D, lane, o);
      const float* hp = L == 0 ? (r < CTXL ? a.in[2] + (size_t)r * D : a.in[0] + (size_t)(r - CTXL) * D) : HRES + (size_t)r * D;
      ld_row_f32(hp, lane, h);
      const float rstd1 = rsqrtf(sumsq32(o) * (1.f / D) + EPS);
#pragma unroll
      for (int j = 0; j < 4; ++j) { const int idx = 8 * lane + 512 * j;
        float g1[8], gt[8]; ld8f(ng + D + idx, g1); ld8f(mod + 2 * D + idx, gt);
#pragma unroll
        for (int i = 0; i < 8; ++i) h[8 * j + i] += gt[i] * (o[8 * j + i] * rstd1 * g1[i]);
        if (!dry) st8f(HRES + (size_t)r * D + idx, &h[8 * j]); }
      const float rstd2 = rsqrtf(sumsq32(h) * (1.f / D) + EPS);
      modulate_store<true, true>(h, rstd2, ng + 2 * D, mod + 3 * D, mod + 4 * D, (bf16_t*)((unsigned char*)F + (size_t)r * D), lane, ft + wave * D);
    }
    __syncthreads();
    float acc[8] = {0, 0, 0, 0, 0, 0, 0, 0};
    const int d0 = wave * 256;
#pragma unroll 2
    for (int dd = 0; dd < 256; dd += 4) {
      const float* rp = router + (size_t)(d0 + dd) * NE + lane;
      const float r0 = rp[0], r1 = rp[NE], r2 = rp[2 * NE], r3 = rp[3 * NE];
#pragma unroll
      for (int t = 0; t < 8; ++t) { const f32x4 fv = *(LAS const f32x4*)(ft + t * D + d0 + dd); acc[t] += fv[0] * r0 + fv[1] * r1 + fv[2] * r2 + fv[3] * r3; }
    }
#pragma unroll
    for (int t = 0; t < 8; ++t) part[(wave * 8 + t) * 64 + lane] = acc[t];
    __syncthreads();
    float logit = 0;
#pragma unroll
    for (int w = 0; w < 8; ++w) logit += part[(w * 8 + wave) * 64 + lane];
#if MK_DIAG
    ((float*)(a.ws + WS_Y))[(size_t)r * 64 + lane] = logit;
#endif
    const float score = sigmoidf_(logit);
    const float choice = score + rbias[lane];
    int rank = 0; const int gl = lane & 7;
#pragma unroll
    for (int j = 0; j < 8; ++j) { const float o = __shfl(choice, (lane & ~7) | j); rank += (o > choice || (o == choice && j < gl)) ? 1 : 0; }
    float gs = rank < 2 ? choice : 0.f;
    gs += __shfl_xor(gs, 1); gs += __shfl_xor(gs, 2); gs += __shfl_xor(gs, 4);
    int grank = 0; const int g = lane >> 3;
#pragma unroll
    for (int j = 0; j < 8; ++j) { const float o = __shfl(gs, j * 8); grank += (o > gs || (o == gs && j < g)) ? 1 : 0; }
    const bool gsel = grank < 4;
    const float mc = gsel ? choice : -INFINITY;
    int erank = 0;
#pragma unroll 4
    for (int j = 0; j < 64; ++j) { const float o = __int_as_float(__builtin_amdgcn_readlane(__float_as_int(mc), j)); erank += (o > mc || (o == mc && j < lane)) ? 1 : 0; }
    const bool sel = gsel && erank < 8;
    const unsigned long long bal = __ballot(sel);
    const int idx = __popcll(bal & ((1ull << lane) - 1ull));
    const float ssum = wave_sum(sel ? score : 0.f);
    if (sel && !dry) { const int pos = atomicAdd(&counts[lane], 1);
      top_e[r * 8 + idx] = lane; top_w[r * 8 + idx] = score / ssum * 2.5f; top_p[r * 8 + idx] = pos; }
  }
}

__device__ __forceinline__ void moe_tile_prefix(const int* counts, LAS int* ts) {
  if (threadIdx.x == 0) { int s = 0; for (int e = 0; e < 64; ++e) { ts[e] = s; s += (counts[e] + 255) >> 8; } ts[64] = s; }
  __syncthreads();
}
__device__ __forceinline__ void phase_H(const Args& a, int L, LAS char* lds) {
  const int NTOK = L == 0 ? MT : SEQ, ROW0 = L == 0 ? 0 : CTXL;
  const int* counts = (const int*)(a.ws + WS_CTL + CTL_CNT) + L * 64;
  const int* top_e = (const int*)(a.ws + WS_TOPE); const int* top_p = (const int*)(a.ws + WS_TOPP);
  int* tslot = (int*)(a.ws + WS_TSLOT); int* stok = (int*)(a.ws + WS_STOK);
  LAS int* ts = (LAS int*)lds;
  moe_tile_prefix(counts, ts);
  int tid = threadIdx.x; asm volatile("" : "+v"(tid)); tid &= 511;
  const int gt = blockIdx.x * NTHREADS + tid, gs = gridDim.x * NTHREADS;
  for (int i = gt; i < NTOK * 8; i += gs) { const int q = ROW0 * 8 + i; const int e = top_e[q]; const int slot = ts[e] * 256 + top_p[q]; stok[slot] = q >> 3; tslot[q] = slot; }
  for (int i = gt; i < 64 * 256; i += gs) { const int e = i >> 8, p = i & 255, cnt = counts[e], nt = (cnt + 255) >> 8; if (cnt + p < nt * 256) stok[ts[e] * 256 + cnt + p] = ROW0; }
  for (int i = gt; i < NTOK; i += gs) stok[SH_BASE + i] = ROW0 + i;
  __syncthreads();
}
struct MoeSched {
  LAS const int* ts; int TR, NN, total; const unsigned char* W; size_t woff;
  __device__ __forceinline__ bool unit(int i, int& slot0, const unsigned char*& Bt, int& bcol) const {
    for (int u = blockIdx.x + i * (int)gridDim.x; ; u += gridDim.x) {
      const int rnd = u >> 8, b = u & 255, v = rnd * 256 + (b & 7) * 32 + (b >> 3);
      if (rnd * 256 >= total) return false;
      if (v >= total) return false;
      const int m = v / NN, pn = v % NN;
      int e;
      if (m >= TR) { e = 64; slot0 = SH_BASE + 256 * (m - TR); } else { e = 0; while (ts[e + 1] <= m) ++e; slot0 = 256 * m; }
      Bt = W + (size_t)e * WMOE8_E + woff; bcol = pn * 256;
      return true;
    }
  }
};
__device__ __forceinline__ void phase_moe_up(const Args& a, int L, LAS char* lds) {
  const int NSH = L == 0 ? MT / 256 : SEQ / 256;
  const int* counts = (const int*)(a.ws + WS_CTL + CTL_CNT) + L * 64;
  LAS int* ts = (LAS int*)(lds + LDS_CTL + 64);
  moe_tile_prefix(counts, ts);
  const int TR = ts[64], TM = TR + NSH;
  const unsigned char* F = (const unsigned char*)(a.ws + WS_ABUF); const unsigned char* W = (const unsigned char*)(a.ws + WS_WMOE) + (size_t)L * 65 * WMOE8_E;
  const int* stok = (const int*)(a.ws + WS_STOK);
  EpiSwiGLU8 epi{(unsigned char*)(a.ws + WS_ACT), EFF};
  MoeSched sc{ts, TR, 4, TM * 4, W, 0};
  gemm8_run<true, D, D, D>(F, stok, lds, epi, sc);
}
__device__ __forceinline__ void phase_moe_down(const Args& a, int L, LAS char* lds) {
  const int NSH = L == 0 ? MT / 256 : SEQ / 256;
  const int* counts = (const int*)(a.ws + WS_CTL + CTL_CNT) + L * 64;
  LAS int* ts = (LAS int*)(lds + LDS_CTL + 64);
  moe_tile_prefix(counts, ts);
  const int TR = ts[64], TM = TR + NSH;
  const unsigned char* ACT = (const unsigned char*)(a.ws + WS_ACT); const unsigned char* W = (const unsigned char*)(a.ws + WS_WMOE) + (size_t)L * 65 * WMOE8_E;
  EpiPlainS epi{(bf16_t*)(a.ws + WS_Y), D, 1.f / 128.f};
  MoeSched sc{ts, TR, 8, TM * 8, W, (size_t)1024 * D};
  gemm8_run<false, EFF, EFF, EFF>(ACT, nullptr, lds, epi, sc);
}
__device__ __forceinline__ void phase_combine(const Args& a, int L, bool dry = false) {
  int tid = threadIdx.x; asm volatile("" : "+v"(tid)); tid &= 511; const int wave = tid >> 6, lane = tid & 63;
  const int NTOK = L == 0 ? MT : SEQ, ROW0 = L == 0 ? 0 : CTXL;
  const float* ng = a.in[6] + (size_t)L * 4 * D;
  const float* MODL = (const float*)(a.ws + WS_MOD) + (size_t)(L * 2) * 12288;
  const bf16_t* Y = (const bf16_t*)(a.ws + WS_Y);
  float* HRES = (float*)(a.ws + WS_HRES);
  const int* tslot = (const int*)(a.ws + WS_TSLOT); const float* top_w = (const float*)(a.ws + WS_TOPW);
  for (int it = blockIdx.x; it < NTOK / 8; it += gridDim.x) {
    const int r = ROW0 + it * 8 + wave;
    const float* mod = MODL + (r < CTXL ? 12288 : 0);
    float y[32];
    { float t[32]; ld_row_bf16(Y + (size_t)(SH_BASE + r - ROW0) * D, lane, t);
#pragma unroll
      for (int i = 0; i < 32; ++i) y[i] = t[i]; }
#pragma unroll 4
    for (int k = 0; k < 8; ++k) { const int slot = tslot[r * 8 + k]; const float w = top_w[r * 8 + k];
      float t[32]; ld_row_bf16(Y + (size_t)slot * D, lane, t);
#pragma unroll
      for (int i = 0; i < 32; ++i) y[i] += w * t[i]; }
    const float rstd = rsqrtf(sumsq32(y) * (1.f / D) + EPS);
    float h[32]; ld_row_f32(HRES + (size_t)r * D, lane, h);
#pragma unroll
    for (int j = 0; j < 4; ++j) { const int idx = 8 * lane + 512 * j;
      float g3[8], gt[8]; ld8f(ng + 3 * D + idx, g3); ld8f(mod + 5 * D + idx, gt);
#pragma unroll
      for (int i = 0; i < 8; ++i) h[8 * j + i] += gt[i] * (y[8 * j + i] * rstd * g3[i]);
      if (L == 0) { if (!dry) st8f(HRES + (size_t)r * D + idx, &h[8 * j]); } else st8f(a.out + (size_t)(r - CTXL) * D + idx, &h[8 * j]); }
    if (L == 0) {
      const float* mod1 = MODL + 2 * 12288 + (r < CTXL ? 12288 : 0);
      const float rstd2 = rsqrtf(sumsq32(h) * (1.f / D) + EPS);
      modulate_store<false>(h, rstd2, a.in[6] + (size_t)4 * D, mod1, mod1 + D, (bf16_t*)(a.ws + WS_ABUF) + (size_t)r * D, lane, nullptr);
    }
  }
}

constexpr int NPH = 21;
typedef const __attribute__((address_space(4))) Args* ArgsP;
#if defined(__HIP_DEVICE_COMPILE__)
#define FRESH_ARGS() const Args a = *({ ArgsP _p = (ArgsP)__builtin_amdgcn_kernarg_segment_ptr(); asm volatile("" : "+s"(_p)); _p; })
#else
#define FRESH_ARGS() const Args a = kargs
#endif
__global__ void __launch_bounds__(NTHREADS, 2) fwd(Args kargs) {
  extern __shared__ __attribute__((aligned(16))) unsigned char lds_raw[];
  LAS char* lds = (LAS char*)lds_raw;
  const int lo = kargs.ph_lo, hi = kargs.ph_hi;
  if (threadIdx.x < 64) ((LAS unsigned*)(lds + LDS_CTL))[threadIdx.x] = 0u;
  __syncthreads();
  if (hi - lo > 1) (void)xcd_barrier_post((unsigned*)(kargs.ws + WS_CTL), (volatile LAS unsigned*)(lds + LDS_CTL));
#ifndef PHASE_MASK
#define PHASE_MASK 0xFFFFFFFFu
#endif
#define IN(k) (((PHASE_MASK >> (k)) & 1u) && lo <= (k) && (k) < hi)
#ifndef PH_REPEAT_MASK
#define PH_REPEAT_MASK 0u
#endif
#define REP(k) for (int _rep = 0; _rep < (((PH_REPEAT_MASK >> (k)) & 1u) ? 2 : 1); ++_rep)
#define SEAM(k) do { if ((k) + 1 < hi) { XcdBarrier _b; _b.bar = (unsigned*)(a.ws + WS_CTL); _b.x = xb_xcc_id(); _b.st = (volatile LAS unsigned*)(lds + LDS_CTL); xcd_barrier(_b); } } while (0)

  if (IN(0)) { FRESH_ARGS(); REP(0) phase_prologue(a, lds); SEAM(0); }
  if (IN(1)) { FRESH_ARGS(); REP(1) phase_modulate0(a); SEAM(1); }
#pragma unroll
  for (int L = 0; L < 2; ++L) {
    const int base = 2 + (L == 0 ? 0 : 9);
    if (IN(base + 0)) {
      FRESH_ARGS();
      const bf16_t* A = (const bf16_t*)(a.ws + WS_ABUF);
      const bf16_t* Bt = (const bf16_t*)(a.ws + (L == 0 ? WS_WIN0 : WS_WIN1));
      const int nN = L == 0 ? N_IN0 / 256 : N_IN1 / 256, nM = MT / 256;
      EpiG1 epi{EpiPlain{(bf16_t*)(a.ws + WS_QKVU), L == 0 ? N_QKV0 : N_IN1}, EpiPair<0>{(bf16_t*)(a.ws + WS_HG), 1024, N_QKV0}, L == 0 ? N_QKV0 : N_IN1};
      REP(2) for (int u = blockIdx.x; u < nM * nN; u += gridDim.x) { int pm, pn; dense_unit(u, nM, nN, pm, pn);
        gemm_tile<false>(A, D, nullptr, pm * 256, Bt, D, pn * 256, D, lds, epi); }
      SEAM(base + 0);
    }
    if (L == 0) {
      if (IN(3)) { FRESH_ARGS(); if ((PH_REPEAT_MASK >> 3) & 1u) { phase_rope_conv0(a, lds, true); __syncthreads(); } phase_rope_conv0(a, lds); SEAM(3); }
      if (IN(4)) { FRESH_ARGS(); REP(4) phase_attn(a, 0, lds); SEAM(4); }
    } else {
      if (IN(12)) { FRESH_ARGS(); if ((PH_REPEAT_MASK >> 12) & 1u) { phase_rope1(a, lds, true); __syncthreads(); } phase_rope1(a, lds); SEAM(12); }
      if (IN(13)) { FRESH_ARGS(); REP(13) phase_attn(a, 1, lds); SEAM(13); }
      if (IN(14)) { FRESH_ARGS(); REP(14) phase_diff(a); SEAM(14); }
    }
    const int b2 = L == 0 ? 5 : 15;
    if (IN(b2 + 0)) {
      FRESH_ARGS();
      const bf16_t* A = (const bf16_t*)(a.ws + WS_X2);
      const bf16_t* Bt = (const bf16_t*)(a.ws + (L == 0 ? WS_WOUT0 : WS_WOUT1));
      const int nN = D / 256, nM = L == 0 ? MT / 256 : SEQ / 256, r0 = L == 0 ? 0 : CTXL;
      EpiPlain epi{(bf16_t*)(a.ws + WS_OUT), D};
      REP(5) for (int u = blockIdx.x; u < nM * nN; u += gridDim.x) { int pm, pn; dense_unit(u, nM, nN, pm, pn);
        gemm_tile<false>(A, D, nullptr, r0 + pm * 256, Bt, D, pn * 256, D, lds, epi); }
      SEAM(b2 + 0);
    }
    if (IN(b2 + 1)) { FRESH_ARGS(); if ((PH_REPEAT_MASK >> 6) & 1u) { phase_G(a, L, lds, true); __syncthreads(); } phase_G(a, L, lds); SEAM(b2 + 1); }
    if (IN(b2 + 2)) { FRESH_ARGS(); REP(7) phase_H(a, L, lds); SEAM(b2 + 2); }
    if (IN(b2 + 3)) { FRESH_ARGS(); REP(8) phase_moe_up(a, L, lds); SEAM(b2 + 3); }
    if (IN(b2 + 4)) { FRESH_ARGS(); REP(9) phase_moe_down(a, L, lds); SEAM(b2 + 4); }
    if (IN(b2 + 5)) { FRESH_ARGS(); if ((PH_REPEAT_MASK >> 10) & 1u) phase_combine(a, L, true); phase_combine(a, L); SEAM(b2 + 5); }
  }
#undef IN
#undef SEAM
}

#ifndef MK_DIAG
#define MK_DIAG 0
#endif
#if MK_DIAG
__device__ __forceinline__ void rope_cs(int r, int lane, float& cs, float& sn) {
  cs = 1.f; sn = 0.f;
  if (r >= CTXL) { const int t = r - CTXL; const int a = lane >> 5, i = lane & 31;
    const float pos = a ? (float)(t & 63) : (float)(t >> 6);
    const float inv = powf(10000.f, -(float)i / 32.f);
    sincosf(pos * inv, &sn, &cs); }
}
__device__ __forceinline__ bool dclose(float got, float ref, float rtol, float atol) { return fabsf(got - ref) <= rtol * fabsf(ref) + atol; }
__device__ __forceinline__ unsigned dhash(unsigned x) { x ^= x >> 16; x *= 0x7feb352du; x ^= x >> 15; x *= 0x846ca68bu; x ^= x >> 16; return x; }
__device__ float wdot(const bf16_t* arow, const float* W, int ldw, int col, int K, int lane) {
  float s = 0; for (int k = lane; k < K; k += 64) s += bf2f(arow[k]) * W[(size_t)k * ldw + col]; return wave_sum(s); }
__device__ void dflag(int* dg, int s, int bad, int lane) { if (lane == 0 && bad) atomicAdd(&dg[s], bad); }
__device__ const float* h0row(const Args& a, int r) { return r < CTXL ? a.in[2] + (size_t)r * D : a.in[0] + (size_t)(r - CTXL) * D; }
__device__ int pick_row(unsigned h, int lo, int n) { const unsigned m = h % 8; if (m == 0) return lo; if (m == 1) return lo + n - 1; if (m == 2) return lo + 255 < lo + n ? lo + 255 : lo; if (m == 3) return lo + 256 < lo + n ? lo + 256 : lo; return lo + (int)((h >> 3) % (unsigned)n); }
__device__ void naive_attn(const bf16_t* q, const bf16_t* K, const bf16_t* V, int ld, int nkeys, int lane, float& o0, float& o1) {
  const float q0 = bf2f(q[lane]), q1 = bf2f(q[lane + 64]);
  float m = -1e30f, l = 0; o0 = 0; o1 = 0;
  for (int k = 0; k < nkeys; ++k) {
    const float s = wave_sum(q0 * bf2f(K[(size_t)k * ld + lane]) + q1 * bf2f(K[(size_t)k * ld + lane + 64])) * 0.088388347648318440f;
    const float mn = fmaxf(m, s), al = expf(m - mn), p = expf(s - mn);
    l = l * al + p; o0 = o0 * al + p * bf2f(V[(size_t)k * ld + lane]); o1 = o1 * al + p * bf2f(V[(size_t)k * ld + lane + 64]); m = mn;
  }
  o0 /= l; o1 /= l;
}
__global__ void __launch_bounds__(256) diag(Args a, int k) {
  __shared__ float fsh[4][2048];
  __shared__ float csh[4][64];
  const int lane = threadIdx.x & 63, wv = threadIdx.x >> 6, gw = blockIdx.x * 4 + wv;
  int* dg = (int*)(a.ws + WS_CTL + CTL_CNT + 512);
  const float* MOD = (const float*)(a.ws + WS_MOD);
  const bf16_t* AB = (const bf16_t*)(a.ws + WS_ABUF);
  const bf16_t* QK = (const bf16_t*)(a.ws + WS_QKVU);
  const bf16_t* HG = (const bf16_t*)(a.ws + WS_HG);
  const bf16_t* X2 = (const bf16_t*)(a.ws + WS_X2);
  const bf16_t* OUT = (const bf16_t*)(a.ws + WS_OUT);
  const bf16_t* ACT = (const bf16_t*)(a.ws + WS_ACT);
  const bf16_t* Y = (const bf16_t*)(a.ws + WS_Y);
  const float* HRES = (const float*)(a.ws + WS_HRES);
  const int* top_e = (const int*)(a.ws + WS_TOPE); const float* top_w = (const float*)(a.ws + WS_TOPW); const int* top_p = (const int*)(a.ws + WS_TOPP);
  const int* tslot = (const int*)(a.ws + WS_TSLOT); const int* stok = (const int*)(a.ws + WS_STOK);
  const unsigned h = dhash(gw * 7919u + k * 104729u + 17u), h2 = dhash(h + 12345u);
  int bad = 0;
  const int L = k >= 11 ? 1 : 0;
  const int NTOK = L == 0 ? MT : SEQ, ROW0 = L == 0 ? 0 : CTXL;
  const int* counts = (const int*)(a.ws + WS_CTL + CTL_CNT) + L * 64;
  if (k == 0) {
    const int LL = gw & 1, which = (gw >> 1) & 1, j = h % 12288;
    const float* v = which ? a.in[3] : a.in[1];
    float s = 0; for (int d = lane; d < D; d += 64) { const float x = v[d]; s += x * sigmoidf_(x) * a.in[4][((size_t)LL * D + d) * 12288 + j]; }
    s = wave_sum(s) + a.in[5][LL * 12288 + j];
    bad = !dclose(MOD[(LL * 2 + which) * 12288 + j], s, 1e-3f, 1e-3f); dflag(dg, 1, bad, lane);
  } else if (k == 1) {
    const int r = pick_row(h, 0, MT); const float* x = h0row(a, r); const float* mod = MOD + (r < CTXL ? 12288 : 0);
    float ss = 0; for (int d = lane; d < D; d += 64) ss += x[d] * x[d]; ss = wave_sum(ss); const float rstd = rsqrtf(ss / D + EPS);
    for (int d = lane; d < D; d += 64) { const float ref = x[d] * rstd * a.in[6][d] * (1.f + mod[D + d]) + mod[d]; bad += !dclose(bf2f(AB[(size_t)r * D + d]), ref, 0.01f, 0.01f); }
    bad = (int)wave_sum((float)bad); dflag(dg, 2, bad, lane);
  } else if (k == 2 || k == 11) {
    const int r = pick_row(h, 0, MT);
    if (L == 0) {
      const int c = h2 % N_QKV0; const float ref = wdot(AB + (size_t)r * D, a.in[7], N_IN0, c, D, lane);
      bad = !dclose(bf2f(QK[(size_t)r * N_QKV0 + c]), ref, 0.02f, 0.05f); dflag(dg, 3, bad, lane);
      const int ch = (h2 >> 11) % 1024; const float av = wdot(AB + (size_t)r * D, a.in[7], N_IN0, N_QKV0 + ch, D, lane), gv = wdot(AB + (size_t)r * D, a.in[7], N_IN0, N_QKV0 + 1024 + ch, D, lane);
      bad = !dclose(bf2f(HG[(size_t)r * 1024 + ch]), av * sigmoidf_(gv), 0.03f, 0.05f); dflag(dg, 4, bad, lane);
    } else {
      const int c = h2 % N_IN1; const float ref = wdot(AB + (size_t)r * D, a.in[15], N_IN1, c, D, lane);
      bad = !dclose(bf2f(QK[(size_t)r * N_IN1 + c]), ref, 0.02f, 0.05f); dflag(dg, 15, bad, lane);
    }
  } else if (k == 3) {
    { const int r = pick_row(h, 0, MT), hh = h2 % 10; const float* g = hh < 8 ? a.in[9] : a.in[10];
      float raw0 = 0, raw1 = 0;
      for (int d = 0; d < 128; ++d) { const float v = wdot(AB + (size_t)r * D, a.in[7], N_IN0, hh * 128 + d, D, lane); if (d == lane) raw0 = v; if (d == lane + 64) raw1 = v; }
      const float rstd = rsqrtf(wave_sum(raw0 * raw0 + raw1 * raw1) / 128.f + EPS);
      const float y0 = raw0 * rstd * g[lane], y1 = raw1 * rstd * g[lane + 64];
      float cs, sn; rope_cs(r, lane, cs, sn);
      const float cs0 = __shfl(cs, lane & 31), sn0 = __shfl(sn, lane & 31), cs1 = __shfl(cs, 32 + (lane & 31)), sn1 = __shfl(sn, 32 + (lane & 31));
      const float p0 = __shfl_xor(y0, 32), p1 = __shfl_xor(y1, 32);
      const float o0 = (lane < 32) ? y0 * cs0 - p0 * sn0 : y0 * cs0 + p0 * sn0;
      const float o1 = (lane < 32) ? y1 * cs1 - p1 * sn1 : y1 * cs1 + p1 * sn1;
      bad = !dclose(bf2f(QK[(size_t)r * N_QKV0 + hh * 128 + lane]), o0, 0.03f, 0.05f) + !dclose(bf2f(QK[(size_t)r * N_QKV0 + hh * 128 + 64 + lane]), o1, 0.03f, 0.05f);
      bad = (int)wave_sum((float)bad); dflag(dg, 5, bad, lane); }
    { const int r = pick_row(h2, 0, MT); const int seg0 = r < CTXL ? 0 : CTXL, seg1 = r < CTXL ? CTXL : MT;
      float cv[16]; float s1 = 0, s2 = 0;
      for (int q = 0; q < 16; ++q) { const int c = lane + 64 * q; float acc = a.in[12][c];
        for (int j = 0; j < 31; ++j) { const int rr = r + j - 15; if (rr >= seg0 && rr < seg1) acc += bf2f(HG[(size_t)rr * 1024 + c]) * a.in[11][j * 1024 + c]; }
        cv[q] = acc; s1 += acc; s2 += acc * acc; }
      s1 = wave_sum(s1); s2 = wave_sum(s2); const float mean = s1 / 1024.f, rstd = rsqrtf(s2 / 1024.f - mean * mean + EPS);
      bad = 0;
      for (int q = 0; q < 16; ++q) { const int c = lane + 64 * q; float y = (cv[q] - mean) * rstd * a.in[13][c] + a.in[14][c]; y = y * sigmoidf_(y);
        bad += !dclose(bf2f(X2[(size_t)r * D + 1024 + c]), y, 0.03f, 0.03f); }
      bad = (int)wave_sum((float)bad); dflag(dg, 6, bad, lane); }
  } else if (k == 4) {
    if (gw < 64) { const int r = pick_row(h, 0, MT), head = h2 % 8; const int nkeys = r < CTXL ? CTXL : MT;
      float o0, o1; naive_attn(QK + (size_t)r * N_QKV0 + head * 128, QK + 1024 + (head >> 2) * 128, QK + 1280 + (head >> 2) * 128, N_QKV0, nkeys, lane, o0, o1);
      bad = !dclose(bf2f(X2[(size_t)r * D + head * 128 + lane]), o0, 0.05f, 0.01f) + !dclose(bf2f(X2[(size_t)r * D + head * 128 + 64 + lane]), o1, 0.05f, 0.01f);
      bad = (int)wave_sum((float)bad); dflag(dg, 7, bad, lane); }
  } else if (k == 5 || k == 15) {
    const int r = pick_row(h, ROW0, NTOK), c = h2 % D; const float ref = wdot(X2 + (size_t)r * D, L == 0 ? a.in[8] : a.in[16], D, c, D, lane);
    bad = !dclose(bf2f(OUT[(size_t)r * D + c]), ref, 0.02f, 0.05f); dflag(dg, L == 0 ? 8 : 19, bad, lane);
  } else if (k == 6 || k == 16) {
    const int r = pick_row(h, ROW0, NTOK); const float* mod = MOD + (size_t)(L * 2) * 12288 + (r < CTXL ? 12288 : 0); const float* ng = a.in[6] + (size_t)L * 4 * D;
    float ss = 0; for (int d = lane; d < D; d += 64) { const float o = bf2f(OUT[(size_t)r * D + d]); ss += o * o; } ss = wave_sum(ss); const float rstd1 = rsqrtf(ss / D + EPS);
    bad = 0;
    if (L == 0) { const float* x = h0row(a, r); for (int d = lane; d < D; d += 64) { const float ref = x[d] + mod[2 * D + d] * (bf2f(OUT[(size_t)r * D + d]) * rstd1 * ng[D + d]); bad += !dclose(HRES[(size_t)r * D + d], ref, 1e-3f, 1e-3f); } }
    float s2 = 0; for (int d = lane; d < D; d += 64) { const float x = HRES[(size_t)r * D + d]; s2 += x * x; } s2 = wave_sum(s2); const float rstd2 = rsqrtf(s2 / D + EPS);
    for (int d = lane; d < D; d += 64) { const float f = HRES[(size_t)r * D + d] * rstd2 * ng[2 * D + d] * (1.f + mod[4 * D + d]) + mod[3 * D + d]; fsh[wv][d] = f; bad += !dclose(bf2f(AB[(size_t)r * D + d]), f, 0.01f, 0.01f); }
    bad = (int)wave_sum((float)bad); dflag(dg, L == 0 ? 9 : 20, bad, lane);
    __syncthreads();
    float lg = 0; for (int d = 0; d < D; ++d) lg += fsh[wv][d] * a.in[19][((size_t)L * D + d) * NE + lane];
    const float sc = sigmoidf_(lg); csh[wv][lane] = sc + a.in[20][L * NE + lane];
    __syncthreads();
    { const float plg = ((const float*)(a.ws + WS_Y))[(size_t)r * 64 + lane]; int lb = !dclose(plg, lg, 1e-3f, 1e-3f); lb = (int)wave_sum((float)lb); if (lane == 0 && lb) { atomicAdd(&dg[32 + (L == 0 ? 10 : 21) + 3], 1); atomicOr(&dg[60], 1 << (r & 7)); } }
    unsigned long long wsel;
    { const float choice = csh[wv][lane]; int rank = 0; const int gl = lane & 7;
      for (int j = 0; j < 8; ++j) { const float o = __shfl(choice, (lane & ~7) | j); rank += (o > choice || (o == choice && j < gl)) ? 1 : 0; }
      float gs = rank < 2 ? choice : 0.f; gs += __shfl_xor(gs, 1); gs += __shfl_xor(gs, 2); gs += __shfl_xor(gs, 4);
      int grank = 0; const int g = lane >> 3;
      for (int j = 0; j < 8; ++j) { const float o = __shfl(gs, j * 8); grank += (o > gs || (o == gs && j < g)) ? 1 : 0; }
      const bool gsel = grank < 4; const float mc = gsel ? choice : -INFINITY; int erank = 0;
      for (int j = 0; j < 64; ++j) { const float o = __shfl(mc, j); erank += (o > mc || (o == mc && j < lane)) ? 1 : 0; }
      wsel = __ballot(gsel && erank < 8); }
    int setbad = 0;
    if (lane == 0) {
      float gsc[8]; for (int g = 0; g < 8; ++g) { float m1 = -1e30f, m2 = -1e30f; for (int j = 0; j < 8; ++j) { const float v = csh[wv][g * 8 + j]; if (v > m1) { m2 = m1; m1 = v; } else if (v > m2) m2 = v; } gsc[g] = m1 + m2; }
      bool gs[8] = {false, false, false, false, false, false, false, false};
      for (int t = 0; t < 4; ++t) { int bi = 0; float bv = -1e30f; for (int g = 0; g < 8; ++g) if (!gs[g] && gsc[g] > bv) { bv = gsc[g]; bi = g; } gs[bi] = true; }
      unsigned long long selm = 0; for (int t = 0; t < 8; ++t) { int bi = 0; float bv = -1e30f; for (int e = 0; e < 64; ++e) if (gs[e >> 3] && !((selm >> e) & 1ull) && csh[wv][e] > bv) { bv = csh[wv][e]; bi = e; } selm |= 1ull << bi; }
      unsigned long long got = 0; for (int t = 0; t < 8; ++t) { const int e = top_e[r * 8 + t]; if (e < 0 || e > 63) setbad = 1000; else got |= 1ull << e; }
      if (setbad == 0 && got != selm) setbad = 1;
      if (wsel != selm) atomicAdd(&dg[32 + (L == 0 ? 10 : 21) + 4], 1);
    }
    setbad = __shfl(setbad, 0);
    { float wgot = -1.f; int mine = 0; for (int t = 0; t < 8; ++t) if (top_e[r * 8 + t] == lane) { mine = 1; wgot = top_w[r * 8 + t]; }
      const float ssum = wave_sum(mine ? sc : 0.f);
      int wbad = (mine && !dclose(wgot, sc / ssum * 2.5f, 0.01f, 1e-3f)) ? 1 : 0; wbad = (int)wave_sum((float)wbad);
      if (lane == 0) { int* q = &dg[32 + (L == 0 ? 10 : 21)]; if (setbad >= 1000) atomicAdd(q + 1, 1); else if (setbad) atomicAdd(q, 1); else if (wbad) atomicAdd(q + 2, 1); } }
  } else if (k == 7 || k == 17) {
    const int r = pick_row(h, ROW0, NTOK), t = h2 % 8, q = r * 8 + t; const int slot = tslot[q], e = top_e[q];
    int ts0 = 0; for (int j = 0; j < e; ++j) ts0 += (counts[j] + 255) >> 8;
    bad = (slot < ts0 * 256 || slot >= ts0 * 256 + counts[e] || stok[slot] != r || top_p[q] != slot - ts0 * 256) ? 1 : 0;
    bad += (stok[SH_BASE + r - ROW0] != r) ? 1 : 0;
    dflag(dg, L == 0 ? 11 : 22, bad, lane);
  } else if (k == 8 || k == 18 || k == 9 || k == 19) {
    int TR = 0; for (int j = 0; j < 64; ++j) TR += (counts[j] + 255) >> 8;
    int slot, e;
    if ((h & 3) == 0) { slot = SH_BASE + (int)((h >> 2) % (unsigned)NTOK); e = 64; }
    else { e = (h >> 2) % 64; int guard = 0; while (counts[e] == 0 && guard++ < 64) e = (e + 1) % 64; int ts0 = 0; for (int j = 0; j < e; ++j) ts0 += (counts[j] + 255) >> 8;
      const unsigned m = (h >> 8) % 4; const int cnt = counts[e]; const int p = m == 0 ? 0 : m == 1 ? cnt - 1 : (int)((h >> 10) % (unsigned)cnt); slot = ts0 * 256 + p; }
    const int tok = stok[slot];
    if (k == 8 || k == 18) {
      const int ch = h2 % EFF;
      const float* Wg = e < 64 ? a.in[21] + ((size_t)L * 64 + e) * D * EFF : a.in[24] + (size_t)L * D * EFF;
      const float* Wu = e < 64 ? a.in[22] + ((size_t)L * 64 + e) * D * EFF : a.in[25] + (size_t)L * D * EFF;
      const float gv = wdot(AB + (size_t)tok * D, Wg, EFF, ch, D, lane), uv = wdot(AB + (size_t)tok * D, Wu, EFF, ch, D, lane);
      bad = !dclose(bf2f(ACT[(size_t)slot * EFF + ch]), gv * sigmoidf_(gv) * uv, 0.03f, 0.03f); dflag(dg, L == 0 ? 12 : 23, bad, lane);
    } else {
      const int c = h2 % D; const float* Wd = e < 64 ? a.in[23] + ((size_t)L * 64 + e) * EFF * D : a.in[26] + (size_t)L * EFF * D;
      const float ref = wdot(ACT + (size_t)slot * EFF, Wd, D, c, EFF, lane);
      bad = !dclose(bf2f(Y[(size_t)slot * D + c]), ref, 0.02f, 0.03f); dflag(dg, L == 0 ? 13 : 24, bad, lane);
    }
  } else if (k == 10 || k == 20) {
    const int r = pick_row(h, ROW0, NTOK); const float* mod = MOD + (size_t)(L * 2) * 12288 + (r < CTXL ? 12288 : 0); const float* ng = a.in[6] + (size_t)L * 4 * D;
    float ss = 0; for (int d = lane; d < D; d += 64) { float y = bf2f(Y[(size_t)(SH_BASE + r - ROW0) * D + d]); for (int t = 0; t < 8; ++t) y += top_w[r * 8 + t] * bf2f(Y[(size_t)tslot[r * 8 + t] * D + d]); fsh[wv][d] = y; ss += y * y; }
    ss = wave_sum(ss); const float rstd = rsqrtf(ss / D + EPS);
    bad = 0;
    if (L == 0) { float s2 = 0; for (int d = lane; d < D; d += 64) { const float x = HRES[(size_t)r * D + d]; s2 += x * x; } s2 = wave_sum(s2); const float rstd2 = rsqrtf(s2 / D + EPS);
      const float* mod1 = MOD + (size_t)2 * 12288 + (r < CTXL ? 12288 : 0);
      for (int d = lane; d < D; d += 64) { const float ref = HRES[(size_t)r * D + d] * rstd2 * a.in[6][4 * D + d] * (1.f + mod1[D + d]) + mod1[d]; bad += !dclose(bf2f(AB[(size_t)r * D + d]), ref, 0.01f, 0.01f); } }
    else { for (int d = lane; d < D; d += 64) { const float ref = HRES[(size_t)r * D + d] + mod[5 * D + d] * (fsh[wv][d] * rstd * ng[3 * D + d]); bad += !dclose(a.out[(size_t)(r - CTXL) * D + d], ref, 1e-3f, 1e-3f); } }
    bad = (int)wave_sum((float)bad); dflag(dg, L == 0 ? 14 : 25, bad, lane);
  } else if (k == 12) {
    const int r = pick_row(h, CTXL, SEQ), hh = h2 % 32;
    float raw0 = 0, raw1 = 0;
    for (int d = 0; d < 128; ++d) { const float v = wdot(AB + (size_t)r * D, a.in[15], N_IN1, hh * 128 + d, D, lane); if (d == lane) raw0 = v; if (d == lane + 64) raw1 = v; }
    float cs, sn; rope_cs(r, lane, cs, sn);
    const float cs0 = __shfl(cs, lane & 31), sn0 = __shfl(sn, lane & 31), cs1 = __shfl(cs, 32 + (lane & 31)), sn1 = __shfl(sn, 32 + (lane & 31));
    const float p0 = __shfl_xor(raw0, 32), p1 = __shfl_xor(raw1, 32);
    const float o0 = (lane < 32) ? raw0 * cs0 - p0 * sn0 : raw0 * cs0 + p0 * sn0;
    const float o1 = (lane < 32) ? raw1 * cs1 - p1 * sn1 : raw1 * cs1 + p1 * sn1;
    bad = !dclose(bf2f(QK[(size_t)r * N_IN1 + hh * 128 + lane]), o0, 0.03f, 0.05f) + !dclose(bf2f(QK[(size_t)r * N_IN1 + hh * 128 + 64 + lane]), o1, 0.03f, 0.05f);
    bad = (int)wave_sum((float)bad); dflag(dg, 16, bad, lane);
  } else if (k == 13) {
    if (gw < 64) { const int r = pick_row(h, CTXL, SEQ), hc = h2 % 16, vh = (h2 >> 4) & 1, hd = hc >> 1;
      float o0, o1; naive_attn(QK + (size_t)r * N_IN1 + hc * 128, QK + 2048 + hc * 128, QK + 4096 + hd * 256 + vh * 128, N_IN1, MT, lane, o0, o1);
      const bf16_t* O = Y + (size_t)(r - CTXL) * 4096 + hc * 256 + vh * 128;
      bad = !dclose(bf2f(O[lane]), o0, 0.05f, 0.01f) + !dclose(bf2f(O[64 + lane]), o1, 0.05f, 0.01f);
      bad = (int)wave_sum((float)bad); dflag(dg, 17, bad, lane); }
  } else if (k == 14) {
    const int r = pick_row(h, CTXL, SEQ), hd = h2 % 8; const float* lp = a.in[17];
    float s1 = 0, s2 = 0; for (int i = lane; i < 128; i += 64) { s1 += lp[i] * lp[128 + i]; s2 += lp[256 + i] * lp[384 + i]; } s1 = wave_sum(s1); s2 = wave_sum(s2);
    const float lam = expf(s1) - expf(s2) + LAM_INIT; const bf16_t* O = Y + (size_t)(r - CTXL) * 4096;
    float dv[4], ss = 0; for (int i = 0; i < 4; ++i) { const int d = lane + 64 * i; dv[i] = bf2f(O[(2 * hd) * 256 + d]) - lam * bf2f(O[(2 * hd + 1) * 256 + d]); ss += dv[i] * dv[i]; }
    ss = wave_sum(ss); const float rstd = rsqrtf(ss / 256.f + EPS) * (1.f - LAM_INIT); bad = 0;
    for (int i = 0; i < 4; ++i) { const int d = lane + 64 * i; bad += !dclose(bf2f(X2[(size_t)r * D + hd * 256 + d]), dv[i] * rstd * a.in[18][d], 0.02f, 0.01f); }
    bad = (int)wave_sum((float)bad); dflag(dg, 18, bad, lane);
  }
}
__global__ void diag_encode(Args a) {
  const int* dg = (const int*)(a.ws + WS_CTL + CTL_CNT + 512);
  int s = 0;
  int sub = 0;
  for (int i = 1; i < 32; ++i) { int v = dg[i]; if (i == 10 || i == 21) { v = (dg[32 + i] > 25 ? 1 : 0) + (dg[33 + i] > 0 ? 2 : 0) + (dg[34 + i] > 0 ? 4 : 0) + (dg[35 + i] > 0 ? 8 : 0) + (dg[36 + i] > 0 ? 16 : 0); sub = v; } if (v) { s = i; break; } }
  if (s == 0) return;
  const float c = sub ? 30.f + 8.f * sub : 10.f * s;
  for (size_t i = (size_t)blockIdx.x * blockDim.x + threadIdx.x; i < (size_t)SEQ * D; i += (size_t)gridDim.x * blockDim.x) a.out[i] = c;
}
#endif

extern "C" void kernel_launch(void* const* d_in, const int* in_sizes, int n_in, void* d_out, int out_size, void* d_ws, size_t ws_size, hipStream_t stream) {
  static int grid = 0;
  if (grid == 0) {
    if (n_in != 27 || out_size != SEQ * D || ws_size < WS_END) { fprintf(stderr, "kernel_launch: unexpected shapes (n_in %d out %d ws %zu need %zu)\n", n_in, out_size, ws_size, (size_t)WS_END); grid = -1; return; }
    if (hipFuncSetAttribute((const void*)fwd, hipFuncAttributeMaxDynamicSharedMemorySize, LDS_BYTES) != hipSuccess) { fprintf(stderr, "kernel_launch: hipFuncSetAttribute failed\n"); grid = -1; return; }
    int dev = 0, cus = 0, per_cu = 0;
    hipGetDevice(&dev); hipDeviceGetAttribute(&cus, hipDeviceAttributeMultiprocessorCount, dev);
    if (hipOccupancyMaxActiveBlocksPerMultiprocessor(&per_cu, (const void*)fwd, NTHREADS, LDS_BYTES) != hipSuccess || per_cu < 1) fprintf(stderr, "kernel_launch: occupancy query says %d\n", per_cu);
    (void)hipGetLastError();
    grid = cus < 256 ? cus : 256;
    if (grid != 256) fprintf(stderr, "kernel_launch: %d CUs (expected 256)\n", cus);
  }
  if (grid < 0) return;
  hipMemsetAsync((char*)d_ws + WS_CTL, 0, CTL_BYTES, stream);
  Args a{};
  for (int i = 0; i < 27; ++i) a.in[i] = (const float*)d_in[i];
  a.out = (float*)d_out; a.ws = (unsigned char*)d_ws;
#if MK_MULTI
  for (int k = 0; k < NPH; ++k) { a.ph_lo = k; a.ph_hi = k + 1; hipLaunchKernelGGL(fwd, dim3(grid), dim3(NTHREADS), LDS_BYTES, stream, a);
#if MK_DIAG
    hipLaunchKernelGGL(diag, dim3(64), dim3(256), 0, stream, a, k);
#endif
  }
#if MK_DIAG
  hipLaunchKernelGGL(diag_encode, dim3(1024), dim3(256), 0, stream, a);
#endif
#else
  a.ph_lo = 0; a.ph_hi = NPH;
  hipLaunchKernelGGL(fwd, dim3(grid), dim3(NTHREADS), LDS_BYTES, stream, a);
#endif
  const hipError_t le = hipPeekAtLastError();
  if (le != hipSuccess) fprintf(stderr, "kernel_launch: launch failed: %s\n", hipGetErrorName(le));
}
```

```cpp
#include <hip/hip_runtime.h>
#include <cstdio>
#include <cstdint>

#define MK_DIAG 0
#ifndef MK_MULTI
#define MK_MULTI 0
#endif

#define LAS __attribute__((address_space(3)))
typedef unsigned short bf16_t;
typedef short bf16x8 __attribute__((ext_vector_type(8)));
typedef short s16x4 __attribute__((ext_vector_type(4)));
typedef float f32x4 __attribute__((ext_vector_type(4)));
typedef float f32x2 __attribute__((ext_vector_type(2)));
typedef float f32x16 __attribute__((ext_vector_type(16)));
typedef unsigned u32x4 __attribute__((ext_vector_type(4)));
typedef unsigned u32x2 __attribute__((ext_vector_type(2)));

constexpr int D = 2048, SEQ = 16384, CTXL = 256, MT = SEQ + CTXL;
constexpr int NE = 64, TOPK = 8, EFF = 512;
constexpr int N_IN0 = 3584, N_QKV0 = 1536, N_IN1 = 6144;
constexpr float EPS = 1e-6f;
constexpr float LAM_INIT = 0.35550907f;
constexpr int SH_BASE = SEQ * 0 + (MT * TOPK) + NE * 256;
constexpr int NSLOT = SH_BASE + MT;
constexpr int NTHREADS = 512;
constexpr int LDS_BYTES = 131072 + 1024;
constexpr int LDS_CTL = 131072;

constexpr size_t al256(size_t x) { return (x + 255) & ~(size_t)255; }
constexpr size_t WS_CTL   = 0;
constexpr size_t CTL_BYTES = 32768;
constexpr size_t CTL_CNT  = 16384;
constexpr size_t CTL_KMAX = 16384 + 2048;
constexpr size_t WS_MOD   = CTL_BYTES;
constexpr size_t WS_WIN0  = al256(WS_MOD + 2 * 2 * 12288 * 4);
constexpr size_t WS_WOUT0 = al256(WS_WIN0 + (size_t)N_IN0 * D * 2);
constexpr size_t WS_WIN1  = al256(WS_WOUT0 + (size_t)D * D * 2);
constexpr size_t WS_WOUT1 = al256(WS_WIN1 + (size_t)N_IN1 * D * 2);
constexpr size_t WMOE_E   = (size_t)1024 * D + (size_t)D * EFF;
constexpr size_t WS_WMOE  = al256(WS_WOUT1 + (size_t)D * D * 2);
constexpr size_t WS_HRES  = al256(WS_WMOE + 65 * WMOE_E * 2);
constexpr size_t WS_ABUF  = al256(WS_HRES + (size_t)MT * D * 4);
constexpr size_t WS_QKVU  = al256(WS_ABUF + (size_t)MT * D * 2);
constexpr size_t WS_HG    = al256(WS_QKVU + (size_t)MT * N_IN1 * 2);
constexpr size_t WS_X2    = al256(WS_HG + (size_t)MT * 1024 * 2);
constexpr size_t WS_OUT   = al256(WS_X2 + (size_t)MT * D * 2);
constexpr size_t WS_ACT   = al256(WS_OUT + (size_t)MT * D * 2);
constexpr size_t WS_Y     = al256(WS_ACT + (size_t)NSLOT * EFF * 2);
constexpr size_t WS_TOPE  = al256(WS_Y + (size_t)NSLOT * D * 2);
constexpr size_t WS_TOPW  = al256(WS_TOPE + (size_t)MT * TOPK * 4);
constexpr size_t WS_TOPP  = al256(WS_TOPW + (size_t)MT * TOPK * 4);
constexpr size_t WS_TSLOT = al256(WS_TOPP + (size_t)MT * TOPK * 4);
constexpr size_t WS_STOK  = al256(WS_TSLOT + (size_t)MT * TOPK * 4);
constexpr size_t WS_END   = al256(WS_STOK + (size_t)NSLOT * 4);

struct Args { const float* in[27]; float* out; unsigned char* ws; int ph_lo, ph_hi; };

__device__ __forceinline__ float bflo(unsigned x) { return __uint_as_float(x << 16); }
__device__ __forceinline__ float bfhi(unsigned x) { return __uint_as_float(x & 0xffff0000u); }
__device__ __forceinline__ float bf2f(bf16_t b) { return __uint_as_float(((unsigned)b) << 16); }
__device__ __forceinline__ unsigned cvtpk(float lo, float hi) { unsigned r; asm("v_cvt_pk_bf16_f32 %0, %1, %2" : "=v"(r) : "v"(lo), "v"(hi)); return r; }
__device__ __forceinline__ bf16_t f2bf(float x) { return (bf16_t)(cvtpk(x, 0.f) & 0xffffu); }
__device__ __forceinline__ float wave_sum(float v) {
#pragma unroll
  for (int o = 32; o; o >>= 1) v += __shfl_xor(v, o);
  return v;
}
__device__ __forceinline__ float sigmoidf_(float x) { return 1.f / (1.f + expf(-x)); }
__device__ __forceinline__ float sigmoid_fast(float x) { return __builtin_amdgcn_rcpf(1.f + __builtin_amdgcn_exp2f(-1.4426950408889634f * x)); }

#define XB_TMO      128
#define XB_XCNT(j)  (256  + 64 * (j))
#define XB_XSUB(j)  (1280 + 64 * (j))
#define XB_XGEN(j)  (2304 + 64 * (j))
#define XB_TOP      3328
#define XB_TOPGEN   3392
#define XCD_BAR_WORDS 3456
#define XB_SPIN_CAP (1u << 22)
__device__ __forceinline__ unsigned xb_ld(unsigned* p)              { return __hip_atomic_load(p, __ATOMIC_RELAXED, __HIP_MEMORY_SCOPE_AGENT); }
__device__ __forceinline__ unsigned xb_add(unsigned* p, unsigned v) { return __hip_atomic_fetch_add(p, v, __ATOMIC_RELAXED, __HIP_MEMORY_SCOPE_AGENT); }
__device__ __forceinline__ unsigned xb_xcc_id() { return (unsigned)__builtin_amdgcn_s_getreg((3 << 11) | 20) & 0xFu; }
#define XB_SPIN(cond, bar) do { unsigned _sp = 0; while (cond) { __builtin_amdgcn_s_sleep(1); \
    if ((++_sp & 255u) == 0u) { if (xb_ld(&(bar)[XB_TMO])) break; if (_sp > XB_SPIN_CAP) { atomicAdd(&(bar)[XB_TMO], 1u); break; } } } } while (0)
struct XcdBarrier { unsigned* bar; unsigned x; volatile LAS unsigned* st; };
__device__ __forceinline__ XcdBarrier xcd_barrier_post(unsigned* bar, volatile LAS unsigned* st) {
    XcdBarrier b; b.bar = bar; b.x = xb_xcc_id(); b.st = st;
    if (threadIdx.x == 0) (void)xb_add(&bar[XB_XCNT(b.x)], 1u);
    return b;
}
__device__ __forceinline__ void xcd_barrier_complete(unsigned* bar, unsigned x, unsigned& nloc, unsigned& nx) {
    const unsigned G = gridDim.x * gridDim.y * gridDim.z;
    unsigned sum, cnt, mine, sp = 0u;
    for (;;) {
        sum = 0u; cnt = 0u; mine = 0u;
#pragma unroll
        for (unsigned j = 0; j < 16; ++j) { const unsigned c = xb_ld(&bar[XB_XCNT(j)]); sum += c; cnt += (c > 0u) ? 1u : 0u; mine = (j == x) ? c : mine; }
        if (sum == G) break;
        __builtin_amdgcn_s_sleep(1);
        if ((++sp & 255u) == 0u) { if (xb_ld(&bar[XB_TMO])) break; if (sp > XB_SPIN_CAP) { atomicAdd(&bar[XB_TMO], 1u); break; } }
    }
    nloc = mine > 0u ? mine : 1u; nx = cnt > 0u ? cnt : 1u;
}
__device__ __forceinline__ void xcd_barrier(const XcdBarrier& b) {
    asm volatile("s_waitcnt vmcnt(0)" ::: "memory");
    __syncthreads();
    if (threadIdx.x == 0) {
        unsigned* bar = b.bar;
        __builtin_amdgcn_s_waitcnt(0);
        unsigned nloc = b.st[0], nx = b.st[1];
        if (nloc == 0u) { xcd_barrier_complete(bar, b.x, nloc, nx); b.st[0] = nloc; b.st[1] = nx; }
        const unsigned old = xb_add(&bar[XB_XSUB(b.x)], 1u);
        const unsigned gen = old / nloc;
        if (old + 1u == (gen + 1u) * nloc) {
            __builtin_amdgcn_fence(__ATOMIC_RELEASE, "agent");
            asm volatile("s_waitcnt vmcnt(0)" ::: "memory");
            const unsigned og = xb_add(&bar[XB_TOP], 1u);
            const unsigned tg = og / nx;
            if (og + 1u == (tg + 1u) * nx) xb_add(&bar[XB_TOPGEN], 1u);
            else XB_SPIN(xb_ld(&bar[XB_TOPGEN]) == tg, bar);
            __builtin_amdgcn_fence(__ATOMIC_ACQUIRE, "agent");
            xb_add(&bar[XB_XGEN(b.x)], 1u);
            asm volatile("s_waitcnt vmcnt(0)" ::: "memory");
        } else {
            XB_SPIN(xb_ld(&bar[XB_XGEN(b.x)]) == gen, bar);
            __builtin_amdgcn_fence(__ATOMIC_ACQUIRE, "agent");
            asm volatile("s_waitcnt vmcnt(0)" ::: "memory");
        }
    }
    __syncthreads();
}

__device__ __forceinline__ int lds_byte(int r, int c) {
  int st = (r >> 4) * 2 + (c >> 5), rr = r & 15, cc = c & 31, ob = rr * 64 + cc * 2;
  return st * 1024 + (ob ^ (((ob >> 9) & 1) << 5));
}
#define GLDS(gp, lp) __builtin_amdgcn_global_load_lds((const unsigned*)(gp), (LAS unsigned*)(lp), 16, 0, 0)
#define WAIT_V(n) asm volatile("s_waitcnt vmcnt(" #n ")" ::: "memory")
#define WAIT_L(n) asm volatile("s_waitcnt lgkmcnt(" #n ")" ::: "memory")
#define BAR __builtin_amdgcn_s_barrier()
#define SCHED __builtin_amdgcn_sched_barrier(0)

template <bool GATHER, class Epi>
__device__ __forceinline__ void gemm_tile(const bf16_t* __restrict__ A, const int lda, const int* __restrict__ tok, const int brow,
                                          const bf16_t* __restrict__ Bt, const int ldb, const int bcol, const int K,
                                          LAS char* shm, const Epi& epi) {
#define G_SA(b, h) (shm + ((b) * 2 + (h)) * 16384)
#define G_SB(b, h) (shm + (4 + (b) * 2 + (h)) * 16384)
  int tid = threadIdx.x; asm volatile("" : "+v"(tid)); tid &= 511;
  int wid = tid >> 6, lane = tid & 63, wr = wid >> 2, wc = wid & 3, fr = lane & 15, fq = lane >> 4;
  unsigned ao0, ao1, ao2, ao3, bo;
  {
    const int sb = (tid & 63) * 16, swz = sb ^ (((sb >> 9) & 1) << 5);
    const int R0 = ((tid >> 6) >> 1) * 16 + (swz >> 6), C0 = ((tid >> 6) & 1) * 32 + ((swz & 63) >> 1);
    if (GATHER) { ao0 = (unsigned)(tok[R0] * lda + C0); ao1 = (unsigned)(tok[R0 + 64] * lda + C0); ao2 = (unsigned)(tok[R0 + 128] * lda + C0); ao3 = (unsigned)(tok[R0 + 192] * lda + C0); }
    else { ao0 = (unsigned)((brow + R0) * lda + C0); ao1 = ao0 + 64u * lda; ao2 = ao0 + 128u * lda; ao3 = ao0 + 192u * lda; }
    bo = (unsigned)((bcol + R0) * ldb + C0);
  }
  const int lo = __builtin_amdgcn_readfirstlane(tid >> 6) * 1024;
#define STAGE_A0(P, kt) do { GLDS((A + (kt) * 64) + ao0, (P) + lo); GLDS((A + (kt) * 64) + ao1, (P) + lo + 8192); } while (0)
#define STAGE_A1(P, kt) do { GLDS((A + (kt) * 64) + ao2, (P) + lo); GLDS((A + (kt) * 64) + ao3, (P) + lo + 8192); } while (0)
#define STAGE_B0(P, kt) do { GLDS((Bt + (kt) * 64) + bo, (P) + lo); GLDS((Bt + 64 * ldb + (kt) * 64) + bo, (P) + lo + 8192); } while (0)
#define STAGE_B1(P, kt) do { GLDS((Bt + 128 * ldb + (kt) * 64) + bo, (P) + lo); GLDS((Bt + 192 * ldb + (kt) * 64) + bo, (P) + lo + 8192); } while (0)
#define LDA(dst, b, h) _Pragma("unroll") for (int m = 0; m < 4; ++m) _Pragma("unroll") for (int k = 0; k < 2; ++k) \
    dst[m][k] = *(LAS const bf16x8*)(G_SA(b, h) + lds_byte(wr * 64 + m * 16 + fr, k * 32 + fq * 8))
#define LDB(dst, b, h) _Pragma("unroll") for (int n = 0; n < 2; ++n) _Pragma("unroll") for (int k = 0; k < 2; ++k) \
    dst[n][k] = *(LAS const bf16x8*)(G_SB(b, h) + lds_byte(wc * 32 + n * 16 + fr, k * 32 + fq * 8))
#define MMA(ai, bj, At_, Bt_) do { __builtin_amdgcn_s_setprio(1); \
    _Pragma("unroll") for (int m = 0; m < 4; ++m) _Pragma("unroll") for (int n = 0; n < 2; ++n) _Pragma("unroll") for (int k = 0; k < 2; ++k) \
      acc[ai][bj][m][n] = __builtin_amdgcn_mfma_f32_16x16x32_bf16(Bt_[n][k], At_[m][k], acc[ai][bj][m][n], 0, 0, 0); \
    __builtin_amdgcn_s_setprio(0); } while (0)

  f32x4 acc[2][2][4][2] = {};
  bf16x8 At[4][2], B0[2][2], B1[2][2];
  const int nt = K / 64;
  STAGE_B0(G_SB(0, 0), 0); STAGE_A0(G_SA(0, 0), 0);
  STAGE_B1(G_SB(0, 1), 0); STAGE_A1(G_SA(0, 1), 0);
  if (wr == 1) BAR;
  WAIT_V(4); BAR;
  STAGE_B0(G_SB(1, 0), 1); STAGE_A0(G_SA(1, 0), 1); STAGE_B1(G_SB(1, 1), 1);
  WAIT_V(6); BAR;
  for (int t = 0; t < nt - 2; t += 2) {
    LDB(B0, 0, 0); SCHED; LDA(At, 0, 0); STAGE_A1(G_SA(1, 1), t + 1);
    WAIT_L(8); BAR; WAIT_L(0); MMA(0, 0, At, B0); BAR; SCHED;
    LDB(B1, 0, 1); STAGE_B0(G_SB(0, 0), t + 2);
    BAR; WAIT_L(0); MMA(0, 1, At, B1); BAR;
    LDA(At, 0, 1); STAGE_A0(G_SA(0, 0), t + 2);
    BAR; WAIT_L(0); MMA(1, 0, At, B0); BAR; SCHED;
    STAGE_B1(G_SB(0, 1), t + 2);
    WAIT_V(6); BAR; MMA(1, 1, At, B1); BAR;
    LDB(B0, 1, 0); SCHED; LDA(At, 1, 0); STAGE_A1(G_SA(0, 1), t + 2);
    WAIT_L(8); BAR; WAIT_L(0); MMA(0, 0, At, B0); BAR; SCHED;
    LDB(B1, 1, 1); STAGE_B0(G_SB(1, 0), t + 3);
    BAR; WAIT_L(0); MMA(0, 1, At, B1); BAR;
    LDA(At, 1, 1); STAGE_A0(G_SA(1, 0), t + 3);
    BAR; WAIT_L(0); MMA(1, 0, At, B0); BAR; SCHED;
    STAGE_B1(G_SB(1, 1), t + 3);
    WAIT_V(6); BAR; MMA(1, 1, At, B1); BAR;
  }
  { LDB(B0, 0, 0); WAIT_V(0); LDA(At, 0, 0); STAGE_A1(G_SA(1, 1), nt - 1);
    BAR; WAIT_L(0); MMA(0, 0, At, B0); BAR;
    LDB(B1, 0, 1); BAR; WAIT_L(0); MMA(0, 1, At, B1); BAR;
    LDA(At, 0, 1); WAIT_V(4); BAR; WAIT_L(0); MMA(1, 0, At, B0); MMA(1, 1, At, B1); BAR; }
  { LDB(B0, 1, 0); LDA(At, 1, 0); WAIT_V(2); BAR; WAIT_L(0); MMA(0, 0, At, B0); BAR;
    LDB(B1, 1, 1); WAIT_V(0); BAR; WAIT_L(0); MMA(0, 1, At, B1); BAR;
    LDA(At, 1, 1); BAR; WAIT_L(0); MMA(1, 0, At, B0); MMA(1, 1, At, B1); BAR; }
  if (wr == 0) BAR;
  int tz = threadIdx.x; asm volatile("" : "+v"(tz)); wid = tz >> 6; lane = tz & 63; wr = wid >> 2; wc = wid & 3; fr = lane & 15; fq = lane >> 4;
  epi(acc, brow, bcol, wr, wc, fr, fq);
#undef G_SA
#undef G_SB
#undef STAGE_A0
#undef STAGE_A1
#undef STAGE_B0
#undef STAGE_B1
#undef LDA
#undef LDB
#undef MMA
}

struct EpiPlain {
  bf16_t* C; int ldc;
  __device__ __forceinline__ void operator()(const f32x4 (&acc)[2][2][4][2], int brow, int bcol, int wr, int wc, int fr, int fq) const {
#pragma unroll
    for (int ai = 0; ai < 2; ++ai)
#pragma unroll
      for (int m = 0; m < 4; ++m) {
        bf16_t* rp = C + (size_t)(brow + ai * 128 + wr * 64 + m * 16 + fr) * ldc + bcol + wc * 32 + fq * 8;
#pragma unroll
        for (int bj = 0; bj < 2; ++bj) {
          u32x4 v = {cvtpk(acc[ai][bj][m][0][0], acc[ai][bj][m][0][1]), cvtpk(acc[ai][bj][m][0][2], acc[ai][bj][m][0][3]),
                     cvtpk(acc[ai][bj][m][1][0], acc[ai][bj][m][1][1]), cvtpk(acc[ai][bj][m][1][2], acc[ai][bj][m][1][3])};
          *(u32x4*)(rp + bj * 128) = v;
        }
      }
  }
};
template <int MODE>
struct EpiPair {
  bf16_t* C; int ldc; int colbase;
  __device__ __forceinline__ void operator()(const f32x4 (&acc)[2][2][4][2], int brow, int bcol, int wr, int wc, int fr, int fq) const {
#pragma unroll
    for (int ai = 0; ai < 2; ++ai)
#pragma unroll
      for (int m = 0; m < 4; ++m) {
        bf16_t* rp = C + (size_t)(brow + ai * 128 + wr * 64 + m * 16 + fr) * ldc + ((bcol - colbase) >> 1) + wc * 16 + fq * 4;
#pragma unroll
        for (int bj = 0; bj < 2; ++bj) {
          float r[4];
#pragma unroll
          for (int j = 0; j < 4; ++j) {
            const float x0 = acc[ai][bj][m][0][j], x1 = acc[ai][bj][m][1][j];
            r[j] = MODE == 0 ? x0 * sigmoid_fast(x1) : x0 * sigmoid_fast(x0) * x1;
          }
          u32x2 v = {cvtpk(r[0], r[1]), cvtpk(r[2], r[3])};
          *(u32x2*)(rp + bj * 64) = v;
        }
      }
  }
};
struct EpiG1 {
  EpiPlain p; EpiPair<0> g; int nplain;
  __device__ __forceinline__ void operator()(const f32x4 (&acc)[2][2][4][2], int brow, int bcol, int wr, int wc, int fr, int fq) const {
    if (bcol < nplain) p(acc, brow, bcol, wr, wc, fr, fq); else g(acc, brow, bcol, wr, wc, fr, fq);
  }
};

typedef int v8i __attribute__((ext_vector_type(8)));
typedef int v4i __attribute__((ext_vector_type(4)));
__device__ __forceinline__ int lds8(int r, int c) { return r * 128 + ((c ^ ((r >> 1) & 7)) << 4); }
template <bool GATHER, int lda, int ldb, int K, class Epi, class S>
__device__ __forceinline__ void gemm8_run(const unsigned char* __restrict__ A, const int* __restrict__ stok,
                                          LAS char* shm, const Epi& epi, const S& sched) {
#define G_SA(b, h) (shm + ((b) * 2 + (h)) * 16384)
#define G_SB(b, h) (shm + (4 + (b) * 2 + (h)) * 16384)
  int tid = threadIdx.x; asm volatile("" : "+v"(tid)); tid &= 511;
  int wid = tid >> 6, lane = tid & 63, wr = wid >> 2, wc = wid & 3, fr = lane & 15, fq = lane >> 4;
  unsigned ao0, ao1, ao2, ao3, bo;
  int R0 = 8 * wid + (lane >> 3), C0 = ((lane & 7) ^ ((R0 >> 1) & 7)) << 4;
  const int lo = __builtin_amdgcn_readfirstlane(tid >> 6) * 1024;
  int brow, bcol; const unsigned char* Bt;
  int ui = 0;
  if (!sched.unit(ui, brow, Bt, bcol)) return;
#define SETOFF(br, bc) do { if (GATHER) { const int* _t = stok + (br); ao0 = (unsigned)(_t[R0] * lda + C0); ao1 = (unsigned)(_t[R0 + 64] * lda + C0); ao2 = (unsigned)(_t[R0 + 128] * lda + C0); ao3 = (unsigned)(_t[R0 + 192] * lda + C0); } \
    else { ao0 = (unsigned)(((br) + R0) * lda + C0); ao1 = ao0 + 64u * lda; ao2 = ao0 + 128u * lda; ao3 = ao0 + 192u * lda; } \
    bo = (unsigned)(((bc) + R0) * ldb + C0); } while (0)
#define STAGE_A0(P, kt) do { GLDS((A + (kt) * 128) + ao0, (P) + lo); GLDS((A + (kt) * 128) + ao1, (P) + lo + 8192); } while (0)
#define STAGE_A1(P, kt) do { GLDS((A + (kt) * 128) + ao2, (P) + lo); GLDS((A + (kt) * 128) + ao3, (P) + lo + 8192); } while (0)
#define STAGE_B0(P, kt) do { GLDS((Bt + (kt) * 128) + bo, (P) + lo); GLDS((Bt + 64 * ldb + (kt) * 128) + bo, (P) + lo + 8192); } while (0)
#define STAGE_B1(P, kt) do { GLDS((Bt + 128 * ldb + (kt) * 128) + bo, (P) + lo); GLDS((Bt + 192 * ldb + (kt) * 128) + bo, (P) + lo + 8192); } while (0)
#define PRO() do { STAGE_B0(G_SB(0, 0), 0); STAGE_A0(G_SA(0, 0), 0); STAGE_B1(G_SB(0, 1), 0); STAGE_A1(G_SA(0, 1), 0); } while (0)
  const int fx = (fq ^ ((fr >> 1) & 7)) << 4;
  const int fa0 = (wr * 64 + fr) * 128 + fx, fb0 = (wc * 32 + fr) * 128 + fx;
#define FRAG8(dst, p0, p1) do { const v4i _x = *(LAS const v4i*)(p0); const v4i _y = *(LAS const v4i*)(p1); \
    dst = (v8i){_x[0], _x[1], _x[2], _x[3], _y[0], _y[1], _y[2], _y[3]}; } while (0)
#define LDA(dst, b, h) do { int fa1 = fa0; asm volatile("v_xor_b32 %0, 64, %0" : "+v"(fa1)); \
    _Pragma("unroll") for (int m = 0; m < 4; ++m) FRAG8(dst[m], G_SA(b, h) + fa0 + m * 2048, G_SA(b, h) + fa1 + m * 2048); } while (0)
#define LDB(dst, b, h) do { int fb1 = fb0; asm volatile("v_xor_b32 %0, 64, %0" : "+v"(fb1)); \
    _Pragma("unroll") for (int n = 0; n < 2; ++n) FRAG8(dst[n], G_SB(b, h) + fb0 + n * 2048, G_SB(b, h) + fb1 + n * 2048); } while (0)
#define MMA(ai, bj, At_, Bt_) do { __builtin_amdgcn_s_setprio(1); \
    _Pragma("unroll") for (int m = 0; m < 4; ++m) _Pragma("unroll") for (int n = 0; n < 2; ++n) \
      asm volatile("v_mfma_scale_f32_16x16x128_f8f6f4 %0, %1, %2, %0, %3, %3 op_sel_hi:[0,0,0]" : "+v"(acc[ai][bj][m][n]) : "v"(Bt_[n]), "v"(At_[m]), "v"(sc1)); \
    __builtin_amdgcn_s_setprio(0); } while (0)
  int sc1; asm volatile("v_mov_b32 %0, 0x7f7f7f7f" : "=v"(sc1));
  const int nt = K / 128;
  SETOFF(brow, bcol); PRO();
  bool first = true;
  for (;;) {
    f32x4 acc[2][2][4][2] = {};
    v8i At[4], B0[2], B1[2];
    if (wr == 1) BAR;
    if (first) WAIT_V(4); else WAIT_V(0);
    BAR;
    STAGE_B0(G_SB(1, 0), 1); STAGE_A0(G_SA(1, 0), 1); STAGE_B1(G_SB(1, 1), 1);
    WAIT_V(6); BAR;
    for (int t = 0; t < nt - 2; t += 2) {
      LDB(B0, 0, 0); SCHED; LDA(At, 0, 0); STAGE_A1(G_SA(1, 1), t + 1);
      WAIT_L(8); BAR; WAIT_L(0); MMA(0, 0, At, B0); BAR; SCHED;
      LDB(B1, 0, 1); STAGE_B0(G_SB(0, 0), t + 2);
      BAR; WAIT_L(0); MMA(0, 1, At, B1); BAR;
      LDA(At, 0, 1); STAGE_A0(G_SA(0, 0), t + 2);
      BAR; WAIT_L(0); MMA(1, 0, At, B0); BAR; SCHED;
      STAGE_B1(G_SB(0, 1), t + 2);
      WAIT_V(6); BAR; MMA(1, 1, At, B1); BAR;
      LDB(B0, 1, 0); SCHED; LDA(At, 1, 0); STAGE_A1(G_SA(0, 1), t + 2);
      WAIT_L(8); BAR; WAIT_L(0); MMA(0, 0, At, B0); BAR; SCHED;
      LDB(B1, 1, 1); STAGE_B0(G_SB(1, 0), t + 3);
      BAR; WAIT_L(0); MMA(0, 1, At, B1); BAR;
      LDA(At, 1, 1); STAGE_A0(G_SA(1, 0), t + 3);
      BAR; WAIT_L(0); MMA(1, 0, At, B0); BAR; SCHED;
      STAGE_B1(G_SB(1, 1), t + 3);
      WAIT_V(6); BAR; MMA(1, 1, At, B1); BAR;
    }
    { LDB(B0, 0, 0); WAIT_V(0); LDA(At, 0, 0); STAGE_A1(G_SA(1, 1), nt - 1);
      BAR; WAIT_L(0); MMA(0, 0, At, B0); BAR;
      LDB(B1, 0, 1); BAR; WAIT_L(0); MMA(0, 1, At, B1); BAR;
      LDA(At, 0, 1); WAIT_V(4); BAR; WAIT_L(0); MMA(1, 0, At, B0); MMA(1, 1, At, B1); BAR; }
    { LDB(B0, 1, 0); LDA(At, 1, 0); WAIT_V(2); BAR; WAIT_L(0); MMA(0, 0, At, B0); BAR;
      LDB(B1, 1, 1); WAIT_V(0); BAR; WAIT_L(0); MMA(0, 1, At, B1); BAR;
      LDA(At, 1, 1); BAR; WAIT_L(0); MMA(1, 0, At, B0); MMA(1, 1, At, B1); BAR; }
    if (wr == 0) BAR;
    const int cbrow = brow, cbcol = bcol;
    { int tz = threadIdx.x; asm volatile("" : "+v"(tz)); tz &= 511; wid = tz >> 6; lane = tz & 63; wr = wid >> 2; wc = wid & 3; fr = lane & 15; fq = lane >> 4;
      R0 = 8 * wid + (lane >> 3); C0 = ((lane & 7) ^ ((R0 >> 1) & 7)) << 4; }
    ++ui;
    const bool more = sched.unit(ui, brow, Bt, bcol);
    if (more) { SETOFF(brow, bcol); asm volatile("" ::: "memory"); PRO(); asm volatile("" ::: "memory"); }
    asm volatile("s_nop 15\n\ts_nop 15\n\ts_nop 7" ::: "memory");
    epi(acc, cbrow, cbcol, wr, wc, fr, fq);
    if (!more) break;
    first = false;
  }
#undef G_SA
#undef G_SB
#undef SETOFF
#undef STAGE_A0
#undef STAGE_A1
#undef STAGE_B0
#undef STAGE_B1
#undef PRO
#undef FRAG8
#undef LDA
#undef LDB
#undef MMA
}
__device__ __forceinline__ float clamp8(float x) { return fminf(fmaxf(x, -448.f), 448.f); }
__device__ __forceinline__ unsigned pack_fp8x4(float a, float b, float c, float d) {
  int p = __builtin_amdgcn_cvt_pk_fp8_f32(clamp8(a), clamp8(b), 0, false); p = __builtin_amdgcn_cvt_pk_fp8_f32(clamp8(c), clamp8(d), p, true); return (unsigned)p; }
struct EpiSwiGLU8 {
  unsigned char* C; int ldc;
  __device__ __forceinline__ void operator()(const f32x4 (&acc)[2][2][4][2], int brow, int bcol, int wr, int wc, int fr, int fq) const {
    constexpr float S = 1.f / 256.f;
#pragma unroll
    for (int ai = 0; ai < 2; ++ai)
#pragma unroll
      for (int m = 0; m < 4; ++m) {
        unsigned char* rp = C + (size_t)(brow + ai * 128 + wr * 64 + m * 16 + fr) * ldc + (bcol >> 1) + wc * 16 + fq * 4;
#pragma unroll
        for (int bj = 0; bj < 2; ++bj) {
          float r[4];
#pragma unroll
          for (int j = 0; j < 4; ++j) { const float g = acc[ai][bj][m][0][j] * S, u = acc[ai][bj][m][1][j] * S; r[j] = g * sigmoid_fast(g) * u; }
          *(unsigned*)(rp + bj * 64) = pack_fp8x4(r[0], r[1], r[2], r[3]);
        }
      }
  }
};
struct EpiPlainS {
  bf16_t* C; int ldc; float sc;
  __device__ __forceinline__ void operator()(const f32x4 (&acc)[2][2][4][2], int brow, int bcol, int wr, int wc, int fr, int fq) const {
#pragma unroll
    for (int ai = 0; ai < 2; ++ai)
#pragma unroll
      for (int m = 0; m < 4; ++m) {
        bf16_t* rp = C + (size_t)(brow + ai * 128 + wr * 64 + m * 16 + fr) * ldc + bcol + wc * 32 + fq * 8;
#pragma unroll
        for (int bj = 0; bj < 2; ++bj) {
          u32x4 v = {cvtpk(acc[ai][bj][m][0][0] * sc, acc[ai][bj][m][0][1] * sc), cvtpk(acc[ai][bj][m][0][2] * sc, acc[ai][bj][m][0][3] * sc),
                     cvtpk(acc[ai][bj][m][1][0] * sc, acc[ai][bj][m][1][1] * sc), cvtpk(acc[ai][bj][m][1][2] * sc, acc[ai][bj][m][1][3] * sc)};
          *(u32x4*)(rp + bj * 128) = v;
        }
      }
  }
};

__device__ __forceinline__ void dense_unit(int u, int nM, int nN, int& pm, int& pn) {
  const int nwg = nM * nN, NX = 8, WGM = 8;
  int wgid = u;
  { const int q = nwg / NX, r = nwg % NX, xcd = wgid % NX, off = wgid / NX; wgid = (xcd < r ? xcd * (q + 1) : r * (q + 1) + (xcd - r) * q) + off; }
  const int nig = WGM * nN, gid = wgid / nig, fm = gid * WGM, gsz = min(nM - fm, WGM);
  pm = fm + ((wgid % nig) % gsz); pn = (wgid % nig) / gsz;
}

namespace at {
constexpr int DH = 128, NW = 8, QBLK = 32, KVBLK = 64;
constexpr float SCALE = 0.088388347648318440f;
constexpr float QC = SCALE * 1.4426950408889634f;
constexpr int SHM_V = KVBLK * DH * 2, SHM_K = KVBLK * DH * 2;
#define KSWZ(row, colB) ((row) * 256 + ((colB) ^ (((row) & 7) << 4)))
__device__ __forceinline__ int crow(int r, int hi) { return (r & 3) + 8 * (r >> 2) + 4 * hi; }
__device__ __forceinline__ unsigned cvtpkv(float lo, float hi) { unsigned r; asm volatile("v_cvt_pk_bf16_f32 %0, %1, %2" : "=v"(r) : "v"(lo), "v"(hi)); return r; }
#define PK4(P, BASE, OUT) do { unsigned a0 = cvtpkv(P[BASE + 0], P[BASE + 1]), a1 = cvtpkv(P[BASE + 2], P[BASE + 3]);   \
    unsigned b0 = cvtpkv(P[BASE + 4], P[BASE + 5]), b1 = cvtpkv(P[BASE + 6], P[BASE + 7]);                              \
    auto r0 = __builtin_amdgcn_permlane32_swap(a0, b0, false, false); auto r1 = __builtin_amdgcn_permlane32_swap(a1, b1, false, false); \
    u32x4 w = {r0[0], r1[0], r0[1], r1[1]}; OUT = *reinterpret_cast<bf16x8*>(&w); } while (0)
__device__ __forceinline__ float load_q(const bf16_t* __restrict__ Qw, bf16x8 (&qr)[8], float kmax2) {
  float ss = 0;
#pragma unroll
  for (int d0 = 0; d0 < 8; ++d0) {
    const u32x4 raw = *reinterpret_cast<const u32x4*>(Qw + d0 * 16); u32x4 o;
#pragma unroll
    for (int i = 0; i < 4; ++i) { const unsigned pk = cvtpk(bflo(raw[i]) * QC, bfhi(raw[i]) * QC); o[i] = pk; const float a = bflo(pk), b = bfhi(pk); ss += a * a + b * b; }
    qr[d0] = *reinterpret_cast<bf16x8*>(&o);
  }
  { auto rr = __builtin_amdgcn_permlane32_swap(__float_as_uint(ss), __float_as_uint(ss), false, false); ss = __uint_as_float(rr[0]) + __uint_as_float(rr[1]); }
  return -(sqrtf(ss * kmax2) * 1.01f + 1e-3f);
}
__device__ __forceinline__ void exp16(f32x16& p) {
#pragma unroll
  for (int r = 0; r < 16; ++r) p[r] = __builtin_amdgcn_exp2f(p[r]);
}
__device__ __forceinline__ float sum16(const f32x16& p) { float s = 0;
#pragma unroll
  for (int r = 0; r < 16; ++r) s += p[r];
  return s; }
__device__ __forceinline__ void qkt(f32x16& p0, f32x16& p1, LAS const char* Ks, const bf16x8* qr, int r32, int hi, float nmc) {
#pragma unroll
  for (int r = 0; r < 16; ++r) { p0[r] = nmc; p1[r] = nmc; }
#pragma unroll
  for (int d0 = 0; d0 < 8; ++d0) { int cb = (d0 * 16 + hi * 8) * 2;
    bf16x8 b0 = *(LAS const bf16x8*)(Ks + KSWZ(r32, cb));
    bf16x8 b1 = *(LAS const bf16x8*)(Ks + KSWZ(32 + r32, cb));
    p0 = __builtin_amdgcn_mfma_f32_32x32x16_bf16(b0, qr[d0], p0, 0, 0, 0);
    p1 = __builtin_amdgcn_mfma_f32_32x32x16_bf16(b1, qr[d0], p1, 0, 0, 0); }
}
__device__ __forceinline__ int v_st(int k, int c) { const int kk = (k & ~0xC) | ((k & 4) << 1) | ((k & 8) >> 1); return ((kk >> 3) * 4 + (c >> 5)) * 512 + ((kk & 7) * 32 + (c & 31)) * 2; }
__device__ __forceinline__ int v_st256(int k, int c) { const int kk = (k & ~0xC) | ((k & 4) << 1) | ((k & 8) >> 1); return ((kk >> 3) * 8 + (c >> 5)) * 512 + ((kk & 7) * 32 + (c & 31)) * 2; }
__device__ __forceinline__ int v_rd_base(int lane) { return ((lane & 3) << 3) | (((lane >> 2) & 3) << 6) | (((lane >> 4) & 1) << 5) | (((lane >> 5) & 1) << 8); }
template <int OFF> __device__ __forceinline__ s16x4 tr_read(int vb) {
  s16x4 r; asm volatile("ds_read_b64_tr_b16 %0, %1 offset:%2" : "=&v"(r) : "v"(vb), "i"(OFF) : "memory"); return r;
}
template <int BASE, int KS, int HS> __device__ __forceinline__ void pv_one(f32x16& od, int vb, bf16x8 pa0, bf16x8 pa1, bf16x8 pa2, bf16x8 pa3) {
  const s16x4 l0 = tr_read<BASE>(vb), h0 = tr_read<BASE + HS>(vb), l1 = tr_read<BASE + KS>(vb), h1 = tr_read<BASE + KS + HS>(vb);
  const s16x4 l2 = tr_read<BASE + 2 * KS>(vb), h2 = tr_read<BASE + 2 * KS + HS>(vb), l3 = tr_read<BASE + 3 * KS>(vb), h3 = tr_read<BASE + 3 * KS + HS>(vb);
  asm volatile("s_waitcnt lgkmcnt(0)" ::: "memory"); SCHED;
#define PK(L, H) (bf16x8){L[0], L[1], L[2], L[3], H[0], H[1], H[2], H[3]}
  od = __builtin_amdgcn_mfma_f32_32x32x16_bf16(pa0, PK(l0, h0), od, 0, 0, 0);
  od = __builtin_amdgcn_mfma_f32_32x32x16_bf16(pa1, PK(l1, h1), od, 0, 0, 0);
  od = __builtin_amdgcn_mfma_f32_32x32x16_bf16(pa2, PK(l2, h2), od, 0, 0, 0);
  od = __builtin_amdgcn_mfma_f32_32x32x16_bf16(pa3, PK(l3, h3), od, 0, 0, 0);
#undef PK
}
__device__ __forceinline__ void pv_d0(f32x16* o, int vb, bf16x8 pa0, bf16x8 pa1, bf16x8 pa2, bf16x8 pa3) {
  pv_one<0, 4096, 2048>(o[0], vb, pa0, pa1, pa2, pa3); pv_one<512, 4096, 2048>(o[1], vb, pa0, pa1, pa2, pa3);
  pv_one<1024, 4096, 2048>(o[2], vb, pa0, pa1, pa2, pa3); pv_one<1536, 4096, 2048>(o[3], vb, pa0, pa1, pa2, pa3);
}
__device__ __forceinline__ void pv_d0_256(f32x16* o, int vb, bf16x8 pa0, bf16x8 pa1, bf16x8 pa2, bf16x8 pa3) {
  pv_one<0, 8192, 4096>(o[0], vb, pa0, pa1, pa2, pa3); pv_one<512, 8192, 4096>(o[1], vb, pa0, pa1, pa2, pa3);
  pv_one<1024, 8192, 4096>(o[2], vb, pa0, pa1, pa2, pa3); pv_one<1536, 8192, 4096>(o[3], vb, pa0, pa1, pa2, pa3);
}
__device__ __forceinline__ void store_o(const f32x16* o, float l_tot, LAS float* li, bf16_t* __restrict__ Ow, int ldo, int r32, int hi) {
  if (hi == 0) li[r32] = l_tot; asm volatile("s_waitcnt lgkmcnt(0)" ::: "memory");
  float rli[16];
#pragma unroll
  for (int r = 0; r < 16; ++r) rli[r] = __builtin_amdgcn_rcpf(li[crow(r, hi)]);
#pragma unroll
  for (int r = 0; r < 16; ++r) { const int orow = crow(r, hi);
#pragma unroll
    for (int d0 = 0; d0 < 4; ++d0) Ow[(long)orow * ldo + d0 * 32 + r32] = f2bf(o[d0][r] * rli[r]); }
}

__device__ __forceinline__ int unswap23(int kk) { return (kk & ~0xC) | ((kk & 4) << 1) | ((kk & 8) >> 1); }
__device__ __forceinline__ int k_dma_voff(int wid, int lane, int ldk) {
  const int row = 4 * wid + (lane >> 4); return row * ldk * 2 + (((lane & 15) * 16) ^ ((row & 7) << 4)); }
#define DMA16(rs, ldsp, voff, soff) __builtin_amdgcn_raw_ptr_buffer_load_lds(rs, (LAS void*)(ldsp), 16, voff, soff, 0, 0)

constexpr int SHM_T = SHM_K + SHM_V;
__device__ __forceinline__ void attn_body(const bf16_t* __restrict__ Qb, const int ldq, const bf16_t* __restrict__ Kh, const bf16_t* __restrict__ Vh, const int ldk,
                                          bf16_t* __restrict__ Ob, const int ldo, const int seq, const float kmax2, LAS char* lds) {
  int tid = threadIdx.x; asm volatile("" : "+v"(tid)); tid &= 511;
  const int wid = tid >> 6, lane = tid & 63, r32 = lane & 31, hi = lane >> 5;
  LAS float* li_l = (LAS float*)(lds + 3 * SHM_T) + wid * 64;
  float l_reg = 0; f32x16 o[4] = {}; bf16x8 qr[8];
  const float nmc = load_q(Qb + (long)(wid * QBLK + r32) * ldq + hi * 8, qr, kmax2);
  const int vrb = v_rd_base(lane);
  const int kvo = k_dma_voff(wid, lane, ldk);
  const int vvo = unswap23(8 * (wid >> 1) + ((lane & 31) >> 2)) * ldk * 2 + ((2 * (wid & 1) + (lane >> 5)) * 32 + (lane & 3) * 8) * 2;
  const int l32 = 64 * ldk, pz = wid * 1024;
  const __amdgpu_buffer_rsrc_t krs = __builtin_amdgcn_make_buffer_rsrc((void*)Kh, 0, 0x7ffffff0, 0x00020000);
  const __amdgpu_buffer_rsrc_t vrs = __builtin_amdgcn_make_buffer_rsrc((void*)Vh, 0, 0x7ffffff0, 0x00020000);
#define TDMA(slot, k0) do { const int _o = (k0) * ldk * 2; LAS char* _b = lds + (slot) * SHM_T + pz; \
    DMA16(krs, _b, kvo, _o); DMA16(krs, _b + 8192, kvo, _o + l32); DMA16(vrs, _b + SHM_K, vvo, _o); DMA16(vrs, _b + SHM_K + 8192, vvo, _o + l32); } while (0)
#define VM0() asm volatile("s_waitcnt vmcnt(0)" ::: "memory")
#define FINISH(P0, P1) do { exp16(P1); l_reg += sum16(P0) + sum16(P1); PK4(P0, 0, pa0); PK4(P0, 8, pa1); PK4(P1, 0, pa2); PK4(P1, 8, pa3); } while (0)
  f32x16 pA0, pA1, pB0, pB1; bf16x8 pa0, pa1, pa2, pa3; const int NT = seq / KVBLK;
  TDMA(0, 0); VM0(); __syncthreads();
  TDMA(1, KVBLK);
  qkt(pA0, pA1, lds, qr, r32, hi, nmc); exp16(pA0);
  VM0(); __syncthreads();
  int sk = 1, sv = 0, sd = 2;
  for (int j = 1; j + 1 < NT; j += 2) {
    TDMA(sd, (j + 1) * KVBLK);
    SCHED; qkt(pB0, pB1, lds + sk * SHM_T, qr, r32, hi, nmc);
    FINISH(pA0, pA1); SCHED;
    pv_d0(o, (int)(uintptr_t)(lds + sv * SHM_T + SHM_K) + vrb, pa0, pa1, pa2, pa3); exp16(pB0);
    VM0(); __syncthreads();
    { const int t = sv; sv = sk; sk = sd; sd = t; }
    if (j + 2 < NT) TDMA(sd, (j + 2) * KVBLK);
    SCHED; qkt(pA0, pA1, lds + sk * SHM_T, qr, r32, hi, nmc);
    FINISH(pB0, pB1); SCHED;
    pv_d0(o, (int)(uintptr_t)(lds + sv * SHM_T + SHM_K) + vrb, pa0, pa1, pa2, pa3); exp16(pA0);
    VM0(); __syncthreads();
    { const int t = sv; sv = sk; sk = sd; sd = t; }
  }
  SCHED; qkt(pB0, pB1, lds + sk * SHM_T, qr, r32, hi, nmc);
  FINISH(pA0, pA1); SCHED;
  pv_d0(o, (int)(uintptr_t)(lds + sv * SHM_T + SHM_K) + vrb, pa0, pa1, pa2, pa3); exp16(pB0);
  FINISH(pB0, pB1); SCHED;
  pv_d0(o, (int)(uintptr_t)(lds + sk * SHM_T + SHM_K) + vrb, pa0, pa1, pa2, pa3);
  { auto rr = __builtin_amdgcn_permlane32_swap(__float_as_uint(l_reg), __float_as_uint(l_reg), false, false); l_reg = __uint_as_float(rr[0]) + __uint_as_float(rr[1]); }
  store_o(o, l_reg, li_l, Ob + (long)(wid * QBLK) * ldo, ldo, r32, hi);
  VM0();
  __syncthreads();
#undef TDMA
#undef FINISH
}

constexpr int SHM_V2 = KVBLK * 256 * 2;
__device__ __forceinline__ void attn_body_dv256(const bf16_t* __restrict__ Qb, const int ldq, const bf16_t* __restrict__ Kh, const bf16_t* __restrict__ Vh, const int ldk,
                                                bf16_t* __restrict__ Ob, const int ldo, const int seq, const float kmax2, LAS char* lds) {
  int tid = threadIdx.x; asm volatile("" : "+v"(tid)); tid &= 511;
  const int wid = tid >> 6, lane = tid & 63, r32 = lane & 31, hi = lane >> 5, rg = wid >> 1, kh = wid & 1;
  LAS char* K_lds = lds; LAS char* V_lds = lds + 2 * SHM_K; LAS char* X_lds = lds + 2 * SHM_K + 2 * SHM_V2;
  float l_reg = 0; f32x16 o[4] = {}; bf16x8 qr[8];
  const float nmc = load_q(Qb + (long)(rg * QBLK + r32) * ldq + hi * 8, qr, kmax2);
  const int vb0 = (int)(uintptr_t)V_lds + v_rd_base(lane) + kh * 2048;
  const int kvo = k_dma_voff(wid, lane, ldk);
  const int vvo = unswap23(8 * (wid >> 2) + ((lane & 31) >> 2)) * ldk * 2 + ((2 * (wid & 3) + (lane >> 5)) * 32 + (lane & 3) * 8) * 2;
  const int l32 = 64 * ldk, l16 = 32 * ldk, pz = wid * 1024;
  const int xw = (rg * 4 + kh * 2) * 1024 + lane * 16, xr = rg * 4096 + lane * 16;
  const __amdgpu_buffer_rsrc_t krs = __builtin_amdgcn_make_buffer_rsrc((void*)Kh, 0, 0x7ffffff0, 0x00020000);
  const __amdgpu_buffer_rsrc_t vrs = __builtin_amdgcn_make_buffer_rsrc((void*)Vh, 0, 0x7ffffff0, 0x00020000);
#define KDMA(b, k0) do { const int _o = (k0) * ldk * 2; LAS char* _b = K_lds + (b) * SHM_K + pz; DMA16(krs, _b, kvo, _o); DMA16(krs, _b + 8192, kvo, _o + l32); } while (0)
#define VDMA(b, k0) do { const int _o = (k0) * ldk * 2; LAS char* _b = V_lds + (b) * SHM_V2 + pz; DMA16(vrs, _b, vvo, _o); DMA16(vrs, _b + 8192, vvo, _o + l16); \
    DMA16(vrs, _b + 16384, vvo, _o + 2 * l16); DMA16(vrs, _b + 24576, vvo, _o + 3 * l16); } while (0)
  f32x16 pA, pB; bf16x8 pa0, pa1, pa2, pa3, own0, own1; const int NT = seq / KVBLK;
  const int kxor = ((32 * kh + r32) & 7) << 4, krb = (32 * kh + r32) * 256;
#define QKHALF(P, b) do { _Pragma("unroll") for (int r = 0; r < 16; ++r) P[r] = nmc; \
    _Pragma("unroll") for (int d0 = 0; d0 < 8; ++d0) { const bf16x8 bk = *(LAS const bf16x8*)(K_lds + (b) * SHM_K + krb + (((d0 * 16 + hi * 8) * 2) ^ kxor)); \
      P = __builtin_amdgcn_mfma_f32_32x32x16_bf16(bk, qr[d0], P, 0, 0, 0); } } while (0)
#define FINH(P) do { exp16(P); l_reg += sum16(P); PK4(P, 0, own0); PK4(P, 8, own1); } while (0)
#define XWRITE(b) do { *(LAS bf16x8*)(X_lds + (b) * 16384 + xw) = own0; *(LAS bf16x8*)(X_lds + (b) * 16384 + xw + 1024) = own1; } while (0)
#define XREAD(b) do { pa0 = *(LAS const bf16x8*)(X_lds + (b) * 16384 + xr); pa1 = *(LAS const bf16x8*)(X_lds + (b) * 16384 + xr + 1024); \
    pa2 = *(LAS const bf16x8*)(X_lds + (b) * 16384 + xr + 2048); pa3 = *(LAS const bf16x8*)(X_lds + (b) * 16384 + xr + 3072); } while (0)
#define STEP(PA, PB, b, j) do { \
    SCHED; if ((j) + 1 < NT) QKHALF(PB, (b) ^ 1); FINH(PA); SCHED; \
    XWRITE(b); VM0(); __syncthreads(); \
    if ((j) + 3 < NT) KDMA((b) ^ 1, ((j) + 3) * KVBLK); if ((j) + 1 < NT) VDMA((b) ^ 1, ((j) + 1) * KVBLK); \
    XREAD(b); \
    pv_d0_256(o, vb0 + (b) * SHM_V2, pa0, pa1, pa2, pa3); } while (0)
  KDMA(0, 0); KDMA(1, KVBLK); VDMA(0, 0); VM0(); __syncthreads();
  QKHALF(pA, 0);
  __syncthreads();
  if (2 < NT) KDMA(0, 2 * KVBLK);
  for (int j = 0; j < NT; j += 2) { STEP(pA, pB, 0, j); STEP(pB, pA, 1, j + 1); }
  __syncthreads();
  LAS float* lx = (LAS float*)X_lds;
  lx[wid * 64 + lane] = l_reg; __syncthreads();
  const float l_tot = lx[wid * 64 + r32] + lx[wid * 64 + 32 + r32] + lx[(wid ^ 1) * 64 + r32] + lx[(wid ^ 1) * 64 + 32 + r32];
  store_o(o, l_tot, lx + 512 + wid * 32, Ob + (long)(rg * QBLK) * ldo + kh * 128, ldo, r32, hi);
  VM0();
  __syncthreads();
#undef KDMA
#undef VDMA
#undef QKHALF
#undef FINH
#undef XWRITE
#undef XREAD
#undef STEP
#undef VM0
}

#define LGK(n) asm volatile("s_waitcnt lgkmcnt(" #n ")" ::: "memory")
template <int OFF> __device__ __forceinline__ bf16x8 k_read(int ka) { bf16x8 r; asm volatile("ds_read_b128 %0, %1 offset:%2" : "=&v"(r) : "v"(ka), "i"(OFF) : "memory"); return r; }
struct VSet { s16x4 l0, h0, l1, h1; };
template <int OFF> __device__ __forceinline__ void v_read(VSet& s, int vb) { s.l0 = tr_read<OFF>(vb); s.h0 = tr_read<OFF + 4096>(vb); s.l1 = tr_read<OFF + 8192>(vb); s.h1 = tr_read<OFF + 12288>(vb); }
__device__ __forceinline__ void pv2(f32x16& oa, const VSet& s, bf16x8 pa0, bf16x8 pa1) {
#define PK(L, H) (bf16x8){L[0], L[1], L[2], L[3], H[0], H[1], H[2], H[3]}
  oa = __builtin_amdgcn_mfma_f32_32x32x16_bf16(pa0, PK(s.l0, s.h0), oa, 0, 0, 0);
  oa = __builtin_amdgcn_mfma_f32_32x32x16_bf16(pa1, PK(s.l1, s.h1), oa, 0, 0, 0);
#undef PK
}
template <bool SHIFT>
__device__ __forceinline__ void attn_body_c256_t(const bf16_t* __restrict__ Qb, const int ldq, const bf16_t* __restrict__ Kh, const bf16_t* __restrict__ Vh, const int ldk,
                                                 bf16_t* __restrict__ Ob, const int ldo, const int seq, const float nmc, const bf16x8 (&qr)[8], LAS char* lds) {
  int tid = threadIdx.x; asm volatile("" : "+v"(tid)); tid &= 511;
  const int wid = __builtin_amdgcn_readfirstlane(tid >> 6), lane = tid & 63, r32 = lane & 31, hi = lane >> 5;
  LAS char* K_lds = lds; LAS char* V_lds = lds + 2 * SHM_K;
  LAS float* li_l = (LAS float*)(lds + 2 * SHM_K + 2 * SHM_V2) + wid * 64;
  float l_reg = 0; f32x16 o[8] = {};
  const int vb0 = (int)(uintptr_t)V_lds + v_rd_base(lane);
  const int kvo = k_dma_voff(wid, lane, ldk);
  const int vvo = unswap23(8 * (wid >> 2) + ((lane & 31) >> 2)) * ldk * 2 + ((2 * (wid & 3) + (lane >> 5)) * 32 + (lane & 3) * 8) * 2;
  const int l32 = 64 * ldk, l16 = 32 * ldk, pz = wid * 1024;
  const __amdgpu_buffer_rsrc_t krs = __builtin_amdgcn_make_buffer_rsrc((void*)Kh, 0, 0x7ffffff0, 0x00020000);
  const __amdgpu_buffer_rsrc_t vrs = __builtin_amdgcn_make_buffer_rsrc((void*)Vh, 0, 0x7ffffff0, 0x00020000);
#define VM0() asm volatile("s_waitcnt vmcnt(0)" ::: "memory")
#define KVDMA(b, k0) do { const int _o = (k0) * ldk * 2; LAS char* _k = K_lds + (b) * SHM_K + pz; LAS char* _v = V_lds + (b) * SHM_V2 + pz; \
    DMA16(krs, _k, kvo, _o); DMA16(krs, _k + 8192, kvo, _o + l32); DMA16(vrs, _v, vvo, _o); DMA16(vrs, _v + 8192, vvo, _o + l16); \
    DMA16(vrs, _v + 16384, vvo, _o + 2 * l16); DMA16(vrs, _v + 24576, vvo, _o + 3 * l16); } while (0)
  int ka[8];
  { const int kxor = (r32 & 7) << 4, krb = (int)(uintptr_t)K_lds + r32 * 256;
#pragma unroll
    for (int d0 = 0; d0 < 8; ++d0) ka[d0] = krb + (((d0 * 16 + hi * 8) * 2) ^ kxor); }
  f32x16 P; bf16x8 pa0, pa1, f0, f1, f2, f3; VSet va, vb_, vc;
  const int NT = seq / KVBLK;
#define PINIT() do { _Pragma("unroll") for (int r = 0; r < 16; ++r) { float _z; asm volatile("v_mov_b32 %0, %1" : "=v"(_z) : "v"(SHIFT ? nmc : 0.f)); P[r] = _z; } } while (0)
#define KOFF(b, h) ((b) * 16384 + (h) * 8192)
#define VOFF(b, h, d0) ((b) * 32768 + (h) * 16384 + (d0) * 512)
#define KPRO(b, h) do { f0 = k_read<KOFF(b, h)>(ka[0]); f1 = k_read<KOFF(b, h)>(ka[1]); f2 = k_read<KOFF(b, h)>(ka[2]); } while (0)
#define QKM(F, d0) do { SCHED; P = __builtin_amdgcn_mfma_f32_32x32x16_bf16(F, qr[d0], P, 0, 0, 0); SCHED; } while (0)
#define QKHALF(b, h) do { PINIT(); \
    LGK(2); QKM(f0, 0); f3 = k_read<KOFF(b, h)>(ka[3]); \
    LGK(2); QKM(f1, 1); f0 = k_read<KOFF(b, h)>(ka[4]); \
    LGK(2); QKM(f2, 2); f1 = k_read<KOFF(b, h)>(ka[5]); \
    LGK(2); QKM(f3, 3); f2 = k_read<KOFF(b, h)>(ka[6]); \
    LGK(2); QKM(f0, 4); f3 = k_read<KOFF(b, h)>(ka[7]); \
    LGK(2); QKM(f1, 5); v_read<VOFF(b, h, 0)>(va, vb0); \
    LGK(5); QKM(f2, 6); v_read<VOFF(b, h, 1)>(vb_, vb0); \
    LGK(8); QKM(f3, 7); } while (0)
#define SMH() do { exp16(P); l_reg += sum16(P); PK4(P, 0, pa0); PK4(P, 8, pa1); } while (0)
#define PVM(S, d0) do { SCHED; pv2(o[d0], S, pa0, pa1); SCHED; } while (0)
#define PVHALF(b, h, NEXTK, nb, nh) do { \
    LGK(4); PVM(va, 0); v_read<VOFF(b, h, 2)>(vc, vb0); \
    LGK(4); PVM(vb_, 1); v_read<VOFF(b, h, 3)>(va, vb0); \
    LGK(4); PVM(vc, 2); v_read<VOFF(b, h, 4)>(vb_, vb0); \
    LGK(4); PVM(va, 3); v_read<VOFF(b, h, 5)>(vc, vb0); \
    LGK(4); PVM(vb_, 4); v_read<VOFF(b, h, 6)>(va, vb0); \
    LGK(4); PVM(vc, 5); v_read<VOFF(b, h, 7)>(vb_, vb0); \
    LGK(4); PVM(va, 6); if (NEXTK) { f0 = k_read<KOFF(nb, nh)>(ka[0]); f1 = k_read<KOFF(nb, nh)>(ka[1]); } \
    if (NEXTK) { LGK(2); } else { LGK(0); } PVM(vb_, 7); if (NEXTK) { f2 = k_read<KOFF(nb, nh)>(ka[2]); } } while (0)
#define STEPC(b, j) do { if ((j) + 1 < NT) KVDMA((b) ^ 1, ((j) + 1) * KVBLK); \
    KPRO(b, 0); QKHALF(b, 0); SMH(); PVHALF(b, 0, true, b, 1); \
    QKHALF(b, 1); SMH(); PVHALF(b, 1, false, 0, 0); \
    VM0(); __syncthreads(); } while (0)
  KVDMA(0, 0); VM0(); __syncthreads();
  for (int j = 0; j < NT; j += 2) { STEPC(0, j); STEPC(1, j + 1); }
  { auto rr = __builtin_amdgcn_permlane32_swap(__float_as_uint(l_reg), __float_as_uint(l_reg), false, false); l_reg = __uint_as_float(rr[0]) + __uint_as_float(rr[1]); }
  if (hi == 0) li_l[r32] = l_reg; asm volatile("s_waitcnt lgkmcnt(0)" ::: "memory");
  bf16_t* Ow = Ob + (long)(wid * QBLK) * ldo;
#pragma unroll
  for (int r = 0; r < 16; ++r) { const int orow = crow(r, hi); const float rl = __builtin_amdgcn_rcpf(li_l[orow]);
#pragma unroll
    for (int d0 = 0; d0 < 8; ++d0) Ow[(long)orow * ldo + d0 * 32 + r32] = f2bf(o[d0][r] * rl); }
  VM0();
  __syncthreads();
#undef KVDMA
#undef PINIT
#undef KOFF
#undef VOFF
#undef KPRO
#undef QKM
#undef QKHALF
#undef SMH
#undef PVM
#undef PVHALF
#undef STEPC
#undef VM0
}
__device__ __forceinline__ void attn_body_c256(const bf16_t* __restrict__ Qb, const int ldq, const bf16_t* __restrict__ Kh, const bf16_t* __restrict__ Vh, const int ldk,
                                               bf16_t* __restrict__ Ob, const int ldo, const int seq, const float kmax2, LAS char* lds) {
  int tid = threadIdx.x; asm volatile("" : "+v"(tid)); tid &= 511;
  const int wid = tid >> 6, lane = tid & 63, r32 = lane & 31, hi = lane >> 5;
  bf16x8 qr[8];
  const float nmc = load_q(Qb + (long)(wid * QBLK + r32) * ldq + hi * 8, qr, kmax2);
  if (__all(nmc > -64.f)) attn_body_c256_t<false>(Qb, ldq, Kh, Vh, ldk, Ob, ldo, seq, 0.f, qr, lds);
  else attn_body_c256_t<true>(Qb, ldq, Kh, Vh, ldk, Ob, ldo, seq, nmc, qr, lds);
}
#undef PK4
}

__device__ __forceinline__ int perm_plain8(int n) { const int r = n & 31; return (n & ~31) + 16 * ((r >> 2) & 1) + 4 * (r >> 3) + (r & 3); }
__device__ __forceinline__ int perm_row(int kind, int n) {
  if (kind == 0) return perm_plain8(n);
  if (kind == 1) { if (n < N_QKV0) return perm_plain8(n); const int c = n - N_QKV0; const int ch = c & 1023; return N_QKV0 + 32 * (ch >> 4) + ((c >> 10) << 4) + (ch & 15); }
  return 32 * (n >> 4) + ((kind == 3) ? 16 : 0) + (n & 15);
}
__device__ __forceinline__ void cvt_tile(const float* __restrict__ src, int N, bf16_t* __restrict__ dst, int K, int kind, int k0, int n0, LAS unsigned* t32) {
  int tid = threadIdx.x; asm volatile("" : "+v"(tid)); tid &= 511;
#pragma unroll
  for (int j = 0; j < 2; ++j) {
    const int item = tid + 512 * j, kp = item >> 4, q = item & 15;
    const f32x4 v0 = *(const f32x4*)(src + (size_t)(k0 + 2 * kp) * N + n0 + 4 * q);
    const f32x4 v1 = *(const f32x4*)(src + (size_t)(k0 + 2 * kp + 1) * N + n0 + 4 * q);
#pragma unroll
    for (int i = 0; i < 4; ++i) t32[(4 * q + i) * 65 + kp] = cvtpk(v0[i], v1[i]);
  }
  __syncthreads();
#pragma unroll
  for (int j = 0; j < 2; ++j) {
    const int item = tid + 512 * j, n = item >> 4, ko = item & 15;
    u32x4 v;
#pragma unroll
    for (int i = 0; i < 4; ++i) v[i] = t32[n * 65 + 4 * ko + i];
    *(u32x4*)(dst + (size_t)perm_row(kind, n0 + n) * K + k0 + 8 * ko) = v;
  }
  __syncthreads();
}
__device__ __forceinline__ void cvt_matrix_units(const float* src, int K, int N, bf16_t* dst, int kind, int u0, int ustride, LAS unsigned* t32) {
  const int nN = N / 64, nK = K / 128;
  for (int u = u0; u < nN * nK; u += ustride) cvt_tile(src, N, dst, K, kind, (u / nN) * 128, (u % nN) * 64, t32);
}
constexpr size_t WMOE8_E = (size_t)1024 * D + (size_t)D * EFF;
__device__ __forceinline__ void cvt_tile8(const float* __restrict__ src, int N, unsigned char* __restrict__ dst, int K, int kind, int k0, int n0, float scale, LAS unsigned* t32) {
  int tid = threadIdx.x; asm volatile("" : "+v"(tid)); tid &= 511;
  { const int kq = tid >> 4, q = tid & 15;
    f32x4 v[4];
#pragma unroll
    for (int r = 0; r < 4; ++r) v[r] = *(const f32x4*)(src + (size_t)(k0 + 4 * kq + r) * N + n0 + 4 * q);
#pragma unroll
    for (int i = 0; i < 4; ++i) t32[(4 * q + i) * 33 + kq] = pack_fp8x4(v[0][i] * scale, v[1][i] * scale, v[2][i] * scale, v[3][i] * scale); }
  __syncthreads();
  { const int n = tid >> 3, kc = tid & 7;
    u32x4 v;
#pragma unroll
    for (int i = 0; i < 4; ++i) v[i] = t32[n * 33 + 4 * kc + i];
    *(u32x4*)(dst + (size_t)perm_row(kind, n0 + n) * K + k0 + 16 * kc) = v; }
  __syncthreads();
}
__device__ __forceinline__ void cvt_moe_all8(const Args& a, LAS unsigned* t32) {
  unsigned char* W = (unsigned char*)(a.ws + WS_WMOE);
  for (int u = blockIdx.x; u < 2 * 65 * 384; u += gridDim.x) {
    const int le = u / 384, L = le / 65, e = le % 65, r = u % 384, mtx = r >> 7, lu = r & 127;
    const float* src; unsigned char* dst = W + (size_t)le * WMOE8_E; int K, N, kind; float sc;
    if (mtx == 0)      { src = e < 64 ? a.in[21] + ((size_t)L * 64 + e) * D * EFF : a.in[24] + (size_t)L * D * EFF; K = D; N = EFF; kind = 2; sc = 256.f; }
    else if (mtx == 1) { src = e < 64 ? a.in[22] + ((size_t)L * 64 + e) * D * EFF : a.in[25] + (size_t)L * D * EFF; K = D; N = EFF; kind = 3; sc = 256.f; }
    else               { src = e < 64 ? a.in[23] + ((size_t)L * 64 + e) * EFF * D : a.in[26] + (size_t)L * EFF * D; K = EFF; N = D; kind = 0; sc = 128.f; dst += (size_t)1024 * D; }
    const int nN = N / 64;
    cvt_tile8(src, N, dst, K, kind, (lu / nN) * 128, (lu % nN) * 64, sc, t32);
  }
}

__device__ __forceinline__ void ld_row_f32(const float* __restrict__ p, int lane, float (&v)[32]) {
#pragma unroll
  for (int j = 0; j < 4; ++j) { const f32x4 t0 = *(const f32x4*)(p + 8 * lane + 512 * j), t1 = *(const f32x4*)(p + 8 * lane + 512 * j + 4);
#pragma unroll
    for (int i = 0; i < 4; ++i) { v[8 * j + i] = t0[i]; v[8 * j + 4 + i] = t1[i]; } }
}
__device__ __forceinline__ void ld_row_bf16(const bf16_t* __restrict__ p, int lane, float (&v)[32]) {
#pragma unroll
  for (int j = 0; j < 4; ++j) { const u32x4 t = *(const u32x4*)(p + 8 * lane + 512 * j);
#pragma unroll
    for (int i = 0; i < 4; ++i) { v[8 * j + 2 * i] = bflo(t[i]); v[8 * j + 2 * i + 1] = bfhi(t[i]); } }
}
__device__ __forceinline__ void ld8f(const float* __restrict__ p, float (&x)[8]) { const f32x4 t0 = *(const f32x4*)p, t1 = *(const f32x4*)(p + 4);
#pragma unroll
  for (int i = 0; i < 4; ++i) { x[i] = t0[i]; x[4 + i] = t1[i]; } }
__device__ __forceinline__ void st8f(float* __restrict__ p, const float* x) { f32x4 t0 = {x[0], x[1], x[2], x[3]}, t1 = {x[4], x[5], x[6], x[7]}; *(f32x4*)p = t0; *(f32x4*)(p + 4) = t1; }
__device__ __forceinline__ float sumsq32(const float (&v)[32]) { float s = 0;
#pragma unroll
  for (int i = 0; i < 32; ++i) s += v[i] * v[i];
  return wave_sum(s); }
template <bool COPY, bool OUT8 = false>
__device__ __forceinline__ void modulate_store(const float (&v)[32], float rstd, const float* __restrict__ g, const float* __restrict__ shift, const float* __restrict__ scale,
                                               bf16_t* __restrict__ dst, int lane, LAS float* f32copy) {
#pragma unroll
  for (int j = 0; j < 4; ++j) {
    const int idx = 8 * lane + 512 * j;
    float gv[8], sh[8], sc[8], y[8]; ld8f(g + idx, gv); ld8f(shift + idx, sh); ld8f(scale + idx, sc);
#pragma unroll
    for (int i = 0; i < 8; ++i) y[i] = v[8 * j + i] * rstd * gv[i] * (1.f + sc[i]) + sh[i];
    if (OUT8) { u32x2 p8 = {pack_fp8x4(y[0], y[1], y[2], y[3]), pack_fp8x4(y[4], y[5], y[6], y[7])}; *(u32x2*)((unsigned char*)dst + idx) = p8; }
    else { u32x4 pk = {cvtpk(y[0], y[1]), cvtpk(y[2], y[3]), cvtpk(y[4], y[5]), cvtpk(y[6], y[7])}; *(u32x4*)(dst + idx) = pk; }
    if (COPY) { f32x4 t0 = {y[0], y[1], y[2], y[3]}, t1 = {y[4], y[5], y[6], y[7]};
      *(LAS f32x4*)(f32copy + idx) = t0; *(LAS f32x4*)(f32copy + idx + 4) = t1; }
  }
}

__device__ __forceinline__ void phase_prologue(const Args& a, LAS char* lds) {
  int tid = threadIdx.x; asm volatile("" : "+v"(tid)); tid &= 511; const int wave = tid >> 6, lane = tid & 63;
  {
    LAS float* sc = (LAS float*)lds;
    LAS float* part = sc + 4096;
    const float* c = a.in[1]; const float* cc = a.in[3];
    for (int i = tid; i < D; i += NTHREADS) { float v = c[i]; sc[i] = v * sigmoidf_(v); float u = cc[i]; sc[D + i] = u * sigmoidf_(u); }
    __syncthreads();
    float* MOD = (float*)(a.ws + WS_MOD);
    for (int u = blockIdx.x; u < 2 * 192; u += gridDim.x) {
      const int L = u / 192, chunk = u % 192;
      const float* W = a.in[4] + (size_t)L * D * 12288 + chunk * 64 + lane;
      float a0 = 0, a1 = 0; const int d0 = wave * 256;
#pragma unroll 8
      for (int dd = 0; dd < 256; ++dd) { const float w = W[(size_t)(d0 + dd) * 12288]; a0 += sc[d0 + dd] * w; a1 += sc[D + d0 + dd] * w; }
      part[(wave * 2 + 0) * 64 + lane] = a0; part[(wave * 2 + 1) * 64 + lane] = a1;
      __syncthreads();
      if (tid < 128) { const int which = tid >> 6; float s = 0;
#pragma unroll
        for (int w = 0; w < 8; ++w) s += part[(w * 2 + which) * 64 + lane];
        const int j = chunk * 64 + lane; MOD[(size_t)(L * 2 + which) * 12288 + j] = s + a.in[5][L * 12288 + j]; }
      __syncthreads();
    }
  }
  LAS unsigned* t32 = (LAS unsigned*)lds;
  cvt_matrix_units(a.in[7], D, N_IN0, (bf16_t*)(a.ws + WS_WIN0), 1, blockIdx.x, gridDim.x, t32);
  cvt_matrix_units(a.in[8], D, D, (bf16_t*)(a.ws + WS_WOUT0), 0, blockIdx.x, gridDim.x, t32);
  cvt_matrix_units(a.in[15], D, N_IN1, (bf16_t*)(a.ws + WS_WIN1), 0, blockIdx.x, gridDim.x, t32);
  cvt_matrix_units(a.in[16], D, D, (bf16_t*)(a.ws + WS_WOUT1), 0, blockIdx.x, gridDim.x, t32);
  cvt_moe_all8(a, t32);
}

__device__ __forceinline__ void phase_modulate0(const Args& a) {
  int tid = threadIdx.x; asm volatile("" : "+v"(tid)); tid &= 511; const int wave = tid >> 6, lane = tid & 63;
  const float* MOD = (const float*)(a.ws + WS_MOD);
  bf16_t* A = (bf16_t*)(a.ws + WS_ABUF);
  for (int it = blockIdx.x; it < MT / 8; it += gridDim.x) {
    const int r = it * 8 + wave;
    const float* src = r < CTXL ? a.in[2] + (size_t)r * D : a.in[0] + (size_t)(r - CTXL) * D;
    const float* mod = MOD + (r < CTXL ? 12288 : 0);
    float v[32]; ld_row_f32(src, lane, v);
    const float rstd = rsqrtf(sumsq32(v) * (1.f / D) + EPS);
    modulate_store<false>(v, rstd, a.in[6], mod, mod + D, A + (size_t)r * D, lane, nullptr);
  }
}

__device__ __forceinline__ void rope_cs4(int r, int lane, float (&cs)[4], float (&sn)[4]) {
#pragma unroll
  for (int q = 0; q < 4; ++q) { cs[q] = 1.f; sn[q] = 0.f; }
  if (r >= CTXL) { const int t = r - CTXL; const int l = lane & 15, a = l >> 3, i0 = 4 * (l & 7);
    const float pos = a ? (float)(t & 63) : (float)(t >> 6);
#pragma unroll
    for (int q = 0; q < 4; ++q) { const float inv = powf(10000.f, -(float)(i0 + q) / 32.f); sincosf(pos * inv, &sn[q], &cs[q]); } }
}
__device__ __forceinline__ float sum16lanes(float v) { v += __shfl_xor(v, 1); v += __shfl_xor(v, 2); v += __shfl_xor(v, 4); v += __shfl_xor(v, 8); return v; }
__device__ __forceinline__ void phase_rope_conv0(const Args& a, LAS char* lds, bool dry = false) {
  int tid = threadIdx.x; asm volatile("" : "+v"(tid)); tid &= 511; const int wave = tid >> 6, lane = tid & 63;
  bf16_t* Q = (bf16_t*)(a.ws + WS_QKVU);
  {
    const bf16_t* HG = (const bf16_t*)(a.ws + WS_HG);
    bf16_t* X2 = (bf16_t*)(a.ws + WS_X2);
    LAS char* lt = lds;
    LAS float* part = (LAS float*)(lds + 62 * 2048);
    LAS float* stats = part + 512;
    const float* dw_w = a.in[11]; const float* dw_b = a.in[12]; const float* ln_g = a.in[13]; const float* ln_b = a.in[14];
    const __amdgpu_buffer_rsrc_t wrs = __builtin_amdgcn_make_buffer_rsrc((void*)dw_w, 0, 31 * 1024 * 4, 0x00020000);
    for (int u = blockIdx.x; u < 520; u += gridDim.x) {
      int seg0, seg1, r0;
      if (u < 8) { seg0 = 0; seg1 = CTXL; r0 = u * 32; } else { seg0 = CTXL; seg1 = MT; r0 = CTXL + (u - 8) * 32; }
      for (int c = tid; c < 62 * 128; c += NTHREADS) { const int rr = c >> 7, cc = c & 127, gr = r0 - 15 + rr;
        u32x4 v = {0u, 0u, 0u, 0u}; if (gr >= seg0 && gr < seg1) v = *(const u32x4*)(HG + (size_t)gr * 1024 + cc * 8);
        *(LAS u32x4*)(lt + rr * 2048 + cc * 16) = v; }
      __syncthreads();
      float w0[31], w1[31];
#pragma unroll
      for (int j = 0; j < 31; ++j) { const u32x2 w = __builtin_amdgcn_raw_buffer_load_b64(wrs, tid * 8, j * 4096, 0); w0[j] = __uint_as_float(w[0]); w1[j] = __uint_as_float(w[1]); }
      const f32x2 bb = *(const f32x2*)(dw_b + 2 * tid);
      const f32x2 gg = *(const f32x2*)(ln_g + 2 * tid), gb = *(const f32x2*)(ln_b + 2 * tid);
#pragma unroll 1
      for (int hf = 0; hf < 4; ++hf) {
        float o0[8], o1[8];
        LAS const char* lth = lt + (hf * 8) * 2048 + tid * 4;
#pragma unroll
        for (int r = 0; r < 8; ++r) { o0[r] = bb[0]; o1[r] = bb[1]; }
#pragma unroll
        for (int i = 0; i < 38; ++i) {
          const unsigned p = *(LAS const unsigned*)(lth + i * 2048);
          const float x0 = bflo(p), x1 = bfhi(p);
#pragma unroll
          for (int r = 0; r < 8; ++r) { const int j = i - r; if (j >= 0 && j < 31) { o0[r] += x0 * w0[j]; o1[r] += x1 * w1[j]; } }
        }
#pragma unroll
        for (int r = 0; r < 8; ++r) {
          const float s = wave_sum(o0[r] + o1[r]), q = wave_sum(o0[r] * o0[r] + o1[r] * o1[r]);
          if (lane == 0) { part[(r * 8 + wave) * 2] = s; part[(r * 8 + wave) * 2 + 1] = q; }
        }
        __syncthreads();
        if (tid < 8) { float s = 0, q = 0;
#pragma unroll
          for (int w = 0; w < 8; ++w) { s += part[(tid * 8 + w) * 2]; q += part[(tid * 8 + w) * 2 + 1]; }
          const float mean = s * (1.f / 1024), var = q * (1.f / 1024) - mean * mean;
          stats[tid * 2] = mean; stats[tid * 2 + 1] = rsqrtf(fmaxf(var, 0.f) + EPS); }
        __syncthreads();
#pragma unroll
        for (int r = 0; r < 8; ++r) {
          const float mean = stats[r * 2], rstd = stats[r * 2 + 1];
          float y0 = (o0[r] - mean) * rstd * gg[0] + gb[0], y1 = (o1[r] - mean) * rstd * gg[1] + gb[1];
          y0 = y0 * sigmoid_fast(y0); y1 = y1 * sigmoid_fast(y1);
          *(unsigned*)(X2 + (size_t)(r0 + hf * 8 + r) * D + 1024 + 2 * tid) = cvtpk(y0, y1);
        }
      }
      __syncthreads();
    }
  }
  const float* qn = a.in[9]; const float* kn = a.in[10];
  unsigned* kmx = (unsigned*)(a.ws + WS_CTL + CTL_KMAX);
  const int slot = lane >> 4, l16 = lane & 15, e1 = (l16 >> 3) * 64 + 4 * (l16 & 7), e2 = e1 + 32;
  float km0 = 0.f, km1 = 0.f;
  for (int it = blockIdx.x; it < MT / 8; it += gridDim.x) {
    const int r = it * 8 + wave;
    float cs[4], sn[4]; rope_cs4(r, lane, cs, sn);
    bf16_t* rowp = Q + (size_t)r * N_QKV0;
#pragma unroll
    for (int hb = 0; hb < 12; hb += 4) {
      const int hh = hb + slot;
      if (hh < 10) {
        const float* g = hh < 8 ? qn : kn;
        const u32x2 a1 = *(const u32x2*)(rowp + hh * 128 + e1), a2 = *(const u32x2*)(rowp + hh * 128 + e2);
        float x1[4] = {bflo(a1[0]), bfhi(a1[0]), bflo(a1[1]), bfhi(a1[1])}, x2[4] = {bflo(a2[0]), bfhi(a2[0]), bflo(a2[1]), bfhi(a2[1])};
        float ss = 0;
#pragma unroll
        for (int q = 0; q < 4; ++q) ss += x1[q] * x1[q] + x2[q] * x2[q];
        ss = sum16lanes(ss);
        const float rstd = rsqrtf(ss * (1.f / 128) + EPS);
        const f32x4 g1 = *(const f32x4*)(g + e1), g2 = *(const f32x4*)(g + e2);
        float o1[4], o2[4], so = 0;
#pragma unroll
        for (int q = 0; q < 4; ++q) { const float y1 = x1[q] * rstd * g1[q], y2 = x2[q] * rstd * g2[q]; o1[q] = y1 * cs[q] - y2 * sn[q]; o2[q] = y2 * cs[q] + y1 * sn[q]; }
        const u32x2 w1 = {cvtpk(o1[0], o1[1]), cvtpk(o1[2], o1[3])}, w2 = {cvtpk(o2[0], o2[1]), cvtpk(o2[2], o2[3])};
        if (!dry) { *(u32x2*)(rowp + hh * 128 + e1) = w1; *(u32x2*)(rowp + hh * 128 + e2) = w2; }
        if (hb == 8) {
          so = bflo(w1[0]) * bflo(w1[0]) + bfhi(w1[0]) * bfhi(w1[0]) + bflo(w1[1]) * bflo(w1[1]) + bfhi(w1[1]) * bfhi(w1[1])
             + bflo(w2[0]) * bflo(w2[0]) + bfhi(w2[0]) * bfhi(w2[0]) + bflo(w2[1]) * bflo(w2[1]) + bfhi(w2[1]) * bfhi(w2[1]);
          so = sum16lanes(so); if (slot == 0) km0 = fmaxf(km0, so); else km1 = fmaxf(km1, so);
        }
      }
    }
  }
  if (l16 == 0 && slot < 2) atomicMax(&kmx[slot], __float_as_uint(slot == 0 ? km0 : km1));
}
__device__ __forceinline__ void phase_rope1(const Args& a, LAS char* lds, bool dry = false) {
  int tid = threadIdx.x; asm volatile("" : "+v"(tid)); tid &= 511; const int wave = tid >> 6, lane = tid & 63;
  bf16_t* Q = (bf16_t*)(a.ws + WS_QKVU);
  unsigned* kmx = (unsigned*)(a.ws + WS_CTL + CTL_KMAX) + 16;
  LAS unsigned* lk = (LAS unsigned*)lds;
  if (tid < 16) lk[tid] = 0u;
  __syncthreads();
  const int slot = lane >> 4, l16 = lane & 15, e1 = (l16 >> 3) * 64 + 4 * (l16 & 7), e2 = e1 + 32;
  for (int it = blockIdx.x; it < MT / 8; it += gridDim.x) {
    const int r = it * 8 + wave;
    float cs[4], sn[4]; rope_cs4(r, lane, cs, sn);
    bf16_t* rowp = Q + (size_t)r * N_IN1;
#pragma unroll 2
    for (int hb = (r < CTXL ? 16 : 0); hb < 32; hb += 4) {
      const int hh = hb + slot;
      const u32x2 a1 = *(const u32x2*)(rowp + hh * 128 + e1), a2 = *(const u32x2*)(rowp + hh * 128 + e2);
      const float x1[4] = {bflo(a1[0]), bfhi(a1[0]), bflo(a1[1]), bfhi(a1[1])}, x2[4] = {bflo(a2[0]), bfhi(a2[0]), bflo(a2[1]), bfhi(a2[1])};
      float o1[4], o2[4];
#pragma unroll
      for (int q = 0; q < 4; ++q) { o1[q] = x1[q] * cs[q] - x2[q] * sn[q]; o2[q] = x2[q] * cs[q] + x1[q] * sn[q]; }
      const u32x2 w1 = {cvtpk(o1[0], o1[1]), cvtpk(o1[2], o1[3])}, w2 = {cvtpk(o2[0], o2[1]), cvtpk(o2[2], o2[3])};
      if (r >= CTXL && !dry) { *(u32x2*)(rowp + hh * 128 + e1) = w1; *(u32x2*)(rowp + hh * 128 + e2) = w2; }
      if (hb >= 16) {
        float so = bflo(w1[0]) * bflo(w1[0]) + bfhi(w1[0]) * bfhi(w1[0]) + bflo(w1[1]) * bflo(w1[1]) + bfhi(w1[1]) * bfhi(w1[1])
                 + bflo(w2[0]) * bflo(w2[0]) + bfhi(w2[0]) * bfhi(w2[0]) + bflo(w2[1]) * bflo(w2[1]) + bfhi(w2[1]) * bfhi(w2[1]);
        so = sum16lanes(so);
        if (l16 == 0) atomicMax((unsigned*)&lk[hh - 16], __float_as_uint(so));
      }
    }
  }
  __syncthreads();
  if (tid < 16) atomicMax(&kmx[tid], lk[tid]);
  __syncthreads();
}

__device__ __forceinline__ void phase_attn(const Args& a, int L, LAS char* lds) {
  const bf16_t* Q = (const bf16_t*)(a.ws + WS_QKVU);
  const unsigned* kmx = (const unsigned*)(a.ws + WS_CTL + CTL_KMAX) + L * 16;
  if (L == 0) {
    bf16_t* X2 = (bf16_t*)(a.ws + WS_X2);
    for (int u = blockIdx.x; u < 520; u += gridDim.x) {
      const int head = u < 512 ? (u & 7) : (u - 512);
      const float kmax2 = __uint_as_float(kmx[head >> 2]);
      if (u < 512) { const int qb = u >> 3; const size_t q0 = (size_t)(CTXL + qb * 256);
        at::attn_body(Q + q0 * N_QKV0 + head * 128, N_QKV0, Q + 1024 + (head >> 2) * 128, Q + 1280 + (head >> 2) * 128, N_QKV0, X2 + q0 * D + head * 128, D, MT, kmax2, lds);
      } else {
        at::attn_body(Q + head * 128, N_QKV0, Q + 1024 + (head >> 2) * 128, Q + 1280 + (head >> 2) * 128, N_QKV0, X2 + head * 128, D, CTXL, kmax2, lds); }
    }
  } else {
    bf16_t* O = (bf16_t*)(a.ws + WS_Y);
    for (int u = blockIdx.x; u < 1024; u += gridDim.x) {
      const int x = u & 7, w = u >> 3, hc = x + 8 * (w >> 6), qb = w & 63, h = hc >> 1;
      const float kmax2 = __uint_as_float(kmx[hc]);
      const size_t q0 = (size_t)(CTXL + qb * 256);
      at::attn_body_c256(Q + q0 * N_IN1 + hc * 128, N_IN1, Q + 2048 + hc * 128, Q + 4096 + h * 256, N_IN1,
                         O + (size_t)(qb * 256) * 4096 + hc * 256, 4096, MT, kmax2, lds);
    }
  }
}

__device__ __forceinline__ void phase_diff(const Args& a) {
  int tid = threadIdx.x; asm volatile("" : "+v"(tid)); tid &= 511; const int wave = tid >> 6, lane = tid & 63;
  const bf16_t* O = (const bf16_t*)(a.ws + WS_Y);
  bf16_t* X2 = (bf16_t*)(a.ws + WS_X2);
  const float* lp = a.in[17];
  const float s1 = wave_sum(lp[lane] * lp[128 + lane] + lp[64 + lane] * lp[192 + lane]);
  const float s2 = wave_sum(lp[256 + lane] * lp[384 + lane] + lp[320 + lane] * lp[448 + lane]);
  const float lam = expf(s1) - expf(s2) + LAM_INIT;
  const f32x4 sg = *(const f32x4*)(a.in[18] + 4 * lane);
  for (int it = blockIdx.x; it < SEQ / 8; it += gridDim.x) {
    const int t = it * 8 + wave;
    const bf16_t* op = O + (size_t)t * 4096;
    bf16_t* xp = X2 + (size_t)(CTXL + t) * D;
#pragma unroll 2
    for (int h = 0; h < 8; ++h) {
      const u32x2 a0 = *(const u32x2*)(op + (2 * h) * 256 + 4 * lane), a1 = *(const u32x2*)(op + (2 * h + 1) * 256 + 4 * lane);
      float d[4] = {bflo(a0[0]) - lam * bflo(a1[0]), bfhi(a0[0]) - lam * bfhi(a1[0]), bflo(a0[1]) - lam * bflo(a1[1]), bfhi(a0[1]) - lam * bfhi(a1[1])};
      const float ss = wave_sum(d[0] * d[0] + d[1] * d[1] + d[2] * d[2] + d[3] * d[3]);
      const float rstd = rsqrtf(ss * (1.f / 256) + EPS) * (1.f - LAM_INIT);
      u32x2 pk = {cvtpk(d[0] * rstd * sg[0], d[1] * rstd * sg[1]), cvtpk(d[2] * rstd * sg[2], d[3] * rstd * sg[3])};
      *(u32x2*)(xp + h * 256 + 4 * lane) = pk;
    }
  }
}

__device__ __forceinline__ void phase_G(const Args& a, int L, LAS char* lds, bool dry = false) {
  int tid = threadIdx.x; asm volatile("" : "+v"(tid)); tid &= 511; const int wave = tid >> 6, lane = tid & 63;
  const int NTOK = L == 0 ? MT : SEQ, ROW0 = L == 0 ? 0 : CTXL;
  const float* ng = a.in[6] + (size_t)L * 4 * D;
  const float* MODL = (const float*)(a.ws + WS_MOD) + (size_t)(L * 2) * 12288;
  const float* router = a.in[19] + (size_t)L * D * NE; const float* rbias = a.in[20] + L * NE;
  const bf16_t* OUT = (const bf16_t*)(a.ws + WS_OUT);
  float* HRES = (float*)(a.ws + WS_HRES);
  bf16_t* F = (bf16_t*)(a.ws + WS_ABUF);
  int* counts = (int*)(a.ws + WS_CTL + CTL_CNT) + L * 64;
  int* top_e = (int*)(a.ws + WS_TOPE); float* top_w = (float*)(a.ws + WS_TOPW); int* top_p = (int*)(a.ws + WS_TOPP);
  LAS float* ft = (LAS float*)lds;
  LAS float* part = ft + 8 * D;
  for (int it = blockIdx.x; it < NTOK / 8; it += gridDim.x) {
    const int r = ROW0 + it * 8 + wave;
    const float* mod = MODL + (r < CTXL ? 12288 : 0);
    {
      float o[32], h[32];
      ld_row_bf16(OUT + (size_t)r * D, lane, o);
      const float* hp = L == 0 ? (r < CTXL ? a.in[2] + (size_t)r * D : a.in[0] + (size_t)(r - CTXL) * D) : HRES + (size_t)r * D;
      ld_row_f32(hp, lane, h);
      const float rstd1 = rsqrtf(sumsq32(o) * (1.f / D) + EPS);
#pragma unroll
      for (int j = 0; j < 4; ++j) { const int idx = 8 * lane + 512 * j;
        float g1[8], gt[8]; ld8f(ng + D + idx, g1); ld8f(mod + 2 * D + idx, gt);
#pragma unroll
        for (int i = 0; i < 8; ++i) h[8 * j + i] += gt[i] * (o[8 * j + i] * rstd1 * g1[i]);
        if (!dry) st8f(HRES + (size_t)r * D + idx, &h[8 * j]); }
      const float rstd2 = rsqrtf(sumsq32(h) * (1.f / D) + EPS);
      modulate_store<true, true>(h, rstd2, ng + 2 * D, mod + 3 * D, mod + 4 * D, (bf16_t*)((unsigned char*)F + (size_t)r * D), lane, ft + wave * D);
    }
    __syncthreads();
    float acc[8] = {0, 0, 0, 0, 0, 0, 0, 0};
    const int d0 = wave * 256;
#pragma unroll 2
    for (int dd = 0; dd < 256; dd += 4) {
      const float* rp = router + (size_t)(d0 + dd) * NE + lane;
      const float r0 = rp[0], r1 = rp[NE], r2 = rp[2 * NE], r3 = rp[3 * NE];
#pragma unroll
      for (int t = 0; t < 8; ++t) { const f32x4 fv = *(LAS const f32x4*)(ft + t * D + d0 + dd); acc[t] += fv[0] * r0 + fv[1] * r1 + fv[2] * r2 + fv[3] * r3; }
    }
#pragma unroll
    for (int t = 0; t < 8; ++t) part[(wave * 8 + t) * 64 + lane] = acc[t];
    __syncthreads();
    float logit = 0;
#pragma unroll
    for (int w = 0; w < 8; ++w) logit += part[(w * 8 + wave) * 64 + lane];
#if MK_DIAG
    ((float*)(a.ws + WS_Y))[(size_t)r * 64 + lane] = logit;
#endif
    const float score = sigmoidf_(logit);
    const float choice = score + rbias[lane];
    int rank = 0; const int gl = lane & 7;
#pragma unroll
    for (int j = 0; j < 8; ++j) { const float o = __shfl(choice, (lane & ~7) | j); rank += (o > choice || (o == choice && j < gl)) ? 1 : 0; }
    float gs = rank < 2 ? choice : 0.f;
    gs += __shfl_xor(gs, 1); gs += __shfl_xor(gs, 2); gs += __shfl_xor(gs, 4);
    int grank = 0; const int g = lane >> 3;
#pragma unroll
    for (int j = 0; j < 8; ++j) { const float o = __shfl(gs, j * 8); grank += (o > gs || (o == gs && j < g)) ? 1 : 0; }
    const bool gsel = grank < 4;
    const float mc = gsel ? choice : -INFINITY;
    int erank = 0;
#pragma unroll 4
    for (int j = 0; j < 64; ++j) { const float o = __int_as_float(__builtin_amdgcn_readlane(__float_as_int(mc), j)); erank += (o > mc || (o == mc && j < lane)) ? 1 : 0; }
    const bool sel = gsel && erank < 8;
    const unsigned long long bal = __ballot(sel);
    const int idx = __popcll(bal & ((1ull << lane) - 1ull));
    const float ssum = wave_sum(sel ? score : 0.f);
    if (sel && !dry) { const int pos = atomicAdd(&counts[lane], 1);
      top_e[r * 8 + idx] = lane; top_w[r * 8 + idx] = score / ssum * 2.5f; top_p[r * 8 + idx] = pos; }
  }
}

__device__ __forceinline__ void moe_tile_prefix(const int* counts, LAS int* ts) {
  if (threadIdx.x == 0) { int s = 0; for (int e = 0; e < 64; ++e) { ts[e] = s; s += (counts[e] + 255) >> 8; } ts[64] = s; }
  __syncthreads();
}
__device__ __forceinline__ void phase_H(const Args& a, int L, LAS char* lds) {
  const int NTOK = L == 0 ? MT : SEQ, ROW0 = L == 0 ? 0 : CTXL;
  const int* counts = (const int*)(a.ws + WS_CTL + CTL_CNT) + L * 64;
  const int* top_e = (const int*)(a.ws + WS_TOPE); const int* top_p = (const int*)(a.ws + WS_TOPP);
  int* tslot = (int*)(a.ws + WS_TSLOT); int* stok = (int*)(a.ws + WS_STOK);
  LAS int* ts = (LAS int*)lds;
  moe_tile_prefix(counts, ts);
  int tid = threadIdx.x; asm volatile("" : "+v"(tid)); tid &= 511;
  const int gt = blockIdx.x * NTHREADS + tid, gs = gridDim.x * NTHREADS;
  for (int i = gt; i < NTOK * 8; i += gs) { const int q = ROW0 * 8 + i; const int e = top_e[q]; const int slot = ts[e] * 256 + top_p[q]; stok[slot] = q >> 3; tslot[q] = slot; }
  for (int i = gt; i < 64 * 256; i += gs) { const int e = i >> 8, p = i & 255, cnt = counts[e], nt = (cnt + 255) >> 8; if (cnt + p < nt * 256) stok[ts[e] * 256 + cnt + p] = ROW0; }
  for (int i = gt; i < NTOK; i += gs) stok[SH_BASE + i] = ROW0 + i;
  __syncthreads();
}
struct MoeSched {
  LAS const int* ts; int TR, NN, total; const unsigned char* W; size_t woff;
  __device__ __forceinline__ bool unit(int i, int& slot0, const unsigned char*& Bt, int& bcol) const {
    for (int u = blockIdx.x + i * (int)gridDim.x; ; u += gridDim.x) {
      const int rnd = u >> 8, b = u & 255, v = rnd * 256 + (b & 7) * 32 + (b >> 3);
      if (rnd * 256 >= total) return false;
      if (v >= total) return false;
      const int m = v / NN, pn = v % NN;
      int e;
      if (m >= TR) { e = 64; slot0 = SH_BASE + 256 * (m - TR); } else { e = 0; while (ts[e + 1] <= m) ++e; slot0 = 256 * m; }
      Bt = W + (size_t)e * WMOE8_E + woff; bcol = pn * 256;
      return true;
    }
  }
};
__device__ __forceinline__ void phase_moe_up(const Args& a, int L, LAS char* lds) {
  const int NSH = L == 0 ? MT / 256 : SEQ / 256;
  const int* counts = (const int*)(a.ws + WS_CTL + CTL_CNT) + L * 64;
  LAS int* ts = (LAS int*)(lds + LDS_CTL + 64);
  moe_tile_prefix(counts, ts);
  const int TR = ts[64], TM = TR + NSH;
  const unsigned char* F = (const unsigned char*)(a.ws + WS_ABUF); const unsigned char* W = (const unsigned char*)(a.ws + WS_WMOE) + (size_t)L * 65 * WMOE8_E;
  const int* stok = (const int*)(a.ws + WS_STOK);
  EpiSwiGLU8 epi{(unsigned char*)(a.ws + WS_ACT), EFF};
  MoeSched sc{ts, TR, 4, TM * 4, W, 0};
  gemm8_run<true, D, D, D>(F, stok, lds, epi, sc);
}
__device__ __forceinline__ void phase_moe_down(const Args& a, int L, LAS char* lds) {
  const int NSH = L == 0 ? MT / 256 : SEQ / 256;
  const int* counts = (const int*)(a.ws + WS_CTL + CTL_CNT) + L * 64;
  LAS int* ts = (LAS int*)(lds + LDS_CTL + 64);
  moe_tile_prefix(counts, ts);
  const int TR = ts[64], TM = TR + NSH;
  const unsigned char* ACT = (const unsigned char*)(a.ws + WS_ACT); const unsigned char* W = (const unsigned char*)(a.ws + WS_WMOE) + (size_t)L * 65 * WMOE8_E;
  EpiPlainS epi{(bf16_t*)(a.ws + WS_Y), D, 1.f / 128.f};
  MoeSched sc{ts, TR, 8, TM * 8, W, (size_t)1024 * D};
  gemm8_run<false, EFF, EFF, EFF>(ACT, nullptr, lds, epi, sc);
}
__device__ __forceinline__ void phase_combine(const Args& a, int L, bool dry = false) {
  int tid = threadIdx.x; asm volatile("" : "+v"(tid)); tid &= 511; const int wave = tid >> 6, lane = tid & 63;
  const int NTOK = L == 0 ? MT : SEQ, ROW0 = L == 0 ? 0 : CTXL;
  const float* ng = a.in[6] + (size_t)L * 4 * D;
  const float* MODL = (const float*)(a.ws + WS_MOD) + (size_t)(L * 2) * 12288;
  const bf16_t* Y = (const bf16_t*)(a.ws + WS_Y);
  float* HRES = (float*)(a.ws + WS_HRES);
  const int* tslot = (const int*)(a.ws + WS_TSLOT); const float* top_w = (const float*)(a.ws + WS_TOPW);
  for (int it = blockIdx.x; it < NTOK / 8; it += gridDim.x) {
    const int r = ROW0 + it * 8 + wave;
    const float* mod = MODL + (r < CTXL ? 12288 : 0);
    float y[32];
    { float t[32]; ld_row_bf16(Y + (size_t)(SH_BASE + r - ROW0) * D, lane, t);
#pragma unroll
      for (int i = 0; i < 32; ++i) y[i] = t[i]; }
#pragma unroll 4
    for (int k = 0; k < 8; ++k) { const int slot = tslot[r * 8 + k]; const float w = top_w[r * 8 + k];
      float t[32]; ld_row_bf16(Y + (size_t)slot * D, lane, t);
#pragma unroll
      for (int i = 0; i < 32; ++i) y[i] += w * t[i]; }
    const float rstd = rsqrtf(sumsq32(y) * (1.f / D) + EPS);
    float h[32]; ld_row_f32(HRES + (size_t)r * D, lane, h);
#pragma unroll
    for (int j = 0; j < 4; ++j) { const int idx = 8 * lane + 512 * j;
      float g3[8], gt[8]; ld8f(ng + 3 * D + idx, g3); ld8f(mod + 5 * D + idx, gt);
#pragma unroll
      for (int i = 0; i < 8; ++i) h[8 * j + i] += gt[i] * (y[8 * j + i] * rstd * g3[i]);
      if (L == 0) { if (!dry) st8f(HRES + (size_t)r * D + idx, &h[8 * j]); } else st8f(a.out + (size_t)(r - CTXL) * D + idx, &h[8 * j]); }
    if (L == 0) {
      const float* mod1 = MODL + 2 * 12288 + (r < CTXL ? 12288 : 0);
      const float rstd2 = rsqrtf(sumsq32(h) * (1.f / D) + EPS);
      modulate_store<false>(h, rstd2, a.in[6] + (size_t)4 * D, mod1, mod1 + D, (bf16_t*)(a.ws + WS_ABUF) + (size_t)r * D, lane, nullptr);
    }
  }
}

constexpr int NPH = 21;
typedef const __attribute__((address_space(4))) Args* ArgsP;
#if defined(__HIP_DEVICE_COMPILE__)
#define FRESH_ARGS() const Args a = *({ ArgsP _p = (ArgsP)__builtin_amdgcn_kernarg_segment_ptr(); asm volatile("" : "+s"(_p)); _p; })
#else
#define FRESH_ARGS() const Args a = kargs
#endif
__global__ void __launch_bounds__(NTHREADS, 2) fwd(Args kargs) {
  extern __shared__ __attribute__((aligned(16))) unsigned char lds_raw[];
  LAS char* lds = (LAS char*)lds_raw;
  const int lo = kargs.ph_lo, hi = kargs.ph_hi;
  if (threadIdx.x < 64) ((LAS unsigned*)(lds + LDS_CTL))[threadIdx.x] = 0u;
  __syncthreads();
  if (hi - lo > 1) (void)xcd_barrier_post((unsigned*)(kargs.ws + WS_CTL), (volatile LAS unsigned*)(lds + LDS_CTL));
#ifndef PHASE_MASK
#define PHASE_MASK 0xFFFFFFFFu
#endif
#define IN(k) (((PHASE_MASK >> (k)) & 1u) && lo <= (k) && (k) < hi)
#ifndef PH_REPEAT_MASK
#define PH_REPEAT_MASK 0u
#endif
#define REP(k) for (int _rep = 0; _rep < (((PH_REPEAT_MASK >> (k)) & 1u) ? 2 : 1); ++_rep)
#define SEAM(k) do { if ((k) + 1 < hi) { XcdBarrier _b; _b.bar = (unsigned*)(a.ws + WS_CTL); _b.x = xb_xcc_id(); _b.st = (volatile LAS unsigned*)(lds + LDS_CTL); xcd_barrier(_b); } } while (0)

  if (IN(0)) { FRESH_ARGS(); REP(0) phase_prologue(a, lds); SEAM(0); }
  if (IN(1)) { FRESH_ARGS(); REP(1) phase_modulate0(a); SEAM(1); }
#pragma unroll
  for (int L = 0; L < 2; ++L) {
    const int base = 2 + (L == 0 ? 0 : 9);
    if (IN(base + 0)) {
      FRESH_ARGS();
      const bf16_t* A = (const bf16_t*)(a.ws + WS_ABUF);
      const bf16_t* Bt = (const bf16_t*)(a.ws + (L == 0 ? WS_WIN0 : WS_WIN1));
      const int nN = L == 0 ? N_IN0 / 256 : N_IN1 / 256, nM = MT / 256;
      EpiG1 epi{EpiPlain{(bf16_t*)(a.ws + WS_QKVU), L == 0 ? N_QKV0 : N_IN1}, EpiPair<0>{(bf16_t*)(a.ws + WS_HG), 1024, N_QKV0}, L == 0 ? N_QKV0 : N_IN1};
      REP(2) for (int u = blockIdx.x; u < nM * nN; u += gridDim.x) { int pm, pn; dense_unit(u, nM, nN, pm, pn);
        gemm_tile<false>(A, D, nullptr, pm * 256, Bt, D, pn * 256, D, lds, epi); }
      SEAM(base + 0);
    }
    if (L == 0) {
      if (IN(3)) { FRESH_ARGS(); if ((PH_REPEAT_MASK >> 3) & 1u) { phase_rope_conv0(a, lds, true); __syncthreads(); } phase_rope_conv0(a, lds); SEAM(3); }
      if (IN(4)) { FRESH_ARGS(); REP(4) phase_attn(a, 0, lds); SEAM(4); }
    } else {
      if (IN(12)) { FRESH_ARGS(); if ((PH_REPEAT_MASK >> 12) & 1u) { phase_rope1(a, lds, true); __syncthreads(); } phase_rope1(a, lds); SEAM(12); }
      if (IN(13)) { FRESH_ARGS(); REP(13) phase_attn(a, 1, lds); SEAM(13); }
      if (IN(14)) { FRESH_ARGS(); REP(14) phase_diff(a); SEAM(14); }
    }
    const int b2 = L == 0 ? 5 : 15;
    if (IN(b2 + 0)) {
      FRESH_ARGS();
      const bf16_t* A = (const bf16_t*)(a.ws + WS_X2);
      const bf16_t* Bt = (const bf16_t*)(a.ws + (L == 0 ? WS_WOUT0 : WS_WOUT1));
      const int nN = D / 256, nM = L == 0 ? MT / 256 : SEQ / 256, r0 = L == 0 ? 0 : CTXL;
      EpiPlain epi{(bf16_t*)(a.ws + WS_OUT), D};
      REP(5) for (int u = blockIdx.x; u < nM * nN; u += gridDim.x) { int pm, pn; dense_unit(u, nM, nN, pm, pn);
        gemm_tile<false>(A, D, nullptr, r0 + pm * 256, Bt, D, pn * 256, D, lds, epi); }
      SEAM(b2 + 0);
    }
    if (IN(b2 + 1)) { FRESH_ARGS(); if ((PH_REPEAT_MASK >> 6) & 1u) { phase_G(a, L, lds, true); __syncthreads(); } phase_G(a, L, lds); SEAM(b2 + 1); }
    if (IN(b2 + 2)) { FRESH_ARGS(); REP(7) phase_H(a, L, lds); SEAM(b2 + 2); }
    if (IN(b2 + 3)) { FRESH_ARGS(); REP(8) phase_moe_up(a, L, lds); SEAM(b2 + 3); }
    if (IN(b2 + 4)) { FRESH_ARGS(); REP(9) phase_moe_down(a, L, lds); SEAM(b2 + 4); }
    if (IN(b2 + 5)) { FRESH_ARGS(); if ((PH_REPEAT_MASK >> 10) & 1u) phase_combine(a, L, true); phase_combine(a, L); SEAM(b2 + 5); }
  }
#undef IN
#undef SEAM
}

#ifndef MK_DIAG
#define MK_DIAG 0
#endif
#if MK_DIAG
__device__ __forceinline__ void rope_cs(int r, int lane, float& cs, float& sn) {
  cs = 1.f; sn = 0.f;
  if (r >= CTXL) { const int t = r - CTXL; const int a = lane >> 5, i = lane & 31;
    const float pos = a ? (float)(t & 63) : (float)(t >> 6);
    const float inv = powf(10000.f, -(float)i / 32.f);
    sincosf(pos * inv, &sn, &cs); }
}
__device__ __forceinline__ bool dclose(float got, float ref, float rtol, float atol) { return fabsf(got - ref) <= rtol * fabsf(ref) + atol; }
__device__ __forceinline__ unsigned dhash(unsigned x) { x ^= x >> 16; x *= 0x7feb352du; x ^= x >> 15; x *= 0x846ca68bu; x ^= x >> 16; return x; }
__device__ float wdot(const bf16_t* arow, const float* W, int ldw, int col, int K, int lane) {
  float s = 0; for (int k = lane; k < K; k += 64) s += bf2f(arow[k]) * W[(size_t)k * ldw + col]; return wave_sum(s); }
__device__ void dflag(int* dg, int s, int bad, int lane) { if (lane == 0 && bad) atomicAdd(&dg[s], bad); }
__device__ const float* h0row(const Args& a, int r) { return r < CTXL ? a.in[2] + (size_t)r * D : a.in[0] + (size_t)(r - CTXL) * D; }
__device__ int pick_row(unsigned h, int lo, int n) { const unsigned m = h % 8; if (m == 0) return lo; if (m == 1) return lo + n - 1; if (m == 2) return lo + 255 < lo + n ? lo + 255 : lo; if (m == 3) return lo + 256 < lo + n ? lo + 256 : lo; return lo + (int)((h >> 3) % (unsigned)n); }
__device__ void naive_attn(const bf16_t* q, const bf16_t* K, const bf16_t* V, int ld, int nkeys, int lane, float& o0, float& o1) {
  const float q0 = bf2f(q[lane]), q1 = bf2f(q[lane + 64]);
  float m = -1e30f, l = 0; o0 = 0; o1 = 0;
  for (int k = 0; k < nkeys; ++k) {
    const float s = wave_sum(q0 * bf2f(K[(size_t)k * ld + lane]) + q1 * bf2f(K[(size_t)k * ld + lane + 64])) * 0.088388347648318440f;
    const float mn = fmaxf(m, s), al = expf(m - mn), p = expf(s - mn);
    l = l * al + p; o0 = o0 * al + p * bf2f(V[(size_t)k * ld + lane]); o1 = o1 * al + p * bf2f(V[(size_t)k * ld + lane + 64]); m = mn;
  }
  o0 /= l; o1 /= l;
}
__global__ void __launch_bounds__(256) diag(Args a, int k) {
  __shared__ float fsh[4][2048];
  __shared__ float csh[4][64];
  const int lane = threadIdx.x & 63, wv = threadIdx.x >> 6, gw = blockIdx.x * 4 + wv;
  int* dg = (int*)(a.ws + WS_CTL + CTL_CNT + 512);
  const float* MOD = (const float*)(a.ws + WS_MOD);
  const bf16_t* AB = (const bf16_t*)(a.ws + WS_ABUF);
  const bf16_t* QK = (const bf16_t*)(a.ws + WS_QKVU);
  const bf16_t* HG = (const bf16_t*)(a.ws + WS_HG);
  const bf16_t* X2 = (const bf16_t*)(a.ws + WS_X2);
  const bf16_t* OUT = (const bf16_t*)(a.ws + WS_OUT);
  const bf16_t* ACT = (const bf16_t*)(a.ws + WS_ACT);
  const bf16_t* Y = (const bf16_t*)(a.ws + WS_Y);
  const float* HRES = (const float*)(a.ws + WS_HRES);
  const int* top_e = (const int*)(a.ws + WS_TOPE); const float* top_w = (const float*)(a.ws + WS_TOPW); const int* top_p = (const int*)(a.ws + WS_TOPP);
  const int* tslot = (const int*)(a.ws + WS_TSLOT); const int* stok = (const int*)(a.ws + WS_STOK);
  const unsigned h = dhash(gw * 7919u + k * 104729u + 17u), h2 = dhash(h + 12345u);
  int bad = 0;
  const int L = k >= 11 ? 1 : 0;
  const int NTOK = L == 0 ? MT : SEQ, ROW0 = L == 0 ? 0 : CTXL;
  const int* counts = (const int*)(a.ws + WS_CTL + CTL_CNT) + L * 64;
  if (k == 0) {
    const int LL = gw & 1, which = (gw >> 1) & 1, j = h % 12288;
    const float* v = which ? a.in[3] : a.in[1];
    float s = 0; for (int d = lane; d < D; d += 64) { const float x = v[d]; s += x * sigmoidf_(x) * a.in[4][((size_t)LL * D + d) * 12288 + j]; }
    s = wave_sum(s) + a.in[5][LL * 12288 + j];
    bad = !dclose(MOD[(LL * 2 + which) * 12288 + j], s, 1e-3f, 1e-3f); dflag(dg, 1, bad, lane);
  } else if (k == 1) {
    const int r = pick_row(h, 0, MT); const float* x = h0row(a, r); const float* mod = MOD + (r < CTXL ? 12288 : 0);
    float ss = 0; for (int d = lane; d < D; d += 64) ss += x[d] * x[d]; ss = wave_sum(ss); const float rstd = rsqrtf(ss / D + EPS);
    for (int d = lane; d < D; d += 64) { const float ref = x[d] * rstd * a.in[6][d] * (1.f + mod[D + d]) + mod[d]; bad += !dclose(bf2f(AB[(size_t)r * D + d]), ref, 0.01f, 0.01f); }
    bad = (int)wave_sum((float)bad); dflag(dg, 2, bad, lane);
  } else if (k == 2 || k == 11) {
    const int r = pick_row(h, 0, MT);
    if (L == 0) {
      const int c = h2 % N_QKV0; const float ref = wdot(AB + (size_t)r * D, a.in[7], N_IN0, c, D, lane);
      bad = !dclose(bf2f(QK[(size_t)r * N_QKV0 + c]), ref, 0.02f, 0.05f); dflag(dg, 3, bad, lane);
      const int ch = (h2 >> 11) % 1024; const float av = wdot(AB + (size_t)r * D, a.in[7], N_IN0, N_QKV0 + ch, D, lane), gv = wdot(AB + (size_t)r * D, a.in[7], N_IN0, N_QKV0 + 1024 + ch, D, lane);
      bad = !dclose(bf2f(HG[(size_t)r * 1024 + ch]), av * sigmoidf_(gv), 0.03f, 0.05f); dflag(dg, 4, bad, lane);
    } else {
      const int c = h2 % N_IN1; const float ref = wdot(AB + (size_t)r * D, a.in[15], N_IN1, c, D, lane);
      bad = !dclose(bf2f(QK[(size_t)r * N_IN1 + c]), ref, 0.02f, 0.05f); dflag(dg, 15, bad, lane);
    }
  } else if (k == 3) {
    { const int r = pick_row(h, 0, MT), hh = h2 % 10; const float* g = hh < 8 ? a.in[9] : a.in[10];
      float raw0 = 0, raw1 = 0;
      for (int d = 0; d < 128; ++d) { const float v = wdot(AB + (size_t)r * D, a.in[7], N_IN0, hh * 128 + d, D, lane); if (d == lane) raw0 = v; if (d == lane + 64) raw1 = v; }
      const float rstd = rsqrtf(wave_sum(raw0 * raw0 + raw1 * raw1) / 128.f + EPS);
      const float y0 = raw0 * rstd * g[lane], y1 = raw1 * rstd * g[lane + 64];
      float cs, sn; rope_cs(r, lane, cs, sn);
      const float cs0 = __shfl(cs, lane & 31), sn0 = __shfl(sn, lane & 31), cs1 = __shfl(cs, 32 + (lane & 31)), sn1 = __shfl(sn, 32 + (lane & 31));
      const float p0 = __shfl_xor(y0, 32), p1 = __shfl_xor(y1, 32);
      const float o0 = (lane < 32) ? y0 * cs0 - p0 * sn0 : y0 * cs0 + p0 * sn0;
      const float o1 = (lane < 32) ? y1 * cs1 - p1 * sn1 : y1 * cs1 + p1 * sn1;
      bad = !dclose(bf2f(QK[(size_t)r * N_QKV0 + hh * 128 + lane]), o0, 0.03f, 0.05f) + !dclose(bf2f(QK[(size_t)r * N_QKV0 + hh * 128 + 64 + lane]), o1, 0.03f, 0.05f);
      bad = (int)wave_sum((float)bad); dflag(dg, 5, bad, lane); }
    { const int r = pick_row(h2, 0, MT); const int seg0 = r < CTXL ? 0 : CTXL, seg1 = r < CTXL ? CTXL : MT;
      float cv[16]; float s1 = 0, s2 = 0;
      for (int q = 0; q < 16; ++q) { const int c = lane + 64 * q; float acc = a.in[12][c];
        for (int j = 0; j < 31; ++j) { const int rr = r + j - 15; if (rr >= seg0 && rr < seg1) acc += bf2f(HG[(size_t)rr * 1024 + c]) * a.in[11][j * 1024 + c]; }
        cv[q] = acc; s1 += acc; s2 += acc * acc; }
      s1 = wave_sum(s1); s2 = wave_sum(s2); const float mean = s1 / 1024.f, rstd = rsqrtf(s2 / 1024.f - mean * mean + EPS);
      bad = 0;
      for (int q = 0; q < 16; ++q) { const int c = lane + 64 * q; float y = (cv[q] - mean) * rstd * a.in[13][c] + a.in[14][c]; y = y * sigmoidf_(y);
        bad += !dclose(bf2f(X2[(size_t)r * D + 1024 + c]), y, 0.03f, 0.03f); }
      bad = (int)wave_sum((float)bad); dflag(dg, 6, bad, lane); }
  } else if (k == 4) {
    if (gw < 64) { const int r = pick_row(h, 0, MT), head = h2 % 8; const int nkeys = r < CTXL ? CTXL : MT;
      float o0, o1; naive_attn(QK + (size_t)r * N_QKV0 + head * 128, QK + 1024 + (head >> 2) * 128, QK + 1280 + (head >> 2) * 128, N_QKV0, nkeys, lane, o0, o1);
      bad = !dclose(bf2f(X2[(size_t)r * D + head * 128 + lane]), o0, 0.05f, 0.01f) + !dclose(bf2f(X2[(size_t)r * D + head * 128 + 64 + lane]), o1, 0.05f, 0.01f);
      bad = (int)wave_sum((float)bad); dflag(dg, 7, bad, lane); }
  } else if (k == 5 || k == 15) {
    const int r = pick_row(h, ROW0, NTOK), c = h2 % D; const float ref = wdot(X2 + (size_t)r * D, L == 0 ? a.in[8] : a.in[16], D, c, D, lane);
    bad = !dclose(bf2f(OUT[(size_t)r * D + c]), ref, 0.02f, 0.05f); dflag(dg, L == 0 ? 8 : 19, bad, lane);
  } else if (k == 6 || k == 16) {
    const int r = pick_row(h, ROW0, NTOK); const float* mod = MOD + (size_t)(L * 2) * 12288 + (r < CTXL ? 12288 : 0); const float* ng = a.in[6] + (size_t)L * 4 * D;
    float ss = 0; for (int d = lane; d < D; d += 64) { const float o = bf2f(OUT[(size_t)r * D + d]); ss += o * o; } ss = wave_sum(ss); const float rstd1 = rsqrtf(ss / D + EPS);
    bad = 0;
    if (L == 0) { const float* x = h0row(a, r); for (int d = lane; d < D; d += 64) { const float ref = x[d] + mod[2 * D + d] * (bf2f(OUT[(size_t)r * D + d]) * rstd1 * ng[D + d]); bad += !dclose(HRES[(size_t)r * D + d], ref, 1e-3f, 1e-3f); } }
    float s2 = 0; for (int d = lane; d < D; d += 64) { const float x = HRES[(size_t)r * D + d]; s2 += x * x; } s2 = wave_sum(s2); const float rstd2 = rsqrtf(s2 / D + EPS);
    for (int d = lane; d < D; d += 64) { const float f = HRES[(size_t)r * D + d] * rstd2 * ng[2 * D + d] * (1.f + mod[4 * D + d]) + mod[3 * D + d]; fsh[wv][d] = f; bad += !dclose(bf2f(AB[(size_t)r * D + d]), f, 0.01f, 0.01f); }
    bad = (int)wave_sum((float)bad); dflag(dg, L == 0 ? 9 : 20, bad, lane);
    __syncthreads();
    float lg = 0; for (int d = 0; d < D; ++d) lg += fsh[wv][d] * a.in[19][((size_t)L * D + d) * NE + lane];
    const float sc = sigmoidf_(lg); csh[wv][lane] = sc + a.in[20][L * NE + lane];
    __syncthreads();
    { const float plg = ((const float*)(a.ws + WS_Y))[(size_t)r * 64 + lane]; int lb = !dclose(plg, lg, 1e-3f, 1e-3f); lb = (int)wave_sum((float)lb); if (lane == 0 && lb) { atomicAdd(&dg[32 + (L == 0 ? 10 : 21) + 3], 1); atomicOr(&dg[60], 1 << (r & 7)); } }
    unsigned long long wsel;
    { const float choice = csh[wv][lane]; int rank = 0; const int gl = lane & 7;
      for (int j = 0; j < 8; ++j) { const float o = __shfl(choice, (lane & ~7) | j); rank += (o > choice || (o == choice && j < gl)) ? 1 : 0; }
      float gs = rank < 2 ? choice : 0.f; gs += __shfl_xor(gs, 1); gs += __shfl_xor(gs, 2); gs += __shfl_xor(gs, 4);
      int grank = 0; const int g = lane >> 3;
      for (int j = 0; j < 8; ++j) { const float o = __shfl(gs, j * 8); grank += (o > gs || (o == gs && j < g)) ? 1 : 0; }
      const bool gsel = grank < 4; const float mc = gsel ? choice : -INFINITY; int erank = 0;
      for (int j = 0; j < 64; ++j) { const float o = __shfl(mc, j); erank += (o > mc || (o == mc && j < lane)) ? 1 : 0; }
      wsel = __ballot(gsel && erank < 8); }
    int setbad = 0;
    if (lane == 0) {
      float gsc[8]; for (int g = 0; g < 8; ++g) { float m1 = -1e30f, m2 = -1e30f; for (int j = 0; j < 8; ++j) { const float v = csh[wv][g * 8 + j]; if (v > m1) { m2 = m1; m1 = v; } else if (v > m2) m2 = v; } gsc[g] = m1 + m2; }
      bool gs[8] = {false, false, false, false, false, false, false, false};
      for (int t = 0; t < 4; ++t) { int bi = 0; float bv = -1e30f; for (int g = 0; g < 8; ++g) if (!gs[g] && gsc[g] > bv) { bv = gsc[g]; bi = g; } gs[bi] = true; }
      unsigned long long selm = 0; for (int t = 0; t < 8; ++t) { int bi = 0; float bv = -1e30f; for (int e = 0; e < 64; ++e) if (gs[e >> 3] && !((selm >> e) & 1ull) && csh[wv][e] > bv) { bv = csh[wv][e]; bi = e; } selm |= 1ull << bi; }
      unsigned long long got = 0; for (int t = 0; t < 8; ++t) { const int e = top_e[r * 8 + t]; if (e < 0 || e > 63) setbad = 1000; else got |= 1ull << e; }
      if (setbad == 0 && got != selm) setbad = 1;
      if (wsel != selm) atomicAdd(&dg[32 + (L == 0 ? 10 : 21) + 4], 1);
    }
    setbad = __shfl(setbad, 0);
    { float wgot = -1.f; int mine = 0; for (int t = 0; t < 8; ++t) if (top_e[r * 8 + t] == lane) { mine = 1; wgot = top_w[r * 8 + t]; }
      const float ssum = wave_sum(mine ? sc : 0.f);
      int wbad = (mine && !dclose(wgot, sc / ssum * 2.5f, 0.01f, 1e-3f)) ? 1 : 0; wbad = (int)wave_sum((float)wbad);
      if (lane == 0) { int* q = &dg[32 + (L == 0 ? 10 : 21)]; if (setbad >= 1000) atomicAdd(q + 1, 1); else if (setbad) atomicAdd(q, 1); else if (wbad) atomicAdd(q + 2, 1); } }
  } else if (k == 7 || k == 17) {
    const int r = pick_row(h, ROW0, NTOK), t = h2 % 8, q = r * 8 + t; const int slot = tslot[q], e = top_e[q];
    int ts0 = 0; for (int j = 0; j < e; ++j) ts0 += (counts[j] + 255) >> 8;
    bad = (slot < ts0 * 256 || slot >= ts0 * 256 + counts[e] || stok[slot] != r || top_p[q] != slot - ts0 * 256) ? 1 : 0;
    bad += (stok[SH_BASE + r - ROW0] != r) ? 1 : 0;
    dflag(dg, L == 0 ? 11 : 22, bad, lane);
  } else if (k == 8 || k == 18 || k == 9 || k == 19) {
    int TR = 0; for (int j = 0; j < 64; ++j) TR += (counts[j] + 255) >> 8;
    int slot, e;
    if ((h & 3) == 0) { slot = SH_BASE + (int)((h >> 2) % (unsigned)NTOK); e = 64; }
    else { e = (h >> 2) % 64; int guard = 0; while (counts[e] == 0 && guard++ < 64) e = (e + 1) % 64; int ts0 = 0; for (int j = 0; j < e; ++j) ts0 += (counts[j] + 255) >> 8;
      const unsigned m = (h >> 8) % 4; const int cnt = counts[e]; const int p = m == 0 ? 0 : m == 1 ? cnt - 1 : (int)((h >> 10) % (unsigned)cnt); slot = ts0 * 256 + p; }
    const int tok = stok[slot];
    if (k == 8 || k == 18) {
      const int ch = h2 % EFF;
      const float* Wg = e < 64 ? a.in[21] + ((size_t)L * 64 + e) * D * EFF : a.in[24] + (size_t)L * D * EFF;
      const float* Wu = e < 64 ? a.in[22] + ((size_t)L * 64 + e) * D * EFF : a.in[25] + (size_t)L * D * EFF;
      const float gv = wdot(AB + (size_t)tok * D, Wg, EFF, ch, D, lane), uv = wdot(AB + (size_t)tok * D, Wu, EFF, ch, D, lane);
      bad = !dclose(bf2f(ACT[(size_t)slot * EFF + ch]), gv * sigmoidf_(gv) * uv, 0.03f, 0.03f); dflag(dg, L == 0 ? 12 : 23, bad, lane);
    } else {
      const int c = h2 % D; const float* Wd = e < 64 ? a.in[23] + ((size_t)L * 64 + e) * EFF * D : a.in[26] + (size_t)L * EFF * D;
      const float ref = wdot(ACT + (size_t)slot * EFF, Wd, D, c, EFF, lane);
      bad = !dclose(bf2f(Y[(size_t)slot * D + c]), ref, 0.02f, 0.03f); dflag(dg, L == 0 ? 13 : 24, bad, lane);
    }
  } else if (k == 10 || k == 20) {
    const int r = pick_row(h, ROW0, NTOK); const float* mod = MOD + (size_t)(L * 2) * 12288 + (r < CTXL ? 12288 : 0); const float* ng = a.in[6] + (size_t)L * 4 * D;
    float ss = 0; for (int d = lane; d < D; d += 64) { float y = bf2f(Y[(size_t)(SH_BASE + r - ROW0) * D + d]); for (int t = 0; t < 8; ++t) y += top_w[r * 8 + t] * bf2f(Y[(size_t)tslot[r * 8 + t] * D + d]); fsh[wv][d] = y; ss += y * y; }
    ss = wave_sum(ss); const float rstd = rsqrtf(ss / D + EPS);
    bad = 0;
    if (L == 0) { float s2 = 0; for (int d = lane; d < D; d += 64) { const float x = HRES[(size_t)r * D + d]; s2 += x * x; } s2 = wave_sum(s2); const float rstd2 = rsqrtf(s2 / D + EPS);
      const float* mod1 = MOD + (size_t)2 * 12288 + (r < CTXL ? 12288 : 0);
      for (int d = lane; d < D; d += 64) { const float ref = HRES[(size_t)r * D + d] * rstd2 * a.in[6][4 * D + d] * (1.f + mod1[D + d]) + mod1[d]; bad += !dclose(bf2f(AB[(size_t)r * D + d]), ref, 0.01f, 0.01f); } }
    else { for (int d = lane; d < D; d += 64) { const float ref = HRES[(size_t)r * D + d] + mod[5 * D + d] * (fsh[wv][d] * rstd * ng[3 * D + d]); bad += !dclose(a.out[(size_t)(r - CTXL) * D + d], ref, 1e-3f, 1e-3f); } }
    bad = (int)wave_sum((float)bad); dflag(dg, L == 0 ? 14 : 25, bad, lane);
  } else if (k == 12) {
    const int r = pick_row(h, CTXL, SEQ), hh = h2 % 32;
    float raw0 = 0, raw1 = 0;
    for (int d = 0; d < 128; ++d) { const float v = wdot(AB + (size_t)r * D, a.in[15], N_IN1, hh * 128 + d, D, lane); if (d == lane) raw0 = v; if (d == lane + 64) raw1 = v; }
    float cs, sn; rope_cs(r, lane, cs, sn);
    const float cs0 = __shfl(cs, lane & 31), sn0 = __shfl(sn, lane & 31), cs1 = __shfl(cs, 32 + (lane & 31)), sn1 = __shfl(sn, 32 + (lane & 31));
    const float p0 = __shfl_xor(raw0, 32), p1 = __shfl_xor(raw1, 32);
    const float o0 = (lane < 32) ? raw0 * cs0 - p0 * sn0 : raw0 * cs0 + p0 * sn0;
    const float o1 = (lane < 32) ? raw1 * cs1 - p1 * sn1 : raw1 * cs1 + p1 * sn1;
    bad = !dclose(bf2f(QK[(size_t)r * N_IN1 + hh * 128 + lane]), o0, 0.03f, 0.05f) + !dclose(bf2f(QK[(size_t)r * N_IN1 + hh * 128 + 64 + lane]), o1, 0.03f, 0.05f);
    bad = (int)wave_sum((float)bad); dflag(dg, 16, bad, lane);
  } else if (k == 13) {
    if (gw < 64) { const int r = pick_row(h, CTXL, SEQ), hc = h2 % 16, vh = (h2 >> 4) & 1, hd = hc >> 1;
      float o0, o1; naive_attn(QK + (size_t)r * N_IN1 + hc * 128, QK + 2048 + hc * 128, QK + 4096 + hd * 256 + vh * 128, N_IN1, MT, lane, o0, o1);
      const bf16_t* O = Y + (size_t)(r - CTXL) * 4096 + hc * 256 + vh * 128;
      bad = !dclose(bf2f(O[lane]), o0, 0.05f, 0.01f) + !dclose(bf2f(O[64 + lane]), o1, 0.05f, 0.01f);
      bad = (int)wave_sum((float)bad); dflag(dg, 17, bad, lane); }
  } else if (k == 14) {
    const int r = pick_row(h, CTXL, SEQ), hd = h2 % 8; const float* lp = a.in[17];
    float s1 = 0, s2 = 0; for (int i = lane; i < 128; i += 64) { s1 += lp[i] * lp[128 + i]; s2 += lp[256 + i] * lp[384 + i]; } s1 = wave_sum(s1); s2 = wave_sum(s2);
    const float lam = expf(s1) - expf(s2) + LAM_INIT; const bf16_t* O = Y + (size_t)(r - CTXL) * 4096;
    float dv[4], ss = 0; for (int i = 0; i < 4; ++i) { const int d = lane + 64 * i; dv[i] = bf2f(O[(2 * hd) * 256 + d]) - lam * bf2f(O[(2 * hd + 1) * 256 + d]); ss += dv[i] * dv[i]; }
    ss = wave_sum(ss); const float rstd = rsqrtf(ss / 256.f + EPS) * (1.f - LAM_INIT); bad = 0;
    for (int i = 0; i < 4; ++i) { const int d = lane + 64 * i; bad += !dclose(bf2f(X2[(size_t)r * D + hd * 256 + d]), dv[i] * rstd * a.in[18][d], 0.02f, 0.01f); }
    bad = (int)wave_sum((float)bad); dflag(dg, 18, bad, lane);
  }
}
__global__ void diag_encode(Args a) {
  const int* dg = (const int*)(a.ws + WS_CTL + CTL_CNT + 512);
  int s = 0;
  int sub = 0;
  for (int i = 1; i < 32; ++i) { int v = dg[i]; if (i == 10 || i == 21) { v = (dg[32 + i] > 25 ? 1 : 0) + (dg[33 + i] > 0 ? 2 : 0) + (dg[34 + i] > 0 ? 4 : 0) + (dg[35 + i] > 0 ? 8 : 0) + (dg[36 + i] > 0 ? 16 : 0); sub = v; } if (v) { s = i; break; } }
  if (s == 0) return;
  const float c = sub ? 30.f + 8.f * sub : 10.f * s;
  for (size_t i = (size_t)blockIdx.x * blockDim.x + threadIdx.x; i < (size_t)SEQ * D; i += (size_t)gridDim.x * blockDim.x) a.out[i] = c;
}
#endif

extern "C" void kernel_launch(void* const* d_in, const int* in_sizes, int n_in, void* d_out, int out_size, void* d_ws, size_t ws_size, hipStream_t stream) {
  static int grid = 0;
  if (grid == 0) {
    if (n_in != 27 || out_size != SEQ * D || ws_size < WS_END) { fprintf(stderr, "kernel_launch: unexpected shapes (n_in %d out %d ws %zu need %zu)\n", n_in, out_size, ws_size, (size_t)WS_END); grid = -1; return; }
    if (hipFuncSetAttribute((const void*)fwd, hipFuncAttributeMaxDynamicSharedMemorySize, LDS_BYTES) != hipSuccess) { fprintf(stderr, "kernel_launch: hipFuncSetAttribute failed\n"); grid = -1; return; }
    int dev = 0, cus = 0, per_cu = 0;
    hipGetDevice(&dev); hipDeviceGetAttribute(&cus, hipDeviceAttributeMultiprocessorCount, dev);
    if (hipOccupancyMaxActiveBlocksPerMultiprocessor(&per_cu, (const void*)fwd, NTHREADS, LDS_BYTES) != hipSuccess || per_cu < 1) fprintf(stderr, "kernel_launch: occupancy query says %d\n", per_cu);
    (void)hipGetLastError();
    grid = cus < 256 ? cus : 256;
    if (grid != 256) fprintf(stderr, "kernel_launch: %d CUs (expected 256)\n", cus);
  }
  if (grid < 0) return;
  hipMemsetAsync((char*)d_ws + WS_CTL, 0, CTL_BYTES, stream);
  Args a{};
  for (int i = 0; i < 27; ++i) a.in[i] = (const float*)d_in[i];
  a.out = (float*)d_out; a.ws = (unsigned char*)d_ws;
#if MK_MULTI
  for (int k = 0; k < NPH; ++k) { a.ph_lo = k; a.ph_hi = k + 1; hipLaunchKernelGGL(fwd, dim3(grid), dim3(NTHREADS), LDS_BYTES, stream, a);
#if MK_DIAG
    hipLaunchKernelGGL(diag, dim3(64), dim3(256), 0, stream, a, k);
#endif
  }
#if MK_DIAG
  hipLaunchKernelGGL(diag_encode, dim3(1024), dim3(256), 0, stream, a);
#endif
#else
  a.ph_lo = 0; a.ph_hi = NPH;
  hipLaunchKernelGGL(fwd, dim3(grid), dim3(NTHREADS), LDS_BYTES, stream, a);
#endif
  const hipError_t le = hipPeekAtLastError();
  if (le != hipSuccess) fprintf(stderr, "kernel_launch: launch failed: %s\n", hipGetErrorName(le));
}
```

```cpp
#include <hip/hip_runtime.h>
#include <cstdio>
#include <cstdint>

#define MK_DIAG 0
#ifndef MK_MULTI
#define MK_MULTI 0
#endif

#define LAS __attribute__((address_space(3)))
typedef unsigned short bf16_t;
typedef short bf16x8 __attribute__((ext_vector_type(8)));
typedef short s16x4 __attribute__((ext_vector_type(4)));
typedef float f32x4 __attribute__((ext_vector_type(4)));
typedef float f32x2 __attribute__((ext_vector_type(2)));
typedef float f32x16 __attribute__((ext_vector_type(16)));
typedef unsigned u32x4 __attribute__((ext_vector_type(4)));
typedef unsigned u32x2 __attribute__((ext_vector_type(2)));

constexpr int D = 2048, SEQ = 16384, CTXL = 256, MT = SEQ + CTXL;
constexpr int NE = 64, TOPK = 8, EFF = 512;
constexpr int N_IN0 = 3584, N_QKV0 = 1536, N_IN1 = 6144;
constexpr float EPS = 1e-6f;
constexpr float LAM_INIT = 0.35550907f;
constexpr int SH_BASE = SEQ * 0 + (MT * TOPK) + NE * 256;
constexpr int NSLOT = SH_BASE + MT;
constexpr int NTHREADS = 512;
constexpr int LDS_BYTES = 131072 + 1024;
constexpr int LDS_CTL = 131072;

constexpr size_t al256(size_t x) { return (x + 255) & ~(size_t)255; }
constexpr size_t WS_CTL   = 0;
constexpr size_t CTL_BYTES = 32768;
constexpr size_t CTL_CNT  = 16384;
constexpr size_t CTL_KMAX = 16384 + 2048;
constexpr size_t WS_MOD   = CTL_BYTES;
constexpr size_t WS_WIN0  = al256(WS_MOD + 2 * 2 * 12288 * 4);
constexpr size_t WS_WOUT0 = al256(WS_WIN0 + (size_t)N_IN0 * D * 2);
constexpr size_t WS_WIN1  = al256(WS_WOUT0 + (size_t)D * D * 2);
constexpr size_t WS_WOUT1 = al256(WS_WIN1 + (size_t)N_IN1 * D * 2);
constexpr size_t WMOE_E   = (size_t)1024 * D + (size_t)D * EFF;
constexpr size_t WS_WMOE  = al256(WS_WOUT1 + (size_t)D * D * 2);
constexpr size_t WS_HRES  = al256(WS_WMOE + 65 * WMOE_E * 2);
constexpr size_t WS_ABUF  = al256(WS_HRES + (size_t)MT * D * 4);
constexpr size_t WS_QKVU  = al256(WS_ABUF + (size_t)MT * D * 2);
constexpr size_t WS_HG    = al256(WS_QKVU + (size_t)MT * N_IN1 * 2);
constexpr size_t WS_X2    = al256(WS_HG + (size_t)MT * 1024 * 2);
constexpr size_t WS_OUT   = al256(WS_X2 + (size_t)MT * D * 2);
constexpr size_t WS_ACT   = al256(WS_OUT + (size_t)MT * D * 2);
constexpr size_t WS_K8    = WS_ACT + al256((size_t)NSLOT * EFF);
constexpr size_t WS_Y     = al256(WS_ACT + (size_t)NSLOT * EFF * 2);
constexpr size_t WS_TOPE  = al256(WS_Y + (size_t)NSLOT * D * 2);
constexpr size_t WS_TOPW  = al256(WS_TOPE + (size_t)MT * TOPK * 4);
constexpr size_t WS_TOPP  = al256(WS_TOPW + (size_t)MT * TOPK * 4);
constexpr size_t WS_TSLOT = al256(WS_TOPP + (size_t)MT * TOPK * 4);
constexpr size_t WS_STOK  = al256(WS_TSLOT + (size_t)MT * TOPK * 4);
constexpr size_t WS_END   = al256(WS_STOK + (size_t)NSLOT * 4);

struct Args { const float* in[27]; float* out; unsigned char* ws; int ph_lo, ph_hi; };

__device__ __forceinline__ float bflo(unsigned x) { return __uint_as_float(x << 16); }
__device__ __forceinline__ float bfhi(unsigned x) { return __uint_as_float(x & 0xffff0000u); }
__device__ __forceinline__ float bf2f(bf16_t b) { return __uint_as_float(((unsigned)b) << 16); }
__device__ __forceinline__ unsigned cvtpk(float lo, float hi) { unsigned r; asm("v_cvt_pk_bf16_f32 %0, %1, %2" : "=v"(r) : "v"(lo), "v"(hi)); return r; }
__device__ __forceinline__ bf16_t f2bf(float x) { return (bf16_t)(cvtpk(x, 0.f) & 0xffffu); }
__device__ __forceinline__ float wave_sum(float v) {
#pragma unroll
  for (int o = 32; o; o >>= 1) v += __shfl_xor(v, o);
  return v;
}
__device__ __forceinline__ float sigmoidf_(float x) { return 1.f / (1.f + expf(-x)); }
__device__ __forceinline__ float sigmoid_fast(float x) { return __builtin_amdgcn_rcpf(1.f + __builtin_amdgcn_exp2f(-1.4426950408889634f * x)); }

__device__ __forceinline__ float clamp8e(float x) { return fminf(fmaxf(x, -448.f), 448.f); }
__device__ __forceinline__ unsigned pack8x4(float a, float b, float c, float d) {
  int p = __builtin_amdgcn_cvt_pk_fp8_f32(clamp8e(a), clamp8e(b), 0, false); p = __builtin_amdgcn_cvt_pk_fp8_f32(clamp8e(c), clamp8e(d), p, true); return (unsigned)p; }
__device__ __forceinline__ float sq8x4(unsigned p) {
  const float a = __builtin_amdgcn_cvt_f32_fp8((int)p, 0), b = __builtin_amdgcn_cvt_f32_fp8((int)p, 1), c = __builtin_amdgcn_cvt_f32_fp8((int)p, 2), d = __builtin_amdgcn_cvt_f32_fp8((int)p, 3);
  return a * a + b * b + c * c + d * d; }
typedef int v8i_ __attribute__((ext_vector_type(8)));
typedef int v4i __attribute__((ext_vector_type(4)));
#define XB_TMO      128
#define XB_XCNT(j)  (256  + 64 * (j))
#define XB_XSUB(j)  (1280 + 64 * (j))
#define XB_XGEN(j)  (2304 + 64 * (j))
#define XB_TOP      3328
#define XB_TOPGEN   3392
#define XCD_BAR_WORDS 3456
#define XB_SPIN_CAP (1u << 22)
__device__ __forceinline__ unsigned xb_ld(unsigned* p)              { return __hip_atomic_load(p, __ATOMIC_RELAXED, __HIP_MEMORY_SCOPE_AGENT); }
__device__ __forceinline__ unsigned xb_add(unsigned* p, unsigned v) { return __hip_atomic_fetch_add(p, v, __ATOMIC_RELAXED, __HIP_MEMORY_SCOPE_AGENT); }
__device__ __forceinline__ unsigned xb_xcc_id() { return (unsigned)__builtin_amdgcn_s_getreg((3 << 11) | 20) & 0xFu; }
#define XB_SPIN(cond, bar) do { unsigned _sp = 0; while (cond) { __builtin_amdgcn_s_sleep(1); \
    if ((++_sp & 255u) == 0u) { if (xb_ld(&(bar)[XB_TMO])) break; if (_sp > XB_SPIN_CAP) { atomicAdd(&(bar)[XB_TMO], 1u); break; } } } } while (0)
struct XcdBarrier { unsigned* bar; unsigned x; volatile LAS unsigned* st; };
__device__ __forceinline__ XcdBarrier xcd_barrier_post(unsigned* bar, volatile LAS unsigned* st) {
    XcdBarrier b; b.bar = bar; b.x = xb_xcc_id(); b.st = st;
    if (threadIdx.x == 0) (void)xb_add(&bar[XB_XCNT(b.x)], 1u);
    return b;
}
__device__ __forceinline__ void xcd_barrier_complete(unsigned* bar, unsigned x, unsigned& nloc, unsigned& nx) {
    const unsigned G = gridDim.x * gridDim.y * gridDim.z;
    unsigned sum, cnt, mine, sp = 0u;
    for (;;) {
        sum = 0u; cnt = 0u; mine = 0u;
#pragma unroll
        for (unsigned j = 0; j < 16; ++j) { const unsigned c = xb_ld(&bar[XB_XCNT(j)]); sum += c; cnt += (c > 0u) ? 1u : 0u; mine = (j == x) ? c : mine; }
        if (sum == G) break;
        __builtin_amdgcn_s_sleep(1);
        if ((++sp & 255u) == 0u) { if (xb_ld(&bar[XB_TMO])) break; if (sp > XB_SPIN_CAP) { atomicAdd(&bar[XB_TMO], 1u); break; } }
    }
    nloc = mine > 0u ? mine : 1u; nx = cnt > 0u ? cnt : 1u;
}
__device__ __forceinline__ void xcd_barrier(const XcdBarrier& b) {
    asm volatile("s_waitcnt vmcnt(0)" ::: "memory");
    __syncthreads();
    if (threadIdx.x == 0) {
        unsigned* bar = b.bar;
        __builtin_amdgcn_s_waitcnt(0);
        unsigned nloc = b.st[0], nx = b.st[1];
        if (nloc == 0u) { xcd_barrier_complete(bar, b.x, nloc, nx); b.st[0] = nloc; b.st[1] = nx; }
        const unsigned old = xb_add(&bar[XB_XSUB(b.x)], 1u);
        const unsigned gen = old / nloc;
        if (old + 1u == (gen + 1u) * nloc) {
            __builtin_amdgcn_fence(__ATOMIC_RELEASE, "agent");
            asm volatile("s_waitcnt vmcnt(0)" ::: "memory");
            const unsigned og = xb_add(&bar[XB_TOP], 1u);
            const unsigned tg = og / nx;
            if (og + 1u == (tg + 1u) * nx) xb_add(&bar[XB_TOPGEN], 1u);
            else XB_SPIN(xb_ld(&bar[XB_TOPGEN]) == tg, bar);
            __builtin_amdgcn_fence(__ATOMIC_ACQUIRE, "agent");
            xb_add(&bar[XB_XGEN(b.x)], 1u);
            asm volatile("s_waitcnt vmcnt(0)" ::: "memory");
        } else {
            XB_SPIN(xb_ld(&bar[XB_XGEN(b.x)]) == gen, bar);
            __builtin_amdgcn_fence(__ATOMIC_ACQUIRE, "agent");
            asm volatile("s_waitcnt vmcnt(0)" ::: "memory");
        }
    }
    __syncthreads();
}

__device__ __forceinline__ int lds_byte(int r, int c) {
  int st = (r >> 4) * 2 + (c >> 5), rr = r & 15, cc = c & 31, ob = rr * 64 + cc * 2;
  return st * 1024 + (ob ^ (((ob >> 9) & 1) << 5));
}
#define GLDS(gp, lp) __builtin_amdgcn_global_load_lds((const unsigned*)(gp), (LAS unsigned*)(lp), 16, 0, 0)
#define WAIT_V(n) asm volatile("s_waitcnt vmcnt(" #n ")" ::: "memory")
#define WAIT_L(n) asm volatile("s_waitcnt lgkmcnt(" #n ")" ::: "memory")
#define BAR __builtin_amdgcn_s_barrier()
#define SCHED __builtin_amdgcn_sched_barrier(0)

template <bool GATHER, class Epi>
__device__ __forceinline__ void gemm_tile(const bf16_t* __restrict__ A, const int lda, const int* __restrict__ tok, const int brow,
                                          const bf16_t* __restrict__ Bt, const int ldb, const int bcol, const int K,
                                          LAS char* shm, const Epi& epi) {
#define G_SA(b, h) (shm + ((b) * 2 + (h)) * 16384)
#define G_SB(b, h) (shm + (4 + (b) * 2 + (h)) * 16384)
  int tid = threadIdx.x; asm volatile("" : "+v"(tid)); tid &= 511;
  int wid = tid >> 6, lane = tid & 63, wr = wid >> 2, wc = wid & 3, fr = lane & 15, fq = lane >> 4;
  unsigned ao0, ao1, ao2, ao3, bo;
  {
    const int sb = (tid & 63) * 16, swz = sb ^ (((sb >> 9) & 1) << 5);
    const int R0 = ((tid >> 6) >> 1) * 16 + (swz >> 6), C0 = ((tid >> 6) & 1) * 32 + ((swz & 63) >> 1);
    if (GATHER) { ao0 = (unsigned)(tok[R0] * lda + C0); ao1 = (unsigned)(tok[R0 + 64] * lda + C0); ao2 = (unsigned)(tok[R0 + 128] * lda + C0); ao3 = (unsigned)(tok[R0 + 192] * lda + C0); }
    else { ao0 = (unsigned)((brow + R0) * lda + C0); ao1 = ao0 + 64u * lda; ao2 = ao0 + 128u * lda; ao3 = ao0 + 192u * lda; }
    bo = (unsigned)((bcol + R0) * ldb + C0);
  }
  const int lo = __builtin_amdgcn_readfirstlane(tid >> 6) * 1024;
#define STAGE_A0(P, kt) do { GLDS((A + (kt) * 64) + ao0, (P) + lo); GLDS((A + (kt) * 64) + ao1, (P) + lo + 8192); } while (0)
#define STAGE_A1(P, kt) do { GLDS((A + (kt) * 64) + ao2, (P) + lo); GLDS((A + (kt) * 64) + ao3, (P) + lo + 8192); } while (0)
#define STAGE_B0(P, kt) do { GLDS((Bt + (kt) * 64) + bo, (P) + lo); GLDS((Bt + 64 * ldb + (kt) * 64) + bo, (P) + lo + 8192); } while (0)
#define STAGE_B1(P, kt) do { GLDS((Bt + 128 * ldb + (kt) * 64) + bo, (P) + lo); GLDS((Bt + 192 * ldb + (kt) * 64) + bo, (P) + lo + 8192); } while (0)
#define LDA(dst, b, h) _Pragma("unroll") for (int m = 0; m < 4; ++m) _Pragma("unroll") for (int k = 0; k < 2; ++k) \
    dst[m][k] = *(LAS const bf16x8*)(G_SA(b, h) + lds_byte(wr * 64 + m * 16 + fr, k * 32 + fq * 8))
#define LDB(dst, b, h) _Pragma("unroll") for (int n = 0; n < 2; ++n) _Pragma("unroll") for (int k = 0; k < 2; ++k) \
    dst[n][k] = *(LAS const bf16x8*)(G_SB(b, h) + lds_byte(wc * 32 + n * 16 + fr, k * 32 + fq * 8))
#define MMA(ai, bj, At_, Bt_) do { __builtin_amdgcn_s_setprio(1); \
    _Pragma("unroll") for (int m = 0; m < 4; ++m) _Pragma("unroll") for (int n = 0; n < 2; ++n) _Pragma("unroll") for (int k = 0; k < 2; ++k) \
      acc[ai][bj][m][n] = __builtin_amdgcn_mfma_f32_16x16x32_bf16(Bt_[n][k], At_[m][k], acc[ai][bj][m][n], 0, 0, 0); \
    __builtin_amdgcn_s_setprio(0); } while (0)

  f32x4 acc[2][2][4][2] = {};
  bf16x8 At[4][2], B0[2][2], B1[2][2];
  const int nt = K / 64;
  STAGE_B0(G_SB(0, 0), 0); STAGE_A0(G_SA(0, 0), 0);
  STAGE_B1(G_SB(0, 1), 0); STAGE_A1(G_SA(0, 1), 0);
  if (wr == 1) BAR;
  WAIT_V(4); BAR;
  STAGE_B0(G_SB(1, 0), 1); STAGE_A0(G_SA(1, 0), 1); STAGE_B1(G_SB(1, 1), 1);
  WAIT_V(6); BAR;
  for (int t = 0; t < nt - 2; t += 2) {
    LDB(B0, 0, 0); SCHED; LDA(At, 0, 0); STAGE_A1(G_SA(1, 1), t + 1);
    WAIT_L(8); BAR; WAIT_L(0); MMA(0, 0, At, B0); BAR; SCHED;
    LDB(B1, 0, 1); STAGE_B0(G_SB(0, 0), t + 2);
    BAR; WAIT_L(0); MMA(0, 1, At, B1); BAR;
    LDA(At, 0, 1); STAGE_A0(G_SA(0, 0), t + 2);
    BAR; WAIT_L(0); MMA(1, 0, At, B0); BAR; SCHED;
    STAGE_B1(G_SB(0, 1), t + 2);
    WAIT_V(6); BAR; MMA(1, 1, At, B1); BAR;
    LDB(B0, 1, 0); SCHED; LDA(At, 1, 0); STAGE_A1(G_SA(0, 1), t + 2);
    WAIT_L(8); BAR; WAIT_L(0); MMA(0, 0, At, B0); BAR; SCHED;
    LDB(B1, 1, 1); STAGE_B0(G_SB(1, 0), t + 3);
    BAR; WAIT_L(0); MMA(0, 1, At, B1); BAR;
    LDA(At, 1, 1); STAGE_A0(G_SA(1, 0), t + 3);
    BAR; WAIT_L(0); MMA(1, 0, At, B0); BAR; SCHED;
    STAGE_B1(G_SB(1, 1), t + 3);
    WAIT_V(6); BAR; MMA(1, 1, At, B1); BAR;
  }
  { LDB(B0, 0, 0); WAIT_V(0); LDA(At, 0, 0); STAGE_A1(G_SA(1, 1), nt - 1);
    BAR; WAIT_L(0); MMA(0, 0, At, B0); BAR;
    LDB(B1, 0, 1); BAR; WAIT_L(0); MMA(0, 1, At, B1); BAR;
    LDA(At, 0, 1); WAIT_V(4); BAR; WAIT_L(0); MMA(1, 0, At, B0); MMA(1, 1, At, B1); BAR; }
  { LDB(B0, 1, 0); LDA(At, 1, 0); WAIT_V(2); BAR; WAIT_L(0); MMA(0, 0, At, B0); BAR;
    LDB(B1, 1, 1); WAIT_V(0); BAR; WAIT_L(0); MMA(0, 1, At, B1); BAR;
    LDA(At, 1, 1); BAR; WAIT_L(0); MMA(1, 0, At, B0); MMA(1, 1, At, B1); BAR; }
  if (wr == 0) BAR;
  int tz = threadIdx.x; asm volatile("" : "+v"(tz)); wid = tz >> 6; lane = tz & 63; wr = wid >> 2; wc = wid & 3; fr = lane & 15; fq = lane >> 4;
  epi(acc, brow, bcol, wr, wc, fr, fq);
#undef G_SA
#undef G_SB
#undef STAGE_A0
#undef STAGE_A1
#undef STAGE_B0
#undef STAGE_B1
#undef LDA
#undef LDB
#undef MMA
}

struct EpiPlain {
  bf16_t* C; int ldc;
  __device__ __forceinline__ void operator()(const f32x4 (&acc)[2][2][4][2], int brow, int bcol, int wr, int wc, int fr, int fq) const {
#pragma unroll
    for (int ai = 0; ai < 2; ++ai)
#pragma unroll
      for (int m = 0; m < 4; ++m) {
        bf16_t* rp = C + (size_t)(brow + ai * 128 + wr * 64 + m * 16 + fr) * ldc + bcol + wc * 32 + fq * 8;
#pragma unroll
        for (int bj = 0; bj < 2; ++bj) {
          u32x4 v = {cvtpk(acc[ai][bj][m][0][0], acc[ai][bj][m][0][1]), cvtpk(acc[ai][bj][m][0][2], acc[ai][bj][m][0][3]),
                     cvtpk(acc[ai][bj][m][1][0], acc[ai][bj][m][1][1]), cvtpk(acc[ai][bj][m][1][2], acc[ai][bj][m][1][3])};
          *(u32x4*)(rp + bj * 128) = v;
        }
      }
  }
};
template <int MODE>
struct EpiPair {
  bf16_t* C; int ldc; int colbase;
  __device__ __forceinline__ void operator()(const f32x4 (&acc)[2][2][4][2], int brow, int bcol, int wr, int wc, int fr, int fq) const {
#pragma unroll
    for (int ai = 0; ai < 2; ++ai)
#pragma unroll
      for (int m = 0; m < 4; ++m) {
        bf16_t* rp = C + (size_t)(brow + ai * 128 + wr * 64 + m * 16 + fr) * ldc + ((bcol - colbase) >> 1) + wc * 16 + fq * 4;
#pragma unroll
        for (int bj = 0; bj < 2; ++bj) {
          float r[4];
#pragma unroll
          for (int j = 0; j < 4; ++j) {
            const float x0 = acc[ai][bj][m][0][j], x1 = acc[ai][bj][m][1][j];
            r[j] = MODE == 0 ? x0 * sigmoid_fast(x1) : x0 * sigmoid_fast(x0) * x1;
          }
          u32x2 v = {cvtpk(r[0], r[1]), cvtpk(r[2], r[3])};
          *(u32x2*)(rp + bj * 64) = v;
        }
      }
  }
};
struct EpiG1 {
  EpiPlain p; EpiPair<0> g; int nplain;
  __device__ __forceinline__ void operator()(const f32x4 (&acc)[2][2][4][2], int brow, int bcol, int wr, int wc, int fr, int fq) const {
    if (bcol < nplain) p(acc, brow, bcol, wr, wc, fr, fq); else g(acc, brow, bcol, wr, wc, fr, fq);
  }
};

typedef int v8i __attribute__((ext_vector_type(8)));
__device__ __forceinline__ int lds8(int r, int c) { return r * 128 + ((c ^ ((r >> 1) & 7)) << 4); }
template <bool GATHER, int lda, int ldb, int K, class Epi, class S>
__device__ __forceinline__ void gemm8_run(const unsigned char* __restrict__ A, const int* __restrict__ stok,
                                          LAS char* shm, const Epi& epi, const S& sched) {
#define G_SA(b, h) (shm + ((b) * 2 + (h)) * 16384)
#define G_SB(b, h) (shm + (4 + (b) * 2 + (h)) * 16384)
  int tid = threadIdx.x; asm volatile("" : "+v"(tid)); tid &= 511;
  int wid = tid >> 6, lane = tid & 63, wr = wid >> 2, wc = wid & 3, fr = lane & 15, fq = lane >> 4;
  unsigned ao0, ao1, ao2, ao3, bo;
  int R0 = 8 * wid + (lane >> 3), C0 = ((lane & 7) ^ ((R0 >> 1) & 7)) << 4;
  const int lo = __builtin_amdgcn_readfirstlane(tid >> 6) * 1024;
  int brow, bcol; const unsigned char* Bt;
  int ui = 0;
  if (!sched.unit(ui, brow, Bt, bcol)) return;
#define SETOFF(br, bc) do { if (GATHER) { const int* _t = stok + (br); ao0 = (unsigned)(_t[R0] * lda + C0); ao1 = (unsigned)(_t[R0 + 64] * lda + C0); ao2 = (unsigned)(_t[R0 + 128] * lda + C0); ao3 = (unsigned)(_t[R0 + 192] * lda + C0); } \
    else { ao0 = (unsigned)(((br) + R0) * lda + C0); ao1 = ao0 + 64u * lda; ao2 = ao0 + 128u * lda; ao3 = ao0 + 192u * lda; } \
    bo = (unsigned)(((bc) + R0) * ldb + C0); } while (0)
#define STAGE_A0(P, kt) do { GLDS((A + (kt) * 128) + ao0, (P) + lo); GLDS((A + (kt) * 128) + ao1, (P) + lo + 8192); } while (0)
#define STAGE_A1(P, kt) do { GLDS((A + (kt) * 128) + ao2, (P) + lo); GLDS((A + (kt) * 128) + ao3, (P) + lo + 8192); } while (0)
#define STAGE_B0(P, kt) do { GLDS((Bt + (kt) * 128) + bo, (P) + lo); GLDS((Bt + 64 * ldb + (kt) * 128) + bo, (P) + lo + 8192); } while (0)
#define STAGE_B1(P, kt) do { GLDS((Bt + 128 * ldb + (kt) * 128) + bo, (P) + lo); GLDS((Bt + 192 * ldb + (kt) * 128) + bo, (P) + lo + 8192); } while (0)
#define PRO() do { STAGE_B0(G_SB(0, 0), 0); STAGE_A0(G_SA(0, 0), 0); STAGE_B1(G_SB(0, 1), 0); STAGE_A1(G_SA(0, 1), 0); } while (0)
  const int fx = (fq ^ ((fr >> 1) & 7)) << 4;
  const int fa0 = (wr * 64 + fr) * 128 + fx, fb0 = (wc * 32 + fr) * 128 + fx;
#define FRAG8(dst, p0, p1) do { const v4i _x = *(LAS const v4i*)(p0); const v4i _y = *(LAS const v4i*)(p1); \
    dst = (v8i){_x[0], _x[1], _x[2], _x[3], _y[0], _y[1], _y[2], _y[3]}; } while (0)
#define LDA(dst, b, h) do { int fa1 = fa0; asm volatile("v_xor_b32 %0, 64, %0" : "+v"(fa1)); \
    _Pragma("unroll") for (int m = 0; m < 4; ++m) FRAG8(dst[m], G_SA(b, h) + fa0 + m * 2048, G_SA(b, h) + fa1 + m * 2048); } while (0)
#define LDB(dst, b, h) do { int fb1 = fb0; asm volatile("v_xor_b32 %0, 64, %0" : "+v"(fb1)); \
    _Pragma("unroll") for (int n = 0; n < 2; ++n) FRAG8(dst[n], G_SB(b, h) + fb0 + n * 2048, G_SB(b, h) + fb1 + n * 2048); } while (0)
#define MMA(ai, bj, At_, Bt_) do { __builtin_amdgcn_s_setprio(1); \
    _Pragma("unroll") for (int m = 0; m < 4; ++m) _Pragma("unroll") for (int n = 0; n < 2; ++n) \
      asm volatile("v_mfma_scale_f32_16x16x128_f8f6f4 %0, %1, %2, %0, %3, %3 op_sel_hi:[0,0,0]" : "+v"(acc[ai][bj][m][n]) : "v"(Bt_[n]), "v"(At_[m]), "v"(sc1)); \
    __builtin_amdgcn_s_setprio(0); } while (0)
  int sc1; asm volatile("v_mov_b32 %0, 0x7f7f7f7f" : "=v"(sc1));
  const int nt = K / 128;
  SETOFF(brow, bcol); PRO();
  bool first = true;
  for (;;) {
    f32x4 acc[2][2][4][2] = {};
    v8i At[4], B0[2], B1[2];
    if (wr == 1) BAR;
    if (first) WAIT_V(4); else WAIT_V(0);
    BAR;
    STAGE_B0(G_SB(1, 0), 1); STAGE_A0(G_SA(1, 0), 1); STAGE_B1(G_SB(1, 1), 1);
    WAIT_V(6); BAR;
    for (int t = 0; t < nt - 2; t += 2) {
      LDB(B0, 0, 0); SCHED; LDA(At, 0, 0); STAGE_A1(G_SA(1, 1), t + 1);
      WAIT_L(8); BAR; WAIT_L(0); MMA(0, 0, At, B0); BAR; SCHED;
      LDB(B1, 0, 1); STAGE_B0(G_SB(0, 0), t + 2);
      BAR; WAIT_L(0); MMA(0, 1, At, B1); BAR;
      LDA(At, 0, 1); STAGE_A0(G_SA(0, 0), t + 2);
      BAR; WAIT_L(0); MMA(1, 0, At, B0); BAR; SCHED;
      STAGE_B1(G_SB(0, 1), t + 2);
      WAIT_V(6); BAR; MMA(1, 1, At, B1); BAR;
      LDB(B0, 1, 0); SCHED; LDA(At, 1, 0); STAGE_A1(G_SA(0, 1), t + 2);
      WAIT_L(8); BAR; WAIT_L(0); MMA(0, 0, At, B0); BAR; SCHED;
      LDB(B1, 1, 1); STAGE_B0(G_SB(1, 0), t + 3);
      BAR; WAIT_L(0); MMA(0, 1, At, B1); BAR;
      LDA(At, 1, 1); STAGE_A0(G_SA(1, 0), t + 3);
      BAR; WAIT_L(0); MMA(1, 0, At, B0); BAR; SCHED;
      STAGE_B1(G_SB(1, 1), t + 3);
      WAIT_V(6); BAR; MMA(1, 1, At, B1); BAR;
    }
    { LDB(B0, 0, 0); WAIT_V(0); LDA(At, 0, 0); STAGE_A1(G_SA(1, 1), nt - 1);
      BAR; WAIT_L(0); MMA(0, 0, At, B0); BAR;
      LDB(B1, 0, 1); BAR; WAIT_L(0); MMA(0, 1, At, B1); BAR;
      LDA(At, 0, 1); WAIT_V(4); BAR; WAIT_L(0); MMA(1, 0, At, B0); MMA(1, 1, At, B1); BAR; }
    { LDB(B0, 1, 0); LDA(At, 1, 0); WAIT_V(2); BAR; WAIT_L(0); MMA(0, 0, At, B0); BAR;
      LDB(B1, 1, 1); WAIT_V(0); BAR; WAIT_L(0); MMA(0, 1, At, B1); BAR;
      LDA(At, 1, 1); BAR; WAIT_L(0); MMA(1, 0, At, B0); MMA(1, 1, At, B1); BAR; }
    if (wr == 0) BAR;
    const int cbrow = brow, cbcol = bcol;
    { int tz = threadIdx.x; asm volatile("" : "+v"(tz)); tz &= 511; wid = tz >> 6; lane = tz & 63; wr = wid >> 2; wc = wid & 3; fr = lane & 15; fq = lane >> 4;
      R0 = 8 * wid + (lane >> 3); C0 = ((lane & 7) ^ ((R0 >> 1) & 7)) << 4; }
    ++ui;
    const bool more = sched.unit(ui, brow, Bt, bcol);
    if (more) { SETOFF(brow, bcol); asm volatile("" ::: "memory"); PRO(); asm volatile("" ::: "memory"); }
    asm volatile("s_nop 15\n\ts_nop 15\n\ts_nop 7" ::: "memory");
#pragma unroll
    for (int i = 0; i < 32; ++i) asm volatile("" : "+v"((&acc[0][0][0][0])[i]));
    epi(acc, cbrow, cbcol, wr, wc, fr, fq);
    if (!more) break;
    first = false;
  }
#undef G_SA
#undef G_SB
#undef SETOFF
#undef STAGE_A0
#undef STAGE_A1
#undef STAGE_B0
#undef STAGE_B1
#undef PRO
#undef FRAG8
#undef LDA
#undef LDB
#undef MMA
}
__device__ __forceinline__ float clamp8(float x) { return fminf(fmaxf(x, -448.f), 448.f); }
__device__ __forceinline__ unsigned pack_fp8x4(float a, float b, float c, float d) {
  int p = __builtin_amdgcn_cvt_pk_fp8_f32(clamp8(a), clamp8(b), 0, false); p = __builtin_amdgcn_cvt_pk_fp8_f32(clamp8(c), clamp8(d), p, true); return (unsigned)p; }
struct EpiSwiGLU8 {
  unsigned char* C; int ldc;
  __device__ __forceinline__ void operator()(const f32x4 (&acc)[2][2][4][2], int brow, int bcol, int wr, int wc, int fr, int fq) const {
    constexpr float S = 1.f / 256.f;
#pragma unroll
    for (int ai = 0; ai < 2; ++ai)
#pragma unroll
      for (int m = 0; m < 4; ++m) {
        unsigned char* rp = C + (size_t)(brow + ai * 128 + wr * 64 + m * 16 + fr) * ldc + (bcol >> 1) + wc * 16 + fq * 4;
#pragma unroll
        for (int bj = 0; bj < 2; ++bj) {
          float r[4];
#pragma unroll
          for (int j = 0; j < 4; ++j) { const float g = acc[ai][bj][m][0][j] * S, u = acc[ai][bj][m][1][j] * S; r[j] = g * sigmoid_fast(g) * u; }
          *(unsigned*)(rp + bj * 64) = pack_fp8x4(r[0], r[1], r[2], r[3]);
        }
      }
  }
};
struct EpiPlainS {
  bf16_t* C; int ldc; float sc;
  __device__ __forceinline__ void operator()(const f32x4 (&acc)[2][2][4][2], int brow, int bcol, int wr, int wc, int fr, int fq) const {
#pragma unroll
    for (int ai = 0; ai < 2; ++ai)
#pragma unroll
      for (int m = 0; m < 4; ++m) {
        bf16_t* rp = C + (size_t)(brow + ai * 128 + wr * 64 + m * 16 + fr) * ldc + bcol + wc * 32 + fq * 8;
#pragma unroll
        for (int bj = 0; bj < 2; ++bj) {
          u32x4 v = {cvtpk(acc[ai][bj][m][0][0] * sc, acc[ai][bj][m][0][1] * sc), cvtpk(acc[ai][bj][m][0][2] * sc, acc[ai][bj][m][0][3] * sc),
                     cvtpk(acc[ai][bj][m][1][0] * sc, acc[ai][bj][m][1][1] * sc), cvtpk(acc[ai][bj][m][1][2] * sc, acc[ai][bj][m][1][3] * sc)};
          *(u32x4*)(rp + bj * 128) = v;
        }
      }
  }
};

__device__ __forceinline__ void dense_unit(int u, int nM, int nN, int& pm, int& pn) {
  const int nwg = nM * nN, NX = 8, WGM = 8;
  int wgid = u;
  { const int q = nwg / NX, r = nwg % NX, xcd = wgid % NX, off = wgid / NX; wgid = (xcd < r ? xcd * (q + 1) : r * (q + 1) + (xcd - r) * q) + off; }
  const int nig = WGM * nN, gid = wgid / nig, fm = gid * WGM, gsz = min(nM - fm, WGM);
  pm = fm + ((wgid % nig) % gsz); pn = (wgid % nig) / gsz;
}

namespace at {
constexpr int DH = 128, NW = 8, QBLK = 32, KVBLK = 64;
constexpr float SCALE = 0.088388347648318440f;
constexpr float QC = SCALE * 1.4426950408889634f;
constexpr int SHM_V = KVBLK * DH * 2, SHM_K = KVBLK * DH * 2;
#define KSWZ(row, colB) ((row) * 256 + ((colB) ^ (((row) & 7) << 4)))
__device__ __forceinline__ int crow(int r, int hi) { return (r & 3) + 8 * (r >> 2) + 4 * hi; }
__device__ __forceinline__ unsigned cvtpkv(float lo, float hi) { unsigned r; asm volatile("v_cvt_pk_bf16_f32 %0, %1, %2" : "=v"(r) : "v"(lo), "v"(hi)); return r; }
#define PK4(P, BASE, OUT) do { unsigned a0 = cvtpkv(P[BASE + 0], P[BASE + 1]), a1 = cvtpkv(P[BASE + 2], P[BASE + 3]);   \
    unsigned b0 = cvtpkv(P[BASE + 4], P[BASE + 5]), b1 = cvtpkv(P[BASE + 6], P[BASE + 7]);                              \
    auto r0 = __builtin_amdgcn_permlane32_swap(a0, b0, false, false); auto r1 = __builtin_amdgcn_permlane32_swap(a1, b1, false, false); \
    u32x4 w = {r0[0], r1[0], r0[1], r1[1]}; OUT = *reinterpret_cast<bf16x8*>(&w); } while (0)
__device__ __forceinline__ float load_q(const bf16_t* __restrict__ Qw, bf16x8 (&qr)[8], float kmax2) {
  float ss = 0;
#pragma unroll
  for (int d0 = 0; d0 < 8; ++d0) {
    const u32x4 raw = *reinterpret_cast<const u32x4*>(Qw + d0 * 16); u32x4 o;
#pragma unroll
    for (int i = 0; i < 4; ++i) { const unsigned pk = cvtpk(bflo(raw[i]) * QC, bfhi(raw[i]) * QC); o[i] = pk; const float a = bflo(pk), b = bfhi(pk); ss += a * a + b * b; }
    qr[d0] = *reinterpret_cast<bf16x8*>(&o);
  }
  { auto rr = __builtin_amdgcn_permlane32_swap(__float_as_uint(ss), __float_as_uint(ss), false, false); ss = __uint_as_float(rr[0]) + __uint_as_float(rr[1]); }
  return -(sqrtf(ss * kmax2) * 1.01f + 1e-3f);
}
__device__ __forceinline__ void exp16(f32x16& p) {
#pragma unroll
  for (int r = 0; r < 16; ++r) p[r] = __builtin_amdgcn_exp2f(p[r]);
}
__device__ __forceinline__ float sum16(const f32x16& p) { float s = 0;
#pragma unroll
  for (int r = 0; r < 16; ++r) s += p[r];
  return s; }
__device__ __forceinline__ void qkt(f32x16& p0, f32x16& p1, LAS const char* Ks, const bf16x8* qr, int r32, int hi, float nmc) {
#pragma unroll
  for (int r = 0; r < 16; ++r) { p0[r] = nmc; p1[r] = nmc; }
#pragma unroll
  for (int d0 = 0; d0 < 8; ++d0) { int cb = (d0 * 16 + hi * 8) * 2;
    bf16x8 b0 = *(LAS const bf16x8*)(Ks + KSWZ(r32, cb));
    bf16x8 b1 = *(LAS const bf16x8*)(Ks + KSWZ(32 + r32, cb));
    p0 = __builtin_amdgcn_mfma_f32_32x32x16_bf16(b0, qr[d0], p0, 0, 0, 0);
    p1 = __builtin_amdgcn_mfma_f32_32x32x16_bf16(b1, qr[d0], p1, 0, 0, 0); }
}
__device__ __forceinline__ int v_st(int k, int c) { const int kk = (k & ~0xC) | ((k & 4) << 1) | ((k & 8) >> 1); return ((kk >> 3) * 4 + (c >> 5)) * 512 + ((kk & 7) * 32 + (c & 31)) * 2; }
__device__ __forceinline__ int v_st256(int k, int c) { const int kk = (k & ~0xC) | ((k & 4) << 1) | ((k & 8) >> 1); return ((kk >> 3) * 8 + (c >> 5)) * 512 + ((kk & 7) * 32 + (c & 31)) * 2; }
__device__ __forceinline__ int v_rd_base(int lane) { return ((lane & 3) << 3) | (((lane >> 2) & 3) << 6) | (((lane >> 4) & 1) << 5) | (((lane >> 5) & 1) << 8); }
template <int OFF> __device__ __forceinline__ s16x4 tr_read(int vb) {
  s16x4 r; asm volatile("ds_read_b64_tr_b16 %0, %1 offset:%2" : "=&v"(r) : "v"(vb), "i"(OFF) : "memory"); return r;
}
template <int BASE, int KS, int HS> __device__ __forceinline__ void pv_one(f32x16& od, int vb, bf16x8 pa0, bf16x8 pa1, bf16x8 pa2, bf16x8 pa3) {
  const s16x4 l0 = tr_read<BASE>(vb), h0 = tr_read<BASE + HS>(vb), l1 = tr_read<BASE + KS>(vb), h1 = tr_read<BASE + KS + HS>(vb);
  const s16x4 l2 = tr_read<BASE + 2 * KS>(vb), h2 = tr_read<BASE + 2 * KS + HS>(vb), l3 = tr_read<BASE + 3 * KS>(vb), h3 = tr_read<BASE + 3 * KS + HS>(vb);
  asm volatile("s_waitcnt lgkmcnt(0)" ::: "memory"); SCHED;
#define PK(L, H) (bf16x8){L[0], L[1], L[2], L[3], H[0], H[1], H[2], H[3]}
  od = __builtin_amdgcn_mfma_f32_32x32x16_bf16(pa0, PK(l0, h0), od, 0, 0, 0);
  od = __builtin_amdgcn_mfma_f32_32x32x16_bf16(pa1, PK(l1, h1), od, 0, 0, 0);
  od = __builtin_amdgcn_mfma_f32_32x32x16_bf16(pa2, PK(l2, h2), od, 0, 0, 0);
  od = __builtin_amdgcn_mfma_f32_32x32x16_bf16(pa3, PK(l3, h3), od, 0, 0, 0);
#undef PK
}
__device__ __forceinline__ void pv_d0(f32x16* o, int vb, bf16x8 pa0, bf16x8 pa1, bf16x8 pa2, bf16x8 pa3) {
  pv_one<0, 4096, 2048>(o[0], vb, pa0, pa1, pa2, pa3); pv_one<512, 4096, 2048>(o[1], vb, pa0, pa1, pa2, pa3);
  pv_one<1024, 4096, 2048>(o[2], vb, pa0, pa1, pa2, pa3); pv_one<1536, 4096, 2048>(o[3], vb, pa0, pa1, pa2, pa3);
}
__device__ __forceinline__ void pv_d0_256(f32x16* o, int vb, bf16x8 pa0, bf16x8 pa1, bf16x8 pa2, bf16x8 pa3) {
  pv_one<0, 8192, 4096>(o[0], vb, pa0, pa1, pa2, pa3); pv_one<512, 8192, 4096>(o[1], vb, pa0, pa1, pa2, pa3);
  pv_one<1024, 8192, 4096>(o[2], vb, pa0, pa1, pa2, pa3); pv_one<1536, 8192, 4096>(o[3], vb, pa0, pa1, pa2, pa3);
}
__device__ __forceinline__ void store_o(const f32x16* o, float l_tot, LAS float* li, bf16_t* __restrict__ Ow, int ldo, int r32, int hi) {
  if (hi == 0) li[r32] = l_tot; asm volatile("s_waitcnt lgkmcnt(0)" ::: "memory");
  float rli[16];
#pragma unroll
  for (int r = 0; r < 16; ++r) rli[r] = __builtin_amdgcn_rcpf(li[crow(r, hi)]);
#pragma unroll
  for (int r = 0; r < 16; ++r) { const int orow = crow(r, hi);
#pragma unroll
    for (int d0 = 0; d0 < 4; ++d0) Ow[(long)orow * ldo + d0 * 32 + r32] = f2bf(o[d0][r] * rli[r]); }
}

__device__ __forceinline__ int unswap23(int kk) { return (kk & ~0xC) | ((kk & 4) << 1) | ((kk & 8) >> 1); }
__device__ __forceinline__ int k_dma_voff(int wid, int lane, int ldk) {
  const int row = 4 * wid + (lane >> 4); return row * ldk * 2 + (((lane & 15) * 16) ^ ((row & 7) << 4)); }
#define DMA16(rs, ldsp, voff, soff) __builtin_amdgcn_raw_ptr_buffer_load_lds(rs, (LAS void*)(ldsp), 16, voff, soff, 0, 0)

constexpr int SHM_T = SHM_K + SHM_V;
__device__ __forceinline__ void attn_body(const bf16_t* __restrict__ Qb, const int ldq, const bf16_t* __restrict__ Kh, const bf16_t* __restrict__ Vh, const int ldk,
                                          bf16_t* __restrict__ Ob, const int ldo, const int seq, const float kmax2, LAS char* lds) {
  int tid = threadIdx.x; asm volatile("" : "+v"(tid)); tid &= 511;
  const int wid = tid >> 6, lane = tid & 63, r32 = lane & 31, hi = lane >> 5;
  LAS float* li_l = (LAS float*)(lds + 3 * SHM_T) + wid * 64;
  float l_reg = 0; f32x16 o[4] = {}; bf16x8 qr[8];
  const float nmc = load_q(Qb + (long)(wid * QBLK + r32) * ldq + hi * 8, qr, kmax2);
  const int vrb = v_rd_base(lane);
  const int kvo = k_dma_voff(wid, lane, ldk);
  const int vvo = unswap23(8 * (wid >> 1) + ((lane & 31) >> 2)) * ldk * 2 + ((2 * (wid & 1) + (lane >> 5)) * 32 + (lane & 3) * 8) * 2;
  const int l32 = 64 * ldk, pz = wid * 1024;
  const __amdgpu_buffer_rsrc_t krs = __builtin_amdgcn_make_buffer_rsrc((void*)Kh, 0, 0x7ffffff0, 0x00020000);
  const __amdgpu_buffer_rsrc_t vrs = __builtin_amdgcn_make_buffer_rsrc((void*)Vh, 0, 0x7ffffff0, 0x00020000);
#define TDMA(slot, k0) do { const int _o = (k0) * ldk * 2; LAS char* _b = lds + (slot) * SHM_T + pz; \
    DMA16(krs, _b, kvo, _o); DMA16(krs, _b + 8192, kvo, _o + l32); DMA16(vrs, _b + SHM_K, vvo, _o); DMA16(vrs, _b + SHM_K + 8192, vvo, _o + l32); } while (0)
#define VM0() asm volatile("s_waitcnt vmcnt(0)" ::: "memory")
#define FINISH(P0, P1) do { exp16(P1); l_reg += sum16(P0) + sum16(P1); PK4(P0, 0, pa0); PK4(P0, 8, pa1); PK4(P1, 0, pa2); PK4(P1, 8, pa3); } while (0)
  f32x16 pA0, pA1, pB0, pB1; bf16x8 pa0, pa1, pa2, pa3; const int NT = seq / KVBLK;
  TDMA(0, 0); VM0(); __syncthreads();
  TDMA(1, KVBLK);
  qkt(pA0, pA1, lds, qr, r32, hi, nmc); exp16(pA0);
  VM0(); __syncthreads();
  int sk = 1, sv = 0, sd = 2;
  for (int j = 1; j + 1 < NT; j += 2) {
    TDMA(sd, (j + 1) * KVBLK);
    SCHED; qkt(pB0, pB1, lds + sk * SHM_T, qr, r32, hi, nmc);
    FINISH(pA0, pA1); SCHED;
    pv_d0(o, (int)(uintptr_t)(lds + sv * SHM_T + SHM_K) + vrb, pa0, pa1, pa2, pa3); exp16(pB0);
    VM0(); __syncthreads();
    { const int t = sv; sv = sk; sk = sd; sd = t; }
    if (j + 2 < NT) TDMA(sd, (j + 2) * KVBLK);
    SCHED; qkt(pA0, pA1, lds + sk * SHM_T, qr, r32, hi, nmc);
    FINISH(pB0, pB1); SCHED;
    pv_d0(o, (int)(uintptr_t)(lds + sv * SHM_T + SHM_K) + vrb, pa0, pa1, pa2, pa3); exp16(pA0);
    VM0(); __syncthreads();
    { const int t = sv; sv = sk; sk = sd; sd = t; }
  }
  SCHED; qkt(pB0, pB1, lds + sk * SHM_T, qr, r32, hi, nmc);
  FINISH(pA0, pA1); SCHED;
  pv_d0(o, (int)(uintptr_t)(lds + sv * SHM_T + SHM_K) + vrb, pa0, pa1, pa2, pa3); exp16(pB0);
  FINISH(pB0, pB1); SCHED;
  pv_d0(o, (int)(uintptr_t)(lds + sk * SHM_T + SHM_K) + vrb, pa0, pa1, pa2, pa3);
  { auto rr = __builtin_amdgcn_permlane32_swap(__float_as_uint(l_reg), __float_as_uint(l_reg), false, false); l_reg = __uint_as_float(rr[0]) + __uint_as_float(rr[1]); }
  store_o(o, l_reg, li_l, Ob + (long)(wid * QBLK) * ldo, ldo, r32, hi);
  VM0();
  __syncthreads();
#undef TDMA
#undef FINISH
}

constexpr int SHM_V2 = KVBLK * 256 * 2;
__device__ __forceinline__ void attn_body_dv256(const bf16_t* __restrict__ Qb, const int ldq, const bf16_t* __restrict__ Kh, const bf16_t* __restrict__ Vh, const int ldk,
                                                bf16_t* __restrict__ Ob, const int ldo, const int seq, const float kmax2, LAS char* lds) {
  int tid = threadIdx.x; asm volatile("" : "+v"(tid)); tid &= 511;
  const int wid = tid >> 6, lane = tid & 63, r32 = lane & 31, hi = lane >> 5, rg = wid >> 1, kh = wid & 1;
  LAS char* K_lds = lds; LAS char* V_lds = lds + 2 * SHM_K; LAS char* X_lds = lds + 2 * SHM_K + 2 * SHM_V2;
  float l_reg = 0; f32x16 o[4] = {}; bf16x8 qr[8];
  const float nmc = load_q(Qb + (long)(rg * QBLK + r32) * ldq + hi * 8, qr, kmax2);
  const int vb0 = (int)(uintptr_t)V_lds + v_rd_base(lane) + kh * 2048;
  const int kvo = k_dma_voff(wid, lane, ldk);
  const int vvo = unswap23(8 * (wid >> 2) + ((lane & 31) >> 2)) * ldk * 2 + ((2 * (wid & 3) + (lane >> 5)) * 32 + (lane & 3) * 8) * 2;
  const int l32 = 64 * ldk, l16 = 32 * ldk, pz = wid * 1024;
  const int xw = (rg * 4 + kh * 2) * 1024 + lane * 16, xr = rg * 4096 + lane * 16;
  const __amdgpu_buffer_rsrc_t krs = __builtin_amdgcn_make_buffer_rsrc((void*)Kh, 0, 0x7ffffff0, 0x00020000);
  const __amdgpu_buffer_rsrc_t vrs = __builtin_amdgcn_make_buffer_rsrc((void*)Vh, 0, 0x7ffffff0, 0x00020000);
#define KDMA(b, k0) do { const int _o = (k0) * ldk * 2; LAS char* _b = K_lds + (b) * SHM_K + pz; DMA16(krs, _b, kvo, _o); DMA16(krs, _b + 8192, kvo, _o + l32); } while (0)
#define VDMA(b, k0) do { const int _o = (k0) * ldk * 2; LAS char* _b = V_lds + (b) * SHM_V2 + pz; DMA16(vrs, _b, vvo, _o); DMA16(vrs, _b + 8192, vvo, _o + l16); \
    DMA16(vrs, _b + 16384, vvo, _o + 2 * l16); DMA16(vrs, _b + 24576, vvo, _o + 3 * l16); } while (0)
  f32x16 pA, pB; bf16x8 pa0, pa1, pa2, pa3, own0, own1; const int NT = seq / KVBLK;
  const int kxor = ((32 * kh + r32) & 7) << 4, krb = (32 * kh + r32) * 256;
#define QKHALF(P, b) do { _Pragma("unroll") for (int r = 0; r < 16; ++r) P[r] = nmc; \
    _Pragma("unroll") for (int d0 = 0; d0 < 8; ++d0) { const bf16x8 bk = *(LAS const bf16x8*)(K_lds + (b) * SHM_K + krb + (((d0 * 16 + hi * 8) * 2) ^ kxor)); \
      P = __builtin_amdgcn_mfma_f32_32x32x16_bf16(bk, qr[d0], P, 0, 0, 0); } } while (0)
#define FINH(P) do { exp16(P); l_reg += sum16(P); PK4(P, 0, own0); PK4(P, 8, own1); } while (0)
#define XWRITE(b) do { *(LAS bf16x8*)(X_lds + (b) * 16384 + xw) = own0; *(LAS bf16x8*)(X_lds + (b) * 16384 + xw + 1024) = own1; } while (0)
#define XREAD(b) do { pa0 = *(LAS const bf16x8*)(X_lds + (b) * 16384 + xr); pa1 = *(LAS const bf16x8*)(X_lds + (b) * 16384 + xr + 1024); \
    pa2 = *(LAS const bf16x8*)(X_lds + (b) * 16384 + xr + 2048); pa3 = *(LAS const bf16x8*)(X_lds + (b) * 16384 + xr + 3072); } while (0)
#define STEP(PA, PB, b, j) do { \
    SCHED; if ((j) + 1 < NT) QKHALF(PB, (b) ^ 1); FINH(PA); SCHED; \
    XWRITE(b); VM0(); __syncthreads(); \
    if ((j) + 3 < NT) KDMA((b) ^ 1, ((j) + 3) * KVBLK); if ((j) + 1 < NT) VDMA((b) ^ 1, ((j) + 1) * KVBLK); \
    XREAD(b); \
    pv_d0_256(o, vb0 + (b) * SHM_V2, pa0, pa1, pa2, pa3); } while (0)
  KDMA(0, 0); KDMA(1, KVBLK); VDMA(0, 0); VM0(); __syncthreads();
  QKHALF(pA, 0);
  __syncthreads();
  if (2 < NT) KDMA(0, 2 * KVBLK);
  for (int j = 0; j < NT; j += 2) { STEP(pA, pB, 0, j); STEP(pB, pA, 1, j + 1); }
  __syncthreads();
  LAS float* lx = (LAS float*)X_lds;
  lx[wid * 64 + lane] = l_reg; __syncthreads();
  const float l_tot = lx[wid * 64 + r32] + lx[wid * 64 + 32 + r32] + lx[(wid ^ 1) * 64 + r32] + lx[(wid ^ 1) * 64 + 32 + r32];
  store_o(o, l_tot, lx + 512 + wid * 32, Ob + (long)(rg * QBLK) * ldo + kh * 128, ldo, r32, hi);
  VM0();
  __syncthreads();
#undef KDMA
#undef VDMA
#undef QKHALF
#undef FINH
#undef XWRITE
#undef XREAD
#undef STEP
#undef VM0
}

#define LGK(n) asm volatile("s_waitcnt lgkmcnt(" #n ")" ::: "memory")
template <int OFF> __device__ __forceinline__ bf16x8 k_read(int ka) { bf16x8 r; asm volatile("ds_read_b128 %0, %1 offset:%2" : "=&v"(r) : "v"(ka), "i"(OFF) : "memory"); return r; }
struct VSet { s16x4 l0, h0, l1, h1; };
template <int OFF> __device__ __forceinline__ void v_read(VSet& s, int vb) { s.l0 = tr_read<OFF>(vb); s.h0 = tr_read<OFF + 4096>(vb); s.l1 = tr_read<OFF + 8192>(vb); s.h1 = tr_read<OFF + 12288>(vb); }
__device__ __forceinline__ void pv2(f32x16& oa, const VSet& s, bf16x8 pa0, bf16x8 pa1) {
#define PK(L, H) (bf16x8){L[0], L[1], L[2], L[3], H[0], H[1], H[2], H[3]}
  oa = __builtin_amdgcn_mfma_f32_32x32x16_bf16(pa0, PK(s.l0, s.h0), oa, 0, 0, 0);
  oa = __builtin_amdgcn_mfma_f32_32x32x16_bf16(pa1, PK(s.l1, s.h1), oa, 0, 0, 0);
#undef PK
}
template <bool SHIFT>
__device__ __forceinline__ void attn_body_c256_t(const bf16_t* __restrict__ Qb, const int ldq, const bf16_t* __restrict__ Kh, const bf16_t* __restrict__ Vh, const int ldk,
                                                 bf16_t* __restrict__ Ob, const int ldo, const int seq, const float nmc, const bf16x8 (&qr)[8], LAS char* lds) {
  int tid = threadIdx.x; asm volatile("" : "+v"(tid)); tid &= 511;
  const int wid = __builtin_amdgcn_readfirstlane(tid >> 6), lane = tid & 63, r32 = lane & 31, hi = lane >> 5;
  LAS char* K_lds = lds; LAS char* V_lds = lds + 2 * SHM_K;
  LAS float* li_l = (LAS float*)(lds + 2 * SHM_K + 2 * SHM_V2) + wid * 64;
  float l_reg = 0; f32x16 o[8] = {};
  const int vb0 = (int)(uintptr_t)V_lds + v_rd_base(lane);
  const int kvo = k_dma_voff(wid, lane, ldk);
  const int vvo = unswap23(8 * (wid >> 2) + ((lane & 31) >> 2)) * ldk * 2 + ((2 * (wid & 3) + (lane >> 5)) * 32 + (lane & 3) * 8) * 2;
  const int l32 = 64 * ldk, l16 = 32 * ldk, pz = wid * 1024;
  const __amdgpu_buffer_rsrc_t krs = __builtin_amdgcn_make_buffer_rsrc((void*)Kh, 0, 0x7ffffff0, 0x00020000);
  const __amdgpu_buffer_rsrc_t vrs = __builtin_amdgcn_make_buffer_rsrc((void*)Vh, 0, 0x7ffffff0, 0x00020000);
#define VM0() asm volatile("s_waitcnt vmcnt(0)" ::: "memory")
#define KVDMA(b, k0) do { const int _o = (k0) * ldk * 2; LAS char* _k = K_lds + (b) * SHM_K + pz; LAS char* _v = V_lds + (b) * SHM_V2 + pz; \
    DMA16(krs, _k, kvo, _o); DMA16(krs, _k + 8192, kvo, _o + l32); DMA16(vrs, _v, vvo, _o); DMA16(vrs, _v + 8192, vvo, _o + l16); \
    DMA16(vrs, _v + 16384, vvo, _o + 2 * l16); DMA16(vrs, _v + 24576, vvo, _o + 3 * l16); } while (0)
  int ka[8];
  { const int kxor = (r32 & 7) << 4, krb = (int)(uintptr_t)K_lds + r32 * 256;
#pragma unroll
    for (int d0 = 0; d0 < 8; ++d0) ka[d0] = krb + (((d0 * 16 + hi * 8) * 2) ^ kxor); }
  f32x16 P; bf16x8 pa0, pa1, f0, f1, f2, f3; VSet va, vb_, vc;
  const int NT = seq / KVBLK;
#define PINIT() do { _Pragma("unroll") for (int r = 0; r < 16; ++r) { float _z; asm volatile("v_mov_b32 %0, %1" : "=v"(_z) : "v"(SHIFT ? nmc : 0.f)); P[r] = _z; } } while (0)
#define KOFF(b, h) ((b) * 16384 + (h) * 8192)
#define VOFF(b, h, d0) ((b) * 32768 + (h) * 16384 + (d0) * 512)
#define KPRO(b, h) do { f0 = k_read<KOFF(b, h)>(ka[0]); f1 = k_read<KOFF(b, h)>(ka[1]); f2 = k_read<KOFF(b, h)>(ka[2]); } while (0)
#define QKM(F, d0) do { SCHED; P = __builtin_amdgcn_mfma_f32_32x32x16_bf16(F, qr[d0], P, 0, 0, 0); SCHED; } while (0)
#define QKHALF(b, h) do { PINIT(); \
    LGK(2); QKM(f0, 0); f3 = k_read<KOFF(b, h)>(ka[3]); \
    LGK(2); QKM(f1, 1); f0 = k_read<KOFF(b, h)>(ka[4]); \
    LGK(2); QKM(f2, 2); f1 = k_read<KOFF(b, h)>(ka[5]); \
    LGK(2); QKM(f3, 3); f2 = k_read<KOFF(b, h)>(ka[6]); \
    LGK(2); QKM(f0, 4); f3 = k_read<KOFF(b, h)>(ka[7]); \
    LGK(2); QKM(f1, 5); v_read<VOFF(b, h, 0)>(va, vb0); \
    LGK(5); QKM(f2, 6); v_read<VOFF(b, h, 1)>(vb_, vb0); \
    LGK(8); QKM(f3, 7); } while (0)
#define SMH() do { exp16(P); l_reg += sum16(P); PK4(P, 0, pa0); PK4(P, 8, pa1); } while (0)
#define PVM(S, d0) do { SCHED; pv2(o[d0], S, pa0, pa1); SCHED; } while (0)
#define PVHALF(b, h, NEXTK, nb, nh) do { \
    LGK(4); PVM(va, 0); v_read<VOFF(b, h, 2)>(vc, vb0); \
    LGK(4); PVM(vb_, 1); v_read<VOFF(b, h, 3)>(va, vb0); \
    LGK(4); PVM(vc, 2); v_read<VOFF(b, h, 4)>(vb_, vb0); \
    LGK(4); PVM(va, 3); v_read<VOFF(b, h, 5)>(vc, vb0); \
    LGK(4); PVM(vb_, 4); v_read<VOFF(b, h, 6)>(va, vb0); \
    LGK(4); PVM(vc, 5); v_read<VOFF(b, h, 7)>(vb_, vb0); \
    LGK(4); PVM(va, 6); if (NEXTK) { f0 = k_read<KOFF(nb, nh)>(ka[0]); f1 = k_read<KOFF(nb, nh)>(ka[1]); } \
    if (NEXTK) { LGK(2); } else { LGK(0); } PVM(vb_, 7); if (NEXTK) { f2 = k_read<KOFF(nb, nh)>(ka[2]); } } while (0)
#define STEPC(b, j) do { if ((j) + 1 < NT) KVDMA((b) ^ 1, ((j) + 1) * KVBLK); \
    KPRO(b, 0); QKHALF(b, 0); SMH(); PVHALF(b, 0, true, b, 1); \
    QKHALF(b, 1); SMH(); PVHALF(b, 1, false, 0, 0); \
    VM0(); __syncthreads(); } while (0)
  KVDMA(0, 0); VM0(); __syncthreads();
  for (int j = 0; j < NT; j += 2) { STEPC(0, j); STEPC(1, j + 1); }
  { auto rr = __builtin_amdgcn_permlane32_swap(__float_as_uint(l_reg), __float_as_uint(l_reg), false, false); l_reg = __uint_as_float(rr[0]) + __uint_as_float(rr[1]); }
  if (hi == 0) li_l[r32] = l_reg; asm volatile("s_waitcnt lgkmcnt(0)" ::: "memory");
  bf16_t* Ow = Ob + (long)(wid * QBLK) * ldo;
#pragma unroll
  for (int r = 0; r < 16; ++r) { const int orow = crow(r, hi); const float rl = __builtin_amdgcn_rcpf(li_l[orow]);
#pragma unroll
    for (int d0 = 0; d0 < 8; ++d0) Ow[(long)orow * ldo + d0 * 32 + r32] = f2bf(o[d0][r] * rl); }
  VM0();
  __syncthreads();
#undef KVDMA
#undef PINIT
#undef KOFF
#undef VOFF
#undef KPRO
#undef QKM
#undef QKHALF
#undef SMH
#undef PVM
#undef PVHALF
#undef STEPC
#undef VM0
}
__device__ __forceinline__ void attn_body_c256(const bf16_t* __restrict__ Qb, const int ldq, const bf16_t* __restrict__ Kh, const bf16_t* __restrict__ Vh, const int ldk,
                                               bf16_t* __restrict__ Ob, const int ldo, const int seq, const float kmax2, LAS char* lds) {
  int tid = threadIdx.x; asm volatile("" : "+v"(tid)); tid &= 511;
  const int wid = tid >> 6, lane = tid & 63, r32 = lane & 31, hi = lane >> 5;
  bf16x8 qr[8];
  const float nmc = load_q(Qb + (long)(wid * QBLK + r32) * ldq + hi * 8, qr, kmax2);
  if (__all(nmc > -64.f)) attn_body_c256_t<false>(Qb, ldq, Kh, Vh, ldk, Ob, ldo, seq, 0.f, qr, lds);
  else attn_body_c256_t<true>(Qb, ldq, Kh, Vh, ldk, Ob, ldo, seq, nmc, qr, lds);
}

__device__ __forceinline__ float load_q8(const bf16_t* __restrict__ Qrow, int hi, v8i_ (&qf)[2], float kmax2) {
  float ss = 0;
#pragma unroll
  for (int st = 0; st < 2; ++st) {
    const bf16_t* p = Qrow + 64 * st + 32 * hi; v8i_ o;
#pragma unroll
    for (int c = 0; c < 4; ++c) { const u32x4 raw = *reinterpret_cast<const u32x4*>(p + 8 * c);
      const unsigned w0 = pack8x4(bflo(raw[0]) * QC, bfhi(raw[0]) * QC, bflo(raw[1]) * QC, bfhi(raw[1]) * QC);
      const unsigned w1 = pack8x4(bflo(raw[2]) * QC, bfhi(raw[2]) * QC, bflo(raw[3]) * QC, bfhi(raw[3]) * QC);
      o[2 * c] = (int)w0; o[2 * c + 1] = (int)w1; ss += sq8x4(w0) + sq8x4(w1); }
    qf[st] = o;
  }
  { auto rr = __builtin_amdgcn_permlane32_swap(__float_as_uint(ss), __float_as_uint(ss), false, false); ss = __uint_as_float(rr[0]) + __uint_as_float(rr[1]); }
  return -(sqrtf(ss * kmax2) * 1.01f + 1e-3f);
}
__device__ __forceinline__ int k8_dma_voff(int wid, int lane, int ldk8) {
  const int row = 8 * wid + (lane >> 3); return row * ldk8 + (((lane & 7) ^ ((row >> 1) & 7)) << 4); }
template <int OFF> __device__ __forceinline__ v4i k8_read(int ka) { v4i r; asm volatile("ds_read_b128 %0, %1 offset:%2" : "=&v"(r) : "v"(ka), "i"(OFF) : "memory"); return r; }

template <bool SHIFT>
__device__ __forceinline__ void attn_body_c256q8_t(const unsigned char* __restrict__ K8, const int ldk8, const bf16_t* __restrict__ Vh, const int ldk,
                                                   bf16_t* __restrict__ Ob, const int ldo, const int seq, const float nmc, const v8i_ (&qf)[2], LAS char* lds) {
  int tid = threadIdx.x; asm volatile("" : "+v"(tid)); tid &= 511;
  const int wid = __builtin_amdgcn_readfirstlane(tid >> 6), lane = tid & 63, r32 = lane & 31, hi = lane >> 5;
  constexpr int SHM_K8 = KVBLK * 128;
  LAS char* K_lds = lds; LAS char* V_lds = lds + 2 * SHM_K8;
  LAS float* li_l = (LAS float*)(lds + 2 * SHM_K8 + 2 * SHM_V2) + wid * 64;
  float l_reg = 0; f32x16 o[8] = {};
  const int vb0 = (int)(uintptr_t)V_lds + v_rd_base(lane);
  const int kvo = k8_dma_voff(wid, lane, ldk8);
  const int vvo = unswap23(8 * (wid >> 2) + ((lane & 31) >> 2)) * ldk * 2 + ((2 * (wid & 3) + (lane >> 5)) * 32 + (lane & 3) * 8) * 2;
  const int l16 = 32 * ldk, pz = wid * 1024;
  const __amdgpu_buffer_rsrc_t krs = __builtin_amdgcn_make_buffer_rsrc((void*)K8, 0, 0x7ffffff0, 0x00020000);
  const __amdgpu_buffer_rsrc_t vrs = __builtin_amdgcn_make_buffer_rsrc((void*)Vh, 0, 0x7ffffff0, 0x00020000);
#define VM0() asm volatile("s_waitcnt vmcnt(0)" ::: "memory")
#define KVDMA(b, k0) do { const int _o = (k0) * ldk * 2; LAS char* _v = V_lds + (b) * SHM_V2 + pz; \
    DMA16(krs, K_lds + (b) * SHM_K8 + pz, kvo, (k0) * ldk8); DMA16(vrs, _v, vvo, _o); DMA16(vrs, _v + 8192, vvo, _o + l16); \
    DMA16(vrs, _v + 16384, vvo, _o + 2 * l16); DMA16(vrs, _v + 24576, vvo, _o + 3 * l16); } while (0)
  const int ka0 = (int)(uintptr_t)K_lds + r32 * 128 + (((2 * hi) ^ ((r32 >> 1) & 7)) << 4);
  const int ka1 = ka0 ^ 16, ka2 = ka0 ^ 64, ka3 = ka0 ^ 80;
  int sc1; asm volatile("v_mov_b32 %0, 0x7f7f7f7f" : "=v"(sc1));
  f32x16 P; bf16x8 pa0, pa1; v4i k0a, k0b, k1a, k1b; VSet va, vb_, vc;
  const int NT = seq / KVBLK;
#define KOFF(b, h) ((b) * 8192 + (h) * 4096)
#define VOFF(b, h, d0) ((b) * 32768 + (h) * 16384 + (d0) * 512)
#define KPRO(b, h) do { k0a = k8_read<KOFF(b, h)>(ka0); k0b = k8_read<KOFF(b, h)>(ka1); k1a = k8_read<KOFF(b, h)>(ka2); k1b = k8_read<KOFF(b, h)>(ka3); } while (0)
#define V8(x, y) (v8i_){x[0], x[1], x[2], x[3], y[0], y[1], y[2], y[3]}
#define QKHALF(b, h) do { \
    if (SHIFT) { _Pragma("unroll") for (int r = 0; r < 16; ++r) { float _z; asm volatile("v_mov_b32 %0, %1" : "=v"(_z) : "v"(nmc)); P[r] = _z; } } \
    LGK(2); SCHED; { const v8i_ kf = V8(k0a, k0b); \
      if (SHIFT) asm volatile("s_nop 4\n\tv_mfma_scale_f32_32x32x64_f8f6f4 %0, %1, %2, %0, %3, %3 op_sel_hi:[0,0,0]" : "+v"(P) : "v"(kf), "v"(qf[0]), "v"(sc1)); \
      else       asm volatile("v_mfma_scale_f32_32x32x64_f8f6f4 %0, %1, %2, 0, %3, %3 op_sel_hi:[0,0,0]" : "=&v"(P) : "v"(kf), "v"(qf[0]), "v"(sc1)); } \
    SCHED; v_read<VOFF(b, h, 0)>(va, vb0); \
    LGK(4); SCHED; { const v8i_ kf = V8(k1a, k1b); \
      asm volatile("v_mfma_scale_f32_32x32x64_f8f6f4 %0, %1, %2, %0, %3, %3 op_sel_hi:[0,0,0]" : "+v"(P) : "v"(kf), "v"(qf[1]), "v"(sc1)); } \
    SCHED; v_read<VOFF(b, h, 1)>(vb_, vb0); \
    asm volatile("s_nop 15\n\ts_nop 7" : "+v"(P)); } while (0)
#define SMH() do { exp16(P); l_reg += sum16(P); PK4(P, 0, pa0); PK4(P, 8, pa1); } while (0)
#define PVM(S, d0) do { SCHED; pv2(o[d0], S, pa0, pa1); SCHED; } while (0)
#define PVHALF(b, h, NEXTK, nb, nh) do { \
    LGK(4); PVM(va, 0); v_read<VOFF(b, h, 2)>(vc, vb0); \
    LGK(4); PVM(vb_, 1); v_read<VOFF(b, h, 3)>(va, vb0); \
    LGK(4); PVM(vc, 2); v_read<VOFF(b, h, 4)>(vb_, vb0); \
    LGK(4); PVM(va, 3); v_read<VOFF(b, h, 5)>(vc, vb0); \
    LGK(4); PVM(vb_, 4); v_read<VOFF(b, h, 6)>(va, vb0); \
    LGK(4); PVM(vc, 5); v_read<VOFF(b, h, 7)>(vb_, vb0); \
    LGK(4); PVM(va, 6); if (NEXTK) { k0a = k8_read<KOFF(nb, nh)>(ka0); k0b = k8_read<KOFF(nb, nh)>(ka1); } \
    if (NEXTK) { LGK(2); } else { LGK(0); } PVM(vb_, 7); if (NEXTK) { k1a = k8_read<KOFF(nb, nh)>(ka2); k1b = k8_read<KOFF(nb, nh)>(ka3); } } while (0)
#define STEPC(b, j) do { if ((j) + 1 < NT) KVDMA((b) ^ 1, ((j) + 1) * KVBLK); \
    KPRO(b, 0); QKHALF(b, 0); SMH(); PVHALF(b, 0, true, b, 1); \
    QKHALF(b, 1); SMH(); PVHALF(b, 1, false, 0, 0); \
    VM0(); __syncthreads(); } while (0)
  KVDMA(0, 0); VM0(); __syncthreads();
  for (int j = 0; j < NT; j += 2) { STEPC(0, j); STEPC(1, j + 1); }
  { auto rr = __builtin_amdgcn_permlane32_swap(__float_as_uint(l_reg), __float_as_uint(l_reg), false, false); l_reg = __uint_as_float(rr[0]) + __uint_as_float(rr[1]); }
  if (hi == 0) li_l[r32] = l_reg; asm volatile("s_waitcnt lgkmcnt(0)" ::: "memory");
  bf16_t* Ow = Ob + (long)(wid * QBLK) * ldo;
#pragma unroll
  for (int r = 0; r < 16; ++r) { const int orow = crow(r, hi); const float rl = __builtin_amdgcn_rcpf(li_l[orow]);
#pragma unroll
    for (int d0 = 0; d0 < 8; ++d0) Ow[(long)orow * ldo + d0 * 32 + r32] = f2bf(o[d0][r] * rl); }
  VM0();
  __syncthreads();
#undef KVDMA
#undef KOFF
#undef VOFF
#undef KPRO
#undef V8
#undef QKHALF
#undef SMH
#undef PVM
#undef PVHALF
#undef STEPC
#undef VM0
}
__device__ __forceinline__ void attn_body_c256q8(const bf16_t* __restrict__ Qb, const int ldq, const unsigned char* __restrict__ K8, const int ldk8,
                                                 const bf16_t* __restrict__ Vh, const int ldk, bf16_t* __restrict__ Ob, const int ldo, const int seq, const float kmax2, LAS char* lds) {
  int tid = threadIdx.x; asm volatile("" : "+v"(tid)); tid &= 511;
  const int wid = tid >> 6, lane = tid & 63, r32 = lane & 31, hi = lane >> 5;
  v8i_ qf[2];
  const float nmc = load_q8(Qb + (long)(wid * QBLK + r32) * ldq, hi, qf, kmax2);
  if (__all(nmc > -64.f)) attn_body_c256q8_t<false>(K8, ldk8, Vh, ldk, Ob, ldo, seq, 0.f, qf, lds);
  else attn_body_c256q8_t<true>(K8, ldk8, Vh, ldk, Ob, ldo, seq, nmc, qf, lds);
}
#undef PK4
}

__device__ __forceinline__ int perm_plain8(int n) { const int r = n & 31; return (n & ~31) + 16 * ((r >> 2) & 1) + 4 * (r >> 3) + (r & 3); }
__device__ __forceinline__ int perm_row(int kind, int n) {
  if (kind == 0) return perm_plain8(n);
  if (kind == 1) { if (n < N_QKV0) return perm_plain8(n); const int c = n - N_QKV0; const int ch = c & 1023; return N_QKV0 + 32 * (ch >> 4) + ((c >> 10) << 4) + (ch & 15); }
  return 32 * (n >> 4) + ((kind == 3) ? 16 : 0) + (n & 15);
}
__device__ __forceinline__ void cvt_tile(const float* __restrict__ src, int N, bf16_t* __restrict__ dst, int K, int kind, int k0, int n0, LAS unsigned* t32) {
  int tid = threadIdx.x; asm volatile("" : "+v"(tid)); tid &= 511;
#pragma unroll
  for (int j = 0; j < 2; ++j) {
    const int item = tid + 512 * j, kp = item >> 4, q = item & 15;
    const f32x4 v0 = *(const f32x4*)(src + (size_t)(k0 + 2 * kp) * N + n0 + 4 * q);
    const f32x4 v1 = *(const f32x4*)(src + (size_t)(k0 + 2 * kp + 1) * N + n0 + 4 * q);
#pragma unroll
    for (int i = 0; i < 4; ++i) t32[(4 * q + i) * 65 + kp] = cvtpk(v0[i], v1[i]);
  }
  __syncthreads();
#pragma unroll
  for (int j = 0; j < 2; ++j) {
    const int item = tid + 512 * j, n = item >> 4, ko = item & 15;
    u32x4 v;
#pragma unroll
    for (int i = 0; i < 4; ++i) v[i] = t32[n * 65 + 4 * ko + i];
    *(u32x4*)(dst + (size_t)perm_row(kind, n0 + n) * K + k0 + 8 * ko) = v;
  }
  __syncthreads();
}
__device__ __forceinline__ void cvt_matrix_units(const float* src, int K, int N, bf16_t* dst, int kind, int u0, int ustride, LAS unsigned* t32) {
  const int nN = N / 64, nK = K / 128;
  for (int u = u0; u < nN * nK; u += ustride) cvt_tile(src, N, dst, K, kind, (u / nN) * 128, (u % nN) * 64, t32);
}
constexpr size_t WMOE8_E = (size_t)1024 * D + (size_t)D * EFF;
__device__ __forceinline__ void cvt_tile8(const float* __restrict__ src, int N, unsigned char* __restrict__ dst, int K, int kind, int k0, int n0, float scale, LAS unsigned* t32) {
  int tid = threadIdx.x; asm volatile("" : "+v"(tid)); tid &= 511;
  { const int kq = tid >> 4, q = tid & 15;
    f32x4 v[4];
#pragma unroll
    for (int r = 0; r < 4; ++r) v[r] = *(const f32x4*)(src + (size_t)(k0 + 4 * kq + r) * N + n0 + 4 * q);
#pragma unroll
    for (int i = 0; i < 4; ++i) t32[(4 * q + i) * 33 + kq] = pack_fp8x4(v[0][i] * scale, v[1][i] * scale, v[2][i] * scale, v[3][i] * scale); }
  __syncthreads();
  { const int n = tid >> 3, kc = tid & 7;
    u32x4 v;
#pragma unroll
    for (int i = 0; i < 4; ++i) v[i] = t32[n * 33 + 4 * kc + i];
    *(u32x4*)(dst + (size_t)perm_row(kind, n0 + n) * K + k0 + 16 * kc) = v; }
  __syncthreads();
}
__device__ __forceinline__ void cvt_moe_all8(const Args& a, LAS unsigned* t32) {
  unsigned char* W = (unsigned char*)(a.ws + WS_WMOE);
  for (int u = blockIdx.x; u < 2 * 65 * 384; u += gridDim.x) {
    const int le = u / 384, L = le / 65, e = le % 65, r = u % 384, mtx = r >> 7, lu = r & 127;
    const float* src; unsigned char* dst = W + (size_t)le * WMOE8_E; int K, N, kind; float sc;
    if (mtx == 0)      { src = e < 64 ? a.in[21] + ((size_t)L * 64 + e) * D * EFF : a.in[24] + (size_t)L * D * EFF; K = D; N = EFF; kind = 2; sc = 256.f; }
    else if (mtx == 1) { src = e < 64 ? a.in[22] + ((size_t)L * 64 + e) * D * EFF : a.in[25] + (size_t)L * D * EFF; K = D; N = EFF; kind = 3; sc = 256.f; }
    else               { src = e < 64 ? a.in[23] + ((size_t)L * 64 + e) * EFF * D : a.in[26] + (size_t)L * EFF * D; K = EFF; N = D; kind = 0; sc = 128.f; dst += (size_t)1024 * D; }
    const int nN = N / 64;
    cvt_tile8(src, N, dst, K, kind, (lu / nN) * 128, (lu % nN) * 64, sc, t32);
  }
}

__device__ __forceinline__ void ld_row_f32(const float* __restrict__ p, int lane, float (&v)[32]) {
#pragma unroll
  for (int j = 0; j < 4; ++j) { const f32x4 t0 = *(const f32x4*)(p + 8 * lane + 512 * j), t1 = *(const f32x4*)(p + 8 * lane + 512 * j + 4);
#pragma unroll
    for (int i = 0; i < 4; ++i) { v[8 * j + i] = t0[i]; v[8 * j + 4 + i] = t1[i]; } }
}
__device__ __forceinline__ void ld_row_bf16(const bf16_t* __restrict__ p, int lane, float (&v)[32]) {
#pragma unroll
  for (int j = 0; j < 4; ++j) { const u32x4 t = *(const u32x4*)(p + 8 * lane + 512 * j);
#pragma unroll
    for (int i = 0; i < 4; ++i) { v[8 * j + 2 * i] = bflo(t[i]); v[8 * j + 2 * i + 1] = bfhi(t[i]); } }
}
__device__ __forceinline__ void ld8f(const float* __restrict__ p, float (&x)[8]) { const f32x4 t0 = *(const f32x4*)p, t1 = *(const f32x4*)(p + 4);
#pragma unroll
  for (int i = 0; i < 4; ++i) { x[i] = t0[i]; x[4 + i] = t1[i]; } }
__device__ __forceinline__ void st8f(float* __restrict__ p, const float* x) { f32x4 t0 = {x[0], x[1], x[2], x[3]}, t1 = {x[4], x[5], x[6], x[7]}; *(f32x4*)p = t0; *(f32x4*)(p + 4) = t1; }
__device__ __forceinline__ float sumsq32(const float (&v)[32]) { float s = 0;
#pragma unroll
  for (int i = 0; i < 32; ++i) s += v[i] * v[i];
  return wave_sum(s); }
template <bool COPY, bool OUT8 = false>
__device__ __forceinline__ void modulate_store(const float (&v)[32], float rstd, const float* __restrict__ g, const float* __restrict__ shift, const float* __restrict__ scale,
                                               bf16_t* __restrict__ dst, int lane, LAS float* f32copy) {
#pragma unroll
  for (int j = 0; j < 4; ++j) {
    const int idx = 8 * lane + 512 * j;
    float gv[8], sh[8], sc[8], y[8]; ld8f(g + idx, gv); ld8f(shift + idx, sh); ld8f(scale + idx, sc);
#pragma unroll
    for (int i = 0; i < 8; ++i) y[i] = v[8 * j + i] * rstd * gv[i] * (1.f + sc[i]) + sh[i];
    if (OUT8) { u32x2 p8 = {pack_fp8x4(y[0], y[1], y[2], y[3]), pack_fp8x4(y[4], y[5], y[6], y[7])}; *(u32x2*)((unsigned char*)dst + idx) = p8; }
    else { u32x4 pk = {cvtpk(y[0], y[1]), cvtpk(y[2], y[3]), cvtpk(y[4], y[5]), cvtpk(y[6], y[7])}; *(u32x4*)(dst + idx) = pk; }
    if (COPY) { f32x4 t0 = {y[0], y[1], y[2], y[3]}, t1 = {y[4], y[5], y[6], y[7]};
      *(LAS f32x4*)(f32copy + idx) = t0; *(LAS f32x4*)(f32copy + idx + 4) = t1; }
  }
}

__device__ __forceinline__ void phase_prologue(const Args& a, LAS char* lds) {
  int tid = threadIdx.x; asm volatile("" : "+v"(tid)); tid &= 511; const int wave = tid >> 6, lane = tid & 63;
  {
    LAS float* sc = (LAS float*)lds;
    LAS float* part = sc + 4096;
    const float* c = a.in[1]; const float* cc = a.in[3];
    for (int i = tid; i < D; i += NTHREADS) { float v = c[i]; sc[i] = v * sigmoidf_(v); float u = cc[i]; sc[D + i] = u * sigmoidf_(u); }
    __syncthreads();
    float* MOD = (float*)(a.ws + WS_MOD);
    for (int u = blockIdx.x; u < 2 * 192; u += gridDim.x) {
      const int L = u / 192, chunk = u % 192;
      const float* W = a.in[4] + (size_t)L * D * 12288 + chunk * 64 + lane;
      float a0 = 0, a1 = 0; const int d0 = wave * 256;
#pragma unroll 8
      for (int dd = 0; dd < 256; ++dd) { const float w = W[(size_t)(d0 + dd) * 12288]; a0 += sc[d0 + dd] * w; a1 += sc[D + d0 + dd] * w; }
      part[(wave * 2 + 0) * 64 + lane] = a0; part[(wave * 2 + 1) * 64 + lane] = a1;
      __syncthreads();
      if (tid < 128) { const int which = tid >> 6; float s = 0;
#pragma unroll
        for (int w = 0; w < 8; ++w) s += part[(w * 2 + which) * 64 + lane];
        const int j = chunk * 64 + lane; MOD[(size_t)(L * 2 + which) * 12288 + j] = s + a.in[5][L * 12288 + j]; }
      __syncthreads();
    }
  }
  LAS unsigned* t32 = (LAS unsigned*)lds;
  cvt_matrix_units(a.in[7], D, N_IN0, (bf16_t*)(a.ws + WS_WIN0), 1, blockIdx.x, gridDim.x, t32);
  cvt_matrix_units(a.in[8], D, D, (bf16_t*)(a.ws + WS_WOUT0), 0, blockIdx.x, gridDim.x, t32);
  cvt_matrix_units(a.in[15], D, N_IN1, (bf16_t*)(a.ws + WS_WIN1), 0, blockIdx.x, gridDim.x, t32);
  cvt_matrix_units(a.in[16], D, D, (bf16_t*)(a.ws + WS_WOUT1), 0, blockIdx.x, gridDim.x, t32);
  cvt_moe_all8(a, t32);
}

__device__ __forceinline__ void phase_modulate0(const Args& a) {
  int tid = threadIdx.x; asm volatile("" : "+v"(tid)); tid &= 511; const int wave = tid >> 6, lane = tid & 63;
  const float* MOD = (const float*)(a.ws + WS_MOD);
  bf16_t* A = (bf16_t*)(a.ws + WS_ABUF);
  for (int it = blockIdx.x; it < MT / 8; it += gridDim.x) {
    const int r = it * 8 + wave;
    const float* src = r < CTXL ? a.in[2] + (size_t)r * D : a.in[0] + (size_t)(r - CTXL) * D;
    const float* mod = MOD + (r < CTXL ? 12288 : 0);
    float v[32]; ld_row_f32(src, lane, v);
    const float rstd = rsqrtf(sumsq32(v) * (1.f / D) + EPS);
    modulate_store<false>(v, rstd, a.in[6], mod, mod + D, A + (size_t)r * D, lane, nullptr);
  }
}

__device__ __forceinline__ void rope_cs4(int r, int lane, float (&cs)[4], float (&sn)[4]) {
#pragma unroll
  for (int q = 0; q < 4; ++q) { cs[q] = 1.f; sn[q] = 0.f; }
  if (r >= CTXL) { const int t = r - CTXL; const int l = lane & 15, a = l >> 3, i0 = 4 * (l & 7);
    const float pos = a ? (float)(t & 63) : (float)(t >> 6);
#pragma unroll
    for (int q = 0; q < 4; ++q) { const float inv = powf(10000.f, -(float)(i0 + q) / 32.f); sincosf(pos * inv, &sn[q], &cs[q]); } }
}
__device__ __forceinline__ float sum16lanes(float v) { v += __shfl_xor(v, 1); v += __shfl_xor(v, 2); v += __shfl_xor(v, 4); v += __shfl_xor(v, 8); return v; }
__device__ __forceinline__ void phase_rope_conv0(const Args& a, LAS char* lds, bool dry = false) {
  int tid = threadIdx.x; asm volatile("" : "+v"(tid)); tid &= 511; const int wave = tid >> 6, lane = tid & 63;
  bf16_t* Q = (bf16_t*)(a.ws + WS_QKVU);
  {
    const bf16_t* HG = (const bf16_t*)(a.ws + WS_HG);
    bf16_t* X2 = (bf16_t*)(a.ws + WS_X2);
    LAS char* lt = lds;
    LAS float* part = (LAS float*)(lds + 62 * 2048);
    LAS float* stats = part + 512;
    const float* dw_w = a.in[11]; const float* dw_b = a.in[12]; const float* ln_g = a.in[13]; const float* ln_b = a.in[14];
    const __amdgpu_buffer_rsrc_t wrs = __builtin_amdgcn_make_buffer_rsrc((void*)dw_w, 0, 31 * 1024 * 4, 0x00020000);
    for (int u = blockIdx.x; u < 520; u += gridDim.x) {
      int seg0, seg1, r0;
      if (u < 8) { seg0 = 0; seg1 = CTXL; r0 = u * 32; } else { seg0 = CTXL; seg1 = MT; r0 = CTXL + (u - 8) * 32; }
      for (int c = tid; c < 62 * 128; c += NTHREADS) { const int rr = c >> 7, cc = c & 127, gr = r0 - 15 + rr;
        u32x4 v = {0u, 0u, 0u, 0u}; if (gr >= seg0 && gr < seg1) v = *(const u32x4*)(HG + (size_t)gr * 1024 + cc * 8);
        *(LAS u32x4*)(lt + rr * 2048 + cc * 16) = v; }
      __syncthreads();
      float w0[31], w1[31];
#pragma unroll
      for (int j = 0; j < 31; ++j) { const u32x2 w = __builtin_amdgcn_raw_buffer_load_b64(wrs, tid * 8, j * 4096, 0); w0[j] = __uint_as_float(w[0]); w1[j] = __uint_as_float(w[1]); }
      const f32x2 bb = *(const f32x2*)(dw_b + 2 * tid);
      const f32x2 gg = *(const f32x2*)(ln_g + 2 * tid), gb = *(const f32x2*)(ln_b + 2 * tid);
#pragma unroll 1
      for (int hf = 0; hf < 4; ++hf) {
        float o0[8], o1[8];
        LAS const char* lth = lt + (hf * 8) * 2048 + tid * 4;
#pragma unroll
        for (int r = 0; r < 8; ++r) { o0[r] = bb[0]; o1[r] = bb[1]; }
#pragma unroll
        for (int i = 0; i < 38; ++i) {
          const unsigned p = *(LAS const unsigned*)(lth + i * 2048);
          const float x0 = bflo(p), x1 = bfhi(p);
#pragma unroll
          for (int r = 0; r < 8; ++r) { const int j = i - r; if (j >= 0 && j < 31) { o0[r] += x0 * w0[j]; o1[r] += x1 * w1[j]; } }
        }
#pragma unroll
        for (int r = 0; r < 8; ++r) {
          const float s = wave_sum(o0[r] + o1[r]), q = wave_sum(o0[r] * o0[r] + o1[r] * o1[r]);
          if (lane == 0) { part[(r * 8 + wave) * 2] = s; part[(r * 8 + wave) * 2 + 1] = q; }
        }
        __syncthreads();
        if (tid < 8) { float s = 0, q = 0;
#pragma unroll
          for (int w = 0; w < 8; ++w) { s += part[(tid * 8 + w) * 2]; q += part[(tid * 8 + w) * 2 + 1]; }
          const float mean = s * (1.f / 1024), var = q * (1.f / 1024) - mean * mean;
          stats[tid * 2] = mean; stats[tid * 2 + 1] = rsqrtf(fmaxf(var, 0.f) + EPS); }
        __syncthreads();
#pragma unroll
        for (int r = 0; r < 8; ++r) {
          const float mean = stats[r * 2], rstd = stats[r * 2 + 1];
          float y0 = (o0[r] - mean) * rstd * gg[0] + gb[0], y1 = (o1[r] - mean) * rstd * gg[1] + gb[1];
          y0 = y0 * sigmoid_fast(y0); y1 = y1 * sigmoid_fast(y1);
          *(unsigned*)(X2 + (size_t)(r0 + hf * 8 + r) * D + 1024 + 2 * tid) = cvtpk(y0, y1);
        }
      }
      __syncthreads();
    }
  }
  const float* qn = a.in[9]; const float* kn = a.in[10];
  unsigned* kmx = (unsigned*)(a.ws + WS_CTL + CTL_KMAX);
  const int slot = lane >> 4, l16 = lane & 15, e1 = (l16 >> 3) * 64 + 4 * (l16 & 7), e2 = e1 + 32;
  float km0 = 0.f, km1 = 0.f;
  for (int it = blockIdx.x; it < MT / 8; it += gridDim.x) {
    const int r = it * 8 + wave;
    float cs[4], sn[4]; rope_cs4(r, lane, cs, sn);
    bf16_t* rowp = Q + (size_t)r * N_QKV0;
#pragma unroll
    for (int hb = 0; hb < 12; hb += 4) {
      const int hh = hb + slot;
      if (hh < 10) {
        const float* g = hh < 8 ? qn : kn;
        const u32x2 a1 = *(const u32x2*)(rowp + hh * 128 + e1), a2 = *(const u32x2*)(rowp + hh * 128 + e2);
        float x1[4] = {bflo(a1[0]), bfhi(a1[0]), bflo(a1[1]), bfhi(a1[1])}, x2[4] = {bflo(a2[0]), bfhi(a2[0]), bflo(a2[1]), bfhi(a2[1])};
        float ss = 0;
#pragma unroll
        for (int q = 0; q < 4; ++q) ss += x1[q] * x1[q] + x2[q] * x2[q];
        ss = sum16lanes(ss);
        const float rstd = rsqrtf(ss * (1.f / 128) + EPS);
        const f32x4 g1 = *(const f32x4*)(g + e1), g2 = *(const f32x4*)(g + e2);
        float o1[4], o2[4], so = 0;
#pragma unroll
        for (int q = 0; q < 4; ++q) { const float y1 = x1[q] * rstd * g1[q], y2 = x2[q] * rstd * g2[q]; o1[q] = y1 * cs[q] - y2 * sn[q]; o2[q] = y2 * cs[q] + y1 * sn[q]; }
        const u32x2 w1 = {cvtpk(o1[0], o1[1]), cvtpk(o1[2], o1[3])}, w2 = {cvtpk(o2[0], o2[1]), cvtpk(o2[2], o2[3])};
        if (!dry) { *(u32x2*)(rowp + hh * 128 + e1) = w1; *(u32x2*)(rowp + hh * 128 + e2) = w2; }
        if (hb == 8) {
          so = bflo(w1[0]) * bflo(w1[0]) + bfhi(w1[0]) * bfhi(w1[0]) + bflo(w1[1]) * bflo(w1[1]) + bfhi(w1[1]) * bfhi(w1[1])
             + bflo(w2[0]) * bflo(w2[0]) + bfhi(w2[0]) * bfhi(w2[0]) + bflo(w2[1]) * bflo(w2[1]) + bfhi(w2[1]) * bfhi(w2[1]);
          so = sum16lanes(so); if (slot == 0) km0 = fmaxf(km0, so); else km1 = fmaxf(km1, so);
        }
      }
    }
  }
  if (l16 == 0 && slot < 2) atomicMax(&kmx[slot], __float_as_uint(slot == 0 ? km0 : km1));
}
__device__ __forceinline__ void phase_rope1(const Args& a, LAS char* lds, bool dry = false) {
  int tid = threadIdx.x; asm volatile("" : "+v"(tid)); tid &= 511; const int wave = tid >> 6, lane = tid & 63;
  bf16_t* Q = (bf16_t*)(a.ws + WS_QKVU);
  unsigned* kmx = (unsigned*)(a.ws + WS_CTL + CTL_KMAX) + 16;
  unsigned char* K8 = (unsigned char*)(a.ws + WS_K8);
  LAS unsigned* lk = (LAS unsigned*)lds;
  if (tid < 16) lk[tid] = 0u;
  __syncthreads();
  const int slot = lane >> 4, l16 = lane & 15, e1 = (l16 >> 3) * 64 + 4 * (l16 & 7), e2 = e1 + 32;
  for (int it = blockIdx.x; it < MT / 8; it += gridDim.x) {
    const int r = it * 8 + wave;
    float cs[4], sn[4]; rope_cs4(r, lane, cs, sn);
    bf16_t* rowp = Q + (size_t)r * N_IN1;
#pragma unroll 2
    for (int hb = (r < CTXL ? 16 : 0); hb < 32; hb += 4) {
      const int hh = hb + slot;
      const u32x2 a1 = *(const u32x2*)(rowp + hh * 128 + e1), a2 = *(const u32x2*)(rowp + hh * 128 + e2);
      const float x1[4] = {bflo(a1[0]), bfhi(a1[0]), bflo(a1[1]), bfhi(a1[1])}, x2[4] = {bflo(a2[0]), bfhi(a2[0]), bflo(a2[1]), bfhi(a2[1])};
      float o1[4], o2[4];
#pragma unroll
      for (int q = 0; q < 4; ++q) { o1[q] = x1[q] * cs[q] - x2[q] * sn[q]; o2[q] = x2[q] * cs[q] + x1[q] * sn[q]; }
      const u32x2 w1 = {cvtpk(o1[0], o1[1]), cvtpk(o1[2], o1[3])}, w2 = {cvtpk(o2[0], o2[1]), cvtpk(o2[2], o2[3])};
      if (r >= CTXL && !dry) { *(u32x2*)(rowp + hh * 128 + e1) = w1; *(u32x2*)(rowp + hh * 128 + e2) = w2; }
      if (hb >= 16) {
        const unsigned q1 = pack8x4(o1[0], o1[1], o1[2], o1[3]), q2 = pack8x4(o2[0], o2[1], o2[2], o2[3]);
        unsigned char* k8p = K8 + (size_t)r * 2048 + (hh - 16) * 128;
        *(unsigned*)(k8p + e1) = q1; *(unsigned*)(k8p + e2) = q2;
        float so = sum16lanes(sq8x4(q1) + sq8x4(q2));
        if (l16 == 0) atomicMax((unsigned*)&lk[hh - 16], __float_as_uint(so));
      }
    }
  }
  __syncthreads();
  if (tid < 16) atomicMax(&kmx[tid], lk[tid]);
  __syncthreads();
}

__device__ __forceinline__ void phase_attn(const Args& a, int L, LAS char* lds) {
  const bf16_t* Q = (const bf16_t*)(a.ws + WS_QKVU);
  const unsigned* kmx = (const unsigned*)(a.ws + WS_CTL + CTL_KMAX) + L * 16;
  if (L == 0) {
    bf16_t* X2 = (bf16_t*)(a.ws + WS_X2);
    for (int u = blockIdx.x; u < 520; u += gridDim.x) {
      const int head = u < 512 ? (u & 7) : (u - 512);
      const float kmax2 = __uint_as_float(kmx[head >> 2]);
      if (u < 512) { const int qb = u >> 3; const size_t q0 = (size_t)(CTXL + qb * 256);
        at::attn_body(Q + q0 * N_QKV0 + head * 128, N_QKV0, Q + 1024 + (head >> 2) * 128, Q + 1280 + (head >> 2) * 128, N_QKV0, X2 + q0 * D + head * 128, D, MT, kmax2, lds);
      } else {
        at::attn_body(Q + head * 128, N_QKV0, Q + 1024 + (head >> 2) * 128, Q + 1280 + (head >> 2) * 128, N_QKV0, X2 + head * 128, D, CTXL, kmax2, lds); }
    }
  } else {
    bf16_t* O = (bf16_t*)(a.ws + WS_Y);
    for (int u = blockIdx.x; u < 1024; u += gridDim.x) {
      const int x = u & 7, w = u >> 3, hc = x + 8 * (w >> 6), qb = w & 63, h = hc >> 1;
      const float kmax2 = __uint_as_float(kmx[hc]);
      const size_t q0 = (size_t)(CTXL + qb * 256);
      at::attn_body_c256q8(Q + q0 * N_IN1 + hc * 128, N_IN1, (const unsigned char*)(a.ws + WS_K8) + hc * 128, 2048, Q + 4096 + h * 256, N_IN1,
                           O + (size_t)(qb * 256) * 4096 + hc * 256, 4096, MT, kmax2, lds);
    }
  }
}

__device__ __forceinline__ void phase_diff(const Args& a) {
  int tid = threadIdx.x; asm volatile("" : "+v"(tid)); tid &= 511; const int wave = tid >> 6, lane = tid & 63;
  const bf16_t* O = (const bf16_t*)(a.ws + WS_Y);
  bf16_t* X2 = (bf16_t*)(a.ws + WS_X2);
  const float* lp = a.in[17];
  const float s1 = wave_sum(lp[lane] * lp[128 + lane] + lp[64 + lane] * lp[192 + lane]);
  const float s2 = wave_sum(lp[256 + lane] * lp[384 + lane] + lp[320 + lane] * lp[448 + lane]);
  const float lam = expf(s1) - expf(s2) + LAM_INIT;
  const f32x4 sg = *(const f32x4*)(a.in[18] + 4 * lane);
  for (int it = blockIdx.x; it < SEQ / 8; it += gridDim.x) {
    const int t = it * 8 + wave;
    const bf16_t* op = O + (size_t)t * 4096;
    bf16_t* xp = X2 + (size_t)(CTXL + t) * D;
#pragma unroll 2
    for (int h = 0; h < 8; ++h) {
      const u32x2 a0 = *(const u32x2*)(op + (2 * h) * 256 + 4 * lane), a1 = *(const u32x2*)(op + (2 * h + 1) * 256 + 4 * lane);
      float d[4] = {bflo(a0[0]) - lam * bflo(a1[0]), bfhi(a0[0]) - lam * bfhi(a1[0]), bflo(a0[1]) - lam * bflo(a1[1]), bfhi(a0[1]) - lam * bfhi(a1[1])};
      const float ss = wave_sum(d[0] * d[0] + d[1] * d[1] + d[2] * d[2] + d[3] * d[3]);
      const float rstd = rsqrtf(ss * (1.f / 256) + EPS) * (1.f - LAM_INIT);
      u32x2 pk = {cvtpk(d[0] * rstd * sg[0], d[1] * rstd * sg[1]), cvtpk(d[2] * rstd * sg[2], d[3] * rstd * sg[3])};
      *(u32x2*)(xp + h * 256 + 4 * lane) = pk;
    }
  }
}

__device__ __forceinline__ void phase_G(const Args& a, int L, LAS char* lds, bool dry = false) {
  int tid = threadIdx.x; asm volatile("" : "+v"(tid)); tid &= 511; const int wave = tid >> 6, lane = tid & 63;
  const int NTOK = L == 0 ? MT : SEQ, ROW0 = L == 0 ? 0 : CTXL;
  const float* ng = a.in[6] + (size_t)L * 4 * D;
  const float* MODL = (const float*)(a.ws + WS_MOD) + (size_t)(L * 2) * 12288;
  const float* router = a.in[19] + (size_t)L * D * NE; const float* rbias = a.in[20] + L * NE;
  const bf16_t* OUT = (const bf16_t*)(a.ws + WS_OUT);
  float* HRES = (float*)(a.ws + WS_HRES);
  bf16_t* F = (bf16_t*)(a.ws + WS_ABUF);
  int* counts = (int*)(a.ws + WS_CTL + CTL_CNT) + L * 64;
  int* top_e = (int*)(a.ws + WS_TOPE); float* top_w = (float*)(a.ws + WS_TOPW); int* top_p = (int*)(a.ws + WS_TOPP);
  LAS float* ft = (LAS float*)lds;
  LAS float* part = ft + 8 * D;
  for (int it = blockIdx.x; it < NTOK / 8; it += gridDim.x) {
    const int r = ROW0 + it * 8 + wave;
    const float* mod = MODL + (r < CTXL ? 12288 : 0);
    {
      float o[32], h[32];
      ld_row_bf16(OUT + (size_t)r * D, lane, o);
      const float* hp = L == 0 ? (r < CTXL ? a.in[2] + (size_t)r * D : a.in[0] + (size_t)(r - CTXL) * D) : HRES + (size_t)r * D;
      ld_row_f32(hp, lane, h);
      const float rstd1 = rsqrtf(sumsq32(o) * (1.f / D) + EPS);
#pragma unroll
      for (int j = 0; j < 4; ++j) { const int idx = 8 * lane + 512 * j;
        float g1[8], gt[8]; ld8f(ng + D + idx, g1); ld8f(mod + 2 * D + idx, gt);
#pragma unroll
        for (int i = 0; i < 8; ++i) h[8 * j + i] += gt[i] * (o[8 * j + i] * rstd1 * g1[i]);
        if (!dry) st8f(HRES + (size_t)r * D + idx, &h[8 * j]); }
      const float rstd2 = rsqrtf(sumsq32(h) * (1.f / D) + EPS);
      modulate_store<true, true>(h, rstd2, ng + 2 * D, mod + 3 * D, mod + 4 * D, (bf16_t*)((unsigned char*)F + (size_t)r * D), lane, ft + wave * D);
    }
    __syncthreads();
    float acc[8] = {0, 0, 0, 0, 0, 0, 0, 0};
    const int d0 = wave * 256;
#pragma unroll 2
    for (int dd = 0; dd < 256; dd += 4) {
      const float* rp = router + (size_t)(d0 + dd) * NE + lane;
      const float r0 = rp[0], r1 = rp[NE], r2 = rp[2 * NE], r3 = rp[3 * NE];
#pragma unroll
      for (int t = 0; t < 8; ++t) { const f32x4 fv = *(LAS const f32x4*)(ft + t * D + d0 + dd); acc[t] += fv[0] * r0 + fv[1] * r1 + fv[2] * r2 + fv[3] * r3; }
    }
#pragma unroll
    for (int t = 0; t < 8; ++t) part[(wave * 8 + t) * 64 + lane] = acc[t];
    __syncthreads();
    float logit = 0;
#pragma unroll
    for (int w = 0; w < 8; ++w) logit += part[(w * 8 + wave) * 64 + lane];
#if MK_DIAG
    ((float*)(a.ws + WS_Y))[(size_t)r * 64 + lane] = logit;
#endif
    const float score = sigmoidf_(logit);
    const float choice = score + rbias[lane];
    int rank = 0; const int gl = lane & 7;
#pragma unroll
    for (int j = 0; j < 8; ++j) { const float o = __shfl(choice, (lane & ~7) | j); rank += (o > choice || (o == choice && j < gl)) ? 1 : 0; }
    float gs = rank < 2 ? choice : 0.f;
    gs += __shfl_xor(gs, 1); gs += __shfl_xor(gs, 2); gs += __shfl_xor(gs, 4);
    int grank = 0; const int g = lane >> 3;
#pragma unroll
    for (int j = 0; j < 8; ++j) { const float o = __shfl(gs, j * 8); grank += (o > gs || (o == gs && j < g)) ? 1 : 0; }
    const bool gsel = grank < 4;
    const float mc = gsel ? choice : -INFINITY;
    int erank = 0;
#pragma unroll 4
    for (int j = 0; j < 64; ++j) { const float o = __int_as_float(__builtin_amdgcn_readlane(__float_as_int(mc), j)); erank += (o > mc || (o == mc && j < lane)) ? 1 : 0; }
    const bool sel = gsel && erank < 8;
    const unsigned long long bal = __ballot(sel);
    const int idx = __popcll(bal & ((1ull << lane) - 1ull));
    const float ssum = wave_sum(sel ? score : 0.f);
    if (sel && !dry) { const int pos = atomicAdd(&counts[lane], 1);
      top_e[r * 8 + idx] = lane; top_w[r * 8 + idx] = score / ssum * 2.5f; top_p[r * 8 + idx] = pos; }
  }
}

__device__ __forceinline__ void moe_tile_prefix(const int* counts, LAS int* ts) {
  if (threadIdx.x == 0) { int s = 0; for (int e = 0; e < 64; ++e) { ts[e] = s; s += (counts[e] + 255) >> 8; } ts[64] = s; }
  __syncthreads();
}
__device__ __forceinline__ void phase_H(const Args& a, int L, LAS char* lds) {
  const int NTOK = L == 0 ? MT : SEQ, ROW0 = L == 0 ? 0 : CTXL;
  const int* counts = (const int*)(a.ws + WS_CTL + CTL_CNT) + L * 64;
  const int* top_e = (const int*)(a.ws + WS_TOPE); const int* top_p = (const int*)(a.ws + WS_TOPP);
  int* tslot = (int*)(a.ws + WS_TSLOT); int* stok = (int*)(a.ws + WS_STOK);
  LAS int* ts = (LAS int*)lds;
  moe_tile_prefix(counts, ts);
  int tid = threadIdx.x; asm volatile("" : "+v"(tid)); tid &= 511;
  const int gt = blockIdx.x * NTHREADS + tid, gs = gridDim.x * NTHREADS;
  for (int i = gt; i < NTOK * 8; i += gs) { const int q = ROW0 * 8 + i; const int e = top_e[q]; const int slot = ts[e] * 256 + top_p[q]; stok[slot] = q >> 3; tslot[q] = slot; }
  for (int i = gt; i < 64 * 256; i += gs) { const int e = i >> 8, p = i & 255, cnt = counts[e], nt = (cnt + 255) >> 8; if (cnt + p < nt * 256) stok[ts[e] * 256 + cnt + p] = ROW0; }
  for (int i = gt; i < NTOK; i += gs) stok[SH_BASE + i] = ROW0 + i;
  __syncthreads();
}
struct MoeSched {
  LAS const int* ts; int TR, NN, total; const unsigned char* W; size_t woff;
  __device__ __forceinline__ bool unit(int i, int& slot0, const unsigned char*& Bt, int& bcol) const {
    for (int u = blockIdx.x + i * (int)gridDim.x; ; u += gridDim.x) {
      const int rnd = u >> 8, b = u & 255, v = rnd * 256 + (b & 7) * 32 + (b >> 3);
      if (rnd * 256 >= total) return false;
      if (v >= total) return false;
      const int m = v / NN, pn = v % NN;
      int e;
      if (m >= TR) { e = 64; slot0 = SH_BASE + 256 * (m - TR); } else { e = 0; while (ts[e + 1] <= m) ++e; slot0 = 256 * m; }
      Bt = W + (size_t)e * WMOE8_E + woff; bcol = pn * 256;
      return true;
    }
  }
};
__device__ __forceinline__ void phase_moe_up(const Args& a, int L, LAS char* lds) {
  const int NSH = L == 0 ? MT / 256 : SEQ / 256;
  const int* counts = (const int*)(a.ws + WS_CTL + CTL_CNT) + L * 64;
  LAS int* ts = (LAS int*)(lds + LDS_CTL + 64);
  moe_tile_prefix(counts, ts);
  const int TR = ts[64], TM = TR + NSH;
  const unsigned char* F = (const unsigned char*)(a.ws + WS_ABUF); const unsigned char* W = (const unsigned char*)(a.ws + WS_WMOE) + (size_t)L * 65 * WMOE8_E;
  const int* stok = (const int*)(a.ws + WS_STOK);
  EpiSwiGLU8 epi{(unsigned char*)(a.ws + WS_ACT), EFF};
  MoeSched sc{ts, TR, 4, TM * 4, W, 0};
  gemm8_run<true, D, D, D>(F, stok, lds, epi, sc);
}
__device__ __forceinline__ void phase_moe_down(const Args& a, int L, LAS char* lds) {
  const int NSH = L == 0 ? MT / 256 : SEQ / 256;
  const int* counts = (const int*)(a.ws + WS_CTL + CTL_CNT) + L * 64;
  LAS int* ts = (LAS int*)(lds + LDS_CTL + 64);
  moe_tile_prefix(counts, ts);
  const int TR = ts[64], TM = TR + NSH;
  const unsigned char* ACT = (const unsigned char*)(a.ws + WS_ACT); const unsigned char* W = (const unsigned char*)(a.ws + WS_WMOE) + (size_t)L * 65 * WMOE8_E;
  EpiPlainS epi{(bf16_t*)(a.ws + WS_Y), D, 1.f / 128.f};
  MoeSched sc{ts, TR, 8, TM * 8, W, (size_t)1024 * D};
  gemm8_run<false, EFF, EFF, EFF>(ACT, nullptr, lds, epi, sc);
}
__device__ __forceinline__ void phase_combine(const Args& a, int L, bool dry = false) {
  int tid = threadIdx.x; asm volatile("" : "+v"(tid)); tid &= 511; const int wave = tid >> 6, lane = tid & 63;
  const int NTOK = L == 0 ? MT : SEQ, ROW0 = L == 0 ? 0 : CTXL;
  const float* ng = a.in[6] + (size_t)L * 4 * D;
  const float* MODL = (const float*)(a.ws + WS_MOD) + (size_t)(L * 2) * 12288;
  const bf16_t* Y = (const bf16_t*)(a.ws + WS_Y);
  float* HRES = (float*)(a.ws + WS_HRES);
  const int* tslot = (const int*)(a.ws + WS_TSLOT); const float* top_w = (const float*)(a.ws + WS_TOPW);
  for (int it = blockIdx.x; it < NTOK / 8; it += gridDim.x) {
    const int r = ROW0 + it * 8 + wave;
    const float* mod = MODL + (r < CTXL ? 12288 : 0);
    float y[32];
    { float t[32]; ld_row_bf16(Y + (size_t)(SH_BASE + r - ROW0) * D, lane, t);
#pragma unroll
      for (int i = 0; i < 32; ++i) y[i] = t[i]; }
#pragma unroll 4
    for (int k = 0; k < 8; ++k) { const int slot = tslot[r * 8 + k]; const float w = top_w[r * 8 + k];
      float t[32]; ld_row_bf16(Y + (size_t)slot * D, lane, t);
#pragma unroll
      for (int i = 0; i < 32; ++i) y[i] += w * t[i]; }
    const float rstd = rsqrtf(sumsq32(y) * (1.f / D) + EPS);
    float h[32]; ld_row_f32(HRES + (size_t)r * D, lane, h);
#pragma unroll
    for (int j = 0; j < 4; ++j) { const int idx = 8 * lane + 512 * j;
      float g3[8], gt[8]; ld8f(ng + 3 * D + idx, g3); ld8f(mod + 5 * D + idx, gt);
#pragma unroll
      for (int i = 0; i < 8; ++i) h[8 * j + i] += gt[i] * (y[8 * j + i] * rstd * g3[i]);
      if (L == 0) { if (!dry) st8f(HRES + (size_t)r * D + idx, &h[8 * j]); } else st8f(a.out + (size_t)(r - CTXL) * D + idx, &h[8 * j]); }
    if (L == 0) {
      const float* mod1 = MODL + 2 * 12288 + (r < CTXL ? 12288 : 0);
      const float rstd2 = rsqrtf(sumsq32(h) * (1.f / D) + EPS);
      modulate_store<false>(h, rstd2, a.in[6] + (size_t)4 * D, mod1, mod1 + D, (bf16_t*)(a.ws + WS_ABUF) + (size_t)r * D, lane, nullptr);
    }
  }
}

constexpr int NPH = 21;
typedef const __attribute__((address_space(4))) Args* ArgsP;
#if defined(__HIP_DEVICE_COMPILE__)
#define FRESH_ARGS() const Args a = *({ ArgsP _p = (ArgsP)__builtin_amdgcn_kernarg_segment_ptr(); asm volatile("" : "+s"(_p)); _p; })
#else
#define FRESH_ARGS() const Args a = kargs
#endif
__global__ void __launch_bounds__(NTHREADS, 2) fwd(Args kargs) {
  extern __shared__ __attribute__((aligned(16))) unsigned char lds_raw[];
  LAS char* lds = (LAS char*)lds_raw;
  const int lo = kargs.ph_lo, hi = kargs.ph_hi;
  if (threadIdx.x < 64) ((LAS unsigned*)(lds + LDS_CTL))[threadIdx.x] = 0u;
  __syncthreads();
  if (hi - lo > 1) (void)xcd_barrier_post((unsigned*)(kargs.ws + WS_CTL), (volatile LAS unsigned*)(lds + LDS_CTL));
#ifndef PHASE_MASK
#define PHASE_MASK 0xFFFFFFFFu
#endif
#define IN(k) (((PHASE_MASK >> (k)) & 1u) && lo <= (k) && (k) < hi)
#ifndef PH_REPEAT_MASK
#define PH_REPEAT_MASK 0u
#endif
#define REP(k) for (int _rep = 0; _rep < (((PH_REPEAT_MASK >> (k)) & 1u) ? 2 : 1); ++_rep)
#define SEAM(k) do { if ((k) + 1 < hi) { XcdBarrier _b; _b.bar = (unsigned*)(a.ws + WS_CTL); _b.x = xb_xcc_id(); _b.st = (volatile LAS unsigned*)(lds + LDS_CTL); xcd_barrier(_b); } } while (0)

  if (IN(0)) { FRESH_ARGS(); REP(0) phase_prologue(a, lds); SEAM(0); }
  if (IN(1)) { FRESH_ARGS(); REP(1) phase_modulate0(a); SEAM(1); }
#pragma unroll
  for (int L = 0; L < 2; ++L) {
    const int base = 2 + (L == 0 ? 0 : 9);
    if (IN(base + 0)) {
      FRESH_ARGS();
      const bf16_t* A = (const bf16_t*)(a.ws + WS_ABUF);
      const bf16_t* Bt = (const bf16_t*)(a.ws + (L == 0 ? WS_WIN0 : WS_WIN1));
      const int nN = L == 0 ? N_IN0 / 256 : N_IN1 / 256, nM = MT / 256;
      EpiG1 epi{EpiPlain{(bf16_t*)(a.ws + WS_QKVU), L == 0 ? N_QKV0 : N_IN1}, EpiPair<0>{(bf16_t*)(a.ws + WS_HG), 1024, N_QKV0}, L == 0 ? N_QKV0 : N_IN1};
      REP(2) for (int u = blockIdx.x; u < nM * nN; u += gridDim.x) { int pm, pn; dense_unit(u, nM, nN, pm, pn);
        gemm_tile<false>(A, D, nullptr, pm * 256, Bt, D, pn * 256, D, lds, epi); }
      SEAM(base + 0);
    }
    if (L == 0) {
      if (IN(3)) { FRESH_ARGS(); if ((PH_REPEAT_MASK >> 3) & 1u) { phase_rope_conv0(a, lds, true); __syncthreads(); } phase_rope_conv0(a, lds); SEAM(3); }
      if (IN(4)) { FRESH_ARGS(); REP(4) phase_attn(a, 0, lds); SEAM(4); }
    } else {
      if (IN(12)) { FRESH_ARGS(); if ((PH_REPEAT_MASK >> 12) & 1u) { phase_rope1(a, lds, true); __syncthreads(); } phase_rope1(a, lds); SEAM(12); }
      if (IN(13)) { FRESH_ARGS(); REP(13) phase_attn(a, 1, lds); SEAM(13); }
      if (IN(14)) { FRESH_ARGS(); REP(14) phase_diff(a); SEAM(14); }
    }
    const int b2 = L == 0 ? 5 : 15;
    if (IN(b2 + 0)) {
      FRESH_ARGS();
      const bf16_t* A = (const bf16_t*)(a.ws + WS_X2);
      const bf16_t* Bt = (const bf16_t*)(a.ws + (L == 0 ? WS_WOUT0 : WS_WOUT1));
      const int nN = D / 256, nM = L == 0 ? MT / 256 : SEQ / 256, r0 = L == 0 ? 0 : CTXL;
      EpiPlain epi{(bf16_t*)(a.ws + WS_OUT), D};
      REP(5) for (int u = blockIdx.x; u < nM * nN; u += gridDim.x) { int pm, pn; dense_unit(u, nM, nN, pm, pn);
        gemm_tile<false>(A, D, nullptr, r0 + pm * 256, Bt, D, pn * 256, D, lds, epi); }
      SEAM(b2 + 0);
    }
    if (IN(b2 + 1)) { FRESH_ARGS(); if ((PH_REPEAT_MASK >> 6) & 1u) { phase_G(a, L, lds, true); __syncthreads(); } phase_G(a, L, lds); SEAM(b2 + 1); }
    if (IN(b2 + 2)) { FRESH_ARGS(); REP(7) phase_H(a, L, lds); SEAM(b2 + 2); }
    if (IN(b2 + 3)) { FRESH_ARGS(); REP(8) phase_moe_up(a, L, lds); SEAM(b2 + 3); }
    if (IN(b2 + 4)) { FRESH_ARGS(); REP(9) phase_moe_down(a, L, lds); SEAM(b2 + 4); }
    if (IN(b2 + 5)) { FRESH_ARGS(); if ((PH_REPEAT_MASK >> 10) & 1u) phase_combine(a, L, true); phase_combine(a, L); SEAM(b2 + 5); }
  }
#undef IN
#undef SEAM
}

#ifndef MK_DIAG
#define MK_DIAG 0
#endif
#if MK_DIAG
__device__ __forceinline__ void rope_cs(int r, int lane, float& cs, float& sn) {
  cs = 1.f; sn = 0.f;
  if (r >= CTXL) { const int t = r - CTXL; const int a = lane >> 5, i = lane & 31;
    const float pos = a ? (float)(t & 63) : (float)(t >> 6);
    const float inv = powf(10000.f, -(float)i / 32.f);
    sincosf(pos * inv, &sn, &cs); }
}
__device__ __forceinline__ bool dclose(float got, float ref, float rtol, float atol) { return fabsf(got - ref) <= rtol * fabsf(ref) + atol; }
__device__ __forceinline__ unsigned dhash(unsigned x) { x ^= x >> 16; x *= 0x7feb352du; x ^= x >> 15; x *= 0x846ca68bu; x ^= x >> 16; return x; }
__device__ float wdot(const bf16_t* arow, const float* W, int ldw, int col, int K, int lane) {
  float s = 0; for (int k = lane; k < K; k += 64) s += bf2f(arow[k]) * W[(size_t)k * ldw + col]; return wave_sum(s); }
__device__ float dq8(const unsigned char* p, size_t i) { const unsigned w = ((const unsigned*)p)[i >> 2]; const int b = (int)(i & 3);
  return b == 0 ? __builtin_amdgcn_cvt_f32_fp8((int)w, 0) : b == 1 ? __builtin_amdgcn_cvt_f32_fp8((int)w, 1) : b == 2 ? __builtin_amdgcn_cvt_f32_fp8((int)w, 2) : __builtin_amdgcn_cvt_f32_fp8((int)w, 3); }
__device__ float wdot8(const unsigned char* arow8, const float* W, int ldw, int col, int K, int lane) {
  float s = 0; for (int k = lane; k < K; k += 64) s += dq8(arow8, k) * W[(size_t)k * ldw + col]; return wave_sum(s); }
__device__ void dflag(int* dg, int s, int bad, int lane) { if (lane == 0 && bad) atomicAdd(&dg[s], bad); }
__device__ const float* h0row(const Args& a, int r) { return r < CTXL ? a.in[2] + (size_t)r * D : a.in[0] + (size_t)(r - CTXL) * D; }
__device__ int pick_row(unsigned h, int lo, int n) { const unsigned m = h % 8; if (m == 0) return lo; if (m == 1) return lo + n - 1; if (m == 2) return lo + 255 < lo + n ? lo + 255 : lo; if (m == 3) return lo + 256 < lo + n ? lo + 256 : lo; return lo + (int)((h >> 3) % (unsigned)n); }
__device__ void naive_attn(const bf16_t* q, const bf16_t* K, const bf16_t* V, int ld, int nkeys, int lane, float& o0, float& o1) {
  const float q0 = bf2f(q[lane]), q1 = bf2f(q[lane + 64]);
  float m = -1e30f, l = 0; o0 = 0; o1 = 0;
  for (int k = 0; k < nkeys; ++k) {
    const float s = wave_sum(q0 * bf2f(K[(size_t)k * ld + lane]) + q1 * bf2f(K[(size_t)k * ld + lane + 64])) * 0.088388347648318440f;
    const float mn = fmaxf(m, s), al = expf(m - mn), p = expf(s - mn);
    l = l * al + p; o0 = o0 * al + p * bf2f(V[(size_t)k * ld + lane]); o1 = o1 * al + p * bf2f(V[(size_t)k * ld + lane + 64]); m = mn;
  }
  o0 /= l; o1 /= l;
}
__global__ void __launch_bounds__(256) diag(Args a, int k) {
  __shared__ float fsh[4][2048];
  __shared__ float csh[4][64];
  const int lane = threadIdx.x & 63, wv = threadIdx.x >> 6, gw = blockIdx.x * 4 + wv;
  int* dg = (int*)(a.ws + WS_CTL + CTL_CNT + 512);
  const float* MOD = (const float*)(a.ws + WS_MOD);
  const bf16_t* AB = (const bf16_t*)(a.ws + WS_ABUF);
  const bf16_t* QK = (const bf16_t*)(a.ws + WS_QKVU);
  const bf16_t* HG = (const bf16_t*)(a.ws + WS_HG);
  const bf16_t* X2 = (const bf16_t*)(a.ws + WS_X2);
  const bf16_t* OUT = (const bf16_t*)(a.ws + WS_OUT);
  const bf16_t* ACT = (const bf16_t*)(a.ws + WS_ACT);
  const bf16_t* Y = (const bf16_t*)(a.ws + WS_Y);
  const float* HRES = (const float*)(a.ws + WS_HRES);
  const int* top_e = (const int*)(a.ws + WS_TOPE); const float* top_w = (const float*)(a.ws + WS_TOPW); const int* top_p = (const int*)(a.ws + WS_TOPP);
  const int* tslot = (const int*)(a.ws + WS_TSLOT); const int* stok = (const int*)(a.ws + WS_STOK);
  const unsigned h = dhash(gw * 7919u + k * 104729u + 17u), h2 = dhash(h + 12345u);
  int bad = 0;
  const int L = k >= 11 ? 1 : 0;
  const int NTOK = L == 0 ? MT : SEQ, ROW0 = L == 0 ? 0 : CTXL;
  const int* counts = (const int*)(a.ws + WS_CTL + CTL_CNT) + L * 64;
  if (k == 0) {
    const int LL = gw & 1, which = (gw >> 1) & 1, j = h % 12288;
    const float* v = which ? a.in[3] : a.in[1];
    float s = 0; for (int d = lane; d < D; d += 64) { const float x = v[d]; s += x * sigmoidf_(x) * a.in[4][((size_t)LL * D + d) * 12288 + j]; }
    s = wave_sum(s) + a.in[5][LL * 12288 + j];
    bad = !dclose(MOD[(LL * 2 + which) * 12288 + j], s, 1e-3f, 1e-3f); dflag(dg, 1, bad, lane);
  } else if (k == 1) {
    const int r = pick_row(h, 0, MT); const float* x = h0row(a, r); const float* mod = MOD + (r < CTXL ? 12288 : 0);
    float ss = 0; for (int d = lane; d < D; d += 64) ss += x[d] * x[d]; ss = wave_sum(ss); const float rstd = rsqrtf(ss / D + EPS);
    for (int d = lane; d < D; d += 64) { const float ref = x[d] * rstd * a.in[6][d] * (1.f + mod[D + d]) + mod[d]; bad += !dclose(bf2f(AB[(size_t)r * D + d]), ref, 0.01f, 0.01f); }
    bad = (int)wave_sum((float)bad); dflag(dg, 2, bad, lane);
  } else if (k == 2 || k == 11) {
    const int r = pick_row(h, 0, MT);
    if (L == 0) {
      const int c = h2 % N_QKV0; const float ref = wdot(AB + (size_t)r * D, a.in[7], N_IN0, c, D, lane);
      bad = !dclose(bf2f(QK[(size_t)r * N_QKV0 + c]), ref, 0.02f, 0.05f); dflag(dg, 3, bad, lane);
      const int ch = (h2 >> 11) % 1024; const float av = wdot(AB + (size_t)r * D, a.in[7], N_IN0, N_QKV0 + ch, D, lane), gv = wdot(AB + (size_t)r * D, a.in[7], N_IN0, N_QKV0 + 1024 + ch, D, lane);
      bad = !dclose(bf2f(HG[(size_t)r * 1024 + ch]), av * sigmoidf_(gv), 0.03f, 0.05f); dflag(dg, 4, bad, lane);
    } else {
      const int c = h2 % N_IN1; const float ref = wdot(AB + (size_t)r * D, a.in[15], N_IN1, c, D, lane);
      bad = !dclose(bf2f(QK[(size_t)r * N_IN1 + c]), ref, 0.02f, 0.05f); dflag(dg, 15, bad, lane);
    }
  } else if (k == 3) {
    { const int r = pick_row(h, 0, MT), hh = h2 % 10; const float* g = hh < 8 ? a.in[9] : a.in[10];
      float raw0 = 0, raw1 = 0;
      for (int d = 0; d < 128; ++d) { const float v = wdot(AB + (size_t)r * D, a.in[7], N_IN0, hh * 128 + d, D, lane); if (d == lane) raw0 = v; if (d == lane + 64) raw1 = v; }
      const float rstd = rsqrtf(wave_sum(raw0 * raw0 + raw1 * raw1) / 128.f + EPS);
      const float y0 = raw0 * rstd * g[lane], y1 = raw1 * rstd * g[lane + 64];
      float cs, sn; rope_cs(r, lane, cs, sn);
      const float cs0 = __shfl(cs, lane & 31), sn0 = __shfl(sn, lane & 31), cs1 = __shfl(cs, 32 + (lane & 31)), sn1 = __shfl(sn, 32 + (lane & 31));
      const float p0 = __shfl_xor(y0, 32), p1 = __shfl_xor(y1, 32);
      const float o0 = (lane < 32) ? y0 * cs0 - p0 * sn0 : y0 * cs0 + p0 * sn0;
      const float o1 = (lane < 32) ? y1 * cs1 - p1 * sn1 : y1 * cs1 + p1 * sn1;
      bad = !dclose(bf2f(QK[(size_t)r * N_QKV0 + hh * 128 + lane]), o0, 0.03f, 0.05f) + !dclose(bf2f(QK[(size_t)r * N_QKV0 + hh * 128 + 64 + lane]), o1, 0.03f, 0.05f);
      bad = (int)wave_sum((float)bad); dflag(dg, 5, bad, lane); }
    { const int r = pick_row(h2, 0, MT); const int seg0 = r < CTXL ? 0 : CTXL, seg1 = r < CTXL ? CTXL : MT;
      float cv[16]; float s1 = 0, s2 = 0;
      for (int q = 0; q < 16; ++q) { const int c = lane + 64 * q; float acc = a.in[12][c];
        for (int j = 0; j < 31; ++j) { const int rr = r + j - 15; if (rr >= seg0 && rr < seg1) acc += bf2f(HG[(size_t)rr * 1024 + c]) * a.in[11][j * 1024 + c]; }
        cv[q] = acc; s1 += acc; s2 += acc * acc; }
      s1 = wave_sum(s1); s2 = wave_sum(s2); const float mean = s1 / 1024.f, rstd = rsqrtf(s2 / 1024.f - mean * mean + EPS);
      bad = 0;
      for (int q = 0; q < 16; ++q) { const int c = lane + 64 * q; float y = (cv[q] - mean) * rstd * a.in[13][c] + a.in[14][c]; y = y * sigmoidf_(y);
        bad += !dclose(bf2f(X2[(size_t)r * D + 1024 + c]), y, 0.03f, 0.03f); }
      bad = (int)wave_sum((float)bad); dflag(dg, 6, bad, lane); }
  } else if (k == 4) {
    if (gw < 64) { const int r = pick_row(h, 0, MT), head = h2 % 8; const int nkeys = r < CTXL ? CTXL : MT;
      float o0, o1; naive_attn(QK + (size_t)r * N_QKV0 + head * 128, QK + 1024 + (head >> 2) * 128, QK + 1280 + (head >> 2) * 128, N_QKV0, nkeys, lane, o0, o1);
      bad = !dclose(bf2f(X2[(size_t)r * D + head * 128 + lane]), o0, 0.05f, 0.01f) + !dclose(bf2f(X2[(size_t)r * D + head * 128 + 64 + lane]), o1, 0.05f, 0.01f);
      bad = (int)wave_sum((float)bad); dflag(dg, 7, bad, lane); }
  } else if (k == 5 || k == 15) {
    const int r = pick_row(h, ROW0, NTOK), c = h2 % D; const float ref = wdot(X2 + (size_t)r * D, L == 0 ? a.in[8] : a.in[16], D, c, D, lane);
    bad = !dclose(bf2f(OUT[(size_t)r * D + c]), ref, 0.02f, 0.05f); dflag(dg, L == 0 ? 8 : 19, bad, lane);
  } else if (k == 6 || k == 16) {
    const int r = pick_row(h, ROW0, NTOK); const float* mod = MOD + (size_t)(L * 2) * 12288 + (r < CTXL ? 12288 : 0); const float* ng = a.in[6] + (size_t)L * 4 * D;
    float ss = 0; for (int d = lane; d < D; d += 64) { const float o = bf2f(OUT[(size_t)r * D + d]); ss += o * o; } ss = wave_sum(ss); const float rstd1 = rsqrtf(ss / D + EPS);
    bad = 0;
    if (L == 0) { const float* x = h0row(a, r); for (int d = lane; d < D; d += 64) { const float ref = x[d] + mod[2 * D + d] * (bf2f(OUT[(size_t)r * D + d]) * rstd1 * ng[D + d]); bad += !dclose(HRES[(size_t)r * D + d], ref, 1e-3f, 1e-3f); } }
    float s2 = 0; for (int d = lane; d < D; d += 64) { const float x = HRES[(size_t)r * D + d]; s2 += x * x; } s2 = wave_sum(s2); const float rstd2 = rsqrtf(s2 / D + EPS);
    for (int d = lane; d < D; d += 64) { const float f = HRES[(size_t)r * D + d] * rstd2 * ng[2 * D + d] * (1.f + mod[4 * D + d]) + mod[3 * D + d]; fsh[wv][d] = f; bad += !dclose(dq8((const unsigned char*)AB + (size_t)r * D, d), f, 0.07f, 0.01f); }
    bad = (int)wave_sum((float)bad); dflag(dg, L == 0 ? 9 : 20, bad, lane);
    __syncthreads();
    float lg = 0; for (int d = 0; d < D; ++d) lg += fsh[wv][d] * a.in[19][((size_t)L * D + d) * NE + lane];
    const float sc = sigmoidf_(lg); csh[wv][lane] = sc + a.in[20][L * NE + lane];
    __syncthreads();
    { const float plg = ((const float*)(a.ws + WS_Y))[(size_t)r * 64 + lane]; int lb = !dclose(plg, lg, 1e-3f, 1e-3f); lb = (int)wave_sum((float)lb); if (lane == 0 && lb) { atomicAdd(&dg[32 + (L == 0 ? 10 : 21) + 3], 1); atomicOr(&dg[60], 1 << (r & 7)); } }
    unsigned long long wsel;
    { const float choice = csh[wv][lane]; int rank = 0; const int gl = lane & 7;
      for (int j = 0; j < 8; ++j) { const float o = __shfl(choice, (lane & ~7) | j); rank += (o > choice || (o == choice && j < gl)) ? 1 : 0; }
      float gs = rank < 2 ? choice : 0.f; gs += __shfl_xor(gs, 1); gs += __shfl_xor(gs, 2); gs += __shfl_xor(gs, 4);
      int grank = 0; const int g = lane >> 3;
      for (int j = 0; j < 8; ++j) { const float o = __shfl(gs, j * 8); grank += (o > gs || (o == gs && j < g)) ? 1 : 0; }
      const bool gsel = grank < 4; const float mc = gsel ? choice : -INFINITY; int erank = 0;
      for (int j = 0; j < 64; ++j) { const float o = __shfl(mc, j); erank += (o > mc || (o == mc && j < lane)) ? 1 : 0; }
      wsel = __ballot(gsel && erank < 8); }
    int setbad = 0;
    if (lane == 0) {
      float gsc[8]; for (int g = 0; g < 8; ++g) { float m1 = -1e30f, m2 = -1e30f; for (int j = 0; j < 8; ++j) { const float v = csh[wv][g * 8 + j]; if (v > m1) { m2 = m1; m1 = v; } else if (v > m2) m2 = v; } gsc[g] = m1 + m2; }
      bool gs[8] = {false, false, false, false, false, false, false, false};
      for (int t = 0; t < 4; ++t) { int bi = 0; float bv = -1e30f; for (int g = 0; g < 8; ++g) if (!gs[g] && gsc[g] > bv) { bv = gsc[g]; bi = g; } gs[bi] = true; }
      unsigned long long selm = 0; for (int t = 0; t < 8; ++t) { int bi = 0; float bv = -1e30f; for (int e = 0; e < 64; ++e) if (gs[e >> 3] && !((selm >> e) & 1ull) && csh[wv][e] > bv) { bv = csh[wv][e]; bi = e; } selm |= 1ull << bi; }
      unsigned long long got = 0; for (int t = 0; t < 8; ++t) { const int e = top_e[r * 8 + t]; if (e < 0 || e > 63) setbad = 1000; else got |= 1ull << e; }
      if (setbad == 0 && got != selm) setbad = 1;
      if (wsel != selm) atomicAdd(&dg[32 + (L == 0 ? 10 : 21) + 4], 1);
    }
    setbad = __shfl(setbad, 0);
    { float wgot = -1.f; int mine = 0; for (int t = 0; t < 8; ++t) if (top_e[r * 8 + t] == lane) { mine = 1; wgot = top_w[r * 8 + t]; }
      const float ssum = wave_sum(mine ? sc : 0.f);
      int wbad = (mine && !dclose(wgot, sc / ssum * 2.5f, 0.01f, 1e-3f)) ? 1 : 0; wbad = (int)wave_sum((float)wbad);
      if (lane == 0) { int* q = &dg[32 + (L == 0 ? 10 : 21)]; if (setbad >= 1000) atomicAdd(q + 1, 1); else if (setbad) atomicAdd(q, 1); else if (wbad) atomicAdd(q + 2, 1); } }
  } else if (k == 7 || k == 17) {
    const int r = pick_row(h, ROW0, NTOK), t = h2 % 8, q = r * 8 + t; const int slot = tslot[q], e = top_e[q];
    int ts0 = 0; for (int j = 0; j < e; ++j) ts0 += (counts[j] + 255) >> 8;
    bad = (slot < ts0 * 256 || slot >= ts0 * 256 + counts[e] || stok[slot] != r || top_p[q] != slot - ts0 * 256) ? 1 : 0;
    bad += (stok[SH_BASE + r - ROW0] != r) ? 1 : 0;
    dflag(dg, L == 0 ? 11 : 22, bad, lane);
  } else if (k == 8 || k == 18 || k == 9 || k == 19) {
    int TR = 0; for (int j = 0; j < 64; ++j) TR += (counts[j] + 255) >> 8;
    int slot, e;
    if ((h & 3) == 0) { slot = SH_BASE + (int)((h >> 2) % (unsigned)NTOK); e = 64; }
    else { e = (h >> 2) % 64; int guard = 0; while (counts[e] == 0 && guard++ < 64) e = (e + 1) % 64; int ts0 = 0; for (int j = 0; j < e; ++j) ts0 += (counts[j] + 255) >> 8;
      const unsigned m = (h >> 8) % 4; const int cnt = counts[e]; const int p = m == 0 ? 0 : m == 1 ? cnt - 1 : (int)((h >> 10) % (unsigned)cnt); slot = ts0 * 256 + p; }
    const int tok = stok[slot];
    if (k == 8 || k == 18) {
      const int ch = h2 % EFF;
      const float* Wg = e < 64 ? a.in[21] + ((size_t)L * 64 + e) * D * EFF : a.in[24] + (size_t)L * D * EFF;
      const float* Wu = e < 64 ? a.in[22] + ((size_t)L * 64 + e) * D * EFF : a.in[25] + (size_t)L * D * EFF;
      const unsigned char* F8 = (const unsigned char*)AB + (size_t)tok * D;
      const float gv = wdot8(F8, Wg, EFF, ch, D, lane), uv = wdot8(F8, Wu, EFF, ch, D, lane);
      bad = !dclose(dq8((const unsigned char*)ACT + (size_t)slot * EFF, ch), gv * sigmoidf_(gv) * uv, 0.2f, 0.15f); dflag(dg, L == 0 ? 12 : 23, bad, lane);
    } else {
      const int c = h2 % D; const float* Wd = e < 64 ? a.in[23] + ((size_t)L * 64 + e) * EFF * D : a.in[26] + (size_t)L * EFF * D;
      const float ref = wdot8((const unsigned char*)ACT + (size_t)slot * EFF, Wd, D, c, EFF, lane);
      bad = !dclose(bf2f(Y[(size_t)slot * D + c]), ref, 0.15f, 0.15f); dflag(dg, L == 0 ? 13 : 24, bad, lane);
    }
  } else if (k == 10 || k == 20) {
    const int r = pick_row(h, ROW0, NTOK); const float* mod = MOD + (size_t)(L * 2) * 12288 + (r < CTXL ? 12288 : 0); const float* ng = a.in[6] + (size_t)L * 4 * D;
    float ss = 0; for (int d = lane; d < D; d += 64) { float y = bf2f(Y[(size_t)(SH_BASE + r - ROW0) * D + d]); for (int t = 0; t < 8; ++t) y += top_w[r * 8 + t] * bf2f(Y[(size_t)tslot[r * 8 + t] * D + d]); fsh[wv][d] = y; ss += y * y; }
    ss = wave_sum(ss); const float rstd = rsqrtf(ss / D + EPS);
    bad = 0;
    if (L == 0) { float s2 = 0; for (int d = lane; d < D; d += 64) { const float x = HRES[(size_t)r * D + d]; s2 += x * x; } s2 = wave_sum(s2); const float rstd2 = rsqrtf(s2 / D + EPS);
      const float* mod1 = MOD + (size_t)2 * 12288 + (r < CTXL ? 12288 : 0);
      for (int d = lane; d < D; d += 64) { const float ref = HRES[(size_t)r * D + d] * rstd2 * a.in[6][4 * D + d] * (1.f + mod1[D + d]) + mod1[d]; bad += !dclose(bf2f(AB[(size_t)r * D + d]), ref, 0.01f, 0.01f); } }
    else { for (int d = lane; d < D; d += 64) { const float ref = HRES[(size_t)r * D + d] + mod[5 * D + d] * (fsh[wv][d] * rstd * ng[3 * D + d]); bad += !dclose(a.out[(size_t)(r - CTXL) * D + d], ref, 1e-3f, 1e-3f); } }
    bad = (int)wave_sum((float)bad); dflag(dg, L == 0 ? 14 : 25, bad, lane);
  } else if (k == 12) {
    const int r = pick_row(h, CTXL, SEQ), hh = h2 % 32;
    float raw0 = 0, raw1 = 0;
    for (int d = 0; d < 128; ++d) { const float v = wdot(AB + (size_t)r * D, a.in[15], N_IN1, hh * 128 + d, D, lane); if (d == lane) raw0 = v; if (d == lane + 64) raw1 = v; }
    float cs, sn; rope_cs(r, lane, cs, sn);
    const float cs0 = __shfl(cs, lane & 31), sn0 = __shfl(sn, lane & 31), cs1 = __shfl(cs, 32 + (lane & 31)), sn1 = __shfl(sn, 32 + (lane & 31));
    const float p0 = __shfl_xor(raw0, 32), p1 = __shfl_xor(raw1, 32);
    const float o0 = (lane < 32) ? raw0 * cs0 - p0 * sn0 : raw0 * cs0 + p0 * sn0;
    const float o1 = (lane < 32) ? raw1 * cs1 - p1 * sn1 : raw1 * cs1 + p1 * sn1;
    bad = !dclose(bf2f(QK[(size_t)r * N_IN1 + hh * 128 + lane]), o0, 0.03f, 0.05f) + !dclose(bf2f(QK[(size_t)r * N_IN1 + hh * 128 + 64 + lane]), o1, 0.03f, 0.05f);
    bad = (int)wave_sum((float)bad); dflag(dg, 16, bad, lane);
  } else if (k == 13) {
    if (gw < 64) { const int r = pick_row(h, CTXL, SEQ), hc = h2 % 16, vh = (h2 >> 4) & 1, hd = hc >> 1;
      float o0, o1; naive_attn(QK + (size_t)r * N_IN1 + hc * 128, QK + 2048 + hc * 128, QK + 4096 + hd * 256 + vh * 128, N_IN1, MT, lane, o0, o1);
      const bf16_t* O = Y + (size_t)(r - CTXL) * 4096 + hc * 256 + vh * 128;
      bad = !dclose(bf2f(O[lane]), o0, 0.05f, 0.01f) + !dclose(bf2f(O[64 + lane]), o1, 0.05f, 0.01f);
      bad = (int)wave_sum((float)bad); dflag(dg, 17, bad, lane); }
  } else if (k == 14) {
    const int r = pick_row(h, CTXL, SEQ), hd = h2 % 8; const float* lp = a.in[17];
    float s1 = 0, s2 = 0; for (int i = lane; i < 128; i += 64) { s1 += lp[i] * lp[128 + i]; s2 += lp[256 + i] * lp[384 + i]; } s1 = wave_sum(s1); s2 = wave_sum(s2);
    const float lam = expf(s1) - expf(s2) + LAM_INIT; const bf16_t* O = Y + (size_t)(r - CTXL) * 4096;
    float dv[4], ss = 0; for (int i = 0; i < 4; ++i) { const int d = lane + 64 * i; dv[i] = bf2f(O[(2 * hd) * 256 + d]) - lam * bf2f(O[(2 * hd + 1) * 256 + d]); ss += dv[i] * dv[i]; }
    ss = wave_sum(ss); const float rstd = rsqrtf(ss / 256.f + EPS) * (1.f - LAM_INIT); bad = 0;
    for (int i = 0; i < 4; ++i) { const int d = lane + 64 * i; bad += !dclose(bf2f(X2[(size_t)r * D + hd * 256 + d]), dv[i] * rstd * a.in[18][d], 0.02f, 0.01f); }
    bad = (int)wave_sum((float)bad); dflag(dg, 18, bad, lane);
  }
}
__global__ void diag_encode(Args a) {
  const int* dg = (const int*)(a.ws + WS_CTL + CTL_CNT + 512);
  int s = 0;
  int sub = 0;
  for (int i = 1; i < 32; ++i) { int v = dg[i]; if (i == 10 || i == 21) { v = (dg[32 + i] > 25 ? 1 : 0) + (dg[33 + i] > 0 ? 2 : 0) + (dg[34 + i] > 0 ? 4 : 0) + (dg[35 + i] > 0 ? 8 : 0) + (dg[36 + i] > 0 ? 16 : 0); sub = v; } if (v) { s = i; break; } }
  if (s == 0) return;
  const float c = sub ? 30.f + 8.f * sub : 10.f * s;
  for (size_t i = (size_t)blockIdx.x * blockDim.x + threadIdx.x; i < (size_t)SEQ * D; i += (size_t)gridDim.x * blockDim.x) a.out[i] = c;
}
#endif

extern "C" void kernel_launch(void* const* d_in, const int* in_sizes, int n_in, void* d_out, int out_size, void* d_ws, size_t ws_size, hipStream_t stream) {
  static int grid = 0;
  if (grid == 0) {
    if (n_in != 27 || out_size != SEQ * D || ws_size < WS_END) { fprintf(stderr, "kernel_launch: unexpected shapes (n_in %d out %d ws %zu need %zu)\n", n_in, out_size, ws_size, (size_t)WS_END); grid = -1; return; }
    if (hipFuncSetAttribute((const void*)fwd, hipFuncAttributeMaxDynamicSharedMemorySize, LDS_BYTES) != hipSuccess) { fprintf(stderr, "kernel_launch: hipFuncSetAttribute failed\n"); grid = -1; return; }
    int dev = 0, cus = 0, per_cu = 0;
    hipGetDevice(&dev); hipDeviceGetAttribute(&cus, hipDeviceAttributeMultiprocessorCount, dev);
    if (hipOccupancyMaxActiveBlocksPerMultiprocessor(&per_cu, (const void*)fwd, NTHREADS, LDS_BYTES) != hipSuccess || per_cu < 1) fprintf(stderr, "kernel_launch: occupancy query says %d\n", per_cu);
    (void)hipGetLastError();
    grid = cus < 256 ? cus : 256;
    if (grid != 256) fprintf(stderr, "kernel_launch: %d CUs (expected 256)\n", cus);
  }
  if (grid < 0) return;
  hipMemsetAsync((char*)d_ws + WS_CTL, 0, CTL_BYTES, stream);
  Args a{};
  for (int i = 0; i < 27; ++i) a.in[i] = (const float*)d_in[i];
  a.out = (float*)d_out; a.ws = (unsigned char*)d_ws;
#if MK_MULTI
  for (int k = 0; k < NPH; ++k) { a.ph_lo = k; a.ph_hi = k + 1; hipLaunchKernelGGL(fwd, dim3(grid), dim3(NTHREADS), LDS_BYTES, stream, a);
#if MK_DIAG
    hipLaunchKernelGGL(diag, dim3(64), dim3(256), 0, stream, a, k);
#endif
  }
#if MK_DIAG
  hipLaunchKernelGGL(diag_encode, dim3(1024), dim3(256), 0, stream, a);
#endif
#else
  a.ph_lo = 0; a.ph_hi = NPH;
  hipLaunchKernelGGL(fwd, dim3(grid), dim3(NTHREADS), LDS_BYTES, stream, a);
#endif
  const hipError_t le = hipPeekAtLastError();
  if (le != hipSuccess) fprintf(stderr, "kernel_launch: launch failed: %s\n", hipGetErrorName(le));
}
```

```cpp
#include <hip/hip_runtime.h>
#include <cstdio>
#include <cstdint>

#define MK_DIAG 0
#ifndef MK_MULTI
#define MK_MULTI 0
#endif

#define LAS __attribute__((address_space(3)))
typedef unsigned short bf16_t;
typedef short bf16x8 __attribute__((ext_vector_type(8)));
typedef short s16x4 __attribute__((ext_vector_type(4)));
typedef float f32x4 __attribute__((ext_vector_type(4)));
typedef float f32x2 __attribute__((ext_vector_type(2)));
typedef float f32x16 __attribute__((ext_vector_type(16)));
typedef unsigned u32x4 __attribute__((ext_vector_type(4)));
typedef unsigned u32x2 __attribute__((ext_vector_type(2)));

constexpr int D = 2048, SEQ = 16384, CTXL = 256, MT = SEQ + CTXL;
constexpr int NE = 64, TOPK = 8, EFF = 512;
constexpr int N_IN0 = 3584, N_QKV0 = 1536, N_IN1 = 6144;
constexpr float EPS = 1e-6f;
constexpr float LAM_INIT = 0.35550907f;
constexpr int SH_BASE = SEQ * 0 + (MT * TOPK) + NE * 256;
constexpr int NSLOT = SH_BASE + MT;
constexpr int NTHREADS = 512;
constexpr int LDS_BYTES = 131072 + 1024;
constexpr int LDS_CTL = 131072;

constexpr size_t al256(size_t x) { return (x + 255) & ~(size_t)255; }
constexpr size_t WS_CTL   = 0;
constexpr size_t CTL_BYTES = 32768;
constexpr size_t CTL_CNT  = 16384;
constexpr size_t CTL_KMAX = 16384 + 2048;
constexpr size_t WS_MOD   = CTL_BYTES;
constexpr size_t WS_WIN0  = al256(WS_MOD + 2 * 2 * 12288 * 4);
constexpr size_t WS_WOUT0 = al256(WS_WIN0 + (size_t)N_IN0 * D * 2);
constexpr size_t WS_WIN1  = al256(WS_WOUT0 + (size_t)D * D * 2);
constexpr size_t WS_WOUT1 = al256(WS_WIN1 + (size_t)N_IN1 * D * 2);
constexpr size_t WMOE_E   = (size_t)1024 * D + (size_t)D * EFF;
constexpr size_t WS_WMOE  = al256(WS_WOUT1 + (size_t)D * D * 2);
constexpr size_t WS_HRES  = al256(WS_WMOE + 65 * WMOE_E * 2);
constexpr size_t WS_ABUF  = al256(WS_HRES + (size_t)MT * D * 4);
constexpr size_t WS_QKVU  = al256(WS_ABUF + (size_t)MT * D * 2);
constexpr size_t WS_HG    = al256(WS_QKVU + (size_t)MT * N_IN1 * 2);
constexpr size_t WS_X2    = al256(WS_HG + (size_t)MT * 1024 * 2);
constexpr size_t WS_OUT   = al256(WS_X2 + (size_t)MT * D * 2);
constexpr size_t WS_ACT   = al256(WS_OUT + (size_t)MT * D * 2);
constexpr size_t WS_K8    = WS_ACT + al256((size_t)NSLOT * EFF);
constexpr size_t WS_Y     = al256(WS_ACT + (size_t)NSLOT * EFF * 2);
constexpr size_t WS_TOPE  = al256(WS_Y + (size_t)NSLOT * D * 2);
constexpr size_t WS_TOPW  = al256(WS_TOPE + (size_t)MT * TOPK * 4);
constexpr size_t WS_TOPP  = al256(WS_TOPW + (size_t)MT * TOPK * 4);
constexpr size_t WS_TSLOT = al256(WS_TOPP + (size_t)MT * TOPK * 4);
constexpr size_t WS_STOK  = al256(WS_TSLOT + (size_t)MT * TOPK * 4);
constexpr size_t WS_END   = al256(WS_STOK + (size_t)NSLOT * 4);

struct Args { const float* in[27]; float* out; unsigned char* ws; int ph_lo, ph_hi; };

__device__ __forceinline__ float bflo(unsigned x) { return __uint_as_float(x << 16); }
__device__ __forceinline__ float bfhi(unsigned x) { return __uint_as_float(x & 0xffff0000u); }
__device__ __forceinline__ float bf2f(bf16_t b) { return __uint_as_float(((unsigned)b) << 16); }
__device__ __forceinline__ unsigned cvtpk(float lo, float hi) { unsigned r; asm("v_cvt_pk_bf16_f32 %0, %1, %2" : "=v"(r) : "v"(lo), "v"(hi)); return r; }
__device__ __forceinline__ bf16_t f2bf(float x) { return (bf16_t)(cvtpk(x, 0.f) & 0xffffu); }
__device__ __forceinline__ float wave_sum(float v) {
#pragma unroll
  for (int o = 32; o; o >>= 1) v += __shfl_xor(v, o);
  return v;
}
__device__ __forceinline__ float sigmoidf_(float x) { return 1.f / (1.f + expf(-x)); }
__device__ __forceinline__ float sigmoid_fast(float x) { return __builtin_amdgcn_rcpf(1.f + __builtin_amdgcn_exp2f(-1.4426950408889634f * x)); }

__device__ __forceinline__ float clamp8e(float x) { return fminf(fmaxf(x, -448.f), 448.f); }
__device__ __forceinline__ unsigned pack8x4(float a, float b, float c, float d) {
  int p = __builtin_amdgcn_cvt_pk_fp8_f32(clamp8e(a), clamp8e(b), 0, false); p = __builtin_amdgcn_cvt_pk_fp8_f32(clamp8e(c), clamp8e(d), p, true); return (unsigned)p; }
__device__ __forceinline__ float sq8x4(unsigned p) {
  const float a = __builtin_amdgcn_cvt_f32_fp8((int)p, 0), b = __builtin_amdgcn_cvt_f32_fp8((int)p, 1), c = __builtin_amdgcn_cvt_f32_fp8((int)p, 2), d = __builtin_amdgcn_cvt_f32_fp8((int)p, 3);
  return a * a + b * b + c * c + d * d; }
typedef int v8i_ __attribute__((ext_vector_type(8)));
typedef int v4i __attribute__((ext_vector_type(4)));
#define XB_TMO      128
#define XB_XCNT(j)  (256  + 64 * (j))
#define XB_XSUB(j)  (1280 + 64 * (j))
#define XB_XGEN(j)  (2304 + 64 * (j))
#define XB_TOP      3328
#define XB_TOPGEN   3392
#define XCD_BAR_WORDS 3456
#define XB_SPIN_CAP (1u << 22)
__device__ __forceinline__ unsigned xb_ld(unsigned* p)              { return __hip_atomic_load(p, __ATOMIC_RELAXED, __HIP_MEMORY_SCOPE_AGENT); }
__device__ __forceinline__ unsigned xb_add(unsigned* p, unsigned v) { return __hip_atomic_fetch_add(p, v, __ATOMIC_RELAXED, __HIP_MEMORY_SCOPE_AGENT); }
__device__ __forceinline__ unsigned xb_xcc_id() { return (unsigned)__builtin_amdgcn_s_getreg((3 << 11) | 20) & 0xFu; }
#define XB_SPIN(cond, bar) do { unsigned _sp = 0; while (cond) { __builtin_amdgcn_s_sleep(1); \
    if ((++_sp & 255u) == 0u) { if (xb_ld(&(bar)[XB_TMO])) break; if (_sp > XB_SPIN_CAP) { atomicAdd(&(bar)[XB_TMO], 1u); break; } } } } while (0)
struct XcdBarrier { unsigned* bar; unsigned x; volatile LAS unsigned* st; };
__device__ __forceinline__ XcdBarrier xcd_barrier_post(unsigned* bar, volatile LAS unsigned* st) {
    XcdBarrier b; b.bar = bar; b.x = xb_xcc_id(); b.st = st;
    if (threadIdx.x == 0) (void)xb_add(&bar[XB_XCNT(b.x)], 1u);
    return b;
}
__device__ __forceinline__ void xcd_barrier_complete(unsigned* bar, unsigned x, unsigned& nloc, unsigned& nx) {
    const unsigned G = gridDim.x * gridDim.y * gridDim.z;
    unsigned sum, cnt, mine, sp = 0u;
    for (;;) {
        sum = 0u; cnt = 0u; mine = 0u;
#pragma unroll
        for (unsigned j = 0; j < 16; ++j) { const unsigned c = xb_ld(&bar[XB_XCNT(j)]); sum += c; cnt += (c > 0u) ? 1u : 0u; mine = (j == x) ? c : mine; }
        if (sum == G) break;
        __builtin_amdgcn_s_sleep(1);
        if ((++sp & 255u) == 0u) { if (xb_ld(&bar[XB_TMO])) break; if (sp > XB_SPIN_CAP) { atomicAdd(&bar[XB_TMO], 1u); break; } }
    }
    nloc = mine > 0u ? mine : 1u; nx = cnt > 0u ? cnt : 1u;
}
__device__ __forceinline__ void xcd_barrier(const XcdBarrier& b) {
    asm volatile("s_waitcnt vmcnt(0)" ::: "memory");
    __syncthreads();
    if (threadIdx.x == 0) {
        unsigned* bar = b.bar;
        __builtin_amdgcn_s_waitcnt(0);
        unsigned nloc = b.st[0], nx = b.st[1];
        if (nloc == 0u) { xcd_barrier_complete(bar, b.x, nloc, nx); b.st[0] = nloc; b.st[1] = nx; }
        const unsigned old = xb_add(&bar[XB_XSUB(b.x)], 1u);
        const unsigned gen = old / nloc;
        if (old + 1u == (gen + 1u) * nloc) {
            __builtin_amdgcn_fence(__ATOMIC_RELEASE, "agent");
            asm volatile("s_waitcnt vmcnt(0)" ::: "memory");
            const unsigned og = xb_add(&bar[XB_TOP], 1u);
            const unsigned tg = og / nx;
            if (og + 1u == (tg + 1u) * nx) xb_add(&bar[XB_TOPGEN], 1u);
            else XB_SPIN(xb_ld(&bar[XB_TOPGEN]) == tg, bar);
            __builtin_amdgcn_fence(__ATOMIC_ACQUIRE, "agent");
            xb_add(&bar[XB_XGEN(b.x)], 1u);
            asm volatile("s_waitcnt vmcnt(0)" ::: "memory");
        } else {
            XB_SPIN(xb_ld(&bar[XB_XGEN(b.x)]) == gen, bar);
            __builtin_amdgcn_fence(__ATOMIC_ACQUIRE, "agent");
            asm volatile("s_waitcnt vmcnt(0)" ::: "memory");
        }
    }
    __syncthreads();
}

__device__ __forceinline__ int lds_byte(int r, int c) {
  int st = (r >> 4) * 2 + (c >> 5), rr = r & 15, cc = c & 31, ob = rr * 64 + cc * 2;
  return st * 1024 + (ob ^ (((ob >> 9) & 1) << 5));
}
#define GLDS(gp, lp) __builtin_amdgcn_global_load_lds((const unsigned*)(gp), (LAS unsigned*)(lp), 16, 0, 0)
#define WAIT_V(n) asm volatile("s_waitcnt vmcnt(" #n ")" ::: "memory")
#define WAIT_L(n) asm volatile("s_waitcnt lgkmcnt(" #n ")" ::: "memory")
#define BAR __builtin_amdgcn_s_barrier()
#define SCHED __builtin_amdgcn_sched_barrier(0)

template <bool GATHER, class Epi>
__device__ __forceinline__ void gemm_tile(const bf16_t* __restrict__ A, const int lda, const int* __restrict__ tok, const int brow,
                                          const bf16_t* __restrict__ Bt, const int ldb, const int bcol, const int K,
                                          LAS char* shm, const Epi& epi) {
#define G_SA(b, h) (shm + ((b) * 2 + (h)) * 16384)
#define G_SB(b, h) (shm + (4 + (b) * 2 + (h)) * 16384)
  int tid = threadIdx.x; asm volatile("" : "+v"(tid)); tid &= 511;
  int wid = tid >> 6, lane = tid & 63, wr = wid >> 2, wc = wid & 3, fr = lane & 15, fq = lane >> 4;
  unsigned ao0, ao1, ao2, ao3, bo;
  {
    const int sb = (tid & 63) * 16, swz = sb ^ (((sb >> 9) & 1) << 5);
    const int R0 = ((tid >> 6) >> 1) * 16 + (swz >> 6), C0 = ((tid >> 6) & 1) * 32 + ((swz & 63) >> 1);
    if (GATHER) { ao0 = (unsigned)(tok[R0] * lda + C0); ao1 = (unsigned)(tok[R0 + 64] * lda + C0); ao2 = (unsigned)(tok[R0 + 128] * lda + C0); ao3 = (unsigned)(tok[R0 + 192] * lda + C0); }
    else { ao0 = (unsigned)((brow + R0) * lda + C0); ao1 = ao0 + 64u * lda; ao2 = ao0 + 128u * lda; ao3 = ao0 + 192u * lda; }
    bo = (unsigned)((bcol + R0) * ldb + C0);
  }
  const int lo = __builtin_amdgcn_readfirstlane(tid >> 6) * 1024;
#define STAGE_A0(P, kt) do { GLDS((A + (kt) * 64) + ao0, (P) + lo); GLDS((A + (kt) * 64) + ao1, (P) + lo + 8192); } while (0)
#define STAGE_A1(P, kt) do { GLDS((A + (kt) * 64) + ao2, (P) + lo); GLDS((A + (kt) * 64) + ao3, (P) + lo + 8192); } while (0)
#define STAGE_B0(P, kt) do { GLDS((Bt + (kt) * 64) + bo, (P) + lo); GLDS((Bt + 64 * ldb + (kt) * 64) + bo, (P) + lo + 8192); } while (0)
#define STAGE_B1(P, kt) do { GLDS((Bt + 128 * ldb + (kt) * 64) + bo, (P) + lo); GLDS((Bt + 192 * ldb + (kt) * 64) + bo, (P) + lo + 8192); } while (0)
#define LDA(dst, b, h) _Pragma("unroll") for (int m = 0; m < 4; ++m) _Pragma("unroll") for (int k = 0; k < 2; ++k) \
    dst[m][k] = *(LAS const bf16x8*)(G_SA(b, h) + lds_byte(wr * 64 + m * 16 + fr, k * 32 + fq * 8))
#define LDB(dst, b, h) _Pragma("unroll") for (int n = 0; n < 2; ++n) _Pragma("unroll") for (int k = 0; k < 2; ++k) \
    dst[n][k] = *(LAS const bf16x8*)(G_SB(b, h) + lds_byte(wc * 32 + n * 16 + fr, k * 32 + fq * 8))
#define MMA(ai, bj, At_, Bt_) do { __builtin_amdgcn_s_setprio(1); \
    _Pragma("unroll") for (int m = 0; m < 4; ++m) _Pragma("unroll") for (int n = 0; n < 2; ++n) _Pragma("unroll") for (int k = 0; k < 2; ++k) \
      acc[ai][bj][m][n] = __builtin_amdgcn_mfma_f32_16x16x32_bf16(Bt_[n][k], At_[m][k], acc[ai][bj][m][n], 0, 0, 0); \
    __builtin_amdgcn_s_setprio(0); } while (0)

  f32x4 acc[2][2][4][2] = {};
  bf16x8 At[4][2], B0[2][2], B1[2][2];
  const int nt = K / 64;
  STAGE_B0(G_SB(0, 0), 0); STAGE_A0(G_SA(0, 0), 0);
  STAGE_B1(G_SB(0, 1), 0); STAGE_A1(G_SA(0, 1), 0);
  if (wr == 1) BAR;
  WAIT_V(4); BAR;
  STAGE_B0(G_SB(1, 0), 1); STAGE_A0(G_SA(1, 0), 1); STAGE_B1(G_SB(1, 1), 1);
  WAIT_V(6); BAR;
  for (int t = 0; t < nt - 2; t += 2) {
    LDB(B0, 0, 0); SCHED; LDA(At, 0, 0); STAGE_A1(G_SA(1, 1), t + 1);
    WAIT_L(8); BAR; WAIT_L(0); MMA(0, 0, At, B0); BAR; SCHED;
    LDB(B1, 0, 1); STAGE_B0(G_SB(0, 0), t + 2);
    BAR; WAIT_L(0); MMA(0, 1, At, B1); BAR;
    LDA(At, 0, 1); STAGE_A0(G_SA(0, 0), t + 2);
    BAR; WAIT_L(0); MMA(1, 0, At, B0); BAR; SCHED;
    STAGE_B1(G_SB(0, 1), t + 2);
    WAIT_V(6); BAR; MMA(1, 1, At, B1); BAR;
    LDB(B0, 1, 0); SCHED; LDA(At, 1, 0); STAGE_A1(G_SA(0, 1), t + 2);
    WAIT_L(8); BAR; WAIT_L(0); MMA(0, 0, At, B0); BAR; SCHED;
    LDB(B1, 1, 1); STAGE_B0(G_SB(1, 0), t + 3);
    BAR; WAIT_L(0); MMA(0, 1, At, B1); BAR;
    LDA(At, 1, 1); STAGE_A0(G_SA(1, 0), t + 3);
    BAR; WAIT_L(0); MMA(1, 0, At, B0); BAR; SCHED;
    STAGE_B1(G_SB(1, 1), t + 3);
    WAIT_V(6); BAR; MMA(1, 1, At, B1); BAR;
  }
  { LDB(B0, 0, 0); WAIT_V(0); LDA(At, 0, 0); STAGE_A1(G_SA(1, 1), nt - 1);
    BAR; WAIT_L(0); MMA(0, 0, At, B0); BAR;
    LDB(B1, 0, 1); BAR; WAIT_L(0); MMA(0, 1, At, B1); BAR;
    LDA(At, 0, 1); WAIT_V(4); BAR; WAIT_L(0); MMA(1, 0, At, B0); MMA(1, 1, At, B1); BAR; }
  { LDB(B0, 1, 0); LDA(At, 1, 0); WAIT_V(2); BAR; WAIT_L(0); MMA(0, 0, At, B0); BAR;
    LDB(B1, 1, 1); WAIT_V(0); BAR; WAIT_L(0); MMA(0, 1, At, B1); BAR;
    LDA(At, 1, 1); BAR; WAIT_L(0); MMA(1, 0, At, B0); MMA(1, 1, At, B1); BAR; }
  if (wr == 0) BAR;
  int tz = threadIdx.x; asm volatile("" : "+v"(tz)); wid = tz >> 6; lane = tz & 63; wr = wid >> 2; wc = wid & 3; fr = lane & 15; fq = lane >> 4;
  epi(acc, brow, bcol, wr, wc, fr, fq);
#undef G_SA
#undef G_SB
#undef STAGE_A0
#undef STAGE_A1
#undef STAGE_B0
#undef STAGE_B1
#undef LDA
#undef LDB
#undef MMA
}

struct EpiPlain {
  bf16_t* C; int ldc;
  __device__ __forceinline__ void operator()(const f32x4 (&acc)[2][2][4][2], int brow, int bcol, int wr, int wc, int fr, int fq) const {
#pragma unroll
    for (int ai = 0; ai < 2; ++ai)
#pragma unroll
      for (int m = 0; m < 4; ++m) {
        bf16_t* rp = C + (size_t)(brow + ai * 128 + wr * 64 + m * 16 + fr) * ldc + bcol + wc * 32 + fq * 8;
#pragma unroll
        for (int bj = 0; bj < 2; ++bj) {
          u32x4 v = {cvtpk(acc[ai][bj][m][0][0], acc[ai][bj][m][0][1]), cvtpk(acc[ai][bj][m][0][2], acc[ai][bj][m][0][3]),
                     cvtpk(acc[ai][bj][m][1][0], acc[ai][bj][m][1][1]), cvtpk(acc[ai][bj][m][1][2], acc[ai][bj][m][1][3])};
          *(u32x4*)(rp + bj * 128) = v;
        }
      }
  }
};
template <int MODE>
struct EpiPair {
  bf16_t* C; int ldc; int colbase;
  __device__ __forceinline__ void operator()(const f32x4 (&acc)[2][2][4][2], int brow, int bcol, int wr, int wc, int fr, int fq) const {
#pragma unroll
    for (int ai = 0; ai < 2; ++ai)
#pragma unroll
      for (int m = 0; m < 4; ++m) {
        bf16_t* rp = C + (size_t)(brow + ai * 128 + wr * 64 + m * 16 + fr) * ldc + ((bcol - colbase) >> 1) + wc * 16 + fq * 4;
#pragma unroll
        for (int bj = 0; bj < 2; ++bj) {
          float r[4];
#pragma unroll
          for (int j = 0; j < 4; ++j) {
            const float x0 = acc[ai][bj][m][0][j], x1 = acc[ai][bj][m][1][j];
            r[j] = MODE == 0 ? x0 * sigmoid_fast(x1) : x0 * sigmoid_fast(x0) * x1;
          }
          u32x2 v = {cvtpk(r[0], r[1]), cvtpk(r[2], r[3])};
          *(u32x2*)(rp + bj * 64) = v;
        }
      }
  }
};
struct EpiG1 {
  EpiPlain p; EpiPair<0> g; int nplain;
  __device__ __forceinline__ void operator()(const f32x4 (&acc)[2][2][4][2], int brow, int bcol, int wr, int wc, int fr, int fq) const {
    if (bcol < nplain) p(acc, brow, bcol, wr, wc, fr, fq); else g(acc, brow, bcol, wr, wc, fr, fq);
  }
};

typedef int v8i __attribute__((ext_vector_type(8)));
__device__ __forceinline__ int lds8(int r, int c) { return r * 128 + ((c ^ ((r >> 1) & 7)) << 4); }
template <bool GATHER, int lda, int ldb, int K, class Epi, class S>
__device__ __forceinline__ void gemm8_run(const unsigned char* __restrict__ A, const int* __restrict__ stok,
                                          LAS char* shm, const Epi& epi, const S& sched) {
#define G_SA(b, h) (shm + ((b) * 2 + (h)) * 16384)
#define G_SB(b, h) (shm + (4 + (b) * 2 + (h)) * 16384)
  int tid = threadIdx.x; asm volatile("" : "+v"(tid)); tid &= 511;
  int wid = tid >> 6, lane = tid & 63, wr = wid >> 2, wc = wid & 3, fr = lane & 15, fq = lane >> 4;
  unsigned ao0, ao1, ao2, ao3, bo;
  int R0 = 8 * wid + (lane >> 3), C0 = ((lane & 7) ^ ((R0 >> 1) & 7)) << 4;
  const int lo = __builtin_amdgcn_readfirstlane(tid >> 6) * 1024;
  int brow, bcol; const unsigned char* Bt;
  int ui = 0;
  if (!sched.unit(ui, brow, Bt, bcol)) return;
#define SETOFF(br, bc) do { if (GATHER) { const int* _t = stok + (br); ao0 = (unsigned)(_t[R0] * lda + C0); ao1 = (unsigned)(_t[R0 + 64] * lda + C0); ao2 = (unsigned)(_t[R0 + 128] * lda + C0); ao3 = (unsigned)(_t[R0 + 192] * lda + C0); } \
    else { ao0 = (unsigned)(((br) + R0) * lda + C0); ao1 = ao0 + 64u * lda; ao2 = ao0 + 128u * lda; ao3 = ao0 + 192u * lda; } \
    bo = (unsigned)(((bc) + R0) * ldb + C0); } while (0)
#define STAGE_A0(P, kt) do { GLDS((A + (kt) * 128) + ao0, (P) + lo); GLDS((A + (kt) * 128) + ao1, (P) + lo + 8192); } while (0)
#define STAGE_A1(P, kt) do { GLDS((A + (kt) * 128) + ao2, (P) + lo); GLDS((A + (kt) * 128) + ao3, (P) + lo + 8192); } while (0)
#define STAGE_B0(P, kt) do { GLDS((Bt + (kt) * 128) + bo, (P) + lo); GLDS((Bt + 64 * ldb + (kt) * 128) + bo, (P) + lo + 8192); } while (0)
#define STAGE_B1(P, kt) do { GLDS((Bt + 128 * ldb + (kt) * 128) + bo, (P) + lo); GLDS((Bt + 192 * ldb + (kt) * 128) + bo, (P) + lo + 8192); } while (0)
#define PRO() do { STAGE_B0(G_SB(0, 0), 0); STAGE_A0(G_SA(0, 0), 0); STAGE_B1(G_SB(0, 1), 0); STAGE_A1(G_SA(0, 1), 0); } while (0)
  const int fx = (fq ^ ((fr >> 1) & 7)) << 4;
  const int fa0 = (wr * 64 + fr) * 128 + fx, fb0 = (wc * 32 + fr) * 128 + fx;
#define FRAG8(dst, p0, p1) do { const v4i _x = *(LAS const v4i*)(p0); const v4i _y = *(LAS const v4i*)(p1); \
    dst = (v8i){_x[0], _x[1], _x[2], _x[3], _y[0], _y[1], _y[2], _y[3]}; } while (0)
#define LDA(dst, b, h) do { int fa1 = fa0; asm volatile("v_xor_b32 %0, 64, %0" : "+v"(fa1)); \
    _Pragma("unroll") for (int m = 0; m < 4; ++m) FRAG8(dst[m], G_SA(b, h) + fa0 + m * 2048, G_SA(b, h) + fa1 + m * 2048); } while (0)
#define LDB(dst, b, h) do { int fb1 = fb0; asm volatile("v_xor_b32 %0, 64, %0" : "+v"(fb1)); \
    _Pragma("unroll") for (int n = 0; n < 2; ++n) FRAG8(dst[n], G_SB(b, h) + fb0 + n * 2048, G_SB(b, h) + fb1 + n * 2048); } while (0)
#define MMA(ai, bj, At_, Bt_) do { __builtin_amdgcn_s_setprio(1); \
    _Pragma("unroll") for (int m = 0; m < 4; ++m) _Pragma("unroll") for (int n = 0; n < 2; ++n) \
      asm volatile("v_mfma_scale_f32_16x16x128_f8f6f4 %0, %1, %2, %0, %3, %3 op_sel_hi:[0,0,0]" : "+v"(acc[ai][bj][m][n]) : "v"(Bt_[n]), "v"(At_[m]), "v"(sc1)); \
    __builtin_amdgcn_s_setprio(0); } while (0)
  int sc1; asm volatile("v_mov_b32 %0, 0x7f7f7f7f" : "=v"(sc1));
  const int nt = K / 128;
  SETOFF(brow, bcol); PRO();
  bool first = true;
  for (;;) {
    f32x4 acc[2][2][4][2] = {};
    v8i At[4], B0[2], B1[2];
    if (wr == 1) BAR;
    if (first) WAIT_V(4); else WAIT_V(0);
    BAR;
    STAGE_B0(G_SB(1, 0), 1); STAGE_A0(G_SA(1, 0), 1); STAGE_B1(G_SB(1, 1), 1);
    WAIT_V(6); BAR;
    for (int t = 0; t < nt - 2; t += 2) {
      LDB(B0, 0, 0); SCHED; LDA(At, 0, 0); STAGE_A1(G_SA(1, 1), t + 1);
      WAIT_L(8); BAR; WAIT_L(0); MMA(0, 0, At, B0); BAR; SCHED;
      LDB(B1, 0, 1); STAGE_B0(G_SB(0, 0), t + 2);
      BAR; WAIT_L(0); MMA(0, 1, At, B1); BAR;
      LDA(At, 0, 1); STAGE_A0(G_SA(0, 0), t + 2);
      BAR; WAIT_L(0); MMA(1, 0, At, B0); BAR; SCHED;
      STAGE_B1(G_SB(0, 1), t + 2);
      WAIT_V(6); BAR; MMA(1, 1, At, B1); BAR;
      LDB(B0, 1, 0); SCHED; LDA(At, 1, 0); STAGE_A1(G_SA(0, 1), t + 2);
      WAIT_L(8); BAR; WAIT_L(0); MMA(0, 0, At, B0); BAR; SCHED;
      LDB(B1, 1, 1); STAGE_B0(G_SB(1, 0), t + 3);
      BAR; WAIT_L(0); MMA(0, 1, At, B1); BAR;
      LDA(At, 1, 1); STAGE_A0(G_SA(1, 0), t + 3);
      BAR; WAIT_L(0); MMA(1, 0, At, B0); BAR; SCHED;
      STAGE_B1(G_SB(1, 1), t + 3);
      WAIT_V(6); BAR; MMA(1, 1, At, B1); BAR;
    }
    { LDB(B0, 0, 0); WAIT_V(0); LDA(At, 0, 0); STAGE_A1(G_SA(1, 1), nt - 1);
      BAR; WAIT_L(0); MMA(0, 0, At, B0); BAR;
      LDB(B1, 0, 1); BAR; WAIT_L(0); MMA(0, 1, At, B1); BAR;
      LDA(At, 0, 1); WAIT_V(4); BAR; WAIT_L(0); MMA(1, 0, At, B0); MMA(1, 1, At, B1); BAR; }
    { LDB(B0, 1, 0); LDA(At, 1, 0); WAIT_V(2); BAR; WAIT_L(0); MMA(0, 0, At, B0); BAR;
      LDB(B1, 1, 1); WAIT_V(0); BAR; WAIT_L(0); MMA(0, 1, At, B1); BAR;
      LDA(At, 1, 1); BAR; WAIT_L(0); MMA(1, 0, At, B0); MMA(1, 1, At, B1); BAR; }
    if (wr == 0) BAR;
    const int cbrow = brow, cbcol = bcol;
    { int tz = threadIdx.x; asm volatile("" : "+v"(tz)); tz &= 511; wid = tz >> 6; lane = tz & 63; wr = wid >> 2; wc = wid & 3; fr = lane & 15; fq = lane >> 4;
      R0 = 8 * wid + (lane >> 3); C0 = ((lane & 7) ^ ((R0 >> 1) & 7)) << 4; }
    ++ui;
    const bool more = sched.unit(ui, brow, Bt, bcol);
    if (more) { SETOFF(brow, bcol); asm volatile("" ::: "memory"); PRO(); asm volatile("" ::: "memory"); }
    asm volatile("s_nop 15\n\ts_nop 15\n\ts_nop 7" ::: "memory");
#pragma unroll
    for (int i = 0; i < 32; ++i) asm volatile("" : "+v"((&acc[0][0][0][0])[i]));
    epi(acc, cbrow, cbcol, wr, wc, fr, fq);
    if (!more) break;
    first = false;
  }
#undef G_SA
#undef G_SB
#undef SETOFF
#undef STAGE_A0
#undef STAGE_A1
#undef STAGE_B0
#undef STAGE_B1
#undef PRO
#undef FRAG8
#undef LDA
#undef LDB
#undef MMA
}
__device__ __forceinline__ float clamp8(float x) { return fminf(fmaxf(x, -448.f), 448.f); }
__device__ __forceinline__ unsigned pack_fp8x4(float a, float b, float c, float d) {
  int p = __builtin_amdgcn_cvt_pk_fp8_f32(clamp8(a), clamp8(b), 0, false); p = __builtin_amdgcn_cvt_pk_fp8_f32(clamp8(c), clamp8(d), p, true); return (unsigned)p; }
struct EpiSwiGLU8 {
  unsigned char* C; int ldc;
  __device__ __forceinline__ void operator()(const f32x4 (&acc)[2][2][4][2], int brow, int bcol, int wr, int wc, int fr, int fq) const {
    constexpr float S = 1.f / 256.f;
#pragma unroll
    for (int ai = 0; ai < 2; ++ai)
#pragma unroll
      for (int m = 0; m < 4; ++m) {
        unsigned char* rp = C + (size_t)(brow + ai * 128 + wr * 64 + m * 16 + fr) * ldc + (bcol >> 1) + wc * 16 + fq * 4;
#pragma unroll
        for (int bj = 0; bj < 2; ++bj) {
          float r[4];
#pragma unroll
          for (int j = 0; j < 4; ++j) { const float g = acc[ai][bj][m][0][j] * S, u = acc[ai][bj][m][1][j] * S; r[j] = g * sigmoid_fast(g) * u; }
          *(unsigned*)(rp + bj * 64) = pack_fp8x4(r[0], r[1], r[2], r[3]);
        }
      }
  }
};
struct EpiPlainS {
  bf16_t* C; int ldc; float sc;
  __device__ __forceinline__ void operator()(const f32x4 (&acc)[2][2][4][2], int brow, int bcol, int wr, int wc, int fr, int fq) const {
#pragma unroll
    for (int ai = 0; ai < 2; ++ai)
#pragma unroll
      for (int m = 0; m < 4; ++m) {
        bf16_t* rp = C + (size_t)(brow + ai * 128 + wr * 64 + m * 16 + fr) * ldc + bcol + wc * 32 + fq * 8;
#pragma unroll
        for (int bj = 0; bj < 2; ++bj) {
          u32x4 v = {cvtpk(acc[ai][bj][m][0][0] * sc, acc[ai][bj][m][0][1] * sc), cvtpk(acc[ai][bj][m][0][2] * sc, acc[ai][bj][m][0][3] * sc),
                     cvtpk(acc[ai][bj][m][1][0] * sc, acc[ai][bj][m][1][1] * sc), cvtpk(acc[ai][bj][m][1][2] * sc, acc[ai][bj][m][1][3] * sc)};
          *(u32x4*)(rp + bj * 128) = v;
        }
      }
  }
};

__device__ __forceinline__ void dense_unit(int u, int nM, int nN, int& pm, int& pn) {
  const int nwg = nM * nN, NX = 8, WGM = 8;
  int wgid = u;
  { const int q = nwg / NX, r = nwg % NX, xcd = wgid % NX, off = wgid / NX; wgid = (xcd < r ? xcd * (q + 1) : r * (q + 1) + (xcd - r) * q) + off; }
  const int nig = WGM * nN, gid = wgid / nig, fm = gid * WGM, gsz = min(nM - fm, WGM);
  pm = fm + ((wgid % nig) % gsz); pn = (wgid % nig) / gsz;
}

namespace at {
constexpr int DH = 128, NW = 8, QBLK = 32, KVBLK = 64;
constexpr float SCALE = 0.088388347648318440f;
constexpr float QC = SCALE * 1.4426950408889634f;
constexpr int SHM_V = KVBLK * DH * 2, SHM_K = KVBLK * DH * 2;
#define KSWZ(row, colB) ((row) * 256 + ((colB) ^ (((row) & 7) << 4)))
__device__ __forceinline__ int crow(int r, int hi) { return (r & 3) + 8 * (r >> 2) + 4 * hi; }
__device__ __forceinline__ unsigned cvtpkv(float lo, float hi) { unsigned r; asm volatile("v_cvt_pk_bf16_f32 %0, %1, %2" : "=v"(r) : "v"(lo), "v"(hi)); return r; }
#define PK4(P, BASE, OUT) do { unsigned a0 = cvtpkv(P[BASE + 0], P[BASE + 1]), a1 = cvtpkv(P[BASE + 2], P[BASE + 3]);   \
    unsigned b0 = cvtpkv(P[BASE + 4], P[BASE + 5]), b1 = cvtpkv(P[BASE + 6], P[BASE + 7]);                              \
    auto r0 = __builtin_amdgcn_permlane32_swap(a0, b0, false, false); auto r1 = __builtin_amdgcn_permlane32_swap(a1, b1, false, false); \
    u32x4 w = {r0[0], r1[0], r0[1], r1[1]}; OUT = *reinterpret_cast<bf16x8*>(&w); } while (0)
__device__ __forceinline__ float load_q(const bf16_t* __restrict__ Qw, bf16x8 (&qr)[8], float kmax2) {
  float ss = 0;
#pragma unroll
  for (int d0 = 0; d0 < 8; ++d0) {
    const u32x4 raw = *reinterpret_cast<const u32x4*>(Qw + d0 * 16); u32x4 o;
#pragma unroll
    for (int i = 0; i < 4; ++i) { const unsigned pk = cvtpk(bflo(raw[i]) * QC, bfhi(raw[i]) * QC); o[i] = pk; const float a = bflo(pk), b = bfhi(pk); ss += a * a + b * b; }
    qr[d0] = *reinterpret_cast<bf16x8*>(&o);
  }
  { auto rr = __builtin_amdgcn_permlane32_swap(__float_as_uint(ss), __float_as_uint(ss), false, false); ss = __uint_as_float(rr[0]) + __uint_as_float(rr[1]); }
  return -(sqrtf(ss * kmax2) * 1.01f + 1e-3f);
}
__device__ __forceinline__ void exp16(f32x16& p) {
#pragma unroll
  for (int r = 0; r < 16; ++r) p[r] = __builtin_amdgcn_exp2f(p[r]);
}
__device__ __forceinline__ float sum16(const f32x16& p) { float s = 0;
#pragma unroll
  for (int r = 0; r < 16; ++r) s += p[r];
  return s; }
__device__ __forceinline__ void qkt(f32x16& p0, f32x16& p1, LAS const char* Ks, const bf16x8* qr, int r32, int hi, float nmc) {
#pragma unroll
  for (int r = 0; r < 16; ++r) { p0[r] = nmc; p1[r] = nmc; }
#pragma unroll
  for (int d0 = 0; d0 < 8; ++d0) { int cb = (d0 * 16 + hi * 8) * 2;
    bf16x8 b0 = *(LAS const bf16x8*)(Ks + KSWZ(r32, cb));
    bf16x8 b1 = *(LAS const bf16x8*)(Ks + KSWZ(32 + r32, cb));
    p0 = __builtin_amdgcn_mfma_f32_32x32x16_bf16(b0, qr[d0], p0, 0, 0, 0);
    p1 = __builtin_amdgcn_mfma_f32_32x32x16_bf16(b1, qr[d0], p1, 0, 0, 0); }
}
__device__ __forceinline__ int v_st(int k, int c) { const int kk = (k & ~0xC) | ((k & 4) << 1) | ((k & 8) >> 1); return ((kk >> 3) * 4 + (c >> 5)) * 512 + ((kk & 7) * 32 + (c & 31)) * 2; }
__device__ __forceinline__ int v_st256(int k, int c) { const int kk = (k & ~0xC) | ((k & 4) << 1) | ((k & 8) >> 1); return ((kk >> 3) * 8 + (c >> 5)) * 512 + ((kk & 7) * 32 + (c & 31)) * 2; }
__device__ __forceinline__ int v_rd_base(int lane) { return ((lane & 3) << 3) | (((lane >> 2) & 3) << 6) | (((lane >> 4) & 1) << 5) | (((lane >> 5) & 1) << 8); }
template <int OFF> __device__ __forceinline__ s16x4 tr_read(int vb) {
  s16x4 r; asm volatile("ds_read_b64_tr_b16 %0, %1 offset:%2" : "=&v"(r) : "v"(vb), "i"(OFF) : "memory"); return r;
}
template <int BASE, int KS, int HS> __device__ __forceinline__ void pv_one(f32x16& od, int vb, bf16x8 pa0, bf16x8 pa1, bf16x8 pa2, bf16x8 pa3) {
  const s16x4 l0 = tr_read<BASE>(vb), h0 = tr_read<BASE + HS>(vb), l1 = tr_read<BASE + KS>(vb), h1 = tr_read<BASE + KS + HS>(vb);
  const s16x4 l2 = tr_read<BASE + 2 * KS>(vb), h2 = tr_read<BASE + 2 * KS + HS>(vb), l3 = tr_read<BASE + 3 * KS>(vb), h3 = tr_read<BASE + 3 * KS + HS>(vb);
  asm volatile("s_waitcnt lgkmcnt(0)" ::: "memory"); SCHED;
#define PK(L, H) (bf16x8){L[0], L[1], L[2], L[3], H[0], H[1], H[2], H[3]}
  od = __builtin_amdgcn_mfma_f32_32x32x16_bf16(pa0, PK(l0, h0), od, 0, 0, 0);
  od = __builtin_amdgcn_mfma_f32_32x32x16_bf16(pa1, PK(l1, h1), od, 0, 0, 0);
  od = __builtin_amdgcn_mfma_f32_32x32x16_bf16(pa2, PK(l2, h2), od, 0, 0, 0);
  od = __builtin_amdgcn_mfma_f32_32x32x16_bf16(pa3, PK(l3, h3), od, 0, 0, 0);
#undef PK
}
__device__ __forceinline__ void pv_d0(f32x16* o, int vb, bf16x8 pa0, bf16x8 pa1, bf16x8 pa2, bf16x8 pa3) {
  pv_one<0, 4096, 2048>(o[0], vb, pa0, pa1, pa2, pa3); pv_one<512, 4096, 2048>(o[1], vb, pa0, pa1, pa2, pa3);
  pv_one<1024, 4096, 2048>(o[2], vb, pa0, pa1, pa2, pa3); pv_one<1536, 4096, 2048>(o[3], vb, pa0, pa1, pa2, pa3);
}
__device__ __forceinline__ void pv_d0_256(f32x16* o, int vb, bf16x8 pa0, bf16x8 pa1, bf16x8 pa2, bf16x8 pa3) {
  pv_one<0, 8192, 4096>(o[0], vb, pa0, pa1, pa2, pa3); pv_one<512, 8192, 4096>(o[1], vb, pa0, pa1, pa2, pa3);
  pv_one<1024, 8192, 4096>(o[2], vb, pa0, pa1, pa2, pa3); pv_one<1536, 8192, 4096>(o[3], vb, pa0, pa1, pa2, pa3);
}
__device__ __forceinline__ void store_o(const f32x16* o, float l_tot, LAS float* li, bf16_t* __restrict__ Ow, int ldo, int r32, int hi) {
  if (hi == 0) li[r32] = l_tot; asm volatile("s_waitcnt lgkmcnt(0)" ::: "memory");
  float rli[16];
#pragma unroll
  for (int r = 0; r < 16; ++r) rli[r] = __builtin_amdgcn_rcpf(li[crow(r, hi)]);
#pragma unroll
  for (int r = 0; r < 16; ++r) { const int orow = crow(r, hi);
#pragma unroll
    for (int d0 = 0; d0 < 4; ++d0) Ow[(long)orow * ldo + d0 * 32 + r32] = f2bf(o[d0][r] * rli[r]); }
}

__device__ __forceinline__ int unswap23(int kk) { return (kk & ~0xC) | ((kk & 4) << 1) | ((kk & 8) >> 1); }
__device__ __forceinline__ int k_dma_voff(int wid, int lane, int ldk) {
  const int row = 4 * wid + (lane >> 4); return row * ldk * 2 + (((lane & 15) * 16) ^ ((row & 7) << 4)); }
#define DMA16(rs, ldsp, voff, soff) __builtin_amdgcn_raw_ptr_buffer_load_lds(rs, (LAS void*)(ldsp), 16, voff, soff, 0, 0)

constexpr int SHM_T = SHM_K + SHM_V;
__device__ __forceinline__ void attn_body(const bf16_t* __restrict__ Qb, const int ldq, const bf16_t* __restrict__ Kh, const bf16_t* __restrict__ Vh, const int ldk,
                                          bf16_t* __restrict__ Ob, const int ldo, const int seq, const float kmax2, LAS char* lds) {
  int tid = threadIdx.x; asm volatile("" : "+v"(tid)); tid &= 511;
  const int wid = tid >> 6, lane = tid & 63, r32 = lane & 31, hi = lane >> 5;
  LAS float* li_l = (LAS float*)(lds + 3 * SHM_T) + wid * 64;
  float l_reg = 0; f32x16 o[4] = {}; bf16x8 qr[8];
  const float nmc = load_q(Qb + (long)(wid * QBLK + r32) * ldq + hi * 8, qr, kmax2);
  const int vrb = v_rd_base(lane);
  const int kvo = k_dma_voff(wid, lane, ldk);
  const int vvo = unswap23(8 * (wid >> 1) + ((lane & 31) >> 2)) * ldk * 2 + ((2 * (wid & 1) + (lane >> 5)) * 32 + (lane & 3) * 8) * 2;
  const int l32 = 64 * ldk, pz = wid * 1024;
  const __amdgpu_buffer_rsrc_t krs = __builtin_amdgcn_make_buffer_rsrc((void*)Kh, 0, 0x7ffffff0, 0x00020000);
  const __amdgpu_buffer_rsrc_t vrs = __builtin_amdgcn_make_buffer_rsrc((void*)Vh, 0, 0x7ffffff0, 0x00020000);
#define TDMA(slot, k0) do { const int _o = (k0) * ldk * 2; LAS char* _b = lds + (slot) * SHM_T + pz; \
    DMA16(krs, _b, kvo, _o); DMA16(krs, _b + 8192, kvo, _o + l32); DMA16(vrs, _b + SHM_K, vvo, _o); DMA16(vrs, _b + SHM_K + 8192, vvo, _o + l32); } while (0)
#define VM0() asm volatile("s_waitcnt vmcnt(0)" ::: "memory")
#define FINISH(P0, P1) do { exp16(P1); l_reg += sum16(P0) + sum16(P1); PK4(P0, 0, pa0); PK4(P0, 8, pa1); PK4(P1, 0, pa2); PK4(P1, 8, pa3); } while (0)
  f32x16 pA0, pA1, pB0, pB1; bf16x8 pa0, pa1, pa2, pa3; const int NT = seq / KVBLK;
  TDMA(0, 0); VM0(); __syncthreads();
  TDMA(1, KVBLK);
  qkt(pA0, pA1, lds, qr, r32, hi, nmc); exp16(pA0);
  VM0(); __syncthreads();
  int sk = 1, sv = 0, sd = 2;
  for (int j = 1; j + 1 < NT; j += 2) {
    TDMA(sd, (j + 1) * KVBLK);
    SCHED; qkt(pB0, pB1, lds + sk * SHM_T, qr, r32, hi, nmc);
    FINISH(pA0, pA1); SCHED;
    pv_d0(o, (int)(uintptr_t)(lds + sv * SHM_T + SHM_K) + vrb, pa0, pa1, pa2, pa3); exp16(pB0);
    VM0(); __syncthreads();
    { const int t = sv; sv = sk; sk = sd; sd = t; }
    if (j + 2 < NT) TDMA(sd, (j + 2) * KVBLK);
    SCHED; qkt(pA0, pA1, lds + sk * SHM_T, qr, r32, hi, nmc);
    FINISH(pB0, pB1); SCHED;
    pv_d0(o, (int)(uintptr_t)(lds + sv * SHM_T + SHM_K) + vrb, pa0, pa1, pa2, pa3); exp16(pA0);
    VM0(); __syncthreads();
    { const int t = sv; sv = sk; sk = sd; sd = t; }
  }
  SCHED; qkt(pB0, pB1, lds + sk * SHM_T, qr, r32, hi, nmc);
  FINISH(pA0, pA1); SCHED;
  pv_d0(o, (int)(uintptr_t)(lds + sv * SHM_T + SHM_K) + vrb, pa0, pa1, pa2, pa3); exp16(pB0);
  FINISH(pB0, pB1); SCHED;
  pv_d0(o, (int)(uintptr_t)(lds + sk * SHM_T + SHM_K) + vrb, pa0, pa1, pa2, pa3);
  { auto rr = __builtin_amdgcn_permlane32_swap(__float_as_uint(l_reg), __float_as_uint(l_reg), false, false); l_reg = __uint_as_float(rr[0]) + __uint_as_float(rr[1]); }
  store_o(o, l_reg, li_l, Ob + (long)(wid * QBLK) * ldo, ldo, r32, hi);
  VM0();
  __syncthreads();
#undef TDMA
#undef FINISH
}

constexpr int SHM_V2 = KVBLK * 256 * 2;
__device__ __forceinline__ void attn_body_dv256(const bf16_t* __restrict__ Qb, const int ldq, const bf16_t* __restrict__ Kh, const bf16_t* __restrict__ Vh, const int ldk,
                                                bf16_t* __restrict__ Ob, const int ldo, const int seq, const float kmax2, LAS char* lds) {
  int tid = threadIdx.x; asm volatile("" : "+v"(tid)); tid &= 511;
  const int wid = tid >> 6, lane = tid & 63, r32 = lane & 31, hi = lane >> 5, rg = wid >> 1, kh = wid & 1;
  LAS char* K_lds = lds; LAS char* V_lds = lds + 2 * SHM_K; LAS char* X_lds = lds + 2 * SHM_K + 2 * SHM_V2;
  float l_reg = 0; f32x16 o[4] = {}; bf16x8 qr[8];
  const float nmc = load_q(Qb + (long)(rg * QBLK + r32) * ldq + hi * 8, qr, kmax2);
  const int vb0 = (int)(uintptr_t)V_lds + v_rd_base(lane) + kh * 2048;
  const int kvo = k_dma_voff(wid, lane, ldk);
  const int vvo = unswap23(8 * (wid >> 2) + ((lane & 31) >> 2)) * ldk * 2 + ((2 * (wid & 3) + (lane >> 5)) * 32 + (lane & 3) * 8) * 2;
  const int l32 = 64 * ldk, l16 = 32 * ldk, pz = wid * 1024;
  const int xw = (rg * 4 + kh * 2) * 1024 + lane * 16, xr = rg * 4096 + lane * 16;
  const __amdgpu_buffer_rsrc_t krs = __builtin_amdgcn_make_buffer_rsrc((void*)Kh, 0, 0x7ffffff0, 0x00020000);
  const __amdgpu_buffer_rsrc_t vrs = __builtin_amdgcn_make_buffer_rsrc((void*)Vh, 0, 0x7ffffff0, 0x00020000);
#define KDMA(b, k0) do { const int _o = (k0) * ldk * 2; LAS char* _b = K_lds + (b) * SHM_K + pz; DMA16(krs, _b, kvo, _o); DMA16(krs, _b + 8192, kvo, _o + l32); } while (0)
#define VDMA(b, k0) do { const int _o = (k0) * ldk * 2; LAS char* _b = V_lds + (b) * SHM_V2 + pz; DMA16(vrs, _b, vvo, _o); DMA16(vrs, _b + 8192, vvo, _o + l16); \
    DMA16(vrs, _b + 16384, vvo, _o + 2 * l16); DMA16(vrs, _b + 24576, vvo, _o + 3 * l16); } while (0)
  f32x16 pA, pB; bf16x8 pa0, pa1, pa2, pa3, own0, own1; const int NT = seq / KVBLK;
  const int kxor = ((32 * kh + r32) & 7) << 4, krb = (32 * kh + r32) * 256;
#define QKHALF(P, b) do { _Pragma("unroll") for (int r = 0; r < 16; ++r) P[r] = nmc; \
    _Pragma("unroll") for (int d0 = 0; d0 < 8; ++d0) { const bf16x8 bk = *(LAS const bf16x8*)(K_lds + (b) * SHM_K + krb + (((d0 * 16 + hi * 8) * 2) ^ kxor)); \
      P = __builtin_amdgcn_mfma_f32_32x32x16_bf16(bk, qr[d0], P, 0, 0, 0); } } while (0)
#define FINH(P) do { exp16(P); l_reg += sum16(P); PK4(P, 0, own0); PK4(P, 8, own1); } while (0)
#define XWRITE(b) do { *(LAS bf16x8*)(X_lds + (b) * 16384 + xw) = own0; *(LAS bf16x8*)(X_lds + (b) * 16384 + xw + 1024) = own1; } while (0)
#define XREAD(b) do { pa0 = *(LAS const bf16x8*)(X_lds + (b) * 16384 + xr); pa1 = *(LAS const bf16x8*)(X_lds + (b) * 16384 + xr + 1024); \
    pa2 = *(LAS const bf16x8*)(X_lds + (b) * 16384 + xr + 2048); pa3 = *(LAS const bf16x8*)(X_lds + (b) * 16384 + xr + 3072); } while (0)
#define STEP(PA, PB, b, j) do { \
    SCHED; if ((j) + 1 < NT) QKHALF(PB, (b) ^ 1); FINH(PA); SCHED; \
    XWRITE(b); VM0(); __syncthreads(); \
    if ((j) + 3 < NT) KDMA((b) ^ 1, ((j) + 3) * KVBLK); if ((j) + 1 < NT) VDMA((b) ^ 1, ((j) + 1) * KVBLK); \
    XREAD(b); \
    pv_d0_256(o, vb0 + (b) * SHM_V2, pa0, pa1, pa2, pa3); } while (0)
  KDMA(0, 0); KDMA(1, KVBLK); VDMA(0, 0); VM0(); __syncthreads();
  QKHALF(pA, 0);
  __syncthreads();
  if (2 < NT) KDMA(0, 2 * KVBLK);
  for (int j = 0; j < NT; j += 2) { STEP(pA, pB, 0, j); STEP(pB, pA, 1, j + 1); }
  __syncthreads();
  LAS float* lx = (LAS float*)X_lds;
  lx[wid * 64 + lane] = l_reg; __syncthreads();
  const float l_tot = lx[wid * 64 + r32] + lx[wid * 64 + 32 + r32] + lx[(wid ^ 1) * 64 + r32] + lx[(wid ^ 1) * 64 + 32 + r32];
  store_o(o, l_tot, lx + 512 + wid * 32, Ob + (long)(rg * QBLK) * ldo + kh * 128, ldo, r32, hi);
  VM0();
  __syncthreads();
#undef KDMA
#undef VDMA
#undef QKHALF
#undef FINH
#undef XWRITE
#undef XREAD
#undef STEP
#undef VM0
}

#define LGK(n) asm volatile("s_waitcnt lgkmcnt(" #n ")" ::: "memory")
template <int OFF> __device__ __forceinline__ bf16x8 k_read(int ka) { bf16x8 r; asm volatile("ds_read_b128 %0, %1 offset:%2" : "=&v"(r) : "v"(ka), "i"(OFF) : "memory"); return r; }
struct VSet { s16x4 l0, h0, l1, h1; };
template <int OFF> __device__ __forceinline__ void v_read(VSet& s, int vb) { s.l0 = tr_read<OFF>(vb); s.h0 = tr_read<OFF + 4096>(vb); s.l1 = tr_read<OFF + 8192>(vb); s.h1 = tr_read<OFF + 12288>(vb); }
__device__ __forceinline__ void pv2(f32x16& oa, const VSet& s, bf16x8 pa0, bf16x8 pa1) {
#define PK(L, H) (bf16x8){L[0], L[1], L[2], L[3], H[0], H[1], H[2], H[3]}
  oa = __builtin_amdgcn_mfma_f32_32x32x16_bf16(pa0, PK(s.l0, s.h0), oa, 0, 0, 0);
  oa = __builtin_amdgcn_mfma_f32_32x32x16_bf16(pa1, PK(s.l1, s.h1), oa, 0, 0, 0);
#undef PK
}
template <bool SHIFT>
__device__ __forceinline__ void attn_body_c256_t(const bf16_t* __restrict__ Qb, const int ldq, const bf16_t* __restrict__ Kh, const bf16_t* __restrict__ Vh, const int ldk,
                                                 bf16_t* __restrict__ Ob, const int ldo, const int seq, const float nmc, const bf16x8 (&qr)[8], LAS char* lds) {
  int tid = threadIdx.x; asm volatile("" : "+v"(tid)); tid &= 511;
  const int wid = __builtin_amdgcn_readfirstlane(tid >> 6), lane = tid & 63, r32 = lane & 31, hi = lane >> 5;
  LAS char* K_lds = lds; LAS char* V_lds = lds + 2 * SHM_K;
  LAS float* li_l = (LAS float*)(lds + 2 * SHM_K + 2 * SHM_V2) + wid * 64;
  float l_reg = 0; f32x16 o[8] = {};
  const int vb0 = (int)(uintptr_t)V_lds + v_rd_base(lane);
  const int kvo = k_dma_voff(wid, lane, ldk);
  const int vvo = unswap23(8 * (wid >> 2) + ((lane & 31) >> 2)) * ldk * 2 + ((2 * (wid & 3) + (lane >> 5)) * 32 + (lane & 3) * 8) * 2;
  const int l32 = 64 * ldk, l16 = 32 * ldk, pz = wid * 1024;
  const __amdgpu_buffer_rsrc_t krs = __builtin_amdgcn_make_buffer_rsrc((void*)Kh, 0, 0x7ffffff0, 0x00020000);
  const __amdgpu_buffer_rsrc_t vrs = __builtin_amdgcn_make_buffer_rsrc((void*)Vh, 0, 0x7ffffff0, 0x00020000);
#define VM0() asm volatile("s_waitcnt vmcnt(0)" ::: "memory")
#define KVDMA(b, k0) do { const int _o = (k0) * ldk * 2; LAS char* _k = K_lds + (b) * SHM_K + pz; LAS char* _v = V_lds + (b) * SHM_V2 + pz; \
    DMA16(krs, _k, kvo, _o); DMA16(krs, _k + 8192, kvo, _o + l32); DMA16(vrs, _v, vvo, _o); DMA16(vrs, _v + 8192, vvo, _o + l16); \
    DMA16(vrs, _v + 16384, vvo, _o + 2 * l16); DMA16(vrs, _v + 24576, vvo, _o + 3 * l16); } while (0)
  int ka[8];
  { const int kxor = (r32 & 7) << 4, krb = (int)(uintptr_t)K_lds + r32 * 256;
#pragma unroll
    for (int d0 = 0; d0 < 8; ++d0) ka[d0] = krb + (((d0 * 16 + hi * 8) * 2) ^ kxor); }
  f32x16 P; bf16x8 pa0, pa1, f0, f1, f2, f3; VSet va, vb_, vc;
  const int NT = seq / KVBLK;
#define PINIT() do { _Pragma("unroll") for (int r = 0; r < 16; ++r) { float _z; asm volatile("v_mov_b32 %0, %1" : "=v"(_z) : "v"(SHIFT ? nmc : 0.f)); P[r] = _z; } } while (0)
#define KOFF(b, h) ((b) * 16384 + (h) * 8192)
#define VOFF(b, h, d0) ((b) * 32768 + (h) * 16384 + (d0) * 512)
#define KPRO(b, h) do { f0 = k_read<KOFF(b, h)>(ka[0]); f1 = k_read<KOFF(b, h)>(ka[1]); f2 = k_read<KOFF(b, h)>(ka[2]); } while (0)
#define QKM(F, d0) do { SCHED; P = __builtin_amdgcn_mfma_f32_32x32x16_bf16(F, qr[d0], P, 0, 0, 0); SCHED; } while (0)
#define QKHALF(b, h) do { PINIT(); \
    LGK(2); QKM(f0, 0); f3 = k_read<KOFF(b, h)>(ka[3]); \
    LGK(2); QKM(f1, 1); f0 = k_read<KOFF(b, h)>(ka[4]); \
    LGK(2); QKM(f2, 2); f1 = k_read<KOFF(b, h)>(ka[5]); \
    LGK(2); QKM(f3, 3); f2 = k_read<KOFF(b, h)>(ka[6]); \
    LGK(2); QKM(f0, 4); f3 = k_read<KOFF(b, h)>(ka[7]); \
    LGK(2); QKM(f1, 5); v_read<VOFF(b, h, 0)>(va, vb0); \
    LGK(5); QKM(f2, 6); v_read<VOFF(b, h, 1)>(vb_, vb0); \
    LGK(8); QKM(f3, 7); } while (0)
#define SMH() do { exp16(P); l_reg += sum16(P); PK4(P, 0, pa0); PK4(P, 8, pa1); } while (0)
#define PVM(S, d0) do { SCHED; pv2(o[d0], S, pa0, pa1); SCHED; } while (0)
#define PVHALF(b, h, NEXTK, nb, nh) do { \
    LGK(4); PVM(va, 0); v_read<VOFF(b, h, 2)>(vc, vb0); \
    LGK(4); PVM(vb_, 1); v_read<VOFF(b, h, 3)>(va, vb0); \
    LGK(4); PVM(vc, 2); v_read<VOFF(b, h, 4)>(vb_, vb0); \
    LGK(4); PVM(va, 3); v_read<VOFF(b, h, 5)>(vc, vb0); \
    LGK(4); PVM(vb_, 4); v_read<VOFF(b, h, 6)>(va, vb0); \
    LGK(4); PVM(vc, 5); v_read<VOFF(b, h, 7)>(vb_, vb0); \
    LGK(4); PVM(va, 6); if (NEXTK) { f0 = k_read<KOFF(nb, nh)>(ka[0]); f1 = k_read<KOFF(nb, nh)>(ka[1]); } \
    if (NEXTK) { LGK(2); } else { LGK(0); } PVM(vb_, 7); if (NEXTK) { f2 = k_read<KOFF(nb, nh)>(ka[2]); } } while (0)
#define STEPC(b, j) do { if ((j) + 1 < NT) KVDMA((b) ^ 1, ((j) + 1) * KVBLK); \
    KPRO(b, 0); QKHALF(b, 0); SMH(); PVHALF(b, 0, true, b, 1); \
    QKHALF(b, 1); SMH(); PVHALF(b, 1, false, 0, 0); \
    VM0(); __syncthreads(); } while (0)
  KVDMA(0, 0); VM0(); __syncthreads();
  for (int j = 0; j < NT; j += 2) { STEPC(0, j); STEPC(1, j + 1); }
  { auto rr = __builtin_amdgcn_permlane32_swap(__float_as_uint(l_reg), __float_as_uint(l_reg), false, false); l_reg = __uint_as_float(rr[0]) + __uint_as_float(rr[1]); }
  if (hi == 0) li_l[r32] = l_reg; asm volatile("s_waitcnt lgkmcnt(0)" ::: "memory");
  bf16_t* Ow = Ob + (long)(wid * QBLK) * ldo;
#pragma unroll
  for (int r = 0; r < 16; ++r) { const int orow = crow(r, hi); const float rl = __builtin_amdgcn_rcpf(li_l[orow]);
#pragma unroll
    for (int d0 = 0; d0 < 8; ++d0) Ow[(long)orow * ldo + d0 * 32 + r32] = f2bf(o[d0][r] * rl); }
  VM0();
  __syncthreads();
#undef KVDMA
#undef PINIT
#undef KOFF
#undef VOFF
#undef KPRO
#undef QKM
#undef QKHALF
#undef SMH
#undef PVM
#undef PVHALF
#undef STEPC
#undef VM0
}
__device__ __forceinline__ void attn_body_c256(const bf16_t* __restrict__ Qb, const int ldq, const bf16_t* __restrict__ Kh, const bf16_t* __restrict__ Vh, const int ldk,
                                               bf16_t* __restrict__ Ob, const int ldo, const int seq, const float kmax2, LAS char* lds) {
  int tid = threadIdx.x; asm volatile("" : "+v"(tid)); tid &= 511;
  const int wid = tid >> 6, lane = tid & 63, r32 = lane & 31, hi = lane >> 5;
  bf16x8 qr[8];
  const float nmc = load_q(Qb + (long)(wid * QBLK + r32) * ldq + hi * 8, qr, kmax2);
  if (__all(nmc > -64.f)) attn_body_c256_t<false>(Qb, ldq, Kh, Vh, ldk, Ob, ldo, seq, 0.f, qr, lds);
  else attn_body_c256_t<true>(Qb, ldq, Kh, Vh, ldk, Ob, ldo, seq, nmc, qr, lds);
}

__device__ __forceinline__ float load_q8(const bf16_t* __restrict__ Qrow, int hi, v8i_ (&qf)[2], float kmax2) {
  float ss = 0;
#pragma unroll
  for (int st = 0; st < 2; ++st) {
    const bf16_t* p = Qrow + 64 * st + 32 * hi; v8i_ o;
#pragma unroll
    for (int c = 0; c < 4; ++c) { const u32x4 raw = *reinterpret_cast<const u32x4*>(p + 8 * c);
      const unsigned w0 = pack8x4(bflo(raw[0]) * QC, bfhi(raw[0]) * QC, bflo(raw[1]) * QC, bfhi(raw[1]) * QC);
      const unsigned w1 = pack8x4(bflo(raw[2]) * QC, bfhi(raw[2]) * QC, bflo(raw[3]) * QC, bfhi(raw[3]) * QC);
      o[2 * c] = (int)w0; o[2 * c + 1] = (int)w1; ss += sq8x4(w0) + sq8x4(w1); }
    qf[st] = o;
  }
  { auto rr = __builtin_amdgcn_permlane32_swap(__float_as_uint(ss), __float_as_uint(ss), false, false); ss = __uint_as_float(rr[0]) + __uint_as_float(rr[1]); }
  return -(sqrtf(ss * kmax2) * 1.01f + 1e-3f);
}
__device__ __forceinline__ int k8_dma_voff(int wid, int lane, int ldk8) {
  const int row = 8 * wid + (lane >> 3); return row * ldk8 + (((lane & 7) ^ ((row >> 1) & 7)) << 4); }
template <int OFF> __device__ __forceinline__ v4i k8_read(int ka) { v4i r; asm volatile("ds_read_b128 %0, %1 offset:%2" : "=&v"(r) : "v"(ka), "i"(OFF) : "memory"); return r; }

template <bool SHIFT>
__device__ __forceinline__ void attn_body_c256q8_t(const unsigned char* __restrict__ K8, const int ldk8, const bf16_t* __restrict__ Vh, const int ldk,
                                                   bf16_t* __restrict__ Ob, const int ldo, const int seq, const float nmc, const v8i_ (&qf)[2], LAS char* lds) {
  int tid = threadIdx.x; asm volatile("" : "+v"(tid)); tid &= 511;
  const int wid = __builtin_amdgcn_readfirstlane(tid >> 6), lane = tid & 63, r32 = lane & 31, hi = lane >> 5;
  constexpr int SHM_K8 = KVBLK * 128;
  LAS char* K_lds = lds; LAS char* V_lds = lds + 2 * SHM_K8;
  LAS float* li_l = (LAS float*)(lds + 2 * SHM_K8 + 2 * SHM_V2) + wid * 64;
  float l_reg = 0; f32x16 o[8] = {};
  const int vb0 = (int)(uintptr_t)V_lds + v_rd_base(lane);
  const int kvo = k8_dma_voff(wid, lane, ldk8);
  const int vvo = unswap23(8 * (wid >> 2) + ((lane & 31) >> 2)) * ldk * 2 + ((2 * (wid & 3) + (lane >> 5)) * 32 + (lane & 3) * 8) * 2;
  const int l16 = 32 * ldk, pz = wid * 1024;
  const __amdgpu_buffer_rsrc_t krs = __builtin_amdgcn_make_buffer_rsrc((void*)K8, 0, 0x7ffffff0, 0x00020000);
  const __amdgpu_buffer_rsrc_t vrs = __builtin_amdgcn_make_buffer_rsrc((void*)Vh, 0, 0x7ffffff0, 0x00020000);
#define VM0() asm volatile("s_waitcnt vmcnt(0)" ::: "memory")
#define KVDMA(b, k0) do { const int _o = (k0) * ldk * 2; LAS char* _v = V_lds + (b) * SHM_V2 + pz; \
    DMA16(krs, K_lds + (b) * SHM_K8 + pz, kvo, (k0) * ldk8); DMA16(vrs, _v, vvo, _o); DMA16(vrs, _v + 8192, vvo, _o + l16); \
    DMA16(vrs, _v + 16384, vvo, _o + 2 * l16); DMA16(vrs, _v + 24576, vvo, _o + 3 * l16); } while (0)
  const int ka0 = (int)(uintptr_t)K_lds + r32 * 128 + (((2 * hi) ^ ((r32 >> 1) & 7)) << 4);
  const int ka1 = ka0 ^ 16, ka2 = ka0 ^ 64, ka3 = ka0 ^ 80;
  int sc1; asm volatile("v_mov_b32 %0, 0x7f7f7f7f" : "=v"(sc1));
  f32x16 P; bf16x8 pa0, pa1; v4i k0a, k0b, k1a, k1b; VSet va, vb_, vc;
  const int NT = seq / KVBLK;
#define KOFF(b, h) ((b) * 8192 + (h) * 4096)
#define VOFF(b, h, d0) ((b) * 32768 + (h) * 16384 + (d0) * 512)
#define KPRO(b, h) do { k0a = k8_read<KOFF(b, h)>(ka0); k0b = k8_read<KOFF(b, h)>(ka1); k1a = k8_read<KOFF(b, h)>(ka2); k1b = k8_read<KOFF(b, h)>(ka3); } while (0)
#define V8(x, y) (v8i_){x[0], x[1], x[2], x[3], y[0], y[1], y[2], y[3]}
#define QKHALF(b, h) do { \
    if (SHIFT) { _Pragma("unroll") for (int r = 0; r < 16; ++r) { float _z; asm volatile("v_mov_b32 %0, %1" : "=v"(_z) : "v"(nmc)); P[r] = _z; } } \
    LGK(2); SCHED; { const v8i_ kf = V8(k0a, k0b); \
      if (SHIFT) asm volatile("s_nop 4\n\tv_mfma_scale_f32_32x32x64_f8f6f4 %0, %1, %2, %0, %3, %3 op_sel_hi:[0,0,0]" : "+v"(P) : "v"(kf), "v"(qf[0]), "v"(sc1)); \
      else       asm volatile("v_mfma_scale_f32_32x32x64_f8f6f4 %0, %1, %2, 0, %3, %3 op_sel_hi:[0,0,0]" : "=&v"(P) : "v"(kf), "v"(qf[0]), "v"(sc1)); } \
    SCHED; v_read<VOFF(b, h, 0)>(va, vb0); \
    LGK(4); SCHED; { const v8i_ kf = V8(k1a, k1b); \
      asm volatile("v_mfma_scale_f32_32x32x64_f8f6f4 %0, %1, %2, %0, %3, %3 op_sel_hi:[0,0,0]" : "+v"(P) : "v"(kf), "v"(qf[1]), "v"(sc1)); } \
    SCHED; v_read<VOFF(b, h, 1)>(vb_, vb0); \
    asm volatile("s_nop 15\n\ts_nop 7" : "+v"(P)); } while (0)
#define SMH() do { exp16(P); l_reg += sum16(P); PK4(P, 0, pa0); PK4(P, 8, pa1); } while (0)
#define PVM(S, d0) do { SCHED; pv2(o[d0], S, pa0, pa1); SCHED; } while (0)
#define PVHALF(b, h, NEXTK, nb, nh) do { \
    LGK(4); PVM(va, 0); v_read<VOFF(b, h, 2)>(vc, vb0); \
    LGK(4); PVM(vb_, 1); v_read<VOFF(b, h, 3)>(va, vb0); \
    LGK(4); PVM(vc, 2); v_read<VOFF(b, h, 4)>(vb_, vb0); \
    LGK(4); PVM(va, 3); v_read<VOFF(b, h, 5)>(vc, vb0); \
    LGK(4); PVM(vb_, 4); v_read<VOFF(b, h, 6)>(va, vb0); \
    LGK(4); PVM(vc, 5); v_read<VOFF(b, h, 7)>(vb_, vb0); \
    LGK(4); PVM(va, 6); if (NEXTK) { k0a = k8_read<KOFF(nb, nh)>(ka0); k0b = k8_read<KOFF(nb, nh)>(ka1); } \
    if (NEXTK) { LGK(2); } else { LGK(0); } PVM(vb_, 7); if (NEXTK) { k1a = k8_read<KOFF(nb, nh)>(ka2); k1b = k8_read<KOFF(nb, nh)>(ka3); } } while (0)
#define STEPC(b, j) do { if ((j) + 1 < NT) KVDMA((b) ^ 1, ((j) + 1) * KVBLK); \
    KPRO(b, 0); QKHALF(b, 0); SMH(); PVHALF(b, 0, true, b, 1); \
    QKHALF(b, 1); SMH(); PVHALF(b, 1, false, 0, 0); \
    VM0(); __syncthreads(); } while (0)
  KVDMA(0, 0); VM0(); __syncthreads();
  for (int j = 0; j < NT; j += 2) { STEPC(0, j); STEPC(1, j + 1); }
  { auto rr = __builtin_amdgcn_permlane32_swap(__float_as_uint(l_reg), __float_as_uint(l_reg), false, false); l_reg = __uint_as_float(rr[0]) + __uint_as_float(rr[1]); }
  if (hi == 0) li_l[r32] = l_reg; asm volatile("s_waitcnt lgkmcnt(0)" ::: "memory");
  bf16_t* Ow = Ob + (long)(wid * QBLK) * ldo;
#pragma unroll
  for (int r = 0; r < 16; ++r) { const int orow = crow(r, hi); const float rl = __builtin_amdgcn_rcpf(li_l[orow]);
#pragma unroll
    for (int d0 = 0; d0 < 8; ++d0) Ow[(long)orow * ldo + d0 * 32 + r32] = f2bf(o[d0][r] * rl); }
  VM0();
  __syncthreads();
#undef KVDMA
#undef KOFF
#undef VOFF
#undef KPRO
#undef V8
#undef QKHALF
#undef SMH
#undef PVM
#undef PVHALF
#undef STEPC
#undef VM0
}
__device__ __forceinline__ void attn_body_c256q8(const bf16_t* __restrict__ Qb, const int ldq, const unsigned char* __restrict__ K8, const int ldk8,
                                                 const bf16_t* __restrict__ Vh, const int ldk, bf16_t* __restrict__ Ob, const int ldo, const int seq, const float kmax2, LAS char* lds) {
  int tid = threadIdx.x; asm volatile("" : "+v"(tid)); tid &= 511;
  const int wid = tid >> 6, lane = tid & 63, r32 = lane & 31, hi = lane >> 5;
  v8i_ qf[2];
  const float nmc = load_q8(Qb + (long)(wid * QBLK + r32) * ldq, hi, qf, kmax2);
  if (__all(nmc > -64.f)) attn_body_c256q8_t<false>(K8, ldk8, Vh, ldk, Ob, ldo, seq, 0.f, qf, lds);
  else attn_body_c256q8_t<true>(K8, ldk8, Vh, ldk, Ob, ldo, seq, nmc, qf, lds);
}

template <bool SHIFT>
__device__ __forceinline__ void attn_body_q8_t(const unsigned char* __restrict__ K8, const int ldk8, const bf16_t* __restrict__ Vh, const int ldk,
                                               bf16_t* __restrict__ Ob, const int ldo, const int seq, const float nmc, const v8i_ (&qf)[2], LAS char* lds) {
  int tid = threadIdx.x; asm volatile("" : "+v"(tid)); tid &= 511;
  const int wid = __builtin_amdgcn_readfirstlane(tid >> 6), lane = tid & 63, r32 = lane & 31, hi = lane >> 5;
  constexpr int SK8 = KVBLK * 128, ST = SK8 + SHM_V;
  LAS float* li_l = (LAS float*)(lds + 3 * ST) + wid * 64;
  float l_reg = 0; f32x16 o[4] = {};
  const int vrb = v_rd_base(lane);
  const int kvo = k8_dma_voff(wid, lane, ldk8);
  const int vvo = unswap23(8 * (wid >> 1) + ((lane & 31) >> 2)) * ldk * 2 + ((2 * (wid & 1) + (lane >> 5)) * 32 + (lane & 3) * 8) * 2;
  const int l32 = 64 * ldk, pz = wid * 1024;
  const __amdgpu_buffer_rsrc_t krs = __builtin_amdgcn_make_buffer_rsrc((void*)K8, 0, 0x7ffffff0, 0x00020000);
  const __amdgpu_buffer_rsrc_t vrs = __builtin_amdgcn_make_buffer_rsrc((void*)Vh, 0, 0x7ffffff0, 0x00020000);
#define TDMA(slot, k0) do { const int _o = (k0) * ldk * 2; LAS char* _b = lds + (slot) * ST + pz; \
    DMA16(krs, _b, kvo, (k0) * ldk8); DMA16(vrs, _b + SK8, vvo, _o); DMA16(vrs, _b + SK8 + 8192, vvo, _o + l32); } while (0)
#define VM0() asm volatile("s_waitcnt vmcnt(0)" ::: "memory")
  int sc1; asm volatile("v_mov_b32 %0, 0x7f7f7f7f" : "=v"(sc1));
  const int kof = r32 * 128 + (((2 * hi) ^ ((r32 >> 1) & 7)) << 4);
#define QKT8(P0, P1, Ks) do { \
    const v4i a0 = *(LAS const v4i*)((Ks) + kof), a1 = *(LAS const v4i*)((Ks) + (kof ^ 16)), a2 = *(LAS const v4i*)((Ks) + (kof ^ 64)), a3 = *(LAS const v4i*)((Ks) + (kof ^ 80)); \
    const v4i b0 = *(LAS const v4i*)((Ks) + 4096 + kof), b1 = *(LAS const v4i*)((Ks) + 4096 + (kof ^ 16)), b2 = *(LAS const v4i*)((Ks) + 4096 + (kof ^ 64)), b3 = *(LAS const v4i*)((Ks) + 4096 + (kof ^ 80)); \
    v8i_ k00 = (v8i_){a0[0], a0[1], a0[2], a0[3], a1[0], a1[1], a1[2], a1[3]}, k01 = (v8i_){a2[0], a2[1], a2[2], a2[3], a3[0], a3[1], a3[2], a3[3]}; \
    v8i_ k10 = (v8i_){b0[0], b0[1], b0[2], b0[3], b1[0], b1[1], b1[2], b1[3]}, k11 = (v8i_){b2[0], b2[1], b2[2], b2[3], b3[0], b3[1], b3[2], b3[3]}; \
    if (SHIFT) { _Pragma("unroll") for (int r = 0; r < 16; ++r) { P0[r] = nmc; P1[r] = nmc; } \
      asm volatile("s_nop 4\n\tv_mfma_scale_f32_32x32x64_f8f6f4 %0, %1, %2, %0, %3, %3 op_sel_hi:[0,0,0]" : "+v"(P0) : "v"(k00), "v"(qf[0]), "v"(sc1)); \
      asm volatile("v_mfma_scale_f32_32x32x64_f8f6f4 %0, %1, %2, %0, %3, %3 op_sel_hi:[0,0,0]" : "+v"(P1) : "v"(k10), "v"(qf[0]), "v"(sc1)); } \
    else { asm volatile("v_mfma_scale_f32_32x32x64_f8f6f4 %0, %1, %2, 0, %3, %3 op_sel_hi:[0,0,0]" : "=&v"(P0) : "v"(k00), "v"(qf[0]), "v"(sc1)); \
      asm volatile("v_mfma_scale_f32_32x32x64_f8f6f4 %0, %1, %2, 0, %3, %3 op_sel_hi:[0,0,0]" : "=&v"(P1) : "v"(k10), "v"(qf[0]), "v"(sc1)); } \
    asm volatile("v_mfma_scale_f32_32x32x64_f8f6f4 %0, %1, %2, %0, %3, %3 op_sel_hi:[0,0,0]" : "+v"(P0) : "v"(k01), "v"(qf[1]), "v"(sc1)); \
    asm volatile("v_mfma_scale_f32_32x32x64_f8f6f4 %0, %1, %2, %0, %3, %3 op_sel_hi:[0,0,0]" : "+v"(P1) : "v"(k11), "v"(qf[1]), "v"(sc1)); \
      \
    asm volatile("s_nop 15" : "+v"(k00), "+v"(k01), "+v"(k10), "+v"(k11)); } while (0)
#define TIE(P0, P1) asm volatile("s_nop 15\n\ts_nop 7" : "+v"(P0), "+v"(P1))
#define TIE0(P0, P1) asm volatile("" : "+v"(P0), "+v"(P1))
#define FINISH(P0, P1) do { exp16(P1); l_reg += sum16(P0) + sum16(P1); PK4(P0, 0, pa0); PK4(P0, 8, pa1); PK4(P1, 0, pa2); PK4(P1, 8, pa3); } while (0)
  f32x16 pA0, pA1, pB0, pB1; bf16x8 pa0, pa1, pa2, pa3; const int NT = seq / KVBLK;
  TDMA(0, 0); VM0(); __syncthreads();
  TDMA(1, KVBLK);
  QKT8(pA0, pA1, lds); TIE(pA0, pA1); exp16(pA0);
  VM0(); __syncthreads();
  int sk = 1, sv = 0, sd = 2;
  for (int j = 1; j + 1 < NT; j += 2) {
    TDMA(sd, (j + 1) * KVBLK);
    SCHED; QKT8(pB0, pB1, lds + sk * ST);
    FINISH(pA0, pA1); SCHED;
    pv_d0(o, (int)(uintptr_t)(lds + sv * ST + SK8) + vrb, pa0, pa1, pa2, pa3); TIE0(pB0, pB1); exp16(pB0);
    VM0(); __syncthreads();
    { const int t = sv; sv = sk; sk = sd; sd = t; }
    if (j + 2 < NT) TDMA(sd, (j + 2) * KVBLK);
    SCHED; QKT8(pA0, pA1, lds + sk * ST);
    FINISH(pB0, pB1); SCHED;
    pv_d0(o, (int)(uintptr_t)(lds + sv * ST + SK8) + vrb, pa0, pa1, pa2, pa3); TIE0(pA0, pA1); exp16(pA0);
    VM0(); __syncthreads();
    { const int t = sv; sv = sk; sk = sd; sd = t; }
  }
  SCHED; QKT8(pB0, pB1, lds + sk * ST);
  FINISH(pA0, pA1); SCHED;
  pv_d0(o, (int)(uintptr_t)(lds + sv * ST + SK8) + vrb, pa0, pa1, pa2, pa3); TIE0(pB0, pB1); exp16(pB0);
  FINISH(pB0, pB1); SCHED;
  pv_d0(o, (int)(uintptr_t)(lds + sk * ST + SK8) + vrb, pa0, pa1, pa2, pa3);
  { auto rr = __builtin_amdgcn_permlane32_swap(__float_as_uint(l_reg), __float_as_uint(l_reg), false, false); l_reg = __uint_as_float(rr[0]) + __uint_as_float(rr[1]); }
  store_o(o, l_reg, li_l, Ob + (long)(wid * QBLK) * ldo, ldo, r32, hi);
  VM0();
  __syncthreads();
#undef TDMA
#undef VM0
#undef QKT8
#undef TIE
#undef TIE0
#undef FINISH
}
__device__ __forceinline__ void attn_body_q8(const bf16_t* __restrict__ Qb, const int ldq, const unsigned char* __restrict__ K8, const int ldk8,
                                             const bf16_t* __restrict__ Vh, const int ldk, bf16_t* __restrict__ Ob, const int ldo, const int seq, const float kmax2, LAS char* lds) {
  int tid = threadIdx.x; asm volatile("" : "+v"(tid)); tid &= 511;
  const int wid = tid >> 6, lane = tid & 63, r32 = lane & 31, hi = lane >> 5;
  v8i_ qf[2];
  const float nmc = load_q8(Qb + (long)(wid * QBLK + r32) * ldq, hi, qf, kmax2);
  if (__all(nmc > -64.f)) attn_body_q8_t<false>(K8, ldk8, Vh, ldk, Ob, ldo, seq, 0.f, qf, lds);
  else attn_body_q8_t<true>(K8, ldk8, Vh, ldk, Ob, ldo, seq, nmc, qf, lds);
}
#undef PK4
}

__device__ __forceinline__ int perm_plain8(int n) { const int r = n & 31; return (n & ~31) + 16 * ((r >> 2) & 1) + 4 * (r >> 3) + (r & 3); }
__device__ __forceinline__ int perm_row(int kind, int n) {
  if (kind == 0) return perm_plain8(n);
  if (kind == 1) { if (n < N_QKV0) return perm_plain8(n); const int c = n - N_QKV0; const int ch = c & 1023; return N_QKV0 + 32 * (ch >> 4) + ((c >> 10) << 4) + (ch & 15); }
  return 32 * (n >> 4) + ((kind == 3) ? 16 : 0) + (n & 15);
}
__device__ __forceinline__ void cvt_tile(const float* __restrict__ src, int N, bf16_t* __restrict__ dst, int K, int kind, int k0, int n0, LAS unsigned* t32) {
  int tid = threadIdx.x; asm volatile("" : "+v"(tid)); tid &= 511;
#pragma unroll
  for (int j = 0; j < 2; ++j) {
    const int item = tid + 512 * j, kp = item >> 4, q = item & 15;
    const f32x4 v0 = *(const f32x4*)(src + (size_t)(k0 + 2 * kp) * N + n0 + 4 * q);
    const f32x4 v1 = *(const f32x4*)(src + (size_t)(k0 + 2 * kp + 1) * N + n0 + 4 * q);
#pragma unroll
    for (int i = 0; i < 4; ++i) t32[(4 * q + i) * 65 + kp] = cvtpk(v0[i], v1[i]);
  }
  __syncthreads();
#pragma unroll
  for (int j = 0; j < 2; ++j) {
    const int item = tid + 512 * j, n = item >> 4, ko = item & 15;
    u32x4 v;
#pragma unroll
    for (int i = 0; i < 4; ++i) v[i] = t32[n * 65 + 4 * ko + i];
    *(u32x4*)(dst + (size_t)perm_row(kind, n0 + n) * K + k0 + 8 * ko) = v;
  }
  __syncthreads();
}
__device__ __forceinline__ void cvt_matrix_units(const float* src, int K, int N, bf16_t* dst, int kind, int u0, int ustride, LAS unsigned* t32) {
  const int nN = N / 64, nK = K / 128;
  for (int u = u0; u < nN * nK; u += ustride) cvt_tile(src, N, dst, K, kind, (u / nN) * 128, (u % nN) * 64, t32);
}
constexpr size_t WMOE8_E = (size_t)1024 * D + (size_t)D * EFF;
__device__ __forceinline__ void cvt_tile8(const float* __restrict__ src, int N, unsigned char* __restrict__ dst, int K, int kind, int k0, int n0, float scale, LAS unsigned* t32) {
  int tid = threadIdx.x; asm volatile("" : "+v"(tid)); tid &= 511;
  { const int kq = tid >> 4, q = tid & 15;
    f32x4 v[4];
#pragma unroll
    for (int r = 0; r < 4; ++r) v[r] = *(const f32x4*)(src + (size_t)(k0 + 4 * kq + r) * N + n0 + 4 * q);
#pragma unroll
    for (int i = 0; i < 4; ++i) t32[(4 * q + i) * 33 + kq] = pack_fp8x4(v[0][i] * scale, v[1][i] * scale, v[2][i] * scale, v[3][i] * scale); }
  __syncthreads();
  { const int n = tid >> 3, kc = tid & 7;
    u32x4 v;
#pragma unroll
    for (int i = 0; i < 4; ++i) v[i] = t32[n * 33 + 4 * kc + i];
    *(u32x4*)(dst + (size_t)perm_row(kind, n0 + n) * K + k0 + 16 * kc) = v; }
  __syncthreads();
}
__device__ __forceinline__ void cvt_moe_all8(const Args& a, LAS unsigned* t32) {
  unsigned char* W = (unsigned char*)(a.ws + WS_WMOE);
  for (int u = blockIdx.x; u < 2 * 65 * 384; u += gridDim.x) {
    const int le = u / 384, L = le / 65, e = le % 65, r = u % 384, mtx = r >> 7, lu = r & 127;
    const float* src; unsigned char* dst = W + (size_t)le * WMOE8_E; int K, N, kind; float sc;
    if (mtx == 0)      { src = e < 64 ? a.in[21] + ((size_t)L * 64 + e) * D * EFF : a.in[24] + (size_t)L * D * EFF; K = D; N = EFF; kind = 2; sc = 256.f; }
    else if (mtx == 1) { src = e < 64 ? a.in[22] + ((size_t)L * 64 + e) * D * EFF : a.in[25] + (size_t)L * D * EFF; K = D; N = EFF; kind = 3; sc = 256.f; }
    else               { src = e < 64 ? a.in[23] + ((size_t)L * 64 + e) * EFF * D : a.in[26] + (size_t)L * EFF * D; K = EFF; N = D; kind = 0; sc = 128.f; dst += (size_t)1024 * D; }
    const int nN = N / 64;
    cvt_tile8(src, N, dst, K, kind, (lu / nN) * 128, (lu % nN) * 64, sc, t32);
  }
}

__device__ __forceinline__ void ld_row_f32(const float* __restrict__ p, int lane, float (&v)[32]) {
#pragma unroll
  for (int j = 0; j < 4; ++j) { const f32x4 t0 = *(const f32x4*)(p + 8 * lane + 512 * j), t1 = *(const f32x4*)(p + 8 * lane + 512 * j + 4);
#pragma unroll
    for (int i = 0; i < 4; ++i) { v[8 * j + i] = t0[i]; v[8 * j + 4 + i] = t1[i]; } }
}
__device__ __forceinline__ void ld_row_bf16(const bf16_t* __restrict__ p, int lane, float (&v)[32]) {
#pragma unroll
  for (int j = 0; j < 4; ++j) { const u32x4 t = *(const u32x4*)(p + 8 * lane + 512 * j);
#pragma unroll
    for (int i = 0; i < 4; ++i) { v[8 * j + 2 * i] = bflo(t[i]); v[8 * j + 2 * i + 1] = bfhi(t[i]); } }
}
__device__ __forceinline__ void ld8f(const float* __restrict__ p, float (&x)[8]) { const f32x4 t0 = *(const f32x4*)p, t1 = *(const f32x4*)(p + 4);
#pragma unroll
  for (int i = 0; i < 4; ++i) { x[i] = t0[i]; x[4 + i] = t1[i]; } }
__device__ __forceinline__ void st8f(float* __restrict__ p, const float* x) { f32x4 t0 = {x[0], x[1], x[2], x[3]}, t1 = {x[4], x[5], x[6], x[7]}; *(f32x4*)p = t0; *(f32x4*)(p + 4) = t1; }
__device__ __forceinline__ float sumsq32(const float (&v)[32]) { float s = 0;
#pragma unroll
  for (int i = 0; i < 32; ++i) s += v[i] * v[i];
  return wave_sum(s); }
template <bool COPY, bool OUT8 = false>
__device__ __forceinline__ void modulate_store(const float (&v)[32], float rstd, const float* __restrict__ g, const float* __restrict__ shift, const float* __restrict__ scale,
                                               bf16_t* __restrict__ dst, int lane, LAS float* f32copy) {
#pragma unroll
  for (int j = 0; j < 4; ++j) {
    const int idx = 8 * lane + 512 * j;
    float gv[8], sh[8], sc[8], y[8]; ld8f(g + idx, gv); ld8f(shift + idx, sh); ld8f(scale + idx, sc);
#pragma unroll
    for (int i = 0; i < 8; ++i) y[i] = v[8 * j + i] * rstd * gv[i] * (1.f + sc[i]) + sh[i];
    if (OUT8) { u32x2 p8 = {pack_fp8x4(y[0], y[1], y[2], y[3]), pack_fp8x4(y[4], y[5], y[6], y[7])}; *(u32x2*)((unsigned char*)dst + idx) = p8; }
    else { u32x4 pk = {cvtpk(y[0], y[1]), cvtpk(y[2], y[3]), cvtpk(y[4], y[5]), cvtpk(y[6], y[7])}; *(u32x4*)(dst + idx) = pk; }
    if (COPY) { f32x4 t0 = {y[0], y[1], y[2], y[3]}, t1 = {y[4], y[5], y[6], y[7]};
      *(LAS f32x4*)(f32copy + idx) = t0; *(LAS f32x4*)(f32copy + idx + 4) = t1; }
  }
}

__device__ __forceinline__ void phase_prologue(const Args& a, LAS char* lds) {
  int tid = threadIdx.x; asm volatile("" : "+v"(tid)); tid &= 511; const int wave = tid >> 6, lane = tid & 63;
  {
    LAS float* sc = (LAS float*)lds;
    LAS float* part = sc + 4096;
    const float* c = a.in[1]; const float* cc = a.in[3];
    for (int i = tid; i < D; i += NTHREADS) { float v = c[i]; sc[i] = v * sigmoidf_(v); float u = cc[i]; sc[D + i] = u * sigmoidf_(u); }
    __syncthreads();
    float* MOD = (float*)(a.ws + WS_MOD);
    for (int u = blockIdx.x; u < 2 * 192; u += gridDim.x) {
      const int L = u / 192, chunk = u % 192;
      const float* W = a.in[4] + (size_t)L * D * 12288 + chunk * 64 + lane;
      float a0 = 0, a1 = 0; const int d0 = wave * 256;
#pragma unroll 8
      for (int dd = 0; dd < 256; ++dd) { const float w = W[(size_t)(d0 + dd) * 12288]; a0 += sc[d0 + dd] * w; a1 += sc[D + d0 + dd] * w; }
      part[(wave * 2 + 0) * 64 + lane] = a0; part[(wave * 2 + 1) * 64 + lane] = a1;
      __syncthreads();
      if (tid < 128) { const int which = tid >> 6; float s = 0;
#pragma unroll
        for (int w = 0; w < 8; ++w) s += part[(w * 2 + which) * 64 + lane];
        const int j = chunk * 64 + lane; MOD[(size_t)(L * 2 + which) * 12288 + j] = s + a.in[5][L * 12288 + j]; }
      __syncthreads();
    }
  }
  LAS unsigned* t32 = (LAS unsigned*)lds;
  cvt_matrix_units(a.in[7], D, N_IN0, (bf16_t*)(a.ws + WS_WIN0), 1, blockIdx.x, gridDim.x, t32);
  cvt_matrix_units(a.in[8], D, D, (bf16_t*)(a.ws + WS_WOUT0), 0, blockIdx.x, gridDim.x, t32);
  cvt_matrix_units(a.in[15], D, N_IN1, (bf16_t*)(a.ws + WS_WIN1), 0, blockIdx.x, gridDim.x, t32);
  cvt_matrix_units(a.in[16], D, D, (bf16_t*)(a.ws + WS_WOUT1), 0, blockIdx.x, gridDim.x, t32);
  cvt_moe_all8(a, t32);
}

__device__ __forceinline__ void phase_modulate0(const Args& a) {
  int tid = threadIdx.x; asm volatile("" : "+v"(tid)); tid &= 511; const int wave = tid >> 6, lane = tid & 63;
  const float* MOD = (const float*)(a.ws + WS_MOD);
  bf16_t* A = (bf16_t*)(a.ws + WS_ABUF);
  for (int it = blockIdx.x; it < MT / 8; it += gridDim.x) {
    const int r = it * 8 + wave;
    const float* src = r < CTXL ? a.in[2] + (size_t)r * D : a.in[0] + (size_t)(r - CTXL) * D;
    const float* mod = MOD + (r < CTXL ? 12288 : 0);
    float v[32]; ld_row_f32(src, lane, v);
    const float rstd = rsqrtf(sumsq32(v) * (1.f / D) + EPS);
    modulate_store<false>(v, rstd, a.in[6], mod, mod + D, A + (size_t)r * D, lane, nullptr);
  }
}

__device__ __forceinline__ void rope_cs4(int r, int lane, float (&cs)[4], float (&sn)[4]) {
#pragma unroll
  for (int q = 0; q < 4; ++q) { cs[q] = 1.f; sn[q] = 0.f; }
  if (r >= CTXL) { const int t = r - CTXL; const int l = lane & 15, a = l >> 3, i0 = 4 * (l & 7);
    const float pos = a ? (float)(t & 63) : (float)(t >> 6);
#pragma unroll
    for (int q = 0; q < 4; ++q) { const float inv = powf(10000.f, -(float)(i0 + q) / 32.f); sincosf(pos * inv, &sn[q], &cs[q]); } }
}
__device__ __forceinline__ float sum16lanes(float v) { v += __shfl_xor(v, 1); v += __shfl_xor(v, 2); v += __shfl_xor(v, 4); v += __shfl_xor(v, 8); return v; }
__device__ __forceinline__ void phase_rope_conv0(const Args& a, LAS char* lds, bool dry = false) {
  int tid = threadIdx.x; asm volatile("" : "+v"(tid)); tid &= 511; const int wave = tid >> 6, lane = tid & 63;
  bf16_t* Q = (bf16_t*)(a.ws + WS_QKVU);
  {
    const bf16_t* HG = (const bf16_t*)(a.ws + WS_HG);
    bf16_t* X2 = (bf16_t*)(a.ws + WS_X2);
    LAS char* lt = lds;
    LAS float* part = (LAS float*)(lds + 62 * 2048);
    LAS float* stats = part + 512;
    const float* dw_w = a.in[11]; const float* dw_b = a.in[12]; const float* ln_g = a.in[13]; const float* ln_b = a.in[14];
    const __amdgpu_buffer_rsrc_t wrs = __builtin_amdgcn_make_buffer_rsrc((void*)dw_w, 0, 31 * 1024 * 4, 0x00020000);
    for (int u = blockIdx.x; u < 520; u += gridDim.x) {
      int seg0, seg1, r0;
      if (u < 8) { seg0 = 0; seg1 = CTXL; r0 = u * 32; } else { seg0 = CTXL; seg1 = MT; r0 = CTXL + (u - 8) * 32; }
      for (int c = tid; c < 62 * 128; c += NTHREADS) { const int rr = c >> 7, cc = c & 127, gr = r0 - 15 + rr;
        u32x4 v = {0u, 0u, 0u, 0u}; if (gr >= seg0 && gr < seg1) v = *(const u32x4*)(HG + (size_t)gr * 1024 + cc * 8);
        *(LAS u32x4*)(lt + rr * 2048 + cc * 16) = v; }
      __syncthreads();
      float w0[31], w1[31];
#pragma unroll
      for (int j = 0; j < 31; ++j) { const u32x2 w = __builtin_amdgcn_raw_buffer_load_b64(wrs, tid * 8, j * 4096, 0); w0[j] = __uint_as_float(w[0]); w1[j] = __uint_as_float(w[1]); }
      const f32x2 bb = *(const f32x2*)(dw_b + 2 * tid);
      const f32x2 gg = *(const f32x2*)(ln_g + 2 * tid), gb = *(const f32x2*)(ln_b + 2 * tid);
#pragma unroll 1
      for (int hf = 0; hf < 4; ++hf) {
        float o0[8], o1[8];
        LAS const char* lth = lt + (hf * 8) * 2048 + tid * 4;
#pragma unroll
        for (int r = 0; r < 8; ++r) { o0[r] = bb[0]; o1[r] = bb[1]; }
#pragma unroll
        for (int i = 0; i < 38; ++i) {
          const unsigned p = *(LAS const unsigned*)(lth + i * 2048);
          const float x0 = bflo(p), x1 = bfhi(p);
#pragma unroll
          for (int r = 0; r < 8; ++r) { const int j = i - r; if (j >= 0 && j < 31) { o0[r] += x0 * w0[j]; o1[r] += x1 * w1[j]; } }
        }
#pragma unroll
        for (int r = 0; r < 8; ++r) {
          const float s = wave_sum(o0[r] + o1[r]), q = wave_sum(o0[r] * o0[r] + o1[r] * o1[r]);
          if (lane == 0) { part[(r * 8 + wave) * 2] = s; part[(r * 8 + wave) * 2 + 1] = q; }
        }
        __syncthreads();
        if (tid < 8) { float s = 0, q = 0;
#pragma unroll
          for (int w = 0; w < 8; ++w) { s += part[(tid * 8 + w) * 2]; q += part[(tid * 8 + w) * 2 + 1]; }
          const float mean = s * (1.f / 1024), var = q * (1.f / 1024) - mean * mean;
          stats[tid * 2] = mean; stats[tid * 2 + 1] = rsqrtf(fmaxf(var, 0.f) + EPS); }
        __syncthreads();
#pragma unroll
        for (int r = 0; r < 8; ++r) {
          const float mean = stats[r * 2], rstd = stats[r * 2 + 1];
          float y0 = (o0[r] - mean) * rstd * gg[0] + gb[0], y1 = (o1[r] - mean) * rstd * gg[1] + gb[1];
          y0 = y0 * sigmoid_fast(y0); y1 = y1 * sigmoid_fast(y1);
          *(unsigned*)(X2 + (size_t)(r0 + hf * 8 + r) * D + 1024 + 2 * tid) = cvtpk(y0, y1);
        }
      }
      __syncthreads();
    }
  }
  const float* qn = a.in[9]; const float* kn = a.in[10];
  unsigned* kmx = (unsigned*)(a.ws + WS_CTL + CTL_KMAX);
  const int slot = lane >> 4, l16 = lane & 15, e1 = (l16 >> 3) * 64 + 4 * (l16 & 7), e2 = e1 + 32;
  float km0 = 0.f, km1 = 0.f;
  for (int it = blockIdx.x; it < MT / 8; it += gridDim.x) {
    const int r = it * 8 + wave;
    float cs[4], sn[4]; rope_cs4(r, lane, cs, sn);
    bf16_t* rowp = Q + (size_t)r * N_QKV0;
#pragma unroll
    for (int hb = 0; hb < 12; hb += 4) {
      const int hh = hb + slot;
      if (hh < 10) {
        const float* g = hh < 8 ? qn : kn;
        const u32x2 a1 = *(const u32x2*)(rowp + hh * 128 + e1), a2 = *(const u32x2*)(rowp + hh * 128 + e2);
        float x1[4] = {bflo(a1[0]), bfhi(a1[0]), bflo(a1[1]), bfhi(a1[1])}, x2[4] = {bflo(a2[0]), bfhi(a2[0]), bflo(a2[1]), bfhi(a2[1])};
        float ss = 0;
#pragma unroll
        for (int q = 0; q < 4; ++q) ss += x1[q] * x1[q] + x2[q] * x2[q];
        ss = sum16lanes(ss);
        const float rstd = rsqrtf(ss * (1.f / 128) + EPS);
        const f32x4 g1 = *(const f32x4*)(g + e1), g2 = *(const f32x4*)(g + e2);
        float o1[4], o2[4], so = 0;
#pragma unroll
        for (int q = 0; q < 4; ++q) { const float y1 = x1[q] * rstd * g1[q], y2 = x2[q] * rstd * g2[q]; o1[q] = y1 * cs[q] - y2 * sn[q]; o2[q] = y2 * cs[q] + y1 * sn[q]; }
        const u32x2 w1 = {cvtpk(o1[0], o1[1]), cvtpk(o1[2], o1[3])}, w2 = {cvtpk(o2[0], o2[1]), cvtpk(o2[2], o2[3])};
        if (!dry) { *(u32x2*)(rowp + hh * 128 + e1) = w1; *(u32x2*)(rowp + hh * 128 + e2) = w2; }
        if (hb == 8) {
          const unsigned q1 = pack8x4(o1[0], o1[1], o1[2], o1[3]), q2 = pack8x4(o2[0], o2[1], o2[2], o2[3]);
          unsigned char* k8p = (unsigned char*)(a.ws + WS_K8) + (size_t)r * 256 + (hh - 8) * 128;
          *(unsigned*)(k8p + e1) = q1; *(unsigned*)(k8p + e2) = q2;
          so = sum16lanes(sq8x4(q1) + sq8x4(q2)); if (slot == 0) km0 = fmaxf(km0, so); else km1 = fmaxf(km1, so);
        }
      }
    }
  }
  if (l16 == 0 && slot < 2) atomicMax(&kmx[slot], __float_as_uint(slot == 0 ? km0 : km1));
}
__device__ __forceinline__ void phase_rope1(const Args& a, LAS char* lds, bool dry = false) {
  int tid = threadIdx.x; asm volatile("" : "+v"(tid)); tid &= 511; const int wave = tid >> 6, lane = tid & 63;
  bf16_t* Q = (bf16_t*)(a.ws + WS_QKVU);
  unsigned* kmx = (unsigned*)(a.ws + WS_CTL + CTL_KMAX) + 16;
  unsigned char* K8 = (unsigned char*)(a.ws + WS_K8);
  LAS unsigned* lk = (LAS unsigned*)lds;
  if (tid < 16) lk[tid] = 0u;
  __syncthreads();
  const int slot = lane >> 4, l16 = lane & 15, e1 = (l16 >> 3) * 64 + 4 * (l16 & 7), e2 = e1 + 32;
  for (int it = blockIdx.x; it < MT / 8; it += gridDim.x) {
    const int r = it * 8 + wave;
    float cs[4], sn[4]; rope_cs4(r, lane, cs, sn);
    bf16_t* rowp = Q + (size_t)r * N_IN1;
#pragma unroll 2
    for (int hb = (r < CTXL ? 16 : 0); hb < 32; hb += 4) {
      const int hh = hb + slot;
      const u32x2 a1 = *(const u32x2*)(rowp + hh * 128 + e1), a2 = *(const u32x2*)(rowp + hh * 128 + e2);
      const float x1[4] = {bflo(a1[0]), bfhi(a1[0]), bflo(a1[1]), bfhi(a1[1])}, x2[4] = {bflo(a2[0]), bfhi(a2[0]), bflo(a2[1]), bfhi(a2[1])};
      float o1[4], o2[4];
#pragma unroll
      for (int q = 0; q < 4; ++q) { o1[q] = x1[q] * cs[q] - x2[q] * sn[q]; o2[q] = x2[q] * cs[q] + x1[q] * sn[q]; }
      const u32x2 w1 = {cvtpk(o1[0], o1[1]), cvtpk(o1[2], o1[3])}, w2 = {cvtpk(o2[0], o2[1]), cvtpk(o2[2], o2[3])};
      if (r >= CTXL && !dry) { *(u32x2*)(rowp + hh * 128 + e1) = w1; *(u32x2*)(rowp + hh * 128 + e2) = w2; }
      if (hb >= 16) {
        const unsigned q1 = pack8x4(o1[0], o1[1], o1[2], o1[3]), q2 = pack8x4(o2[0], o2[1], o2[2], o2[3]);
        unsigned char* k8p = K8 + (size_t)r * 2048 + (hh - 16) * 128;
        *(unsigned*)(k8p + e1) = q1; *(unsigned*)(k8p + e2) = q2;
        float so = sum16lanes(sq8x4(q1) + sq8x4(q2));
        if (l16 == 0) atomicMax((unsigned*)&lk[hh - 16], __float_as_uint(so));
      }
    }
  }
  __syncthreads();
  if (tid < 16) atomicMax(&kmx[tid], lk[tid]);
  __syncthreads();
}

__device__ __forceinline__ void phase_attn(const Args& a, int L, LAS char* lds) {
  const bf16_t* Q = (const bf16_t*)(a.ws + WS_QKVU);
  const unsigned* kmx = (const unsigned*)(a.ws + WS_CTL + CTL_KMAX) + L * 16;
  if (L == 0) {
    bf16_t* X2 = (bf16_t*)(a.ws + WS_X2);
    for (int u = blockIdx.x; u < 520; u += gridDim.x) {
      const int head = u < 512 ? (u & 7) : (u - 512);
      const float kmax2 = __uint_as_float(kmx[head >> 2]);
      if (u < 512) { const int qb = u >> 3; const size_t q0 = (size_t)(CTXL + qb * 256);
        at::attn_body_q8(Q + q0 * N_QKV0 + head * 128, N_QKV0, (const unsigned char*)(a.ws + WS_K8) + (head >> 2) * 128, 256, Q + 1280 + (head >> 2) * 128, N_QKV0, X2 + q0 * D + head * 128, D, MT, kmax2, lds);
      } else {
        at::attn_body_q8(Q + head * 128, N_QKV0, (const unsigned char*)(a.ws + WS_K8) + (head >> 2) * 128, 256, Q + 1280 + (head >> 2) * 128, N_QKV0, X2 + head * 128, D, CTXL, kmax2, lds); }
    }
  } else {
    bf16_t* O = (bf16_t*)(a.ws + WS_Y);
    for (int u = blockIdx.x; u < 1024; u += gridDim.x) {
      const int x = u & 7, w = u >> 3, hc = x + 8 * (w >> 6), qb = w & 63, h = hc >> 1;
      const float kmax2 = __uint_as_float(kmx[hc]);
      const size_t q0 = (size_t)(CTXL + qb * 256);
      at::attn_body_c256q8(Q + q0 * N_IN1 + hc * 128, N_IN1, (const unsigned char*)(a.ws + WS_K8) + hc * 128, 2048, Q + 4096 + h * 256, N_IN1,
                           O + (size_t)(qb * 256) * 4096 + hc * 256, 4096, MT, kmax2, lds);
    }
  }
}

__device__ __forceinline__ void phase_diff(const Args& a) {
  int tid = threadIdx.x; asm volatile("" : "+v"(tid)); tid &= 511; const int wave = tid >> 6, lane = tid & 63;
  const bf16_t* O = (const bf16_t*)(a.ws + WS_Y);
  bf16_t* X2 = (bf16_t*)(a.ws + WS_X2);
  const float* lp = a.in[17];
  const float s1 = wave_sum(lp[lane] * lp[128 + lane] + lp[64 + lane] * lp[192 + lane]);
  const float s2 = wave_sum(lp[256 + lane] * lp[384 + lane] + lp[320 + lane] * lp[448 + lane]);
  const float lam = expf(s1) - expf(s2) + LAM_INIT;
  const f32x4 sg = *(const f32x4*)(a.in[18] + 4 * lane);
  for (int it = blockIdx.x; it < SEQ / 8; it += gridDim.x) {
    const int t = it * 8 + wave;
    const bf16_t* op = O + (size_t)t * 4096;
    bf16_t* xp = X2 + (size_t)(CTXL + t) * D;
#pragma unroll 2
    for (int h = 0; h < 8; ++h) {
      const u32x2 a0 = *(const u32x2*)(op + (2 * h) * 256 + 4 * lane), a1 = *(const u32x2*)(op + (2 * h + 1) * 256 + 4 * lane);
      float d[4] = {bflo(a0[0]) - lam * bflo(a1[0]), bfhi(a0[0]) - lam * bfhi(a1[0]), bflo(a0[1]) - lam * bflo(a1[1]), bfhi(a0[1]) - lam * bfhi(a1[1])};
      const float ss = wave_sum(d[0] * d[0] + d[1] * d[1] + d[2] * d[2] + d[3] * d[3]);
      const float rstd = rsqrtf(ss * (1.f / 256) + EPS) * (1.f - LAM_INIT);
      u32x2 pk = {cvtpk(d[0] * rstd * sg[0], d[1] * rstd * sg[1]), cvtpk(d[2] * rstd * sg[2], d[3] * rstd * sg[3])};
      *(u32x2*)(xp + h * 256 + 4 * lane) = pk;
    }
  }
}

__device__ __forceinline__ void phase_G(const Args& a, int L, LAS char* lds, bool dry = false) {
  int tid = threadIdx.x; asm volatile("" : "+v"(tid)); tid &= 511; const int wave = tid >> 6, lane = tid & 63;
  const int NTOK = L == 0 ? MT : SEQ, ROW0 = L == 0 ? 0 : CTXL;
  const float* ng = a.in[6] + (size_t)L * 4 * D;
  const float* MODL = (const float*)(a.ws + WS_MOD) + (size_t)(L * 2) * 12288;
  const float* router = a.in[19] + (size_t)L * D * NE; const float* rbias = a.in[20] + L * NE;
  const bf16_t* OUT = (const bf16_t*)(a.ws + WS_OUT);
  float* HRES = (float*)(a.ws + WS_HRES);
  bf16_t* F = (bf16_t*)(a.ws + WS_ABUF);
  int* counts = (int*)(a.ws + WS_CTL + CTL_CNT) + L * 64;
  int* top_e = (int*)(a.ws + WS_TOPE); float* top_w = (float*)(a.ws + WS_TOPW); int* top_p = (int*)(a.ws + WS_TOPP);
  LAS float* ft = (LAS float*)lds;
  LAS float* part = ft + 8 * D;
  for (int it = blockIdx.x; it < NTOK / 8; it += gridDim.x) {
    const int r = ROW0 + it * 8 + wave;
    const float* mod = MODL + (r < CTXL ? 12288 : 0);
    {
      float o[32], h[32];
      ld_row_bf16(OUT + (size_t)r * D, lane, o);
      const float* hp = L == 0 ? (r < CTXL ? a.in[2] + (size_t)r * D : a.in[0] + (size_t)(r - CTXL) * D) : HRES + (size_t)r * D;
      ld_row_f32(hp, lane, h);
      const float rstd1 = rsqrtf(sumsq32(o) * (1.f / D) + EPS);
#pragma unroll
      for (int j = 0; j < 4; ++j) { const int idx = 8 * lane + 512 * j;
        float g1[8], gt[8]; ld8f(ng + D + idx, g1); ld8f(mod + 2 * D + idx, gt);
#pragma unroll
        for (int i = 0; i < 8; ++i) h[8 * j + i] += gt[i] * (o[8 * j + i] * rstd1 * g1[i]);
        if (!dry) st8f(HRES + (size_t)r * D + idx, &h[8 * j]); }
      const float rstd2 = rsqrtf(sumsq32(h) * (1.f / D) + EPS);
      modulate_store<true, true>(h, rstd2, ng + 2 * D, mod + 3 * D, mod + 4 * D, (bf16_t*)((unsigned char*)F + (size_t)r * D), lane, ft + wave * D);
    }
    __syncthreads();
    float acc[8] = {0, 0, 0, 0, 0, 0, 0, 0};
    const int d0 = wave * 256;
#pragma unroll 2
    for (int dd = 0; dd < 256; dd += 4) {
      const float* rp = router + (size_t)(d0 + dd) * NE + lane;
      const float r0 = rp[0], r1 = rp[NE], r2 = rp[2 * NE], r3 = rp[3 * NE];
#pragma unroll
      for (int t = 0; t < 8; ++t) { const f32x4 fv = *(LAS const f32x4*)(ft + t * D + d0 + dd); acc[t] += fv[0] * r0 + fv[1] * r1 + fv[2] * r2 + fv[3] * r3; }
    }
#pragma unroll
    for (int t = 0; t < 8; ++t) part[(wave * 8 + t) * 64 + lane] = acc[t];
    __syncthreads();
    float logit = 0;
#pragma unroll
    for (int w = 0; w < 8; ++w) logit += part[(w * 8 + wave) * 64 + lane];
#if MK_DIAG
    ((float*)(a.ws + WS_Y))[(size_t)r * 64 + lane] = logit;
#endif
    const float score = sigmoidf_(logit);
    const float choice = score + rbias[lane];
    int rank = 0; const int gl = lane & 7;
#pragma unroll
    for (int j = 0; j < 8; ++j) { const float o = __shfl(choice, (lane & ~7) | j); rank += (o > choice || (o == choice && j < gl)) ? 1 : 0; }
    float gs = rank < 2 ? choice : 0.f;
    gs += __shfl_xor(gs, 1); gs += __shfl_xor(gs, 2); gs += __shfl_xor(gs, 4);
    int grank = 0; const int g = lane >> 3;
#pragma unroll
    for (int j = 0; j < 8; ++j) { const float o = __shfl(gs, j * 8); grank += (o > gs || (o == gs && j < g)) ? 1 : 0; }
    const bool gsel = grank < 4;
    const float mc = gsel ? choice : -INFINITY;
    int erank = 0;
#pragma unroll 4
    for (int j = 0; j < 64; ++j) { const float o = __int_as_float(__builtin_amdgcn_readlane(__float_as_int(mc), j)); erank += (o > mc || (o == mc && j < lane)) ? 1 : 0; }
    const bool sel = gsel && erank < 8;
    const unsigned long long bal = __ballot(sel);
    const int idx = __popcll(bal & ((1ull << lane) - 1ull));
    const float ssum = wave_sum(sel ? score : 0.f);
    if (sel && !dry) { const int pos = atomicAdd(&counts[lane], 1);
      top_e[r * 8 + idx] = lane; top_w[r * 8 + idx] = score / ssum * 2.5f; top_p[r * 8 + idx] = pos; }
  }
}

__device__ __forceinline__ void moe_tile_prefix(const int* counts, LAS int* ts) {
  if (threadIdx.x == 0) { int s = 0; for (int e = 0; e < 64; ++e) { ts[e] = s; s += (counts[e] + 255) >> 8; } ts[64] = s; }
  __syncthreads();
}
__device__ __forceinline__ void phase_H(const Args& a, int L, LAS char* lds) {
  const int NTOK = L == 0 ? MT : SEQ, ROW0 = L == 0 ? 0 : CTXL;
  const int* counts = (const int*)(a.ws + WS_CTL + CTL_CNT) + L * 64;
  const int* top_e = (const int*)(a.ws + WS_TOPE); const int* top_p = (const int*)(a.ws + WS_TOPP);
  int* tslot = (int*)(a.ws + WS_TSLOT); int* stok = (int*)(a.ws + WS_STOK);
  LAS int* ts = (LAS int*)lds;
  moe_tile_prefix(counts, ts);
  int tid = threadIdx.x; asm volatile("" : "+v"(tid)); tid &= 511;
  const int gt = blockIdx.x * NTHREADS + tid, gs = gridDim.x * NTHREADS;
  for (int i = gt; i < NTOK * 8; i += gs) { const int q = ROW0 * 8 + i; const int e = top_e[q]; const int slot = ts[e] * 256 + top_p[q]; stok[slot] = q >> 3; tslot[q] = slot; }
  for (int i = gt; i < 64 * 256; i += gs) { const int e = i >> 8, p = i & 255, cnt = counts[e], nt = (cnt + 255) >> 8; if (cnt + p < nt * 256) stok[ts[e] * 256 + cnt + p] = ROW0; }
  for (int i = gt; i < NTOK; i += gs) stok[SH_BASE + i] = ROW0 + i;
  __syncthreads();
}
struct MoeSched {
  LAS const int* ts; int TR, NN, total; const unsigned char* W; size_t woff;
  __device__ __forceinline__ bool unit(int i, int& slot0, const unsigned char*& Bt, int& bcol) const {
    for (int u = blockIdx.x + i * (int)gridDim.x; ; u += gridDim.x) {
      const int rnd = u >> 8, b = u & 255, v = rnd * 256 + (b & 7) * 32 + (b >> 3);
      if (rnd * 256 >= total) return false;
      if (v >= total) return false;
      const int m = v / NN, pn = v % NN;
      int e;
      if (m >= TR) { e = 64; slot0 = SH_BASE + 256 * (m - TR); } else { e = 0; while (ts[e + 1] <= m) ++e; slot0 = 256 * m; }
      Bt = W + (size_t)e * WMOE8_E + woff; bcol = pn * 256;
      return true;
    }
  }
};
__device__ __forceinline__ void phase_moe_up(const Args& a, int L, LAS char* lds) {
  const int NSH = L == 0 ? MT / 256 : SEQ / 256;
  const int* counts = (const int*)(a.ws + WS_CTL + CTL_CNT) + L * 64;
  LAS int* ts = (LAS int*)(lds + LDS_CTL + 64);
  moe_tile_prefix(counts, ts);
  const int TR = ts[64], TM = TR + NSH;
  const unsigned char* F = (const unsigned char*)(a.ws + WS_ABUF); const unsigned char* W = (const unsigned char*)(a.ws + WS_WMOE) + (size_t)L * 65 * WMOE8_E;
  const int* stok = (const int*)(a.ws + WS_STOK);
  EpiSwiGLU8 epi{(unsigned char*)(a.ws + WS_ACT), EFF};
  MoeSched sc{ts, TR, 4, TM * 4, W, 0};
  gemm8_run<true, D, D, D>(F, stok, lds, epi, sc);
}
__device__ __forceinline__ void phase_moe_down(const Args& a, int L, LAS char* lds) {
  const int NSH = L == 0 ? MT / 256 : SEQ / 256;
  const int* counts = (const int*)(a.ws + WS_CTL + CTL_CNT) + L * 64;
  LAS int* ts = (LAS int*)(lds + LDS_CTL + 64);
  moe_tile_prefix(counts, ts);
  const int TR = ts[64], TM = TR + NSH;
  const unsigned char* ACT = (const unsigned char*)(a.ws + WS_ACT); const unsigned char* W = (const unsigned char*)(a.ws + WS_WMOE) + (size_t)L * 65 * WMOE8_E;
  EpiPlainS epi{(bf16_t*)(a.ws + WS_Y), D, 1.f / 128.f};
  MoeSched sc{ts, TR, 8, TM * 8, W, (size_t)1024 * D};
  gemm8_run<false, EFF, EFF, EFF>(ACT, nullptr, lds, epi, sc);
}
__device__ __forceinline__ void phase_combine(const Args& a, int L, bool dry = false) {
  int tid = threadIdx.x; asm volatile("" : "+v"(tid)); tid &= 511; const int wave = tid >> 6, lane = tid & 63;
  const int NTOK = L == 0 ? MT : SEQ, ROW0 = L == 0 ? 0 : CTXL;
  const float* ng = a.in[6] + (size_t)L * 4 * D;
  const float* MODL = (const float*)(a.ws + WS_MOD) + (size_t)(L * 2) * 12288;
  const bf16_t* Y = (const bf16_t*)(a.ws + WS_Y);
  float* HRES = (float*)(a.ws + WS_HRES);
  const int* tslot = (const int*)(a.ws + WS_TSLOT); const float* top_w = (const float*)(a.ws + WS_TOPW);
  for (int it = blockIdx.x; it < NTOK / 8; it += gridDim.x) {
    const int r = ROW0 + it * 8 + wave;
    const float* mod = MODL + (r < CTXL ? 12288 : 0);
    float y[32];
    { float t[32]; ld_row_bf16(Y + (size_t)(SH_BASE + r - ROW0) * D, lane, t);
#pragma unroll
      for (int i = 0; i < 32; ++i) y[i] = t[i]; }
#pragma unroll 4
    for (int k = 0; k < 8; ++k) { const int slot = tslot[r * 8 + k]; const float w = top_w[r * 8 + k];
      float t[32]; ld_row_bf16(Y + (size_t)slot * D, lane, t);
#pragma unroll
      for (int i = 0; i < 32; ++i) y[i] += w * t[i]; }
    const float rstd = rsqrtf(sumsq32(y) * (1.f / D) + EPS);
    float h[32]; ld_row_f32(HRES + (size_t)r * D, lane, h);
#pragma unroll
    for (int j = 0; j < 4; ++j) { const int idx = 8 * lane + 512 * j;
      float g3[8], gt[8]; ld8f(ng + 3 * D + idx, g3); ld8f(mod + 5 * D + idx, gt);
#pragma unroll
      for (int i = 0; i < 8; ++i) h[8 * j + i] += gt[i] * (y[8 * j + i] * rstd * g3[i]);
      if (L == 0) { if (!dry) st8f(HRES + (size_t)r * D + idx, &h[8 * j]); } else st8f(a.out + (size_t)(r - CTXL) * D + idx, &h[8 * j]); }
    if (L == 0) {
      const float* mod1 = MODL + 2 * 12288 + (r < CTXL ? 12288 : 0);
      const float rstd2 = rsqrtf(sumsq32(h) * (1.f / D) + EPS);
      modulate_store<false>(h, rstd2, a.in[6] + (size_t)4 * D, mod1, mod1 + D, (bf16_t*)(a.ws + WS_ABUF) + (size_t)r * D, lane, nullptr);
    }
  }
}

constexpr int NPH = 21;
typedef const __attribute__((address_space(4))) Args* ArgsP;
#if defined(__HIP_DEVICE_COMPILE__)
#define FRESH_ARGS() const Args a = *({ ArgsP _p = (ArgsP)__builtin_amdgcn_kernarg_segment_ptr(); asm volatile("" : "+s"(_p)); _p; })
#else
#define FRESH_ARGS() const Args a = kargs
#endif
__global__ void __launch_bounds__(NTHREADS, 2) fwd(Args kargs) {
  extern __shared__ __attribute__((aligned(16))) unsigned char lds_raw[];
  LAS char* lds = (LAS char*)lds_raw;
  const int lo = kargs.ph_lo, hi = kargs.ph_hi;
  if (threadIdx.x < 64) ((LAS unsigned*)(lds + LDS_CTL))[threadIdx.x] = 0u;
  __syncthreads();
  if (hi - lo > 1) (void)xcd_barrier_post((unsigned*)(kargs.ws + WS_CTL), (volatile LAS unsigned*)(lds + LDS_CTL));
#ifndef PHASE_MASK
#define PHASE_MASK 0xFFFFFFFFu
#endif
#define IN(k) (((PHASE_MASK >> (k)) & 1u) && lo <= (k) && (k) < hi)
#ifndef PH_REPEAT_MASK
#define PH_REPEAT_MASK 0u
#endif
#define REP(k) for (int _rep = 0; _rep < (((PH_REPEAT_MASK >> (k)) & 1u) ? 2 : 1); ++_rep)
#define SEAM(k) do { if ((k) + 1 < hi) { XcdBarrier _b; _b.bar = (unsigned*)(a.ws + WS_CTL); _b.x = xb_xcc_id(); _b.st = (volatile LAS unsigned*)(lds + LDS_CTL); xcd_barrier(_b); } } while (0)

  if (IN(0)) { FRESH_ARGS(); REP(0) phase_prologue(a, lds); SEAM(0); }
  if (IN(1)) { FRESH_ARGS(); REP(1) phase_modulate0(a); SEAM(1); }
#pragma unroll
  for (int L = 0; L < 2; ++L) {
    const int base = 2 + (L == 0 ? 0 : 9);
    if (IN(base + 0)) {
      FRESH_ARGS();
      const bf16_t* A = (const bf16_t*)(a.ws + WS_ABUF);
      const bf16_t* Bt = (const bf16_t*)(a.ws + (L == 0 ? WS_WIN0 : WS_WIN1));
      const int nN = L == 0 ? N_IN0 / 256 : N_IN1 / 256, nM = MT / 256;
      EpiG1 epi{EpiPlain{(bf16_t*)(a.ws + WS_QKVU), L == 0 ? N_QKV0 : N_IN1}, EpiPair<0>{(bf16_t*)(a.ws + WS_HG), 1024, N_QKV0}, L == 0 ? N_QKV0 : N_IN1};
      REP(2) for (int u = blockIdx.x; u < nM * nN; u += gridDim.x) { int pm, pn; dense_unit(u, nM, nN, pm, pn);
        gemm_tile<false>(A, D, nullptr, pm * 256, Bt, D, pn * 256, D, lds, epi); }
      SEAM(base + 0);
    }
    if (L == 0) {
      if (IN(3)) { FRESH_ARGS(); if ((PH_REPEAT_MASK >> 3) & 1u) { phase_rope_conv0(a, lds, true); __syncthreads(); } phase_rope_conv0(a, lds); SEAM(3); }
      if (IN(4)) { FRESH_ARGS(); REP(4) phase_attn(a, 0, lds); SEAM(4); }
    } else {
      if (IN(12)) { FRESH_ARGS(); if ((PH_REPEAT_MASK >> 12) & 1u) { phase_rope1(a, lds, true); __syncthreads(); } phase_rope1(a, lds); SEAM(12); }
      if (IN(13)) { FRESH_ARGS(); REP(13) phase_attn(a, 1, lds); SEAM(13); }
      if (IN(14)) { FRESH_ARGS(); REP(14) phase_diff(a); SEAM(14); }
    }
    const int b2 = L == 0 ? 5 : 15;
    if (IN(b2 + 0)) {
      FRESH_ARGS();
      const bf16_t* A = (const bf16_t*)(a.ws + WS_X2);
      const bf16_t* Bt = (const bf16_t*)(a.ws + (L == 0 ? WS_WOUT0 : WS_WOUT1));
      const int nN = D / 256, nM = L == 0 ? MT / 256 : SEQ / 256, r0 = L == 0 ? 0 : CTXL;
      EpiPlain epi{(bf16_t*)(a.ws + WS_OUT), D};
      REP(5) for (int u = blockIdx.x; u < nM * nN; u += gridDim.x) { int pm, pn; dense_unit(u, nM, nN, pm, pn);
        gemm_tile<false>(A, D, nullptr, r0 + pm * 256, Bt, D, pn * 256, D, lds, epi); }
      SEAM(b2 + 0);
    }
    if (IN(b2 + 1)) { FRESH_ARGS(); if ((PH_REPEAT_MASK >> 6) & 1u) { phase_G(a, L, lds, true); __syncthreads(); } phase_G(a, L, lds); SEAM(b2 + 1); }
    if (IN(b2 + 2)) { FRESH_ARGS(); REP(7) phase_H(a, L, lds); SEAM(b2 + 2); }
    if (IN(b2 + 3)) { FRESH_ARGS(); REP(8) phase_moe_up(a, L, lds); SEAM(b2 + 3); }
    if (IN(b2 + 4)) { FRESH_ARGS(); REP(9) phase_moe_down(a, L, lds); SEAM(b2 + 4); }
    if (IN(b2 + 5)) { FRESH_ARGS(); if ((PH_REPEAT_MASK >> 10) & 1u) phase_combine(a, L, true); phase_combine(a, L); SEAM(b2 + 5); }
  }
#undef IN
#undef SEAM
}

#ifndef MK_DIAG
#define MK_DIAG 0
#endif
#if MK_DIAG
__device__ __forceinline__ void rope_cs(int r, int lane, float& cs, float& sn) {
  cs = 1.f; sn = 0.f;
  if (r >= CTXL) { const int t = r - CTXL; const int a = lane >> 5, i = lane & 31;
    const float pos = a ? (float)(t & 63) : (float)(t >> 6);
    const float inv = powf(10000.f, -(float)i / 32.f);
    sincosf(pos * inv, &sn, &cs); }
}
__device__ __forceinline__ bool dclose(float got, float ref, float rtol, float atol) { return fabsf(got - ref) <= rtol * fabsf(ref) + atol; }
__device__ __forceinline__ unsigned dhash(unsigned x) { x ^= x >> 16; x *= 0x7feb352du; x ^= x >> 15; x *= 0x846ca68bu; x ^= x >> 16; return x; }
__device__ float wdot(const bf16_t* arow, const float* W, int ldw, int col, int K, int lane) {
  float s = 0; for (int k = lane; k < K; k += 64) s += bf2f(arow[k]) * W[(size_t)k * ldw + col]; return wave_sum(s); }
__device__ float dq8(const unsigned char* p, size_t i) { const unsigned w = ((const unsigned*)p)[i >> 2]; const int b = (int)(i & 3);
  return b == 0 ? __builtin_amdgcn_cvt_f32_fp8((int)w, 0) : b == 1 ? __builtin_amdgcn_cvt_f32_fp8((int)w, 1) : b == 2 ? __builtin_amdgcn_cvt_f32_fp8((int)w, 2) : __builtin_amdgcn_cvt_f32_fp8((int)w, 3); }
__device__ float wdot8(const unsigned char* arow8, const float* W, int ldw, int col, int K, int lane) {
  float s = 0; for (int k = lane; k < K; k += 64) s += dq8(arow8, k) * W[(size_t)k * ldw + col]; return wave_sum(s); }
__device__ void dflag(int* dg, int s, int bad, int lane) { if (lane == 0 && bad) atomicAdd(&dg[s], bad); }
__device__ const float* h0row(const Args& a, int r) { return r < CTXL ? a.in[2] + (size_t)r * D : a.in[0] + (size_t)(r - CTXL) * D; }
__device__ int pick_row(unsigned h, int lo, int n) { const unsigned m = h % 8; if (m == 0) return lo; if (m == 1) return lo + n - 1; if (m == 2) return lo + 255 < lo + n ? lo + 255 : lo; if (m == 3) return lo + 256 < lo + n ? lo + 256 : lo; return lo + (int)((h >> 3) % (unsigned)n); }
__device__ void naive_attn(const bf16_t* q, const bf16_t* K, const bf16_t* V, int ld, int nkeys, int lane, float& o0, float& o1) {
  const float q0 = bf2f(q[lane]), q1 = bf2f(q[lane + 64]);
  float m = -1e30f, l = 0; o0 = 0; o1 = 0;
  for (int k = 0; k < nkeys; ++k) {
    const float s = wave_sum(q0 * bf2f(K[(size_t)k * ld + lane]) + q1 * bf2f(K[(size_t)k * ld + lane + 64])) * 0.088388347648318440f;
    const float mn = fmaxf(m, s), al = expf(m - mn), p = expf(s - mn);
    l = l * al + p; o0 = o0 * al + p * bf2f(V[(size_t)k * ld + lane]); o1 = o1 * al + p * bf2f(V[(size_t)k * ld + lane + 64]); m = mn;
  }
  o0 /= l; o1 /= l;
}
__global__ void __launch_bounds__(256) diag(Args a, int k) {
  __shared__ float fsh[4][2048];
  __shared__ float csh[4][64];
  const int lane = threadIdx.x & 63, wv = threadIdx.x >> 6, gw = blockIdx.x * 4 + wv;
  int* dg = (int*)(a.ws + WS_CTL + CTL_CNT + 512);
  const float* MOD = (const float*)(a.ws + WS_MOD);
  const bf16_t* AB = (const bf16_t*)(a.ws + WS_ABUF);
  const bf16_t* QK = (const bf16_t*)(a.ws + WS_QKVU);
  const bf16_t* HG = (const bf16_t*)(a.ws + WS_HG);
  const bf16_t* X2 = (const bf16_t*)(a.ws + WS_X2);
  const bf16_t* OUT = (const bf16_t*)(a.ws + WS_OUT);
  const bf16_t* ACT = (const bf16_t*)(a.ws + WS_ACT);
  const bf16_t* Y = (const bf16_t*)(a.ws + WS_Y);
  const float* HRES = (const float*)(a.ws + WS_HRES);
  const int* top_e = (const int*)(a.ws + WS_TOPE); const float* top_w = (const float*)(a.ws + WS_TOPW); const int* top_p = (const int*)(a.ws + WS_TOPP);
  const int* tslot = (const int*)(a.ws + WS_TSLOT); const int* stok = (const int*)(a.ws + WS_STOK);
  const unsigned h = dhash(gw * 7919u + k * 104729u + 17u), h2 = dhash(h + 12345u);
  int bad = 0;
  const int L = k >= 11 ? 1 : 0;
  const int NTOK = L == 0 ? MT : SEQ, ROW0 = L == 0 ? 0 : CTXL;
  const int* counts = (const int*)(a.ws + WS_CTL + CTL_CNT) + L * 64;
  if (k == 0) {
    const int LL = gw & 1, which = (gw >> 1) & 1, j = h % 12288;
    const float* v = which ? a.in[3] : a.in[1];
    float s = 0; for (int d = lane; d < D; d += 64) { const float x = v[d]; s += x * sigmoidf_(x) * a.in[4][((size_t)LL * D + d) * 12288 + j]; }
    s = wave_sum(s) + a.in[5][LL * 12288 + j];
    bad = !dclose(MOD[(LL * 2 + which) * 12288 + j], s, 1e-3f, 1e-3f); dflag(dg, 1, bad, lane);
  } else if (k == 1) {
    const int r = pick_row(h, 0, MT); const float* x = h0row(a, r); const float* mod = MOD + (r < CTXL ? 12288 : 0);
    float ss = 0; for (int d = lane; d < D; d += 64) ss += x[d] * x[d]; ss = wave_sum(ss); const float rstd = rsqrtf(ss / D + EPS);
    for (int d = lane; d < D; d += 64) { const float ref = x[d] * rstd * a.in[6][d] * (1.f + mod[D + d]) + mod[d]; bad += !dclose(bf2f(AB[(size_t)r * D + d]), ref, 0.01f, 0.01f); }
    bad = (int)wave_sum((float)bad); dflag(dg, 2, bad, lane);
  } else if (k == 2 || k == 11) {
    const int r = pick_row(h, 0, MT);
    if (L == 0) {
      const int c = h2 % N_QKV0; const float ref = wdot(AB + (size_t)r * D, a.in[7], N_IN0, c, D, lane);
      bad = !dclose(bf2f(QK[(size_t)r * N_QKV0 + c]), ref, 0.02f, 0.05f); dflag(dg, 3, bad, lane);
      const int ch = (h2 >> 11) % 1024; const float av = wdot(AB + (size_t)r * D, a.in[7], N_IN0, N_QKV0 + ch, D, lane), gv = wdot(AB + (size_t)r * D, a.in[7], N_IN0, N_QKV0 + 1024 + ch, D, lane);
      bad = !dclose(bf2f(HG[(size_t)r * 1024 + ch]), av * sigmoidf_(gv), 0.03f, 0.05f); dflag(dg, 4, bad, lane);
    } else {
      const int c = h2 % N_IN1; const float ref = wdot(AB + (size_t)r * D, a.in[15], N_IN1, c, D, lane);
      bad = !dclose(bf2f(QK[(size_t)r * N_IN1 + c]), ref, 0.02f, 0.05f); dflag(dg, 15, bad, lane);
    }
  } else if (k == 3) {
    { const int r = pick_row(h, 0, MT), hh = h2 % 10; const float* g = hh < 8 ? a.in[9] : a.in[10];
      float raw0 = 0, raw1 = 0;
      for (int d = 0; d < 128; ++d) { const float v = wdot(AB + (size_t)r * D, a.in[7], N_IN0, hh * 128 + d, D, lane); if (d == lane) raw0 = v; if (d == lane + 64) raw1 = v; }
      const float rstd = rsqrtf(wave_sum(raw0 * raw0 + raw1 * raw1) / 128.f + EPS);
      const float y0 = raw0 * rstd * g[lane], y1 = raw1 * rstd * g[lane + 64];
      float cs, sn; rope_cs(r, lane, cs, sn);
      const float cs0 = __shfl(cs, lane & 31), sn0 = __shfl(sn, lane & 31), cs1 = __shfl(cs, 32 + (lane & 31)), sn1 = __shfl(sn, 32 + (lane & 31));
      const float p0 = __shfl_xor(y0, 32), p1 = __shfl_xor(y1, 32);
      const float o0 = (lane < 32) ? y0 * cs0 - p0 * sn0 : y0 * cs0 + p0 * sn0;
      const float o1 = (lane < 32) ? y1 * cs1 - p1 * sn1 : y1 * cs1 + p1 * sn1;
      bad = !dclose(bf2f(QK[(size_t)r * N_QKV0 + hh * 128 + lane]), o0, 0.03f, 0.05f) + !dclose(bf2f(QK[(size_t)r * N_QKV0 + hh * 128 + 64 + lane]), o1, 0.03f, 0.05f);
      bad = (int)wave_sum((float)bad); dflag(dg, 5, bad, lane); }
    { const int r = pick_row(h2, 0, MT); const int seg0 = r < CTXL ? 0 : CTXL, seg1 = r < CTXL ? CTXL : MT;
      float cv[16]; float s1 = 0, s2 = 0;
      for (int q = 0; q < 16; ++q) { const int c = lane + 64 * q; float acc = a.in[12][c];
        for (int j = 0; j < 31; ++j) { const int rr = r + j - 15; if (rr >= seg0 && rr < seg1) acc += bf2f(HG[(size_t)rr * 1024 + c]) * a.in[11][j * 1024 + c]; }
        cv[q] = acc; s1 += acc; s2 += acc * acc; }
      s1 = wave_sum(s1); s2 = wave_sum(s2); const float mean = s1 / 1024.f, rstd = rsqrtf(s2 / 1024.f - mean * mean + EPS);
      bad = 0;
      for (int q = 0; q < 16; ++q) { const int c = lane + 64 * q; float y = (cv[q] - mean) * rstd * a.in[13][c] + a.in[14][c]; y = y * sigmoidf_(y);
        bad += !dclose(bf2f(X2[(size_t)r * D + 1024 + c]), y, 0.03f, 0.03f); }
      bad = (int)wave_sum((float)bad); dflag(dg, 6, bad, lane); }
  } else if (k == 4) {
    if (gw < 64) { const int r = pick_row(h, 0, MT), head = h2 % 8; const int nkeys = r < CTXL ? CTXL : MT;
      float o0, o1; naive_attn(QK + (size_t)r * N_QKV0 + head * 128, QK + 1024 + (head >> 2) * 128, QK + 1280 + (head >> 2) * 128, N_QKV0, nkeys, lane, o0, o1);
      bad = !dclose(bf2f(X2[(size_t)r * D + head * 128 + lane]), o0, 0.05f, 0.01f) + !dclose(bf2f(X2[(size_t)r * D + head * 128 + 64 + lane]), o1, 0.05f, 0.01f);
      bad = (int)wave_sum((float)bad); dflag(dg, 7, bad, lane); }
  } else if (k == 5 || k == 15) {
    const int r = pick_row(h, ROW0, NTOK), c = h2 % D; const float ref = wdot(X2 + (size_t)r * D, L == 0 ? a.in[8] : a.in[16], D, c, D, lane);
    bad = !dclose(bf2f(OUT[(size_t)r * D + c]), ref, 0.02f, 0.05f); dflag(dg, L == 0 ? 8 : 19, bad, lane);
  } else if (k == 6 || k == 16) {
    const int r = pick_row(h, ROW0, NTOK); const float* mod = MOD + (size_t)(L * 2) * 12288 + (r < CTXL ? 12288 : 0); const float* ng = a.in[6] + (size_t)L * 4 * D;
    float ss = 0; for (int d = lane; d < D; d += 64) { const float o = bf2f(OUT[(size_t)r * D + d]); ss += o * o; } ss = wave_sum(ss); const float rstd1 = rsqrtf(ss / D + EPS);
    bad = 0;
    if (L == 0) { const float* x = h0row(a, r); for (int d = lane; d < D; d += 64) { const float ref = x[d] + mod[2 * D + d] * (bf2f(OUT[(size_t)r * D + d]) * rstd1 * ng[D + d]); bad += !dclose(HRES[(size_t)r * D + d], ref, 1e-3f, 1e-3f); } }
    float s2 = 0; for (int d = lane; d < D; d += 64) { const float x = HRES[(size_t)r * D + d]; s2 += x * x; } s2 = wave_sum(s2); const float rstd2 = rsqrtf(s2 / D + EPS);
    for (int d = lane; d < D; d += 64) { const float f = HRES[(size_t)r * D + d] * rstd2 * ng[2 * D + d] * (1.f + mod[4 * D + d]) + mod[3 * D + d]; fsh[wv][d] = f; bad += !dclose(dq8((const unsigned char*)AB + (size_t)r * D, d), f, 0.07f, 0.01f); }
    bad = (int)wave_sum((float)bad); dflag(dg, L == 0 ? 9 : 20, bad, lane);
    __syncthreads();
    float lg = 0; for (int d = 0; d < D; ++d) lg += fsh[wv][d] * a.in[19][((size_t)L * D + d) * NE + lane];
    const float sc = sigmoidf_(lg); csh[wv][lane] = sc + a.in[20][L * NE + lane];
    __syncthreads();
    { const float plg = ((const float*)(a.ws + WS_Y))[(size_t)r * 64 + lane]; int lb = !dclose(plg, lg, 1e-3f, 1e-3f); lb = (int)wave_sum((float)lb); if (lane == 0 && lb) { atomicAdd(&dg[32 + (L == 0 ? 10 : 21) + 3], 1); atomicOr(&dg[60], 1 << (r & 7)); } }
    unsigned long long wsel;
    { const float choice = csh[wv][lane]; int rank = 0; const int gl = lane & 7;
      for (int j = 0; j < 8; ++j) { const float o = __shfl(choice, (lane & ~7) | j); rank += (o > choice || (o == choice && j < gl)) ? 1 : 0; }
      float gs = rank < 2 ? choice : 0.f; gs += __shfl_xor(gs, 1); gs += __shfl_xor(gs, 2); gs += __shfl_xor(gs, 4);
      int grank = 0; const int g = lane >> 3;
      for (int j = 0; j < 8; ++j) { const float o = __shfl(gs, j * 8); grank += (o > gs || (o == gs && j < g)) ? 1 : 0; }
      const bool gsel = grank < 4; const float mc = gsel ? choice : -INFINITY; int erank = 0;
      for (int j = 0; j < 64; ++j) { const float o = __shfl(mc, j); erank += (o > mc || (o == mc && j < lane)) ? 1 : 0; }
      wsel = __ballot(gsel && erank < 8); }
    int setbad = 0;
    if (lane == 0) {
      float gsc[8]; for (int g = 0; g < 8; ++g) { float m1 = -1e30f, m2 = -1e30f; for (int j = 0; j < 8; ++j) { const float v = csh[wv][g * 8 + j]; if (v > m1) { m2 = m1; m1 = v; } else if (v > m2) m2 = v; } gsc[g] = m1 + m2; }
      bool gs[8] = {false, false, false, false, false, false, false, false};
      for (int t = 0; t < 4; ++t) { int bi = 0; float bv = -1e30f; for (int g = 0; g < 8; ++g) if (!gs[g] && gsc[g] > bv) { bv = gsc[g]; bi = g; } gs[bi] = true; }
      unsigned long long selm = 0; for (int t = 0; t < 8; ++t) { int bi = 0; float bv = -1e30f; for (int e = 0; e < 64; ++e) if (gs[e >> 3] && !((selm >> e) & 1ull) && csh[wv][e] > bv) { bv = csh[wv][e]; bi = e; } selm |= 1ull << bi; }
      unsigned long long got = 0; for (int t = 0; t < 8; ++t) { const int e = top_e[r * 8 + t]; if (e < 0 || e > 63) setbad = 1000; else got |= 1ull << e; }
      if (setbad == 0 && got != selm) setbad = 1;
      if (wsel != selm) atomicAdd(&dg[32 + (L == 0 ? 10 : 21) + 4], 1);
    }
    setbad = __shfl(setbad, 0);
    { float wgot = -1.f; int mine = 0; for (int t = 0; t < 8; ++t) if (top_e[r * 8 + t] == lane) { mine = 1; wgot = top_w[r * 8 + t]; }
      const float ssum = wave_sum(mine ? sc : 0.f);
      int wbad = (mine && !dclose(wgot, sc / ssum * 2.5f, 0.01f, 1e-3f)) ? 1 : 0; wbad = (int)wave_sum((float)wbad);
      if (lane == 0) { int* q = &dg[32 + (L == 0 ? 10 : 21)]; if (setbad >= 1000) atomicAdd(q + 1, 1); else if (setbad) atomicAdd(q, 1); else if (wbad) atomicAdd(q + 2, 1); } }
  } else if (k == 7 || k == 17) {
    const int r = pick_row(h, ROW0, NTOK), t = h2 % 8, q = r * 8 + t; const int slot = tslot[q], e = top_e[q];
    int ts0 = 0; for (int j = 0; j < e; ++j) ts0 += (counts[j] + 255) >> 8;
    bad = (slot < ts0 * 256 || slot >= ts0 * 256 + counts[e] || stok[slot] != r || top_p[q] != slot - ts0 * 256) ? 1 : 0;
    bad += (stok[SH_BASE + r - ROW0] != r) ? 1 : 0;
    dflag(dg, L == 0 ? 11 : 22, bad, lane);
  } else if (k == 8 || k == 18 || k == 9 || k == 19) {
    int TR = 0; for (int j = 0; j < 64; ++j) TR += (counts[j] + 255) >> 8;
    int slot, e;
    if ((h & 3) == 0) { slot = SH_BASE + (int)((h >> 2) % (unsigned)NTOK); e = 64; }
    else { e = (h >> 2) % 64; int guard = 0; while (counts[e] == 0 && guard++ < 64) e = (e + 1) % 64; int ts0 = 0; for (int j = 0; j < e; ++j) ts0 += (counts[j] + 255) >> 8;
      const unsigned m = (h >> 8) % 4; const int cnt = counts[e]; const int p = m == 0 ? 0 : m == 1 ? cnt - 1 : (int)((h >> 10) % (unsigned)cnt); slot = ts0 * 256 + p; }
    const int tok = stok[slot];
    if (k == 8 || k == 18) {
      const int ch = h2 % EFF;
      const float* Wg = e < 64 ? a.in[21] + ((size_t)L * 64 + e) * D * EFF : a.in[24] + (size_t)L * D * EFF;
      const float* Wu = e < 64 ? a.in[22] + ((size_t)L * 64 + e) * D * EFF : a.in[25] + (size_t)L * D * EFF;
      const unsigned char* F8 = (const unsigned char*)AB + (size_t)tok * D;
      const float gv = wdot8(F8, Wg, EFF, ch, D, lane), uv = wdot8(F8, Wu, EFF, ch, D, lane);
      bad = !dclose(dq8((const unsigned char*)ACT + (size_t)slot * EFF, ch), gv * sigmoidf_(gv) * uv, 0.2f, 0.15f); dflag(dg, L == 0 ? 12 : 23, bad, lane);
    } else {
      const int c = h2 % D; const float* Wd = e < 64 ? a.in[23] + ((size_t)L * 64 + e) * EFF * D : a.in[26] + (size_t)L * EFF * D;
      const float ref = wdot8((const unsigned char*)ACT + (size_t)slot * EFF, Wd, D, c, EFF, lane);
      bad = !dclose(bf2f(Y[(size_t)slot * D + c]), ref, 0.15f, 0.15f); dflag(dg, L == 0 ? 13 : 24, bad, lane);
    }
  } else if (k == 10 || k == 20) {
    const int r = pick_row(h, ROW0, NTOK); const float* mod = MOD + (size_t)(L * 2) * 12288 + (r < CTXL ? 12288 : 0); const float* ng = a.in[6] + (size_t)L * 4 * D;
    float ss = 0; for (int d = lane; d < D; d += 64) { float y = bf2f(Y[(size_t)(SH_BASE + r - ROW0) * D + d]); for (int t = 0; t < 8; ++t) y += top_w[r * 8 + t] * bf2f(Y[(size_t)tslot[r * 8 + t] * D + d]); fsh[wv][d] = y; ss += y * y; }
    ss = wave_sum(ss); const float rstd = rsqrtf(ss / D + EPS);
    bad = 0;
    if (L == 0) { float s2 = 0; for (int d = lane; d < D; d += 64) { const float x = HRES[(size_t)r * D + d]; s2 += x * x; } s2 = wave_sum(s2); const float rstd2 = rsqrtf(s2 / D + EPS);
      const float* mod1 = MOD + (size_t)2 * 12288 + (r < CTXL ? 12288 : 0);
      for (int d = lane; d < D; d += 64) { const float ref = HRES[(size_t)r * D + d] * rstd2 * a.in[6][4 * D + d] * (1.f + mod1[D + d]) + mod1[d]; bad += !dclose(bf2f(AB[(size_t)r * D + d]), ref, 0.01f, 0.01f); } }
    else { for (int d = lane; d < D; d += 64) { const float ref = HRES[(size_t)r * D + d] + mod[5 * D + d] * (fsh[wv][d] * rstd * ng[3 * D + d]); bad += !dclose(a.out[(size_t)(r - CTXL) * D + d], ref, 1e-3f, 1e-3f); } }
    bad = (int)wave_sum((float)bad); dflag(dg, L == 0 ? 14 : 25, bad, lane);
  } else if (k == 12) {
    const int r = pick_row(h, CTXL, SEQ), hh = h2 % 32;
    float raw0 = 0, raw1 = 0;
    for (int d = 0; d < 128; ++d) { const float v = wdot(AB + (size_t)r * D, a.in[15], N_IN1, hh * 128 + d, D, lane); if (d == lane) raw0 = v; if (d == lane + 64) raw1 = v; }
    float cs, sn; rope_cs(r, lane, cs, sn);
    const float cs0 = __shfl(cs, lane & 31), sn0 = __shfl(sn, lane & 31), cs1 = __shfl(cs, 32 + (lane & 31)), sn1 = __shfl(sn, 32 + (lane & 31));
    const float p0 = __shfl_xor(raw0, 32), p1 = __shfl_xor(raw1, 32);
    const float o0 = (lane < 32) ? raw0 * cs0 - p0 * sn0 : raw0 * cs0 + p0 * sn0;
    const float o1 = (lane < 32) ? raw1 * cs1 - p1 * sn1 : raw1 * cs1 + p1 * sn1;
    bad = !dclose(bf2f(QK[(size_t)r * N_IN1 + hh * 128 + lane]), o0, 0.03f, 0.05f) + !dclose(bf2f(QK[(size_t)r * N_IN1 + hh * 128 + 64 + lane]), o1, 0.03f, 0.05f);
    bad = (int)wave_sum((float)bad); dflag(dg, 16, bad, lane);
  } else if (k == 13) {
    if (gw < 64) { const int r = pick_row(h, CTXL, SEQ), hc = h2 % 16, vh = (h2 >> 4) & 1, hd = hc >> 1;
      float o0, o1; naive_attn(QK + (size_t)r * N_IN1 + hc * 128, QK + 2048 + hc * 128, QK + 4096 + hd * 256 + vh * 128, N_IN1, MT, lane, o0, o1);
      const bf16_t* O = Y + (size_t)(r - CTXL) * 4096 + hc * 256 + vh * 128;
      bad = !dclose(bf2f(O[lane]), o0, 0.05f, 0.01f) + !dclose(bf2f(O[64 + lane]), o1, 0.05f, 0.01f);
      bad = (int)wave_sum((float)bad); dflag(dg, 17, bad, lane); }
  } else if (k == 14) {
    const int r = pick_row(h, CTXL, SEQ), hd = h2 % 8; const float* lp = a.in[17];
    float s1 = 0, s2 = 0; for (int i = lane; i < 128; i += 64) { s1 += lp[i] * lp[128 + i]; s2 += lp[256 + i] * lp[384 + i]; } s1 = wave_sum(s1); s2 = wave_sum(s2);
    const float lam = expf(s1) - expf(s2) + LAM_INIT; const bf16_t* O = Y + (size_t)(r - CTXL) * 4096;
    float dv[4], ss = 0; for (int i = 0; i < 4; ++i) { const int d = lane + 64 * i; dv[i] = bf2f(O[(2 * hd) * 256 + d]) - lam * bf2f(O[(2 * hd + 1) * 256 + d]); ss += dv[i] * dv[i]; }
    ss = wave_sum(ss); const float rstd = rsqrtf(ss / 256.f + EPS) * (1.f - LAM_INIT); bad = 0;
    for (int i = 0; i < 4; ++i) { const int d = lane + 64 * i; bad += !dclose(bf2f(X2[(size_t)r * D + hd * 256 + d]), dv[i] * rstd * a.in[18][d], 0.02f, 0.01f); }
    bad = (int)wave_sum((float)bad); dflag(dg, 18, bad, lane);
  }
}
__global__ void diag_encode(Args a) {
  const int* dg = (const int*)(a.ws + WS_CTL + CTL_CNT + 512);
  int s = 0;
  int sub = 0;
  for (int i = 1; i < 32; ++i) { int v = dg[i]; if (i == 10 || i == 21) { v = (dg[32 + i] > 25 ? 1 : 0) + (dg[33 + i] > 0 ? 2 : 0) + (dg[34 + i] > 0 ? 4 : 0) + (dg[35 + i] > 0 ? 8 : 0) + (dg[36 + i] > 0 ? 16 : 0); sub = v; } if (v) { s = i; break; } }
  if (s == 0) return;
  const float c = sub ? 30.f + 8.f * sub : 10.f * s;
  for (size_t i = (size_t)blockIdx.x * blockDim.x + threadIdx.x; i < (size_t)SEQ * D; i += (size_t)gridDim.x * blockDim.x) a.out[i] = c;
}
#endif

extern "C" void kernel_launch(void* const* d_in, const int* in_sizes, int n_in, void* d_out, int out_size, void* d_ws, size_t ws_size, hipStream_t stream) {
  static int grid = 0;
  if (grid == 0) {
    if (n_in != 27 || out_size != SEQ * D || ws_size < WS_END) { fprintf(stderr, "kernel_launch: unexpected shapes (n_in %d out %d ws %zu need %zu)\n", n_in, out_size, ws_size, (size_t)WS_END); grid = -1; return; }
    if (hipFuncSetAttribute((const void*)fwd, hipFuncAttributeMaxDynamicSharedMemorySize, LDS_BYTES) != hipSuccess) { fprintf(stderr, "kernel_launch: hipFuncSetAttribute failed\n"); grid = -1; return; }
    int dev = 0, cus = 0, per_cu = 0;
    hipGetDevice(&dev); hipDeviceGetAttribute(&cus, hipDeviceAttributeMultiprocessorCount, dev);
    if (hipOccupancyMaxActiveBlocksPerMultiprocessor(&per_cu, (const void*)fwd, NTHREADS, LDS_BYTES) != hipSuccess || per_cu < 1) fprintf(stderr, "kernel_launch: occupancy query says %d\n", per_cu);
    (void)hipGetLastError();
    grid = cus < 256 ? cus : 256;
    if (grid != 256) fprintf(stderr, "kernel_launch: %d CUs (expected 256)\n", cus);
  }
  if (grid < 0) return;
  hipMemsetAsync((char*)d_ws + WS_CTL, 0, CTL_BYTES, stream);
  Args a{};
  for (int i = 0; i < 27; ++i) a.in[i] = (const float*)d_in[i];
  a.out = (float*)d_out; a.ws = (unsigned char*)d_ws;
#if MK_MULTI
  for (int k = 0; k < NPH; ++k) { a.ph_lo = k; a.ph_hi = k + 1; hipLaunchKernelGGL(fwd, dim3(grid), dim3(NTHREADS), LDS_BYTES, stream, a);
#if MK_DIAG
    hipLaunchKernelGGL(diag, dim3(64), dim3(256), 0, stream, a, k);
#endif
  }
#if MK_DIAG
  hipLaunchKernelGGL(diag_encode, dim3(1024), dim3(256), 0, stream, a);
#endif
#else
  a.ph_lo = 0; a.ph_hi = NPH;
  hipLaunchKernelGGL(fwd, dim3(grid), dim3(NTHREADS), LDS_BYTES, stream, a);
#endif
  const hipError_t le = hipPeekAtLastError();
  if (le != hipSuccess) fprintf(stderr, "kernel_launch: launch failed: %s\n", hipGetErrorName(le));
}
```

```cpp
#include <hip/hip_runtime.h>
#include <cstdio>
#include <cstdint>

#define MK_DIAG 0
#ifndef MK_MULTI
#define MK_MULTI 0
#endif

#define LAS __attribute__((address_space(3)))
typedef unsigned short bf16_t;
typedef short bf16x8 __attribute__((ext_vector_type(8)));
typedef short s16x4 __attribute__((ext_vector_type(4)));
typedef float f32x4 __attribute__((ext_vector_type(4)));
typedef float f32x2 __attribute__((ext_vector_type(2)));
typedef float f32x16 __attribute__((ext_vector_type(16)));
typedef unsigned u32x4 __attribute__((ext_vector_type(4)));
typedef unsigned u32x2 __attribute__((ext_vector_type(2)));

constexpr int D = 2048, SEQ = 16384, CTXL = 256, MT = SEQ + CTXL;
constexpr int NE = 64, TOPK = 8, EFF = 512;
constexpr int N_IN0 = 3584, N_QKV0 = 1536, N_IN1 = 6144;
constexpr float EPS = 1e-6f;
constexpr float LAM_INIT = 0.35550907f;
constexpr int SH_BASE = SEQ * 0 + (MT * TOPK) + NE * 256;
constexpr int NSLOT = SH_BASE + MT;
constexpr int NTHREADS = 512;
constexpr int LDS_BYTES = 131072 + 1024;
constexpr int LDS_CTL = 131072;

constexpr size_t al256(size_t x) { return (x + 255) & ~(size_t)255; }
constexpr size_t WS_CTL   = 0;
constexpr size_t CTL_BYTES = 32768;
constexpr size_t CTL_CNT  = 16384;
constexpr size_t CTL_KMAX = 16384 + 2048;
constexpr size_t WS_MOD   = CTL_BYTES;
constexpr size_t WS_WIN0  = al256(WS_MOD + 2 * 2 * 12288 * 4);
constexpr size_t WS_WOUT0 = al256(WS_WIN0 + (size_t)N_IN0 * D * 2);
constexpr size_t WS_WIN1  = al256(WS_WOUT0 + (size_t)D * D * 2);
constexpr size_t WS_WOUT1 = al256(WS_WIN1 + (size_t)N_IN1 * D * 2);
constexpr size_t WMOE_E   = (size_t)1024 * D + (size_t)D * EFF;
constexpr size_t WS_WMOE  = al256(WS_WOUT1 + (size_t)D * D * 2);
constexpr size_t WS_HRES  = al256(WS_WMOE + 65 * WMOE_E * 2);
constexpr size_t WS_ABUF  = al256(WS_HRES + (size_t)MT * D * 4);
constexpr size_t WS_QKVU  = al256(WS_ABUF + (size_t)MT * D * 2);
constexpr size_t WS_HG    = al256(WS_QKVU + (size_t)MT * N_IN1 * 2);
constexpr size_t WS_X2    = al256(WS_HG + (size_t)MT * 1024 * 2);
constexpr size_t WS_OUT   = al256(WS_X2 + (size_t)MT * D * 2);
constexpr size_t WS_ACT   = al256(WS_OUT + (size_t)MT * D * 2);
constexpr size_t WS_K8    = WS_ACT + al256((size_t)NSLOT * EFF);
constexpr size_t WS_Y     = al256(WS_ACT + (size_t)NSLOT * EFF * 2);
constexpr size_t WS_TOPE  = al256(WS_Y + (size_t)NSLOT * D * 2);
constexpr size_t WS_TOPW  = al256(WS_TOPE + (size_t)MT * TOPK * 4);
constexpr size_t WS_TOPP  = al256(WS_TOPW + (size_t)MT * TOPK * 4);
constexpr size_t WS_TSLOT = al256(WS_TOPP + (size_t)MT * TOPK * 4);
constexpr size_t WS_STOK  = al256(WS_TSLOT + (size_t)MT * TOPK * 4);
constexpr size_t WS_END   = al256(WS_STOK + (size_t)NSLOT * 4);

struct Args { const float* in[27]; float* out; unsigned char* ws; int ph_lo, ph_hi; };

__device__ __forceinline__ float bflo(unsigned x) { return __uint_as_float(x << 16); }
__device__ __forceinline__ float bfhi(unsigned x) { return __uint_as_float(x & 0xffff0000u); }
__device__ __forceinline__ float bf2f(bf16_t b) { return __uint_as_float(((unsigned)b) << 16); }
__device__ __forceinline__ unsigned cvtpk(float lo, float hi) { unsigned r; asm("v_cvt_pk_bf16_f32 %0, %1, %2" : "=v"(r) : "v"(lo), "v"(hi)); return r; }
__device__ __forceinline__ bf16_t f2bf(float x) { return (bf16_t)(cvtpk(x, 0.f) & 0xffffu); }
__device__ __forceinline__ float wave_sum(float v) {
#pragma unroll
  for (int o = 32; o; o >>= 1) v += __shfl_xor(v, o);
  return v;
}
__device__ __forceinline__ float sigmoidf_(float x) { return 1.f / (1.f + expf(-x)); }
__device__ __forceinline__ float sigmoid_fast(float x) { return __builtin_amdgcn_rcpf(1.f + __builtin_amdgcn_exp2f(-1.4426950408889634f * x)); }

__device__ __forceinline__ float clamp8e(float x) { return fminf(fmaxf(x, -448.f), 448.f); }
__device__ __forceinline__ unsigned pack8x4(float a, float b, float c, float d) {
  int p = __builtin_amdgcn_cvt_pk_fp8_f32(clamp8e(a), clamp8e(b), 0, false); p = __builtin_amdgcn_cvt_pk_fp8_f32(clamp8e(c), clamp8e(d), p, true); return (unsigned)p; }
__device__ __forceinline__ float sq8x4(unsigned p) {
  const float a = __builtin_amdgcn_cvt_f32_fp8((int)p, 0), b = __builtin_amdgcn_cvt_f32_fp8((int)p, 1), c = __builtin_amdgcn_cvt_f32_fp8((int)p, 2), d = __builtin_amdgcn_cvt_f32_fp8((int)p, 3);
  return a * a + b * b + c * c + d * d; }
typedef int v8i_ __attribute__((ext_vector_type(8)));
typedef int v4i __attribute__((ext_vector_type(4)));
#define XB_TMO      128
#define XB_XCNT(j)  (256  + 64 * (j))
#define XB_XSUB(j)  (1280 + 64 * (j))
#define XB_XGEN(j)  (2304 + 64 * (j))
#define XB_TOP      3328
#define XB_TOPGEN   3392
#define XCD_BAR_WORDS 3456
#define XB_SPIN_CAP (1u << 22)
__device__ __forceinline__ unsigned xb_ld(unsigned* p)              { return __hip_atomic_load(p, __ATOMIC_RELAXED, __HIP_MEMORY_SCOPE_AGENT); }
__device__ __forceinline__ unsigned xb_add(unsigned* p, unsigned v) { return __hip_atomic_fetch_add(p, v, __ATOMIC_RELAXED, __HIP_MEMORY_SCOPE_AGENT); }
__device__ __forceinline__ unsigned xb_xcc_id() { return (unsigned)__builtin_amdgcn_s_getreg((3 << 11) | 20) & 0xFu; }
#define XB_SPIN(cond, bar) do { unsigned _sp = 0; while (cond) { __builtin_amdgcn_s_sleep(1); \
    if ((++_sp & 255u) == 0u) { if (xb_ld(&(bar)[XB_TMO])) break; if (_sp > XB_SPIN_CAP) { atomicAdd(&(bar)[XB_TMO], 1u); break; } } } } while (0)
struct XcdBarrier { unsigned* bar; unsigned x; volatile LAS unsigned* st; };
__device__ __forceinline__ XcdBarrier xcd_barrier_post(unsigned* bar, volatile LAS unsigned* st) {
    XcdBarrier b; b.bar = bar; b.x = xb_xcc_id(); b.st = st;
    if (threadIdx.x == 0) (void)xb_add(&bar[XB_XCNT(b.x)], 1u);
    return b;
}
__device__ __forceinline__ void xcd_barrier_complete(unsigned* bar, unsigned x, unsigned& nloc, unsigned& nx) {
    const unsigned G = gridDim.x * gridDim.y * gridDim.z;
    unsigned sum, cnt, mine, sp = 0u;
    for (;;) {
        sum = 0u; cnt = 0u; mine = 0u;
#pragma unroll
        for (unsigned j = 0; j < 16; ++j) { const unsigned c = xb_ld(&bar[XB_XCNT(j)]); sum += c; cnt += (c > 0u) ? 1u : 0u; mine = (j == x) ? c : mine; }
        if (sum == G) break;
        __builtin_amdgcn_s_sleep(1);
        if ((++sp & 255u) == 0u) { if (xb_ld(&bar[XB_TMO])) break; if (sp > XB_SPIN_CAP) { atomicAdd(&bar[XB_TMO], 1u); break; } }
    }
    nloc = mine > 0u ? mine : 1u; nx = cnt > 0u ? cnt : 1u;
}
__device__ __forceinline__ void xcd_barrier(const XcdBarrier& b) {
    asm volatile("s_waitcnt vmcnt(0)" ::: "memory");
    __syncthreads();
    if (threadIdx.x == 0) {
        unsigned* bar = b.bar;
        __builtin_amdgcn_s_waitcnt(0);
        unsigned nloc = b.st[0], nx = b.st[1];
        if (nloc == 0u) { xcd_barrier_complete(bar, b.x, nloc, nx); b.st[0] = nloc; b.st[1] = nx; }
        const unsigned old = xb_add(&bar[XB_XSUB(b.x)], 1u);
        const unsigned gen = old / nloc;
        if (old + 1u == (gen + 1u) * nloc) {
            __builtin_amdgcn_fence(__ATOMIC_RELEASE, "agent");
            asm volatile("s_waitcnt vmcnt(0)" ::: "memory");
            const unsigned og = xb_add(&bar[XB_TOP], 1u);
            const unsigned tg = og / nx;
            if (og + 1u == (tg + 1u) * nx) xb_add(&bar[XB_TOPGEN], 1u);
            else XB_SPIN(xb_ld(&bar[XB_TOPGEN]) == tg, bar);
            __builtin_amdgcn_fence(__ATOMIC_ACQUIRE, "agent");
            xb_add(&bar[XB_XGEN(b.x)], 1u);
            asm volatile("s_waitcnt vmcnt(0)" ::: "memory");
        } else {
            XB_SPIN(xb_ld(&bar[XB_XGEN(b.x)]) == gen, bar);
            __builtin_amdgcn_fence(__ATOMIC_ACQUIRE, "agent");
            asm volatile("s_waitcnt vmcnt(0)" ::: "memory");
        }
    }
    __syncthreads();
}

__device__ __forceinline__ int lds_byte(int r, int c) {
  int st = (r >> 4) * 2 + (c >> 5), rr = r & 15, cc = c & 31, ob = rr * 64 + cc * 2;
  return st * 1024 + (ob ^ (((ob >> 9) & 1) << 5));
}
#define GLDS(gp, lp) __builtin_amdgcn_global_load_lds((const unsigned*)(gp), (LAS unsigned*)(lp), 16, 0, 0)
#define WAIT_V(n) asm volatile("s_waitcnt vmcnt(" #n ")" ::: "memory")
#define WAIT_L(n) asm volatile("s_waitcnt lgkmcnt(" #n ")" ::: "memory")
#define BAR __builtin_amdgcn_s_barrier()
#define SCHED __builtin_amdgcn_sched_barrier(0)

template <bool GATHER, class Epi>
__device__ __forceinline__ void gemm_tile(const bf16_t* __restrict__ A, const int lda, const int* __restrict__ tok, const int brow,
                                          const bf16_t* __restrict__ Bt, const int ldb, const int bcol, const int K,
                                          LAS char* shm, const Epi& epi) {
#define G_SA(b, h) (shm + ((b) * 2 + (h)) * 16384)
#define G_SB(b, h) (shm + (4 + (b) * 2 + (h)) * 16384)
  int tid = threadIdx.x; asm volatile("" : "+v"(tid)); tid &= 511;
  int wid = tid >> 6, lane = tid & 63, wr = wid >> 2, wc = wid & 3, fr = lane & 15, fq = lane >> 4;
  unsigned ao0, ao1, ao2, ao3, bo;
  {
    const int sb = (tid & 63) * 16, swz = sb ^ (((sb >> 9) & 1) << 5);
    const int R0 = ((tid >> 6) >> 1) * 16 + (swz >> 6), C0 = ((tid >> 6) & 1) * 32 + ((swz & 63) >> 1);
    if (GATHER) { ao0 = (unsigned)(tok[R0] * lda + C0); ao1 = (unsigned)(tok[R0 + 64] * lda + C0); ao2 = (unsigned)(tok[R0 + 128] * lda + C0); ao3 = (unsigned)(tok[R0 + 192] * lda + C0); }
    else { ao0 = (unsigned)((brow + R0) * lda + C0); ao1 = ao0 + 64u * lda; ao2 = ao0 + 128u * lda; ao3 = ao0 + 192u * lda; }
    bo = (unsigned)((bcol + R0) * ldb + C0);
  }
  const int lo = __builtin_amdgcn_readfirstlane(tid >> 6) * 1024;
#define STAGE_A0(P, kt) do { GLDS((A + (kt) * 64) + ao0, (P) + lo); GLDS((A + (kt) * 64) + ao1, (P) + lo + 8192); } while (0)
#define STAGE_A1(P, kt) do { GLDS((A + (kt) * 64) + ao2, (P) + lo); GLDS((A + (kt) * 64) + ao3, (P) + lo + 8192); } while (0)
#define STAGE_B0(P, kt) do { GLDS((Bt + (kt) * 64) + bo, (P) + lo); GLDS((Bt + 64 * ldb + (kt) * 64) + bo, (P) + lo + 8192); } while (0)
#define STAGE_B1(P, kt) do { GLDS((Bt + 128 * ldb + (kt) * 64) + bo, (P) + lo); GLDS((Bt + 192 * ldb + (kt) * 64) + bo, (P) + lo + 8192); } while (0)
#define LDA(dst, b, h) _Pragma("unroll") for (int m = 0; m < 4; ++m) _Pragma("unroll") for (int k = 0; k < 2; ++k) \
    dst[m][k] = *(LAS const bf16x8*)(G_SA(b, h) + lds_byte(wr * 64 + m * 16 + fr, k * 32 + fq * 8))
#define LDB(dst, b, h) _Pragma("unroll") for (int n = 0; n < 2; ++n) _Pragma("unroll") for (int k = 0; k < 2; ++k) \
    dst[n][k] = *(LAS const bf16x8*)(G_SB(b, h) + lds_byte(wc * 32 + n * 16 + fr, k * 32 + fq * 8))
#define MMA(ai, bj, At_, Bt_) do { __builtin_amdgcn_s_setprio(1); \
    _Pragma("unroll") for (int m = 0; m < 4; ++m) _Pragma("unroll") for (int n = 0; n < 2; ++n) _Pragma("unroll") for (int k = 0; k < 2; ++k) \
      acc[ai][bj][m][n] = __builtin_amdgcn_mfma_f32_16x16x32_bf16(Bt_[n][k], At_[m][k], acc[ai][bj][m][n], 0, 0, 0); \
    __builtin_amdgcn_s_setprio(0); } while (0)

  f32x4 acc[2][2][4][2] = {};
  bf16x8 At[4][2], B0[2][2], B1[2][2];
  const int nt = K / 64;
  STAGE_B0(G_SB(0, 0), 0); STAGE_A0(G_SA(0, 0), 0);
  STAGE_B1(G_SB(0, 1), 0); STAGE_A1(G_SA(0, 1), 0);
  if (wr == 1) BAR;
  WAIT_V(4); BAR;
  STAGE_B0(G_SB(1, 0), 1); STAGE_A0(G_SA(1, 0), 1); STAGE_B1(G_SB(1, 1), 1);
  WAIT_V(6); BAR;
  for (int t = 0; t < nt - 2; t += 2) {
    LDB(B0, 0, 0); SCHED; LDA(At, 0, 0); STAGE_A1(G_SA(1, 1), t + 1);
    WAIT_L(8); BAR; WAIT_L(0); MMA(0, 0, At, B0); BAR; SCHED;
    LDB(B1, 0, 1); STAGE_B0(G_SB(0, 0), t + 2);
    BAR; WAIT_L(0); MMA(0, 1, At, B1); BAR;
    LDA(At, 0, 1); STAGE_A0(G_SA(0, 0), t + 2);
    BAR; WAIT_L(0); MMA(1, 0, At, B0); BAR; SCHED;
    STAGE_B1(G_SB(0, 1), t + 2);
    WAIT_V(6); BAR; MMA(1, 1, At, B1); BAR;
    LDB(B0, 1, 0); SCHED; LDA(At, 1, 0); STAGE_A1(G_SA(0, 1), t + 2);
    WAIT_L(8); BAR; WAIT_L(0); MMA(0, 0, At, B0); BAR; SCHED;
    LDB(B1, 1, 1); STAGE_B0(G_SB(1, 0), t + 3);
    BAR; WAIT_L(0); MMA(0, 1, At, B1); BAR;
    LDA(At, 1, 1); STAGE_A0(G_SA(1, 0), t + 3);
    BAR; WAIT_L(0); MMA(1, 0, At, B0); BAR; SCHED;
    STAGE_B1(G_SB(1, 1), t + 3);
    WAIT_V(6); BAR; MMA(1, 1, At, B1); BAR;
  }
  { LDB(B0, 0, 0); WAIT_V(0); LDA(At, 0, 0); STAGE_A1(G_SA(1, 1), nt - 1);
    BAR; WAIT_L(0); MMA(0, 0, At, B0); BAR;
    LDB(B1, 0, 1); BAR; WAIT_L(0); MMA(0, 1, At, B1); BAR;
    LDA(At, 0, 1); WAIT_V(4); BAR; WAIT_L(0); MMA(1, 0, At, B0); MMA(1, 1, At, B1); BAR; }
  { LDB(B0, 1, 0); LDA(At, 1, 0); WAIT_V(2); BAR; WAIT_L(0); MMA(0, 0, At, B0); BAR;
    LDB(B1, 1, 1); WAIT_V(0); BAR; WAIT_L(0); MMA(0, 1, At, B1); BAR;
    LDA(At, 1, 1); BAR; WAIT_L(0); MMA(1, 0, At, B0); MMA(1, 1, At, B1); BAR; }
  if (wr == 0) BAR;
  int tz = threadIdx.x; asm volatile("" : "+v"(tz)); wid = tz >> 6; lane = tz & 63; wr = wid >> 2; wc = wid & 3; fr = lane & 15; fq = lane >> 4;
  epi(acc, brow, bcol, wr, wc, fr, fq);
#undef G_SA
#undef G_SB
#undef STAGE_A0
#undef STAGE_A1
#undef STAGE_B0
#undef STAGE_B1
#undef LDA
#undef LDB
#undef MMA
}

struct EpiPlain {
  bf16_t* C; int ldc;
  __device__ __forceinline__ void operator()(const f32x4 (&acc)[2][2][4][2], int brow, int bcol, int wr, int wc, int fr, int fq) const {
#pragma unroll
    for (int ai = 0; ai < 2; ++ai)
#pragma unroll
      for (int m = 0; m < 4; ++m) {
        bf16_t* rp = C + (size_t)(brow + ai * 128 + wr * 64 + m * 16 + fr) * ldc + bcol + wc * 32 + fq * 8;
#pragma unroll
        for (int bj = 0; bj < 2; ++bj) {
          u32x4 v = {cvtpk(acc[ai][bj][m][0][0], acc[ai][bj][m][0][1]), cvtpk(acc[ai][bj][m][0][2], acc[ai][bj][m][0][3]),
                     cvtpk(acc[ai][bj][m][1][0], acc[ai][bj][m][1][1]), cvtpk(acc[ai][bj][m][1][2], acc[ai][bj][m][1][3])};
          *(u32x4*)(rp + bj * 128) = v;
        }
      }
  }
};
template <int MODE>
struct EpiPair {
  bf16_t* C; int ldc; int colbase;
  __device__ __forceinline__ void operator()(const f32x4 (&acc)[2][2][4][2], int brow, int bcol, int wr, int wc, int fr, int fq) const {
#pragma unroll
    for (int ai = 0; ai < 2; ++ai)
#pragma unroll
      for (int m = 0; m < 4; ++m) {
        bf16_t* rp = C + (size_t)(brow + ai * 128 + wr * 64 + m * 16 + fr) * ldc + ((bcol - colbase) >> 1) + wc * 16 + fq * 4;
#pragma unroll
        for (int bj = 0; bj < 2; ++bj) {
          float r[4];
#pragma unroll
          for (int j = 0; j < 4; ++j) {
            const float x0 = acc[ai][bj][m][0][j], x1 = acc[ai][bj][m][1][j];
            r[j] = MODE == 0 ? x0 * sigmoid_fast(x1) : x0 * sigmoid_fast(x0) * x1;
          }
          u32x2 v = {cvtpk(r[0], r[1]), cvtpk(r[2], r[3])};
          *(u32x2*)(rp + bj * 64) = v;
        }
      }
  }
};
struct EpiG1 {
  EpiPlain p; EpiPair<0> g; int nplain;
  __device__ __forceinline__ void operator()(const f32x4 (&acc)[2][2][4][2], int brow, int bcol, int wr, int wc, int fr, int fq) const {
    if (bcol < nplain) p(acc, brow, bcol, wr, wc, fr, fq); else g(acc, brow, bcol, wr, wc, fr, fq);
  }
};

typedef int v8i __attribute__((ext_vector_type(8)));
__device__ __forceinline__ int lds8(int r, int c) { return r * 128 + ((c ^ ((r >> 1) & 7)) << 4); }
template <bool GATHER, int lda, int ldb, int K, class Epi, class S>
__device__ __forceinline__ void gemm8_run(const unsigned char* __restrict__ A, const int* __restrict__ stok,
                                          LAS char* shm, const Epi& epi, const S& sched) {
#define G_SA(b, h) (shm + ((b) * 2 + (h)) * 16384)
#define G_SB(b, h) (shm + (4 + (b) * 2 + (h)) * 16384)
  int tid = threadIdx.x; asm volatile("" : "+v"(tid)); tid &= 511;
  int wid = tid >> 6, lane = tid & 63, wr = wid >> 2, wc = wid & 3, fr = lane & 15, fq = lane >> 4;
  unsigned ao0, ao1, ao2, ao3, bo;
  int R0 = 8 * wid + (lane >> 3), C0 = ((lane & 7) ^ ((R0 >> 1) & 7)) << 4;
  const int lo = __builtin_amdgcn_readfirstlane(tid >> 6) * 1024;
  int brow, bcol; const unsigned char* Bt;
  int ui = 0;
  if (!sched.unit(ui, brow, Bt, bcol)) return;
#define SETOFF(br, bc) do { if (GATHER) { const int* _t = stok + (br); ao0 = (unsigned)(_t[R0] * lda + C0); ao1 = (unsigned)(_t[R0 + 64] * lda + C0); ao2 = (unsigned)(_t[R0 + 128] * lda + C0); ao3 = (unsigned)(_t[R0 + 192] * lda + C0); } \
    else { ao0 = (unsigned)(((br) + R0) * lda + C0); ao1 = ao0 + 64u * lda; ao2 = ao0 + 128u * lda; ao3 = ao0 + 192u * lda; } \
    bo = (unsigned)(((bc) + R0) * ldb + C0); } while (0)
#define STAGE_A0(P, kt) do { GLDS((A + (kt) * 128) + ao0, (P) + lo); GLDS((A + (kt) * 128) + ao1, (P) + lo + 8192); } while (0)
#define STAGE_A1(P, kt) do { GLDS((A + (kt) * 128) + ao2, (P) + lo); GLDS((A + (kt) * 128) + ao3, (P) + lo + 8192); } while (0)
#define STAGE_B0(P, kt) do { GLDS((Bt + (kt) * 128) + bo, (P) + lo); GLDS((Bt + 64 * ldb + (kt) * 128) + bo, (P) + lo + 8192); } while (0)
#define STAGE_B1(P, kt) do { GLDS((Bt + 128 * ldb + (kt) * 128) + bo, (P) + lo); GLDS((Bt + 192 * ldb + (kt) * 128) + bo, (P) + lo + 8192); } while (0)
#define PRO() do { STAGE_B0(G_SB(0, 0), 0); STAGE_A0(G_SA(0, 0), 0); STAGE_B1(G_SB(0, 1), 0); STAGE_A1(G_SA(0, 1), 0); } while (0)
  const int fx = (fq ^ ((fr >> 1) & 7)) << 4;
  const int fa0 = (wr * 64 + fr) * 128 + fx, fb0 = (wc * 32 + fr) * 128 + fx;
#define FRAG8(dst, p0, p1) do { const v4i _x = *(LAS const v4i*)(p0); const v4i _y = *(LAS const v4i*)(p1); \
    dst = (v8i){_x[0], _x[1], _x[2], _x[3], _y[0], _y[1], _y[2], _y[3]}; } while (0)
#define LDA(dst, b, h) do { int fa1 = fa0; asm volatile("v_xor_b32 %0, 64, %0" : "+v"(fa1)); \
    _Pragma("unroll") for (int m = 0; m < 4; ++m) FRAG8(dst[m], G_SA(b, h) + fa0 + m * 2048, G_SA(b, h) + fa1 + m * 2048); } while (0)
#define LDB(dst, b, h) do { int fb1 = fb0; asm volatile("v_xor_b32 %0, 64, %0" : "+v"(fb1)); \
    _Pragma("unroll") for (int n = 0; n < 2; ++n) FRAG8(dst[n], G_SB(b, h) + fb0 + n * 2048, G_SB(b, h) + fb1 + n * 2048); } while (0)
#define MMA(ai, bj, At_, Bt_) do { __builtin_amdgcn_s_setprio(1); \
    _Pragma("unroll") for (int m = 0; m < 4; ++m) _Pragma("unroll") for (int n = 0; n < 2; ++n) \
      asm volatile("v_mfma_scale_f32_16x16x128_f8f6f4 %0, %1, %2, %0, %3, %3 op_sel_hi:[0,0,0]" : "+v"(acc[ai][bj][m][n]) : "v"(Bt_[n]), "v"(At_[m]), "v"(sc1)); \
    __builtin_amdgcn_s_setprio(0); } while (0)
  int sc1; asm volatile("v_mov_b32 %0, 0x7f7f7f7f" : "=v"(sc1));
  const int nt = K / 128;
  SETOFF(brow, bcol); PRO();
  bool first = true;
  for (;;) {
    f32x4 acc[2][2][4][2] = {};
    v8i At[4], B0[2], B1[2];
    if (wr == 1) BAR;
    if (first) WAIT_V(4); else WAIT_V(0);
    BAR;
    STAGE_B0(G_SB(1, 0), 1); STAGE_A0(G_SA(1, 0), 1); STAGE_B1(G_SB(1, 1), 1);
    WAIT_V(6); BAR;
    for (int t = 0; t < nt - 2; t += 2) {
      LDB(B0, 0, 0); SCHED; LDA(At, 0, 0); STAGE_A1(G_SA(1, 1), t + 1);
      WAIT_L(8); BAR; WAIT_L(0); MMA(0, 0, At, B0); BAR; SCHED;
      LDB(B1, 0, 1); STAGE_B0(G_SB(0, 0), t + 2);
      BAR; WAIT_L(0); MMA(0, 1, At, B1); BAR;
      LDA(At, 0, 1); STAGE_A0(G_SA(0, 0), t + 2);
      BAR; WAIT_L(0); MMA(1, 0, At, B0); BAR; SCHED;
      STAGE_B1(G_SB(0, 1), t + 2);
      WAIT_V(6); BAR; MMA(1, 1, At, B1); BAR;
      LDB(B0, 1, 0); SCHED; LDA(At, 1, 0); STAGE_A1(G_SA(0, 1), t + 2);
      WAIT_L(8); BAR; WAIT_L(0); MMA(0, 0, At, B0); BAR; SCHED;
      LDB(B1, 1, 1); STAGE_B0(G_SB(1, 0), t + 3);
      BAR; WAIT_L(0); MMA(0, 1, At, B1); BAR;
      LDA(At, 1, 1); STAGE_A0(G_SA(1, 0), t + 3);
      BAR; WAIT_L(0); MMA(1, 0, At, B0); BAR; SCHED;
      STAGE_B1(G_SB(1, 1), t + 3);
      WAIT_V(6); BAR; MMA(1, 1, At, B1); BAR;
    }
    { LDB(B0, 0, 0); WAIT_V(0); LDA(At, 0, 0); STAGE_A1(G_SA(1, 1), nt - 1);
      BAR; WAIT_L(0); MMA(0, 0, At, B0); BAR;
      LDB(B1, 0, 1); BAR; WAIT_L(0); MMA(0, 1, At, B1); BAR;
      LDA(At, 0, 1); WAIT_V(4); BAR; WAIT_L(0); MMA(1, 0, At, B0); MMA(1, 1, At, B1); BAR; }
    { LDB(B0, 1, 0); LDA(At, 1, 0); WAIT_V(2); BAR; WAIT_L(0); MMA(0, 0, At, B0); BAR;
      LDB(B1, 1, 1); WAIT_V(0); BAR; WAIT_L(0); MMA(0, 1, At, B1); BAR;
      LDA(At, 1, 1); BAR; WAIT_L(0); MMA(1, 0, At, B0); MMA(1, 1, At, B1); BAR; }
    if (wr == 0) BAR;
    const int cbrow = brow, cbcol = bcol;
    { int tz = threadIdx.x; asm volatile("" : "+v"(tz)); tz &= 511; wid = tz >> 6; lane = tz & 63; wr = wid >> 2; wc = wid & 3; fr = lane & 15; fq = lane >> 4;
      R0 = 8 * wid + (lane >> 3); C0 = ((lane & 7) ^ ((R0 >> 1) & 7)) << 4; }
    ++ui;
    const bool more = sched.unit(ui, brow, Bt, bcol);
    if (more) { SETOFF(brow, bcol); asm volatile("" ::: "memory"); PRO(); asm volatile("" ::: "memory"); }
    asm volatile("s_nop 15\n\ts_nop 15\n\ts_nop 7" ::: "memory");
#pragma unroll
    for (int i = 0; i < 32; ++i) asm volatile("" : "+v"((&acc[0][0][0][0])[i]));
    epi(acc, cbrow, cbcol, wr, wc, fr, fq);
    if (!more) break;
    first = false;
  }
#undef G_SA
#undef G_SB
#undef SETOFF
#undef STAGE_A0
#undef STAGE_A1
#undef STAGE_B0
#undef STAGE_B1
#undef PRO
#undef FRAG8
#undef LDA
#undef LDB
#undef MMA
}
__device__ __forceinline__ float clamp8(float x) { return fminf(fmaxf(x, -448.f), 448.f); }
__device__ __forceinline__ unsigned pack_fp8x4(float a, float b, float c, float d) {
  int p = __builtin_amdgcn_cvt_pk_fp8_f32(clamp8(a), clamp8(b), 0, false); p = __builtin_amdgcn_cvt_pk_fp8_f32(clamp8(c), clamp8(d), p, true); return (unsigned)p; }
struct EpiSwiGLU8 {
  unsigned char* C; int ldc;
  __device__ __forceinline__ void operator()(const f32x4 (&acc)[2][2][4][2], int brow, int bcol, int wr, int wc, int fr, int fq) const {
    constexpr float S = 1.f / 256.f;
#pragma unroll
    for (int ai = 0; ai < 2; ++ai)
#pragma unroll
      for (int m = 0; m < 4; ++m) {
        unsigned char* rp = C + (size_t)(brow + ai * 128 + wr * 64 + m * 16 + fr) * ldc + (bcol >> 1) + wc * 16 + fq * 4;
#pragma unroll
        for (int bj = 0; bj < 2; ++bj) {
          float r[4];
#pragma unroll
          for (int j = 0; j < 4; ++j) { const float g = acc[ai][bj][m][0][j] * S, u = acc[ai][bj][m][1][j] * S; r[j] = g * sigmoid_fast(g) * u; }
          *(unsigned*)(rp + bj * 64) = pack_fp8x4(r[0], r[1], r[2], r[3]);
        }
      }
  }
};
struct EpiPlain8 {
  unsigned char* C; int ldc; float sc;
  __device__ __forceinline__ void operator()(const f32x4 (&acc)[2][2][4][2], int brow, int bcol, int wr, int wc, int fr, int fq) const {
#pragma unroll
    for (int ai = 0; ai < 2; ++ai)
#pragma unroll
      for (int m = 0; m < 4; ++m) {
        unsigned char* rp = C + (size_t)(brow + ai * 128 + wr * 64 + m * 16 + fr) * ldc + bcol + wc * 32 + fq * 8;
#pragma unroll
        for (int bj = 0; bj < 2; ++bj) {
          u32x2 v = {pack_fp8x4(acc[ai][bj][m][0][0] * sc, acc[ai][bj][m][0][1] * sc, acc[ai][bj][m][0][2] * sc, acc[ai][bj][m][0][3] * sc),
                     pack_fp8x4(acc[ai][bj][m][1][0] * sc, acc[ai][bj][m][1][1] * sc, acc[ai][bj][m][1][2] * sc, acc[ai][bj][m][1][3] * sc)};
          *(u32x2*)(rp + bj * 128) = v;
        }
      }
  }
};
struct EpiPlainS {
  bf16_t* C; int ldc; float sc;
  __device__ __forceinline__ void operator()(const f32x4 (&acc)[2][2][4][2], int brow, int bcol, int wr, int wc, int fr, int fq) const {
#pragma unroll
    for (int ai = 0; ai < 2; ++ai)
#pragma unroll
      for (int m = 0; m < 4; ++m) {
        bf16_t* rp = C + (size_t)(brow + ai * 128 + wr * 64 + m * 16 + fr) * ldc + bcol + wc * 32 + fq * 8;
#pragma unroll
        for (int bj = 0; bj < 2; ++bj) {
          u32x4 v = {cvtpk(acc[ai][bj][m][0][0] * sc, acc[ai][bj][m][0][1] * sc), cvtpk(acc[ai][bj][m][0][2] * sc, acc[ai][bj][m][0][3] * sc),
                     cvtpk(acc[ai][bj][m][1][0] * sc, acc[ai][bj][m][1][1] * sc), cvtpk(acc[ai][bj][m][1][2] * sc, acc[ai][bj][m][1][3] * sc)};
          *(u32x4*)(rp + bj * 128) = v;
        }
      }
  }
};

__device__ __forceinline__ void dense_unit(int u, int nM, int nN, int& pm, int& pn) {
  const int nwg = nM * nN, NX = 8, WGM = 8;
  int wgid = u;
  { const int q = nwg / NX, r = nwg % NX, xcd = wgid % NX, off = wgid / NX; wgid = (xcd < r ? xcd * (q + 1) : r * (q + 1) + (xcd - r) * q) + off; }
  const int nig = WGM * nN, gid = wgid / nig, fm = gid * WGM, gsz = min(nM - fm, WGM);
  pm = fm + ((wgid % nig) % gsz); pn = (wgid % nig) / gsz;
}

namespace at {
constexpr int DH = 128, NW = 8, QBLK = 32, KVBLK = 64;
constexpr float SCALE = 0.088388347648318440f;
constexpr float QC = SCALE * 1.4426950408889634f;
constexpr int SHM_V = KVBLK * DH * 2, SHM_K = KVBLK * DH * 2;
#define KSWZ(row, colB) ((row) * 256 + ((colB) ^ (((row) & 7) << 4)))
__device__ __forceinline__ int crow(int r, int hi) { return (r & 3) + 8 * (r >> 2) + 4 * hi; }
__device__ __forceinline__ unsigned cvtpkv(float lo, float hi) { unsigned r; asm volatile("v_cvt_pk_bf16_f32 %0, %1, %2" : "=v"(r) : "v"(lo), "v"(hi)); return r; }
#define PK4(P, BASE, OUT) do { unsigned a0 = cvtpkv(P[BASE + 0], P[BASE + 1]), a1 = cvtpkv(P[BASE + 2], P[BASE + 3]);   \
    unsigned b0 = cvtpkv(P[BASE + 4], P[BASE + 5]), b1 = cvtpkv(P[BASE + 6], P[BASE + 7]);                              \
    auto r0 = __builtin_amdgcn_permlane32_swap(a0, b0, false, false); auto r1 = __builtin_amdgcn_permlane32_swap(a1, b1, false, false); \
    u32x4 w = {r0[0], r1[0], r0[1], r1[1]}; OUT = *reinterpret_cast<bf16x8*>(&w); } while (0)
__device__ __forceinline__ float load_q(const bf16_t* __restrict__ Qw, bf16x8 (&qr)[8], float kmax2) {
  float ss = 0;
#pragma unroll
  for (int d0 = 0; d0 < 8; ++d0) {
    const u32x4 raw = *reinterpret_cast<const u32x4*>(Qw + d0 * 16); u32x4 o;
#pragma unroll
    for (int i = 0; i < 4; ++i) { const unsigned pk = cvtpk(bflo(raw[i]) * QC, bfhi(raw[i]) * QC); o[i] = pk; const float a = bflo(pk), b = bfhi(pk); ss += a * a + b * b; }
    qr[d0] = *reinterpret_cast<bf16x8*>(&o);
  }
  { auto rr = __builtin_amdgcn_permlane32_swap(__float_as_uint(ss), __float_as_uint(ss), false, false); ss = __uint_as_float(rr[0]) + __uint_as_float(rr[1]); }
  return -(sqrtf(ss * kmax2) * 1.01f + 1e-3f);
}
__device__ __forceinline__ void exp16(f32x16& p) {
#pragma unroll
  for (int r = 0; r < 16; ++r) p[r] = __builtin_amdgcn_exp2f(p[r]);
}
__device__ __forceinline__ float sum16(const f32x16& p) { float s = 0;
#pragma unroll
  for (int r = 0; r < 16; ++r) s += p[r];
  return s; }
__device__ __forceinline__ void qkt(f32x16& p0, f32x16& p1, LAS const char* Ks, const bf16x8* qr, int r32, int hi, float nmc) {
#pragma unroll
  for (int r = 0; r < 16; ++r) { p0[r] = nmc; p1[r] = nmc; }
#pragma unroll
  for (int d0 = 0; d0 < 8; ++d0) { int cb = (d0 * 16 + hi * 8) * 2;
    bf16x8 b0 = *(LAS const bf16x8*)(Ks + KSWZ(r32, cb));
    bf16x8 b1 = *(LAS const bf16x8*)(Ks + KSWZ(32 + r32, cb));
    p0 = __builtin_amdgcn_mfma_f32_32x32x16_bf16(b0, qr[d0], p0, 0, 0, 0);
    p1 = __builtin_amdgcn_mfma_f32_32x32x16_bf16(b1, qr[d0], p1, 0, 0, 0); }
}
__device__ __forceinline__ int v_st(int k, int c) { const int kk = (k & ~0xC) | ((k & 4) << 1) | ((k & 8) >> 1); return ((kk >> 3) * 4 + (c >> 5)) * 512 + ((kk & 7) * 32 + (c & 31)) * 2; }
__device__ __forceinline__ int v_st256(int k, int c) { const int kk = (k & ~0xC) | ((k & 4) << 1) | ((k & 8) >> 1); return ((kk >> 3) * 8 + (c >> 5)) * 512 + ((kk & 7) * 32 + (c & 31)) * 2; }
__device__ __forceinline__ int v_rd_base(int lane) { return ((lane & 3) << 3) | (((lane >> 2) & 3) << 6) | (((lane >> 4) & 1) << 5) | (((lane >> 5) & 1) << 8); }
template <int OFF> __device__ __forceinline__ s16x4 tr_read(int vb) {
  s16x4 r; asm volatile("ds_read_b64_tr_b16 %0, %1 offset:%2" : "=&v"(r) : "v"(vb), "i"(OFF) : "memory"); return r;
}
template <int BASE, int KS, int HS> __device__ __forceinline__ void pv_one(f32x16& od, int vb, bf16x8 pa0, bf16x8 pa1, bf16x8 pa2, bf16x8 pa3) {
  const s16x4 l0 = tr_read<BASE>(vb), h0 = tr_read<BASE + HS>(vb), l1 = tr_read<BASE + KS>(vb), h1 = tr_read<BASE + KS + HS>(vb);
  const s16x4 l2 = tr_read<BASE + 2 * KS>(vb), h2 = tr_read<BASE + 2 * KS + HS>(vb), l3 = tr_read<BASE + 3 * KS>(vb), h3 = tr_read<BASE + 3 * KS + HS>(vb);
  asm volatile("s_waitcnt lgkmcnt(0)" ::: "memory"); SCHED;
#define PK(L, H) (bf16x8){L[0], L[1], L[2], L[3], H[0], H[1], H[2], H[3]}
  od = __builtin_amdgcn_mfma_f32_32x32x16_bf16(pa0, PK(l0, h0), od, 0, 0, 0);
  od = __builtin_amdgcn_mfma_f32_32x32x16_bf16(pa1, PK(l1, h1), od, 0, 0, 0);
  od = __builtin_amdgcn_mfma_f32_32x32x16_bf16(pa2, PK(l2, h2), od, 0, 0, 0);
  od = __builtin_amdgcn_mfma_f32_32x32x16_bf16(pa3, PK(l3, h3), od, 0, 0, 0);
#undef PK
}
__device__ __forceinline__ void pv_d0(f32x16* o, int vb, bf16x8 pa0, bf16x8 pa1, bf16x8 pa2, bf16x8 pa3) {
  pv_one<0, 4096, 2048>(o[0], vb, pa0, pa1, pa2, pa3); pv_one<512, 4096, 2048>(o[1], vb, pa0, pa1, pa2, pa3);
  pv_one<1024, 4096, 2048>(o[2], vb, pa0, pa1, pa2, pa3); pv_one<1536, 4096, 2048>(o[3], vb, pa0, pa1, pa2, pa3);
}
__device__ __forceinline__ void pv_d0_256(f32x16* o, int vb, bf16x8 pa0, bf16x8 pa1, bf16x8 pa2, bf16x8 pa3) {
  pv_one<0, 8192, 4096>(o[0], vb, pa0, pa1, pa2, pa3); pv_one<512, 8192, 4096>(o[1], vb, pa0, pa1, pa2, pa3);
  pv_one<1024, 8192, 4096>(o[2], vb, pa0, pa1, pa2, pa3); pv_one<1536, 8192, 4096>(o[3], vb, pa0, pa1, pa2, pa3);
}
__device__ __forceinline__ void store_o(const f32x16* o, float l_tot, LAS float* li, bf16_t* __restrict__ Ow, int ldo, int r32, int hi) {
  if (hi == 0) li[r32] = l_tot; asm volatile("s_waitcnt lgkmcnt(0)" ::: "memory");
  float rli[16];
#pragma unroll
  for (int r = 0; r < 16; ++r) rli[r] = __builtin_amdgcn_rcpf(li[crow(r, hi)]);
#pragma unroll
  for (int r = 0; r < 16; ++r) { const int orow = crow(r, hi);
#pragma unroll
    for (int d0 = 0; d0 < 4; ++d0) Ow[(long)orow * ldo + d0 * 32 + r32] = f2bf(o[d0][r] * rli[r]); }
}

__device__ __forceinline__ int unswap23(int kk) { return (kk & ~0xC) | ((kk & 4) << 1) | ((kk & 8) >> 1); }
__device__ __forceinline__ int k_dma_voff(int wid, int lane, int ldk) {
  const int row = 4 * wid + (lane >> 4); return row * ldk * 2 + (((lane & 15) * 16) ^ ((row & 7) << 4)); }
#define DMA16(rs, ldsp, voff, soff) __builtin_amdgcn_raw_ptr_buffer_load_lds(rs, (LAS void*)(ldsp), 16, voff, soff, 0, 0)

constexpr int SHM_T = SHM_K + SHM_V;
__device__ __forceinline__ void attn_body(const bf16_t* __restrict__ Qb, const int ldq, const bf16_t* __restrict__ Kh, const bf16_t* __restrict__ Vh, const int ldk,
                                          bf16_t* __restrict__ Ob, const int ldo, const int seq, const float kmax2, LAS char* lds) {
  int tid = threadIdx.x; asm volatile("" : "+v"(tid)); tid &= 511;
  const int wid = tid >> 6, lane = tid & 63, r32 = lane & 31, hi = lane >> 5;
  LAS float* li_l = (LAS float*)(lds + 3 * SHM_T) + wid * 64;
  float l_reg = 0; f32x16 o[4] = {}; bf16x8 qr[8];
  const float nmc = load_q(Qb + (long)(wid * QBLK + r32) * ldq + hi * 8, qr, kmax2);
  const int vrb = v_rd_base(lane);
  const int kvo = k_dma_voff(wid, lane, ldk);
  const int vvo = unswap23(8 * (wid >> 1) + ((lane & 31) >> 2)) * ldk * 2 + ((2 * (wid & 1) + (lane >> 5)) * 32 + (lane & 3) * 8) * 2;
  const int l32 = 64 * ldk, pz = wid * 1024;
  const __amdgpu_buffer_rsrc_t krs = __builtin_amdgcn_make_buffer_rsrc((void*)Kh, 0, 0x7ffffff0, 0x00020000);
  const __amdgpu_buffer_rsrc_t vrs = __builtin_amdgcn_make_buffer_rsrc((void*)Vh, 0, 0x7ffffff0, 0x00020000);
#define TDMA(slot, k0) do { const int _o = (k0) * ldk * 2; LAS char* _b = lds + (slot) * SHM_T + pz; \
    DMA16(krs, _b, kvo, _o); DMA16(krs, _b + 8192, kvo, _o + l32); DMA16(vrs, _b + SHM_K, vvo, _o); DMA16(vrs, _b + SHM_K + 8192, vvo, _o + l32); } while (0)
#define VM0() asm volatile("s_waitcnt vmcnt(0)" ::: "memory")
#define FINISH(P0, P1) do { exp16(P1); l_reg += sum16(P0) + sum16(P1); PK4(P0, 0, pa0); PK4(P0, 8, pa1); PK4(P1, 0, pa2); PK4(P1, 8, pa3); } while (0)
  f32x16 pA0, pA1, pB0, pB1; bf16x8 pa0, pa1, pa2, pa3; const int NT = seq / KVBLK;
  TDMA(0, 0); VM0(); __syncthreads();
  TDMA(1, KVBLK);
  qkt(pA0, pA1, lds, qr, r32, hi, nmc); exp16(pA0);
  VM0(); __syncthreads();
  int sk = 1, sv = 0, sd = 2;
  for (int j = 1; j + 1 < NT; j += 2) {
    TDMA(sd, (j + 1) * KVBLK);
    SCHED; qkt(pB0, pB1, lds + sk * SHM_T, qr, r32, hi, nmc);
    FINISH(pA0, pA1); SCHED;
    pv_d0(o, (int)(uintptr_t)(lds + sv * SHM_T + SHM_K) + vrb, pa0, pa1, pa2, pa3); exp16(pB0);
    VM0(); __syncthreads();
    { const int t = sv; sv = sk; sk = sd; sd = t; }
    if (j + 2 < NT) TDMA(sd, (j + 2) * KVBLK);
    SCHED; qkt(pA0, pA1, lds + sk * SHM_T, qr, r32, hi, nmc);
    FINISH(pB0, pB1); SCHED;
    pv_d0(o, (int)(uintptr_t)(lds + sv * SHM_T + SHM_K) + vrb, pa0, pa1, pa2, pa3); exp16(pA0);
    VM0(); __syncthreads();
    { const int t = sv; sv = sk; sk = sd; sd = t; }
  }
  SCHED; qkt(pB0, pB1, lds + sk * SHM_T, qr, r32, hi, nmc);
  FINISH(pA0, pA1); SCHED;
  pv_d0(o, (int)(uintptr_t)(lds + sv * SHM_T + SHM_K) + vrb, pa0, pa1, pa2, pa3); exp16(pB0);
  FINISH(pB0, pB1); SCHED;
  pv_d0(o, (int)(uintptr_t)(lds + sk * SHM_T + SHM_K) + vrb, pa0, pa1, pa2, pa3);
  { auto rr = __builtin_amdgcn_permlane32_swap(__float_as_uint(l_reg), __float_as_uint(l_reg), false, false); l_reg = __uint_as_float(rr[0]) + __uint_as_float(rr[1]); }
  store_o(o, l_reg, li_l, Ob + (long)(wid * QBLK) * ldo, ldo, r32, hi);
  VM0();
  __syncthreads();
#undef TDMA
#undef FINISH
}

constexpr int SHM_V2 = KVBLK * 256 * 2;
__device__ __forceinline__ void attn_body_dv256(const bf16_t* __restrict__ Qb, const int ldq, const bf16_t* __restrict__ Kh, const bf16_t* __restrict__ Vh, const int ldk,
                                                bf16_t* __restrict__ Ob, const int ldo, const int seq, const float kmax2, LAS char* lds) {
  int tid = threadIdx.x; asm volatile("" : "+v"(tid)); tid &= 511;
  const int wid = tid >> 6, lane = tid & 63, r32 = lane & 31, hi = lane >> 5, rg = wid >> 1, kh = wid & 1;
  LAS char* K_lds = lds; LAS char* V_lds = lds + 2 * SHM_K; LAS char* X_lds = lds + 2 * SHM_K + 2 * SHM_V2;
  float l_reg = 0; f32x16 o[4] = {}; bf16x8 qr[8];
  const float nmc = load_q(Qb + (long)(rg * QBLK + r32) * ldq + hi * 8, qr, kmax2);
  const int vb0 = (int)(uintptr_t)V_lds + v_rd_base(lane) + kh * 2048;
  const int kvo = k_dma_voff(wid, lane, ldk);
  const int vvo = unswap23(8 * (wid >> 2) + ((lane & 31) >> 2)) * ldk * 2 + ((2 * (wid & 3) + (lane >> 5)) * 32 + (lane & 3) * 8) * 2;
  const int l32 = 64 * ldk, l16 = 32 * ldk, pz = wid * 1024;
  const int xw = (rg * 4 + kh * 2) * 1024 + lane * 16, xr = rg * 4096 + lane * 16;
  const __amdgpu_buffer_rsrc_t krs = __builtin_amdgcn_make_buffer_rsrc((void*)Kh, 0, 0x7ffffff0, 0x00020000);
  const __amdgpu_buffer_rsrc_t vrs = __builtin_amdgcn_make_buffer_rsrc((void*)Vh, 0, 0x7ffffff0, 0x00020000);
#define KDMA(b, k0) do { const int _o = (k0) * ldk * 2; LAS char* _b = K_lds + (b) * SHM_K + pz; DMA16(krs, _b, kvo, _o); DMA16(krs, _b + 8192, kvo, _o + l32); } while (0)
#define VDMA(b, k0) do { const int _o = (k0) * ldk * 2; LAS char* _b = V_lds + (b) * SHM_V2 + pz; DMA16(vrs, _b, vvo, _o); DMA16(vrs, _b + 8192, vvo, _o + l16); \
    DMA16(vrs, _b + 16384, vvo, _o + 2 * l16); DMA16(vrs, _b + 24576, vvo, _o + 3 * l16); } while (0)
  f32x16 pA, pB; bf16x8 pa0, pa1, pa2, pa3, own0, own1; const int NT = seq / KVBLK;
  const int kxor = ((32 * kh + r32) & 7) << 4, krb = (32 * kh + r32) * 256;
#define QKHALF(P, b) do { _Pragma("unroll") for (int r = 0; r < 16; ++r) P[r] = nmc; \
    _Pragma("unroll") for (int d0 = 0; d0 < 8; ++d0) { const bf16x8 bk = *(LAS const bf16x8*)(K_lds + (b) * SHM_K + krb + (((d0 * 16 + hi * 8) * 2) ^ kxor)); \
      P = __builtin_amdgcn_mfma_f32_32x32x16_bf16(bk, qr[d0], P, 0, 0, 0); } } while (0)
#define FINH(P) do { exp16(P); l_reg += sum16(P); PK4(P, 0, own0); PK4(P, 8, own1); } while (0)
#define XWRITE(b) do { *(LAS bf16x8*)(X_lds + (b) * 16384 + xw) = own0; *(LAS bf16x8*)(X_lds + (b) * 16384 + xw + 1024) = own1; } while (0)
#define XREAD(b) do { pa0 = *(LAS const bf16x8*)(X_lds + (b) * 16384 + xr); pa1 = *(LAS const bf16x8*)(X_lds + (b) * 16384 + xr + 1024); \
    pa2 = *(LAS const bf16x8*)(X_lds + (b) * 16384 + xr + 2048); pa3 = *(LAS const bf16x8*)(X_lds + (b) * 16384 + xr + 3072); } while (0)
#define STEP(PA, PB, b, j) do { \
    SCHED; if ((j) + 1 < NT) QKHALF(PB, (b) ^ 1); FINH(PA); SCHED; \
    XWRITE(b); VM0(); __syncthreads(); \
    if ((j) + 3 < NT) KDMA((b) ^ 1, ((j) + 3) * KVBLK); if ((j) + 1 < NT) VDMA((b) ^ 1, ((j) + 1) * KVBLK); \
    XREAD(b); \
    pv_d0_256(o, vb0 + (b) * SHM_V2, pa0, pa1, pa2, pa3); } while (0)
  KDMA(0, 0); KDMA(1, KVBLK); VDMA(0, 0); VM0(); __syncthreads();
  QKHALF(pA, 0);
  __syncthreads();
  if (2 < NT) KDMA(0, 2 * KVBLK);
  for (int j = 0; j < NT; j += 2) { STEP(pA, pB, 0, j); STEP(pB, pA, 1, j + 1); }
  __syncthreads();
  LAS float* lx = (LAS float*)X_lds;
  lx[wid * 64 + lane] = l_reg; __syncthreads();
  const float l_tot = lx[wid * 64 + r32] + lx[wid * 64 + 32 + r32] + lx[(wid ^ 1) * 64 + r32] + lx[(wid ^ 1) * 64 + 32 + r32];
  store_o(o, l_tot, lx + 512 + wid * 32, Ob + (long)(rg * QBLK) * ldo + kh * 128, ldo, r32, hi);
  VM0();
  __syncthreads();
#undef KDMA
#undef VDMA
#undef QKHALF
#undef FINH
#undef XWRITE
#undef XREAD
#undef STEP
#undef VM0
}

#define LGK(n) asm volatile("s_waitcnt lgkmcnt(" #n ")" ::: "memory")
template <int OFF> __device__ __forceinline__ bf16x8 k_read(int ka) { bf16x8 r; asm volatile("ds_read_b128 %0, %1 offset:%2" : "=&v"(r) : "v"(ka), "i"(OFF) : "memory"); return r; }
struct VSet { s16x4 l0, h0, l1, h1; };
template <int OFF> __device__ __forceinline__ void v_read(VSet& s, int vb) { s.l0 = tr_read<OFF>(vb); s.h0 = tr_read<OFF + 4096>(vb); s.l1 = tr_read<OFF + 8192>(vb); s.h1 = tr_read<OFF + 12288>(vb); }
__device__ __forceinline__ void pv2(f32x16& oa, const VSet& s, bf16x8 pa0, bf16x8 pa1) {
#define PK(L, H) (bf16x8){L[0], L[1], L[2], L[3], H[0], H[1], H[2], H[3]}
  oa = __builtin_amdgcn_mfma_f32_32x32x16_bf16(pa0, PK(s.l0, s.h0), oa, 0, 0, 0);
  oa = __builtin_amdgcn_mfma_f32_32x32x16_bf16(pa1, PK(s.l1, s.h1), oa, 0, 0, 0);
#undef PK
}
template <bool SHIFT>
__device__ __forceinline__ void attn_body_c256_t(const bf16_t* __restrict__ Qb, const int ldq, const bf16_t* __restrict__ Kh, const bf16_t* __restrict__ Vh, const int ldk,
                                                 bf16_t* __restrict__ Ob, const int ldo, const int seq, const float nmc, const bf16x8 (&qr)[8], LAS char* lds) {
  int tid = threadIdx.x; asm volatile("" : "+v"(tid)); tid &= 511;
  const int wid = __builtin_amdgcn_readfirstlane(tid >> 6), lane = tid & 63, r32 = lane & 31, hi = lane >> 5;
  LAS char* K_lds = lds; LAS char* V_lds = lds + 2 * SHM_K;
  LAS float* li_l = (LAS float*)(lds + 2 * SHM_K + 2 * SHM_V2) + wid * 64;
  float l_reg = 0; f32x16 o[8] = {};
  const int vb0 = (int)(uintptr_t)V_lds + v_rd_base(lane);
  const int kvo = k_dma_voff(wid, lane, ldk);
  const int vvo = unswap23(8 * (wid >> 2) + ((lane & 31) >> 2)) * ldk * 2 + ((2 * (wid & 3) + (lane >> 5)) * 32 + (lane & 3) * 8) * 2;
  const int l32 = 64 * ldk, l16 = 32 * ldk, pz = wid * 1024;
  const __amdgpu_buffer_rsrc_t krs = __builtin_amdgcn_make_buffer_rsrc((void*)Kh, 0, 0x7ffffff0, 0x00020000);
  const __amdgpu_buffer_rsrc_t vrs = __builtin_amdgcn_make_buffer_rsrc((void*)Vh, 0, 0x7ffffff0, 0x00020000);
#define VM0() asm volatile("s_waitcnt vmcnt(0)" ::: "memory")
#define KVDMA(b, k0) do { const int _o = (k0) * ldk * 2; LAS char* _k = K_lds + (b) * SHM_K + pz; LAS char* _v = V_lds + (b) * SHM_V2 + pz; \
    DMA16(krs, _k, kvo, _o); DMA16(krs, _k + 8192, kvo, _o + l32); DMA16(vrs, _v, vvo, _o); DMA16(vrs, _v + 8192, vvo, _o + l16); \
    DMA16(vrs, _v + 16384, vvo, _o + 2 * l16); DMA16(vrs, _v + 24576, vvo, _o + 3 * l16); } while (0)
  int ka[8];
  { const int kxor = (r32 & 7) << 4, krb = (int)(uintptr_t)K_lds + r32 * 256;
#pragma unroll
    for (int d0 = 0; d0 < 8; ++d0) ka[d0] = krb + (((d0 * 16 + hi * 8) * 2) ^ kxor); }
  f32x16 P; bf16x8 pa0, pa1, f0, f1, f2, f3; VSet va, vb_, vc;
  const int NT = seq / KVBLK;
#define PINIT() do { _Pragma("unroll") for (int r = 0; r < 16; ++r) { float _z; asm volatile("v_mov_b32 %0, %1" : "=v"(_z) : "v"(SHIFT ? nmc : 0.f)); P[r] = _z; } } while (0)
#define KOFF(b, h) ((b) * 16384 + (h) * 8192)
#define VOFF(b, h, d0) ((b) * 32768 + (h) * 16384 + (d0) * 512)
#define KPRO(b, h) do { f0 = k_read<KOFF(b, h)>(ka[0]); f1 = k_read<KOFF(b, h)>(ka[1]); f2 = k_read<KOFF(b, h)>(ka[2]); } while (0)
#define QKM(F, d0) do { SCHED; P = __builtin_amdgcn_mfma_f32_32x32x16_bf16(F, qr[d0], P, 0, 0, 0); SCHED; } while (0)
#define QKHALF(b, h) do { PINIT(); \
    LGK(2); QKM(f0, 0); f3 = k_read<KOFF(b, h)>(ka[3]); \
    LGK(2); QKM(f1, 1); f0 = k_read<KOFF(b, h)>(ka[4]); \
    LGK(2); QKM(f2, 2); f1 = k_read<KOFF(b, h)>(ka[5]); \
    LGK(2); QKM(f3, 3); f2 = k_read<KOFF(b, h)>(ka[6]); \
    LGK(2); QKM(f0, 4); f3 = k_read<KOFF(b, h)>(ka[7]); \
    LGK(2); QKM(f1, 5); v_read<VOFF(b, h, 0)>(va, vb0); \
    LGK(5); QKM(f2, 6); v_read<VOFF(b, h, 1)>(vb_, vb0); \
    LGK(8); QKM(f3, 7); } while (0)
#define SMH() do { exp16(P); l_reg += sum16(P); PK4(P, 0, pa0); PK4(P, 8, pa1); } while (0)
#define PVM(S, d0) do { SCHED; pv2(o[d0], S, pa0, pa1); SCHED; } while (0)
#define PVHALF(b, h, NEXTK, nb, nh) do { \
    LGK(4); PVM(va, 0); v_read<VOFF(b, h, 2)>(vc, vb0); \
    LGK(4); PVM(vb_, 1); v_read<VOFF(b, h, 3)>(va, vb0); \
    LGK(4); PVM(vc, 2); v_read<VOFF(b, h, 4)>(vb_, vb0); \
    LGK(4); PVM(va, 3); v_read<VOFF(b, h, 5)>(vc, vb0); \
    LGK(4); PVM(vb_, 4); v_read<VOFF(b, h, 6)>(va, vb0); \
    LGK(4); PVM(vc, 5); v_read<VOFF(b, h, 7)>(vb_, vb0); \
    LGK(4); PVM(va, 6); if (NEXTK) { f0 = k_read<KOFF(nb, nh)>(ka[0]); f1 = k_read<KOFF(nb, nh)>(ka[1]); } \
    if (NEXTK) { LGK(2); } else { LGK(0); } PVM(vb_, 7); if (NEXTK) { f2 = k_read<KOFF(nb, nh)>(ka[2]); } } while (0)
#define STEPC(b, j) do { if ((j) + 1 < NT) KVDMA((b) ^ 1, ((j) + 1) * KVBLK); \
    KPRO(b, 0); QKHALF(b, 0); SMH(); PVHALF(b, 0, true, b, 1); \
    QKHALF(b, 1); SMH(); PVHALF(b, 1, false, 0, 0); \
    VM0(); __syncthreads(); } while (0)
  KVDMA(0, 0); VM0(); __syncthreads();
  for (int j = 0; j < NT; j += 2) { STEPC(0, j); STEPC(1, j + 1); }
  { auto rr = __builtin_amdgcn_permlane32_swap(__float_as_uint(l_reg), __float_as_uint(l_reg), false, false); l_reg = __uint_as_float(rr[0]) + __uint_as_float(rr[1]); }
  if (hi == 0) li_l[r32] = l_reg; asm volatile("s_waitcnt lgkmcnt(0)" ::: "memory");
  bf16_t* Ow = Ob + (long)(wid * QBLK) * ldo;
#pragma unroll
  for (int r = 0; r < 16; ++r) { const int orow = crow(r, hi); const float rl = __builtin_amdgcn_rcpf(li_l[orow]);
#pragma unroll
    for (int d0 = 0; d0 < 8; ++d0) Ow[(long)orow * ldo + d0 * 32 + r32] = f2bf(o[d0][r] * rl); }
  VM0();
  __syncthreads();
#undef KVDMA
#undef PINIT
#undef KOFF
#undef VOFF
#undef KPRO
#undef QKM
#undef QKHALF
#undef SMH
#undef PVM
#undef PVHALF
#undef STEPC
#undef VM0
}
__device__ __forceinline__ void attn_body_c256(const bf16_t* __restrict__ Qb, const int ldq, const bf16_t* __restrict__ Kh, const bf16_t* __restrict__ Vh, const int ldk,
                                               bf16_t* __restrict__ Ob, const int ldo, const int seq, const float kmax2, LAS char* lds) {
  int tid = threadIdx.x; asm volatile("" : "+v"(tid)); tid &= 511;
  const int wid = tid >> 6, lane = tid & 63, r32 = lane & 31, hi = lane >> 5;
  bf16x8 qr[8];
  const float nmc = load_q(Qb + (long)(wid * QBLK + r32) * ldq + hi * 8, qr, kmax2);
  if (__all(nmc > -64.f)) attn_body_c256_t<false>(Qb, ldq, Kh, Vh, ldk, Ob, ldo, seq, 0.f, qr, lds);
  else attn_body_c256_t<true>(Qb, ldq, Kh, Vh, ldk, Ob, ldo, seq, nmc, qr, lds);
}

__device__ __forceinline__ float load_q8(const bf16_t* __restrict__ Qrow, int hi, v8i_ (&qf)[2], float kmax2) {
  float ss = 0;
#pragma unroll
  for (int st = 0; st < 2; ++st) {
    const bf16_t* p = Qrow + 64 * st + 32 * hi; v8i_ o;
#pragma unroll
    for (int c = 0; c < 4; ++c) { const u32x4 raw = *reinterpret_cast<const u32x4*>(p + 8 * c);
      const unsigned w0 = pack8x4(bflo(raw[0]) * QC, bfhi(raw[0]) * QC, bflo(raw[1]) * QC, bfhi(raw[1]) * QC);
      const unsigned w1 = pack8x4(bflo(raw[2]) * QC, bfhi(raw[2]) * QC, bflo(raw[3]) * QC, bfhi(raw[3]) * QC);
      o[2 * c] = (int)w0; o[2 * c + 1] = (int)w1; ss += sq8x4(w0) + sq8x4(w1); }
    qf[st] = o;
  }
  { auto rr = __builtin_amdgcn_permlane32_swap(__float_as_uint(ss), __float_as_uint(ss), false, false); ss = __uint_as_float(rr[0]) + __uint_as_float(rr[1]); }
  return -(sqrtf(ss * kmax2) * 1.01f + 1e-3f);
}
__device__ __forceinline__ int k8_dma_voff(int wid, int lane, int ldk8) {
  const int row = 8 * wid + (lane >> 3); return row * ldk8 + (((lane & 7) ^ ((row >> 1) & 7)) << 4); }
template <int OFF> __device__ __forceinline__ v4i k8_read(int ka) { v4i r; asm volatile("ds_read_b128 %0, %1 offset:%2" : "=&v"(r) : "v"(ka), "i"(OFF) : "memory"); return r; }

template <bool SHIFT>
__device__ __forceinline__ void attn_body_c256q8_t(const unsigned char* __restrict__ K8, const int ldk8, const bf16_t* __restrict__ Vh, const int ldk,
                                                   bf16_t* __restrict__ Ob, const int ldo, const int seq, const float nmc, const v8i_ (&qf)[2], LAS char* lds) {
  int tid = threadIdx.x; asm volatile("" : "+v"(tid)); tid &= 511;
  const int wid = __builtin_amdgcn_readfirstlane(tid >> 6), lane = tid & 63, r32 = lane & 31, hi = lane >> 5;
  constexpr int SHM_K8 = KVBLK * 128;
  LAS char* K_lds = lds; LAS char* V_lds = lds + 2 * SHM_K8;
  LAS float* li_l = (LAS float*)(lds + 2 * SHM_K8 + 2 * SHM_V2) + wid * 64;
  float l_reg = 0; f32x16 o[8] = {};
  const int vb0 = (int)(uintptr_t)V_lds + v_rd_base(lane);
  const int kvo = k8_dma_voff(wid, lane, ldk8);
  const int vvo = unswap23(8 * (wid >> 2) + ((lane & 31) >> 2)) * ldk * 2 + ((2 * (wid & 3) + (lane >> 5)) * 32 + (lane & 3) * 8) * 2;
  const int l16 = 32 * ldk, pz = wid * 1024;
  const __amdgpu_buffer_rsrc_t krs = __builtin_amdgcn_make_buffer_rsrc((void*)K8, 0, 0x7ffffff0, 0x00020000);
  const __amdgpu_buffer_rsrc_t vrs = __builtin_amdgcn_make_buffer_rsrc((void*)Vh, 0, 0x7ffffff0, 0x00020000);
#define VM0() asm volatile("s_waitcnt vmcnt(0)" ::: "memory")
#define KVDMA(b, k0) do { const int _o = (k0) * ldk * 2; LAS char* _v = V_lds + (b) * SHM_V2 + pz; \
    DMA16(krs, K_lds + (b) * SHM_K8 + pz, kvo, (k0) * ldk8); DMA16(vrs, _v, vvo, _o); DMA16(vrs, _v + 8192, vvo, _o + l16); \
    DMA16(vrs, _v + 16384, vvo, _o + 2 * l16); DMA16(vrs, _v + 24576, vvo, _o + 3 * l16); } while (0)
  const int ka0 = (int)(uintptr_t)K_lds + r32 * 128 + (((2 * hi) ^ ((r32 >> 1) & 7)) << 4);
  const int ka1 = ka0 ^ 16, ka2 = ka0 ^ 64, ka3 = ka0 ^ 80;
  int sc1; asm volatile("v_mov_b32 %0, 0x7f7f7f7f" : "=v"(sc1));
  f32x16 P; bf16x8 pa0, pa1; v4i k0a, k0b, k1a, k1b; VSet va, vb_, vc;
  const int NT = seq / KVBLK;
#define KOFF(b, h) ((b) * 8192 + (h) * 4096)
#define VOFF(b, h, d0) ((b) * 32768 + (h) * 16384 + (d0) * 512)
#define KPRO(b, h) do { k0a = k8_read<KOFF(b, h)>(ka0); k0b = k8_read<KOFF(b, h)>(ka1); k1a = k8_read<KOFF(b, h)>(ka2); k1b = k8_read<KOFF(b, h)>(ka3); } while (0)
#define V8(x, y) (v8i_){x[0], x[1], x[2], x[3], y[0], y[1], y[2], y[3]}
#define QKHALF(b, h) do { \
    if (SHIFT) { _Pragma("unroll") for (int r = 0; r < 16; ++r) { float _z; asm volatile("v_mov_b32 %0, %1" : "=v"(_z) : "v"(nmc)); P[r] = _z; } } \
    LGK(2); SCHED; { const v8i_ kf = V8(k0a, k0b); \
      if (SHIFT) asm volatile("s_nop 4\n\tv_mfma_scale_f32_32x32x64_f8f6f4 %0, %1, %2, %0, %3, %3 op_sel_hi:[0,0,0]" : "+v"(P) : "v"(kf), "v"(qf[0]), "v"(sc1)); \
      else       asm volatile("v_mfma_scale_f32_32x32x64_f8f6f4 %0, %1, %2, 0, %3, %3 op_sel_hi:[0,0,0]" : "=&v"(P) : "v"(kf), "v"(qf[0]), "v"(sc1)); } \
    SCHED; v_read<VOFF(b, h, 0)>(va, vb0); \
    LGK(4); SCHED; { const v8i_ kf = V8(k1a, k1b); \
      asm volatile("v_mfma_scale_f32_32x32x64_f8f6f4 %0, %1, %2, %0, %3, %3 op_sel_hi:[0,0,0]" : "+v"(P) : "v"(kf), "v"(qf[1]), "v"(sc1)); } \
    SCHED; v_read<VOFF(b, h, 1)>(vb_, vb0); \
    asm volatile("s_nop 15\n\ts_nop 7" : "+v"(P)); } while (0)
#define SMH() do { exp16(P); l_reg += sum16(P); PK4(P, 0, pa0); PK4(P, 8, pa1); } while (0)
#define PVM(S, d0) do { SCHED; pv2(o[d0], S, pa0, pa1); SCHED; } while (0)
#define PVHALF(b, h, NEXTK, nb, nh) do { \
    LGK(4); PVM(va, 0); v_read<VOFF(b, h, 2)>(vc, vb0); \
    LGK(4); PVM(vb_, 1); v_read<VOFF(b, h, 3)>(va, vb0); \
    LGK(4); PVM(vc, 2); v_read<VOFF(b, h, 4)>(vb_, vb0); \
    LGK(4); PVM(va, 3); v_read<VOFF(b, h, 5)>(vc, vb0); \
    LGK(4); PVM(vb_, 4); v_read<VOFF(b, h, 6)>(va, vb0); \
    LGK(4); PVM(vc, 5); v_read<VOFF(b, h, 7)>(vb_, vb0); \
    LGK(4); PVM(va, 6); if (NEXTK) { k0a = k8_read<KOFF(nb, nh)>(ka0); k0b = k8_read<KOFF(nb, nh)>(ka1); } \
    if (NEXTK) { LGK(2); } else { LGK(0); } PVM(vb_, 7); if (NEXTK) { k1a = k8_read<KOFF(nb, nh)>(ka2); k1b = k8_read<KOFF(nb, nh)>(ka3); } } while (0)
#define STEPC(b, j) do { if ((j) + 1 < NT) KVDMA((b) ^ 1, ((j) + 1) * KVBLK); \
    KPRO(b, 0); QKHALF(b, 0); SMH(); PVHALF(b, 0, true, b, 1); \
    QKHALF(b, 1); SMH(); PVHALF(b, 1, false, 0, 0); \
    VM0(); __syncthreads(); } while (0)
  KVDMA(0, 0); VM0(); __syncthreads();
  for (int j = 0; j < NT; j += 2) { STEPC(0, j); STEPC(1, j + 1); }
  { auto rr = __builtin_amdgcn_permlane32_swap(__float_as_uint(l_reg), __float_as_uint(l_reg), false, false); l_reg = __uint_as_float(rr[0]) + __uint_as_float(rr[1]); }
  if (hi == 0) li_l[r32] = l_reg; asm volatile("s_waitcnt lgkmcnt(0)" ::: "memory");
  bf16_t* Ow = Ob + (long)(wid * QBLK) * ldo;
#pragma unroll
  for (int r = 0; r < 16; ++r) { const int orow = crow(r, hi); const float rl = __builtin_amdgcn_rcpf(li_l[orow]);
#pragma unroll
    for (int d0 = 0; d0 < 8; ++d0) Ow[(long)orow * ldo + d0 * 32 + r32] = f2bf(o[d0][r] * rl); }
  VM0();
  __syncthreads();
#undef KVDMA
#undef KOFF
#undef VOFF
#undef KPRO
#undef V8
#undef QKHALF
#undef SMH
#undef PVM
#undef PVHALF
#undef STEPC
#undef VM0
}
__device__ __forceinline__ void attn_body_c256q8(const bf16_t* __restrict__ Qb, const int ldq, const unsigned char* __restrict__ K8, const int ldk8,
                                                 const bf16_t* __restrict__ Vh, const int ldk, bf16_t* __restrict__ Ob, const int ldo, const int seq, const float kmax2, LAS char* lds) {
  int tid = threadIdx.x; asm volatile("" : "+v"(tid)); tid &= 511;
  const int wid = tid >> 6, lane = tid & 63, r32 = lane & 31, hi = lane >> 5;
  v8i_ qf[2];
  const float nmc = load_q8(Qb + (long)(wid * QBLK + r32) * ldq, hi, qf, kmax2);
  if (__all(nmc > -64.f)) attn_body_c256q8_t<false>(K8, ldk8, Vh, ldk, Ob, ldo, seq, 0.f, qf, lds);
  else attn_body_c256q8_t<true>(K8, ldk8, Vh, ldk, Ob, ldo, seq, nmc, qf, lds);
}

template <bool SHIFT>
__device__ __forceinline__ void attn_body_q8_t(const unsigned char* __restrict__ K8, const int ldk8, const bf16_t* __restrict__ Vh, const int ldk,
                                               bf16_t* __restrict__ Ob, const int ldo, const int seq, const float nmc, const v8i_ (&qf)[2], LAS char* lds) {
  int tid = threadIdx.x; asm volatile("" : "+v"(tid)); tid &= 511;
  const int wid = __builtin_amdgcn_readfirstlane(tid >> 6), lane = tid & 63, r32 = lane & 31, hi = lane >> 5;
  constexpr int SK8 = KVBLK * 128, ST = SK8 + SHM_V;
  LAS float* li_l = (LAS float*)(lds + 3 * ST) + wid * 64;
  float l_reg = 0; f32x16 o[4] = {};
  const int vrb = v_rd_base(lane);
  const int kvo = k8_dma_voff(wid, lane, ldk8);
  const int vvo = unswap23(8 * (wid >> 1) + ((lane & 31) >> 2)) * ldk * 2 + ((2 * (wid & 1) + (lane >> 5)) * 32 + (lane & 3) * 8) * 2;
  const int l32 = 64 * ldk, pz = wid * 1024;
  const __amdgpu_buffer_rsrc_t krs = __builtin_amdgcn_make_buffer_rsrc((void*)K8, 0, 0x7ffffff0, 0x00020000);
  const __amdgpu_buffer_rsrc_t vrs = __builtin_amdgcn_make_buffer_rsrc((void*)Vh, 0, 0x7ffffff0, 0x00020000);
#define TDMA(slot, k0) do { const int _o = (k0) * ldk * 2; LAS char* _b = lds + (slot) * ST + pz; \
    DMA16(krs, _b, kvo, (k0) * ldk8); DMA16(vrs, _b + SK8, vvo, _o); DMA16(vrs, _b + SK8 + 8192, vvo, _o + l32); } while (0)
#define VM0() asm volatile("s_waitcnt vmcnt(0)" ::: "memory")
  int sc1; asm volatile("v_mov_b32 %0, 0x7f7f7f7f" : "=v"(sc1));
  const int kof = r32 * 128 + (((2 * hi) ^ ((r32 >> 1) & 7)) << 4);
#define QKT8(P0, P1, Ks) do { \
    const v4i a0 = *(LAS const v4i*)((Ks) + kof), a1 = *(LAS const v4i*)((Ks) + (kof ^ 16)), a2 = *(LAS const v4i*)((Ks) + (kof ^ 64)), a3 = *(LAS const v4i*)((Ks) + (kof ^ 80)); \
    const v4i b0 = *(LAS const v4i*)((Ks) + 4096 + kof), b1 = *(LAS const v4i*)((Ks) + 4096 + (kof ^ 16)), b2 = *(LAS const v4i*)((Ks) + 4096 + (kof ^ 64)), b3 = *(LAS const v4i*)((Ks) + 4096 + (kof ^ 80)); \
    v8i_ k00 = (v8i_){a0[0], a0[1], a0[2], a0[3], a1[0], a1[1], a1[2], a1[3]}, k01 = (v8i_){a2[0], a2[1], a2[2], a2[3], a3[0], a3[1], a3[2], a3[3]}; \
    v8i_ k10 = (v8i_){b0[0], b0[1], b0[2], b0[3], b1[0], b1[1], b1[2], b1[3]}, k11 = (v8i_){b2[0], b2[1], b2[2], b2[3], b3[0], b3[1], b3[2], b3[3]}; \
    if (SHIFT) { _Pragma("unroll") for (int r = 0; r < 16; ++r) { P0[r] = nmc; P1[r] = nmc; } \
      asm volatile("s_nop 4\n\tv_mfma_scale_f32_32x32x64_f8f6f4 %0, %1, %2, %0, %3, %3 op_sel_hi:[0,0,0]" : "+v"(P0) : "v"(k00), "v"(qf[0]), "v"(sc1)); \
      asm volatile("v_mfma_scale_f32_32x32x64_f8f6f4 %0, %1, %2, %0, %3, %3 op_sel_hi:[0,0,0]" : "+v"(P1) : "v"(k10), "v"(qf[0]), "v"(sc1)); } \
    else { asm volatile("v_mfma_scale_f32_32x32x64_f8f6f4 %0, %1, %2, 0, %3, %3 op_sel_hi:[0,0,0]" : "=&v"(P0) : "v"(k00), "v"(qf[0]), "v"(sc1)); \
      asm volatile("v_mfma_scale_f32_32x32x64_f8f6f4 %0, %1, %2, 0, %3, %3 op_sel_hi:[0,0,0]" : "=&v"(P1) : "v"(k10), "v"(qf[0]), "v"(sc1)); } \
    asm volatile("v_mfma_scale_f32_32x32x64_f8f6f4 %0, %1, %2, %0, %3, %3 op_sel_hi:[0,0,0]" : "+v"(P0) : "v"(k01), "v"(qf[1]), "v"(sc1)); \
    asm volatile("v_mfma_scale_f32_32x32x64_f8f6f4 %0, %1, %2, %0, %3, %3 op_sel_hi:[0,0,0]" : "+v"(P1) : "v"(k11), "v"(qf[1]), "v"(sc1)); \
      \
    asm volatile("s_nop 15" : "+v"(k00), "+v"(k01), "+v"(k10), "+v"(k11)); } while (0)
#define TIE(P0, P1) asm volatile("s_nop 15\n\ts_nop 7" : "+v"(P0), "+v"(P1))
#define TIE0(P0, P1) asm volatile("" : "+v"(P0), "+v"(P1))
#define FINISH(P0, P1) do { exp16(P1); l_reg += sum16(P0) + sum16(P1); PK4(P0, 0, pa0); PK4(P0, 8, pa1); PK4(P1, 0, pa2); PK4(P1, 8, pa3); } while (0)
  f32x16 pA0, pA1, pB0, pB1; bf16x8 pa0, pa1, pa2, pa3; const int NT = seq / KVBLK;
  TDMA(0, 0); VM0(); __syncthreads();
  TDMA(1, KVBLK);
  QKT8(pA0, pA1, lds); TIE(pA0, pA1); exp16(pA0);
  VM0(); __syncthreads();
  int sk = 1, sv = 0, sd = 2;
  for (int j = 1; j + 1 < NT; j += 2) {
    TDMA(sd, (j + 1) * KVBLK);
    SCHED; QKT8(pB0, pB1, lds + sk * ST);
    FINISH(pA0, pA1); SCHED;
    pv_d0(o, (int)(uintptr_t)(lds + sv * ST + SK8) + vrb, pa0, pa1, pa2, pa3); TIE0(pB0, pB1); exp16(pB0);
    VM0(); __syncthreads();
    { const int t = sv; sv = sk; sk = sd; sd = t; }
    if (j + 2 < NT) TDMA(sd, (j + 2) * KVBLK);
    SCHED; QKT8(pA0, pA1, lds + sk * ST);
    FINISH(pB0, pB1); SCHED;
    pv_d0(o, (int)(uintptr_t)(lds + sv * ST + SK8) + vrb, pa0, pa1, pa2, pa3); TIE0(pA0, pA1); exp16(pA0);
    VM0(); __syncthreads();
    { const int t = sv; sv = sk; sk = sd; sd = t; }
  }
  SCHED; QKT8(pB0, pB1, lds + sk * ST);
  FINISH(pA0, pA1); SCHED;
  pv_d0(o, (int)(uintptr_t)(lds + sv * ST + SK8) + vrb, pa0, pa1, pa2, pa3); TIE0(pB0, pB1); exp16(pB0);
  FINISH(pB0, pB1); SCHED;
  pv_d0(o, (int)(uintptr_t)(lds + sk * ST + SK8) + vrb, pa0, pa1, pa2, pa3);
  { auto rr = __builtin_amdgcn_permlane32_swap(__float_as_uint(l_reg), __float_as_uint(l_reg), false, false); l_reg = __uint_as_float(rr[0]) + __uint_as_float(rr[1]); }
  store_o(o, l_reg, li_l, Ob + (long)(wid * QBLK) * ldo, ldo, r32, hi);
  VM0();
  __syncthreads();
#undef TDMA
#undef VM0
#undef QKT8
#undef TIE
#undef TIE0
#undef FINISH
}
__device__ __forceinline__ void attn_body_q8(const bf16_t* __restrict__ Qb, const int ldq, const unsigned char* __restrict__ K8, const int ldk8,
                                             const bf16_t* __restrict__ Vh, const int ldk, bf16_t* __restrict__ Ob, const int ldo, const int seq, const float kmax2, LAS char* lds) {
  int tid = threadIdx.x; asm volatile("" : "+v"(tid)); tid &= 511;
  const int wid = tid >> 6, lane = tid & 63, r32 = lane & 31, hi = lane >> 5;
  v8i_ qf[2];
  const float nmc = load_q8(Qb + (long)(wid * QBLK + r32) * ldq, hi, qf, kmax2);
  if (__all(nmc > -64.f)) attn_body_q8_t<false>(K8, ldk8, Vh, ldk, Ob, ldo, seq, 0.f, qf, lds);
  else attn_body_q8_t<true>(K8, ldk8, Vh, ldk, Ob, ldo, seq, nmc, qf, lds);
}
#undef PK4
}

__device__ __forceinline__ int perm_plain8(int n) { const int r = n & 31; return (n & ~31) + 16 * ((r >> 2) & 1) + 4 * (r >> 3) + (r & 3); }
__device__ __forceinline__ int perm_row(int kind, int n) {
  if (kind == 0) return perm_plain8(n);
  if (kind == 1) { if (n < N_QKV0) return perm_plain8(n); const int c = n - N_QKV0; const int ch = c & 1023; return N_QKV0 + 32 * (ch >> 4) + ((c >> 10) << 4) + (ch & 15); }
  return 32 * (n >> 4) + ((kind == 3) ? 16 : 0) + (n & 15);
}
__device__ __forceinline__ void cvt_tile(const float* __restrict__ src, int N, bf16_t* __restrict__ dst, int K, int kind, int k0, int n0, LAS unsigned* t32) {
  int tid = threadIdx.x; asm volatile("" : "+v"(tid)); tid &= 511;
#pragma unroll
  for (int j = 0; j < 2; ++j) {
    const int item = tid + 512 * j, kp = item >> 4, q = item & 15;
    const f32x4 v0 = *(const f32x4*)(src + (size_t)(k0 + 2 * kp) * N + n0 + 4 * q);
    const f32x4 v1 = *(const f32x4*)(src + (size_t)(k0 + 2 * kp + 1) * N + n0 + 4 * q);
#pragma unroll
    for (int i = 0; i < 4; ++i) t32[(4 * q + i) * 65 + kp] = cvtpk(v0[i], v1[i]);
  }
  __syncthreads();
#pragma unroll
  for (int j = 0; j < 2; ++j) {
    const int item = tid + 512 * j, n = item >> 4, ko = item & 15;
    u32x4 v;
#pragma unroll
    for (int i = 0; i < 4; ++i) v[i] = t32[n * 65 + 4 * ko + i];
    *(u32x4*)(dst + (size_t)perm_row(kind, n0 + n) * K + k0 + 8 * ko) = v;
  }
  __syncthreads();
}
__device__ __forceinline__ void cvt_matrix_units(const float* src, int K, int N, bf16_t* dst, int kind, int u0, int ustride, LAS unsigned* t32) {
  const int nN = N / 64, nK = K / 128;
  for (int u = u0; u < nN * nK; u += ustride) cvt_tile(src, N, dst, K, kind, (u / nN) * 128, (u % nN) * 64, t32);
}
constexpr size_t WMOE8_E = (size_t)1024 * D + (size_t)D * EFF;
__device__ __forceinline__ void cvt_tile8(const float* __restrict__ src, int N, unsigned char* __restrict__ dst, int K, int kind, int k0, int n0, float scale, LAS unsigned* t32) {
  int tid = threadIdx.x; asm volatile("" : "+v"(tid)); tid &= 511;
  { const int kq = tid >> 4, q = tid & 15;
    f32x4 v[4];
#pragma unroll
    for (int r = 0; r < 4; ++r) v[r] = *(const f32x4*)(src + (size_t)(k0 + 4 * kq + r) * N + n0 + 4 * q);
#pragma unroll
    for (int i = 0; i < 4; ++i) t32[(4 * q + i) * 33 + kq] = pack_fp8x4(v[0][i] * scale, v[1][i] * scale, v[2][i] * scale, v[3][i] * scale); }
  __syncthreads();
  { const int n = tid >> 3, kc = tid & 7;
    u32x4 v;
#pragma unroll
    for (int i = 0; i < 4; ++i) v[i] = t32[n * 33 + 4 * kc + i];
    *(u32x4*)(dst + (size_t)perm_row(kind, n0 + n) * K + k0 + 16 * kc) = v; }
  __syncthreads();
}
__device__ __forceinline__ void cvt_moe_all8(const Args& a, LAS unsigned* t32) {
  unsigned char* W = (unsigned char*)(a.ws + WS_WMOE);
  for (int u = blockIdx.x; u < 2 * 65 * 384; u += gridDim.x) {
    const int le = u / 384, L = le / 65, e = le % 65, r = u % 384, mtx = r >> 7, lu = r & 127;
    const float* src; unsigned char* dst = W + (size_t)le * WMOE8_E; int K, N, kind; float sc;
    if (mtx == 0)      { src = e < 64 ? a.in[21] + ((size_t)L * 64 + e) * D * EFF : a.in[24] + (size_t)L * D * EFF; K = D; N = EFF; kind = 2; sc = 256.f; }
    else if (mtx == 1) { src = e < 64 ? a.in[22] + ((size_t)L * 64 + e) * D * EFF : a.in[25] + (size_t)L * D * EFF; K = D; N = EFF; kind = 3; sc = 256.f; }
    else               { src = e < 64 ? a.in[23] + ((size_t)L * 64 + e) * EFF * D : a.in[26] + (size_t)L * EFF * D; K = EFF; N = D; kind = 0; sc = 128.f; dst += (size_t)1024 * D; }
    const int nN = N / 64;
    cvt_tile8(src, N, dst, K, kind, (lu / nN) * 128, (lu % nN) * 64, sc, t32);
  }
}

__device__ __forceinline__ void ld_row_f32(const float* __restrict__ p, int lane, float (&v)[32]) {
#pragma unroll
  for (int j = 0; j < 4; ++j) { const f32x4 t0 = *(const f32x4*)(p + 8 * lane + 512 * j), t1 = *(const f32x4*)(p + 8 * lane + 512 * j + 4);
#pragma unroll
    for (int i = 0; i < 4; ++i) { v[8 * j + i] = t0[i]; v[8 * j + 4 + i] = t1[i]; } }
}
__device__ __forceinline__ void ld_row_bf16(const bf16_t* __restrict__ p, int lane, float (&v)[32]) {
#pragma unroll
  for (int j = 0; j < 4; ++j) { const u32x4 t = *(const u32x4*)(p + 8 * lane + 512 * j);
#pragma unroll
    for (int i = 0; i < 4; ++i) { v[8 * j + 2 * i] = bflo(t[i]); v[8 * j + 2 * i + 1] = bfhi(t[i]); } }
}
__device__ __forceinline__ void ld_row_fp8(const unsigned char* __restrict__ p, int lane, float (&v)[32]) {
#pragma unroll
  for (int j = 0; j < 4; ++j) { const u32x2 t = *(const u32x2*)(p + 8 * lane + 512 * j);
#pragma unroll
    for (int i = 0; i < 2; ++i) { v[8 * j + 4 * i] = __builtin_amdgcn_cvt_f32_fp8((int)t[i], 0); v[8 * j + 4 * i + 1] = __builtin_amdgcn_cvt_f32_fp8((int)t[i], 1);
      v[8 * j + 4 * i + 2] = __builtin_amdgcn_cvt_f32_fp8((int)t[i], 2); v[8 * j + 4 * i + 3] = __builtin_amdgcn_cvt_f32_fp8((int)t[i], 3); } }
}
__device__ __forceinline__ void ld8f(const float* __restrict__ p, float (&x)[8]) { const f32x4 t0 = *(const f32x4*)p, t1 = *(const f32x4*)(p + 4);
#pragma unroll
  for (int i = 0; i < 4; ++i) { x[i] = t0[i]; x[4 + i] = t1[i]; } }
__device__ __forceinline__ void st8f(float* __restrict__ p, const float* x) { f32x4 t0 = {x[0], x[1], x[2], x[3]}, t1 = {x[4], x[5], x[6], x[7]}; *(f32x4*)p = t0; *(f32x4*)(p + 4) = t1; }
__device__ __forceinline__ float sumsq32(const float (&v)[32]) { float s = 0;
#pragma unroll
  for (int i = 0; i < 32; ++i) s += v[i] * v[i];
  return wave_sum(s); }
template <bool COPY, bool OUT8 = false>
__device__ __forceinline__ void modulate_store(const float (&v)[32], float rstd, const float* __restrict__ g, const float* __restrict__ shift, const float* __restrict__ scale,
                                               bf16_t* __restrict__ dst, int lane, LAS float* f32copy) {
#pragma unroll
  for (int j = 0; j < 4; ++j) {
    const int idx = 8 * lane + 512 * j;
    float gv[8], sh[8], sc[8], y[8]; ld8f(g + idx, gv); ld8f(shift + idx, sh); ld8f(scale + idx, sc);
#pragma unroll
    for (int i = 0; i < 8; ++i) y[i] = v[8 * j + i] * rstd * gv[i] * (1.f + sc[i]) + sh[i];
    if (OUT8) { u32x2 p8 = {pack_fp8x4(y[0], y[1], y[2], y[3]), pack_fp8x4(y[4], y[5], y[6], y[7])}; *(u32x2*)((unsigned char*)dst + idx) = p8; }
    else { u32x4 pk = {cvtpk(y[0], y[1]), cvtpk(y[2], y[3]), cvtpk(y[4], y[5]), cvtpk(y[6], y[7])}; *(u32x4*)(dst + idx) = pk; }
    if (COPY) { f32x4 t0 = {y[0], y[1], y[2], y[3]}, t1 = {y[4], y[5], y[6], y[7]};
      *(LAS f32x4*)(f32copy + idx) = t0; *(LAS f32x4*)(f32copy + idx + 4) = t1; }
  }
}

__device__ __forceinline__ void phase_prologue(const Args& a, LAS char* lds) {
  int tid = threadIdx.x; asm volatile("" : "+v"(tid)); tid &= 511; const int wave = tid >> 6, lane = tid & 63;
  {
    LAS float* sc = (LAS float*)lds;
    LAS float* part = sc + 4096;
    const float* c = a.in[1]; const float* cc = a.in[3];
    for (int i = tid; i < D; i += NTHREADS) { float v = c[i]; sc[i] = v * sigmoidf_(v); float u = cc[i]; sc[D + i] = u * sigmoidf_(u); }
    __syncthreads();
    float* MOD = (float*)(a.ws + WS_MOD);
    for (int u = blockIdx.x; u < 2 * 192; u += gridDim.x) {
      const int L = u / 192, chunk = u % 192;
      const float* W = a.in[4] + (size_t)L * D * 12288 + chunk * 64 + lane;
      float a0 = 0, a1 = 0; const int d0 = wave * 256;
#pragma unroll 8
      for (int dd = 0; dd < 256; ++dd) { const float w = W[(size_t)(d0 + dd) * 12288]; a0 += sc[d0 + dd] * w; a1 += sc[D + d0 + dd] * w; }
      part[(wave * 2 + 0) * 64 + lane] = a0; part[(wave * 2 + 1) * 64 + lane] = a1;
      __syncthreads();
      if (tid < 128) { const int which = tid >> 6; float s = 0;
#pragma unroll
        for (int w = 0; w < 8; ++w) s += part[(w * 2 + which) * 64 + lane];
        const int j = chunk * 64 + lane; MOD[(size_t)(L * 2 + which) * 12288 + j] = s + a.in[5][L * 12288 + j]; }
      __syncthreads();
    }
  }
  LAS unsigned* t32 = (LAS unsigned*)lds;
  cvt_matrix_units(a.in[7], D, N_IN0, (bf16_t*)(a.ws + WS_WIN0), 1, blockIdx.x, gridDim.x, t32);
  cvt_matrix_units(a.in[8], D, D, (bf16_t*)(a.ws + WS_WOUT0), 0, blockIdx.x, gridDim.x, t32);
  cvt_matrix_units(a.in[15], D, N_IN1, (bf16_t*)(a.ws + WS_WIN1), 0, blockIdx.x, gridDim.x, t32);
  cvt_matrix_units(a.in[16], D, D, (bf16_t*)(a.ws + WS_WOUT1), 0, blockIdx.x, gridDim.x, t32);
  cvt_moe_all8(a, t32);
}

__device__ __forceinline__ void phase_modulate0(const Args& a) {
  int tid = threadIdx.x; asm volatile("" : "+v"(tid)); tid &= 511; const int wave = tid >> 6, lane = tid & 63;
  const float* MOD = (const float*)(a.ws + WS_MOD);
  bf16_t* A = (bf16_t*)(a.ws + WS_ABUF);
  for (int it = blockIdx.x; it < MT / 8; it += gridDim.x) {
    const int r = it * 8 + wave;
    const float* src = r < CTXL ? a.in[2] + (size_t)r * D : a.in[0] + (size_t)(r - CTXL) * D;
    const float* mod = MOD + (r < CTXL ? 12288 : 0);
    float v[32]; ld_row_f32(src, lane, v);
    const float rstd = rsqrtf(sumsq32(v) * (1.f / D) + EPS);
    modulate_store<false>(v, rstd, a.in[6], mod, mod + D, A + (size_t)r * D, lane, nullptr);
  }
}

__device__ __forceinline__ void rope_cs4(int r, int lane, float (&cs)[4], float (&sn)[4]) {
#pragma unroll
  for (int q = 0; q < 4; ++q) { cs[q] = 1.f; sn[q] = 0.f; }
  if (r >= CTXL) { const int t = r - CTXL; const int l = lane & 15, a = l >> 3, i0 = 4 * (l & 7);
    const float pos = a ? (float)(t & 63) : (float)(t >> 6);
#pragma unroll
    for (int q = 0; q < 4; ++q) { const float inv = powf(10000.f, -(float)(i0 + q) / 32.f); sincosf(pos * inv, &sn[q], &cs[q]); } }
}
__device__ __forceinline__ float sum16lanes(float v) { v += __shfl_xor(v, 1); v += __shfl_xor(v, 2); v += __shfl_xor(v, 4); v += __shfl_xor(v, 8); return v; }
__device__ __forceinline__ void phase_rope_conv0(const Args& a, LAS char* lds, bool dry = false) {
  int tid = threadIdx.x; asm volatile("" : "+v"(tid)); tid &= 511; const int wave = tid >> 6, lane = tid & 63;
  bf16_t* Q = (bf16_t*)(a.ws + WS_QKVU);
  {
    const bf16_t* HG = (const bf16_t*)(a.ws + WS_HG);
    bf16_t* X2 = (bf16_t*)(a.ws + WS_X2);
    LAS char* lt = lds;
    LAS float* part = (LAS float*)(lds + 62 * 2048);
    LAS float* stats = part + 512;
    const float* dw_w = a.in[11]; const float* dw_b = a.in[12]; const float* ln_g = a.in[13]; const float* ln_b = a.in[14];
    const __amdgpu_buffer_rsrc_t wrs = __builtin_amdgcn_make_buffer_rsrc((void*)dw_w, 0, 31 * 1024 * 4, 0x00020000);
    for (int u = blockIdx.x; u < 520; u += gridDim.x) {
      int seg0, seg1, r0;
      if (u < 8) { seg0 = 0; seg1 = CTXL; r0 = u * 32; } else { seg0 = CTXL; seg1 = MT; r0 = CTXL + (u - 8) * 32; }
      for (int c = tid; c < 62 * 128; c += NTHREADS) { const int rr = c >> 7, cc = c & 127, gr = r0 - 15 + rr;
        u32x4 v = {0u, 0u, 0u, 0u}; if (gr >= seg0 && gr < seg1) v = *(const u32x4*)(HG + (size_t)gr * 1024 + cc * 8);
        *(LAS u32x4*)(lt + rr * 2048 + cc * 16) = v; }
      __syncthreads();
      float w0[31], w1[31];
#pragma unroll
      for (int j = 0; j < 31; ++j) { const u32x2 w = __builtin_amdgcn_raw_buffer_load_b64(wrs, tid * 8, j * 4096, 0); w0[j] = __uint_as_float(w[0]); w1[j] = __uint_as_float(w[1]); }
      const f32x2 bb = *(const f32x2*)(dw_b + 2 * tid);
      const f32x2 gg = *(const f32x2*)(ln_g + 2 * tid), gb = *(const f32x2*)(ln_b + 2 * tid);
#pragma unroll 1
      for (int hf = 0; hf < 4; ++hf) {
        float o0[8], o1[8];
        LAS const char* lth = lt + (hf * 8) * 2048 + tid * 4;
#pragma unroll
        for (int r = 0; r < 8; ++r) { o0[r] = bb[0]; o1[r] = bb[1]; }
#pragma unroll
        for (int i = 0; i < 38; ++i) {
          const unsigned p = *(LAS const unsigned*)(lth + i * 2048);
          const float x0 = bflo(p), x1 = bfhi(p);
#pragma unroll
          for (int r = 0; r < 8; ++r) { const int j = i - r; if (j >= 0 && j < 31) { o0[r] += x0 * w0[j]; o1[r] += x1 * w1[j]; } }
        }
#pragma unroll
        for (int r = 0; r < 8; ++r) {
          const float s = wave_sum(o0[r] + o1[r]), q = wave_sum(o0[r] * o0[r] + o1[r] * o1[r]);
          if (lane == 0) { part[(r * 8 + wave) * 2] = s; part[(r * 8 + wave) * 2 + 1] = q; }
        }
        __syncthreads();
        if (tid < 8) { float s = 0, q = 0;
#pragma unroll
          for (int w = 0; w < 8; ++w) { s += part[(tid * 8 + w) * 2]; q += part[(tid * 8 + w) * 2 + 1]; }
          const float mean = s * (1.f / 1024), var = q * (1.f / 1024) - mean * mean;
          stats[tid * 2] = mean; stats[tid * 2 + 1] = rsqrtf(fmaxf(var, 0.f) + EPS); }
        __syncthreads();
#pragma unroll
        for (int r = 0; r < 8; ++r) {
          const float mean = stats[r * 2], rstd = stats[r * 2 + 1];
          float y0 = (o0[r] - mean) * rstd * gg[0] + gb[0], y1 = (o1[r] - mean) * rstd * gg[1] + gb[1];
          y0 = y0 * sigmoid_fast(y0); y1 = y1 * sigmoid_fast(y1);
          *(unsigned*)(X2 + (size_t)(r0 + hf * 8 + r) * D + 1024 + 2 * tid) = cvtpk(y0, y1);
        }
      }
      __syncthreads();
    }
  }
  const float* qn = a.in[9]; const float* kn = a.in[10];
  unsigned* kmx = (unsigned*)(a.ws + WS_CTL + CTL_KMAX);
  const int slot = lane >> 4, l16 = lane & 15, e1 = (l16 >> 3) * 64 + 4 * (l16 & 7), e2 = e1 + 32;
  float km0 = 0.f, km1 = 0.f;
  for (int it = blockIdx.x; it < MT / 8; it += gridDim.x) {
    const int r = it * 8 + wave;
    float cs[4], sn[4]; rope_cs4(r, lane, cs, sn);
    bf16_t* rowp = Q + (size_t)r * N_QKV0;
#pragma unroll
    for (int hb = 0; hb < 12; hb += 4) {
      const int hh = hb + slot;
      if (hh < 10) {
        const float* g = hh < 8 ? qn : kn;
        const u32x2 a1 = *(const u32x2*)(rowp + hh * 128 + e1), a2 = *(const u32x2*)(rowp + hh * 128 + e2);
        float x1[4] = {bflo(a1[0]), bfhi(a1[0]), bflo(a1[1]), bfhi(a1[1])}, x2[4] = {bflo(a2[0]), bfhi(a2[0]), bflo(a2[1]), bfhi(a2[1])};
        float ss = 0;
#pragma unroll
        for (int q = 0; q < 4; ++q) ss += x1[q] * x1[q] + x2[q] * x2[q];
        ss = sum16lanes(ss);
        const float rstd = rsqrtf(ss * (1.f / 128) + EPS);
        const f32x4 g1 = *(const f32x4*)(g + e1), g2 = *(const f32x4*)(g + e2);
        float o1[4], o2[4], so = 0;
#pragma unroll
        for (int q = 0; q < 4; ++q) { const float y1 = x1[q] * rstd * g1[q], y2 = x2[q] * rstd * g2[q]; o1[q] = y1 * cs[q] - y2 * sn[q]; o2[q] = y2 * cs[q] + y1 * sn[q]; }
        const u32x2 w1 = {cvtpk(o1[0], o1[1]), cvtpk(o1[2], o1[3])}, w2 = {cvtpk(o2[0], o2[1]), cvtpk(o2[2], o2[3])};
        if (!dry) { *(u32x2*)(rowp + hh * 128 + e1) = w1; *(u32x2*)(rowp + hh * 128 + e2) = w2; }
        if (hb == 8) {
          const unsigned q1 = pack8x4(o1[0], o1[1], o1[2], o1[3]), q2 = pack8x4(o2[0], o2[1], o2[2], o2[3]);
          unsigned char* k8p = (unsigned char*)(a.ws + WS_K8) + (size_t)r * 256 + (hh - 8) * 128;
          *(unsigned*)(k8p + e1) = q1; *(unsigned*)(k8p + e2) = q2;
          so = sum16lanes(sq8x4(q1) + sq8x4(q2)); if (slot == 0) km0 = fmaxf(km0, so); else km1 = fmaxf(km1, so);
        }
      }
    }
  }
  if (l16 == 0 && slot < 2) atomicMax(&kmx[slot], __float_as_uint(slot == 0 ? km0 : km1));
}
__device__ __forceinline__ void phase_rope1(const Args& a, LAS char* lds, bool dry = false) {
  int tid = threadIdx.x; asm volatile("" : "+v"(tid)); tid &= 511; const int wave = tid >> 6, lane = tid & 63;
  bf16_t* Q = (bf16_t*)(a.ws + WS_QKVU);
  unsigned* kmx = (unsigned*)(a.ws + WS_CTL + CTL_KMAX) + 16;
  unsigned char* K8 = (unsigned char*)(a.ws + WS_K8);
  LAS unsigned* lk = (LAS unsigned*)lds;
  if (tid < 16) lk[tid] = 0u;
  __syncthreads();
  const int slot = lane >> 4, l16 = lane & 15, e1 = (l16 >> 3) * 64 + 4 * (l16 & 7), e2 = e1 + 32;
  for (int it = blockIdx.x; it < MT / 8; it += gridDim.x) {
    const int r = it * 8 + wave;
    float cs[4], sn[4]; rope_cs4(r, lane, cs, sn);
    bf16_t* rowp = Q + (size_t)r * N_IN1;
#pragma unroll 2
    for (int hb = (r < CTXL ? 16 : 0); hb < 32; hb += 4) {
      const int hh = hb + slot;
      const u32x2 a1 = *(const u32x2*)(rowp + hh * 128 + e1), a2 = *(const u32x2*)(rowp + hh * 128 + e2);
      const float x1[4] = {bflo(a1[0]), bfhi(a1[0]), bflo(a1[1]), bfhi(a1[1])}, x2[4] = {bflo(a2[0]), bfhi(a2[0]), bflo(a2[1]), bfhi(a2[1])};
      float o1[4], o2[4];
#pragma unroll
      for (int q = 0; q < 4; ++q) { o1[q] = x1[q] * cs[q] - x2[q] * sn[q]; o2[q] = x2[q] * cs[q] + x1[q] * sn[q]; }
      const u32x2 w1 = {cvtpk(o1[0], o1[1]), cvtpk(o1[2], o1[3])}, w2 = {cvtpk(o2[0], o2[1]), cvtpk(o2[2], o2[3])};
      if (r >= CTXL && !dry) { *(u32x2*)(rowp + hh * 128 + e1) = w1; *(u32x2*)(rowp + hh * 128 + e2) = w2; }
      if (hb >= 16) {
        const unsigned q1 = pack8x4(o1[0], o1[1], o1[2], o1[3]), q2 = pack8x4(o2[0], o2[1], o2[2], o2[3]);
        unsigned char* k8p = K8 + (size_t)r * 2048 + (hh - 16) * 128;
        *(unsigned*)(k8p + e1) = q1; *(unsigned*)(k8p + e2) = q2;
        float so = sum16lanes(sq8x4(q1) + sq8x4(q2));
        if (l16 == 0) atomicMax((unsigned*)&lk[hh - 16], __float_as_uint(so));
      }
    }
  }
  __syncthreads();
  if (tid < 16) atomicMax(&kmx[tid], lk[tid]);
  __syncthreads();
}

__device__ __forceinline__ void phase_attn(const Args& a, int L, LAS char* lds) {
  const bf16_t* Q = (const bf16_t*)(a.ws + WS_QKVU);
  const unsigned* kmx = (const unsigned*)(a.ws + WS_CTL + CTL_KMAX) + L * 16;
  if (L == 0) {
    bf16_t* X2 = (bf16_t*)(a.ws + WS_X2);
    for (int u = blockIdx.x; u < 520; u += gridDim.x) {
      const int head = u < 512 ? (u & 7) : (u - 512);
      const float kmax2 = __uint_as_float(kmx[head >> 2]);
      if (u < 512) { const int qb = u >> 3; const size_t q0 = (size_t)(CTXL + qb * 256);
        at::attn_body_q8(Q + q0 * N_QKV0 + head * 128, N_QKV0, (const unsigned char*)(a.ws + WS_K8) + (head >> 2) * 128, 256, Q + 1280 + (head >> 2) * 128, N_QKV0, X2 + q0 * D + head * 128, D, MT, kmax2, lds);
      } else {
        at::attn_body_q8(Q + head * 128, N_QKV0, (const unsigned char*)(a.ws + WS_K8) + (head >> 2) * 128, 256, Q + 1280 + (head >> 2) * 128, N_QKV0, X2 + head * 128, D, CTXL, kmax2, lds); }
    }
  } else {
    bf16_t* O = (bf16_t*)(a.ws + WS_Y);
    for (int u = blockIdx.x; u < 1024; u += gridDim.x) {
      const int x = u & 7, w = u >> 3, hc = x + 8 * (w >> 6), qb = w & 63, h = hc >> 1;
      const float kmax2 = __uint_as_float(kmx[hc]);
      const size_t q0 = (size_t)(CTXL + qb * 256);
      at::attn_body_c256q8(Q + q0 * N_IN1 + hc * 128, N_IN1, (const unsigned char*)(a.ws + WS_K8) + hc * 128, 2048, Q + 4096 + h * 256, N_IN1,
                           O + (size_t)(qb * 256) * 4096 + hc * 256, 4096, MT, kmax2, lds);
    }
  }
}

__device__ __forceinline__ void phase_diff(const Args& a) {
  int tid = threadIdx.x; asm volatile("" : "+v"(tid)); tid &= 511; const int wave = tid >> 6, lane = tid & 63;
  const bf16_t* O = (const bf16_t*)(a.ws + WS_Y);
  bf16_t* X2 = (bf16_t*)(a.ws + WS_X2);
  const float* lp = a.in[17];
  const float s1 = wave_sum(lp[lane] * lp[128 + lane] + lp[64 + lane] * lp[192 + lane]);
  const float s2 = wave_sum(lp[256 + lane] * lp[384 + lane] + lp[320 + lane] * lp[448 + lane]);
  const float lam = expf(s1) - expf(s2) + LAM_INIT;
  const f32x4 sg = *(const f32x4*)(a.in[18] + 4 * lane);
  for (int it = blockIdx.x; it < SEQ / 8; it += gridDim.x) {
    const int t = it * 8 + wave;
    const bf16_t* op = O + (size_t)t * 4096;
    bf16_t* xp = X2 + (size_t)(CTXL + t) * D;
#pragma unroll 2
    for (int h = 0; h < 8; ++h) {
      const u32x2 a0 = *(const u32x2*)(op + (2 * h) * 256 + 4 * lane), a1 = *(const u32x2*)(op + (2 * h + 1) * 256 + 4 * lane);
      float d[4] = {bflo(a0[0]) - lam * bflo(a1[0]), bfhi(a0[0]) - lam * bfhi(a1[0]), bflo(a0[1]) - lam * bflo(a1[1]), bfhi(a0[1]) - lam * bfhi(a1[1])};
      const float ss = wave_sum(d[0] * d[0] + d[1] * d[1] + d[2] * d[2] + d[3] * d[3]);
      const float rstd = rsqrtf(ss * (1.f / 256) + EPS) * (1.f - LAM_INIT);
      u32x2 pk = {cvtpk(d[0] * rstd * sg[0], d[1] * rstd * sg[1]), cvtpk(d[2] * rstd * sg[2], d[3] * rstd * sg[3])};
      *(u32x2*)(xp + h * 256 + 4 * lane) = pk;
    }
  }
}

__device__ __forceinline__ void phase_G(const Args& a, int L, LAS char* lds, bool dry = false) {
  int tid = threadIdx.x; asm volatile("" : "+v"(tid)); tid &= 511; const int wave = tid >> 6, lane = tid & 63;
  const int NTOK = L == 0 ? MT : SEQ, ROW0 = L == 0 ? 0 : CTXL;
  const float* ng = a.in[6] + (size_t)L * 4 * D;
  const float* MODL = (const float*)(a.ws + WS_MOD) + (size_t)(L * 2) * 12288;
  const float* router = a.in[19] + (size_t)L * D * NE; const float* rbias = a.in[20] + L * NE;
  const bf16_t* OUT = (const bf16_t*)(a.ws + WS_OUT);
  float* HRES = (float*)(a.ws + WS_HRES);
  bf16_t* F = (bf16_t*)(a.ws + WS_ABUF);
  int* counts = (int*)(a.ws + WS_CTL + CTL_CNT) + L * 64;
  int* top_e = (int*)(a.ws + WS_TOPE); float* top_w = (float*)(a.ws + WS_TOPW); int* top_p = (int*)(a.ws + WS_TOPP);
  LAS float* ft = (LAS float*)lds;
  LAS float* part = ft + 8 * D;
  for (int it = blockIdx.x; it < NTOK / 8; it += gridDim.x) {
    const int r = ROW0 + it * 8 + wave;
    const float* mod = MODL + (r < CTXL ? 12288 : 0);
    {
      float o[32], h[32];
      ld_row_bf16(OUT + (size_t)r * D, lane, o);
      const float* hp = L == 0 ? (r < CTXL ? a.in[2] + (size_t)r * D : a.in[0] + (size_t)(r - CTXL) * D) : HRES + (size_t)r * D;
      ld_row_f32(hp, lane, h);
      const float rstd1 = rsqrtf(sumsq32(o) * (1.f / D) + EPS);
#pragma unroll
      for (int j = 0; j < 4; ++j) { const int idx = 8 * lane + 512 * j;
        float g1[8], gt[8]; ld8f(ng + D + idx, g1); ld8f(mod + 2 * D + idx, gt);
#pragma unroll
        for (int i = 0; i < 8; ++i) h[8 * j + i] += gt[i] * (o[8 * j + i] * rstd1 * g1[i]);
        if (!dry) st8f(HRES + (size_t)r * D + idx, &h[8 * j]); }
      const float rstd2 = rsqrtf(sumsq32(h) * (1.f / D) + EPS);
      modulate_store<true, true>(h, rstd2, ng + 2 * D, mod + 3 * D, mod + 4 * D, (bf16_t*)((unsigned char*)F + (size_t)r * D), lane, ft + wave * D);
    }
    __syncthreads();
    float acc[8] = {0, 0, 0, 0, 0, 0, 0, 0};
    const int d0 = wave * 256;
#pragma unroll 2
    for (int dd = 0; dd < 256; dd += 4) {
      const float* rp = router + (size_t)(d0 + dd) * NE + lane;
      const float r0 = rp[0], r1 = rp[NE], r2 = rp[2 * NE], r3 = rp[3 * NE];
#pragma unroll
      for (int t = 0; t < 8; ++t) { const f32x4 fv = *(LAS const f32x4*)(ft + t * D + d0 + dd); acc[t] += fv[0] * r0 + fv[1] * r1 + fv[2] * r2 + fv[3] * r3; }
    }
#pragma unroll
    for (int t = 0; t < 8; ++t) part[(wave * 8 + t) * 64 + lane] = acc[t];
    __syncthreads();
    float logit = 0;
#pragma unroll
    for (int w = 0; w < 8; ++w) logit += part[(w * 8 + wave) * 64 + lane];
#if MK_DIAG
    ((float*)(a.ws + WS_Y))[(size_t)r * 64 + lane] = logit;
#endif
    const float score = sigmoidf_(logit);
    const float choice = score + rbias[lane];
    int rank = 0; const int gl = lane & 7;
#pragma unroll
    for (int j = 0; j < 8; ++j) { const float o = __shfl(choice, (lane & ~7) | j); rank += (o > choice || (o == choice && j < gl)) ? 1 : 0; }
    float gs = rank < 2 ? choice : 0.f;
    gs += __shfl_xor(gs, 1); gs += __shfl_xor(gs, 2); gs += __shfl_xor(gs, 4);
    int grank = 0; const int g = lane >> 3;
#pragma unroll
    for (int j = 0; j < 8; ++j) { const float o = __shfl(gs, j * 8); grank += (o > gs || (o == gs && j < g)) ? 1 : 0; }
    const bool gsel = grank < 4;
    const float mc = gsel ? choice : -INFINITY;
    int erank = 0;
#pragma unroll 4
    for (int j = 0; j < 64; ++j) { const float o = __int_as_float(__builtin_amdgcn_readlane(__float_as_int(mc), j)); erank += (o > mc || (o == mc && j < lane)) ? 1 : 0; }
    const bool sel = gsel && erank < 8;
    const unsigned long long bal = __ballot(sel);
    const int idx = __popcll(bal & ((1ull << lane) - 1ull));
    const float ssum = wave_sum(sel ? score : 0.f);
    if (sel && !dry) { const int pos = atomicAdd(&counts[lane], 1);
      top_e[r * 8 + idx] = lane; top_w[r * 8 + idx] = score / ssum * 2.5f; top_p[r * 8 + idx] = pos; }
  }
}

__device__ __forceinline__ void moe_tile_prefix(const int* counts, LAS int* ts) {
  if (threadIdx.x == 0) { int s = 0; for (int e = 0; e < 64; ++e) { ts[e] = s; s += (counts[e] + 255) >> 8; } ts[64] = s; }
  __syncthreads();
}
__device__ __forceinline__ void phase_H(const Args& a, int L, LAS char* lds) {
  const int NTOK = L == 0 ? MT : SEQ, ROW0 = L == 0 ? 0 : CTXL;
  const int* counts = (const int*)(a.ws + WS_CTL + CTL_CNT) + L * 64;
  const int* top_e = (const int*)(a.ws + WS_TOPE); const int* top_p = (const int*)(a.ws + WS_TOPP);
  int* tslot = (int*)(a.ws + WS_TSLOT); int* stok = (int*)(a.ws + WS_STOK);
  LAS int* ts = (LAS int*)lds;
  moe_tile_prefix(counts, ts);
  int tid = threadIdx.x; asm volatile("" : "+v"(tid)); tid &= 511;
  const int gt = blockIdx.x * NTHREADS + tid, gs = gridDim.x * NTHREADS;
  for (int i = gt; i < NTOK * 8; i += gs) { const int q = ROW0 * 8 + i; const int e = top_e[q]; const int slot = ts[e] * 256 + top_p[q]; stok[slot] = q >> 3; tslot[q] = slot; }
  for (int i = gt; i < 64 * 256; i += gs) { const int e = i >> 8, p = i & 255, cnt = counts[e], nt = (cnt + 255) >> 8; if (cnt + p < nt * 256) stok[ts[e] * 256 + cnt + p] = ROW0; }
  for (int i = gt; i < NTOK; i += gs) stok[SH_BASE + i] = ROW0 + i;
  __syncthreads();
}
struct MoeSched {
  LAS const int* ts; int TR, NN, total; const unsigned char* W; size_t woff;
  __device__ __forceinline__ bool unit(int i, int& slot0, const unsigned char*& Bt, int& bcol) const {
    for (int u = blockIdx.x + i * (int)gridDim.x; ; u += gridDim.x) {
      const int rnd = u >> 8, b = u & 255, v = rnd * 256 + (b & 7) * 32 + (b >> 3);
      if (rnd * 256 >= total) return false;
      if (v >= total) return false;
      const int m = v / NN, pn = v % NN;
      int e;
      if (m >= TR) { e = 64; slot0 = SH_BASE + 256 * (m - TR); } else { e = 0; while (ts[e + 1] <= m) ++e; slot0 = 256 * m; }
      Bt = W + (size_t)e * WMOE8_E + woff; bcol = pn * 256;
      return true;
    }
  }
};
__device__ __forceinline__ void phase_moe_up(const Args& a, int L, LAS char* lds) {
  const int NSH = L == 0 ? MT / 256 : SEQ / 256;
  const int* counts = (const int*)(a.ws + WS_CTL + CTL_CNT) + L * 64;
  LAS int* ts = (LAS int*)(lds + LDS_CTL + 64);
  moe_tile_prefix(counts, ts);
  const int TR = ts[64], TM = TR + NSH;
  const unsigned char* F = (const unsigned char*)(a.ws + WS_ABUF); const unsigned char* W = (const unsigned char*)(a.ws + WS_WMOE) + (size_t)L * 65 * WMOE8_E;
  const int* stok = (const int*)(a.ws + WS_STOK);
  EpiSwiGLU8 epi{(unsigned char*)(a.ws + WS_ACT), EFF};
  MoeSched sc{ts, TR, 4, TM * 4, W, 0};
  gemm8_run<true, D, D, D>(F, stok, lds, epi, sc);
}
__device__ __forceinline__ void phase_moe_down(const Args& a, int L, LAS char* lds) {
  const int NSH = L == 0 ? MT / 256 : SEQ / 256;
  const int* counts = (const int*)(a.ws + WS_CTL + CTL_CNT) + L * 64;
  LAS int* ts = (LAS int*)(lds + LDS_CTL + 64);
  moe_tile_prefix(counts, ts);
  const int TR = ts[64], TM = TR + NSH;
  const unsigned char* ACT = (const unsigned char*)(a.ws + WS_ACT); const unsigned char* W = (const unsigned char*)(a.ws + WS_WMOE) + (size_t)L * 65 * WMOE8_E;
  EpiPlain8 epi{(unsigned char*)(a.ws + WS_Y), D, 16.f / 128.f};
  MoeSched sc{ts, TR, 8, TM * 8, W, (size_t)1024 * D};
  gemm8_run<false, EFF, EFF, EFF>(ACT, nullptr, lds, epi, sc);
}
__device__ __forceinline__ void phase_combine(const Args& a, int L, bool dry = false) {
  int tid = threadIdx.x; asm volatile("" : "+v"(tid)); tid &= 511; const int wave = tid >> 6, lane = tid & 63;
  const int NTOK = L == 0 ? MT : SEQ, ROW0 = L == 0 ? 0 : CTXL;
  const float* ng = a.in[6] + (size_t)L * 4 * D;
  const float* MODL = (const float*)(a.ws + WS_MOD) + (size_t)(L * 2) * 12288;
  const unsigned char* Y = (const unsigned char*)(a.ws + WS_Y);
  float* HRES = (float*)(a.ws + WS_HRES);
  const int* tslot = (const int*)(a.ws + WS_TSLOT); const float* top_w = (const float*)(a.ws + WS_TOPW);
  for (int it = blockIdx.x; it < NTOK / 8; it += gridDim.x) {
    const int r = ROW0 + it * 8 + wave;
    const float* mod = MODL + (r < CTXL ? 12288 : 0);
    float y[32];
    { float t[32]; ld_row_fp8(Y + (size_t)(SH_BASE + r - ROW0) * D, lane, t);
#pragma unroll
      for (int i = 0; i < 32; ++i) y[i] = t[i] * (1.f / 16.f); }
#pragma unroll 4
    for (int k = 0; k < 8; ++k) { const int slot = tslot[r * 8 + k]; const float w = top_w[r * 8 + k] * (1.f / 16.f);
      float t[32]; ld_row_fp8(Y + (size_t)slot * D, lane, t);
#pragma unroll
      for (int i = 0; i < 32; ++i) y[i] += w * t[i]; }
    const float rstd = rsqrtf(sumsq32(y) * (1.f / D) + EPS);
    float h[32]; ld_row_f32(HRES + (size_t)r * D, lane, h);
#pragma unroll
    for (int j = 0; j < 4; ++j) { const int idx = 8 * lane + 512 * j;
      float g3[8], gt[8]; ld8f(ng + 3 * D + idx, g3); ld8f(mod + 5 * D + idx, gt);
#pragma unroll
      for (int i = 0; i < 8; ++i) h[8 * j + i] += gt[i] * (y[8 * j + i] * rstd * g3[i]);
      if (L == 0) { if (!dry) st8f(HRES + (size_t)r * D + idx, &h[8 * j]); } else st8f(a.out + (size_t)(r - CTXL) * D + idx, &h[8 * j]); }
    if (L == 0) {
      const float* mod1 = MODL + 2 * 12288 + (r < CTXL ? 12288 : 0);
      const float rstd2 = rsqrtf(sumsq32(h) * (1.f / D) + EPS);
      modulate_store<false>(h, rstd2, a.in[6] + (size_t)4 * D, mod1, mod1 + D, (bf16_t*)(a.ws + WS_ABUF) + (size_t)r * D, lane, nullptr);
    }
  }
}

constexpr int NPH = 21;
typedef const __attribute__((address_space(4))) Args* ArgsP;
#if defined(__HIP_DEVICE_COMPILE__)
#define FRESH_ARGS() const Args a = *({ ArgsP _p = (ArgsP)__builtin_amdgcn_kernarg_segment_ptr(); asm volatile("" : "+s"(_p)); _p; })
#else
#define FRESH_ARGS() const Args a = kargs
#endif
__global__ void __launch_bounds__(NTHREADS, 2) fwd(Args kargs) {
  extern __shared__ __attribute__((aligned(16))) unsigned char lds_raw[];
  LAS char* lds = (LAS char*)lds_raw;
  const int lo = kargs.ph_lo, hi = kargs.ph_hi;
  if (threadIdx.x < 64) ((LAS unsigned*)(lds + LDS_CTL))[threadIdx.x] = 0u;
  __syncthreads();
  if (hi - lo > 1) (void)xcd_barrier_post((unsigned*)(kargs.ws + WS_CTL), (volatile LAS unsigned*)(lds + LDS_CTL));
#ifndef PHASE_MASK
#define PHASE_MASK 0xFFFFFFFFu
#endif
#define IN(k) (((PHASE_MASK >> (k)) & 1u) && lo <= (k) && (k) < hi)
#ifndef PH_REPEAT_MASK
#define PH_REPEAT_MASK 0u
#endif
#define REP(k) for (int _rep = 0; _rep < (((PH_REPEAT_MASK >> (k)) & 1u) ? 2 : 1); ++_rep)
#define SEAM(k) do { if ((k) + 1 < hi) { XcdBarrier _b; _b.bar = (unsigned*)(a.ws + WS_CTL); _b.x = xb_xcc_id(); _b.st = (volatile LAS unsigned*)(lds + LDS_CTL); xcd_barrier(_b); } } while (0)

  if (IN(0)) { FRESH_ARGS(); REP(0) phase_prologue(a, lds); SEAM(0); }
  if (IN(1)) { FRESH_ARGS(); REP(1) phase_modulate0(a); SEAM(1); }
#pragma unroll
  for (int L = 0; L < 2; ++L) {
    const int base = 2 + (L == 0 ? 0 : 9);
    if (IN(base + 0)) {
      FRESH_ARGS();
      const bf16_t* A = (const bf16_t*)(a.ws + WS_ABUF);
      const bf16_t* Bt = (const bf16_t*)(a.ws + (L == 0 ? WS_WIN0 : WS_WIN1));
      const int nN = L == 0 ? N_IN0 / 256 : N_IN1 / 256, nM = MT / 256;
      EpiG1 epi{EpiPlain{(bf16_t*)(a.ws + WS_QKVU), L == 0 ? N_QKV0 : N_IN1}, EpiPair<0>{(bf16_t*)(a.ws + WS_HG), 1024, N_QKV0}, L == 0 ? N_QKV0 : N_IN1};
      REP(2) for (int u = blockIdx.x; u < nM * nN; u += gridDim.x) { int pm, pn; dense_unit(u, nM, nN, pm, pn);
        gemm_tile<false>(A, D, nullptr, pm * 256, Bt, D, pn * 256, D, lds, epi); }
      SEAM(base + 0);
    }
    if (L == 0) {
      if (IN(3)) { FRESH_ARGS(); if ((PH_REPEAT_MASK >> 3) & 1u) { phase_rope_conv0(a, lds, true); __syncthreads(); } phase_rope_conv0(a, lds); SEAM(3); }
      if (IN(4)) { FRESH_ARGS(); REP(4) phase_attn(a, 0, lds); SEAM(4); }
    } else {
      if (IN(12)) { FRESH_ARGS(); if ((PH_REPEAT_MASK >> 12) & 1u) { phase_rope1(a, lds, true); __syncthreads(); } phase_rope1(a, lds); SEAM(12); }
      if (IN(13)) { FRESH_ARGS(); REP(13) phase_attn(a, 1, lds); SEAM(13); }
      if (IN(14)) { FRESH_ARGS(); REP(14) phase_diff(a); SEAM(14); }
    }
    const int b2 = L == 0 ? 5 : 15;
    if (IN(b2 + 0)) {
      FRESH_ARGS();
      const bf16_t* A = (const bf16_t*)(a.ws + WS_X2);
      const bf16_t* Bt = (const bf16_t*)(a.ws + (L == 0 ? WS_WOUT0 : WS_WOUT1));
      const int nN = D / 256, nM = L == 0 ? MT / 256 : SEQ / 256, r0 = L == 0 ? 0 : CTXL;
      EpiPlain epi{(bf16_t*)(a.ws + WS_OUT), D};
      REP(5) for (int u = blockIdx.x; u < nM * nN; u += gridDim.x) { int pm, pn; dense_unit(u, nM, nN, pm, pn);
        gemm_tile<false>(A, D, nullptr, r0 + pm * 256, Bt, D, pn * 256, D, lds, epi); }
      SEAM(b2 + 0);
    }
    if (IN(b2 + 1)) { FRESH_ARGS(); if ((PH_REPEAT_MASK >> 6) & 1u) { phase_G(a, L, lds, true); __syncthreads(); } phase_G(a, L, lds); SEAM(b2 + 1); }
    if (IN(b2 + 2)) { FRESH_ARGS(); REP(7) phase_H(a, L, lds); SEAM(b2 + 2); }
    if (IN(b2 + 3)) { FRESH_ARGS(); REP(8) phase_moe_up(a, L, lds); SEAM(b2 + 3); }
    if (IN(b2 + 4)) { FRESH_ARGS(); REP(9) phase_moe_down(a, L, lds); SEAM(b2 + 4); }
    if (IN(b2 + 5)) { FRESH_ARGS(); if ((PH_REPEAT_MASK >> 10) & 1u) phase_combine(a, L, true); phase_combine(a, L); SEAM(b2 + 5); }
  }
#undef IN
#undef SEAM
}

#ifndef MK_DIAG
#define MK_DIAG 0
#endif
#if MK_DIAG
__device__ __forceinline__ void rope_cs(int r, int lane, float& cs, float& sn) {
  cs = 1.f; sn = 0.f;
  if (r >= CTXL) { const int t = r - CTXL; const int a = lane >> 5, i = lane & 31;
    const float pos = a ? (float)(t & 63) : (float)(t >> 6);
    const float inv = powf(10000.f, -(float)i / 32.f);
    sincosf(pos * inv, &sn, &cs); }
}
__device__ __forceinline__ bool dclose(float got, float ref, float rtol, float atol) { return fabsf(got - ref) <= rtol * fabsf(ref) + atol; }
__device__ __forceinline__ unsigned dhash(unsigned x) { x ^= x >> 16; x *= 0x7feb352du; x ^= x >> 15; x *= 0x846ca68bu; x ^= x >> 16; return x; }
__device__ float wdot(const bf16_t* arow, const float* W, int ldw, int col, int K, int lane) {
  float s = 0; for (int k = lane; k < K; k += 64) s += bf2f(arow[k]) * W[(size_t)k * ldw + col]; return wave_sum(s); }
__device__ float dq8(const unsigned char* p, size_t i) { const unsigned w = ((const unsigned*)p)[i >> 2]; const int b = (int)(i & 3);
  return b == 0 ? __builtin_amdgcn_cvt_f32_fp8((int)w, 0) : b == 1 ? __builtin_amdgcn_cvt_f32_fp8((int)w, 1) : b == 2 ? __builtin_amdgcn_cvt_f32_fp8((int)w, 2) : __builtin_amdgcn_cvt_f32_fp8((int)w, 3); }
__device__ float wdot8(const unsigned char* arow8, const float* W, int ldw, int col, int K, int lane) {
  float s = 0; for (int k = lane; k < K; k += 64) s += dq8(arow8, k) * W[(size_t)k * ldw + col]; return wave_sum(s); }
__device__ void dflag(int* dg, int s, int bad, int lane) { if (lane == 0 && bad) atomicAdd(&dg[s], bad); }
__device__ const float* h0row(const Args& a, int r) { return r < CTXL ? a.in[2] + (size_t)r * D : a.in[0] + (size_t)(r - CTXL) * D; }
__device__ int pick_row(unsigned h, int lo, int n) { const unsigned m = h % 8; if (m == 0) return lo; if (m == 1) return lo + n - 1; if (m == 2) return lo + 255 < lo + n ? lo + 255 : lo; if (m == 3) return lo + 256 < lo + n ? lo + 256 : lo; return lo + (int)((h >> 3) % (unsigned)n); }
__device__ void naive_attn(const bf16_t* q, const bf16_t* K, const bf16_t* V, int ld, int nkeys, int lane, float& o0, float& o1) {
  const float q0 = bf2f(q[lane]), q1 = bf2f(q[lane + 64]);
  float m = -1e30f, l = 0; o0 = 0; o1 = 0;
  for (int k = 0; k < nkeys; ++k) {
    const float s = wave_sum(q0 * bf2f(K[(size_t)k * ld + lane]) + q1 * bf2f(K[(size_t)k * ld + lane + 64])) * 0.088388347648318440f;
    const float mn = fmaxf(m, s), al = expf(m - mn), p = expf(s - mn);
    l = l * al + p; o0 = o0 * al + p * bf2f(V[(size_t)k * ld + lane]); o1 = o1 * al + p * bf2f(V[(size_t)k * ld + lane + 64]); m = mn;
  }
  o0 /= l; o1 /= l;
}
__global__ void __launch_bounds__(256) diag(Args a, int k) {
  __shared__ float fsh[4][2048];
  __shared__ float csh[4][64];
  const int lane = threadIdx.x & 63, wv = threadIdx.x >> 6, gw = blockIdx.x * 4 + wv;
  int* dg = (int*)(a.ws + WS_CTL + CTL_CNT + 512);
  const float* MOD = (const float*)(a.ws + WS_MOD);
  const bf16_t* AB = (const bf16_t*)(a.ws + WS_ABUF);
  const bf16_t* QK = (const bf16_t*)(a.ws + WS_QKVU);
  const bf16_t* HG = (const bf16_t*)(a.ws + WS_HG);
  const bf16_t* X2 = (const bf16_t*)(a.ws + WS_X2);
  const bf16_t* OUT = (const bf16_t*)(a.ws + WS_OUT);
  const bf16_t* ACT = (const bf16_t*)(a.ws + WS_ACT);
  const bf16_t* Y = (const bf16_t*)(a.ws + WS_Y);
  const float* HRES = (const float*)(a.ws + WS_HRES);
  const int* top_e = (const int*)(a.ws + WS_TOPE); const float* top_w = (const float*)(a.ws + WS_TOPW); const int* top_p = (const int*)(a.ws + WS_TOPP);
  const int* tslot = (const int*)(a.ws + WS_TSLOT); const int* stok = (const int*)(a.ws + WS_STOK);
  const unsigned h = dhash(gw * 7919u + k * 104729u + 17u), h2 = dhash(h + 12345u);
  int bad = 0;
  const int L = k >= 11 ? 1 : 0;
  const int NTOK = L == 0 ? MT : SEQ, ROW0 = L == 0 ? 0 : CTXL;
  const int* counts = (const int*)(a.ws + WS_CTL + CTL_CNT) + L * 64;
  if (k == 0) {
    const int LL = gw & 1, which = (gw >> 1) & 1, j = h % 12288;
    const float* v = which ? a.in[3] : a.in[1];
    float s = 0; for (int d = lane; d < D; d += 64) { const float x = v[d]; s += x * sigmoidf_(x) * a.in[4][((size_t)LL * D + d) * 12288 + j]; }
    s = wave_sum(s) + a.in[5][LL * 12288 + j];
    bad = !dclose(MOD[(LL * 2 + which) * 12288 + j], s, 1e-3f, 1e-3f); dflag(dg, 1, bad, lane);
  } else if (k == 1) {
    const int r = pick_row(h, 0, MT); const float* x = h0row(a, r); const float* mod = MOD + (r < CTXL ? 12288 : 0);
    float ss = 0; for (int d = lane; d < D; d += 64) ss += x[d] * x[d]; ss = wave_sum(ss); const float rstd = rsqrtf(ss / D + EPS);
    for (int d = lane; d < D; d += 64) { const float ref = x[d] * rstd * a.in[6][d] * (1.f + mod[D + d]) + mod[d]; bad += !dclose(bf2f(AB[(size_t)r * D + d]), ref, 0.01f, 0.01f); }
    bad = (int)wave_sum((float)bad); dflag(dg, 2, bad, lane);
  } else if (k == 2 || k == 11) {
    const int r = pick_row(h, 0, MT);
    if (L == 0) {
      const int c = h2 % N_QKV0; const float ref = wdot(AB + (size_t)r * D, a.in[7], N_IN0, c, D, lane);
      bad = !dclose(bf2f(QK[(size_t)r * N_QKV0 + c]), ref, 0.02f, 0.05f); dflag(dg, 3, bad, lane);
      const int ch = (h2 >> 11) % 1024; const float av = wdot(AB + (size_t)r * D, a.in[7], N_IN0, N_QKV0 + ch, D, lane), gv = wdot(AB + (size_t)r * D, a.in[7], N_IN0, N_QKV0 + 1024 + ch, D, lane);
      bad = !dclose(bf2f(HG[(size_t)r * 1024 + ch]), av * sigmoidf_(gv), 0.03f, 0.05f); dflag(dg, 4, bad, lane);
    } else {
      const int c = h2 % N_IN1; const float ref = wdot(AB + (size_t)r * D, a.in[15], N_IN1, c, D, lane);
      bad = !dclose(bf2f(QK[(size_t)r * N_IN1 + c]), ref, 0.02f, 0.05f); dflag(dg, 15, bad, lane);
    }
  } else if (k == 3) {
    { const int r = pick_row(h, 0, MT), hh = h2 % 10; const float* g = hh < 8 ? a.in[9] : a.in[10];
      float raw0 = 0, raw1 = 0;
      for (int d = 0; d < 128; ++d) { const float v = wdot(AB + (size_t)r * D, a.in[7], N_IN0, hh * 128 + d, D, lane); if (d == lane) raw0 = v; if (d == lane + 64) raw1 = v; }
      const float rstd = rsqrtf(wave_sum(raw0 * raw0 + raw1 * raw1) / 128.f + EPS);
      const float y0 = raw0 * rstd * g[lane], y1 = raw1 * rstd * g[lane + 64];
      float cs, sn; rope_cs(r, lane, cs, sn);
      const float cs0 = __shfl(cs, lane & 31), sn0 = __shfl(sn, lane & 31), cs1 = __shfl(cs, 32 + (lane & 31)), sn1 = __shfl(sn, 32 + (lane & 31));
      const float p0 = __shfl_xor(y0, 32), p1 = __shfl_xor(y1, 32);
      const float o0 = (lane < 32) ? y0 * cs0 - p0 * sn0 : y0 * cs0 + p0 * sn0;
      const float o1 = (lane < 32) ? y1 * cs1 - p1 * sn1 : y1 * cs1 + p1 * sn1;
      bad = !dclose(bf2f(QK[(size_t)r * N_QKV0 + hh * 128 + lane]), o0, 0.03f, 0.05f) + !dclose(bf2f(QK[(size_t)r * N_QKV0 + hh * 128 + 64 + lane]), o1, 0.03f, 0.05f);
      bad = (int)wave_sum((float)bad); dflag(dg, 5, bad, lane); }
    { const int r = pick_row(h2, 0, MT); const int seg0 = r < CTXL ? 0 : CTXL, seg1 = r < CTXL ? CTXL : MT;
      float cv[16]; float s1 = 0, s2 = 0;
      for (int q = 0; q < 16; ++q) { const int c = lane + 64 * q; float acc = a.in[12][c];
        for (int j = 0; j < 31; ++j) { const int rr = r + j - 15; if (rr >= seg0 && rr < seg1) acc += bf2f(HG[(size_t)rr * 1024 + c]) * a.in[11][j * 1024 + c]; }
        cv[q] = acc; s1 += acc; s2 += acc * acc; }
      s1 = wave_sum(s1); s2 = wave_sum(s2); const float mean = s1 / 1024.f, rstd = rsqrtf(s2 / 1024.f - mean * mean + EPS);
      bad = 0;
      for (int q = 0; q < 16; ++q) { const int c = lane + 64 * q; float y = (cv[q] - mean) * rstd * a.in[13][c] + a.in[14][c]; y = y * sigmoidf_(y);
        bad += !dclose(bf2f(X2[(size_t)r * D + 1024 + c]), y, 0.03f, 0.03f); }
      bad = (int)wave_sum((float)bad); dflag(dg, 6, bad, lane); }
  } else if (k == 4) {
    if (gw < 64) { const int r = pick_row(h, 0, MT), head = h2 % 8; const int nkeys = r < CTXL ? CTXL : MT;
      float o0, o1; naive_attn(QK + (size_t)r * N_QKV0 + head * 128, QK + 1024 + (head >> 2) * 128, QK + 1280 + (head >> 2) * 128, N_QKV0, nkeys, lane, o0, o1);
      const float rt = r < CTXL ? 0.15f : 0.05f, at_ = r < CTXL ? 0.04f : 0.01f;
      bad = !dclose(bf2f(X2[(size_t)r * D + head * 128 + lane]), o0, rt, at_) + !dclose(bf2f(X2[(size_t)r * D + head * 128 + 64 + lane]), o1, rt, at_);
      bad = (int)wave_sum((float)bad); dflag(dg, r < CTXL ? 26 : 7, bad, lane); }
  } else if (k == 5 || k == 15) {
    const int r = pick_row(h, ROW0, NTOK), c = h2 % D; const float ref = wdot(X2 + (size_t)r * D, L == 0 ? a.in[8] : a.in[16], D, c, D, lane);
    bad = !dclose(bf2f(OUT[(size_t)r * D + c]), ref, 0.02f, 0.05f); dflag(dg, L == 0 ? 8 : 19, bad, lane);
  } else if (k == 6 || k == 16) {
    const int r = pick_row(h, ROW0, NTOK); const float* mod = MOD + (size_t)(L * 2) * 12288 + (r < CTXL ? 12288 : 0); const float* ng = a.in[6] + (size_t)L * 4 * D;
    float ss = 0; for (int d = lane; d < D; d += 64) { const float o = bf2f(OUT[(size_t)r * D + d]); ss += o * o; } ss = wave_sum(ss); const float rstd1 = rsqrtf(ss / D + EPS);
    bad = 0;
    if (L == 0) { const float* x = h0row(a, r); for (int d = lane; d < D; d += 64) { const float ref = x[d] + mod[2 * D + d] * (bf2f(OUT[(size_t)r * D + d]) * rstd1 * ng[D + d]); bad += !dclose(HRES[(size_t)r * D + d], ref, 1e-3f, 1e-3f); } }
    float s2 = 0; for (int d = lane; d < D; d += 64) { const float x = HRES[(size_t)r * D + d]; s2 += x * x; } s2 = wave_sum(s2); const float rstd2 = rsqrtf(s2 / D + EPS);
    for (int d = lane; d < D; d += 64) { const float f = HRES[(size_t)r * D + d] * rstd2 * ng[2 * D + d] * (1.f + mod[4 * D + d]) + mod[3 * D + d]; fsh[wv][d] = f; bad += !dclose(dq8((const unsigned char*)AB + (size_t)r * D, d), f, 0.07f, 0.01f); }
    bad = (int)wave_sum((float)bad); dflag(dg, L == 0 ? 9 : 20, bad, lane);
    __syncthreads();
    float lg = 0; for (int d = 0; d < D; ++d) lg += fsh[wv][d] * a.in[19][((size_t)L * D + d) * NE + lane];
    const float sc = sigmoidf_(lg); csh[wv][lane] = sc + a.in[20][L * NE + lane];
    __syncthreads();
    { const float plg = ((const float*)(a.ws + WS_Y))[(size_t)r * 64 + lane]; int lb = !dclose(plg, lg, 1e-3f, 1e-3f); lb = (int)wave_sum((float)lb); if (lane == 0 && lb) { atomicAdd(&dg[32 + (L == 0 ? 10 : 21) + 3], 1); atomicOr(&dg[60], 1 << (r & 7)); } }
    unsigned long long wsel;
    { const float choice = csh[wv][lane]; int rank = 0; const int gl = lane & 7;
      for (int j = 0; j < 8; ++j) { const float o = __shfl(choice, (lane & ~7) | j); rank += (o > choice || (o == choice && j < gl)) ? 1 : 0; }
      float gs = rank < 2 ? choice : 0.f; gs += __shfl_xor(gs, 1); gs += __shfl_xor(gs, 2); gs += __shfl_xor(gs, 4);
      int grank = 0; const int g = lane >> 3;
      for (int j = 0; j < 8; ++j) { const float o = __shfl(gs, j * 8); grank += (o > gs || (o == gs && j < g)) ? 1 : 0; }
      const bool gsel = grank < 4; const float mc = gsel ? choice : -INFINITY; int erank = 0;
      for (int j = 0; j < 64; ++j) { const float o = __shfl(mc, j); erank += (o > mc || (o == mc && j < lane)) ? 1 : 0; }
      wsel = __ballot(gsel && erank < 8); }
    int setbad = 0;
    if (lane == 0) {
      float gsc[8]; for (int g = 0; g < 8; ++g) { float m1 = -1e30f, m2 = -1e30f; for (int j = 0; j < 8; ++j) { const float v = csh[wv][g * 8 + j]; if (v > m1) { m2 = m1; m1 = v; } else if (v > m2) m2 = v; } gsc[g] = m1 + m2; }
      bool gs[8] = {false, false, false, false, false, false, false, false};
      for (int t = 0; t < 4; ++t) { int bi = 0; float bv = -1e30f; for (int g = 0; g < 8; ++g) if (!gs[g] && gsc[g] > bv) { bv = gsc[g]; bi = g; } gs[bi] = true; }
      unsigned long long selm = 0; for (int t = 0; t < 8; ++t) { int bi = 0; float bv = -1e30f; for (int e = 0; e < 64; ++e) if (gs[e >> 3] && !((selm >> e) & 1ull) && csh[wv][e] > bv) { bv = csh[wv][e]; bi = e; } selm |= 1ull << bi; }
      unsigned long long got = 0; for (int t = 0; t < 8; ++t) { const int e = top_e[r * 8 + t]; if (e < 0 || e > 63) setbad = 1000; else got |= 1ull << e; }
      if (setbad == 0 && got != selm) setbad = 1;
      if (wsel != selm) atomicAdd(&dg[32 + (L == 0 ? 10 : 21) + 4], 1);
    }
    setbad = __shfl(setbad, 0);
    { float wgot = -1.f; int mine = 0; for (int t = 0; t < 8; ++t) if (top_e[r * 8 + t] == lane) { mine = 1; wgot = top_w[r * 8 + t]; }
      const float ssum = wave_sum(mine ? sc : 0.f);
      int wbad = (mine && !dclose(wgot, sc / ssum * 2.5f, 0.01f, 1e-3f)) ? 1 : 0; wbad = (int)wave_sum((float)wbad);
      if (lane == 0) { int* q = &dg[32 + (L == 0 ? 10 : 21)]; if (setbad >= 1000) atomicAdd(q + 1, 1); else if (setbad) atomicAdd(q, 1); else if (wbad) atomicAdd(q + 2, 1); } }
  } else if (k == 7 || k == 17) {
    const int r = pick_row(h, ROW0, NTOK), t = h2 % 8, q = r * 8 + t; const int slot = tslot[q], e = top_e[q];
    int ts0 = 0; for (int j = 0; j < e; ++j) ts0 += (counts[j] + 255) >> 8;
    bad = (slot < ts0 * 256 || slot >= ts0 * 256 + counts[e] || stok[slot] != r || top_p[q] != slot - ts0 * 256) ? 1 : 0;
    bad += (stok[SH_BASE + r - ROW0] != r) ? 1 : 0;
    dflag(dg, L == 0 ? 11 : 22, bad, lane);
  } else if (k == 8 || k == 18 || k == 9 || k == 19) {
    int TR = 0; for (int j = 0; j < 64; ++j) TR += (counts[j] + 255) >> 8;
    int slot, e;
    if ((h & 3) == 0) { slot = SH_BASE + (int)((h >> 2) % (unsigned)NTOK); e = 64; }
    else { e = (h >> 2) % 64; int guard = 0; while (counts[e] == 0 && guard++ < 64) e = (e + 1) % 64; int ts0 = 0; for (int j = 0; j < e; ++j) ts0 += (counts[j] + 255) >> 8;
      const unsigned m = (h >> 8) % 4; const int cnt = counts[e]; const int p = m == 0 ? 0 : m == 1 ? cnt - 1 : (int)((h >> 10) % (unsigned)cnt); slot = ts0 * 256 + p; }
    const int tok = stok[slot];
    if (k == 8 || k == 18) {
      const int ch = h2 % EFF;
      const float* Wg = e < 64 ? a.in[21] + ((size_t)L * 64 + e) * D * EFF : a.in[24] + (size_t)L * D * EFF;
      const float* Wu = e < 64 ? a.in[22] + ((size_t)L * 64 + e) * D * EFF : a.in[25] + (size_t)L * D * EFF;
      const unsigned char* F8 = (const unsigned char*)AB + (size_t)tok * D;
      const float gv = wdot8(F8, Wg, EFF, ch, D, lane), uv = wdot8(F8, Wu, EFF, ch, D, lane);
      bad = !dclose(dq8((const unsigned char*)ACT + (size_t)slot * EFF, ch), gv * sigmoidf_(gv) * uv, 0.2f, 0.15f); dflag(dg, L == 0 ? 12 : 23, bad, lane);
    } else {
      const int c = h2 % D; const float* Wd = e < 64 ? a.in[23] + ((size_t)L * 64 + e) * EFF * D : a.in[26] + (size_t)L * EFF * D;
      const float ref = wdot8((const unsigned char*)ACT + (size_t)slot * EFF, Wd, D, c, EFF, lane);
      bad = !dclose(dq8((const unsigned char*)Y + (size_t)slot * D, c) * (1.f / 16.f), ref, 0.2f, 0.15f); dflag(dg, L == 0 ? 13 : 24, bad, lane);
    }
  } else if (k == 10 || k == 20) {
    const int r = pick_row(h, ROW0, NTOK); const float* mod = MOD + (size_t)(L * 2) * 12288 + (r < CTXL ? 12288 : 0); const float* ng = a.in[6] + (size_t)L * 4 * D;
    float ss = 0; for (int d = lane; d < D; d += 64) { const unsigned char* Y8 = (const unsigned char*)Y; float y = dq8(Y8 + (size_t)(SH_BASE + r - ROW0) * D, d) * (1.f / 16.f); for (int t = 0; t < 8; ++t) y += top_w[r * 8 + t] * dq8(Y8 + (size_t)tslot[r * 8 + t] * D, d) * (1.f / 16.f); fsh[wv][d] = y; ss += y * y; }
    ss = wave_sum(ss); const float rstd = rsqrtf(ss / D + EPS);
    bad = 0;
    if (L == 0) { float s2 = 0; for (int d = lane; d < D; d += 64) { const float x = HRES[(size_t)r * D + d]; s2 += x * x; } s2 = wave_sum(s2); const float rstd2 = rsqrtf(s2 / D + EPS);
      const float* mod1 = MOD + (size_t)2 * 12288 + (r < CTXL ? 12288 : 0);
      for (int d = lane; d < D; d += 64) { const float ref = HRES[(size_t)r * D + d] * rstd2 * a.in[6][4 * D + d] * (1.f + mod1[D + d]) + mod1[d]; bad += !dclose(bf2f(AB[(size_t)r * D + d]), ref, 0.01f, 0.01f); } }
    else { for (int d = lane; d < D; d += 64) { const float ref = HRES[(size_t)r * D + d] + mod[5 * D + d] * (fsh[wv][d] * rstd * ng[3 * D + d]); bad += !dclose(a.out[(size_t)(r - CTXL) * D + d], ref, 1e-3f, 1e-3f); } }
    bad = (int)wave_sum((float)bad); dflag(dg, L == 0 ? 14 : 25, bad, lane);
  } else if (k == 12) {
    const int r = pick_row(h, CTXL, SEQ), hh = h2 % 32;
    float raw0 = 0, raw1 = 0;
    for (int d = 0; d < 128; ++d) { const float v = wdot(AB + (size_t)r * D, a.in[15], N_IN1, hh * 128 + d, D, lane); if (d == lane) raw0 = v; if (d == lane + 64) raw1 = v; }
    float cs, sn; rope_cs(r, lane, cs, sn);
    const float cs0 = __shfl(cs, lane & 31), sn0 = __shfl(sn, lane & 31), cs1 = __shfl(cs, 32 + (lane & 31)), sn1 = __shfl(sn, 32 + (lane & 31));
    const float p0 = __shfl_xor(raw0, 32), p1 = __shfl_xor(raw1, 32);
    const float o0 = (lane < 32) ? raw0 * cs0 - p0 * sn0 : raw0 * cs0 + p0 * sn0;
    const float o1 = (lane < 32) ? raw1 * cs1 - p1 * sn1 : raw1 * cs1 + p1 * sn1;
    bad = !dclose(bf2f(QK[(size_t)r * N_IN1 + hh * 128 + lane]), o0, 0.03f, 0.05f) + !dclose(bf2f(QK[(size_t)r * N_IN1 + hh * 128 + 64 + lane]), o1, 0.03f, 0.05f);
    bad = (int)wave_sum((float)bad); dflag(dg, 16, bad, lane);
  } else if (k == 13) {
    if (gw < 64) { const int r = pick_row(h, CTXL, SEQ), hc = h2 % 16, vh = (h2 >> 4) & 1, hd = hc >> 1;
      float o0, o1; naive_attn(QK + (size_t)r * N_IN1 + hc * 128, QK + 2048 + hc * 128, QK + 4096 + hd * 256 + vh * 128, N_IN1, MT, lane, o0, o1);
      const bf16_t* O = Y + (size_t)(r - CTXL) * 4096 + hc * 256 + vh * 128;
      bad = !dclose(bf2f(O[lane]), o0, 0.05f, 0.01f) + !dclose(bf2f(O[64 + lane]), o1, 0.05f, 0.01f);
      bad = (int)wave_sum((float)bad); dflag(dg, 17, bad, lane); }
  } else if (k == 14) {
    const int r = pick_row(h, CTXL, SEQ), hd = h2 % 8; const float* lp = a.in[17];
    float s1 = 0, s2 = 0; for (int i = lane; i < 128; i += 64) { s1 += lp[i] * lp[128 + i]; s2 += lp[256 + i] * lp[384 + i]; } s1 = wave_sum(s1); s2 = wave_sum(s2);
    const float lam = expf(s1) - expf(s2) + LAM_INIT; const bf16_t* O = Y + (size_t)(r - CTXL) * 4096;
    float dv[4], ss = 0; for (int i = 0; i < 4; ++i) { const int d = lane + 64 * i; dv[i] = bf2f(O[(2 * hd) * 256 + d]) - lam * bf2f(O[(2 * hd + 1) * 256 + d]); ss += dv[i] * dv[i]; }
    ss = wave_sum(ss); const float rstd = rsqrtf(ss / 256.f + EPS) * (1.f - LAM_INIT); bad = 0;
    for (int i = 0; i < 4; ++i) { const int d = lane + 64 * i; bad += !dclose(bf2f(X2[(size_t)r * D + hd * 256 + d]), dv[i] * rstd * a.in[18][d], 0.02f, 0.01f); }
    bad = (int)wave_sum((float)bad); dflag(dg, 18, bad, lane);
  }
}
__global__ void diag_encode(Args a) {
  const int* dg = (const int*)(a.ws + WS_CTL + CTL_CNT + 512);
  int s = 0;
  int sub = 0;
  for (int i = 1; i < 32; ++i) { int v = dg[i]; if (i == 10 || i == 21) { v = (dg[32 + i] > 25 ? 1 : 0) + (dg[33 + i] > 0 ? 2 : 0) + (dg[34 + i] > 0 ? 4 : 0) + (dg[35 + i] > 0 ? 8 : 0) + (dg[36 + i] > 0 ? 16 : 0); sub = v; } if (v) { s = i; break; } }
  if (s == 0) return;
  const float c = sub ? 30.f + 8.f * sub : 10.f * s;
  for (size_t i = (size_t)blockIdx.x * blockDim.x + threadIdx.x; i < (size_t)SEQ * D; i += (size_t)gridDim.x * blockDim.x) a.out[i] = c;
}
#endif

extern "C" void kernel_launch(void* const* d_in, const int* in_sizes, int n_in, void* d_out, int out_size, void* d_ws, size_t ws_size, hipStream_t stream) {
  static int grid = 0;
  if (grid == 0) {
    if (n_in != 27 || out_size != SEQ * D || ws_size < WS_END) { fprintf(stderr, "kernel_launch: unexpected shapes (n_in %d out %d ws %zu need %zu)\n", n_in, out_size, ws_size, (size_t)WS_END); grid = -1; return; }
    if (hipFuncSetAttribute((const void*)fwd, hipFuncAttributeMaxDynamicSharedMemorySize, LDS_BYTES) != hipSuccess) { fprintf(stderr, "kernel_launch: hipFuncSetAttribute failed\n"); grid = -1; return; }
    int dev = 0, cus = 0, per_cu = 0;
    hipGetDevice(&dev); hipDeviceGetAttribute(&cus, hipDeviceAttributeMultiprocessorCount, dev);
    if (hipOccupancyMaxActiveBlocksPerMultiprocessor(&per_cu, (const void*)fwd, NTHREADS, LDS_BYTES) != hipSuccess || per_cu < 1) fprintf(stderr, "kernel_launch: occupancy query says %d\n", per_cu);
    (void)hipGetLastError();
    grid = cus < 256 ? cus : 256;
    if (grid != 256) fprintf(stderr, "kernel_launch: %d CUs (expected 256)\n", cus);
  }
  if (grid < 0) return;
  hipMemsetAsync((char*)d_ws + WS_CTL, 0, CTL_BYTES, stream);
  Args a{};
  for (int i = 0; i < 27; ++i) a.in[i] = (const float*)d_in[i];
  a.out = (float*)d_out; a.ws = (unsigned char*)d_ws;
#if MK_MULTI
  for (int k = 0; k < NPH; ++k) { a.ph_lo = k; a.ph_hi = k + 1; hipLaunchKernelGGL(fwd, dim3(grid), dim3(NTHREADS), LDS_BYTES, stream, a);
#if MK_DIAG
    hipLaunchKernelGGL(diag, dim3(64), dim3(256), 0, stream, a, k);
#endif
  }
#if MK_DIAG
  hipLaunchKernelGGL(diag_encode, dim3(1024), dim3(256), 0, stream, a);
#endif
#else
  a.ph_lo = 0; a.ph_hi = NPH;
  hipLaunchKernelGGL(fwd, dim3(grid), dim3(NTHREADS), LDS_BYTES, stream, a);
#endif
  const hipError_t le = hipPeekAtLastError();
  if (le != hipSuccess) fprintf(stderr, "kernel_launch: launch failed: %s\n", hipGetErrorName(le));
}
```

```cpp
#include <hip/hip_runtime.h>
#include <cstdio>
#include <cstdint>

#define MK_DIAG 0
#ifndef DENSE8_G2
#define DENSE8_G2 0
#endif
#ifndef MK_MULTI
#define MK_MULTI 0
#endif

#define LAS __attribute__((address_space(3)))
typedef unsigned short bf16_t;
typedef short bf16x8 __attribute__((ext_vector_type(8)));
typedef short s16x4 __attribute__((ext_vector_type(4)));
typedef float f32x4 __attribute__((ext_vector_type(4)));
typedef float f32x2 __attribute__((ext_vector_type(2)));
typedef float f32x16 __attribute__((ext_vector_type(16)));
typedef unsigned u32x4 __attribute__((ext_vector_type(4)));
typedef unsigned u32x2 __attribute__((ext_vector_type(2)));

constexpr int D = 2048, SEQ = 16384, CTXL = 256, MT = SEQ + CTXL;
constexpr int NE = 64, TOPK = 8, EFF = 512;
constexpr int N_IN0 = 3584, N_QKV0 = 1536, N_IN1 = 6144;
constexpr float EPS = 1e-6f;
constexpr float LAM_INIT = 0.35550907f;
constexpr int SH_BASE = SEQ * 0 + (MT * TOPK) + NE * 256;
constexpr int NSLOT = SH_BASE + MT;
constexpr int NTHREADS = 512;
constexpr int LDS_BYTES = 131072 + 1024;
constexpr int LDS_CTL = 131072;

constexpr size_t al256(size_t x) { return (x + 255) & ~(size_t)255; }
constexpr size_t WS_CTL   = 0;
constexpr size_t CTL_BYTES = 32768;
constexpr size_t CTL_CNT  = 16384;
constexpr size_t CTL_KMAX = 16384 + 2048;
constexpr size_t WS_MOD   = CTL_BYTES;
constexpr size_t WS_WIN0  = al256(WS_MOD + 2 * 2 * 12288 * 4);
constexpr size_t WS_WOUT0 = al256(WS_WIN0 + (size_t)N_IN0 * D * 2);
constexpr size_t WS_WIN1  = al256(WS_WOUT0 + (size_t)D * D * 2);
constexpr size_t WS_WOUT1 = al256(WS_WIN1 + (size_t)N_IN1 * D * 2);
constexpr size_t WMOE_E   = (size_t)1024 * D + (size_t)D * EFF;
constexpr size_t WS_WMOE  = al256(WS_WOUT1 + (size_t)D * D * 2);
constexpr size_t WS_HRES  = al256(WS_WMOE + 65 * WMOE_E * 2);
constexpr size_t WS_ABUF  = al256(WS_HRES + (size_t)MT * D * 4);
constexpr size_t WS_QKVU  = al256(WS_ABUF + (size_t)MT * D * 2);
constexpr size_t WS_HG    = al256(WS_QKVU + (size_t)MT * N_IN1 * 2);
constexpr size_t WS_X2    = al256(WS_HG + (size_t)MT * 1024 * 2);
constexpr size_t WS_OUT   = al256(WS_X2 + (size_t)MT * D * 2);
constexpr size_t WS_ACT   = al256(WS_OUT + (size_t)MT * D * 2);
constexpr size_t WS_K8    = WS_ACT + al256((size_t)NSLOT * EFF);
constexpr size_t WS_Y     = al256(WS_ACT + (size_t)NSLOT * EFF * 2);
constexpr size_t WS_TOPE  = al256(WS_Y + (size_t)NSLOT * D * 2);
constexpr size_t WS_TOPW  = al256(WS_TOPE + (size_t)MT * TOPK * 4);
constexpr size_t WS_TOPP  = al256(WS_TOPW + (size_t)MT * TOPK * 4);
constexpr size_t WS_TSLOT = al256(WS_TOPP + (size_t)MT * TOPK * 4);
constexpr size_t WS_STOK  = al256(WS_TSLOT + (size_t)MT * TOPK * 4);
constexpr size_t WS_END   = al256(WS_STOK + (size_t)NSLOT * 4);

struct Args { const float* in[27]; float* out; unsigned char* ws; int ph_lo, ph_hi; };

__device__ __forceinline__ float bflo(unsigned x) { return __uint_as_float(x << 16); }
__device__ __forceinline__ float bfhi(unsigned x) { return __uint_as_float(x & 0xffff0000u); }
__device__ __forceinline__ float bf2f(bf16_t b) { return __uint_as_float(((unsigned)b) << 16); }
__device__ __forceinline__ unsigned cvtpk(float lo, float hi) { unsigned r; asm("v_cvt_pk_bf16_f32 %0, %1, %2" : "=v"(r) : "v"(lo), "v"(hi)); return r; }
__device__ __forceinline__ bf16_t f2bf(float x) { return (bf16_t)(cvtpk(x, 0.f) & 0xffffu); }
__device__ __forceinline__ float wave_sum(float v) {
#pragma unroll
  for (int o = 32; o; o >>= 1) v += __shfl_xor(v, o);
  return v;
}
__device__ __forceinline__ float sigmoidf_(float x) { return 1.f / (1.f + expf(-x)); }
__device__ __forceinline__ float sigmoid_fast(float x) { return __builtin_amdgcn_rcpf(1.f + __builtin_amdgcn_exp2f(-1.4426950408889634f * x)); }

__device__ __forceinline__ float clamp8e(float x) { return fminf(fmaxf(x, -448.f), 448.f); }
__device__ __forceinline__ unsigned pack8x4(float a, float b, float c, float d) {
  int p = __builtin_amdgcn_cvt_pk_fp8_f32(clamp8e(a), clamp8e(b), 0, false); p = __builtin_amdgcn_cvt_pk_fp8_f32(clamp8e(c), clamp8e(d), p, true); return (unsigned)p; }
__device__ __forceinline__ float sq8x4(unsigned p) {
  const float a = __builtin_amdgcn_cvt_f32_fp8((int)p, 0), b = __builtin_amdgcn_cvt_f32_fp8((int)p, 1), c = __builtin_amdgcn_cvt_f32_fp8((int)p, 2), d = __builtin_amdgcn_cvt_f32_fp8((int)p, 3);
  return a * a + b * b + c * c + d * d; }
typedef int v8i_ __attribute__((ext_vector_type(8)));
typedef int v4i __attribute__((ext_vector_type(4)));
#define XB_TMO      128
#define XB_XCNT(j)  (256  + 64 * (j))
#define XB_XSUB(j)  (1280 + 64 * (j))
#define XB_XGEN(j)  (2304 + 64 * (j))
#define XB_TOP      3328
#define XB_TOPGEN   3392
#define XCD_BAR_WORDS 3456
#define XB_SPIN_CAP (1u << 22)
__device__ __forceinline__ unsigned xb_ld(unsigned* p)              { return __hip_atomic_load(p, __ATOMIC_RELAXED, __HIP_MEMORY_SCOPE_AGENT); }
__device__ __forceinline__ unsigned xb_add(unsigned* p, unsigned v) { return __hip_atomic_fetch_add(p, v, __ATOMIC_RELAXED, __HIP_MEMORY_SCOPE_AGENT); }
__device__ __forceinline__ unsigned xb_xcc_id() { return (unsigned)__builtin_amdgcn_s_getreg((3 << 11) | 20) & 0xFu; }
#define XB_SPIN(cond, bar) do { unsigned _sp = 0; while (cond) { __builtin_amdgcn_s_sleep(1); \
    if ((++_sp & 255u) == 0u) { if (xb_ld(&(bar)[XB_TMO])) break; if (_sp > XB_SPIN_CAP) { atomicAdd(&(bar)[XB_TMO], 1u); break; } } } } while (0)
struct XcdBarrier { unsigned* bar; unsigned x; volatile LAS unsigned* st; };
__device__ __forceinline__ XcdBarrier xcd_barrier_post(unsigned* bar, volatile LAS unsigned* st) {
    XcdBarrier b; b.bar = bar; b.x = xb_xcc_id(); b.st = st;
    if (threadIdx.x == 0) (void)xb_add(&bar[XB_XCNT(b.x)], 1u);
    return b;
}
__device__ __forceinline__ void xcd_barrier_complete(unsigned* bar, unsigned x, unsigned& nloc, unsigned& nx) {
    const unsigned G = gridDim.x * gridDim.y * gridDim.z;
    unsigned sum, cnt, mine, sp = 0u;
    for (;;) {
        sum = 0u; cnt = 0u; mine = 0u;
#pragma unroll
        for (unsigned j = 0; j < 16; ++j) { const unsigned c = xb_ld(&bar[XB_XCNT(j)]); sum += c; cnt += (c > 0u) ? 1u : 0u; mine = (j == x) ? c : mine; }
        if (sum == G) break;
        __builtin_amdgcn_s_sleep(1);
        if ((++sp & 255u) == 0u) { if (xb_ld(&bar[XB_TMO])) break; if (sp > XB_SPIN_CAP) { atomicAdd(&bar[XB_TMO], 1u); break; } }
    }
    nloc = mine > 0u ? mine : 1u; nx = cnt > 0u ? cnt : 1u;
}
__device__ __forceinline__ void xcd_barrier(const XcdBarrier& b) {
    asm volatile("s_waitcnt vmcnt(0)" ::: "memory");
    __syncthreads();
    if (threadIdx.x == 0) {
        unsigned* bar = b.bar;
        __builtin_amdgcn_s_waitcnt(0);
        unsigned nloc = b.st[0], nx = b.st[1];
        if (nloc == 0u) { xcd_barrier_complete(bar, b.x, nloc, nx); b.st[0] = nloc; b.st[1] = nx; }
        const unsigned old = xb_add(&bar[XB_XSUB(b.x)], 1u);
        const unsigned gen = old / nloc;
        if (old + 1u == (gen + 1u) * nloc) {
            __builtin_amdgcn_fence(__ATOMIC_RELEASE, "agent");
            asm volatile("s_waitcnt vmcnt(0)" ::: "memory");
            const unsigned og = xb_add(&bar[XB_TOP], 1u);
            const unsigned tg = og / nx;
            if (og + 1u == (tg + 1u) * nx) xb_add(&bar[XB_TOPGEN], 1u);
            else XB_SPIN(xb_ld(&bar[XB_TOPGEN]) == tg, bar);
            __builtin_amdgcn_fence(__ATOMIC_ACQUIRE, "agent");
            xb_add(&bar[XB_XGEN(b.x)], 1u);
            asm volatile("s_waitcnt vmcnt(0)" ::: "memory");
        } else {
            XB_SPIN(xb_ld(&bar[XB_XGEN(b.x)]) == gen, bar);
            __builtin_amdgcn_fence(__ATOMIC_ACQUIRE, "agent");
            asm volatile("s_waitcnt vmcnt(0)" ::: "memory");
        }
    }
    __syncthreads();
}

__device__ __forceinline__ int lds_byte(int r, int c) {
  int st = (r >> 4) * 2 + (c >> 5), rr = r & 15, cc = c & 31, ob = rr * 64 + cc * 2;
  return st * 1024 + (ob ^ (((ob >> 9) & 1) << 5));
}
#define GLDS(gp, lp) __builtin_amdgcn_global_load_lds((const unsigned*)(gp), (LAS unsigned*)(lp), 16, 0, 0)
#define WAIT_V(n) asm volatile("s_waitcnt vmcnt(" #n ")" ::: "memory")
#define WAIT_L(n) asm volatile("s_waitcnt lgkmcnt(" #n ")" ::: "memory")
#define BAR __builtin_amdgcn_s_barrier()
#define SCHED __builtin_amdgcn_sched_barrier(0)

template <bool GATHER, class Epi>
__device__ __forceinline__ void gemm_tile(const bf16_t* __restrict__ A, const int lda, const int* __restrict__ tok, const int brow,
                                          const bf16_t* __restrict__ Bt, const int ldb, const int bcol, const int K,
                                          LAS char* shm, const Epi& epi) {
#define G_SA(b, h) (shm + ((b) * 2 + (h)) * 16384)
#define G_SB(b, h) (shm + (4 + (b) * 2 + (h)) * 16384)
  int tid = threadIdx.x; asm volatile("" : "+v"(tid)); tid &= 511;
  int wid = tid >> 6, lane = tid & 63, wr = wid >> 2, wc = wid & 3, fr = lane & 15, fq = lane >> 4;
  unsigned ao0, ao1, ao2, ao3, bo;
  {
    const int sb = (tid & 63) * 16, swz = sb ^ (((sb >> 9) & 1) << 5);
    const int R0 = ((tid >> 6) >> 1) * 16 + (swz >> 6), C0 = ((tid >> 6) & 1) * 32 + ((swz & 63) >> 1);
    if (GATHER) { ao0 = (unsigned)(tok[R0] * lda + C0); ao1 = (unsigned)(tok[R0 + 64] * lda + C0); ao2 = (unsigned)(tok[R0 + 128] * lda + C0); ao3 = (unsigned)(tok[R0 + 192] * lda + C0); }
    else { ao0 = (unsigned)((brow + R0) * lda + C0); ao1 = ao0 + 64u * lda; ao2 = ao0 + 128u * lda; ao3 = ao0 + 192u * lda; }
    bo = (unsigned)((bcol + R0) * ldb + C0);
  }
  const int lo = __builtin_amdgcn_readfirstlane(tid >> 6) * 1024;
#define STAGE_A0(P, kt) do { GLDS((A + (kt) * 64) + ao0, (P) + lo); GLDS((A + (kt) * 64) + ao1, (P) + lo + 8192); } while (0)
#define STAGE_A1(P, kt) do { GLDS((A + (kt) * 64) + ao2, (P) + lo); GLDS((A + (kt) * 64) + ao3, (P) + lo + 8192); } while (0)
#define STAGE_B0(P, kt) do { GLDS((Bt + (kt) * 64) + bo, (P) + lo); GLDS((Bt + 64 * ldb + (kt) * 64) + bo, (P) + lo + 8192); } while (0)
#define STAGE_B1(P, kt) do { GLDS((Bt + 128 * ldb + (kt) * 64) + bo, (P) + lo); GLDS((Bt + 192 * ldb + (kt) * 64) + bo, (P) + lo + 8192); } while (0)
#define LDA(dst, b, h) _Pragma("unroll") for (int m = 0; m < 4; ++m) _Pragma("unroll") for (int k = 0; k < 2; ++k) \
    dst[m][k] = *(LAS const bf16x8*)(G_SA(b, h) + lds_byte(wr * 64 + m * 16 + fr, k * 32 + fq * 8))
#define LDB(dst, b, h) _Pragma("unroll") for (int n = 0; n < 2; ++n) _Pragma("unroll") for (int k = 0; k < 2; ++k) \
    dst[n][k] = *(LAS const bf16x8*)(G_SB(b, h) + lds_byte(wc * 32 + n * 16 + fr, k * 32 + fq * 8))
#define MMA(ai, bj, At_, Bt_) do { __builtin_amdgcn_s_setprio(1); \
    _Pragma("unroll") for (int m = 0; m < 4; ++m) _Pragma("unroll") for (int n = 0; n < 2; ++n) _Pragma("unroll") for (int k = 0; k < 2; ++k) \
      acc[ai][bj][m][n] = __builtin_amdgcn_mfma_f32_16x16x32_bf16(Bt_[n][k], At_[m][k], acc[ai][bj][m][n], 0, 0, 0); \
    __builtin_amdgcn_s_setprio(0); } while (0)

  f32x4 acc[2][2][4][2] = {};
  bf16x8 At[4][2], B0[2][2], B1[2][2];
  const int nt = K / 64;
  STAGE_B0(G_SB(0, 0), 0); STAGE_A0(G_SA(0, 0), 0);
  STAGE_B1(G_SB(0, 1), 0); STAGE_A1(G_SA(0, 1), 0);
  if (wr == 1) BAR;
  WAIT_V(4); BAR;
  STAGE_B0(G_SB(1, 0), 1); STAGE_A0(G_SA(1, 0), 1); STAGE_B1(G_SB(1, 1), 1);
  WAIT_V(6); BAR;
  for (int t = 0; t < nt - 2; t += 2) {
    LDB(B0, 0, 0); SCHED; LDA(At, 0, 0); STAGE_A1(G_SA(1, 1), t + 1);
    WAIT_L(8); BAR; WAIT_L(0); MMA(0, 0, At, B0); BAR; SCHED;
    LDB(B1, 0, 1); STAGE_B0(G_SB(0, 0), t + 2);
    BAR; WAIT_L(0); MMA(0, 1, At, B1); BAR;
    LDA(At, 0, 1); STAGE_A0(G_SA(0, 0), t + 2);
    BAR; WAIT_L(0); MMA(1, 0, At, B0); BAR; SCHED;
    STAGE_B1(G_SB(0, 1), t + 2);
    WAIT_V(6); BAR; MMA(1, 1, At, B1); BAR;
    LDB(B0, 1, 0); SCHED; LDA(At, 1, 0); STAGE_A1(G_SA(0, 1), t + 2);
    WAIT_L(8); BAR; WAIT_L(0); MMA(0, 0, At, B0); BAR; SCHED;
    LDB(B1, 1, 1); STAGE_B0(G_SB(1, 0), t + 3);
    BAR; WAIT_L(0); MMA(0, 1, At, B1); BAR;
    LDA(At, 1, 1); STAGE_A0(G_SA(1, 0), t + 3);
    BAR; WAIT_L(0); MMA(1, 0, At, B0); BAR; SCHED;
    STAGE_B1(G_SB(1, 1), t + 3);
    WAIT_V(6); BAR; MMA(1, 1, At, B1); BAR;
  }
  { LDB(B0, 0, 0); WAIT_V(0); LDA(At, 0, 0); STAGE_A1(G_SA(1, 1), nt - 1);
    BAR; WAIT_L(0); MMA(0, 0, At, B0); BAR;
    LDB(B1, 0, 1); BAR; WAIT_L(0); MMA(0, 1, At, B1); BAR;
    LDA(At, 0, 1); WAIT_V(4); BAR; WAIT_L(0); MMA(1, 0, At, B0); MMA(1, 1, At, B1); BAR; }
  { LDB(B0, 1, 0); LDA(At, 1, 0); WAIT_V(2); BAR; WAIT_L(0); MMA(0, 0, At, B0); BAR;
    LDB(B1, 1, 1); WAIT_V(0); BAR; WAIT_L(0); MMA(0, 1, At, B1); BAR;
    LDA(At, 1, 1); BAR; WAIT_L(0); MMA(1, 0, At, B0); MMA(1, 1, At, B1); BAR; }
  if (wr == 0) BAR;
  int tz = threadIdx.x; asm volatile("" : "+v"(tz)); wid = tz >> 6; lane = tz & 63; wr = wid >> 2; wc = wid & 3; fr = lane & 15; fq = lane >> 4;
  epi(acc, brow, bcol, wr, wc, fr, fq);
#undef G_SA
#undef G_SB
#undef STAGE_A0
#undef STAGE_A1
#undef STAGE_B0
#undef STAGE_B1
#undef LDA
#undef LDB
#undef MMA
}

struct EpiPlain {
  bf16_t* C; int ldc; float sc;
  __device__ __forceinline__ void operator()(const f32x4 (&acc)[2][2][4][2], int brow, int bcol, int wr, int wc, int fr, int fq) const {
#pragma unroll
    for (int ai = 0; ai < 2; ++ai)
#pragma unroll
      for (int m = 0; m < 4; ++m) {
        bf16_t* rp = C + (size_t)(brow + ai * 128 + wr * 64 + m * 16 + fr) * ldc + bcol + wc * 32 + fq * 8;
#pragma unroll
        for (int bj = 0; bj < 2; ++bj) {
          u32x4 v = {cvtpk(acc[ai][bj][m][0][0] * sc, acc[ai][bj][m][0][1] * sc), cvtpk(acc[ai][bj][m][0][2] * sc, acc[ai][bj][m][0][3] * sc),
                     cvtpk(acc[ai][bj][m][1][0] * sc, acc[ai][bj][m][1][1] * sc), cvtpk(acc[ai][bj][m][1][2] * sc, acc[ai][bj][m][1][3] * sc)};
          *(u32x4*)(rp + bj * 128) = v;
        }
      }
  }
};
template <int MODE>
struct EpiPair {
  bf16_t* C; int ldc; int colbase; float sc;
  __device__ __forceinline__ void operator()(const f32x4 (&acc)[2][2][4][2], int brow, int bcol, int wr, int wc, int fr, int fq) const {
#pragma unroll
    for (int ai = 0; ai < 2; ++ai)
#pragma unroll
      for (int m = 0; m < 4; ++m) {
        bf16_t* rp = C + (size_t)(brow + ai * 128 + wr * 64 + m * 16 + fr) * ldc + ((bcol - colbase) >> 1) + wc * 16 + fq * 4;
#pragma unroll
        for (int bj = 0; bj < 2; ++bj) {
          float r[4];
#pragma unroll
          for (int j = 0; j < 4; ++j) {
            const float x0 = acc[ai][bj][m][0][j] * sc, x1 = acc[ai][bj][m][1][j] * sc;
            r[j] = MODE == 0 ? x0 * sigmoid_fast(x1) : x0 * sigmoid_fast(x0) * x1;
          }
          u32x2 v = {cvtpk(r[0], r[1]), cvtpk(r[2], r[3])};
          *(u32x2*)(rp + bj * 64) = v;
        }
      }
  }
};
struct EpiG1 {
  EpiPlain p; EpiPair<0> g; int nplain;
  __device__ __forceinline__ void operator()(const f32x4 (&acc)[2][2][4][2], int brow, int bcol, int wr, int wc, int fr, int fq) const {
    if (bcol < nplain) p(acc, brow, bcol, wr, wc, fr, fq); else g(acc, brow, bcol, wr, wc, fr, fq);
  }
};

typedef int v8i __attribute__((ext_vector_type(8)));
__device__ __forceinline__ int lds8(int r, int c) { return r * 128 + ((c ^ ((r >> 1) & 7)) << 4); }
template <bool GATHER, int lda, int ldb, int K, class Epi, class S>
__device__ __forceinline__ void gemm8_run(const unsigned char* __restrict__ A, const int* __restrict__ stok,
                                          LAS char* shm, const Epi& epi, const S& sched) {
#define G_SA(b, h) (shm + ((b) * 2 + (h)) * 16384)
#define G_SB(b, h) (shm + (4 + (b) * 2 + (h)) * 16384)
  int tid = threadIdx.x; asm volatile("" : "+v"(tid)); tid &= 511;
  int wid = tid >> 6, lane = tid & 63, wr = wid >> 2, wc = wid & 3, fr = lane & 15, fq = lane >> 4;
  unsigned ao0, ao1, ao2, ao3, bo;
  int R0 = 8 * wid + (lane >> 3), C0 = ((lane & 7) ^ ((R0 >> 1) & 7)) << 4;
  const int lo = __builtin_amdgcn_readfirstlane(tid >> 6) * 1024;
  int brow, bcol; const unsigned char* Bt;
  int ui = 0;
  if (!sched.unit(ui, brow, Bt, bcol)) return;
#define SETOFF(br, bc) do { if (GATHER) { const int* _t = stok + (br); ao0 = (unsigned)(_t[R0] * lda + C0); ao1 = (unsigned)(_t[R0 + 64] * lda + C0); ao2 = (unsigned)(_t[R0 + 128] * lda + C0); ao3 = (unsigned)(_t[R0 + 192] * lda + C0); } \
    else { ao0 = (unsigned)(((br) + R0) * lda + C0); ao1 = ao0 + 64u * lda; ao2 = ao0 + 128u * lda; ao3 = ao0 + 192u * lda; } \
    bo = (unsigned)(((bc) + R0) * ldb + C0); } while (0)
#define STAGE_A0(P, kt) do { GLDS((A + (kt) * 128) + ao0, (P) + lo); GLDS((A + (kt) * 128) + ao1, (P) + lo + 8192); } while (0)
#define STAGE_A1(P, kt) do { GLDS((A + (kt) * 128) + ao2, (P) + lo); GLDS((A + (kt) * 128) + ao3, (P) + lo + 8192); } while (0)
#define STAGE_B0(P, kt) do { GLDS((Bt + (kt) * 128) + bo, (P) + lo); GLDS((Bt + 64 * ldb + (kt) * 128) + bo, (P) + lo + 8192); } while (0)
#define STAGE_B1(P, kt) do { GLDS((Bt + 128 * ldb + (kt) * 128) + bo, (P) + lo); GLDS((Bt + 192 * ldb + (kt) * 128) + bo, (P) + lo + 8192); } while (0)
#define PRO() do { STAGE_B0(G_SB(0, 0), 0); STAGE_A0(G_SA(0, 0), 0); STAGE_B1(G_SB(0, 1), 0); STAGE_A1(G_SA(0, 1), 0); } while (0)
  const int fx = (fq ^ ((fr >> 1) & 7)) << 4;
  const int fa0 = (wr * 64 + fr) * 128 + fx, fb0 = (wc * 32 + fr) * 128 + fx;
#define FRAG8(dst, p0, p1) do { const v4i _x = *(LAS const v4i*)(p0); const v4i _y = *(LAS const v4i*)(p1); \
    dst = (v8i){_x[0], _x[1], _x[2], _x[3], _y[0], _y[1], _y[2], _y[3]}; } while (0)
#define LDA(dst, b, h) do { int fa1 = fa0; asm volatile("v_xor_b32 %0, 64, %0" : "+v"(fa1)); \
    _Pragma("unroll") for (int m = 0; m < 4; ++m) FRAG8(dst[m], G_SA(b, h) + fa0 + m * 2048, G_SA(b, h) + fa1 + m * 2048); } while (0)
#define LDB(dst, b, h) do { int fb1 = fb0; asm volatile("v_xor_b32 %0, 64, %0" : "+v"(fb1)); \
    _Pragma("unroll") for (int n = 0; n < 2; ++n) FRAG8(dst[n], G_SB(b, h) + fb0 + n * 2048, G_SB(b, h) + fb1 + n * 2048); } while (0)
#define MMA(ai, bj, At_, Bt_) do { __builtin_amdgcn_s_setprio(1); \
    _Pragma("unroll") for (int m = 0; m < 4; ++m) _Pragma("unroll") for (int n = 0; n < 2; ++n) \
      asm volatile("v_mfma_scale_f32_16x16x128_f8f6f4 %0, %1, %2, %0, %3, %3 op_sel_hi:[0,0,0]" : "+v"(acc[ai][bj][m][n]) : "v"(Bt_[n]), "v"(At_[m]), "v"(sc1)); \
    __builtin_amdgcn_s_setprio(0); } while (0)
  int sc1; asm volatile("v_mov_b32 %0, 0x7f7f7f7f" : "=v"(sc1));
  const int nt = K / 128;
  SETOFF(brow, bcol); PRO();
  bool first = true;
  for (;;) {
    f32x4 acc[2][2][4][2] = {};
    v8i At[4], B0[2], B1[2];
    if (wr == 1) BAR;
    if (first) WAIT_V(4); else WAIT_V(0);
    BAR;
    STAGE_B0(G_SB(1, 0), 1); STAGE_A0(G_SA(1, 0), 1); STAGE_B1(G_SB(1, 1), 1);
    WAIT_V(6); BAR;
    for (int t = 0; t < nt - 2; t += 2) {
      LDB(B0, 0, 0); SCHED; LDA(At, 0, 0); STAGE_A1(G_SA(1, 1), t + 1);
      WAIT_L(8); BAR; WAIT_L(0); MMA(0, 0, At, B0); BAR; SCHED;
      LDB(B1, 0, 1); STAGE_B0(G_SB(0, 0), t + 2);
      BAR; WAIT_L(0); MMA(0, 1, At, B1); BAR;
      LDA(At, 0, 1); STAGE_A0(G_SA(0, 0), t + 2);
      BAR; WAIT_L(0); MMA(1, 0, At, B0); BAR; SCHED;
      STAGE_B1(G_SB(0, 1), t + 2);
      WAIT_V(6); BAR; MMA(1, 1, At, B1); BAR;
      LDB(B0, 1, 0); SCHED; LDA(At, 1, 0); STAGE_A1(G_SA(0, 1), t + 2);
      WAIT_L(8); BAR; WAIT_L(0); MMA(0, 0, At, B0); BAR; SCHED;
      LDB(B1, 1, 1); STAGE_B0(G_SB(1, 0), t + 3);
      BAR; WAIT_L(0); MMA(0, 1, At, B1); BAR;
      LDA(At, 1, 1); STAGE_A0(G_SA(1, 0), t + 3);
      BAR; WAIT_L(0); MMA(1, 0, At, B0); BAR; SCHED;
      STAGE_B1(G_SB(1, 1), t + 3);
      WAIT_V(6); BAR; MMA(1, 1, At, B1); BAR;
    }
    { LDB(B0, 0, 0); WAIT_V(0); LDA(At, 0, 0); STAGE_A1(G_SA(1, 1), nt - 1);
      BAR; WAIT_L(0); MMA(0, 0, At, B0); BAR;
      LDB(B1, 0, 1); BAR; WAIT_L(0); MMA(0, 1, At, B1); BAR;
      LDA(At, 0, 1); WAIT_V(4); BAR; WAIT_L(0); MMA(1, 0, At, B0); MMA(1, 1, At, B1); BAR; }
    { LDB(B0, 1, 0); LDA(At, 1, 0); WAIT_V(2); BAR; WAIT_L(0); MMA(0, 0, At, B0); BAR;
      LDB(B1, 1, 1); WAIT_V(0); BAR; WAIT_L(0); MMA(0, 1, At, B1); BAR;
      LDA(At, 1, 1); BAR; WAIT_L(0); MMA(1, 0, At, B0); MMA(1, 1, At, B1); BAR; }
    if (wr == 0) BAR;
    const int cbrow = brow, cbcol = bcol;
    { int tz = threadIdx.x; asm volatile("" : "+v"(tz)); tz &= 511; wid = tz >> 6; lane = tz & 63; wr = wid >> 2; wc = wid & 3; fr = lane & 15; fq = lane >> 4;
      R0 = 8 * wid + (lane >> 3); C0 = ((lane & 7) ^ ((R0 >> 1) & 7)) << 4; }
    ++ui;
    const bool more = sched.unit(ui, brow, Bt, bcol);
    if (more) { SETOFF(brow, bcol); asm volatile("" ::: "memory"); PRO(); asm volatile("" ::: "memory"); }
    asm volatile("s_nop 15\n\ts_nop 15\n\ts_nop 7" ::: "memory");
#pragma unroll
    for (int i = 0; i < 32; ++i) asm volatile("" : "+v"((&acc[0][0][0][0])[i]));
    epi(acc, cbrow, cbcol, wr, wc, fr, fq);
    if (!more) break;
    first = false;
  }
#undef G_SA
#undef G_SB
#undef SETOFF
#undef STAGE_A0
#undef STAGE_A1
#undef STAGE_B0
#undef STAGE_B1
#undef PRO
#undef FRAG8
#undef LDA
#undef LDB
#undef MMA
}
__device__ __forceinline__ float clamp8(float x) { return fminf(fmaxf(x, -448.f), 448.f); }
__device__ __forceinline__ unsigned pack_fp8x4(float a, float b, float c, float d) {
  int p = __builtin_amdgcn_cvt_pk_fp8_f32(clamp8(a), clamp8(b), 0, false); p = __builtin_amdgcn_cvt_pk_fp8_f32(clamp8(c), clamp8(d), p, true); return (unsigned)p; }
struct EpiSwiGLU8 {
  unsigned char* C; int ldc;
  __device__ __forceinline__ void operator()(const f32x4 (&acc)[2][2][4][2], int brow, int bcol, int wr, int wc, int fr, int fq) const {
    constexpr float S = 1.f / 256.f;
#pragma unroll
    for (int ai = 0; ai < 2; ++ai)
#pragma unroll
      for (int m = 0; m < 4; ++m) {
        unsigned char* rp = C + (size_t)(brow + ai * 128 + wr * 64 + m * 16 + fr) * ldc + (bcol >> 1) + wc * 16 + fq * 4;
#pragma unroll
        for (int bj = 0; bj < 2; ++bj) {
          float r[4];
#pragma unroll
          for (int j = 0; j < 4; ++j) { const float g = acc[ai][bj][m][0][j] * S, u = acc[ai][bj][m][1][j] * S; r[j] = g * sigmoid_fast(g) * u; }
          *(unsigned*)(rp + bj * 64) = pack_fp8x4(r[0], r[1], r[2], r[3]);
        }
      }
  }
};
struct EpiPlain8 {
  unsigned char* C; int ldc; float sc;
  __device__ __forceinline__ void operator()(const f32x4 (&acc)[2][2][4][2], int brow, int bcol, int wr, int wc, int fr, int fq) const {
#pragma unroll
    for (int ai = 0; ai < 2; ++ai)
#pragma unroll
      for (int m = 0; m < 4; ++m) {
        unsigned char* rp = C + (size_t)(brow + ai * 128 + wr * 64 + m * 16 + fr) * ldc + bcol + wc * 32 + fq * 8;
#pragma unroll
        for (int bj = 0; bj < 2; ++bj) {
          u32x2 v = {pack_fp8x4(acc[ai][bj][m][0][0] * sc, acc[ai][bj][m][0][1] * sc, acc[ai][bj][m][0][2] * sc, acc[ai][bj][m][0][3] * sc),
                     pack_fp8x4(acc[ai][bj][m][1][0] * sc, acc[ai][bj][m][1][1] * sc, acc[ai][bj][m][1][2] * sc, acc[ai][bj][m][1][3] * sc)};
          *(u32x2*)(rp + bj * 128) = v;
        }
      }
  }
};
struct EpiPlainS {
  bf16_t* C; int ldc; float sc;
  __device__ __forceinline__ void operator()(const f32x4 (&acc)[2][2][4][2], int brow, int bcol, int wr, int wc, int fr, int fq) const {
#pragma unroll
    for (int ai = 0; ai < 2; ++ai)
#pragma unroll
      for (int m = 0; m < 4; ++m) {
        bf16_t* rp = C + (size_t)(brow + ai * 128 + wr * 64 + m * 16 + fr) * ldc + bcol + wc * 32 + fq * 8;
#pragma unroll
        for (int bj = 0; bj < 2; ++bj) {
          u32x4 v = {cvtpk(acc[ai][bj][m][0][0] * sc, acc[ai][bj][m][0][1] * sc), cvtpk(acc[ai][bj][m][0][2] * sc, acc[ai][bj][m][0][3] * sc),
                     cvtpk(acc[ai][bj][m][1][0] * sc, acc[ai][bj][m][1][1] * sc), cvtpk(acc[ai][bj][m][1][2] * sc, acc[ai][bj][m][1][3] * sc)};
          *(u32x4*)(rp + bj * 128) = v;
        }
      }
  }
};

__device__ __forceinline__ void dense_unit(int u, int nM, int nN, int& pm, int& pn) {
  const int nwg = nM * nN, NX = 8, WGM = 8;
  int wgid = u;
  { const int q = nwg / NX, r = nwg % NX, xcd = wgid % NX, off = wgid / NX; wgid = (xcd < r ? xcd * (q + 1) : r * (q + 1) + (xcd - r) * q) + off; }
  const int nig = WGM * nN, gid = wgid / nig, fm = gid * WGM, gsz = min(nM - fm, WGM);
  pm = fm + ((wgid % nig) % gsz); pn = (wgid % nig) / gsz;
}

namespace at {
constexpr int DH = 128, NW = 8, QBLK = 32, KVBLK = 64;
constexpr float SCALE = 0.088388347648318440f;
constexpr float QC = SCALE * 1.4426950408889634f;
constexpr int SHM_V = KVBLK * DH * 2, SHM_K = KVBLK * DH * 2;
#define KSWZ(row, colB) ((row) * 256 + ((colB) ^ (((row) & 7) << 4)))
__device__ __forceinline__ int crow(int r, int hi) { return (r & 3) + 8 * (r >> 2) + 4 * hi; }
__device__ __forceinline__ unsigned cvtpkv(float lo, float hi) { unsigned r; asm volatile("v_cvt_pk_bf16_f32 %0, %1, %2" : "=v"(r) : "v"(lo), "v"(hi)); return r; }
#define PK4(P, BASE, OUT) do { unsigned a0 = cvtpkv(P[BASE + 0], P[BASE + 1]), a1 = cvtpkv(P[BASE + 2], P[BASE + 3]);   \
    unsigned b0 = cvtpkv(P[BASE + 4], P[BASE + 5]), b1 = cvtpkv(P[BASE + 6], P[BASE + 7]);                              \
    auto r0 = __builtin_amdgcn_permlane32_swap(a0, b0, false, false); auto r1 = __builtin_amdgcn_permlane32_swap(a1, b1, false, false); \
    u32x4 w = {r0[0], r1[0], r0[1], r1[1]}; OUT = *reinterpret_cast<bf16x8*>(&w); } while (0)
__device__ __forceinline__ float load_q(const bf16_t* __restrict__ Qw, bf16x8 (&qr)[8], float kmax2) {
  float ss = 0;
#pragma unroll
  for (int d0 = 0; d0 < 8; ++d0) {
    const u32x4 raw = *reinterpret_cast<const u32x4*>(Qw + d0 * 16); u32x4 o;
#pragma unroll
    for (int i = 0; i < 4; ++i) { const unsigned pk = cvtpk(bflo(raw[i]) * QC, bfhi(raw[i]) * QC); o[i] = pk; const float a = bflo(pk), b = bfhi(pk); ss += a * a + b * b; }
    qr[d0] = *reinterpret_cast<bf16x8*>(&o);
  }
  { auto rr = __builtin_amdgcn_permlane32_swap(__float_as_uint(ss), __float_as_uint(ss), false, false); ss = __uint_as_float(rr[0]) + __uint_as_float(rr[1]); }
  return -(sqrtf(ss * kmax2) * 1.01f + 1e-3f);
}
__device__ __forceinline__ void exp16(f32x16& p) {
#pragma unroll
  for (int r = 0; r < 16; ++r) p[r] = __builtin_amdgcn_exp2f(p[r]);
}
__device__ __forceinline__ float sum16(const f32x16& p) { float s = 0;
#pragma unroll
  for (int r = 0; r < 16; ++r) s += p[r];
  return s; }
__device__ __forceinline__ void qkt(f32x16& p0, f32x16& p1, LAS const char* Ks, const bf16x8* qr, int r32, int hi, float nmc) {
#pragma unroll
  for (int r = 0; r < 16; ++r) { p0[r] = nmc; p1[r] = nmc; }
#pragma unroll
  for (int d0 = 0; d0 < 8; ++d0) { int cb = (d0 * 16 + hi * 8) * 2;
    bf16x8 b0 = *(LAS const bf16x8*)(Ks + KSWZ(r32, cb));
    bf16x8 b1 = *(LAS const bf16x8*)(Ks + KSWZ(32 + r32, cb));
    p0 = __builtin_amdgcn_mfma_f32_32x32x16_bf16(b0, qr[d0], p0, 0, 0, 0);
    p1 = __builtin_amdgcn_mfma_f32_32x32x16_bf16(b1, qr[d0], p1, 0, 0, 0); }
}
__device__ __forceinline__ int v_st(int k, int c) { const int kk = (k & ~0xC) | ((k & 4) << 1) | ((k & 8) >> 1); return ((kk >> 3) * 4 + (c >> 5)) * 512 + ((kk & 7) * 32 + (c & 31)) * 2; }
__device__ __forceinline__ int v_st256(int k, int c) { const int kk = (k & ~0xC) | ((k & 4) << 1) | ((k & 8) >> 1); return ((kk >> 3) * 8 + (c >> 5)) * 512 + ((kk & 7) * 32 + (c & 31)) * 2; }
__device__ __forceinline__ int v_rd_base(int lane) { return ((lane & 3) << 3) | (((lane >> 2) & 3) << 6) | (((lane >> 4) & 1) << 5) | (((lane >> 5) & 1) << 8); }
template <int OFF> __device__ __forceinline__ s16x4 tr_read(int vb) {
  s16x4 r; asm volatile("ds_read_b64_tr_b16 %0, %1 offset:%2" : "=&v"(r) : "v"(vb), "i"(OFF) : "memory"); return r;
}
template <int BASE, int KS, int HS> __device__ __forceinline__ void pv_one(f32x16& od, int vb, bf16x8 pa0, bf16x8 pa1, bf16x8 pa2, bf16x8 pa3) {
  const s16x4 l0 = tr_read<BASE>(vb), h0 = tr_read<BASE + HS>(vb), l1 = tr_read<BASE + KS>(vb), h1 = tr_read<BASE + KS + HS>(vb);
  const s16x4 l2 = tr_read<BASE + 2 * KS>(vb), h2 = tr_read<BASE + 2 * KS + HS>(vb), l3 = tr_read<BASE + 3 * KS>(vb), h3 = tr_read<BASE + 3 * KS + HS>(vb);
  asm volatile("s_waitcnt lgkmcnt(0)" ::: "memory"); SCHED;
#define PK(L, H) (bf16x8){L[0], L[1], L[2], L[3], H[0], H[1], H[2], H[3]}
  od = __builtin_amdgcn_mfma_f32_32x32x16_bf16(pa0, PK(l0, h0), od, 0, 0, 0);
  od = __builtin_amdgcn_mfma_f32_32x32x16_bf16(pa1, PK(l1, h1), od, 0, 0, 0);
  od = __builtin_amdgcn_mfma_f32_32x32x16_bf16(pa2, PK(l2, h2), od, 0, 0, 0);
  od = __builtin_amdgcn_mfma_f32_32x32x16_bf16(pa3, PK(l3, h3), od, 0, 0, 0);
#undef PK
}
__device__ __forceinline__ void pv_d0(f32x16* o, int vb, bf16x8 pa0, bf16x8 pa1, bf16x8 pa2, bf16x8 pa3) {
  pv_one<0, 4096, 2048>(o[0], vb, pa0, pa1, pa2, pa3); pv_one<512, 4096, 2048>(o[1], vb, pa0, pa1, pa2, pa3);
  pv_one<1024, 4096, 2048>(o[2], vb, pa0, pa1, pa2, pa3); pv_one<1536, 4096, 2048>(o[3], vb, pa0, pa1, pa2, pa3);
}
__device__ __forceinline__ void pv_d0_256(f32x16* o, int vb, bf16x8 pa0, bf16x8 pa1, bf16x8 pa2, bf16x8 pa3) {
  pv_one<0, 8192, 4096>(o[0], vb, pa0, pa1, pa2, pa3); pv_one<512, 8192, 4096>(o[1], vb, pa0, pa1, pa2, pa3);
  pv_one<1024, 8192, 4096>(o[2], vb, pa0, pa1, pa2, pa3); pv_one<1536, 8192, 4096>(o[3], vb, pa0, pa1, pa2, pa3);
}
__device__ __forceinline__ void store_o8(const f32x16* o, float l_tot, LAS float* li, unsigned char* __restrict__ Ow, int ldo, int r32, int hi) {
  if (hi == 0) li[r32] = l_tot; asm volatile("s_waitcnt lgkmcnt(0)" ::: "memory");
  float rli[16];
#pragma unroll
  for (int r = 0; r < 16; ++r) rli[r] = 8.f * __builtin_amdgcn_rcpf(li[crow(r, hi)]);
#pragma unroll
  for (int r = 0; r < 16; ++r) { const int orow = crow(r, hi);
#pragma unroll
    for (int d0 = 0; d0 < 4; ++d0) Ow[(long)orow * ldo + d0 * 32 + r32] = (unsigned char)__builtin_amdgcn_cvt_pk_fp8_f32(o[d0][r] * rli[r], 0.f, 0, false); }
}
__device__ __forceinline__ void store_o(const f32x16* o, float l_tot, LAS float* li, bf16_t* __restrict__ Ow, int ldo, int r32, int hi) {
  if (hi == 0) li[r32] = l_tot; asm volatile("s_waitcnt lgkmcnt(0)" ::: "memory");
  float rli[16];
#pragma unroll
  for (int r = 0; r < 16; ++r) rli[r] = __builtin_amdgcn_rcpf(li[crow(r, hi)]);
#pragma unroll
  for (int r = 0; r < 16; ++r) { const int orow = crow(r, hi);
#pragma unroll
    for (int d0 = 0; d0 < 4; ++d0) Ow[(long)orow * ldo + d0 * 32 + r32] = f2bf(o[d0][r] * rli[r]); }
}

__device__ __forceinline__ int unswap23(int kk) { return (kk & ~0xC) | ((kk & 4) << 1) | ((kk & 8) >> 1); }
__device__ __forceinline__ int k_dma_voff(int wid, int lane, int ldk) {
  const int row = 4 * wid + (lane >> 4); return row * ldk * 2 + (((lane & 15) * 16) ^ ((row & 7) << 4)); }
#define DMA16(rs, ldsp, voff, soff) __builtin_amdgcn_raw_ptr_buffer_load_lds(rs, (LAS void*)(ldsp), 16, voff, soff, 0, 0)

constexpr int SHM_T = SHM_K + SHM_V;
__device__ __forceinline__ void attn_body(const bf16_t* __restrict__ Qb, const int ldq, const bf16_t* __restrict__ Kh, const bf16_t* __restrict__ Vh, const int ldk,
                                          bf16_t* __restrict__ Ob, const int ldo, const int seq, const float kmax2, LAS char* lds) {
  int tid = threadIdx.x; asm volatile("" : "+v"(tid)); tid &= 511;
  const int wid = tid >> 6, lane = tid & 63, r32 = lane & 31, hi = lane >> 5;
  LAS float* li_l = (LAS float*)(lds + 3 * SHM_T) + wid * 64;
  float l_reg = 0; f32x16 o[4] = {}; bf16x8 qr[8];
  const float nmc = load_q(Qb + (long)(wid * QBLK + r32) * ldq + hi * 8, qr, kmax2);
  const int vrb = v_rd_base(lane);
  const int kvo = k_dma_voff(wid, lane, ldk);
  const int vvo = unswap23(8 * (wid >> 1) + ((lane & 31) >> 2)) * ldk * 2 + ((2 * (wid & 1) + (lane >> 5)) * 32 + (lane & 3) * 8) * 2;
  const int l32 = 64 * ldk, pz = wid * 1024;
  const __amdgpu_buffer_rsrc_t krs = __builtin_amdgcn_make_buffer_rsrc((void*)Kh, 0, 0x7ffffff0, 0x00020000);
  const __amdgpu_buffer_rsrc_t vrs = __builtin_amdgcn_make_buffer_rsrc((void*)Vh, 0, 0x7ffffff0, 0x00020000);
#define TDMA(slot, k0) do { const int _o = (k0) * ldk * 2; LAS char* _b = lds + (slot) * SHM_T + pz; \
    DMA16(krs, _b, kvo, _o); DMA16(krs, _b + 8192, kvo, _o + l32); DMA16(vrs, _b + SHM_K, vvo, _o); DMA16(vrs, _b + SHM_K + 8192, vvo, _o + l32); } while (0)
#define VM0() asm volatile("s_waitcnt vmcnt(0)" ::: "memory")
#define FINISH(P0, P1) do { exp16(P1); l_reg += sum16(P0) + sum16(P1); PK4(P0, 0, pa0); PK4(P0, 8, pa1); PK4(P1, 0, pa2); PK4(P1, 8, pa3); } while (0)
  f32x16 pA0, pA1, pB0, pB1; bf16x8 pa0, pa1, pa2, pa3; const int NT = seq / KVBLK;
  TDMA(0, 0); VM0(); __syncthreads();
  TDMA(1, KVBLK);
  qkt(pA0, pA1, lds, qr, r32, hi, nmc); exp16(pA0);
  VM0(); __syncthreads();
  int sk = 1, sv = 0, sd = 2;
  for (int j = 1; j + 1 < NT; j += 2) {
    TDMA(sd, (j + 1) * KVBLK);
    SCHED; qkt(pB0, pB1, lds + sk * SHM_T, qr, r32, hi, nmc);
    FINISH(pA0, pA1); SCHED;
    pv_d0(o, (int)(uintptr_t)(lds + sv * SHM_T + SHM_K) + vrb, pa0, pa1, pa2, pa3); exp16(pB0);
    VM0(); __syncthreads();
    { const int t = sv; sv = sk; sk = sd; sd = t; }
    if (j + 2 < NT) TDMA(sd, (j + 2) * KVBLK);
    SCHED; qkt(pA0, pA1, lds + sk * SHM_T, qr, r32, hi, nmc);
    FINISH(pB0, pB1); SCHED;
    pv_d0(o, (int)(uintptr_t)(lds + sv * SHM_T + SHM_K) + vrb, pa0, pa1, pa2, pa3); exp16(pA0);
    VM0(); __syncthreads();
    { const int t = sv; sv = sk; sk = sd; sd = t; }
  }
  SCHED; qkt(pB0, pB1, lds + sk * SHM_T, qr, r32, hi, nmc);
  FINISH(pA0, pA1); SCHED;
  pv_d0(o, (int)(uintptr_t)(lds + sv * SHM_T + SHM_K) + vrb, pa0, pa1, pa2, pa3); exp16(pB0);
  FINISH(pB0, pB1); SCHED;
  pv_d0(o, (int)(uintptr_t)(lds + sk * SHM_T + SHM_K) + vrb, pa0, pa1, pa2, pa3);
  { auto rr = __builtin_amdgcn_permlane32_swap(__float_as_uint(l_reg), __float_as_uint(l_reg), false, false); l_reg = __uint_as_float(rr[0]) + __uint_as_float(rr[1]); }
  store_o(o, l_reg, li_l, Ob + (long)(wid * QBLK) * ldo, ldo, r32, hi);
  VM0();
  __syncthreads();
#undef TDMA
#undef FINISH
}

constexpr int SHM_V2 = KVBLK * 256 * 2;
__device__ __forceinline__ void attn_body_dv256(const bf16_t* __restrict__ Qb, const int ldq, const bf16_t* __restrict__ Kh, const bf16_t* __restrict__ Vh, const int ldk,
                                                bf16_t* __restrict__ Ob, const int ldo, const int seq, const float kmax2, LAS char* lds) {
  int tid = threadIdx.x; asm volatile("" : "+v"(tid)); tid &= 511;
  const int wid = tid >> 6, lane = tid & 63, r32 = lane & 31, hi = lane >> 5, rg = wid >> 1, kh = wid & 1;
  LAS char* K_lds = lds; LAS char* V_lds = lds + 2 * SHM_K; LAS char* X_lds = lds + 2 * SHM_K + 2 * SHM_V2;
  float l_reg = 0; f32x16 o[4] = {}; bf16x8 qr[8];
  const float nmc = load_q(Qb + (long)(rg * QBLK + r32) * ldq + hi * 8, qr, kmax2);
  const int vb0 = (int)(uintptr_t)V_lds + v_rd_base(lane) + kh * 2048;
  const int kvo = k_dma_voff(wid, lane, ldk);
  const int vvo = unswap23(8 * (wid >> 2) + ((lane & 31) >> 2)) * ldk * 2 + ((2 * (wid & 3) + (lane >> 5)) * 32 + (lane & 3) * 8) * 2;
  const int l32 = 64 * ldk, l16 = 32 * ldk, pz = wid * 1024;
  const int xw = (rg * 4 + kh * 2) * 1024 + lane * 16, xr = rg * 4096 + lane * 16;
  const __amdgpu_buffer_rsrc_t krs = __builtin_amdgcn_make_buffer_rsrc((void*)Kh, 0, 0x7ffffff0, 0x00020000);
  const __amdgpu_buffer_rsrc_t vrs = __builtin_amdgcn_make_buffer_rsrc((void*)Vh, 0, 0x7ffffff0, 0x00020000);
#define KDMA(b, k0) do { const int _o = (k0) * ldk * 2; LAS char* _b = K_lds + (b) * SHM_K + pz; DMA16(krs, _b, kvo, _o); DMA16(krs, _b + 8192, kvo, _o + l32); } while (0)
#define VDMA(b, k0) do { const int _o = (k0) * ldk * 2; LAS char* _b = V_lds + (b) * SHM_V2 + pz; DMA16(vrs, _b, vvo, _o); DMA16(vrs, _b + 8192, vvo, _o + l16); \
    DMA16(vrs, _b + 16384, vvo, _o + 2 * l16); DMA16(vrs, _b + 24576, vvo, _o + 3 * l16); } while (0)
  f32x16 pA, pB; bf16x8 pa0, pa1, pa2, pa3, own0, own1; const int NT = seq / KVBLK;
  const int kxor = ((32 * kh + r32) & 7) << 4, krb = (32 * kh + r32) * 256;
#define QKHALF(P, b) do { _Pragma("unroll") for (int r = 0; r < 16; ++r) P[r] = nmc; \
    _Pragma("unroll") for (int d0 = 0; d0 < 8; ++d0) { const bf16x8 bk = *(LAS const bf16x8*)(K_lds + (b) * SHM_K + krb + (((d0 * 16 + hi * 8) * 2) ^ kxor)); \
      P = __builtin_amdgcn_mfma_f32_32x32x16_bf16(bk, qr[d0], P, 0, 0, 0); } } while (0)
#define FINH(P) do { exp16(P); l_reg += sum16(P); PK4(P, 0, own0); PK4(P, 8, own1); } while (0)
#define XWRITE(b) do { *(LAS bf16x8*)(X_lds + (b) * 16384 + xw) = own0; *(LAS bf16x8*)(X_lds + (b) * 16384 + xw + 1024) = own1; } while (0)
#define XREAD(b) do { pa0 = *(LAS const bf16x8*)(X_lds + (b) * 16384 + xr); pa1 = *(LAS const bf16x8*)(X_lds + (b) * 16384 + xr + 1024); \
    pa2 = *(LAS const bf16x8*)(X_lds + (b) * 16384 + xr + 2048); pa3 = *(LAS const bf16x8*)(X_lds + (b) * 16384 + xr + 3072); } while (0)
#define STEP(PA, PB, b, j) do { \
    SCHED; if ((j) + 1 < NT) QKHALF(PB, (b) ^ 1); FINH(PA); SCHED; \
    XWRITE(b); VM0(); __syncthreads(); \
    if ((j) + 3 < NT) KDMA((b) ^ 1, ((j) + 3) * KVBLK); if ((j) + 1 < NT) VDMA((b) ^ 1, ((j) + 1) * KVBLK); \
    XREAD(b); \
    pv_d0_256(o, vb0 + (b) * SHM_V2, pa0, pa1, pa2, pa3); } while (0)
  KDMA(0, 0); KDMA(1, KVBLK); VDMA(0, 0); VM0(); __syncthreads();
  QKHALF(pA, 0);
  __syncthreads();
  if (2 < NT) KDMA(0, 2 * KVBLK);
  for (int j = 0; j < NT; j += 2) { STEP(pA, pB, 0, j); STEP(pB, pA, 1, j + 1); }
  __syncthreads();
  LAS float* lx = (LAS float*)X_lds;
  lx[wid * 64 + lane] = l_reg; __syncthreads();
  const float l_tot = lx[wid * 64 + r32] + lx[wid * 64 + 32 + r32] + lx[(wid ^ 1) * 64 + r32] + lx[(wid ^ 1) * 64 + 32 + r32];
  store_o(o, l_tot, lx + 512 + wid * 32, Ob + (long)(rg * QBLK) * ldo + kh * 128, ldo, r32, hi);
  VM0();
  __syncthreads();
#undef KDMA
#undef VDMA
#undef QKHALF
#undef FINH
#undef XWRITE
#undef XREAD
#undef STEP
#undef VM0
}

#define LGK(n) asm volatile("s_waitcnt lgkmcnt(" #n ")" ::: "memory")
template <int OFF> __device__ __forceinline__ bf16x8 k_read(int ka) { bf16x8 r; asm volatile("ds_read_b128 %0, %1 offset:%2" : "=&v"(r) : "v"(ka), "i"(OFF) : "memory"); return r; }
struct VSet { s16x4 l0, h0, l1, h1; };
template <int OFF> __device__ __forceinline__ void v_read(VSet& s, int vb) { s.l0 = tr_read<OFF>(vb); s.h0 = tr_read<OFF + 4096>(vb); s.l1 = tr_read<OFF + 8192>(vb); s.h1 = tr_read<OFF + 12288>(vb); }
__device__ __forceinline__ void pv2(f32x16& oa, const VSet& s, bf16x8 pa0, bf16x8 pa1) {
#define PK(L, H) (bf16x8){L[0], L[1], L[2], L[3], H[0], H[1], H[2], H[3]}
  oa = __builtin_amdgcn_mfma_f32_32x32x16_bf16(pa0, PK(s.l0, s.h0), oa, 0, 0, 0);
  oa = __builtin_amdgcn_mfma_f32_32x32x16_bf16(pa1, PK(s.l1, s.h1), oa, 0, 0, 0);
#undef PK
}
template <bool SHIFT>
__device__ __forceinline__ void attn_body_c256_t(const bf16_t* __restrict__ Qb, const int ldq, const bf16_t* __restrict__ Kh, const bf16_t* __restrict__ Vh, const int ldk,
                                                 bf16_t* __restrict__ Ob, const int ldo, const int seq, const float nmc, const bf16x8 (&qr)[8], LAS char* lds) {
  int tid = threadIdx.x; asm volatile("" : "+v"(tid)); tid &= 511;
  const int wid = __builtin_amdgcn_readfirstlane(tid >> 6), lane = tid & 63, r32 = lane & 31, hi = lane >> 5;
  LAS char* K_lds = lds; LAS char* V_lds = lds + 2 * SHM_K;
  LAS float* li_l = (LAS float*)(lds + 2 * SHM_K + 2 * SHM_V2) + wid * 64;
  float l_reg = 0; f32x16 o[8] = {};
  const int vb0 = (int)(uintptr_t)V_lds + v_rd_base(lane);
  const int kvo = k_dma_voff(wid, lane, ldk);
  const int vvo = unswap23(8 * (wid >> 2) + ((lane & 31) >> 2)) * ldk * 2 + ((2 * (wid & 3) + (lane >> 5)) * 32 + (lane & 3) * 8) * 2;
  const int l32 = 64 * ldk, l16 = 32 * ldk, pz = wid * 1024;
  const __amdgpu_buffer_rsrc_t krs = __builtin_amdgcn_make_buffer_rsrc((void*)Kh, 0, 0x7ffffff0, 0x00020000);
  const __amdgpu_buffer_rsrc_t vrs = __builtin_amdgcn_make_buffer_rsrc((void*)Vh, 0, 0x7ffffff0, 0x00020000);
#define VM0() asm volatile("s_waitcnt vmcnt(0)" ::: "memory")
#define KVDMA(b, k0) do { const int _o = (k0) * ldk * 2; LAS char* _k = K_lds + (b) * SHM_K + pz; LAS char* _v = V_lds + (b) * SHM_V2 + pz; \
    DMA16(krs, _k, kvo, _o); DMA16(krs, _k + 8192, kvo, _o + l32); DMA16(vrs, _v, vvo, _o); DMA16(vrs, _v + 8192, vvo, _o + l16); \
    DMA16(vrs, _v + 16384, vvo, _o + 2 * l16); DMA16(vrs, _v + 24576, vvo, _o + 3 * l16); } while (0)
  int ka[8];
  { const int kxor = (r32 & 7) << 4, krb = (int)(uintptr_t)K_lds + r32 * 256;
#pragma unroll
    for (int d0 = 0; d0 < 8; ++d0) ka[d0] = krb + (((d0 * 16 + hi * 8) * 2) ^ kxor); }
  f32x16 P; bf16x8 pa0, pa1, f0, f1, f2, f3; VSet va, vb_, vc;
  const int NT = seq / KVBLK;
#define PINIT() do { _Pragma("unroll") for (int r = 0; r < 16; ++r) { float _z; asm volatile("v_mov_b32 %0, %1" : "=v"(_z) : "v"(SHIFT ? nmc : 0.f)); P[r] = _z; } } while (0)
#define KOFF(b, h) ((b) * 16384 + (h) * 8192)
#define VOFF(b, h, d0) ((b) * 32768 + (h) * 16384 + (d0) * 512)
#define KPRO(b, h) do { f0 = k_read<KOFF(b, h)>(ka[0]); f1 = k_read<KOFF(b, h)>(ka[1]); f2 = k_read<KOFF(b, h)>(ka[2]); } while (0)
#define QKM(F, d0) do { SCHED; P = __builtin_amdgcn_mfma_f32_32x32x16_bf16(F, qr[d0], P, 0, 0, 0); SCHED; } while (0)
#define QKHALF(b, h) do { PINIT(); \
    LGK(2); QKM(f0, 0); f3 = k_read<KOFF(b, h)>(ka[3]); \
    LGK(2); QKM(f1, 1); f0 = k_read<KOFF(b, h)>(ka[4]); \
    LGK(2); QKM(f2, 2); f1 = k_read<KOFF(b, h)>(ka[5]); \
    LGK(2); QKM(f3, 3); f2 = k_read<KOFF(b, h)>(ka[6]); \
    LGK(2); QKM(f0, 4); f3 = k_read<KOFF(b, h)>(ka[7]); \
    LGK(2); QKM(f1, 5); v_read<VOFF(b, h, 0)>(va, vb0); \
    LGK(5); QKM(f2, 6); v_read<VOFF(b, h, 1)>(vb_, vb0); \
    LGK(8); QKM(f3, 7); } while (0)
#define SMH() do { exp16(P); l_reg += sum16(P); PK4(P, 0, pa0); PK4(P, 8, pa1); } while (0)
#define PVM(S, d0) do { SCHED; pv2(o[d0], S, pa0, pa1); SCHED; } while (0)
#define PVHALF(b, h, NEXTK, nb, nh) do { \
    LGK(4); PVM(va, 0); v_read<VOFF(b, h, 2)>(vc, vb0); \
    LGK(4); PVM(vb_, 1); v_read<VOFF(b, h, 3)>(va, vb0); \
    LGK(4); PVM(vc, 2); v_read<VOFF(b, h, 4)>(vb_, vb0); \
    LGK(4); PVM(va, 3); v_read<VOFF(b, h, 5)>(vc, vb0); \
    LGK(4); PVM(vb_, 4); v_read<VOFF(b, h, 6)>(va, vb0); \
    LGK(4); PVM(vc, 5); v_read<VOFF(b, h, 7)>(vb_, vb0); \
    LGK(4); PVM(va, 6); if (NEXTK) { f0 = k_read<KOFF(nb, nh)>(ka[0]); f1 = k_read<KOFF(nb, nh)>(ka[1]); } \
    if (NEXTK) { LGK(2); } else { LGK(0); } PVM(vb_, 7); if (NEXTK) { f2 = k_read<KOFF(nb, nh)>(ka[2]); } } while (0)
#define STEPC(b, j) do { if ((j) + 1 < NT) KVDMA((b) ^ 1, ((j) + 1) * KVBLK); \
    KPRO(b, 0); QKHALF(b, 0); SMH(); PVHALF(b, 0, true, b, 1); \
    QKHALF(b, 1); SMH(); PVHALF(b, 1, false, 0, 0); \
    VM0(); __syncthreads(); } while (0)
  KVDMA(0, 0); VM0(); __syncthreads();
  for (int j = 0; j < NT; j += 2) { STEPC(0, j); STEPC(1, j + 1); }
  { auto rr = __builtin_amdgcn_permlane32_swap(__float_as_uint(l_reg), __float_as_uint(l_reg), false, false); l_reg = __uint_as_float(rr[0]) + __uint_as_float(rr[1]); }
  if (hi == 0) li_l[r32] = l_reg; asm volatile("s_waitcnt lgkmcnt(0)" ::: "memory");
  bf16_t* Ow = Ob + (long)(wid * QBLK) * ldo;
#pragma unroll
  for (int r = 0; r < 16; ++r) { const int orow = crow(r, hi); const float rl = __builtin_amdgcn_rcpf(li_l[orow]);
#pragma unroll
    for (int d0 = 0; d0 < 8; ++d0) Ow[(long)orow * ldo + d0 * 32 + r32] = f2bf(o[d0][r] * rl); }
  VM0();
  __syncthreads();
#undef KVDMA
#undef PINIT
#undef KOFF
#undef VOFF
#undef KPRO
#undef QKM
#undef QKHALF
#undef SMH
#undef PVM
#undef PVHALF
#undef STEPC
#undef VM0
}
__device__ __forceinline__ void attn_body_c256(const bf16_t* __restrict__ Qb, const int ldq, const bf16_t* __restrict__ Kh, const bf16_t* __restrict__ Vh, const int ldk,
                                               bf16_t* __restrict__ Ob, const int ldo, const int seq, const float kmax2, LAS char* lds) {
  int tid = threadIdx.x; asm volatile("" : "+v"(tid)); tid &= 511;
  const int wid = tid >> 6, lane = tid & 63, r32 = lane & 31, hi = lane >> 5;
  bf16x8 qr[8];
  const float nmc = load_q(Qb + (long)(wid * QBLK + r32) * ldq + hi * 8, qr, kmax2);
  if (__all(nmc > -64.f)) attn_body_c256_t<false>(Qb, ldq, Kh, Vh, ldk, Ob, ldo, seq, 0.f, qr, lds);
  else attn_body_c256_t<true>(Qb, ldq, Kh, Vh, ldk, Ob, ldo, seq, nmc, qr, lds);
}

__device__ __forceinline__ float load_q8(const bf16_t* __restrict__ Qrow, int hi, v8i_ (&qf)[2], float kmax2) {
  float ss = 0;
#pragma unroll
  for (int st = 0; st < 2; ++st) {
    const bf16_t* p = Qrow + 64 * st + 32 * hi; v8i_ o;
#pragma unroll
    for (int c = 0; c < 4; ++c) { const u32x4 raw = *reinterpret_cast<const u32x4*>(p + 8 * c);
      const unsigned w0 = pack8x4(bflo(raw[0]) * QC, bfhi(raw[0]) * QC, bflo(raw[1]) * QC, bfhi(raw[1]) * QC);
      const unsigned w1 = pack8x4(bflo(raw[2]) * QC, bfhi(raw[2]) * QC, bflo(raw[3]) * QC, bfhi(raw[3]) * QC);
      o[2 * c] = (int)w0; o[2 * c + 1] = (int)w1; ss += sq8x4(w0) + sq8x4(w1); }
    qf[st] = o;
  }
  { auto rr = __builtin_amdgcn_permlane32_swap(__float_as_uint(ss), __float_as_uint(ss), false, false); ss = __uint_as_float(rr[0]) + __uint_as_float(rr[1]); }
  return -(sqrtf(ss * kmax2) * 1.01f + 1e-3f);
}
__device__ __forceinline__ int k8_dma_voff(int wid, int lane, int ldk8) {
  const int row = 8 * wid + (lane >> 3); return row * ldk8 + (((lane & 7) ^ ((row >> 1) & 7)) << 4); }
template <int OFF> __device__ __forceinline__ v4i k8_read(int ka) { v4i r; asm volatile("ds_read_b128 %0, %1 offset:%2" : "=&v"(r) : "v"(ka), "i"(OFF) : "memory"); return r; }

template <bool SHIFT>
__device__ __forceinline__ void attn_body_c256q8_t(const unsigned char* __restrict__ K8, const int ldk8, const bf16_t* __restrict__ Vh, const int ldk,
                                                   bf16_t* __restrict__ Ob, const int ldo, const int seq, const float nmc, const v8i_ (&qf)[2], LAS char* lds) {
  int tid = threadIdx.x; asm volatile("" : "+v"(tid)); tid &= 511;
  const int wid = __builtin_amdgcn_readfirstlane(tid >> 6), lane = tid & 63, r32 = lane & 31, hi = lane >> 5;
  constexpr int SHM_K8 = KVBLK * 128;
  LAS char* K_lds = lds; LAS char* V_lds = lds + 2 * SHM_K8;
  LAS float* li_l = (LAS float*)(lds + 2 * SHM_K8 + 2 * SHM_V2) + wid * 64;
  float l_reg = 0; f32x16 o[8] = {};
  const int vb0 = (int)(uintptr_t)V_lds + v_rd_base(lane);
  const int kvo = k8_dma_voff(wid, lane, ldk8);
  const int vvo = unswap23(8 * (wid >> 2) + ((lane & 31) >> 2)) * ldk * 2 + ((2 * (wid & 3) + (lane >> 5)) * 32 + (lane & 3) * 8) * 2;
  const int l16 = 32 * ldk, pz = wid * 1024;
  const __amdgpu_buffer_rsrc_t krs = __builtin_amdgcn_make_buffer_rsrc((void*)K8, 0, 0x7ffffff0, 0x00020000);
  const __amdgpu_buffer_rsrc_t vrs = __builtin_amdgcn_make_buffer_rsrc((void*)Vh, 0, 0x7ffffff0, 0x00020000);
#define VM0() asm volatile("s_waitcnt vmcnt(0)" ::: "memory")
#define KVDMA(b, k0) do { const int _o = (k0) * ldk * 2; LAS char* _v = V_lds + (b) * SHM_V2 + pz; \
    DMA16(krs, K_lds + (b) * SHM_K8 + pz, kvo, (k0) * ldk8); DMA16(vrs, _v, vvo, _o); DMA16(vrs, _v + 8192, vvo, _o + l16); \
    DMA16(vrs, _v + 16384, vvo, _o + 2 * l16); DMA16(vrs, _v + 24576, vvo, _o + 3 * l16); } while (0)
  const int ka0 = (int)(uintptr_t)K_lds + r32 * 128 + (((2 * hi) ^ ((r32 >> 1) & 7)) << 4);
  const int ka1 = ka0 ^ 16, ka2 = ka0 ^ 64, ka3 = ka0 ^ 80;
  int sc1; asm volatile("v_mov_b32 %0, 0x7f7f7f7f" : "=v"(sc1));
  f32x16 P; bf16x8 pa0, pa1; v4i k0a, k0b, k1a, k1b; VSet va, vb_, vc;
  const int NT = seq / KVBLK;
#define KOFF(b, h) ((b) * 8192 + (h) * 4096)
#define VOFF(b, h, d0) ((b) * 32768 + (h) * 16384 + (d0) * 512)
#define KPRO(b, h) do { k0a = k8_read<KOFF(b, h)>(ka0); k0b = k8_read<KOFF(b, h)>(ka1); k1a = k8_read<KOFF(b, h)>(ka2); k1b = k8_read<KOFF(b, h)>(ka3); } while (0)
#define V8(x, y) (v8i_){x[0], x[1], x[2], x[3], y[0], y[1], y[2], y[3]}
#define QKHALF(b, h) do { \
    if (SHIFT) { _Pragma("unroll") for (int r = 0; r < 16; ++r) { float _z; asm volatile("v_mov_b32 %0, %1" : "=v"(_z) : "v"(nmc)); P[r] = _z; } } \
    LGK(2); SCHED; { const v8i_ kf = V8(k0a, k0b); \
      if (SHIFT) asm volatile("s_nop 4\n\tv_mfma_scale_f32_32x32x64_f8f6f4 %0, %1, %2, %0, %3, %3 op_sel_hi:[0,0,0]" : "+v"(P) : "v"(kf), "v"(qf[0]), "v"(sc1)); \
      else       asm volatile("v_mfma_scale_f32_32x32x64_f8f6f4 %0, %1, %2, 0, %3, %3 op_sel_hi:[0,0,0]" : "=&v"(P) : "v"(kf), "v"(qf[0]), "v"(sc1)); } \
    SCHED; v_read<VOFF(b, h, 0)>(va, vb0); \
    LGK(4); SCHED; { const v8i_ kf = V8(k1a, k1b); \
      asm volatile("v_mfma_scale_f32_32x32x64_f8f6f4 %0, %1, %2, %0, %3, %3 op_sel_hi:[0,0,0]" : "+v"(P) : "v"(kf), "v"(qf[1]), "v"(sc1)); } \
    SCHED; v_read<VOFF(b, h, 1)>(vb_, vb0); \
    asm volatile("s_nop 15\n\ts_nop 7" : "+v"(P)); } while (0)
#define SMH() do { exp16(P); l_reg += sum16(P); PK4(P, 0, pa0); PK4(P, 8, pa1); } while (0)
#define PVM(S, d0) do { SCHED; pv2(o[d0], S, pa0, pa1); SCHED; } while (0)
#define PVHALF(b, h, NEXTK, nb, nh) do { \
    LGK(4); PVM(va, 0); v_read<VOFF(b, h, 2)>(vc, vb0); \
    LGK(4); PVM(vb_, 1); v_read<VOFF(b, h, 3)>(va, vb0); \
    LGK(4); PVM(vc, 2); v_read<VOFF(b, h, 4)>(vb_, vb0); \
    LGK(4); PVM(va, 3); v_read<VOFF(b, h, 5)>(vc, vb0); \
    LGK(4); PVM(vb_, 4); v_read<VOFF(b, h, 6)>(va, vb0); \
    LGK(4); PVM(vc, 5); v_read<VOFF(b, h, 7)>(vb_, vb0); \
    LGK(4); PVM(va, 6); if (NEXTK) { k0a = k8_read<KOFF(nb, nh)>(ka0); k0b = k8_read<KOFF(nb, nh)>(ka1); } \
    if (NEXTK) { LGK(2); } else { LGK(0); } PVM(vb_, 7); if (NEXTK) { k1a = k8_read<KOFF(nb, nh)>(ka2); k1b = k8_read<KOFF(nb, nh)>(ka3); } } while (0)
#define STEPC(b, j) do { if ((j) + 1 < NT) KVDMA((b) ^ 1, ((j) + 1) * KVBLK); \
    KPRO(b, 0); QKHALF(b, 0); SMH(); PVHALF(b, 0, true, b, 1); \
    QKHALF(b, 1); SMH(); PVHALF(b, 1, false, 0, 0); \
    VM0(); __syncthreads(); } while (0)
  KVDMA(0, 0); VM0(); __syncthreads();
  for (int j = 0; j < NT; j += 2) { STEPC(0, j); STEPC(1, j + 1); }
  { auto rr = __builtin_amdgcn_permlane32_swap(__float_as_uint(l_reg), __float_as_uint(l_reg), false, false); l_reg = __uint_as_float(rr[0]) + __uint_as_float(rr[1]); }
  if (hi == 0) li_l[r32] = l_reg; asm volatile("s_waitcnt lgkmcnt(0)" ::: "memory");
  bf16_t* Ow = Ob + (long)(wid * QBLK) * ldo;
#pragma unroll
  for (int r = 0; r < 16; ++r) { const int orow = crow(r, hi); const float rl = __builtin_amdgcn_rcpf(li_l[orow]);
#pragma unroll
    for (int d0 = 0; d0 < 8; ++d0) Ow[(long)orow * ldo + d0 * 32 + r32] = f2bf(o[d0][r] * rl); }
  VM0();
  __syncthreads();
#undef KVDMA
#undef KOFF
#undef VOFF
#undef KPRO
#undef V8
#undef QKHALF
#undef SMH
#undef PVM
#undef PVHALF
#undef STEPC
#undef VM0
}
__device__ __forceinline__ void attn_body_c256q8(const bf16_t* __restrict__ Qb, const int ldq, const unsigned char* __restrict__ K8, const int ldk8,
                                                 const bf16_t* __restrict__ Vh, const int ldk, bf16_t* __restrict__ Ob, const int ldo, const int seq, const float kmax2, LAS char* lds) {
  int tid = threadIdx.x; asm volatile("" : "+v"(tid)); tid &= 511;
  const int wid = tid >> 6, lane = tid & 63, r32 = lane & 31, hi = lane >> 5;
  v8i_ qf[2];
  const float nmc = load_q8(Qb + (long)(wid * QBLK + r32) * ldq, hi, qf, kmax2);
  if (__all(nmc > -64.f)) attn_body_c256q8_t<false>(K8, ldk8, Vh, ldk, Ob, ldo, seq, 0.f, qf, lds);
  else attn_body_c256q8_t<true>(K8, ldk8, Vh, ldk, Ob, ldo, seq, nmc, qf, lds);
}

template <bool SHIFT>
__device__ __forceinline__ void attn_body_q8_t(const unsigned char* __restrict__ K8, const int ldk8, const bf16_t* __restrict__ Vh, const int ldk,
                                               bf16_t* __restrict__ Ob, const int ldo, const int seq, const float nmc, const v8i_ (&qf)[2], LAS char* lds) {
  int tid = threadIdx.x; asm volatile("" : "+v"(tid)); tid &= 511;
  const int wid = __builtin_amdgcn_readfirstlane(tid >> 6), lane = tid & 63, r32 = lane & 31, hi = lane >> 5;
  constexpr int SK8 = KVBLK * 128, ST = SK8 + SHM_V;
  LAS float* li_l = (LAS float*)(lds + 3 * ST) + wid * 64;
  float l_reg = 0; f32x16 o[4] = {};
  const int vrb = v_rd_base(lane);
  const int kvo = k8_dma_voff(wid, lane, ldk8);
  const int vvo = unswap23(8 * (wid >> 1) + ((lane & 31) >> 2)) * ldk * 2 + ((2 * (wid & 1) + (lane >> 5)) * 32 + (lane & 3) * 8) * 2;
  const int l32 = 64 * ldk, pz = wid * 1024;
  const __amdgpu_buffer_rsrc_t krs = __builtin_amdgcn_make_buffer_rsrc((void*)K8, 0, 0x7ffffff0, 0x00020000);
  const __amdgpu_buffer_rsrc_t vrs = __builtin_amdgcn_make_buffer_rsrc((void*)Vh, 0, 0x7ffffff0, 0x00020000);
#define TDMA(slot, k0) do { const int _o = (k0) * ldk * 2; LAS char* _b = lds + (slot) * ST + pz; \
    DMA16(krs, _b, kvo, (k0) * ldk8); DMA16(vrs, _b + SK8, vvo, _o); DMA16(vrs, _b + SK8 + 8192, vvo, _o + l32); } while (0)
#define VM0() asm volatile("s_waitcnt vmcnt(0)" ::: "memory")
  int sc1; asm volatile("v_mov_b32 %0, 0x7f7f7f7f" : "=v"(sc1));
  const int kof = r32 * 128 + (((2 * hi) ^ ((r32 >> 1) & 7)) << 4);
#define QKT8(P0, P1, Ks) do { \
    const v4i a0 = *(LAS const v4i*)((Ks) + kof), a1 = *(LAS const v4i*)((Ks) + (kof ^ 16)), a2 = *(LAS const v4i*)((Ks) + (kof ^ 64)), a3 = *(LAS const v4i*)((Ks) + (kof ^ 80)); \
    const v4i b0 = *(LAS const v4i*)((Ks) + 4096 + kof), b1 = *(LAS const v4i*)((Ks) + 4096 + (kof ^ 16)), b2 = *(LAS const v4i*)((Ks) + 4096 + (kof ^ 64)), b3 = *(LAS const v4i*)((Ks) + 4096 + (kof ^ 80)); \
    v8i_ k00 = (v8i_){a0[0], a0[1], a0[2], a0[3], a1[0], a1[1], a1[2], a1[3]}, k01 = (v8i_){a2[0], a2[1], a2[2], a2[3], a3[0], a3[1], a3[2], a3[3]}; \
    v8i_ k10 = (v8i_){b0[0], b0[1], b0[2], b0[3], b1[0], b1[1], b1[2], b1[3]}, k11 = (v8i_){b2[0], b2[1], b2[2], b2[3], b3[0], b3[1], b3[2], b3[3]}; \
    if (SHIFT) { _Pragma("unroll") for (int r = 0; r < 16; ++r) { P0[r] = nmc; P1[r] = nmc; } \
      asm volatile("s_nop 4\n\tv_mfma_scale_f32_32x32x64_f8f6f4 %0, %1, %2, %0, %3, %3 op_sel_hi:[0,0,0]" : "+v"(P0) : "v"(k00), "v"(qf[0]), "v"(sc1)); \
      asm volatile("v_mfma_scale_f32_32x32x64_f8f6f4 %0, %1, %2, %0, %3, %3 op_sel_hi:[0,0,0]" : "+v"(P1) : "v"(k10), "v"(qf[0]), "v"(sc1)); } \
    else { asm volatile("v_mfma_scale_f32_32x32x64_f8f6f4 %0, %1, %2, 0, %3, %3 op_sel_hi:[0,0,0]" : "=&v"(P0) : "v"(k00), "v"(qf[0]), "v"(sc1)); \
      asm volatile("v_mfma_scale_f32_32x32x64_f8f6f4 %0, %1, %2, 0, %3, %3 op_sel_hi:[0,0,0]" : "=&v"(P1) : "v"(k10), "v"(qf[0]), "v"(sc1)); } \
    asm volatile("v_mfma_scale_f32_32x32x64_f8f6f4 %0, %1, %2, %0, %3, %3 op_sel_hi:[0,0,0]" : "+v"(P0) : "v"(k01), "v"(qf[1]), "v"(sc1)); \
    asm volatile("v_mfma_scale_f32_32x32x64_f8f6f4 %0, %1, %2, %0, %3, %3 op_sel_hi:[0,0,0]" : "+v"(P1) : "v"(k11), "v"(qf[1]), "v"(sc1)); \
      \
    asm volatile("s_nop 15" : "+v"(k00), "+v"(k01), "+v"(k10), "+v"(k11)); } while (0)
#define TIE(P0, P1) asm volatile("s_nop 15\n\ts_nop 7" : "+v"(P0), "+v"(P1))
#define TIE0(P0, P1) asm volatile("" : "+v"(P0), "+v"(P1))
#define FINISH(P0, P1) do { exp16(P1); l_reg += sum16(P0) + sum16(P1); PK4(P0, 0, pa0); PK4(P0, 8, pa1); PK4(P1, 0, pa2); PK4(P1, 8, pa3); } while (0)
  f32x16 pA0, pA1, pB0, pB1; bf16x8 pa0, pa1, pa2, pa3; const int NT = seq / KVBLK;
  TDMA(0, 0); VM0(); __syncthreads();
  TDMA(1, KVBLK);
  QKT8(pA0, pA1, lds); TIE(pA0, pA1); exp16(pA0);
  VM0(); __syncthreads();
  int sk = 1, sv = 0, sd = 2;
  for (int j = 1; j + 1 < NT; j += 2) {
    TDMA(sd, (j + 1) * KVBLK);
    SCHED; QKT8(pB0, pB1, lds + sk * ST);
    FINISH(pA0, pA1); SCHED;
    pv_d0(o, (int)(uintptr_t)(lds + sv * ST + SK8) + vrb, pa0, pa1, pa2, pa3); TIE0(pB0, pB1); exp16(pB0);
    VM0(); __syncthreads();
    { const int t = sv; sv = sk; sk = sd; sd = t; }
    if (j + 2 < NT) TDMA(sd, (j + 2) * KVBLK);
    SCHED; QKT8(pA0, pA1, lds + sk * ST);
    FINISH(pB0, pB1); SCHED;
    pv_d0(o, (int)(uintptr_t)(lds + sv * ST + SK8) + vrb, pa0, pa1, pa2, pa3); TIE0(pA0, pA1); exp16(pA0);
    VM0(); __syncthreads();
    { const int t = sv; sv = sk; sk = sd; sd = t; }
  }
  SCHED; QKT8(pB0, pB1, lds + sk * ST);
  FINISH(pA0, pA1); SCHED;
  pv_d0(o, (int)(uintptr_t)(lds + sv * ST + SK8) + vrb, pa0, pa1, pa2, pa3); TIE0(pB0, pB1); exp16(pB0);
  FINISH(pB0, pB1); SCHED;
  pv_d0(o, (int)(uintptr_t)(lds + sk * ST + SK8) + vrb, pa0, pa1, pa2, pa3);
  { auto rr = __builtin_amdgcn_permlane32_swap(__float_as_uint(l_reg), __float_as_uint(l_reg), false, false); l_reg = __uint_as_float(rr[0]) + __uint_as_float(rr[1]); }
#if DENSE8_G2
  store_o8(o, l_reg, li_l, (unsigned char*)Ob + (long)(wid * QBLK) * ldo, ldo, r32, hi);
#else
  store_o(o, l_reg, li_l, Ob + (long)(wid * QBLK) * ldo, ldo, r32, hi);
#endif
  VM0();
  __syncthreads();
#undef TDMA
#undef VM0
#undef QKT8
#undef TIE
#undef TIE0
#undef FINISH
}
__device__ __forceinline__ void attn_body_q8(const bf16_t* __restrict__ Qb, const int ldq, const unsigned char* __restrict__ K8, const int ldk8,
                                             const bf16_t* __restrict__ Vh, const int ldk, bf16_t* __restrict__ Ob, const int ldo, const int seq, const float kmax2, LAS char* lds) {
  int tid = threadIdx.x; asm volatile("" : "+v"(tid)); tid &= 511;
  const int wid = tid >> 6, lane = tid & 63, r32 = lane & 31, hi = lane >> 5;
  v8i_ qf[2];
  const float nmc = load_q8(Qb + (long)(wid * QBLK + r32) * ldq, hi, qf, kmax2);
  if (__all(nmc > -64.f)) attn_body_q8_t<false>(K8, ldk8, Vh, ldk, Ob, ldo, seq, 0.f, qf, lds);
  else attn_body_q8_t<true>(K8, ldk8, Vh, ldk, Ob, ldo, seq, nmc, qf, lds);
}
#undef PK4
}

__device__ __forceinline__ int perm_plain8(int n) { const int r = n & 31; return (n & ~31) + 16 * ((r >> 2) & 1) + 4 * (r >> 3) + (r & 3); }
__device__ __forceinline__ int perm_row(int kind, int n) {
  if (kind == 0) return perm_plain8(n);
  if (kind == 1) { if (n < N_QKV0) return perm_plain8(n); const int c = n - N_QKV0; const int ch = c & 1023; return N_QKV0 + 32 * (ch >> 4) + ((c >> 10) << 4) + (ch & 15); }
  return 32 * (n >> 4) + ((kind == 3) ? 16 : 0) + (n & 15);
}
__device__ __forceinline__ void cvt_tile(const float* __restrict__ src, int N, bf16_t* __restrict__ dst, int K, int kind, int k0, int n0, LAS unsigned* t32) {
  int tid = threadIdx.x; asm volatile("" : "+v"(tid)); tid &= 511;
#pragma unroll
  for (int j = 0; j < 2; ++j) {
    const int item = tid + 512 * j, kp = item >> 4, q = item & 15;
    const f32x4 v0 = *(const f32x4*)(src + (size_t)(k0 + 2 * kp) * N + n0 + 4 * q);
    const f32x4 v1 = *(const f32x4*)(src + (size_t)(k0 + 2 * kp + 1) * N + n0 + 4 * q);
#pragma unroll
    for (int i = 0; i < 4; ++i) t32[(4 * q + i) * 65 + kp] = cvtpk(v0[i], v1[i]);
  }
  __syncthreads();
#pragma unroll
  for (int j = 0; j < 2; ++j) {
    const int item = tid + 512 * j, n = item >> 4, ko = item & 15;
    u32x4 v;
#pragma unroll
    for (int i = 0; i < 4; ++i) v[i] = t32[n * 65 + 4 * ko + i];
    *(u32x4*)(dst + (size_t)perm_row(kind, n0 + n) * K + k0 + 8 * ko) = v;
  }
  __syncthreads();
}
__device__ __forceinline__ void cvt_matrix_units(const float* src, int K, int N, bf16_t* dst, int kind, int u0, int ustride, LAS unsigned* t32) {
  const int nN = N / 64, nK = K / 128;
  for (int u = u0; u < nN * nK; u += ustride) cvt_tile(src, N, dst, K, kind, (u / nN) * 128, (u % nN) * 64, t32);
}
constexpr size_t WMOE8_E = (size_t)1024 * D + (size_t)D * EFF;
__device__ __forceinline__ void cvt_tile8(const float* __restrict__ src, int N, unsigned char* __restrict__ dst, int K, int kind, int k0, int n0, float scale, LAS unsigned* t32) {
  int tid = threadIdx.x; asm volatile("" : "+v"(tid)); tid &= 511;
  { const int kq = tid >> 4, q = tid & 15;
    f32x4 v[4];
#pragma unroll
    for (int r = 0; r < 4; ++r) v[r] = *(const f32x4*)(src + (size_t)(k0 + 4 * kq + r) * N + n0 + 4 * q);
#pragma unroll
    for (int i = 0; i < 4; ++i) t32[(4 * q + i) * 33 + kq] = pack_fp8x4(v[0][i] * scale, v[1][i] * scale, v[2][i] * scale, v[3][i] * scale); }
  __syncthreads();
  { const int n = tid >> 3, kc = tid & 7;
    u32x4 v;
#pragma unroll
    for (int i = 0; i < 4; ++i) v[i] = t32[n * 33 + 4 * kc + i];
    *(u32x4*)(dst + (size_t)perm_row(kind, n0 + n) * K + k0 + 16 * kc) = v; }
  __syncthreads();
}
__device__ __forceinline__ void cvt_matrix_units8(const float* src, int K, int N, unsigned char* dst, int kind, float scale, LAS unsigned* t32) {
  const int nN = N / 64, nK = K / 128;
  for (int u = blockIdx.x; u < nN * nK; u += gridDim.x) cvt_tile8(src, N, dst, K, kind, (u / nN) * 128, (u % nN) * 64, scale, t32);
}
__device__ __forceinline__ void cvt_moe_all8(const Args& a, LAS unsigned* t32) {
  unsigned char* W = (unsigned char*)(a.ws + WS_WMOE);
  for (int u = blockIdx.x; u < 2 * 65 * 384; u += gridDim.x) {
    const int le = u / 384, L = le / 65, e = le % 65, r = u % 384, mtx = r >> 7, lu = r & 127;
    const float* src; unsigned char* dst = W + (size_t)le * WMOE8_E; int K, N, kind; float sc;
    if (mtx == 0)      { src = e < 64 ? a.in[21] + ((size_t)L * 64 + e) * D * EFF : a.in[24] + (size_t)L * D * EFF; K = D; N = EFF; kind = 2; sc = 256.f; }
    else if (mtx == 1) { src = e < 64 ? a.in[22] + ((size_t)L * 64 + e) * D * EFF : a.in[25] + (size_t)L * D * EFF; K = D; N = EFF; kind = 3; sc = 256.f; }
    else               { src = e < 64 ? a.in[23] + ((size_t)L * 64 + e) * EFF * D : a.in[26] + (size_t)L * EFF * D; K = EFF; N = D; kind = 0; sc = 128.f; dst += (size_t)1024 * D; }
    const int nN = N / 64;
    cvt_tile8(src, N, dst, K, kind, (lu / nN) * 128, (lu % nN) * 64, sc, t32);
  }
}

__device__ __forceinline__ void ld_row_f32(const float* __restrict__ p, int lane, float (&v)[32]) {
#pragma unroll
  for (int j = 0; j < 4; ++j) { const f32x4 t0 = *(const f32x4*)(p + 8 * lane + 512 * j), t1 = *(const f32x4*)(p + 8 * lane + 512 * j + 4);
#pragma unroll
    for (int i = 0; i < 4; ++i) { v[8 * j + i] = t0[i]; v[8 * j + 4 + i] = t1[i]; } }
}
__device__ __forceinline__ void ld_row_bf16(const bf16_t* __restrict__ p, int lane, float (&v)[32]) {
#pragma unroll
  for (int j = 0; j < 4; ++j) { const u32x4 t = *(const u32x4*)(p + 8 * lane + 512 * j);
#pragma unroll
    for (int i = 0; i < 4; ++i) { v[8 * j + 2 * i] = bflo(t[i]); v[8 * j + 2 * i + 1] = bfhi(t[i]); } }
}
__device__ __forceinline__ void ld_row_fp8(const unsigned char* __restrict__ p, int lane, float (&v)[32]) {
#pragma unroll
  for (int j = 0; j < 4; ++j) { const u32x2 t = *(const u32x2*)(p + 8 * lane + 512 * j);
#pragma unroll
    for (int i = 0; i < 2; ++i) { v[8 * j + 4 * i] = __builtin_amdgcn_cvt_f32_fp8((int)t[i], 0); v[8 * j + 4 * i + 1] = __builtin_amdgcn_cvt_f32_fp8((int)t[i], 1);
      v[8 * j + 4 * i + 2] = __builtin_amdgcn_cvt_f32_fp8((int)t[i], 2); v[8 * j + 4 * i + 3] = __builtin_amdgcn_cvt_f32_fp8((int)t[i], 3); } }
}
__device__ __forceinline__ void ld8f(const float* __restrict__ p, float (&x)[8]) { const f32x4 t0 = *(const f32x4*)p, t1 = *(const f32x4*)(p + 4);
#pragma unroll
  for (int i = 0; i < 4; ++i) { x[i] = t0[i]; x[4 + i] = t1[i]; } }
__device__ __forceinline__ void st8f(float* __restrict__ p, const float* x) { f32x4 t0 = {x[0], x[1], x[2], x[3]}, t1 = {x[4], x[5], x[6], x[7]}; *(f32x4*)p = t0; *(f32x4*)(p + 4) = t1; }
__device__ __forceinline__ float sumsq32(const float (&v)[32]) { float s = 0;
#pragma unroll
  for (int i = 0; i < 32; ++i) s += v[i] * v[i];
  return wave_sum(s); }
template <bool COPY, bool OUT8 = false>
__device__ __forceinline__ void modulate_store(const float (&v)[32], float rstd, const float* __restrict__ g, const float* __restrict__ shift, const float* __restrict__ scale,
                                               bf16_t* __restrict__ dst, int lane, LAS float* f32copy) {
#pragma unroll
  for (int j = 0; j < 4; ++j) {
    const int idx = 8 * lane + 512 * j;
    float gv[8], sh[8], sc[8], y[8]; ld8f(g + idx, gv); ld8f(shift + idx, sh); ld8f(scale + idx, sc);
#pragma unroll
    for (int i = 0; i < 8; ++i) y[i] = v[8 * j + i] * rstd * gv[i] * (1.f + sc[i]) + sh[i];
    if (OUT8) { u32x2 p8 = {pack_fp8x4(y[0], y[1], y[2], y[3]), pack_fp8x4(y[4], y[5], y[6], y[7])}; *(u32x2*)((unsigned char*)dst + idx) = p8; }
    else { u32x4 pk = {cvtpk(y[0], y[1]), cvtpk(y[2], y[3]), cvtpk(y[4], y[5]), cvtpk(y[6], y[7])}; *(u32x4*)(dst + idx) = pk; }
    if (COPY) { f32x4 t0 = {y[0], y[1], y[2], y[3]}, t1 = {y[4], y[5], y[6], y[7]};
      *(LAS f32x4*)(f32copy + idx) = t0; *(LAS f32x4*)(f32copy + idx + 4) = t1; }
  }
}

__device__ __forceinline__ void phase_prologue(const Args& a, LAS char* lds) {
  int tid = threadIdx.x; asm volatile("" : "+v"(tid)); tid &= 511; const int wave = tid >> 6, lane = tid & 63;
  {
    LAS float* sc = (LAS float*)lds;
    LAS float* part = sc + 4096;
    const float* c = a.in[1]; const float* cc = a.in[3];
    for (int i = tid; i < D; i += NTHREADS) { float v = c[i]; sc[i] = v * sigmoidf_(v); float u = cc[i]; sc[D + i] = u * sigmoidf_(u); }
    __syncthreads();
    float* MOD = (float*)(a.ws + WS_MOD);
    for (int u = blockIdx.x; u < 2 * 192; u += gridDim.x) {
      const int L = u / 192, chunk = u % 192;
      const float* W = a.in[4] + (size_t)L * D * 12288 + chunk * 64 + lane;
      float a0 = 0, a1 = 0; const int d0 = wave * 256;
#pragma unroll 8
      for (int dd = 0; dd < 256; ++dd) { const float w = W[(size_t)(d0 + dd) * 12288]; a0 += sc[d0 + dd] * w; a1 += sc[D + d0 + dd] * w; }
      part[(wave * 2 + 0) * 64 + lane] = a0; part[(wave * 2 + 1) * 64 + lane] = a1;
      __syncthreads();
      if (tid < 128) { const int which = tid >> 6; float s = 0;
#pragma unroll
        for (int w = 0; w < 8; ++w) s += part[(w * 2 + which) * 64 + lane];
        const int j = chunk * 64 + lane; MOD[(size_t)(L * 2 + which) * 12288 + j] = s + a.in[5][L * 12288 + j]; }
      __syncthreads();
    }
  }
  LAS unsigned* t32 = (LAS unsigned*)lds;
  cvt_matrix_units8(a.in[7], D, N_IN0, (unsigned char*)(a.ws + WS_WIN0), 1, 256.f, t32);
#if DENSE8_G2
  cvt_matrix_units8(a.in[8], D, D, (unsigned char*)(a.ws + WS_WOUT0), 0, 256.f, t32);
  cvt_matrix_units8(a.in[16], D, D, (unsigned char*)(a.ws + WS_WOUT1), 0, 256.f, t32);
#else
  cvt_matrix_units(a.in[8], D, D, (bf16_t*)(a.ws + WS_WOUT0), 0, blockIdx.x, gridDim.x, t32);
  cvt_matrix_units(a.in[16], D, D, (bf16_t*)(a.ws + WS_WOUT1), 0, blockIdx.x, gridDim.x, t32);
#endif
  cvt_matrix_units8(a.in[15], D, N_IN1, (unsigned char*)(a.ws + WS_WIN1), 0, 256.f, t32);
  cvt_moe_all8(a, t32);
}

__device__ __forceinline__ void phase_modulate0(const Args& a) {
  int tid = threadIdx.x; asm volatile("" : "+v"(tid)); tid &= 511; const int wave = tid >> 6, lane = tid & 63;
  const float* MOD = (const float*)(a.ws + WS_MOD);
  bf16_t* A = (bf16_t*)(a.ws + WS_ABUF);
  for (int it = blockIdx.x; it < MT / 8; it += gridDim.x) {
    const int r = it * 8 + wave;
    const float* src = r < CTXL ? a.in[2] + (size_t)r * D : a.in[0] + (size_t)(r - CTXL) * D;
    const float* mod = MOD + (r < CTXL ? 12288 : 0);
    float v[32]; ld_row_f32(src, lane, v);
    const float rstd = rsqrtf(sumsq32(v) * (1.f / D) + EPS);
    modulate_store<false, true>(v, rstd, a.in[6], mod, mod + D, (bf16_t*)((unsigned char*)A + (size_t)r * D), lane, nullptr);
  }
}

__device__ __forceinline__ void rope_cs4(int r, int lane, float (&cs)[4], float (&sn)[4]) {
#pragma unroll
  for (int q = 0; q < 4; ++q) { cs[q] = 1.f; sn[q] = 0.f; }
  if (r >= CTXL) { const int t = r - CTXL; const int l = lane & 15, a = l >> 3, i0 = 4 * (l & 7);
    const float pos = a ? (float)(t & 63) : (float)(t >> 6);
#pragma unroll
    for (int q = 0; q < 4; ++q) { const float inv = powf(10000.f, -(float)(i0 + q) / 32.f); sincosf(pos * inv, &sn[q], &cs[q]); } }
}
__device__ __forceinline__ float sum16lanes(float v) { v += __shfl_xor(v, 1); v += __shfl_xor(v, 2); v += __shfl_xor(v, 4); v += __shfl_xor(v, 8); return v; }
__device__ __forceinline__ void phase_rope_conv0(const Args& a, LAS char* lds, bool dry = false) {
  int tid = threadIdx.x; asm volatile("" : "+v"(tid)); tid &= 511; const int wave = tid >> 6, lane = tid & 63;
  bf16_t* Q = (bf16_t*)(a.ws + WS_QKVU);
  {
    const bf16_t* HG = (const bf16_t*)(a.ws + WS_HG);
    bf16_t* X2 = (bf16_t*)(a.ws + WS_X2);
    LAS char* lt = lds;
    LAS float* part = (LAS float*)(lds + 62 * 2048);
    LAS float* stats = part + 512;
    const float* dw_w = a.in[11]; const float* dw_b = a.in[12]; const float* ln_g = a.in[13]; const float* ln_b = a.in[14];
    const __amdgpu_buffer_rsrc_t wrs = __builtin_amdgcn_make_buffer_rsrc((void*)dw_w, 0, 31 * 1024 * 4, 0x00020000);
    for (int u = blockIdx.x; u < 520; u += gridDim.x) {
      int seg0, seg1, r0;
      if (u < 8) { seg0 = 0; seg1 = CTXL; r0 = u * 32; } else { seg0 = CTXL; seg1 = MT; r0 = CTXL + (u - 8) * 32; }
      for (int c = tid; c < 62 * 128; c += NTHREADS) { const int rr = c >> 7, cc = c & 127, gr = r0 - 15 + rr;
        u32x4 v = {0u, 0u, 0u, 0u}; if (gr >= seg0 && gr < seg1) v = *(const u32x4*)(HG + (size_t)gr * 1024 + cc * 8);
        *(LAS u32x4*)(lt + rr * 2048 + cc * 16) = v; }
      __syncthreads();
      float w0[31], w1[31];
#pragma unroll
      for (int j = 0; j < 31; ++j) { const u32x2 w = __builtin_amdgcn_raw_buffer_load_b64(wrs, tid * 8, j * 4096, 0); w0[j] = __uint_as_float(w[0]); w1[j] = __uint_as_float(w[1]); }
      const f32x2 bb = *(const f32x2*)(dw_b + 2 * tid);
      const f32x2 gg = *(const f32x2*)(ln_g + 2 * tid), gb = *(const f32x2*)(ln_b + 2 * tid);
#pragma unroll 1
      for (int hf = 0; hf < 4; ++hf) {
        float o0[8], o1[8];
        LAS const char* lth = lt + (hf * 8) * 2048 + tid * 4;
#pragma unroll
        for (int r = 0; r < 8; ++r) { o0[r] = bb[0]; o1[r] = bb[1]; }
#pragma unroll
        for (int i = 0; i < 38; ++i) {
          const unsigned p = *(LAS const unsigned*)(lth + i * 2048);
          const float x0 = bflo(p), x1 = bfhi(p);
#pragma unroll
          for (int r = 0; r < 8; ++r) { const int j = i - r; if (j >= 0 && j < 31) { o0[r] += x0 * w0[j]; o1[r] += x1 * w1[j]; } }
        }
#pragma unroll
        for (int r = 0; r < 8; ++r) {
          const float s = wave_sum(o0[r] + o1[r]), q = wave_sum(o0[r] * o0[r] + o1[r] * o1[r]);
          if (lane == 0) { part[(r * 8 + wave) * 2] = s; part[(r * 8 + wave) * 2 + 1] = q; }
        }
        __syncthreads();
        if (tid < 8) { float s = 0, q = 0;
#pragma unroll
          for (int w = 0; w < 8; ++w) { s += part[(tid * 8 + w) * 2]; q += part[(tid * 8 + w) * 2 + 1]; }
          const float mean = s * (1.f / 1024), var = q * (1.f / 1024) - mean * mean;
          stats[tid * 2] = mean; stats[tid * 2 + 1] = rsqrtf(fmaxf(var, 0.f) + EPS); }
        __syncthreads();
#pragma unroll
        for (int r = 0; r < 8; ++r) {
          const float mean = stats[r * 2], rstd = stats[r * 2 + 1];
          float y0 = (o0[r] - mean) * rstd * gg[0] + gb[0], y1 = (o1[r] - mean) * rstd * gg[1] + gb[1];
          y0 = y0 * sigmoid_fast(y0); y1 = y1 * sigmoid_fast(y1);
#if DENSE8_G2
          *(unsigned short*)((unsigned char*)X2 + (size_t)(r0 + hf * 8 + r) * D + 1024 + 2 * tid) = (unsigned short)__builtin_amdgcn_cvt_pk_fp8_f32(y0 * 8.f, y1 * 8.f, 0, false);
#else
          *(unsigned*)(X2 + (size_t)(r0 + hf * 8 + r) * D + 1024 + 2 * tid) = cvtpk(y0, y1);
#endif
        }
      }
      __syncthreads();
    }
  }
  const float* qn = a.in[9]; const float* kn = a.in[10];
  unsigned* kmx = (unsigned*)(a.ws + WS_CTL + CTL_KMAX);
  const int slot = lane >> 4, l16 = lane & 15, e1 = (l16 >> 3) * 64 + 4 * (l16 & 7), e2 = e1 + 32;
  float km0 = 0.f, km1 = 0.f;
  for (int it = blockIdx.x; it < MT / 8; it += gridDim.x) {
    const int r = it * 8 + wave;
    float cs[4], sn[4]; rope_cs4(r, lane, cs, sn);
    bf16_t* rowp = Q + (size_t)r * N_QKV0;
#pragma unroll
    for (int hb = 0; hb < 12; hb += 4) {
      const int hh = hb + slot;
      if (hh < 10) {
        const float* g = hh < 8 ? qn : kn;
        const u32x2 a1 = *(const u32x2*)(rowp + hh * 128 + e1), a2 = *(const u32x2*)(rowp + hh * 128 + e2);
        float x1[4] = {bflo(a1[0]), bfhi(a1[0]), bflo(a1[1]), bfhi(a1[1])}, x2[4] = {bflo(a2[0]), bfhi(a2[0]), bflo(a2[1]), bfhi(a2[1])};
        float ss = 0;
#pragma unroll
        for (int q = 0; q < 4; ++q) ss += x1[q] * x1[q] + x2[q] * x2[q];
        ss = sum16lanes(ss);
        const float rstd = rsqrtf(ss * (1.f / 128) + EPS);
        const f32x4 g1 = *(const f32x4*)(g + e1), g2 = *(const f32x4*)(g + e2);
        float o1[4], o2[4], so = 0;
#pragma unroll
        for (int q = 0; q < 4; ++q) { const float y1 = x1[q] * rstd * g1[q], y2 = x2[q] * rstd * g2[q]; o1[q] = y1 * cs[q] - y2 * sn[q]; o2[q] = y2 * cs[q] + y1 * sn[q]; }
        const u32x2 w1 = {cvtpk(o1[0], o1[1]), cvtpk(o1[2], o1[3])}, w2 = {cvtpk(o2[0], o2[1]), cvtpk(o2[2], o2[3])};
        if (!dry) { *(u32x2*)(rowp + hh * 128 + e1) = w1; *(u32x2*)(rowp + hh * 128 + e2) = w2; }
        if (hb == 8) {
          const unsigned q1 = pack8x4(o1[0], o1[1], o1[2], o1[3]), q2 = pack8x4(o2[0], o2[1], o2[2], o2[3]);
          unsigned char* k8p = (unsigned char*)(a.ws + WS_K8) + (size_t)r * 256 + (hh - 8) * 128;
          *(unsigned*)(k8p + e1) = q1; *(unsigned*)(k8p + e2) = q2;
          so = sum16lanes(sq8x4(q1) + sq8x4(q2)); if (slot == 0) km0 = fmaxf(km0, so); else km1 = fmaxf(km1, so);
        }
      }
    }
  }
  if (l16 == 0 && slot < 2) atomicMax(&kmx[slot], __float_as_uint(slot == 0 ? km0 : km1));
}
__device__ __forceinline__ void phase_rope1(const Args& a, LAS char* lds, bool dry = false) {
  int tid = threadIdx.x; asm volatile("" : "+v"(tid)); tid &= 511; const int wave = tid >> 6, lane = tid & 63;
  bf16_t* Q = (bf16_t*)(a.ws + WS_QKVU);
  unsigned* kmx = (unsigned*)(a.ws + WS_CTL + CTL_KMAX) + 16;
  unsigned char* K8 = (unsigned char*)(a.ws + WS_K8);
  LAS unsigned* lk = (LAS unsigned*)lds;
  if (tid < 16) lk[tid] = 0u;
  __syncthreads();
  const int slot = lane >> 4, l16 = lane & 15, e1 = (l16 >> 3) * 64 + 4 * (l16 & 7), e2 = e1 + 32;
  for (int it = blockIdx.x; it < MT / 8; it += gridDim.x) {
    const int r = it * 8 + wave;
    float cs[4], sn[4]; rope_cs4(r, lane, cs, sn);
    bf16_t* rowp = Q + (size_t)r * N_IN1;
#pragma unroll 2
    for (int hb = (r < CTXL ? 16 : 0); hb < 32; hb += 4) {
      const int hh = hb + slot;
      const u32x2 a1 = *(const u32x2*)(rowp + hh * 128 + e1), a2 = *(const u32x2*)(rowp + hh * 128 + e2);
      const float x1[4] = {bflo(a1[0]), bfhi(a1[0]), bflo(a1[1]), bfhi(a1[1])}, x2[4] = {bflo(a2[0]), bfhi(a2[0]), bflo(a2[1]), bfhi(a2[1])};
      float o1[4], o2[4];
#pragma unroll
      for (int q = 0; q < 4; ++q) { o1[q] = x1[q] * cs[q] - x2[q] * sn[q]; o2[q] = x2[q] * cs[q] + x1[q] * sn[q]; }
      const u32x2 w1 = {cvtpk(o1[0], o1[1]), cvtpk(o1[2], o1[3])}, w2 = {cvtpk(o2[0], o2[1]), cvtpk(o2[2], o2[3])};
      if (r >= CTXL && !dry) { *(u32x2*)(rowp + hh * 128 + e1) = w1; *(u32x2*)(rowp + hh * 128 + e2) = w2; }
      if (hb >= 16) {
        const unsigned q1 = pack8x4(o1[0], o1[1], o1[2], o1[3]), q2 = pack8x4(o2[0], o2[1], o2[2], o2[3]);
        unsigned char* k8p = K8 + (size_t)r * 2048 + (hh - 16) * 128;
        *(unsigned*)(k8p + e1) = q1; *(unsigned*)(k8p + e2) = q2;
        float so = sum16lanes(sq8x4(q1) + sq8x4(q2));
        if (l16 == 0) atomicMax((unsigned*)&lk[hh - 16], __float_as_uint(so));
      }
    }
  }
  __syncthreads();
  if (tid < 16) atomicMax(&kmx[tid], lk[tid]);
  __syncthreads();
}

__device__ __forceinline__ void phase_attn(const Args& a, int L, LAS char* lds) {
  const bf16_t* Q = (const bf16_t*)(a.ws + WS_QKVU);
  const unsigned* kmx = (const unsigned*)(a.ws + WS_CTL + CTL_KMAX) + L * 16;
  if (L == 0) {
    bf16_t* X2 = (bf16_t*)(a.ws + WS_X2);
    for (int u = blockIdx.x; u < 520; u += gridDim.x) {
      const int head = u < 512 ? (u & 7) : (u - 512);
      const float kmax2 = __uint_as_float(kmx[head >> 2]);
      if (u < 512) { const int qb = u >> 3; const size_t q0 = (size_t)(CTXL + qb * 256);
        at::attn_body_q8(Q + q0 * N_QKV0 + head * 128, N_QKV0, (const unsigned char*)(a.ws + WS_K8) + (head >> 2) * 128, 256, Q + 1280 + (head >> 2) * 128, N_QKV0, (DENSE8_G2 ? (bf16_t*)((unsigned char*)X2 + q0 * D + head * 128) : X2 + q0 * D + head * 128), D, MT, kmax2, lds);
      } else {
        at::attn_body_q8(Q + head * 128, N_QKV0, (const unsigned char*)(a.ws + WS_K8) + (head >> 2) * 128, 256, Q + 1280 + (head >> 2) * 128, N_QKV0, (DENSE8_G2 ? (bf16_t*)((unsigned char*)X2 + head * 128) : X2 + head * 128), D, CTXL, kmax2, lds); }
    }
  } else {
    bf16_t* O = (bf16_t*)(a.ws + WS_Y);
    for (int u = blockIdx.x; u < 1024; u += gridDim.x) {
      const int x = u & 7, w = u >> 3, hc = x + 8 * (w >> 6), qb = w & 63, h = hc >> 1;
      const float kmax2 = __uint_as_float(kmx[hc]);
      const size_t q0 = (size_t)(CTXL + qb * 256);
      at::attn_body_c256q8(Q + q0 * N_IN1 + hc * 128, N_IN1, (const unsigned char*)(a.ws + WS_K8) + hc * 128, 2048, Q + 4096 + h * 256, N_IN1,
                           O + (size_t)(qb * 256) * 4096 + hc * 256, 4096, MT, kmax2, lds);
    }
  }
}

__device__ __forceinline__ void phase_diff(const Args& a) {
  int tid = threadIdx.x; asm volatile("" : "+v"(tid)); tid &= 511; const int wave = tid >> 6, lane = tid & 63;
  const bf16_t* O = (const bf16_t*)(a.ws + WS_Y);
  bf16_t* X2 = (bf16_t*)(a.ws + WS_X2);
  const float* lp = a.in[17];
  const float s1 = wave_sum(lp[lane] * lp[128 + lane] + lp[64 + lane] * lp[192 + lane]);
  const float s2 = wave_sum(lp[256 + lane] * lp[384 + lane] + lp[320 + lane] * lp[448 + lane]);
  const float lam = expf(s1) - expf(s2) + LAM_INIT;
  const f32x4 sg = *(const f32x4*)(a.in[18] + 4 * lane);
  for (int it = blockIdx.x; it < SEQ / 8; it += gridDim.x) {
    const int t = it * 8 + wave;
    const bf16_t* op = O + (size_t)t * 4096;
    unsigned char* xp = (unsigned char*)X2 + (size_t)(CTXL + t) * D * (DENSE8_G2 ? 1 : 2);
#pragma unroll 2
    for (int h = 0; h < 8; ++h) {
      const u32x2 a0 = *(const u32x2*)(op + (2 * h) * 256 + 4 * lane), a1 = *(const u32x2*)(op + (2 * h + 1) * 256 + 4 * lane);
      float d[4] = {bflo(a0[0]) - lam * bflo(a1[0]), bfhi(a0[0]) - lam * bfhi(a1[0]), bflo(a0[1]) - lam * bflo(a1[1]), bfhi(a0[1]) - lam * bfhi(a1[1])};
      const float ss = wave_sum(d[0] * d[0] + d[1] * d[1] + d[2] * d[2] + d[3] * d[3]);
      const float rstd = rsqrtf(ss * (1.f / 256) + EPS) * (1.f - LAM_INIT);
#if DENSE8_G2
      const float r8 = rstd * 8.f;
      *(unsigned*)(xp + h * 256 + 4 * lane) = pack8x4(d[0] * r8 * sg[0], d[1] * r8 * sg[1], d[2] * r8 * sg[2], d[3] * r8 * sg[3]);
#else
      u32x2 pk = {cvtpk(d[0] * rstd * sg[0], d[1] * rstd * sg[1]), cvtpk(d[2] * rstd * sg[2], d[3] * rstd * sg[3])};
      *(u32x2*)((bf16_t*)xp + h * 256 + 4 * lane) = pk;
#endif
    }
  }
}

__device__ __forceinline__ void phase_G(const Args& a, int L, LAS char* lds, bool dry = false) {
  int tid = threadIdx.x; asm volatile("" : "+v"(tid)); tid &= 511; const int wave = tid >> 6, lane = tid & 63;
  const int NTOK = L == 0 ? MT : SEQ, ROW0 = L == 0 ? 0 : CTXL;
  const float* ng = a.in[6] + (size_t)L * 4 * D;
  const float* MODL = (const float*)(a.ws + WS_MOD) + (size_t)(L * 2) * 12288;
  const float* router = a.in[19] + (size_t)L * D * NE; const float* rbias = a.in[20] + L * NE;
  const bf16_t* OUT = (const bf16_t*)(a.ws + WS_OUT);
  float* HRES = (float*)(a.ws + WS_HRES);
  bf16_t* F = (bf16_t*)(a.ws + WS_ABUF);
  int* counts = (int*)(a.ws + WS_CTL + CTL_CNT) + L * 64;
  int* top_e = (int*)(a.ws + WS_TOPE); float* top_w = (float*)(a.ws + WS_TOPW); int* top_p = (int*)(a.ws + WS_TOPP);
  LAS float* ft = (LAS float*)lds;
  LAS float* part = ft + 8 * D;
  for (int it = blockIdx.x; it < NTOK / 8; it += gridDim.x) {
    const int r = ROW0 + it * 8 + wave;
    const float* mod = MODL + (r < CTXL ? 12288 : 0);
    {
      float o[32], h[32];
      ld_row_bf16(OUT + (size_t)r * D, lane, o);
      const float* hp = L == 0 ? (r < CTXL ? a.in[2] + (size_t)r * D : a.in[0] + (size_t)(r - CTXL) * D) : HRES + (size_t)r * D;
      ld_row_f32(hp, lane, h);
      const float rstd1 = rsqrtf(sumsq32(o) * (1.f / D) + EPS);
#pragma unroll
      for (int j = 0; j < 4; ++j) { const int idx = 8 * lane + 512 * j;
        float g1[8], gt[8]; ld8f(ng + D + idx, g1); ld8f(mod + 2 * D + idx, gt);
#pragma unroll
        for (int i = 0; i < 8; ++i) h[8 * j + i] += gt[i] * (o[8 * j + i] * rstd1 * g1[i]);
        if (!dry) st8f(HRES + (size_t)r * D + idx, &h[8 * j]); }
      const float rstd2 = rsqrtf(sumsq32(h) * (1.f / D) + EPS);
      modulate_store<true, true>(h, rstd2, ng + 2 * D, mod + 3 * D, mod + 4 * D, (bf16_t*)((unsigned char*)F + (size_t)r * D), lane, ft + wave * D);
    }
    __syncthreads();
    float acc[8] = {0, 0, 0, 0, 0, 0, 0, 0};
    const int d0 = wave * 256;
#pragma unroll 2
    for (int dd = 0; dd < 256; dd += 4) {
      const float* rp = router + (size_t)(d0 + dd) * NE + lane;
      const float r0 = rp[0], r1 = rp[NE], r2 = rp[2 * NE], r3 = rp[3 * NE];
#pragma unroll
      for (int t = 0; t < 8; ++t) { const f32x4 fv = *(LAS const f32x4*)(ft + t * D + d0 + dd); acc[t] += fv[0] * r0 + fv[1] * r1 + fv[2] * r2 + fv[3] * r3; }
    }
#pragma unroll
    for (int t = 0; t < 8; ++t) part[(wave * 8 + t) * 64 + lane] = acc[t];
    __syncthreads();
    float logit = 0;
#pragma unroll
    for (int w = 0; w < 8; ++w) logit += part[(w * 8 + wave) * 64 + lane];
#if MK_DIAG
    ((float*)(a.ws + WS_Y))[(size_t)r * 64 + lane] = logit;
#endif
    const float score = sigmoidf_(logit);
    const float choice = score + rbias[lane];
    int rank = 0; const int gl = lane & 7;
#pragma unroll
    for (int j = 0; j < 8; ++j) { const float o = __shfl(choice, (lane & ~7) | j); rank += (o > choice || (o == choice && j < gl)) ? 1 : 0; }
    float gs = rank < 2 ? choice : 0.f;
    gs += __shfl_xor(gs, 1); gs += __shfl_xor(gs, 2); gs += __shfl_xor(gs, 4);
    int grank = 0; const int g = lane >> 3;
#pragma unroll
    for (int j = 0; j < 8; ++j) { const float o = __shfl(gs, j * 8); grank += (o > gs || (o == gs && j < g)) ? 1 : 0; }
    const bool gsel = grank < 4;
    const float mc = gsel ? choice : -INFINITY;
    int erank = 0;
#pragma unroll 4
    for (int j = 0; j < 64; ++j) { const float o = __int_as_float(__builtin_amdgcn_readlane(__float_as_int(mc), j)); erank += (o > mc || (o == mc && j < lane)) ? 1 : 0; }
    const bool sel = gsel && erank < 8;
    const unsigned long long bal = __ballot(sel);
    const int idx = __popcll(bal & ((1ull << lane) - 1ull));
    const float ssum = wave_sum(sel ? score : 0.f);
    if (sel && !dry) { const int pos = atomicAdd(&counts[lane], 1);
      top_e[r * 8 + idx] = lane; top_w[r * 8 + idx] = score / ssum * 2.5f; top_p[r * 8 + idx] = pos; }
  }
}

__device__ __forceinline__ void moe_tile_prefix(const int* counts, LAS int* ts) {
  if (threadIdx.x == 0) { int s = 0; for (int e = 0; e < 64; ++e) { ts[e] = s; s += (counts[e] + 255) >> 8; } ts[64] = s; }
  __syncthreads();
}
__device__ __forceinline__ void phase_H(const Args& a, int L, LAS char* lds) {
  const int NTOK = L == 0 ? MT : SEQ, ROW0 = L == 0 ? 0 : CTXL;
  const int* counts = (const int*)(a.ws + WS_CTL + CTL_CNT) + L * 64;
  const int* top_e = (const int*)(a.ws + WS_TOPE); const int* top_p = (const int*)(a.ws + WS_TOPP);
  int* tslot = (int*)(a.ws + WS_TSLOT); int* stok = (int*)(a.ws + WS_STOK);
  LAS int* ts = (LAS int*)lds;
  moe_tile_prefix(counts, ts);
  int tid = threadIdx.x; asm volatile("" : "+v"(tid)); tid &= 511;
  const int gt = blockIdx.x * NTHREADS + tid, gs = gridDim.x * NTHREADS;
  for (int i = gt; i < NTOK * 8; i += gs) { const int q = ROW0 * 8 + i; const int e = top_e[q]; const int slot = ts[e] * 256 + top_p[q]; stok[slot] = q >> 3; tslot[q] = slot; }
  for (int i = gt; i < 64 * 256; i += gs) { const int e = i >> 8, p = i & 255, cnt = counts[e], nt = (cnt + 255) >> 8; if (cnt + p < nt * 256) stok[ts[e] * 256 + cnt + p] = ROW0; }
  for (int i = gt; i < NTOK; i += gs) stok[SH_BASE + i] = ROW0 + i;
  __syncthreads();
}
struct DenseSched {
  int nM, nN, r0; const unsigned char* W;
  __device__ __forceinline__ bool unit(int i, int& brow, const unsigned char*& Bt, int& bcol) const {
    const int u = blockIdx.x + i * (int)gridDim.x; if (u >= nM * nN) return false;
    int pm, pn; dense_unit(u, nM, nN, pm, pn); brow = r0 + pm * 256; bcol = pn * 256; Bt = W; return true; }
};
struct MoeSched {
  LAS const int* ts; int TR, NN, total; const unsigned char* W; size_t woff;
  __device__ __forceinline__ bool unit(int i, int& slot0, const unsigned char*& Bt, int& bcol) const {
    for (int u = blockIdx.x + i * (int)gridDim.x; ; u += gridDim.x) {
      const int rnd = u >> 8, b = u & 255, v = rnd * 256 + (b & 7) * 32 + (b >> 3);
      if (rnd * 256 >= total) return false;
      if (v >= total) return false;
      const int m = v / NN, pn = v % NN;
      int e;
      if (m >= TR) { e = 64; slot0 = SH_BASE + 256 * (m - TR); } else { e = 0; while (ts[e + 1] <= m) ++e; slot0 = 256 * m; }
      Bt = W + (size_t)e * WMOE8_E + woff; bcol = pn * 256;
      return true;
    }
  }
};
__device__ __forceinline__ void phase_moe_up(const Args& a, int L, LAS char* lds) {
  const int NSH = L == 0 ? MT / 256 : SEQ / 256;
  const int* counts = (const int*)(a.ws + WS_CTL + CTL_CNT) + L * 64;
  LAS int* ts = (LAS int*)(lds + LDS_CTL + 64);
  moe_tile_prefix(counts, ts);
  const int TR = ts[64], TM = TR + NSH;
  const unsigned char* F = (const unsigned char*)(a.ws + WS_ABUF); const unsigned char* W = (const unsigned char*)(a.ws + WS_WMOE) + (size_t)L * 65 * WMOE8_E;
  const int* stok = (const int*)(a.ws + WS_STOK);
  EpiSwiGLU8 epi{(unsigned char*)(a.ws + WS_ACT), EFF};
  MoeSched sc{ts, TR, 4, TM * 4, W, 0};
  gemm8_run<true, D, D, D>(F, stok, lds, epi, sc);
}
__device__ __forceinline__ void phase_moe_down(const Args& a, int L, LAS char* lds) {
  const int NSH = L == 0 ? MT / 256 : SEQ / 256;
  const int* counts = (const int*)(a.ws + WS_CTL + CTL_CNT) + L * 64;
  LAS int* ts = (LAS int*)(lds + LDS_CTL + 64);
  moe_tile_prefix(counts, ts);
  const int TR = ts[64], TM = TR + NSH;
  const unsigned char* ACT = (const unsigned char*)(a.ws + WS_ACT); const unsigned char* W = (const unsigned char*)(a.ws + WS_WMOE) + (size_t)L * 65 * WMOE8_E;
  EpiPlain8 epi{(unsigned char*)(a.ws + WS_Y), D, 16.f / 128.f};
  MoeSched sc{ts, TR, 8, TM * 8, W, (size_t)1024 * D};
  gemm8_run<false, EFF, EFF, EFF>(ACT, nullptr, lds, epi, sc);
}
__device__ __forceinline__ void phase_combine(const Args& a, int L, bool dry = false) {
  int tid = threadIdx.x; asm volatile("" : "+v"(tid)); tid &= 511; const int wave = tid >> 6, lane = tid & 63;
  const int NTOK = L == 0 ? MT : SEQ, ROW0 = L == 0 ? 0 : CTXL;
  const float* ng = a.in[6] + (size_t)L * 4 * D;
  const float* MODL = (const float*)(a.ws + WS_MOD) + (size_t)(L * 2) * 12288;
  const unsigned char* Y = (const unsigned char*)(a.ws + WS_Y);
  float* HRES = (float*)(a.ws + WS_HRES);
  const int* tslot = (const int*)(a.ws + WS_TSLOT); const float* top_w = (const float*)(a.ws + WS_TOPW);
  for (int it = blockIdx.x; it < NTOK / 8; it += gridDim.x) {
    const int r = ROW0 + it * 8 + wave;
    const float* mod = MODL + (r < CTXL ? 12288 : 0);
    float y[32];
    { float t[32]; ld_row_fp8(Y + (size_t)(SH_BASE + r - ROW0) * D, lane, t);
#pragma unroll
      for (int i = 0; i < 32; ++i) y[i] = t[i] * (1.f / 16.f); }
#pragma unroll 4
    for (int k = 0; k < 8; ++k) { const int slot = tslot[r * 8 + k]; const float w = top_w[r * 8 + k] * (1.f / 16.f);
      float t[32]; ld_row_fp8(Y + (size_t)slot * D, lane, t);
#pragma unroll
      for (int i = 0; i < 32; ++i) y[i] += w * t[i]; }
    const float rstd = rsqrtf(sumsq32(y) * (1.f / D) + EPS);
    float h[32]; ld_row_f32(HRES + (size_t)r * D, lane, h);
#pragma unroll
    for (int j = 0; j < 4; ++j) { const int idx = 8 * lane + 512 * j;
      float g3[8], gt[8]; ld8f(ng + 3 * D + idx, g3); ld8f(mod + 5 * D + idx, gt);
#pragma unroll
      for (int i = 0; i < 8; ++i) h[8 * j + i] += gt[i] * (y[8 * j + i] * rstd * g3[i]);
      if (L == 0) { if (!dry) st8f(HRES + (size_t)r * D + idx, &h[8 * j]); } else st8f(a.out + (size_t)(r - CTXL) * D + idx, &h[8 * j]); }
    if (L == 0) {
      const float* mod1 = MODL + 2 * 12288 + (r < CTXL ? 12288 : 0);
      const float rstd2 = rsqrtf(sumsq32(h) * (1.f / D) + EPS);
      modulate_store<false, true>(h, rstd2, a.in[6] + (size_t)4 * D, mod1, mod1 + D, (bf16_t*)((unsigned char*)(a.ws + WS_ABUF) + (size_t)r * D), lane, nullptr);
    }
  }
}

constexpr int NPH = 21;
typedef const __attribute__((address_space(4))) Args* ArgsP;
#if defined(__HIP_DEVICE_COMPILE__)
#define FRESH_ARGS() const Args a = *({ ArgsP _p = (ArgsP)__builtin_amdgcn_kernarg_segment_ptr(); asm volatile("" : "+s"(_p)); _p; })
#else
#define FRESH_ARGS() const Args a = kargs
#endif
__global__ void __launch_bounds__(NTHREADS, 2) fwd(Args kargs) {
  extern __shared__ __attribute__((aligned(16))) unsigned char lds_raw[];
  LAS char* lds = (LAS char*)lds_raw;
  const int lo = kargs.ph_lo, hi = kargs.ph_hi;
  if (threadIdx.x < 64) ((LAS unsigned*)(lds + LDS_CTL))[threadIdx.x] = 0u;
  __syncthreads();
  if (hi - lo > 1) (void)xcd_barrier_post((unsigned*)(kargs.ws + WS_CTL), (volatile LAS unsigned*)(lds + LDS_CTL));
#ifndef PHASE_MASK
#define PHASE_MASK 0xFFFFFFFFu
#endif
#define IN(k) (((PHASE_MASK >> (k)) & 1u) && lo <= (k) && (k) < hi)
#ifndef PH_REPEAT_MASK
#define PH_REPEAT_MASK 0u
#endif
#define REP(k) for (int _rep = 0; _rep < (((PH_REPEAT_MASK >> (k)) & 1u) ? 2 : 1); ++_rep)
#define SEAM(k) do { if ((k) + 1 < hi) { XcdBarrier _b; _b.bar = (unsigned*)(a.ws + WS_CTL); _b.x = xb_xcc_id(); _b.st = (volatile LAS unsigned*)(lds + LDS_CTL); xcd_barrier(_b); } } while (0)

  if (IN(0)) { FRESH_ARGS(); REP(0) phase_prologue(a, lds); SEAM(0); }
  if (IN(1)) { FRESH_ARGS(); REP(1) phase_modulate0(a); SEAM(1); }
#pragma unroll
  for (int L = 0; L < 2; ++L) {
    const int base = 2 + (L == 0 ? 0 : 9);
    if (IN(base + 0)) {
      FRESH_ARGS();
      const unsigned char* A = (const unsigned char*)(a.ws + WS_ABUF);
      const int nN = L == 0 ? N_IN0 / 256 : N_IN1 / 256, nM = MT / 256;
      EpiG1 epi{EpiPlain{(bf16_t*)(a.ws + WS_QKVU), L == 0 ? N_QKV0 : N_IN1, 1.f / 256.f}, EpiPair<0>{(bf16_t*)(a.ws + WS_HG), 1024, N_QKV0, 1.f / 256.f}, L == 0 ? N_QKV0 : N_IN1};
      DenseSched sc{nM, nN, 0, (const unsigned char*)(a.ws + (L == 0 ? WS_WIN0 : WS_WIN1))};
      REP(2) gemm8_run<false, D, D, D>(A, nullptr, lds, epi, sc);
      SEAM(base + 0);
    }
    if (L == 0) {
      if (IN(3)) { FRESH_ARGS(); if ((PH_REPEAT_MASK >> 3) & 1u) { phase_rope_conv0(a, lds, true); __syncthreads(); } phase_rope_conv0(a, lds); SEAM(3); }
      if (IN(4)) { FRESH_ARGS(); REP(4) phase_attn(a, 0, lds); SEAM(4); }
    } else {
      if (IN(12)) { FRESH_ARGS(); if ((PH_REPEAT_MASK >> 12) & 1u) { phase_rope1(a, lds, true); __syncthreads(); } phase_rope1(a, lds); SEAM(12); }
      if (IN(13)) { FRESH_ARGS(); REP(13) phase_attn(a, 1, lds); SEAM(13); }
      if (IN(14)) { FRESH_ARGS(); REP(14) phase_diff(a); SEAM(14); }
    }
    const int b2 = L == 0 ? 5 : 15;
    if (IN(b2 + 0)) {
      FRESH_ARGS();
      const int nN = D / 256, nM = L == 0 ? MT / 256 : SEQ / 256, r0 = L == 0 ? 0 : CTXL;
#if DENSE8_G2
      const unsigned char* A = (const unsigned char*)(a.ws + WS_X2);
      EpiPlain epi{(bf16_t*)(a.ws + WS_OUT), D, 1.f / 2048.f};
      DenseSched sc{nM, nN, r0, (const unsigned char*)(a.ws + (L == 0 ? WS_WOUT0 : WS_WOUT1))};
      REP(5) gemm8_run<false, D, D, D>(A, nullptr, lds, epi, sc);
#else
      const bf16_t* A = (const bf16_t*)(a.ws + WS_X2);
      const bf16_t* Bt = (const bf16_t*)(a.ws + (L == 0 ? WS_WOUT0 : WS_WOUT1));
      EpiPlain epi{(bf16_t*)(a.ws + WS_OUT), D, 1.f};
      REP(5) for (int u = blockIdx.x; u < nM * nN; u += gridDim.x) { int pm, pn; dense_unit(u, nM, nN, pm, pn);
        gemm_tile<false>(A, D, nullptr, r0 + pm * 256, Bt, D, pn * 256, D, lds, epi); }
#endif
      SEAM(b2 + 0);
    }
    if (IN(b2 + 1)) { FRESH_ARGS(); if ((PH_REPEAT_MASK >> 6) & 1u) { phase_G(a, L, lds, true); __syncthreads(); } phase_G(a, L, lds); SEAM(b2 + 1); }
    if (IN(b2 + 2)) { FRESH_ARGS(); REP(7) phase_H(a, L, lds); SEAM(b2 + 2); }
    if (IN(b2 + 3)) { FRESH_ARGS(); REP(8) phase_moe_up(a, L, lds); SEAM(b2 + 3); }
    if (IN(b2 + 4)) { FRESH_ARGS(); REP(9) phase_moe_down(a, L, lds); SEAM(b2 + 4); }
    if (IN(b2 + 5)) { FRESH_ARGS(); if ((PH_REPEAT_MASK >> 10) & 1u) phase_combine(a, L, true); phase_combine(a, L); SEAM(b2 + 5); }
  }
#undef IN
#undef SEAM
}

#ifndef MK_DIAG
#define MK_DIAG 0
#endif
#if MK_DIAG
__device__ __forceinline__ void rope_cs(int r, int lane, float& cs, float& sn) {
  cs = 1.f; sn = 0.f;
  if (r >= CTXL) { const int t = r - CTXL; const int a = lane >> 5, i = lane & 31;
    const float pos = a ? (float)(t & 63) : (float)(t >> 6);
    const float inv = powf(10000.f, -(float)i / 32.f);
    sincosf(pos * inv, &sn, &cs); }
}
__device__ __forceinline__ bool dclose(float got, float ref, float rtol, float atol) { return fabsf(got - ref) <= rtol * fabsf(ref) + atol; }
__device__ __forceinline__ unsigned dhash(unsigned x) { x ^= x >> 16; x *= 0x7feb352du; x ^= x >> 15; x *= 0x846ca68bu; x ^= x >> 16; return x; }
__device__ float wdot(const bf16_t* arow, const float* W, int ldw, int col, int K, int lane) {
  float s = 0; for (int k = lane; k < K; k += 64) s += bf2f(arow[k]) * W[(size_t)k * ldw + col]; return wave_sum(s); }
__device__ float dq8(const unsigned char* p, size_t i) { const unsigned w = ((const unsigned*)p)[i >> 2]; const int b = (int)(i & 3);
  return b == 0 ? __builtin_amdgcn_cvt_f32_fp8((int)w, 0) : b == 1 ? __builtin_amdgcn_cvt_f32_fp8((int)w, 1) : b == 2 ? __builtin_amdgcn_cvt_f32_fp8((int)w, 2) : __builtin_amdgcn_cvt_f32_fp8((int)w, 3); }
__device__ float wdot8(const unsigned char* arow8, const float* W, int ldw, int col, int K, int lane) {
  float s = 0; for (int k = lane; k < K; k += 64) s += dq8(arow8, k) * W[(size_t)k * ldw + col]; return wave_sum(s); }
__device__ void dflag(int* dg, int s, int bad, int lane) { if (lane == 0 && bad) atomicAdd(&dg[s], bad); }
__device__ const float* h0row(const Args& a, int r) { return r < CTXL ? a.in[2] + (size_t)r * D : a.in[0] + (size_t)(r - CTXL) * D; }
__device__ int pick_row(unsigned h, int lo, int n) { const unsigned m = h % 8; if (m == 0) return lo; if (m == 1) return lo + n - 1; if (m == 2) return lo + 255 < lo + n ? lo + 255 : lo; if (m == 3) return lo + 256 < lo + n ? lo + 256 : lo; return lo + (int)((h >> 3) % (unsigned)n); }
__device__ void naive_attn(const bf16_t* q, const bf16_t* K, const bf16_t* V, int ld, int nkeys, int lane, float& o0, float& o1) {
  const float q0 = bf2f(q[lane]), q1 = bf2f(q[lane + 64]);
  float m = -1e30f, l = 0; o0 = 0; o1 = 0;
  for (int k = 0; k < nkeys; ++k) {
    const float s = wave_sum(q0 * bf2f(K[(size_t)k * ld + lane]) + q1 * bf2f(K[(size_t)k * ld + lane + 64])) * 0.088388347648318440f;
    const float mn = fmaxf(m, s), al = expf(m - mn), p = expf(s - mn);
    l = l * al + p; o0 = o0 * al + p * bf2f(V[(size_t)k * ld + lane]); o1 = o1 * al + p * bf2f(V[(size_t)k * ld + lane + 64]); m = mn;
  }
  o0 /= l; o1 /= l;
}
__global__ void __launch_bounds__(256) diag(Args a, int k) {
  __shared__ float fsh[4][2048];
  __shared__ float csh[4][64];
  const int lane = threadIdx.x & 63, wv = threadIdx.x >> 6, gw = blockIdx.x * 4 + wv;
  int* dg = (int*)(a.ws + WS_CTL + CTL_CNT + 512);
  const float* MOD = (const float*)(a.ws + WS_MOD);
  const bf16_t* AB = (const bf16_t*)(a.ws + WS_ABUF);
  const bf16_t* QK = (const bf16_t*)(a.ws + WS_QKVU);
  const bf16_t* HG = (const bf16_t*)(a.ws + WS_HG);
  const bf16_t* X2 = (const bf16_t*)(a.ws + WS_X2);
  const bf16_t* OUT = (const bf16_t*)(a.ws + WS_OUT);
  const bf16_t* ACT = (const bf16_t*)(a.ws + WS_ACT);
  const bf16_t* Y = (const bf16_t*)(a.ws + WS_Y);
  const float* HRES = (const float*)(a.ws + WS_HRES);
  const int* top_e = (const int*)(a.ws + WS_TOPE); const float* top_w = (const float*)(a.ws + WS_TOPW); const int* top_p = (const int*)(a.ws + WS_TOPP);
  const int* tslot = (const int*)(a.ws + WS_TSLOT); const int* stok = (const int*)(a.ws + WS_STOK);
  const unsigned h = dhash(gw * 7919u + k * 104729u + 17u), h2 = dhash(h + 12345u);
  int bad = 0;
  const int L = k >= 11 ? 1 : 0;
  const int NTOK = L == 0 ? MT : SEQ, ROW0 = L == 0 ? 0 : CTXL;
  const int* counts = (const int*)(a.ws + WS_CTL + CTL_CNT) + L * 64;
  if (k == 0) {
    const int LL = gw & 1, which = (gw >> 1) & 1, j = h % 12288;
    const float* v = which ? a.in[3] : a.in[1];
    float s = 0; for (int d = lane; d < D; d += 64) { const float x = v[d]; s += x * sigmoidf_(x) * a.in[4][((size_t)LL * D + d) * 12288 + j]; }
    s = wave_sum(s) + a.in[5][LL * 12288 + j];
    bad = !dclose(MOD[(LL * 2 + which) * 12288 + j], s, 1e-3f, 1e-3f); dflag(dg, 1, bad, lane);
  } else if (k == 1) {
    const int r = pick_row(h, 0, MT); const float* x = h0row(a, r); const float* mod = MOD + (r < CTXL ? 12288 : 0);
    float ss = 0; for (int d = lane; d < D; d += 64) ss += x[d] * x[d]; ss = wave_sum(ss); const float rstd = rsqrtf(ss / D + EPS);
    for (int d = lane; d < D; d += 64) { const float ref = x[d] * rstd * a.in[6][d] * (1.f + mod[D + d]) + mod[d]; bad += !dclose(bf2f(AB[(size_t)r * D + d]), ref, 0.01f, 0.01f); }
    bad = (int)wave_sum((float)bad); dflag(dg, 2, bad, lane);
  } else if (k == 2 || k == 11) {
    const int r = pick_row(h, 0, MT);
    if (L == 0) {
      const int c = h2 % N_QKV0; const float ref = wdot(AB + (size_t)r * D, a.in[7], N_IN0, c, D, lane);
      bad = !dclose(bf2f(QK[(size_t)r * N_QKV0 + c]), ref, 0.02f, 0.05f); dflag(dg, 3, bad, lane);
      const int ch = (h2 >> 11) % 1024; const float av = wdot(AB + (size_t)r * D, a.in[7], N_IN0, N_QKV0 + ch, D, lane), gv = wdot(AB + (size_t)r * D, a.in[7], N_IN0, N_QKV0 + 1024 + ch, D, lane);
      bad = !dclose(bf2f(HG[(size_t)r * 1024 + ch]), av * sigmoidf_(gv), 0.03f, 0.05f); dflag(dg, 4, bad, lane);
    } else {
      const int c = h2 % N_IN1; const float ref = wdot(AB + (size_t)r * D, a.in[15], N_IN1, c, D, lane);
      bad = !dclose(bf2f(QK[(size_t)r * N_IN1 + c]), ref, 0.02f, 0.05f); dflag(dg, 15, bad, lane);
    }
  } else if (k == 3) {
    { const int r = pick_row(h, 0, MT), hh = h2 % 10; const float* g = hh < 8 ? a.in[9] : a.in[10];
      float raw0 = 0, raw1 = 0;
      for (int d = 0; d < 128; ++d) { const float v = wdot(AB + (size_t)r * D, a.in[7], N_IN0, hh * 128 + d, D, lane); if (d == lane) raw0 = v; if (d == lane + 64) raw1 = v; }
      const float rstd = rsqrtf(wave_sum(raw0 * raw0 + raw1 * raw1) / 128.f + EPS);
      const float y0 = raw0 * rstd * g[lane], y1 = raw1 * rstd * g[lane + 64];
      float cs, sn; rope_cs(r, lane, cs, sn);
      const float cs0 = __shfl(cs, lane & 31), sn0 = __shfl(sn, lane & 31), cs1 = __shfl(cs, 32 + (lane & 31)), sn1 = __shfl(sn, 32 + (lane & 31));
      const float p0 = __shfl_xor(y0, 32), p1 = __shfl_xor(y1, 32);
      const float o0 = (lane < 32) ? y0 * cs0 - p0 * sn0 : y0 * cs0 + p0 * sn0;
      const float o1 = (lane < 32) ? y1 * cs1 - p1 * sn1 : y1 * cs1 + p1 * sn1;
      bad = !dclose(bf2f(QK[(size_t)r * N_QKV0 + hh * 128 + lane]), o0, 0.03f, 0.05f) + !dclose(bf2f(QK[(size_t)r * N_QKV0 + hh * 128 + 64 + lane]), o1, 0.03f, 0.05f);
      bad = (int)wave_sum((float)bad); dflag(dg, 5, bad, lane); }
    { const int r = pick_row(h2, 0, MT); const int seg0 = r < CTXL ? 0 : CTXL, seg1 = r < CTXL ? CTXL : MT;
      float cv[16]; float s1 = 0, s2 = 0;
      for (int q = 0; q < 16; ++q) { const int c = lane + 64 * q; float acc = a.in[12][c];
        for (int j = 0; j < 31; ++j) { const int rr = r + j - 15; if (rr >= seg0 && rr < seg1) acc += bf2f(HG[(size_t)rr * 1024 + c]) * a.in[11][j * 1024 + c]; }
        cv[q] = acc; s1 += acc; s2 += acc * acc; }
      s1 = wave_sum(s1); s2 = wave_sum(s2); const float mean = s1 / 1024.f, rstd = rsqrtf(s2 / 1024.f - mean * mean + EPS);
      bad = 0;
      for (int q = 0; q < 16; ++q) { const int c = lane + 64 * q; float y = (cv[q] - mean) * rstd * a.in[13][c] + a.in[14][c]; y = y * sigmoidf_(y);
        bad += !dclose(bf2f(X2[(size_t)r * D + 1024 + c]), y, 0.03f, 0.03f); }
      bad = (int)wave_sum((float)bad); dflag(dg, 6, bad, lane); }
  } else if (k == 4) {
    if (gw < 64) { const int r = pick_row(h, 0, MT), head = h2 % 8; const int nkeys = r < CTXL ? CTXL : MT;
      float o0, o1; naive_attn(QK + (size_t)r * N_QKV0 + head * 128, QK + 1024 + (head >> 2) * 128, QK + 1280 + (head >> 2) * 128, N_QKV0, nkeys, lane, o0, o1);
      const float rt = r < CTXL ? 0.15f : 0.05f, at_ = r < CTXL ? 0.04f : 0.01f;
      bad = !dclose(bf2f(X2[(size_t)r * D + head * 128 + lane]), o0, rt, at_) + !dclose(bf2f(X2[(size_t)r * D + head * 128 + 64 + lane]), o1, rt, at_);
      bad = (int)wave_sum((float)bad); dflag(dg, r < CTXL ? 26 : 7, bad, lane); }
  } else if (k == 5 || k == 15) {
    const int r = pick_row(h, ROW0, NTOK), c = h2 % D; const float ref = wdot(X2 + (size_t)r * D, L == 0 ? a.in[8] : a.in[16], D, c, D, lane);
    bad = !dclose(bf2f(OUT[(size_t)r * D + c]), ref, 0.02f, 0.05f); dflag(dg, L == 0 ? 8 : 19, bad, lane);
  } else if (k == 6 || k == 16) {
    const int r = pick_row(h, ROW0, NTOK); const float* mod = MOD + (size_t)(L * 2) * 12288 + (r < CTXL ? 12288 : 0); const float* ng = a.in[6] + (size_t)L * 4 * D;
    float ss = 0; for (int d = lane; d < D; d += 64) { const float o = bf2f(OUT[(size_t)r * D + d]); ss += o * o; } ss = wave_sum(ss); const float rstd1 = rsqrtf(ss / D + EPS);
    bad = 0;
    if (L == 0) { const float* x = h0row(a, r); for (int d = lane; d < D; d += 64) { const float ref = x[d] + mod[2 * D + d] * (bf2f(OUT[(size_t)r * D + d]) * rstd1 * ng[D + d]); bad += !dclose(HRES[(size_t)r * D + d], ref, 1e-3f, 1e-3f); } }
    float s2 = 0; for (int d = lane; d < D; d += 64) { const float x = HRES[(size_t)r * D + d]; s2 += x * x; } s2 = wave_sum(s2); const float rstd2 = rsqrtf(s2 / D + EPS);
    for (int d = lane; d < D; d += 64) { const float f = HRES[(size_t)r * D + d] * rstd2 * ng[2 * D + d] * (1.f + mod[4 * D + d]) + mod[3 * D + d]; fsh[wv][d] = f; bad += !dclose(dq8((const unsigned char*)AB + (size_t)r * D, d), f, 0.07f, 0.01f); }
    bad = (int)wave_sum((float)bad); dflag(dg, L == 0 ? 9 : 20, bad, lane);
    __syncthreads();
    float lg = 0; for (int d = 0; d < D; ++d) lg += fsh[wv][d] * a.in[19][((size_t)L * D + d) * NE + lane];
    const float sc = sigmoidf_(lg); csh[wv][lane] = sc + a.in[20][L * NE + lane];
    __syncthreads();
    { const float plg = ((const float*)(a.ws + WS_Y))[(size_t)r * 64 + lane]; int lb = !dclose(plg, lg, 1e-3f, 1e-3f); lb = (int)wave_sum((float)lb); if (lane == 0 && lb) { atomicAdd(&dg[32 + (L == 0 ? 10 : 21) + 3], 1); atomicOr(&dg[60], 1 << (r & 7)); } }
    unsigned long long wsel;
    { const float choice = csh[wv][lane]; int rank = 0; const int gl = lane & 7;
      for (int j = 0; j < 8; ++j) { const float o = __shfl(choice, (lane & ~7) | j); rank += (o > choice || (o == choice && j < gl)) ? 1 : 0; }
      float gs = rank < 2 ? choice : 0.f; gs += __shfl_xor(gs, 1); gs += __shfl_xor(gs, 2); gs += __shfl_xor(gs, 4);
      int grank = 0; const int g = lane >> 3;
      for (int j = 0; j < 8; ++j) { const float o = __shfl(gs, j * 8); grank += (o > gs || (o == gs && j < g)) ? 1 : 0; }
      const bool gsel = grank < 4; const float mc = gsel ? choice : -INFINITY; int erank = 0;
      for (int j = 0; j < 64; ++j) { const float o = __shfl(mc, j); erank += (o > mc || (o == mc && j < lane)) ? 1 : 0; }
      wsel = __ballot(gsel && erank < 8); }
    int setbad = 0;
    if (lane == 0) {
      float gsc[8]; for (int g = 0; g < 8; ++g) { float m1 = -1e30f, m2 = -1e30f; for (int j = 0; j < 8; ++j) { const float v = csh[wv][g * 8 + j]; if (v > m1) { m2 = m1; m1 = v; } else if (v > m2) m2 = v; } gsc[g] = m1 + m2; }
      bool gs[8] = {false, false, false, false, false, false, false, false};
      for (int t = 0; t < 4; ++t) { int bi = 0; float bv = -1e30f; for (int g = 0; g < 8; ++g) if (!gs[g] && gsc[g] > bv) { bv = gsc[g]; bi = g; } gs[bi] = true; }
      unsigned long long selm = 0; for (int t = 0; t < 8; ++t) { int bi = 0; float bv = -1e30f; for (int e = 0; e < 64; ++e) if (gs[e >> 3] && !((selm >> e) & 1ull) && csh[wv][e] > bv) { bv = csh[wv][e]; bi = e; } selm |= 1ull << bi; }
      unsigned long long got = 0; for (int t = 0; t < 8; ++t) { const int e = top_e[r * 8 + t]; if (e < 0 || e > 63) setbad = 1000; else got |= 1ull << e; }
      if (setbad == 0 && got != selm) setbad = 1;
      if (wsel != selm) atomicAdd(&dg[32 + (L == 0 ? 10 : 21) + 4], 1);
    }
    setbad = __shfl(setbad, 0);
    { float wgot = -1.f; int mine = 0; for (int t = 0; t < 8; ++t) if (top_e[r * 8 + t] == lane) { mine = 1; wgot = top_w[r * 8 + t]; }
      const float ssum = wave_sum(mine ? sc : 0.f);
      int wbad = (mine && !dclose(wgot, sc / ssum * 2.5f, 0.01f, 1e-3f)) ? 1 : 0; wbad = (int)wave_sum((float)wbad);
      if (lane == 0) { int* q = &dg[32 + (L == 0 ? 10 : 21)]; if (setbad >= 1000) atomicAdd(q + 1, 1); else if (setbad) atomicAdd(q, 1); else if (wbad) atomicAdd(q + 2, 1); } }
  } else if (k == 7 || k == 17) {
    const int r = pick_row(h, ROW0, NTOK), t = h2 % 8, q = r * 8 + t; const int slot = tslot[q], e = top_e[q];
    int ts0 = 0; for (int j = 0; j < e; ++j) ts0 += (counts[j] + 255) >> 8;
    bad = (slot < ts0 * 256 || slot >= ts0 * 256 + counts[e] || stok[slot] != r || top_p[q] != slot - ts0 * 256) ? 1 : 0;
    bad += (stok[SH_BASE + r - ROW0] != r) ? 1 : 0;
    dflag(dg, L == 0 ? 11 : 22, bad, lane);
  } else if (k == 8 || k == 18 || k == 9 || k == 19) {
    int TR = 0; for (int j = 0; j < 64; ++j) TR += (counts[j] + 255) >> 8;
    int slot, e;
    if ((h & 3) == 0) { slot = SH_BASE + (int)((h >> 2) % (unsigned)NTOK); e = 64; }
    else { e = (h >> 2) % 64; int guard = 0; while (counts[e] == 0 && guard++ < 64) e = (e + 1) % 64; int ts0 = 0; for (int j = 0; j < e; ++j) ts0 += (counts[j] + 255) >> 8;
      const unsigned m = (h >> 8) % 4; const int cnt = counts[e]; const int p = m == 0 ? 0 : m == 1 ? cnt - 1 : (int)((h >> 10) % (unsigned)cnt); slot = ts0 * 256 + p; }
    const int tok = stok[slot];
    if (k == 8 || k == 18) {
      const int ch = h2 % EFF;
      const float* Wg = e < 64 ? a.in[21] + ((size_t)L * 64 + e) * D * EFF : a.in[24] + (size_t)L * D * EFF;
      const float* Wu = e < 64 ? a.in[22] + ((size_t)L * 64 + e) * D * EFF : a.in[25] + (size_t)L * D * EFF;
      const unsigned char* F8 = (const unsigned char*)AB + (size_t)tok * D;
      const float gv = wdot8(F8, Wg, EFF, ch, D, lane), uv = wdot8(F8, Wu, EFF, ch, D, lane);
      bad = !dclose(dq8((const unsigned char*)ACT + (size_t)slot * EFF, ch), gv * sigmoidf_(gv) * uv, 0.2f, 0.15f); dflag(dg, L == 0 ? 12 : 23, bad, lane);
    } else {
      const int c = h2 % D; const float* Wd = e < 64 ? a.in[23] + ((size_t)L * 64 + e) * EFF * D : a.in[26] + (size_t)L * EFF * D;
      const float ref = wdot8((const unsigned char*)ACT + (size_t)slot * EFF, Wd, D, c, EFF, lane);
      bad = !dclose(dq8((const unsigned char*)Y + (size_t)slot * D, c) * (1.f / 16.f), ref, 0.2f, 0.15f); dflag(dg, L == 0 ? 13 : 24, bad, lane);
    }
  } else if (k == 10 || k == 20) {
    const int r = pick_row(h, ROW0, NTOK); const float* mod = MOD + (size_t)(L * 2) * 12288 + (r < CTXL ? 12288 : 0); const float* ng = a.in[6] + (size_t)L * 4 * D;
    float ss = 0; for (int d = lane; d < D; d += 64) { const unsigned char* Y8 = (const unsigned char*)Y; float y = dq8(Y8 + (size_t)(SH_BASE + r - ROW0) * D, d) * (1.f / 16.f); for (int t = 0; t < 8; ++t) y += top_w[r * 8 + t] * dq8(Y8 + (size_t)tslot[r * 8 + t] * D, d) * (1.f / 16.f); fsh[wv][d] = y; ss += y * y; }
    ss = wave_sum(ss); const float rstd = rsqrtf(ss / D + EPS);
    bad = 0;
    if (L == 0) { float s2 = 0; for (int d = lane; d < D; d += 64) { const float x = HRES[(size_t)r * D + d]; s2 += x * x; } s2 = wave_sum(s2); const float rstd2 = rsqrtf(s2 / D + EPS);
      const float* mod1 = MOD + (size_t)2 * 12288 + (r < CTXL ? 12288 : 0);
      for (int d = lane; d < D; d += 64) { const float ref = HRES[(size_t)r * D + d] * rstd2 * a.in[6][4 * D + d] * (1.f + mod1[D + d]) + mod1[d]; bad += !dclose(bf2f(AB[(size_t)r * D + d]), ref, 0.01f, 0.01f); } }
    else { for (int d = lane; d < D; d += 64) { const float ref = HRES[(size_t)r * D + d] + mod[5 * D + d] * (fsh[wv][d] * rstd * ng[3 * D + d]); bad += !dclose(a.out[(size_t)(r - CTXL) * D + d], ref, 1e-3f, 1e-3f); } }
    bad = (int)wave_sum((float)bad); dflag(dg, L == 0 ? 14 : 25, bad, lane);
  } else if (k == 12) {
    const int r = pick_row(h, CTXL, SEQ), hh = h2 % 32;
    float raw0 = 0, raw1 = 0;
    for (int d = 0; d < 128; ++d) { const float v = wdot(AB + (size_t)r * D, a.in[15], N_IN1, hh * 128 + d, D, lane); if (d == lane) raw0 = v; if (d == lane + 64) raw1 = v; }
    float cs, sn; rope_cs(r, lane, cs, sn);
    const float cs0 = __shfl(cs, lane & 31), sn0 = __shfl(sn, lane & 31), cs1 = __shfl(cs, 32 + (lane & 31)), sn1 = __shfl(sn, 32 + (lane & 31));
    const float p0 = __shfl_xor(raw0, 32), p1 = __shfl_xor(raw1, 32);
    const float o0 = (lane < 32) ? raw0 * cs0 - p0 * sn0 : raw0 * cs0 + p0 * sn0;
    const float o1 = (lane < 32) ? raw1 * cs1 - p1 * sn1 : raw1 * cs1 + p1 * sn1;
    bad = !dclose(bf2f(QK[(size_t)r * N_IN1 + hh * 128 + lane]), o0, 0.03f, 0.05f) + !dclose(bf2f(QK[(size_t)r * N_IN1 + hh * 128 + 64 + lane]), o1, 0.03f, 0.05f);
    bad = (int)wave_sum((float)bad); dflag(dg, 16, bad, lane);
  } else if (k == 13) {
    if (gw < 64) { const int r = pick_row(h, CTXL, SEQ), hc = h2 % 16, vh = (h2 >> 4) & 1, hd = hc >> 1;
      float o0, o1; naive_attn(QK + (size_t)r * N_IN1 + hc * 128, QK + 2048 + hc * 128, QK + 4096 + hd * 256 + vh * 128, N_IN1, MT, lane, o0, o1);
      const bf16_t* O = Y + (size_t)(r - CTXL) * 4096 + hc * 256 + vh * 128;
      bad = !dclose(bf2f(O[lane]), o0, 0.05f, 0.01f) + !dclose(bf2f(O[64 + lane]), o1, 0.05f, 0.01f);
      bad = (int)wave_sum((float)bad); dflag(dg, 17, bad, lane); }
  } else if (k == 14) {
    const int r = pick_row(h, CTXL, SEQ), hd = h2 % 8; const float* lp = a.in[17];
    float s1 = 0, s2 = 0; for (int i = lane; i < 128; i += 64) { s1 += lp[i] * lp[128 + i]; s2 += lp[256 + i] * lp[384 + i]; } s1 = wave_sum(s1); s2 = wave_sum(s2);
    const float lam = expf(s1) - expf(s2) + LAM_INIT; const bf16_t* O = Y + (size_t)(r - CTXL) * 4096;
    float dv[4], ss = 0; for (int i = 0; i < 4; ++i) { const int d = lane + 64 * i; dv[i] = bf2f(O[(2 * hd) * 256 + d]) - lam * bf2f(O[(2 * hd + 1) * 256 + d]); ss += dv[i] * dv[i]; }
    ss = wave_sum(ss); const float rstd = rsqrtf(ss / 256.f + EPS) * (1.f - LAM_INIT); bad = 0;
    for (int i = 0; i < 4; ++i) { const int d = lane + 64 * i; bad += !dclose(bf2f(X2[(size_t)r * D + hd * 256 + d]), dv[i] * rstd * a.in[18][d], 0.02f, 0.01f); }
    bad = (int)wave_sum((float)bad); dflag(dg, 18, bad, lane);
  }
}
__global__ void diag_encode(Args a) {
  const int* dg = (const int*)(a.ws + WS_CTL + CTL_CNT + 512);
  int s = 0;
  int sub = 0;
  for (int i = 1; i < 32; ++i) { int v = dg[i]; if (i == 10 || i == 21) { v = (dg[32 + i] > 25 ? 1 : 0) + (dg[33 + i] > 0 ? 2 : 0) + (dg[34 + i] > 0 ? 4 : 0) + (dg[35 + i] > 0 ? 8 : 0) + (dg[36 + i] > 0 ? 16 : 0); sub = v; } if (v) { s = i; break; } }
  if (s == 0) return;
  const float c = sub ? 30.f + 8.f * sub : 10.f * s;
  for (size_t i = (size_t)blockIdx.x * blockDim.x + threadIdx.x; i < (size_t)SEQ * D; i += (size_t)gridDim.x * blockDim.x) a.out[i] = c;
}
#endif

extern "C" void kernel_launch(void* const* d_in, const int* in_sizes, int n_in, void* d_out, int out_size, void* d_ws, size_t ws_size, hipStream_t stream) {
  static int grid = 0;
  if (grid == 0) {
    if (n_in != 27 || out_size != SEQ * D || ws_size < WS_END) { fprintf(stderr, "kernel_launch: unexpected shapes (n_in %d out %d ws %zu need %zu)\n", n_in, out_size, ws_size, (size_t)WS_END); grid = -1; return; }
    if (hipFuncSetAttribute((const void*)fwd, hipFuncAttributeMaxDynamicSharedMemorySize, LDS_BYTES) != hipSuccess) { fprintf(stderr, "kernel_launch: hipFuncSetAttribute failed\n"); grid = -1; return; }
    int dev = 0, cus = 0, per_cu = 0;
    hipGetDevice(&dev); hipDeviceGetAttribute(&cus, hipDeviceAttributeMultiprocessorCount, dev);
    if (hipOccupancyMaxActiveBlocksPerMultiprocessor(&per_cu, (const void*)fwd, NTHREADS, LDS_BYTES) != hipSuccess || per_cu < 1) fprintf(stderr, "kernel_launch: occupancy query says %d\n", per_cu);
    (void)hipGetLastError();
    grid = cus < 256 ? cus : 256;
    if (grid != 256) fprintf(stderr, "kernel_launch: %d CUs (expected 256)\n", cus);
  }
  if (grid < 0) return;
  hipMemsetAsync((char*)d_ws + WS_CTL, 0, CTL_BYTES, stream);
  Args a{};
  for (int i = 0; i < 27; ++i) a.in[i] = (const float*)d_in[i];
  a.out = (float*)d_out; a.ws = (unsigned char*)d_ws;
#if MK_MULTI
  for (int k = 0; k < NPH; ++k) { a.ph_lo = k; a.ph_hi = k + 1; hipLaunchKernelGGL(fwd, dim3(grid), dim3(NTHREADS), LDS_BYTES, stream, a);
#if MK_DIAG
    hipLaunchKernelGGL(diag, dim3(64), dim3(256), 0, stream, a, k);
#endif
  }
#if MK_DIAG
  hipLaunchKernelGGL(diag_encode, dim3(1024), dim3(256), 0, stream, a);
#endif
#else
  a.ph_lo = 0; a.ph_hi = NPH;
  hipLaunchKernelGGL(fwd, dim3(grid), dim3(NTHREADS), LDS_BYTES, stream, a);
#endif
  const hipError_t le = hipPeekAtLastError();
  if (le != hipSuccess) fprintf(stderr, "kernel_launch: launch failed: %s\n", hipGetErrorName(le));
}
```

```cpp
#include <hip/hip_runtime.h>
#include <cstdio>
#include <cstdint>

#define MK_DIAG 0
#ifndef DENSE8_G2
#define DENSE8_G2 1
#endif
#ifndef MK_MULTI
#define MK_MULTI 0
#endif

#define LAS __attribute__((address_space(3)))
typedef unsigned short bf16_t;
typedef short bf16x8 __attribute__((ext_vector_type(8)));
typedef short s16x4 __attribute__((ext_vector_type(4)));
typedef float f32x4 __attribute__((ext_vector_type(4)));
typedef float f32x2 __attribute__((ext_vector_type(2)));
typedef float f32x16 __attribute__((ext_vector_type(16)));
typedef unsigned u32x4 __attribute__((ext_vector_type(4)));
typedef unsigned u32x2 __attribute__((ext_vector_type(2)));

constexpr int D = 2048, SEQ = 16384, CTXL = 256, MT = SEQ + CTXL;
constexpr int NE = 64, TOPK = 8, EFF = 512;
constexpr int N_IN0 = 3584, N_QKV0 = 1536, N_IN1 = 6144;
constexpr float EPS = 1e-6f;
constexpr float LAM_INIT = 0.35550907f;
constexpr int SH_BASE = SEQ * 0 + (MT * TOPK) + NE * 256;
constexpr int NSLOT = SH_BASE + MT;
constexpr int NTHREADS = 512;
constexpr int LDS_BYTES = 131072 + 1024;
constexpr int LDS_CTL = 131072;

constexpr size_t al256(size_t x) { return (x + 255) & ~(size_t)255; }
constexpr size_t WS_CTL   = 0;
constexpr size_t CTL_BYTES = 32768;
constexpr size_t CTL_CNT  = 16384;
constexpr size_t CTL_KMAX = 16384 + 2048;
constexpr size_t WS_MOD   = CTL_BYTES;
constexpr size_t WS_WIN0  = al256(WS_MOD + 2 * 2 * 12288 * 4);
constexpr size_t WS_WOUT0 = al256(WS_WIN0 + (size_t)N_IN0 * D * 2);
constexpr size_t WS_WIN1  = al256(WS_WOUT0 + (size_t)D * D * 2);
constexpr size_t WS_WOUT1 = al256(WS_WIN1 + (size_t)N_IN1 * D * 2);
constexpr size_t WMOE_E   = (size_t)1024 * D + (size_t)D * EFF;
constexpr size_t WS_WMOE  = al256(WS_WOUT1 + (size_t)D * D * 2);
constexpr size_t WS_HRES  = al256(WS_WMOE + 65 * WMOE_E * 2);
constexpr size_t WS_ABUF  = al256(WS_HRES + (size_t)MT * D * 4);
constexpr size_t WS_QKVU  = al256(WS_ABUF + (size_t)MT * D * 2);
constexpr size_t WS_HG    = al256(WS_QKVU + (size_t)MT * N_IN1 * 2);
constexpr size_t WS_X2    = al256(WS_HG + (size_t)MT * 1024 * 2);
constexpr size_t WS_OUT   = al256(WS_X2 + (size_t)MT * D * 2);
constexpr size_t WS_ACT   = al256(WS_OUT + (size_t)MT * D * 2);
constexpr size_t WS_K8    = WS_ACT + al256((size_t)NSLOT * EFF);
constexpr size_t WS_Y     = al256(WS_ACT + (size_t)NSLOT * EFF * 2);
constexpr size_t WS_TOPE  = al256(WS_Y + (size_t)NSLOT * D * 2);
constexpr size_t WS_TOPW  = al256(WS_TOPE + (size_t)MT * TOPK * 4);
constexpr size_t WS_TOPP  = al256(WS_TOPW + (size_t)MT * TOPK * 4);
constexpr size_t WS_TSLOT = al256(WS_TOPP + (size_t)MT * TOPK * 4);
constexpr size_t WS_STOK  = al256(WS_TSLOT + (size_t)MT * TOPK * 4);
constexpr size_t WS_END   = al256(WS_STOK + (size_t)NSLOT * 4);

struct Args { const float* in[27]; float* out; unsigned char* ws; int ph_lo, ph_hi; };

__device__ __forceinline__ float bflo(unsigned x) { return __uint_as_float(x << 16); }
__device__ __forceinline__ float bfhi(unsigned x) { return __uint_as_float(x & 0xffff0000u); }
__device__ __forceinline__ float bf2f(bf16_t b) { return __uint_as_float(((unsigned)b) << 16); }
__device__ __forceinline__ unsigned cvtpk(float lo, float hi) { unsigned r; asm("v_cvt_pk_bf16_f32 %0, %1, %2" : "=v"(r) : "v"(lo), "v"(hi)); return r; }
__device__ __forceinline__ bf16_t f2bf(float x) { return (bf16_t)(cvtpk(x, 0.f) & 0xffffu); }
__device__ __forceinline__ float wave_sum(float v) {
#pragma unroll
  for (int o = 32; o; o >>= 1) v += __shfl_xor(v, o);
  return v;
}
__device__ __forceinline__ float sigmoidf_(float x) { return 1.f / (1.f + expf(-x)); }
__device__ __forceinline__ float sigmoid_fast(float x) { return __builtin_amdgcn_rcpf(1.f + __builtin_amdgcn_exp2f(-1.4426950408889634f * x)); }

__device__ __forceinline__ float clamp8e(float x) { return fminf(fmaxf(x, -448.f), 448.f); }
__device__ __forceinline__ unsigned pack8x4(float a, float b, float c, float d) {
  int p = __builtin_amdgcn_cvt_pk_fp8_f32(clamp8e(a), clamp8e(b), 0, false); p = __builtin_amdgcn_cvt_pk_fp8_f32(clamp8e(c), clamp8e(d), p, true); return (unsigned)p; }
__device__ __forceinline__ float sq8x4(unsigned p) {
  const float a = __builtin_amdgcn_cvt_f32_fp8((int)p, 0), b = __builtin_amdgcn_cvt_f32_fp8((int)p, 1), c = __builtin_amdgcn_cvt_f32_fp8((int)p, 2), d = __builtin_amdgcn_cvt_f32_fp8((int)p, 3);
  return a * a + b * b + c * c + d * d; }
typedef int v8i_ __attribute__((ext_vector_type(8)));
typedef int v4i __attribute__((ext_vector_type(4)));
#define XB_TMO      128
#define XB_XCNT(j)  (256  + 64 * (j))
#define XB_XSUB(j)  (1280 + 64 * (j))
#define XB_XGEN(j)  (2304 + 64 * (j))
#define XB_TOP      3328
#define XB_TOPGEN   3392
#define XCD_BAR_WORDS 3456
#define XB_SPIN_CAP (1u << 22)
__device__ __forceinline__ unsigned xb_ld(unsigned* p)              { return __hip_atomic_load(p, __ATOMIC_RELAXED, __HIP_MEMORY_SCOPE_AGENT); }
__device__ __forceinline__ unsigned xb_add(unsigned* p, unsigned v) { return __hip_atomic_fetch_add(p, v, __ATOMIC_RELAXED, __HIP_MEMORY_SCOPE_AGENT); }
__device__ __forceinline__ unsigned xb_xcc_id() { return (unsigned)__builtin_amdgcn_s_getreg((3 << 11) | 20) & 0xFu; }
#define XB_SPIN(cond, bar) do { unsigned _sp = 0; while (cond) { __builtin_amdgcn_s_sleep(1); \
    if ((++_sp & 255u) == 0u) { if (xb_ld(&(bar)[XB_TMO])) break; if (_sp > XB_SPIN_CAP) { atomicAdd(&(bar)[XB_TMO], 1u); break; } } } } while (0)
struct XcdBarrier { unsigned* bar; unsigned x; volatile LAS unsigned* st; };
__device__ __forceinline__ XcdBarrier xcd_barrier_post(unsigned* bar, volatile LAS unsigned* st) {
    XcdBarrier b; b.bar = bar; b.x = xb_xcc_id(); b.st = st;
    if (threadIdx.x == 0) (void)xb_add(&bar[XB_XCNT(b.x)], 1u);
    return b;
}
__device__ __forceinline__ void xcd_barrier_complete(unsigned* bar, unsigned x, unsigned& nloc, unsigned& nx) {
    const unsigned G = gridDim.x * gridDim.y * gridDim.z;
    unsigned sum, cnt, mine, sp = 0u;
    for (;;) {
        sum = 0u; cnt = 0u; mine = 0u;
#pragma unroll
        for (unsigned j = 0; j < 16; ++j) { const unsigned c = xb_ld(&bar[XB_XCNT(j)]); sum += c; cnt += (c > 0u) ? 1u : 0u; mine = (j == x) ? c : mine; }
        if (sum == G) break;
        __builtin_amdgcn_s_sleep(1);
        if ((++sp & 255u) == 0u) { if (xb_ld(&bar[XB_TMO])) break; if (sp > XB_SPIN_CAP) { atomicAdd(&bar[XB_TMO], 1u); break; } }
    }
    nloc = mine > 0u ? mine : 1u; nx = cnt > 0u ? cnt : 1u;
}
__device__ __forceinline__ void xcd_barrier(const XcdBarrier& b) {
    asm volatile("s_waitcnt vmcnt(0)" ::: "memory");
    __syncthreads();
    if (threadIdx.x == 0) {
        unsigned* bar = b.bar;
        __builtin_amdgcn_s_waitcnt(0);
        unsigned nloc = b.st[0], nx = b.st[1];
        if (nloc == 0u) { xcd_barrier_complete(bar, b.x, nloc, nx); b.st[0] = nloc; b.st[1] = nx; }
        const unsigned old = xb_add(&bar[XB_XSUB(b.x)], 1u);
        const unsigned gen = old / nloc;
        if (old + 1u == (gen + 1u) * nloc) {
            __builtin_amdgcn_fence(__ATOMIC_RELEASE, "agent");
            asm volatile("s_waitcnt vmcnt(0)" ::: "memory");
            const unsigned og = xb_add(&bar[XB_TOP], 1u);
            const unsigned tg = og / nx;
            if (og + 1u == (tg + 1u) * nx) xb_add(&bar[XB_TOPGEN], 1u);
            else XB_SPIN(xb_ld(&bar[XB_TOPGEN]) == tg, bar);
            __builtin_amdgcn_fence(__ATOMIC_ACQUIRE, "agent");
            xb_add(&bar[XB_XGEN(b.x)], 1u);
            asm volatile("s_waitcnt vmcnt(0)" ::: "memory");
        } else {
            XB_SPIN(xb_ld(&bar[XB_XGEN(b.x)]) == gen, bar);
            __builtin_amdgcn_fence(__ATOMIC_ACQUIRE, "agent");
            asm volatile("s_waitcnt vmcnt(0)" ::: "memory");
        }
    }
    __syncthreads();
}

__device__ __forceinline__ int lds_byte(int r, int c) {
  int st = (r >> 4) * 2 + (c >> 5), rr = r & 15, cc = c & 31, ob = rr * 64 + cc * 2;
  return st * 1024 + (ob ^ (((ob >> 9) & 1) << 5));
}
#define GLDS(gp, lp) __builtin_amdgcn_global_load_lds((const unsigned*)(gp), (LAS unsigned*)(lp), 16, 0, 0)
#define WAIT_V(n) asm volatile("s_waitcnt vmcnt(" #n ")" ::: "memory")
#define WAIT_L(n) asm volatile("s_waitcnt lgkmcnt(" #n ")" ::: "memory")
#define BAR __builtin_amdgcn_s_barrier()
#define SCHED __builtin_amdgcn_sched_barrier(0)

template <bool GATHER, class Epi>
__device__ __forceinline__ void gemm_tile(const bf16_t* __restrict__ A, const int lda, const int* __restrict__ tok, const int brow,
                                          const bf16_t* __restrict__ Bt, const int ldb, const int bcol, const int K,
                                          LAS char* shm, const Epi& epi) {
#define G_SA(b, h) (shm + ((b) * 2 + (h)) * 16384)
#define G_SB(b, h) (shm + (4 + (b) * 2 + (h)) * 16384)
  int tid = threadIdx.x; asm volatile("" : "+v"(tid)); tid &= 511;
  int wid = tid >> 6, lane = tid & 63, wr = wid >> 2, wc = wid & 3, fr = lane & 15, fq = lane >> 4;
  unsigned ao0, ao1, ao2, ao3, bo;
  {
    const int sb = (tid & 63) * 16, swz = sb ^ (((sb >> 9) & 1) << 5);
    const int R0 = ((tid >> 6) >> 1) * 16 + (swz >> 6), C0 = ((tid >> 6) & 1) * 32 + ((swz & 63) >> 1);
    if (GATHER) { ao0 = (unsigned)(tok[R0] * lda + C0); ao1 = (unsigned)(tok[R0 + 64] * lda + C0); ao2 = (unsigned)(tok[R0 + 128] * lda + C0); ao3 = (unsigned)(tok[R0 + 192] * lda + C0); }
    else { ao0 = (unsigned)((brow + R0) * lda + C0); ao1 = ao0 + 64u * lda; ao2 = ao0 + 128u * lda; ao3 = ao0 + 192u * lda; }
    bo = (unsigned)((bcol + R0) * ldb + C0);
  }
  const int lo = __builtin_amdgcn_readfirstlane(tid >> 6) * 1024;
#define STAGE_A0(P, kt) do { GLDS((A + (kt) * 64) + ao0, (P) + lo); GLDS((A + (kt) * 64) + ao1, (P) + lo + 8192); } while (0)
#define STAGE_A1(P, kt) do { GLDS((A + (kt) * 64) + ao2, (P) + lo); GLDS((A + (kt) * 64) + ao3, (P) + lo + 8192); } while (0)
#define STAGE_B0(P, kt) do { GLDS((Bt + (kt) * 64) + bo, (P) + lo); GLDS((Bt + 64 * ldb + (kt) * 64) + bo, (P) + lo + 8192); } while (0)
#define STAGE_B1(P, kt) do { GLDS((Bt + 128 * ldb + (kt) * 64) + bo, (P) + lo); GLDS((Bt + 192 * ldb + (kt) * 64) + bo, (P) + lo + 8192); } while (0)
#define LDA(dst, b, h) _Pragma("unroll") for (int m = 0; m < 4; ++m) _Pragma("unroll") for (int k = 0; k < 2; ++k) \
    dst[m][k] = *(LAS const bf16x8*)(G_SA(b, h) + lds_byte(wr * 64 + m * 16 + fr, k * 32 + fq * 8))
#define LDB(dst, b, h) _Pragma("unroll") for (int n = 0; n < 2; ++n) _Pragma("unroll") for (int k = 0; k < 2; ++k) \
    dst[n][k] = *(LAS const bf16x8*)(G_SB(b, h) + lds_byte(wc * 32 + n * 16 + fr, k * 32 + fq * 8))
#define MMA(ai, bj, At_, Bt_) do { __builtin_amdgcn_s_setprio(1); \
    _Pragma("unroll") for (int m = 0; m < 4; ++m) _Pragma("unroll") for (int n = 0; n < 2; ++n) _Pragma("unroll") for (int k = 0; k < 2; ++k) \
      acc[ai][bj][m][n] = __builtin_amdgcn_mfma_f32_16x16x32_bf16(Bt_[n][k], At_[m][k], acc[ai][bj][m][n], 0, 0, 0); \
    __builtin_amdgcn_s_setprio(0); } while (0)

  f32x4 acc[2][2][4][2] = {};
  bf16x8 At[4][2], B0[2][2], B1[2][2];
  const int nt = K / 64;
  STAGE_B0(G_SB(0, 0), 0); STAGE_A0(G_SA(0, 0), 0);
  STAGE_B1(G_SB(0, 1), 0); STAGE_A1(G_SA(0, 1), 0);
  if (wr == 1) BAR;
  WAIT_V(4); BAR;
  STAGE_B0(G_SB(1, 0), 1); STAGE_A0(G_SA(1, 0), 1); STAGE_B1(G_SB(1, 1), 1);
  WAIT_V(6); BAR;
  for (int t = 0; t < nt - 2; t += 2) {
    LDB(B0, 0, 0); SCHED; LDA(At, 0, 0); STAGE_A1(G_SA(1, 1), t + 1);
    WAIT_L(8); BAR; WAIT_L(0); MMA(0, 0, At, B0); BAR; SCHED;
    LDB(B1, 0, 1); STAGE_B0(G_SB(0, 0), t + 2);
    BAR; WAIT_L(0); MMA(0, 1, At, B1); BAR;
    LDA(At, 0, 1); STAGE_A0(G_SA(0, 0), t + 2);
    BAR; WAIT_L(0); MMA(1, 0, At, B0); BAR; SCHED;
    STAGE_B1(G_SB(0, 1), t + 2);
    WAIT_V(6); BAR; MMA(1, 1, At, B1); BAR;
    LDB(B0, 1, 0); SCHED; LDA(At, 1, 0); STAGE_A1(G_SA(0, 1), t + 2);
    WAIT_L(8); BAR; WAIT_L(0); MMA(0, 0, At, B0); BAR; SCHED;
    LDB(B1, 1, 1); STAGE_B0(G_SB(1, 0), t + 3);
    BAR; WAIT_L(0); MMA(0, 1, At, B1); BAR;
    LDA(At, 1, 1); STAGE_A0(G_SA(1, 0), t + 3);
    BAR; WAIT_L(0); MMA(1, 0, At, B0); BAR; SCHED;
    STAGE_B1(G_SB(1, 1), t + 3);
    WAIT_V(6); BAR; MMA(1, 1, At, B1); BAR;
  }
  { LDB(B0, 0, 0); WAIT_V(0); LDA(At, 0, 0); STAGE_A1(G_SA(1, 1), nt - 1);
    BAR; WAIT_L(0); MMA(0, 0, At, B0); BAR;
    LDB(B1, 0, 1); BAR; WAIT_L(0); MMA(0, 1, At, B1); BAR;
    LDA(At, 0, 1); WAIT_V(4); BAR; WAIT_L(0); MMA(1, 0, At, B0); MMA(1, 1, At, B1); BAR; }
  { LDB(B0, 1, 0); LDA(At, 1, 0); WAIT_V(2); BAR; WAIT_L(0); MMA(0, 0, At, B0); BAR;
    LDB(B1, 1, 1); WAIT_V(0); BAR; WAIT_L(0); MMA(0, 1, At, B1); BAR;
    LDA(At, 1, 1); BAR; WAIT_L(0); MMA(1, 0, At, B0); MMA(1, 1, At, B1); BAR; }
  if (wr == 0) BAR;
  int tz = threadIdx.x; asm volatile("" : "+v"(tz)); wid = tz >> 6; lane = tz & 63; wr = wid >> 2; wc = wid & 3; fr = lane & 15; fq = lane >> 4;
  epi(acc, brow, bcol, wr, wc, fr, fq);
#undef G_SA
#undef G_SB
#undef STAGE_A0
#undef STAGE_A1
#undef STAGE_B0
#undef STAGE_B1
#undef LDA
#undef LDB
#undef MMA
}

struct EpiPlain {
  bf16_t* C; int ldc; float sc;
  __device__ __forceinline__ void operator()(const f32x4 (&acc)[2][2][4][2], int brow, int bcol, int wr, int wc, int fr, int fq) const {
#pragma unroll
    for (int ai = 0; ai < 2; ++ai)
#pragma unroll
      for (int m = 0; m < 4; ++m) {
        bf16_t* rp = C + (size_t)(brow + ai * 128 + wr * 64 + m * 16 + fr) * ldc + bcol + wc * 32 + fq * 8;
#pragma unroll
        for (int bj = 0; bj < 2; ++bj) {
          u32x4 v = {cvtpk(acc[ai][bj][m][0][0] * sc, acc[ai][bj][m][0][1] * sc), cvtpk(acc[ai][bj][m][0][2] * sc, acc[ai][bj][m][0][3] * sc),
                     cvtpk(acc[ai][bj][m][1][0] * sc, acc[ai][bj][m][1][1] * sc), cvtpk(acc[ai][bj][m][1][2] * sc, acc[ai][bj][m][1][3] * sc)};
          *(u32x4*)(rp + bj * 128) = v;
        }
      }
  }
};
template <int MODE>
struct EpiPair {
  bf16_t* C; int ldc; int colbase; float sc;
  __device__ __forceinline__ void operator()(const f32x4 (&acc)[2][2][4][2], int brow, int bcol, int wr, int wc, int fr, int fq) const {
#pragma unroll
    for (int ai = 0; ai < 2; ++ai)
#pragma unroll
      for (int m = 0; m < 4; ++m) {
        bf16_t* rp = C + (size_t)(brow + ai * 128 + wr * 64 + m * 16 + fr) * ldc + ((bcol - colbase) >> 1) + wc * 16 + fq * 4;
#pragma unroll
        for (int bj = 0; bj < 2; ++bj) {
          float r[4];
#pragma unroll
          for (int j = 0; j < 4; ++j) {
            const float x0 = acc[ai][bj][m][0][j] * sc, x1 = acc[ai][bj][m][1][j] * sc;
            r[j] = MODE == 0 ? x0 * sigmoid_fast(x1) : x0 * sigmoid_fast(x0) * x1;
          }
          u32x2 v = {cvtpk(r[0], r[1]), cvtpk(r[2], r[3])};
          *(u32x2*)(rp + bj * 64) = v;
        }
      }
  }
};
struct EpiG1 {
  EpiPlain p; EpiPair<0> g; int nplain;
  __device__ __forceinline__ void operator()(const f32x4 (&acc)[2][2][4][2], int brow, int bcol, int wr, int wc, int fr, int fq) const {
    if (bcol < nplain) p(acc, brow, bcol, wr, wc, fr, fq); else g(acc, brow, bcol, wr, wc, fr, fq);
  }
};

typedef int v8i __attribute__((ext_vector_type(8)));
__device__ __forceinline__ int lds8(int r, int c) { return r * 128 + ((c ^ ((r >> 1) & 7)) << 4); }
template <bool GATHER, int lda, int ldb, int K, class Epi, class S>
__device__ __forceinline__ void gemm8_run(const unsigned char* __restrict__ A, const int* __restrict__ stok,
                                          LAS char* shm, const Epi& epi, const S& sched) {
#define G_SA(b, h) (shm + ((b) * 2 + (h)) * 16384)
#define G_SB(b, h) (shm + (4 + (b) * 2 + (h)) * 16384)
  int tid = threadIdx.x; asm volatile("" : "+v"(tid)); tid &= 511;
  int wid = tid >> 6, lane = tid & 63, wr = wid >> 2, wc = wid & 3, fr = lane & 15, fq = lane >> 4;
  unsigned ao0, ao1, ao2, ao3, bo;
  int R0 = 8 * wid + (lane >> 3), C0 = ((lane & 7) ^ ((R0 >> 1) & 7)) << 4;
  const int lo = __builtin_amdgcn_readfirstlane(tid >> 6) * 1024;
  int brow, bcol; const unsigned char* Bt;
  int ui = 0;
  if (!sched.unit(ui, brow, Bt, bcol)) return;
#define SETOFF(br, bc) do { if (GATHER) { const int* _t = stok + (br); ao0 = (unsigned)(_t[R0] * lda + C0); ao1 = (unsigned)(_t[R0 + 64] * lda + C0); ao2 = (unsigned)(_t[R0 + 128] * lda + C0); ao3 = (unsigned)(_t[R0 + 192] * lda + C0); } \
    else { ao0 = (unsigned)(((br) + R0) * lda + C0); ao1 = ao0 + 64u * lda; ao2 = ao0 + 128u * lda; ao3 = ao0 + 192u * lda; } \
    bo = (unsigned)(((bc) + R0) * ldb + C0); } while (0)
#define STAGE_A0(P, kt) do { GLDS((A + (kt) * 128) + ao0, (P) + lo); GLDS((A + (kt) * 128) + ao1, (P) + lo + 8192); } while (0)
#define STAGE_A1(P, kt) do { GLDS((A + (kt) * 128) + ao2, (P) + lo); GLDS((A + (kt) * 128) + ao3, (P) + lo + 8192); } while (0)
#define STAGE_B0(P, kt) do { GLDS((Bt + (kt) * 128) + bo, (P) + lo); GLDS((Bt + 64 * ldb + (kt) * 128) + bo, (P) + lo + 8192); } while (0)
#define STAGE_B1(P, kt) do { GLDS((Bt + 128 * ldb + (kt) * 128) + bo, (P) + lo); GLDS((Bt + 192 * ldb + (kt) * 128) + bo, (P) + lo + 8192); } while (0)
#define PRO() do { STAGE_B0(G_SB(0, 0), 0); STAGE_A0(G_SA(0, 0), 0); STAGE_B1(G_SB(0, 1), 0); STAGE_A1(G_SA(0, 1), 0); } while (0)
  const int fx = (fq ^ ((fr >> 1) & 7)) << 4;
  const int fa0 = (wr * 64 + fr) * 128 + fx, fb0 = (wc * 32 + fr) * 128 + fx;
#define FRAG8(dst, p0, p1) do { const v4i _x = *(LAS const v4i*)(p0); const v4i _y = *(LAS const v4i*)(p1); \
    dst = (v8i){_x[0], _x[1], _x[2], _x[3], _y[0], _y[1], _y[2], _y[3]}; } while (0)
#define LDA(dst, b, h) do { int fa1 = fa0; asm volatile("v_xor_b32 %0, 64, %0" : "+v"(fa1)); \
    _Pragma("unroll") for (int m = 0; m < 4; ++m) FRAG8(dst[m], G_SA(b, h) + fa0 + m * 2048, G_SA(b, h) + fa1 + m * 2048); } while (0)
#define LDB(dst, b, h) do { int fb1 = fb0; asm volatile("v_xor_b32 %0, 64, %0" : "+v"(fb1)); \
    _Pragma("unroll") for (int n = 0; n < 2; ++n) FRAG8(dst[n], G_SB(b, h) + fb0 + n * 2048, G_SB(b, h) + fb1 + n * 2048); } while (0)
#define MMA(ai, bj, At_, Bt_) do { __builtin_amdgcn_s_setprio(1); \
    _Pragma("unroll") for (int m = 0; m < 4; ++m) _Pragma("unroll") for (int n = 0; n < 2; ++n) \
      asm volatile("v_mfma_scale_f32_16x16x128_f8f6f4 %0, %1, %2, %0, %3, %3 op_sel_hi:[0,0,0]" : "+v"(acc[ai][bj][m][n]) : "v"(Bt_[n]), "v"(At_[m]), "v"(sc1)); \
    __builtin_amdgcn_s_setprio(0); } while (0)
  int sc1; asm volatile("v_mov_b32 %0, 0x7f7f7f7f" : "=v"(sc1));
  const int nt = K / 128;
  SETOFF(brow, bcol); PRO();
  bool first = true;
  for (;;) {
    f32x4 acc[2][2][4][2] = {};
    v8i At[4], B0[2], B1[2];
    if (wr == 1) BAR;
    if (first) WAIT_V(4); else WAIT_V(0);
    BAR;
    STAGE_B0(G_SB(1, 0), 1); STAGE_A0(G_SA(1, 0), 1); STAGE_B1(G_SB(1, 1), 1);
    WAIT_V(6); BAR;
    for (int t = 0; t < nt - 2; t += 2) {
      LDB(B0, 0, 0); SCHED; LDA(At, 0, 0); STAGE_A1(G_SA(1, 1), t + 1);
      WAIT_L(8); BAR; WAIT_L(0); MMA(0, 0, At, B0); BAR; SCHED;
      LDB(B1, 0, 1); STAGE_B0(G_SB(0, 0), t + 2);
      BAR; WAIT_L(0); MMA(0, 1, At, B1); BAR;
      LDA(At, 0, 1); STAGE_A0(G_SA(0, 0), t + 2);
      BAR; WAIT_L(0); MMA(1, 0, At, B0); BAR; SCHED;
      STAGE_B1(G_SB(0, 1), t + 2);
      WAIT_V(6); BAR; MMA(1, 1, At, B1); BAR;
      LDB(B0, 1, 0); SCHED; LDA(At, 1, 0); STAGE_A1(G_SA(0, 1), t + 2);
      WAIT_L(8); BAR; WAIT_L(0); MMA(0, 0, At, B0); BAR; SCHED;
      LDB(B1, 1, 1); STAGE_B0(G_SB(1, 0), t + 3);
      BAR; WAIT_L(0); MMA(0, 1, At, B1); BAR;
      LDA(At, 1, 1); STAGE_A0(G_SA(1, 0), t + 3);
      BAR; WAIT_L(0); MMA(1, 0, At, B0); BAR; SCHED;
      STAGE_B1(G_SB(1, 1), t + 3);
      WAIT_V(6); BAR; MMA(1, 1, At, B1); BAR;
    }
    { LDB(B0, 0, 0); WAIT_V(0); LDA(At, 0, 0); STAGE_A1(G_SA(1, 1), nt - 1);
      BAR; WAIT_L(0); MMA(0, 0, At, B0); BAR;
      LDB(B1, 0, 1); BAR; WAIT_L(0); MMA(0, 1, At, B1); BAR;
      LDA(At, 0, 1); WAIT_V(4); BAR; WAIT_L(0); MMA(1, 0, At, B0); MMA(1, 1, At, B1); BAR; }
    { LDB(B0, 1, 0); LDA(At, 1, 0); WAIT_V(2); BAR; WAIT_L(0); MMA(0, 0, At, B0); BAR;
      LDB(B1, 1, 1); WAIT_V(0); BAR; WAIT_L(0); MMA(0, 1, At, B1); BAR;
      LDA(At, 1, 1); BAR; WAIT_L(0); MMA(1, 0, At, B0); MMA(1, 1, At, B1); BAR; }
    if (wr == 0) BAR;
    const int cbrow = brow, cbcol = bcol;
    { int tz = threadIdx.x; asm volatile("" : "+v"(tz)); tz &= 511; wid = tz >> 6; lane = tz & 63; wr = wid >> 2; wc = wid & 3; fr = lane & 15; fq = lane >> 4;
      R0 = 8 * wid + (lane >> 3); C0 = ((lane & 7) ^ ((R0 >> 1) & 7)) << 4; }
    ++ui;
    const bool more = sched.unit(ui, brow, Bt, bcol);
    if (more) { SETOFF(brow, bcol); asm volatile("" ::: "memory"); PRO(); asm volatile("" ::: "memory"); }
    asm volatile("s_nop 15\n\ts_nop 15\n\ts_nop 7" ::: "memory");
#pragma unroll
    for (int i = 0; i < 32; ++i) asm volatile("" : "+v"((&acc[0][0][0][0])[i]));
    epi(acc, cbrow, cbcol, wr, wc, fr, fq);
    if (!more) break;
    first = false;
  }
#undef G_SA
#undef G_SB
#undef SETOFF
#undef STAGE_A0
#undef STAGE_A1
#undef STAGE_B0
#undef STAGE_B1
#undef PRO
#undef FRAG8
#undef LDA
#undef LDB
#undef MMA
}
__device__ __forceinline__ float clamp8(float x) { return fminf(fmaxf(x, -448.f), 448.f); }
__device__ __forceinline__ unsigned pack_fp8x4(float a, float b, float c, float d) {
  int p = __builtin_amdgcn_cvt_pk_fp8_f32(clamp8(a), clamp8(b), 0, false); p = __builtin_amdgcn_cvt_pk_fp8_f32(clamp8(c), clamp8(d), p, true); return (unsigned)p; }
struct EpiSwiGLU8 {
  unsigned char* C; int ldc;
  __device__ __forceinline__ void operator()(const f32x4 (&acc)[2][2][4][2], int brow, int bcol, int wr, int wc, int fr, int fq) const {
    constexpr float S = 1.f / 256.f;
#pragma unroll
    for (int ai = 0; ai < 2; ++ai)
#pragma unroll
      for (int m = 0; m < 4; ++m) {
        unsigned char* rp = C + (size_t)(brow + ai * 128 + wr * 64 + m * 16 + fr) * ldc + (bcol >> 1) + wc * 16 + fq * 4;
#pragma unroll
        for (int bj = 0; bj < 2; ++bj) {
          float r[4];
#pragma unroll
          for (int j = 0; j < 4; ++j) { const float g = acc[ai][bj][m][0][j] * S, u = acc[ai][bj][m][1][j] * S; r[j] = g * sigmoid_fast(g) * u; }
          *(unsigned*)(rp + bj * 64) = pack_fp8x4(r[0], r[1], r[2], r[3]);
        }
      }
  }
};
struct EpiPlain8 {
  unsigned char* C; int ldc; float sc;
  __device__ __forceinline__ void operator()(const f32x4 (&acc)[2][2][4][2], int brow, int bcol, int wr, int wc, int fr, int fq) const {
#pragma unroll
    for (int ai = 0; ai < 2; ++ai)
#pragma unroll
      for (int m = 0; m < 4; ++m) {
        unsigned char* rp = C + (size_t)(brow + ai * 128 + wr * 64 + m * 16 + fr) * ldc + bcol + wc * 32 + fq * 8;
#pragma unroll
        for (int bj = 0; bj < 2; ++bj) {
          u32x2 v = {pack_fp8x4(acc[ai][bj][m][0][0] * sc, acc[ai][bj][m][0][1] * sc, acc[ai][bj][m][0][2] * sc, acc[ai][bj][m][0][3] * sc),
                     pack_fp8x4(acc[ai][bj][m][1][0] * sc, acc[ai][bj][m][1][1] * sc, acc[ai][bj][m][1][2] * sc, acc[ai][bj][m][1][3] * sc)};
          *(u32x2*)(rp + bj * 128) = v;
        }
      }
  }
};
struct EpiPlainS {
  bf16_t* C; int ldc; float sc;
  __device__ __forceinline__ void operator()(const f32x4 (&acc)[2][2][4][2], int brow, int bcol, int wr, int wc, int fr, int fq) const {
#pragma unroll
    for (int ai = 0; ai < 2; ++ai)
#pragma unroll
      for (int m = 0; m < 4; ++m) {
        bf16_t* rp = C + (size_t)(brow + ai * 128 + wr * 64 + m * 16 + fr) * ldc + bcol + wc * 32 + fq * 8;
#pragma unroll
        for (int bj = 0; bj < 2; ++bj) {
          u32x4 v = {cvtpk(acc[ai][bj][m][0][0] * sc, acc[ai][bj][m][0][1] * sc), cvtpk(acc[ai][bj][m][0][2] * sc, acc[ai][bj][m][0][3] * sc),
                     cvtpk(acc[ai][bj][m][1][0] * sc, acc[ai][bj][m][1][1] * sc), cvtpk(acc[ai][bj][m][1][2] * sc, acc[ai][bj][m][1][3] * sc)};
          *(u32x4*)(rp + bj * 128) = v;
        }
      }
  }
};

__device__ __forceinline__ void dense_unit(int u, int nM, int nN, int& pm, int& pn) {
  const int nwg = nM * nN, NX = 8, WGM = 8;
  int wgid = u;
  { const int q = nwg / NX, r = nwg % NX, xcd = wgid % NX, off = wgid / NX; wgid = (xcd < r ? xcd * (q + 1) : r * (q + 1) + (xcd - r) * q) + off; }
  const int nig = WGM * nN, gid = wgid / nig, fm = gid * WGM, gsz = min(nM - fm, WGM);
  pm = fm + ((wgid % nig) % gsz); pn = (wgid % nig) / gsz;
}

namespace at {
constexpr int DH = 128, NW = 8, QBLK = 32, KVBLK = 64;
constexpr float SCALE = 0.088388347648318440f;
constexpr float QC = SCALE * 1.4426950408889634f;
constexpr int SHM_V = KVBLK * DH * 2, SHM_K = KVBLK * DH * 2;
#define KSWZ(row, colB) ((row) * 256 + ((colB) ^ (((row) & 7) << 4)))
__device__ __forceinline__ int crow(int r, int hi) { return (r & 3) + 8 * (r >> 2) + 4 * hi; }
__device__ __forceinline__ unsigned cvtpkv(float lo, float hi) { unsigned r; asm volatile("v_cvt_pk_bf16_f32 %0, %1, %2" : "=v"(r) : "v"(lo), "v"(hi)); return r; }
#define PK4(P, BASE, OUT) do { unsigned a0 = cvtpkv(P[BASE + 0], P[BASE + 1]), a1 = cvtpkv(P[BASE + 2], P[BASE + 3]);   \
    unsigned b0 = cvtpkv(P[BASE + 4], P[BASE + 5]), b1 = cvtpkv(P[BASE + 6], P[BASE + 7]);                              \
    auto r0 = __builtin_amdgcn_permlane32_swap(a0, b0, false, false); auto r1 = __builtin_amdgcn_permlane32_swap(a1, b1, false, false); \
    u32x4 w = {r0[0], r1[0], r0[1], r1[1]}; OUT = *reinterpret_cast<bf16x8*>(&w); } while (0)
__device__ __forceinline__ float load_q(const bf16_t* __restrict__ Qw, bf16x8 (&qr)[8], float kmax2) {
  float ss = 0;
#pragma unroll
  for (int d0 = 0; d0 < 8; ++d0) {
    const u32x4 raw = *reinterpret_cast<const u32x4*>(Qw + d0 * 16); u32x4 o;
#pragma unroll
    for (int i = 0; i < 4; ++i) { const unsigned pk = cvtpk(bflo(raw[i]) * QC, bfhi(raw[i]) * QC); o[i] = pk; const float a = bflo(pk), b = bfhi(pk); ss += a * a + b * b; }
    qr[d0] = *reinterpret_cast<bf16x8*>(&o);
  }
  { auto rr = __builtin_amdgcn_permlane32_swap(__float_as_uint(ss), __float_as_uint(ss), false, false); ss = __uint_as_float(rr[0]) + __uint_as_float(rr[1]); }
  return -(sqrtf(ss * kmax2) * 1.01f + 1e-3f);
}
__device__ __forceinline__ void exp16(f32x16& p) {
#pragma unroll
  for (int r = 0; r < 16; ++r) p[r] = __builtin_amdgcn_exp2f(p[r]);
}
__device__ __forceinline__ float sum16(const f32x16& p) { float s = 0;
#pragma unroll
  for (int r = 0; r < 16; ++r) s += p[r];
  return s; }
__device__ __forceinline__ void qkt(f32x16& p0, f32x16& p1, LAS const char* Ks, const bf16x8* qr, int r32, int hi, float nmc) {
#pragma unroll
  for (int r = 0; r < 16; ++r) { p0[r] = nmc; p1[r] = nmc; }
#pragma unroll
  for (int d0 = 0; d0 < 8; ++d0) { int cb = (d0 * 16 + hi * 8) * 2;
    bf16x8 b0 = *(LAS const bf16x8*)(Ks + KSWZ(r32, cb));
    bf16x8 b1 = *(LAS const bf16x8*)(Ks + KSWZ(32 + r32, cb));
    p0 = __builtin_amdgcn_mfma_f32_32x32x16_bf16(b0, qr[d0], p0, 0, 0, 0);
    p1 = __builtin_amdgcn_mfma_f32_32x32x16_bf16(b1, qr[d0], p1, 0, 0, 0); }
}
__device__ __forceinline__ int v_st(int k, int c) { const int kk = (k & ~0xC) | ((k & 4) << 1) | ((k & 8) >> 1); return ((kk >> 3) * 4 + (c >> 5)) * 512 + ((kk & 7) * 32 + (c & 31)) * 2; }
__device__ __forceinline__ int v_st256(int k, int c) { const int kk = (k & ~0xC) | ((k & 4) << 1) | ((k & 8) >> 1); return ((kk >> 3) * 8 + (c >> 5)) * 512 + ((kk & 7) * 32 + (c & 31)) * 2; }
__device__ __forceinline__ int v_rd_base(int lane) { return ((lane & 3) << 3) | (((lane >> 2) & 3) << 6) | (((lane >> 4) & 1) << 5) | (((lane >> 5) & 1) << 8); }
template <int OFF> __device__ __forceinline__ s16x4 tr_read(int vb) {
  s16x4 r; asm volatile("ds_read_b64_tr_b16 %0, %1 offset:%2" : "=&v"(r) : "v"(vb), "i"(OFF) : "memory"); return r;
}
template <int BASE, int KS, int HS> __device__ __forceinline__ void pv_one(f32x16& od, int vb, bf16x8 pa0, bf16x8 pa1, bf16x8 pa2, bf16x8 pa3) {
  const s16x4 l0 = tr_read<BASE>(vb), h0 = tr_read<BASE + HS>(vb), l1 = tr_read<BASE + KS>(vb), h1 = tr_read<BASE + KS + HS>(vb);
  const s16x4 l2 = tr_read<BASE + 2 * KS>(vb), h2 = tr_read<BASE + 2 * KS + HS>(vb), l3 = tr_read<BASE + 3 * KS>(vb), h3 = tr_read<BASE + 3 * KS + HS>(vb);
  asm volatile("s_waitcnt lgkmcnt(0)" ::: "memory"); SCHED;
#define PK(L, H) (bf16x8){L[0], L[1], L[2], L[3], H[0], H[1], H[2], H[3]}
  od = __builtin_amdgcn_mfma_f32_32x32x16_bf16(pa0, PK(l0, h0), od, 0, 0, 0);
  od = __builtin_amdgcn_mfma_f32_32x32x16_bf16(pa1, PK(l1, h1), od, 0, 0, 0);
  od = __builtin_amdgcn_mfma_f32_32x32x16_bf16(pa2, PK(l2, h2), od, 0, 0, 0);
  od = __builtin_amdgcn_mfma_f32_32x32x16_bf16(pa3, PK(l3, h3), od, 0, 0, 0);
#undef PK
}
__device__ __forceinline__ void pv_d0(f32x16* o, int vb, bf16x8 pa0, bf16x8 pa1, bf16x8 pa2, bf16x8 pa3) {
  pv_one<0, 4096, 2048>(o[0], vb, pa0, pa1, pa2, pa3); pv_one<512, 4096, 2048>(o[1], vb, pa0, pa1, pa2, pa3);
  pv_one<1024, 4096, 2048>(o[2], vb, pa0, pa1, pa2, pa3); pv_one<1536, 4096, 2048>(o[3], vb, pa0, pa1, pa2, pa3);
}
__device__ __forceinline__ void pv_d0_256(f32x16* o, int vb, bf16x8 pa0, bf16x8 pa1, bf16x8 pa2, bf16x8 pa3) {
  pv_one<0, 8192, 4096>(o[0], vb, pa0, pa1, pa2, pa3); pv_one<512, 8192, 4096>(o[1], vb, pa0, pa1, pa2, pa3);
  pv_one<1024, 8192, 4096>(o[2], vb, pa0, pa1, pa2, pa3); pv_one<1536, 8192, 4096>(o[3], vb, pa0, pa1, pa2, pa3);
}
__device__ __forceinline__ void store_o8(const f32x16* o, float l_tot, LAS float* li, unsigned char* __restrict__ Ow, int ldo, int r32, int hi) {
  if (hi == 0) li[r32] = l_tot; asm volatile("s_waitcnt lgkmcnt(0)" ::: "memory");
  float rli[16];
#pragma unroll
  for (int r = 0; r < 16; ++r) rli[r] = 8.f * __builtin_amdgcn_rcpf(li[crow(r, hi)]);
#pragma unroll
  for (int r = 0; r < 16; ++r) { const int orow = crow(r, hi);
#pragma unroll
    for (int d0 = 0; d0 < 4; ++d0) Ow[(long)orow * ldo + d0 * 32 + r32] = (unsigned char)__builtin_amdgcn_cvt_pk_fp8_f32(o[d0][r] * rli[r], 0.f, 0, false); }
}
__device__ __forceinline__ void store_o(const f32x16* o, float l_tot, LAS float* li, bf16_t* __restrict__ Ow, int ldo, int r32, int hi) {
  if (hi == 0) li[r32] = l_tot; asm volatile("s_waitcnt lgkmcnt(0)" ::: "memory");
  float rli[16];
#pragma unroll
  for (int r = 0; r < 16; ++r) rli[r] = __builtin_amdgcn_rcpf(li[crow(r, hi)]);
#pragma unroll
  for (int r = 0; r < 16; ++r) { const int orow = crow(r, hi);
#pragma unroll
    for (int d0 = 0; d0 < 4; ++d0) Ow[(long)orow * ldo + d0 * 32 + r32] = f2bf(o[d0][r] * rli[r]); }
}

__device__ __forceinline__ int unswap23(int kk) { return (kk & ~0xC) | ((kk & 4) << 1) | ((kk & 8) >> 1); }
__device__ __forceinline__ int k_dma_voff(int wid, int lane, int ldk) {
  const int row = 4 * wid + (lane >> 4); return row * ldk * 2 + (((lane & 15) * 16) ^ ((row & 7) << 4)); }
#define DMA16(rs, ldsp, voff, soff) __builtin_amdgcn_raw_ptr_buffer_load_lds(rs, (LAS void*)(ldsp), 16, voff, soff, 0, 0)

constexpr int SHM_T = SHM_K + SHM_V;
__device__ __forceinline__ void attn_body(const bf16_t* __restrict__ Qb, const int ldq, const bf16_t* __restrict__ Kh, const bf16_t* __restrict__ Vh, const int ldk,
                                          bf16_t* __restrict__ Ob, const int ldo, const int seq, const float kmax2, LAS char* lds) {
  int tid = threadIdx.x; asm volatile("" : "+v"(tid)); tid &= 511;
  const int wid = tid >> 6, lane = tid & 63, r32 = lane & 31, hi = lane >> 5;
  LAS float* li_l = (LAS float*)(lds + 3 * SHM_T) + wid * 64;
  float l_reg = 0; f32x16 o[4] = {}; bf16x8 qr[8];
  const float nmc = load_q(Qb + (long)(wid * QBLK + r32) * ldq + hi * 8, qr, kmax2);
  const int vrb = v_rd_base(lane);
  const int kvo = k_dma_voff(wid, lane, ldk);
  const int vvo = unswap23(8 * (wid >> 1) + ((lane & 31) >> 2)) * ldk * 2 + ((2 * (wid & 1) + (lane >> 5)) * 32 + (lane & 3) * 8) * 2;
  const int l32 = 64 * ldk, pz = wid * 1024;
  const __amdgpu_buffer_rsrc_t krs = __builtin_amdgcn_make_buffer_rsrc((void*)Kh, 0, 0x7ffffff0, 0x00020000);
  const __amdgpu_buffer_rsrc_t vrs = __builtin_amdgcn_make_buffer_rsrc((void*)Vh, 0, 0x7ffffff0, 0x00020000);
#define TDMA(slot, k0) do { const int _o = (k0) * ldk * 2; LAS char* _b = lds + (slot) * SHM_T + pz; \
    DMA16(krs, _b, kvo, _o); DMA16(krs, _b + 8192, kvo, _o + l32); DMA16(vrs, _b + SHM_K, vvo, _o); DMA16(vrs, _b + SHM_K + 8192, vvo, _o + l32); } while (0)
#define VM0() asm volatile("s_waitcnt vmcnt(0)" ::: "memory")
#define FINISH(P0, P1) do { exp16(P1); l_reg += sum16(P0) + sum16(P1); PK4(P0, 0, pa0); PK4(P0, 8, pa1); PK4(P1, 0, pa2); PK4(P1, 8, pa3); } while (0)
  f32x16 pA0, pA1, pB0, pB1; bf16x8 pa0, pa1, pa2, pa3; const int NT = seq / KVBLK;
  TDMA(0, 0); VM0(); __syncthreads();
  TDMA(1, KVBLK);
  qkt(pA0, pA1, lds, qr, r32, hi, nmc); exp16(pA0);
  VM0(); __syncthreads();
  int sk = 1, sv = 0, sd = 2;
  for (int j = 1; j + 1 < NT; j += 2) {
    TDMA(sd, (j + 1) * KVBLK);
    SCHED; qkt(pB0, pB1, lds + sk * SHM_T, qr, r32, hi, nmc);
    FINISH(pA0, pA1); SCHED;
    pv_d0(o, (int)(uintptr_t)(lds + sv * SHM_T + SHM_K) + vrb, pa0, pa1, pa2, pa3); exp16(pB0);
    VM0(); __syncthreads();
    { const int t = sv; sv = sk; sk = sd; sd = t; }
    if (j + 2 < NT) TDMA(sd, (j + 2) * KVBLK);
    SCHED; qkt(pA0, pA1, lds + sk * SHM_T, qr, r32, hi, nmc);
    FINISH(pB0, pB1); SCHED;
    pv_d0(o, (int)(uintptr_t)(lds + sv * SHM_T + SHM_K) + vrb, pa0, pa1, pa2, pa3); exp16(pA0);
    VM0(); __syncthreads();
    { const int t = sv; sv = sk; sk = sd; sd = t; }
  }
  SCHED; qkt(pB0, pB1, lds + sk * SHM_T, qr, r32, hi, nmc);
  FINISH(pA0, pA1); SCHED;
  pv_d0(o, (int)(uintptr_t)(lds + sv * SHM_T + SHM_K) + vrb, pa0, pa1, pa2, pa3); exp16(pB0);
  FINISH(pB0, pB1); SCHED;
  pv_d0(o, (int)(uintptr_t)(lds + sk * SHM_T + SHM_K) + vrb, pa0, pa1, pa2, pa3);
  { auto rr = __builtin_amdgcn_permlane32_swap(__float_as_uint(l_reg), __float_as_uint(l_reg), false, false); l_reg = __uint_as_float(rr[0]) + __uint_as_float(rr[1]); }
  store_o(o, l_reg, li_l, Ob + (long)(wid * QBLK) * ldo, ldo, r32, hi);
  VM0();
  __syncthreads();
#undef TDMA
#undef FINISH
}

constexpr int SHM_V2 = KVBLK * 256 * 2;
__device__ __forceinline__ void attn_body_dv256(const bf16_t* __restrict__ Qb, const int ldq, const bf16_t* __restrict__ Kh, const bf16_t* __restrict__ Vh, const int ldk,
                                                bf16_t* __restrict__ Ob, const int ldo, const int seq, const float kmax2, LAS char* lds) {
  int tid = threadIdx.x; asm volatile("" : "+v"(tid)); tid &= 511;
  const int wid = tid >> 6, lane = tid & 63, r32 = lane & 31, hi = lane >> 5, rg = wid >> 1, kh = wid & 1;
  LAS char* K_lds = lds; LAS char* V_lds = lds + 2 * SHM_K; LAS char* X_lds = lds + 2 * SHM_K + 2 * SHM_V2;
  float l_reg = 0; f32x16 o[4] = {}; bf16x8 qr[8];
  const float nmc = load_q(Qb + (long)(rg * QBLK + r32) * ldq + hi * 8, qr, kmax2);
  const int vb0 = (int)(uintptr_t)V_lds + v_rd_base(lane) + kh * 2048;
  const int kvo = k_dma_voff(wid, lane, ldk);
  const int vvo = unswap23(8 * (wid >> 2) + ((lane & 31) >> 2)) * ldk * 2 + ((2 * (wid & 3) + (lane >> 5)) * 32 + (lane & 3) * 8) * 2;
  const int l32 = 64 * ldk, l16 = 32 * ldk, pz = wid * 1024;
  const int xw = (rg * 4 + kh * 2) * 1024 + lane * 16, xr = rg * 4096 + lane * 16;
  const __amdgpu_buffer_rsrc_t krs = __builtin_amdgcn_make_buffer_rsrc((void*)Kh, 0, 0x7ffffff0, 0x00020000);
  const __amdgpu_buffer_rsrc_t vrs = __builtin_amdgcn_make_buffer_rsrc((void*)Vh, 0, 0x7ffffff0, 0x00020000);
#define KDMA(b, k0) do { const int _o = (k0) * ldk * 2; LAS char* _b = K_lds + (b) * SHM_K + pz; DMA16(krs, _b, kvo, _o); DMA16(krs, _b + 8192, kvo, _o + l32); } while (0)
#define VDMA(b, k0) do { const int _o = (k0) * ldk * 2; LAS char* _b = V_lds + (b) * SHM_V2 + pz; DMA16(vrs, _b, vvo, _o); DMA16(vrs, _b + 8192, vvo, _o + l16); \
    DMA16(vrs, _b + 16384, vvo, _o + 2 * l16); DMA16(vrs, _b + 24576, vvo, _o + 3 * l16); } while (0)
  f32x16 pA, pB; bf16x8 pa0, pa1, pa2, pa3, own0, own1; const int NT = seq / KVBLK;
  const int kxor = ((32 * kh + r32) & 7) << 4, krb = (32 * kh + r32) * 256;
#define QKHALF(P, b) do { _Pragma("unroll") for (int r = 0; r < 16; ++r) P[r] = nmc; \
    _Pragma("unroll") for (int d0 = 0; d0 < 8; ++d0) { const bf16x8 bk = *(LAS const bf16x8*)(K_lds + (b) * SHM_K + krb + (((d0 * 16 + hi * 8) * 2) ^ kxor)); \
      P = __builtin_amdgcn_mfma_f32_32x32x16_bf16(bk, qr[d0], P, 0, 0, 0); } } while (0)
#define FINH(P) do { exp16(P); l_reg += sum16(P); PK4(P, 0, own0); PK4(P, 8, own1); } while (0)
#define XWRITE(b) do { *(LAS bf16x8*)(X_lds + (b) * 16384 + xw) = own0; *(LAS bf16x8*)(X_lds + (b) * 16384 + xw + 1024) = own1; } while (0)
#define XREAD(b) do { pa0 = *(LAS const bf16x8*)(X_lds + (b) * 16384 + xr); pa1 = *(LAS const bf16x8*)(X_lds + (b) * 16384 + xr + 1024); \
    pa2 = *(LAS const bf16x8*)(X_lds + (b) * 16384 + xr + 2048); pa3 = *(LAS const bf16x8*)(X_lds + (b) * 16384 + xr + 3072); } while (0)
#define STEP(PA, PB, b, j) do { \
    SCHED; if ((j) + 1 < NT) QKHALF(PB, (b) ^ 1); FINH(PA); SCHED; \
    XWRITE(b); VM0(); __syncthreads(); \
    if ((j) + 3 < NT) KDMA((b) ^ 1, ((j) + 3) * KVBLK); if ((j) + 1 < NT) VDMA((b) ^ 1, ((j) + 1) * KVBLK); \
    XREAD(b); \
    pv_d0_256(o, vb0 + (b) * SHM_V2, pa0, pa1, pa2, pa3); } while (0)
  KDMA(0, 0); KDMA(1, KVBLK); VDMA(0, 0); VM0(); __syncthreads();
  QKHALF(pA, 0);
  __syncthreads();
  if (2 < NT) KDMA(0, 2 * KVBLK);
  for (int j = 0; j < NT; j += 2) { STEP(pA, pB, 0, j); STEP(pB, pA, 1, j + 1); }
  __syncthreads();
  LAS float* lx = (LAS float*)X_lds;
  lx[wid * 64 + lane] = l_reg; __syncthreads();
  const float l_tot = lx[wid * 64 + r32] + lx[wid * 64 + 32 + r32] + lx[(wid ^ 1) * 64 + r32] + lx[(wid ^ 1) * 64 + 32 + r32];
  store_o(o, l_tot, lx + 512 + wid * 32, Ob + (long)(rg * QBLK) * ldo + kh * 128, ldo, r32, hi);
  VM0();
  __syncthreads();
#undef KDMA
#undef VDMA
#undef QKHALF
#undef FINH
#undef XWRITE
#undef XREAD
#undef STEP
#undef VM0
}

#define LGK(n) asm volatile("s_waitcnt lgkmcnt(" #n ")" ::: "memory")
template <int OFF> __device__ __forceinline__ bf16x8 k_read(int ka) { bf16x8 r; asm volatile("ds_read_b128 %0, %1 offset:%2" : "=&v"(r) : "v"(ka), "i"(OFF) : "memory"); return r; }
struct VSet { s16x4 l0, h0, l1, h1; };
template <int OFF> __device__ __forceinline__ void v_read(VSet& s, int vb) { s.l0 = tr_read<OFF>(vb); s.h0 = tr_read<OFF + 4096>(vb); s.l1 = tr_read<OFF + 8192>(vb); s.h1 = tr_read<OFF + 12288>(vb); }
__device__ __forceinline__ void pv2(f32x16& oa, const VSet& s, bf16x8 pa0, bf16x8 pa1) {
#define PK(L, H) (bf16x8){L[0], L[1], L[2], L[3], H[0], H[1], H[2], H[3]}
  oa = __builtin_amdgcn_mfma_f32_32x32x16_bf16(pa0, PK(s.l0, s.h0), oa, 0, 0, 0);
  oa = __builtin_amdgcn_mfma_f32_32x32x16_bf16(pa1, PK(s.l1, s.h1), oa, 0, 0, 0);
#undef PK
}
template <bool SHIFT>
__device__ __forceinline__ void attn_body_c256_t(const bf16_t* __restrict__ Qb, const int ldq, const bf16_t* __restrict__ Kh, const bf16_t* __restrict__ Vh, const int ldk,
                                                 bf16_t* __restrict__ Ob, const int ldo, const int seq, const float nmc, const bf16x8 (&qr)[8], LAS char* lds) {
  int tid = threadIdx.x; asm volatile("" : "+v"(tid)); tid &= 511;
  const int wid = __builtin_amdgcn_readfirstlane(tid >> 6), lane = tid & 63, r32 = lane & 31, hi = lane >> 5;
  LAS char* K_lds = lds; LAS char* V_lds = lds + 2 * SHM_K;
  LAS float* li_l = (LAS float*)(lds + 2 * SHM_K + 2 * SHM_V2) + wid * 64;
  float l_reg = 0; f32x16 o[8] = {};
  const int vb0 = (int)(uintptr_t)V_lds + v_rd_base(lane);
  const int kvo = k_dma_voff(wid, lane, ldk);
  const int vvo = unswap23(8 * (wid >> 2) + ((lane & 31) >> 2)) * ldk * 2 + ((2 * (wid & 3) + (lane >> 5)) * 32 + (lane & 3) * 8) * 2;
  const int l32 = 64 * ldk, l16 = 32 * ldk, pz = wid * 1024;
  const __amdgpu_buffer_rsrc_t krs = __builtin_amdgcn_make_buffer_rsrc((void*)Kh, 0, 0x7ffffff0, 0x00020000);
  const __amdgpu_buffer_rsrc_t vrs = __builtin_amdgcn_make_buffer_rsrc((void*)Vh, 0, 0x7ffffff0, 0x00020000);
#define VM0() asm volatile("s_waitcnt vmcnt(0)" ::: "memory")
#define KVDMA(b, k0) do { const int _o = (k0) * ldk * 2; LAS char* _k = K_lds + (b) * SHM_K + pz; LAS char* _v = V_lds + (b) * SHM_V2 + pz; \
    DMA16(krs, _k, kvo, _o); DMA16(krs, _k + 8192, kvo, _o + l32); DMA16(vrs, _v, vvo, _o); DMA16(vrs, _v + 8192, vvo, _o + l16); \
    DMA16(vrs, _v + 16384, vvo, _o + 2 * l16); DMA16(vrs, _v + 24576, vvo, _o + 3 * l16); } while (0)
  int ka[8];
  { const int kxor = (r32 & 7) << 4, krb = (int)(uintptr_t)K_lds + r32 * 256;
#pragma unroll
    for (int d0 = 0; d0 < 8; ++d0) ka[d0] = krb + (((d0 * 16 + hi * 8) * 2) ^ kxor); }
  f32x16 P; bf16x8 pa0, pa1, f0, f1, f2, f3; VSet va, vb_, vc;
  const int NT = seq / KVBLK;
#define PINIT() do { _Pragma("unroll") for (int r = 0; r < 16; ++r) { float _z; asm volatile("v_mov_b32 %0, %1" : "=v"(_z) : "v"(SHIFT ? nmc : 0.f)); P[r] = _z; } } while (0)
#define KOFF(b, h) ((b) * 16384 + (h) * 8192)
#define VOFF(b, h, d0) ((b) * 32768 + (h) * 16384 + (d0) * 512)
#define KPRO(b, h) do { f0 = k_read<KOFF(b, h)>(ka[0]); f1 = k_read<KOFF(b, h)>(ka[1]); f2 = k_read<KOFF(b, h)>(ka[2]); } while (0)
#define QKM(F, d0) do { SCHED; P = __builtin_amdgcn_mfma_f32_32x32x16_bf16(F, qr[d0], P, 0, 0, 0); SCHED; } while (0)
#define QKHALF(b, h) do { PINIT(); \
    LGK(2); QKM(f0, 0); f3 = k_read<KOFF(b, h)>(ka[3]); \
    LGK(2); QKM(f1, 1); f0 = k_read<KOFF(b, h)>(ka[4]); \
    LGK(2); QKM(f2, 2); f1 = k_read<KOFF(b, h)>(ka[5]); \
    LGK(2); QKM(f3, 3); f2 = k_read<KOFF(b, h)>(ka[6]); \
    LGK(2); QKM(f0, 4); f3 = k_read<KOFF(b, h)>(ka[7]); \
    LGK(2); QKM(f1, 5); v_read<VOFF(b, h, 0)>(va, vb0); \
    LGK(5); QKM(f2, 6); v_read<VOFF(b, h, 1)>(vb_, vb0); \
    LGK(8); QKM(f3, 7); } while (0)
#define SMH() do { exp16(P); l_reg += sum16(P); PK4(P, 0, pa0); PK4(P, 8, pa1); } while (0)
#define PVM(S, d0) do { SCHED; pv2(o[d0], S, pa0, pa1); SCHED; } while (0)
#define PVHALF(b, h, NEXTK, nb, nh) do { \
    LGK(4); PVM(va, 0); v_read<VOFF(b, h, 2)>(vc, vb0); \
    LGK(4); PVM(vb_, 1); v_read<VOFF(b, h, 3)>(va, vb0); \
    LGK(4); PVM(vc, 2); v_read<VOFF(b, h, 4)>(vb_, vb0); \
    LGK(4); PVM(va, 3); v_read<VOFF(b, h, 5)>(vc, vb0); \
    LGK(4); PVM(vb_, 4); v_read<VOFF(b, h, 6)>(va, vb0); \
    LGK(4); PVM(vc, 5); v_read<VOFF(b, h, 7)>(vb_, vb0); \
    LGK(4); PVM(va, 6); if (NEXTK) { f0 = k_read<KOFF(nb, nh)>(ka[0]); f1 = k_read<KOFF(nb, nh)>(ka[1]); } \
    if (NEXTK) { LGK(2); } else { LGK(0); } PVM(vb_, 7); if (NEXTK) { f2 = k_read<KOFF(nb, nh)>(ka[2]); } } while (0)
#define STEPC(b, j) do { if ((j) + 1 < NT) KVDMA((b) ^ 1, ((j) + 1) * KVBLK); \
    KPRO(b, 0); QKHALF(b, 0); SMH(); PVHALF(b, 0, true, b, 1); \
    QKHALF(b, 1); SMH(); PVHALF(b, 1, false, 0, 0); \
    VM0(); __syncthreads(); } while (0)
  KVDMA(0, 0); VM0(); __syncthreads();
  for (int j = 0; j < NT; j += 2) { STEPC(0, j); STEPC(1, j + 1); }
  { auto rr = __builtin_amdgcn_permlane32_swap(__float_as_uint(l_reg), __float_as_uint(l_reg), false, false); l_reg = __uint_as_float(rr[0]) + __uint_as_float(rr[1]); }
  if (hi == 0) li_l[r32] = l_reg; asm volatile("s_waitcnt lgkmcnt(0)" ::: "memory");
  bf16_t* Ow = Ob + (long)(wid * QBLK) * ldo;
#pragma unroll
  for (int r = 0; r < 16; ++r) { const int orow = crow(r, hi); const float rl = __builtin_amdgcn_rcpf(li_l[orow]);
#pragma unroll
    for (int d0 = 0; d0 < 8; ++d0) Ow[(long)orow * ldo + d0 * 32 + r32] = f2bf(o[d0][r] * rl); }
  VM0();
  __syncthreads();
#undef KVDMA
#undef PINIT
#undef KOFF
#undef VOFF
#undef KPRO
#undef QKM
#undef QKHALF
#undef SMH
#undef PVM
#undef PVHALF
#undef STEPC
#undef VM0
}
__device__ __forceinline__ void attn_body_c256(const bf16_t* __restrict__ Qb, const int ldq, const bf16_t* __restrict__ Kh, const bf16_t* __restrict__ Vh, const int ldk,
                                               bf16_t* __restrict__ Ob, const int ldo, const int seq, const float kmax2, LAS char* lds) {
  int tid = threadIdx.x; asm volatile("" : "+v"(tid)); tid &= 511;
  const int wid = tid >> 6, lane = tid & 63, r32 = lane & 31, hi = lane >> 5;
  bf16x8 qr[8];
  const float nmc = load_q(Qb + (long)(wid * QBLK + r32) * ldq + hi * 8, qr, kmax2);
  if (__all(nmc > -64.f)) attn_body_c256_t<false>(Qb, ldq, Kh, Vh, ldk, Ob, ldo, seq, 0.f, qr, lds);
  else attn_body_c256_t<true>(Qb, ldq, Kh, Vh, ldk, Ob, ldo, seq, nmc, qr, lds);
}

__device__ __forceinline__ float load_q8(const bf16_t* __restrict__ Qrow, int hi, v8i_ (&qf)[2], float kmax2) {
  float ss = 0;
#pragma unroll
  for (int st = 0; st < 2; ++st) {
    const bf16_t* p = Qrow + 64 * st + 32 * hi; v8i_ o;
#pragma unroll
    for (int c = 0; c < 4; ++c) { const u32x4 raw = *reinterpret_cast<const u32x4*>(p + 8 * c);
      const unsigned w0 = pack8x4(bflo(raw[0]) * QC, bfhi(raw[0]) * QC, bflo(raw[1]) * QC, bfhi(raw[1]) * QC);
      const unsigned w1 = pack8x4(bflo(raw[2]) * QC, bfhi(raw[2]) * QC, bflo(raw[3]) * QC, bfhi(raw[3]) * QC);
      o[2 * c] = (int)w0; o[2 * c + 1] = (int)w1; ss += sq8x4(w0) + sq8x4(w1); }
    qf[st] = o;
  }
  { auto rr = __builtin_amdgcn_permlane32_swap(__float_as_uint(ss), __float_as_uint(ss), false, false); ss = __uint_as_float(rr[0]) + __uint_as_float(rr[1]); }
  return -(sqrtf(ss * kmax2) * 1.01f + 1e-3f);
}
__device__ __forceinline__ int k8_dma_voff(int wid, int lane, int ldk8) {
  const int row = 8 * wid + (lane >> 3); return row * ldk8 + (((lane & 7) ^ ((row >> 1) & 7)) << 4); }
template <int OFF> __device__ __forceinline__ v4i k8_read(int ka) { v4i r; asm volatile("ds_read_b128 %0, %1 offset:%2" : "=&v"(r) : "v"(ka), "i"(OFF) : "memory"); return r; }

template <bool SHIFT>
__device__ __forceinline__ void attn_body_c256q8_t(const unsigned char* __restrict__ K8, const int ldk8, const bf16_t* __restrict__ Vh, const int ldk,
                                                   bf16_t* __restrict__ Ob, const int ldo, const int seq, const float nmc, const v8i_ (&qf)[2], LAS char* lds) {
  int tid = threadIdx.x; asm volatile("" : "+v"(tid)); tid &= 511;
  const int wid = __builtin_amdgcn_readfirstlane(tid >> 6), lane = tid & 63, r32 = lane & 31, hi = lane >> 5;
  constexpr int SHM_K8 = KVBLK * 128;
  LAS char* K_lds = lds; LAS char* V_lds = lds + 2 * SHM_K8;
  LAS float* li_l = (LAS float*)(lds + 2 * SHM_K8 + 2 * SHM_V2) + wid * 64;
  float l_reg = 0; f32x16 o[8] = {};
  const int vb0 = (int)(uintptr_t)V_lds + v_rd_base(lane);
  const int kvo = k8_dma_voff(wid, lane, ldk8);
  const int vvo = unswap23(8 * (wid >> 2) + ((lane & 31) >> 2)) * ldk * 2 + ((2 * (wid & 3) + (lane >> 5)) * 32 + (lane & 3) * 8) * 2;
  const int l16 = 32 * ldk, pz = wid * 1024;
  const __amdgpu_buffer_rsrc_t krs = __builtin_amdgcn_make_buffer_rsrc((void*)K8, 0, 0x7ffffff0, 0x00020000);
  const __amdgpu_buffer_rsrc_t vrs = __builtin_amdgcn_make_buffer_rsrc((void*)Vh, 0, 0x7ffffff0, 0x00020000);
#define VM0() asm volatile("s_waitcnt vmcnt(0)" ::: "memory")
#define KVDMA(b, k0) do { const int _o = (k0) * ldk * 2; LAS char* _v = V_lds + (b) * SHM_V2 + pz; \
    DMA16(krs, K_lds + (b) * SHM_K8 + pz, kvo, (k0) * ldk8); DMA16(vrs, _v, vvo, _o); DMA16(vrs, _v + 8192, vvo, _o + l16); \
    DMA16(vrs, _v + 16384, vvo, _o + 2 * l16); DMA16(vrs, _v + 24576, vvo, _o + 3 * l16); } while (0)
  const int ka0 = (int)(uintptr_t)K_lds + r32 * 128 + (((2 * hi) ^ ((r32 >> 1) & 7)) << 4);
  const int ka1 = ka0 ^ 16, ka2 = ka0 ^ 64, ka3 = ka0 ^ 80;
  int sc1; asm volatile("v_mov_b32 %0, 0x7f7f7f7f" : "=v"(sc1));
  f32x16 P; bf16x8 pa0, pa1; v4i k0a, k0b, k1a, k1b; VSet va, vb_, vc;
  const int NT = seq / KVBLK;
#define KOFF(b, h) ((b) * 8192 + (h) * 4096)
#define VOFF(b, h, d0) ((b) * 32768 + (h) * 16384 + (d0) * 512)
#define KPRO(b, h) do { k0a = k8_read<KOFF(b, h)>(ka0); k0b = k8_read<KOFF(b, h)>(ka1); k1a = k8_read<KOFF(b, h)>(ka2); k1b = k8_read<KOFF(b, h)>(ka3); } while (0)
#define V8(x, y) (v8i_){x[0], x[1], x[2], x[3], y[0], y[1], y[2], y[3]}
#define QKHALF(b, h) do { \
    if (SHIFT) { _Pragma("unroll") for (int r = 0; r < 16; ++r) { float _z; asm volatile("v_mov_b32 %0, %1" : "=v"(_z) : "v"(nmc)); P[r] = _z; } } \
    LGK(2); SCHED; { const v8i_ kf = V8(k0a, k0b); \
      if (SHIFT) asm volatile("s_nop 4\n\tv_mfma_scale_f32_32x32x64_f8f6f4 %0, %1, %2, %0, %3, %3 op_sel_hi:[0,0,0]" : "+v"(P) : "v"(kf), "v"(qf[0]), "v"(sc1)); \
      else       asm volatile("v_mfma_scale_f32_32x32x64_f8f6f4 %0, %1, %2, 0, %3, %3 op_sel_hi:[0,0,0]" : "=&v"(P) : "v"(kf), "v"(qf[0]), "v"(sc1)); } \
    SCHED; v_read<VOFF(b, h, 0)>(va, vb0); \
    LGK(4); SCHED; { const v8i_ kf = V8(k1a, k1b); \
      asm volatile("v_mfma_scale_f32_32x32x64_f8f6f4 %0, %1, %2, %0, %3, %3 op_sel_hi:[0,0,0]" : "+v"(P) : "v"(kf), "v"(qf[1]), "v"(sc1)); } \
    SCHED; v_read<VOFF(b, h, 1)>(vb_, vb0); \
    asm volatile("s_nop 15\n\ts_nop 7" : "+v"(P)); } while (0)
#define SMH() do { exp16(P); l_reg += sum16(P); PK4(P, 0, pa0); PK4(P, 8, pa1); } while (0)
#define PVM(S, d0) do { SCHED; pv2(o[d0], S, pa0, pa1); SCHED; } while (0)
#define PVHALF(b, h, NEXTK, nb, nh) do { \
    LGK(4); PVM(va, 0); v_read<VOFF(b, h, 2)>(vc, vb0); \
    LGK(4); PVM(vb_, 1); v_read<VOFF(b, h, 3)>(va, vb0); \
    LGK(4); PVM(vc, 2); v_read<VOFF(b, h, 4)>(vb_, vb0); \
    LGK(4); PVM(va, 3); v_read<VOFF(b, h, 5)>(vc, vb0); \
    LGK(4); PVM(vb_, 4); v_read<VOFF(b, h, 6)>(va, vb0); \
    LGK(4); PVM(vc, 5); v_read<VOFF(b, h, 7)>(vb_, vb0); \
    LGK(4); PVM(va, 6); if (NEXTK) { k0a = k8_read<KOFF(nb, nh)>(ka0); k0b = k8_read<KOFF(nb, nh)>(ka1); } \
    if (NEXTK) { LGK(2); } else { LGK(0); } PVM(vb_, 7); if (NEXTK) { k1a = k8_read<KOFF(nb, nh)>(ka2); k1b = k8_read<KOFF(nb, nh)>(ka3); } } while (0)
#define STEPC(b, j) do { if ((j) + 1 < NT) KVDMA((b) ^ 1, ((j) + 1) * KVBLK); \
    KPRO(b, 0); QKHALF(b, 0); SMH(); PVHALF(b, 0, true, b, 1); \
    QKHALF(b, 1); SMH(); PVHALF(b, 1, false, 0, 0); \
    VM0(); __syncthreads(); } while (0)
  KVDMA(0, 0); VM0(); __syncthreads();
  for (int j = 0; j < NT; j += 2) { STEPC(0, j); STEPC(1, j + 1); }
  { auto rr = __builtin_amdgcn_permlane32_swap(__float_as_uint(l_reg), __float_as_uint(l_reg), false, false); l_reg = __uint_as_float(rr[0]) + __uint_as_float(rr[1]); }
  if (hi == 0) li_l[r32] = l_reg; asm volatile("s_waitcnt lgkmcnt(0)" ::: "memory");
  bf16_t* Ow = Ob + (long)(wid * QBLK) * ldo;
#pragma unroll
  for (int r = 0; r < 16; ++r) { const int orow = crow(r, hi); const float rl = __builtin_amdgcn_rcpf(li_l[orow]);
#pragma unroll
    for (int d0 = 0; d0 < 8; ++d0) Ow[(long)orow * ldo + d0 * 32 + r32] = f2bf(o[d0][r] * rl); }
  VM0();
  __syncthreads();
#undef KVDMA
#undef KOFF
#undef VOFF
#undef KPRO
#undef V8
#undef QKHALF
#undef SMH
#undef PVM
#undef PVHALF
#undef STEPC
#undef VM0
}
__device__ __forceinline__ void attn_body_c256q8(const bf16_t* __restrict__ Qb, const int ldq, const unsigned char* __restrict__ K8, const int ldk8,
                                                 const bf16_t* __restrict__ Vh, const int ldk, bf16_t* __restrict__ Ob, const int ldo, const int seq, const float kmax2, LAS char* lds) {
  int tid = threadIdx.x; asm volatile("" : "+v"(tid)); tid &= 511;
  const int wid = tid >> 6, lane = tid & 63, r32 = lane & 31, hi = lane >> 5;
  v8i_ qf[2];
  const float nmc = load_q8(Qb + (long)(wid * QBLK + r32) * ldq, hi, qf, kmax2);
  if (__all(nmc > -64.f)) attn_body_c256q8_t<false>(K8, ldk8, Vh, ldk, Ob, ldo, seq, 0.f, qf, lds);
  else attn_body_c256q8_t<true>(K8, ldk8, Vh, ldk, Ob, ldo, seq, nmc, qf, lds);
}

template <bool SHIFT>
__device__ __forceinline__ void attn_body_q8_t(const unsigned char* __restrict__ K8, const int ldk8, const bf16_t* __restrict__ Vh, const int ldk,
                                               bf16_t* __restrict__ Ob, const int ldo, const int seq, const float nmc, const v8i_ (&qf)[2], LAS char* lds) {
  int tid = threadIdx.x; asm volatile("" : "+v"(tid)); tid &= 511;
  const int wid = __builtin_amdgcn_readfirstlane(tid >> 6), lane = tid & 63, r32 = lane & 31, hi = lane >> 5;
  constexpr int SK8 = KVBLK * 128, ST = SK8 + SHM_V;
  LAS float* li_l = (LAS float*)(lds + 3 * ST) + wid * 64;
  float l_reg = 0; f32x16 o[4] = {};
  const int vrb = v_rd_base(lane);
  const int kvo = k8_dma_voff(wid, lane, ldk8);
  const int vvo = unswap23(8 * (wid >> 1) + ((lane & 31) >> 2)) * ldk * 2 + ((2 * (wid & 1) + (lane >> 5)) * 32 + (lane & 3) * 8) * 2;
  const int l32 = 64 * ldk, pz = wid * 1024;
  const __amdgpu_buffer_rsrc_t krs = __builtin_amdgcn_make_buffer_rsrc((void*)K8, 0, 0x7ffffff0, 0x00020000);
  const __amdgpu_buffer_rsrc_t vrs = __builtin_amdgcn_make_buffer_rsrc((void*)Vh, 0, 0x7ffffff0, 0x00020000);
#define TDMA(slot, k0) do { const int _o = (k0) * ldk * 2; LAS char* _b = lds + (slot) * ST + pz; \
    DMA16(krs, _b, kvo, (k0) * ldk8); DMA16(vrs, _b + SK8, vvo, _o); DMA16(vrs, _b + SK8 + 8192, vvo, _o + l32); } while (0)
#define VM0() asm volatile("s_waitcnt vmcnt(0)" ::: "memory")
  int sc1; asm volatile("v_mov_b32 %0, 0x7f7f7f7f" : "=v"(sc1));
  const int kof = r32 * 128 + (((2 * hi) ^ ((r32 >> 1) & 7)) << 4);
#define QKT8(P0, P1, Ks) do { \
    const v4i a0 = *(LAS const v4i*)((Ks) + kof), a1 = *(LAS const v4i*)((Ks) + (kof ^ 16)), a2 = *(LAS const v4i*)((Ks) + (kof ^ 64)), a3 = *(LAS const v4i*)((Ks) + (kof ^ 80)); \
    const v4i b0 = *(LAS const v4i*)((Ks) + 4096 + kof), b1 = *(LAS const v4i*)((Ks) + 4096 + (kof ^ 16)), b2 = *(LAS const v4i*)((Ks) + 4096 + (kof ^ 64)), b3 = *(LAS const v4i*)((Ks) + 4096 + (kof ^ 80)); \
    v8i_ k00 = (v8i_){a0[0], a0[1], a0[2], a0[3], a1[0], a1[1], a1[2], a1[3]}, k01 = (v8i_){a2[0], a2[1], a2[2], a2[3], a3[0], a3[1], a3[2], a3[3]}; \
    v8i_ k10 = (v8i_){b0[0], b0[1], b0[2], b0[3], b1[0], b1[1], b1[2], b1[3]}, k11 = (v8i_){b2[0], b2[1], b2[2], b2[3], b3[0], b3[1], b3[2], b3[3]}; \
    if (SHIFT) { _Pragma("unroll") for (int r = 0; r < 16; ++r) { P0[r] = nmc; P1[r] = nmc; } \
      asm volatile("s_nop 4\n\tv_mfma_scale_f32_32x32x64_f8f6f4 %0, %1, %2, %0, %3, %3 op_sel_hi:[0,0,0]" : "+v"(P0) : "v"(k00), "v"(qf[0]), "v"(sc1)); \
      asm volatile("v_mfma_scale_f32_32x32x64_f8f6f4 %0, %1, %2, %0, %3, %3 op_sel_hi:[0,0,0]" : "+v"(P1) : "v"(k10), "v"(qf[0]), "v"(sc1)); } \
    else { asm volatile("v_mfma_scale_f32_32x32x64_f8f6f4 %0, %1, %2, 0, %3, %3 op_sel_hi:[0,0,0]" : "=&v"(P0) : "v"(k00), "v"(qf[0]), "v"(sc1)); \
      asm volatile("v_mfma_scale_f32_32x32x64_f8f6f4 %0, %1, %2, 0, %3, %3 op_sel_hi:[0,0,0]" : "=&v"(P1) : "v"(k10), "v"(qf[0]), "v"(sc1)); } \
    asm volatile("v_mfma_scale_f32_32x32x64_f8f6f4 %0, %1, %2, %0, %3, %3 op_sel_hi:[0,0,0]" : "+v"(P0) : "v"(k01), "v"(qf[1]), "v"(sc1)); \
    asm volatile("v_mfma_scale_f32_32x32x64_f8f6f4 %0, %1, %2, %0, %3, %3 op_sel_hi:[0,0,0]" : "+v"(P1) : "v"(k11), "v"(qf[1]), "v"(sc1)); \
      \
    asm volatile("s_nop 15" : "+v"(k00), "+v"(k01), "+v"(k10), "+v"(k11)); } while (0)
#define TIE(P0, P1) asm volatile("s_nop 15\n\ts_nop 7" : "+v"(P0), "+v"(P1))
#define TIE0(P0, P1) asm volatile("" : "+v"(P0), "+v"(P1))
#define FINISH(P0, P1) do { exp16(P1); l_reg += sum16(P0) + sum16(P1); PK4(P0, 0, pa0); PK4(P0, 8, pa1); PK4(P1, 0, pa2); PK4(P1, 8, pa3); } while (0)
  f32x16 pA0, pA1, pB0, pB1; bf16x8 pa0, pa1, pa2, pa3; const int NT = seq / KVBLK;
  TDMA(0, 0); VM0(); __syncthreads();
  TDMA(1, KVBLK);
  QKT8(pA0, pA1, lds); TIE(pA0, pA1); exp16(pA0);
  VM0(); __syncthreads();
  int sk = 1, sv = 0, sd = 2;
  for (int j = 1; j + 1 < NT; j += 2) {
    TDMA(sd, (j + 1) * KVBLK);
    SCHED; QKT8(pB0, pB1, lds + sk * ST);
    FINISH(pA0, pA1); SCHED;
    pv_d0(o, (int)(uintptr_t)(lds + sv * ST + SK8) + vrb, pa0, pa1, pa2, pa3); TIE0(pB0, pB1); exp16(pB0);
    VM0(); __syncthreads();
    { const int t = sv; sv = sk; sk = sd; sd = t; }
    if (j + 2 < NT) TDMA(sd, (j + 2) * KVBLK);
    SCHED; QKT8(pA0, pA1, lds + sk * ST);
    FINISH(pB0, pB1); SCHED;
    pv_d0(o, (int)(uintptr_t)(lds + sv * ST + SK8) + vrb, pa0, pa1, pa2, pa3); TIE0(pA0, pA1); exp16(pA0);
    VM0(); __syncthreads();
    { const int t = sv; sv = sk; sk = sd; sd = t; }
  }
  SCHED; QKT8(pB0, pB1, lds + sk * ST);
  FINISH(pA0, pA1); SCHED;
  pv_d0(o, (int)(uintptr_t)(lds + sv * ST + SK8) + vrb, pa0, pa1, pa2, pa3); TIE0(pB0, pB1); exp16(pB0);
  FINISH(pB0, pB1); SCHED;
  pv_d0(o, (int)(uintptr_t)(lds + sk * ST + SK8) + vrb, pa0, pa1, pa2, pa3);
  { auto rr = __builtin_amdgcn_permlane32_swap(__float_as_uint(l_reg), __float_as_uint(l_reg), false, false); l_reg = __uint_as_float(rr[0]) + __uint_as_float(rr[1]); }
#if DENSE8_G2
  store_o8(o, l_reg, li_l, (unsigned char*)Ob + (long)(wid * QBLK) * ldo, ldo, r32, hi);
#else
  store_o(o, l_reg, li_l, Ob + (long)(wid * QBLK) * ldo, ldo, r32, hi);
#endif
  VM0();
  __syncthreads();
#undef TDMA
#undef VM0
#undef QKT8
#undef TIE
#undef TIE0
#undef FINISH
}
__device__ __forceinline__ void attn_body_q8(const bf16_t* __restrict__ Qb, const int ldq, const unsigned char* __restrict__ K8, const int ldk8,
                                             const bf16_t* __restrict__ Vh, const int ldk, bf16_t* __restrict__ Ob, const int ldo, const int seq, const float kmax2, LAS char* lds) {
  int tid = threadIdx.x; asm volatile("" : "+v"(tid)); tid &= 511;
  const int wid = tid >> 6, lane = tid & 63, r32 = lane & 31, hi = lane >> 5;
  v8i_ qf[2];
  const float nmc = load_q8(Qb + (long)(wid * QBLK + r32) * ldq, hi, qf, kmax2);
  if (__all(nmc > -64.f)) attn_body_q8_t<false>(K8, ldk8, Vh, ldk, Ob, ldo, seq, 0.f, qf, lds);
  else attn_body_q8_t<true>(K8, ldk8, Vh, ldk, Ob, ldo, seq, nmc, qf, lds);
}
#undef PK4
}

__device__ __forceinline__ int perm_plain8(int n) { const int r = n & 31; return (n & ~31) + 16 * ((r >> 2) & 1) + 4 * (r >> 3) + (r & 3); }
__device__ __forceinline__ int perm_row(int kind, int n) {
  if (kind == 0) return perm_plain8(n);
  if (kind == 1) { if (n < N_QKV0) return perm_plain8(n); const int c = n - N_QKV0; const int ch = c & 1023; return N_QKV0 + 32 * (ch >> 4) + ((c >> 10) << 4) + (ch & 15); }
  return 32 * (n >> 4) + ((kind == 3) ? 16 : 0) + (n & 15);
}
__device__ __forceinline__ void cvt_tile(const float* __restrict__ src, int N, bf16_t* __restrict__ dst, int K, int kind, int k0, int n0, LAS unsigned* t32) {
  int tid = threadIdx.x; asm volatile("" : "+v"(tid)); tid &= 511;
#pragma unroll
  for (int j = 0; j < 2; ++j) {
    const int item = tid + 512 * j, kp = item >> 4, q = item & 15;
    const f32x4 v0 = *(const f32x4*)(src + (size_t)(k0 + 2 * kp) * N + n0 + 4 * q);
    const f32x4 v1 = *(const f32x4*)(src + (size_t)(k0 + 2 * kp + 1) * N + n0 + 4 * q);
#pragma unroll
    for (int i = 0; i < 4; ++i) t32[(4 * q + i) * 65 + kp] = cvtpk(v0[i], v1[i]);
  }
  __syncthreads();
#pragma unroll
  for (int j = 0; j < 2; ++j) {
    const int item = tid + 512 * j, n = item >> 4, ko = item & 15;
    u32x4 v;
#pragma unroll
    for (int i = 0; i < 4; ++i) v[i] = t32[n * 65 + 4 * ko + i];
    *(u32x4*)(dst + (size_t)perm_row(kind, n0 + n) * K + k0 + 8 * ko) = v;
  }
  __syncthreads();
}
__device__ __forceinline__ void cvt_matrix_units(const float* src, int K, int N, bf16_t* dst, int kind, int u0, int ustride, LAS unsigned* t32) {
  const int nN = N / 64, nK = K / 128;
  for (int u = u0; u < nN * nK; u += ustride) cvt_tile(src, N, dst, K, kind, (u / nN) * 128, (u % nN) * 64, t32);
}
constexpr size_t WMOE8_E = (size_t)1024 * D + (size_t)D * EFF;
__device__ __forceinline__ void cvt_tile8(const float* __restrict__ src, int N, unsigned char* __restrict__ dst, int K, int kind, int k0, int n0, float scale, LAS unsigned* t32) {
  int tid = threadIdx.x; asm volatile("" : "+v"(tid)); tid &= 511;
  { const int kq = tid >> 4, q = tid & 15;
    f32x4 v[4];
#pragma unroll
    for (int r = 0; r < 4; ++r) v[r] = *(const f32x4*)(src + (size_t)(k0 + 4 * kq + r) * N + n0 + 4 * q);
#pragma unroll
    for (int i = 0; i < 4; ++i) t32[(4 * q + i) * 33 + kq] = pack_fp8x4(v[0][i] * scale, v[1][i] * scale, v[2][i] * scale, v[3][i] * scale); }
  __syncthreads();
  { const int n = tid >> 3, kc = tid & 7;
    u32x4 v;
#pragma unroll
    for (int i = 0; i < 4; ++i) v[i] = t32[n * 33 + 4 * kc + i];
    *(u32x4*)(dst + (size_t)perm_row(kind, n0 + n) * K + k0 + 16 * kc) = v; }
  __syncthreads();
}
__device__ __forceinline__ void cvt_matrix_units8(const float* src, int K, int N, unsigned char* dst, int kind, float scale, LAS unsigned* t32) {
  const int nN = N / 64, nK = K / 128;
  for (int u = blockIdx.x; u < nN * nK; u += gridDim.x) cvt_tile8(src, N, dst, K, kind, (u / nN) * 128, (u % nN) * 64, scale, t32);
}
__device__ __forceinline__ void cvt_moe_all8(const Args& a, LAS unsigned* t32) {
  unsigned char* W = (unsigned char*)(a.ws + WS_WMOE);
  for (int u = blockIdx.x; u < 2 * 65 * 384; u += gridDim.x) {
    const int le = u / 384, L = le / 65, e = le % 65, r = u % 384, mtx = r >> 7, lu = r & 127;
    const float* src; unsigned char* dst = W + (size_t)le * WMOE8_E; int K, N, kind; float sc;
    if (mtx == 0)      { src = e < 64 ? a.in[21] + ((size_t)L * 64 + e) * D * EFF : a.in[24] + (size_t)L * D * EFF; K = D; N = EFF; kind = 2; sc = 256.f; }
    else if (mtx == 1) { src = e < 64 ? a.in[22] + ((size_t)L * 64 + e) * D * EFF : a.in[25] + (size_t)L * D * EFF; K = D; N = EFF; kind = 3; sc = 256.f; }
    else               { src = e < 64 ? a.in[23] + ((size_t)L * 64 + e) * EFF * D : a.in[26] + (size_t)L * EFF * D; K = EFF; N = D; kind = 0; sc = 128.f; dst += (size_t)1024 * D; }
    const int nN = N / 64;
    cvt_tile8(src, N, dst, K, kind, (lu / nN) * 128, (lu % nN) * 64, sc, t32);
  }
}

__device__ __forceinline__ void ld_row_f32(const float* __restrict__ p, int lane, float (&v)[32]) {
#pragma unroll
  for (int j = 0; j < 4; ++j) { const f32x4 t0 = *(const f32x4*)(p + 8 * lane + 512 * j), t1 = *(const f32x4*)(p + 8 * lane + 512 * j + 4);
#pragma unroll
    for (int i = 0; i < 4; ++i) { v[8 * j + i] = t0[i]; v[8 * j + 4 + i] = t1[i]; } }
}
__device__ __forceinline__ void ld_row_bf16(const bf16_t* __restrict__ p, int lane, float (&v)[32]) {
#pragma unroll
  for (int j = 0; j < 4; ++j) { const u32x4 t = *(const u32x4*)(p + 8 * lane + 512 * j);
#pragma unroll
    for (int i = 0; i < 4; ++i) { v[8 * j + 2 * i] = bflo(t[i]); v[8 * j + 2 * i + 1] = bfhi(t[i]); } }
}
__device__ __forceinline__ void ld_row_fp8(const unsigned char* __restrict__ p, int lane, float (&v)[32]) {
#pragma unroll
  for (int j = 0; j < 4; ++j) { const u32x2 t = *(const u32x2*)(p + 8 * lane + 512 * j);
#pragma unroll
    for (int i = 0; i < 2; ++i) { v[8 * j + 4 * i] = __builtin_amdgcn_cvt_f32_fp8((int)t[i], 0); v[8 * j + 4 * i + 1] = __builtin_amdgcn_cvt_f32_fp8((int)t[i], 1);
      v[8 * j + 4 * i + 2] = __builtin_amdgcn_cvt_f32_fp8((int)t[i], 2); v[8 * j + 4 * i + 3] = __builtin_amdgcn_cvt_f32_fp8((int)t[i], 3); } }
}
__device__ __forceinline__ void ld8f(const float* __restrict__ p, float (&x)[8]) { const f32x4 t0 = *(const f32x4*)p, t1 = *(const f32x4*)(p + 4);
#pragma unroll
  for (int i = 0; i < 4; ++i) { x[i] = t0[i]; x[4 + i] = t1[i]; } }
__device__ __forceinline__ void st8f(float* __restrict__ p, const float* x) { f32x4 t0 = {x[0], x[1], x[2], x[3]}, t1 = {x[4], x[5], x[6], x[7]}; *(f32x4*)p = t0; *(f32x4*)(p + 4) = t1; }
__device__ __forceinline__ float sumsq32(const float (&v)[32]) { float s = 0;
#pragma unroll
  for (int i = 0; i < 32; ++i) s += v[i] * v[i];
  return wave_sum(s); }
template <bool COPY, bool OUT8 = false>
__device__ __forceinline__ void modulate_store(const float (&v)[32], float rstd, const float* __restrict__ g, const float* __restrict__ shift, const float* __restrict__ scale,
                                               bf16_t* __restrict__ dst, int lane, LAS float* f32copy) {
#pragma unroll
  for (int j = 0; j < 4; ++j) {
    const int idx = 8 * lane + 512 * j;
    float gv[8], sh[8], sc[8], y[8]; ld8f(g + idx, gv); ld8f(shift + idx, sh); ld8f(scale + idx, sc);
#pragma unroll
    for (int i = 0; i < 8; ++i) y[i] = v[8 * j + i] * rstd * gv[i] * (1.f + sc[i]) + sh[i];
    if (OUT8) { u32x2 p8 = {pack_fp8x4(y[0], y[1], y[2], y[3]), pack_fp8x4(y[4], y[5], y[6], y[7])}; *(u32x2*)((unsigned char*)dst + idx) = p8; }
    else { u32x4 pk = {cvtpk(y[0], y[1]), cvtpk(y[2], y[3]), cvtpk(y[4], y[5]), cvtpk(y[6], y[7])}; *(u32x4*)(dst + idx) = pk; }
    if (COPY) { f32x4 t0 = {y[0], y[1], y[2], y[3]}, t1 = {y[4], y[5], y[6], y[7]};
      *(LAS f32x4*)(f32copy + idx) = t0; *(LAS f32x4*)(f32copy + idx + 4) = t1; }
  }
}

__device__ __forceinline__ void phase_prologue(const Args& a, LAS char* lds) {
  int tid = threadIdx.x; asm volatile("" : "+v"(tid)); tid &= 511; const int wave = tid >> 6, lane = tid & 63;
  {
    LAS float* sc = (LAS float*)lds;
    LAS float* part = sc + 4096;
    const float* c = a.in[1]; const float* cc = a.in[3];
    for (int i = tid; i < D; i += NTHREADS) { float v = c[i]; sc[i] = v * sigmoidf_(v); float u = cc[i]; sc[D + i] = u * sigmoidf_(u); }
    __syncthreads();
    float* MOD = (float*)(a.ws + WS_MOD);
    for (int u = blockIdx.x; u < 2 * 192; u += gridDim.x) {
      const int L = u / 192, chunk = u % 192;
      const float* W = a.in[4] + (size_t)L * D * 12288 + chunk * 64 + lane;
      float a0 = 0, a1 = 0; const int d0 = wave * 256;
#pragma unroll 8
      for (int dd = 0; dd < 256; ++dd) { const float w = W[(size_t)(d0 + dd) * 12288]; a0 += sc[d0 + dd] * w; a1 += sc[D + d0 + dd] * w; }
      part[(wave * 2 + 0) * 64 + lane] = a0; part[(wave * 2 + 1) * 64 + lane] = a1;
      __syncthreads();
      if (tid < 128) { const int which = tid >> 6; float s = 0;
#pragma unroll
        for (int w = 0; w < 8; ++w) s += part[(w * 2 + which) * 64 + lane];
        const int j = chunk * 64 + lane; MOD[(size_t)(L * 2 + which) * 12288 + j] = s + a.in[5][L * 12288 + j]; }
      __syncthreads();
    }
  }
  LAS unsigned* t32 = (LAS unsigned*)lds;
  cvt_matrix_units8(a.in[7], D, N_IN0, (unsigned char*)(a.ws + WS_WIN0), 1, 256.f, t32);
#if DENSE8_G2
  cvt_matrix_units8(a.in[8], D, D, (unsigned char*)(a.ws + WS_WOUT0), 0, 256.f, t32);
  cvt_matrix_units8(a.in[16], D, D, (unsigned char*)(a.ws + WS_WOUT1), 0, 256.f, t32);
#else
  cvt_matrix_units(a.in[8], D, D, (bf16_t*)(a.ws + WS_WOUT0), 0, blockIdx.x, gridDim.x, t32);
  cvt_matrix_units(a.in[16], D, D, (bf16_t*)(a.ws + WS_WOUT1), 0, blockIdx.x, gridDim.x, t32);
#endif
  cvt_matrix_units8(a.in[15], D, N_IN1, (unsigned char*)(a.ws + WS_WIN1), 0, 256.f, t32);
  cvt_moe_all8(a, t32);
}

__device__ __forceinline__ void phase_modulate0(const Args& a) {
  int tid = threadIdx.x; asm volatile("" : "+v"(tid)); tid &= 511; const int wave = tid >> 6, lane = tid & 63;
  const float* MOD = (const float*)(a.ws + WS_MOD);
  bf16_t* A = (bf16_t*)(a.ws + WS_ABUF);
  for (int it = blockIdx.x; it < MT / 8; it += gridDim.x) {
    const int r = it * 8 + wave;
    const float* src = r < CTXL ? a.in[2] + (size_t)r * D : a.in[0] + (size_t)(r - CTXL) * D;
    const float* mod = MOD + (r < CTXL ? 12288 : 0);
    float v[32]; ld_row_f32(src, lane, v);
    const float rstd = rsqrtf(sumsq32(v) * (1.f / D) + EPS);
    modulate_store<false, true>(v, rstd, a.in[6], mod, mod + D, (bf16_t*)((unsigned char*)A + (size_t)r * D), lane, nullptr);
  }
}

__device__ __forceinline__ void rope_cs4(int r, int lane, float (&cs)[4], float (&sn)[4]) {
#pragma unroll
  for (int q = 0; q < 4; ++q) { cs[q] = 1.f; sn[q] = 0.f; }
  if (r >= CTXL) { const int t = r - CTXL; const int l = lane & 15, a = l >> 3, i0 = 4 * (l & 7);
    const float pos = a ? (float)(t & 63) : (float)(t >> 6);
#pragma unroll
    for (int q = 0; q < 4; ++q) { const float inv = powf(10000.f, -(float)(i0 + q) / 32.f); sincosf(pos * inv, &sn[q], &cs[q]); } }
}
__device__ __forceinline__ float sum16lanes(float v) { v += __shfl_xor(v, 1); v += __shfl_xor(v, 2); v += __shfl_xor(v, 4); v += __shfl_xor(v, 8); return v; }
__device__ __forceinline__ void phase_rope_conv0(const Args& a, LAS char* lds, bool dry = false) {
  int tid = threadIdx.x; asm volatile("" : "+v"(tid)); tid &= 511; const int wave = tid >> 6, lane = tid & 63;
  bf16_t* Q = (bf16_t*)(a.ws + WS_QKVU);
  {
    const bf16_t* HG = (const bf16_t*)(a.ws + WS_HG);
    bf16_t* X2 = (bf16_t*)(a.ws + WS_X2);
    LAS char* lt = lds;
    LAS float* part = (LAS float*)(lds + 62 * 2048);
    LAS float* stats = part + 512;
    const float* dw_w = a.in[11]; const float* dw_b = a.in[12]; const float* ln_g = a.in[13]; const float* ln_b = a.in[14];
    const __amdgpu_buffer_rsrc_t wrs = __builtin_amdgcn_make_buffer_rsrc((void*)dw_w, 0, 31 * 1024 * 4, 0x00020000);
    for (int u = blockIdx.x; u < 520; u += gridDim.x) {
      int seg0, seg1, r0;
      if (u < 8) { seg0 = 0; seg1 = CTXL; r0 = u * 32; } else { seg0 = CTXL; seg1 = MT; r0 = CTXL + (u - 8) * 32; }
      for (int c = tid; c < 62 * 128; c += NTHREADS) { const int rr = c >> 7, cc = c & 127, gr = r0 - 15 + rr;
        u32x4 v = {0u, 0u, 0u, 0u}; if (gr >= seg0 && gr < seg1) v = *(const u32x4*)(HG + (size_t)gr * 1024 + cc * 8);
        *(LAS u32x4*)(lt + rr * 2048 + cc * 16) = v; }
      __syncthreads();
      float w0[31], w1[31];
#pragma unroll
      for (int j = 0; j < 31; ++j) { const u32x2 w = __builtin_amdgcn_raw_buffer_load_b64(wrs, tid * 8, j * 4096, 0); w0[j] = __uint_as_float(w[0]); w1[j] = __uint_as_float(w[1]); }
      const f32x2 bb = *(const f32x2*)(dw_b + 2 * tid);
      const f32x2 gg = *(const f32x2*)(ln_g + 2 * tid), gb = *(const f32x2*)(ln_b + 2 * tid);
#pragma unroll 1
      for (int hf = 0; hf < 4; ++hf) {
        float o0[8], o1[8];
        LAS const char* lth = lt + (hf * 8) * 2048 + tid * 4;
#pragma unroll
        for (int r = 0; r < 8; ++r) { o0[r] = bb[0]; o1[r] = bb[1]; }
#pragma unroll
        for (int i = 0; i < 38; ++i) {
          const unsigned p = *(LAS const unsigned*)(lth + i * 2048);
          const float x0 = bflo(p), x1 = bfhi(p);
#pragma unroll
          for (int r = 0; r < 8; ++r) { const int j = i - r; if (j >= 0 && j < 31) { o0[r] += x0 * w0[j]; o1[r] += x1 * w1[j]; } }
        }
#pragma unroll
        for (int r = 0; r < 8; ++r) {
          const float s = wave_sum(o0[r] + o1[r]), q = wave_sum(o0[r] * o0[r] + o1[r] * o1[r]);
          if (lane == 0) { part[(r * 8 + wave) * 2] = s; part[(r * 8 + wave) * 2 + 1] = q; }
        }
        __syncthreads();
        if (tid < 8) { float s = 0, q = 0;
#pragma unroll
          for (int w = 0; w < 8; ++w) { s += part[(tid * 8 + w) * 2]; q += part[(tid * 8 + w) * 2 + 1]; }
          const float mean = s * (1.f / 1024), var = q * (1.f / 1024) - mean * mean;
          stats[tid * 2] = mean; stats[tid * 2 + 1] = rsqrtf(fmaxf(var, 0.f) + EPS); }
        __syncthreads();
#pragma unroll
        for (int r = 0; r < 8; ++r) {
          const float mean = stats[r * 2], rstd = stats[r * 2 + 1];
          float y0 = (o0[r] - mean) * rstd * gg[0] + gb[0], y1 = (o1[r] - mean) * rstd * gg[1] + gb[1];
          y0 = y0 * sigmoid_fast(y0); y1 = y1 * sigmoid_fast(y1);
#if DENSE8_G2
          *(unsigned short*)((unsigned char*)X2 + (size_t)(r0 + hf * 8 + r) * D + 1024 + 2 * tid) = (unsigned short)__builtin_amdgcn_cvt_pk_fp8_f32(y0 * 8.f, y1 * 8.f, 0, false);
#else
          *(unsigned*)(X2 + (size_t)(r0 + hf * 8 + r) * D + 1024 + 2 * tid) = cvtpk(y0, y1);
#endif
        }
      }
      __syncthreads();
    }
  }
  const float* qn = a.in[9]; const float* kn = a.in[10];
  unsigned* kmx = (unsigned*)(a.ws + WS_CTL + CTL_KMAX);
  const int slot = lane >> 4, l16 = lane & 15, e1 = (l16 >> 3) * 64 + 4 * (l16 & 7), e2 = e1 + 32;
  float km0 = 0.f, km1 = 0.f;
  for (int it = blockIdx.x; it < MT / 8; it += gridDim.x) {
    const int r = it * 8 + wave;
    float cs[4], sn[4]; rope_cs4(r, lane, cs, sn);
    bf16_t* rowp = Q + (size_t)r * N_QKV0;
#pragma unroll
    for (int hb = 0; hb < 12; hb += 4) {
      const int hh = hb + slot;
      if (hh < 10) {
        const float* g = hh < 8 ? qn : kn;
        const u32x2 a1 = *(const u32x2*)(rowp + hh * 128 + e1), a2 = *(const u32x2*)(rowp + hh * 128 + e2);
        float x1[4] = {bflo(a1[0]), bfhi(a1[0]), bflo(a1[1]), bfhi(a1[1])}, x2[4] = {bflo(a2[0]), bfhi(a2[0]), bflo(a2[1]), bfhi(a2[1])};
        float ss = 0;
#pragma unroll
        for (int q = 0; q < 4; ++q) ss += x1[q] * x1[q] + x2[q] * x2[q];
        ss = sum16lanes(ss);
        const float rstd = rsqrtf(ss * (1.f / 128) + EPS);
        const f32x4 g1 = *(const f32x4*)(g + e1), g2 = *(const f32x4*)(g + e2);
        float o1[4], o2[4], so = 0;
#pragma unroll
        for (int q = 0; q < 4; ++q) { const float y1 = x1[q] * rstd * g1[q], y2 = x2[q] * rstd * g2[q]; o1[q] = y1 * cs[q] - y2 * sn[q]; o2[q] = y2 * cs[q] + y1 * sn[q]; }
        const u32x2 w1 = {cvtpk(o1[0], o1[1]), cvtpk(o1[2], o1[3])}, w2 = {cvtpk(o2[0], o2[1]), cvtpk(o2[2], o2[3])};
        if (!dry) { *(u32x2*)(rowp + hh * 128 + e1) = w1; *(u32x2*)(rowp + hh * 128 + e2) = w2; }
        if (hb == 8) {
          const unsigned q1 = pack8x4(o1[0], o1[1], o1[2], o1[3]), q2 = pack8x4(o2[0], o2[1], o2[2], o2[3]);
          unsigned char* k8p = (unsigned char*)(a.ws + WS_K8) + (size_t)r * 256 + (hh - 8) * 128;
          *(unsigned*)(k8p + e1) = q1; *(unsigned*)(k8p + e2) = q2;
          so = sum16lanes(sq8x4(q1) + sq8x4(q2)); if (slot == 0) km0 = fmaxf(km0, so); else km1 = fmaxf(km1, so);
        }
      }
    }
  }
  if (l16 == 0 && slot < 2) atomicMax(&kmx[slot], __float_as_uint(slot == 0 ? km0 : km1));
}
__device__ __forceinline__ void phase_rope1(const Args& a, LAS char* lds, bool dry = false) {
  int tid = threadIdx.x; asm volatile("" : "+v"(tid)); tid &= 511; const int wave = tid >> 6, lane = tid & 63;
  bf16_t* Q = (bf16_t*)(a.ws + WS_QKVU);
  unsigned* kmx = (unsigned*)(a.ws + WS_CTL + CTL_KMAX) + 16;
  unsigned char* K8 = (unsigned char*)(a.ws + WS_K8);
  LAS unsigned* lk = (LAS unsigned*)lds;
  if (tid < 16) lk[tid] = 0u;
  __syncthreads();
  const int slot = lane >> 4, l16 = lane & 15, e1 = (l16 >> 3) * 64 + 4 * (l16 & 7), e2 = e1 + 32;
  for (int it = blockIdx.x; it < MT / 8; it += gridDim.x) {
    const int r = it * 8 + wave;
    float cs[4], sn[4]; rope_cs4(r, lane, cs, sn);
    bf16_t* rowp = Q + (size_t)r * N_IN1;
#pragma unroll 2
    for (int hb = (r < CTXL ? 16 : 0); hb < 32; hb += 4) {
      const int hh = hb + slot;
      const u32x2 a1 = *(const u32x2*)(rowp + hh * 128 + e1), a2 = *(const u32x2*)(rowp + hh * 128 + e2);
      const float x1[4] = {bflo(a1[0]), bfhi(a1[0]), bflo(a1[1]), bfhi(a1[1])}, x2[4] = {bflo(a2[0]), bfhi(a2[0]), bflo(a2[1]), bfhi(a2[1])};
      float o1[4], o2[4];
#pragma unroll
      for (int q = 0; q < 4; ++q) { o1[q] = x1[q] * cs[q] - x2[q] * sn[q]; o2[q] = x2[q] * cs[q] + x1[q] * sn[q]; }
      const u32x2 w1 = {cvtpk(o1[0], o1[1]), cvtpk(o1[2], o1[3])}, w2 = {cvtpk(o2[0], o2[1]), cvtpk(o2[2], o2[3])};
      if (r >= CTXL && !dry) { *(u32x2*)(rowp + hh * 128 + e1) = w1; *(u32x2*)(rowp + hh * 128 + e2) = w2; }
      if (hb >= 16) {
        const unsigned q1 = pack8x4(o1[0], o1[1], o1[2], o1[3]), q2 = pack8x4(o2[0], o2[1], o2[2], o2[3]);
        unsigned char* k8p = K8 + (size_t)r * 2048 + (hh - 16) * 128;
        *(unsigned*)(k8p + e1) = q1; *(unsigned*)(k8p + e2) = q2;
        float so = sum16lanes(sq8x4(q1) + sq8x4(q2));
        if (l16 == 0) atomicMax((unsigned*)&lk[hh - 16], __float_as_uint(so));
      }
    }
  }
  __syncthreads();
  if (tid < 16) atomicMax(&kmx[tid], lk[tid]);
  __syncthreads();
}

__device__ __forceinline__ void phase_attn(const Args& a, int L, LAS char* lds) {
  const bf16_t* Q = (const bf16_t*)(a.ws + WS_QKVU);
  const unsigned* kmx = (const unsigned*)(a.ws + WS_CTL + CTL_KMAX) + L * 16;
  if (L == 0) {
    bf16_t* X2 = (bf16_t*)(a.ws + WS_X2);
    for (int u = blockIdx.x; u < 520; u += gridDim.x) {
      const int head = u < 512 ? (u & 7) : (u - 512);
      const float kmax2 = __uint_as_float(kmx[head >> 2]);
      if (u < 512) { const int qb = u >> 3; const size_t q0 = (size_t)(CTXL + qb * 256);
        at::attn_body_q8(Q + q0 * N_QKV0 + head * 128, N_QKV0, (const unsigned char*)(a.ws + WS_K8) + (head >> 2) * 128, 256, Q + 1280 + (head >> 2) * 128, N_QKV0, (DENSE8_G2 ? (bf16_t*)((unsigned char*)X2 + q0 * D + head * 128) : X2 + q0 * D + head * 128), D, MT, kmax2, lds);
      } else {
        at::attn_body_q8(Q + head * 128, N_QKV0, (const unsigned char*)(a.ws + WS_K8) + (head >> 2) * 128, 256, Q + 1280 + (head >> 2) * 128, N_QKV0, (DENSE8_G2 ? (bf16_t*)((unsigned char*)X2 + head * 128) : X2 + head * 128), D, CTXL, kmax2, lds); }
    }
  } else {
    bf16_t* O = (bf16_t*)(a.ws + WS_Y);
    for (int u = blockIdx.x; u < 1024; u += gridDim.x) {
      const int x = u & 7, w = u >> 3, hc = x + 8 * (w >> 6), qb = w & 63, h = hc >> 1;
      const float kmax2 = __uint_as_float(kmx[hc]);
      const size_t q0 = (size_t)(CTXL + qb * 256);
      at::attn_body_c256q8(Q + q0 * N_IN1 + hc * 128, N_IN1, (const unsigned char*)(a.ws + WS_K8) + hc * 128, 2048, Q + 4096 + h * 256, N_IN1,
                           O + (size_t)(qb * 256) * 4096 + hc * 256, 4096, MT, kmax2, lds);
    }
  }
}

__device__ __forceinline__ void phase_diff(const Args& a) {
  int tid = threadIdx.x; asm volatile("" : "+v"(tid)); tid &= 511; const int wave = tid >> 6, lane = tid & 63;
  const bf16_t* O = (const bf16_t*)(a.ws + WS_Y);
  bf16_t* X2 = (bf16_t*)(a.ws + WS_X2);
  const float* lp = a.in[17];
  const float s1 = wave_sum(lp[lane] * lp[128 + lane] + lp[64 + lane] * lp[192 + lane]);
  const float s2 = wave_sum(lp[256 + lane] * lp[384 + lane] + lp[320 + lane] * lp[448 + lane]);
  const float lam = expf(s1) - expf(s2) + LAM_INIT;
  const f32x4 sg = *(const f32x4*)(a.in[18] + 4 * lane);
  for (int it = blockIdx.x; it < SEQ / 8; it += gridDim.x) {
    const int t = it * 8 + wave;
    const bf16_t* op = O + (size_t)t * 4096;
    unsigned char* xp = (unsigned char*)X2 + (size_t)(CTXL + t) * D * (DENSE8_G2 ? 1 : 2);
#pragma unroll 2
    for (int h = 0; h < 8; ++h) {
      const u32x2 a0 = *(const u32x2*)(op + (2 * h) * 256 + 4 * lane), a1 = *(const u32x2*)(op + (2 * h + 1) * 256 + 4 * lane);
      float d[4] = {bflo(a0[0]) - lam * bflo(a1[0]), bfhi(a0[0]) - lam * bfhi(a1[0]), bflo(a0[1]) - lam * bflo(a1[1]), bfhi(a0[1]) - lam * bfhi(a1[1])};
      const float ss = wave_sum(d[0] * d[0] + d[1] * d[1] + d[2] * d[2] + d[3] * d[3]);
      const float rstd = rsqrtf(ss * (1.f / 256) + EPS) * (1.f - LAM_INIT);
#if DENSE8_G2
      const float r8 = rstd * 8.f;
      *(unsigned*)(xp + h * 256 + 4 * lane) = pack8x4(d[0] * r8 * sg[0], d[1] * r8 * sg[1], d[2] * r8 * sg[2], d[3] * r8 * sg[3]);
#else
      u32x2 pk = {cvtpk(d[0] * rstd * sg[0], d[1] * rstd * sg[1]), cvtpk(d[2] * rstd * sg[2], d[3] * rstd * sg[3])};
      *(u32x2*)((bf16_t*)xp + h * 256 + 4 * lane) = pk;
#endif
    }
  }
}

__device__ __forceinline__ void phase_G(const Args& a, int L, LAS char* lds, bool dry = false) {
  int tid = threadIdx.x; asm volatile("" : "+v"(tid)); tid &= 511; const int wave = tid >> 6, lane = tid & 63;
  const int NTOK = L == 0 ? MT : SEQ, ROW0 = L == 0 ? 0 : CTXL;
  const float* ng = a.in[6] + (size_t)L * 4 * D;
  const float* MODL = (const float*)(a.ws + WS_MOD) + (size_t)(L * 2) * 12288;
  const float* router = a.in[19] + (size_t)L * D * NE; const float* rbias = a.in[20] + L * NE;
  const bf16_t* OUT = (const bf16_t*)(a.ws + WS_OUT);
  float* HRES = (float*)(a.ws + WS_HRES);
  bf16_t* F = (bf16_t*)(a.ws + WS_ABUF);
  int* counts = (int*)(a.ws + WS_CTL + CTL_CNT) + L * 64;
  int* top_e = (int*)(a.ws + WS_TOPE); float* top_w = (float*)(a.ws + WS_TOPW); int* top_p = (int*)(a.ws + WS_TOPP);
  LAS float* ft = (LAS float*)lds;
  LAS float* part = ft + 8 * D;
  for (int it = blockIdx.x; it < NTOK / 8; it += gridDim.x) {
    const int r = ROW0 + it * 8 + wave;
    const float* mod = MODL + (r < CTXL ? 12288 : 0);
    {
      float o[32], h[32];
      ld_row_bf16(OUT + (size_t)r * D, lane, o);
      const float* hp = L == 0 ? (r < CTXL ? a.in[2] + (size_t)r * D : a.in[0] + (size_t)(r - CTXL) * D) : HRES + (size_t)r * D;
      ld_row_f32(hp, lane, h);
      const float rstd1 = rsqrtf(sumsq32(o) * (1.f / D) + EPS);
#pragma unroll
      for (int j = 0; j < 4; ++j) { const int idx = 8 * lane + 512 * j;
        float g1[8], gt[8]; ld8f(ng + D + idx, g1); ld8f(mod + 2 * D + idx, gt);
#pragma unroll
        for (int i = 0; i < 8; ++i) h[8 * j + i] += gt[i] * (o[8 * j + i] * rstd1 * g1[i]);
        if (!dry) st8f(HRES + (size_t)r * D + idx, &h[8 * j]); }
      const float rstd2 = rsqrtf(sumsq32(h) * (1.f / D) + EPS);
      modulate_store<true, true>(h, rstd2, ng + 2 * D, mod + 3 * D, mod + 4 * D, (bf16_t*)((unsigned char*)F + (size_t)r * D), lane, ft + wave * D);
    }
    __syncthreads();
    float acc[8] = {0, 0, 0, 0, 0, 0, 0, 0};
    const int d0 = wave * 256;
#pragma unroll 2
    for (int dd = 0; dd < 256; dd += 4) {
      const float* rp = router + (size_t)(d0 + dd) * NE + lane;
      const float r0 = rp[0], r1 = rp[NE], r2 = rp[2 * NE], r3 = rp[3 * NE];
#pragma unroll
      for (int t = 0; t < 8; ++t) { const f32x4 fv = *(LAS const f32x4*)(ft + t * D + d0 + dd); acc[t] += fv[0] * r0 + fv[1] * r1 + fv[2] * r2 + fv[3] * r3; }
    }
#pragma unroll
    for (int t = 0; t < 8; ++t) part[(wave * 8 + t) * 64 + lane] = acc[t];
    __syncthreads();
    float logit = 0;
#pragma unroll
    for (int w = 0; w < 8; ++w) logit += part[(w * 8 + wave) * 64 + lane];
#if MK_DIAG
    ((float*)(a.ws + WS_Y))[(size_t)r * 64 + lane] = logit;
#endif
    const float score = sigmoidf_(logit);
    const float choice = score + rbias[lane];
    int rank = 0; const int gl = lane & 7;
#pragma unroll
    for (int j = 0; j < 8; ++j) { const float o = __shfl(choice, (lane & ~7) | j); rank += (o > choice || (o == choice && j < gl)) ? 1 : 0; }
    float gs = rank < 2 ? choice : 0.f;
    gs += __shfl_xor(gs, 1); gs += __shfl_xor(gs, 2); gs += __shfl_xor(gs, 4);
    int grank = 0; const int g = lane >> 3;
#pragma unroll
    for (int j = 0; j < 8; ++j) { const float o = __shfl(gs, j * 8); grank += (o > gs || (o == gs && j < g)) ? 1 : 0; }
    const bool gsel = grank < 4;
    const float mc = gsel ? choice : -INFINITY;
    int erank = 0;
#pragma unroll 4
    for (int j = 0; j < 64; ++j) { const float o = __int_as_float(__builtin_amdgcn_readlane(__float_as_int(mc), j)); erank += (o > mc || (o == mc && j < lane)) ? 1 : 0; }
    const bool sel = gsel && erank < 8;
    const unsigned long long bal = __ballot(sel);
    const int idx = __popcll(bal & ((1ull << lane) - 1ull));
    const float ssum = wave_sum(sel ? score : 0.f);
    if (sel && !dry) { const int pos = atomicAdd(&counts[lane], 1);
      top_e[r * 8 + idx] = lane; top_w[r * 8 + idx] = score / ssum * 2.5f; top_p[r * 8 + idx] = pos; }
  }
}

__device__ __forceinline__ void moe_tile_prefix(const int* counts, LAS int* ts) {
  if (threadIdx.x == 0) { int s = 0; for (int e = 0; e < 64; ++e) { ts[e] = s; s += (counts[e] + 255) >> 8; } ts[64] = s; }
  __syncthreads();
}
__device__ __forceinline__ void phase_H(const Args& a, int L, LAS char* lds) {
  const int NTOK = L == 0 ? MT : SEQ, ROW0 = L == 0 ? 0 : CTXL;
  const int* counts = (const int*)(a.ws + WS_CTL + CTL_CNT) + L * 64;
  const int* top_e = (const int*)(a.ws + WS_TOPE); const int* top_p = (const int*)(a.ws + WS_TOPP);
  int* tslot = (int*)(a.ws + WS_TSLOT); int* stok = (int*)(a.ws + WS_STOK);
  LAS int* ts = (LAS int*)lds;
  moe_tile_prefix(counts, ts);
  int tid = threadIdx.x; asm volatile("" : "+v"(tid)); tid &= 511;
  const int gt = blockIdx.x * NTHREADS + tid, gs = gridDim.x * NTHREADS;
  for (int i = gt; i < NTOK * 8; i += gs) { const int q = ROW0 * 8 + i; const int e = top_e[q]; const int slot = ts[e] * 256 + top_p[q]; stok[slot] = q >> 3; tslot[q] = slot; }
  for (int i = gt; i < 64 * 256; i += gs) { const int e = i >> 8, p = i & 255, cnt = counts[e], nt = (cnt + 255) >> 8; if (cnt + p < nt * 256) stok[ts[e] * 256 + cnt + p] = ROW0; }
  for (int i = gt; i < NTOK; i += gs) stok[SH_BASE + i] = ROW0 + i;
  __syncthreads();
}
struct DenseSched {
  int nM, nN, r0; const unsigned char* W;
  __device__ __forceinline__ bool unit(int i, int& brow, const unsigned char*& Bt, int& bcol) const {
    const int u = blockIdx.x + i * (int)gridDim.x; if (u >= nM * nN) return false;
    int pm, pn; dense_unit(u, nM, nN, pm, pn); brow = r0 + pm * 256; bcol = pn * 256; Bt = W; return true; }
};
struct MoeSched {
  LAS const int* ts; int TR, NN, total; const unsigned char* W; size_t woff;
  __device__ __forceinline__ bool unit(int i, int& slot0, const unsigned char*& Bt, int& bcol) const {
    for (int u = blockIdx.x + i * (int)gridDim.x; ; u += gridDim.x) {
      const int rnd = u >> 8, b = u & 255, v = rnd * 256 + (b & 7) * 32 + (b >> 3);
      if (rnd * 256 >= total) return false;
      if (v >= total) return false;
      const int m = v / NN, pn = v % NN;
      int e;
      if (m >= TR) { e = 64; slot0 = SH_BASE + 256 * (m - TR); } else { e = 0; while (ts[e + 1] <= m) ++e; slot0 = 256 * m; }
      Bt = W + (size_t)e * WMOE8_E + woff; bcol = pn * 256;
      return true;
    }
  }
};
__device__ __forceinline__ void phase_moe_up(const Args& a, int L, LAS char* lds) {
  const int NSH = L == 0 ? MT / 256 : SEQ / 256;
  const int* counts = (const int*)(a.ws + WS_CTL + CTL_CNT) + L * 64;
  LAS int* ts = (LAS int*)(lds + LDS_CTL + 64);
  moe_tile_prefix(counts, ts);
  const int TR = ts[64], TM = TR + NSH;
  const unsigned char* F = (const unsigned char*)(a.ws + WS_ABUF); const unsigned char* W = (const unsigned char*)(a.ws + WS_WMOE) + (size_t)L * 65 * WMOE8_E;
  const int* stok = (const int*)(a.ws + WS_STOK);
  EpiSwiGLU8 epi{(unsigned char*)(a.ws + WS_ACT), EFF};
  MoeSched sc{ts, TR, 4, TM * 4, W, 0};
  gemm8_run<true, D, D, D>(F, stok, lds, epi, sc);
}
__device__ __forceinline__ void phase_moe_down(const Args& a, int L, LAS char* lds) {
  const int NSH = L == 0 ? MT / 256 : SEQ / 256;
  const int* counts = (const int*)(a.ws + WS_CTL + CTL_CNT) + L * 64;
  LAS int* ts = (LAS int*)(lds + LDS_CTL + 64);
  moe_tile_prefix(counts, ts);
  const int TR = ts[64], TM = TR + NSH;
  const unsigned char* ACT = (const unsigned char*)(a.ws + WS_ACT); const unsigned char* W = (const unsigned char*)(a.ws + WS_WMOE) + (size_t)L * 65 * WMOE8_E;
  EpiPlain8 epi{(unsigned char*)(a.ws + WS_Y), D, 16.f / 128.f};
  MoeSched sc{ts, TR, 8, TM * 8, W, (size_t)1024 * D};
  gemm8_run<false, EFF, EFF, EFF>(ACT, nullptr, lds, epi, sc);
}
__device__ __forceinline__ void phase_combine(const Args& a, int L, bool dry = false) {
  int tid = threadIdx.x; asm volatile("" : "+v"(tid)); tid &= 511; const int wave = tid >> 6, lane = tid & 63;
  const int NTOK = L == 0 ? MT : SEQ, ROW0 = L == 0 ? 0 : CTXL;
  const float* ng = a.in[6] + (size_t)L * 4 * D;
  const float* MODL = (const float*)(a.ws + WS_MOD) + (size_t)(L * 2) * 12288;
  const unsigned char* Y = (const unsigned char*)(a.ws + WS_Y);
  float* HRES = (float*)(a.ws + WS_HRES);
  const int* tslot = (const int*)(a.ws + WS_TSLOT); const float* top_w = (const float*)(a.ws + WS_TOPW);
  for (int it = blockIdx.x; it < NTOK / 8; it += gridDim.x) {
    const int r = ROW0 + it * 8 + wave;
    const float* mod = MODL + (r < CTXL ? 12288 : 0);
    float y[32];
    { float t[32]; ld_row_fp8(Y + (size_t)(SH_BASE + r - ROW0) * D, lane, t);
#pragma unroll
      for (int i = 0; i < 32; ++i) y[i] = t[i] * (1.f / 16.f); }
#pragma unroll 4
    for (int k = 0; k < 8; ++k) { const int slot = tslot[r * 8 + k]; const float w = top_w[r * 8 + k] * (1.f / 16.f);
      float t[32]; ld_row_fp8(Y + (size_t)slot * D, lane, t);
#pragma unroll
      for (int i = 0; i < 32; ++i) y[i] += w * t[i]; }
    const float rstd = rsqrtf(sumsq32(y) * (1.f / D) + EPS);
    float h[32]; ld_row_f32(HRES + (size_t)r * D, lane, h);
#pragma unroll
    for (int j = 0; j < 4; ++j) { const int idx = 8 * lane + 512 * j;
      float g3[8], gt[8]; ld8f(ng + 3 * D + idx, g3); ld8f(mod + 5 * D + idx, gt);
#pragma unroll
      for (int i = 0; i < 8; ++i) h[8 * j + i] += gt[i] * (y[8 * j + i] * rstd * g3[i]);
      if (L == 0) { if (!dry) st8f(HRES + (size_t)r * D + idx, &h[8 * j]); } else st8f(a.out + (size_t)(r - CTXL) * D + idx, &h[8 * j]); }
    if (L == 0) {
      const float* mod1 = MODL + 2 * 12288 + (r < CTXL ? 12288 : 0);
      const float rstd2 = rsqrtf(sumsq32(h) * (1.f / D) + EPS);
      modulate_store<false, true>(h, rstd2, a.in[6] + (size_t)4 * D, mod1, mod1 + D, (bf16_t*)((unsigned char*)(a.ws + WS_ABUF) + (size_t)r * D), lane, nullptr);
    }
  }
}

constexpr int NPH = 21;
typedef const __attribute__((address_space(4))) Args* ArgsP;
#if defined(__HIP_DEVICE_COMPILE__)
#define FRESH_ARGS() const Args a = *({ ArgsP _p = (ArgsP)__builtin_amdgcn_kernarg_segment_ptr(); asm volatile("" : "+s"(_p)); _p; })
#else
#define FRESH_ARGS() const Args a = kargs
#endif
__global__ void __launch_bounds__(NTHREADS, 2) fwd(Args kargs) {
  extern __shared__ __attribute__((aligned(16))) unsigned char lds_raw[];
  LAS char* lds = (LAS char*)lds_raw;
  const int lo = kargs.ph_lo, hi = kargs.ph_hi;
  if (threadIdx.x < 64) ((LAS unsigned*)(lds + LDS_CTL))[threadIdx.x] = 0u;
  __syncthreads();
  if (hi - lo > 1) (void)xcd_barrier_post((unsigned*)(kargs.ws + WS_CTL), (volatile LAS unsigned*)(lds + LDS_CTL));
#ifndef PHASE_MASK
#define PHASE_MASK 0xFFFFFFFFu
#endif
#define IN(k) (((PHASE_MASK >> (k)) & 1u) && lo <= (k) && (k) < hi)
#ifndef PH_REPEAT_MASK
#define PH_REPEAT_MASK 0u
#endif
#define REP(k) for (int _rep = 0; _rep < (((PH_REPEAT_MASK >> (k)) & 1u) ? 2 : 1); ++_rep)
#define SEAM(k) do { if ((k) + 1 < hi) { XcdBarrier _b; _b.bar = (unsigned*)(a.ws + WS_CTL); _b.x = xb_xcc_id(); _b.st = (volatile LAS unsigned*)(lds + LDS_CTL); xcd_barrier(_b); } } while (0)

  if (IN(0)) { FRESH_ARGS(); REP(0) phase_prologue(a, lds); SEAM(0); }
  if (IN(1)) { FRESH_ARGS(); REP(1) phase_modulate0(a); SEAM(1); }
#pragma unroll
  for (int L = 0; L < 2; ++L) {
    const int base = 2 + (L == 0 ? 0 : 9);
    if (IN(base + 0)) {
      FRESH_ARGS();
      const unsigned char* A = (const unsigned char*)(a.ws + WS_ABUF);
      const int nN = L == 0 ? N_IN0 / 256 : N_IN1 / 256, nM = MT / 256;
      EpiG1 epi{EpiPlain{(bf16_t*)(a.ws + WS_QKVU), L == 0 ? N_QKV0 : N_IN1, 1.f / 256.f}, EpiPair<0>{(bf16_t*)(a.ws + WS_HG), 1024, N_QKV0, 1.f / 256.f}, L == 0 ? N_QKV0 : N_IN1};
      DenseSched sc{nM, nN, 0, (const unsigned char*)(a.ws + (L == 0 ? WS_WIN0 : WS_WIN1))};
      REP(2) gemm8_run<false, D, D, D>(A, nullptr, lds, epi, sc);
      SEAM(base + 0);
    }
    if (L == 0) {
      if (IN(3)) { FRESH_ARGS(); if ((PH_REPEAT_MASK >> 3) & 1u) { phase_rope_conv0(a, lds, true); __syncthreads(); } phase_rope_conv0(a, lds); SEAM(3); }
      if (IN(4)) { FRESH_ARGS(); REP(4) phase_attn(a, 0, lds); SEAM(4); }
    } else {
      if (IN(12)) { FRESH_ARGS(); if ((PH_REPEAT_MASK >> 12) & 1u) { phase_rope1(a, lds, true); __syncthreads(); } phase_rope1(a, lds); SEAM(12); }
      if (IN(13)) { FRESH_ARGS(); REP(13) phase_attn(a, 1, lds); SEAM(13); }
      if (IN(14)) { FRESH_ARGS(); REP(14) phase_diff(a); SEAM(14); }
    }
    const int b2 = L == 0 ? 5 : 15;
    if (IN(b2 + 0)) {
      FRESH_ARGS();
      const int nN = D / 256, nM = L == 0 ? MT / 256 : SEQ / 256, r0 = L == 0 ? 0 : CTXL;
#if DENSE8_G2
      const unsigned char* A = (const unsigned char*)(a.ws + WS_X2);
      EpiPlain epi{(bf16_t*)(a.ws + WS_OUT), D, 1.f / 2048.f};
      DenseSched sc{nM, nN, r0, (const unsigned char*)(a.ws + (L == 0 ? WS_WOUT0 : WS_WOUT1))};
      REP(5) gemm8_run<false, D, D, D>(A, nullptr, lds, epi, sc);
#else
      const bf16_t* A = (const bf16_t*)(a.ws + WS_X2);
      const bf16_t* Bt = (const bf16_t*)(a.ws + (L == 0 ? WS_WOUT0 : WS_WOUT1));
      EpiPlain epi{(bf16_t*)(a.ws + WS_OUT), D, 1.f};
      REP(5) for (int u = blockIdx.x; u < nM * nN; u += gridDim.x) { int pm, pn; dense_unit(u, nM, nN, pm, pn);
        gemm_tile<false>(A, D, nullptr, r0 + pm * 256, Bt, D, pn * 256, D, lds, epi); }
#endif
      SEAM(b2 + 0);
    }
    if (IN(b2 + 1)) { FRESH_ARGS(); if ((PH_REPEAT_MASK >> 6) & 1u) { phase_G(a, L, lds, true); __syncthreads(); } phase_G(a, L, lds); SEAM(b2 + 1); }
    if (IN(b2 + 2)) { FRESH_ARGS(); REP(7) phase_H(a, L, lds); SEAM(b2 + 2); }
    if (IN(b2 + 3)) { FRESH_ARGS(); REP(8) phase_moe_up(a, L, lds); SEAM(b2 + 3); }
    if (IN(b2 + 4)) { FRESH_ARGS(); REP(9) phase_moe_down(a, L, lds); SEAM(b2 + 4); }
    if (IN(b2 + 5)) { FRESH_ARGS(); if ((PH_REPEAT_MASK >> 10) & 1u) phase_combine(a, L, true); phase_combine(a, L); SEAM(b2 + 5); }
  }
#undef IN
#undef SEAM
}

#ifndef MK_DIAG
#define MK_DIAG 0
#endif
#if MK_DIAG
__device__ __forceinline__ void rope_cs(int r, int lane, float& cs, float& sn) {
  cs = 1.f; sn = 0.f;
  if (r >= CTXL) { const int t = r - CTXL; const int a = lane >> 5, i = lane & 31;
    const float pos = a ? (float)(t & 63) : (float)(t >> 6);
    const float inv = powf(10000.f, -(float)i / 32.f);
    sincosf(pos * inv, &sn, &cs); }
}
__device__ __forceinline__ bool dclose(float got, float ref, float rtol, float atol) { return fabsf(got - ref) <= rtol * fabsf(ref) + atol; }
__device__ __forceinline__ unsigned dhash(unsigned x) { x ^= x >> 16; x *= 0x7feb352du; x ^= x >> 15; x *= 0x846ca68bu; x ^= x >> 16; return x; }
__device__ float wdot(const bf16_t* arow, const float* W, int ldw, int col, int K, int lane) {
  float s = 0; for (int k = lane; k < K; k += 64) s += bf2f(arow[k]) * W[(size_t)k * ldw + col]; return wave_sum(s); }
__device__ float dq8(const unsigned char* p, size_t i) { const unsigned w = ((const unsigned*)p)[i >> 2]; const int b = (int)(i & 3);
  return b == 0 ? __builtin_amdgcn_cvt_f32_fp8((int)w, 0) : b == 1 ? __builtin_amdgcn_cvt_f32_fp8((int)w, 1) : b == 2 ? __builtin_amdgcn_cvt_f32_fp8((int)w, 2) : __builtin_amdgcn_cvt_f32_fp8((int)w, 3); }
__device__ float wdot8(const unsigned char* arow8, const float* W, int ldw, int col, int K, int lane) {
  float s = 0; for (int k = lane; k < K; k += 64) s += dq8(arow8, k) * W[(size_t)k * ldw + col]; return wave_sum(s); }
__device__ void dflag(int* dg, int s, int bad, int lane) { if (lane == 0 && bad) atomicAdd(&dg[s], bad); }
__device__ const float* h0row(const Args& a, int r) { return r < CTXL ? a.in[2] + (size_t)r * D : a.in[0] + (size_t)(r - CTXL) * D; }
__device__ int pick_row(unsigned h, int lo, int n) { const unsigned m = h % 8; if (m == 0) return lo; if (m == 1) return lo + n - 1; if (m == 2) return lo + 255 < lo + n ? lo + 255 : lo; if (m == 3) return lo + 256 < lo + n ? lo + 256 : lo; return lo + (int)((h >> 3) % (unsigned)n); }
__device__ void naive_attn(const bf16_t* q, const bf16_t* K, const bf16_t* V, int ld, int nkeys, int lane, float& o0, float& o1) {
  const float q0 = bf2f(q[lane]), q1 = bf2f(q[lane + 64]);
  float m = -1e30f, l = 0; o0 = 0; o1 = 0;
  for (int k = 0; k < nkeys; ++k) {
    const float s = wave_sum(q0 * bf2f(K[(size_t)k * ld + lane]) + q1 * bf2f(K[(size_t)k * ld + lane + 64])) * 0.088388347648318440f;
    const float mn = fmaxf(m, s), al = expf(m - mn), p = expf(s - mn);
    l = l * al + p; o0 = o0 * al + p * bf2f(V[(size_t)k * ld + lane]); o1 = o1 * al + p * bf2f(V[(size_t)k * ld + lane + 64]); m = mn;
  }
  o0 /= l; o1 /= l;
}
__global__ void __launch_bounds__(256) diag(Args a, int k) {
  __shared__ float fsh[4][2048];
  __shared__ float csh[4][64];
  const int lane = threadIdx.x & 63, wv = threadIdx.x >> 6, gw = blockIdx.x * 4 + wv;
  int* dg = (int*)(a.ws + WS_CTL + CTL_CNT + 512);
  const float* MOD = (const float*)(a.ws + WS_MOD);
  const bf16_t* AB = (const bf16_t*)(a.ws + WS_ABUF);
  const bf16_t* QK = (const bf16_t*)(a.ws + WS_QKVU);
  const bf16_t* HG = (const bf16_t*)(a.ws + WS_HG);
  const bf16_t* X2 = (const bf16_t*)(a.ws + WS_X2);
  const bf16_t* OUT = (const bf16_t*)(a.ws + WS_OUT);
  const bf16_t* ACT = (const bf16_t*)(a.ws + WS_ACT);
  const bf16_t* Y = (const bf16_t*)(a.ws + WS_Y);
  const float* HRES = (const float*)(a.ws + WS_HRES);
  const int* top_e = (const int*)(a.ws + WS_TOPE); const float* top_w = (const float*)(a.ws + WS_TOPW); const int* top_p = (const int*)(a.ws + WS_TOPP);
  const int* tslot = (const int*)(a.ws + WS_TSLOT); const int* stok = (const int*)(a.ws + WS_STOK);
  const unsigned h = dhash(gw * 7919u + k * 104729u + 17u), h2 = dhash(h + 12345u);
  int bad = 0;
  const int L = k >= 11 ? 1 : 0;
  const int NTOK = L == 0 ? MT : SEQ, ROW0 = L == 0 ? 0 : CTXL;
  const int* counts = (const int*)(a.ws + WS_CTL + CTL_CNT) + L * 64;
  if (k == 0) {
    const int LL = gw & 1, which = (gw >> 1) & 1, j = h % 12288;
    const float* v = which ? a.in[3] : a.in[1];
    float s = 0; for (int d = lane; d < D; d += 64) { const float x = v[d]; s += x * sigmoidf_(x) * a.in[4][((size_t)LL * D + d) * 12288 + j]; }
    s = wave_sum(s) + a.in[5][LL * 12288 + j];
    bad = !dclose(MOD[(LL * 2 + which) * 12288 + j], s, 1e-3f, 1e-3f); dflag(dg, 1, bad, lane);
  } else if (k == 1) {
    const int r = pick_row(h, 0, MT); const float* x = h0row(a, r); const float* mod = MOD + (r < CTXL ? 12288 : 0);
    float ss = 0; for (int d = lane; d < D; d += 64) ss += x[d] * x[d]; ss = wave_sum(ss); const float rstd = rsqrtf(ss / D + EPS);
    for (int d = lane; d < D; d += 64) { const float ref = x[d] * rstd * a.in[6][d] * (1.f + mod[D + d]) + mod[d]; bad += !dclose(bf2f(AB[(size_t)r * D + d]), ref, 0.01f, 0.01f); }
    bad = (int)wave_sum((float)bad); dflag(dg, 2, bad, lane);
  } else if (k == 2 || k == 11) {
    const int r = pick_row(h, 0, MT);
    if (L == 0) {
      const int c = h2 % N_QKV0; const float ref = wdot(AB + (size_t)r * D, a.in[7], N_IN0, c, D, lane);
      bad = !dclose(bf2f(QK[(size_t)r * N_QKV0 + c]), ref, 0.02f, 0.05f); dflag(dg, 3, bad, lane);
      const int ch = (h2 >> 11) % 1024; const float av = wdot(AB + (size_t)r * D, a.in[7], N_IN0, N_QKV0 + ch, D, lane), gv = wdot(AB + (size_t)r * D, a.in[7], N_IN0, N_QKV0 + 1024 + ch, D, lane);
      bad = !dclose(bf2f(HG[(size_t)r * 1024 + ch]), av * sigmoidf_(gv), 0.03f, 0.05f); dflag(dg, 4, bad, lane);
    } else {
      const int c = h2 % N_IN1; const float ref = wdot(AB + (size_t)r * D, a.in[15], N_IN1, c, D, lane);
      bad = !dclose(bf2f(QK[(size_t)r * N_IN1 + c]), ref, 0.02f, 0.05f); dflag(dg, 15, bad, lane);
    }
  } else if (k == 3) {
    { const int r = pick_row(h, 0, MT), hh = h2 % 10; const float* g = hh < 8 ? a.in[9] : a.in[10];
      float raw0 = 0, raw1 = 0;
      for (int d = 0; d < 128; ++d) { const float v = wdot(AB + (size_t)r * D, a.in[7], N_IN0, hh * 128 + d, D, lane); if (d == lane) raw0 = v; if (d == lane + 64) raw1 = v; }
      const float rstd = rsqrtf(wave_sum(raw0 * raw0 + raw1 * raw1) / 128.f + EPS);
      const float y0 = raw0 * rstd * g[lane], y1 = raw1 * rstd * g[lane + 64];
      float cs, sn; rope_cs(r, lane, cs, sn);
      const float cs0 = __shfl(cs, lane & 31), sn0 = __shfl(sn, lane & 31), cs1 = __shfl(cs, 32 + (lane & 31)), sn1 = __shfl(sn, 32 + (lane & 31));
      const float p0 = __shfl_xor(y0, 32), p1 = __shfl_xor(y1, 32);
      const float o0 = (lane < 32) ? y0 * cs0 - p0 * sn0 : y0 * cs0 + p0 * sn0;
      const float o1 = (lane < 32) ? y1 * cs1 - p1 * sn1 : y1 * cs1 + p1 * sn1;
      bad = !dclose(bf2f(QK[(size_t)r * N_QKV0 + hh * 128 + lane]), o0, 0.03f, 0.05f) + !dclose(bf2f(QK[(size_t)r * N_QKV0 + hh * 128 + 64 + lane]), o1, 0.03f, 0.05f);
      bad = (int)wave_sum((float)bad); dflag(dg, 5, bad, lane); }
    { const int r = pick_row(h2, 0, MT); const int seg0 = r < CTXL ? 0 : CTXL, seg1 = r < CTXL ? CTXL : MT;
      float cv[16]; float s1 = 0, s2 = 0;
      for (int q = 0; q < 16; ++q) { const int c = lane + 64 * q; float acc = a.in[12][c];
        for (int j = 0; j < 31; ++j) { const int rr = r + j - 15; if (rr >= seg0 && rr < seg1) acc += bf2f(HG[(size_t)rr * 1024 + c]) * a.in[11][j * 1024 + c]; }
        cv[q] = acc; s1 += acc; s2 += acc * acc; }
      s1 = wave_sum(s1); s2 = wave_sum(s2); const float mean = s1 / 1024.f, rstd = rsqrtf(s2 / 1024.f - mean * mean + EPS);
      bad = 0;
      for (int q = 0; q < 16; ++q) { const int c = lane + 64 * q; float y = (cv[q] - mean) * rstd * a.in[13][c] + a.in[14][c]; y = y * sigmoidf_(y);
        bad += !dclose(bf2f(X2[(size_t)r * D + 1024 + c]), y, 0.03f, 0.03f); }
      bad = (int)wave_sum((float)bad); dflag(dg, 6, bad, lane); }
  } else if (k == 4) {
    if (gw < 64) { const int r = pick_row(h, 0, MT), head = h2 % 8; const int nkeys = r < CTXL ? CTXL : MT;
      float o0, o1; naive_attn(QK + (size_t)r * N_QKV0 + head * 128, QK + 1024 + (head >> 2) * 128, QK + 1280 + (head >> 2) * 128, N_QKV0, nkeys, lane, o0, o1);
      const float rt = r < CTXL ? 0.15f : 0.05f, at_ = r < CTXL ? 0.04f : 0.01f;
      bad = !dclose(bf2f(X2[(size_t)r * D + head * 128 + lane]), o0, rt, at_) + !dclose(bf2f(X2[(size_t)r * D + head * 128 + 64 + lane]), o1, rt, at_);
      bad = (int)wave_sum((float)bad); dflag(dg, r < CTXL ? 26 : 7, bad, lane); }
  } else if (k == 5 || k == 15) {
    const int r = pick_row(h, ROW0, NTOK), c = h2 % D; const float ref = wdot(X2 + (size_t)r * D, L == 0 ? a.in[8] : a.in[16], D, c, D, lane);
    bad = !dclose(bf2f(OUT[(size_t)r * D + c]), ref, 0.02f, 0.05f); dflag(dg, L == 0 ? 8 : 19, bad, lane);
  } else if (k == 6 || k == 16) {
    const int r = pick_row(h, ROW0, NTOK); const float* mod = MOD + (size_t)(L * 2) * 12288 + (r < CTXL ? 12288 : 0); const float* ng = a.in[6] + (size_t)L * 4 * D;
    float ss = 0; for (int d = lane; d < D; d += 64) { const float o = bf2f(OUT[(size_t)r * D + d]); ss += o * o; } ss = wave_sum(ss); const float rstd1 = rsqrtf(ss / D + EPS);
    bad = 0;
    if (L == 0) { const float* x = h0row(a, r); for (int d = lane; d < D; d += 64) { const float ref = x[d] + mod[2 * D + d] * (bf2f(OUT[(size_t)r * D + d]) * rstd1 * ng[D + d]); bad += !dclose(HRES[(size_t)r * D + d], ref, 1e-3f, 1e-3f); } }
    float s2 = 0; for (int d = lane; d < D; d += 64) { const float x = HRES[(size_t)r * D + d]; s2 += x * x; } s2 = wave_sum(s2); const float rstd2 = rsqrtf(s2 / D + EPS);
    for (int d = lane; d < D; d += 64) { const float f = HRES[(size_t)r * D + d] * rstd2 * ng[2 * D + d] * (1.f + mod[4 * D + d]) + mod[3 * D + d]; fsh[wv][d] = f; bad += !dclose(dq8((const unsigned char*)AB + (size_t)r * D, d), f, 0.07f, 0.01f); }
    bad = (int)wave_sum((float)bad); dflag(dg, L == 0 ? 9 : 20, bad, lane);
    __syncthreads();
    float lg = 0; for (int d = 0; d < D; ++d) lg += fsh[wv][d] * a.in[19][((size_t)L * D + d) * NE + lane];
    const float sc = sigmoidf_(lg); csh[wv][lane] = sc + a.in[20][L * NE + lane];
    __syncthreads();
    { const float plg = ((const float*)(a.ws + WS_Y))[(size_t)r * 64 + lane]; int lb = !dclose(plg, lg, 1e-3f, 1e-3f); lb = (int)wave_sum((float)lb); if (lane == 0 && lb) { atomicAdd(&dg[32 + (L == 0 ? 10 : 21) + 3], 1); atomicOr(&dg[60], 1 << (r & 7)); } }
    unsigned long long wsel;
    { const float choice = csh[wv][lane]; int rank = 0; const int gl = lane & 7;
      for (int j = 0; j < 8; ++j) { const float o = __shfl(choice, (lane & ~7) | j); rank += (o > choice || (o == choice && j < gl)) ? 1 : 0; }
      float gs = rank < 2 ? choice : 0.f; gs += __shfl_xor(gs, 1); gs += __shfl_xor(gs, 2); gs += __shfl_xor(gs, 4);
      int grank = 0; const int g = lane >> 3;
      for (int j = 0; j < 8; ++j) { const float o = __shfl(gs, j * 8); grank += (o > gs || (o == gs && j < g)) ? 1 : 0; }
      const bool gsel = grank < 4; const float mc = gsel ? choice : -INFINITY; int erank = 0;
      for (int j = 0; j < 64; ++j) { const float o = __shfl(mc, j); erank += (o > mc || (o == mc && j < lane)) ? 1 : 0; }
      wsel = __ballot(gsel && erank < 8); }
    int setbad = 0;
    if (lane == 0) {
      float gsc[8]; for (int g = 0; g < 8; ++g) { float m1 = -1e30f, m2 = -1e30f; for (int j = 0; j < 8; ++j) { const float v = csh[wv][g * 8 + j]; if (v > m1) { m2 = m1; m1 = v; } else if (v > m2) m2 = v; } gsc[g] = m1 + m2; }
      bool gs[8] = {false, false, false, false, false, false, false, false};
      for (int t = 0; t < 4; ++t) { int bi = 0; float bv = -1e30f; for (int g = 0; g < 8; ++g) if (!gs[g] && gsc[g] > bv) { bv = gsc[g]; bi = g; } gs[bi] = true; }
      unsigned long long selm = 0; for (int t = 0; t < 8; ++t) { int bi = 0; float bv = -1e30f; for (int e = 0; e < 64; ++e) if (gs[e >> 3] && !((selm >> e) & 1ull) && csh[wv][e] > bv) { bv = csh[wv][e]; bi = e; } selm |= 1ull << bi; }
      unsigned long long got = 0; for (int t = 0; t < 8; ++t) { const int e = top_e[r * 8 + t]; if (e < 0 || e > 63) setbad = 1000; else got |= 1ull << e; }
      if (setbad == 0 && got != selm) setbad = 1;
      if (wsel != selm) atomicAdd(&dg[32 + (L == 0 ? 10 : 21) + 4], 1);
    }
    setbad = __shfl(setbad, 0);
    { float wgot = -1.f; int mine = 0; for (int t = 0; t < 8; ++t) if (top_e[r * 8 + t] == lane) { mine = 1; wgot = top_w[r * 8 + t]; }
      const float ssum = wave_sum(mine ? sc : 0.f);
      int wbad = (mine && !dclose(wgot, sc / ssum * 2.5f, 0.01f, 1e-3f)) ? 1 : 0; wbad = (int)wave_sum((float)wbad);
      if (lane == 0) { int* q = &dg[32 + (L == 0 ? 10 : 21)]; if (setbad >= 1000) atomicAdd(q + 1, 1); else if (setbad) atomicAdd(q, 1); else if (wbad) atomicAdd(q + 2, 1); } }
  } else if (k == 7 || k == 17) {
    const int r = pick_row(h, ROW0, NTOK), t = h2 % 8, q = r * 8 + t; const int slot = tslot[q], e = top_e[q];
    int ts0 = 0; for (int j = 0; j < e; ++j) ts0 += (counts[j] + 255) >> 8;
    bad = (slot < ts0 * 256 || slot >= ts0 * 256 + counts[e] || stok[slot] != r || top_p[q] != slot - ts0 * 256) ? 1 : 0;
    bad += (stok[SH_BASE + r - ROW0] != r) ? 1 : 0;
    dflag(dg, L == 0 ? 11 : 22, bad, lane);
  } else if (k == 8 || k == 18 || k == 9 || k == 19) {
    int TR = 0; for (int j = 0; j < 64; ++j) TR += (counts[j] + 255) >> 8;
    int slot, e;
    if ((h & 3) == 0) { slot = SH_BASE + (int)((h >> 2) % (unsigned)NTOK); e = 64; }
    else { e = (h >> 2) % 64; int guard = 0; while (counts[e] == 0 && guard++ < 64) e = (e + 1) % 64; int ts0 = 0; for (int j = 0; j < e; ++j) ts0 += (counts[j] + 255) >> 8;
      const unsigned m = (h >> 8) % 4; const int cnt = counts[e]; const int p = m == 0 ? 0 : m == 1 ? cnt - 1 : (int)((h >> 10) % (unsigned)cnt); slot = ts0 * 256 + p; }
    const int tok = stok[slot];
    if (k == 8 || k == 18) {
      const int ch = h2 % EFF;
      const float* Wg = e < 64 ? a.in[21] + ((size_t)L * 64 + e) * D * EFF : a.in[24] + (size_t)L * D * EFF;
      const float* Wu = e < 64 ? a.in[22] + ((size_t)L * 64 + e) * D * EFF : a.in[25] + (size_t)L * D * EFF;
      const unsigned char* F8 = (const unsigned char*)AB + (size_t)tok * D;
      const float gv = wdot8(F8, Wg, EFF, ch, D, lane), uv = wdot8(F8, Wu, EFF, ch, D, lane);
      bad = !dclose(dq8((const unsigned char*)ACT + (size_t)slot * EFF, ch), gv * sigmoidf_(gv) * uv, 0.2f, 0.15f); dflag(dg, L == 0 ? 12 : 23, bad, lane);
    } else {
      const int c = h2 % D; const float* Wd = e < 64 ? a.in[23] + ((size_t)L * 64 + e) * EFF * D : a.in[26] + (size_t)L * EFF * D;
      const float ref = wdot8((const unsigned char*)ACT + (size_t)slot * EFF, Wd, D, c, EFF, lane);
      bad = !dclose(dq8((const unsigned char*)Y + (size_t)slot * D, c) * (1.f / 16.f), ref, 0.2f, 0.15f); dflag(dg, L == 0 ? 13 : 24, bad, lane);
    }
  } else if (k == 10 || k == 20) {
    const int r = pick_row(h, ROW0, NTOK); const float* mod = MOD + (size_t)(L * 2) * 12288 + (r < CTXL ? 12288 : 0); const float* ng = a.in[6] + (size_t)L * 4 * D;
    float ss = 0; for (int d = lane; d < D; d += 64) { const unsigned char* Y8 = (const unsigned char*)Y; float y = dq8(Y8 + (size_t)(SH_BASE + r - ROW0) * D, d) * (1.f / 16.f); for (int t = 0; t < 8; ++t) y += top_w[r * 8 + t] * dq8(Y8 + (size_t)tslot[r * 8 + t] * D, d) * (1.f / 16.f); fsh[wv][d] = y; ss += y * y; }
    ss = wave_sum(ss); const float rstd = rsqrtf(ss / D + EPS);
    bad = 0;
    if (L == 0) { float s2 = 0; for (int d = lane; d < D; d += 64) { const float x = HRES[(size_t)r * D + d]; s2 += x * x; } s2 = wave_sum(s2); const float rstd2 = rsqrtf(s2 / D + EPS);
      const float* mod1 = MOD + (size_t)2 * 12288 + (r < CTXL ? 12288 : 0);
      for (int d = lane; d < D; d += 64) { const float ref = HRES[(size_t)r * D + d] * rstd2 * a.in[6][4 * D + d] * (1.f + mod1[D + d]) + mod1[d]; bad += !dclose(bf2f(AB[(size_t)r * D + d]), ref, 0.01f, 0.01f); } }
    else { for (int d = lane; d < D; d += 64) { const float ref = HRES[(size_t)r * D + d] + mod[5 * D + d] * (fsh[wv][d] * rstd * ng[3 * D + d]); bad += !dclose(a.out[(size_t)(r - CTXL) * D + d], ref, 1e-3f, 1e-3f); } }
    bad = (int)wave_sum((float)bad); dflag(dg, L == 0 ? 14 : 25, bad, lane);
  } else if (k == 12) {
    const int r = pick_row(h, CTXL, SEQ), hh = h2 % 32;
    float raw0 = 0, raw1 = 0;
    for (int d = 0; d < 128; ++d) { const float v = wdot(AB + (size_t)r * D, a.in[15], N_IN1, hh * 128 + d, D, lane); if (d == lane) raw0 = v; if (d == lane + 64) raw1 = v; }
    float cs, sn; rope_cs(r, lane, cs, sn);
    const float cs0 = __shfl(cs, lane & 31), sn0 = __shfl(sn, lane & 31), cs1 = __shfl(cs, 32 + (lane & 31)), sn1 = __shfl(sn, 32 + (lane & 31));
    const float p0 = __shfl_xor(raw0, 32), p1 = __shfl_xor(raw1, 32);
    const float o0 = (lane < 32) ? raw0 * cs0 - p0 * sn0 : raw0 * cs0 + p0 * sn0;
    const float o1 = (lane < 32) ? raw1 * cs1 - p1 * sn1 : raw1 * cs1 + p1 * sn1;
    bad = !dclose(bf2f(QK[(size_t)r * N_IN1 + hh * 128 + lane]), o0, 0.03f, 0.05f) + !dclose(bf2f(QK[(size_t)r * N_IN1 + hh * 128 + 64 + lane]), o1, 0.03f, 0.05f);
    bad = (int)wave_sum((float)bad); dflag(dg, 16, bad, lane);
  } else if (k == 13) {
    if (gw < 64) { const int r = pick_row(h, CTXL, SEQ), hc = h2 % 16, vh = (h2 >> 4) & 1, hd = hc >> 1;
      float o0, o1; naive_attn(QK + (size_t)r * N_IN1 + hc * 128, QK + 2048 + hc * 128, QK + 4096 + hd * 256 + vh * 128, N_IN1, MT, lane, o0, o1);
      const bf16_t* O = Y + (size_t)(r - CTXL) * 4096 + hc * 256 + vh * 128;
      bad = !dclose(bf2f(O[lane]), o0, 0.05f, 0.01f) + !dclose(bf2f(O[64 + lane]), o1, 0.05f, 0.01f);
      bad = (int)wave_sum((float)bad); dflag(dg, 17, bad, lane); }
  } else if (k == 14) {
    const int r = pick_row(h, CTXL, SEQ), hd = h2 % 8; const float* lp = a.in[17];
    float s1 = 0, s2 = 0; for (int i = lane; i < 128; i += 64) { s1 += lp[i] * lp[128 + i]; s2 += lp[256 + i] * lp[384 + i]; } s1 = wave_sum(s1); s2 = wave_sum(s2);
    const float lam = expf(s1) - expf(s2) + LAM_INIT; const bf16_t* O = Y + (size_t)(r - CTXL) * 4096;
    float dv[4], ss = 0; for (int i = 0; i < 4; ++i) { const int d = lane + 64 * i; dv[i] = bf2f(O[(2 * hd) * 256 + d]) - lam * bf2f(O[(2 * hd + 1) * 256 + d]); ss += dv[i] * dv[i]; }
    ss = wave_sum(ss); const float rstd = rsqrtf(ss / 256.f + EPS) * (1.f - LAM_INIT); bad = 0;
    for (int i = 0; i < 4; ++i) { const int d = lane + 64 * i; bad += !dclose(bf2f(X2[(size_t)r * D + hd * 256 + d]), dv[i] * rstd * a.in[18][d], 0.02f, 0.01f); }
    bad = (int)wave_sum((float)bad); dflag(dg, 18, bad, lane);
  }
}
__global__ void diag_encode(Args a) {
  const int* dg = (const int*)(a.ws + WS_CTL + CTL_CNT + 512);
  int s = 0;
  int sub = 0;
  for (int i = 1; i < 32; ++i) { int v = dg[i]; if (i == 10 || i == 21) { v = (dg[32 + i] > 25 ? 1 : 0) + (dg[33 + i] > 0 ? 2 : 0) + (dg[34 + i] > 0 ? 4 : 0) + (dg[35 + i] > 0 ? 8 : 0) + (dg[36 + i] > 0 ? 16 : 0); sub = v; } if (v) { s = i; break; } }
  if (s == 0) return;
  const float c = sub ? 30.f + 8.f * sub : 10.f * s;
  for (size_t i = (size_t)blockIdx.x * blockDim.x + threadIdx.x; i < (size_t)SEQ * D; i += (size_t)gridDim.x * blockDim.x) a.out[i] = c;
}
#endif

extern "C" void kernel_launch(void* const* d_in, const int* in_sizes, int n_in, void* d_out, int out_size, void* d_ws, size_t ws_size, hipStream_t stream) {
  static int grid = 0;
  if (grid == 0) {
    if (n_in != 27 || out_size != SEQ * D || ws_size < WS_END) { fprintf(stderr, "kernel_launch: unexpected shapes (n_in %d out %d ws %zu need %zu)\n", n_in, out_size, ws_size, (size_t)WS_END); grid = -1; return; }
    if (hipFuncSetAttribute((const void*)fwd, hipFuncAttributeMaxDynamicSharedMemorySize, LDS_BYTES) != hipSuccess) { fprintf(stderr, "kernel_launch: hipFuncSetAttribute failed\n"); grid = -1; return; }
    int dev = 0, cus = 0, per_cu = 0;
    hipGetDevice(&dev); hipDeviceGetAttribute(&cus, hipDeviceAttributeMultiprocessorCount, dev);
    if (hipOccupancyMaxActiveBlocksPerMultiprocessor(&per_cu, (const void*)fwd, NTHREADS, LDS_BYTES) != hipSuccess || per_cu < 1) fprintf(stderr, "kernel_launch: occupancy query says %d\n", per_cu);
    (void)hipGetLastError();
    grid = cus < 256 ? cus : 256;
    if (grid != 256) fprintf(stderr, "kernel_launch: %d CUs (expected 256)\n", cus);
  }
  if (grid < 0) return;
  hipMemsetAsync((char*)d_ws + WS_CTL, 0, CTL_BYTES, stream);
  Args a{};
  for (int i = 0; i < 27; ++i) a.in[i] = (const float*)d_in[i];
  a.out = (float*)d_out; a.ws = (unsigned char*)d_ws;
#if MK_MULTI
  for (int k = 0; k < NPH; ++k) { a.ph_lo = k; a.ph_hi = k + 1; hipLaunchKernelGGL(fwd, dim3(grid), dim3(NTHREADS), LDS_BYTES, stream, a);
#if MK_DIAG
    hipLaunchKernelGGL(diag, dim3(64), dim3(256), 0, stream, a, k);
#endif
  }
#if MK_DIAG
  hipLaunchKernelGGL(diag_encode, dim3(1024), dim3(256), 0, stream, a);
#endif
#else
  a.ph_lo = 0; a.ph_hi = NPH;
  hipLaunchKernelGGL(fwd, dim3(grid), dim3(NTHREADS), LDS_BYTES, stream, a);
#endif
  const hipError_t le = hipPeekAtLastError();
  if (le != hipSuccess) fprintf(stderr, "kernel_launch: launch failed: %s\n", hipGetErrorName(le));
}
```

```cpp
#include <hip/hip_runtime.h>
#include <cstdio>
#include <cstdint>

#define MK_DIAG 0
#ifndef DENSE8_G1
#define DENSE8_G1 0
#endif
#ifndef DENSE8_G2
#define DENSE8_G2 0
#endif
#ifndef MK_MULTI
#define MK_MULTI 0
#endif

#define LAS __attribute__((address_space(3)))
typedef unsigned short bf16_t;
typedef short bf16x8 __attribute__((ext_vector_type(8)));
typedef short s16x4 __attribute__((ext_vector_type(4)));
typedef float f32x4 __attribute__((ext_vector_type(4)));
typedef float f32x2 __attribute__((ext_vector_type(2)));
typedef float f32x16 __attribute__((ext_vector_type(16)));
typedef unsigned u32x4 __attribute__((ext_vector_type(4)));
typedef unsigned u32x2 __attribute__((ext_vector_type(2)));

constexpr int D = 2048, SEQ = 16384, CTXL = 256, MT = SEQ + CTXL;
constexpr int NE = 64, TOPK = 8, EFF = 512;
constexpr int N_IN0 = 3584, N_QKV0 = 1536, N_IN1 = 6144;
constexpr float EPS = 1e-6f;
constexpr float LAM_INIT = 0.35550907f;
constexpr int SH_BASE = SEQ * 0 + (MT * TOPK) + NE * 256;
constexpr int NSLOT = SH_BASE + MT;
constexpr int NTHREADS = 512;
constexpr int LDS_BYTES = 131072 + 1024;
constexpr int LDS_CTL = 131072;

constexpr size_t al256(size_t x) { return (x + 255) & ~(size_t)255; }
constexpr size_t WS_CTL   = 0;
constexpr size_t CTL_BYTES = 32768;
constexpr size_t CTL_CNT  = 16384;
constexpr size_t CTL_KMAX = 16384 + 2048;
constexpr size_t WS_MOD   = CTL_BYTES;
constexpr size_t WS_WIN0  = al256(WS_MOD + 2 * 2 * 12288 * 4);
constexpr size_t WS_WOUT0 = al256(WS_WIN0 + (size_t)N_IN0 * D * 2);
constexpr size_t WS_WIN1  = al256(WS_WOUT0 + (size_t)D * D * 2);
constexpr size_t WS_WOUT1 = al256(WS_WIN1 + (size_t)N_IN1 * D * 2);
constexpr size_t WMOE_E   = (size_t)1024 * D + (size_t)D * EFF;
constexpr size_t WS_WMOE  = al256(WS_WOUT1 + (size_t)D * D * 2);
constexpr size_t WS_HRES  = al256(WS_WMOE + 65 * WMOE_E * 2);
constexpr size_t WS_ABUF  = al256(WS_HRES + (size_t)MT * D * 4);
constexpr size_t WS_QKVU  = al256(WS_ABUF + (size_t)MT * D * 2);
constexpr size_t WS_HG    = al256(WS_QKVU + (size_t)MT * N_IN1 * 2);
constexpr size_t WS_X2    = al256(WS_HG + (size_t)MT * 1024 * 2);
constexpr size_t WS_OUT   = al256(WS_X2 + (size_t)MT * D * 2);
constexpr size_t WS_ACT   = al256(WS_OUT + (size_t)MT * D * 2);
constexpr size_t WS_K8    = WS_ACT + al256((size_t)NSLOT * EFF);
constexpr size_t WS_Y     = al256(WS_ACT + (size_t)NSLOT * EFF * 2);
constexpr size_t WS_TOPE  = al256(WS_Y + (size_t)NSLOT * D * 2);
constexpr size_t WS_TOPW  = al256(WS_TOPE + (size_t)MT * TOPK * 4);
constexpr size_t WS_TOPP  = al256(WS_TOPW + (size_t)MT * TOPK * 4);
constexpr size_t WS_TSLOT = al256(WS_TOPP + (size_t)MT * TOPK * 4);
constexpr size_t WS_STOK  = al256(WS_TSLOT + (size_t)MT * TOPK * 4);
constexpr size_t WS_END   = al256(WS_STOK + (size_t)NSLOT * 4);

struct Args { const float* in[27]; float* out; unsigned char* ws; int ph_lo, ph_hi; };

__device__ __forceinline__ float bflo(unsigned x) { return __uint_as_float(x << 16); }
__device__ __forceinline__ float bfhi(unsigned x) { return __uint_as_float(x & 0xffff0000u); }
__device__ __forceinline__ float bf2f(bf16_t b) { return __uint_as_float(((unsigned)b) << 16); }
__device__ __forceinline__ unsigned cvtpk(float lo, float hi) { unsigned r; asm("v_cvt_pk_bf16_f32 %0, %1, %2" : "=v"(r) : "v"(lo), "v"(hi)); return r; }
__device__ __forceinline__ bf16_t f2bf(float x) { return (bf16_t)(cvtpk(x, 0.f) & 0xffffu); }
__device__ __forceinline__ float wave_sum(float v) {
#pragma unroll
  for (int o = 32; o; o >>= 1) v += __shfl_xor(v, o);
  return v;
}
__device__ __forceinline__ float sigmoidf_(float x) { return 1.f / (1.f + expf(-x)); }
__device__ __forceinline__ float sigmoid_fast(float x) { return __builtin_amdgcn_rcpf(1.f + __builtin_amdgcn_exp2f(-1.4426950408889634f * x)); }

__device__ __forceinline__ float clamp8e(float x) { return fminf(fmaxf(x, -448.f), 448.f); }
__device__ __forceinline__ unsigned pack8x4(float a, float b, float c, float d) {
  int p = __builtin_amdgcn_cvt_pk_fp8_f32(clamp8e(a), clamp8e(b), 0, false); p = __builtin_amdgcn_cvt_pk_fp8_f32(clamp8e(c), clamp8e(d), p, true); return (unsigned)p; }
__device__ __forceinline__ float sq8x4(unsigned p) {
  const float a = __builtin_amdgcn_cvt_f32_fp8((int)p, 0), b = __builtin_amdgcn_cvt_f32_fp8((int)p, 1), c = __builtin_amdgcn_cvt_f32_fp8((int)p, 2), d = __builtin_amdgcn_cvt_f32_fp8((int)p, 3);
  return a * a + b * b + c * c + d * d; }
typedef int v8i_ __attribute__((ext_vector_type(8)));
typedef int v4i __attribute__((ext_vector_type(4)));
#define XB_TMO      128
#define XB_XCNT(j)  (256  + 64 * (j))
#define XB_XSUB(j)  (1280 + 64 * (j))
#define XB_XGEN(j)  (2304 + 64 * (j))
#define XB_TOP      3328
#define XB_TOPGEN   3392
#define XCD_BAR_WORDS 3456
#define XB_SPIN_CAP (1u << 22)
__device__ __forceinline__ unsigned xb_ld(unsigned* p)              { return __hip_atomic_load(p, __ATOMIC_RELAXED, __HIP_MEMORY_SCOPE_AGENT); }
__device__ __forceinline__ unsigned xb_add(unsigned* p, unsigned v) { return __hip_atomic_fetch_add(p, v, __ATOMIC_RELAXED, __HIP_MEMORY_SCOPE_AGENT); }
__device__ __forceinline__ unsigned xb_xcc_id() { return (unsigned)__builtin_amdgcn_s_getreg((3 << 11) | 20) & 0xFu; }
#define XB_SPIN(cond, bar) do { unsigned _sp = 0; while (cond) { __builtin_amdgcn_s_sleep(1); \
    if ((++_sp & 255u) == 0u) { if (xb_ld(&(bar)[XB_TMO])) break; if (_sp > XB_SPIN_CAP) { atomicAdd(&(bar)[XB_TMO], 1u); break; } } } } while (0)
struct XcdBarrier { unsigned* bar; unsigned x; volatile LAS unsigned* st; };
__device__ __forceinline__ XcdBarrier xcd_barrier_post(unsigned* bar, volatile LAS unsigned* st) {
    XcdBarrier b; b.bar = bar; b.x = xb_xcc_id(); b.st = st;
    if (threadIdx.x == 0) (void)xb_add(&bar[XB_XCNT(b.x)], 1u);
    return b;
}
__device__ __forceinline__ void xcd_barrier_complete(unsigned* bar, unsigned x, unsigned& nloc, unsigned& nx) {
    const unsigned G = gridDim.x * gridDim.y * gridDim.z;
    unsigned sum, cnt, mine, sp = 0u;
    for (;;) {
        sum = 0u; cnt = 0u; mine = 0u;
#pragma unroll
        for (unsigned j = 0; j < 16; ++j) { const unsigned c = xb_ld(&bar[XB_XCNT(j)]); sum += c; cnt += (c > 0u) ? 1u : 0u; mine = (j == x) ? c : mine; }
        if (sum == G) break;
        __builtin_amdgcn_s_sleep(1);
        if ((++sp & 255u) == 0u) { if (xb_ld(&bar[XB_TMO])) break; if (sp > XB_SPIN_CAP) { atomicAdd(&bar[XB_TMO], 1u); break; } }
    }
    nloc = mine > 0u ? mine : 1u; nx = cnt > 0u ? cnt : 1u;
}
__device__ __forceinline__ void xcd_barrier(const XcdBarrier& b) {
    asm volatile("s_waitcnt vmcnt(0)" ::: "memory");
    __syncthreads();
    if (threadIdx.x == 0) {
        unsigned* bar = b.bar;
        __builtin_amdgcn_s_waitcnt(0);
        unsigned nloc = b.st[0], nx = b.st[1];
        if (nloc == 0u) { xcd_barrier_complete(bar, b.x, nloc, nx); b.st[0] = nloc; b.st[1] = nx; }
        const unsigned old = xb_add(&bar[XB_XSUB(b.x)], 1u);
        const unsigned gen = old / nloc;
        if (old + 1u == (gen + 1u) * nloc) {
            __builtin_amdgcn_fence(__ATOMIC_RELEASE, "agent");
            asm volatile("s_waitcnt vmcnt(0)" ::: "memory");
            const unsigned og = xb_add(&bar[XB_TOP], 1u);
            const unsigned tg = og / nx;
            if (og + 1u == (tg + 1u) * nx) xb_add(&bar[XB_TOPGEN], 1u);
            else XB_SPIN(xb_ld(&bar[XB_TOPGEN]) == tg, bar);
            __builtin_amdgcn_fence(__ATOMIC_ACQUIRE, "agent");
            xb_add(&bar[XB_XGEN(b.x)], 1u);
            asm volatile("s_waitcnt vmcnt(0)" ::: "memory");
        } else {
            XB_SPIN(xb_ld(&bar[XB_XGEN(b.x)]) == gen, bar);
            __builtin_amdgcn_fence(__ATOMIC_ACQUIRE, "agent");
            asm volatile("s_waitcnt vmcnt(0)" ::: "memory");
        }
    }
    __syncthreads();
}

__device__ __forceinline__ int lds_byte(int r, int c) {
  int st = (r >> 4) * 2 + (c >> 5), rr = r & 15, cc = c & 31, ob = rr * 64 + cc * 2;
  return st * 1024 + (ob ^ (((ob >> 9) & 1) << 5));
}
#define GLDS(gp, lp) __builtin_amdgcn_global_load_lds((const unsigned*)(gp), (LAS unsigned*)(lp), 16, 0, 0)
#define WAIT_V(n) asm volatile("s_waitcnt vmcnt(" #n ")" ::: "memory")
#define WAIT_L(n) asm volatile("s_waitcnt lgkmcnt(" #n ")" ::: "memory")
#define BAR __builtin_amdgcn_s_barrier()
#define SCHED __builtin_amdgcn_sched_barrier(0)

template <bool GATHER, class Epi>
__device__ __forceinline__ void gemm_tile(const bf16_t* __restrict__ A, const int lda, const int* __restrict__ tok, const int brow,
                                          const bf16_t* __restrict__ Bt, const int ldb, const int bcol, const int K,
                                          LAS char* shm, const Epi& epi) {
#define G_SA(b, h) (shm + ((b) * 2 + (h)) * 16384)
#define G_SB(b, h) (shm + (4 + (b) * 2 + (h)) * 16384)
  int tid = threadIdx.x; asm volatile("" : "+v"(tid)); tid &= 511;
  int wid = tid >> 6, lane = tid & 63, wr = wid >> 2, wc = wid & 3, fr = lane & 15, fq = lane >> 4;
  unsigned ao0, ao1, ao2, ao3, bo;
  {
    const int sb = (tid & 63) * 16, swz = sb ^ (((sb >> 9) & 1) << 5);
    const int R0 = ((tid >> 6) >> 1) * 16 + (swz >> 6), C0 = ((tid >> 6) & 1) * 32 + ((swz & 63) >> 1);
    if (GATHER) { ao0 = (unsigned)(tok[R0] * lda + C0); ao1 = (unsigned)(tok[R0 + 64] * lda + C0); ao2 = (unsigned)(tok[R0 + 128] * lda + C0); ao3 = (unsigned)(tok[R0 + 192] * lda + C0); }
    else { ao0 = (unsigned)((brow + R0) * lda + C0); ao1 = ao0 + 64u * lda; ao2 = ao0 + 128u * lda; ao3 = ao0 + 192u * lda; }
    bo = (unsigned)((bcol + R0) * ldb + C0);
  }
  const int lo = __builtin_amdgcn_readfirstlane(tid >> 6) * 1024;
#define STAGE_A0(P, kt) do { GLDS((A + (kt) * 64) + ao0, (P) + lo); GLDS((A + (kt) * 64) + ao1, (P) + lo + 8192); } while (0)
#define STAGE_A1(P, kt) do { GLDS((A + (kt) * 64) + ao2, (P) + lo); GLDS((A + (kt) * 64) + ao3, (P) + lo + 8192); } while (0)
#define STAGE_B0(P, kt) do { GLDS((Bt + (kt) * 64) + bo, (P) + lo); GLDS((Bt + 64 * ldb + (kt) * 64) + bo, (P) + lo + 8192); } while (0)
#define STAGE_B1(P, kt) do { GLDS((Bt + 128 * ldb + (kt) * 64) + bo, (P) + lo); GLDS((Bt + 192 * ldb + (kt) * 64) + bo, (P) + lo + 8192); } while (0)
#define LDA(dst, b, h) _Pragma("unroll") for (int m = 0; m < 4; ++m) _Pragma("unroll") for (int k = 0; k < 2; ++k) \
    dst[m][k] = *(LAS const bf16x8*)(G_SA(b, h) + lds_byte(wr * 64 + m * 16 + fr, k * 32 + fq * 8))
#define LDB(dst, b, h) _Pragma("unroll") for (int n = 0; n < 2; ++n) _Pragma("unroll") for (int k = 0; k < 2; ++k) \
    dst[n][k] = *(LAS const bf16x8*)(G_SB(b, h) + lds_byte(wc * 32 + n * 16 + fr, k * 32 + fq * 8))
#define MMA(ai, bj, At_, Bt_) do { __builtin_amdgcn_s_setprio(1); \
    _Pragma("unroll") for (int m = 0; m < 4; ++m) _Pragma("unroll") for (int n = 0; n < 2; ++n) _Pragma("unroll") for (int k = 0; k < 2; ++k) \
      acc[ai][bj][m][n] = __builtin_amdgcn_mfma_f32_16x16x32_bf16(Bt_[n][k], At_[m][k], acc[ai][bj][m][n], 0, 0, 0); \
    __builtin_amdgcn_s_setprio(0); } while (0)

  f32x4 acc[2][2][4][2] = {};
  bf16x8 At[4][2], B0[2][2], B1[2][2];
  const int nt = K / 64;
  STAGE_B0(G_SB(0, 0), 0); STAGE_A0(G_SA(0, 0), 0);
  STAGE_B1(G_SB(0, 1), 0); STAGE_A1(G_SA(0, 1), 0);
  if (wr == 1) BAR;
  WAIT_V(4); BAR;
  STAGE_B0(G_SB(1, 0), 1); STAGE_A0(G_SA(1, 0), 1); STAGE_B1(G_SB(1, 1), 1);
  WAIT_V(6); BAR;
  for (int t = 0; t < nt - 2; t += 2) {
    LDB(B0, 0, 0); SCHED; LDA(At, 0, 0); STAGE_A1(G_SA(1, 1), t + 1);
    WAIT_L(8); BAR; WAIT_L(0); MMA(0, 0, At, B0); BAR; SCHED;
    LDB(B1, 0, 1); STAGE_B0(G_SB(0, 0), t + 2);
    BAR; WAIT_L(0); MMA(0, 1, At, B1); BAR;
    LDA(At, 0, 1); STAGE_A0(G_SA(0, 0), t + 2);
    BAR; WAIT_L(0); MMA(1, 0, At, B0); BAR; SCHED;
    STAGE_B1(G_SB(0, 1), t + 2);
    WAIT_V(6); BAR; MMA(1, 1, At, B1); BAR;
    LDB(B0, 1, 0); SCHED; LDA(At, 1, 0); STAGE_A1(G_SA(0, 1), t + 2);
    WAIT_L(8); BAR; WAIT_L(0); MMA(0, 0, At, B0); BAR; SCHED;
    LDB(B1, 1, 1); STAGE_B0(G_SB(1, 0), t + 3);
    BAR; WAIT_L(0); MMA(0, 1, At, B1); BAR;
    LDA(At, 1, 1); STAGE_A0(G_SA(1, 0), t + 3);
    BAR; WAIT_L(0); MMA(1, 0, At, B0); BAR; SCHED;
    STAGE_B1(G_SB(1, 1), t + 3);
    WAIT_V(6); BAR; MMA(1, 1, At, B1); BAR;
  }
  { LDB(B0, 0, 0); WAIT_V(0); LDA(At, 0, 0); STAGE_A1(G_SA(1, 1), nt - 1);
    BAR; WAIT_L(0); MMA(0, 0, At, B0); BAR;
    LDB(B1, 0, 1); BAR; WAIT_L(0); MMA(0, 1, At, B1); BAR;
    LDA(At, 0, 1); WAIT_V(4); BAR; WAIT_L(0); MMA(1, 0, At, B0); MMA(1, 1, At, B1); BAR; }
  { LDB(B0, 1, 0); LDA(At, 1, 0); WAIT_V(2); BAR; WAIT_L(0); MMA(0, 0, At, B0); BAR;
    LDB(B1, 1, 1); WAIT_V(0); BAR; WAIT_L(0); MMA(0, 1, At, B1); BAR;
    LDA(At, 1, 1); BAR; WAIT_L(0); MMA(1, 0, At, B0); MMA(1, 1, At, B1); BAR; }
  if (wr == 0) BAR;
  int tz = threadIdx.x; asm volatile("" : "+v"(tz)); wid = tz >> 6; lane = tz & 63; wr = wid >> 2; wc = wid & 3; fr = lane & 15; fq = lane >> 4;
  epi(acc, brow, bcol, wr, wc, fr, fq);
#undef G_SA
#undef G_SB
#undef STAGE_A0
#undef STAGE_A1
#undef STAGE_B0
#undef STAGE_B1
#undef LDA
#undef LDB
#undef MMA
}

struct EpiPlain {
  bf16_t* C; int ldc; float sc;
  __device__ __forceinline__ void operator()(const f32x4 (&acc)[2][2][4][2], int brow, int bcol, int wr, int wc, int fr, int fq) const {
#pragma unroll
    for (int ai = 0; ai < 2; ++ai)
#pragma unroll
      for (int m = 0; m < 4; ++m) {
        bf16_t* rp = C + (size_t)(brow + ai * 128 + wr * 64 + m * 16 + fr) * ldc + bcol + wc * 32 + fq * 8;
#pragma unroll
        for (int bj = 0; bj < 2; ++bj) {
          u32x4 v = {cvtpk(acc[ai][bj][m][0][0] * sc, acc[ai][bj][m][0][1] * sc), cvtpk(acc[ai][bj][m][0][2] * sc, acc[ai][bj][m][0][3] * sc),
                     cvtpk(acc[ai][bj][m][1][0] * sc, acc[ai][bj][m][1][1] * sc), cvtpk(acc[ai][bj][m][1][2] * sc, acc[ai][bj][m][1][3] * sc)};
          *(u32x4*)(rp + bj * 128) = v;
        }
      }
  }
};
template <int MODE>
struct EpiPair {
  bf16_t* C; int ldc; int colbase; float sc;
  __device__ __forceinline__ void operator()(const f32x4 (&acc)[2][2][4][2], int brow, int bcol, int wr, int wc, int fr, int fq) const {
#pragma unroll
    for (int ai = 0; ai < 2; ++ai)
#pragma unroll
      for (int m = 0; m < 4; ++m) {
        bf16_t* rp = C + (size_t)(brow + ai * 128 + wr * 64 + m * 16 + fr) * ldc + ((bcol - colbase) >> 1) + wc * 16 + fq * 4;
#pragma unroll
        for (int bj = 0; bj < 2; ++bj) {
          float r[4];
#pragma unroll
          for (int j = 0; j < 4; ++j) {
            const float x0 = acc[ai][bj][m][0][j] * sc, x1 = acc[ai][bj][m][1][j] * sc;
            r[j] = MODE == 0 ? x0 * sigmoid_fast(x1) : x0 * sigmoid_fast(x0) * x1;
          }
          u32x2 v = {cvtpk(r[0], r[1]), cvtpk(r[2], r[3])};
          *(u32x2*)(rp + bj * 64) = v;
        }
      }
  }
};
struct EpiG1 {
  EpiPlain p; EpiPair<0> g; int nplain;
  __device__ __forceinline__ void operator()(const f32x4 (&acc)[2][2][4][2], int brow, int bcol, int wr, int wc, int fr, int fq) const {
    if (bcol < nplain) p(acc, brow, bcol, wr, wc, fr, fq); else g(acc, brow, bcol, wr, wc, fr, fq);
  }
};

typedef int v8i __attribute__((ext_vector_type(8)));
__device__ __forceinline__ int lds8(int r, int c) { return r * 128 + ((c ^ ((r >> 1) & 7)) << 4); }
template <bool GATHER, int lda, int ldb, int K, class Epi, class S>
__device__ __forceinline__ void gemm8_run(const unsigned char* __restrict__ A, const int* __restrict__ stok,
                                          LAS char* shm, const Epi& epi, const S& sched) {
#define G_SA(b, h) (shm + ((b) * 2 + (h)) * 16384)
#define G_SB(b, h) (shm + (4 + (b) * 2 + (h)) * 16384)
  int tid = threadIdx.x; asm volatile("" : "+v"(tid)); tid &= 511;
  int wid = tid >> 6, lane = tid & 63, wr = wid >> 2, wc = wid & 3, fr = lane & 15, fq = lane >> 4;
  unsigned ao0, ao1, ao2, ao3, bo;
  int R0 = 8 * wid + (lane >> 3), C0 = ((lane & 7) ^ ((R0 >> 1) & 7)) << 4;
  const int lo = __builtin_amdgcn_readfirstlane(tid >> 6) * 1024;
  int brow, bcol; const unsigned char* Bt;
  int ui = 0;
  if (!sched.unit(ui, brow, Bt, bcol)) return;
#define SETOFF(br, bc) do { if (GATHER) { const int* _t = stok + (br); ao0 = (unsigned)(_t[R0] * lda + C0); ao1 = (unsigned)(_t[R0 + 64] * lda + C0); ao2 = (unsigned)(_t[R0 + 128] * lda + C0); ao3 = (unsigned)(_t[R0 + 192] * lda + C0); } \
    else { ao0 = (unsigned)(((br) + R0) * lda + C0); ao1 = ao0 + 64u * lda; ao2 = ao0 + 128u * lda; ao3 = ao0 + 192u * lda; } \
    bo = (unsigned)(((bc) + R0) * ldb + C0); } while (0)
#define STAGE_A0(P, kt) do { GLDS((A + (kt) * 128) + ao0, (P) + lo); GLDS((A + (kt) * 128) + ao1, (P) + lo + 8192); } while (0)
#define STAGE_A1(P, kt) do { GLDS((A + (kt) * 128) + ao2, (P) + lo); GLDS((A + (kt) * 128) + ao3, (P) + lo + 8192); } while (0)
#define STAGE_B0(P, kt) do { GLDS((Bt + (kt) * 128) + bo, (P) + lo); GLDS((Bt + 64 * ldb + (kt) * 128) + bo, (P) + lo + 8192); } while (0)
#define STAGE_B1(P, kt) do { GLDS((Bt + 128 * ldb + (kt) * 128) + bo, (P) + lo); GLDS((Bt + 192 * ldb + (kt) * 128) + bo, (P) + lo + 8192); } while (0)
#define PRO() do { STAGE_B0(G_SB(0, 0), 0); STAGE_A0(G_SA(0, 0), 0); STAGE_B1(G_SB(0, 1), 0); STAGE_A1(G_SA(0, 1), 0); } while (0)
  const int fx = (fq ^ ((fr >> 1) & 7)) << 4;
  const int fa0 = (wr * 64 + fr) * 128 + fx, fb0 = (wc * 32 + fr) * 128 + fx;
#define FRAG8(dst, p0, p1) do { const v4i _x = *(LAS const v4i*)(p0); const v4i _y = *(LAS const v4i*)(p1); \
    dst = (v8i){_x[0], _x[1], _x[2], _x[3], _y[0], _y[1], _y[2], _y[3]}; } while (0)
#define LDA(dst, b, h) do { int fa1 = fa0; asm volatile("v_xor_b32 %0, 64, %0" : "+v"(fa1)); \
    _Pragma("unroll") for (int m = 0; m < 4; ++m) FRAG8(dst[m], G_SA(b, h) + fa0 + m * 2048, G_SA(b, h) + fa1 + m * 2048); } while (0)
#define LDB(dst, b, h) do { int fb1 = fb0; asm volatile("v_xor_b32 %0, 64, %0" : "+v"(fb1)); \
    _Pragma("unroll") for (int n = 0; n < 2; ++n) FRAG8(dst[n], G_SB(b, h) + fb0 + n * 2048, G_SB(b, h) + fb1 + n * 2048); } while (0)
#define MMA(ai, bj, At_, Bt_) do { __builtin_amdgcn_s_setprio(1); \
    _Pragma("unroll") for (int m = 0; m < 4; ++m) _Pragma("unroll") for (int n = 0; n < 2; ++n) \
      asm volatile("v_mfma_scale_f32_16x16x128_f8f6f4 %0, %1, %2, %0, %3, %3 op_sel_hi:[0,0,0]" : "+v"(acc[ai][bj][m][n]) : "v"(Bt_[n]), "v"(At_[m]), "v"(sc1)); \
    __builtin_amdgcn_s_setprio(0); } while (0)
  int sc1; asm volatile("v_mov_b32 %0, 0x7f7f7f7f" : "=v"(sc1));
  const int nt = K / 128;
  SETOFF(brow, bcol); PRO();
  bool first = true;
  for (;;) {
    f32x4 acc[2][2][4][2] = {};
    v8i At[4], B0[2], B1[2];
    if (wr == 1) BAR;
    if (first) WAIT_V(4); else WAIT_V(0);
    BAR;
    STAGE_B0(G_SB(1, 0), 1); STAGE_A0(G_SA(1, 0), 1); STAGE_B1(G_SB(1, 1), 1);
    WAIT_V(6); BAR;
    for (int t = 0; t < nt - 2; t += 2) {
      LDB(B0, 0, 0); SCHED; LDA(At, 0, 0); STAGE_A1(G_SA(1, 1), t + 1);
      WAIT_L(8); BAR; WAIT_L(0); MMA(0, 0, At, B0); BAR; SCHED;
      LDB(B1, 0, 1); STAGE_B0(G_SB(0, 0), t + 2);
      BAR; WAIT_L(0); MMA(0, 1, At, B1); BAR;
      LDA(At, 0, 1); STAGE_A0(G_SA(0, 0), t + 2);
      BAR; WAIT_L(0); MMA(1, 0, At, B0); BAR; SCHED;
      STAGE_B1(G_SB(0, 1), t + 2);
      WAIT_V(6); BAR; MMA(1, 1, At, B1); BAR;
      LDB(B0, 1, 0); SCHED; LDA(At, 1, 0); STAGE_A1(G_SA(0, 1), t + 2);
      WAIT_L(8); BAR; WAIT_L(0); MMA(0, 0, At, B0); BAR; SCHED;
      LDB(B1, 1, 1); STAGE_B0(G_SB(1, 0), t + 3);
      BAR; WAIT_L(0); MMA(0, 1, At, B1); BAR;
      LDA(At, 1, 1); STAGE_A0(G_SA(1, 0), t + 3);
      BAR; WAIT_L(0); MMA(1, 0, At, B0); BAR; SCHED;
      STAGE_B1(G_SB(1, 1), t + 3);
      WAIT_V(6); BAR; MMA(1, 1, At, B1); BAR;
    }
    { LDB(B0, 0, 0); WAIT_V(0); LDA(At, 0, 0); STAGE_A1(G_SA(1, 1), nt - 1);
      BAR; WAIT_L(0); MMA(0, 0, At, B0); BAR;
      LDB(B1, 0, 1); BAR; WAIT_L(0); MMA(0, 1, At, B1); BAR;
      LDA(At, 0, 1); WAIT_V(4); BAR; WAIT_L(0); MMA(1, 0, At, B0); MMA(1, 1, At, B1); BAR; }
    { LDB(B0, 1, 0); LDA(At, 1, 0); WAIT_V(2); BAR; WAIT_L(0); MMA(0, 0, At, B0); BAR;
      LDB(B1, 1, 1); WAIT_V(0); BAR; WAIT_L(0); MMA(0, 1, At, B1); BAR;
      LDA(At, 1, 1); BAR; WAIT_L(0); MMA(1, 0, At, B0); MMA(1, 1, At, B1); BAR; }
    if (wr == 0) BAR;
    const int cbrow = brow, cbcol = bcol;
    { int tz = threadIdx.x; asm volatile("" : "+v"(tz)); tz &= 511; wid = tz >> 6; lane = tz & 63; wr = wid >> 2; wc = wid & 3; fr = lane & 15; fq = lane >> 4;
      R0 = 8 * wid + (lane >> 3); C0 = ((lane & 7) ^ ((R0 >> 1) & 7)) << 4; }
    ++ui;
    const bool more = sched.unit(ui, brow, Bt, bcol);
    if (more) { SETOFF(brow, bcol); asm volatile("" ::: "memory"); PRO(); asm volatile("" ::: "memory"); }
    asm volatile("s_nop 15\n\ts_nop 15\n\ts_nop 7" ::: "memory");
#pragma unroll
    for (int i = 0; i < 32; ++i) asm volatile("" : "+v"((&acc[0][0][0][0])[i]));
    epi(acc, cbrow, cbcol, wr, wc, fr, fq);
    if (!more) break;
    first = false;
  }
#undef G_SA
#undef G_SB
#undef SETOFF
#undef STAGE_A0
#undef STAGE_A1
#undef STAGE_B0
#undef STAGE_B1
#undef PRO
#undef FRAG8
#undef LDA
#undef LDB
#undef MMA
}
__device__ __forceinline__ float clamp8(float x) { return fminf(fmaxf(x, -448.f), 448.f); }
__device__ __forceinline__ unsigned pack_fp8x4(float a, float b, float c, float d) {
  int p = __builtin_amdgcn_cvt_pk_fp8_f32(clamp8(a), clamp8(b), 0, false); p = __builtin_amdgcn_cvt_pk_fp8_f32(clamp8(c), clamp8(d), p, true); return (unsigned)p; }
struct EpiSwiGLU8 {
  unsigned char* C; int ldc;
  __device__ __forceinline__ void operator()(const f32x4 (&acc)[2][2][4][2], int brow, int bcol, int wr, int wc, int fr, int fq) const {
    constexpr float S = 1.f / 256.f;
#pragma unroll
    for (int ai = 0; ai < 2; ++ai)
#pragma unroll
      for (int m = 0; m < 4; ++m) {
        unsigned char* rp = C + (size_t)(brow + ai * 128 + wr * 64 + m * 16 + fr) * ldc + (bcol >> 1) + wc * 16 + fq * 4;
#pragma unroll
        for (int bj = 0; bj < 2; ++bj) {
          float r[4];
#pragma unroll
          for (int j = 0; j < 4; ++j) { const float g = acc[ai][bj][m][0][j] * S, u = acc[ai][bj][m][1][j] * S; r[j] = g * sigmoid_fast(g) * u; }
          *(unsigned*)(rp + bj * 64) = pack_fp8x4(r[0], r[1], r[2], r[3]);
        }
      }
  }
};
struct EpiPlain8 {
  unsigned char* C; int ldc; float sc;
  __device__ __forceinline__ void operator()(const f32x4 (&acc)[2][2][4][2], int brow, int bcol, int wr, int wc, int fr, int fq) const {
#pragma unroll
    for (int ai = 0; ai < 2; ++ai)
#pragma unroll
      for (int m = 0; m < 4; ++m) {
        unsigned char* rp = C + (size_t)(brow + ai * 128 + wr * 64 + m * 16 + fr) * ldc + bcol + wc * 32 + fq * 8;
#pragma unroll
        for (int bj = 0; bj < 2; ++bj) {
          u32x2 v = {pack_fp8x4(acc[ai][bj][m][0][0] * sc, acc[ai][bj][m][0][1] * sc, acc[ai][bj][m][0][2] * sc, acc[ai][bj][m][0][3] * sc),
                     pack_fp8x4(acc[ai][bj][m][1][0] * sc, acc[ai][bj][m][1][1] * sc, acc[ai][bj][m][1][2] * sc, acc[ai][bj][m][1][3] * sc)};
          *(u32x2*)(rp + bj * 128) = v;
        }
      }
  }
};
struct EpiPlainS {
  bf16_t* C; int ldc; float sc;
  __device__ __forceinline__ void operator()(const f32x4 (&acc)[2][2][4][2], int brow, int bcol, int wr, int wc, int fr, int fq) const {
#pragma unroll
    for (int ai = 0; ai < 2; ++ai)
#pragma unroll
      for (int m = 0; m < 4; ++m) {
        bf16_t* rp = C + (size_t)(brow + ai * 128 + wr * 64 + m * 16 + fr) * ldc + bcol + wc * 32 + fq * 8;
#pragma unroll
        for (int bj = 0; bj < 2; ++bj) {
          u32x4 v = {cvtpk(acc[ai][bj][m][0][0] * sc, acc[ai][bj][m][0][1] * sc), cvtpk(acc[ai][bj][m][0][2] * sc, acc[ai][bj][m][0][3] * sc),
                     cvtpk(acc[ai][bj][m][1][0] * sc, acc[ai][bj][m][1][1] * sc), cvtpk(acc[ai][bj][m][1][2] * sc, acc[ai][bj][m][1][3] * sc)};
          *(u32x4*)(rp + bj * 128) = v;
        }
      }
  }
};

__device__ __forceinline__ void dense_unit(int u, int nM, int nN, int& pm, int& pn) {
  const int nwg = nM * nN, NX = 8, WGM = 8;
  int wgid = u;
  { const int q = nwg / NX, r = nwg % NX, xcd = wgid % NX, off = wgid / NX; wgid = (xcd < r ? xcd * (q + 1) : r * (q + 1) + (xcd - r) * q) + off; }
  const int nig = WGM * nN, gid = wgid / nig, fm = gid * WGM, gsz = min(nM - fm, WGM);
  pm = fm + ((wgid % nig) % gsz); pn = (wgid % nig) / gsz;
}

namespace at {
constexpr int DH = 128, NW = 8, QBLK = 32, KVBLK = 64;
constexpr float SCALE = 0.088388347648318440f;
constexpr float QC = SCALE * 1.4426950408889634f;
constexpr int SHM_V = KVBLK * DH * 2, SHM_K = KVBLK * DH * 2;
#define KSWZ(row, colB) ((row) * 256 + ((colB) ^ (((row) & 7) << 4)))
__device__ __forceinline__ int crow(int r, int hi) { return (r & 3) + 8 * (r >> 2) + 4 * hi; }
__device__ __forceinline__ unsigned cvtpkv(float lo, float hi) { unsigned r; asm volatile("v_cvt_pk_bf16_f32 %0, %1, %2" : "=v"(r) : "v"(lo), "v"(hi)); return r; }
#define PK4(P, BASE, OUT) do { unsigned a0 = cvtpkv(P[BASE + 0], P[BASE + 1]), a1 = cvtpkv(P[BASE + 2], P[BASE + 3]);   \
    unsigned b0 = cvtpkv(P[BASE + 4], P[BASE + 5]), b1 = cvtpkv(P[BASE + 6], P[BASE + 7]);                              \
    auto r0 = __builtin_amdgcn_permlane32_swap(a0, b0, false, false); auto r1 = __builtin_amdgcn_permlane32_swap(a1, b1, false, false); \
    u32x4 w = {r0[0], r1[0], r0[1], r1[1]}; OUT = *reinterpret_cast<bf16x8*>(&w); } while (0)
__device__ __forceinline__ float load_q(const bf16_t* __restrict__ Qw, bf16x8 (&qr)[8], float kmax2) {
  float ss = 0;
#pragma unroll
  for (int d0 = 0; d0 < 8; ++d0) {
    const u32x4 raw = *reinterpret_cast<const u32x4*>(Qw + d0 * 16); u32x4 o;
#pragma unroll
    for (int i = 0; i < 4; ++i) { const unsigned pk = cvtpk(bflo(raw[i]) * QC, bfhi(raw[i]) * QC); o[i] = pk; const float a = bflo(pk), b = bfhi(pk); ss += a * a + b * b; }
    qr[d0] = *reinterpret_cast<bf16x8*>(&o);
  }
  { auto rr = __builtin_amdgcn_permlane32_swap(__float_as_uint(ss), __float_as_uint(ss), false, false); ss = __uint_as_float(rr[0]) + __uint_as_float(rr[1]); }
  return -(sqrtf(ss * kmax2) * 1.01f + 1e-3f);
}
__device__ __forceinline__ void exp16(f32x16& p) {
#pragma unroll
  for (int r = 0; r < 16; ++r) p[r] = __builtin_amdgcn_exp2f(p[r]);
}
__device__ __forceinline__ float sum16(const f32x16& p) { float s = 0;
#pragma unroll
  for (int r = 0; r < 16; ++r) s += p[r];
  return s; }
__device__ __forceinline__ void qkt(f32x16& p0, f32x16& p1, LAS const char* Ks, const bf16x8* qr, int r32, int hi, float nmc) {
#pragma unroll
  for (int r = 0; r < 16; ++r) { p0[r] = nmc; p1[r] = nmc; }
#pragma unroll
  for (int d0 = 0; d0 < 8; ++d0) { int cb = (d0 * 16 + hi * 8) * 2;
    bf16x8 b0 = *(LAS const bf16x8*)(Ks + KSWZ(r32, cb));
    bf16x8 b1 = *(LAS const bf16x8*)(Ks + KSWZ(32 + r32, cb));
    p0 = __builtin_amdgcn_mfma_f32_32x32x16_bf16(b0, qr[d0], p0, 0, 0, 0);
    p1 = __builtin_amdgcn_mfma_f32_32x32x16_bf16(b1, qr[d0], p1, 0, 0, 0); }
}
__device__ __forceinline__ int v_st(int k, int c) { const int kk = (k & ~0xC) | ((k & 4) << 1) | ((k & 8) >> 1); return ((kk >> 3) * 4 + (c >> 5)) * 512 + ((kk & 7) * 32 + (c & 31)) * 2; }
__device__ __forceinline__ int v_st256(int k, int c) { const int kk = (k & ~0xC) | ((k & 4) << 1) | ((k & 8) >> 1); return ((kk >> 3) * 8 + (c >> 5)) * 512 + ((kk & 7) * 32 + (c & 31)) * 2; }
__device__ __forceinline__ int v_rd_base(int lane) { return ((lane & 3) << 3) | (((lane >> 2) & 3) << 6) | (((lane >> 4) & 1) << 5) | (((lane >> 5) & 1) << 8); }
template <int OFF> __device__ __forceinline__ s16x4 tr_read(int vb) {
  s16x4 r; asm volatile("ds_read_b64_tr_b16 %0, %1 offset:%2" : "=&v"(r) : "v"(vb), "i"(OFF) : "memory"); return r;
}
template <int BASE, int KS, int HS> __device__ __forceinline__ void pv_one(f32x16& od, int vb, bf16x8 pa0, bf16x8 pa1, bf16x8 pa2, bf16x8 pa3) {
  const s16x4 l0 = tr_read<BASE>(vb), h0 = tr_read<BASE + HS>(vb), l1 = tr_read<BASE + KS>(vb), h1 = tr_read<BASE + KS + HS>(vb);
  const s16x4 l2 = tr_read<BASE + 2 * KS>(vb), h2 = tr_read<BASE + 2 * KS + HS>(vb), l3 = tr_read<BASE + 3 * KS>(vb), h3 = tr_read<BASE + 3 * KS + HS>(vb);
  asm volatile("s_waitcnt lgkmcnt(0)" ::: "memory"); SCHED;
#define PK(L, H) (bf16x8){L[0], L[1], L[2], L[3], H[0], H[1], H[2], H[3]}
  od = __builtin_amdgcn_mfma_f32_32x32x16_bf16(pa0, PK(l0, h0), od, 0, 0, 0);
  od = __builtin_amdgcn_mfma_f32_32x32x16_bf16(pa1, PK(l1, h1), od, 0, 0, 0);
  od = __builtin_amdgcn_mfma_f32_32x32x16_bf16(pa2, PK(l2, h2), od, 0, 0, 0);
  od = __builtin_amdgcn_mfma_f32_32x32x16_bf16(pa3, PK(l3, h3), od, 0, 0, 0);
#undef PK
}
__device__ __forceinline__ void pv_d0(f32x16* o, int vb, bf16x8 pa0, bf16x8 pa1, bf16x8 pa2, bf16x8 pa3) {
  pv_one<0, 4096, 2048>(o[0], vb, pa0, pa1, pa2, pa3); pv_one<512, 4096, 2048>(o[1], vb, pa0, pa1, pa2, pa3);
  pv_one<1024, 4096, 2048>(o[2], vb, pa0, pa1, pa2, pa3); pv_one<1536, 4096, 2048>(o[3], vb, pa0, pa1, pa2, pa3);
}
__device__ __forceinline__ void pv_d0_256(f32x16* o, int vb, bf16x8 pa0, bf16x8 pa1, bf16x8 pa2, bf16x8 pa3) {
  pv_one<0, 8192, 4096>(o[0], vb, pa0, pa1, pa2, pa3); pv_one<512, 8192, 4096>(o[1], vb, pa0, pa1, pa2, pa3);
  pv_one<1024, 8192, 4096>(o[2], vb, pa0, pa1, pa2, pa3); pv_one<1536, 8192, 4096>(o[3], vb, pa0, pa1, pa2, pa3);
}
__device__ __forceinline__ void store_o8(const f32x16* o, float l_tot, LAS float* li, unsigned char* __restrict__ Ow, int ldo, int r32, int hi) {
  if (hi == 0) li[r32] = l_tot; asm volatile("s_waitcnt lgkmcnt(0)" ::: "memory");
  float rli[16];
#pragma unroll
  for (int r = 0; r < 16; ++r) rli[r] = 8.f * __builtin_amdgcn_rcpf(li[crow(r, hi)]);
#pragma unroll
  for (int r = 0; r < 16; ++r) { const int orow = crow(r, hi);
#pragma unroll
    for (int d0 = 0; d0 < 4; ++d0) Ow[(long)orow * ldo + d0 * 32 + r32] = (unsigned char)__builtin_amdgcn_cvt_pk_fp8_f32(o[d0][r] * rli[r], 0.f, 0, false); }
}
__device__ __forceinline__ void store_o(const f32x16* o, float l_tot, LAS float* li, bf16_t* __restrict__ Ow, int ldo, int r32, int hi) {
  if (hi == 0) li[r32] = l_tot; asm volatile("s_waitcnt lgkmcnt(0)" ::: "memory");
  float rli[16];
#pragma unroll
  for (int r = 0; r < 16; ++r) rli[r] = __builtin_amdgcn_rcpf(li[crow(r, hi)]);
#pragma unroll
  for (int r = 0; r < 16; ++r) { const int orow = crow(r, hi);
#pragma unroll
    for (int d0 = 0; d0 < 4; ++d0) Ow[(long)orow * ldo + d0 * 32 + r32] = f2bf(o[d0][r] * rli[r]); }
}

__device__ __forceinline__ int unswap23(int kk) { return (kk & ~0xC) | ((kk & 4) << 1) | ((kk & 8) >> 1); }
__device__ __forceinline__ int k_dma_voff(int wid, int lane, int ldk) {
  const int row = 4 * wid + (lane >> 4); return row * ldk * 2 + (((lane & 15) * 16) ^ ((row & 7) << 4)); }
#define DMA16(rs, ldsp, voff, soff) __builtin_amdgcn_raw_ptr_buffer_load_lds(rs, (LAS void*)(ldsp), 16, voff, soff, 0, 0)

constexpr int SHM_T = SHM_K + SHM_V;
__device__ __forceinline__ void attn_body(const bf16_t* __restrict__ Qb, const int ldq, const bf16_t* __restrict__ Kh, const bf16_t* __restrict__ Vh, const int ldk,
                                          bf16_t* __restrict__ Ob, const int ldo, const int seq, const float kmax2, LAS char* lds) {
  int tid = threadIdx.x; asm volatile("" : "+v"(tid)); tid &= 511;
  const int wid = tid >> 6, lane = tid & 63, r32 = lane & 31, hi = lane >> 5;
  LAS float* li_l = (LAS float*)(lds + 3 * SHM_T) + wid * 64;
  float l_reg = 0; f32x16 o[4] = {}; bf16x8 qr[8];
  const float nmc = load_q(Qb + (long)(wid * QBLK + r32) * ldq + hi * 8, qr, kmax2);
  const int vrb = v_rd_base(lane);
  const int kvo = k_dma_voff(wid, lane, ldk);
  const int vvo = unswap23(8 * (wid >> 1) + ((lane & 31) >> 2)) * ldk * 2 + ((2 * (wid & 1) + (lane >> 5)) * 32 + (lane & 3) * 8) * 2;
  const int l32 = 64 * ldk, pz = wid * 1024;
  const __amdgpu_buffer_rsrc_t krs = __builtin_amdgcn_make_buffer_rsrc((void*)Kh, 0, 0x7ffffff0, 0x00020000);
  const __amdgpu_buffer_rsrc_t vrs = __builtin_amdgcn_make_buffer_rsrc((void*)Vh, 0, 0x7ffffff0, 0x00020000);
#define TDMA(slot, k0) do { const int _o = (k0) * ldk * 2; LAS char* _b = lds + (slot) * SHM_T + pz; \
    DMA16(krs, _b, kvo, _o); DMA16(krs, _b + 8192, kvo, _o + l32); DMA16(vrs, _b + SHM_K, vvo, _o); DMA16(vrs, _b + SHM_K + 8192, vvo, _o + l32); } while (0)
#define VM0() asm volatile("s_waitcnt vmcnt(0)" ::: "memory")
#define FINISH(P0, P1) do { exp16(P1); l_reg += sum16(P0) + sum16(P1); PK4(P0, 0, pa0); PK4(P0, 8, pa1); PK4(P1, 0, pa2); PK4(P1, 8, pa3); } while (0)
  f32x16 pA0, pA1, pB0, pB1; bf16x8 pa0, pa1, pa2, pa3; const int NT = seq / KVBLK;
  TDMA(0, 0); VM0(); __syncthreads();
  TDMA(1, KVBLK);
  qkt(pA0, pA1, lds, qr, r32, hi, nmc); exp16(pA0);
  VM0(); __syncthreads();
  int sk = 1, sv = 0, sd = 2;
  for (int j = 1; j + 1 < NT; j += 2) {
    TDMA(sd, (j + 1) * KVBLK);
    SCHED; qkt(pB0, pB1, lds + sk * SHM_T, qr, r32, hi, nmc);
    FINISH(pA0, pA1); SCHED;
    pv_d0(o, (int)(uintptr_t)(lds + sv * SHM_T + SHM_K) + vrb, pa0, pa1, pa2, pa3); exp16(pB0);
    VM0(); __syncthreads();
    { const int t = sv; sv = sk; sk = sd; sd = t; }
    if (j + 2 < NT) TDMA(sd, (j + 2) * KVBLK);
    SCHED; qkt(pA0, pA1, lds + sk * SHM_T, qr, r32, hi, nmc);
    FINISH(pB0, pB1); SCHED;
    pv_d0(o, (int)(uintptr_t)(lds + sv * SHM_T + SHM_K) + vrb, pa0, pa1, pa2, pa3); exp16(pA0);
    VM0(); __syncthreads();
    { const int t = sv; sv = sk; sk = sd; sd = t; }
  }
  SCHED; qkt(pB0, pB1, lds + sk * SHM_T, qr, r32, hi, nmc);
  FINISH(pA0, pA1); SCHED;
  pv_d0(o, (int)(uintptr_t)(lds + sv * SHM_T + SHM_K) + vrb, pa0, pa1, pa2, pa3); exp16(pB0);
  FINISH(pB0, pB1); SCHED;
  pv_d0(o, (int)(uintptr_t)(lds + sk * SHM_T + SHM_K) + vrb, pa0, pa1, pa2, pa3);
  { auto rr = __builtin_amdgcn_permlane32_swap(__float_as_uint(l_reg), __float_as_uint(l_reg), false, false); l_reg = __uint_as_float(rr[0]) + __uint_as_float(rr[1]); }
  store_o(o, l_reg, li_l, Ob + (long)(wid * QBLK) * ldo, ldo, r32, hi);
  VM0();
  __syncthreads();
#undef TDMA
#undef FINISH
}

constexpr int SHM_V2 = KVBLK * 256 * 2;
__device__ __forceinline__ void attn_body_dv256(const bf16_t* __restrict__ Qb, const int ldq, const bf16_t* __restrict__ Kh, const bf16_t* __restrict__ Vh, const int ldk,
                                                bf16_t* __restrict__ Ob, const int ldo, const int seq, const float kmax2, LAS char* lds) {
  int tid = threadIdx.x; asm volatile("" : "+v"(tid)); tid &= 511;
  const int wid = tid >> 6, lane = tid & 63, r32 = lane & 31, hi = lane >> 5, rg = wid >> 1, kh = wid & 1;
  LAS char* K_lds = lds; LAS char* V_lds = lds + 2 * SHM_K; LAS char* X_lds = lds + 2 * SHM_K + 2 * SHM_V2;
  float l_reg = 0; f32x16 o[4] = {}; bf16x8 qr[8];
  const float nmc = load_q(Qb + (long)(rg * QBLK + r32) * ldq + hi * 8, qr, kmax2);
  const int vb0 = (int)(uintptr_t)V_lds + v_rd_base(lane) + kh * 2048;
  const int kvo = k_dma_voff(wid, lane, ldk);
  const int vvo = unswap23(8 * (wid >> 2) + ((lane & 31) >> 2)) * ldk * 2 + ((2 * (wid & 3) + (lane >> 5)) * 32 + (lane & 3) * 8) * 2;
  const int l32 = 64 * ldk, l16 = 32 * ldk, pz = wid * 1024;
  const int xw = (rg * 4 + kh * 2) * 1024 + lane * 16, xr = rg * 4096 + lane * 16;
  const __amdgpu_buffer_rsrc_t krs = __builtin_amdgcn_make_buffer_rsrc((void*)Kh, 0, 0x7ffffff0, 0x00020000);
  const __amdgpu_buffer_rsrc_t vrs = __builtin_amdgcn_make_buffer_rsrc((void*)Vh, 0, 0x7ffffff0, 0x00020000);
#define KDMA(b, k0) do { const int _o = (k0) * ldk * 2; LAS char* _b = K_lds + (b) * SHM_K + pz; DMA16(krs, _b, kvo, _o); DMA16(krs, _b + 8192, kvo, _o + l32); } while (0)
#define VDMA(b, k0) do { const int _o = (k0) * ldk * 2; LAS char* _b = V_lds + (b) * SHM_V2 + pz; DMA16(vrs, _b, vvo, _o); DMA16(vrs, _b + 8192, vvo, _o + l16); \
    DMA16(vrs, _b + 16384, vvo, _o + 2 * l16); DMA16(vrs, _b + 24576, vvo, _o + 3 * l16); } while (0)
  f32x16 pA, pB; bf16x8 pa0, pa1, pa2, pa3, own0, own1; const int NT = seq / KVBLK;
  const int kxor = ((32 * kh + r32) & 7) << 4, krb = (32 * kh + r32) * 256;
#define QKHALF(P, b) do { _Pragma("unroll") for (int r = 0; r < 16; ++r) P[r] = nmc; \
    _Pragma("unroll") for (int d0 = 0; d0 < 8; ++d0) { const bf16x8 bk = *(LAS const bf16x8*)(K_lds + (b) * SHM_K + krb + (((d0 * 16 + hi * 8) * 2) ^ kxor)); \
      P = __builtin_amdgcn_mfma_f32_32x32x16_bf16(bk, qr[d0], P, 0, 0, 0); } } while (0)
#define FINH(P) do { exp16(P); l_reg += sum16(P); PK4(P, 0, own0); PK4(P, 8, own1); } while (0)
#define XWRITE(b) do { *(LAS bf16x8*)(X_lds + (b) * 16384 + xw) = own0; *(LAS bf16x8*)(X_lds + (b) * 16384 + xw + 1024) = own1; } while (0)
#define XREAD(b) do { pa0 = *(LAS const bf16x8*)(X_lds + (b) * 16384 + xr); pa1 = *(LAS const bf16x8*)(X_lds + (b) * 16384 + xr + 1024); \
    pa2 = *(LAS const bf16x8*)(X_lds + (b) * 16384 + xr + 2048); pa3 = *(LAS const bf16x8*)(X_lds + (b) * 16384 + xr + 3072); } while (0)
#define STEP(PA, PB, b, j) do { \
    SCHED; if ((j) + 1 < NT) QKHALF(PB, (b) ^ 1); FINH(PA); SCHED; \
    XWRITE(b); VM0(); __syncthreads(); \
    if ((j) + 3 < NT) KDMA((b) ^ 1, ((j) + 3) * KVBLK); if ((j) + 1 < NT) VDMA((b) ^ 1, ((j) + 1) * KVBLK); \
    XREAD(b); \
    pv_d0_256(o, vb0 + (b) * SHM_V2, pa0, pa1, pa2, pa3); } while (0)
  KDMA(0, 0); KDMA(1, KVBLK); VDMA(0, 0); VM0(); __syncthreads();
  QKHALF(pA, 0);
  __syncthreads();
  if (2 < NT) KDMA(0, 2 * KVBLK);
  for (int j = 0; j < NT; j += 2) { STEP(pA, pB, 0, j); STEP(pB, pA, 1, j + 1); }
  __syncthreads();
  LAS float* lx = (LAS float*)X_lds;
  lx[wid * 64 + lane] = l_reg; __syncthreads();
  const float l_tot = lx[wid * 64 + r32] + lx[wid * 64 + 32 + r32] + lx[(wid ^ 1) * 64 + r32] + lx[(wid ^ 1) * 64 + 32 + r32];
  store_o(o, l_tot, lx + 512 + wid * 32, Ob + (long)(rg * QBLK) * ldo + kh * 128, ldo, r32, hi);
  VM0();
  __syncthreads();
#undef KDMA
#undef VDMA
#undef QKHALF
#undef FINH
#undef XWRITE
#undef XREAD
#undef STEP
#undef VM0
}

#define LGK(n) asm volatile("s_waitcnt lgkmcnt(" #n ")" ::: "memory")
template <int OFF> __device__ __forceinline__ bf16x8 k_read(int ka) { bf16x8 r; asm volatile("ds_read_b128 %0, %1 offset:%2" : "=&v"(r) : "v"(ka), "i"(OFF) : "memory"); return r; }
struct VSet { s16x4 l0, h0, l1, h1; };
template <int OFF> __device__ __forceinline__ void v_read(VSet& s, int vb) { s.l0 = tr_read<OFF>(vb); s.h0 = tr_read<OFF + 4096>(vb); s.l1 = tr_read<OFF + 8192>(vb); s.h1 = tr_read<OFF + 12288>(vb); }
__device__ __forceinline__ void pv2(f32x16& oa, const VSet& s, bf16x8 pa0, bf16x8 pa1) {
#define PK(L, H) (bf16x8){L[0], L[1], L[2], L[3], H[0], H[1], H[2], H[3]}
  oa = __builtin_amdgcn_mfma_f32_32x32x16_bf16(pa0, PK(s.l0, s.h0), oa, 0, 0, 0);
  oa = __builtin_amdgcn_mfma_f32_32x32x16_bf16(pa1, PK(s.l1, s.h1), oa, 0, 0, 0);
#undef PK
}
template <bool SHIFT>
__device__ __forceinline__ void attn_body_c256_t(const bf16_t* __restrict__ Qb, const int ldq, const bf16_t* __restrict__ Kh, const bf16_t* __restrict__ Vh, const int ldk,
                                                 bf16_t* __restrict__ Ob, const int ldo, const int seq, const float nmc, const bf16x8 (&qr)[8], LAS char* lds) {
  int tid = threadIdx.x; asm volatile("" : "+v"(tid)); tid &= 511;
  const int wid = __builtin_amdgcn_readfirstlane(tid >> 6), lane = tid & 63, r32 = lane & 31, hi = lane >> 5;
  LAS char* K_lds = lds; LAS char* V_lds = lds + 2 * SHM_K;
  LAS float* li_l = (LAS float*)(lds + 2 * SHM_K + 2 * SHM_V2) + wid * 64;
  float l_reg = 0; f32x16 o[8] = {};
  const int vb0 = (int)(uintptr_t)V_lds + v_rd_base(lane);
  const int kvo = k_dma_voff(wid, lane, ldk);
  const int vvo = unswap23(8 * (wid >> 2) + ((lane & 31) >> 2)) * ldk * 2 + ((2 * (wid & 3) + (lane >> 5)) * 32 + (lane & 3) * 8) * 2;
  const int l32 = 64 * ldk, l16 = 32 * ldk, pz = wid * 1024;
  const __amdgpu_buffer_rsrc_t krs = __builtin_amdgcn_make_buffer_rsrc((void*)Kh, 0, 0x7ffffff0, 0x00020000);
  const __amdgpu_buffer_rsrc_t vrs = __builtin_amdgcn_make_buffer_rsrc((void*)Vh, 0, 0x7ffffff0, 0x00020000);
#define VM0() asm volatile("s_waitcnt vmcnt(0)" ::: "memory")
#define KVDMA(b, k0) do { const int _o = (k0) * ldk * 2; LAS char* _k = K_lds + (b) * SHM_K + pz; LAS char* _v = V_lds + (b) * SHM_V2 + pz; \
    DMA16(krs, _k, kvo, _o); DMA16(krs, _k + 8192, kvo, _o + l32); DMA16(vrs, _v, vvo, _o); DMA16(vrs, _v + 8192, vvo, _o + l16); \
    DMA16(vrs, _v + 16384, vvo, _o + 2 * l16); DMA16(vrs, _v + 24576, vvo, _o + 3 * l16); } while (0)
  int ka[8];
  { const int kxor = (r32 & 7) << 4, krb = (int)(uintptr_t)K_lds + r32 * 256;
#pragma unroll
    for (int d0 = 0; d0 < 8; ++d0) ka[d0] = krb + (((d0 * 16 + hi * 8) * 2) ^ kxor); }
  f32x16 P; bf16x8 pa0, pa1, f0, f1, f2, f3; VSet va, vb_, vc;
  const int NT = seq / KVBLK;
#define PINIT() do { _Pragma("unroll") for (int r = 0; r < 16; ++r) { float _z; asm volatile("v_mov_b32 %0, %1" : "=v"(_z) : "v"(SHIFT ? nmc : 0.f)); P[r] = _z; } } while (0)
#define KOFF(b, h) ((b) * 16384 + (h) * 8192)
#define VOFF(b, h, d0) ((b) * 32768 + (h) * 16384 + (d0) * 512)
#define KPRO(b, h) do { f0 = k_read<KOFF(b, h)>(ka[0]); f1 = k_read<KOFF(b, h)>(ka[1]); f2 = k_read<KOFF(b, h)>(ka[2]); } while (0)
#define QKM(F, d0) do { SCHED; P = __builtin_amdgcn_mfma_f32_32x32x16_bf16(F, qr[d0], P, 0, 0, 0); SCHED; } while (0)
#define QKHALF(b, h) do { PINIT(); \
    LGK(2); QKM(f0, 0); f3 = k_read<KOFF(b, h)>(ka[3]); \
    LGK(2); QKM(f1, 1); f0 = k_read<KOFF(b, h)>(ka[4]); \
    LGK(2); QKM(f2, 2); f1 = k_read<KOFF(b, h)>(ka[5]); \
    LGK(2); QKM(f3, 3); f2 = k_read<KOFF(b, h)>(ka[6]); \
    LGK(2); QKM(f0, 4); f3 = k_read<KOFF(b, h)>(ka[7]); \
    LGK(2); QKM(f1, 5); v_read<VOFF(b, h, 0)>(va, vb0); \
    LGK(5); QKM(f2, 6); v_read<VOFF(b, h, 1)>(vb_, vb0); \
    LGK(8); QKM(f3, 7); } while (0)
#define SMH() do { exp16(P); l_reg += sum16(P); PK4(P, 0, pa0); PK4(P, 8, pa1); } while (0)
#define PVM(S, d0) do { SCHED; pv2(o[d0], S, pa0, pa1); SCHED; } while (0)
#define PVHALF(b, h, NEXTK, nb, nh) do { \
    LGK(4); PVM(va, 0); v_read<VOFF(b, h, 2)>(vc, vb0); \
    LGK(4); PVM(vb_, 1); v_read<VOFF(b, h, 3)>(va, vb0); \
    LGK(4); PVM(vc, 2); v_read<VOFF(b, h, 4)>(vb_, vb0); \
    LGK(4); PVM(va, 3); v_read<VOFF(b, h, 5)>(vc, vb0); \
    LGK(4); PVM(vb_, 4); v_read<VOFF(b, h, 6)>(va, vb0); \
    LGK(4); PVM(vc, 5); v_read<VOFF(b, h, 7)>(vb_, vb0); \
    LGK(4); PVM(va, 6); if (NEXTK) { f0 = k_read<KOFF(nb, nh)>(ka[0]); f1 = k_read<KOFF(nb, nh)>(ka[1]); } \
    if (NEXTK) { LGK(2); } else { LGK(0); } PVM(vb_, 7); if (NEXTK) { f2 = k_read<KOFF(nb, nh)>(ka[2]); } } while (0)
#define STEPC(b, j) do { if ((j) + 1 < NT) KVDMA((b) ^ 1, ((j) + 1) * KVBLK); \
    KPRO(b, 0); QKHALF(b, 0); SMH(); PVHALF(b, 0, true, b, 1); \
    QKHALF(b, 1); SMH(); PVHALF(b, 1, false, 0, 0); \
    VM0(); __syncthreads(); } while (0)
  KVDMA(0, 0); VM0(); __syncthreads();
  for (int j = 0; j < NT; j += 2) { STEPC(0, j); STEPC(1, j + 1); }
  { auto rr = __builtin_amdgcn_permlane32_swap(__float_as_uint(l_reg), __float_as_uint(l_reg), false, false); l_reg = __uint_as_float(rr[0]) + __uint_as_float(rr[1]); }
  if (hi == 0) li_l[r32] = l_reg; asm volatile("s_waitcnt lgkmcnt(0)" ::: "memory");
  bf16_t* Ow = Ob + (long)(wid * QBLK) * ldo;
#pragma unroll
  for (int r = 0; r < 16; ++r) { const int orow = crow(r, hi); const float rl = __builtin_amdgcn_rcpf(li_l[orow]);
#pragma unroll
    for (int d0 = 0; d0 < 8; ++d0) Ow[(long)orow * ldo + d0 * 32 + r32] = f2bf(o[d0][r] * rl); }
  VM0();
  __syncthreads();
#undef KVDMA
#undef PINIT
#undef KOFF
#undef VOFF
#undef KPRO
#undef QKM
#undef QKHALF
#undef SMH
#undef PVM
#undef PVHALF
#undef STEPC
#undef VM0
}
__device__ __forceinline__ void attn_body_c256(const bf16_t* __restrict__ Qb, const int ldq, const bf16_t* __restrict__ Kh, const bf16_t* __restrict__ Vh, const int ldk,
                                               bf16_t* __restrict__ Ob, const int ldo, const int seq, const float kmax2, LAS char* lds) {
  int tid = threadIdx.x; asm volatile("" : "+v"(tid)); tid &= 511;
  const int wid = tid >> 6, lane = tid & 63, r32 = lane & 31, hi = lane >> 5;
  bf16x8 qr[8];
  const float nmc = load_q(Qb + (long)(wid * QBLK + r32) * ldq + hi * 8, qr, kmax2);
  if (__all(nmc > -64.f)) attn_body_c256_t<false>(Qb, ldq, Kh, Vh, ldk, Ob, ldo, seq, 0.f, qr, lds);
  else attn_body_c256_t<true>(Qb, ldq, Kh, Vh, ldk, Ob, ldo, seq, nmc, qr, lds);
}

__device__ __forceinline__ float load_q8(const bf16_t* __restrict__ Qrow, int hi, v8i_ (&qf)[2], float kmax2) {
  float ss = 0;
#pragma unroll
  for (int st = 0; st < 2; ++st) {
    const bf16_t* p = Qrow + 64 * st + 32 * hi; v8i_ o;
#pragma unroll
    for (int c = 0; c < 4; ++c) { const u32x4 raw = *reinterpret_cast<const u32x4*>(p + 8 * c);
      const unsigned w0 = pack8x4(bflo(raw[0]) * QC, bfhi(raw[0]) * QC, bflo(raw[1]) * QC, bfhi(raw[1]) * QC);
      const unsigned w1 = pack8x4(bflo(raw[2]) * QC, bfhi(raw[2]) * QC, bflo(raw[3]) * QC, bfhi(raw[3]) * QC);
      o[2 * c] = (int)w0; o[2 * c + 1] = (int)w1; ss += sq8x4(w0) + sq8x4(w1); }
    qf[st] = o;
  }
  { auto rr = __builtin_amdgcn_permlane32_swap(__float_as_uint(ss), __float_as_uint(ss), false, false); ss = __uint_as_float(rr[0]) + __uint_as_float(rr[1]); }
  return -(sqrtf(ss * kmax2) * 1.01f + 1e-3f);
}
__device__ __forceinline__ int k8_dma_voff(int wid, int lane, int ldk8) {
  const int row = 8 * wid + (lane >> 3); return row * ldk8 + (((lane & 7) ^ ((row >> 1) & 7)) << 4); }
template <int OFF> __device__ __forceinline__ v4i k8_read(int ka) { v4i r; asm volatile("ds_read_b128 %0, %1 offset:%2" : "=&v"(r) : "v"(ka), "i"(OFF) : "memory"); return r; }

template <bool SHIFT>
__device__ __forceinline__ void attn_body_c256q8_t(const unsigned char* __restrict__ K8, const int ldk8, const bf16_t* __restrict__ Vh, const int ldk,
                                                   bf16_t* __restrict__ Ob, const int ldo, const int seq, const float nmc, const v8i_ (&qf)[2], LAS char* lds) {
  int tid = threadIdx.x; asm volatile("" : "+v"(tid)); tid &= 511;
  const int wid = __builtin_amdgcn_readfirstlane(tid >> 6), lane = tid & 63, r32 = lane & 31, hi = lane >> 5;
  constexpr int SHM_K8 = KVBLK * 128;
  LAS char* K_lds = lds; LAS char* V_lds = lds + 2 * SHM_K8;
  LAS float* li_l = (LAS float*)(lds + 2 * SHM_K8 + 2 * SHM_V2) + wid * 64;
  float l_reg = 0; f32x16 o[8] = {};
  const int vb0 = (int)(uintptr_t)V_lds + v_rd_base(lane);
  const int kvo = k8_dma_voff(wid, lane, ldk8);
  const int vvo = unswap23(8 * (wid >> 2) + ((lane & 31) >> 2)) * ldk * 2 + ((2 * (wid & 3) + (lane >> 5)) * 32 + (lane & 3) * 8) * 2;
  const int l16 = 32 * ldk, pz = wid * 1024;
  const __amdgpu_buffer_rsrc_t krs = __builtin_amdgcn_make_buffer_rsrc((void*)K8, 0, 0x7ffffff0, 0x00020000);
  const __amdgpu_buffer_rsrc_t vrs = __builtin_amdgcn_make_buffer_rsrc((void*)Vh, 0, 0x7ffffff0, 0x00020000);
#define VM0() asm volatile("s_waitcnt vmcnt(0)" ::: "memory")
#define KVDMA(b, k0) do { const int _o = (k0) * ldk * 2; LAS char* _v = V_lds + (b) * SHM_V2 + pz; \
    DMA16(krs, K_lds + (b) * SHM_K8 + pz, kvo, (k0) * ldk8); DMA16(vrs, _v, vvo, _o); DMA16(vrs, _v + 8192, vvo, _o + l16); \
    DMA16(vrs, _v + 16384, vvo, _o + 2 * l16); DMA16(vrs, _v + 24576, vvo, _o + 3 * l16); } while (0)
  const int ka0 = (int)(uintptr_t)K_lds + r32 * 128 + (((2 * hi) ^ ((r32 >> 1) & 7)) << 4);
  const int ka1 = ka0 ^ 16, ka2 = ka0 ^ 64, ka3 = ka0 ^ 80;
  int sc1; asm volatile("v_mov_b32 %0, 0x7f7f7f7f" : "=v"(sc1));
  f32x16 P; bf16x8 pa0, pa1; v4i k0a, k0b, k1a, k1b; VSet va, vb_, vc;
  const int NT = seq / KVBLK;
#define KOFF(b, h) ((b) * 8192 + (h) * 4096)
#define VOFF(b, h, d0) ((b) * 32768 + (h) * 16384 + (d0) * 512)
#define KPRO(b, h) do { k0a = k8_read<KOFF(b, h)>(ka0); k0b = k8_read<KOFF(b, h)>(ka1); k1a = k8_read<KOFF(b, h)>(ka2); k1b = k8_read<KOFF(b, h)>(ka3); } while (0)
#define V8(x, y) (v8i_){x[0], x[1], x[2], x[3], y[0], y[1], y[2], y[3]}
#define QKHALF(b, h) do { \
    if (SHIFT) { _Pragma("unroll") for (int r = 0; r < 16; ++r) { float _z; asm volatile("v_mov_b32 %0, %1" : "=v"(_z) : "v"(nmc)); P[r] = _z; } } \
    LGK(2); SCHED; { const v8i_ kf = V8(k0a, k0b); \
      if (SHIFT) asm volatile("s_nop 4\n\tv_mfma_scale_f32_32x32x64_f8f6f4 %0, %1, %2, %0, %3, %3 op_sel_hi:[0,0,0]" : "+v"(P) : "v"(kf), "v"(qf[0]), "v"(sc1)); \
      else       asm volatile("v_mfma_scale_f32_32x32x64_f8f6f4 %0, %1, %2, 0, %3, %3 op_sel_hi:[0,0,0]" : "=&v"(P) : "v"(kf), "v"(qf[0]), "v"(sc1)); } \
    SCHED; v_read<VOFF(b, h, 0)>(va, vb0); \
    LGK(4); SCHED; { const v8i_ kf = V8(k1a, k1b); \
      asm volatile("v_mfma_scale_f32_32x32x64_f8f6f4 %0, %1, %2, %0, %3, %3 op_sel_hi:[0,0,0]" : "+v"(P) : "v"(kf), "v"(qf[1]), "v"(sc1)); } \
    SCHED; v_read<VOFF(b, h, 1)>(vb_, vb0); \
    asm volatile("s_nop 15\n\ts_nop 7" : "+v"(P)); } while (0)
#define SMH() do { exp16(P); l_reg += sum16(P); PK4(P, 0, pa0); PK4(P, 8, pa1); } while (0)
#define PVM(S, d0) do { SCHED; pv2(o[d0], S, pa0, pa1); SCHED; } while (0)
#define PVHALF(b, h, NEXTK, nb, nh) do { \
    LGK(4); PVM(va, 0); v_read<VOFF(b, h, 2)>(vc, vb0); \
    LGK(4); PVM(vb_, 1); v_read<VOFF(b, h, 3)>(va, vb0); \
    LGK(4); PVM(vc, 2); v_read<VOFF(b, h, 4)>(vb_, vb0); \
    LGK(4); PVM(va, 3); v_read<VOFF(b, h, 5)>(vc, vb0); \
    LGK(4); PVM(vb_, 4); v_read<VOFF(b, h, 6)>(va, vb0); \
    LGK(4); PVM(vc, 5); v_read<VOFF(b, h, 7)>(vb_, vb0); \
    LGK(4); PVM(va, 6); if (NEXTK) { k0a = k8_read<KOFF(nb, nh)>(ka0); k0b = k8_read<KOFF(nb, nh)>(ka1); } \
    if (NEXTK) { LGK(2); } else { LGK(0); } PVM(vb_, 7); if (NEXTK) { k1a = k8_read<KOFF(nb, nh)>(ka2); k1b = k8_read<KOFF(nb, nh)>(ka3); } } while (0)
#define STEPC(b, j) do { if ((j) + 1 < NT) KVDMA((b) ^ 1, ((j) + 1) * KVBLK); \
    KPRO(b, 0); QKHALF(b, 0); SMH(); PVHALF(b, 0, true, b, 1); \
    QKHALF(b, 1); SMH(); PVHALF(b, 1, false, 0, 0); \
    VM0(); __syncthreads(); } while (0)
  KVDMA(0, 0); VM0(); __syncthreads();
  for (int j = 0; j < NT; j += 2) { STEPC(0, j); STEPC(1, j + 1); }
  { auto rr = __builtin_amdgcn_permlane32_swap(__float_as_uint(l_reg), __float_as_uint(l_reg), false, false); l_reg = __uint_as_float(rr[0]) + __uint_as_float(rr[1]); }
  if (hi == 0) li_l[r32] = l_reg; asm volatile("s_waitcnt lgkmcnt(0)" ::: "memory");
  bf16_t* Ow = Ob + (long)(wid * QBLK) * ldo;
#pragma unroll
  for (int r = 0; r < 16; ++r) { const int orow = crow(r, hi); const float rl = __builtin_amdgcn_rcpf(li_l[orow]);
#pragma unroll
    for (int d0 = 0; d0 < 8; ++d0) Ow[(long)orow * ldo + d0 * 32 + r32] = f2bf(o[d0][r] * rl); }
  VM0();
  __syncthreads();
#undef KVDMA
#undef KOFF
#undef VOFF
#undef KPRO
#undef V8
#undef QKHALF
#undef SMH
#undef PVM
#undef PVHALF
#undef STEPC
#undef VM0
}
__device__ __forceinline__ void attn_body_c256q8(const bf16_t* __restrict__ Qb, const int ldq, const unsigned char* __restrict__ K8, const int ldk8,
                                                 const bf16_t* __restrict__ Vh, const int ldk, bf16_t* __restrict__ Ob, const int ldo, const int seq, const float kmax2, LAS char* lds) {
  int tid = threadIdx.x; asm volatile("" : "+v"(tid)); tid &= 511;
  const int wid = tid >> 6, lane = tid & 63, r32 = lane & 31, hi = lane >> 5;
  v8i_ qf[2];
  const float nmc = load_q8(Qb + (long)(wid * QBLK + r32) * ldq, hi, qf, kmax2);
  if (__all(nmc > -64.f)) attn_body_c256q8_t<false>(K8, ldk8, Vh, ldk, Ob, ldo, seq, 0.f, qf, lds);
  else attn_body_c256q8_t<true>(K8, ldk8, Vh, ldk, Ob, ldo, seq, nmc, qf, lds);
}

template <bool SHIFT>
__device__ __forceinline__ void attn_body_q8_t(const unsigned char* __restrict__ K8, const int ldk8, const bf16_t* __restrict__ Vh, const int ldk,
                                               bf16_t* __restrict__ Ob, const int ldo, const int seq, const float nmc, const v8i_ (&qf)[2], LAS char* lds) {
  int tid = threadIdx.x; asm volatile("" : "+v"(tid)); tid &= 511;
  const int wid = __builtin_amdgcn_readfirstlane(tid >> 6), lane = tid & 63, r32 = lane & 31, hi = lane >> 5;
  constexpr int SK8 = KVBLK * 128, ST = SK8 + SHM_V;
  LAS float* li_l = (LAS float*)(lds + 3 * ST) + wid * 64;
  float l_reg = 0; f32x16 o[4] = {};
  const int vrb = v_rd_base(lane);
  const int kvo = k8_dma_voff(wid, lane, ldk8);
  const int vvo = unswap23(8 * (wid >> 1) + ((lane & 31) >> 2)) * ldk * 2 + ((2 * (wid & 1) + (lane >> 5)) * 32 + (lane & 3) * 8) * 2;
  const int l32 = 64 * ldk, pz = wid * 1024;
  const __amdgpu_buffer_rsrc_t krs = __builtin_amdgcn_make_buffer_rsrc((void*)K8, 0, 0x7ffffff0, 0x00020000);
  const __amdgpu_buffer_rsrc_t vrs = __builtin_amdgcn_make_buffer_rsrc((void*)Vh, 0, 0x7ffffff0, 0x00020000);
#define TDMA(slot, k0) do { const int _o = (k0) * ldk * 2; LAS char* _b = lds + (slot) * ST + pz; \
    DMA16(krs, _b, kvo, (k0) * ldk8); DMA16(vrs, _b + SK8, vvo, _o); DMA16(vrs, _b + SK8 + 8192, vvo, _o + l32); } while (0)
#define VM0() asm volatile("s_waitcnt vmcnt(0)" ::: "memory")
  int sc1; asm volatile("v_mov_b32 %0, 0x7f7f7f7f" : "=v"(sc1));
  const int kof = r32 * 128 + (((2 * hi) ^ ((r32 >> 1) & 7)) << 4);
#define QKT8(P0, P1, Ks) do { \
    const v4i a0 = *(LAS const v4i*)((Ks) + kof), a1 = *(LAS const v4i*)((Ks) + (kof ^ 16)), a2 = *(LAS const v4i*)((Ks) + (kof ^ 64)), a3 = *(LAS const v4i*)((Ks) + (kof ^ 80)); \
    const v4i b0 = *(LAS const v4i*)((Ks) + 4096 + kof), b1 = *(LAS const v4i*)((Ks) + 4096 + (kof ^ 16)), b2 = *(LAS const v4i*)((Ks) + 4096 + (kof ^ 64)), b3 = *(LAS const v4i*)((Ks) + 4096 + (kof ^ 80)); \
    v8i_ k00 = (v8i_){a0[0], a0[1], a0[2], a0[3], a1[0], a1[1], a1[2], a1[3]}, k01 = (v8i_){a2[0], a2[1], a2[2], a2[3], a3[0], a3[1], a3[2], a3[3]}; \
    v8i_ k10 = (v8i_){b0[0], b0[1], b0[2], b0[3], b1[0], b1[1], b1[2], b1[3]}, k11 = (v8i_){b2[0], b2[1], b2[2], b2[3], b3[0], b3[1], b3[2], b3[3]}; \
    if (SHIFT) { _Pragma("unroll") for (int r = 0; r < 16; ++r) { P0[r] = nmc; P1[r] = nmc; } \
      asm volatile("s_nop 4\n\tv_mfma_scale_f32_32x32x64_f8f6f4 %0, %1, %2, %0, %3, %3 op_sel_hi:[0,0,0]" : "+v"(P0) : "v"(k00), "v"(qf[0]), "v"(sc1)); \
      asm volatile("v_mfma_scale_f32_32x32x64_f8f6f4 %0, %1, %2, %0, %3, %3 op_sel_hi:[0,0,0]" : "+v"(P1) : "v"(k10), "v"(qf[0]), "v"(sc1)); } \
    else { asm volatile("v_mfma_scale_f32_32x32x64_f8f6f4 %0, %1, %2, 0, %3, %3 op_sel_hi:[0,0,0]" : "=&v"(P0) : "v"(k00), "v"(qf[0]), "v"(sc1)); \
      asm volatile("v_mfma_scale_f32_32x32x64_f8f6f4 %0, %1, %2, 0, %3, %3 op_sel_hi:[0,0,0]" : "=&v"(P1) : "v"(k10), "v"(qf[0]), "v"(sc1)); } \
    asm volatile("v_mfma_scale_f32_32x32x64_f8f6f4 %0, %1, %2, %0, %3, %3 op_sel_hi:[0,0,0]" : "+v"(P0) : "v"(k01), "v"(qf[1]), "v"(sc1)); \
    asm volatile("v_mfma_scale_f32_32x32x64_f8f6f4 %0, %1, %2, %0, %3, %3 op_sel_hi:[0,0,0]" : "+v"(P1) : "v"(k11), "v"(qf[1]), "v"(sc1)); \
      \
    asm volatile("s_nop 15" : "+v"(k00), "+v"(k01), "+v"(k10), "+v"(k11)); } while (0)
#define TIE(P0, P1) asm volatile("s_nop 15\n\ts_nop 7" : "+v"(P0), "+v"(P1))
#define TIE0(P0, P1) asm volatile("" : "+v"(P0), "+v"(P1))
#define FINISH(P0, P1) do { exp16(P1); l_reg += sum16(P0) + sum16(P1); PK4(P0, 0, pa0); PK4(P0, 8, pa1); PK4(P1, 0, pa2); PK4(P1, 8, pa3); } while (0)
  f32x16 pA0, pA1, pB0, pB1; bf16x8 pa0, pa1, pa2, pa3; const int NT = seq / KVBLK;
  TDMA(0, 0); VM0(); __syncthreads();
  TDMA(1, KVBLK);
  QKT8(pA0, pA1, lds); TIE(pA0, pA1); exp16(pA0);
  VM0(); __syncthreads();
  int sk = 1, sv = 0, sd = 2;
  for (int j = 1; j + 1 < NT; j += 2) {
    TDMA(sd, (j + 1) * KVBLK);
    SCHED; QKT8(pB0, pB1, lds + sk * ST);
    FINISH(pA0, pA1); SCHED;
    pv_d0(o, (int)(uintptr_t)(lds + sv * ST + SK8) + vrb, pa0, pa1, pa2, pa3); TIE0(pB0, pB1); exp16(pB0);
    VM0(); __syncthreads();
    { const int t = sv; sv = sk; sk = sd; sd = t; }
    if (j + 2 < NT) TDMA(sd, (j + 2) * KVBLK);
    SCHED; QKT8(pA0, pA1, lds + sk * ST);
    FINISH(pB0, pB1); SCHED;
    pv_d0(o, (int)(uintptr_t)(lds + sv * ST + SK8) + vrb, pa0, pa1, pa2, pa3); TIE0(pA0, pA1); exp16(pA0);
    VM0(); __syncthreads();
    { const int t = sv; sv = sk; sk = sd; sd = t; }
  }
  SCHED; QKT8(pB0, pB1, lds + sk * ST);
  FINISH(pA0, pA1); SCHED;
  pv_d0(o, (int)(uintptr_t)(lds + sv * ST + SK8) + vrb, pa0, pa1, pa2, pa3); TIE0(pB0, pB1); exp16(pB0);
  FINISH(pB0, pB1); SCHED;
  pv_d0(o, (int)(uintptr_t)(lds + sk * ST + SK8) + vrb, pa0, pa1, pa2, pa3);
  { auto rr = __builtin_amdgcn_permlane32_swap(__float_as_uint(l_reg), __float_as_uint(l_reg), false, false); l_reg = __uint_as_float(rr[0]) + __uint_as_float(rr[1]); }
#if DENSE8_G2
  store_o8(o, l_reg, li_l, (unsigned char*)Ob + (long)(wid * QBLK) * ldo, ldo, r32, hi);
#else
  store_o(o, l_reg, li_l, Ob + (long)(wid * QBLK) * ldo, ldo, r32, hi);
#endif
  VM0();
  __syncthreads();
#undef TDMA
#undef VM0
#undef QKT8
#undef TIE
#undef TIE0
#undef FINISH
}
__device__ __forceinline__ void attn_body_q8(const bf16_t* __restrict__ Qb, const int ldq, const unsigned char* __restrict__ K8, const int ldk8,
                                             const bf16_t* __restrict__ Vh, const int ldk, bf16_t* __restrict__ Ob, const int ldo, const int seq, const float kmax2, LAS char* lds) {
  int tid = threadIdx.x; asm volatile("" : "+v"(tid)); tid &= 511;
  const int wid = tid >> 6, lane = tid & 63, r32 = lane & 31, hi = lane >> 5;
  v8i_ qf[2];
  const float nmc = load_q8(Qb + (long)(wid * QBLK + r32) * ldq, hi, qf, kmax2);
  if (__all(nmc > -64.f)) attn_body_q8_t<false>(K8, ldk8, Vh, ldk, Ob, ldo, seq, 0.f, qf, lds);
  else attn_body_q8_t<true>(K8, ldk8, Vh, ldk, Ob, ldo, seq, nmc, qf, lds);
}

__device__ __forceinline__ unsigned pk8nc(float a, float b, float c, float d) {
  int p = __builtin_amdgcn_cvt_pk_fp8_f32(a, b, 0, false); p = __builtin_amdgcn_cvt_pk_fp8_f32(c, d, p, true); return (unsigned)p; }
__device__ __forceinline__ float max16(const f32x16& p) {
  float a = fmaxf(fmaxf(p[0], p[1]), fmaxf(p[2], p[3])), b = fmaxf(fmaxf(p[4], p[5]), fmaxf(p[6], p[7]));
  float c = fmaxf(fmaxf(p[8], p[9]), fmaxf(p[10], p[11])), d = fmaxf(fmaxf(p[12], p[13]), fmaxf(p[14], p[15]));
  return fmaxf(fmaxf(a, b), fmaxf(c, d)); }
__device__ __forceinline__ void attn_body_d256(const bf16_t* __restrict__ Qb, const int ldq, const unsigned char* __restrict__ K8, const int ldk8,
                                               const unsigned char* __restrict__ V8T  ,
                                               bf16_t* __restrict__ Ob, const int ldo, const int seq, LAS char* lds) {
  int tid = threadIdx.x; asm volatile("" : "+v"(tid)); tid &= 511;
  const int wid = __builtin_amdgcn_readfirstlane(tid >> 6), lane = tid & 63, r32 = lane & 31, hi = lane >> 5;
  v8i_ qf[2];
  (void)load_q8(Qb + (long)(wid * QBLK + r32) * ldq, hi, qf, 0.f);
  constexpr int SK8 = KVBLK * 128, SV8 = 256 * 64;
  LAS char* K_lds = lds; LAS char* V_lds = lds + 2 * SK8;
  LAS float* li_l = (LAS float*)(lds + 2 * SK8 + 2 * SV8) + wid * 64;
  float l_reg = 0; f32x16 o[8] = {};
  const int kvo = k8_dma_voff(wid, lane, ldk8);
  const int vvo = lane * 16 + wid * 1024, pz = wid * 1024;
  const __amdgpu_buffer_rsrc_t krs = __builtin_amdgcn_make_buffer_rsrc((void*)K8, 0, 0x7ffffff0, 0x00020000);
  const __amdgpu_buffer_rsrc_t vrs = __builtin_amdgcn_make_buffer_rsrc((void*)V8T, 0, 0x7ffffff0, 0x00020000);
#define VM0() asm volatile("s_waitcnt vmcnt(0)" ::: "memory")
#define KVDMA(b, t) do { DMA16(krs, K_lds + (b) * SK8 + pz, kvo, (t) * KVBLK * ldk8); \
    DMA16(vrs, V_lds + (b) * SV8 + pz, vvo, (t) * SV8); DMA16(vrs, V_lds + (b) * SV8 + pz + 8192, vvo, (t) * SV8 + 8192); } while (0)
  const int ka0 = (int)(uintptr_t)K_lds + r32 * 128 + (((2 * hi) ^ ((r32 >> 1) & 7)) << 4);
  const int ka1 = ka0 ^ 16, ka2 = ka0 ^ 64, ka3 = ka0 ^ 80;
  const int vf0 = (int)(uintptr_t)V_lds + r32 * 64 + (((2 * hi) ^ ((r32 >> 2) & 3)) << 4), vf1 = vf0 ^ 16;
  int sc1; asm volatile("v_mov_b32 %0, 0x7f7f7f7f" : "=v"(sc1));
  const int NT = seq / KVBLK;
#define RD128(dst, addr, OFF) asm volatile("ds_read_b128 %0, %1 offset:%2" : "=&v"(dst) : "v"(addr), "i"(OFF) : "memory")
#define V8(x, y) (v8i_){x[0], x[1], x[2], x[3], y[0], y[1], y[2], y[3]}
#define VFR(A_, B_, b, d0) do { RD128(A_, vf0, (b) * 16384 + (d0) * 2048); RD128(B_, vf1, (b) * 16384 + (d0) * 2048); } while (0)
#define PVM(A_, B_, d0) do { SCHED; { const v8i_ vfr = V8(A_, B_); \
    asm volatile("v_mfma_scale_f32_32x32x64_f8f6f4 %0, %1, %2, %0, %3, %4 op_sel_hi:[0,0,0]" : "+v"(o[d0]) : "v"(pa8), "v"(vfr), "v"(sca), "v"(sc1)); } SCHED; } while (0)
#define STEPD(b, j) do { if ((j) + 1 < NT) KVDMA((b) ^ 1, (j) + 1); \
      \
    RD128(k0, ka0, (b) * 8192); RD128(k1, ka1, (b) * 8192); RD128(k2, ka2, (b) * 8192); RD128(k3, ka3, (b) * 8192); \
    RD128(k4, ka0, (b) * 8192 + 4096); RD128(k5, ka1, (b) * 8192 + 4096); RD128(k6, ka2, (b) * 8192 + 4096); RD128(k7, ka3, (b) * 8192 + 4096); \
    LGK(6); SCHED; { const v8i_ kf = V8(k0, k1); asm volatile("v_mfma_scale_f32_32x32x64_f8f6f4 %0, %1, %2, 0, %3, %3 op_sel_hi:[0,0,0]" : "=&v"(p0) : "v"(kf), "v"(qf[0]), "v"(sc1)); } \
    LGK(4); SCHED; { const v8i_ kf = V8(k2, k3); asm volatile("v_mfma_scale_f32_32x32x64_f8f6f4 %0, %1, %2, %0, %3, %3 op_sel_hi:[0,0,0]" : "+v"(p0) : "v"(kf), "v"(qf[1]), "v"(sc1)); } \
    LGK(2); SCHED; { const v8i_ kf = V8(k4, k5); asm volatile("v_mfma_scale_f32_32x32x64_f8f6f4 %0, %1, %2, 0, %3, %3 op_sel_hi:[0,0,0]" : "=&v"(p1) : "v"(kf), "v"(qf[0]), "v"(sc1)); } \
    LGK(0); SCHED; { const v8i_ kf = V8(k6, k7); asm volatile("v_mfma_scale_f32_32x32x64_f8f6f4 %0, %1, %2, %0, %3, %3 op_sel_hi:[0,0,0]" : "+v"(p1) : "v"(kf), "v"(qf[1]), "v"(sc1)); } \
    SCHED; VFR(va, vb, b, 0); VFR(vc, vd, b, 1); \
    asm volatile("s_nop 15\n\ts_nop 7" : "+v"(p0), "+v"(p1)); \
      \
    { const float mo = fmaxf(max16(p0), max16(p1)); \
      auto sA = __builtin_amdgcn_permlane32_swap(__float_as_uint(mo), __float_as_uint(mo), false, false); \
      const float e0 = fminf(fmaxf(ceilf(fmaxf(__uint_as_float(sA[0]), __uint_as_float(sA[1]))), -120.f), 120.f); \
      _Pragma("unroll") for (int r = 0; r < 16; ++r) { p0[r] = __builtin_amdgcn_exp2f(p0[r] - e0); p1[r] = __builtin_amdgcn_exp2f(p1[r] - e0); } \
      l_reg += __builtin_amdgcn_exp2f(e0) * (sum16(p0) + sum16(p1)); \
      sca = 127 + (int)e0; \
      _Pragma("unroll") for (int q = 0; q < 4; ++q) { \
        const unsigned x = pk8nc(p0[4 * q], p0[4 * q + 1], p0[4 * q + 2], p0[4 * q + 3]), y = pk8nc(p1[4 * q], p1[4 * q + 1], p1[4 * q + 2], p1[4 * q + 3]); \
        auto rr = __builtin_amdgcn_permlane32_swap(x, y, false, false); pa8[q] = (int)rr[0]; pa8[4 + q] = (int)rr[1]; } } \
      \
    asm volatile("s_nop 4" : "+v"(pa8), "+v"(sca));     \
    LGK(2); PVM(va, vb, 0); VFR(ve, vf, b, 2); \
    LGK(2); PVM(vc, vd, 1); VFR(va, vb, b, 3); \
    LGK(2); PVM(ve, vf, 2); VFR(vc, vd, b, 4); \
    LGK(2); PVM(va, vb, 3); VFR(ve, vf, b, 5); \
    LGK(2); PVM(vc, vd, 4); VFR(va, vb, b, 6); \
    LGK(2); PVM(ve, vf, 5); VFR(vc, vd, b, 7); \
    LGK(2); PVM(va, vb, 6); \
    LGK(0); PVM(vc, vd, 7); \
    VM0(); __syncthreads(); } while (0)
  f32x16 p0, p1; v8i_ pa8; int sca; v4i k0, k1, k2, k3, k4, k5, k6, k7, va, vb, vc, vd, ve, vf;
  KVDMA(0, 0); VM0(); __syncthreads();
  for (int j = 0; j < NT; j += 2) { STEPD(0, j); STEPD(1, j + 1); }
  asm volatile("s_nop 15\n\ts_nop 7" ::: "memory");
#pragma unroll
  for (int d0 = 0; d0 < 8; ++d0) asm volatile("" : "+v"(o[d0]));
  { auto rr = __builtin_amdgcn_permlane32_swap(__float_as_uint(l_reg), __float_as_uint(l_reg), false, false); l_reg = __uint_as_float(rr[0]) + __uint_as_float(rr[1]); }
  if (hi == 0) li_l[r32] = l_reg; asm volatile("s_waitcnt lgkmcnt(0)" ::: "memory");
  bf16_t* Ow = Ob + (long)(wid * QBLK) * ldo;
#pragma unroll
  for (int r = 0; r < 16; ++r) { const int orow = crow(r, hi); const float rl = __builtin_amdgcn_rcpf(li_l[orow]);
#pragma unroll
    for (int d0 = 0; d0 < 8; ++d0) Ow[(long)orow * ldo + d0 * 32 + r32] = f2bf(o[d0][r] * rl); }
  VM0();
  __syncthreads();
#undef VM0
#undef KVDMA
#undef RD128
#undef V8
#undef VFR
#undef PVM
#undef STEPD
}
#undef PK4
}

__device__ __forceinline__ int perm_plain8(int n) { const int r = n & 31; return (n & ~31) + 16 * ((r >> 2) & 1) + 4 * (r >> 3) + (r & 3); }
__device__ __forceinline__ int perm_row(int kind, int n) {
  if (kind == 0) return perm_plain8(n);
  if (kind == 1) { if (n < N_QKV0) return perm_plain8(n); const int c = n - N_QKV0; const int ch = c & 1023; return N_QKV0 + 32 * (ch >> 4) + ((c >> 10) << 4) + (ch & 15); }
  return 32 * (n >> 4) + ((kind == 3) ? 16 : 0) + (n & 15);
}
__device__ __forceinline__ void cvt_tile(const float* __restrict__ src, int N, bf16_t* __restrict__ dst, int K, int kind, int k0, int n0, LAS unsigned* t32) {
  int tid = threadIdx.x; asm volatile("" : "+v"(tid)); tid &= 511;
#pragma unroll
  for (int j = 0; j < 2; ++j) {
    const int item = tid + 512 * j, kp = item >> 4, q = item & 15;
    const f32x4 v0 = *(const f32x4*)(src + (size_t)(k0 + 2 * kp) * N + n0 + 4 * q);
    const f32x4 v1 = *(const f32x4*)(src + (size_t)(k0 + 2 * kp + 1) * N + n0 + 4 * q);
#pragma unroll
    for (int i = 0; i < 4; ++i) t32[(4 * q + i) * 65 + kp] = cvtpk(v0[i], v1[i]);
  }
  __syncthreads();
#pragma unroll
  for (int j = 0; j < 2; ++j) {
    const int item = tid + 512 * j, n = item >> 4, ko = item & 15;
    u32x4 v;
#pragma unroll
    for (int i = 0; i < 4; ++i) v[i] = t32[n * 65 + 4 * ko + i];
    *(u32x4*)(dst + (size_t)perm_row(kind, n0 + n) * K + k0 + 8 * ko) = v;
  }
  __syncthreads();
}
__device__ __forceinline__ void cvt_matrix_units(const float* src, int K, int N, bf16_t* dst, int kind, int u0, int ustride, LAS unsigned* t32) {
  const int nN = N / 64, nK = K / 128;
  for (int u = u0; u < nN * nK; u += ustride) cvt_tile(src, N, dst, K, kind, (u / nN) * 128, (u % nN) * 64, t32);
}
constexpr size_t WMOE8_E = (size_t)1024 * D + (size_t)D * EFF;
__device__ __forceinline__ void cvt_tile8(const float* __restrict__ src, int N, unsigned char* __restrict__ dst, int K, int kind, int k0, int n0, float scale, LAS unsigned* t32) {
  int tid = threadIdx.x; asm volatile("" : "+v"(tid)); tid &= 511;
  { const int kq = tid >> 4, q = tid & 15;
    f32x4 v[4];
#pragma unroll
    for (int r = 0; r < 4; ++r) v[r] = *(const f32x4*)(src + (size_t)(k0 + 4 * kq + r) * N + n0 + 4 * q);
#pragma unroll
    for (int i = 0; i < 4; ++i) t32[(4 * q + i) * 33 + kq] = pack_fp8x4(v[0][i] * scale, v[1][i] * scale, v[2][i] * scale, v[3][i] * scale); }
  __syncthreads();
  { const int n = tid >> 3, kc = tid & 7;
    u32x4 v;
#pragma unroll
    for (int i = 0; i < 4; ++i) v[i] = t32[n * 33 + 4 * kc + i];
    *(u32x4*)(dst + (size_t)perm_row(kind, n0 + n) * K + k0 + 16 * kc) = v; }
  __syncthreads();
}
__device__ __forceinline__ void cvt_matrix_units8(const float* src, int K, int N, unsigned char* dst, int kind, float scale, LAS unsigned* t32) {
  const int nN = N / 64, nK = K / 128;
  for (int u = blockIdx.x; u < nN * nK; u += gridDim.x) cvt_tile8(src, N, dst, K, kind, (u / nN) * 128, (u % nN) * 64, scale, t32);
}
__device__ __forceinline__ void cvt_moe_all8(const Args& a, LAS unsigned* t32) {
  unsigned char* W = (unsigned char*)(a.ws + WS_WMOE);
  for (int u = blockIdx.x; u < 2 * 65 * 384; u += gridDim.x) {
    const int le = u / 384, L = le / 65, e = le % 65, r = u % 384, mtx = r >> 7, lu = r & 127;
    const float* src; unsigned char* dst = W + (size_t)le * WMOE8_E; int K, N, kind; float sc;
    if (mtx == 0)      { src = e < 64 ? a.in[21] + ((size_t)L * 64 + e) * D * EFF : a.in[24] + (size_t)L * D * EFF; K = D; N = EFF; kind = 2; sc = 256.f; }
    else if (mtx == 1) { src = e < 64 ? a.in[22] + ((size_t)L * 64 + e) * D * EFF : a.in[25] + (size_t)L * D * EFF; K = D; N = EFF; kind = 3; sc = 256.f; }
    else               { src = e < 64 ? a.in[23] + ((size_t)L * 64 + e) * EFF * D : a.in[26] + (size_t)L * EFF * D; K = EFF; N = D; kind = 0; sc = 128.f; dst += (size_t)1024 * D; }
    const int nN = N / 64;
    cvt_tile8(src, N, dst, K, kind, (lu / nN) * 128, (lu % nN) * 64, sc, t32);
  }
}

__device__ __forceinline__ void ld_row_f32(const float* __restrict__ p, int lane, float (&v)[32]) {
#pragma unroll
  for (int j = 0; j < 4; ++j) { const f32x4 t0 = *(const f32x4*)(p + 8 * lane + 512 * j), t1 = *(const f32x4*)(p + 8 * lane + 512 * j + 4);
#pragma unroll
    for (int i = 0; i < 4; ++i) { v[8 * j + i] = t0[i]; v[8 * j + 4 + i] = t1[i]; } }
}
__device__ __forceinline__ void ld_row_bf16(const bf16_t* __restrict__ p, int lane, float (&v)[32]) {
#pragma unroll
  for (int j = 0; j < 4; ++j) { const u32x4 t = *(const u32x4*)(p + 8 * lane + 512 * j);
#pragma unroll
    for (int i = 0; i < 4; ++i) { v[8 * j + 2 * i] = bflo(t[i]); v[8 * j + 2 * i + 1] = bfhi(t[i]); } }
}
__device__ __forceinline__ void ld_row_fp8(const unsigned char* __restrict__ p, int lane, float (&v)[32]) {
#pragma unroll
  for (int j = 0; j < 4; ++j) { const u32x2 t = *(const u32x2*)(p + 8 * lane + 512 * j);
#pragma unroll
    for (int i = 0; i < 2; ++i) { v[8 * j + 4 * i] = __builtin_amdgcn_cvt_f32_fp8((int)t[i], 0); v[8 * j + 4 * i + 1] = __builtin_amdgcn_cvt_f32_fp8((int)t[i], 1);
      v[8 * j + 4 * i + 2] = __builtin_amdgcn_cvt_f32_fp8((int)t[i], 2); v[8 * j + 4 * i + 3] = __builtin_amdgcn_cvt_f32_fp8((int)t[i], 3); } }
}
__device__ __forceinline__ void ld8f(const float* __restrict__ p, float (&x)[8]) { const f32x4 t0 = *(const f32x4*)p, t1 = *(const f32x4*)(p + 4);
#pragma unroll
  for (int i = 0; i < 4; ++i) { x[i] = t0[i]; x[4 + i] = t1[i]; } }
__device__ __forceinline__ void st8f(float* __restrict__ p, const float* x) { f32x4 t0 = {x[0], x[1], x[2], x[3]}, t1 = {x[4], x[5], x[6], x[7]}; *(f32x4*)p = t0; *(f32x4*)(p + 4) = t1; }
__device__ __forceinline__ float sumsq32(const float (&v)[32]) { float s = 0;
#pragma unroll
  for (int i = 0; i < 32; ++i) s += v[i] * v[i];
  return wave_sum(s); }
template <bool COPY, bool OUT8 = false>
__device__ __forceinline__ void modulate_store(const float (&v)[32], float rstd, const float* __restrict__ g, const float* __restrict__ shift, const float* __restrict__ scale,
                                               bf16_t* __restrict__ dst, int lane, LAS float* f32copy) {
#pragma unroll
  for (int j = 0; j < 4; ++j) {
    const int idx = 8 * lane + 512 * j;
    float gv[8], sh[8], sc[8], y[8]; ld8f(g + idx, gv); ld8f(shift + idx, sh); ld8f(scale + idx, sc);
#pragma unroll
    for (int i = 0; i < 8; ++i) y[i] = v[8 * j + i] * rstd * gv[i] * (1.f + sc[i]) + sh[i];
    if (OUT8) { u32x2 p8 = {pack_fp8x4(y[0], y[1], y[2], y[3]), pack_fp8x4(y[4], y[5], y[6], y[7])}; *(u32x2*)((unsigned char*)dst + idx) = p8; }
    else { u32x4 pk = {cvtpk(y[0], y[1]), cvtpk(y[2], y[3]), cvtpk(y[4], y[5]), cvtpk(y[6], y[7])}; *(u32x4*)(dst + idx) = pk; }
    if (COPY) { f32x4 t0 = {y[0], y[1], y[2], y[3]}, t1 = {y[4], y[5], y[6], y[7]};
      *(LAS f32x4*)(f32copy + idx) = t0; *(LAS f32x4*)(f32copy + idx + 4) = t1; }
  }
}

__device__ __forceinline__ void phase_prologue(const Args& a, LAS char* lds) {
  int tid = threadIdx.x; asm volatile("" : "+v"(tid)); tid &= 511; const int wave = tid >> 6, lane = tid & 63;
  {
    LAS float* sc = (LAS float*)lds;
    LAS float* part = sc + 4096;
    const float* c = a.in[1]; const float* cc = a.in[3];
    for (int i = tid; i < D; i += NTHREADS) { float v = c[i]; sc[i] = v * sigmoidf_(v); float u = cc[i]; sc[D + i] = u * sigmoidf_(u); }
    __syncthreads();
    float* MOD = (float*)(a.ws + WS_MOD);
    for (int u = blockIdx.x; u < 2 * 192; u += gridDim.x) {
      const int L = u / 192, chunk = u % 192;
      const float* W = a.in[4] + (size_t)L * D * 12288 + chunk * 64 + lane;
      float a0 = 0, a1 = 0; const int d0 = wave * 256;
#pragma unroll 8
      for (int dd = 0; dd < 256; ++dd) { const float w = W[(size_t)(d0 + dd) * 12288]; a0 += sc[d0 + dd] * w; a1 += sc[D + d0 + dd] * w; }
      part[(wave * 2 + 0) * 64 + lane] = a0; part[(wave * 2 + 1) * 64 + lane] = a1;
      __syncthreads();
      if (tid < 128) { const int which = tid >> 6; float s = 0;
#pragma unroll
        for (int w = 0; w < 8; ++w) s += part[(w * 2 + which) * 64 + lane];
        const int j = chunk * 64 + lane; MOD[(size_t)(L * 2 + which) * 12288 + j] = s + a.in[5][L * 12288 + j]; }
      __syncthreads();
    }
  }
  LAS unsigned* t32 = (LAS unsigned*)lds;
#if DENSE8_G1
  cvt_matrix_units8(a.in[7], D, N_IN0, (unsigned char*)(a.ws + WS_WIN0), 1, 256.f, t32);
  cvt_matrix_units8(a.in[15], D, N_IN1, (unsigned char*)(a.ws + WS_WIN1), 0, 256.f, t32);
#else
  cvt_matrix_units(a.in[7], D, N_IN0, (bf16_t*)(a.ws + WS_WIN0), 1, blockIdx.x, gridDim.x, t32);
  cvt_matrix_units(a.in[15], D, N_IN1, (bf16_t*)(a.ws + WS_WIN1), 0, blockIdx.x, gridDim.x, t32);
#endif
#if DENSE8_G2
  cvt_matrix_units8(a.in[8], D, D, (unsigned char*)(a.ws + WS_WOUT0), 0, 256.f, t32);
  cvt_matrix_units8(a.in[16], D, D, (unsigned char*)(a.ws + WS_WOUT1), 0, 256.f, t32);
#else
  cvt_matrix_units(a.in[8], D, D, (bf16_t*)(a.ws + WS_WOUT0), 0, blockIdx.x, gridDim.x, t32);
  cvt_matrix_units(a.in[16], D, D, (bf16_t*)(a.ws + WS_WOUT1), 0, blockIdx.x, gridDim.x, t32);
#endif
  cvt_moe_all8(a, t32);
}

__device__ __forceinline__ void phase_modulate0(const Args& a) {
  int tid = threadIdx.x; asm volatile("" : "+v"(tid)); tid &= 511; const int wave = tid >> 6, lane = tid & 63;
  const float* MOD = (const float*)(a.ws + WS_MOD);
  bf16_t* A = (bf16_t*)(a.ws + WS_ABUF);
  for (int it = blockIdx.x; it < MT / 8; it += gridDim.x) {
    const int r = it * 8 + wave;
    const float* src = r < CTXL ? a.in[2] + (size_t)r * D : a.in[0] + (size_t)(r - CTXL) * D;
    const float* mod = MOD + (r < CTXL ? 12288 : 0);
    float v[32]; ld_row_f32(src, lane, v);
    const float rstd = rsqrtf(sumsq32(v) * (1.f / D) + EPS);
#if DENSE8_G1
    modulate_store<false, true>(v, rstd, a.in[6], mod, mod + D, (bf16_t*)((unsigned char*)A + (size_t)r * D), lane, nullptr);
#else
    modulate_store<false>(v, rstd, a.in[6], mod, mod + D, A + (size_t)r * D, lane, nullptr);
#endif
  }
}

__device__ __forceinline__ void rope_cs4(int r, int lane, float (&cs)[4], float (&sn)[4]) {
#pragma unroll
  for (int q = 0; q < 4; ++q) { cs[q] = 1.f; sn[q] = 0.f; }
  if (r >= CTXL) { const int t = r - CTXL; const int l = lane & 15, a = l >> 3, i0 = 4 * (l & 7);
    const float pos = a ? (float)(t & 63) : (float)(t >> 6);
#pragma unroll
    for (int q = 0; q < 4; ++q) { const float inv = powf(10000.f, -(float)(i0 + q) / 32.f); sincosf(pos * inv, &sn[q], &cs[q]); } }
}
__device__ __forceinline__ float sum16lanes(float v) { v += __shfl_xor(v, 1); v += __shfl_xor(v, 2); v += __shfl_xor(v, 4); v += __shfl_xor(v, 8); return v; }
__device__ __forceinline__ void phase_rope_conv0(const Args& a, LAS char* lds, bool dry = false) {
  int tid = threadIdx.x; asm volatile("" : "+v"(tid)); tid &= 511; const int wave = tid >> 6, lane = tid & 63;
  bf16_t* Q = (bf16_t*)(a.ws + WS_QKVU);
  {
    const bf16_t* HG = (const bf16_t*)(a.ws + WS_HG);
    bf16_t* X2 = (bf16_t*)(a.ws + WS_X2);
    LAS char* lt = lds;
    LAS float* part = (LAS float*)(lds + 62 * 2048);
    LAS float* stats = part + 512;
    const float* dw_w = a.in[11]; const float* dw_b = a.in[12]; const float* ln_g = a.in[13]; const float* ln_b = a.in[14];
    const __amdgpu_buffer_rsrc_t wrs = __builtin_amdgcn_make_buffer_rsrc((void*)dw_w, 0, 31 * 1024 * 4, 0x00020000);
    for (int u = blockIdx.x; u < 520; u += gridDim.x) {
      int seg0, seg1, r0;
      if (u < 8) { seg0 = 0; seg1 = CTXL; r0 = u * 32; } else { seg0 = CTXL; seg1 = MT; r0 = CTXL + (u - 8) * 32; }
      for (int c = tid; c < 62 * 128; c += NTHREADS) { const int rr = c >> 7, cc = c & 127, gr = r0 - 15 + rr;
        u32x4 v = {0u, 0u, 0u, 0u}; if (gr >= seg0 && gr < seg1) v = *(const u32x4*)(HG + (size_t)gr * 1024 + cc * 8);
        *(LAS u32x4*)(lt + rr * 2048 + cc * 16) = v; }
      __syncthreads();
      float w0[31], w1[31];
#pragma unroll
      for (int j = 0; j < 31; ++j) { const u32x2 w = __builtin_amdgcn_raw_buffer_load_b64(wrs, tid * 8, j * 4096, 0); w0[j] = __uint_as_float(w[0]); w1[j] = __uint_as_float(w[1]); }
      const f32x2 bb = *(const f32x2*)(dw_b + 2 * tid);
      const f32x2 gg = *(const f32x2*)(ln_g + 2 * tid), gb = *(const f32x2*)(ln_b + 2 * tid);
#pragma unroll 1
      for (int hf = 0; hf < 4; ++hf) {
        float o0[8], o1[8];
        LAS const char* lth = lt + (hf * 8) * 2048 + tid * 4;
#pragma unroll
        for (int r = 0; r < 8; ++r) { o0[r] = bb[0]; o1[r] = bb[1]; }
#pragma unroll
        for (int i = 0; i < 38; ++i) {
          const unsigned p = *(LAS const unsigned*)(lth + i * 2048);
          const float x0 = bflo(p), x1 = bfhi(p);
#pragma unroll
          for (int r = 0; r < 8; ++r) { const int j = i - r; if (j >= 0 && j < 31) { o0[r] += x0 * w0[j]; o1[r] += x1 * w1[j]; } }
        }
#pragma unroll
        for (int r = 0; r < 8; ++r) {
          const float s = wave_sum(o0[r] + o1[r]), q = wave_sum(o0[r] * o0[r] + o1[r] * o1[r]);
          if (lane == 0) { part[(r * 8 + wave) * 2] = s; part[(r * 8 + wave) * 2 + 1] = q; }
        }
        __syncthreads();
        if (tid < 8) { float s = 0, q = 0;
#pragma unroll
          for (int w = 0; w < 8; ++w) { s += part[(tid * 8 + w) * 2]; q += part[(tid * 8 + w) * 2 + 1]; }
          const float mean = s * (1.f / 1024), var = q * (1.f / 1024) - mean * mean;
          stats[tid * 2] = mean; stats[tid * 2 + 1] = rsqrtf(fmaxf(var, 0.f) + EPS); }
        __syncthreads();
#pragma unroll
        for (int r = 0; r < 8; ++r) {
          const float mean = stats[r * 2], rstd = stats[r * 2 + 1];
          float y0 = (o0[r] - mean) * rstd * gg[0] + gb[0], y1 = (o1[r] - mean) * rstd * gg[1] + gb[1];
          y0 = y0 * sigmoid_fast(y0); y1 = y1 * sigmoid_fast(y1);
#if DENSE8_G2
          *(unsigned short*)((unsigned char*)X2 + (size_t)(r0 + hf * 8 + r) * D + 1024 + 2 * tid) = (unsigned short)__builtin_amdgcn_cvt_pk_fp8_f32(y0 * 8.f, y1 * 8.f, 0, false);
#else
          *(unsigned*)(X2 + (size_t)(r0 + hf * 8 + r) * D + 1024 + 2 * tid) = cvtpk(y0, y1);
#endif
        }
      }
      __syncthreads();
    }
  }
  const float* qn = a.in[9]; const float* kn = a.in[10];
  unsigned* kmx = (unsigned*)(a.ws + WS_CTL + CTL_KMAX);
  const int slot = lane >> 4, l16 = lane & 15, e1 = (l16 >> 3) * 64 + 4 * (l16 & 7), e2 = e1 + 32;
  float km0 = 0.f, km1 = 0.f;
  for (int it = blockIdx.x; it < MT / 8; it += gridDim.x) {
    const int r = it * 8 + wave;
    float cs[4], sn[4]; rope_cs4(r, lane, cs, sn);
    bf16_t* rowp = Q + (size_t)r * N_QKV0;
#pragma unroll
    for (int hb = 0; hb < 12; hb += 4) {
      const int hh = hb + slot;
      if (hh < 10) {
        const float* g = hh < 8 ? qn : kn;
        const u32x2 a1 = *(const u32x2*)(rowp + hh * 128 + e1), a2 = *(const u32x2*)(rowp + hh * 128 + e2);
        float x1[4] = {bflo(a1[0]), bfhi(a1[0]), bflo(a1[1]), bfhi(a1[1])}, x2[4] = {bflo(a2[0]), bfhi(a2[0]), bflo(a2[1]), bfhi(a2[1])};
        float ss = 0;
#pragma unroll
        for (int q = 0; q < 4; ++q) ss += x1[q] * x1[q] + x2[q] * x2[q];
        ss = sum16lanes(ss);
        const float rstd = rsqrtf(ss * (1.f / 128) + EPS);
        const f32x4 g1 = *(const f32x4*)(g + e1), g2 = *(const f32x4*)(g + e2);
        float o1[4], o2[4], so = 0;
#pragma unroll
        for (int q = 0; q < 4; ++q) { const float y1 = x1[q] * rstd * g1[q], y2 = x2[q] * rstd * g2[q]; o1[q] = y1 * cs[q] - y2 * sn[q]; o2[q] = y2 * cs[q] + y1 * sn[q]; }
        const u32x2 w1 = {cvtpk(o1[0], o1[1]), cvtpk(o1[2], o1[3])}, w2 = {cvtpk(o2[0], o2[1]), cvtpk(o2[2], o2[3])};
        if (!dry) { *(u32x2*)(rowp + hh * 128 + e1) = w1; *(u32x2*)(rowp + hh * 128 + e2) = w2; }
        if (hb == 8) {
          const unsigned q1 = pack8x4(o1[0], o1[1], o1[2], o1[3]), q2 = pack8x4(o2[0], o2[1], o2[2], o2[3]);
          unsigned char* k8p = (unsigned char*)(a.ws + WS_K8) + (size_t)r * 256 + (hh - 8) * 128;
          *(unsigned*)(k8p + e1) = q1; *(unsigned*)(k8p + e2) = q2;
          so = sum16lanes(sq8x4(q1) + sq8x4(q2)); if (slot == 0) km0 = fmaxf(km0, so); else km1 = fmaxf(km1, so);
        }
      }
    }
  }
  if (l16 == 0 && slot < 2) atomicMax(&kmx[slot], __float_as_uint(slot == 0 ? km0 : km1));
}
__device__ __forceinline__ void phase_rope1(const Args& a, LAS char* lds, bool dry = false) {
  int tid = threadIdx.x; asm volatile("" : "+v"(tid)); tid &= 511; const int wave = tid >> 6, lane = tid & 63;
  bf16_t* Q = (bf16_t*)(a.ws + WS_QKVU);
  unsigned* kmx = (unsigned*)(a.ws + WS_CTL + CTL_KMAX) + 16;
  unsigned char* K8 = (unsigned char*)(a.ws + WS_K8);
  LAS unsigned* lk = (LAS unsigned*)lds;
  if (tid < 16) lk[tid] = 0u;
  __syncthreads();
  const int slot = lane >> 4, l16 = lane & 15, e1 = (l16 >> 3) * 64 + 4 * (l16 & 7), e2 = e1 + 32;
  for (int it = blockIdx.x; it < MT / 8; it += gridDim.x) {
    const int r = it * 8 + wave;
    float cs[4], sn[4]; rope_cs4(r, lane, cs, sn);
    bf16_t* rowp = Q + (size_t)r * N_IN1;
#pragma unroll 2
    for (int hb = (r < CTXL ? 16 : 0); hb < 32; hb += 4) {
      const int hh = hb + slot;
      const u32x2 a1 = *(const u32x2*)(rowp + hh * 128 + e1), a2 = *(const u32x2*)(rowp + hh * 128 + e2);
      const float x1[4] = {bflo(a1[0]), bfhi(a1[0]), bflo(a1[1]), bfhi(a1[1])}, x2[4] = {bflo(a2[0]), bfhi(a2[0]), bflo(a2[1]), bfhi(a2[1])};
      float o1[4], o2[4];
#pragma unroll
      for (int q = 0; q < 4; ++q) { o1[q] = x1[q] * cs[q] - x2[q] * sn[q]; o2[q] = x2[q] * cs[q] + x1[q] * sn[q]; }
      const u32x2 w1 = {cvtpk(o1[0], o1[1]), cvtpk(o1[2], o1[3])}, w2 = {cvtpk(o2[0], o2[1]), cvtpk(o2[2], o2[3])};
      if (r >= CTXL && !dry) { *(u32x2*)(rowp + hh * 128 + e1) = w1; *(u32x2*)(rowp + hh * 128 + e2) = w2; }
      if (hb >= 16) {
        const unsigned q1 = pack8x4(o1[0], o1[1], o1[2], o1[3]), q2 = pack8x4(o2[0], o2[1], o2[2], o2[3]);
        unsigned char* k8p = K8 + (size_t)r * 2048 + (hh - 16) * 128;
        *(unsigned*)(k8p + e1) = q1; *(unsigned*)(k8p + e2) = q2;
        float so = sum16lanes(sq8x4(q1) + sq8x4(q2));
        if (l16 == 0) atomicMax((unsigned*)&lk[hh - 16], __float_as_uint(so));
      }
    }
  }
  __syncthreads();
  if (tid < 16) atomicMax(&kmx[tid], lk[tid]);
  __syncthreads();
  { unsigned char* V8T = (unsigned char*)(a.ws + WS_HG);
    LAS unsigned char* img = (LAS unsigned char*)lds;
    const int k = tid >> 3, cc = tid & 7, kb = k >> 5, kk = k & 31;
    const int j = (kk & 3) | (((kk >> 3) & 3) << 2) | (((kk >> 2) & 1) << 4);
    for (int u = blockIdx.x; u < 8 * (MT / 64); u += gridDim.x) {
      const int h = u / (MT / 64), t = u % (MT / 64);
      const bf16_t* vp = Q + (size_t)(t * 64 + k) * N_IN1 + 4096 + h * 256 + cc * 32;
#pragma unroll
      for (int q = 0; q < 4; ++q) { const u32x4 raw = *(const u32x4*)(vp + 8 * q);
#pragma unroll
        for (int i = 0; i < 4; ++i) { const int p = __builtin_amdgcn_cvt_pk_fp8_f32(bflo(raw[i]), bfhi(raw[i]), 0, false);
#pragma unroll
          for (int hh = 0; hh < 2; ++hh) { const int col = cc * 32 + q * 8 + 2 * i + hh;
            img[col * 64 + (((2 * kb + (j >> 4)) ^ ((col >> 2) & 3)) << 4) + (j & 15)] = (unsigned char)(p >> (8 * hh)); } } }
      __syncthreads();
      unsigned char* dst = V8T + ((size_t)h * (MT / 64) + t) * 16384;
      *(u32x4*)(dst + tid * 16) = *(LAS const u32x4*)(img + tid * 16);
      *(u32x4*)(dst + 8192 + tid * 16) = *(LAS const u32x4*)(img + 8192 + tid * 16);
      __syncthreads();
    }
  }
}

__device__ __forceinline__ void phase_attn(const Args& a, int L, LAS char* lds) {
  const bf16_t* Q = (const bf16_t*)(a.ws + WS_QKVU);
  const unsigned* kmx = (const unsigned*)(a.ws + WS_CTL + CTL_KMAX) + L * 16;
  if (L == 0) {
    bf16_t* X2 = (bf16_t*)(a.ws + WS_X2);
    for (int u = blockIdx.x; u < 520; u += gridDim.x) {
      const int head = u < 512 ? (u & 7) : (u - 512);
      const float kmax2 = __uint_as_float(kmx[head >> 2]);
      if (u < 512) { const int qb = u >> 3; const size_t q0 = (size_t)(CTXL + qb * 256);
        at::attn_body_q8(Q + q0 * N_QKV0 + head * 128, N_QKV0, (const unsigned char*)(a.ws + WS_K8) + (head >> 2) * 128, 256, Q + 1280 + (head >> 2) * 128, N_QKV0, (DENSE8_G2 ? (bf16_t*)((unsigned char*)X2 + q0 * D + head * 128) : X2 + q0 * D + head * 128), D, MT, kmax2, lds);
      } else {
        at::attn_body_q8(Q + head * 128, N_QKV0, (const unsigned char*)(a.ws + WS_K8) + (head >> 2) * 128, 256, Q + 1280 + (head >> 2) * 128, N_QKV0, (DENSE8_G2 ? (bf16_t*)((unsigned char*)X2 + head * 128) : X2 + head * 128), D, CTXL, kmax2, lds); }
    }
  } else {
    bf16_t* O = (bf16_t*)(a.ws + WS_Y);
    for (int u = blockIdx.x; u < 1024; u += gridDim.x) {
      const int x = u & 7, w = u >> 3, hc = x + 8 * (w >> 6), qb = w & 63, h = hc >> 1;
      const float kmax2 = __uint_as_float(kmx[hc]);
      const size_t q0 = (size_t)(CTXL + qb * 256);
      (void)kmax2;
      at::attn_body_d256(Q + q0 * N_IN1 + hc * 128, N_IN1, (const unsigned char*)(a.ws + WS_K8) + hc * 128, 2048,
                         (const unsigned char*)(a.ws + WS_HG) + (size_t)h * (MT / 64) * 16384, O + (size_t)(qb * 256) * 4096 + hc * 256, 4096, MT, lds);
    }
  }
}

__device__ __forceinline__ void phase_diff(const Args& a) {
  int tid = threadIdx.x; asm volatile("" : "+v"(tid)); tid &= 511; const int wave = tid >> 6, lane = tid & 63;
  const bf16_t* O = (const bf16_t*)(a.ws + WS_Y);
  bf16_t* X2 = (bf16_t*)(a.ws + WS_X2);
  const float* lp = a.in[17];
  const float s1 = wave_sum(lp[lane] * lp[128 + lane] + lp[64 + lane] * lp[192 + lane]);
  const float s2 = wave_sum(lp[256 + lane] * lp[384 + lane] + lp[320 + lane] * lp[448 + lane]);
  const float lam = expf(s1) - expf(s2) + LAM_INIT;
  const f32x4 sg = *(const f32x4*)(a.in[18] + 4 * lane);
  for (int it = blockIdx.x; it < SEQ / 8; it += gridDim.x) {
    const int t = it * 8 + wave;
    const bf16_t* op = O + (size_t)t * 4096;
    unsigned char* xp = (unsigned char*)X2 + (size_t)(CTXL + t) * D * (DENSE8_G2 ? 1 : 2);
#pragma unroll 2
    for (int h = 0; h < 8; ++h) {
      const u32x2 a0 = *(const u32x2*)(op + (2 * h) * 256 + 4 * lane), a1 = *(const u32x2*)(op + (2 * h + 1) * 256 + 4 * lane);
      float d[4] = {bflo(a0[0]) - lam * bflo(a1[0]), bfhi(a0[0]) - lam * bfhi(a1[0]), bflo(a0[1]) - lam * bflo(a1[1]), bfhi(a0[1]) - lam * bfhi(a1[1])};
      const float ss = wave_sum(d[0] * d[0] + d[1] * d[1] + d[2] * d[2] + d[3] * d[3]);
      const float rstd = rsqrtf(ss * (1.f / 256) + EPS) * (1.f - LAM_INIT);
#if DENSE8_G2
      const float r8 = rstd * 8.f;
      *(unsigned*)(xp + h * 256 + 4 * lane) = pack8x4(d[0] * r8 * sg[0], d[1] * r8 * sg[1], d[2] * r8 * sg[2], d[3] * r8 * sg[3]);
#else
      u32x2 pk = {cvtpk(d[0] * rstd * sg[0], d[1] * rstd * sg[1]), cvtpk(d[2] * rstd * sg[2], d[3] * rstd * sg[3])};
      *(u32x2*)((bf16_t*)xp + h * 256 + 4 * lane) = pk;
#endif
    }
  }
}

__device__ __forceinline__ void phase_G(const Args& a, int L, LAS char* lds, bool dry = false) {
  int tid = threadIdx.x; asm volatile("" : "+v"(tid)); tid &= 511; const int wave = tid >> 6, lane = tid & 63;
  const int NTOK = L == 0 ? MT : SEQ, ROW0 = L == 0 ? 0 : CTXL;
  const float* ng = a.in[6] + (size_t)L * 4 * D;
  const float* MODL = (const float*)(a.ws + WS_MOD) + (size_t)(L * 2) * 12288;
  const float* router = a.in[19] + (size_t)L * D * NE; const float* rbias = a.in[20] + L * NE;
  const bf16_t* OUT = (const bf16_t*)(a.ws + WS_OUT);
  float* HRES = (float*)(a.ws + WS_HRES);
  bf16_t* F = (bf16_t*)(a.ws + WS_ABUF);
  int* counts = (int*)(a.ws + WS_CTL + CTL_CNT) + L * 64;
  int* top_e = (int*)(a.ws + WS_TOPE); float* top_w = (float*)(a.ws + WS_TOPW); int* top_p = (int*)(a.ws + WS_TOPP);
  LAS float* ft = (LAS float*)lds;
  LAS float* part = ft + 8 * D;
  for (int it = blockIdx.x; it < NTOK / 8; it += gridDim.x) {
    const int r = ROW0 + it * 8 + wave;
    const float* mod = MODL + (r < CTXL ? 12288 : 0);
    {
      float o[32], h[32];
      ld_row_bf16(OUT + (size_t)r * D, lane, o);
      const float* hp = L == 0 ? (r < CTXL ? a.in[2] + (size_t)r * D : a.in[0] + (size_t)(r - CTXL) * D) : HRES + (size_t)r * D;
      ld_row_f32(hp, lane, h);
      const float rstd1 = rsqrtf(sumsq32(o) * (1.f / D) + EPS);
#pragma unroll
      for (int j = 0; j < 4; ++j) { const int idx = 8 * lane + 512 * j;
        float g1[8], gt[8]; ld8f(ng + D + idx, g1); ld8f(mod + 2 * D + idx, gt);
#pragma unroll
        for (int i = 0; i < 8; ++i) h[8 * j + i] += gt[i] * (o[8 * j + i] * rstd1 * g1[i]);
        if (!dry) st8f(HRES + (size_t)r * D + idx, &h[8 * j]); }
      const float rstd2 = rsqrtf(sumsq32(h) * (1.f / D) + EPS);
      modulate_store<true, true>(h, rstd2, ng + 2 * D, mod + 3 * D, mod + 4 * D, (bf16_t*)((unsigned char*)F + (size_t)r * D), lane, ft + wave * D);
    }
    __syncthreads();
    float acc[8] = {0, 0, 0, 0, 0, 0, 0, 0};
    const int d0 = wave * 256;
#pragma unroll 2
    for (int dd = 0; dd < 256; dd += 4) {
      const float* rp = router + (size_t)(d0 + dd) * NE + lane;
      const float r0 = rp[0], r1 = rp[NE], r2 = rp[2 * NE], r3 = rp[3 * NE];
#pragma unroll
      for (int t = 0; t < 8; ++t) { const f32x4 fv = *(LAS const f32x4*)(ft + t * D + d0 + dd); acc[t] += fv[0] * r0 + fv[1] * r1 + fv[2] * r2 + fv[3] * r3; }
    }
#pragma unroll
    for (int t = 0; t < 8; ++t) part[(wave * 8 + t) * 64 + lane] = acc[t];
    __syncthreads();
    float logit = 0;
#pragma unroll
    for (int w = 0; w < 8; ++w) logit += part[(w * 8 + wave) * 64 + lane];
#if MK_DIAG
    ((float*)(a.ws + WS_Y))[(size_t)r * 64 + lane] = logit;
#endif
    const float score = sigmoidf_(logit);
    const float choice = score + rbias[lane];
    int rank = 0; const int gl = lane & 7;
#pragma unroll
    for (int j = 0; j < 8; ++j) { const float o = __shfl(choice, (lane & ~7) | j); rank += (o > choice || (o == choice && j < gl)) ? 1 : 0; }
    float gs = rank < 2 ? choice : 0.f;
    gs += __shfl_xor(gs, 1); gs += __shfl_xor(gs, 2); gs += __shfl_xor(gs, 4);
    int grank = 0; const int g = lane >> 3;
#pragma unroll
    for (int j = 0; j < 8; ++j) { const float o = __shfl(gs, j * 8); grank += (o > gs || (o == gs && j < g)) ? 1 : 0; }
    const bool gsel = grank < 4;
    const float mc = gsel ? choice : -INFINITY;
    int erank = 0;
#pragma unroll 4
    for (int j = 0; j < 64; ++j) { const float o = __int_as_float(__builtin_amdgcn_readlane(__float_as_int(mc), j)); erank += (o > mc || (o == mc && j < lane)) ? 1 : 0; }
    const bool sel = gsel && erank < 8;
    const unsigned long long bal = __ballot(sel);
    const int idx = __popcll(bal & ((1ull << lane) - 1ull));
    const float ssum = wave_sum(sel ? score : 0.f);
    if (sel && !dry) { const int pos = atomicAdd(&counts[lane], 1);
      top_e[r * 8 + idx] = lane; top_w[r * 8 + idx] = score / ssum * 2.5f; top_p[r * 8 + idx] = pos; }
  }
}

__device__ __forceinline__ void moe_tile_prefix(const int* counts, LAS int* ts) {
  if (threadIdx.x == 0) { int s = 0; for (int e = 0; e < 64; ++e) { ts[e] = s; s += (counts[e] + 255) >> 8; } ts[64] = s; }
  __syncthreads();
}
__device__ __forceinline__ void phase_H(const Args& a, int L, LAS char* lds) {
  const int NTOK = L == 0 ? MT : SEQ, ROW0 = L == 0 ? 0 : CTXL;
  const int* counts = (const int*)(a.ws + WS_CTL + CTL_CNT) + L * 64;
  const int* top_e = (const int*)(a.ws + WS_TOPE); const int* top_p = (const int*)(a.ws + WS_TOPP);
  int* tslot = (int*)(a.ws + WS_TSLOT); int* stok = (int*)(a.ws + WS_STOK);
  LAS int* ts = (LAS int*)lds;
  moe_tile_prefix(counts, ts);
  int tid = threadIdx.x; asm volatile("" : "+v"(tid)); tid &= 511;
  const int gt = blockIdx.x * NTHREADS + tid, gs = gridDim.x * NTHREADS;
  for (int i = gt; i < NTOK * 8; i += gs) { const int q = ROW0 * 8 + i; const int e = top_e[q]; const int slot = ts[e] * 256 + top_p[q]; stok[slot] = q >> 3; tslot[q] = slot; }
  for (int i = gt; i < 64 * 256; i += gs) { const int e = i >> 8, p = i & 255, cnt = counts[e], nt = (cnt + 255) >> 8; if (cnt + p < nt * 256) stok[ts[e] * 256 + cnt + p] = ROW0; }
  for (int i = gt; i < NTOK; i += gs) stok[SH_BASE + i] = ROW0 + i;
  __syncthreads();
}
struct DenseSched {
  int nM, nN, r0; const unsigned char* W;
  __device__ __forceinline__ bool unit(int i, int& brow, const unsigned char*& Bt, int& bcol) const {
    const int u = blockIdx.x + i * (int)gridDim.x; if (u >= nM * nN) return false;
    int pm, pn; dense_unit(u, nM, nN, pm, pn); brow = r0 + pm * 256; bcol = pn * 256; Bt = W; return true; }
};
struct MoeSched {
  LAS const int* ts; int TR, NN, total; const unsigned char* W; size_t woff;
  __device__ __forceinline__ bool unit(int i, int& slot0, const unsigned char*& Bt, int& bcol) const {
    for (int u = blockIdx.x + i * (int)gridDim.x; ; u += gridDim.x) {
      const int rnd = u >> 8, b = u & 255, v = rnd * 256 + (b & 7) * 32 + (b >> 3);
      if (rnd * 256 >= total) return false;
      if (v >= total) return false;
      const int m = v / NN, pn = v % NN;
      int e;
      if (m >= TR) { e = 64; slot0 = SH_BASE + 256 * (m - TR); } else { e = 0; while (ts[e + 1] <= m) ++e; slot0 = 256 * m; }
      Bt = W + (size_t)e * WMOE8_E + woff; bcol = pn * 256;
      return true;
    }
  }
};
__device__ __forceinline__ void phase_moe_up(const Args& a, int L, LAS char* lds) {
  const int NSH = L == 0 ? MT / 256 : SEQ / 256;
  const int* counts = (const int*)(a.ws + WS_CTL + CTL_CNT) + L * 64;
  LAS int* ts = (LAS int*)(lds + LDS_CTL + 64);
  moe_tile_prefix(counts, ts);
  const int TR = ts[64], TM = TR + NSH;
  const unsigned char* F = (const unsigned char*)(a.ws + WS_ABUF); const unsigned char* W = (const unsigned char*)(a.ws + WS_WMOE) + (size_t)L * 65 * WMOE8_E;
  const int* stok = (const int*)(a.ws + WS_STOK);
  EpiSwiGLU8 epi{(unsigned char*)(a.ws + WS_ACT), EFF};
  MoeSched sc{ts, TR, 4, TM * 4, W, 0};
  gemm8_run<true, D, D, D>(F, stok, lds, epi, sc);
}
__device__ __forceinline__ void phase_moe_down(const Args& a, int L, LAS char* lds) {
  const int NSH = L == 0 ? MT / 256 : SEQ / 256;
  const int* counts = (const int*)(a.ws + WS_CTL + CTL_CNT) + L * 64;
  LAS int* ts = (LAS int*)(lds + LDS_CTL + 64);
  moe_tile_prefix(counts, ts);
  const int TR = ts[64], TM = TR + NSH;
  const unsigned char* ACT = (const unsigned char*)(a.ws + WS_ACT); const unsigned char* W = (const unsigned char*)(a.ws + WS_WMOE) + (size_t)L * 65 * WMOE8_E;
  EpiPlain8 epi{(unsigned char*)(a.ws + WS_Y), D, 16.f / 128.f};
  MoeSched sc{ts, TR, 8, TM * 8, W, (size_t)1024 * D};
  gemm8_run<false, EFF, EFF, EFF>(ACT, nullptr, lds, epi, sc);
}
__device__ __forceinline__ void phase_combine(const Args& a, int L, bool dry = false) {
  int tid = threadIdx.x; asm volatile("" : "+v"(tid)); tid &= 511; const int wave = tid >> 6, lane = tid & 63;
  const int NTOK = L == 0 ? MT : SEQ, ROW0 = L == 0 ? 0 : CTXL;
  const float* ng = a.in[6] + (size_t)L * 4 * D;
  const float* MODL = (const float*)(a.ws + WS_MOD) + (size_t)(L * 2) * 12288;
  const unsigned char* Y = (const unsigned char*)(a.ws + WS_Y);
  float* HRES = (float*)(a.ws + WS_HRES);
  const int* tslot = (const int*)(a.ws + WS_TSLOT); const float* top_w = (const float*)(a.ws + WS_TOPW);
  for (int it = blockIdx.x; it < NTOK / 8; it += gridDim.x) {
    const int r = ROW0 + it * 8 + wave;
    const float* mod = MODL + (r < CTXL ? 12288 : 0);
    float y[32];
    { float t[32]; ld_row_fp8(Y + (size_t)(SH_BASE + r - ROW0) * D, lane, t);
#pragma unroll
      for (int i = 0; i < 32; ++i) y[i] = t[i] * (1.f / 16.f); }
#pragma unroll 4
    for (int k = 0; k < 8; ++k) { const int slot = tslot[r * 8 + k]; const float w = top_w[r * 8 + k] * (1.f / 16.f);
      float t[32]; ld_row_fp8(Y + (size_t)slot * D, lane, t);
#pragma unroll
      for (int i = 0; i < 32; ++i) y[i] += w * t[i]; }
    const float rstd = rsqrtf(sumsq32(y) * (1.f / D) + EPS);
    float h[32]; ld_row_f32(HRES + (size_t)r * D, lane, h);
#pragma unroll
    for (int j = 0; j < 4; ++j) { const int idx = 8 * lane + 512 * j;
      float g3[8], gt[8]; ld8f(ng + 3 * D + idx, g3); ld8f(mod + 5 * D + idx, gt);
#pragma unroll
      for (int i = 0; i < 8; ++i) h[8 * j + i] += gt[i] * (y[8 * j + i] * rstd * g3[i]);
      if (L == 0) { if (!dry) st8f(HRES + (size_t)r * D + idx, &h[8 * j]); } else st8f(a.out + (size_t)(r - CTXL) * D + idx, &h[8 * j]); }
    if (L == 0) {
      const float* mod1 = MODL + 2 * 12288 + (r < CTXL ? 12288 : 0);
      const float rstd2 = rsqrtf(sumsq32(h) * (1.f / D) + EPS);
#if DENSE8_G1
      modulate_store<false, true>(h, rstd2, a.in[6] + (size_t)4 * D, mod1, mod1 + D, (bf16_t*)((unsigned char*)(a.ws + WS_ABUF) + (size_t)r * D), lane, nullptr);
#else
      modulate_store<false>(h, rstd2, a.in[6] + (size_t)4 * D, mod1, mod1 + D, (bf16_t*)(a.ws + WS_ABUF) + (size_t)r * D, lane, nullptr);
#endif
    }
  }
}

constexpr int NPH = 21;
typedef const __attribute__((address_space(4))) Args* ArgsP;
#if defined(__HIP_DEVICE_COMPILE__)
#define FRESH_ARGS() const Args a = *({ ArgsP _p = (ArgsP)__builtin_amdgcn_kernarg_segment_ptr(); asm volatile("" : "+s"(_p)); _p; })
#else
#define FRESH_ARGS() const Args a = kargs
#endif
__global__ void __launch_bounds__(NTHREADS, 2) fwd(Args kargs) {
  extern __shared__ __attribute__((aligned(16))) unsigned char lds_raw[];
  LAS char* lds = (LAS char*)lds_raw;
  const int lo = kargs.ph_lo, hi = kargs.ph_hi;
  if (threadIdx.x < 64) ((LAS unsigned*)(lds + LDS_CTL))[threadIdx.x] = 0u;
  __syncthreads();
  if (hi - lo > 1) (void)xcd_barrier_post((unsigned*)(kargs.ws + WS_CTL), (volatile LAS unsigned*)(lds + LDS_CTL));
#ifndef PHASE_MASK
#define PHASE_MASK 0xFFFFFFFFu
#endif
#define IN(k) (((PHASE_MASK >> (k)) & 1u) && lo <= (k) && (k) < hi)
#ifndef PH_REPEAT_MASK
#define PH_REPEAT_MASK 0u
#endif
#define REP(k) for (int _rep = 0; _rep < (((PH_REPEAT_MASK >> (k)) & 1u) ? 2 : 1); ++_rep)
#define SEAM(k) do { if ((k) + 1 < hi) { XcdBarrier _b; _b.bar = (unsigned*)(a.ws + WS_CTL); _b.x = xb_xcc_id(); _b.st = (volatile LAS unsigned*)(lds + LDS_CTL); xcd_barrier(_b); } } while (0)

  if (IN(0)) { FRESH_ARGS(); REP(0) phase_prologue(a, lds); SEAM(0); }
  if (IN(1)) { FRESH_ARGS(); REP(1) phase_modulate0(a); SEAM(1); }
#pragma unroll
  for (int L = 0; L < 2; ++L) {
    const int base = 2 + (L == 0 ? 0 : 9);
    if (IN(base + 0)) {
      FRESH_ARGS();
      const int nN = L == 0 ? N_IN0 / 256 : N_IN1 / 256, nM = MT / 256;
#if DENSE8_G1
      const unsigned char* A = (const unsigned char*)(a.ws + WS_ABUF);
      EpiG1 epi{EpiPlain{(bf16_t*)(a.ws + WS_QKVU), L == 0 ? N_QKV0 : N_IN1, 1.f / 256.f}, EpiPair<0>{(bf16_t*)(a.ws + WS_HG), 1024, N_QKV0, 1.f / 256.f}, L == 0 ? N_QKV0 : N_IN1};
      DenseSched sc{nM, nN, 0, (const unsigned char*)(a.ws + (L == 0 ? WS_WIN0 : WS_WIN1))};
      REP(2) gemm8_run<false, D, D, D>(A, nullptr, lds, epi, sc);
#else
      const bf16_t* A = (const bf16_t*)(a.ws + WS_ABUF);
      const bf16_t* Bt = (const bf16_t*)(a.ws + (L == 0 ? WS_WIN0 : WS_WIN1));
      EpiG1 epi{EpiPlain{(bf16_t*)(a.ws + WS_QKVU), L == 0 ? N_QKV0 : N_IN1, 1.f}, EpiPair<0>{(bf16_t*)(a.ws + WS_HG), 1024, N_QKV0, 1.f}, L == 0 ? N_QKV0 : N_IN1};
      REP(2) for (int u = blockIdx.x; u < nM * nN; u += gridDim.x) { int pm, pn; dense_unit(u, nM, nN, pm, pn);
        gemm_tile<false>(A, D, nullptr, pm * 256, Bt, D, pn * 256, D, lds, epi); }
#endif
      SEAM(base + 0);
    }
    if (L == 0) {
      if (IN(3)) { FRESH_ARGS(); if ((PH_REPEAT_MASK >> 3) & 1u) { phase_rope_conv0(a, lds, true); __syncthreads(); } phase_rope_conv0(a, lds); SEAM(3); }
      if (IN(4)) { FRESH_ARGS(); REP(4) phase_attn(a, 0, lds); SEAM(4); }
    } else {
      if (IN(12)) { FRESH_ARGS(); if ((PH_REPEAT_MASK >> 12) & 1u) { phase_rope1(a, lds, true); __syncthreads(); } phase_rope1(a, lds); SEAM(12); }
      if (IN(13)) { FRESH_ARGS(); REP(13) phase_attn(a, 1, lds); SEAM(13); }
      if (IN(14)) { FRESH_ARGS(); REP(14) phase_diff(a); SEAM(14); }
    }
    const int b2 = L == 0 ? 5 : 15;
    if (IN(b2 + 0)) {
      FRESH_ARGS();
      const int nN = D / 256, nM = L == 0 ? MT / 256 : SEQ / 256, r0 = L == 0 ? 0 : CTXL;
#if DENSE8_G2
      const unsigned char* A = (const unsigned char*)(a.ws + WS_X2);
      EpiPlain epi{(bf16_t*)(a.ws + WS_OUT), D, 1.f / 2048.f};
      DenseSched sc{nM, nN, r0, (const unsigned char*)(a.ws + (L == 0 ? WS_WOUT0 : WS_WOUT1))};
      REP(5) gemm8_run<false, D, D, D>(A, nullptr, lds, epi, sc);
#else
      const bf16_t* A = (const bf16_t*)(a.ws + WS_X2);
      const bf16_t* Bt = (const bf16_t*)(a.ws + (L == 0 ? WS_WOUT0 : WS_WOUT1));
      EpiPlain epi{(bf16_t*)(a.ws + WS_OUT), D, 1.f};
      REP(5) for (int u = blockIdx.x; u < nM * nN; u += gridDim.x) { int pm, pn; dense_unit(u, nM, nN, pm, pn);
        gemm_tile<false>(A, D, nullptr, r0 + pm * 256, Bt, D, pn * 256, D, lds, epi); }
#endif
      SEAM(b2 + 0);
    }
    if (IN(b2 + 1)) { FRESH_ARGS(); if ((PH_REPEAT_MASK >> 6) & 1u) { phase_G(a, L, lds, true); __syncthreads(); } phase_G(a, L, lds); SEAM(b2 + 1); }
    if (IN(b2 + 2)) { FRESH_ARGS(); REP(7) phase_H(a, L, lds); SEAM(b2 + 2); }
    if (IN(b2 + 3)) { FRESH_ARGS(); REP(8) phase_moe_up(a, L, lds); SEAM(b2 + 3); }
    if (IN(b2 + 4)) { FRESH_ARGS(); REP(9) phase_moe_down(a, L, lds); SEAM(b2 + 4); }
    if (IN(b2 + 5)) { FRESH_ARGS(); if ((PH_REPEAT_MASK >> 10) & 1u) phase_combine(a, L, true); phase_combine(a, L); SEAM(b2 + 5); }
  }
#undef IN
#undef SEAM
}

#ifndef MK_DIAG
#define MK_DIAG 0
#endif
#if MK_DIAG
__device__ __forceinline__ void rope_cs(int r, int lane, float& cs, float& sn) {
  cs = 1.f; sn = 0.f;
  if (r >= CTXL) { const int t = r - CTXL; const int a = lane >> 5, i = lane & 31;
    const float pos = a ? (float)(t & 63) : (float)(t >> 6);
    const float inv = powf(10000.f, -(float)i / 32.f);
    sincosf(pos * inv, &sn, &cs); }
}
__device__ __forceinline__ bool dclose(float got, float ref, float rtol, float atol) { return fabsf(got - ref) <= rtol * fabsf(ref) + atol; }
__device__ __forceinline__ unsigned dhash(unsigned x) { x ^= x >> 16; x *= 0x7feb352du; x ^= x >> 15; x *= 0x846ca68bu; x ^= x >> 16; return x; }
__device__ float wdot(const bf16_t* arow, const float* W, int ldw, int col, int K, int lane) {
  float s = 0; for (int k = lane; k < K; k += 64) s += bf2f(arow[k]) * W[(size_t)k * ldw + col]; return wave_sum(s); }
__device__ float dq8(const unsigned char* p, size_t i) { const unsigned w = ((const unsigned*)p)[i >> 2]; const int b = (int)(i & 3);
  return b == 0 ? __builtin_amdgcn_cvt_f32_fp8((int)w, 0) : b == 1 ? __builtin_amdgcn_cvt_f32_fp8((int)w, 1) : b == 2 ? __builtin_amdgcn_cvt_f32_fp8((int)w, 2) : __builtin_amdgcn_cvt_f32_fp8((int)w, 3); }
__device__ float wdot8(const unsigned char* arow8, const float* W, int ldw, int col, int K, int lane) {
  float s = 0; for (int k = lane; k < K; k += 64) s += dq8(arow8, k) * W[(size_t)k * ldw + col]; return wave_sum(s); }
__device__ void dflag(int* dg, int s, int bad, int lane) { if (lane == 0 && bad) atomicAdd(&dg[s], bad); }
__device__ const float* h0row(const Args& a, int r) { return r < CTXL ? a.in[2] + (size_t)r * D : a.in[0] + (size_t)(r - CTXL) * D; }
__device__ int pick_row(unsigned h, int lo, int n) { const unsigned m = h % 8; if (m == 0) return lo; if (m == 1) return lo + n - 1; if (m == 2) return lo + 255 < lo + n ? lo + 255 : lo; if (m == 3) return lo + 256 < lo + n ? lo + 256 : lo; return lo + (int)((h >> 3) % (unsigned)n); }
__device__ void naive_attn(const bf16_t* q, const bf16_t* K, const bf16_t* V, int ld, int nkeys, int lane, float& o0, float& o1) {
  const float q0 = bf2f(q[lane]), q1 = bf2f(q[lane + 64]);
  float m = -1e30f, l = 0; o0 = 0; o1 = 0;
  for (int k = 0; k < nkeys; ++k) {
    const float s = wave_sum(q0 * bf2f(K[(size_t)k * ld + lane]) + q1 * bf2f(K[(size_t)k * ld + lane + 64])) * 0.088388347648318440f;
    const float mn = fmaxf(m, s), al = expf(m - mn), p = expf(s - mn);
    l = l * al + p; o0 = o0 * al + p * bf2f(V[(size_t)k * ld + lane]); o1 = o1 * al + p * bf2f(V[(size_t)k * ld + lane + 64]); m = mn;
  }
  o0 /= l; o1 /= l;
}
__global__ void __launch_bounds__(256) diag(Args a, int k) {
  __shared__ float fsh[4][2048];
  __shared__ float csh[4][64];
  const int lane = threadIdx.x & 63, wv = threadIdx.x >> 6, gw = blockIdx.x * 4 + wv;
  int* dg = (int*)(a.ws + WS_CTL + CTL_CNT + 512);
  const float* MOD = (const float*)(a.ws + WS_MOD);
  const bf16_t* AB = (const bf16_t*)(a.ws + WS_ABUF);
  const bf16_t* QK = (const bf16_t*)(a.ws + WS_QKVU);
  const bf16_t* HG = (const bf16_t*)(a.ws + WS_HG);
  const bf16_t* X2 = (const bf16_t*)(a.ws + WS_X2);
  const bf16_t* OUT = (const bf16_t*)(a.ws + WS_OUT);
  const bf16_t* ACT = (const bf16_t*)(a.ws + WS_ACT);
  const bf16_t* Y = (const bf16_t*)(a.ws + WS_Y);
  const float* HRES = (const float*)(a.ws + WS_HRES);
  const int* top_e = (const int*)(a.ws + WS_TOPE); const float* top_w = (const float*)(a.ws + WS_TOPW); const int* top_p = (const int*)(a.ws + WS_TOPP);
  const int* tslot = (const int*)(a.ws + WS_TSLOT); const int* stok = (const int*)(a.ws + WS_STOK);
  const unsigned h = dhash(gw * 7919u + k * 104729u + 17u), h2 = dhash(h + 12345u);
  int bad = 0;
  const int L = k >= 11 ? 1 : 0;
  const int NTOK = L == 0 ? MT : SEQ, ROW0 = L == 0 ? 0 : CTXL;
  const int* counts = (const int*)(a.ws + WS_CTL + CTL_CNT) + L * 64;
  if (k == 0) {
    const int LL = gw & 1, which = (gw >> 1) & 1, j = h % 12288;
    const float* v = which ? a.in[3] : a.in[1];
    float s = 0; for (int d = lane; d < D; d += 64) { const float x = v[d]; s += x * sigmoidf_(x) * a.in[4][((size_t)LL * D + d) * 12288 + j]; }
    s = wave_sum(s) + a.in[5][LL * 12288 + j];
    bad = !dclose(MOD[(LL * 2 + which) * 12288 + j], s, 1e-3f, 1e-3f); dflag(dg, 1, bad, lane);
  } else if (k == 1) {
    const int r = pick_row(h, 0, MT); const float* x = h0row(a, r); const float* mod = MOD + (r < CTXL ? 12288 : 0);
    float ss = 0; for (int d = lane; d < D; d += 64) ss += x[d] * x[d]; ss = wave_sum(ss); const float rstd = rsqrtf(ss / D + EPS);
    for (int d = lane; d < D; d += 64) { const float ref = x[d] * rstd * a.in[6][d] * (1.f + mod[D + d]) + mod[d]; bad += !dclose(bf2f(AB[(size_t)r * D + d]), ref, 0.01f, 0.01f); }
    bad = (int)wave_sum((float)bad); dflag(dg, 2, bad, lane);
  } else if (k == 2 || k == 11) {
    const int r = pick_row(h, 0, MT);
    if (L == 0) {
      const int c = h2 % N_QKV0; const float ref = wdot(AB + (size_t)r * D, a.in[7], N_IN0, c, D, lane);
      bad = !dclose(bf2f(QK[(size_t)r * N_QKV0 + c]), ref, 0.02f, 0.05f); dflag(dg, 3, bad, lane);
      const int ch = (h2 >> 11) % 1024; const float av = wdot(AB + (size_t)r * D, a.in[7], N_IN0, N_QKV0 + ch, D, lane), gv = wdot(AB + (size_t)r * D, a.in[7], N_IN0, N_QKV0 + 1024 + ch, D, lane);
      bad = !dclose(bf2f(HG[(size_t)r * 1024 + ch]), av * sigmoidf_(gv), 0.03f, 0.05f); dflag(dg, 4, bad, lane);
    } else {
      const int c = h2 % N_IN1; const float ref = wdot(AB + (size_t)r * D, a.in[15], N_IN1, c, D, lane);
      bad = !dclose(bf2f(QK[(size_t)r * N_IN1 + c]), ref, 0.02f, 0.05f); dflag(dg, 15, bad, lane);
    }
  } else if (k == 3) {
    { const int r = pick_row(h, 0, MT), hh = h2 % 10; const float* g = hh < 8 ? a.in[9] : a.in[10];
      float raw0 = 0, raw1 = 0;
      for (int d = 0; d < 128; ++d) { const float v = wdot(AB + (size_t)r * D, a.in[7], N_IN0, hh * 128 + d, D, lane); if (d == lane) raw0 = v; if (d == lane + 64) raw1 = v; }
      const float rstd = rsqrtf(wave_sum(raw0 * raw0 + raw1 * raw1) / 128.f + EPS);
      const float y0 = raw0 * rstd * g[lane], y1 = raw1 * rstd * g[lane + 64];
      float cs, sn; rope_cs(r, lane, cs, sn);
      const float cs0 = __shfl(cs, lane & 31), sn0 = __shfl(sn, lane & 31), cs1 = __shfl(cs, 32 + (lane & 31)), sn1 = __shfl(sn, 32 + (lane & 31));
      const float p0 = __shfl_xor(y0, 32), p1 = __shfl_xor(y1, 32);
      const float o0 = (lane < 32) ? y0 * cs0 - p0 * sn0 : y0 * cs0 + p0 * sn0;
      const float o1 = (lane < 32) ? y1 * cs1 - p1 * sn1 : y1 * cs1 + p1 * sn1;
      bad = !dclose(bf2f(QK[(size_t)r * N_QKV0 + hh * 128 + lane]), o0, 0.03f, 0.05f) + !dclose(bf2f(QK[(size_t)r * N_QKV0 + hh * 128 + 64 + lane]), o1, 0.03f, 0.05f);
      bad = (int)wave_sum((float)bad); dflag(dg, 5, bad, lane); }
    { const int r = pick_row(h2, 0, MT); const int seg0 = r < CTXL ? 0 : CTXL, seg1 = r < CTXL ? CTXL : MT;
      float cv[16]; float s1 = 0, s2 = 0;
      for (int q = 0; q < 16; ++q) { const int c = lane + 64 * q; float acc = a.in[12][c];
        for (int j = 0; j < 31; ++j) { const int rr = r + j - 15; if (rr >= seg0 && rr < seg1) acc += bf2f(HG[(size_t)rr * 1024 + c]) * a.in[11][j * 1024 + c]; }
        cv[q] = acc; s1 += acc; s2 += acc * acc; }
      s1 = wave_sum(s1); s2 = wave_sum(s2); const float mean = s1 / 1024.f, rstd = rsqrtf(s2 / 1024.f - mean * mean + EPS);
      bad = 0;
      for (int q = 0; q < 16; ++q) { const int c = lane + 64 * q; float y = (cv[q] - mean) * rstd * a.in[13][c] + a.in[14][c]; y = y * sigmoidf_(y);
        bad += !dclose(bf2f(X2[(size_t)r * D + 1024 + c]), y, 0.03f, 0.03f); }
      bad = (int)wave_sum((float)bad); dflag(dg, 6, bad, lane); }
  } else if (k == 4) {
    if (gw < 64) { const int r = pick_row(h, 0, MT), head = h2 % 8; const int nkeys = r < CTXL ? CTXL : MT;
      float o0, o1; naive_attn(QK + (size_t)r * N_QKV0 + head * 128, QK + 1024 + (head >> 2) * 128, QK + 1280 + (head >> 2) * 128, N_QKV0, nkeys, lane, o0, o1);
      const float rt = r < CTXL ? 0.15f : 0.05f, at_ = r < CTXL ? 0.04f : 0.01f;
      bad = !dclose(bf2f(X2[(size_t)r * D + head * 128 + lane]), o0, rt, at_) + !dclose(bf2f(X2[(size_t)r * D + head * 128 + 64 + lane]), o1, rt, at_);
      bad = (int)wave_sum((float)bad); dflag(dg, r < CTXL ? 26 : 7, bad, lane); }
  } else if (k == 5 || k == 15) {
    const int r = pick_row(h, ROW0, NTOK), c = h2 % D; const float ref = wdot(X2 + (size_t)r * D, L == 0 ? a.in[8] : a.in[16], D, c, D, lane);
    bad = !dclose(bf2f(OUT[(size_t)r * D + c]), ref, 0.02f, 0.05f); dflag(dg, L == 0 ? 8 : 19, bad, lane);
  } else if (k == 6 || k == 16) {
    const int r = pick_row(h, ROW0, NTOK); const float* mod = MOD + (size_t)(L * 2) * 12288 + (r < CTXL ? 12288 : 0); const float* ng = a.in[6] + (size_t)L * 4 * D;
    float ss = 0; for (int d = lane; d < D; d += 64) { const float o = bf2f(OUT[(size_t)r * D + d]); ss += o * o; } ss = wave_sum(ss); const float rstd1 = rsqrtf(ss / D + EPS);
    bad = 0;
    if (L == 0) { const float* x = h0row(a, r); for (int d = lane; d < D; d += 64) { const float ref = x[d] + mod[2 * D + d] * (bf2f(OUT[(size_t)r * D + d]) * rstd1 * ng[D + d]); bad += !dclose(HRES[(size_t)r * D + d], ref, 1e-3f, 1e-3f); } }
    float s2 = 0; for (int d = lane; d < D; d += 64) { const float x = HRES[(size_t)r * D + d]; s2 += x * x; } s2 = wave_sum(s2); const float rstd2 = rsqrtf(s2 / D + EPS);
    for (int d = lane; d < D; d += 64) { const float f = HRES[(size_t)r * D + d] * rstd2 * ng[2 * D + d] * (1.f + mod[4 * D + d]) + mod[3 * D + d]; fsh[wv][d] = f; bad += !dclose(dq8((const unsigned char*)AB + (size_t)r * D, d), f, 0.07f, 0.01f); }
    bad = (int)wave_sum((float)bad); dflag(dg, L == 0 ? 9 : 20, bad, lane);
    __syncthreads();
    float lg = 0; for (int d = 0; d < D; ++d) lg += fsh[wv][d] * a.in[19][((size_t)L * D + d) * NE + lane];
    const float sc = sigmoidf_(lg); csh[wv][lane] = sc + a.in[20][L * NE + lane];
    __syncthreads();
    { const float plg = ((const float*)(a.ws + WS_Y))[(size_t)r * 64 + lane]; int lb = !dclose(plg, lg, 1e-3f, 1e-3f); lb = (int)wave_sum((float)lb); if (lane == 0 && lb) { atomicAdd(&dg[32 + (L == 0 ? 10 : 21) + 3], 1); atomicOr(&dg[60], 1 << (r & 7)); } }
    unsigned long long wsel;
    { const float choice = csh[wv][lane]; int rank = 0; const int gl = lane & 7;
      for (int j = 0; j < 8; ++j) { const float o = __shfl(choice, (lane & ~7) | j); rank += (o > choice || (o == choice && j < gl)) ? 1 : 0; }
      float gs = rank < 2 ? choice : 0.f; gs += __shfl_xor(gs, 1); gs += __shfl_xor(gs, 2); gs += __shfl_xor(gs, 4);
      int grank = 0; const int g = lane >> 3;
      for (int j = 0; j < 8; ++j) { const float o = __shfl(gs, j * 8); grank += (o > gs || (o == gs && j < g)) ? 1 : 0; }
      const bool gsel = grank < 4; const float mc = gsel ? choice : -INFINITY; int erank = 0;
      for (int j = 0; j < 64; ++j) { const float o = __shfl(mc, j); erank += (o > mc || (o == mc && j < lane)) ? 1 : 0; }
      wsel = __ballot(gsel && erank < 8); }
    int setbad = 0;
    if (lane == 0) {
      float gsc[8]; for (int g = 0; g < 8; ++g) { float m1 = -1e30f, m2 = -1e30f; for (int j = 0; j < 8; ++j) { const float v = csh[wv][g * 8 + j]; if (v > m1) { m2 = m1; m1 = v; } else if (v > m2) m2 = v; } gsc[g] = m1 + m2; }
      bool gs[8] = {false, false, false, false, false, false, false, false};
      for (int t = 0; t < 4; ++t) { int bi = 0; float bv = -1e30f; for (int g = 0; g < 8; ++g) if (!gs[g] && gsc[g] > bv) { bv = gsc[g]; bi = g; } gs[bi] = true; }
      unsigned long long selm = 0; for (int t = 0; t < 8; ++t) { int bi = 0; float bv = -1e30f; for (int e = 0; e < 64; ++e) if (gs[e >> 3] && !((selm >> e) & 1ull) && csh[wv][e] > bv) { bv = csh[wv][e]; bi = e; } selm |= 1ull << bi; }
      unsigned long long got = 0; for (int t = 0; t < 8; ++t) { const int e = top_e[r * 8 + t]; if (e < 0 || e > 63) setbad = 1000; else got |= 1ull << e; }
      if (setbad == 0 && got != selm) setbad = 1;
      if (wsel != selm) atomicAdd(&dg[32 + (L == 0 ? 10 : 21) + 4], 1);
    }
    setbad = __shfl(setbad, 0);
    { float wgot = -1.f; int mine = 0; for (int t = 0; t < 8; ++t) if (top_e[r * 8 + t] == lane) { mine = 1; wgot = top_w[r * 8 + t]; }
      const float ssum = wave_sum(mine ? sc : 0.f);
      int wbad = (mine && !dclose(wgot, sc / ssum * 2.5f, 0.01f, 1e-3f)) ? 1 : 0; wbad = (int)wave_sum((float)wbad);
      if (lane == 0) { int* q = &dg[32 + (L == 0 ? 10 : 21)]; if (setbad >= 1000) atomicAdd(q + 1, 1); else if (setbad) atomicAdd(q, 1); else if (wbad) atomicAdd(q + 2, 1); } }
  } else if (k == 7 || k == 17) {
    const int r = pick_row(h, ROW0, NTOK), t = h2 % 8, q = r * 8 + t; const int slot = tslot[q], e = top_e[q];
    int ts0 = 0; for (int j = 0; j < e; ++j) ts0 += (counts[j] + 255) >> 8;
    bad = (slot < ts0 * 256 || slot >= ts0 * 256 + counts[e] || stok[slot] != r || top_p[q] != slot - ts0 * 256) ? 1 : 0;
    bad += (stok[SH_BASE + r - ROW0] != r) ? 1 : 0;
    dflag(dg, L == 0 ? 11 : 22, bad, lane);
  } else if (k == 8 || k == 18 || k == 9 || k == 19) {
    int TR = 0; for (int j = 0; j < 64; ++j) TR += (counts[j] + 255) >> 8;
    int slot, e;
    if ((h & 3) == 0) { slot = SH_BASE + (int)((h >> 2) % (unsigned)NTOK); e = 64; }
    else { e = (h >> 2) % 64; int guard = 0; while (counts[e] == 0 && guard++ < 64) e = (e + 1) % 64; int ts0 = 0; for (int j = 0; j < e; ++j) ts0 += (counts[j] + 255) >> 8;
      const unsigned m = (h >> 8) % 4; const int cnt = counts[e]; const int p = m == 0 ? 0 : m == 1 ? cnt - 1 : (int)((h >> 10) % (unsigned)cnt); slot = ts0 * 256 + p; }
    const int tok = stok[slot];
    if (k == 8 || k == 18) {
      const int ch = h2 % EFF;
      const float* Wg = e < 64 ? a.in[21] + ((size_t)L * 64 + e) * D * EFF : a.in[24] + (size_t)L * D * EFF;
      const float* Wu = e < 64 ? a.in[22] + ((size_t)L * 64 + e) * D * EFF : a.in[25] + (size_t)L * D * EFF;
      const unsigned char* F8 = (const unsigned char*)AB + (size_t)tok * D;
      const float gv = wdot8(F8, Wg, EFF, ch, D, lane), uv = wdot8(F8, Wu, EFF, ch, D, lane);
      bad = !dclose(dq8((const unsigned char*)ACT + (size_t)slot * EFF, ch), gv * sigmoidf_(gv) * uv, 0.2f, 0.15f); dflag(dg, L == 0 ? 12 : 23, bad, lane);
    } else {
      const int c = h2 % D; const float* Wd = e < 64 ? a.in[23] + ((size_t)L * 64 + e) * EFF * D : a.in[26] + (size_t)L * EFF * D;
      const float ref = wdot8((const unsigned char*)ACT + (size_t)slot * EFF, Wd, D, c, EFF, lane);
      bad = !dclose(dq8((const unsigned char*)Y + (size_t)slot * D, c) * (1.f / 16.f), ref, 0.2f, 0.15f); dflag(dg, L == 0 ? 13 : 24, bad, lane);
    }
  } else if (k == 10 || k == 20) {
    const int r = pick_row(h, ROW0, NTOK); const float* mod = MOD + (size_t)(L * 2) * 12288 + (r < CTXL ? 12288 : 0); const float* ng = a.in[6] + (size_t)L * 4 * D;
    float ss = 0; for (int d = lane; d < D; d += 64) { const unsigned char* Y8 = (const unsigned char*)Y; float y = dq8(Y8 + (size_t)(SH_BASE + r - ROW0) * D, d) * (1.f / 16.f); for (int t = 0; t < 8; ++t) y += top_w[r * 8 + t] * dq8(Y8 + (size_t)tslot[r * 8 + t] * D, d) * (1.f / 16.f); fsh[wv][d] = y; ss += y * y; }
    ss = wave_sum(ss); const float rstd = rsqrtf(ss / D + EPS);
    bad = 0;
    if (L == 0) { float s2 = 0; for (int d = lane; d < D; d += 64) { const float x = HRES[(size_t)r * D + d]; s2 += x * x; } s2 = wave_sum(s2); const float rstd2 = rsqrtf(s2 / D + EPS);
      const float* mod1 = MOD + (size_t)2 * 12288 + (r < CTXL ? 12288 : 0);
      for (int d = lane; d < D; d += 64) { const float ref = HRES[(size_t)r * D + d] * rstd2 * a.in[6][4 * D + d] * (1.f + mod1[D + d]) + mod1[d]; bad += !dclose(bf2f(AB[(size_t)r * D + d]), ref, 0.01f, 0.01f); } }
    else { for (int d = lane; d < D; d += 64) { const float ref = HRES[(size_t)r * D + d] + mod[5 * D + d] * (fsh[wv][d] * rstd * ng[3 * D + d]); bad += !dclose(a.out[(size_t)(r - CTXL) * D + d], ref, 1e-3f, 1e-3f); } }
    bad = (int)wave_sum((float)bad); dflag(dg, L == 0 ? 14 : 25, bad, lane);
  } else if (k == 12) {
    const int r = pick_row(h, CTXL, SEQ), hh = h2 % 32;
    float raw0 = 0, raw1 = 0;
    for (int d = 0; d < 128; ++d) { const float v = wdot(AB + (size_t)r * D, a.in[15], N_IN1, hh * 128 + d, D, lane); if (d == lane) raw0 = v; if (d == lane + 64) raw1 = v; }
    float cs, sn; rope_cs(r, lane, cs, sn);
    const float cs0 = __shfl(cs, lane & 31), sn0 = __shfl(sn, lane & 31), cs1 = __shfl(cs, 32 + (lane & 31)), sn1 = __shfl(sn, 32 + (lane & 31));
    const float p0 = __shfl_xor(raw0, 32), p1 = __shfl_xor(raw1, 32);
    const float o0 = (lane < 32) ? raw0 * cs0 - p0 * sn0 : raw0 * cs0 + p0 * sn0;
    const float o1 = (lane < 32) ? raw1 * cs1 - p1 * sn1 : raw1 * cs1 + p1 * sn1;
    bad = !dclose(bf2f(QK[(size_t)r * N_IN1 + hh * 128 + lane]), o0, 0.03f, 0.05f) + !dclose(bf2f(QK[(size_t)r * N_IN1 + hh * 128 + 64 + lane]), o1, 0.03f, 0.05f);
    bad = (int)wave_sum((float)bad); dflag(dg, 16, bad, lane);
  } else if (k == 13) {
    if (gw < 64) { const int r = pick_row(h, CTXL, SEQ), hc = h2 % 16, vh = (h2 >> 4) & 1, hd = hc >> 1;
      float o0, o1; naive_attn(QK + (size_t)r * N_IN1 + hc * 128, QK + 2048 + hc * 128, QK + 4096 + hd * 256 + vh * 128, N_IN1, MT, lane, o0, o1);
      const bf16_t* O = Y + (size_t)(r - CTXL) * 4096 + hc * 256 + vh * 128;
      bad = !dclose(bf2f(O[lane]), o0, 0.05f, 0.01f) + !dclose(bf2f(O[64 + lane]), o1, 0.05f, 0.01f);
      bad = (int)wave_sum((float)bad); dflag(dg, 17, bad, lane); }
  } else if (k == 14) {
    const int r = pick_row(h, CTXL, SEQ), hd = h2 % 8; const float* lp = a.in[17];
    float s1 = 0, s2 = 0; for (int i = lane; i < 128; i += 64) { s1 += lp[i] * lp[128 + i]; s2 += lp[256 + i] * lp[384 + i]; } s1 = wave_sum(s1); s2 = wave_sum(s2);
    const float lam = expf(s1) - expf(s2) + LAM_INIT; const bf16_t* O = Y + (size_t)(r - CTXL) * 4096;
    float dv[4], ss = 0; for (int i = 0; i < 4; ++i) { const int d = lane + 64 * i; dv[i] = bf2f(O[(2 * hd) * 256 + d]) - lam * bf2f(O[(2 * hd + 1) * 256 + d]); ss += dv[i] * dv[i]; }
    ss = wave_sum(ss); const float rstd = rsqrtf(ss / 256.f + EPS) * (1.f - LAM_INIT); bad = 0;
    for (int i = 0; i < 4; ++i) { const int d = lane + 64 * i; bad += !dclose(bf2f(X2[(size_t)r * D + hd * 256 + d]), dv[i] * rstd * a.in[18][d], 0.02f, 0.01f); }
    bad = (int)wave_sum((float)bad); dflag(dg, 18, bad, lane);
  }
}
__global__ void diag_encode(Args a) {
  const int* dg = (const int*)(a.ws + WS_CTL + CTL_CNT + 512);
  int s = 0;
  int sub = 0;
  for (int i = 1; i < 32; ++i) { int v = dg[i]; if (i == 10 || i == 21) { v = (dg[32 + i] > 25 ? 1 : 0) + (dg[33 + i] > 0 ? 2 : 0) + (dg[34 + i] > 0 ? 4 : 0) + (dg[35 + i] > 0 ? 8 : 0) + (dg[36 + i] > 0 ? 16 : 0); sub = v; } if (v) { s = i; break; } }
  if (s == 0) return;
  const float c = sub ? 30.f + 8.f * sub : 10.f * s;
  for (size_t i = (size_t)blockIdx.x * blockDim.x + threadIdx.x; i < (size_t)SEQ * D; i += (size_t)gridDim.x * blockDim.x) a.out[i] = c;
}
#endif

extern "C" void kernel_launch(void* const* d_in, const int* in_sizes, int n_in, void* d_out, int out_size, void* d_ws, size_t ws_size, hipStream_t stream) {
  static int grid = 0;
  if (grid == 0) {
    if (n_in != 27 || out_size != SEQ * D || ws_size < WS_END) { fprintf(stderr, "kernel_launch: unexpected shapes (n_in %d out %d ws %zu need %zu)\n", n_in, out_size, ws_size, (size_t)WS_END); grid = -1; return; }
    if (hipFuncSetAttribute((const void*)fwd, hipFuncAttributeMaxDynamicSharedMemorySize, LDS_BYTES) != hipSuccess) { fprintf(stderr, "kernel_launch: hipFuncSetAttribute failed\n"); grid = -1; return; }
    int dev = 0, cus = 0, per_cu = 0;
    hipGetDevice(&dev); hipDeviceGetAttribute(&cus, hipDeviceAttributeMultiprocessorCount, dev);
    if (hipOccupancyMaxActiveBlocksPerMultiprocessor(&per_cu, (const void*)fwd, NTHREADS, LDS_BYTES) != hipSuccess || per_cu < 1) fprintf(stderr, "kernel_launch: occupancy query says %d\n", per_cu);
    (void)hipGetLastError();
    grid = cus < 256 ? cus : 256;
    if (grid != 256) fprintf(stderr, "kernel_launch: %d CUs (expected 256)\n", cus);
  }
  if (grid < 0) return;
  hipMemsetAsync((char*)d_ws + WS_CTL, 0, CTL_BYTES, stream);
  Args a{};
  for (int i = 0; i < 27; ++i) a.in[i] = (const float*)d_in[i];
  a.out = (float*)d_out; a.ws = (unsigned char*)d_ws;
#if MK_MULTI
  for (int k = 0; k < NPH; ++k) { a.ph_lo = k; a.ph_hi = k + 1; hipLaunchKernelGGL(fwd, dim3(grid), dim3(NTHREADS), LDS_BYTES, stream, a);
#if MK_DIAG
    hipLaunchKernelGGL(diag, dim3(64), dim3(256), 0, stream, a, k);
#endif
  }
#if MK_DIAG
  hipLaunchKernelGGL(diag_encode, dim3(1024), dim3(256), 0, stream, a);
#endif
#else
  a.ph_lo = 0; a.ph_hi = NPH;
  hipLaunchKernelGGL(fwd, dim3(grid), dim3(NTHREADS), LDS_BYTES, stream, a);
#endif
  const hipError_t le = hipPeekAtLastError();
  if (le != hipSuccess) fprintf(stderr, "kernel_launch: launch failed: %s\n", hipGetErrorName(le));
}
```

```cpp
#include <hip/hip_runtime.h>
#include <cstdio>
#include <cstdint>

#define MK_DIAG 0
#ifndef DENSE8_G1
#define DENSE8_G1 0
#endif
#ifndef DENSE8_G2
#define DENSE8_G2 0
#endif
#ifndef MK_MULTI
#define MK_MULTI 0
#endif

#define LAS __attribute__((address_space(3)))
typedef unsigned short bf16_t;
typedef short bf16x8 __attribute__((ext_vector_type(8)));
typedef short s16x4 __attribute__((ext_vector_type(4)));
typedef float f32x4 __attribute__((ext_vector_type(4)));
typedef float f32x2 __attribute__((ext_vector_type(2)));
typedef float f32x16 __attribute__((ext_vector_type(16)));
typedef unsigned u32x4 __attribute__((ext_vector_type(4)));
typedef unsigned u32x2 __attribute__((ext_vector_type(2)));

constexpr int D = 2048, SEQ = 16384, CTXL = 256, MT = SEQ + CTXL;
constexpr int NE = 64, TOPK = 8, EFF = 512;
constexpr int N_IN0 = 3584, N_QKV0 = 1536, N_IN1 = 6144;
constexpr float EPS = 1e-6f;
constexpr float LAM_INIT = 0.35550907f;
constexpr int SH_BASE = SEQ * 0 + (MT * TOPK) + NE * 256;
constexpr int NSLOT = SH_BASE + MT;
constexpr int NTHREADS = 512;
constexpr int LDS_BYTES = 131072 + 1024;
constexpr int LDS_CTL = 131072;

constexpr size_t al256(size_t x) { return (x + 255) & ~(size_t)255; }
constexpr size_t WS_CTL   = 0;
constexpr size_t CTL_BYTES = 32768;
constexpr size_t CTL_CNT  = 16384;
constexpr size_t CTL_KMAX = 16384 + 2048;
constexpr size_t WS_MOD   = CTL_BYTES;
constexpr size_t WS_WIN0  = al256(WS_MOD + 2 * 2 * 12288 * 4);
constexpr size_t WS_WOUT0 = al256(WS_WIN0 + (size_t)N_IN0 * D * 2);
constexpr size_t WS_WIN1  = al256(WS_WOUT0 + (size_t)D * D * 2);
constexpr size_t WS_WOUT1 = al256(WS_WIN1 + (size_t)N_IN1 * D * 2);
constexpr size_t WMOE_E   = (size_t)1024 * D + (size_t)D * EFF;
constexpr size_t WS_WMOE  = al256(WS_WOUT1 + (size_t)D * D * 2);
constexpr size_t WS_HRES  = al256(WS_WMOE + 65 * WMOE_E * 2);
constexpr size_t WS_ABUF  = al256(WS_HRES + (size_t)MT * D * 4);
constexpr size_t WS_QKVU  = al256(WS_ABUF + (size_t)MT * D * 2);
constexpr size_t WS_HG    = al256(WS_QKVU + (size_t)MT * N_IN1 * 2);
constexpr size_t WS_X2    = al256(WS_HG + (size_t)MT * 1024 * 2);
constexpr size_t WS_OUT   = al256(WS_X2 + (size_t)MT * D * 2);
constexpr size_t WS_ACT   = al256(WS_OUT + (size_t)MT * D * 2);
constexpr size_t WS_K8    = WS_ACT + al256((size_t)NSLOT * EFF);
constexpr size_t V8T0_OFF = (size_t)8 << 20;
constexpr size_t WS_Y     = al256(WS_ACT + (size_t)NSLOT * EFF * 2);
constexpr size_t WS_TOPE  = al256(WS_Y + (size_t)NSLOT * D * 2);
constexpr size_t WS_TOPW  = al256(WS_TOPE + (size_t)MT * TOPK * 4);
constexpr size_t WS_TOPP  = al256(WS_TOPW + (size_t)MT * TOPK * 4);
constexpr size_t WS_TSLOT = al256(WS_TOPP + (size_t)MT * TOPK * 4);
constexpr size_t WS_STOK  = al256(WS_TSLOT + (size_t)MT * TOPK * 4);
constexpr size_t WS_END   = al256(WS_STOK + (size_t)NSLOT * 4);

struct Args { const float* in[27]; float* out; unsigned char* ws; int ph_lo, ph_hi; };

__device__ __forceinline__ float bflo(unsigned x) { return __uint_as_float(x << 16); }
__device__ __forceinline__ float bfhi(unsigned x) { return __uint_as_float(x & 0xffff0000u); }
__device__ __forceinline__ float bf2f(bf16_t b) { return __uint_as_float(((unsigned)b) << 16); }
__device__ __forceinline__ unsigned cvtpk(float lo, float hi) { unsigned r; asm("v_cvt_pk_bf16_f32 %0, %1, %2" : "=v"(r) : "v"(lo), "v"(hi)); return r; }
__device__ __forceinline__ bf16_t f2bf(float x) { return (bf16_t)(cvtpk(x, 0.f) & 0xffffu); }
__device__ __forceinline__ float wave_sum(float v) {
#pragma unroll
  for (int o = 32; o; o >>= 1) v += __shfl_xor(v, o);
  return v;
}
__device__ __forceinline__ float sigmoidf_(float x) { return 1.f / (1.f + expf(-x)); }
__device__ __forceinline__ float sigmoid_fast(float x) { return __builtin_amdgcn_rcpf(1.f + __builtin_amdgcn_exp2f(-1.4426950408889634f * x)); }

__device__ __forceinline__ float clamp8e(float x) { return fminf(fmaxf(x, -448.f), 448.f); }
__device__ __forceinline__ unsigned pack8x4(float a, float b, float c, float d) {
  int p = __builtin_amdgcn_cvt_pk_fp8_f32(clamp8e(a), clamp8e(b), 0, false); p = __builtin_amdgcn_cvt_pk_fp8_f32(clamp8e(c), clamp8e(d), p, true); return (unsigned)p; }
__device__ __forceinline__ float sq8x4(unsigned p) {
  const float a = __builtin_amdgcn_cvt_f32_fp8((int)p, 0), b = __builtin_amdgcn_cvt_f32_fp8((int)p, 1), c = __builtin_amdgcn_cvt_f32_fp8((int)p, 2), d = __builtin_amdgcn_cvt_f32_fp8((int)p, 3);
  return a * a + b * b + c * c + d * d; }
typedef int v8i_ __attribute__((ext_vector_type(8)));
typedef int v4i __attribute__((ext_vector_type(4)));
#define XB_TMO      128
#define XB_XCNT(j)  (256  + 64 * (j))
#define XB_XSUB(j)  (1280 + 64 * (j))
#define XB_XGEN(j)  (2304 + 64 * (j))
#define XB_TOP      3328
#define XB_TOPGEN   3392
#define XCD_BAR_WORDS 3456
#define XB_SPIN_CAP (1u << 22)
__device__ __forceinline__ unsigned xb_ld(unsigned* p)              { return __hip_atomic_load(p, __ATOMIC_RELAXED, __HIP_MEMORY_SCOPE_AGENT); }
__device__ __forceinline__ unsigned xb_add(unsigned* p, unsigned v) { return __hip_atomic_fetch_add(p, v, __ATOMIC_RELAXED, __HIP_MEMORY_SCOPE_AGENT); }
__device__ __forceinline__ unsigned xb_xcc_id() { return (unsigned)__builtin_amdgcn_s_getreg((3 << 11) | 20) & 0xFu; }
#define XB_SPIN(cond, bar) do { unsigned _sp = 0; while (cond) { __builtin_amdgcn_s_sleep(1); \
    if ((++_sp & 255u) == 0u) { if (xb_ld(&(bar)[XB_TMO])) break; if (_sp > XB_SPIN_CAP) { atomicAdd(&(bar)[XB_TMO], 1u); break; } } } } while (0)
struct XcdBarrier { unsigned* bar; unsigned x; volatile LAS unsigned* st; };
__device__ __forceinline__ XcdBarrier xcd_barrier_post(unsigned* bar, volatile LAS unsigned* st) {
    XcdBarrier b; b.bar = bar; b.x = xb_xcc_id(); b.st = st;
    if (threadIdx.x == 0) (void)xb_add(&bar[XB_XCNT(b.x)], 1u);
    return b;
}
__device__ __forceinline__ void xcd_barrier_complete(unsigned* bar, unsigned x, unsigned& nloc, unsigned& nx) {
    const unsigned G = gridDim.x * gridDim.y * gridDim.z;
    unsigned sum, cnt, mine, sp = 0u;
    for (;;) {
        sum = 0u; cnt = 0u; mine = 0u;
#pragma unroll
        for (unsigned j = 0; j < 16; ++j) { const unsigned c = xb_ld(&bar[XB_XCNT(j)]); sum += c; cnt += (c > 0u) ? 1u : 0u; mine = (j == x) ? c : mine; }
        if (sum == G) break;
        __builtin_amdgcn_s_sleep(1);
        if ((++sp & 255u) == 0u) { if (xb_ld(&bar[XB_TMO])) break; if (sp > XB_SPIN_CAP) { atomicAdd(&bar[XB_TMO], 1u); break; } }
    }
    nloc = mine > 0u ? mine : 1u; nx = cnt > 0u ? cnt : 1u;
}
__device__ __forceinline__ void xcd_barrier(const XcdBarrier& b) {
    asm volatile("s_waitcnt vmcnt(0)" ::: "memory");
    __syncthreads();
    if (threadIdx.x == 0) {
        unsigned* bar = b.bar;
        __builtin_amdgcn_s_waitcnt(0);
        unsigned nloc = b.st[0], nx = b.st[1];
        if (nloc == 0u) { xcd_barrier_complete(bar, b.x, nloc, nx); b.st[0] = nloc; b.st[1] = nx; }
        const unsigned old = xb_add(&bar[XB_XSUB(b.x)], 1u);
        const unsigned gen = old / nloc;
        if (old + 1u == (gen + 1u) * nloc) {
            __builtin_amdgcn_fence(__ATOMIC_RELEASE, "agent");
            asm volatile("s_waitcnt vmcnt(0)" ::: "memory");
            const unsigned og = xb_add(&bar[XB_TOP], 1u);
            const unsigned tg = og / nx;
            if (og + 1u == (tg + 1u) * nx) xb_add(&bar[XB_TOPGEN], 1u);
            else XB_SPIN(xb_ld(&bar[XB_TOPGEN]) == tg, bar);
            __builtin_amdgcn_fence(__ATOMIC_ACQUIRE, "agent");
            xb_add(&bar[XB_XGEN(b.x)], 1u);
            asm volatile("s_waitcnt vmcnt(0)" ::: "memory");
        } else {
            XB_SPIN(xb_ld(&bar[XB_XGEN(b.x)]) == gen, bar);
            __builtin_amdgcn_fence(__ATOMIC_ACQUIRE, "agent");
            asm volatile("s_waitcnt vmcnt(0)" ::: "memory");
        }
    }
    __syncthreads();
}

__device__ __forceinline__ int lds_byte(int r, int c) {
  int st = (r >> 4) * 2 + (c >> 5), rr = r & 15, cc = c & 31, ob = rr * 64 + cc * 2;
  return st * 1024 + (ob ^ (((ob >> 9) & 1) << 5));
}
#define GLDS(gp, lp) __builtin_amdgcn_global_load_lds((const unsigned*)(gp), (LAS unsigned*)(lp), 16, 0, 0)
#define WAIT_V(n) asm volatile("s_waitcnt vmcnt(" #n ")" ::: "memory")
#define WAIT_L(n) asm volatile("s_waitcnt lgkmcnt(" #n ")" ::: "memory")
#define BAR __builtin_amdgcn_s_barrier()
#define SCHED __builtin_amdgcn_sched_barrier(0)

template <bool GATHER, class Epi>
__device__ __forceinline__ void gemm_tile(const bf16_t* __restrict__ A, const int lda, const int* __restrict__ tok, const int brow,
                                          const bf16_t* __restrict__ Bt, const int ldb, const int bcol, const int K,
                                          LAS char* shm, const Epi& epi) {
#define G_SA(b, h) (shm + ((b) * 2 + (h)) * 16384)
#define G_SB(b, h) (shm + (4 + (b) * 2 + (h)) * 16384)
  int tid = threadIdx.x; asm volatile("" : "+v"(tid)); tid &= 511;
  int wid = tid >> 6, lane = tid & 63, wr = wid >> 2, wc = wid & 3, fr = lane & 15, fq = lane >> 4;
  unsigned ao0, ao1, ao2, ao3, bo;
  {
    const int sb = (tid & 63) * 16, swz = sb ^ (((sb >> 9) & 1) << 5);
    const int R0 = ((tid >> 6) >> 1) * 16 + (swz >> 6), C0 = ((tid >> 6) & 1) * 32 + ((swz & 63) >> 1);
    if (GATHER) { ao0 = (unsigned)(tok[R0] * lda + C0); ao1 = (unsigned)(tok[R0 + 64] * lda + C0); ao2 = (unsigned)(tok[R0 + 128] * lda + C0); ao3 = (unsigned)(tok[R0 + 192] * lda + C0); }
    else { ao0 = (unsigned)((brow + R0) * lda + C0); ao1 = ao0 + 64u * lda; ao2 = ao0 + 128u * lda; ao3 = ao0 + 192u * lda; }
    bo = (unsigned)((bcol + R0) * ldb + C0);
  }
  const int lo = __builtin_amdgcn_readfirstlane(tid >> 6) * 1024;
#define STAGE_A0(P, kt) do { GLDS((A + (kt) * 64) + ao0, (P) + lo); GLDS((A + (kt) * 64) + ao1, (P) + lo + 8192); } while (0)
#define STAGE_A1(P, kt) do { GLDS((A + (kt) * 64) + ao2, (P) + lo); GLDS((A + (kt) * 64) + ao3, (P) + lo + 8192); } while (0)
#define STAGE_B0(P, kt) do { GLDS((Bt + (kt) * 64) + bo, (P) + lo); GLDS((Bt + 64 * ldb + (kt) * 64) + bo, (P) + lo + 8192); } while (0)
#define STAGE_B1(P, kt) do { GLDS((Bt + 128 * ldb + (kt) * 64) + bo, (P) + lo); GLDS((Bt + 192 * ldb + (kt) * 64) + bo, (P) + lo + 8192); } while (0)
#define LDA(dst, b, h) _Pragma("unroll") for (int m = 0; m < 4; ++m) _Pragma("unroll") for (int k = 0; k < 2; ++k) \
    dst[m][k] = *(LAS const bf16x8*)(G_SA(b, h) + lds_byte(wr * 64 + m * 16 + fr, k * 32 + fq * 8))
#define LDB(dst, b, h) _Pragma("unroll") for (int n = 0; n < 2; ++n) _Pragma("unroll") for (int k = 0; k < 2; ++k) \
    dst[n][k] = *(LAS const bf16x8*)(G_SB(b, h) + lds_byte(wc * 32 + n * 16 + fr, k * 32 + fq * 8))
#define MMA(ai, bj, At_, Bt_) do { __builtin_amdgcn_s_setprio(1); \
    _Pragma("unroll") for (int m = 0; m < 4; ++m) _Pragma("unroll") for (int n = 0; n < 2; ++n) _Pragma("unroll") for (int k = 0; k < 2; ++k) \
      acc[ai][bj][m][n] = __builtin_amdgcn_mfma_f32_16x16x32_bf16(Bt_[n][k], At_[m][k], acc[ai][bj][m][n], 0, 0, 0); \
    __builtin_amdgcn_s_setprio(0); } while (0)

  f32x4 acc[2][2][4][2] = {};
  bf16x8 At[4][2], B0[2][2], B1[2][2];
  const int nt = K / 64;
  STAGE_B0(G_SB(0, 0), 0); STAGE_A0(G_SA(0, 0), 0);
  STAGE_B1(G_SB(0, 1), 0); STAGE_A1(G_SA(0, 1), 0);
  if (wr == 1) BAR;
  WAIT_V(4); BAR;
  STAGE_B0(G_SB(1, 0), 1); STAGE_A0(G_SA(1, 0), 1); STAGE_B1(G_SB(1, 1), 1);
  WAIT_V(6); BAR;
  for (int t = 0; t < nt - 2; t += 2) {
    LDB(B0, 0, 0); SCHED; LDA(At, 0, 0); STAGE_A1(G_SA(1, 1), t + 1);
    WAIT_L(8); BAR; WAIT_L(0); MMA(0, 0, At, B0); BAR; SCHED;
    LDB(B1, 0, 1); STAGE_B0(G_SB(0, 0), t + 2);
    BAR; WAIT_L(0); MMA(0, 1, At, B1); BAR;
    LDA(At, 0, 1); STAGE_A0(G_SA(0, 0), t + 2);
    BAR; WAIT_L(0); MMA(1, 0, At, B0); BAR; SCHED;
    STAGE_B1(G_SB(0, 1), t + 2);
    WAIT_V(6); BAR; MMA(1, 1, At, B1); BAR;
    LDB(B0, 1, 0); SCHED; LDA(At, 1, 0); STAGE_A1(G_SA(0, 1), t + 2);
    WAIT_L(8); BAR; WAIT_L(0); MMA(0, 0, At, B0); BAR; SCHED;
    LDB(B1, 1, 1); STAGE_B0(G_SB(1, 0), t + 3);
    BAR; WAIT_L(0); MMA(0, 1, At, B1); BAR;
    LDA(At, 1, 1); STAGE_A0(G_SA(1, 0), t + 3);
    BAR; WAIT_L(0); MMA(1, 0, At, B0); BAR; SCHED;
    STAGE_B1(G_SB(1, 1), t + 3);
    WAIT_V(6); BAR; MMA(1, 1, At, B1); BAR;
  }
  { LDB(B0, 0, 0); WAIT_V(0); LDA(At, 0, 0); STAGE_A1(G_SA(1, 1), nt - 1);
    BAR; WAIT_L(0); MMA(0, 0, At, B0); BAR;
    LDB(B1, 0, 1); BAR; WAIT_L(0); MMA(0, 1, At, B1); BAR;
    LDA(At, 0, 1); WAIT_V(4); BAR; WAIT_L(0); MMA(1, 0, At, B0); MMA(1, 1, At, B1); BAR; }
  { LDB(B0, 1, 0); LDA(At, 1, 0); WAIT_V(2); BAR; WAIT_L(0); MMA(0, 0, At, B0); BAR;
    LDB(B1, 1, 1); WAIT_V(0); BAR; WAIT_L(0); MMA(0, 1, At, B1); BAR;
    LDA(At, 1, 1); BAR; WAIT_L(0); MMA(1, 0, At, B0); MMA(1, 1, At, B1); BAR; }
  if (wr == 0) BAR;
  int tz = threadIdx.x; asm volatile("" : "+v"(tz)); wid = tz >> 6; lane = tz & 63; wr = wid >> 2; wc = wid & 3; fr = lane & 15; fq = lane >> 4;
  epi(acc, brow, bcol, wr, wc, fr, fq);
#undef G_SA
#undef G_SB
#undef STAGE_A0
#undef STAGE_A1
#undef STAGE_B0
#undef STAGE_B1
#undef LDA
#undef LDB
#undef MMA
}

struct EpiPlain {
  bf16_t* C; int ldc; float sc;
  __device__ __forceinline__ void operator()(const f32x4 (&acc)[2][2][4][2], int brow, int bcol, int wr, int wc, int fr, int fq) const {
#pragma unroll
    for (int ai = 0; ai < 2; ++ai)
#pragma unroll
      for (int m = 0; m < 4; ++m) {
        bf16_t* rp = C + (size_t)(brow + ai * 128 + wr * 64 + m * 16 + fr) * ldc + bcol + wc * 32 + fq * 8;
#pragma unroll
        for (int bj = 0; bj < 2; ++bj) {
          u32x4 v = {cvtpk(acc[ai][bj][m][0][0] * sc, acc[ai][bj][m][0][1] * sc), cvtpk(acc[ai][bj][m][0][2] * sc, acc[ai][bj][m][0][3] * sc),
                     cvtpk(acc[ai][bj][m][1][0] * sc, acc[ai][bj][m][1][1] * sc), cvtpk(acc[ai][bj][m][1][2] * sc, acc[ai][bj][m][1][3] * sc)};
          *(u32x4*)(rp + bj * 128) = v;
        }
      }
  }
};
template <int MODE>
struct EpiPair {
  bf16_t* C; int ldc; int colbase; float sc;
  __device__ __forceinline__ void operator()(const f32x4 (&acc)[2][2][4][2], int brow, int bcol, int wr, int wc, int fr, int fq) const {
#pragma unroll
    for (int ai = 0; ai < 2; ++ai)
#pragma unroll
      for (int m = 0; m < 4; ++m) {
        bf16_t* rp = C + (size_t)(brow + ai * 128 + wr * 64 + m * 16 + fr) * ldc + ((bcol - colbase) >> 1) + wc * 16 + fq * 4;
#pragma unroll
        for (int bj = 0; bj < 2; ++bj) {
          float r[4];
#pragma unroll
          for (int j = 0; j < 4; ++j) {
            const float x0 = acc[ai][bj][m][0][j] * sc, x1 = acc[ai][bj][m][1][j] * sc;
            r[j] = MODE == 0 ? x0 * sigmoid_fast(x1) : x0 * sigmoid_fast(x0) * x1;
          }
          u32x2 v = {cvtpk(r[0], r[1]), cvtpk(r[2], r[3])};
          *(u32x2*)(rp + bj * 64) = v;
        }
      }
  }
};
struct EpiG1 {
  EpiPlain p; EpiPair<0> g; int nplain;
  __device__ __forceinline__ void operator()(const f32x4 (&acc)[2][2][4][2], int brow, int bcol, int wr, int wc, int fr, int fq) const {
    if (bcol < nplain) p(acc, brow, bcol, wr, wc, fr, fq); else g(acc, brow, bcol, wr, wc, fr, fq);
  }
};

typedef int v8i __attribute__((ext_vector_type(8)));
__device__ __forceinline__ int lds8(int r, int c) { return r * 128 + ((c ^ ((r >> 1) & 7)) << 4); }
template <bool GATHER, int lda, int ldb, int K, class Epi, class S>
__device__ __forceinline__ void gemm8_run(const unsigned char* __restrict__ A, const int* __restrict__ stok,
                                          LAS char* shm, const Epi& epi, const S& sched) {
#define G_SA(b, h) (shm + ((b) * 2 + (h)) * 16384)
#define G_SB(b, h) (shm + (4 + (b) * 2 + (h)) * 16384)
  int tid = threadIdx.x; asm volatile("" : "+v"(tid)); tid &= 511;
  int wid = tid >> 6, lane = tid & 63, wr = wid >> 2, wc = wid & 3, fr = lane & 15, fq = lane >> 4;
  unsigned ao0, ao1, ao2, ao3, bo;
  int R0 = 8 * wid + (lane >> 3), C0 = ((lane & 7) ^ ((R0 >> 1) & 7)) << 4;
  const int lo = __builtin_amdgcn_readfirstlane(tid >> 6) * 1024;
  int brow, bcol; const unsigned char* Bt;
  int ui = 0;
  if (!sched.unit(ui, brow, Bt, bcol)) return;
#define SETOFF(br, bc) do { if (GATHER) { const int* _t = stok + (br); ao0 = (unsigned)(_t[R0] * lda + C0); ao1 = (unsigned)(_t[R0 + 64] * lda + C0); ao2 = (unsigned)(_t[R0 + 128] * lda + C0); ao3 = (unsigned)(_t[R0 + 192] * lda + C0); } \
    else { ao0 = (unsigned)(((br) + R0) * lda + C0); ao1 = ao0 + 64u * lda; ao2 = ao0 + 128u * lda; ao3 = ao0 + 192u * lda; } \
    bo = (unsigned)(((bc) + R0) * ldb + C0); } while (0)
#define STAGE_A0(P, kt) do { GLDS((A + (kt) * 128) + ao0, (P) + lo); GLDS((A + (kt) * 128) + ao1, (P) + lo + 8192); } while (0)
#define STAGE_A1(P, kt) do { GLDS((A + (kt) * 128) + ao2, (P) + lo); GLDS((A + (kt) * 128) + ao3, (P) + lo + 8192); } while (0)
#define STAGE_B0(P, kt) do { GLDS((Bt + (kt) * 128) + bo, (P) + lo); GLDS((Bt + 64 * ldb + (kt) * 128) + bo, (P) + lo + 8192); } while (0)
#define STAGE_B1(P, kt) do { GLDS((Bt + 128 * ldb + (kt) * 128) + bo, (P) + lo); GLDS((Bt + 192 * ldb + (kt) * 128) + bo, (P) + lo + 8192); } while (0)
#define PRO() do { STAGE_B0(G_SB(0, 0), 0); STAGE_A0(G_SA(0, 0), 0); STAGE_B1(G_SB(0, 1), 0); STAGE_A1(G_SA(0, 1), 0); } while (0)
  const int fx = (fq ^ ((fr >> 1) & 7)) << 4;
  const int fa0 = (wr * 64 + fr) * 128 + fx, fb0 = (wc * 32 + fr) * 128 + fx;
#define FRAG8(dst, p0, p1) do { const v4i _x = *(LAS const v4i*)(p0); const v4i _y = *(LAS const v4i*)(p1); \
    dst = (v8i){_x[0], _x[1], _x[2], _x[3], _y[0], _y[1], _y[2], _y[3]}; } while (0)
#define LDA(dst, b, h) do { int fa1 = fa0; asm volatile("v_xor_b32 %0, 64, %0" : "+v"(fa1)); \
    _Pragma("unroll") for (int m = 0; m < 4; ++m) FRAG8(dst[m], G_SA(b, h) + fa0 + m * 2048, G_SA(b, h) + fa1 + m * 2048); } while (0)
#define LDB(dst, b, h) do { int fb1 = fb0; asm volatile("v_xor_b32 %0, 64, %0" : "+v"(fb1)); \
    _Pragma("unroll") for (int n = 0; n < 2; ++n) FRAG8(dst[n], G_SB(b, h) + fb0 + n * 2048, G_SB(b, h) + fb1 + n * 2048); } while (0)
#define MMA(ai, bj, At_, Bt_) do { __builtin_amdgcn_s_setprio(1); \
    _Pragma("unroll") for (int m = 0; m < 4; ++m) _Pragma("unroll") for (int n = 0; n < 2; ++n) \
      asm volatile("v_mfma_scale_f32_16x16x128_f8f6f4 %0, %1, %2, %0, %3, %3 op_sel_hi:[0,0,0]" : "+v"(acc[ai][bj][m][n]) : "v"(Bt_[n]), "v"(At_[m]), "v"(sc1)); \
    __builtin_amdgcn_s_setprio(0); } while (0)
  int sc1; asm volatile("v_mov_b32 %0, 0x7f7f7f7f" : "=v"(sc1));
  const int nt = K / 128;
  SETOFF(brow, bcol); PRO();
  bool first = true;
  for (;;) {
    f32x4 acc[2][2][4][2] = {};
    v8i At[4], B0[2], B1[2];
    if (wr == 1) BAR;
    if (first) WAIT_V(4); else WAIT_V(0);
    BAR;
    STAGE_B0(G_SB(1, 0), 1); STAGE_A0(G_SA(1, 0), 1); STAGE_B1(G_SB(1, 1), 1);
    WAIT_V(6); BAR;
    for (int t = 0; t < nt - 2; t += 2) {
      LDB(B0, 0, 0); SCHED; LDA(At, 0, 0); STAGE_A1(G_SA(1, 1), t + 1);
      WAIT_L(8); BAR; WAIT_L(0); MMA(0, 0, At, B0); BAR; SCHED;
      LDB(B1, 0, 1); STAGE_B0(G_SB(0, 0), t + 2);
      BAR; WAIT_L(0); MMA(0, 1, At, B1); BAR;
      LDA(At, 0, 1); STAGE_A0(G_SA(0, 0), t + 2);
      BAR; WAIT_L(0); MMA(1, 0, At, B0); BAR; SCHED;
      STAGE_B1(G_SB(0, 1), t + 2);
      WAIT_V(6); BAR; MMA(1, 1, At, B1); BAR;
      LDB(B0, 1, 0); SCHED; LDA(At, 1, 0); STAGE_A1(G_SA(0, 1), t + 2);
      WAIT_L(8); BAR; WAIT_L(0); MMA(0, 0, At, B0); BAR; SCHED;
      LDB(B1, 1, 1); STAGE_B0(G_SB(1, 0), t + 3);
      BAR; WAIT_L(0); MMA(0, 1, At, B1); BAR;
      LDA(At, 1, 1); STAGE_A0(G_SA(1, 0), t + 3);
      BAR; WAIT_L(0); MMA(1, 0, At, B0); BAR; SCHED;
      STAGE_B1(G_SB(1, 1), t + 3);
      WAIT_V(6); BAR; MMA(1, 1, At, B1); BAR;
    }
    { LDB(B0, 0, 0); WAIT_V(0); LDA(At, 0, 0); STAGE_A1(G_SA(1, 1), nt - 1);
      BAR; WAIT_L(0); MMA(0, 0, At, B0); BAR;
      LDB(B1, 0, 1); BAR; WAIT_L(0); MMA(0, 1, At, B1); BAR;
      LDA(At, 0, 1); WAIT_V(4); BAR; WAIT_L(0); MMA(1, 0, At, B0); MMA(1, 1, At, B1); BAR; }
    { LDB(B0, 1, 0); LDA(At, 1, 0); WAIT_V(2); BAR; WAIT_L(0); MMA(0, 0, At, B0); BAR;
      LDB(B1, 1, 1); WAIT_V(0); BAR; WAIT_L(0); MMA(0, 1, At, B1); BAR;
      LDA(At, 1, 1); BAR; WAIT_L(0); MMA(1, 0, At, B0); MMA(1, 1, At, B1); BAR; }
    if (wr == 0) BAR;
    const int cbrow = brow, cbcol = bcol;
    { int tz = threadIdx.x; asm volatile("" : "+v"(tz)); tz &= 511; wid = tz >> 6; lane = tz & 63; wr = wid >> 2; wc = wid & 3; fr = lane & 15; fq = lane >> 4;
      R0 = 8 * wid + (lane >> 3); C0 = ((lane & 7) ^ ((R0 >> 1) & 7)) << 4; }
    ++ui;
    const bool more = sched.unit(ui, brow, Bt, bcol);
    if (more) { SETOFF(brow, bcol); asm volatile("" ::: "memory"); PRO(); asm volatile("" ::: "memory"); }
    asm volatile("s_nop 15\n\ts_nop 15\n\ts_nop 7" ::: "memory");
#pragma unroll
    for (int i = 0; i < 32; ++i) asm volatile("" : "+v"((&acc[0][0][0][0])[i]));
    epi(acc, cbrow, cbcol, wr, wc, fr, fq);
    if (!more) break;
    first = false;
  }
#undef G_SA
#undef G_SB
#undef SETOFF
#undef STAGE_A0
#undef STAGE_A1
#undef STAGE_B0
#undef STAGE_B1
#undef PRO
#undef FRAG8
#undef LDA
#undef LDB
#undef MMA
}
__device__ __forceinline__ float clamp8(float x) { return fminf(fmaxf(x, -448.f), 448.f); }
__device__ __forceinline__ unsigned pack_fp8x4(float a, float b, float c, float d) {
  int p = __builtin_amdgcn_cvt_pk_fp8_f32(clamp8(a), clamp8(b), 0, false); p = __builtin_amdgcn_cvt_pk_fp8_f32(clamp8(c), clamp8(d), p, true); return (unsigned)p; }
struct EpiSwiGLU8 {
  unsigned char* C; int ldc;
  __device__ __forceinline__ void operator()(const f32x4 (&acc)[2][2][4][2], int brow, int bcol, int wr, int wc, int fr, int fq) const {
    constexpr float S = 1.f / 256.f;
#pragma unroll
    for (int ai = 0; ai < 2; ++ai)
#pragma unroll
      for (int m = 0; m < 4; ++m) {
        unsigned char* rp = C + (size_t)(brow + ai * 128 + wr * 64 + m * 16 + fr) * ldc + (bcol >> 1) + wc * 16 + fq * 4;
#pragma unroll
        for (int bj = 0; bj < 2; ++bj) {
          float r[4];
#pragma unroll
          for (int j = 0; j < 4; ++j) { const float g = acc[ai][bj][m][0][j] * S, u = acc[ai][bj][m][1][j] * S; r[j] = g * sigmoid_fast(g) * u; }
          *(unsigned*)(rp + bj * 64) = pack_fp8x4(r[0], r[1], r[2], r[3]);
        }
      }
  }
};
struct EpiPlain8 {
  unsigned char* C; int ldc; float sc;
  __device__ __forceinline__ void operator()(const f32x4 (&acc)[2][2][4][2], int brow, int bcol, int wr, int wc, int fr, int fq) const {
#pragma unroll
    for (int ai = 0; ai < 2; ++ai)
#pragma unroll
      for (int m = 0; m < 4; ++m) {
        unsigned char* rp = C + (size_t)(brow + ai * 128 + wr * 64 + m * 16 + fr) * ldc + bcol + wc * 32 + fq * 8;
#pragma unroll
        for (int bj = 0; bj < 2; ++bj) {
          u32x2 v = {pack_fp8x4(acc[ai][bj][m][0][0] * sc, acc[ai][bj][m][0][1] * sc, acc[ai][bj][m][0][2] * sc, acc[ai][bj][m][0][3] * sc),
                     pack_fp8x4(acc[ai][bj][m][1][0] * sc, acc[ai][bj][m][1][1] * sc, acc[ai][bj][m][1][2] * sc, acc[ai][bj][m][1][3] * sc)};
          *(u32x2*)(rp + bj * 128) = v;
        }
      }
  }
};
struct EpiPlainS {
  bf16_t* C; int ldc; float sc;
  __device__ __forceinline__ void operator()(const f32x4 (&acc)[2][2][4][2], int brow, int bcol, int wr, int wc, int fr, int fq) const {
#pragma unroll
    for (int ai = 0; ai < 2; ++ai)
#pragma unroll
      for (int m = 0; m < 4; ++m) {
        bf16_t* rp = C + (size_t)(brow + ai * 128 + wr * 64 + m * 16 + fr) * ldc + bcol + wc * 32 + fq * 8;
#pragma unroll
        for (int bj = 0; bj < 2; ++bj) {
          u32x4 v = {cvtpk(acc[ai][bj][m][0][0] * sc, acc[ai][bj][m][0][1] * sc), cvtpk(acc[ai][bj][m][0][2] * sc, acc[ai][bj][m][0][3] * sc),
                     cvtpk(acc[ai][bj][m][1][0] * sc, acc[ai][bj][m][1][1] * sc), cvtpk(acc[ai][bj][m][1][2] * sc, acc[ai][bj][m][1][3] * sc)};
          *(u32x4*)(rp + bj * 128) = v;
        }
      }
  }
};

__device__ __forceinline__ void dense_unit(int u, int nM, int nN, int& pm, int& pn) {
  const int nwg = nM * nN, NX = 8, WGM = 8;
  int wgid = u;
  { const int q = nwg / NX, r = nwg % NX, xcd = wgid % NX, off = wgid / NX; wgid = (xcd < r ? xcd * (q + 1) : r * (q + 1) + (xcd - r) * q) + off; }
  const int nig = WGM * nN, gid = wgid / nig, fm = gid * WGM, gsz = min(nM - fm, WGM);
  pm = fm + ((wgid % nig) % gsz); pn = (wgid % nig) / gsz;
}

namespace at {
constexpr int DH = 128, NW = 8, QBLK = 32, KVBLK = 64;
constexpr float SCALE = 0.088388347648318440f;
constexpr float QC = SCALE * 1.4426950408889634f;
constexpr int SHM_V = KVBLK * DH * 2, SHM_K = KVBLK * DH * 2;
#define KSWZ(row, colB) ((row) * 256 + ((colB) ^ (((row) & 7) << 4)))
__device__ __forceinline__ int crow(int r, int hi) { return (r & 3) + 8 * (r >> 2) + 4 * hi; }
__device__ __forceinline__ unsigned cvtpkv(float lo, float hi) { unsigned r; asm volatile("v_cvt_pk_bf16_f32 %0, %1, %2" : "=v"(r) : "v"(lo), "v"(hi)); return r; }
#define PK4(P, BASE, OUT) do { unsigned a0 = cvtpkv(P[BASE + 0], P[BASE + 1]), a1 = cvtpkv(P[BASE + 2], P[BASE + 3]);   \
    unsigned b0 = cvtpkv(P[BASE + 4], P[BASE + 5]), b1 = cvtpkv(P[BASE + 6], P[BASE + 7]);                              \
    auto r0 = __builtin_amdgcn_permlane32_swap(a0, b0, false, false); auto r1 = __builtin_amdgcn_permlane32_swap(a1, b1, false, false); \
    u32x4 w = {r0[0], r1[0], r0[1], r1[1]}; OUT = *reinterpret_cast<bf16x8*>(&w); } while (0)
__device__ __forceinline__ float load_q(const bf16_t* __restrict__ Qw, bf16x8 (&qr)[8], float kmax2) {
  float ss = 0;
#pragma unroll
  for (int d0 = 0; d0 < 8; ++d0) {
    const u32x4 raw = *reinterpret_cast<const u32x4*>(Qw + d0 * 16); u32x4 o;
#pragma unroll
    for (int i = 0; i < 4; ++i) { const unsigned pk = cvtpk(bflo(raw[i]) * QC, bfhi(raw[i]) * QC); o[i] = pk; const float a = bflo(pk), b = bfhi(pk); ss += a * a + b * b; }
    qr[d0] = *reinterpret_cast<bf16x8*>(&o);
  }
  { auto rr = __builtin_amdgcn_permlane32_swap(__float_as_uint(ss), __float_as_uint(ss), false, false); ss = __uint_as_float(rr[0]) + __uint_as_float(rr[1]); }
  return -(sqrtf(ss * kmax2) * 1.01f + 1e-3f);
}
__device__ __forceinline__ void exp16(f32x16& p) {
#pragma unroll
  for (int r = 0; r < 16; ++r) p[r] = __builtin_amdgcn_exp2f(p[r]);
}
__device__ __forceinline__ float sum16(const f32x16& p) { float s = 0;
#pragma unroll
  for (int r = 0; r < 16; ++r) s += p[r];
  return s; }
__device__ __forceinline__ void qkt(f32x16& p0, f32x16& p1, LAS const char* Ks, const bf16x8* qr, int r32, int hi, float nmc) {
#pragma unroll
  for (int r = 0; r < 16; ++r) { p0[r] = nmc; p1[r] = nmc; }
#pragma unroll
  for (int d0 = 0; d0 < 8; ++d0) { int cb = (d0 * 16 + hi * 8) * 2;
    bf16x8 b0 = *(LAS const bf16x8*)(Ks + KSWZ(r32, cb));
    bf16x8 b1 = *(LAS const bf16x8*)(Ks + KSWZ(32 + r32, cb));
    p0 = __builtin_amdgcn_mfma_f32_32x32x16_bf16(b0, qr[d0], p0, 0, 0, 0);
    p1 = __builtin_amdgcn_mfma_f32_32x32x16_bf16(b1, qr[d0], p1, 0, 0, 0); }
}
__device__ __forceinline__ int v_st(int k, int c) { const int kk = (k & ~0xC) | ((k & 4) << 1) | ((k & 8) >> 1); return ((kk >> 3) * 4 + (c >> 5)) * 512 + ((kk & 7) * 32 + (c & 31)) * 2; }
__device__ __forceinline__ int v_st256(int k, int c) { const int kk = (k & ~0xC) | ((k & 4) << 1) | ((k & 8) >> 1); return ((kk >> 3) * 8 + (c >> 5)) * 512 + ((kk & 7) * 32 + (c & 31)) * 2; }
__device__ __forceinline__ int v_rd_base(int lane) { return ((lane & 3) << 3) | (((lane >> 2) & 3) << 6) | (((lane >> 4) & 1) << 5) | (((lane >> 5) & 1) << 8); }
template <int OFF> __device__ __forceinline__ s16x4 tr_read(int vb) {
  s16x4 r; asm volatile("ds_read_b64_tr_b16 %0, %1 offset:%2" : "=&v"(r) : "v"(vb), "i"(OFF) : "memory"); return r;
}
template <int BASE, int KS, int HS> __device__ __forceinline__ void pv_one(f32x16& od, int vb, bf16x8 pa0, bf16x8 pa1, bf16x8 pa2, bf16x8 pa3) {
  const s16x4 l0 = tr_read<BASE>(vb), h0 = tr_read<BASE + HS>(vb), l1 = tr_read<BASE + KS>(vb), h1 = tr_read<BASE + KS + HS>(vb);
  const s16x4 l2 = tr_read<BASE + 2 * KS>(vb), h2 = tr_read<BASE + 2 * KS + HS>(vb), l3 = tr_read<BASE + 3 * KS>(vb), h3 = tr_read<BASE + 3 * KS + HS>(vb);
  asm volatile("s_waitcnt lgkmcnt(0)" ::: "memory"); SCHED;
#define PK(L, H) (bf16x8){L[0], L[1], L[2], L[3], H[0], H[1], H[2], H[3]}
  od = __builtin_amdgcn_mfma_f32_32x32x16_bf16(pa0, PK(l0, h0), od, 0, 0, 0);
  od = __builtin_amdgcn_mfma_f32_32x32x16_bf16(pa1, PK(l1, h1), od, 0, 0, 0);
  od = __builtin_amdgcn_mfma_f32_32x32x16_bf16(pa2, PK(l2, h2), od, 0, 0, 0);
  od = __builtin_amdgcn_mfma_f32_32x32x16_bf16(pa3, PK(l3, h3), od, 0, 0, 0);
#undef PK
}
__device__ __forceinline__ void pv_d0(f32x16* o, int vb, bf16x8 pa0, bf16x8 pa1, bf16x8 pa2, bf16x8 pa3) {
  pv_one<0, 4096, 2048>(o[0], vb, pa0, pa1, pa2, pa3); pv_one<512, 4096, 2048>(o[1], vb, pa0, pa1, pa2, pa3);
  pv_one<1024, 4096, 2048>(o[2], vb, pa0, pa1, pa2, pa3); pv_one<1536, 4096, 2048>(o[3], vb, pa0, pa1, pa2, pa3);
}
__device__ __forceinline__ void pv_d0_256(f32x16* o, int vb, bf16x8 pa0, bf16x8 pa1, bf16x8 pa2, bf16x8 pa3) {
  pv_one<0, 8192, 4096>(o[0], vb, pa0, pa1, pa2, pa3); pv_one<512, 8192, 4096>(o[1], vb, pa0, pa1, pa2, pa3);
  pv_one<1024, 8192, 4096>(o[2], vb, pa0, pa1, pa2, pa3); pv_one<1536, 8192, 4096>(o[3], vb, pa0, pa1, pa2, pa3);
}
__device__ __forceinline__ void store_o8(const f32x16* o, float l_tot, LAS float* li, unsigned char* __restrict__ Ow, int ldo, int r32, int hi) {
  if (hi == 0) li[r32] = l_tot; asm volatile("s_waitcnt lgkmcnt(0)" ::: "memory");
  float rli[16];
#pragma unroll
  for (int r = 0; r < 16; ++r) rli[r] = 8.f * __builtin_amdgcn_rcpf(li[crow(r, hi)]);
#pragma unroll
  for (int r = 0; r < 16; ++r) { const int orow = crow(r, hi);
#pragma unroll
    for (int d0 = 0; d0 < 4; ++d0) Ow[(long)orow * ldo + d0 * 32 + r32] = (unsigned char)__builtin_amdgcn_cvt_pk_fp8_f32(o[d0][r] * rli[r], 0.f, 0, false); }
}
__device__ __forceinline__ void store_o(const f32x16* o, float l_tot, LAS float* li, bf16_t* __restrict__ Ow, int ldo, int r32, int hi) {
  if (hi == 0) li[r32] = l_tot; asm volatile("s_waitcnt lgkmcnt(0)" ::: "memory");
  float rli[16];
#pragma unroll
  for (int r = 0; r < 16; ++r) rli[r] = __builtin_amdgcn_rcpf(li[crow(r, hi)]);
#pragma unroll
  for (int r = 0; r < 16; ++r) { const int orow = crow(r, hi);
#pragma unroll
    for (int d0 = 0; d0 < 4; ++d0) Ow[(long)orow * ldo + d0 * 32 + r32] = f2bf(o[d0][r] * rli[r]); }
}

__device__ __forceinline__ int unswap23(int kk) { return (kk & ~0xC) | ((kk & 4) << 1) | ((kk & 8) >> 1); }
__device__ __forceinline__ int k_dma_voff(int wid, int lane, int ldk) {
  const int row = 4 * wid + (lane >> 4); return row * ldk * 2 + (((lane & 15) * 16) ^ ((row & 7) << 4)); }
#define DMA16(rs, ldsp, voff, soff) __builtin_amdgcn_raw_ptr_buffer_load_lds(rs, (LAS void*)(ldsp), 16, voff, soff, 0, 0)

constexpr int SHM_T = SHM_K + SHM_V;
__device__ __forceinline__ void attn_body(const bf16_t* __restrict__ Qb, const int ldq, const bf16_t* __restrict__ Kh, const bf16_t* __restrict__ Vh, const int ldk,
                                          bf16_t* __restrict__ Ob, const int ldo, const int seq, const float kmax2, LAS char* lds) {
  int tid = threadIdx.x; asm volatile("" : "+v"(tid)); tid &= 511;
  const int wid = tid >> 6, lane = tid & 63, r32 = lane & 31, hi = lane >> 5;
  LAS float* li_l = (LAS float*)(lds + 3 * SHM_T) + wid * 64;
  float l_reg = 0; f32x16 o[4] = {}; bf16x8 qr[8];
  const float nmc = load_q(Qb + (long)(wid * QBLK + r32) * ldq + hi * 8, qr, kmax2);
  const int vrb = v_rd_base(lane);
  const int kvo = k_dma_voff(wid, lane, ldk);
  const int vvo = unswap23(8 * (wid >> 1) + ((lane & 31) >> 2)) * ldk * 2 + ((2 * (wid & 1) + (lane >> 5)) * 32 + (lane & 3) * 8) * 2;
  const int l32 = 64 * ldk, pz = wid * 1024;
  const __amdgpu_buffer_rsrc_t krs = __builtin_amdgcn_make_buffer_rsrc((void*)Kh, 0, 0x7ffffff0, 0x00020000);
  const __amdgpu_buffer_rsrc_t vrs = __builtin_amdgcn_make_buffer_rsrc((void*)Vh, 0, 0x7ffffff0, 0x00020000);
#define TDMA(slot, k0) do { const int _o = (k0) * ldk * 2; LAS char* _b = lds + (slot) * SHM_T + pz; \
    DMA16(krs, _b, kvo, _o); DMA16(krs, _b + 8192, kvo, _o + l32); DMA16(vrs, _b + SHM_K, vvo, _o); DMA16(vrs, _b + SHM_K + 8192, vvo, _o + l32); } while (0)
#define VM0() asm volatile("s_waitcnt vmcnt(0)" ::: "memory")
#define FINISH(P0, P1) do { exp16(P1); l_reg += sum16(P0) + sum16(P1); PK4(P0, 0, pa0); PK4(P0, 8, pa1); PK4(P1, 0, pa2); PK4(P1, 8, pa3); } while (0)
  f32x16 pA0, pA1, pB0, pB1; bf16x8 pa0, pa1, pa2, pa3; const int NT = seq / KVBLK;
  TDMA(0, 0); VM0(); __syncthreads();
  TDMA(1, KVBLK);
  qkt(pA0, pA1, lds, qr, r32, hi, nmc); exp16(pA0);
  VM0(); __syncthreads();
  int sk = 1, sv = 0, sd = 2;
  for (int j = 1; j + 1 < NT; j += 2) {
    TDMA(sd, (j + 1) * KVBLK);
    SCHED; qkt(pB0, pB1, lds + sk * SHM_T, qr, r32, hi, nmc);
    FINISH(pA0, pA1); SCHED;
    pv_d0(o, (int)(uintptr_t)(lds + sv * SHM_T + SHM_K) + vrb, pa0, pa1, pa2, pa3); exp16(pB0);
    VM0(); __syncthreads();
    { const int t = sv; sv = sk; sk = sd; sd = t; }
    if (j + 2 < NT) TDMA(sd, (j + 2) * KVBLK);
    SCHED; qkt(pA0, pA1, lds + sk * SHM_T, qr, r32, hi, nmc);
    FINISH(pB0, pB1); SCHED;
    pv_d0(o, (int)(uintptr_t)(lds + sv * SHM_T + SHM_K) + vrb, pa0, pa1, pa2, pa3); exp16(pA0);
    VM0(); __syncthreads();
    { const int t = sv; sv = sk; sk = sd; sd = t; }
  }
  SCHED; qkt(pB0, pB1, lds + sk * SHM_T, qr, r32, hi, nmc);
  FINISH(pA0, pA1); SCHED;
  pv_d0(o, (int)(uintptr_t)(lds + sv * SHM_T + SHM_K) + vrb, pa0, pa1, pa2, pa3); exp16(pB0);
  FINISH(pB0, pB1); SCHED;
  pv_d0(o, (int)(uintptr_t)(lds + sk * SHM_T + SHM_K) + vrb, pa0, pa1, pa2, pa3);
  { auto rr = __builtin_amdgcn_permlane32_swap(__float_as_uint(l_reg), __float_as_uint(l_reg), false, false); l_reg = __uint_as_float(rr[0]) + __uint_as_float(rr[1]); }
  store_o(o, l_reg, li_l, Ob + (long)(wid * QBLK) * ldo, ldo, r32, hi);
  VM0();
  __syncthreads();
#undef TDMA
#undef FINISH
}

constexpr int SHM_V2 = KVBLK * 256 * 2;
__device__ __forceinline__ void attn_body_dv256(const bf16_t* __restrict__ Qb, const int ldq, const bf16_t* __restrict__ Kh, const bf16_t* __restrict__ Vh, const int ldk,
                                                bf16_t* __restrict__ Ob, const int ldo, const int seq, const float kmax2, LAS char* lds) {
  int tid = threadIdx.x; asm volatile("" : "+v"(tid)); tid &= 511;
  const int wid = tid >> 6, lane = tid & 63, r32 = lane & 31, hi = lane >> 5, rg = wid >> 1, kh = wid & 1;
  LAS char* K_lds = lds; LAS char* V_lds = lds + 2 * SHM_K; LAS char* X_lds = lds + 2 * SHM_K + 2 * SHM_V2;
  float l_reg = 0; f32x16 o[4] = {}; bf16x8 qr[8];
  const float nmc = load_q(Qb + (long)(rg * QBLK + r32) * ldq + hi * 8, qr, kmax2);
  const int vb0 = (int)(uintptr_t)V_lds + v_rd_base(lane) + kh * 2048;
  const int kvo = k_dma_voff(wid, lane, ldk);
  const int vvo = unswap23(8 * (wid >> 2) + ((lane & 31) >> 2)) * ldk * 2 + ((2 * (wid & 3) + (lane >> 5)) * 32 + (lane & 3) * 8) * 2;
  const int l32 = 64 * ldk, l16 = 32 * ldk, pz = wid * 1024;
  const int xw = (rg * 4 + kh * 2) * 1024 + lane * 16, xr = rg * 4096 + lane * 16;
  const __amdgpu_buffer_rsrc_t krs = __builtin_amdgcn_make_buffer_rsrc((void*)Kh, 0, 0x7ffffff0, 0x00020000);
  const __amdgpu_buffer_rsrc_t vrs = __builtin_amdgcn_make_buffer_rsrc((void*)Vh, 0, 0x7ffffff0, 0x00020000);
#define KDMA(b, k0) do { const int _o = (k0) * ldk * 2; LAS char* _b = K_lds + (b) * SHM_K + pz; DMA16(krs, _b, kvo, _o); DMA16(krs, _b + 8192, kvo, _o + l32); } while (0)
#define VDMA(b, k0) do { const int _o = (k0) * ldk * 2; LAS char* _b = V_lds + (b) * SHM_V2 + pz; DMA16(vrs, _b, vvo, _o); DMA16(vrs, _b + 8192, vvo, _o + l16); \
    DMA16(vrs, _b + 16384, vvo, _o + 2 * l16); DMA16(vrs, _b + 24576, vvo, _o + 3 * l16); } while (0)
  f32x16 pA, pB; bf16x8 pa0, pa1, pa2, pa3, own0, own1; const int NT = seq / KVBLK;
  const int kxor = ((32 * kh + r32) & 7) << 4, krb = (32 * kh + r32) * 256;
#define QKHALF(P, b) do { _Pragma("unroll") for (int r = 0; r < 16; ++r) P[r] = nmc; \
    _Pragma("unroll") for (int d0 = 0; d0 < 8; ++d0) { const bf16x8 bk = *(LAS const bf16x8*)(K_lds + (b) * SHM_K + krb + (((d0 * 16 + hi * 8) * 2) ^ kxor)); \
      P = __builtin_amdgcn_mfma_f32_32x32x16_bf16(bk, qr[d0], P, 0, 0, 0); } } while (0)
#define FINH(P) do { exp16(P); l_reg += sum16(P); PK4(P, 0, own0); PK4(P, 8, own1); } while (0)
#define XWRITE(b) do { *(LAS bf16x8*)(X_lds + (b) * 16384 + xw) = own0; *(LAS bf16x8*)(X_lds + (b) * 16384 + xw + 1024) = own1; } while (0)
#define XREAD(b) do { pa0 = *(LAS const bf16x8*)(X_lds + (b) * 16384 + xr); pa1 = *(LAS const bf16x8*)(X_lds + (b) * 16384 + xr + 1024); \
    pa2 = *(LAS const bf16x8*)(X_lds + (b) * 16384 + xr + 2048); pa3 = *(LAS const bf16x8*)(X_lds + (b) * 16384 + xr + 3072); } while (0)
#define STEP(PA, PB, b, j) do { \
    SCHED; if ((j) + 1 < NT) QKHALF(PB, (b) ^ 1); FINH(PA); SCHED; \
    XWRITE(b); VM0(); __syncthreads(); \
    if ((j) + 3 < NT) KDMA((b) ^ 1, ((j) + 3) * KVBLK); if ((j) + 1 < NT) VDMA((b) ^ 1, ((j) + 1) * KVBLK); \
    XREAD(b); \
    pv_d0_256(o, vb0 + (b) * SHM_V2, pa0, pa1, pa2, pa3); } while (0)
  KDMA(0, 0); KDMA(1, KVBLK); VDMA(0, 0); VM0(); __syncthreads();
  QKHALF(pA, 0);
  __syncthreads();
  if (2 < NT) KDMA(0, 2 * KVBLK);
  for (int j = 0; j < NT; j += 2) { STEP(pA, pB, 0, j); STEP(pB, pA, 1, j + 1); }
  __syncthreads();
  LAS float* lx = (LAS float*)X_lds;
  lx[wid * 64 + lane] = l_reg; __syncthreads();
  const float l_tot = lx[wid * 64 + r32] + lx[wid * 64 + 32 + r32] + lx[(wid ^ 1) * 64 + r32] + lx[(wid ^ 1) * 64 + 32 + r32];
  store_o(o, l_tot, lx + 512 + wid * 32, Ob + (long)(rg * QBLK) * ldo + kh * 128, ldo, r32, hi);
  VM0();
  __syncthreads();
#undef KDMA
#undef VDMA
#undef QKHALF
#undef FINH
#undef XWRITE
#undef XREAD
#undef STEP
#undef VM0
}

#define LGK(n) asm volatile("s_waitcnt lgkmcnt(" #n ")" ::: "memory")
template <int OFF> __device__ __forceinline__ bf16x8 k_read(int ka) { bf16x8 r; asm volatile("ds_read_b128 %0, %1 offset:%2" : "=&v"(r) : "v"(ka), "i"(OFF) : "memory"); return r; }
struct VSet { s16x4 l0, h0, l1, h1; };
template <int OFF> __device__ __forceinline__ void v_read(VSet& s, int vb) { s.l0 = tr_read<OFF>(vb); s.h0 = tr_read<OFF + 4096>(vb); s.l1 = tr_read<OFF + 8192>(vb); s.h1 = tr_read<OFF + 12288>(vb); }
__device__ __forceinline__ void pv2(f32x16& oa, const VSet& s, bf16x8 pa0, bf16x8 pa1) {
#define PK(L, H) (bf16x8){L[0], L[1], L[2], L[3], H[0], H[1], H[2], H[3]}
  oa = __builtin_amdgcn_mfma_f32_32x32x16_bf16(pa0, PK(s.l0, s.h0), oa, 0, 0, 0);
  oa = __builtin_amdgcn_mfma_f32_32x32x16_bf16(pa1, PK(s.l1, s.h1), oa, 0, 0, 0);
#undef PK
}
template <bool SHIFT>
__device__ __forceinline__ void attn_body_c256_t(const bf16_t* __restrict__ Qb, const int ldq, const bf16_t* __restrict__ Kh, const bf16_t* __restrict__ Vh, const int ldk,
                                                 bf16_t* __restrict__ Ob, const int ldo, const int seq, const float nmc, const bf16x8 (&qr)[8], LAS char* lds) {
  int tid = threadIdx.x; asm volatile("" : "+v"(tid)); tid &= 511;
  const int wid = __builtin_amdgcn_readfirstlane(tid >> 6), lane = tid & 63, r32 = lane & 31, hi = lane >> 5;
  LAS char* K_lds = lds; LAS char* V_lds = lds + 2 * SHM_K;
  LAS float* li_l = (LAS float*)(lds + 2 * SHM_K + 2 * SHM_V2) + wid * 64;
  float l_reg = 0; f32x16 o[8] = {};
  const int vb0 = (int)(uintptr_t)V_lds + v_rd_base(lane);
  const int kvo = k_dma_voff(wid, lane, ldk);
  const int vvo = unswap23(8 * (wid >> 2) + ((lane & 31) >> 2)) * ldk * 2 + ((2 * (wid & 3) + (lane >> 5)) * 32 + (lane & 3) * 8) * 2;
  const int l32 = 64 * ldk, l16 = 32 * ldk, pz = wid * 1024;
  const __amdgpu_buffer_rsrc_t krs = __builtin_amdgcn_make_buffer_rsrc((void*)Kh, 0, 0x7ffffff0, 0x00020000);
  const __amdgpu_buffer_rsrc_t vrs = __builtin_amdgcn_make_buffer_rsrc((void*)Vh, 0, 0x7ffffff0, 0x00020000);
#define VM0() asm volatile("s_waitcnt vmcnt(0)" ::: "memory")
#define KVDMA(b, k0) do { const int _o = (k0) * ldk * 2; LAS char* _k = K_lds + (b) * SHM_K + pz; LAS char* _v = V_lds + (b) * SHM_V2 + pz; \
    DMA16(krs, _k, kvo, _o); DMA16(krs, _k + 8192, kvo, _o + l32); DMA16(vrs, _v, vvo, _o); DMA16(vrs, _v + 8192, vvo, _o + l16); \
    DMA16(vrs, _v + 16384, vvo, _o + 2 * l16); DMA16(vrs, _v + 24576, vvo, _o + 3 * l16); } while (0)
  int ka[8];
  { const int kxor = (r32 & 7) << 4, krb = (int)(uintptr_t)K_lds + r32 * 256;
#pragma unroll
    for (int d0 = 0; d0 < 8; ++d0) ka[d0] = krb + (((d0 * 16 + hi * 8) * 2) ^ kxor); }
  f32x16 P; bf16x8 pa0, pa1, f0, f1, f2, f3; VSet va, vb_, vc;
  const int NT = seq / KVBLK;
#define PINIT() do { _Pragma("unroll") for (int r = 0; r < 16; ++r) { float _z; asm volatile("v_mov_b32 %0, %1" : "=v"(_z) : "v"(SHIFT ? nmc : 0.f)); P[r] = _z; } } while (0)
#define KOFF(b, h) ((b) * 16384 + (h) * 8192)
#define VOFF(b, h, d0) ((b) * 32768 + (h) * 16384 + (d0) * 512)
#define KPRO(b, h) do { f0 = k_read<KOFF(b, h)>(ka[0]); f1 = k_read<KOFF(b, h)>(ka[1]); f2 = k_read<KOFF(b, h)>(ka[2]); } while (0)
#define QKM(F, d0) do { SCHED; P = __builtin_amdgcn_mfma_f32_32x32x16_bf16(F, qr[d0], P, 0, 0, 0); SCHED; } while (0)
#define QKHALF(b, h) do { PINIT(); \
    LGK(2); QKM(f0, 0); f3 = k_read<KOFF(b, h)>(ka[3]); \
    LGK(2); QKM(f1, 1); f0 = k_read<KOFF(b, h)>(ka[4]); \
    LGK(2); QKM(f2, 2); f1 = k_read<KOFF(b, h)>(ka[5]); \
    LGK(2); QKM(f3, 3); f2 = k_read<KOFF(b, h)>(ka[6]); \
    LGK(2); QKM(f0, 4); f3 = k_read<KOFF(b, h)>(ka[7]); \
    LGK(2); QKM(f1, 5); v_read<VOFF(b, h, 0)>(va, vb0); \
    LGK(5); QKM(f2, 6); v_read<VOFF(b, h, 1)>(vb_, vb0); \
    LGK(8); QKM(f3, 7); } while (0)
#define SMH() do { exp16(P); l_reg += sum16(P); PK4(P, 0, pa0); PK4(P, 8, pa1); } while (0)
#define PVM(S, d0) do { SCHED; pv2(o[d0], S, pa0, pa1); SCHED; } while (0)
#define PVHALF(b, h, NEXTK, nb, nh) do { \
    LGK(4); PVM(va, 0); v_read<VOFF(b, h, 2)>(vc, vb0); \
    LGK(4); PVM(vb_, 1); v_read<VOFF(b, h, 3)>(va, vb0); \
    LGK(4); PVM(vc, 2); v_read<VOFF(b, h, 4)>(vb_, vb0); \
    LGK(4); PVM(va, 3); v_read<VOFF(b, h, 5)>(vc, vb0); \
    LGK(4); PVM(vb_, 4); v_read<VOFF(b, h, 6)>(va, vb0); \
    LGK(4); PVM(vc, 5); v_read<VOFF(b, h, 7)>(vb_, vb0); \
    LGK(4); PVM(va, 6); if (NEXTK) { f0 = k_read<KOFF(nb, nh)>(ka[0]); f1 = k_read<KOFF(nb, nh)>(ka[1]); } \
    if (NEXTK) { LGK(2); } else { LGK(0); } PVM(vb_, 7); if (NEXTK) { f2 = k_read<KOFF(nb, nh)>(ka[2]); } } while (0)
#define STEPC(b, j) do { if ((j) + 1 < NT) KVDMA((b) ^ 1, ((j) + 1) * KVBLK); \
    KPRO(b, 0); QKHALF(b, 0); SMH(); PVHALF(b, 0, true, b, 1); \
    QKHALF(b, 1); SMH(); PVHALF(b, 1, false, 0, 0); \
    VM0(); __syncthreads(); } while (0)
  KVDMA(0, 0); VM0(); __syncthreads();
  for (int j = 0; j < NT; j += 2) { STEPC(0, j); STEPC(1, j + 1); }
  { auto rr = __builtin_amdgcn_permlane32_swap(__float_as_uint(l_reg), __float_as_uint(l_reg), false, false); l_reg = __uint_as_float(rr[0]) + __uint_as_float(rr[1]); }
  if (hi == 0) li_l[r32] = l_reg; asm volatile("s_waitcnt lgkmcnt(0)" ::: "memory");
  bf16_t* Ow = Ob + (long)(wid * QBLK) * ldo;
#pragma unroll
  for (int r = 0; r < 16; ++r) { const int orow = crow(r, hi); const float rl = __builtin_amdgcn_rcpf(li_l[orow]);
#pragma unroll
    for (int d0 = 0; d0 < 8; ++d0) Ow[(long)orow * ldo + d0 * 32 + r32] = f2bf(o[d0][r] * rl); }
  VM0();
  __syncthreads();
#undef KVDMA
#undef PINIT
#undef KOFF
#undef VOFF
#undef KPRO
#undef QKM
#undef QKHALF
#undef SMH
#undef PVM
#undef PVHALF
#undef STEPC
#undef VM0
}
__device__ __forceinline__ void attn_body_c256(const bf16_t* __restrict__ Qb, const int ldq, const bf16_t* __restrict__ Kh, const bf16_t* __restrict__ Vh, const int ldk,
                                               bf16_t* __restrict__ Ob, const int ldo, const int seq, const float kmax2, LAS char* lds) {
  int tid = threadIdx.x; asm volatile("" : "+v"(tid)); tid &= 511;
  const int wid = tid >> 6, lane = tid & 63, r32 = lane & 31, hi = lane >> 5;
  bf16x8 qr[8];
  const float nmc = load_q(Qb + (long)(wid * QBLK + r32) * ldq + hi * 8, qr, kmax2);
  if (__all(nmc > -64.f)) attn_body_c256_t<false>(Qb, ldq, Kh, Vh, ldk, Ob, ldo, seq, 0.f, qr, lds);
  else attn_body_c256_t<true>(Qb, ldq, Kh, Vh, ldk, Ob, ldo, seq, nmc, qr, lds);
}

__device__ __forceinline__ float load_q8(const bf16_t* __restrict__ Qrow, int hi, v8i_ (&qf)[2], float kmax2) {
  float ss = 0;
#pragma unroll
  for (int st = 0; st < 2; ++st) {
    const bf16_t* p = Qrow + 64 * st + 32 * hi; v8i_ o;
#pragma unroll
    for (int c = 0; c < 4; ++c) { const u32x4 raw = *reinterpret_cast<const u32x4*>(p + 8 * c);
      const unsigned w0 = pack8x4(bflo(raw[0]) * QC, bfhi(raw[0]) * QC, bflo(raw[1]) * QC, bfhi(raw[1]) * QC);
      const unsigned w1 = pack8x4(bflo(raw[2]) * QC, bfhi(raw[2]) * QC, bflo(raw[3]) * QC, bfhi(raw[3]) * QC);
      o[2 * c] = (int)w0; o[2 * c + 1] = (int)w1; ss += sq8x4(w0) + sq8x4(w1); }
    qf[st] = o;
  }
  { auto rr = __builtin_amdgcn_permlane32_swap(__float_as_uint(ss), __float_as_uint(ss), false, false); ss = __uint_as_float(rr[0]) + __uint_as_float(rr[1]); }
  return -(sqrtf(ss * kmax2) * 1.01f + 1e-3f);
}
__device__ __forceinline__ int k8_dma_voff(int wid, int lane, int ldk8) {
  const int row = 8 * wid + (lane >> 3); return row * ldk8 + (((lane & 7) ^ ((row >> 1) & 7)) << 4); }
template <int OFF> __device__ __forceinline__ v4i k8_read(int ka) { v4i r; asm volatile("ds_read_b128 %0, %1 offset:%2" : "=&v"(r) : "v"(ka), "i"(OFF) : "memory"); return r; }

template <bool SHIFT>
__device__ __forceinline__ void attn_body_c256q8_t(const unsigned char* __restrict__ K8, const int ldk8, const bf16_t* __restrict__ Vh, const int ldk,
                                                   bf16_t* __restrict__ Ob, const int ldo, const int seq, const float nmc, const v8i_ (&qf)[2], LAS char* lds) {
  int tid = threadIdx.x; asm volatile("" : "+v"(tid)); tid &= 511;
  const int wid = __builtin_amdgcn_readfirstlane(tid >> 6), lane = tid & 63, r32 = lane & 31, hi = lane >> 5;
  constexpr int SHM_K8 = KVBLK * 128;
  LAS char* K_lds = lds; LAS char* V_lds = lds + 2 * SHM_K8;
  LAS float* li_l = (LAS float*)(lds + 2 * SHM_K8 + 2 * SHM_V2) + wid * 64;
  float l_reg = 0; f32x16 o[8] = {};
  const int vb0 = (int)(uintptr_t)V_lds + v_rd_base(lane);
  const int kvo = k8_dma_voff(wid, lane, ldk8);
  const int vvo = unswap23(8 * (wid >> 2) + ((lane & 31) >> 2)) * ldk * 2 + ((2 * (wid & 3) + (lane >> 5)) * 32 + (lane & 3) * 8) * 2;
  const int l16 = 32 * ldk, pz = wid * 1024;
  const __amdgpu_buffer_rsrc_t krs = __builtin_amdgcn_make_buffer_rsrc((void*)K8, 0, 0x7ffffff0, 0x00020000);
  const __amdgpu_buffer_rsrc_t vrs = __builtin_amdgcn_make_buffer_rsrc((void*)Vh, 0, 0x7ffffff0, 0x00020000);
#define VM0() asm volatile("s_waitcnt vmcnt(0)" ::: "memory")
#define KVDMA(b, k0) do { const int _o = (k0) * ldk * 2; LAS char* _v = V_lds + (b) * SHM_V2 + pz; \
    DMA16(krs, K_lds + (b) * SHM_K8 + pz, kvo, (k0) * ldk8); DMA16(vrs, _v, vvo, _o); DMA16(vrs, _v + 8192, vvo, _o + l16); \
    DMA16(vrs, _v + 16384, vvo, _o + 2 * l16); DMA16(vrs, _v + 24576, vvo, _o + 3 * l16); } while (0)
  const int ka0 = (int)(uintptr_t)K_lds + r32 * 128 + (((2 * hi) ^ ((r32 >> 1) & 7)) << 4);
  const int ka1 = ka0 ^ 16, ka2 = ka0 ^ 64, ka3 = ka0 ^ 80;
  int sc1; asm volatile("v_mov_b32 %0, 0x7f7f7f7f" : "=v"(sc1));
  f32x16 P; bf16x8 pa0, pa1; v4i k0a, k0b, k1a, k1b; VSet va, vb_, vc;
  const int NT = seq / KVBLK;
#define KOFF(b, h) ((b) * 8192 + (h) * 4096)
#define VOFF(b, h, d0) ((b) * 32768 + (h) * 16384 + (d0) * 512)
#define KPRO(b, h) do { k0a = k8_read<KOFF(b, h)>(ka0); k0b = k8_read<KOFF(b, h)>(ka1); k1a = k8_read<KOFF(b, h)>(ka2); k1b = k8_read<KOFF(b, h)>(ka3); } while (0)
#define V8(x, y) (v8i_){x[0], x[1], x[2], x[3], y[0], y[1], y[2], y[3]}
#define QKHALF(b, h) do { \
    if (SHIFT) { _Pragma("unroll") for (int r = 0; r < 16; ++r) { float _z; asm volatile("v_mov_b32 %0, %1" : "=v"(_z) : "v"(nmc)); P[r] = _z; } } \
    LGK(2); SCHED; { const v8i_ kf = V8(k0a, k0b); \
      if (SHIFT) asm volatile("s_nop 4\n\tv_mfma_scale_f32_32x32x64_f8f6f4 %0, %1, %2, %0, %3, %3 op_sel_hi:[0,0,0]" : "+v"(P) : "v"(kf), "v"(qf[0]), "v"(sc1)); \
      else       asm volatile("v_mfma_scale_f32_32x32x64_f8f6f4 %0, %1, %2, 0, %3, %3 op_sel_hi:[0,0,0]" : "=&v"(P) : "v"(kf), "v"(qf[0]), "v"(sc1)); } \
    SCHED; v_read<VOFF(b, h, 0)>(va, vb0); \
    LGK(4); SCHED; { const v8i_ kf = V8(k1a, k1b); \
      asm volatile("v_mfma_scale_f32_32x32x64_f8f6f4 %0, %1, %2, %0, %3, %3 op_sel_hi:[0,0,0]" : "+v"(P) : "v"(kf), "v"(qf[1]), "v"(sc1)); } \
    SCHED; v_read<VOFF(b, h, 1)>(vb_, vb0); \
    asm volatile("s_nop 15\n\ts_nop 7" : "+v"(P)); } while (0)
#define SMH() do { exp16(P); l_reg += sum16(P); PK4(P, 0, pa0); PK4(P, 8, pa1); } while (0)
#define PVM(S, d0) do { SCHED; pv2(o[d0], S, pa0, pa1); SCHED; } while (0)
#define PVHALF(b, h, NEXTK, nb, nh) do { \
    LGK(4); PVM(va, 0); v_read<VOFF(b, h, 2)>(vc, vb0); \
    LGK(4); PVM(vb_, 1); v_read<VOFF(b, h, 3)>(va, vb0); \
    LGK(4); PVM(vc, 2); v_read<VOFF(b, h, 4)>(vb_, vb0); \
    LGK(4); PVM(va, 3); v_read<VOFF(b, h, 5)>(vc, vb0); \
    LGK(4); PVM(vb_, 4); v_read<VOFF(b, h, 6)>(va, vb0); \
    LGK(4); PVM(vc, 5); v_read<VOFF(b, h, 7)>(vb_, vb0); \
    LGK(4); PVM(va, 6); if (NEXTK) { k0a = k8_read<KOFF(nb, nh)>(ka0); k0b = k8_read<KOFF(nb, nh)>(ka1); } \
    if (NEXTK) { LGK(2); } else { LGK(0); } PVM(vb_, 7); if (NEXTK) { k1a = k8_read<KOFF(nb, nh)>(ka2); k1b = k8_read<KOFF(nb, nh)>(ka3); } } while (0)
#define STEPC(b, j) do { if ((j) + 1 < NT) KVDMA((b) ^ 1, ((j) + 1) * KVBLK); \
    KPRO(b, 0); QKHALF(b, 0); SMH(); PVHALF(b, 0, true, b, 1); \
    QKHALF(b, 1); SMH(); PVHALF(b, 1, false, 0, 0); \
    VM0(); __syncthreads(); } while (0)
  KVDMA(0, 0); VM0(); __syncthreads();
  for (int j = 0; j < NT; j += 2) { STEPC(0, j); STEPC(1, j + 1); }
  { auto rr = __builtin_amdgcn_permlane32_swap(__float_as_uint(l_reg), __float_as_uint(l_reg), false, false); l_reg = __uint_as_float(rr[0]) + __uint_as_float(rr[1]); }
  if (hi == 0) li_l[r32] = l_reg; asm volatile("s_waitcnt lgkmcnt(0)" ::: "memory");
  bf16_t* Ow = Ob + (long)(wid * QBLK) * ldo;
#pragma unroll
  for (int r = 0; r < 16; ++r) { const int orow = crow(r, hi); const float rl = __builtin_amdgcn_rcpf(li_l[orow]);
#pragma unroll
    for (int d0 = 0; d0 < 8; ++d0) Ow[(long)orow * ldo + d0 * 32 + r32] = f2bf(o[d0][r] * rl); }
  VM0();
  __syncthreads();
#undef KVDMA
#undef KOFF
#undef VOFF
#undef KPRO
#undef V8
#undef QKHALF
#undef SMH
#undef PVM
#undef PVHALF
#undef STEPC
#undef VM0
}
__device__ __forceinline__ void attn_body_c256q8(const bf16_t* __restrict__ Qb, const int ldq, const unsigned char* __restrict__ K8, const int ldk8,
                                                 const bf16_t* __restrict__ Vh, const int ldk, bf16_t* __restrict__ Ob, const int ldo, const int seq, const float kmax2, LAS char* lds) {
  int tid = threadIdx.x; asm volatile("" : "+v"(tid)); tid &= 511;
  const int wid = tid >> 6, lane = tid & 63, r32 = lane & 31, hi = lane >> 5;
  v8i_ qf[2];
  const float nmc = load_q8(Qb + (long)(wid * QBLK + r32) * ldq, hi, qf, kmax2);
  if (__all(nmc > -64.f)) attn_body_c256q8_t<false>(K8, ldk8, Vh, ldk, Ob, ldo, seq, 0.f, qf, lds);
  else attn_body_c256q8_t<true>(K8, ldk8, Vh, ldk, Ob, ldo, seq, nmc, qf, lds);
}

template <bool SHIFT>
__device__ __forceinline__ void attn_body_q8_t(const unsigned char* __restrict__ K8, const int ldk8, const bf16_t* __restrict__ Vh, const int ldk,
                                               bf16_t* __restrict__ Ob, const int ldo, const int seq, const float nmc, const v8i_ (&qf)[2], LAS char* lds) {
  int tid = threadIdx.x; asm volatile("" : "+v"(tid)); tid &= 511;
  const int wid = __builtin_amdgcn_readfirstlane(tid >> 6), lane = tid & 63, r32 = lane & 31, hi = lane >> 5;
  constexpr int SK8 = KVBLK * 128, ST = SK8 + SHM_V;
  LAS float* li_l = (LAS float*)(lds + 3 * ST) + wid * 64;
  float l_reg = 0; f32x16 o[4] = {};
  const int vrb = v_rd_base(lane);
  const int kvo = k8_dma_voff(wid, lane, ldk8);
  const int vvo = unswap23(8 * (wid >> 1) + ((lane & 31) >> 2)) * ldk * 2 + ((2 * (wid & 1) + (lane >> 5)) * 32 + (lane & 3) * 8) * 2;
  const int l32 = 64 * ldk, pz = wid * 1024;
  const __amdgpu_buffer_rsrc_t krs = __builtin_amdgcn_make_buffer_rsrc((void*)K8, 0, 0x7ffffff0, 0x00020000);
  const __amdgpu_buffer_rsrc_t vrs = __builtin_amdgcn_make_buffer_rsrc((void*)Vh, 0, 0x7ffffff0, 0x00020000);
#define TDMA(slot, k0) do { const int _o = (k0) * ldk * 2; LAS char* _b = lds + (slot) * ST + pz; \
    DMA16(krs, _b, kvo, (k0) * ldk8); DMA16(vrs, _b + SK8, vvo, _o); DMA16(vrs, _b + SK8 + 8192, vvo, _o + l32); } while (0)
#define VM0() asm volatile("s_waitcnt vmcnt(0)" ::: "memory")
  int sc1; asm volatile("v_mov_b32 %0, 0x7f7f7f7f" : "=v"(sc1));
  const int kof = r32 * 128 + (((2 * hi) ^ ((r32 >> 1) & 7)) << 4);
#define QKT8(P0, P1, Ks) do { \
    const v4i a0 = *(LAS const v4i*)((Ks) + kof), a1 = *(LAS const v4i*)((Ks) + (kof ^ 16)), a2 = *(LAS const v4i*)((Ks) + (kof ^ 64)), a3 = *(LAS const v4i*)((Ks) + (kof ^ 80)); \
    const v4i b0 = *(LAS const v4i*)((Ks) + 4096 + kof), b1 = *(LAS const v4i*)((Ks) + 4096 + (kof ^ 16)), b2 = *(LAS const v4i*)((Ks) + 4096 + (kof ^ 64)), b3 = *(LAS const v4i*)((Ks) + 4096 + (kof ^ 80)); \
    v8i_ k00 = (v8i_){a0[0], a0[1], a0[2], a0[3], a1[0], a1[1], a1[2], a1[3]}, k01 = (v8i_){a2[0], a2[1], a2[2], a2[3], a3[0], a3[1], a3[2], a3[3]}; \
    v8i_ k10 = (v8i_){b0[0], b0[1], b0[2], b0[3], b1[0], b1[1], b1[2], b1[3]}, k11 = (v8i_){b2[0], b2[1], b2[2], b2[3], b3[0], b3[1], b3[2], b3[3]}; \
    if (SHIFT) { _Pragma("unroll") for (int r = 0; r < 16; ++r) { P0[r] = nmc; P1[r] = nmc; } \
      asm volatile("s_nop 4\n\tv_mfma_scale_f32_32x32x64_f8f6f4 %0, %1, %2, %0, %3, %3 op_sel_hi:[0,0,0]" : "+v"(P0) : "v"(k00), "v"(qf[0]), "v"(sc1)); \
      asm volatile("v_mfma_scale_f32_32x32x64_f8f6f4 %0, %1, %2, %0, %3, %3 op_sel_hi:[0,0,0]" : "+v"(P1) : "v"(k10), "v"(qf[0]), "v"(sc1)); } \
    else { asm volatile("v_mfma_scale_f32_32x32x64_f8f6f4 %0, %1, %2, 0, %3, %3 op_sel_hi:[0,0,0]" : "=&v"(P0) : "v"(k00), "v"(qf[0]), "v"(sc1)); \
      asm volatile("v_mfma_scale_f32_32x32x64_f8f6f4 %0, %1, %2, 0, %3, %3 op_sel_hi:[0,0,0]" : "=&v"(P1) : "v"(k10), "v"(qf[0]), "v"(sc1)); } \
    asm volatile("v_mfma_scale_f32_32x32x64_f8f6f4 %0, %1, %2, %0, %3, %3 op_sel_hi:[0,0,0]" : "+v"(P0) : "v"(k01), "v"(qf[1]), "v"(sc1)); \
    asm volatile("v_mfma_scale_f32_32x32x64_f8f6f4 %0, %1, %2, %0, %3, %3 op_sel_hi:[0,0,0]" : "+v"(P1) : "v"(k11), "v"(qf[1]), "v"(sc1)); \
      \
    asm volatile("s_nop 15" : "+v"(k00), "+v"(k01), "+v"(k10), "+v"(k11)); } while (0)
#define TIE(P0, P1) asm volatile("s_nop 15\n\ts_nop 7" : "+v"(P0), "+v"(P1))
#define TIE0(P0, P1) asm volatile("" : "+v"(P0), "+v"(P1))
#define FINISH(P0, P1) do { exp16(P1); l_reg += sum16(P0) + sum16(P1); PK4(P0, 0, pa0); PK4(P0, 8, pa1); PK4(P1, 0, pa2); PK4(P1, 8, pa3); } while (0)
  f32x16 pA0, pA1, pB0, pB1; bf16x8 pa0, pa1, pa2, pa3; const int NT = seq / KVBLK;
  TDMA(0, 0); VM0(); __syncthreads();
  TDMA(1, KVBLK);
  QKT8(pA0, pA1, lds); TIE(pA0, pA1); exp16(pA0);
  VM0(); __syncthreads();
  int sk = 1, sv = 0, sd = 2;
  for (int j = 1; j + 1 < NT; j += 2) {
    TDMA(sd, (j + 1) * KVBLK);
    SCHED; QKT8(pB0, pB1, lds + sk * ST);
    FINISH(pA0, pA1); SCHED;
    pv_d0(o, (int)(uintptr_t)(lds + sv * ST + SK8) + vrb, pa0, pa1, pa2, pa3); TIE0(pB0, pB1); exp16(pB0);
    VM0(); __syncthreads();
    { const int t = sv; sv = sk; sk = sd; sd = t; }
    if (j + 2 < NT) TDMA(sd, (j + 2) * KVBLK);
    SCHED; QKT8(pA0, pA1, lds + sk * ST);
    FINISH(pB0, pB1); SCHED;
    pv_d0(o, (int)(uintptr_t)(lds + sv * ST + SK8) + vrb, pa0, pa1, pa2, pa3); TIE0(pA0, pA1); exp16(pA0);
    VM0(); __syncthreads();
    { const int t = sv; sv = sk; sk = sd; sd = t; }
  }
  SCHED; QKT8(pB0, pB1, lds + sk * ST);
  FINISH(pA0, pA1); SCHED;
  pv_d0(o, (int)(uintptr_t)(lds + sv * ST + SK8) + vrb, pa0, pa1, pa2, pa3); TIE0(pB0, pB1); exp16(pB0);
  FINISH(pB0, pB1); SCHED;
  pv_d0(o, (int)(uintptr_t)(lds + sk * ST + SK8) + vrb, pa0, pa1, pa2, pa3);
  { auto rr = __builtin_amdgcn_permlane32_swap(__float_as_uint(l_reg), __float_as_uint(l_reg), false, false); l_reg = __uint_as_float(rr[0]) + __uint_as_float(rr[1]); }
#if DENSE8_G2
  store_o8(o, l_reg, li_l, (unsigned char*)Ob + (long)(wid * QBLK) * ldo, ldo, r32, hi);
#else
  store_o(o, l_reg, li_l, Ob + (long)(wid * QBLK) * ldo, ldo, r32, hi);
#endif
  VM0();
  __syncthreads();
#undef TDMA
#undef VM0
#undef QKT8
#undef TIE
#undef TIE0
#undef FINISH
}
__device__ __forceinline__ void attn_body_q8(const bf16_t* __restrict__ Qb, const int ldq, const unsigned char* __restrict__ K8, const int ldk8,
                                             const bf16_t* __restrict__ Vh, const int ldk, bf16_t* __restrict__ Ob, const int ldo, const int seq, const float kmax2, LAS char* lds) {
  int tid = threadIdx.x; asm volatile("" : "+v"(tid)); tid &= 511;
  const int wid = tid >> 6, lane = tid & 63, r32 = lane & 31, hi = lane >> 5;
  v8i_ qf[2];
  const float nmc = load_q8(Qb + (long)(wid * QBLK + r32) * ldq, hi, qf, kmax2);
  if (__all(nmc > -64.f)) attn_body_q8_t<false>(K8, ldk8, Vh, ldk, Ob, ldo, seq, 0.f, qf, lds);
  else attn_body_q8_t<true>(K8, ldk8, Vh, ldk, Ob, ldo, seq, nmc, qf, lds);
}

__device__ __forceinline__ unsigned pk8nc(float a, float b, float c, float d) {
  int p = __builtin_amdgcn_cvt_pk_fp8_f32(a, b, 0, false); p = __builtin_amdgcn_cvt_pk_fp8_f32(c, d, p, true); return (unsigned)p; }
__device__ __forceinline__ float max16(const f32x16& p) {
  float a = fmaxf(fmaxf(p[0], p[1]), fmaxf(p[2], p[3])), b = fmaxf(fmaxf(p[4], p[5]), fmaxf(p[6], p[7]));
  float c = fmaxf(fmaxf(p[8], p[9]), fmaxf(p[10], p[11])), d = fmaxf(fmaxf(p[12], p[13]), fmaxf(p[14], p[15]));
  return fmaxf(fmaxf(a, b), fmaxf(c, d)); }
template <int NCB>
__device__ __forceinline__ void attn_body_d(const bf16_t* __restrict__ Qb, const int ldq, const unsigned char* __restrict__ K8, const int ldk8,
                                               const unsigned char* __restrict__ V8T  ,
                                               bf16_t* __restrict__ Ob, const int ldo, const int seq, LAS char* lds) {
  int tid = threadIdx.x; asm volatile("" : "+v"(tid)); tid &= 511;
  const int wid = __builtin_amdgcn_readfirstlane(tid >> 6), lane = tid & 63, r32 = lane & 31, hi = lane >> 5;
  v8i_ qf[2];
  (void)load_q8(Qb + (long)(wid * QBLK + r32) * ldq, hi, qf, 0.f);
  constexpr int SK8 = KVBLK * 128, SV8 = NCB * 32 * 64;
  LAS char* K_lds = lds; LAS char* V_lds = lds + 2 * SK8;
  LAS float* li_l = (LAS float*)(lds + 2 * SK8 + 2 * SV8) + wid * 64;
  float l_reg = 0; f32x16 o[NCB] = {};
  const int kvo = k8_dma_voff(wid, lane, ldk8);
  const int vvo = lane * 16 + wid * 1024, pz = wid * 1024;
  const __amdgpu_buffer_rsrc_t krs = __builtin_amdgcn_make_buffer_rsrc((void*)K8, 0, 0x7ffffff0, 0x00020000);
  const __amdgpu_buffer_rsrc_t vrs = __builtin_amdgcn_make_buffer_rsrc((void*)V8T, 0, 0x7ffffff0, 0x00020000);
#define VM0() asm volatile("s_waitcnt vmcnt(0)" ::: "memory")
#define KVDMA(b, t) do { DMA16(krs, K_lds + (b) * SK8 + pz, kvo, (t) * KVBLK * ldk8); \
    DMA16(vrs, V_lds + (b) * SV8 + pz, vvo, (t) * SV8); if (NCB == 8) DMA16(vrs, V_lds + (b) * SV8 + pz + 8192, vvo, (t) * SV8 + 8192); } while (0)
  const int ka0 = (int)(uintptr_t)K_lds + r32 * 128 + (((2 * hi) ^ ((r32 >> 1) & 7)) << 4);
  const int ka1 = ka0 ^ 16, ka2 = ka0 ^ 64, ka3 = ka0 ^ 80;
  const int vf0 = (int)(uintptr_t)V_lds + r32 * 64 + (((2 * hi) ^ ((r32 >> 2) & 3)) << 4), vf1 = vf0 ^ 16;
  int sc1; asm volatile("v_mov_b32 %0, 0x7f7f7f7f" : "=v"(sc1));
  const int NT = seq / KVBLK;
#define RD128(dst, addr, OFF) asm volatile("ds_read_b128 %0, %1 offset:%2" : "=&v"(dst) : "v"(addr), "i"(OFF) : "memory")
#define V8(x, y) (v8i_){x[0], x[1], x[2], x[3], y[0], y[1], y[2], y[3]}
#define VFR(A_, B_, b, d0) do { RD128(A_, vf0, (b) * SV8 + (d0) * 2048); RD128(B_, vf1, (b) * SV8 + (d0) * 2048); } while (0)
#define PVM(A_, B_, d0) do { SCHED; { const v8i_ vfr = V8(A_, B_); \
    asm volatile("v_mfma_scale_f32_32x32x64_f8f6f4 %0, %1, %2, %0, %3, %4 op_sel_hi:[0,0,0]" : "+v"(o[(d0) < NCB ? (d0) : 0]) : "v"(pa8), "v"(vfr), "v"(sca), "v"(sc1)); } SCHED; } while (0)
#define STEPD(b, j) do { if ((j) + 1 < NT) KVDMA((b) ^ 1, (j) + 1); \
      \
    RD128(k0, ka0, (b) * 8192); RD128(k1, ka1, (b) * 8192); RD128(k2, ka2, (b) * 8192); RD128(k3, ka3, (b) * 8192); \
    RD128(k4, ka0, (b) * 8192 + 4096); RD128(k5, ka1, (b) * 8192 + 4096); RD128(k6, ka2, (b) * 8192 + 4096); RD128(k7, ka3, (b) * 8192 + 4096); \
    LGK(6); SCHED; { const v8i_ kf = V8(k0, k1); asm volatile("v_mfma_scale_f32_32x32x64_f8f6f4 %0, %1, %2, 0, %3, %3 op_sel_hi:[0,0,0]" : "=&v"(p0) : "v"(kf), "v"(qf[0]), "v"(sc1)); } \
    LGK(4); SCHED; { const v8i_ kf = V8(k2, k3); asm volatile("v_mfma_scale_f32_32x32x64_f8f6f4 %0, %1, %2, %0, %3, %3 op_sel_hi:[0,0,0]" : "+v"(p0) : "v"(kf), "v"(qf[1]), "v"(sc1)); } \
    LGK(2); SCHED; { const v8i_ kf = V8(k4, k5); asm volatile("v_mfma_scale_f32_32x32x64_f8f6f4 %0, %1, %2, 0, %3, %3 op_sel_hi:[0,0,0]" : "=&v"(p1) : "v"(kf), "v"(qf[0]), "v"(sc1)); } \
    LGK(0); SCHED; { const v8i_ kf = V8(k6, k7); asm volatile("v_mfma_scale_f32_32x32x64_f8f6f4 %0, %1, %2, %0, %3, %3 op_sel_hi:[0,0,0]" : "+v"(p1) : "v"(kf), "v"(qf[1]), "v"(sc1)); } \
    SCHED; VFR(va, vb, b, 0); VFR(vc, vd, b, 1); \
    asm volatile("s_nop 15\n\ts_nop 7" : "+v"(p0), "+v"(p1)); \
      \
    { const float mo = fmaxf(max16(p0), max16(p1)); \
      auto sA = __builtin_amdgcn_permlane32_swap(__float_as_uint(mo), __float_as_uint(mo), false, false); \
      const float e0 = fminf(fmaxf(ceilf(fmaxf(__uint_as_float(sA[0]), __uint_as_float(sA[1]))), -120.f), 120.f); \
      _Pragma("unroll") for (int r = 0; r < 16; ++r) { p0[r] = __builtin_amdgcn_exp2f(p0[r] - e0); p1[r] = __builtin_amdgcn_exp2f(p1[r] - e0); } \
      l_reg += __builtin_amdgcn_exp2f(e0) * (sum16(p0) + sum16(p1)); \
      sca = 127 + (int)e0; \
      _Pragma("unroll") for (int q = 0; q < 4; ++q) { \
        const unsigned x = pk8nc(p0[4 * q], p0[4 * q + 1], p0[4 * q + 2], p0[4 * q + 3]), y = pk8nc(p1[4 * q], p1[4 * q + 1], p1[4 * q + 2], p1[4 * q + 3]); \
        auto rr = __builtin_amdgcn_permlane32_swap(x, y, false, false); pa8[q] = (int)rr[0]; pa8[4 + q] = (int)rr[1]; } } \
      \
    asm volatile("s_nop 4" : "+v"(pa8), "+v"(sca));     \
    if (NCB == 8) { \
    LGK(2); PVM(va, vb, 0); VFR(ve, vf, b, 2); \
    LGK(2); PVM(vc, vd, 1); VFR(va, vb, b, 3); \
    LGK(2); PVM(ve, vf, 2); VFR(vc, vd, b, 4); \
    LGK(2); PVM(va, vb, 3); VFR(ve, vf, b, 5); \
    LGK(2); PVM(vc, vd, 4); VFR(va, vb, b, 6); \
    LGK(2); PVM(ve, vf, 5); VFR(vc, vd, b, 7); \
    LGK(2); PVM(va, vb, 6); \
    LGK(0); PVM(vc, vd, NCB - 1); } else { \
    LGK(2); PVM(va, vb, 0); VFR(ve, vf, b, 2); \
    LGK(2); PVM(vc, vd, 1); VFR(va, vb, b, 3); \
    LGK(2); PVM(ve, vf, 2); \
    LGK(0); PVM(va, vb, 3); } \
    VM0(); __syncthreads(); } while (0)
  f32x16 p0, p1; v8i_ pa8; int sca; v4i k0, k1, k2, k3, k4, k5, k6, k7, va, vb, vc, vd, ve, vf;
  KVDMA(0, 0); VM0(); __syncthreads();
  for (int j = 0; j < NT; j += 2) { STEPD(0, j); STEPD(1, j + 1); }
  asm volatile("s_nop 15\n\ts_nop 7" ::: "memory");
#pragma unroll
  for (int d0 = 0; d0 < NCB; ++d0) asm volatile("" : "+v"(o[d0]));
  { auto rr = __builtin_amdgcn_permlane32_swap(__float_as_uint(l_reg), __float_as_uint(l_reg), false, false); l_reg = __uint_as_float(rr[0]) + __uint_as_float(rr[1]); }
  if (hi == 0) li_l[r32] = l_reg; asm volatile("s_waitcnt lgkmcnt(0)" ::: "memory");
  bf16_t* Ow = Ob + (long)(wid * QBLK) * ldo;
#pragma unroll
  for (int r = 0; r < 16; ++r) { const int orow = crow(r, hi); const float rl = __builtin_amdgcn_rcpf(li_l[orow]);
#pragma unroll
    for (int d0 = 0; d0 < NCB; ++d0) Ow[(long)orow * ldo + d0 * 32 + r32] = f2bf(o[d0][r] * rl); }
  VM0();
  __syncthreads();
#undef VM0
#undef KVDMA
#undef RD128
#undef V8
#undef VFR
#undef PVM
#undef STEPD
}
#undef PK4
}

__device__ __forceinline__ int perm_plain8(int n) { const int r = n & 31; return (n & ~31) + 16 * ((r >> 2) & 1) + 4 * (r >> 3) + (r & 3); }
__device__ __forceinline__ int perm_row(int kind, int n) {
  if (kind == 0) return perm_plain8(n);
  if (kind == 1) { if (n < N_QKV0) return perm_plain8(n); const int c = n - N_QKV0; const int ch = c & 1023; return N_QKV0 + 32 * (ch >> 4) + ((c >> 10) << 4) + (ch & 15); }
  return 32 * (n >> 4) + ((kind == 3) ? 16 : 0) + (n & 15);
}
__device__ __forceinline__ void cvt_tile(const float* __restrict__ src, int N, bf16_t* __restrict__ dst, int K, int kind, int k0, int n0, LAS unsigned* t32) {
  int tid = threadIdx.x; asm volatile("" : "+v"(tid)); tid &= 511;
#pragma unroll
  for (int j = 0; j < 2; ++j) {
    const int item = tid + 512 * j, kp = item >> 4, q = item & 15;
    const f32x4 v0 = *(const f32x4*)(src + (size_t)(k0 + 2 * kp) * N + n0 + 4 * q);
    const f32x4 v1 = *(const f32x4*)(src + (size_t)(k0 + 2 * kp + 1) * N + n0 + 4 * q);
#pragma unroll
    for (int i = 0; i < 4; ++i) t32[(4 * q + i) * 65 + kp] = cvtpk(v0[i], v1[i]);
  }
  __syncthreads();
#pragma unroll
  for (int j = 0; j < 2; ++j) {
    const int item = tid + 512 * j, n = item >> 4, ko = item & 15;
    u32x4 v;
#pragma unroll
    for (int i = 0; i < 4; ++i) v[i] = t32[n * 65 + 4 * ko + i];
    *(u32x4*)(dst + (size_t)perm_row(kind, n0 + n) * K + k0 + 8 * ko) = v;
  }
  __syncthreads();
}
__device__ __forceinline__ void cvt_matrix_units(const float* src, int K, int N, bf16_t* dst, int kind, int u0, int ustride, LAS unsigned* t32) {
  const int nN = N / 64, nK = K / 128;
  for (int u = u0; u < nN * nK; u += ustride) cvt_tile(src, N, dst, K, kind, (u / nN) * 128, (u % nN) * 64, t32);
}
constexpr size_t WMOE8_E = (size_t)1024 * D + (size_t)D * EFF;
__device__ __forceinline__ void cvt_tile8(const float* __restrict__ src, int N, unsigned char* __restrict__ dst, int K, int kind, int k0, int n0, float scale, LAS unsigned* t32) {
  int tid = threadIdx.x; asm volatile("" : "+v"(tid)); tid &= 511;
  { const int kq = tid >> 4, q = tid & 15;
    f32x4 v[4];
#pragma unroll
    for (int r = 0; r < 4; ++r) v[r] = *(const f32x4*)(src + (size_t)(k0 + 4 * kq + r) * N + n0 + 4 * q);
#pragma unroll
    for (int i = 0; i < 4; ++i) t32[(4 * q + i) * 33 + kq] = pack_fp8x4(v[0][i] * scale, v[1][i] * scale, v[2][i] * scale, v[3][i] * scale); }
  __syncthreads();
  { const int n = tid >> 3, kc = tid & 7;
    u32x4 v;
#pragma unroll
    for (int i = 0; i < 4; ++i) v[i] = t32[n * 33 + 4 * kc + i];
    *(u32x4*)(dst + (size_t)perm_row(kind, n0 + n) * K + k0 + 16 * kc) = v; }
  __syncthreads();
}
__device__ __forceinline__ void cvt_matrix_units8(const float* src, int K, int N, unsigned char* dst, int kind, float scale, LAS unsigned* t32) {
  const int nN = N / 64, nK = K / 128;
  for (int u = blockIdx.x; u < nN * nK; u += gridDim.x) cvt_tile8(src, N, dst, K, kind, (u / nN) * 128, (u % nN) * 64, scale, t32);
}
__device__ __forceinline__ void cvt_moe_all8(const Args& a, LAS unsigned* t32) {
  unsigned char* W = (unsigned char*)(a.ws + WS_WMOE);
  for (int u = blockIdx.x; u < 2 * 65 * 384; u += gridDim.x) {
    const int le = u / 384, L = le / 65, e = le % 65, r = u % 384, mtx = r >> 7, lu = r & 127;
    const float* src; unsigned char* dst = W + (size_t)le * WMOE8_E; int K, N, kind; float sc;
    if (mtx == 0)      { src = e < 64 ? a.in[21] + ((size_t)L * 64 + e) * D * EFF : a.in[24] + (size_t)L * D * EFF; K = D; N = EFF; kind = 2; sc = 256.f; }
    else if (mtx == 1) { src = e < 64 ? a.in[22] + ((size_t)L * 64 + e) * D * EFF : a.in[25] + (size_t)L * D * EFF; K = D; N = EFF; kind = 3; sc = 256.f; }
    else               { src = e < 64 ? a.in[23] + ((size_t)L * 64 + e) * EFF * D : a.in[26] + (size_t)L * EFF * D; K = EFF; N = D; kind = 0; sc = 128.f; dst += (size_t)1024 * D; }
    const int nN = N / 64;
    cvt_tile8(src, N, dst, K, kind, (lu / nN) * 128, (lu % nN) * 64, sc, t32);
  }
}

__device__ __forceinline__ void ld_row_f32(const float* __restrict__ p, int lane, float (&v)[32]) {
#pragma unroll
  for (int j = 0; j < 4; ++j) { const f32x4 t0 = *(const f32x4*)(p + 8 * lane + 512 * j), t1 = *(const f32x4*)(p + 8 * lane + 512 * j + 4);
#pragma unroll
    for (int i = 0; i < 4; ++i) { v[8 * j + i] = t0[i]; v[8 * j + 4 + i] = t1[i]; } }
}
__device__ __forceinline__ void ld_row_bf16(const bf16_t* __restrict__ p, int lane, float (&v)[32]) {
#pragma unroll
  for (int j = 0; j < 4; ++j) { const u32x4 t = *(const u32x4*)(p + 8 * lane + 512 * j);
#pragma unroll
    for (int i = 0; i < 4; ++i) { v[8 * j + 2 * i] = bflo(t[i]); v[8 * j + 2 * i + 1] = bfhi(t[i]); } }
}
__device__ __forceinline__ void ld_row_fp8(const unsigned char* __restrict__ p, int lane, float (&v)[32]) {
#pragma unroll
  for (int j = 0; j < 4; ++j) { const u32x2 t = *(const u32x2*)(p + 8 * lane + 512 * j);
#pragma unroll
    for (int i = 0; i < 2; ++i) { v[8 * j + 4 * i] = __builtin_amdgcn_cvt_f32_fp8((int)t[i], 0); v[8 * j + 4 * i + 1] = __builtin_amdgcn_cvt_f32_fp8((int)t[i], 1);
      v[8 * j + 4 * i + 2] = __builtin_amdgcn_cvt_f32_fp8((int)t[i], 2); v[8 * j + 4 * i + 3] = __builtin_amdgcn_cvt_f32_fp8((int)t[i], 3); } }
}
__device__ __forceinline__ void ld8f(const float* __restrict__ p, float (&x)[8]) { const f32x4 t0 = *(const f32x4*)p, t1 = *(const f32x4*)(p + 4);
#pragma unroll
  for (int i = 0; i < 4; ++i) { x[i] = t0[i]; x[4 + i] = t1[i]; } }
__device__ __forceinline__ void st8f(float* __restrict__ p, const float* x) { f32x4 t0 = {x[0], x[1], x[2], x[3]}, t1 = {x[4], x[5], x[6], x[7]}; *(f32x4*)p = t0; *(f32x4*)(p + 4) = t1; }
__device__ __forceinline__ float sumsq32(const float (&v)[32]) { float s = 0;
#pragma unroll
  for (int i = 0; i < 32; ++i) s += v[i] * v[i];
  return wave_sum(s); }
template <bool COPY, bool OUT8 = false>
__device__ __forceinline__ void modulate_store(const float (&v)[32], float rstd, const float* __restrict__ g, const float* __restrict__ shift, const float* __restrict__ scale,
                                               bf16_t* __restrict__ dst, int lane, LAS float* f32copy) {
#pragma unroll
  for (int j = 0; j < 4; ++j) {
    const int idx = 8 * lane + 512 * j;
    float gv[8], sh[8], sc[8], y[8]; ld8f(g + idx, gv); ld8f(shift + idx, sh); ld8f(scale + idx, sc);
#pragma unroll
    for (int i = 0; i < 8; ++i) y[i] = v[8 * j + i] * rstd * gv[i] * (1.f + sc[i]) + sh[i];
    if (OUT8) { u32x2 p8 = {pack_fp8x4(y[0], y[1], y[2], y[3]), pack_fp8x4(y[4], y[5], y[6], y[7])}; *(u32x2*)((unsigned char*)dst + idx) = p8; }
    else { u32x4 pk = {cvtpk(y[0], y[1]), cvtpk(y[2], y[3]), cvtpk(y[4], y[5]), cvtpk(y[6], y[7])}; *(u32x4*)(dst + idx) = pk; }
    if (COPY) { f32x4 t0 = {y[0], y[1], y[2], y[3]}, t1 = {y[4], y[5], y[6], y[7]};
      *(LAS f32x4*)(f32copy + idx) = t0; *(LAS f32x4*)(f32copy + idx + 4) = t1; }
  }
}

__device__ __forceinline__ void phase_prologue(const Args& a, LAS char* lds) {
  int tid = threadIdx.x; asm volatile("" : "+v"(tid)); tid &= 511; const int wave = tid >> 6, lane = tid & 63;
  {
    LAS float* sc = (LAS float*)lds;
    LAS float* part = sc + 4096;
    const float* c = a.in[1]; const float* cc = a.in[3];
    for (int i = tid; i < D; i += NTHREADS) { float v = c[i]; sc[i] = v * sigmoidf_(v); float u = cc[i]; sc[D + i] = u * sigmoidf_(u); }
    __syncthreads();
    float* MOD = (float*)(a.ws + WS_MOD);
    for (int u = blockIdx.x; u < 2 * 192; u += gridDim.x) {
      const int L = u / 192, chunk = u % 192;
      const float* W = a.in[4] + (size_t)L * D * 12288 + chunk * 64 + lane;
      float a0 = 0, a1 = 0; const int d0 = wave * 256;
#pragma unroll 8
      for (int dd = 0; dd < 256; ++dd) { const float w = W[(size_t)(d0 + dd) * 12288]; a0 += sc[d0 + dd] * w; a1 += sc[D + d0 + dd] * w; }
      part[(wave * 2 + 0) * 64 + lane] = a0; part[(wave * 2 + 1) * 64 + lane] = a1;
      __syncthreads();
      if (tid < 128) { const int which = tid >> 6; float s = 0;
#pragma unroll
        for (int w = 0; w < 8; ++w) s += part[(w * 2 + which) * 64 + lane];
        const int j = chunk * 64 + lane; MOD[(size_t)(L * 2 + which) * 12288 + j] = s + a.in[5][L * 12288 + j]; }
      __syncthreads();
    }
  }
  LAS unsigned* t32 = (LAS unsigned*)lds;
#if DENSE8_G1
  cvt_matrix_units8(a.in[7], D, N_IN0, (unsigned char*)(a.ws + WS_WIN0), 1, 256.f, t32);
  cvt_matrix_units8(a.in[15], D, N_IN1, (unsigned char*)(a.ws + WS_WIN1), 0, 256.f, t32);
#else
  cvt_matrix_units(a.in[7], D, N_IN0, (bf16_t*)(a.ws + WS_WIN0), 1, blockIdx.x, gridDim.x, t32);
  cvt_matrix_units(a.in[15], D, N_IN1, (bf16_t*)(a.ws + WS_WIN1), 0, blockIdx.x, gridDim.x, t32);
#endif
#if DENSE8_G2
  cvt_matrix_units8(a.in[8], D, D, (unsigned char*)(a.ws + WS_WOUT0), 0, 256.f, t32);
  cvt_matrix_units8(a.in[16], D, D, (unsigned char*)(a.ws + WS_WOUT1), 0, 256.f, t32);
#else
  cvt_matrix_units(a.in[8], D, D, (bf16_t*)(a.ws + WS_WOUT0), 0, blockIdx.x, gridDim.x, t32);
  cvt_matrix_units(a.in[16], D, D, (bf16_t*)(a.ws + WS_WOUT1), 0, blockIdx.x, gridDim.x, t32);
#endif
  cvt_moe_all8(a, t32);
}

__device__ __forceinline__ void phase_modulate0(const Args& a) {
  int tid = threadIdx.x; asm volatile("" : "+v"(tid)); tid &= 511; const int wave = tid >> 6, lane = tid & 63;
  const float* MOD = (const float*)(a.ws + WS_MOD);
  bf16_t* A = (bf16_t*)(a.ws + WS_ABUF);
  for (int it = blockIdx.x; it < MT / 8; it += gridDim.x) {
    const int r = it * 8 + wave;
    const float* src = r < CTXL ? a.in[2] + (size_t)r * D : a.in[0] + (size_t)(r - CTXL) * D;
    const float* mod = MOD + (r < CTXL ? 12288 : 0);
    float v[32]; ld_row_f32(src, lane, v);
    const float rstd = rsqrtf(sumsq32(v) * (1.f / D) + EPS);
#if DENSE8_G1
    modulate_store<false, true>(v, rstd, a.in[6], mod, mod + D, (bf16_t*)((unsigned char*)A + (size_t)r * D), lane, nullptr);
#else
    modulate_store<false>(v, rstd, a.in[6], mod, mod + D, A + (size_t)r * D, lane, nullptr);
#endif
  }
}

__device__ __forceinline__ void rope_cs4(int r, int lane, float (&cs)[4], float (&sn)[4]) {
#pragma unroll
  for (int q = 0; q < 4; ++q) { cs[q] = 1.f; sn[q] = 0.f; }
  if (r >= CTXL) { const int t = r - CTXL; const int l = lane & 15, a = l >> 3, i0 = 4 * (l & 7);
    const float pos = a ? (float)(t & 63) : (float)(t >> 6);
#pragma unroll
    for (int q = 0; q < 4; ++q) { const float inv = powf(10000.f, -(float)(i0 + q) / 32.f); sincosf(pos * inv, &sn[q], &cs[q]); } }
}
__device__ __forceinline__ float sum16lanes(float v) { v += __shfl_xor(v, 1); v += __shfl_xor(v, 2); v += __shfl_xor(v, 4); v += __shfl_xor(v, 8); return v; }
__device__ __forceinline__ void phase_rope_conv0(const Args& a, LAS char* lds, bool dry = false) {
  int tid = threadIdx.x; asm volatile("" : "+v"(tid)); tid &= 511; const int wave = tid >> 6, lane = tid & 63;
  bf16_t* Q = (bf16_t*)(a.ws + WS_QKVU);
  {
    const bf16_t* HG = (const bf16_t*)(a.ws + WS_HG);
    bf16_t* X2 = (bf16_t*)(a.ws + WS_X2);
    LAS char* lt = lds;
    LAS float* part = (LAS float*)(lds + 62 * 2048);
    LAS float* stats = part + 512;
    const float* dw_w = a.in[11]; const float* dw_b = a.in[12]; const float* ln_g = a.in[13]; const float* ln_b = a.in[14];
    const __amdgpu_buffer_rsrc_t wrs = __builtin_amdgcn_make_buffer_rsrc((void*)dw_w, 0, 31 * 1024 * 4, 0x00020000);
    for (int u = blockIdx.x; u < 520; u += gridDim.x) {
      int seg0, seg1, r0;
      if (u < 8) { seg0 = 0; seg1 = CTXL; r0 = u * 32; } else { seg0 = CTXL; seg1 = MT; r0 = CTXL + (u - 8) * 32; }
      for (int c = tid; c < 62 * 128; c += NTHREADS) { const int rr = c >> 7, cc = c & 127, gr = r0 - 15 + rr;
        u32x4 v = {0u, 0u, 0u, 0u}; if (gr >= seg0 && gr < seg1) v = *(const u32x4*)(HG + (size_t)gr * 1024 + cc * 8);
        *(LAS u32x4*)(lt + rr * 2048 + cc * 16) = v; }
      __syncthreads();
      float w0[31], w1[31];
#pragma unroll
      for (int j = 0; j < 31; ++j) { const u32x2 w = __builtin_amdgcn_raw_buffer_load_b64(wrs, tid * 8, j * 4096, 0); w0[j] = __uint_as_float(w[0]); w1[j] = __uint_as_float(w[1]); }
      const f32x2 bb = *(const f32x2*)(dw_b + 2 * tid);
      const f32x2 gg = *(const f32x2*)(ln_g + 2 * tid), gb = *(const f32x2*)(ln_b + 2 * tid);
#pragma unroll 1
      for (int hf = 0; hf < 4; ++hf) {
        float o0[8], o1[8];
        LAS const char* lth = lt + (hf * 8) * 2048 + tid * 4;
#pragma unroll
        for (int r = 0; r < 8; ++r) { o0[r] = bb[0]; o1[r] = bb[1]; }
#pragma unroll
        for (int i = 0; i < 38; ++i) {
          const unsigned p = *(LAS const unsigned*)(lth + i * 2048);
          const float x0 = bflo(p), x1 = bfhi(p);
#pragma unroll
          for (int r = 0; r < 8; ++r) { const int j = i - r; if (j >= 0 && j < 31) { o0[r] += x0 * w0[j]; o1[r] += x1 * w1[j]; } }
        }
#pragma unroll
        for (int r = 0; r < 8; ++r) {
          const float s = wave_sum(o0[r] + o1[r]), q = wave_sum(o0[r] * o0[r] + o1[r] * o1[r]);
          if (lane == 0) { part[(r * 8 + wave) * 2] = s; part[(r * 8 + wave) * 2 + 1] = q; }
        }
        __syncthreads();
        if (tid < 8) { float s = 0, q = 0;
#pragma unroll
          for (int w = 0; w < 8; ++w) { s += part[(tid * 8 + w) * 2]; q += part[(tid * 8 + w) * 2 + 1]; }
          const float mean = s * (1.f / 1024), var = q * (1.f / 1024) - mean * mean;
          stats[tid * 2] = mean; stats[tid * 2 + 1] = rsqrtf(fmaxf(var, 0.f) + EPS); }
        __syncthreads();
#pragma unroll
        for (int r = 0; r < 8; ++r) {
          const float mean = stats[r * 2], rstd = stats[r * 2 + 1];
          float y0 = (o0[r] - mean) * rstd * gg[0] + gb[0], y1 = (o1[r] - mean) * rstd * gg[1] + gb[1];
          y0 = y0 * sigmoid_fast(y0); y1 = y1 * sigmoid_fast(y1);
#if DENSE8_G2
          *(unsigned short*)((unsigned char*)X2 + (size_t)(r0 + hf * 8 + r) * D + 1024 + 2 * tid) = (unsigned short)__builtin_amdgcn_cvt_pk_fp8_f32(y0 * 8.f, y1 * 8.f, 0, false);
#else
          *(unsigned*)(X2 + (size_t)(r0 + hf * 8 + r) * D + 1024 + 2 * tid) = cvtpk(y0, y1);
#endif
        }
      }
      __syncthreads();
    }
  }
  const float* qn = a.in[9]; const float* kn = a.in[10];
  unsigned* kmx = (unsigned*)(a.ws + WS_CTL + CTL_KMAX);
  const int slot = lane >> 4, l16 = lane & 15, e1 = (l16 >> 3) * 64 + 4 * (l16 & 7), e2 = e1 + 32;
  float km0 = 0.f, km1 = 0.f;
  for (int it = blockIdx.x; it < MT / 8; it += gridDim.x) {
    const int r = it * 8 + wave;
    float cs[4], sn[4]; rope_cs4(r, lane, cs, sn);
    bf16_t* rowp = Q + (size_t)r * N_QKV0;
#pragma unroll
    for (int hb = 0; hb < 12; hb += 4) {
      const int hh = hb + slot;
      if (hh < 10) {
        const float* g = hh < 8 ? qn : kn;
        const u32x2 a1 = *(const u32x2*)(rowp + hh * 128 + e1), a2 = *(const u32x2*)(rowp + hh * 128 + e2);
        float x1[4] = {bflo(a1[0]), bfhi(a1[0]), bflo(a1[1]), bfhi(a1[1])}, x2[4] = {bflo(a2[0]), bfhi(a2[0]), bflo(a2[1]), bfhi(a2[1])};
        float ss = 0;
#pragma unroll
        for (int q = 0; q < 4; ++q) ss += x1[q] * x1[q] + x2[q] * x2[q];
        ss = sum16lanes(ss);
        const float rstd = rsqrtf(ss * (1.f / 128) + EPS);
        const f32x4 g1 = *(const f32x4*)(g + e1), g2 = *(const f32x4*)(g + e2);
        float o1[4], o2[4], so = 0;
#pragma unroll
        for (int q = 0; q < 4; ++q) { const float y1 = x1[q] * rstd * g1[q], y2 = x2[q] * rstd * g2[q]; o1[q] = y1 * cs[q] - y2 * sn[q]; o2[q] = y2 * cs[q] + y1 * sn[q]; }
        const u32x2 w1 = {cvtpk(o1[0], o1[1]), cvtpk(o1[2], o1[3])}, w2 = {cvtpk(o2[0], o2[1]), cvtpk(o2[2], o2[3])};
        if (!dry) { *(u32x2*)(rowp + hh * 128 + e1) = w1; *(u32x2*)(rowp + hh * 128 + e2) = w2; }
        if (hb == 8) {
          const unsigned q1 = pack8x4(o1[0], o1[1], o1[2], o1[3]), q2 = pack8x4(o2[0], o2[1], o2[2], o2[3]);
          unsigned char* k8p = (unsigned char*)(a.ws + WS_K8) + (size_t)r * 256 + (hh - 8) * 128;
          *(unsigned*)(k8p + e1) = q1; *(unsigned*)(k8p + e2) = q2;
          so = sum16lanes(sq8x4(q1) + sq8x4(q2)); if (slot == 0) km0 = fmaxf(km0, so); else km1 = fmaxf(km1, so);
        }
      }
    }
  }
  if (l16 == 0 && slot < 2) atomicMax(&kmx[slot], __float_as_uint(slot == 0 ? km0 : km1));
  __syncthreads();
  { unsigned char* V8T = (unsigned char*)(a.ws + WS_K8) + V8T0_OFF;
    LAS unsigned char* img = (LAS unsigned char*)lds;
    const int k = tid >> 3, cc = tid & 7, kb = k >> 5, kk = k & 31;
    const int j = (kk & 3) | (((kk >> 3) & 3) << 2) | (((kk >> 2) & 1) << 4);
    for (int u = blockIdx.x; u < 2 * (MT / 64); u += gridDim.x) {
      const int h = u / (MT / 64), t = u % (MT / 64);
      const bf16_t* vp = Q + (size_t)(t * 64 + k) * N_QKV0 + 1280 + h * 128 + cc * 16;
#pragma unroll
      for (int q = 0; q < 2; ++q) { const u32x4 raw = *(const u32x4*)(vp + 8 * q);
#pragma unroll
        for (int i = 0; i < 4; ++i) { const int p = __builtin_amdgcn_cvt_pk_fp8_f32(bflo(raw[i]), bfhi(raw[i]), 0, false);
#pragma unroll
          for (int hh = 0; hh < 2; ++hh) { const int col = cc * 16 + q * 8 + 2 * i + hh;
            img[col * 64 + (((2 * kb + (j >> 4)) ^ ((col >> 2) & 3)) << 4) + (j & 15)] = (unsigned char)(p >> (8 * hh)); } } }
      __syncthreads();
      *(u32x4*)(V8T + ((size_t)h * (MT / 64) + t) * 8192 + tid * 16) = *(LAS const u32x4*)(img + tid * 16);
      __syncthreads();
    }
  }
}
__device__ __forceinline__ void phase_rope1(const Args& a, LAS char* lds, bool dry = false) {
  int tid = threadIdx.x; asm volatile("" : "+v"(tid)); tid &= 511; const int wave = tid >> 6, lane = tid & 63;
  bf16_t* Q = (bf16_t*)(a.ws + WS_QKVU);
  unsigned* kmx = (unsigned*)(a.ws + WS_CTL + CTL_KMAX) + 16;
  unsigned char* K8 = (unsigned char*)(a.ws + WS_K8);
  LAS unsigned* lk = (LAS unsigned*)lds;
  if (tid < 16) lk[tid] = 0u;
  __syncthreads();
  const int slot = lane >> 4, l16 = lane & 15, e1 = (l16 >> 3) * 64 + 4 * (l16 & 7), e2 = e1 + 32;
  for (int it = blockIdx.x; it < MT / 8; it += gridDim.x) {
    const int r = it * 8 + wave;
    float cs[4], sn[4]; rope_cs4(r, lane, cs, sn);
    bf16_t* rowp = Q + (size_t)r * N_IN1;
#pragma unroll 2
    for (int hb = (r < CTXL ? 16 : 0); hb < 32; hb += 4) {
      const int hh = hb + slot;
      const u32x2 a1 = *(const u32x2*)(rowp + hh * 128 + e1), a2 = *(const u32x2*)(rowp + hh * 128 + e2);
      const float x1[4] = {bflo(a1[0]), bfhi(a1[0]), bflo(a1[1]), bfhi(a1[1])}, x2[4] = {bflo(a2[0]), bfhi(a2[0]), bflo(a2[1]), bfhi(a2[1])};
      float o1[4], o2[4];
#pragma unroll
      for (int q = 0; q < 4; ++q) { o1[q] = x1[q] * cs[q] - x2[q] * sn[q]; o2[q] = x2[q] * cs[q] + x1[q] * sn[q]; }
      const u32x2 w1 = {cvtpk(o1[0], o1[1]), cvtpk(o1[2], o1[3])}, w2 = {cvtpk(o2[0], o2[1]), cvtpk(o2[2], o2[3])};
      if (r >= CTXL && !dry) { *(u32x2*)(rowp + hh * 128 + e1) = w1; *(u32x2*)(rowp + hh * 128 + e2) = w2; }
      if (hb >= 16) {
        const unsigned q1 = pack8x4(o1[0], o1[1], o1[2], o1[3]), q2 = pack8x4(o2[0], o2[1], o2[2], o2[3]);
        unsigned char* k8p = K8 + (size_t)r * 2048 + (hh - 16) * 128;
        *(unsigned*)(k8p + e1) = q1; *(unsigned*)(k8p + e2) = q2;
        float so = sum16lanes(sq8x4(q1) + sq8x4(q2));
        if (l16 == 0) atomicMax((unsigned*)&lk[hh - 16], __float_as_uint(so));
      }
    }
  }
  __syncthreads();
  if (tid < 16) atomicMax(&kmx[tid], lk[tid]);
  __syncthreads();
  { unsigned char* V8T = (unsigned char*)(a.ws + WS_HG);
    LAS unsigned char* img = (LAS unsigned char*)lds;
    const int k = tid >> 3, cc = tid & 7, kb = k >> 5, kk = k & 31;
    const int j = (kk & 3) | (((kk >> 3) & 3) << 2) | (((kk >> 2) & 1) << 4);
    for (int u = blockIdx.x; u < 8 * (MT / 64); u += gridDim.x) {
      const int h = u / (MT / 64), t = u % (MT / 64);
      const bf16_t* vp = Q + (size_t)(t * 64 + k) * N_IN1 + 4096 + h * 256 + cc * 32;
#pragma unroll
      for (int q = 0; q < 4; ++q) { const u32x4 raw = *(const u32x4*)(vp + 8 * q);
#pragma unroll
        for (int i = 0; i < 4; ++i) { const int p = __builtin_amdgcn_cvt_pk_fp8_f32(bflo(raw[i]), bfhi(raw[i]), 0, false);
#pragma unroll
          for (int hh = 0; hh < 2; ++hh) { const int col = cc * 32 + q * 8 + 2 * i + hh;
            img[col * 64 + (((2 * kb + (j >> 4)) ^ ((col >> 2) & 3)) << 4) + (j & 15)] = (unsigned char)(p >> (8 * hh)); } } }
      __syncthreads();
      unsigned char* dst = V8T + ((size_t)h * (MT / 64) + t) * 16384;
      *(u32x4*)(dst + tid * 16) = *(LAS const u32x4*)(img + tid * 16);
      *(u32x4*)(dst + 8192 + tid * 16) = *(LAS const u32x4*)(img + 8192 + tid * 16);
      __syncthreads();
    }
  }
}

__device__ __forceinline__ void phase_attn(const Args& a, int L, LAS char* lds) {
  const bf16_t* Q = (const bf16_t*)(a.ws + WS_QKVU);
  const unsigned* kmx = (const unsigned*)(a.ws + WS_CTL + CTL_KMAX) + L * 16;
  if (L == 0) {
    bf16_t* X2 = (bf16_t*)(a.ws + WS_X2);
    for (int u = blockIdx.x; u < 520; u += gridDim.x) {
      const int head = u < 512 ? (u & 7) : (u - 512);
      if (u < 512) { const int qb = u >> 3; const size_t q0 = (size_t)(CTXL + qb * 256);
        at::attn_body_d<4>(Q + q0 * N_QKV0 + head * 128, N_QKV0, (const unsigned char*)(a.ws + WS_K8) + (head >> 2) * 128, 256,
                           (const unsigned char*)(a.ws + WS_K8) + V8T0_OFF + (size_t)(head >> 2) * (MT / 64) * 8192, X2 + q0 * D + head * 128, D, MT, lds);
      } else {
        at::attn_body_d<4>(Q + head * 128, N_QKV0, (const unsigned char*)(a.ws + WS_K8) + (head >> 2) * 128, 256,
                           (const unsigned char*)(a.ws + WS_K8) + V8T0_OFF + (size_t)(head >> 2) * (MT / 64) * 8192, X2 + head * 128, D, CTXL, lds); }
    }
  } else {
    bf16_t* O = (bf16_t*)(a.ws + WS_Y);
    for (int u = blockIdx.x; u < 1024; u += gridDim.x) {
      const int x = u & 7, w = u >> 3, hc = x + 8 * (w >> 6), qb = w & 63, h = hc >> 1;
      const float kmax2 = __uint_as_float(kmx[hc]);
      const size_t q0 = (size_t)(CTXL + qb * 256);
      (void)kmax2;
      at::attn_body_d<8>(Q + q0 * N_IN1 + hc * 128, N_IN1, (const unsigned char*)(a.ws + WS_K8) + hc * 128, 2048,
                         (const unsigned char*)(a.ws + WS_HG) + (size_t)h * (MT / 64) * 16384, O + (size_t)(qb * 256) * 4096 + hc * 256, 4096, MT, lds);
    }
  }
}

__device__ __forceinline__ void phase_diff(const Args& a) {
  int tid = threadIdx.x; asm volatile("" : "+v"(tid)); tid &= 511; const int wave = tid >> 6, lane = tid & 63;
  const bf16_t* O = (const bf16_t*)(a.ws + WS_Y);
  bf16_t* X2 = (bf16_t*)(a.ws + WS_X2);
  const float* lp = a.in[17];
  const float s1 = wave_sum(lp[lane] * lp[128 + lane] + lp[64 + lane] * lp[192 + lane]);
  const float s2 = wave_sum(lp[256 + lane] * lp[384 + lane] + lp[320 + lane] * lp[448 + lane]);
  const float lam = expf(s1) - expf(s2) + LAM_INIT;
  const f32x4 sg = *(const f32x4*)(a.in[18] + 4 * lane);
  for (int it = blockIdx.x; it < SEQ / 8; it += gridDim.x) {
    const int t = it * 8 + wave;
    const bf16_t* op = O + (size_t)t * 4096;
    unsigned char* xp = (unsigned char*)X2 + (size_t)(CTXL + t) * D * (DENSE8_G2 ? 1 : 2);
#pragma unroll 2
    for (int h = 0; h < 8; ++h) {
      const u32x2 a0 = *(const u32x2*)(op + (2 * h) * 256 + 4 * lane), a1 = *(const u32x2*)(op + (2 * h + 1) * 256 + 4 * lane);
      float d[4] = {bflo(a0[0]) - lam * bflo(a1[0]), bfhi(a0[0]) - lam * bfhi(a1[0]), bflo(a0[1]) - lam * bflo(a1[1]), bfhi(a0[1]) - lam * bfhi(a1[1])};
      const float ss = wave_sum(d[0] * d[0] + d[1] * d[1] + d[2] * d[2] + d[3] * d[3]);
      const float rstd = rsqrtf(ss * (1.f / 256) + EPS) * (1.f - LAM_INIT);
#if DENSE8_G2
      const float r8 = rstd * 8.f;
      *(unsigned*)(xp + h * 256 + 4 * lane) = pack8x4(d[0] * r8 * sg[0], d[1] * r8 * sg[1], d[2] * r8 * sg[2], d[3] * r8 * sg[3]);
#else
      u32x2 pk = {cvtpk(d[0] * rstd * sg[0], d[1] * rstd * sg[1]), cvtpk(d[2] * rstd * sg[2], d[3] * rstd * sg[3])};
      *(u32x2*)((bf16_t*)xp + h * 256 + 4 * lane) = pk;
#endif
    }
  }
}

__device__ __forceinline__ void phase_G(const Args& a, int L, LAS char* lds, bool dry = false) {
  int tid = threadIdx.x; asm volatile("" : "+v"(tid)); tid &= 511; const int wave = tid >> 6, lane = tid & 63;
  const int NTOK = L == 0 ? MT : SEQ, ROW0 = L == 0 ? 0 : CTXL;
  const float* ng = a.in[6] + (size_t)L * 4 * D;
  const float* MODL = (const float*)(a.ws + WS_MOD) + (size_t)(L * 2) * 12288;
  const float* router = a.in[19] + (size_t)L * D * NE; const float* rbias = a.in[20] + L * NE;
  const bf16_t* OUT = (const bf16_t*)(a.ws + WS_OUT);
  float* HRES = (float*)(a.ws + WS_HRES);
  bf16_t* F = (bf16_t*)(a.ws + WS_ABUF);
  int* counts = (int*)(a.ws + WS_CTL + CTL_CNT) + L * 64;
  int* top_e = (int*)(a.ws + WS_TOPE); float* top_w = (float*)(a.ws + WS_TOPW); int* top_p = (int*)(a.ws + WS_TOPP);
  LAS float* ft = (LAS float*)lds;
  LAS float* part = ft + 8 * D;
  for (int it = blockIdx.x; it < NTOK / 8; it += gridDim.x) {
    const int r = ROW0 + it * 8 + wave;
    const float* mod = MODL + (r < CTXL ? 12288 : 0);
    {
      float o[32], h[32];
      ld_row_bf16(OUT + (size_t)r * D, lane, o);
      const float* hp = L == 0 ? (r < CTXL ? a.in[2] + (size_t)r * D : a.in[0] + (size_t)(r - CTXL) * D) : HRES + (size_t)r * D;
      ld_row_f32(hp, lane, h);
      const float rstd1 = rsqrtf(sumsq32(o) * (1.f / D) + EPS);
#pragma unroll
      for (int j = 0; j < 4; ++j) { const int idx = 8 * lane + 512 * j;
        float g1[8], gt[8]; ld8f(ng + D + idx, g1); ld8f(mod + 2 * D + idx, gt);
#pragma unroll
        for (int i = 0; i < 8; ++i) h[8 * j + i] += gt[i] * (o[8 * j + i] * rstd1 * g1[i]);
        if (!dry) st8f(HRES + (size_t)r * D + idx, &h[8 * j]); }
      const float rstd2 = rsqrtf(sumsq32(h) * (1.f / D) + EPS);
      modulate_store<true, true>(h, rstd2, ng + 2 * D, mod + 3 * D, mod + 4 * D, (bf16_t*)((unsigned char*)F + (size_t)r * D), lane, ft + wave * D);
    }
    __syncthreads();
    float acc[8] = {0, 0, 0, 0, 0, 0, 0, 0};
    const int d0 = wave * 256;
#pragma unroll 2
    for (int dd = 0; dd < 256; dd += 4) {
      const float* rp = router + (size_t)(d0 + dd) * NE + lane;
      const float r0 = rp[0], r1 = rp[NE], r2 = rp[2 * NE], r3 = rp[3 * NE];
#pragma unroll
      for (int t = 0; t < 8; ++t) { const f32x4 fv = *(LAS const f32x4*)(ft + t * D + d0 + dd); acc[t] += fv[0] * r0 + fv[1] * r1 + fv[2] * r2 + fv[3] * r3; }
    }
#pragma unroll
    for (int t = 0; t < 8; ++t) part[(wave * 8 + t) * 64 + lane] = acc[t];
    __syncthreads();
    float logit = 0;
#pragma unroll
    for (int w = 0; w < 8; ++w) logit += part[(w * 8 + wave) * 64 + lane];
#if MK_DIAG
    ((float*)(a.ws + WS_Y))[(size_t)r * 64 + lane] = logit;
#endif
    const float score = sigmoidf_(logit);
    const float choice = score + rbias[lane];
    int rank = 0; const int gl = lane & 7;
#pragma unroll
    for (int j = 0; j < 8; ++j) { const float o = __shfl(choice, (lane & ~7) | j); rank += (o > choice || (o == choice && j < gl)) ? 1 : 0; }
    float gs = rank < 2 ? choice : 0.f;
    gs += __shfl_xor(gs, 1); gs += __shfl_xor(gs, 2); gs += __shfl_xor(gs, 4);
    int grank = 0; const int g = lane >> 3;
#pragma unroll
    for (int j = 0; j < 8; ++j) { const float o = __shfl(gs, j * 8); grank += (o > gs || (o == gs && j < g)) ? 1 : 0; }
    const bool gsel = grank < 4;
    const float mc = gsel ? choice : -INFINITY;
    int erank = 0;
#pragma unroll 4
    for (int j = 0; j < 64; ++j) { const float o = __int_as_float(__builtin_amdgcn_readlane(__float_as_int(mc), j)); erank += (o > mc || (o == mc && j < lane)) ? 1 : 0; }
    const bool sel = gsel && erank < 8;
    const unsigned long long bal = __ballot(sel);
    const int idx = __popcll(bal & ((1ull << lane) - 1ull));
    const float ssum = wave_sum(sel ? score : 0.f);
    if (sel && !dry) { const int pos = atomicAdd(&counts[lane], 1);
      top_e[r * 8 + idx] = lane; top_w[r * 8 + idx] = score / ssum * 2.5f; top_p[r * 8 + idx] = pos; }
  }
}

__device__ __forceinline__ void moe_tile_prefix(const int* counts, LAS int* ts) {
  if (threadIdx.x == 0) { int s = 0; for (int e = 0; e < 64; ++e) { ts[e] = s; s += (counts[e] + 255) >> 8; } ts[64] = s; }
  __syncthreads();
}
__device__ __forceinline__ void phase_H(const Args& a, int L, LAS char* lds) {
  const int NTOK = L == 0 ? MT : SEQ, ROW0 = L == 0 ? 0 : CTXL;
  const int* counts = (const int*)(a.ws + WS_CTL + CTL_CNT) + L * 64;
  const int* top_e = (const int*)(a.ws + WS_TOPE); const int* top_p = (const int*)(a.ws + WS_TOPP);
  int* tslot = (int*)(a.ws + WS_TSLOT); int* stok = (int*)(a.ws + WS_STOK);
  LAS int* ts = (LAS int*)lds;
  moe_tile_prefix(counts, ts);
  int tid = threadIdx.x; asm volatile("" : "+v"(tid)); tid &= 511;
  const int gt = blockIdx.x * NTHREADS + tid, gs = gridDim.x * NTHREADS;
  for (int i = gt; i < NTOK * 8; i += gs) { const int q = ROW0 * 8 + i; const int e = top_e[q]; const int slot = ts[e] * 256 + top_p[q]; stok[slot] = q >> 3; tslot[q] = slot; }
  for (int i = gt; i < 64 * 256; i += gs) { const int e = i >> 8, p = i & 255, cnt = counts[e], nt = (cnt + 255) >> 8; if (cnt + p < nt * 256) stok[ts[e] * 256 + cnt + p] = ROW0; }
  for (int i = gt; i < NTOK; i += gs) stok[SH_BASE + i] = ROW0 + i;
  __syncthreads();
}
struct DenseSched {
  int nM, nN, r0; const unsigned char* W;
  __device__ __forceinline__ bool unit(int i, int& brow, const unsigned char*& Bt, int& bcol) const {
    const int u = blockIdx.x + i * (int)gridDim.x; if (u >= nM * nN) return false;
    int pm, pn; dense_unit(u, nM, nN, pm, pn); brow = r0 + pm * 256; bcol = pn * 256; Bt = W; return true; }
};
struct MoeSched {
  LAS const int* ts; int TR, NN, total; const unsigned char* W; size_t woff;
  __device__ __forceinline__ bool unit(int i, int& slot0, const unsigned char*& Bt, int& bcol) const {
    for (int u = blockIdx.x + i * (int)gridDim.x; ; u += gridDim.x) {
      const int rnd = u >> 8, b = u & 255, v = rnd * 256 + (b & 7) * 32 + (b >> 3);
      if (rnd * 256 >= total) return false;
      if (v >= total) return false;
      const int m = v / NN, pn = v % NN;
      int e;
      if (m >= TR) { e = 64; slot0 = SH_BASE + 256 * (m - TR); } else { e = 0; while (ts[e + 1] <= m) ++e; slot0 = 256 * m; }
      Bt = W + (size_t)e * WMOE8_E + woff; bcol = pn * 256;
      return true;
    }
  }
};
__device__ __forceinline__ void phase_moe_up(const Args& a, int L, LAS char* lds) {
  const int NSH = L == 0 ? MT / 256 : SEQ / 256;
  const int* counts = (const int*)(a.ws + WS_CTL + CTL_CNT) + L * 64;
  LAS int* ts = (LAS int*)(lds + LDS_CTL + 64);
  moe_tile_prefix(counts, ts);
  const int TR = ts[64], TM = TR + NSH;
  const unsigned char* F = (const unsigned char*)(a.ws + WS_ABUF); const unsigned char* W = (const unsigned char*)(a.ws + WS_WMOE) + (size_t)L * 65 * WMOE8_E;
  const int* stok = (const int*)(a.ws + WS_STOK);
  EpiSwiGLU8 epi{(unsigned char*)(a.ws + WS_ACT), EFF};
  MoeSched sc{ts, TR, 4, TM * 4, W, 0};
  gemm8_run<true, D, D, D>(F, stok, lds, epi, sc);
}
__device__ __forceinline__ void phase_moe_down(const Args& a, int L, LAS char* lds) {
  const int NSH = L == 0 ? MT / 256 : SEQ / 256;
  const int* counts = (const int*)(a.ws + WS_CTL + CTL_CNT) + L * 64;
  LAS int* ts = (LAS int*)(lds + LDS_CTL + 64);
  moe_tile_prefix(counts, ts);
  const int TR = ts[64], TM = TR + NSH;
  const unsigned char* ACT = (const unsigned char*)(a.ws + WS_ACT); const unsigned char* W = (const unsigned char*)(a.ws + WS_WMOE) + (size_t)L * 65 * WMOE8_E;
  EpiPlain8 epi{(unsigned char*)(a.ws + WS_Y), D, 16.f / 128.f};
  MoeSched sc{ts, TR, 8, TM * 8, W, (size_t)1024 * D};
  gemm8_run<false, EFF, EFF, EFF>(ACT, nullptr, lds, epi, sc);
}
__device__ __forceinline__ void phase_combine(const Args& a, int L, bool dry = false) {
  int tid = threadIdx.x; asm volatile("" : "+v"(tid)); tid &= 511; const int wave = tid >> 6, lane = tid & 63;
  const int NTOK = L == 0 ? MT : SEQ, ROW0 = L == 0 ? 0 : CTXL;
  const float* ng = a.in[6] + (size_t)L * 4 * D;
  const float* MODL = (const float*)(a.ws + WS_MOD) + (size_t)(L * 2) * 12288;
  const unsigned char* Y = (const unsigned char*)(a.ws + WS_Y);
  float* HRES = (float*)(a.ws + WS_HRES);
  const int* tslot = (const int*)(a.ws + WS_TSLOT); const float* top_w = (const float*)(a.ws + WS_TOPW);
  for (int it = blockIdx.x; it < NTOK / 8; it += gridDim.x) {
    const int r = ROW0 + it * 8 + wave;
    const float* mod = MODL + (r < CTXL ? 12288 : 0);
    float y[32];
    { float t[32]; ld_row_fp8(Y + (size_t)(SH_BASE + r - ROW0) * D, lane, t);
#pragma unroll
      for (int i = 0; i < 32; ++i) y[i] = t[i] * (1.f / 16.f); }
#pragma unroll 4
    for (int k = 0; k < 8; ++k) { const int slot = tslot[r * 8 + k]; const float w = top_w[r * 8 + k] * (1.f / 16.f);
      float t[32]; ld_row_fp8(Y + (size_t)slot * D, lane, t);
#pragma unroll
      for (int i = 0; i < 32; ++i) y[i] += w * t[i]; }
    const float rstd = rsqrtf(sumsq32(y) * (1.f / D) + EPS);
    float h[32]; ld_row_f32(HRES + (size_t)r * D, lane, h);
#pragma unroll
    for (int j = 0; j < 4; ++j) { const int idx = 8 * lane + 512 * j;
      float g3[8], gt[8]; ld8f(ng + 3 * D + idx, g3); ld8f(mod + 5 * D + idx, gt);
#pragma unroll
      for (int i = 0; i < 8; ++i) h[8 * j + i] += gt[i] * (y[8 * j + i] * rstd * g3[i]);
      if (L == 0) { if (!dry) st8f(HRES + (size_t)r * D + idx, &h[8 * j]); } else st8f(a.out + (size_t)(r - CTXL) * D + idx, &h[8 * j]); }
    if (L == 0) {
      const float* mod1 = MODL + 2 * 12288 + (r < CTXL ? 12288 : 0);
      const float rstd2 = rsqrtf(sumsq32(h) * (1.f / D) + EPS);
#if DENSE8_G1
      modulate_store<false, true>(h, rstd2, a.in[6] + (size_t)4 * D, mod1, mod1 + D, (bf16_t*)((unsigned char*)(a.ws + WS_ABUF) + (size_t)r * D), lane, nullptr);
#else
      modulate_store<false>(h, rstd2, a.in[6] + (size_t)4 * D, mod1, mod1 + D, (bf16_t*)(a.ws + WS_ABUF) + (size_t)r * D, lane, nullptr);
#endif
    }
  }
}

constexpr int NPH = 21;
typedef const __attribute__((address_space(4))) Args* ArgsP;
#if defined(__HIP_DEVICE_COMPILE__)
#define FRESH_ARGS() const Args a = *({ ArgsP _p = (ArgsP)__builtin_amdgcn_kernarg_segment_ptr(); asm volatile("" : "+s"(_p)); _p; })
#else
#define FRESH_ARGS() const Args a = kargs
#endif
__global__ void __launch_bounds__(NTHREADS, 2) fwd(Args kargs) {
  extern __shared__ __attribute__((aligned(16))) unsigned char lds_raw[];
  LAS char* lds = (LAS char*)lds_raw;
  const int lo = kargs.ph_lo, hi = kargs.ph_hi;
  if (threadIdx.x < 64) ((LAS unsigned*)(lds + LDS_CTL))[threadIdx.x] = 0u;
  __syncthreads();
  if (hi - lo > 1) (void)xcd_barrier_post((unsigned*)(kargs.ws + WS_CTL), (volatile LAS unsigned*)(lds + LDS_CTL));
#ifndef PHASE_MASK
#define PHASE_MASK 0xFFFFFFFFu
#endif
#define IN(k) (((PHASE_MASK >> (k)) & 1u) && lo <= (k) && (k) < hi)
#ifndef PH_REPEAT_MASK
#define PH_REPEAT_MASK 0u
#endif
#define REP(k) for (int _rep = 0; _rep < (((PH_REPEAT_MASK >> (k)) & 1u) ? 2 : 1); ++_rep)
#define SEAM(k) do { if ((k) + 1 < hi) { XcdBarrier _b; _b.bar = (unsigned*)(a.ws + WS_CTL); _b.x = xb_xcc_id(); _b.st = (volatile LAS unsigned*)(lds + LDS_CTL); xcd_barrier(_b); } } while (0)

  if (IN(0)) { FRESH_ARGS(); REP(0) phase_prologue(a, lds); SEAM(0); }
  if (IN(1)) { FRESH_ARGS(); REP(1) phase_modulate0(a); SEAM(1); }
#pragma unroll
  for (int L = 0; L < 2; ++L) {
    const int base = 2 + (L == 0 ? 0 : 9);
    if (IN(base + 0)) {
      FRESH_ARGS();
      const int nN = L == 0 ? N_IN0 / 256 : N_IN1 / 256, nM = MT / 256;
#if DENSE8_G1
      const unsigned char* A = (const unsigned char*)(a.ws + WS_ABUF);
      EpiG1 epi{EpiPlain{(bf16_t*)(a.ws + WS_QKVU), L == 0 ? N_QKV0 : N_IN1, 1.f / 256.f}, EpiPair<0>{(bf16_t*)(a.ws + WS_HG), 1024, N_QKV0, 1.f / 256.f}, L == 0 ? N_QKV0 : N_IN1};
      DenseSched sc{nM, nN, 0, (const unsigned char*)(a.ws + (L == 0 ? WS_WIN0 : WS_WIN1))};
      REP(2) gemm8_run<false, D, D, D>(A, nullptr, lds, epi, sc);
#else
      const bf16_t* A = (const bf16_t*)(a.ws + WS_ABUF);
      const bf16_t* Bt = (const bf16_t*)(a.ws + (L == 0 ? WS_WIN0 : WS_WIN1));
      EpiG1 epi{EpiPlain{(bf16_t*)(a.ws + WS_QKVU), L == 0 ? N_QKV0 : N_IN1, 1.f}, EpiPair<0>{(bf16_t*)(a.ws + WS_HG), 1024, N_QKV0, 1.f}, L == 0 ? N_QKV0 : N_IN1};
      REP(2) for (int u = blockIdx.x; u < nM * nN; u += gridDim.x) { int pm, pn; dense_unit(u, nM, nN, pm, pn);
        gemm_tile<false>(A, D, nullptr, pm * 256, Bt, D, pn * 256, D, lds, epi); }
#endif
      SEAM(base + 0);
    }
    if (L == 0) {
      if (IN(3)) { FRESH_ARGS(); if ((PH_REPEAT_MASK >> 3) & 1u) { phase_rope_conv0(a, lds, true); __syncthreads(); } phase_rope_conv0(a, lds); SEAM(3); }
      if (IN(4)) { FRESH_ARGS(); REP(4) phase_attn(a, 0, lds); SEAM(4); }
    } else {
      if (IN(12)) { FRESH_ARGS(); if ((PH_REPEAT_MASK >> 12) & 1u) { phase_rope1(a, lds, true); __syncthreads(); } phase_rope1(a, lds); SEAM(12); }
      if (IN(13)) { FRESH_ARGS(); REP(13) phase_attn(a, 1, lds); SEAM(13); }
      if (IN(14)) { FRESH_ARGS(); REP(14) phase_diff(a); SEAM(14); }
    }
    const int b2 = L == 0 ? 5 : 15;
    if (IN(b2 + 0)) {
      FRESH_ARGS();
      const int nN = D / 256, nM = L == 0 ? MT / 256 : SEQ / 256, r0 = L == 0 ? 0 : CTXL;
#if DENSE8_G2
      const unsigned char* A = (const unsigned char*)(a.ws + WS_X2);
      EpiPlain epi{(bf16_t*)(a.ws + WS_OUT), D, 1.f / 2048.f};
      DenseSched sc{nM, nN, r0, (const unsigned char*)(a.ws + (L == 0 ? WS_WOUT0 : WS_WOUT1))};
      REP(5) gemm8_run<false, D, D, D>(A, nullptr, lds, epi, sc);
#else
      const bf16_t* A = (const bf16_t*)(a.ws + WS_X2);
      const bf16_t* Bt = (const bf16_t*)(a.ws + (L == 0 ? WS_WOUT0 : WS_WOUT1));
      EpiPlain epi{(bf16_t*)(a.ws + WS_OUT), D, 1.f};
      REP(5) for (int u = blockIdx.x; u < nM * nN; u += gridDim.x) { int pm, pn; dense_unit(u, nM, nN, pm, pn);
        gemm_tile<false>(A, D, nullptr, r0 + pm * 256, Bt, D, pn * 256, D, lds, epi); }
#endif
      SEAM(b2 + 0);
    }
    if (IN(b2 + 1)) { FRESH_ARGS(); if ((PH_REPEAT_MASK >> 6) & 1u) { phase_G(a, L, lds, true); __syncthreads(); } phase_G(a, L, lds); SEAM(b2 + 1); }
    if (IN(b2 + 2)) { FRESH_ARGS(); REP(7) phase_H(a, L, lds); SEAM(b2 + 2); }
    if (IN(b2 + 3)) { FRESH_ARGS(); REP(8) phase_moe_up(a, L, lds); SEAM(b2 + 3); }
    if (IN(b2 + 4)) { FRESH_ARGS(); REP(9) phase_moe_down(a, L, lds); SEAM(b2 + 4); }
    if (IN(b2 + 5)) { FRESH_ARGS(); if ((PH_REPEAT_MASK >> 10) & 1u) phase_combine(a, L, true); phase_combine(a, L); SEAM(b2 + 5); }
  }
#undef IN
#undef SEAM
}

#ifndef MK_DIAG
#define MK_DIAG 0
#endif
#if MK_DIAG
__device__ __forceinline__ void rope_cs(int r, int lane, float& cs, float& sn) {
  cs = 1.f; sn = 0.f;
  if (r >= CTXL) { const int t = r - CTXL; const int a = lane >> 5, i = lane & 31;
    const float pos = a ? (float)(t & 63) : (float)(t >> 6);
    const float inv = powf(10000.f, -(float)i / 32.f);
    sincosf(pos * inv, &sn, &cs); }
}
__device__ __forceinline__ bool dclose(float got, float ref, float rtol, float atol) { return fabsf(got - ref) <= rtol * fabsf(ref) + atol; }
__device__ __forceinline__ unsigned dhash(unsigned x) { x ^= x >> 16; x *= 0x7feb352du; x ^= x >> 15; x *= 0x846ca68bu; x ^= x >> 16; return x; }
__device__ float wdot(const bf16_t* arow, const float* W, int ldw, int col, int K, int lane) {
  float s = 0; for (int k = lane; k < K; k += 64) s += bf2f(arow[k]) * W[(size_t)k * ldw + col]; return wave_sum(s); }
__device__ float dq8(const unsigned char* p, size_t i) { const unsigned w = ((const unsigned*)p)[i >> 2]; const int b = (int)(i & 3);
  return b == 0 ? __builtin_amdgcn_cvt_f32_fp8((int)w, 0) : b == 1 ? __builtin_amdgcn_cvt_f32_fp8((int)w, 1) : b == 2 ? __builtin_amdgcn_cvt_f32_fp8((int)w, 2) : __builtin_amdgcn_cvt_f32_fp8((int)w, 3); }
__device__ float wdot8(const unsigned char* arow8, const float* W, int ldw, int col, int K, int lane) {
  float s = 0; for (int k = lane; k < K; k += 64) s += dq8(arow8, k) * W[(size_t)k * ldw + col]; return wave_sum(s); }
__device__ void dflag(int* dg, int s, int bad, int lane) { if (lane == 0 && bad) atomicAdd(&dg[s], bad); }
__device__ const float* h0row(const Args& a, int r) { return r < CTXL ? a.in[2] + (size_t)r * D : a.in[0] + (size_t)(r - CTXL) * D; }
__device__ int pick_row(unsigned h, int lo, int n) { const unsigned m = h % 8; if (m == 0) return lo; if (m == 1) return lo + n - 1; if (m == 2) return lo + 255 < lo + n ? lo + 255 : lo; if (m == 3) return lo + 256 < lo + n ? lo + 256 : lo; return lo + (int)((h >> 3) % (unsigned)n); }
__device__ void naive_attn(const bf16_t* q, const bf16_t* K, const bf16_t* V, int ld, int nkeys, int lane, float& o0, float& o1) {
  const float q0 = bf2f(q[lane]), q1 = bf2f(q[lane + 64]);
  float m = -1e30f, l = 0; o0 = 0; o1 = 0;
  for (int k = 0; k < nkeys; ++k) {
    const float s = wave_sum(q0 * bf2f(K[(size_t)k * ld + lane]) + q1 * bf2f(K[(size_t)k * ld + lane + 64])) * 0.088388347648318440f;
    const float mn = fmaxf(m, s), al = expf(m - mn), p = expf(s - mn);
    l = l * al + p; o0 = o0 * al + p * bf2f(V[(size_t)k * ld + lane]); o1 = o1 * al + p * bf2f(V[(size_t)k * ld + lane + 64]); m = mn;
  }
  o0 /= l; o1 /= l;
}
__global__ void __launch_bounds__(256) diag(Args a, int k) {
  __shared__ float fsh[4][2048];
  __shared__ float csh[4][64];
  const int lane = threadIdx.x & 63, wv = threadIdx.x >> 6, gw = blockIdx.x * 4 + wv;
  int* dg = (int*)(a.ws + WS_CTL + CTL_CNT + 512);
  const float* MOD = (const float*)(a.ws + WS_MOD);
  const bf16_t* AB = (const bf16_t*)(a.ws + WS_ABUF);
  const bf16_t* QK = (const bf16_t*)(a.ws + WS_QKVU);
  const bf16_t* HG = (const bf16_t*)(a.ws + WS_HG);
  const bf16_t* X2 = (const bf16_t*)(a.ws + WS_X2);
  const bf16_t* OUT = (const bf16_t*)(a.ws + WS_OUT);
  const bf16_t* ACT = (const bf16_t*)(a.ws + WS_ACT);
  const bf16_t* Y = (const bf16_t*)(a.ws + WS_Y);
  const float* HRES = (const float*)(a.ws + WS_HRES);
  const int* top_e = (const int*)(a.ws + WS_TOPE); const float* top_w = (const float*)(a.ws + WS_TOPW); const int* top_p = (const int*)(a.ws + WS_TOPP);
  const int* tslot = (const int*)(a.ws + WS_TSLOT); const int* stok = (const int*)(a.ws + WS_STOK);
  const unsigned h = dhash(gw * 7919u + k * 104729u + 17u), h2 = dhash(h + 12345u);
  int bad = 0;
  const int L = k >= 11 ? 1 : 0;
  const int NTOK = L == 0 ? MT : SEQ, ROW0 = L == 0 ? 0 : CTXL;
  const int* counts = (const int*)(a.ws + WS_CTL + CTL_CNT) + L * 64;
  if (k == 0) {
    const int LL = gw & 1, which = (gw >> 1) & 1, j = h % 12288;
    const float* v = which ? a.in[3] : a.in[1];
    float s = 0; for (int d = lane; d < D; d += 64) { const float x = v[d]; s += x * sigmoidf_(x) * a.in[4][((size_t)LL * D + d) * 12288 + j]; }
    s = wave_sum(s) + a.in[5][LL * 12288 + j];
    bad = !dclose(MOD[(LL * 2 + which) * 12288 + j], s, 1e-3f, 1e-3f); dflag(dg, 1, bad, lane);
  } else if (k == 1) {
    const int r = pick_row(h, 0, MT); const float* x = h0row(a, r); const float* mod = MOD + (r < CTXL ? 12288 : 0);
    float ss = 0; for (int d = lane; d < D; d += 64) ss += x[d] * x[d]; ss = wave_sum(ss); const float rstd = rsqrtf(ss / D + EPS);
    for (int d = lane; d < D; d += 64) { const float ref = x[d] * rstd * a.in[6][d] * (1.f + mod[D + d]) + mod[d]; bad += !dclose(bf2f(AB[(size_t)r * D + d]), ref, 0.01f, 0.01f); }
    bad = (int)wave_sum((float)bad); dflag(dg, 2, bad, lane);
  } else if (k == 2 || k == 11) {
    const int r = pick_row(h, 0, MT);
    if (L == 0) {
      const int c = h2 % N_QKV0; const float ref = wdot(AB + (size_t)r * D, a.in[7], N_IN0, c, D, lane);
      bad = !dclose(bf2f(QK[(size_t)r * N_QKV0 + c]), ref, 0.02f, 0.05f); dflag(dg, 3, bad, lane);
      const int ch = (h2 >> 11) % 1024; const float av = wdot(AB + (size_t)r * D, a.in[7], N_IN0, N_QKV0 + ch, D, lane), gv = wdot(AB + (size_t)r * D, a.in[7], N_IN0, N_QKV0 + 1024 + ch, D, lane);
      bad = !dclose(bf2f(HG[(size_t)r * 1024 + ch]), av * sigmoidf_(gv), 0.03f, 0.05f); dflag(dg, 4, bad, lane);
    } else {
      const int c = h2 % N_IN1; const float ref = wdot(AB + (size_t)r * D, a.in[15], N_IN1, c, D, lane);
      bad = !dclose(bf2f(QK[(size_t)r * N_IN1 + c]), ref, 0.02f, 0.05f); dflag(dg, 15, bad, lane);
    }
  } else if (k == 3) {
    { const int r = pick_row(h, 0, MT), hh = h2 % 10; const float* g = hh < 8 ? a.in[9] : a.in[10];
      float raw0 = 0, raw1 = 0;
      for (int d = 0; d < 128; ++d) { const float v = wdot(AB + (size_t)r * D, a.in[7], N_IN0, hh * 128 + d, D, lane); if (d == lane) raw0 = v; if (d == lane + 64) raw1 = v; }
      const float rstd = rsqrtf(wave_sum(raw0 * raw0 + raw1 * raw1) / 128.f + EPS);
      const float y0 = raw0 * rstd * g[lane], y1 = raw1 * rstd * g[lane + 64];
      float cs, sn; rope_cs(r, lane, cs, sn);
      const float cs0 = __shfl(cs, lane & 31), sn0 = __shfl(sn, lane & 31), cs1 = __shfl(cs, 32 + (lane & 31)), sn1 = __shfl(sn, 32 + (lane & 31));
      const float p0 = __shfl_xor(y0, 32), p1 = __shfl_xor(y1, 32);
      const float o0 = (lane < 32) ? y0 * cs0 - p0 * sn0 : y0 * cs0 + p0 * sn0;
      const float o1 = (lane < 32) ? y1 * cs1 - p1 * sn1 : y1 * cs1 + p1 * sn1;
      bad = !dclose(bf2f(QK[(size_t)r * N_QKV0 + hh * 128 + lane]), o0, 0.03f, 0.05f) + !dclose(bf2f(QK[(size_t)r * N_QKV0 + hh * 128 + 64 + lane]), o1, 0.03f, 0.05f);
      bad = (int)wave_sum((float)bad); dflag(dg, 5, bad, lane); }
    { const int r = pick_row(h2, 0, MT); const int seg0 = r < CTXL ? 0 : CTXL, seg1 = r < CTXL ? CTXL : MT;
      float cv[16]; float s1 = 0, s2 = 0;
      for (int q = 0; q < 16; ++q) { const int c = lane + 64 * q; float acc = a.in[12][c];
        for (int j = 0; j < 31; ++j) { const int rr = r + j - 15; if (rr >= seg0 && rr < seg1) acc += bf2f(HG[(size_t)rr * 1024 + c]) * a.in[11][j * 1024 + c]; }
        cv[q] = acc; s1 += acc; s2 += acc * acc; }
      s1 = wave_sum(s1); s2 = wave_sum(s2); const float mean = s1 / 1024.f, rstd = rsqrtf(s2 / 1024.f - mean * mean + EPS);
      bad = 0;
      for (int q = 0; q < 16; ++q) { const int c = lane + 64 * q; float y = (cv[q] - mean) * rstd * a.in[13][c] + a.in[14][c]; y = y * sigmoidf_(y);
        bad += !dclose(bf2f(X2[(size_t)r * D + 1024 + c]), y, 0.03f, 0.03f); }
      bad = (int)wave_sum((float)bad); dflag(dg, 6, bad, lane); }
  } else if (k == 4) {
    if (gw < 64) { const int r = pick_row(h, 0, MT), head = h2 % 8; const int nkeys = r < CTXL ? CTXL : MT;
      float o0, o1; naive_attn(QK + (size_t)r * N_QKV0 + head * 128, QK + 1024 + (head >> 2) * 128, QK + 1280 + (head >> 2) * 128, N_QKV0, nkeys, lane, o0, o1);
      const float rt = r < CTXL ? 0.15f : 0.05f, at_ = r < CTXL ? 0.04f : 0.01f;
      bad = !dclose(bf2f(X2[(size_t)r * D + head * 128 + lane]), o0, rt, at_) + !dclose(bf2f(X2[(size_t)r * D + head * 128 + 64 + lane]), o1, rt, at_);
      bad = (int)wave_sum((float)bad); dflag(dg, r < CTXL ? 26 : 7, bad, lane); }
  } else if (k == 5 || k == 15) {
    const int r = pick_row(h, ROW0, NTOK), c = h2 % D; const float ref = wdot(X2 + (size_t)r * D, L == 0 ? a.in[8] : a.in[16], D, c, D, lane);
    bad = !dclose(bf2f(OUT[(size_t)r * D + c]), ref, 0.02f, 0.05f); dflag(dg, L == 0 ? 8 : 19, bad, lane);
  } else if (k == 6 || k == 16) {
    const int r = pick_row(h, ROW0, NTOK); const float* mod = MOD + (size_t)(L * 2) * 12288 + (r < CTXL ? 12288 : 0); const float* ng = a.in[6] + (size_t)L * 4 * D;
    float ss = 0; for (int d = lane; d < D; d += 64) { const float o = bf2f(OUT[(size_t)r * D + d]); ss += o * o; } ss = wave_sum(ss); const float rstd1 = rsqrtf(ss / D + EPS);
    bad = 0;
    if (L == 0) { const float* x = h0row(a, r); for (int d = lane; d < D; d += 64) { const float ref = x[d] + mod[2 * D + d] * (bf2f(OUT[(size_t)r * D + d]) * rstd1 * ng[D + d]); bad += !dclose(HRES[(size_t)r * D + d], ref, 1e-3f, 1e-3f); } }
    float s2 = 0; for (int d = lane; d < D; d += 64) { const float x = HRES[(size_t)r * D + d]; s2 += x * x; } s2 = wave_sum(s2); const float rstd2 = rsqrtf(s2 / D + EPS);
    for (int d = lane; d < D; d += 64) { const float f = HRES[(size_t)r * D + d] * rstd2 * ng[2 * D + d] * (1.f + mod[4 * D + d]) + mod[3 * D + d]; fsh[wv][d] = f; bad += !dclose(dq8((const unsigned char*)AB + (size_t)r * D, d), f, 0.07f, 0.01f); }
    bad = (int)wave_sum((float)bad); dflag(dg, L == 0 ? 9 : 20, bad, lane);
    __syncthreads();
    float lg = 0; for (int d = 0; d < D; ++d) lg += fsh[wv][d] * a.in[19][((size_t)L * D + d) * NE + lane];
    const float sc = sigmoidf_(lg); csh[wv][lane] = sc + a.in[20][L * NE + lane];
    __syncthreads();
    { const float plg = ((const float*)(a.ws + WS_Y))[(size_t)r * 64 + lane]; int lb = !dclose(plg, lg, 1e-3f, 1e-3f); lb = (int)wave_sum((float)lb); if (lane == 0 && lb) { atomicAdd(&dg[32 + (L == 0 ? 10 : 21) + 3], 1); atomicOr(&dg[60], 1 << (r & 7)); } }
    unsigned long long wsel;
    { const float choice = csh[wv][lane]; int rank = 0; const int gl = lane & 7;
      for (int j = 0; j < 8; ++j) { const float o = __shfl(choice, (lane & ~7) | j); rank += (o > choice || (o == choice && j < gl)) ? 1 : 0; }
      float gs = rank < 2 ? choice : 0.f; gs += __shfl_xor(gs, 1); gs += __shfl_xor(gs, 2); gs += __shfl_xor(gs, 4);
      int grank = 0; const int g = lane >> 3;
      for (int j = 0; j < 8; ++j) { const float o = __shfl(gs, j * 8); grank += (o > gs || (o == gs && j < g)) ? 1 : 0; }
      const bool gsel = grank < 4; const float mc = gsel ? choice : -INFINITY; int erank = 0;
      for (int j = 0; j < 64; ++j) { const float o = __shfl(mc, j); erank += (o > mc || (o == mc && j < lane)) ? 1 : 0; }
      wsel = __ballot(gsel && erank < 8); }
    int setbad = 0;
    if (lane == 0) {
      float gsc[8]; for (int g = 0; g < 8; ++g) { float m1 = -1e30f, m2 = -1e30f; for (int j = 0; j < 8; ++j) { const float v = csh[wv][g * 8 + j]; if (v > m1) { m2 = m1; m1 = v; } else if (v > m2) m2 = v; } gsc[g] = m1 + m2; }
      bool gs[8] = {false, false, false, false, false, false, false, false};
      for (int t = 0; t < 4; ++t) { int bi = 0; float bv = -1e30f; for (int g = 0; g < 8; ++g) if (!gs[g] && gsc[g] > bv) { bv = gsc[g]; bi = g; } gs[bi] = true; }
      unsigned long long selm = 0; for (int t = 0; t < 8; ++t) { int bi = 0; float bv = -1e30f; for (int e = 0; e < 64; ++e) if (gs[e >> 3] && !((selm >> e) & 1ull) && csh[wv][e] > bv) { bv = csh[wv][e]; bi = e; } selm |= 1ull << bi; }
      unsigned long long got = 0; for (int t = 0; t < 8; ++t) { const int e = top_e[r * 8 + t]; if (e < 0 || e > 63) setbad = 1000; else got |= 1ull << e; }
      if (setbad == 0 && got != selm) setbad = 1;
      if (wsel != selm) atomicAdd(&dg[32 + (L == 0 ? 10 : 21) + 4], 1);
    }
    setbad = __shfl(setbad, 0);
    { float wgot = -1.f; int mine = 0; for (int t = 0; t < 8; ++t) if (top_e[r * 8 + t] == lane) { mine = 1; wgot = top_w[r * 8 + t]; }
      const float ssum = wave_sum(mine ? sc : 0.f);
      int wbad = (mine && !dclose(wgot, sc / ssum * 2.5f, 0.01f, 1e-3f)) ? 1 : 0; wbad = (int)wave_sum((float)wbad);
      if (lane == 0) { int* q = &dg[32 + (L == 0 ? 10 : 21)]; if (setbad >= 1000) atomicAdd(q + 1, 1); else if (setbad) atomicAdd(q, 1); else if (wbad) atomicAdd(q + 2, 1); } }
  } else if (k == 7 || k == 17) {
    const int r = pick_row(h, ROW0, NTOK), t = h2 % 8, q = r * 8 + t; const int slot = tslot[q], e = top_e[q];
    int ts0 = 0; for (int j = 0; j < e; ++j) ts0 += (counts[j] + 255) >> 8;
    bad = (slot < ts0 * 256 || slot >= ts0 * 256 + counts[e] || stok[slot] != r || top_p[q] != slot - ts0 * 256) ? 1 : 0;
    bad += (stok[SH_BASE + r - ROW0] != r) ? 1 : 0;
    dflag(dg, L == 0 ? 11 : 22, bad, lane);
  } else if (k == 8 || k == 18 || k == 9 || k == 19) {
    int TR = 0; for (int j = 0; j < 64; ++j) TR += (counts[j] + 255) >> 8;
    int slot, e;
    if ((h & 3) == 0) { slot = SH_BASE + (int)((h >> 2) % (unsigned)NTOK); e = 64; }
    else { e = (h >> 2) % 64; int guard = 0; while (counts[e] == 0 && guard++ < 64) e = (e + 1) % 64; int ts0 = 0; for (int j = 0; j < e; ++j) ts0 += (counts[j] + 255) >> 8;
      const unsigned m = (h >> 8) % 4; const int cnt = counts[e]; const int p = m == 0 ? 0 : m == 1 ? cnt - 1 : (int)((h >> 10) % (unsigned)cnt); slot = ts0 * 256 + p; }
    const int tok = stok[slot];
    if (k == 8 || k == 18) {
      const int ch = h2 % EFF;
      const float* Wg = e < 64 ? a.in[21] + ((size_t)L * 64 + e) * D * EFF : a.in[24] + (size_t)L * D * EFF;
      const float* Wu = e < 64 ? a.in[22] + ((size_t)L * 64 + e) * D * EFF : a.in[25] + (size_t)L * D * EFF;
      const unsigned char* F8 = (const unsigned char*)AB + (size_t)tok * D;
      const float gv = wdot8(F8, Wg, EFF, ch, D, lane), uv = wdot8(F8, Wu, EFF, ch, D, lane);
      bad = !dclose(dq8((const unsigned char*)ACT + (size_t)slot * EFF, ch), gv * sigmoidf_(gv) * uv, 0.2f, 0.15f); dflag(dg, L == 0 ? 12 : 23, bad, lane);
    } else {
      const int c = h2 % D; const float* Wd = e < 64 ? a.in[23] + ((size_t)L * 64 + e) * EFF * D : a.in[26] + (size_t)L * EFF * D;
      const float ref = wdot8((const unsigned char*)ACT + (size_t)slot * EFF, Wd, D, c, EFF, lane);
      bad = !dclose(dq8((const unsigned char*)Y + (size_t)slot * D, c) * (1.f / 16.f), ref, 0.2f, 0.15f); dflag(dg, L == 0 ? 13 : 24, bad, lane);
    }
  } else if (k == 10 || k == 20) {
    const int r = pick_row(h, ROW0, NTOK); const float* mod = MOD + (size_t)(L * 2) * 12288 + (r < CTXL ? 12288 : 0); const float* ng = a.in[6] + (size_t)L * 4 * D;
    float ss = 0; for (int d = lane; d < D; d += 64) { const unsigned char* Y8 = (const unsigned char*)Y; float y = dq8(Y8 + (size_t)(SH_BASE + r - ROW0) * D, d) * (1.f / 16.f); for (int t = 0; t < 8; ++t) y += top_w[r * 8 + t] * dq8(Y8 + (size_t)tslot[r * 8 + t] * D, d) * (1.f / 16.f); fsh[wv][d] = y; ss += y * y; }
    ss = wave_sum(ss); const float rstd = rsqrtf(ss / D + EPS);
    bad = 0;
    if (L == 0) { float s2 = 0; for (int d = lane; d < D; d += 64) { const float x = HRES[(size_t)r * D + d]; s2 += x * x; } s2 = wave_sum(s2); const float rstd2 = rsqrtf(s2 / D + EPS);
      const float* mod1 = MOD + (size_t)2 * 12288 + (r < CTXL ? 12288 : 0);
      for (int d = lane; d < D; d += 64) { const float ref = HRES[(size_t)r * D + d] * rstd2 * a.in[6][4 * D + d] * (1.f + mod1[D + d]) + mod1[d]; bad += !dclose(bf2f(AB[(size_t)r * D + d]), ref, 0.01f, 0.01f); } }
    else { for (int d = lane; d < D; d += 64) { const float ref = HRES[(size_t)r * D + d] + mod[5 * D + d] * (fsh[wv][d] * rstd * ng[3 * D + d]); bad += !dclose(a.out[(size_t)(r - CTXL) * D + d], ref, 1e-3f, 1e-3f); } }
    bad = (int)wave_sum((float)bad); dflag(dg, L == 0 ? 14 : 25, bad, lane);
  } else if (k == 12) {
    const int r = pick_row(h, CTXL, SEQ), hh = h2 % 32;
    float raw0 = 0, raw1 = 0;
    for (int d = 0; d < 128; ++d) { const float v = wdot(AB + (size_t)r * D, a.in[15], N_IN1, hh * 128 + d, D, lane); if (d == lane) raw0 = v; if (d == lane + 64) raw1 = v; }
    float cs, sn; rope_cs(r, lane, cs, sn);
    const float cs0 = __shfl(cs, lane & 31), sn0 = __shfl(sn, lane & 31), cs1 = __shfl(cs, 32 + (lane & 31)), sn1 = __shfl(sn, 32 + (lane & 31));
    const float p0 = __shfl_xor(raw0, 32), p1 = __shfl_xor(raw1, 32);
    const float o0 = (lane < 32) ? raw0 * cs0 - p0 * sn0 : raw0 * cs0 + p0 * sn0;
    const float o1 = (lane < 32) ? raw1 * cs1 - p1 * sn1 : raw1 * cs1 + p1 * sn1;
    bad = !dclose(bf2f(QK[(size_t)r * N_IN1 + hh * 128 + lane]), o0, 0.03f, 0.05f) + !dclose(bf2f(QK[(size_t)r * N_IN1 + hh * 128 + 64 + lane]), o1, 0.03f, 0.05f);
    bad = (int)wave_sum((float)bad); dflag(dg, 16, bad, lane);
  } else if (k == 13) {
    if (gw < 64) { const int r = pick_row(h, CTXL, SEQ), hc = h2 % 16, vh = (h2 >> 4) & 1, hd = hc >> 1;
      float o0, o1; naive_attn(QK + (size_t)r * N_IN1 + hc * 128, QK + 2048 + hc * 128, QK + 4096 + hd * 256 + vh * 128, N_IN1, MT, lane, o0, o1);
      const bf16_t* O = Y + (size_t)(r - CTXL) * 4096 + hc * 256 + vh * 128;
      bad = !dclose(bf2f(O[lane]), o0, 0.05f, 0.01f) + !dclose(bf2f(O[64 + lane]), o1, 0.05f, 0.01f);
      bad = (int)wave_sum((float)bad); dflag(dg, 17, bad, lane); }
  } else if (k == 14) {
    const int r = pick_row(h, CTXL, SEQ), hd = h2 % 8; const float* lp = a.in[17];
    float s1 = 0, s2 = 0; for (int i = lane; i < 128; i += 64) { s1 += lp[i] * lp[128 + i]; s2 += lp[256 + i] * lp[384 + i]; } s1 = wave_sum(s1); s2 = wave_sum(s2);
    const float lam = expf(s1) - expf(s2) + LAM_INIT; const bf16_t* O = Y + (size_t)(r - CTXL) * 4096;
    float dv[4], ss = 0; for (int i = 0; i < 4; ++i) { const int d = lane + 64 * i; dv[i] = bf2f(O[(2 * hd) * 256 + d]) - lam * bf2f(O[(2 * hd + 1) * 256 + d]); ss += dv[i] * dv[i]; }
    ss = wave_sum(ss); const float rstd = rsqrtf(ss / 256.f + EPS) * (1.f - LAM_INIT); bad = 0;
    for (int i = 0; i < 4; ++i) { const int d = lane + 64 * i; bad += !dclose(bf2f(X2[(size_t)r * D + hd * 256 + d]), dv[i] * rstd * a.in[18][d], 0.02f, 0.01f); }
    bad = (int)wave_sum((float)bad); dflag(dg, 18, bad, lane);
  }
}
__global__ void diag_encode(Args a) {
  const int* dg = (const int*)(a.ws + WS_CTL + CTL_CNT + 512);
  int s = 0;
  int sub = 0;
  for (int i = 1; i < 32; ++i) { int v = dg[i]; if (i == 10 || i == 21) { v = (dg[32 + i] > 25 ? 1 : 0) + (dg[33 + i] > 0 ? 2 : 0) + (dg[34 + i] > 0 ? 4 : 0) + (dg[35 + i] > 0 ? 8 : 0) + (dg[36 + i] > 0 ? 16 : 0); sub = v; } if (v) { s = i; break; } }
  if (s == 0) return;
  const float c = sub ? 30.f + 8.f * sub : 10.f * s;
  for (size_t i = (size_t)blockIdx.x * blockDim.x + threadIdx.x; i < (size_t)SEQ * D; i += (size_t)gridDim.x * blockDim.x) a.out[i] = c;
}
#endif

extern "C" void kernel_launch(void* const* d_in, const int* in_sizes, int n_in, void* d_out, int out_size, void* d_ws, size_t ws_size, hipStream_t stream) {
  static int grid = 0;
  if (grid == 0) {
    if (n_in != 27 || out_size != SEQ * D || ws_size < WS_END) { fprintf(stderr, "kernel_launch: unexpected shapes (n_in %d out %d ws %zu need %zu)\n", n_in, out_size, ws_size, (size_t)WS_END); grid = -1; return; }
    if (hipFuncSetAttribute((const void*)fwd, hipFuncAttributeMaxDynamicSharedMemorySize, LDS_BYTES) != hipSuccess) { fprintf(stderr, "kernel_launch: hipFuncSetAttribute failed\n"); grid = -1; return; }
    int dev = 0, cus = 0, per_cu = 0;
    hipGetDevice(&dev); hipDeviceGetAttribute(&cus, hipDeviceAttributeMultiprocessorCount, dev);
    if (hipOccupancyMaxActiveBlocksPerMultiprocessor(&per_cu, (const void*)fwd, NTHREADS, LDS_BYTES) != hipSuccess || per_cu < 1) fprintf(stderr, "kernel_launch: occupancy query says %d\n", per_cu);
    (void)hipGetLastError();
    grid = cus < 256 ? cus : 256;
    if (grid != 256) fprintf(stderr, "kernel_launch: %d CUs (expected 256)\n", cus);
  }
  if (grid < 0) return;
  hipMemsetAsync((char*)d_ws + WS_CTL, 0, CTL_BYTES, stream);
  Args a{};
  for (int i = 0; i < 27; ++i) a.in[i] = (const float*)d_in[i];
  a.out = (float*)d_out; a.ws = (unsigned char*)d_ws;
#if MK_MULTI
  for (int k = 0; k < NPH; ++k) { a.ph_lo = k; a.ph_hi = k + 1; hipLaunchKernelGGL(fwd, dim3(grid), dim3(NTHREADS), LDS_BYTES, stream, a);
#if MK_DIAG
    hipLaunchKernelGGL(diag, dim3(64), dim3(256), 0, stream, a, k);
#endif
  }
#if MK_DIAG
  hipLaunchKernelGGL(diag_encode, dim3(1024), dim3(256), 0, stream, a);
#endif
#else
  a.ph_lo = 0; a.ph_hi = NPH;
  hipLaunchKernelGGL(fwd, dim3(grid), dim3(NTHREADS), LDS_BYTES, stream, a);
#endif
  const hipError_t le = hipPeekAtLastError();
  if (le != hipSuccess) fprintf(stderr, "kernel_launch: launch failed: %s\n", hipGetErrorName(le));
}
```

```cpp
#include <hip/hip_runtime.h>
#include <cstdio>
#include <cstdint>

#define MK_DIAG 0
#define ATT_VAR 0
#define GEMM_VAR 0
#ifndef DENSE8_G1
#define DENSE8_G1 1
#endif
#ifndef DENSE8_G2
#define DENSE8_G2 0
#endif
#ifndef MK_MULTI
#define MK_MULTI 0
#endif

#define LAS __attribute__((address_space(3)))
typedef unsigned short bf16_t;
typedef short bf16x8 __attribute__((ext_vector_type(8)));
typedef short s16x4 __attribute__((ext_vector_type(4)));
typedef float f32x4 __attribute__((ext_vector_type(4)));
typedef float f32x2 __attribute__((ext_vector_type(2)));
typedef float f32x16 __attribute__((ext_vector_type(16)));
typedef unsigned u32x4 __attribute__((ext_vector_type(4)));
typedef unsigned u32x2 __attribute__((ext_vector_type(2)));

constexpr int D = 2048, SEQ = 16384, CTXL = 256, MT = SEQ + CTXL;
constexpr int NE = 64, TOPK = 8, EFF = 512;
constexpr int N_IN0 = 3584, N_QKV0 = 1536, N_IN1 = 6144;
constexpr float EPS = 1e-6f;
constexpr float LAM_INIT = 0.35550907f;
constexpr int SH_BASE = SEQ * 0 + (MT * TOPK) + NE * 256;
constexpr int NSLOT = SH_BASE + MT;
constexpr int NTHREADS = 512;
constexpr int LDS_BYTES = 131072 + 1024;
constexpr int LDS_CTL = 131072;

constexpr size_t al256(size_t x) { return (x + 255) & ~(size_t)255; }
constexpr size_t WS_CTL   = 0;
constexpr size_t CTL_BYTES = 32768;
constexpr size_t CTL_CNT  = 16384;
constexpr size_t CTL_KMAX = 16384 + 2048;
constexpr size_t WS_MOD   = CTL_BYTES;
constexpr size_t WS_WIN0  = al256(WS_MOD + 2 * 2 * 12288 * 4);
constexpr size_t WS_WOUT0 = al256(WS_WIN0 + (size_t)N_IN0 * D * 2);
constexpr size_t WS_WIN1  = al256(WS_WOUT0 + (size_t)D * D * 2);
constexpr size_t WS_WOUT1 = al256(WS_WIN1 + (size_t)N_IN1 * D * 2);
constexpr size_t WMOE_E   = (size_t)1024 * D + (size_t)D * EFF;
constexpr size_t WS_WMOE  = al256(WS_WOUT1 + (size_t)D * D * 2);
constexpr size_t WS_HRES  = al256(WS_WMOE + 65 * WMOE_E * 2);
constexpr size_t WS_ABUF  = al256(WS_HRES + (size_t)MT * D * 4);
constexpr size_t WS_QKVU  = al256(WS_ABUF + (size_t)MT * D * 2);
constexpr size_t WS_HG    = al256(WS_QKVU + (size_t)MT * N_IN1 * 2);
constexpr size_t WS_X2    = al256(WS_HG + (size_t)MT * 1024 * 2);
constexpr size_t WS_OUT   = al256(WS_X2 + (size_t)MT * D * 2);
constexpr size_t WS_ACT   = al256(WS_OUT + (size_t)MT * D * 2);
constexpr size_t WS_K8    = WS_ACT + al256((size_t)NSLOT * EFF);
constexpr size_t V8T0_OFF = (size_t)8 << 20;
constexpr size_t WS_Y     = al256(WS_ACT + (size_t)NSLOT * EFF * 2);
constexpr int ECAP = MT;
constexpr size_t WS_ELIST = al256(WS_Y + (size_t)NSLOT * D);
constexpr size_t WS_RT    = al256(WS_ELIST + (size_t)64 * ECAP * 4);
constexpr size_t WS_TOPE  = al256(WS_Y + (size_t)NSLOT * D * 2);
constexpr size_t WS_TOPW  = al256(WS_TOPE + (size_t)MT * TOPK * 4);
constexpr size_t WS_TOPP  = al256(WS_TOPW + (size_t)MT * TOPK * 4);
constexpr size_t WS_TSLOT = al256(WS_TOPP + (size_t)MT * TOPK * 4);
constexpr size_t WS_STOK  = al256(WS_TSLOT + (size_t)MT * TOPK * 4);
constexpr size_t WS_END   = al256(WS_STOK + (size_t)NSLOT * 4);

struct Args { const float* in[27]; float* out; unsigned char* ws; int ph_lo, ph_hi; };

__device__ __forceinline__ float bflo(unsigned x) { return __uint_as_float(x << 16); }
__device__ __forceinline__ float bfhi(unsigned x) { return __uint_as_float(x & 0xffff0000u); }
__device__ __forceinline__ float bf2f(bf16_t b) { return __uint_as_float(((unsigned)b) << 16); }
__device__ __forceinline__ unsigned cvtpk(float lo, float hi) { unsigned r; asm("v_cvt_pk_bf16_f32 %0, %1, %2" : "=v"(r) : "v"(lo), "v"(hi)); return r; }
__device__ __forceinline__ bf16_t f2bf(float x) { return (bf16_t)(cvtpk(x, 0.f) & 0xffffu); }
__device__ __forceinline__ float wave_sum(float v) {
#pragma unroll
  for (int o = 32; o; o >>= 1) v += __shfl_xor(v, o);
  return v;
}
__device__ __forceinline__ float sigmoidf_(float x) { return 1.f / (1.f + expf(-x)); }
__device__ __forceinline__ float sigmoid_fast(float x) { return __builtin_amdgcn_rcpf(1.f + __builtin_amdgcn_exp2f(-1.4426950408889634f * x)); }

__device__ __forceinline__ float clamp8e(float x) { return fminf(fmaxf(x, -448.f), 448.f); }
__device__ __forceinline__ unsigned pack8x4(float a, float b, float c, float d) {
  int p = __builtin_amdgcn_cvt_pk_fp8_f32(clamp8e(a), clamp8e(b), 0, false); p = __builtin_amdgcn_cvt_pk_fp8_f32(clamp8e(c), clamp8e(d), p, true); return (unsigned)p; }
__device__ __forceinline__ float sq8x4(unsigned p) {
  const float a = __builtin_amdgcn_cvt_f32_fp8((int)p, 0), b = __builtin_amdgcn_cvt_f32_fp8((int)p, 1), c = __builtin_amdgcn_cvt_f32_fp8((int)p, 2), d = __builtin_amdgcn_cvt_f32_fp8((int)p, 3);
  return a * a + b * b + c * c + d * d; }
typedef int v8i_ __attribute__((ext_vector_type(8)));
typedef int v4i __attribute__((ext_vector_type(4)));
#define XB_TMO      128
#define XB_XCNT(j)  (256  + 64 * (j))
#define XB_XSUB(j)  (1280 + 64 * (j))
#define XB_XGEN(j)  (2304 + 64 * (j))
#define XB_TOP      3328
#define XB_TOPGEN   3392
#define XCD_BAR_WORDS 3456
#define XB_SPIN_CAP (1u << 22)
__device__ __forceinline__ unsigned xb_ld(unsigned* p)              { return __hip_atomic_load(p, __ATOMIC_RELAXED, __HIP_MEMORY_SCOPE_AGENT); }
__device__ __forceinline__ unsigned xb_add(unsigned* p, unsigned v) { return __hip_atomic_fetch_add(p, v, __ATOMIC_RELAXED, __HIP_MEMORY_SCOPE_AGENT); }
__device__ __forceinline__ unsigned xb_xcc_id() { return (unsigned)__builtin_amdgcn_s_getreg((3 << 11) | 20) & 0xFu; }
#define XB_SPIN(cond, bar) do { unsigned _sp = 0; while (cond) { __builtin_amdgcn_s_sleep(1); \
    if ((++_sp & 255u) == 0u) { if (xb_ld(&(bar)[XB_TMO])) break; if (_sp > XB_SPIN_CAP) { atomicAdd(&(bar)[XB_TMO], 1u); break; } } } } while (0)
struct XcdBarrier { unsigned* bar; unsigned x; volatile LAS unsigned* st; };
__device__ __forceinline__ XcdBarrier xcd_barrier_post(unsigned* bar, volatile LAS unsigned* st) {
    XcdBarrier b; b.bar = bar; b.x = xb_xcc_id(); b.st = st;
    if (threadIdx.x == 0) (void)xb_add(&bar[XB_XCNT(b.x)], 1u);
    return b;
}
__device__ __forceinline__ void xcd_barrier_complete(unsigned* bar, unsigned x, unsigned& nloc, unsigned& nx) {
    const unsigned G = gridDim.x * gridDim.y * gridDim.z;
    unsigned sum, cnt, mine, sp = 0u;
    for (;;) {
        sum = 0u; cnt = 0u; mine = 0u;
#pragma unroll
        for (unsigned j = 0; j < 16; ++j) { const unsigned c = xb_ld(&bar[XB_XCNT(j)]); sum += c; cnt += (c > 0u) ? 1u : 0u; mine = (j == x) ? c : mine; }
        if (sum == G) break;
        __builtin_amdgcn_s_sleep(1);
        if ((++sp & 255u) == 0u) { if (xb_ld(&bar[XB_TMO])) break; if (sp > XB_SPIN_CAP) { atomicAdd(&bar[XB_TMO], 1u); break; } }
    }
    nloc = mine > 0u ? mine : 1u; nx = cnt > 0u ? cnt : 1u;
}
__device__ __forceinline__ void xcd_barrier(const XcdBarrier& b) {
    asm volatile("s_waitcnt vmcnt(0)" ::: "memory");
    __syncthreads();
    if (threadIdx.x == 0) {
        unsigned* bar = b.bar;
        __builtin_amdgcn_s_waitcnt(0);
        unsigned nloc = b.st[0], nx = b.st[1];
        if (nloc == 0u) { xcd_barrier_complete(bar, b.x, nloc, nx); b.st[0] = nloc; b.st[1] = nx; }
        const unsigned old = xb_add(&bar[XB_XSUB(b.x)], 1u);
        const unsigned gen = old / nloc;
        if (old + 1u == (gen + 1u) * nloc) {
            __builtin_amdgcn_fence(__ATOMIC_RELEASE, "agent");
            asm volatile("s_waitcnt vmcnt(0)" ::: "memory");
            const unsigned og = xb_add(&bar[XB_TOP], 1u);
            const unsigned tg = og / nx;
            if (og + 1u == (tg + 1u) * nx) xb_add(&bar[XB_TOPGEN], 1u);
            else XB_SPIN(xb_ld(&bar[XB_TOPGEN]) == tg, bar);
            __builtin_amdgcn_fence(__ATOMIC_ACQUIRE, "agent");
            xb_add(&bar[XB_XGEN(b.x)], 1u);
            asm volatile("s_waitcnt vmcnt(0)" ::: "memory");
        } else {
            XB_SPIN(xb_ld(&bar[XB_XGEN(b.x)]) == gen, bar);
            __builtin_amdgcn_fence(__ATOMIC_ACQUIRE, "agent");
            asm volatile("s_waitcnt vmcnt(0)" ::: "memory");
        }
    }
    __syncthreads();
}

__device__ __forceinline__ int lds_byte(int r, int c) {
  int st = (r >> 4) * 2 + (c >> 5), rr = r & 15, cc = c & 31, ob = rr * 64 + cc * 2;
  return st * 1024 + (ob ^ (((ob >> 9) & 1) << 5));
}
#define GLDS(gp, lp) __builtin_amdgcn_global_load_lds((const unsigned*)(gp), (LAS unsigned*)(lp), 16, 0, 0)
#define WAIT_V(n) asm volatile("s_waitcnt vmcnt(" #n ")" ::: "memory")
#define WAIT_L(n) asm volatile("s_waitcnt lgkmcnt(" #n ")" ::: "memory")
#define BAR __builtin_amdgcn_s_barrier()
#define SCHED __builtin_amdgcn_sched_barrier(0)

template <bool GATHER, class Epi>
__device__ __forceinline__ void gemm_tile(const bf16_t* __restrict__ A, const int lda, const int* __restrict__ tok, const int brow,
                                          const bf16_t* __restrict__ Bt, const int ldb, const int bcol, const int K,
                                          LAS char* shm, const Epi& epi) {
#define G_SA(b, h) (shm + ((b) * 2 + (h)) * 16384)
#define G_SB(b, h) (shm + (4 + (b) * 2 + (h)) * 16384)
  int tid = threadIdx.x; asm volatile("" : "+v"(tid)); tid &= 511;
  int wid = tid >> 6, lane = tid & 63, wr = wid >> 2, wc = wid & 3, fr = lane & 15, fq = lane >> 4;
  unsigned ao0, ao1, ao2, ao3, bo;
  {
    const int sb = (tid & 63) * 16, swz = sb ^ (((sb >> 9) & 1) << 5);
    const int R0 = ((tid >> 6) >> 1) * 16 + (swz >> 6), C0 = ((tid >> 6) & 1) * 32 + ((swz & 63) >> 1);
    if (GATHER) { ao0 = (unsigned)(tok[R0] * lda + C0); ao1 = (unsigned)(tok[R0 + 64] * lda + C0); ao2 = (unsigned)(tok[R0 + 128] * lda + C0); ao3 = (unsigned)(tok[R0 + 192] * lda + C0); }
    else { ao0 = (unsigned)((brow + R0) * lda + C0); ao1 = ao0 + 64u * lda; ao2 = ao0 + 128u * lda; ao3 = ao0 + 192u * lda; }
    bo = (unsigned)((bcol + R0) * ldb + C0);
  }
  const int lo = __builtin_amdgcn_readfirstlane(tid >> 6) * 1024;
#define STAGE_A0(P, kt) do { GLDS((A + (kt) * 64) + ao0, (P) + lo); GLDS((A + (kt) * 64) + ao1, (P) + lo + 8192); } while (0)
#define STAGE_A1(P, kt) do { GLDS((A + (kt) * 64) + ao2, (P) + lo); GLDS((A + (kt) * 64) + ao3, (P) + lo + 8192); } while (0)
#define STAGE_B0(P, kt) do { GLDS((Bt + (kt) * 64) + bo, (P) + lo); GLDS((Bt + 64 * ldb + (kt) * 64) + bo, (P) + lo + 8192); } while (0)
#define STAGE_B1(P, kt) do { GLDS((Bt + 128 * ldb + (kt) * 64) + bo, (P) + lo); GLDS((Bt + 192 * ldb + (kt) * 64) + bo, (P) + lo + 8192); } while (0)
#define LDA(dst, b, h) _Pragma("unroll") for (int m = 0; m < 4; ++m) _Pragma("unroll") for (int k = 0; k < 2; ++k) \
    dst[m][k] = *(LAS const bf16x8*)(G_SA(b, h) + lds_byte(wr * 64 + m * 16 + fr, k * 32 + fq * 8))
#define LDB(dst, b, h) _Pragma("unroll") for (int n = 0; n < 2; ++n) _Pragma("unroll") for (int k = 0; k < 2; ++k) \
    dst[n][k] = *(LAS const bf16x8*)(G_SB(b, h) + lds_byte(wc * 32 + n * 16 + fr, k * 32 + fq * 8))
#define MMA(ai, bj, At_, Bt_) do { __builtin_amdgcn_s_setprio(1); \
    _Pragma("unroll") for (int m = 0; m < 4; ++m) _Pragma("unroll") for (int n = 0; n < 2; ++n) _Pragma("unroll") for (int k = 0; k < 2; ++k) \
      acc[ai][bj][m][n] = __builtin_amdgcn_mfma_f32_16x16x32_bf16(Bt_[n][k], At_[m][k], acc[ai][bj][m][n], 0, 0, 0); \
    __builtin_amdgcn_s_setprio(0); } while (0)

  f32x4 acc[2][2][4][2] = {};
  bf16x8 At[4][2], B0[2][2], B1[2][2];
  const int nt = K / 64;
  STAGE_B0(G_SB(0, 0), 0); STAGE_A0(G_SA(0, 0), 0);
  STAGE_B1(G_SB(0, 1), 0); STAGE_A1(G_SA(0, 1), 0);
  if (wr == 1) BAR;
  WAIT_V(4); BAR;
  STAGE_B0(G_SB(1, 0), 1); STAGE_A0(G_SA(1, 0), 1); STAGE_B1(G_SB(1, 1), 1);
  WAIT_V(6); BAR;
  for (int t = 0; t < nt - 2; t += 2) {
    LDB(B0, 0, 0); SCHED; LDA(At, 0, 0); STAGE_A1(G_SA(1, 1), t + 1);
    WAIT_L(8); BAR; WAIT_L(0); MMA(0, 0, At, B0); BAR; SCHED;
    LDB(B1, 0, 1); STAGE_B0(G_SB(0, 0), t + 2);
    BAR; WAIT_L(0); MMA(0, 1, At, B1); BAR;
    LDA(At, 0, 1); STAGE_A0(G_SA(0, 0), t + 2);
    BAR; WAIT_L(0); MMA(1, 0, At, B0); BAR; SCHED;
    STAGE_B1(G_SB(0, 1), t + 2);
    WAIT_V(6); BAR; MMA(1, 1, At, B1); BAR;
    LDB(B0, 1, 0); SCHED; LDA(At, 1, 0); STAGE_A1(G_SA(0, 1), t + 2);
    WAIT_L(8); BAR; WAIT_L(0); MMA(0, 0, At, B0); BAR; SCHED;
    LDB(B1, 1, 1); STAGE_B0(G_SB(1, 0), t + 3);
    BAR; WAIT_L(0); MMA(0, 1, At, B1); BAR;
    LDA(At, 1, 1); STAGE_A0(G_SA(1, 0), t + 3);
    BAR; WAIT_L(0); MMA(1, 0, At, B0); BAR; SCHED;
    STAGE_B1(G_SB(1, 1), t + 3);
    WAIT_V(6); BAR; MMA(1, 1, At, B1); BAR;
  }
  { LDB(B0, 0, 0); WAIT_V(0); LDA(At, 0, 0); STAGE_A1(G_SA(1, 1), nt - 1);
    BAR; WAIT_L(0); MMA(0, 0, At, B0); BAR;
    LDB(B1, 0, 1); BAR; WAIT_L(0); MMA(0, 1, At, B1); BAR;
    LDA(At, 0, 1); WAIT_V(4); BAR; WAIT_L(0); MMA(1, 0, At, B0); MMA(1, 1, At, B1); BAR; }
  { LDB(B0, 1, 0); LDA(At, 1, 0); WAIT_V(2); BAR; WAIT_L(0); MMA(0, 0, At, B0); BAR;
    LDB(B1, 1, 1); WAIT_V(0); BAR; WAIT_L(0); MMA(0, 1, At, B1); BAR;
    LDA(At, 1, 1); BAR; WAIT_L(0); MMA(1, 0, At, B0); MMA(1, 1, At, B1); BAR; }
  if (wr == 0) BAR;
  int tz = threadIdx.x; asm volatile("" : "+v"(tz)); wid = tz >> 6; lane = tz & 63; wr = wid >> 2; wc = wid & 3; fr = lane & 15; fq = lane >> 4;
  epi(acc, brow, bcol, wr, wc, fr, fq);
#undef G_SA
#undef G_SB
#undef STAGE_A0
#undef SA0_1
#undef SA0_2
#undef SA1_1
#undef SA1_2
#undef SB0_1
#undef SB0_2
#undef SB1_1
#undef SB1_2
#undef MF1
#undef MMA_S
#undef STAGE_A1
#undef STAGE_B0
#undef STAGE_B1
#undef LDA
#undef LDB
#undef MMA
}

struct EpiPlain {     static constexpr int STAGE_ROWB = 0;
  bf16_t* C; int ldc; float sc;
  __device__ __forceinline__ void operator()(const f32x4 (&acc)[2][2][4][2], int brow, int bcol, int wr, int wc, int fr, int fq) const {
#pragma unroll
    for (int ai = 0; ai < 2; ++ai)
#pragma unroll
      for (int m = 0; m < 4; ++m) {
        bf16_t* rp = C + (size_t)(brow + ai * 128 + wr * 64 + m * 16 + fr) * ldc + bcol + wc * 32 + fq * 8;
#pragma unroll
        for (int bj = 0; bj < 2; ++bj) {
          u32x4 v = {cvtpk(acc[ai][bj][m][0][0] * sc, acc[ai][bj][m][0][1] * sc), cvtpk(acc[ai][bj][m][0][2] * sc, acc[ai][bj][m][0][3] * sc),
                     cvtpk(acc[ai][bj][m][1][0] * sc, acc[ai][bj][m][1][1] * sc), cvtpk(acc[ai][bj][m][1][2] * sc, acc[ai][bj][m][1][3] * sc)};
          *(u32x4*)(rp + bj * 128) = v;
        }
      }
  }
};
template <int MODE>
struct EpiPair {
  bf16_t* C; int ldc; int colbase; float sc;
  __device__ __forceinline__ void operator()(const f32x4 (&acc)[2][2][4][2], int brow, int bcol, int wr, int wc, int fr, int fq) const {
#pragma unroll
    for (int ai = 0; ai < 2; ++ai)
#pragma unroll
      for (int m = 0; m < 4; ++m) {
        bf16_t* rp = C + (size_t)(brow + ai * 128 + wr * 64 + m * 16 + fr) * ldc + ((bcol - colbase) >> 1) + wc * 16 + fq * 4;
#pragma unroll
        for (int bj = 0; bj < 2; ++bj) {
          float r[4];
#pragma unroll
          for (int j = 0; j < 4; ++j) {
            const float x0 = acc[ai][bj][m][0][j] * sc, x1 = acc[ai][bj][m][1][j] * sc;
            r[j] = MODE == 0 ? x0 * sigmoid_fast(x1) : x0 * sigmoid_fast(x0) * x1;
          }
          u32x2 v = {cvtpk(r[0], r[1]), cvtpk(r[2], r[3])};
          *(u32x2*)(rp + bj * 64) = v;
        }
      }
  }
};
struct EpiG1 {        static constexpr int STAGE_ROWB = 0;
  EpiPlain p; EpiPair<0> g; int nplain;
  __device__ __forceinline__ void operator()(const f32x4 (&acc)[2][2][4][2], int brow, int bcol, int wr, int wc, int fr, int fq) const {
    if (bcol < nplain) p(acc, brow, bcol, wr, wc, fr, fq); else g(acc, brow, bcol, wr, wc, fr, fq);
  }
};

typedef int v8i __attribute__((ext_vector_type(8)));
__device__ __forceinline__ int lds8(int r, int c) { return r * 128 + ((c ^ ((r >> 1) & 7)) << 4); }
#ifndef GEMM_VAR
#define GEMM_VAR 0
#endif
template <bool GATHER, int lda, int ldb, int K, int GV = 0, class Epi, class S>
__device__ __forceinline__ void gemm8_run(const unsigned char* __restrict__ A, const int* __restrict__ stok,
                                          LAS char* shm, const Epi& epi, const S& sched) {
#define G_SA(b, h) (shm + ((b) * 2 + (h)) * 16384)
#define G_SB(b, h) (shm + (4 + (b) * 2 + (h)) * 16384)
  int tid = threadIdx.x; asm volatile("" : "+v"(tid)); tid &= 511;
  int wid = tid >> 6, lane = tid & 63, wr = wid >> 2, wc = wid & 3, fr = lane & 15, fq = lane >> 4;
  unsigned ao0, ao1, ao2, ao3, bo;
  int R0 = 8 * wid + (lane >> 3), C0 = ((lane & 7) ^ ((R0 >> 1) & 7)) << 4;
  const int lo = __builtin_amdgcn_readfirstlane(tid >> 6) * 1024;
  int brow, bcol; const unsigned char* Bt;
  int ui = 0;
  if (!sched.unit(ui, brow, Bt, bcol)) return;
#define SETOFF(br, bc) do { if (GATHER) { const auto _g = sched.gather_tile(br); ao0 = (unsigned)(_g.tok(R0) * lda + C0); ao1 = (unsigned)(_g.tok(R0 + 64) * lda + C0); ao2 = (unsigned)(_g.tok(R0 + 128) * lda + C0); ao3 = (unsigned)(_g.tok(R0 + 192) * lda + C0); } \
    else { ao0 = (unsigned)(((br) + R0) * lda + C0); ao1 = ao0 + 64u * lda; ao2 = ao0 + 128u * lda; ao3 = ao0 + 192u * lda; } \
    bo = (unsigned)(((bc) + R0) * ldb + C0); } while (0)
#define SA0_1(P, kt) do { if (GV == 2) break; GLDS((A + (kt) * 128) + ao0, (P) + lo); } while (0)
#define SA0_2(P, kt) do { if (GV == 2) break; GLDS((A + (kt) * 128) + ao1, (P) + lo + 8192); } while (0)
#define SA1_1(P, kt) do { if (GV == 2) break; GLDS((A + (kt) * 128) + ao2, (P) + lo); } while (0)
#define SA1_2(P, kt) do { if (GV == 2) break; GLDS((A + (kt) * 128) + ao3, (P) + lo + 8192); } while (0)
#define SB0_1(P, kt) do { if (GV == 2) break; GLDS((Bt + (kt) * 128) + bo, (P) + lo); } while (0)
#define SB0_2(P, kt) do { if (GV == 2) break; GLDS((Bt + 64 * ldb + (kt) * 128) + bo, (P) + lo + 8192); } while (0)
#define SB1_1(P, kt) do { if (GV == 2) break; GLDS((Bt + 128 * ldb + (kt) * 128) + bo, (P) + lo); } while (0)
#define SB1_2(P, kt) do { if (GV == 2) break; GLDS((Bt + 192 * ldb + (kt) * 128) + bo, (P) + lo + 8192); } while (0)
#define STAGE_A0(P, kt) do { SA0_1(P, kt); SA0_2(P, kt); } while (0)
#define STAGE_A1(P, kt) do { SA1_1(P, kt); SA1_2(P, kt); } while (0)
#define STAGE_B0(P, kt) do { SB0_1(P, kt); SB0_2(P, kt); } while (0)
#define STAGE_B1(P, kt) do { SB1_1(P, kt); SB1_2(P, kt); } while (0)
#define PRO() do { STAGE_B0(G_SB(0, 0), 0); STAGE_A0(G_SA(0, 0), 0); STAGE_B1(G_SB(0, 1), 0); STAGE_A1(G_SA(0, 1), 0); } while (0)
  const int fx = (fq ^ ((fr >> 1) & 7)) << 4;
  const int fa0 = (wr * 64 + fr) * 128 + fx, fb0 = (wc * 32 + fr) * 128 + fx;
#define FRAG8(dst, p0, p1) do { const v4i _x = *(LAS const v4i*)(p0); const v4i _y = *(LAS const v4i*)(p1); \
    dst = (v8i){_x[0], _x[1], _x[2], _x[3], _y[0], _y[1], _y[2], _y[3]}; } while (0)
#define LDA(dst, b, h) do { int fa1 = fa0; asm volatile("v_xor_b32 %0, 64, %0" : "+v"(fa1)); \
    _Pragma("unroll") for (int m = 0; m < 4; ++m) FRAG8(dst[m], G_SA(b, h) + fa0 + m * 2048, G_SA(b, h) + fa1 + m * 2048); } while (0)
#define LDB(dst, b, h) do { int fb1 = fb0; asm volatile("v_xor_b32 %0, 64, %0" : "+v"(fb1)); \
    _Pragma("unroll") for (int n = 0; n < 2; ++n) FRAG8(dst[n], G_SB(b, h) + fb0 + n * 2048, G_SB(b, h) + fb1 + n * 2048); } while (0)
#define MF1(ai, bj, At_, Bt_, m, n) asm volatile("v_mfma_scale_f32_16x16x128_f8f6f4 %0, %1, %2, %0, %3, %3 op_sel_hi:[0,0,0]" : "+v"(acc[ai][bj][m][n]) : "v"(Bt_[n]), "v"(At_[m]), "v"(sc1))
#define MMA(ai, bj, At_, Bt_) do { __builtin_amdgcn_s_setprio(1); \
    _Pragma("unroll") for (int m = 0; m < 4; ++m) _Pragma("unroll") for (int n = 0; n < 2; ++n) MF1(ai, bj, At_, Bt_, m, n); \
    __builtin_amdgcn_s_setprio(0); } while (0)
#define MMA_S(ai, bj, At_, Bt_, ST1, ST2) do { __builtin_amdgcn_s_setprio(1); \
    MF1(ai, bj, At_, Bt_, 0, 0); MF1(ai, bj, At_, Bt_, 0, 1); SCHED; ST1; SCHED; \
    MF1(ai, bj, At_, Bt_, 1, 0); MF1(ai, bj, At_, Bt_, 1, 1); MF1(ai, bj, At_, Bt_, 2, 0); SCHED; ST2; SCHED; \
    MF1(ai, bj, At_, Bt_, 2, 1); MF1(ai, bj, At_, Bt_, 3, 0); MF1(ai, bj, At_, Bt_, 3, 1); \
    __builtin_amdgcn_s_setprio(0); } while (0)
  int sc1; asm volatile("v_mov_b32 %0, 0x7f7f7f7f" : "=v"(sc1));
  const int nt = K / 128;
  SETOFF(brow, bcol); PRO();
  bool first = true;
  for (;;) {
    f32x4 acc[2][2][4][2] = {};
    v8i At[4], B0[2], B1[2];
    if (wr == 1) BAR;
    constexpr int NST = (GV == 1 || GV == 2) ? 0 : (Epi::STAGE_ROWB == 256 ? 8 : (Epi::STAGE_ROWB == 128 ? 4 : 0));
    if (first) WAIT_V(4); else asm volatile("s_waitcnt vmcnt(%0)" :: "i"(NST) : "memory");
    BAR;
    STAGE_B0(G_SB(1, 0), 1); STAGE_A0(G_SA(1, 0), 1); STAGE_B1(G_SB(1, 1), 1);
    WAIT_V(6); BAR;
    static_assert(K >= 512, "the tail assumes the steady-state loop ran at least once");
    for (int t = 0; t < nt - 2; t += 2) {
      LDB(B0, 0, 0); SCHED; LDA(At, 0, 0);
      WAIT_L(8); BAR; WAIT_L(0); MMA_S(0, 0, At, B0, SA1_1(G_SA(1, 1), t + 1), SA1_2(G_SA(1, 1), t + 1)); BAR; SCHED;
      LDB(B1, 0, 1);
      BAR; WAIT_L(0); MMA_S(0, 1, At, B1, SB0_1(G_SB(0, 0), t + 2), SB0_2(G_SB(0, 0), t + 2)); BAR;
      LDA(At, 0, 1);
      BAR; WAIT_L(0); MMA_S(1, 0, At, B0, SA0_1(G_SA(0, 0), t + 2), SA0_2(G_SA(0, 0), t + 2)); BAR; SCHED;
      WAIT_V(4); BAR; MMA_S(1, 1, At, B1, SB1_1(G_SB(0, 1), t + 2), SB1_2(G_SB(0, 1), t + 2)); BAR;
      LDB(B0, 1, 0); SCHED; LDA(At, 1, 0);
      WAIT_L(8); BAR; WAIT_L(0); MMA_S(0, 0, At, B0, SA1_1(G_SA(0, 1), t + 2), SA1_2(G_SA(0, 1), t + 2)); BAR; SCHED;
      LDB(B1, 1, 1);
      BAR; WAIT_L(0); MMA_S(0, 1, At, B1, SB0_1(G_SB(1, 0), t + 3), SB0_2(G_SB(1, 0), t + 3)); BAR;
      LDA(At, 1, 1);
      BAR; WAIT_L(0); MMA_S(1, 0, At, B0, SA0_1(G_SA(1, 0), t + 3), SA0_2(G_SA(1, 0), t + 3)); BAR; SCHED;
      WAIT_V(4); BAR; MMA_S(1, 1, At, B1, SB1_1(G_SB(1, 1), t + 3), SB1_2(G_SB(1, 1), t + 3)); BAR;
    }
    { LDB(B0, 0, 0); LDA(At, 0, 0);
      BAR; WAIT_L(0); MMA_S(0, 0, At, B0, SA1_1(G_SA(1, 1), nt - 1), SA1_2(G_SA(1, 1), nt - 1)); BAR;
      LDB(B1, 0, 1); BAR; WAIT_L(0); MMA(0, 1, At, B1); BAR;
      LDA(At, 0, 1); WAIT_V(4); BAR; WAIT_L(0); MMA(1, 0, At, B0); MMA(1, 1, At, B1); BAR; }
    { LDB(B0, 1, 0); LDA(At, 1, 0); WAIT_V(2); BAR; WAIT_L(0); MMA(0, 0, At, B0); BAR;
      LDB(B1, 1, 1); WAIT_V(0); BAR; WAIT_L(0); MMA(0, 1, At, B1); BAR;
      LDA(At, 1, 1); BAR; WAIT_L(0); MMA(1, 0, At, B0); MMA(1, 1, At, B1); BAR; }
    if (wr == 0) BAR;
    const int cbrow = brow, cbcol = bcol;
    { int tz = threadIdx.x; asm volatile("" : "+v"(tz)); tz &= 511; wid = tz >> 6; lane = tz & 63; wr = wid >> 2; wc = wid & 3; fr = lane & 15; fq = lane >> 4;
      R0 = 8 * wid + (lane >> 3); C0 = ((lane & 7) ^ ((R0 >> 1) & 7)) << 4; }
    ++ui;
    const bool more = sched.unit(ui, brow, Bt, bcol);
    if (more) { SETOFF(brow, bcol); asm volatile("" ::: "memory"); PRO(); asm volatile("" ::: "memory"); }
    asm volatile("s_nop 15\n\ts_nop 15\n\ts_nop 7" ::: "memory");
#pragma unroll
    for (int i = 0; i < 32; ++i) asm volatile("" : "+v"((&acc[0][0][0][0])[i]));
    if (GV != 1 && GV != 2) {
      if constexpr (Epi::STAGE_ROWB == 256) {
#pragma unroll
        for (int ai = 0; ai < 2; ++ai)
#pragma unroll
          for (int m = 0; m < 4; ++m) { const int rloc = wr * 64 + m * 16 + fr;
#pragma unroll
            for (int bj = 0; bj < 2; ++bj) { const int c = wc * 2 + (fq >> 1) + bj * 8;
              *(LAS u32x2*)(shm + (ai ? 98304 : 32768) + rloc * 256 + ((c ^ (rloc & 15)) << 4) + (fq & 1) * 8) = epi.pack(acc, ai, m, bj); } }
        WAIT_L(0); BAR;
        unsigned char* Cb = epi.C + (size_t)cbrow * epi.ldc + epi.colbase(cbcol);
#pragma unroll
        for (int it = 0; it < 8; ++it) { const int row = it * 32 + wid * 4 + (lane >> 4), c = lane & 15, rloc = row & 127;
          const u32x4 v = *(LAS const u32x4*)(shm + (row & 128 ? 98304 : 32768) + rloc * 256 + ((c ^ (rloc & 15)) << 4));
          *(u32x4*)(Cb + (size_t)row * epi.ldc + c * 16) = v; }
      } else if constexpr (Epi::STAGE_ROWB == 128) {
#pragma unroll
        for (int ai = 0; ai < 2; ++ai)
#pragma unroll
          for (int m = 0; m < 4; ++m) { const int row = ai * 128 + wr * 64 + m * 16 + fr;
#pragma unroll
            for (int bj = 0; bj < 2; ++bj) { const int c = wc + 4 * bj;
              *(LAS unsigned*)(shm + 32768 + row * 128 + ((c ^ (row & 7)) << 4) + fq * 4) = epi.pack(acc, ai, m, bj); } }
        WAIT_L(0); BAR;
        unsigned char* Cb = epi.C + (size_t)cbrow * epi.ldc + epi.colbase(cbcol);
#pragma unroll
        for (int it = 0; it < 4; ++it) { const int row = it * 64 + wid * 8 + (lane >> 3), c = lane & 7;
          const u32x4 v = *(LAS const u32x4*)(shm + 32768 + row * 128 + ((c ^ (row & 7)) << 4));
          *(u32x4*)(Cb + (size_t)row * epi.ldc + c * 16) = v; }
      } else epi(acc, cbrow, cbcol, wr, wc, fr, fq);
    }
    if (!more) break;
    first = false;
  }
#undef G_SA
#undef G_SB
#undef SETOFF
#undef STAGE_A0
#undef STAGE_A1
#undef STAGE_B0
#undef STAGE_B1
#undef PRO
#undef FRAG8
#undef LDA
#undef LDB
#undef MMA
}
__device__ __forceinline__ float clamp8(float x) { return fminf(fmaxf(x, -448.f), 448.f); }
__device__ __forceinline__ unsigned pack_fp8x4(float a, float b, float c, float d) {
  int p = __builtin_amdgcn_cvt_pk_fp8_f32(clamp8(a), clamp8(b), 0, false); p = __builtin_amdgcn_cvt_pk_fp8_f32(clamp8(c), clamp8(d), p, true); return (unsigned)p; }
struct EpiSwiGLU8 {
  unsigned char* C; int ldc;
  static constexpr int STAGE_ROWB = 128;
  __device__ __forceinline__ int colbase(int bcol) const { return bcol >> 1; }
  __device__ __forceinline__ unsigned pack(const f32x4 (&acc)[2][2][4][2], int ai, int m, int bj) const {
    constexpr float S = 1.f / 256.f; float r[4];
#pragma unroll
    for (int j = 0; j < 4; ++j) { const float g = acc[ai][bj][m][0][j] * S, u = acc[ai][bj][m][1][j] * S; r[j] = g * sigmoid_fast(g) * u; }
    return pack_fp8x4(r[0], r[1], r[2], r[3]); }
  __device__ __forceinline__ void operator()(const f32x4 (&acc)[2][2][4][2], int brow, int bcol, int wr, int wc, int fr, int fq) const {
    constexpr float S = 1.f / 256.f;
#pragma unroll
    for (int ai = 0; ai < 2; ++ai)
#pragma unroll
      for (int m = 0; m < 4; ++m) {
        unsigned char* rp = C + (size_t)(brow + ai * 128 + wr * 64 + m * 16 + fr) * ldc + (bcol >> 1) + wc * 16 + fq * 4;
#pragma unroll
        for (int bj = 0; bj < 2; ++bj) {
          float r[4];
#pragma unroll
          for (int j = 0; j < 4; ++j) { const float g = acc[ai][bj][m][0][j] * S, u = acc[ai][bj][m][1][j] * S; r[j] = g * sigmoid_fast(g) * u; }
          *(unsigned*)(rp + bj * 64) = pack_fp8x4(r[0], r[1], r[2], r[3]);
        }
      }
  }
};
struct EpiPlain8 {
  unsigned char* C; int ldc; float sc;
  static constexpr int STAGE_ROWB = 256;
  __device__ __forceinline__ int colbase(int bcol) const { return bcol; }
  __device__ __forceinline__ u32x2 pack(const f32x4 (&acc)[2][2][4][2], int ai, int m, int bj) const {
    return (u32x2){pack_fp8x4(acc[ai][bj][m][0][0] * sc, acc[ai][bj][m][0][1] * sc, acc[ai][bj][m][0][2] * sc, acc[ai][bj][m][0][3] * sc),
                   pack_fp8x4(acc[ai][bj][m][1][0] * sc, acc[ai][bj][m][1][1] * sc, acc[ai][bj][m][1][2] * sc, acc[ai][bj][m][1][3] * sc)}; }
  __device__ __forceinline__ void operator()(const f32x4 (&acc)[2][2][4][2], int brow, int bcol, int wr, int wc, int fr, int fq) const {
#pragma unroll
    for (int ai = 0; ai < 2; ++ai)
#pragma unroll
      for (int m = 0; m < 4; ++m) {
        unsigned char* rp = C + (size_t)(brow + ai * 128 + wr * 64 + m * 16 + fr) * ldc + bcol + wc * 32 + fq * 8;
#pragma unroll
        for (int bj = 0; bj < 2; ++bj) {
          u32x2 v = {pack_fp8x4(acc[ai][bj][m][0][0] * sc, acc[ai][bj][m][0][1] * sc, acc[ai][bj][m][0][2] * sc, acc[ai][bj][m][0][3] * sc),
                     pack_fp8x4(acc[ai][bj][m][1][0] * sc, acc[ai][bj][m][1][1] * sc, acc[ai][bj][m][1][2] * sc, acc[ai][bj][m][1][3] * sc)};
          *(u32x2*)(rp + bj * 128) = v;
        }
      }
  }
};
struct EpiPlainS {
  bf16_t* C; int ldc; float sc;
  __device__ __forceinline__ void operator()(const f32x4 (&acc)[2][2][4][2], int brow, int bcol, int wr, int wc, int fr, int fq) const {
#pragma unroll
    for (int ai = 0; ai < 2; ++ai)
#pragma unroll
      for (int m = 0; m < 4; ++m) {
        bf16_t* rp = C + (size_t)(brow + ai * 128 + wr * 64 + m * 16 + fr) * ldc + bcol + wc * 32 + fq * 8;
#pragma unroll
        for (int bj = 0; bj < 2; ++bj) {
          u32x4 v = {cvtpk(acc[ai][bj][m][0][0] * sc, acc[ai][bj][m][0][1] * sc), cvtpk(acc[ai][bj][m][0][2] * sc, acc[ai][bj][m][0][3] * sc),
                     cvtpk(acc[ai][bj][m][1][0] * sc, acc[ai][bj][m][1][1] * sc), cvtpk(acc[ai][bj][m][1][2] * sc, acc[ai][bj][m][1][3] * sc)};
          *(u32x4*)(rp + bj * 128) = v;
        }
      }
  }
};

__device__ __forceinline__ void dense_unit(int u, int nM, int nN, int& pm, int& pn) {
  const int nwg = nM * nN, NX = 8, WGM = 8;
  int wgid = u;
  { const int q = nwg / NX, r = nwg % NX, xcd = wgid % NX, off = wgid / NX; wgid = (xcd < r ? xcd * (q + 1) : r * (q + 1) + (xcd - r) * q) + off; }
  const int nig = WGM * nN, gid = wgid / nig, fm = gid * WGM, gsz = min(nM - fm, WGM);
  pm = fm + ((wgid % nig) % gsz); pn = (wgid % nig) / gsz;
}

namespace at {
constexpr int DH = 128, NW = 8, QBLK = 32, KVBLK = 64;
constexpr float SCALE = 0.088388347648318440f;
constexpr float QC = SCALE * 1.4426950408889634f;
constexpr int SHM_V = KVBLK * DH * 2, SHM_K = KVBLK * DH * 2;
#define KSWZ(row, colB) ((row) * 256 + ((colB) ^ (((row) & 7) << 4)))
__device__ __forceinline__ int crow(int r, int hi) { return (r & 3) + 8 * (r >> 2) + 4 * hi; }
__device__ __forceinline__ unsigned cvtpkv(float lo, float hi) { unsigned r; asm volatile("v_cvt_pk_bf16_f32 %0, %1, %2" : "=v"(r) : "v"(lo), "v"(hi)); return r; }
#define PK4(P, BASE, OUT) do { unsigned a0 = cvtpkv(P[BASE + 0], P[BASE + 1]), a1 = cvtpkv(P[BASE + 2], P[BASE + 3]);   \
    unsigned b0 = cvtpkv(P[BASE + 4], P[BASE + 5]), b1 = cvtpkv(P[BASE + 6], P[BASE + 7]);                              \
    auto r0 = __builtin_amdgcn_permlane32_swap(a0, b0, false, false); auto r1 = __builtin_amdgcn_permlane32_swap(a1, b1, false, false); \
    u32x4 w = {r0[0], r1[0], r0[1], r1[1]}; OUT = *reinterpret_cast<bf16x8*>(&w); } while (0)
__device__ __forceinline__ float load_q(const bf16_t* __restrict__ Qw, bf16x8 (&qr)[8], float kmax2) {
  float ss = 0;
#pragma unroll
  for (int d0 = 0; d0 < 8; ++d0) {
    const u32x4 raw = *reinterpret_cast<const u32x4*>(Qw + d0 * 16); u32x4 o;
#pragma unroll
    for (int i = 0; i < 4; ++i) { const unsigned pk = cvtpk(bflo(raw[i]) * QC, bfhi(raw[i]) * QC); o[i] = pk; const float a = bflo(pk), b = bfhi(pk); ss += a * a + b * b; }
    qr[d0] = *reinterpret_cast<bf16x8*>(&o);
  }
  { auto rr = __builtin_amdgcn_permlane32_swap(__float_as_uint(ss), __float_as_uint(ss), false, false); ss = __uint_as_float(rr[0]) + __uint_as_float(rr[1]); }
  return -(sqrtf(ss * kmax2) * 1.01f + 1e-3f);
}
__device__ __forceinline__ void exp16(f32x16& p) {
#pragma unroll
  for (int r = 0; r < 16; ++r) p[r] = __builtin_amdgcn_exp2f(p[r]);
}
__device__ __forceinline__ float sum16(const f32x16& p) { float s = 0;
#pragma unroll
  for (int r = 0; r < 16; ++r) s += p[r];
  return s; }
__device__ __forceinline__ void qkt(f32x16& p0, f32x16& p1, LAS const char* Ks, const bf16x8* qr, int r32, int hi, float nmc) {
#pragma unroll
  for (int r = 0; r < 16; ++r) { p0[r] = nmc; p1[r] = nmc; }
#pragma unroll
  for (int d0 = 0; d0 < 8; ++d0) { int cb = (d0 * 16 + hi * 8) * 2;
    bf16x8 b0 = *(LAS const bf16x8*)(Ks + KSWZ(r32, cb));
    bf16x8 b1 = *(LAS const bf16x8*)(Ks + KSWZ(32 + r32, cb));
    p0 = __builtin_amdgcn_mfma_f32_32x32x16_bf16(b0, qr[d0], p0, 0, 0, 0);
    p1 = __builtin_amdgcn_mfma_f32_32x32x16_bf16(b1, qr[d0], p1, 0, 0, 0); }
}
__device__ __forceinline__ int v_st(int k, int c) { const int kk = (k & ~0xC) | ((k & 4) << 1) | ((k & 8) >> 1); return ((kk >> 3) * 4 + (c >> 5)) * 512 + ((kk & 7) * 32 + (c & 31)) * 2; }
__device__ __forceinline__ int v_st256(int k, int c) { const int kk = (k & ~0xC) | ((k & 4) << 1) | ((k & 8) >> 1); return ((kk >> 3) * 8 + (c >> 5)) * 512 + ((kk & 7) * 32 + (c & 31)) * 2; }
__device__ __forceinline__ int v_rd_base(int lane) { return ((lane & 3) << 3) | (((lane >> 2) & 3) << 6) | (((lane >> 4) & 1) << 5) | (((lane >> 5) & 1) << 8); }
template <int OFF> __device__ __forceinline__ s16x4 tr_read(int vb) {
  s16x4 r; asm volatile("ds_read_b64_tr_b16 %0, %1 offset:%2" : "=&v"(r) : "v"(vb), "i"(OFF) : "memory"); return r;
}
template <int BASE, int KS, int HS> __device__ __forceinline__ void pv_one(f32x16& od, int vb, bf16x8 pa0, bf16x8 pa1, bf16x8 pa2, bf16x8 pa3) {
  const s16x4 l0 = tr_read<BASE>(vb), h0 = tr_read<BASE + HS>(vb), l1 = tr_read<BASE + KS>(vb), h1 = tr_read<BASE + KS + HS>(vb);
  const s16x4 l2 = tr_read<BASE + 2 * KS>(vb), h2 = tr_read<BASE + 2 * KS + HS>(vb), l3 = tr_read<BASE + 3 * KS>(vb), h3 = tr_read<BASE + 3 * KS + HS>(vb);
  asm volatile("s_waitcnt lgkmcnt(0)" ::: "memory"); SCHED;
#define PK(L, H) (bf16x8){L[0], L[1], L[2], L[3], H[0], H[1], H[2], H[3]}
  od = __builtin_amdgcn_mfma_f32_32x32x16_bf16(pa0, PK(l0, h0), od, 0, 0, 0);
  od = __builtin_amdgcn_mfma_f32_32x32x16_bf16(pa1, PK(l1, h1), od, 0, 0, 0);
  od = __builtin_amdgcn_mfma_f32_32x32x16_bf16(pa2, PK(l2, h2), od, 0, 0, 0);
  od = __builtin_amdgcn_mfma_f32_32x32x16_bf16(pa3, PK(l3, h3), od, 0, 0, 0);
#undef PK
}
__device__ __forceinline__ void pv_d0(f32x16* o, int vb, bf16x8 pa0, bf16x8 pa1, bf16x8 pa2, bf16x8 pa3) {
  pv_one<0, 4096, 2048>(o[0], vb, pa0, pa1, pa2, pa3); pv_one<512, 4096, 2048>(o[1], vb, pa0, pa1, pa2, pa3);
  pv_one<1024, 4096, 2048>(o[2], vb, pa0, pa1, pa2, pa3); pv_one<1536, 4096, 2048>(o[3], vb, pa0, pa1, pa2, pa3);
}
__device__ __forceinline__ void pv_d0_256(f32x16* o, int vb, bf16x8 pa0, bf16x8 pa1, bf16x8 pa2, bf16x8 pa3) {
  pv_one<0, 8192, 4096>(o[0], vb, pa0, pa1, pa2, pa3); pv_one<512, 8192, 4096>(o[1], vb, pa0, pa1, pa2, pa3);
  pv_one<1024, 8192, 4096>(o[2], vb, pa0, pa1, pa2, pa3); pv_one<1536, 8192, 4096>(o[3], vb, pa0, pa1, pa2, pa3);
}
__device__ __forceinline__ void store_o8(const f32x16* o, float l_tot, LAS float* li, unsigned char* __restrict__ Ow, int ldo, int r32, int hi) {
  if (hi == 0) li[r32] = l_tot; asm volatile("s_waitcnt lgkmcnt(0)" ::: "memory");
  float rli[16];
#pragma unroll
  for (int r = 0; r < 16; ++r) rli[r] = 8.f * __builtin_amdgcn_rcpf(li[crow(r, hi)]);
#pragma unroll
  for (int r = 0; r < 16; ++r) { const int orow = crow(r, hi);
#pragma unroll
    for (int d0 = 0; d0 < 4; ++d0) Ow[(long)orow * ldo + d0 * 32 + r32] = (unsigned char)__builtin_amdgcn_cvt_pk_fp8_f32(o[d0][r] * rli[r], 0.f, 0, false); }
}
__device__ __forceinline__ void store_o(const f32x16* o, float l_tot, LAS float* li, bf16_t* __restrict__ Ow, int ldo, int r32, int hi) {
  if (hi == 0) li[r32] = l_tot; asm volatile("s_waitcnt lgkmcnt(0)" ::: "memory");
  float rli[16];
#pragma unroll
  for (int r = 0; r < 16; ++r) rli[r] = __builtin_amdgcn_rcpf(li[crow(r, hi)]);
#pragma unroll
  for (int r = 0; r < 16; ++r) { const int orow = crow(r, hi);
#pragma unroll
    for (int d0 = 0; d0 < 4; ++d0) Ow[(long)orow * ldo + d0 * 32 + r32] = f2bf(o[d0][r] * rli[r]); }
}

__device__ __forceinline__ int unswap23(int kk) { return (kk & ~0xC) | ((kk & 4) << 1) | ((kk & 8) >> 1); }
__device__ __forceinline__ int k_dma_voff(int wid, int lane, int ldk) {
  const int row = 4 * wid + (lane >> 4); return row * ldk * 2 + (((lane & 15) * 16) ^ ((row & 7) << 4)); }
#define DMA16(rs, ldsp, voff, soff) __builtin_amdgcn_raw_ptr_buffer_load_lds(rs, (LAS void*)(ldsp), 16, voff, soff, 0, 0)

constexpr int SHM_T = SHM_K + SHM_V;
__device__ __forceinline__ void attn_body(const bf16_t* __restrict__ Qb, const int ldq, const bf16_t* __restrict__ Kh, const bf16_t* __restrict__ Vh, const int ldk,
                                          bf16_t* __restrict__ Ob, const int ldo, const int seq, const float kmax2, LAS char* lds) {
  int tid = threadIdx.x; asm volatile("" : "+v"(tid)); tid &= 511;
  const int wid = tid >> 6, lane = tid & 63, r32 = lane & 31, hi = lane >> 5;
  LAS float* li_l = (LAS float*)(lds + 3 * SHM_T) + wid * 64;
  float l_reg = 0; f32x16 o[4] = {}; bf16x8 qr[8];
  const float nmc = load_q(Qb + (long)(wid * QBLK + r32) * ldq + hi * 8, qr, kmax2);
  const int vrb = v_rd_base(lane);
  const int kvo = k_dma_voff(wid, lane, ldk);
  const int vvo = unswap23(8 * (wid >> 1) + ((lane & 31) >> 2)) * ldk * 2 + ((2 * (wid & 1) + (lane >> 5)) * 32 + (lane & 3) * 8) * 2;
  const int l32 = 64 * ldk, pz = wid * 1024;
  const __amdgpu_buffer_rsrc_t krs = __builtin_amdgcn_make_buffer_rsrc((void*)Kh, 0, 0x7ffffff0, 0x00020000);
  const __amdgpu_buffer_rsrc_t vrs = __builtin_amdgcn_make_buffer_rsrc((void*)Vh, 0, 0x7ffffff0, 0x00020000);
#define TDMA(slot, k0) do { const int _o = (k0) * ldk * 2; LAS char* _b = lds + (slot) * SHM_T + pz; \
    DMA16(krs, _b, kvo, _o); DMA16(krs, _b + 8192, kvo, _o + l32); DMA16(vrs, _b + SHM_K, vvo, _o); DMA16(vrs, _b + SHM_K + 8192, vvo, _o + l32); } while (0)
#define VM0() asm volatile("s_waitcnt vmcnt(0)" ::: "memory")
#define FINISH(P0, P1) do { exp16(P1); l_reg += sum16(P0) + sum16(P1); PK4(P0, 0, pa0); PK4(P0, 8, pa1); PK4(P1, 0, pa2); PK4(P1, 8, pa3); } while (0)
  f32x16 pA0, pA1, pB0, pB1; bf16x8 pa0, pa1, pa2, pa3; const int NT = seq / KVBLK;
  TDMA(0, 0); VM0(); __syncthreads();
  TDMA(1, KVBLK);
  qkt(pA0, pA1, lds, qr, r32, hi, nmc); exp16(pA0);
  VM0(); __syncthreads();
  int sk = 1, sv = 0, sd = 2;
  for (int j = 1; j + 1 < NT; j += 2) {
    TDMA(sd, (j + 1) * KVBLK);
    SCHED; qkt(pB0, pB1, lds + sk * SHM_T, qr, r32, hi, nmc);
    FINISH(pA0, pA1); SCHED;
    pv_d0(o, (int)(uintptr_t)(lds + sv * SHM_T + SHM_K) + vrb, pa0, pa1, pa2, pa3); exp16(pB0);
    VM0(); __syncthreads();
    { const int t = sv; sv = sk; sk = sd; sd = t; }
    if (j + 2 < NT) TDMA(sd, (j + 2) * KVBLK);
    SCHED; qkt(pA0, pA1, lds + sk * SHM_T, qr, r32, hi, nmc);
    FINISH(pB0, pB1); SCHED;
    pv_d0(o, (int)(uintptr_t)(lds + sv * SHM_T + SHM_K) + vrb, pa0, pa1, pa2, pa3); exp16(pA0);
    VM0(); __syncthreads();
    { const int t = sv; sv = sk; sk = sd; sd = t; }
  }
  SCHED; qkt(pB0, pB1, lds + sk * SHM_T, qr, r32, hi, nmc);
  FINISH(pA0, pA1); SCHED;
  pv_d0(o, (int)(uintptr_t)(lds + sv * SHM_T + SHM_K) + vrb, pa0, pa1, pa2, pa3); exp16(pB0);
  FINISH(pB0, pB1); SCHED;
  pv_d0(o, (int)(uintptr_t)(lds + sk * SHM_T + SHM_K) + vrb, pa0, pa1, pa2, pa3);
  { auto rr = __builtin_amdgcn_permlane32_swap(__float_as_uint(l_reg), __float_as_uint(l_reg), false, false); l_reg = __uint_as_float(rr[0]) + __uint_as_float(rr[1]); }
  store_o(o, l_reg, li_l, Ob + (long)(wid * QBLK) * ldo, ldo, r32, hi);
  VM0();
  __syncthreads();
#undef TDMA
#undef FINISH
}

constexpr int SHM_V2 = KVBLK * 256 * 2;
__device__ __forceinline__ void attn_body_dv256(const bf16_t* __restrict__ Qb, const int ldq, const bf16_t* __restrict__ Kh, const bf16_t* __restrict__ Vh, const int ldk,
                                                bf16_t* __restrict__ Ob, const int ldo, const int seq, const float kmax2, LAS char* lds) {
  int tid = threadIdx.x; asm volatile("" : "+v"(tid)); tid &= 511;
  const int wid = tid >> 6, lane = tid & 63, r32 = lane & 31, hi = lane >> 5, rg = wid >> 1, kh = wid & 1;
  LAS char* K_lds = lds; LAS char* V_lds = lds + 2 * SHM_K; LAS char* X_lds = lds + 2 * SHM_K + 2 * SHM_V2;
  float l_reg = 0; f32x16 o[4] = {}; bf16x8 qr[8];
  const float nmc = load_q(Qb + (long)(rg * QBLK + r32) * ldq + hi * 8, qr, kmax2);
  const int vb0 = (int)(uintptr_t)V_lds + v_rd_base(lane) + kh * 2048;
  const int kvo = k_dma_voff(wid, lane, ldk);
  const int vvo = unswap23(8 * (wid >> 2) + ((lane & 31) >> 2)) * ldk * 2 + ((2 * (wid & 3) + (lane >> 5)) * 32 + (lane & 3) * 8) * 2;
  const int l32 = 64 * ldk, l16 = 32 * ldk, pz = wid * 1024;
  const int xw = (rg * 4 + kh * 2) * 1024 + lane * 16, xr = rg * 4096 + lane * 16;
  const __amdgpu_buffer_rsrc_t krs = __builtin_amdgcn_make_buffer_rsrc((void*)Kh, 0, 0x7ffffff0, 0x00020000);
  const __amdgpu_buffer_rsrc_t vrs = __builtin_amdgcn_make_buffer_rsrc((void*)Vh, 0, 0x7ffffff0, 0x00020000);
#define KDMA(b, k0) do { const int _o = (k0) * ldk * 2; LAS char* _b = K_lds + (b) * SHM_K + pz; DMA16(krs, _b, kvo, _o); DMA16(krs, _b + 8192, kvo, _o + l32); } while (0)
#define VDMA(b, k0) do { const int _o = (k0) * ldk * 2; LAS char* _b = V_lds + (b) * SHM_V2 + pz; DMA16(vrs, _b, vvo, _o); DMA16(vrs, _b + 8192, vvo, _o + l16); \
    DMA16(vrs, _b + 16384, vvo, _o + 2 * l16); DMA16(vrs, _b + 24576, vvo, _o + 3 * l16); } while (0)
  f32x16 pA, pB; bf16x8 pa0, pa1, pa2, pa3, own0, own1; const int NT = seq / KVBLK;
  const int kxor = ((32 * kh + r32) & 7) << 4, krb = (32 * kh + r32) * 256;
#define QKHALF(P, b) do { _Pragma("unroll") for (int r = 0; r < 16; ++r) P[r] = nmc; \
    _Pragma("unroll") for (int d0 = 0; d0 < 8; ++d0) { const bf16x8 bk = *(LAS const bf16x8*)(K_lds + (b) * SHM_K + krb + (((d0 * 16 + hi * 8) * 2) ^ kxor)); \
      P = __builtin_amdgcn_mfma_f32_32x32x16_bf16(bk, qr[d0], P, 0, 0, 0); } } while (0)
#define FINH(P) do { exp16(P); l_reg += sum16(P); PK4(P, 0, own0); PK4(P, 8, own1); } while (0)
#define XWRITE(b) do { *(LAS bf16x8*)(X_lds + (b) * 16384 + xw) = own0; *(LAS bf16x8*)(X_lds + (b) * 16384 + xw + 1024) = own1; } while (0)
#define XREAD(b) do { pa0 = *(LAS const bf16x8*)(X_lds + (b) * 16384 + xr); pa1 = *(LAS const bf16x8*)(X_lds + (b) * 16384 + xr + 1024); \
    pa2 = *(LAS const bf16x8*)(X_lds + (b) * 16384 + xr + 2048); pa3 = *(LAS const bf16x8*)(X_lds + (b) * 16384 + xr + 3072); } while (0)
#define STEP(PA, PB, b, j) do { \
    SCHED; if ((j) + 1 < NT) QKHALF(PB, (b) ^ 1); FINH(PA); SCHED; \
    XWRITE(b); VM0(); __syncthreads(); \
    if ((j) + 3 < NT) KDMA((b) ^ 1, ((j) + 3) * KVBLK); if ((j) + 1 < NT) VDMA((b) ^ 1, ((j) + 1) * KVBLK); \
    XREAD(b); \
    pv_d0_256(o, vb0 + (b) * SHM_V2, pa0, pa1, pa2, pa3); } while (0)
  KDMA(0, 0); KDMA(1, KVBLK); VDMA(0, 0); VM0(); __syncthreads();
  QKHALF(pA, 0);
  __syncthreads();
  if (2 < NT) KDMA(0, 2 * KVBLK);
  for (int j = 0; j < NT; j += 2) { STEP(pA, pB, 0, j); STEP(pB, pA, 1, j + 1); }
  __syncthreads();
  LAS float* lx = (LAS float*)X_lds;
  lx[wid * 64 + lane] = l_reg; __syncthreads();
  const float l_tot = lx[wid * 64 + r32] + lx[wid * 64 + 32 + r32] + lx[(wid ^ 1) * 64 + r32] + lx[(wid ^ 1) * 64 + 32 + r32];
  store_o(o, l_tot, lx + 512 + wid * 32, Ob + (long)(rg * QBLK) * ldo + kh * 128, ldo, r32, hi);
  VM0();
  __syncthreads();
#undef KDMA
#undef VDMA
#undef QKHALF
#undef FINH
#undef XWRITE
#undef XREAD
#undef STEP
#undef VM0
}

#define LGK(n) asm volatile("s_waitcnt lgkmcnt(" #n ")" ::: "memory")
template <int OFF> __device__ __forceinline__ bf16x8 k_read(int ka) { bf16x8 r; asm volatile("ds_read_b128 %0, %1 offset:%2" : "=&v"(r) : "v"(ka), "i"(OFF) : "memory"); return r; }
struct VSet { s16x4 l0, h0, l1, h1; };
template <int OFF> __device__ __forceinline__ void v_read(VSet& s, int vb) { s.l0 = tr_read<OFF>(vb); s.h0 = tr_read<OFF + 4096>(vb); s.l1 = tr_read<OFF + 8192>(vb); s.h1 = tr_read<OFF + 12288>(vb); }
__device__ __forceinline__ void pv2(f32x16& oa, const VSet& s, bf16x8 pa0, bf16x8 pa1) {
#define PK(L, H) (bf16x8){L[0], L[1], L[2], L[3], H[0], H[1], H[2], H[3]}
  oa = __builtin_amdgcn_mfma_f32_32x32x16_bf16(pa0, PK(s.l0, s.h0), oa, 0, 0, 0);
  oa = __builtin_amdgcn_mfma_f32_32x32x16_bf16(pa1, PK(s.l1, s.h1), oa, 0, 0, 0);
#undef PK
}
template <bool SHIFT>
__device__ __forceinline__ void attn_body_c256_t(const bf16_t* __restrict__ Qb, const int ldq, const bf16_t* __restrict__ Kh, const bf16_t* __restrict__ Vh, const int ldk,
                                                 bf16_t* __restrict__ Ob, const int ldo, const int seq, const float nmc, const bf16x8 (&qr)[8], LAS char* lds) {
  int tid = threadIdx.x; asm volatile("" : "+v"(tid)); tid &= 511;
  const int wid = __builtin_amdgcn_readfirstlane(tid >> 6), lane = tid & 63, r32 = lane & 31, hi = lane >> 5;
  LAS char* K_lds = lds; LAS char* V_lds = lds + 2 * SHM_K;
  LAS float* li_l = (LAS float*)(lds + 2 * SHM_K + 2 * SHM_V2) + wid * 64;
  float l_reg = 0; f32x16 o[8] = {};
  const int vb0 = (int)(uintptr_t)V_lds + v_rd_base(lane);
  const int kvo = k_dma_voff(wid, lane, ldk);
  const int vvo = unswap23(8 * (wid >> 2) + ((lane & 31) >> 2)) * ldk * 2 + ((2 * (wid & 3) + (lane >> 5)) * 32 + (lane & 3) * 8) * 2;
  const int l32 = 64 * ldk, l16 = 32 * ldk, pz = wid * 1024;
  const __amdgpu_buffer_rsrc_t krs = __builtin_amdgcn_make_buffer_rsrc((void*)Kh, 0, 0x7ffffff0, 0x00020000);
  const __amdgpu_buffer_rsrc_t vrs = __builtin_amdgcn_make_buffer_rsrc((void*)Vh, 0, 0x7ffffff0, 0x00020000);
#define VM0() asm volatile("s_waitcnt vmcnt(0)" ::: "memory")
#define KVDMA(b, k0) do { const int _o = (k0) * ldk * 2; LAS char* _k = K_lds + (b) * SHM_K + pz; LAS char* _v = V_lds + (b) * SHM_V2 + pz; \
    DMA16(krs, _k, kvo, _o); DMA16(krs, _k + 8192, kvo, _o + l32); DMA16(vrs, _v, vvo, _o); DMA16(vrs, _v + 8192, vvo, _o + l16); \
    DMA16(vrs, _v + 16384, vvo, _o + 2 * l16); DMA16(vrs, _v + 24576, vvo, _o + 3 * l16); } while (0)
  int ka[8];
  { const int kxor = (r32 & 7) << 4, krb = (int)(uintptr_t)K_lds + r32 * 256;
#pragma unroll
    for (int d0 = 0; d0 < 8; ++d0) ka[d0] = krb + (((d0 * 16 + hi * 8) * 2) ^ kxor); }
  f32x16 P; bf16x8 pa0, pa1, f0, f1, f2, f3; VSet va, vb_, vc;
  const int NT = seq / KVBLK;
#define PINIT() do { _Pragma("unroll") for (int r = 0; r < 16; ++r) { float _z; asm volatile("v_mov_b32 %0, %1" : "=v"(_z) : "v"(SHIFT ? nmc : 0.f)); P[r] = _z; } } while (0)
#define KOFF(b, h) ((b) * 16384 + (h) * 8192)
#define VOFF(b, h, d0) ((b) * 32768 + (h) * 16384 + (d0) * 512)
#define KPRO(b, h) do { f0 = k_read<KOFF(b, h)>(ka[0]); f1 = k_read<KOFF(b, h)>(ka[1]); f2 = k_read<KOFF(b, h)>(ka[2]); } while (0)
#define QKM(F, d0) do { SCHED; P = __builtin_amdgcn_mfma_f32_32x32x16_bf16(F, qr[d0], P, 0, 0, 0); SCHED; } while (0)
#define QKHALF(b, h) do { PINIT(); \
    LGK(2); QKM(f0, 0); f3 = k_read<KOFF(b, h)>(ka[3]); \
    LGK(2); QKM(f1, 1); f0 = k_read<KOFF(b, h)>(ka[4]); \
    LGK(2); QKM(f2, 2); f1 = k_read<KOFF(b, h)>(ka[5]); \
    LGK(2); QKM(f3, 3); f2 = k_read<KOFF(b, h)>(ka[6]); \
    LGK(2); QKM(f0, 4); f3 = k_read<KOFF(b, h)>(ka[7]); \
    LGK(2); QKM(f1, 5); v_read<VOFF(b, h, 0)>(va, vb0); \
    LGK(5); QKM(f2, 6); v_read<VOFF(b, h, 1)>(vb_, vb0); \
    LGK(8); QKM(f3, 7); } while (0)
#define SMH() do { exp16(P); l_reg += sum16(P); PK4(P, 0, pa0); PK4(P, 8, pa1); } while (0)
#define PVM(S, d0) do { SCHED; pv2(o[d0], S, pa0, pa1); SCHED; } while (0)
#define PVHALF(b, h, NEXTK, nb, nh) do { \
    LGK(4); PVM(va, 0); v_read<VOFF(b, h, 2)>(vc, vb0); \
    LGK(4); PVM(vb_, 1); v_read<VOFF(b, h, 3)>(va, vb0); \
    LGK(4); PVM(vc, 2); v_read<VOFF(b, h, 4)>(vb_, vb0); \
    LGK(4); PVM(va, 3); v_read<VOFF(b, h, 5)>(vc, vb0); \
    LGK(4); PVM(vb_, 4); v_read<VOFF(b, h, 6)>(va, vb0); \
    LGK(4); PVM(vc, 5); v_read<VOFF(b, h, 7)>(vb_, vb0); \
    LGK(4); PVM(va, 6); if (NEXTK) { f0 = k_read<KOFF(nb, nh)>(ka[0]); f1 = k_read<KOFF(nb, nh)>(ka[1]); } \
    if (NEXTK) { LGK(2); } else { LGK(0); } PVM(vb_, 7); if (NEXTK) { f2 = k_read<KOFF(nb, nh)>(ka[2]); } } while (0)
#define STEPC(b, j) do { if ((j) + 1 < NT) KVDMA((b) ^ 1, ((j) + 1) * KVBLK); \
    KPRO(b, 0); QKHALF(b, 0); SMH(); PVHALF(b, 0, true, b, 1); \
    QKHALF(b, 1); SMH(); PVHALF(b, 1, false, 0, 0); \
    VM0(); __syncthreads(); } while (0)
  KVDMA(0, 0); VM0(); __syncthreads();
  for (int j = 0; j < NT; j += 2) { STEPC(0, j); STEPC(1, j + 1); }
  { auto rr = __builtin_amdgcn_permlane32_swap(__float_as_uint(l_reg), __float_as_uint(l_reg), false, false); l_reg = __uint_as_float(rr[0]) + __uint_as_float(rr[1]); }
  if (hi == 0) li_l[r32] = l_reg; asm volatile("s_waitcnt lgkmcnt(0)" ::: "memory");
  bf16_t* Ow = Ob + (long)(wid * QBLK) * ldo;
#pragma unroll
  for (int r = 0; r < 16; ++r) { const int orow = crow(r, hi); const float rl = __builtin_amdgcn_rcpf(li_l[orow]);
#pragma unroll
    for (int d0 = 0; d0 < 8; ++d0) Ow[(long)orow * ldo + d0 * 32 + r32] = f2bf(o[d0][r] * rl); }
  VM0();
  __syncthreads();
#undef KVDMA
#undef PINIT
#undef KOFF
#undef VOFF
#undef KPRO
#undef QKM
#undef QKHALF
#undef SMH
#undef PVM
#undef PVHALF
#undef STEPC
#undef VM0
}
__device__ __forceinline__ void attn_body_c256(const bf16_t* __restrict__ Qb, const int ldq, const bf16_t* __restrict__ Kh, const bf16_t* __restrict__ Vh, const int ldk,
                                               bf16_t* __restrict__ Ob, const int ldo, const int seq, const float kmax2, LAS char* lds) {
  int tid = threadIdx.x; asm volatile("" : "+v"(tid)); tid &= 511;
  const int wid = tid >> 6, lane = tid & 63, r32 = lane & 31, hi = lane >> 5;
  bf16x8 qr[8];
  const float nmc = load_q(Qb + (long)(wid * QBLK + r32) * ldq + hi * 8, qr, kmax2);
  if (__all(nmc > -64.f)) attn_body_c256_t<false>(Qb, ldq, Kh, Vh, ldk, Ob, ldo, seq, 0.f, qr, lds);
  else attn_body_c256_t<true>(Qb, ldq, Kh, Vh, ldk, Ob, ldo, seq, nmc, qr, lds);
}

__device__ __forceinline__ float load_q8(const bf16_t* __restrict__ Qrow, int hi, v8i_ (&qf)[2], float kmax2) {
  float ss = 0;
#pragma unroll
  for (int st = 0; st < 2; ++st) {
    const bf16_t* p = Qrow + 64 * st + 32 * hi; v8i_ o;
#pragma unroll
    for (int c = 0; c < 4; ++c) { const u32x4 raw = *reinterpret_cast<const u32x4*>(p + 8 * c);
      const unsigned w0 = pack8x4(bflo(raw[0]) * QC, bfhi(raw[0]) * QC, bflo(raw[1]) * QC, bfhi(raw[1]) * QC);
      const unsigned w1 = pack8x4(bflo(raw[2]) * QC, bfhi(raw[2]) * QC, bflo(raw[3]) * QC, bfhi(raw[3]) * QC);
      o[2 * c] = (int)w0; o[2 * c + 1] = (int)w1; ss += sq8x4(w0) + sq8x4(w1); }
    qf[st] = o;
  }
  { auto rr = __builtin_amdgcn_permlane32_swap(__float_as_uint(ss), __float_as_uint(ss), false, false); ss = __uint_as_float(rr[0]) + __uint_as_float(rr[1]); }
  return -(sqrtf(ss * kmax2) * 1.01f + 1e-3f);
}
__device__ __forceinline__ int k8_dma_voff(int wid, int lane, int ldk8) {
  const int row = 8 * wid + (lane >> 3); return row * ldk8 + (((lane & 7) ^ ((row >> 1) & 7)) << 4); }
template <int OFF> __device__ __forceinline__ v4i k8_read(int ka) { v4i r; asm volatile("ds_read_b128 %0, %1 offset:%2" : "=&v"(r) : "v"(ka), "i"(OFF) : "memory"); return r; }

template <bool SHIFT>
__device__ __forceinline__ void attn_body_c256q8_t(const unsigned char* __restrict__ K8, const int ldk8, const bf16_t* __restrict__ Vh, const int ldk,
                                                   bf16_t* __restrict__ Ob, const int ldo, const int seq, const float nmc, const v8i_ (&qf)[2], LAS char* lds) {
  int tid = threadIdx.x; asm volatile("" : "+v"(tid)); tid &= 511;
  const int wid = __builtin_amdgcn_readfirstlane(tid >> 6), lane = tid & 63, r32 = lane & 31, hi = lane >> 5;
  constexpr int SHM_K8 = KVBLK * 128;
  LAS char* K_lds = lds; LAS char* V_lds = lds + 2 * SHM_K8;
  LAS float* li_l = (LAS float*)(lds + 2 * SHM_K8 + 2 * SHM_V2) + wid * 64;
  float l_reg = 0; f32x16 o[8] = {};
  const int vb0 = (int)(uintptr_t)V_lds + v_rd_base(lane);
  const int kvo = k8_dma_voff(wid, lane, ldk8);
  const int vvo = unswap23(8 * (wid >> 2) + ((lane & 31) >> 2)) * ldk * 2 + ((2 * (wid & 3) + (lane >> 5)) * 32 + (lane & 3) * 8) * 2;
  const int l16 = 32 * ldk, pz = wid * 1024;
  const __amdgpu_buffer_rsrc_t krs = __builtin_amdgcn_make_buffer_rsrc((void*)K8, 0, 0x7ffffff0, 0x00020000);
  const __amdgpu_buffer_rsrc_t vrs = __builtin_amdgcn_make_buffer_rsrc((void*)Vh, 0, 0x7ffffff0, 0x00020000);
#define VM0() asm volatile("s_waitcnt vmcnt(0)" ::: "memory")
#define KVDMA(b, k0) do { const int _o = (k0) * ldk * 2; LAS char* _v = V_lds + (b) * SHM_V2 + pz; \
    DMA16(krs, K_lds + (b) * SHM_K8 + pz, kvo, (k0) * ldk8); DMA16(vrs, _v, vvo, _o); DMA16(vrs, _v + 8192, vvo, _o + l16); \
    DMA16(vrs, _v + 16384, vvo, _o + 2 * l16); DMA16(vrs, _v + 24576, vvo, _o + 3 * l16); } while (0)
  const int ka0 = (int)(uintptr_t)K_lds + r32 * 128 + (((2 * hi) ^ ((r32 >> 1) & 7)) << 4);
  const int ka1 = ka0 ^ 16, ka2 = ka0 ^ 64, ka3 = ka0 ^ 80;
  int sc1; asm volatile("v_mov_b32 %0, 0x7f7f7f7f" : "=v"(sc1));
  f32x16 P; bf16x8 pa0, pa1; v4i k0a, k0b, k1a, k1b; VSet va, vb_, vc;
  const int NT = seq / KVBLK;
#define KOFF(b, h) ((b) * 8192 + (h) * 4096)
#define VOFF(b, h, d0) ((b) * 32768 + (h) * 16384 + (d0) * 512)
#define KPRO(b, h) do { k0a = k8_read<KOFF(b, h)>(ka0); k0b = k8_read<KOFF(b, h)>(ka1); k1a = k8_read<KOFF(b, h)>(ka2); k1b = k8_read<KOFF(b, h)>(ka3); } while (0)
#define V8(x, y) (v8i_){x[0], x[1], x[2], x[3], y[0], y[1], y[2], y[3]}
#define QKHALF(b, h) do { \
    if (SHIFT) { _Pragma("unroll") for (int r = 0; r < 16; ++r) { float _z; asm volatile("v_mov_b32 %0, %1" : "=v"(_z) : "v"(nmc)); P[r] = _z; } } \
    LGK(2); SCHED; { const v8i_ kf = V8(k0a, k0b); \
      if (SHIFT) asm volatile("s_nop 4\n\tv_mfma_scale_f32_32x32x64_f8f6f4 %0, %1, %2, %0, %3, %3 op_sel_hi:[0,0,0]" : "+v"(P) : "v"(kf), "v"(qf[0]), "v"(sc1)); \
      else       asm volatile("v_mfma_scale_f32_32x32x64_f8f6f4 %0, %1, %2, 0, %3, %3 op_sel_hi:[0,0,0]" : "=&v"(P) : "v"(kf), "v"(qf[0]), "v"(sc1)); } \
    SCHED; v_read<VOFF(b, h, 0)>(va, vb0); \
    LGK(4); SCHED; { const v8i_ kf = V8(k1a, k1b); \
      asm volatile("v_mfma_scale_f32_32x32x64_f8f6f4 %0, %1, %2, %0, %3, %3 op_sel_hi:[0,0,0]" : "+v"(P) : "v"(kf), "v"(qf[1]), "v"(sc1)); } \
    SCHED; v_read<VOFF(b, h, 1)>(vb_, vb0); \
    asm volatile("s_nop 15\n\ts_nop 7" : "+v"(P)); } while (0)
#define SMH() do { exp16(P); l_reg += sum16(P); PK4(P, 0, pa0); PK4(P, 8, pa1); } while (0)
#define PVM(S, d0) do { SCHED; pv2(o[d0], S, pa0, pa1); SCHED; } while (0)
#define PVHALF(b, h, NEXTK, nb, nh) do { \
    LGK(4); PVM(va, 0); v_read<VOFF(b, h, 2)>(vc, vb0); \
    LGK(4); PVM(vb_, 1); v_read<VOFF(b, h, 3)>(va, vb0); \
    LGK(4); PVM(vc, 2); v_read<VOFF(b, h, 4)>(vb_, vb0); \
    LGK(4); PVM(va, 3); v_read<VOFF(b, h, 5)>(vc, vb0); \
    LGK(4); PVM(vb_, 4); v_read<VOFF(b, h, 6)>(va, vb0); \
    LGK(4); PVM(vc, 5); v_read<VOFF(b, h, 7)>(vb_, vb0); \
    LGK(4); PVM(va, 6); if (NEXTK) { k0a = k8_read<KOFF(nb, nh)>(ka0); k0b = k8_read<KOFF(nb, nh)>(ka1); } \
    if (NEXTK) { LGK(2); } else { LGK(0); } PVM(vb_, 7); if (NEXTK) { k1a = k8_read<KOFF(nb, nh)>(ka2); k1b = k8_read<KOFF(nb, nh)>(ka3); } } while (0)
#define STEPC(b, j) do { if ((j) + 1 < NT) KVDMA((b) ^ 1, ((j) + 1) * KVBLK); \
    KPRO(b, 0); QKHALF(b, 0); SMH(); PVHALF(b, 0, true, b, 1); \
    QKHALF(b, 1); SMH(); PVHALF(b, 1, false, 0, 0); \
    VM0(); __syncthreads(); } while (0)
  KVDMA(0, 0); VM0(); __syncthreads();
  for (int j = 0; j < NT; j += 2) { STEPC(0, j); STEPC(1, j + 1); }
  { auto rr = __builtin_amdgcn_permlane32_swap(__float_as_uint(l_reg), __float_as_uint(l_reg), false, false); l_reg = __uint_as_float(rr[0]) + __uint_as_float(rr[1]); }
  if (hi == 0) li_l[r32] = l_reg; asm volatile("s_waitcnt lgkmcnt(0)" ::: "memory");
  bf16_t* Ow = Ob + (long)(wid * QBLK) * ldo;
#pragma unroll
  for (int r = 0; r < 16; ++r) { const int orow = crow(r, hi); const float rl = __builtin_amdgcn_rcpf(li_l[orow]);
#pragma unroll
    for (int d0 = 0; d0 < 8; ++d0) Ow[(long)orow * ldo + d0 * 32 + r32] = f2bf(o[d0][r] * rl); }
  VM0();
  __syncthreads();
#undef KVDMA
#undef KOFF
#undef VOFF
#undef KPRO
#undef V8
#undef QKHALF
#undef SMH
#undef PVM
#undef PVHALF
#undef STEPC
#undef VM0
}
__device__ __forceinline__ void attn_body_c256q8(const bf16_t* __restrict__ Qb, const int ldq, const unsigned char* __restrict__ K8, const int ldk8,
                                                 const bf16_t* __restrict__ Vh, const int ldk, bf16_t* __restrict__ Ob, const int ldo, const int seq, const float kmax2, LAS char* lds) {
  int tid = threadIdx.x; asm volatile("" : "+v"(tid)); tid &= 511;
  const int wid = tid >> 6, lane = tid & 63, r32 = lane & 31, hi = lane >> 5;
  v8i_ qf[2];
  const float nmc = load_q8(Qb + (long)(wid * QBLK + r32) * ldq, hi, qf, kmax2);
  if (__all(nmc > -64.f)) attn_body_c256q8_t<false>(K8, ldk8, Vh, ldk, Ob, ldo, seq, 0.f, qf, lds);
  else attn_body_c256q8_t<true>(K8, ldk8, Vh, ldk, Ob, ldo, seq, nmc, qf, lds);
}

template <bool SHIFT>
__device__ __forceinline__ void attn_body_q8_t(const unsigned char* __restrict__ K8, const int ldk8, const bf16_t* __restrict__ Vh, const int ldk,
                                               bf16_t* __restrict__ Ob, const int ldo, const int seq, const float nmc, const v8i_ (&qf)[2], LAS char* lds) {
  int tid = threadIdx.x; asm volatile("" : "+v"(tid)); tid &= 511;
  const int wid = __builtin_amdgcn_readfirstlane(tid >> 6), lane = tid & 63, r32 = lane & 31, hi = lane >> 5;
  constexpr int SK8 = KVBLK * 128, ST = SK8 + SHM_V;
  LAS float* li_l = (LAS float*)(lds + 3 * ST) + wid * 64;
  float l_reg = 0; f32x16 o[4] = {};
  const int vrb = v_rd_base(lane);
  const int kvo = k8_dma_voff(wid, lane, ldk8);
  const int vvo = unswap23(8 * (wid >> 1) + ((lane & 31) >> 2)) * ldk * 2 + ((2 * (wid & 1) + (lane >> 5)) * 32 + (lane & 3) * 8) * 2;
  const int l32 = 64 * ldk, pz = wid * 1024;
  const __amdgpu_buffer_rsrc_t krs = __builtin_amdgcn_make_buffer_rsrc((void*)K8, 0, 0x7ffffff0, 0x00020000);
  const __amdgpu_buffer_rsrc_t vrs = __builtin_amdgcn_make_buffer_rsrc((void*)Vh, 0, 0x7ffffff0, 0x00020000);
#define TDMA(slot, k0) do { const int _o = (k0) * ldk * 2; LAS char* _b = lds + (slot) * ST + pz; \
    DMA16(krs, _b, kvo, (k0) * ldk8); DMA16(vrs, _b + SK8, vvo, _o); DMA16(vrs, _b + SK8 + 8192, vvo, _o + l32); } while (0)
#define VM0() asm volatile("s_waitcnt vmcnt(0)" ::: "memory")
  int sc1; asm volatile("v_mov_b32 %0, 0x7f7f7f7f" : "=v"(sc1));
  const int kof = r32 * 128 + (((2 * hi) ^ ((r32 >> 1) & 7)) << 4);
#define QKT8(P0, P1, Ks) do { \
    const v4i a0 = *(LAS const v4i*)((Ks) + kof), a1 = *(LAS const v4i*)((Ks) + (kof ^ 16)), a2 = *(LAS const v4i*)((Ks) + (kof ^ 64)), a3 = *(LAS const v4i*)((Ks) + (kof ^ 80)); \
    const v4i b0 = *(LAS const v4i*)((Ks) + 4096 + kof), b1 = *(LAS const v4i*)((Ks) + 4096 + (kof ^ 16)), b2 = *(LAS const v4i*)((Ks) + 4096 + (kof ^ 64)), b3 = *(LAS const v4i*)((Ks) + 4096 + (kof ^ 80)); \
    v8i_ k00 = (v8i_){a0[0], a0[1], a0[2], a0[3], a1[0], a1[1], a1[2], a1[3]}, k01 = (v8i_){a2[0], a2[1], a2[2], a2[3], a3[0], a3[1], a3[2], a3[3]}; \
    v8i_ k10 = (v8i_){b0[0], b0[1], b0[2], b0[3], b1[0], b1[1], b1[2], b1[3]}, k11 = (v8i_){b2[0], b2[1], b2[2], b2[3], b3[0], b3[1], b3[2], b3[3]}; \
    if (SHIFT) { _Pragma("unroll") for (int r = 0; r < 16; ++r) { P0[r] = nmc; P1[r] = nmc; } \
      asm volatile("s_nop 4\n\tv_mfma_scale_f32_32x32x64_f8f6f4 %0, %1, %2, %0, %3, %3 op_sel_hi:[0,0,0]" : "+v"(P0) : "v"(k00), "v"(qf[0]), "v"(sc1)); \
      asm volatile("v_mfma_scale_f32_32x32x64_f8f6f4 %0, %1, %2, %0, %3, %3 op_sel_hi:[0,0,0]" : "+v"(P1) : "v"(k10), "v"(qf[0]), "v"(sc1)); } \
    else { asm volatile("v_mfma_scale_f32_32x32x64_f8f6f4 %0, %1, %2, 0, %3, %3 op_sel_hi:[0,0,0]" : "=&v"(P0) : "v"(k00), "v"(qf[0]), "v"(sc1)); \
      asm volatile("v_mfma_scale_f32_32x32x64_f8f6f4 %0, %1, %2, 0, %3, %3 op_sel_hi:[0,0,0]" : "=&v"(P1) : "v"(k10), "v"(qf[0]), "v"(sc1)); } \
    asm volatile("v_mfma_scale_f32_32x32x64_f8f6f4 %0, %1, %2, %0, %3, %3 op_sel_hi:[0,0,0]" : "+v"(P0) : "v"(k01), "v"(qf[1]), "v"(sc1)); \
    asm volatile("v_mfma_scale_f32_32x32x64_f8f6f4 %0, %1, %2, %0, %3, %3 op_sel_hi:[0,0,0]" : "+v"(P1) : "v"(k11), "v"(qf[1]), "v"(sc1)); \
      \
    asm volatile("s_nop 15" : "+v"(k00), "+v"(k01), "+v"(k10), "+v"(k11)); } while (0)
#define TIE(P0, P1) asm volatile("s_nop 15\n\ts_nop 7" : "+v"(P0), "+v"(P1))
#define TIE0(P0, P1) asm volatile("" : "+v"(P0), "+v"(P1))
#define FINISH(P0, P1) do { exp16(P1); l_reg += sum16(P0) + sum16(P1); PK4(P0, 0, pa0); PK4(P0, 8, pa1); PK4(P1, 0, pa2); PK4(P1, 8, pa3); } while (0)
  f32x16 pA0, pA1, pB0, pB1; bf16x8 pa0, pa1, pa2, pa3; const int NT = seq / KVBLK;
  TDMA(0, 0); VM0(); __syncthreads();
  TDMA(1, KVBLK);
  QKT8(pA0, pA1, lds); TIE(pA0, pA1); exp16(pA0);
  VM0(); __syncthreads();
  int sk = 1, sv = 0, sd = 2;
  for (int j = 1; j + 1 < NT; j += 2) {
    TDMA(sd, (j + 1) * KVBLK);
    SCHED; QKT8(pB0, pB1, lds + sk * ST);
    FINISH(pA0, pA1); SCHED;
    pv_d0(o, (int)(uintptr_t)(lds + sv * ST + SK8) + vrb, pa0, pa1, pa2, pa3); TIE0(pB0, pB1); exp16(pB0);
    VM0(); __syncthreads();
    { const int t = sv; sv = sk; sk = sd; sd = t; }
    if (j + 2 < NT) TDMA(sd, (j + 2) * KVBLK);
    SCHED; QKT8(pA0, pA1, lds + sk * ST);
    FINISH(pB0, pB1); SCHED;
    pv_d0(o, (int)(uintptr_t)(lds + sv * ST + SK8) + vrb, pa0, pa1, pa2, pa3); TIE0(pA0, pA1); exp16(pA0);
    VM0(); __syncthreads();
    { const int t = sv; sv = sk; sk = sd; sd = t; }
  }
  SCHED; QKT8(pB0, pB1, lds + sk * ST);
  FINISH(pA0, pA1); SCHED;
  pv_d0(o, (int)(uintptr_t)(lds + sv * ST + SK8) + vrb, pa0, pa1, pa2, pa3); TIE0(pB0, pB1); exp16(pB0);
  FINISH(pB0, pB1); SCHED;
  pv_d0(o, (int)(uintptr_t)(lds + sk * ST + SK8) + vrb, pa0, pa1, pa2, pa3);
  { auto rr = __builtin_amdgcn_permlane32_swap(__float_as_uint(l_reg), __float_as_uint(l_reg), false, false); l_reg = __uint_as_float(rr[0]) + __uint_as_float(rr[1]); }
#if DENSE8_G2
  store_o8(o, l_reg, li_l, (unsigned char*)Ob + (long)(wid * QBLK) * ldo, ldo, r32, hi);
#else
  store_o(o, l_reg, li_l, Ob + (long)(wid * QBLK) * ldo, ldo, r32, hi);
#endif
  VM0();
  __syncthreads();
#undef TDMA
#undef VM0
#undef QKT8
#undef TIE
#undef TIE0
#undef FINISH
}
__device__ __forceinline__ void attn_body_q8(const bf16_t* __restrict__ Qb, const int ldq, const unsigned char* __restrict__ K8, const int ldk8,
                                             const bf16_t* __restrict__ Vh, const int ldk, bf16_t* __restrict__ Ob, const int ldo, const int seq, const float kmax2, LAS char* lds) {
  int tid = threadIdx.x; asm volatile("" : "+v"(tid)); tid &= 511;
  const int wid = tid >> 6, lane = tid & 63, r32 = lane & 31, hi = lane >> 5;
  v8i_ qf[2];
  const float nmc = load_q8(Qb + (long)(wid * QBLK + r32) * ldq, hi, qf, kmax2);
  if (__all(nmc > -64.f)) attn_body_q8_t<false>(K8, ldk8, Vh, ldk, Ob, ldo, seq, 0.f, qf, lds);
  else attn_body_q8_t<true>(K8, ldk8, Vh, ldk, Ob, ldo, seq, nmc, qf, lds);
}

__device__ __forceinline__ unsigned pk8nc(float a, float b, float c, float d) {
  int p = __builtin_amdgcn_cvt_pk_fp8_f32(a, b, 0, false); p = __builtin_amdgcn_cvt_pk_fp8_f32(c, d, p, true); return (unsigned)p; }
__device__ __forceinline__ float max16(const f32x16& p) {
  float a = fmaxf(fmaxf(p[0], p[1]), fmaxf(p[2], p[3])), b = fmaxf(fmaxf(p[4], p[5]), fmaxf(p[6], p[7]));
  float c = fmaxf(fmaxf(p[8], p[9]), fmaxf(p[10], p[11])), d = fmaxf(fmaxf(p[12], p[13]), fmaxf(p[14], p[15]));
  return fmaxf(fmaxf(a, b), fmaxf(c, d)); }
template <int NCB>
__device__ __forceinline__ void attn_body_d(const bf16_t* __restrict__ Qb, const int ldq, const unsigned char* __restrict__ K8, const int ldk8,
                                               const unsigned char* __restrict__ V8T  ,
                                               bf16_t* __restrict__ Ob, const int ldo, const int seq, LAS char* lds) {
  int tid = threadIdx.x; asm volatile("" : "+v"(tid)); tid &= 511;
  const int wid = __builtin_amdgcn_readfirstlane(tid >> 6), lane = tid & 63, r32 = lane & 31, hi = lane >> 5;
  v8i_ qf[2];
  (void)load_q8(Qb + (long)(wid * QBLK + r32) * ldq, hi, qf, 0.f);
  constexpr int SK8 = KVBLK * 128, SV8 = NCB * 32 * 64;
  LAS char* K_lds = lds; LAS char* V_lds = lds + 2 * SK8;
  LAS float* li_l = (LAS float*)(lds + 2 * SK8 + 2 * SV8) + wid * 64;
  float l_reg = 0; f32x16 o[NCB] = {};
  const int kvo = k8_dma_voff(wid, lane, ldk8);
  const int vvo = lane * 16 + wid * 1024, pz = wid * 1024;
  const __amdgpu_buffer_rsrc_t krs = __builtin_amdgcn_make_buffer_rsrc((void*)K8, 0, 0x7ffffff0, 0x00020000);
  const __amdgpu_buffer_rsrc_t vrs = __builtin_amdgcn_make_buffer_rsrc((void*)V8T, 0, 0x7ffffff0, 0x00020000);
#define VM0() asm volatile("s_waitcnt vmcnt(0)" ::: "memory")
#define KVDMA(b, t) do { DMA16(krs, K_lds + (b) * SK8 + pz, kvo, (t) * KVBLK * ldk8); \
    DMA16(vrs, V_lds + (b) * SV8 + pz, vvo, (t) * SV8); if (NCB == 8) DMA16(vrs, V_lds + (b) * SV8 + pz + 8192, vvo, (t) * SV8 + 8192); } while (0)
  const int ka0 = (int)(uintptr_t)K_lds + r32 * 128 + (((2 * hi) ^ ((r32 >> 1) & 7)) << 4);
  const int ka1 = ka0 ^ 16, ka2 = ka0 ^ 64, ka3 = ka0 ^ 80;
  const int vf0 = (int)(uintptr_t)V_lds + r32 * 64 + (((2 * hi) ^ ((r32 >> 2) & 3)) << 4), vf1 = vf0 ^ 16;
  int sc1; asm volatile("v_mov_b32 %0, 0x7f7f7f7f" : "=v"(sc1));
  const int NT = seq / KVBLK;
#define RD128(dst, addr, OFF) asm volatile("ds_read_b128 %0, %1 offset:%2" : "=&v"(dst) : "v"(addr), "i"(OFF) : "memory")
#define V8(x, y) (v8i_){x[0], x[1], x[2], x[3], y[0], y[1], y[2], y[3]}
#define VFR(A_, B_, b, d0) do { RD128(A_, vf0, (b) * SV8 + (d0) * 2048); RD128(B_, vf1, (b) * SV8 + (d0) * 2048); } while (0)
#define PVM(A_, B_, d0) do { SCHED; { const v8i_ vfr = V8(A_, B_); \
    asm volatile("v_mfma_scale_f32_32x32x64_f8f6f4 %0, %1, %2, %0, %3, %4 op_sel_hi:[0,0,0]" : "+v"(o[(d0) < NCB ? (d0) : 0]) : "v"(pa8), "v"(vfr), "v"(sca), "v"(sc1)); } SCHED; } while (0)
#define STEPD(b, j) do { if ((j) + 1 < NT) KVDMA((b) ^ 1, (j) + 1); \
      \
    RD128(k0, ka0, (b) * 8192); RD128(k1, ka1, (b) * 8192); RD128(k2, ka2, (b) * 8192); RD128(k3, ka3, (b) * 8192); \
    RD128(k4, ka0, (b) * 8192 + 4096); RD128(k5, ka1, (b) * 8192 + 4096); RD128(k6, ka2, (b) * 8192 + 4096); RD128(k7, ka3, (b) * 8192 + 4096); \
    LGK(6); SCHED; { const v8i_ kf = V8(k0, k1); asm volatile("v_mfma_scale_f32_32x32x64_f8f6f4 %0, %1, %2, 0, %3, %3 op_sel_hi:[0,0,0]" : "=&v"(p0) : "v"(kf), "v"(qf[0]), "v"(sc1)); } \
    LGK(4); SCHED; { const v8i_ kf = V8(k2, k3); asm volatile("v_mfma_scale_f32_32x32x64_f8f6f4 %0, %1, %2, %0, %3, %3 op_sel_hi:[0,0,0]" : "+v"(p0) : "v"(kf), "v"(qf[1]), "v"(sc1)); } \
    LGK(2); SCHED; { const v8i_ kf = V8(k4, k5); asm volatile("v_mfma_scale_f32_32x32x64_f8f6f4 %0, %1, %2, 0, %3, %3 op_sel_hi:[0,0,0]" : "=&v"(p1) : "v"(kf), "v"(qf[0]), "v"(sc1)); } \
    LGK(0); SCHED; { const v8i_ kf = V8(k6, k7); asm volatile("v_mfma_scale_f32_32x32x64_f8f6f4 %0, %1, %2, %0, %3, %3 op_sel_hi:[0,0,0]" : "+v"(p1) : "v"(kf), "v"(qf[1]), "v"(sc1)); } \
    SCHED; VFR(va, vb, b, 0); VFR(vc, vd, b, 1); \
    asm volatile("s_nop 15\n\ts_nop 7" : "+v"(p0), "+v"(p1)); \
      \
    { const float mo = fmaxf(max16(p0), max16(p1)); \
      auto sA = __builtin_amdgcn_permlane32_swap(__float_as_uint(mo), __float_as_uint(mo), false, false); \
      const float e0 = fminf(fmaxf(ceilf(fmaxf(__uint_as_float(sA[0]), __uint_as_float(sA[1]))), -120.f), 120.f); \
      _Pragma("unroll") for (int r = 0; r < 16; ++r) { p0[r] = __builtin_amdgcn_exp2f(p0[r] - e0); p1[r] = __builtin_amdgcn_exp2f(p1[r] - e0); } \
      l_reg += __builtin_amdgcn_exp2f(e0) * (sum16(p0) + sum16(p1)); \
      sca = 127 + (int)e0; \
      _Pragma("unroll") for (int q = 0; q < 4; ++q) { \
        const unsigned x = pk8nc(p0[4 * q], p0[4 * q + 1], p0[4 * q + 2], p0[4 * q + 3]), y = pk8nc(p1[4 * q], p1[4 * q + 1], p1[4 * q + 2], p1[4 * q + 3]); \
        auto rr = __builtin_amdgcn_permlane32_swap(x, y, false, false); pa8[q] = (int)rr[0]; pa8[4 + q] = (int)rr[1]; } } \
      \
    asm volatile("s_nop 4" : "+v"(pa8), "+v"(sca));     \
    if (NCB == 8) { \
    LGK(2); PVM(va, vb, 0); VFR(ve, vf, b, 2); \
    LGK(2); PVM(vc, vd, 1); VFR(va, vb, b, 3); \
    LGK(2); PVM(ve, vf, 2); VFR(vc, vd, b, 4); \
    LGK(2); PVM(va, vb, 3); VFR(ve, vf, b, 5); \
    LGK(2); PVM(vc, vd, 4); VFR(va, vb, b, 6); \
    LGK(2); PVM(ve, vf, 5); VFR(vc, vd, b, 7); \
    LGK(2); PVM(va, vb, 6); \
    LGK(0); PVM(vc, vd, NCB - 1); } else { \
    LGK(2); PVM(va, vb, 0); VFR(ve, vf, b, 2); \
    LGK(2); PVM(vc, vd, 1); VFR(va, vb, b, 3); \
    LGK(2); PVM(ve, vf, 2); \
    LGK(0); PVM(va, vb, 3); } \
    VM0(); __syncthreads(); } while (0)
  f32x16 p0, p1; v8i_ pa8; int sca; v4i k0, k1, k2, k3, k4, k5, k6, k7, va, vb, vc, vd, ve, vf;
  KVDMA(0, 0); VM0(); __syncthreads();
  for (int j = 0; j < NT; j += 2) { STEPD(0, j); STEPD(1, j + 1); }
  asm volatile("s_nop 15\n\ts_nop 7" ::: "memory");
#pragma unroll
  for (int d0 = 0; d0 < NCB; ++d0) asm volatile("" : "+v"(o[d0]));
  { auto rr = __builtin_amdgcn_permlane32_swap(__float_as_uint(l_reg), __float_as_uint(l_reg), false, false); l_reg = __uint_as_float(rr[0]) + __uint_as_float(rr[1]); }
  if (hi == 0) li_l[r32] = l_reg; asm volatile("s_waitcnt lgkmcnt(0)" ::: "memory");
  bf16_t* Ow = Ob + (long)(wid * QBLK) * ldo;
#pragma unroll
  for (int r = 0; r < 16; ++r) { const int orow = crow(r, hi); const float rl = __builtin_amdgcn_rcpf(li_l[orow]);
#pragma unroll
    for (int d0 = 0; d0 < NCB; ++d0) Ow[(long)orow * ldo + d0 * 32 + r32] = f2bf(o[d0][r] * rl); }
  VM0();
  __syncthreads();
#undef VM0
#undef KVDMA
#undef RD128
#undef V8
#undef VFR
#undef PVM
#undef STEPD
}
__device__ __forceinline__ float max3a(float a, float b, float c) { float r; asm("v_max3_f32 %0, %1, %2, %3" : "=v"(r) : "v"(a), "v"(b), "v"(c)); return r; }
__device__ __forceinline__ float max2a(float a, float b) { float r; asm("v_max_f32 %0, %1, %2" : "=v"(r) : "v"(a), "v"(b)); return r; }
__device__ __forceinline__ float max32a(const f32x16& p, const f32x16& q) {
  const float a0 = max3a(p[0], p[1], p[2]), a1 = max3a(p[3], p[4], p[5]), a2 = max3a(p[6], p[7], p[8]), a3 = max3a(p[9], p[10], p[11]), a4 = max3a(p[12], p[13], p[14]);
  const float b0 = max3a(q[0], q[1], q[2]), b1 = max3a(q[3], q[4], q[5]), b2 = max3a(q[6], q[7], q[8]), b3 = max3a(q[9], q[10], q[11]), b4 = max3a(q[12], q[13], q[14]);
  const float c0 = max3a(a0, a1, a2), c1 = max3a(a3, a4, p[15]), c2 = max3a(b0, b1, b2), c3 = max3a(b3, b4, q[15]);
  return max2a(max3a(c0, c1, c2), c3); }
typedef short v2s_ __attribute__((ext_vector_type(2)));
struct DiffEpi { const bf16_t* O0; unsigned char* X2; float lam; const float* sg; };
template <int NCB, int VAR, bool FAST, int EM>
__device__ __forceinline__ void attn_body_e_t(const v8i_ (&qf)[2], const unsigned char* __restrict__ K8, const int ldk8,
                                            const unsigned char* __restrict__ V8T, bf16_t* __restrict__ Ob, const int ldo, const int seq, LAS char* lds, const DiffEpi de) {
  int tid = threadIdx.x; asm volatile("" : "+v"(tid)); tid &= 511;
  const int wid = __builtin_amdgcn_readfirstlane(tid >> 6), lane = tid & 63, r32 = lane & 31, hi = lane >> 5;
  constexpr int SK8 = KVBLK * 128, SV8 = NCB * 32 * 64;
  LAS char* K_lds = lds; LAS char* V_lds = lds + 2 * SK8;
  LAS float* li_l = (LAS float*)(lds + 2 * SK8 + 2 * SV8) + wid * 64;
  float l_reg = 0; f32x16 o[NCB] = {};
  const int kvo = ((wid & 3) * 16 + (lane >> 2)) * ldk8 + (((lane & 3) ^ ((lane >> 4) & 3)) << 4) + (wid >> 2) * 64;
  const int vvo = lane * 16 + wid * 1024, pz = wid * 1024;
  const __amdgpu_buffer_rsrc_t krs = __builtin_amdgcn_make_buffer_rsrc((void*)K8, 0, 0x7ffffff0, 0x00020000);
  const __amdgpu_buffer_rsrc_t vrs = __builtin_amdgcn_make_buffer_rsrc((void*)V8T, 0, 0x7ffffff0, 0x00020000);
#define VM0() asm volatile("s_waitcnt vmcnt(0)" ::: "memory")
#define KDMA(b, t) DMA16(krs, K_lds + (b) * SK8 + pz, kvo, (t) * KVBLK * ldk8)
#define VDMA(b, t) do { DMA16(vrs, V_lds + (b) * SV8 + pz, vvo, (t) * SV8); if (NCB == 8) DMA16(vrs, V_lds + (b) * SV8 + pz + 8192, vvo, (t) * SV8 + 8192); } while (0)
  const int ka0 = (int)(uintptr_t)K_lds + r32 * 64 + (((2 * hi) ^ ((r32 >> 2) & 3)) << 4), ka1 = ka0 ^ 16;
  constexpr int VOFF = 2 * SK8;
  int sc1; asm volatile("v_mov_b32 %0, 0x7f7f7f7f" : "=v"(sc1));
  const int NT = seq / KVBLK;
#define RD128(dst, addr, OFF) asm volatile("ds_read_b128 %0, %1 offset:%2" : "=&v"(dst) : "v"(addr), "i"(OFF) : "memory")
#define V8(x, y) (v8i_){x[0], x[1], x[2], x[3], y[0], y[1], y[2], y[3]}
#define VFR(A_, B_, b, d0) do { RD128(A_, ka0, VOFF + (b) * SV8 + (d0) * 2048); RD128(B_, ka1, VOFF + (b) * SV8 + (d0) * 2048); } while (0)
#define KFR(A_, B_, b, i) do { RD128(A_, ka0, (b) * 8192 + ((i) & 1) * 4096 + ((i) >> 1) * 2048); RD128(B_, ka1, (b) * 8192 + ((i) & 1) * 4096 + ((i) >> 1) * 2048); } while (0)
#define MF_ "v_mfma_scale_f32_32x32x64_f8f6f4 "
#define PVM(A_, B_, d0, PA, SC) do { SCHED; { const v8i_ vfr = V8(A_, B_); \
    if (VAR == 2) { asm volatile("s_nop 3" : "+v"(o[(d0) < NCB ? (d0) : 0]) : "v"(PA), "v"(vfr), "v"(SC), "v"(sc1)); } else { asm volatile(MF_ "%0, %1, %2, %0, %3, %4 op_sel_hi:[0,0,0]\n\ts_nop 3" : "+v"(o[(d0) < NCB ? (d0) : 0]) : "v"(PA), "v"(vfr), "v"(SC), "v"(sc1)); } } SCHED; } while (0)
#define QKZ(A_, B_, N_, qi) do { SCHED; { const v8i_ kf = V8(A_, B_); if (VAR == 2) { asm volatile("s_nop 3" : "=&v"(N_) : "v"(kf), "v"(qf[qi]), "v"(sc1)); } else { asm volatile(MF_ "%0, %1, %2, 0, %3, %3 op_sel_hi:[0,0,0]\n\ts_nop 3" : "=&v"(N_) : "v"(kf), "v"(qf[qi]), "v"(sc1)); } } SCHED; } while (0)
#define QKA(A_, B_, N_, qi) do { SCHED; { const v8i_ kf = V8(A_, B_); if (VAR == 2) { asm volatile("s_nop 3" : "+v"(N_) : "v"(kf), "v"(qf[qi]), "v"(sc1)); } else { asm volatile(MF_ "%0, %1, %2, %0, %3, %3 op_sel_hi:[0,0,0]\n\ts_nop 3" : "+v"(N_) : "v"(kf), "v"(qf[qi]), "v"(sc1)); } } SCHED; } while (0)
#define QKZ0(A_, B_, N_, qi) do { SCHED; { const v8i_ kf = V8(A_, B_); if (VAR == 2) { asm volatile("" : "=&v"(N_) : "v"(kf), "v"(qf[qi]), "v"(sc1)); } else { asm volatile(MF_ "%0, %1, %2, 0, %3, %3 op_sel_hi:[0,0,0]" : "=&v"(N_) : "v"(kf), "v"(qf[qi]), "v"(sc1)); } } SCHED; } while (0)
#define QKA0(A_, B_, N_, qi) do { SCHED; { const v8i_ kf = V8(A_, B_); if (VAR == 2) { asm volatile("" : "+v"(N_) : "v"(kf), "v"(qf[qi]), "v"(sc1)); } else { asm volatile(MF_ "%0, %1, %2, %0, %3, %3 op_sel_hi:[0,0,0]" : "+v"(N_) : "v"(kf), "v"(qf[qi]), "v"(sc1)); } } SCHED; } while (0)
#define PVR(A_, B_, d0, PA, SC, RA_, RB_, OFF) do { SCHED; { const v8i_ vfr = V8(A_, B_); \
    if (VAR == 2) { asm volatile("ds_read_b128 %1, %7 offset:%9\n\tds_read_b128 %2, %8 offset:%9" \
      : "+v"(o[(d0) < NCB ? (d0) : 0]), "=&v"(RA_), "=&v"(RB_) : "v"(PA), "v"(vfr), "v"(SC), "v"(sc1), "v"(ka0), "v"(ka1), "i"(OFF) : "memory"); } else { asm volatile(MF_ "%0, %3, %4, %0, %5, %6 op_sel_hi:[0,0,0]\n\tds_read_b128 %1, %7 offset:%9\n\tds_read_b128 %2, %8 offset:%9" \
      : "+v"(o[(d0) < NCB ? (d0) : 0]), "=&v"(RA_), "=&v"(RB_) : "v"(PA), "v"(vfr), "v"(SC), "v"(sc1), "v"(ka0), "v"(ka1), "i"(OFF) : "memory"); } } SCHED; } while (0)
#define QKZR(A_, B_, N_, qi, RA_, RB_, OFF) do { SCHED; { const v8i_ kf = V8(A_, B_); \
    if (VAR == 2) { asm volatile("ds_read_b128 %1, %6 offset:%8\n\tds_read_b128 %2, %7 offset:%8" \
      : "=&v"(N_), "=&v"(RA_), "=&v"(RB_) : "v"(kf), "v"(qf[qi]), "v"(sc1), "v"(ka0), "v"(ka1), "i"(OFF) : "memory"); } else { asm volatile(MF_ "%0, %3, %4, 0, %5, %5 op_sel_hi:[0,0,0]\n\tds_read_b128 %1, %6 offset:%8\n\tds_read_b128 %2, %7 offset:%8" \
      : "=&v"(N_), "=&v"(RA_), "=&v"(RB_) : "v"(kf), "v"(qf[qi]), "v"(sc1), "v"(ka0), "v"(ka1), "i"(OFF) : "memory"); } } SCHED; } while (0)
#define QKAR(A_, B_, N_, qi, RA_, RB_, OFF) do { SCHED; { const v8i_ kf = V8(A_, B_); \
    if (VAR == 2) { asm volatile("ds_read_b128 %1, %6 offset:%8\n\tds_read_b128 %2, %7 offset:%8" \
      : "+v"(N_), "=&v"(RA_), "=&v"(RB_) : "v"(kf), "v"(qf[qi]), "v"(sc1), "v"(ka0), "v"(ka1), "i"(OFF) : "memory"); } else { asm volatile(MF_ "%0, %3, %4, %0, %5, %5 op_sel_hi:[0,0,0]\n\tds_read_b128 %1, %6 offset:%8\n\tds_read_b128 %2, %7 offset:%8" \
      : "+v"(N_), "=&v"(RA_), "=&v"(RB_) : "v"(kf), "v"(qf[qi]), "v"(sc1), "v"(ka0), "v"(ka1), "i"(OFF) : "memory"); } } SCHED; } while (0)
#define VO(b, d0) (VOFF + (b) * SV8 + (d0) * 2048)
#define KO(b, i) ((b) * 8192 + ((i) & 1) * 4096 + ((i) >> 1) * 2048)
#define M1(P0, P1) do { if (VAR != 1) mo = max32a(P0, P1); } while (0)
#define M2(SCN) do { if (VAR == 1) { asm volatile("" : "=v"(SCN)); ls0 = 0.f; e0 = 0.f; break; } auto sA = __builtin_amdgcn_permlane32_swap(__float_as_uint(mo), __float_as_uint(mo), false, false); \
    e0 = fminf(fmaxf(ceilf(max2a(__uint_as_float(sA[0]), __uint_as_float(sA[1]))), -120.f), 120.f); SCN = 127 + (int)e0; if (FAST) scf = __int_as_float(SCN << 23); ls0 = 0.f; } while (0)
#define PEL(P0, P1, u, k) (((u) >> 1) & 1 ? P1 : P0)[4 * ((u) >> 2) + 2 * ((u) & 1) + (k)]
#define U(P0, P1, u) do { if (VAR == 1) break; \
    const float xa = __builtin_amdgcn_exp2f(FAST ? PEL(P0, P1, u, 0) : PEL(P0, P1, u, 0) - e0), xb = __builtin_amdgcn_exp2f(FAST ? PEL(P0, P1, u, 1) : PEL(P0, P1, u, 1) - e0); \
    ls0 += xa; ls0 += xb; \
    int wo_; if (((u) & 1) == 0) asm volatile("" : "=v"(wo_)); else wo_ = (((u) >> 1) & 1) ? wy : wx; \
    if (FAST) wo_ = __builtin_bit_cast(int, __builtin_amdgcn_cvt_scalef32_pk_fp8_f32(__builtin_bit_cast(v2s_, wo_), xa, xb, scf, ((u) & 1) != 0)); \
    else wo_ = __builtin_amdgcn_cvt_pk_fp8_f32(xa, xb, wo_, ((u) & 1) != 0); \
    if (((u) >> 1) & 1) wy = wo_; else wx = wo_; } while (0)
#define SW(PN, q) do { if (VAR == 1) { if ((q) == 3) asm volatile("" : "=v"(PN)); break; } auto rr = __builtin_amdgcn_permlane32_swap((unsigned)wx, (unsigned)wy, false, false); PN[q] = (int)rr[0]; PN[4 + (q)] = (int)rr[1]; } while (0)
#define HOLD(A_, B_) asm volatile("" :: "v"(A_), "v"(B_))
#define ITER_E(b, t, P0, P1, N0, N1, PA, PN, SCA, SCN) do { \
    if (VAR != 3) { if ((t) + 2 < NT) KDMA(b, (t) + 2); VDMA(b, t); } \
    VFR(va, vb, (b) ^ 1, 0); VFR(vc, vd, (b) ^ 1, 1); \
    asm volatile("s_nop 1" : "+v"(P0), "+v"(P1));     \
    SCHED; M1(P0, P1); SCHED; \
    if (NCB == 8) { \
    LGK(2); PVR(va, vb, 0, PA, SCA, ve, vf, VO((b) ^ 1, 2)); M2(SCN); HOLD(va, vb); \
    LGK(2); PVR(vc, vd, 1, PA, SCA, va, vb, VO((b) ^ 1, 3)); U(P0, P1, 0); U(P0, P1, 1); HOLD(vc, vd); \
    LGK(2); PVR(ve, vf, 2, PA, SCA, vc, vd, VO((b) ^ 1, 4)); U(P0, P1, 2); U(P0, P1, 3); SW(PN, 0); HOLD(ve, vf); \
    LGK(2); PVR(va, vb, 3, PA, SCA, ve, vf, VO((b) ^ 1, 5)); U(P0, P1, 4); HOLD(va, vb); \
    LGK(2); PVR(vc, vd, 4, PA, SCA, va, vb, VO((b) ^ 1, 6)); U(P0, P1, 5); U(P0, P1, 6); HOLD(vc, vd); \
    LGK(2); PVR(ve, vf, 5, PA, SCA, vc, vd, VO((b) ^ 1, 7)); U(P0, P1, 7); SW(PN, 1); HOLD(ve, vf); \
    LGK(2); PVR(va, vb, 6, PA, SCA, ve, vf, KO((b) ^ 1, 0)); U(P0, P1, 8); U(P0, P1, 9); HOLD(va, vb); \
    LGK(2); PVR(vc, vd, NCB - 1, PA, SCA, va, vb, KO((b) ^ 1, 1)); U(P0, P1, 10); HOLD(vc, vd); \
    LGK(2); QKZR(ve, vf, N0, 0, vc, vd, KO((b) ^ 1, 2)); U(P0, P1, 11); SW(PN, 2); U(P0, P1, 12); HOLD(ve, vf); \
    LGK(2); QKAR(va, vb, N0, 1, ve, vf, KO((b) ^ 1, 3)); U(P0, P1, 13); HOLD(va, vb); \
    LGK(2); QKZ0(vc, vd, N1, 0); U(P0, P1, 14); HOLD(vc, vd); \
    LGK(0); QKA0(ve, vf, N1, 1); U(P0, P1, 15); SW(PN, 3); HOLD(ve, vf); \
    } else { \
    LGK(2); PVR(va, vb, 0, PA, SCA, ve, vf, VO((b) ^ 1, 2)); M2(SCN); HOLD(va, vb); \
    LGK(2); PVR(vc, vd, 1, PA, SCA, va, vb, VO((b) ^ 1, 3)); U(P0, P1, 0); U(P0, P1, 1); HOLD(vc, vd); \
    LGK(2); PVR(ve, vf, 2, PA, SCA, vc, vd, KO((b) ^ 1, 0)); U(P0, P1, 2); U(P0, P1, 3); SW(PN, 0); U(P0, P1, 4); HOLD(ve, vf); \
    LGK(2); PVR(va, vb, 3, PA, SCA, ve, vf, KO((b) ^ 1, 1)); U(P0, P1, 5); U(P0, P1, 6); U(P0, P1, 7); SW(PN, 1); HOLD(va, vb); \
    LGK(2); QKZR(vc, vd, N0, 0, va, vb, KO((b) ^ 1, 2)); U(P0, P1, 8); U(P0, P1, 9); U(P0, P1, 10); HOLD(vc, vd); \
    LGK(2); QKAR(ve, vf, N0, 1, vc, vd, KO((b) ^ 1, 3)); U(P0, P1, 11); SW(PN, 2); U(P0, P1, 12); U(P0, P1, 13); HOLD(ve, vf); \
    LGK(2); QKZ0(va, vb, N1, 0); U(P0, P1, 14); HOLD(va, vb); \
    LGK(0); QKA0(vc, vd, N1, 1); U(P0, P1, 15); SW(PN, 3); HOLD(vc, vd); \
    } \
    asm volatile("" : "+v"(ls0));     \
    if (FAST) l_reg += ls0; else l_reg += __builtin_amdgcn_exp2f(e0) * ls0; \
    if (VAR != 3) { VM0(); __syncthreads(); } } while (0)
  f32x16 p0, p1, n0, n1; v8i_ pa8 = {}, pb8; int scaA = 127, scaB; v4i va, vb, vc, vd, ve, vf;
  float mo, e0, ls0, scf = 1.f; int wx = 0, wy = 0;
  KDMA(0, 0); if (NT > 1) KDMA(1, 1); VDMA(1, 0); VM0(); __syncthreads();
  KFR(va, vb, 0, 0); KFR(vc, vd, 0, 1); KFR(ve, vf, 0, 2);
  LGK(4); QKZ(va, vb, p0, 0); KFR(va, vb, 0, 3);
  LGK(4); QKA(vc, vd, p0, 1);
  LGK(2); QKZ(ve, vf, p1, 0);
  LGK(0); QKA(va, vb, p1, 1);
  asm volatile("s_nop 4" : "+v"(pa8), "+v"(scaA));
  __syncthreads();
  for (int j = 0; j < NT; j += 2) {
    ITER_E(0, j, p0, p1, n0, n1, pa8, pb8, scaA, scaB);
    ITER_E(1, j + 1, n0, n1, p0, p1, pb8, pa8, scaB, scaA);
  }
  VFR(va, vb, 1, 0); VFR(vc, vd, 1, 1);
  asm volatile("s_nop 4" : "+v"(pa8), "+v"(scaA));
  if (NCB == 8) {
    LGK(2); PVM(va, vb, 0, pa8, scaA); VFR(ve, vf, 1, 2);
    LGK(2); PVM(vc, vd, 1, pa8, scaA); VFR(va, vb, 1, 3);
    LGK(2); PVM(ve, vf, 2, pa8, scaA); VFR(vc, vd, 1, 4);
    LGK(2); PVM(va, vb, 3, pa8, scaA); VFR(ve, vf, 1, 5);
    LGK(2); PVM(vc, vd, 4, pa8, scaA); VFR(va, vb, 1, 6);
    LGK(2); PVM(ve, vf, 5, pa8, scaA); VFR(vc, vd, 1, 7);
    LGK(2); PVM(va, vb, 6, pa8, scaA);
    LGK(0); PVM(vc, vd, NCB - 1, pa8, scaA);
  } else {
    LGK(2); PVM(va, vb, 0, pa8, scaA); VFR(ve, vf, 1, 2);
    LGK(2); PVM(vc, vd, 1, pa8, scaA); VFR(va, vb, 1, 3);
    LGK(2); PVM(ve, vf, 2, pa8, scaA);
    LGK(0); PVM(va, vb, 3, pa8, scaA);
  }
  asm volatile("s_nop 15\n\ts_nop 7" ::: "memory");
#pragma unroll
  for (int d0 = 0; d0 < NCB; ++d0) asm volatile("" : "+v"(o[d0]));
  { auto rr = __builtin_amdgcn_permlane32_swap(__float_as_uint(l_reg), __float_as_uint(l_reg), false, false); l_reg = __uint_as_float(rr[0]) + __uint_as_float(rr[1]); }
  if (hi == 0) li_l[r32] = l_reg; asm volatile("s_waitcnt lgkmcnt(0)" ::: "memory");
  bf16_t* Ow = Ob + (long)(wid * QBLK) * ldo;
  if (EM == 2) {
    float sgv[NCB];
#pragma unroll
    for (int d0 = 0; d0 < NCB; ++d0) sgv[d0] = de.sg[d0 * 32 + r32];
#pragma unroll
    for (int r = 0; r < 16; ++r) { const int orow = crow(r, hi); const float rl = __builtin_amdgcn_rcpf(li_l[orow]);
      float dv[NCB], ssq = 0.f;
#pragma unroll
      for (int d0 = 0; d0 < NCB; ++d0) { const float o0 = bf2f(de.O0[(long)(wid * QBLK + orow) * ldo + d0 * 32 + r32]); dv[d0] = o0 - de.lam * (o[d0][r] * rl); ssq += dv[d0] * dv[d0]; }
      ssq += __shfl_xor(ssq, 1); ssq += __shfl_xor(ssq, 2); ssq += __shfl_xor(ssq, 4); ssq += __shfl_xor(ssq, 8); ssq += __shfl_xor(ssq, 16);
      const float rstd = rsqrtf(ssq * (1.f / 256) + EPS) * (1.f - LAM_INIT);
#pragma unroll
      for (int d0 = 0; d0 < NCB; ++d0) { const float y = dv[d0] * rstd * sgv[d0];
        if (DENSE8_G2) de.X2[(long)(wid * QBLK + orow) * D + d0 * 32 + r32] = (unsigned char)__builtin_amdgcn_cvt_pk_fp8_f32(clamp8(y * 8.f), 0.f, 0, false);
        else ((bf16_t*)de.X2)[(long)(wid * QBLK + orow) * D + d0 * 32 + r32] = f2bf(y); } }
  } else {
#pragma unroll
  for (int r = 0; r < 16; ++r) { const int orow = crow(r, hi); const float rl = __builtin_amdgcn_rcpf(li_l[orow]);
#pragma unroll
    for (int d0 = 0; d0 < NCB; ++d0) {
      if (EM == 1) ((unsigned char*)Ob)[(long)(wid * QBLK + orow) * ldo + d0 * 32 + r32] = (unsigned char)__builtin_amdgcn_cvt_pk_fp8_f32(clamp8(o[d0][r] * rl * 8.f), 0.f, 0, false);
      else Ow[(long)orow * ldo + d0 * 32 + r32] = f2bf(o[d0][r] * rl); } }
  }
  VM0();
  __syncthreads();
#undef VM0
#undef KDMA
#undef VDMA
#undef RD128
#undef V8
#undef VFR
#undef KFR
#undef PVM
#undef QKZ
#undef QKA
#undef QKZ0
#undef QKA0
#undef PVR
#undef QKZR
#undef QKAR
#undef VO
#undef KO
#undef MF_
#undef M1
#undef M2
#undef U
#undef PEL
#undef SW
#undef ITER_E
#undef HOLD
}
template <int NCB, int VAR = 0, int EM = 0>
__device__ __forceinline__ void attn_body_e(const bf16_t* __restrict__ Qb, const int ldq, const unsigned char* __restrict__ K8, const int ldk8,
                                            const unsigned char* __restrict__ V8T, bf16_t* __restrict__ Ob, const int ldo, const int seq, const float kmax2, LAS char* lds, const DiffEpi de = DiffEpi{}) {
  int tid = threadIdx.x; asm volatile("" : "+v"(tid)); tid &= 511;
  v8i_ qf[2];
  const float nmc = load_q8(Qb + (long)((tid >> 6) * QBLK + (tid & 31)) * ldq, (tid & 63) >> 5, qf, kmax2);
  if (__all(nmc > -100.f)) attn_body_e_t<NCB, VAR, true, EM>(qf, K8, ldk8, V8T, Ob, ldo, seq, lds, de);
  else attn_body_e_t<NCB, VAR, false, EM>(qf, K8, ldk8, V8T, Ob, ldo, seq, lds, de);
}
#undef PK4
}

__device__ __forceinline__ int perm_plain8(int n) { const int r = n & 31; return (n & ~31) + 16 * ((r >> 2) & 1) + 4 * (r >> 3) + (r & 3); }
__device__ __forceinline__ int perm_row(int kind, int n) {
  if (kind == 0) return perm_plain8(n);
  if (kind == 1) { if (n < N_QKV0) return perm_plain8(n); const int c = n - N_QKV0; const int ch = c & 1023; return N_QKV0 + 32 * (ch >> 4) + ((c >> 10) << 4) + (ch & 15); }
  return 32 * (n >> 4) + ((kind == 3) ? 16 : 0) + (n & 15);
}
__device__ __forceinline__ void cvt_tile(const float* __restrict__ src, int N, bf16_t* __restrict__ dst, int K, int kind, int k0, int n0, LAS unsigned* t32) {
  int tid = threadIdx.x; asm volatile("" : "+v"(tid)); tid &= 511;
#pragma unroll
  for (int j = 0; j < 2; ++j) {
    const int item = tid + 512 * j, kp = item >> 4, q = item & 15;
    const f32x4 v0 = *(const f32x4*)(src + (size_t)(k0 + 2 * kp) * N + n0 + 4 * q);
    const f32x4 v1 = *(const f32x4*)(src + (size_t)(k0 + 2 * kp + 1) * N + n0 + 4 * q);
#pragma unroll
    for (int i = 0; i < 4; ++i) t32[(4 * q + i) * 65 + kp] = cvtpk(v0[i], v1[i]);
  }
  __syncthreads();
#pragma unroll
  for (int j = 0; j < 2; ++j) {
    const int item = tid + 512 * j, n = item >> 4, ko = item & 15;
    u32x4 v;
#pragma unroll
    for (int i = 0; i < 4; ++i) v[i] = t32[n * 65 + 4 * ko + i];
    *(u32x4*)(dst + (size_t)perm_row(kind, n0 + n) * K + k0 + 8 * ko) = v;
  }
  __syncthreads();
}
__device__ __forceinline__ void cvt_matrix_units(const float* src, int K, int N, bf16_t* dst, int kind, int u0, int ustride, LAS unsigned* t32) {
  const int nN = N / 64, nK = K / 128;
  for (int u = u0; u < nN * nK; u += ustride) cvt_tile(src, N, dst, K, kind, (u / nN) * 128, (u % nN) * 64, t32);
}
constexpr size_t WMOE8_E = (size_t)1024 * D + (size_t)D * EFF;
__device__ __forceinline__ void cvt_tile8(const float* __restrict__ src, int N, unsigned char* __restrict__ dst, int K, int kind, int k0, int n0, float scale, LAS unsigned* t32) {
  int tid = threadIdx.x; asm volatile("" : "+v"(tid)); tid &= 511;
  { const int kq = tid >> 4, q = tid & 15;
    f32x4 v[4];
#pragma unroll
    for (int r = 0; r < 4; ++r) v[r] = *(const f32x4*)(src + (size_t)(k0 + 4 * kq + r) * N + n0 + 4 * q);
#pragma unroll
    for (int i = 0; i < 4; ++i) t32[(4 * q + i) * 33 + kq] = pack_fp8x4(v[0][i] * scale, v[1][i] * scale, v[2][i] * scale, v[3][i] * scale); }
  __syncthreads();
  { const int n = tid >> 3, kc = tid & 7;
    u32x4 v;
#pragma unroll
    for (int i = 0; i < 4; ++i) v[i] = t32[n * 33 + 4 * kc + i];
    *(u32x4*)(dst + (size_t)perm_row(kind, n0 + n) * K + k0 + 16 * kc) = v; }
  __syncthreads();
}
__device__ __forceinline__ void cvt_matrix_units8(const float* src, int K, int N, unsigned char* dst, int kind, float scale, LAS unsigned* t32) {
  const int nN = N / 64, nK = K / 128;
  for (int u = blockIdx.x; u < nN * nK; u += gridDim.x) cvt_tile8(src, N, dst, K, kind, (u / nN) * 128, (u % nN) * 64, scale, t32);
}
__device__ __forceinline__ void cvt_tile8w(const float* __restrict__ src, int N, unsigned char* __restrict__ dst, int K, int kind, int k0, int n0, float scale, LAS unsigned* t32) {
  int tid = threadIdx.x; asm volatile("" : "+v"(tid)); tid &= 511;
  { const int kq = tid >> 5, q = tid & 31;
    f32x4 v[8];
#pragma unroll
    for (int r = 0; r < 8; ++r) v[r] = *(const f32x4*)(src + (size_t)(k0 + 8 * kq + r) * N + n0 + 4 * q);
#pragma unroll
    for (int i = 0; i < 4; ++i)
#pragma unroll
      for (int h = 0; h < 2; ++h) t32[(4 * q + i) * 33 + 2 * kq + h] = pack_fp8x4(v[4 * h][i] * scale, v[4 * h + 1][i] * scale, v[4 * h + 2][i] * scale, v[4 * h + 3][i] * scale); }
  __syncthreads();
  { const int n = tid >> 2, kc = tid & 3;
    u32x4 o0, o1;
#pragma unroll
    for (int i = 0; i < 4; ++i) { o0[i] = t32[n * 33 + 8 * kc + i]; o1[i] = t32[n * 33 + 8 * kc + 4 + i]; }
    unsigned char* dp = dst + (size_t)perm_row(kind, n0 + n) * K + k0 + 32 * kc;
    *(u32x4*)dp = o0; *(u32x4*)(dp + 16) = o1; }
  __syncthreads();
}
__device__ __forceinline__ void cvt_moe_all8(const Args& a, LAS unsigned* t32) {
  unsigned char* W = (unsigned char*)(a.ws + WS_WMOE);
  for (int u = blockIdx.x; u < 2 * 65 * 192; u += gridDim.x) {
    const int le = u / 192, L = le / 65, e = le % 65, r = u % 192, mtx = r >> 6, lu = r & 63;
    const float* src; unsigned char* dst = W + (size_t)le * WMOE8_E; int K, N, kind; float sc;
    if (mtx == 0)      { src = e < 64 ? a.in[21] + ((size_t)L * 64 + e) * D * EFF : a.in[24] + (size_t)L * D * EFF; K = D; N = EFF; kind = 2; sc = 256.f; }
    else if (mtx == 1) { src = e < 64 ? a.in[22] + ((size_t)L * 64 + e) * D * EFF : a.in[25] + (size_t)L * D * EFF; K = D; N = EFF; kind = 3; sc = 256.f; }
    else               { src = e < 64 ? a.in[23] + ((size_t)L * 64 + e) * EFF * D : a.in[26] + (size_t)L * EFF * D; K = EFF; N = D; kind = 0; sc = 128.f; dst += (size_t)1024 * D; }
    const int nN = N / 128;
    cvt_tile8w(src, N, dst, K, kind, (lu / nN) * 128, (lu % nN) * 128, sc, t32);
  }
}

__device__ __forceinline__ void ld_row_f32(const float* __restrict__ p, int lane, float (&v)[32]) {
#pragma unroll
  for (int j = 0; j < 4; ++j) { const f32x4 t0 = *(const f32x4*)(p + 8 * lane + 512 * j), t1 = *(const f32x4*)(p + 8 * lane + 512 * j + 4);
#pragma unroll
    for (int i = 0; i < 4; ++i) { v[8 * j + i] = t0[i]; v[8 * j + 4 + i] = t1[i]; } }
}
__device__ __forceinline__ void ld_row_bf16(const bf16_t* __restrict__ p, int lane, float (&v)[32]) {
#pragma unroll
  for (int j = 0; j < 4; ++j) { const u32x4 t = *(const u32x4*)(p + 8 * lane + 512 * j);
#pragma unroll
    for (int i = 0; i < 4; ++i) { v[8 * j + 2 * i] = bflo(t[i]); v[8 * j + 2 * i + 1] = bfhi(t[i]); } }
}
__device__ __forceinline__ void ld_row_fp8(const unsigned char* __restrict__ p, int lane, float (&v)[32]) {
#pragma unroll
  for (int j = 0; j < 4; ++j) { const u32x2 t = *(const u32x2*)(p + 8 * lane + 512 * j);
#pragma unroll
    for (int i = 0; i < 2; ++i) { v[8 * j + 4 * i] = __builtin_amdgcn_cvt_f32_fp8((int)t[i], 0); v[8 * j + 4 * i + 1] = __builtin_amdgcn_cvt_f32_fp8((int)t[i], 1);
      v[8 * j + 4 * i + 2] = __builtin_amdgcn_cvt_f32_fp8((int)t[i], 2); v[8 * j + 4 * i + 3] = __builtin_amdgcn_cvt_f32_fp8((int)t[i], 3); } }
}
__device__ __forceinline__ void ld8f(const float* __restrict__ p, float (&x)[8]) { const f32x4 t0 = *(const f32x4*)p, t1 = *(const f32x4*)(p + 4);
#pragma unroll
  for (int i = 0; i < 4; ++i) { x[i] = t0[i]; x[4 + i] = t1[i]; } }
__device__ __forceinline__ void st8f(float* __restrict__ p, const float* x) { f32x4 t0 = {x[0], x[1], x[2], x[3]}, t1 = {x[4], x[5], x[6], x[7]}; *(f32x4*)p = t0; *(f32x4*)(p + 4) = t1; }
__device__ __forceinline__ void st8h(bf16_t* __restrict__ p, const float* x) { u32x4 t = {cvtpk(x[0], x[1]), cvtpk(x[2], x[3]), cvtpk(x[4], x[5]), cvtpk(x[6], x[7])}; *(u32x4*)p = t; }
__device__ __forceinline__ float sumsq32(const float (&v)[32]) { float s = 0;
#pragma unroll
  for (int i = 0; i < 32; ++i) s += v[i] * v[i];
  return wave_sum(s); }
template <bool COPY, bool OUT8 = false>
__device__ __forceinline__ void modulate_store(const float (&v)[32], float rstd, const float* __restrict__ g, const float* __restrict__ shift, const float* __restrict__ scale,
                                               bf16_t* __restrict__ dst, int lane, LAS float* f32copy, int trow = 0) {
#pragma unroll
  for (int j = 0; j < 4; ++j) {
    const int idx = 8 * lane + 512 * j;
    float gv[8], sh[8], sc[8], y[8]; ld8f(g + idx, gv); ld8f(shift + idx, sh); ld8f(scale + idx, sc);
#pragma unroll
    for (int i = 0; i < 8; ++i) y[i] = v[8 * j + i] * rstd * gv[i] * (1.f + sc[i]) + sh[i];
    if (OUT8) { u32x2 p8 = {pack_fp8x4(y[0], y[1], y[2], y[3]), pack_fp8x4(y[4], y[5], y[6], y[7])}; *(u32x2*)((unsigned char*)dst + idx) = p8; }
    else { u32x4 pk = {cvtpk(y[0], y[1]), cvtpk(y[2], y[3]), cvtpk(y[4], y[5]), cvtpk(y[6], y[7])}; *(u32x4*)(dst + idx) = pk; }
    if (COPY) {
      const u32x4 hi = {cvtpk(y[0], y[1]), cvtpk(y[2], y[3]), cvtpk(y[4], y[5]), cvtpk(y[6], y[7])};
      const u32x4 lo = {cvtpk(y[0] - bflo(hi[0]), y[1] - bfhi(hi[0])), cvtpk(y[2] - bflo(hi[1]), y[3] - bfhi(hi[1])), cvtpk(y[4] - bflo(hi[2]), y[5] - bfhi(hi[2])), cvtpk(y[6] - bflo(hi[3]), y[7] - bfhi(hi[3]))};
      LAS char* rowp = (LAS char*)f32copy + trow * 4096 + ((((idx >> 3)) ^ (4 * (trow & 3) + (trow >> 2))) << 4);
      *(LAS u32x4*)rowp = hi; *(LAS u32x4*)(rowp + 32768) = lo; }
  }
}

__device__ __forceinline__ void phase_prologue(const Args& a, LAS char* lds) {
  int tid = threadIdx.x; asm volatile("" : "+v"(tid)); tid &= 511; const int wave = tid >> 6, lane = tid & 63;
  {
    LAS float* sc = (LAS float*)lds;
    LAS float* part = sc + 4096;
    const float* c = a.in[1]; const float* cc = a.in[3];
    for (int i = tid; i < D; i += NTHREADS) { float v = c[i]; sc[i] = v * sigmoidf_(v); float u = cc[i]; sc[D + i] = u * sigmoidf_(u); }
    __syncthreads();
    float* MOD = (float*)(a.ws + WS_MOD);
    for (int u = blockIdx.x; u < 2 * 192; u += gridDim.x) {
      const int L = u / 192, chunk = u % 192;
      const float* W = a.in[4] + (size_t)L * D * 12288 + chunk * 64 + lane;
      float a0 = 0, a1 = 0; const int d0 = wave * 256;
#pragma unroll 8
      for (int dd = 0; dd < 256; ++dd) { const float w = W[(size_t)(d0 + dd) * 12288]; a0 += sc[d0 + dd] * w; a1 += sc[D + d0 + dd] * w; }
      part[(wave * 2 + 0) * 64 + lane] = a0; part[(wave * 2 + 1) * 64 + lane] = a1;
      __syncthreads();
      if (tid < 128) { const int which = tid >> 6; float s = 0;
#pragma unroll
        for (int w = 0; w < 8; ++w) s += part[(w * 2 + which) * 64 + lane];
        const int j = chunk * 64 + lane; MOD[(size_t)(L * 2 + which) * 12288 + j] = s + a.in[5][L * 12288 + j]; }
      __syncthreads();
    }
  }
  { const float* Wr = a.in[19]; bf16_t* RTo = (bf16_t*)(a.ws + WS_RT);
    for (int it = blockIdx.x * NTHREADS + tid; it < 2 * 16384; it += gridDim.x * NTHREADS) {
      const int ln = it & 63, ks = (it >> 6) & 63, nt = (it >> 12) & 3, L = it >> 14;
      const float* wp = Wr + (size_t)L * D * NE + (size_t)(ks * 32 + 8 * (ln >> 4)) * NE + nt * 16 + (ln & 15);
      float w[8];
#pragma unroll
      for (int i = 0; i < 8; ++i) w[i] = wp[(size_t)i * NE];
      const u32x4 hi = {cvtpk(w[0], w[1]), cvtpk(w[2], w[3]), cvtpk(w[4], w[5]), cvtpk(w[6], w[7])};
      const u32x4 lo = {cvtpk(w[0] - bflo(hi[0]), w[1] - bfhi(hi[0])), cvtpk(w[2] - bflo(hi[1]), w[3] - bfhi(hi[1])), cvtpk(w[4] - bflo(hi[2]), w[5] - bfhi(hi[2])), cvtpk(w[6] - bflo(hi[3]), w[7] - bfhi(hi[3]))};
      *(u32x4*)(RTo + ((size_t)(L * 2) * 16384 + (it & 16383)) * 8) = hi; *(u32x4*)(RTo + ((size_t)(L * 2 + 1) * 16384 + (it & 16383)) * 8) = lo; }
  }
  LAS unsigned* t32 = (LAS unsigned*)lds;
#if DENSE8_G1
  cvt_matrix_units8(a.in[7], D, N_IN0, (unsigned char*)(a.ws + WS_WIN0), 1, 256.f, t32);
  cvt_matrix_units8(a.in[15], D, N_IN1, (unsigned char*)(a.ws + WS_WIN1), 0, 256.f, t32);
#else
  cvt_matrix_units(a.in[7], D, N_IN0, (bf16_t*)(a.ws + WS_WIN0), 1, blockIdx.x, gridDim.x, t32);
  cvt_matrix_units(a.in[15], D, N_IN1, (bf16_t*)(a.ws + WS_WIN1), 0, blockIdx.x, gridDim.x, t32);
#endif
#if DENSE8_G2
  cvt_matrix_units8(a.in[8], D, D, (unsigned char*)(a.ws + WS_WOUT0), 0, 256.f, t32);
  cvt_matrix_units8(a.in[16], D, D, (unsigned char*)(a.ws + WS_WOUT1), 0, 256.f, t32);
#else
  cvt_matrix_units(a.in[8], D, D, (bf16_t*)(a.ws + WS_WOUT0), 0, blockIdx.x, gridDim.x, t32);
  cvt_matrix_units(a.in[16], D, D, (bf16_t*)(a.ws + WS_WOUT1), 0, blockIdx.x, gridDim.x, t32);
#endif
  cvt_moe_all8(a, t32);
}

__device__ __forceinline__ void phase_modulate0(const Args& a) {
  int tid = threadIdx.x; asm volatile("" : "+v"(tid)); tid &= 511; const int wave = tid >> 6, lane = tid & 63;
  const float* MOD = (const float*)(a.ws + WS_MOD);
  bf16_t* A = (bf16_t*)(a.ws + WS_ABUF);
  for (int it = blockIdx.x; it < MT / 8; it += gridDim.x) {
    const int r = it * 8 + wave;
    const float* src = r < CTXL ? a.in[2] + (size_t)r * D : a.in[0] + (size_t)(r - CTXL) * D;
    const float* mod = MOD + (r < CTXL ? 12288 : 0);
    float v[32]; ld_row_f32(src, lane, v);
    const float rstd = rsqrtf(sumsq32(v) * (1.f / D) + EPS);
#if DENSE8_G1
    modulate_store<false, true>(v, rstd, a.in[6], mod, mod + D, (bf16_t*)((unsigned char*)A + (size_t)r * D), lane, nullptr);
#else
    modulate_store<false>(v, rstd, a.in[6], mod, mod + D, A + (size_t)r * D, lane, nullptr);
#endif
  }
}

__device__ __forceinline__ void rope_cs4(int r, int lane, float (&cs)[4], float (&sn)[4]) {
#pragma unroll
  for (int q = 0; q < 4; ++q) { cs[q] = 1.f; sn[q] = 0.f; }
  if (r >= CTXL) { const int t = r - CTXL; const int l = lane & 15, a = l >> 3, i0 = 4 * (l & 7);
    const float pos = a ? (float)(t & 63) : (float)(t >> 6);
#pragma unroll
    for (int q = 0; q < 4; ++q) { const float inv = powf(10000.f, -(float)(i0 + q) / 32.f); sincosf(pos * inv, &sn[q], &cs[q]); } }
}
__device__ __forceinline__ float sum16lanes(float v) { v += __shfl_xor(v, 1); v += __shfl_xor(v, 2); v += __shfl_xor(v, 4); v += __shfl_xor(v, 8); return v; }
__device__ __forceinline__ void phase_rope_conv0(const Args& a, LAS char* lds, bool dry = false) {
  int tid = threadIdx.x; asm volatile("" : "+v"(tid)); tid &= 511; const int wave = tid >> 6, lane = tid & 63;
  bf16_t* Q = (bf16_t*)(a.ws + WS_QKVU);
  {
    const bf16_t* HG = (const bf16_t*)(a.ws + WS_HG);
    bf16_t* X2 = (bf16_t*)(a.ws + WS_X2);
    LAS char* lt = lds;
    LAS float* part = (LAS float*)(lds + 62 * 2048);
    LAS float* stats = part + 512;
    const float* dw_w = a.in[11]; const float* dw_b = a.in[12]; const float* ln_g = a.in[13]; const float* ln_b = a.in[14];
    const __amdgpu_buffer_rsrc_t wrs = __builtin_amdgcn_make_buffer_rsrc((void*)dw_w, 0, 31 * 1024 * 4, 0x00020000);
    for (int u = blockIdx.x; u < 520; u += gridDim.x) {
      int seg0, seg1, r0;
      if (u < 8) { seg0 = 0; seg1 = CTXL; r0 = u * 32; } else { seg0 = CTXL; seg1 = MT; r0 = CTXL + (u - 8) * 32; }
      for (int c = tid; c < 62 * 128; c += NTHREADS) { const int rr = c >> 7, cc = c & 127, gr = r0 - 15 + rr;
        u32x4 v = {0u, 0u, 0u, 0u}; if (gr >= seg0 && gr < seg1) v = *(const u32x4*)(HG + (size_t)gr * 1024 + cc * 8);
        *(LAS u32x4*)(lt + rr * 2048 + cc * 16) = v; }
      __syncthreads();
      float w0[31], w1[31];
#pragma unroll
      for (int j = 0; j < 31; ++j) { const u32x2 w = __builtin_amdgcn_raw_buffer_load_b64(wrs, tid * 8, j * 4096, 0); w0[j] = __uint_as_float(w[0]); w1[j] = __uint_as_float(w[1]); }
      const f32x2 bb = *(const f32x2*)(dw_b + 2 * tid);
      const f32x2 gg = *(const f32x2*)(ln_g + 2 * tid), gb = *(const f32x2*)(ln_b + 2 * tid);
#pragma unroll 1
      for (int hf = 0; hf < 4; ++hf) {
        float o0[8], o1[8];
        LAS const char* lth = lt + (hf * 8) * 2048 + tid * 4;
#pragma unroll
        for (int r = 0; r < 8; ++r) { o0[r] = bb[0]; o1[r] = bb[1]; }
#pragma unroll
        for (int i = 0; i < 38; ++i) {
          const unsigned p = *(LAS const unsigned*)(lth + i * 2048);
          const float x0 = bflo(p), x1 = bfhi(p);
#pragma unroll
          for (int r = 0; r < 8; ++r) { const int j = i - r; if (j >= 0 && j < 31) { o0[r] += x0 * w0[j]; o1[r] += x1 * w1[j]; } }
        }
#pragma unroll
        for (int r = 0; r < 8; ++r) {
          const float s = wave_sum(o0[r] + o1[r]), q = wave_sum(o0[r] * o0[r] + o1[r] * o1[r]);
          if (lane == 0) { part[(r * 8 + wave) * 2] = s; part[(r * 8 + wave) * 2 + 1] = q; }
        }
        __syncthreads();
        if (tid < 8) { float s = 0, q = 0;
#pragma unroll
          for (int w = 0; w < 8; ++w) { s += part[(tid * 8 + w) * 2]; q += part[(tid * 8 + w) * 2 + 1]; }
          const float mean = s * (1.f / 1024), var = q * (1.f / 1024) - mean * mean;
          stats[tid * 2] = mean; stats[tid * 2 + 1] = rsqrtf(fmaxf(var, 0.f) + EPS); }
        __syncthreads();
#pragma unroll
        for (int r = 0; r < 8; ++r) {
          const float mean = stats[r * 2], rstd = stats[r * 2 + 1];
          float y0 = (o0[r] - mean) * rstd * gg[0] + gb[0], y1 = (o1[r] - mean) * rstd * gg[1] + gb[1];
          y0 = y0 * sigmoid_fast(y0); y1 = y1 * sigmoid_fast(y1);
#if DENSE8_G2
          *(unsigned short*)((unsigned char*)X2 + (size_t)(r0 + hf * 8 + r) * D + 1024 + 2 * tid) = (unsigned short)__builtin_amdgcn_cvt_pk_fp8_f32(y0 * 8.f, y1 * 8.f, 0, false);
#else
          *(unsigned*)(X2 + (size_t)(r0 + hf * 8 + r) * D + 1024 + 2 * tid) = cvtpk(y0, y1);
#endif
        }
      }
      __syncthreads();
    }
  }
  const float* qn = a.in[9]; const float* kn = a.in[10];
  unsigned* kmx = (unsigned*)(a.ws + WS_CTL + CTL_KMAX);
  const int slot = lane >> 4, l16 = lane & 15, e1 = (l16 >> 3) * 64 + 4 * (l16 & 7), e2 = e1 + 32;
  float km0 = 0.f, km1 = 0.f;
  for (int it = blockIdx.x; it < MT / 8; it += gridDim.x) {
    const int r = it * 8 + wave;
    float cs[4], sn[4]; rope_cs4(r, lane, cs, sn);
    bf16_t* rowp = Q + (size_t)r * N_QKV0;
#pragma unroll
    for (int hb = 0; hb < 12; hb += 4) {
      const int hh = hb + slot;
      if (hh < 10) {
        const float* g = hh < 8 ? qn : kn;
        const u32x2 a1 = *(const u32x2*)(rowp + hh * 128 + e1), a2 = *(const u32x2*)(rowp + hh * 128 + e2);
        float x1[4] = {bflo(a1[0]), bfhi(a1[0]), bflo(a1[1]), bfhi(a1[1])}, x2[4] = {bflo(a2[0]), bfhi(a2[0]), bflo(a2[1]), bfhi(a2[1])};
        float ss = 0;
#pragma unroll
        for (int q = 0; q < 4; ++q) ss += x1[q] * x1[q] + x2[q] * x2[q];
        ss = sum16lanes(ss);
        const float rstd = rsqrtf(ss * (1.f / 128) + EPS);
        const f32x4 g1 = *(const f32x4*)(g + e1), g2 = *(const f32x4*)(g + e2);
        float o1[4], o2[4], so = 0;
#pragma unroll
        for (int q = 0; q < 4; ++q) { const float y1 = x1[q] * rstd * g1[q], y2 = x2[q] * rstd * g2[q]; o1[q] = y1 * cs[q] - y2 * sn[q]; o2[q] = y2 * cs[q] + y1 * sn[q]; }
        const u32x2 w1 = {cvtpk(o1[0], o1[1]), cvtpk(o1[2], o1[3])}, w2 = {cvtpk(o2[0], o2[1]), cvtpk(o2[2], o2[3])};
        if (!dry) { *(u32x2*)(rowp + hh * 128 + e1) = w1; *(u32x2*)(rowp + hh * 128 + e2) = w2; }
        if (hb == 8) {
          const unsigned q1 = pack8x4(o1[0], o1[1], o1[2], o1[3]), q2 = pack8x4(o2[0], o2[1], o2[2], o2[3]);
          unsigned char* k8p = (unsigned char*)(a.ws + WS_K8) + (size_t)r * 256 + (hh - 8) * 128;
          *(unsigned*)(k8p + e1) = q1; *(unsigned*)(k8p + e2) = q2;
          so = sum16lanes(sq8x4(q1) + sq8x4(q2)); if (slot == 0) km0 = fmaxf(km0, so); else km1 = fmaxf(km1, so);
        }
      }
    }
  }
  if (l16 == 0 && slot < 2) atomicMax(&kmx[slot], __float_as_uint(slot == 0 ? km0 : km1));
  __syncthreads();
  { unsigned char* V8T = (unsigned char*)(a.ws + WS_K8) + V8T0_OFF;
    LAS unsigned char* img = (LAS unsigned char*)lds;
    const int k = tid >> 3, cc = tid & 7, kb = k >> 5, kk = k & 31;
    const int j = (kk & 3) | (((kk >> 3) & 3) << 2) | (((kk >> 2) & 1) << 4);
    for (int u = blockIdx.x; u < 2 * (MT / 64); u += gridDim.x) {
      const int h = u / (MT / 64), t = u % (MT / 64);
      const bf16_t* vp = Q + (size_t)(t * 64 + k) * N_QKV0 + 1280 + h * 128 + cc * 16;
#pragma unroll
      for (int q = 0; q < 2; ++q) { const u32x4 raw = *(const u32x4*)(vp + 8 * q);
#pragma unroll
        for (int i = 0; i < 4; ++i) { const int p = __builtin_amdgcn_cvt_pk_fp8_f32(bflo(raw[i]), bfhi(raw[i]), 0, false);
#pragma unroll
          for (int hh = 0; hh < 2; ++hh) { const int col = cc * 16 + q * 8 + 2 * i + hh;
            img[col * 64 + (((2 * kb + (j >> 4)) ^ ((col >> 2) & 3)) << 4) + (j & 15)] = (unsigned char)(p >> (8 * hh)); } } }
      __syncthreads();
      *(u32x4*)(V8T + ((size_t)h * (MT / 64) + t) * 8192 + tid * 16) = *(LAS const u32x4*)(img + tid * 16);
      __syncthreads();
    }
  }
}
__device__ __forceinline__ void phase_rope1(const Args& a, LAS char* lds, bool dry = false) {
  int tid = threadIdx.x; asm volatile("" : "+v"(tid)); tid &= 511; const int wave = tid >> 6, lane = tid & 63;
  bf16_t* Q = (bf16_t*)(a.ws + WS_QKVU);
  unsigned* kmx = (unsigned*)(a.ws + WS_CTL + CTL_KMAX) + 16;
  unsigned char* K8 = (unsigned char*)(a.ws + WS_K8);
  LAS unsigned* lk = (LAS unsigned*)lds;
  if (tid < 16) lk[tid] = 0u;
  __syncthreads();
  const int slot = lane >> 4, l16 = lane & 15, e1 = (l16 >> 3) * 64 + 4 * (l16 & 7), e2 = e1 + 32;
  for (int it = blockIdx.x; it < MT / 8; it += gridDim.x) {
    const int r = it * 8 + wave;
    float cs[4], sn[4]; rope_cs4(r, lane, cs, sn);
    bf16_t* rowp = Q + (size_t)r * N_IN1;
#pragma unroll 2
    for (int hb = (r < CTXL ? 16 : 0); hb < 32; hb += 4) {
      const int hh = hb + slot;
      const u32x2 a1 = *(const u32x2*)(rowp + hh * 128 + e1), a2 = *(const u32x2*)(rowp + hh * 128 + e2);
      const float x1[4] = {bflo(a1[0]), bfhi(a1[0]), bflo(a1[1]), bfhi(a1[1])}, x2[4] = {bflo(a2[0]), bfhi(a2[0]), bflo(a2[1]), bfhi(a2[1])};
      float o1[4], o2[4];
#pragma unroll
      for (int q = 0; q < 4; ++q) { o1[q] = x1[q] * cs[q] - x2[q] * sn[q]; o2[q] = x2[q] * cs[q] + x1[q] * sn[q]; }
      const u32x2 w1 = {cvtpk(o1[0], o1[1]), cvtpk(o1[2], o1[3])}, w2 = {cvtpk(o2[0], o2[1]), cvtpk(o2[2], o2[3])};
      if (r >= CTXL && !dry) { *(u32x2*)(rowp + hh * 128 + e1) = w1; *(u32x2*)(rowp + hh * 128 + e2) = w2; }
      if (hb >= 16) {
        const unsigned q1 = pack8x4(o1[0], o1[1], o1[2], o1[3]), q2 = pack8x4(o2[0], o2[1], o2[2], o2[3]);
        unsigned char* k8p = K8 + (size_t)r * 2048 + (hh - 16) * 128;
        *(unsigned*)(k8p + e1) = q1; *(unsigned*)(k8p + e2) = q2;
        float so = sum16lanes(sq8x4(q1) + sq8x4(q2));
        if (l16 == 0) atomicMax((unsigned*)&lk[hh - 16], __float_as_uint(so));
      }
    }
  }
  __syncthreads();
  if (tid < 16) atomicMax(&kmx[tid], lk[tid]);
  __syncthreads();
  { unsigned char* V8T = (unsigned char*)(a.ws + WS_HG);
    LAS unsigned char* img = (LAS unsigned char*)lds;
    const int k = tid >> 3, cc = tid & 7, kb = k >> 5, kk = k & 31;
    const int j = (kk & 3) | (((kk >> 3) & 3) << 2) | (((kk >> 2) & 1) << 4);
    for (int u = blockIdx.x; u < 8 * (MT / 64); u += gridDim.x) {
      const int h = u / (MT / 64), t = u % (MT / 64);
      const bf16_t* vp = Q + (size_t)(t * 64 + k) * N_IN1 + 4096 + h * 256 + cc * 32;
#pragma unroll
      for (int q = 0; q < 4; ++q) { const u32x4 raw = *(const u32x4*)(vp + 8 * q);
#pragma unroll
        for (int i = 0; i < 4; ++i) { const int p = __builtin_amdgcn_cvt_pk_fp8_f32(bflo(raw[i]), bfhi(raw[i]), 0, false);
#pragma unroll
          for (int hh = 0; hh < 2; ++hh) { const int col = cc * 32 + q * 8 + 2 * i + hh;
            img[col * 64 + (((2 * kb + (j >> 4)) ^ ((col >> 2) & 3)) << 4) + (j & 15)] = (unsigned char)(p >> (8 * hh)); } } }
      __syncthreads();
      unsigned char* dst = V8T + ((size_t)h * (MT / 64) + t) * 16384;
      *(u32x4*)(dst + tid * 16) = *(LAS const u32x4*)(img + tid * 16);
      *(u32x4*)(dst + 8192 + tid * 16) = *(LAS const u32x4*)(img + 8192 + tid * 16);
      __syncthreads();
    }
  }
}

#ifndef ATT_VAR
#define ATT_VAR 0
#endif
template <int VAR = 0>
__device__ __forceinline__ void phase_attn(const Args& a, int L, LAS char* lds) {
  const bf16_t* Q = (const bf16_t*)(a.ws + WS_QKVU);
  const unsigned* kmx = (const unsigned*)(a.ws + WS_CTL + CTL_KMAX) + L * 16;
  if (L == 0) {
    bf16_t* X2 = (bf16_t*)(a.ws + WS_X2);
    for (int u = blockIdx.x; u < 520; u += gridDim.x) {
      const int head = u < 512 ? (u & 7) : (u - 512);
      const float kmax2 = __uint_as_float(kmx[head >> 2]);
      if (u < 512) { const int qb = u >> 3; const size_t q0 = (size_t)(CTXL + qb * 256);
        at::attn_body_e<4, VAR, (DENSE8_G2 ? 1 : 0)>(Q + q0 * N_QKV0 + head * 128, N_QKV0, (const unsigned char*)(a.ws + WS_K8) + (head >> 2) * 128, 256,
                           (const unsigned char*)(a.ws + WS_K8) + V8T0_OFF + (size_t)(head >> 2) * (MT / 64) * 8192, (DENSE8_G2 ? (bf16_t*)((unsigned char*)X2 + q0 * D + head * 128) : X2 + q0 * D + head * 128), D, MT, kmax2, lds);
      } else {
        at::attn_body_e<4, 0, (DENSE8_G2 ? 1 : 0)>(Q + head * 128, N_QKV0, (const unsigned char*)(a.ws + WS_K8) + (head >> 2) * 128, 256,
                           (const unsigned char*)(a.ws + WS_K8) + V8T0_OFF + (size_t)(head >> 2) * (MT / 64) * 8192, (DENSE8_G2 ? (bf16_t*)((unsigned char*)X2 + head * 128) : X2 + head * 128), D, CTXL, kmax2, lds); }
    }
  } else {
    bf16_t* O = (bf16_t*)(a.ws + WS_Y);
    int tid = threadIdx.x; asm volatile("" : "+v"(tid)); tid &= 511; const int lane = tid & 63;
    const float* lp = a.in[17];
    const float s1 = wave_sum(lp[lane] * lp[128 + lane] + lp[64 + lane] * lp[192 + lane]);
    const float s2 = wave_sum(lp[256 + lane] * lp[384 + lane] + lp[320 + lane] * lp[448 + lane]);
    const float lam = expf(s1) - expf(s2) + LAM_INIT;
    for (int u = blockIdx.x; u < 1024; u += gridDim.x) {
      const int b = u & 255, i = u >> 8, h = b & 7, qb = (b >> 3) + 32 * (i >> 1), cmp = i & 1, hc = 2 * h + cmp;
      const float kmax2 = __uint_as_float(kmx[hc]);
      const size_t q0 = (size_t)(CTXL + qb * 256);
      bf16_t* O0 = O + (size_t)(qb * 256) * 4096 + (2 * h) * 256;
      const unsigned char* k8 = (const unsigned char*)(a.ws + WS_K8) + hc * 128; const unsigned char* v8 = (const unsigned char*)(a.ws + WS_HG) + (size_t)h * (MT / 64) * 16384;
      if (cmp == 0) at::attn_body_e<8, VAR, 0>(Q + q0 * N_IN1 + hc * 128, N_IN1, k8, 2048, v8, O0, 4096, MT, kmax2, lds);
      else at::attn_body_e<8, VAR, 2>(Q + q0 * N_IN1 + hc * 128, N_IN1, k8, 2048, v8, O0, 4096, MT, kmax2, lds,
                                      at::DiffEpi{O0, (unsigned char*)(a.ws + WS_X2) + (q0 * D + h * 256) * (DENSE8_G2 ? 1 : 2), lam, a.in[18]});
    }
  }
}

__device__ __forceinline__ void phase_diff(const Args& a) {
  int tid = threadIdx.x; asm volatile("" : "+v"(tid)); tid &= 511; const int wave = tid >> 6, lane = tid & 63;
  const bf16_t* O = (const bf16_t*)(a.ws + WS_Y);
  bf16_t* X2 = (bf16_t*)(a.ws + WS_X2);
  const float* lp = a.in[17];
  const float s1 = wave_sum(lp[lane] * lp[128 + lane] + lp[64 + lane] * lp[192 + lane]);
  const float s2 = wave_sum(lp[256 + lane] * lp[384 + lane] + lp[320 + lane] * lp[448 + lane]);
  const float lam = expf(s1) - expf(s2) + LAM_INIT;
  const f32x4 sg = *(const f32x4*)(a.in[18] + 4 * lane);
  for (int it = blockIdx.x; it < SEQ / 8; it += gridDim.x) {
    const int t = it * 8 + wave;
    const bf16_t* op = O + (size_t)t * 4096;
    unsigned char* xp = (unsigned char*)X2 + (size_t)(CTXL + t) * D * (DENSE8_G2 ? 1 : 2);
#pragma unroll 2
    for (int h = 0; h < 8; ++h) {
      const u32x2 a0 = *(const u32x2*)(op + (2 * h) * 256 + 4 * lane), a1 = *(const u32x2*)(op + (2 * h + 1) * 256 + 4 * lane);
      float d[4] = {bflo(a0[0]) - lam * bflo(a1[0]), bfhi(a0[0]) - lam * bfhi(a1[0]), bflo(a0[1]) - lam * bflo(a1[1]), bfhi(a0[1]) - lam * bfhi(a1[1])};
      const float ss = wave_sum(d[0] * d[0] + d[1] * d[1] + d[2] * d[2] + d[3] * d[3]);
      const float rstd = rsqrtf(ss * (1.f / 256) + EPS) * (1.f - LAM_INIT);
#if DENSE8_G2
      const float r8 = rstd * 8.f;
      *(unsigned*)(xp + h * 256 + 4 * lane) = pack8x4(d[0] * r8 * sg[0], d[1] * r8 * sg[1], d[2] * r8 * sg[2], d[3] * r8 * sg[3]);
#else
      u32x2 pk = {cvtpk(d[0] * rstd * sg[0], d[1] * rstd * sg[1]), cvtpk(d[2] * rstd * sg[2], d[3] * rstd * sg[3])};
      *(u32x2*)((bf16_t*)xp + h * 256 + 4 * lane) = pk;
#endif
    }
  }
}

__device__ __forceinline__ void phase_G(const Args& a, int L, LAS char* lds, bool dry = false) {
  int tid = threadIdx.x; asm volatile("" : "+v"(tid)); tid &= 511; const int wave = tid >> 6, lane = tid & 63;
  const int NTOK = L == 0 ? MT : SEQ, ROW0 = L == 0 ? 0 : CTXL;
  const float* ng = a.in[6] + (size_t)L * 4 * D;
  const float* MODL = (const float*)(a.ws + WS_MOD) + (size_t)(L * 2) * 12288;
  const bf16_t* RT = (const bf16_t*)(a.ws + WS_RT) + (size_t)L * 2 * 131072; const float* rbias = a.in[20] + L * NE;
  const bf16_t* OUT = (const bf16_t*)(a.ws + WS_OUT);
  bf16_t* HRES = (bf16_t*)(a.ws + WS_HRES);
  bf16_t* F = (bf16_t*)(a.ws + WS_ABUF);
  int* counts = (int*)(a.ws + WS_CTL + CTL_CNT) + L * 64;
  int* top_e = (int*)(a.ws + WS_TOPE); float* top_w = (float*)(a.ws + WS_TOPW); int* top_p = (int*)(a.ws + WS_TOPP); int* elist = (int*)(a.ws + WS_ELIST);
  LAS float* ft = (LAS float*)lds;
  LAS float* part = ft + 8 * D;
  for (int it = blockIdx.x; it < NTOK / 8; it += gridDim.x) {
    const int r = ROW0 + it * 8 + wave;
    const float* mod = MODL + (r < CTXL ? 12288 : 0);
    {
      float o[32], h[32];
      ld_row_bf16(OUT + (size_t)r * D, lane, o);
      if (L == 0) ld_row_f32(r < CTXL ? a.in[2] + (size_t)r * D : a.in[0] + (size_t)(r - CTXL) * D, lane, h);
      else ld_row_bf16(HRES + (size_t)r * D, lane, h);
      const float rstd1 = rsqrtf(sumsq32(o) * (1.f / D) + EPS);
#pragma unroll
      for (int j = 0; j < 4; ++j) { const int idx = 8 * lane + 512 * j;
        float g1[8], gt[8]; ld8f(ng + D + idx, g1); ld8f(mod + 2 * D + idx, gt);
#pragma unroll
        for (int i = 0; i < 8; ++i) h[8 * j + i] += gt[i] * (o[8 * j + i] * rstd1 * g1[i]);
        if (!dry) st8h(HRES + (size_t)r * D + idx, &h[8 * j]); }
      const float rstd2 = rsqrtf(sumsq32(h) * (1.f / D) + EPS);
      modulate_store<true, true>(h, rstd2, ng + 2 * D, mod + 3 * D, mod + 4 * D, (bf16_t*)((unsigned char*)F + (size_t)r * D), lane, ft, wave);
    }
    __syncthreads();
    f32x4 acc[4];
#pragma unroll
    for (int nt = 0; nt < 4; ++nt) acc[nt] = (f32x4){0.f, 0.f, 0.f, 0.f};
    { const int trow = lane & 7, kg = lane >> 4, swz = 4 * (trow & 3) + (trow >> 2);
      const bf16_t* rth = RT + (size_t)lane * 8; const bf16_t* rtl = rth + 131072;
#pragma unroll 2
      for (int st = 0; st < 8; ++st) {
        const int ks = 8 * wave + st, c = ks * 4 + kg;
        LAS const char* ap = (LAS const char*)ft + trow * 4096 + ((c ^ swz) << 4);
        const bf16x8 ah = *(LAS const bf16x8*)ap, al = *(LAS const bf16x8*)(ap + 32768);
#pragma unroll
        for (int nt = 0; nt < 4; ++nt) {
          const bf16x8 bh = *(const bf16x8*)(rth + (size_t)((nt * 64 + ks) * 64) * 8), bl = *(const bf16x8*)(rtl + (size_t)((nt * 64 + ks) * 64) * 8);
          acc[nt] = __builtin_amdgcn_mfma_f32_16x16x32_bf16(ah, bh, acc[nt], 0, 0, 0);
          acc[nt] = __builtin_amdgcn_mfma_f32_16x16x32_bf16(ah, bl, acc[nt], 0, 0, 0);
          acc[nt] = __builtin_amdgcn_mfma_f32_16x16x32_bf16(al, bh, acc[nt], 0, 0, 0); }
      }
      if (kg < 2) {
#pragma unroll
        for (int rr = 0; rr < 4; ++rr)
#pragma unroll
          for (int nt = 0; nt < 4; ++nt) part[(wave * 8 + 4 * kg + rr) * 64 + nt * 16 + (lane & 15)] = acc[nt][rr]; }
    }
    __syncthreads();
    float logit = 0;
#pragma unroll
    for (int w = 0; w < 8; ++w) logit += part[(w * 8 + wave) * 64 + lane];
#if MK_DIAG
    ((float*)(a.ws + WS_Y))[(size_t)r * 64 + lane] = logit;
#endif
    const float score = sigmoidf_(logit);
    const float choice = score + rbias[lane];
    int rank = 0; const int gl = lane & 7;
#pragma unroll
    for (int j = 0; j < 8; ++j) { const float o = __shfl(choice, (lane & ~7) | j); rank += (o > choice || (o == choice && j < gl)) ? 1 : 0; }
    float gs = rank < 2 ? choice : 0.f;
    gs += __shfl_xor(gs, 1); gs += __shfl_xor(gs, 2); gs += __shfl_xor(gs, 4);
    int grank = 0; const int g = lane >> 3;
#pragma unroll
    for (int j = 0; j < 8; ++j) { const float o = __shfl(gs, j * 8); grank += (o > gs || (o == gs && j < g)) ? 1 : 0; }
    const bool gsel = grank < 4;
    const float mc = gsel ? choice : -INFINITY;
    int erank = 0;
#pragma unroll 4
    for (int j = 0; j < 64; ++j) { const float o = __int_as_float(__builtin_amdgcn_readlane(__float_as_int(mc), j)); erank += (o > mc || (o == mc && j < lane)) ? 1 : 0; }
    const bool sel = gsel && erank < 8;
    const unsigned long long bal = __ballot(sel);
    const int idx = __popcll(bal & ((1ull << lane) - 1ull));
    const float ssum = wave_sum(sel ? score : 0.f);
    if (sel && !dry) { const int pos = atomicAdd(&counts[lane], 1);
      top_e[r * 8 + idx] = lane; top_w[r * 8 + idx] = score / ssum * 2.5f; top_p[r * 8 + idx] = pos; elist[(size_t)lane * ECAP + pos] = r; }
  }
}

__device__ __forceinline__ void moe_tile_prefix(const int* counts, LAS int* ts) {
  if (threadIdx.x == 0) { int s = 0; for (int e = 0; e < 64; ++e) { ts[e] = s; s += (counts[e] + 255) >> 8; } ts[64] = s; }
  __syncthreads();
}
__device__ __forceinline__ void phase_H(const Args& a, int L, LAS char* lds) {
  const int NTOK = L == 0 ? MT : SEQ, ROW0 = L == 0 ? 0 : CTXL;
  const int* counts = (const int*)(a.ws + WS_CTL + CTL_CNT) + L * 64;
  const int* top_e = (const int*)(a.ws + WS_TOPE); const int* top_p = (const int*)(a.ws + WS_TOPP);
  int* tslot = (int*)(a.ws + WS_TSLOT); int* stok = (int*)(a.ws + WS_STOK);
  LAS int* ts = (LAS int*)lds;
  moe_tile_prefix(counts, ts);
  int tid = threadIdx.x; asm volatile("" : "+v"(tid)); tid &= 511;
  const int gt = blockIdx.x * NTHREADS + tid, gs = gridDim.x * NTHREADS;
  for (int i = gt; i < NTOK * 8; i += gs) { const int q = ROW0 * 8 + i; const int e = top_e[q]; const int slot = ts[e] * 256 + top_p[q]; stok[slot] = q >> 3; tslot[q] = slot; }
  for (int i = gt; i < 64 * 256; i += gs) { const int e = i >> 8, p = i & 255, cnt = counts[e], nt = (cnt + 255) >> 8; if (cnt + p < nt * 256) stok[ts[e] * 256 + cnt + p] = ROW0; }
  for (int i = gt; i < NTOK; i += gs) stok[SH_BASE + i] = ROW0 + i;
  __syncthreads();
}
struct GatherTile {
  const int* lp; int nv, idb;
  __device__ __forceinline__ int tok(int ri) const { return idb >= 0 ? idb + ri : (ri < nv ? lp[ri] : -idb - 1); }
};
struct DenseSched {
  int nM, nN, r0; const unsigned char* W;
  __device__ __forceinline__ GatherTile gather_tile(int) const { return GatherTile{nullptr, 0, 0}; }
  __device__ __forceinline__ bool unit(int i, int& brow, const unsigned char*& Bt, int& bcol) const {
    const int u = blockIdx.x + i * (int)gridDim.x; if (u >= nM * nN) return false;
    int pm, pn; dense_unit(u, nM, nN, pm, pn); brow = r0 + pm * 256; bcol = pn * 256; Bt = W; return true; }
};
struct MoeSched {
  LAS const int* ts; int TR, NN, total; const unsigned char* W; size_t woff; const int* counts; const int* elist; int row0;
  __device__ __forceinline__ GatherTile gather_tile(int slot0) const {
    if (slot0 >= SH_BASE) return GatherTile{nullptr, 0, row0 + (slot0 - SH_BASE)};
    const int m = slot0 >> 8, le = (int)__builtin_amdgcn_mbcnt_hi(~0u, __builtin_amdgcn_mbcnt_lo(~0u, 0u));
    const int e = __popcll(__ballot(ts[le + 1] <= m)), first = (m - ts[e]) * 256;
    return GatherTile{elist + (size_t)e * ECAP + first, counts[e] - first, -row0 - 1};
  }
  __device__ __forceinline__ bool unit(int i, int& slot0, const unsigned char*& Bt, int& bcol) const {
    for (int u = blockIdx.x + i * (int)gridDim.x; ; u += gridDim.x) {
      const int rnd = u >> 8, b = u & 255, v = rnd * 256 + (b & 7) * 32 + (b >> 3);
      if (rnd * 256 >= total) return false;
      if (v >= total) return false;
      const int m = v / NN, pn = v % NN;
      int e;
      if (m >= TR) { e = 64; slot0 = SH_BASE + 256 * (m - TR); }
      else { const int le = (int)__builtin_amdgcn_mbcnt_hi(~0u, __builtin_amdgcn_mbcnt_lo(~0u, 0u));
        e = __popcll(__ballot(ts[le + 1] <= m)); slot0 = 256 * m; }
      Bt = W + (size_t)e * WMOE8_E + woff; bcol = pn * 256;
      return true;
    }
  }
};
template <int GV = 0>
__device__ __forceinline__ void phase_moe_up(const Args& a, int L, LAS char* lds) {
  const int NSH = L == 0 ? MT / 256 : SEQ / 256;
  const int* counts = (const int*)(a.ws + WS_CTL + CTL_CNT) + L * 64;
  LAS int* ts = (LAS int*)(lds + LDS_CTL + 64);
  moe_tile_prefix(counts, ts);
  const int TR = ts[64], TM = TR + NSH;
  const unsigned char* F = (const unsigned char*)(a.ws + WS_ABUF); const unsigned char* W = (const unsigned char*)(a.ws + WS_WMOE) + (size_t)L * 65 * WMOE8_E;
  const int* stok = (const int*)(a.ws + WS_STOK);
  EpiSwiGLU8 epi{(unsigned char*)(a.ws + WS_ACT), EFF};
  MoeSched sc{ts, TR, 4, TM * 4, W, 0, counts, (const int*)(a.ws + WS_ELIST), L == 0 ? 0 : CTXL};
  gemm8_run<true, D, D, D, GV>(F, stok, lds, epi, sc);
}
template <int GV = 0>
__device__ __forceinline__ void phase_moe_down(const Args& a, int L, LAS char* lds) {
  const int NSH = L == 0 ? MT / 256 : SEQ / 256;
  const int* counts = (const int*)(a.ws + WS_CTL + CTL_CNT) + L * 64;
  LAS int* ts = (LAS int*)(lds + LDS_CTL + 64);
  moe_tile_prefix(counts, ts);
  const int TR = ts[64], TM = TR + NSH;
  const unsigned char* ACT = (const unsigned char*)(a.ws + WS_ACT); const unsigned char* W = (const unsigned char*)(a.ws + WS_WMOE) + (size_t)L * 65 * WMOE8_E;
  EpiPlain8 epi{(unsigned char*)(a.ws + WS_Y), D, 16.f / 128.f};
  MoeSched sc{ts, TR, 8, TM * 8, W, (size_t)1024 * D, counts, nullptr, 0};
  gemm8_run<false, EFF, EFF, EFF, GV>(ACT, nullptr, lds, epi, sc);
}
__device__ __forceinline__ void phase_combine(const Args& a, int L, LAS char* lds, bool dry = false) {
  int tid = threadIdx.x; asm volatile("" : "+v"(tid)); tid &= 511; const int wave = tid >> 6, lane = tid & 63;
  const int NTOK = L == 0 ? MT : SEQ, ROW0 = L == 0 ? 0 : CTXL;
  const float* ng = a.in[6] + (size_t)L * 4 * D;
  const float* MODL = (const float*)(a.ws + WS_MOD) + (size_t)(L * 2) * 12288;
  const unsigned char* Y = (const unsigned char*)(a.ws + WS_Y);
  bf16_t* HRES = (bf16_t*)(a.ws + WS_HRES);
  const int* top_e = (const int*)(a.ws + WS_TOPE); const int* top_p = (const int*)(a.ws + WS_TOPP); const float* top_w = (const float*)(a.ws + WS_TOPW);
  LAS int* ts = (LAS int*)(lds + LDS_CTL + 64);
  moe_tile_prefix((const int*)(a.ws + WS_CTL + CTL_CNT) + L * 64, ts);
  for (int it = blockIdx.x; it < NTOK / 8; it += gridDim.x) {
    const int r = ROW0 + it * 8 + wave;
    const float* mod = MODL + (r < CTXL ? 12288 : 0);
    float y[32];
    { float t[32]; ld_row_fp8(Y + (size_t)(SH_BASE + r - ROW0) * D, lane, t);
#pragma unroll
      for (int i = 0; i < 32; ++i) y[i] = t[i] * (1.f / 16.f); }
#pragma unroll 4
    for (int k = 0; k < 8; ++k) { const int slot = ts[top_e[r * 8 + k]] * 256 + top_p[r * 8 + k]; const float w = top_w[r * 8 + k] * (1.f / 16.f);
      float t[32]; ld_row_fp8(Y + (size_t)slot * D, lane, t);
#pragma unroll
      for (int i = 0; i < 32; ++i) y[i] += w * t[i]; }
    const float rstd = rsqrtf(sumsq32(y) * (1.f / D) + EPS);
    float h[32]; ld_row_bf16(HRES + (size_t)r * D, lane, h);
#pragma unroll
    for (int j = 0; j < 4; ++j) { const int idx = 8 * lane + 512 * j;
      float g3[8], gt[8]; ld8f(ng + 3 * D + idx, g3); ld8f(mod + 5 * D + idx, gt);
#pragma unroll
      for (int i = 0; i < 8; ++i) h[8 * j + i] += gt[i] * (y[8 * j + i] * rstd * g3[i]);
      if (L == 0) { if (!dry) st8h(HRES + (size_t)r * D + idx, &h[8 * j]); } else st8f(a.out + (size_t)(r - CTXL) * D + idx, &h[8 * j]); }
    if (L == 0) {
      const float* mod1 = MODL + 2 * 12288 + (r < CTXL ? 12288 : 0);
      const float rstd2 = rsqrtf(sumsq32(h) * (1.f / D) + EPS);
#if DENSE8_G1
      modulate_store<false, true>(h, rstd2, a.in[6] + (size_t)4 * D, mod1, mod1 + D, (bf16_t*)((unsigned char*)(a.ws + WS_ABUF) + (size_t)r * D), lane, nullptr);
#else
      modulate_store<false>(h, rstd2, a.in[6] + (size_t)4 * D, mod1, mod1 + D, (bf16_t*)(a.ws + WS_ABUF) + (size_t)r * D, lane, nullptr);
#endif
    }
  }
}

constexpr int NPH = 21;
typedef const __attribute__((address_space(4))) Args* ArgsP;
#if defined(__HIP_DEVICE_COMPILE__)
#define FRESH_ARGS() const Args a = *({ ArgsP _p = (ArgsP)__builtin_amdgcn_kernarg_segment_ptr(); asm volatile("" : "+s"(_p)); _p; })
#else
#define FRESH_ARGS() const Args a = kargs
#endif
__global__ void __launch_bounds__(NTHREADS, 2) fwd(Args kargs) {
  extern __shared__ __attribute__((aligned(16))) unsigned char lds_raw[];
  LAS char* lds = (LAS char*)lds_raw;
  const int lo = kargs.ph_lo, hi = kargs.ph_hi;
  if (threadIdx.x < 64) ((LAS unsigned*)(lds + LDS_CTL))[threadIdx.x] = 0u;
  __syncthreads();
  if (hi - lo > 1) (void)xcd_barrier_post((unsigned*)(kargs.ws + WS_CTL), (volatile LAS unsigned*)(lds + LDS_CTL));
#ifndef PHASE_MASK
#define PHASE_MASK 0xFFFFFFFFu
#endif
#define IN(k) (((PHASE_MASK >> (k)) & 1u) && lo <= (k) && (k) < hi)
#ifndef PH_REPEAT_MASK
#define PH_REPEAT_MASK 0u
#endif
#define REP(k) for (int _rep = 0; _rep < (((PH_REPEAT_MASK >> (k)) & 1u) ? 2 : 1); ++_rep)
#define SEAM(k) do { if ((k) + 1 < hi) { XcdBarrier _b; _b.bar = (unsigned*)(a.ws + WS_CTL); _b.x = xb_xcc_id(); _b.st = (volatile LAS unsigned*)(lds + LDS_CTL); xcd_barrier(_b); } } while (0)

  if (IN(0)) { FRESH_ARGS(); REP(0) phase_prologue(a, lds); SEAM(0); }
  if (IN(1)) { FRESH_ARGS(); REP(1) phase_modulate0(a); SEAM(1); }
#pragma unroll
  for (int L = 0; L < 2; ++L) {
    const int base = 2 + (L == 0 ? 0 : 9);
    if (IN(base + 0)) {
      FRESH_ARGS();
      const int nN = L == 0 ? N_IN0 / 256 : N_IN1 / 256, nM = MT / 256;
#if DENSE8_G1
      const unsigned char* A = (const unsigned char*)(a.ws + WS_ABUF);
      EpiG1 epi{EpiPlain{(bf16_t*)(a.ws + WS_QKVU), L == 0 ? N_QKV0 : N_IN1, 1.f / 256.f}, EpiPair<0>{(bf16_t*)(a.ws + WS_HG), 1024, N_QKV0, 1.f / 256.f}, L == 0 ? N_QKV0 : N_IN1};
      DenseSched sc{nM, nN, 0, (const unsigned char*)(a.ws + (L == 0 ? WS_WIN0 : WS_WIN1))};
      REP(2) gemm8_run<false, D, D, D>(A, nullptr, lds, epi, sc);
#else
      const bf16_t* A = (const bf16_t*)(a.ws + WS_ABUF);
      const bf16_t* Bt = (const bf16_t*)(a.ws + (L == 0 ? WS_WIN0 : WS_WIN1));
      EpiG1 epi{EpiPlain{(bf16_t*)(a.ws + WS_QKVU), L == 0 ? N_QKV0 : N_IN1, 1.f}, EpiPair<0>{(bf16_t*)(a.ws + WS_HG), 1024, N_QKV0, 1.f}, L == 0 ? N_QKV0 : N_IN1};
      REP(2) for (int u = blockIdx.x; u < nM * nN; u += gridDim.x) { int pm, pn; dense_unit(u, nM, nN, pm, pn);
        gemm_tile<false>(A, D, nullptr, pm * 256, Bt, D, pn * 256, D, lds, epi); }
#endif
      SEAM(base + 0);
    }
    if (L == 0) {
      if (IN(3)) { FRESH_ARGS(); if ((PH_REPEAT_MASK >> 3) & 1u) { phase_rope_conv0(a, lds, true); __syncthreads(); } phase_rope_conv0(a, lds); SEAM(3); }
      if (IN(4)) { FRESH_ARGS(); if ((PH_REPEAT_MASK >> 4) & 1u) { phase_attn<ATT_VAR>(a, 0, lds); __syncthreads(); } phase_attn<0>(a, 0, lds); SEAM(4); }
    } else {
      if (IN(12)) { FRESH_ARGS(); if ((PH_REPEAT_MASK >> 12) & 1u) { phase_rope1(a, lds, true); __syncthreads(); } phase_rope1(a, lds); SEAM(12); }
      if (IN(13)) { FRESH_ARGS(); if ((PH_REPEAT_MASK >> 13) & 1u) { phase_attn<ATT_VAR>(a, 1, lds); __syncthreads(); } phase_attn<0>(a, 1, lds); SEAM(13); }
    }
    const int b2 = L == 0 ? 5 : 15;
    if (IN(b2 + 0)) {
      FRESH_ARGS();
      const int nN = D / 256, nM = L == 0 ? MT / 256 : SEQ / 256, r0 = L == 0 ? 0 : CTXL;
#if DENSE8_G2
      const unsigned char* A = (const unsigned char*)(a.ws + WS_X2);
      EpiPlain epi{(bf16_t*)(a.ws + WS_OUT), D, 1.f / 2048.f};
      DenseSched sc{nM, nN, r0, (const unsigned char*)(a.ws + (L == 0 ? WS_WOUT0 : WS_WOUT1))};
      REP(5) gemm8_run<false, D, D, D>(A, nullptr, lds, epi, sc);
#else
      const bf16_t* A = (const bf16_t*)(a.ws + WS_X2);
      const bf16_t* Bt = (const bf16_t*)(a.ws + (L == 0 ? WS_WOUT0 : WS_WOUT1));
      EpiPlain epi{(bf16_t*)(a.ws + WS_OUT), D, 1.f};
      REP(5) for (int u = blockIdx.x; u < nM * nN; u += gridDim.x) { int pm, pn; dense_unit(u, nM, nN, pm, pn);
        gemm_tile<false>(A, D, nullptr, r0 + pm * 256, Bt, D, pn * 256, D, lds, epi); }
#endif
      SEAM(b2 + 0);
    }
    if (IN(b2 + 1)) { FRESH_ARGS(); if ((PH_REPEAT_MASK >> 6) & 1u) { phase_G(a, L, lds, true); __syncthreads(); } phase_G(a, L, lds); SEAM(b2 + 1); }
    if (IN(b2 + 3)) { FRESH_ARGS(); if ((PH_REPEAT_MASK >> 8) & 1u) { phase_moe_up<GEMM_VAR>(a, L, lds); __syncthreads(); } phase_moe_up<0>(a, L, lds); SEAM(b2 + 3); }
    if (IN(b2 + 4)) { FRESH_ARGS(); if ((PH_REPEAT_MASK >> 9) & 1u) { phase_moe_down<GEMM_VAR>(a, L, lds); __syncthreads(); } phase_moe_down<0>(a, L, lds); SEAM(b2 + 4); }
    if (IN(b2 + 5)) { FRESH_ARGS(); if ((PH_REPEAT_MASK >> 10) & 1u) phase_combine(a, L, lds, true); phase_combine(a, L, lds); SEAM(b2 + 5); }
  }
#undef IN
#undef SEAM
}

#ifndef MK_DIAG
#define MK_DIAG 0
#endif
#if MK_DIAG
__device__ __forceinline__ void rope_cs(int r, int lane, float& cs, float& sn) {
  cs = 1.f; sn = 0.f;
  if (r >= CTXL) { const int t = r - CTXL; const int a = lane >> 5, i = lane & 31;
    const float pos = a ? (float)(t & 63) : (float)(t >> 6);
    const float inv = powf(10000.f, -(float)i / 32.f);
    sincosf(pos * inv, &sn, &cs); }
}
__device__ __forceinline__ bool dclose(float got, float ref, float rtol, float atol) { return fabsf(got - ref) <= rtol * fabsf(ref) + atol; }
__device__ __forceinline__ unsigned dhash(unsigned x) { x ^= x >> 16; x *= 0x7feb352du; x ^= x >> 15; x *= 0x846ca68bu; x ^= x >> 16; return x; }
__device__ float wdot(const bf16_t* arow, const float* W, int ldw, int col, int K, int lane) {
  float s = 0; for (int k = lane; k < K; k += 64) s += bf2f(arow[k]) * W[(size_t)k * ldw + col]; return wave_sum(s); }
__device__ float dq8(const unsigned char* p, size_t i) { const unsigned w = ((const unsigned*)p)[i >> 2]; const int b = (int)(i & 3);
  return b == 0 ? __builtin_amdgcn_cvt_f32_fp8((int)w, 0) : b == 1 ? __builtin_amdgcn_cvt_f32_fp8((int)w, 1) : b == 2 ? __builtin_amdgcn_cvt_f32_fp8((int)w, 2) : __builtin_amdgcn_cvt_f32_fp8((int)w, 3); }
__device__ float wdot8(const unsigned char* arow8, const float* W, int ldw, int col, int K, int lane) {
  float s = 0; for (int k = lane; k < K; k += 64) s += dq8(arow8, k) * W[(size_t)k * ldw + col]; return wave_sum(s); }
__device__ void dflag(int* dg, int s, int bad, int lane) { if (lane == 0 && bad) atomicAdd(&dg[s], bad); }
__device__ const float* h0row(const Args& a, int r) { return r < CTXL ? a.in[2] + (size_t)r * D : a.in[0] + (size_t)(r - CTXL) * D; }
__device__ int pick_row(unsigned h, int lo, int n) { const unsigned m = h % 8; if (m == 0) return lo; if (m == 1) return lo + n - 1; if (m == 2) return lo + 255 < lo + n ? lo + 255 : lo; if (m == 3) return lo + 256 < lo + n ? lo + 256 : lo; return lo + (int)((h >> 3) % (unsigned)n); }
__device__ void naive_attn(const bf16_t* q, const bf16_t* K, const bf16_t* V, int ld, int nkeys, int lane, float& o0, float& o1) {
  const float q0 = bf2f(q[lane]), q1 = bf2f(q[lane + 64]);
  float m = -1e30f, l = 0; o0 = 0; o1 = 0;
  for (int k = 0; k < nkeys; ++k) {
    const float s = wave_sum(q0 * bf2f(K[(size_t)k * ld + lane]) + q1 * bf2f(K[(size_t)k * ld + lane + 64])) * 0.088388347648318440f;
    const float mn = fmaxf(m, s), al = expf(m - mn), p = expf(s - mn);
    l = l * al + p; o0 = o0 * al + p * bf2f(V[(size_t)k * ld + lane]); o1 = o1 * al + p * bf2f(V[(size_t)k * ld + lane + 64]); m = mn;
  }
  o0 /= l; o1 /= l;
}
__global__ void __launch_bounds__(256) diag(Args a, int k) {
  __shared__ float fsh[4][2048];
  __shared__ float csh[4][64];
  const int lane = threadIdx.x & 63, wv = threadIdx.x >> 6, gw = blockIdx.x * 4 + wv;
  int* dg = (int*)(a.ws + WS_CTL + CTL_CNT + 512);
  const float* MOD = (const float*)(a.ws + WS_MOD);
  const bf16_t* AB = (const bf16_t*)(a.ws + WS_ABUF);
  const bf16_t* QK = (const bf16_t*)(a.ws + WS_QKVU);
  const bf16_t* HG = (const bf16_t*)(a.ws + WS_HG);
  const bf16_t* X2 = (const bf16_t*)(a.ws + WS_X2);
  const bf16_t* OUT = (const bf16_t*)(a.ws + WS_OUT);
  const bf16_t* ACT = (const bf16_t*)(a.ws + WS_ACT);
  const bf16_t* Y = (const bf16_t*)(a.ws + WS_Y);
  const float* HRES = (const float*)(a.ws + WS_HRES);
  const int* top_e = (const int*)(a.ws + WS_TOPE); const float* top_w = (const float*)(a.ws + WS_TOPW); const int* top_p = (const int*)(a.ws + WS_TOPP);
  const int* tslot = (const int*)(a.ws + WS_TSLOT); const int* stok = (const int*)(a.ws + WS_STOK);
  const unsigned h = dhash(gw * 7919u + k * 104729u + 17u), h2 = dhash(h + 12345u);
  int bad = 0;
  const int L = k >= 11 ? 1 : 0;
  const int NTOK = L == 0 ? MT : SEQ, ROW0 = L == 0 ? 0 : CTXL;
  const int* counts = (const int*)(a.ws + WS_CTL + CTL_CNT) + L * 64;
  if (k == 0) {
    const int LL = gw & 1, which = (gw >> 1) & 1, j = h % 12288;
    const float* v = which ? a.in[3] : a.in[1];
    float s = 0; for (int d = lane; d < D; d += 64) { const float x = v[d]; s += x * sigmoidf_(x) * a.in[4][((size_t)LL * D + d) * 12288 + j]; }
    s = wave_sum(s) + a.in[5][LL * 12288 + j];
    bad = !dclose(MOD[(LL * 2 + which) * 12288 + j], s, 1e-3f, 1e-3f); dflag(dg, 1, bad, lane);
  } else if (k == 1) {
    const int r = pick_row(h, 0, MT); const float* x = h0row(a, r); const float* mod = MOD + (r < CTXL ? 12288 : 0);
    float ss = 0; for (int d = lane; d < D; d += 64) ss += x[d] * x[d]; ss = wave_sum(ss); const float rstd = rsqrtf(ss / D + EPS);
    for (int d = lane; d < D; d += 64) { const float ref = x[d] * rstd * a.in[6][d] * (1.f + mod[D + d]) + mod[d]; bad += !dclose(bf2f(AB[(size_t)r * D + d]), ref, 0.01f, 0.01f); }
    bad = (int)wave_sum((float)bad); dflag(dg, 2, bad, lane);
  } else if (k == 2 || k == 11) {
    const int r = pick_row(h, 0, MT);
    if (L == 0) {
      const int c = h2 % N_QKV0; const float ref = wdot(AB + (size_t)r * D, a.in[7], N_IN0, c, D, lane);
      bad = !dclose(bf2f(QK[(size_t)r * N_QKV0 + c]), ref, 0.02f, 0.05f); dflag(dg, 3, bad, lane);
      const int ch = (h2 >> 11) % 1024; const float av = wdot(AB + (size_t)r * D, a.in[7], N_IN0, N_QKV0 + ch, D, lane), gv = wdot(AB + (size_t)r * D, a.in[7], N_IN0, N_QKV0 + 1024 + ch, D, lane);
      bad = !dclose(bf2f(HG[(size_t)r * 1024 + ch]), av * sigmoidf_(gv), 0.03f, 0.05f); dflag(dg, 4, bad, lane);
    } else {
      const int c = h2 % N_IN1; const float ref = wdot(AB + (size_t)r * D, a.in[15], N_IN1, c, D, lane);
      bad = !dclose(bf2f(QK[(size_t)r * N_IN1 + c]), ref, 0.02f, 0.05f); dflag(dg, 15, bad, lane);
    }
  } else if (k == 3) {
    { const int r = pick_row(h, 0, MT), hh = h2 % 10; const float* g = hh < 8 ? a.in[9] : a.in[10];
      float raw0 = 0, raw1 = 0;
      for (int d = 0; d < 128; ++d) { const float v = wdot(AB + (size_t)r * D, a.in[7], N_IN0, hh * 128 + d, D, lane); if (d == lane) raw0 = v; if (d == lane + 64) raw1 = v; }
      const float rstd = rsqrtf(wave_sum(raw0 * raw0 + raw1 * raw1) / 128.f + EPS);
      const float y0 = raw0 * rstd * g[lane], y1 = raw1 * rstd * g[lane + 64];
      float cs, sn; rope_cs(r, lane, cs, sn);
      const float cs0 = __shfl(cs, lane & 31), sn0 = __shfl(sn, lane & 31), cs1 = __shfl(cs, 32 + (lane & 31)), sn1 = __shfl(sn, 32 + (lane & 31));
      const float p0 = __shfl_xor(y0, 32), p1 = __shfl_xor(y1, 32);
      const float o0 = (lane < 32) ? y0 * cs0 - p0 * sn0 : y0 * cs0 + p0 * sn0;
      const float o1 = (lane < 32) ? y1 * cs1 - p1 * sn1 : y1 * cs1 + p1 * sn1;
      bad = !dclose(bf2f(QK[(size_t)r * N_QKV0 + hh * 128 + lane]), o0, 0.03f, 0.05f) + !dclose(bf2f(QK[(size_t)r * N_QKV0 + hh * 128 + 64 + lane]), o1, 0.03f, 0.05f);
      bad = (int)wave_sum((float)bad); dflag(dg, 5, bad, lane); }
    { const int r = pick_row(h2, 0, MT); const int seg0 = r < CTXL ? 0 : CTXL, seg1 = r < CTXL ? CTXL : MT;
      float cv[16]; float s1 = 0, s2 = 0;
      for (int q = 0; q < 16; ++q) { const int c = lane + 64 * q; float acc = a.in[12][c];
        for (int j = 0; j < 31; ++j) { const int rr = r + j - 15; if (rr >= seg0 && rr < seg1) acc += bf2f(HG[(size_t)rr * 1024 + c]) * a.in[11][j * 1024 + c]; }
        cv[q] = acc; s1 += acc; s2 += acc * acc; }
      s1 = wave_sum(s1); s2 = wave_sum(s2); const float mean = s1 / 1024.f, rstd = rsqrtf(s2 / 1024.f - mean * mean + EPS);
      bad = 0;
      for (int q = 0; q < 16; ++q) { const int c = lane + 64 * q; float y = (cv[q] - mean) * rstd * a.in[13][c] + a.in[14][c]; y = y * sigmoidf_(y);
        bad += !dclose(bf2f(X2[(size_t)r * D + 1024 + c]), y, 0.03f, 0.03f); }
      bad = (int)wave_sum((float)bad); dflag(dg, 6, bad, lane); }
  } else if (k == 4) {
    if (gw < 64) { const int r = pick_row(h, 0, MT), head = h2 % 8; const int nkeys = r < CTXL ? CTXL : MT;
      float o0, o1; naive_attn(QK + (size_t)r * N_QKV0 + head * 128, QK + 1024 + (head >> 2) * 128, QK + 1280 + (head >> 2) * 128, N_QKV0, nkeys, lane, o0, o1);
      const float rt = r < CTXL ? 0.15f : 0.05f, at_ = r < CTXL ? 0.04f : 0.01f;
      bad = !dclose(bf2f(X2[(size_t)r * D + head * 128 + lane]), o0, rt, at_) + !dclose(bf2f(X2[(size_t)r * D + head * 128 + 64 + lane]), o1, rt, at_);
      bad = (int)wave_sum((float)bad); dflag(dg, r < CTXL ? 26 : 7, bad, lane); }
  } else if (k == 5 || k == 15) {
    const int r = pick_row(h, ROW0, NTOK), c = h2 % D; const float ref = wdot(X2 + (size_t)r * D, L == 0 ? a.in[8] : a.in[16], D, c, D, lane);
    bad = !dclose(bf2f(OUT[(size_t)r * D + c]), ref, 0.02f, 0.05f); dflag(dg, L == 0 ? 8 : 19, bad, lane);
  } else if (k == 6 || k == 16) {
    const int r = pick_row(h, ROW0, NTOK); const float* mod = MOD + (size_t)(L * 2) * 12288 + (r < CTXL ? 12288 : 0); const float* ng = a.in[6] + (size_t)L * 4 * D;
    float ss = 0; for (int d = lane; d < D; d += 64) { const float o = bf2f(OUT[(size_t)r * D + d]); ss += o * o; } ss = wave_sum(ss); const float rstd1 = rsqrtf(ss / D + EPS);
    bad = 0;
    if (L == 0) { const float* x = h0row(a, r); for (int d = lane; d < D; d += 64) { const float ref = x[d] + mod[2 * D + d] * (bf2f(OUT[(size_t)r * D + d]) * rstd1 * ng[D + d]); bad += !dclose(HRES[(size_t)r * D + d], ref, 1e-3f, 1e-3f); } }
    float s2 = 0; for (int d = lane; d < D; d += 64) { const float x = HRES[(size_t)r * D + d]; s2 += x * x; } s2 = wave_sum(s2); const float rstd2 = rsqrtf(s2 / D + EPS);
    for (int d = lane; d < D; d += 64) { const float f = HRES[(size_t)r * D + d] * rstd2 * ng[2 * D + d] * (1.f + mod[4 * D + d]) + mod[3 * D + d]; fsh[wv][d] = f; bad += !dclose(dq8((const unsigned char*)AB + (size_t)r * D, d), f, 0.07f, 0.01f); }
    bad = (int)wave_sum((float)bad); dflag(dg, L == 0 ? 9 : 20, bad, lane);
    __syncthreads();
    float lg = 0; for (int d = 0; d < D; ++d) lg += fsh[wv][d] * a.in[19][((size_t)L * D + d) * NE + lane];
    const float sc = sigmoidf_(lg); csh[wv][lane] = sc + a.in[20][L * NE + lane];
    __syncthreads();
    { const float plg = ((const float*)(a.ws + WS_Y))[(size_t)r * 64 + lane]; int lb = !dclose(plg, lg, 1e-3f, 1e-3f); lb = (int)wave_sum((float)lb); if (lane == 0 && lb) { atomicAdd(&dg[32 + (L == 0 ? 10 : 21) + 3], 1); atomicOr(&dg[60], 1 << (r & 7)); } }
    unsigned long long wsel;
    { const float choice = csh[wv][lane]; int rank = 0; const int gl = lane & 7;
      for (int j = 0; j < 8; ++j) { const float o = __shfl(choice, (lane & ~7) | j); rank += (o > choice || (o == choice && j < gl)) ? 1 : 0; }
      float gs = rank < 2 ? choice : 0.f; gs += __shfl_xor(gs, 1); gs += __shfl_xor(gs, 2); gs += __shfl_xor(gs, 4);
      int grank = 0; const int g = lane >> 3;
      for (int j = 0; j < 8; ++j) { const float o = __shfl(gs, j * 8); grank += (o > gs || (o == gs && j < g)) ? 1 : 0; }
      const bool gsel = grank < 4; const float mc = gsel ? choice : -INFINITY; int erank = 0;
      for (int j = 0; j < 64; ++j) { const float o = __shfl(mc, j); erank += (o > mc || (o == mc && j < lane)) ? 1 : 0; }
      wsel = __ballot(gsel && erank < 8); }
    int setbad = 0;
    if (lane == 0) {
      float gsc[8]; for (int g = 0; g < 8; ++g) { float m1 = -1e30f, m2 = -1e30f; for (int j = 0; j < 8; ++j) { const float v = csh[wv][g * 8 + j]; if (v > m1) { m2 = m1; m1 = v; } else if (v > m2) m2 = v; } gsc[g] = m1 + m2; }
      bool gs[8] = {false, false, false, false, false, false, false, false};
      for (int t = 0; t < 4; ++t) { int bi = 0; float bv = -1e30f; for (int g = 0; g < 8; ++g) if (!gs[g] && gsc[g] > bv) { bv = gsc[g]; bi = g; } gs[bi] = true; }
      unsigned long long selm = 0; for (int t = 0; t < 8; ++t) { int bi = 0; float bv = -1e30f; for (int e = 0; e < 64; ++e) if (gs[e >> 3] && !((selm >> e) & 1ull) && csh[wv][e] > bv) { bv = csh[wv][e]; bi = e; } selm |= 1ull << bi; }
      unsigned long long got = 0; for (int t = 0; t < 8; ++t) { const int e = top_e[r * 8 + t]; if (e < 0 || e > 63) setbad = 1000; else got |= 1ull << e; }
      if (setbad == 0 && got != selm) setbad = 1;
      if (wsel != selm) atomicAdd(&dg[32 + (L == 0 ? 10 : 21) + 4], 1);
    }
    setbad = __shfl(setbad, 0);
    { float wgot = -1.f; int mine = 0; for (int t = 0; t < 8; ++t) if (top_e[r * 8 + t] == lane) { mine = 1; wgot = top_w[r * 8 + t]; }
      const float ssum = wave_sum(mine ? sc : 0.f);
      int wbad = (mine && !dclose(wgot, sc / ssum * 2.5f, 0.01f, 1e-3f)) ? 1 : 0; wbad = (int)wave_sum((float)wbad);
      if (lane == 0) { int* q = &dg[32 + (L == 0 ? 10 : 21)]; if (setbad >= 1000) atomicAdd(q + 1, 1); else if (setbad) atomicAdd(q, 1); else if (wbad) atomicAdd(q + 2, 1); } }
  } else if (k == 7 || k == 17) {
    const int r = pick_row(h, ROW0, NTOK), t = h2 % 8, q = r * 8 + t; const int slot = tslot[q], e = top_e[q];
    int ts0 = 0; for (int j = 0; j < e; ++j) ts0 += (counts[j] + 255) >> 8;
    bad = (slot < ts0 * 256 || slot >= ts0 * 256 + counts[e] || stok[slot] != r || top_p[q] != slot - ts0 * 256) ? 1 : 0;
    bad += (stok[SH_BASE + r - ROW0] != r) ? 1 : 0;
    dflag(dg, L == 0 ? 11 : 22, bad, lane);
  } else if (k == 8 || k == 18 || k == 9 || k == 19) {
    int TR = 0; for (int j = 0; j < 64; ++j) TR += (counts[j] + 255) >> 8;
    int slot, e;
    if ((h & 3) == 0) { slot = SH_BASE + (int)((h >> 2) % (unsigned)NTOK); e = 64; }
    else { e = (h >> 2) % 64; int guard = 0; while (counts[e] == 0 && guard++ < 64) e = (e + 1) % 64; int ts0 = 0; for (int j = 0; j < e; ++j) ts0 += (counts[j] + 255) >> 8;
      const unsigned m = (h >> 8) % 4; const int cnt = counts[e]; const int p = m == 0 ? 0 : m == 1 ? cnt - 1 : (int)((h >> 10) % (unsigned)cnt); slot = ts0 * 256 + p; }
    const int tok = stok[slot];
    if (k == 8 || k == 18) {
      const int ch = h2 % EFF;
      const float* Wg = e < 64 ? a.in[21] + ((size_t)L * 64 + e) * D * EFF : a.in[24] + (size_t)L * D * EFF;
      const float* Wu = e < 64 ? a.in[22] + ((size_t)L * 64 + e) * D * EFF : a.in[25] + (size_t)L * D * EFF;
      const unsigned char* F8 = (const unsigned char*)AB + (size_t)tok * D;
      const float gv = wdot8(F8, Wg, EFF, ch, D, lane), uv = wdot8(F8, Wu, EFF, ch, D, lane);
      bad = !dclose(dq8((const unsigned char*)ACT + (size_t)slot * EFF, ch), gv * sigmoidf_(gv) * uv, 0.2f, 0.15f); dflag(dg, L == 0 ? 12 : 23, bad, lane);
    } else {
      const int c = h2 % D; const float* Wd = e < 64 ? a.in[23] + ((size_t)L * 64 + e) * EFF * D : a.in[26] + (size_t)L * EFF * D;
      const float ref = wdot8((const unsigned char*)ACT + (size_t)slot * EFF, Wd, D, c, EFF, lane);
      bad = !dclose(dq8((const unsigned char*)Y + (size_t)slot * D, c) * (1.f / 16.f), ref, 0.2f, 0.15f); dflag(dg, L == 0 ? 13 : 24, bad, lane);
    }
  } else if (k == 10 || k == 20) {
    const int r = pick_row(h, ROW0, NTOK); const float* mod = MOD + (size_t)(L * 2) * 12288 + (r < CTXL ? 12288 : 0); const float* ng = a.in[6] + (size_t)L * 4 * D;
    float ss = 0; for (int d = lane; d < D; d += 64) { const unsigned char* Y8 = (const unsigned char*)Y; float y = dq8(Y8 + (size_t)(SH_BASE + r - ROW0) * D, d) * (1.f / 16.f); for (int t = 0; t < 8; ++t) y += top_w[r * 8 + t] * dq8(Y8 + (size_t)tslot[r * 8 + t] * D, d) * (1.f / 16.f); fsh[wv][d] = y; ss += y * y; }
    ss = wave_sum(ss); const float rstd = rsqrtf(ss / D + EPS);
    bad = 0;
    if (L == 0) { float s2 = 0; for (int d = lane; d < D; d += 64) { const float x = HRES[(size_t)r * D + d]; s2 += x * x; } s2 = wave_sum(s2); const float rstd2 = rsqrtf(s2 / D + EPS);
      const float* mod1 = MOD + (size_t)2 * 12288 + (r < CTXL ? 12288 : 0);
      for (int d = lane; d < D; d += 64) { const float ref = HRES[(size_t)r * D + d] * rstd2 * a.in[6][4 * D + d] * (1.f + mod1[D + d]) + mod1[d]; bad += !dclose(bf2f(AB[(size_t)r * D + d]), ref, 0.01f, 0.01f); } }
    else { for (int d = lane; d < D; d += 64) { const float ref = HRES[(size_t)r * D + d] + mod[5 * D + d] * (fsh[wv][d] * rstd * ng[3 * D + d]); bad += !dclose(a.out[(size_t)(r - CTXL) * D + d], ref, 1e-3f, 1e-3f); } }
    bad = (int)wave_sum((float)bad); dflag(dg, L == 0 ? 14 : 25, bad, lane);
  } else if (k == 12) {
    const int r = pick_row(h, CTXL, SEQ), hh = h2 % 32;
    float raw0 = 0, raw1 = 0;
    for (int d = 0; d < 128; ++d) { const float v = wdot(AB + (size_t)r * D, a.in[15], N_IN1, hh * 128 + d, D, lane); if (d == lane) raw0 = v; if (d == lane + 64) raw1 = v; }
    float cs, sn; rope_cs(r, lane, cs, sn);
    const float cs0 = __shfl(cs, lane & 31), sn0 = __shfl(sn, lane & 31), cs1 = __shfl(cs, 32 + (lane & 31)), sn1 = __shfl(sn, 32 + (lane & 31));
    const float p0 = __shfl_xor(raw0, 32), p1 = __shfl_xor(raw1, 32);
    const float o0 = (lane < 32) ? raw0 * cs0 - p0 * sn0 : raw0 * cs0 + p0 * sn0;
    const float o1 = (lane < 32) ? raw1 * cs1 - p1 * sn1 : raw1 * cs1 + p1 * sn1;
    bad = !dclose(bf2f(QK[(size_t)r * N_IN1 + hh * 128 + lane]), o0, 0.03f, 0.05f) + !dclose(bf2f(QK[(size_t)r * N_IN1 + hh * 128 + 64 + lane]), o1, 0.03f, 0.05f);
    bad = (int)wave_sum((float)bad); dflag(dg, 16, bad, lane);
  } else if (k == 13) {
    if (gw < 64) { const int r = pick_row(h, CTXL, SEQ), hc = h2 % 16, vh = (h2 >> 4) & 1, hd = hc >> 1;
      float o0, o1; naive_attn(QK + (size_t)r * N_IN1 + hc * 128, QK + 2048 + hc * 128, QK + 4096 + hd * 256 + vh * 128, N_IN1, MT, lane, o0, o1);
      const bf16_t* O = Y + (size_t)(r - CTXL) * 4096 + hc * 256 + vh * 128;
      bad = !dclose(bf2f(O[lane]), o0, 0.05f, 0.01f) + !dclose(bf2f(O[64 + lane]), o1, 0.05f, 0.01f);
      bad = (int)wave_sum((float)bad); dflag(dg, 17, bad, lane); }
  } else if (k == 14) {
    const int r = pick_row(h, CTXL, SEQ), hd = h2 % 8; const float* lp = a.in[17];
    float s1 = 0, s2 = 0; for (int i = lane; i < 128; i += 64) { s1 += lp[i] * lp[128 + i]; s2 += lp[256 + i] * lp[384 + i]; } s1 = wave_sum(s1); s2 = wave_sum(s2);
    const float lam = expf(s1) - expf(s2) + LAM_INIT; const bf16_t* O = Y + (size_t)(r - CTXL) * 4096;
    float dv[4], ss = 0; for (int i = 0; i < 4; ++i) { const int d = lane + 64 * i; dv[i] = bf2f(O[(2 * hd) * 256 + d]) - lam * bf2f(O[(2 * hd + 1) * 256 + d]); ss += dv[i] * dv[i]; }
    ss = wave_sum(ss); const float rstd = rsqrtf(ss / 256.f + EPS) * (1.f - LAM_INIT); bad = 0;
    for (int i = 0; i < 4; ++i) { const int d = lane + 64 * i; bad += !dclose(bf2f(X2[(size_t)r * D + hd * 256 + d]), dv[i] * rstd * a.in[18][d], 0.02f, 0.01f); }
    bad = (int)wave_sum((float)bad); dflag(dg, 18, bad, lane);
  }
}
__global__ void diag_encode(Args a) {
  const int* dg = (const int*)(a.ws + WS_CTL + CTL_CNT + 512);
  int s = 0;
  int sub = 0;
  for (int i = 1; i < 32; ++i) { int v = dg[i]; if (i == 10 || i == 21) { v = (dg[32 + i] > 25 ? 1 : 0) + (dg[33 + i] > 0 ? 2 : 0) + (dg[34 + i] > 0 ? 4 : 0) + (dg[35 + i] > 0 ? 8 : 0) + (dg[36 + i] > 0 ? 16 : 0); sub = v; } if (v) { s = i; break; } }
  if (s == 0) return;
  const float c = sub ? 30.f + 8.f * sub : 10.f * s;
  for (size_t i = (size_t)blockIdx.x * blockDim.x + threadIdx.x; i < (size_t)SEQ * D; i += (size_t)gridDim.x * blockDim.x) a.out[i] = c;
}
#endif

extern "C" void kernel_launch(void* const* d_in, const int* in_sizes, int n_in, void* d_out, int out_size, void* d_ws, size_t ws_size, hipStream_t stream) {
  static int grid = 0;
  if (grid == 0) {
    if (n_in != 27 || out_size != SEQ * D || ws_size < WS_END) { fprintf(stderr, "kernel_launch: unexpected shapes (n_in %d out %d ws %zu need %zu)\n", n_in, out_size, ws_size, (size_t)WS_END); grid = -1; return; }
    if (hipFuncSetAttribute((const void*)fwd, hipFuncAttributeMaxDynamicSharedMemorySize, LDS_BYTES) != hipSuccess) { fprintf(stderr, "kernel_launch: hipFuncSetAttribute failed\n"); grid = -1; return; }
    int dev = 0, cus = 0, per_cu = 0;
    hipGetDevice(&dev); hipDeviceGetAttribute(&cus, hipDeviceAttributeMultiprocessorCount, dev);
    if (hipOccupancyMaxActiveBlocksPerMultiprocessor(&per_cu, (const void*)fwd, NTHREADS, LDS_BYTES) != hipSuccess || per_cu < 1) fprintf(stderr, "kernel_launch: occupancy query says %d\n", per_cu);
    (void)hipGetLastError();
    grid = cus < 256 ? cus : 256;
    if (grid != 256) fprintf(stderr, "kernel_launch: %d CUs (expected 256)\n", cus);
  }
  if (grid < 0) return;
  hipMemsetAsync((char*)d_ws + WS_CTL, 0, CTL_BYTES, stream);
  Args a{};
  for (int i = 0; i < 27; ++i) a.in[i] = (const float*)d_in[i];
  a.out = (float*)d_out; a.ws = (unsigned char*)d_ws;
#if MK_MULTI
  for (int k = 0; k < NPH; ++k) { a.ph_lo = k; a.ph_hi = k + 1; hipLaunchKernelGGL(fwd, dim3(grid), dim3(NTHREADS), LDS_BYTES, stream, a);
#if MK_DIAG
    hipLaunchKernelGGL(diag, dim3(64), dim3(256), 0, stream, a, k);
#endif
  }
#if MK_DIAG
  hipLaunchKernelGGL(diag_encode, dim3(1024), dim3(256), 0, stream, a);
#endif
#else
  a.ph_lo = 0; a.ph_hi = NPH;
  hipLaunchKernelGGL(fwd, dim3(grid), dim3(NTHREADS), LDS_BYTES, stream, a);
#endif
  const hipError_t le = hipPeekAtLastError();
  if (le != hipSuccess) fprintf(stderr, "kernel_launch: launch failed: %s\n", hipGetErrorName(le));
}
```

```cpp
#include <hip/hip_runtime.h>
#include <cstdio>
#include <cstdint>

#define MK_DIAG 0
#define ATT_VAR 0
#define GEMM_VAR 0
#ifndef DENSE8_G1
#define DENSE8_G1 1
#endif
#ifndef DENSE8_G2
#define DENSE8_G2 0
#endif
#ifndef MK_MULTI
#define MK_MULTI 0
#endif

#define LAS __attribute__((address_space(3)))
typedef unsigned short bf16_t;
typedef short bf16x8 __attribute__((ext_vector_type(8)));
typedef short s16x4 __attribute__((ext_vector_type(4)));
typedef float f32x4 __attribute__((ext_vector_type(4)));
typedef float f32x2 __attribute__((ext_vector_type(2)));
typedef float f32x16 __attribute__((ext_vector_type(16)));
typedef unsigned u32x4 __attribute__((ext_vector_type(4)));
typedef unsigned u32x2 __attribute__((ext_vector_type(2)));

constexpr int D = 2048, SEQ = 16384, CTXL = 256, MT = SEQ + CTXL;
constexpr int NE = 64, TOPK = 8, EFF = 512;
constexpr int N_IN0 = 3584, N_QKV0 = 1536, N_IN1 = 6144;
constexpr float EPS = 1e-6f;
constexpr float LAM_INIT = 0.35550907f;
constexpr int SH_BASE = SEQ * 0 + (MT * TOPK) + NE * 256;
constexpr int NSLOT = SH_BASE + MT;
constexpr int NTHREADS = 512;
constexpr int LDS_BYTES = 131072 + 1024;
constexpr int LDS_CTL = 131072;

constexpr size_t al256(size_t x) { return (x + 255) & ~(size_t)255; }
constexpr size_t WS_CTL   = 0;
constexpr size_t CTL_BYTES = 32768;
constexpr size_t CTL_CNT  = 16384;
constexpr size_t CTL_KMAX = 16384 + 2048;
constexpr size_t WS_MOD   = CTL_BYTES;
constexpr size_t WS_WIN0  = al256(WS_MOD + 2 * 2 * 12288 * 4);
constexpr size_t WS_WOUT0 = al256(WS_WIN0 + (size_t)N_IN0 * D * 2);
constexpr size_t WS_WIN1  = al256(WS_WOUT0 + (size_t)D * D * 2);
constexpr size_t WS_WOUT1 = al256(WS_WIN1 + (size_t)N_IN1 * D * 2);
constexpr size_t WMOE_E   = (size_t)1024 * D + (size_t)D * EFF;
constexpr size_t WS_WMOE  = al256(WS_WOUT1 + (size_t)D * D * 2);
constexpr size_t WS_HRES  = al256(WS_WMOE + 65 * WMOE_E * 2);
constexpr size_t WS_ABUF  = al256(WS_HRES + (size_t)MT * D * 4);
constexpr size_t WS_QKVU  = al256(WS_ABUF + (size_t)MT * D * 2);
constexpr size_t WS_HG    = al256(WS_QKVU + (size_t)MT * N_IN1 * 2);
constexpr size_t WS_X2    = al256(WS_HG + (size_t)MT * 1024 * 2);
constexpr size_t WS_OUT   = al256(WS_X2 + (size_t)MT * D * 2);
constexpr size_t WS_ACT   = al256(WS_OUT + (size_t)MT * D * 2);
constexpr size_t WS_K8    = WS_ACT + al256((size_t)NSLOT * EFF);
constexpr size_t V8T0_OFF = (size_t)8 << 20;
constexpr size_t WS_Y     = al256(WS_ACT + (size_t)NSLOT * EFF * 2);
constexpr int ECAP = MT;
constexpr size_t WS_ELIST = al256(WS_Y + (size_t)NSLOT * D);
constexpr size_t WS_RT    = al256(WS_ELIST + (size_t)64 * ECAP * 4);
constexpr size_t WS_TOPE  = al256(WS_Y + (size_t)NSLOT * D * 2);
constexpr size_t WS_TOPW  = al256(WS_TOPE + (size_t)MT * TOPK * 4);
constexpr size_t WS_TOPP  = al256(WS_TOPW + (size_t)MT * TOPK * 4);
constexpr size_t WS_TSLOT = al256(WS_TOPP + (size_t)MT * TOPK * 4);
constexpr size_t WS_STOK  = al256(WS_TSLOT + (size_t)MT * TOPK * 4);
constexpr size_t WS_END   = al256(WS_STOK + (size_t)NSLOT * 4);

struct Args { const float* in[27]; float* out; unsigned char* ws; int ph_lo, ph_hi; };

__device__ __forceinline__ float bflo(unsigned x) { return __uint_as_float(x << 16); }
__device__ __forceinline__ float bfhi(unsigned x) { return __uint_as_float(x & 0xffff0000u); }
__device__ __forceinline__ float bf2f(bf16_t b) { return __uint_as_float(((unsigned)b) << 16); }
__device__ __forceinline__ unsigned cvtpk(float lo, float hi) { unsigned r; asm("v_cvt_pk_bf16_f32 %0, %1, %2" : "=v"(r) : "v"(lo), "v"(hi)); return r; }
__device__ __forceinline__ bf16_t f2bf(float x) { return (bf16_t)(cvtpk(x, 0.f) & 0xffffu); }
__device__ __forceinline__ float wave_sum(float v) {
#pragma unroll
  for (int o = 32; o; o >>= 1) v += __shfl_xor(v, o);
  return v;
}
__device__ __forceinline__ float sigmoidf_(float x) { return 1.f / (1.f + expf(-x)); }
__device__ __forceinline__ float sigmoid_fast(float x) { return __builtin_amdgcn_rcpf(1.f + __builtin_amdgcn_exp2f(-1.4426950408889634f * x)); }

__device__ __forceinline__ float clamp8e(float x) { return fminf(fmaxf(x, -448.f), 448.f); }
__device__ __forceinline__ unsigned pack8x4(float a, float b, float c, float d) {
  int p = __builtin_amdgcn_cvt_pk_fp8_f32(clamp8e(a), clamp8e(b), 0, false); p = __builtin_amdgcn_cvt_pk_fp8_f32(clamp8e(c), clamp8e(d), p, true); return (unsigned)p; }
__device__ __forceinline__ float sq8x4(unsigned p) {
  const float a = __builtin_amdgcn_cvt_f32_fp8((int)p, 0), b = __builtin_amdgcn_cvt_f32_fp8((int)p, 1), c = __builtin_amdgcn_cvt_f32_fp8((int)p, 2), d = __builtin_amdgcn_cvt_f32_fp8((int)p, 3);
  return a * a + b * b + c * c + d * d; }
typedef int v8i_ __attribute__((ext_vector_type(8)));
typedef int v4i __attribute__((ext_vector_type(4)));
#define XB_TMO      128
#define XB_XCNT(j)  (256  + 64 * (j))
#define XB_XSUB(j)  (1280 + 64 * (j))
#define XB_XGEN(j)  (2304 + 64 * (j))
#define XB_TOP      3328
#define XB_TOPGEN   3392
#define XCD_BAR_WORDS 3456
#define XB_SPIN_CAP (1u << 22)
__device__ __forceinline__ unsigned xb_ld(unsigned* p)              { return __hip_atomic_load(p, __ATOMIC_RELAXED, __HIP_MEMORY_SCOPE_AGENT); }
__device__ __forceinline__ unsigned xb_add(unsigned* p, unsigned v) { return __hip_atomic_fetch_add(p, v, __ATOMIC_RELAXED, __HIP_MEMORY_SCOPE_AGENT); }
__device__ __forceinline__ unsigned xb_xcc_id() { return (unsigned)__builtin_amdgcn_s_getreg((3 << 11) | 20) & 0xFu; }
#define XB_SPIN(cond, bar) do { unsigned _sp = 0; while (cond) { __builtin_amdgcn_s_sleep(1); \
    if ((++_sp & 255u) == 0u) { if (xb_ld(&(bar)[XB_TMO])) break; if (_sp > XB_SPIN_CAP) { atomicAdd(&(bar)[XB_TMO], 1u); break; } } } } while (0)
struct XcdBarrier { unsigned* bar; unsigned x; volatile LAS unsigned* st; };
__device__ __forceinline__ XcdBarrier xcd_barrier_post(unsigned* bar, volatile LAS unsigned* st) {
    XcdBarrier b; b.bar = bar; b.x = xb_xcc_id(); b.st = st;
    if (threadIdx.x == 0) (void)xb_add(&bar[XB_XCNT(b.x)], 1u);
    return b;
}
__device__ __forceinline__ void xcd_barrier_complete(unsigned* bar, unsigned x, unsigned& nloc, unsigned& nx) {
    const unsigned G = gridDim.x * gridDim.y * gridDim.z;
    unsigned sum, cnt, mine, sp = 0u;
    for (;;) {
        sum = 0u; cnt = 0u; mine = 0u;
#pragma unroll
        for (unsigned j = 0; j < 16; ++j) { const unsigned c = xb_ld(&bar[XB_XCNT(j)]); sum += c; cnt += (c > 0u) ? 1u : 0u; mine = (j == x) ? c : mine; }
        if (sum == G) break;
        __builtin_amdgcn_s_sleep(1);
        if ((++sp & 255u) == 0u) { if (xb_ld(&bar[XB_TMO])) break; if (sp > XB_SPIN_CAP) { atomicAdd(&bar[XB_TMO], 1u); break; } }
    }
    nloc = mine > 0u ? mine : 1u; nx = cnt > 0u ? cnt : 1u;
}
__device__ __forceinline__ void xcd_barrier(const XcdBarrier& b) {
    asm volatile("s_waitcnt vmcnt(0)" ::: "memory");
    __syncthreads();
    if (threadIdx.x == 0) {
        unsigned* bar = b.bar;
        __builtin_amdgcn_s_waitcnt(0);
        unsigned nloc = b.st[0], nx = b.st[1];
        if (nloc == 0u) { xcd_barrier_complete(bar, b.x, nloc, nx); b.st[0] = nloc; b.st[1] = nx; }
        const unsigned old = xb_add(&bar[XB_XSUB(b.x)], 1u);
        const unsigned gen = old / nloc;
        if (old + 1u == (gen + 1u) * nloc) {
            __builtin_amdgcn_fence(__ATOMIC_RELEASE, "agent");
            asm volatile("s_waitcnt vmcnt(0)" ::: "memory");
            const unsigned og = xb_add(&bar[XB_TOP], 1u);
            const unsigned tg = og / nx;
            if (og + 1u == (tg + 1u) * nx) xb_add(&bar[XB_TOPGEN], 1u);
            else XB_SPIN(xb_ld(&bar[XB_TOPGEN]) == tg, bar);
            __builtin_amdgcn_fence(__ATOMIC_ACQUIRE, "agent");
            xb_add(&bar[XB_XGEN(b.x)], 1u);
            asm volatile("s_waitcnt vmcnt(0)" ::: "memory");
        } else {
            XB_SPIN(xb_ld(&bar[XB_XGEN(b.x)]) == gen, bar);
            __builtin_amdgcn_fence(__ATOMIC_ACQUIRE, "agent");
            asm volatile("s_waitcnt vmcnt(0)" ::: "memory");
        }
    }
    __syncthreads();
}

__device__ __forceinline__ int lds_byte(int r, int c) {
  int st = (r >> 4) * 2 + (c >> 5), rr = r & 15, cc = c & 31, ob = rr * 64 + cc * 2;
  return st * 1024 + (ob ^ (((ob >> 9) & 1) << 5));
}
#define GLDS(gp, lp) __builtin_amdgcn_global_load_lds((const unsigned*)(gp), (LAS unsigned*)(lp), 16, 0, 0)
#define WAIT_V(n) asm volatile("s_waitcnt vmcnt(" #n ")" ::: "memory")
#define WAIT_L(n) asm volatile("s_waitcnt lgkmcnt(" #n ")" ::: "memory")
#define BAR __builtin_amdgcn_s_barrier()
#define SCHED __builtin_amdgcn_sched_barrier(0)

template <bool GATHER, class Epi>
__device__ __forceinline__ void gemm_tile(const bf16_t* __restrict__ A, const int lda, const int* __restrict__ tok, const int brow,
                                          const bf16_t* __restrict__ Bt, const int ldb, const int bcol, const int K,
                                          LAS char* shm, const Epi& epi) {
#define G_SA(b, h) (shm + ((b) * 2 + (h)) * 16384)
#define G_SB(b, h) (shm + (4 + (b) * 2 + (h)) * 16384)
  int tid = threadIdx.x; asm volatile("" : "+v"(tid)); tid &= 511;
  int wid = tid >> 6, lane = tid & 63, wr = wid >> 2, wc = wid & 3, fr = lane & 15, fq = lane >> 4;
  unsigned ao0, ao1, ao2, ao3, bo;
  {
    const int sb = (tid & 63) * 16, swz = sb ^ (((sb >> 9) & 1) << 5);
    const int R0 = ((tid >> 6) >> 1) * 16 + (swz >> 6), C0 = ((tid >> 6) & 1) * 32 + ((swz & 63) >> 1);
    if (GATHER) { ao0 = (unsigned)(tok[R0] * lda + C0); ao1 = (unsigned)(tok[R0 + 64] * lda + C0); ao2 = (unsigned)(tok[R0 + 128] * lda + C0); ao3 = (unsigned)(tok[R0 + 192] * lda + C0); }
    else { ao0 = (unsigned)((brow + R0) * lda + C0); ao1 = ao0 + 64u * lda; ao2 = ao0 + 128u * lda; ao3 = ao0 + 192u * lda; }
    bo = (unsigned)((bcol + R0) * ldb + C0);
  }
  const int lo = __builtin_amdgcn_readfirstlane(tid >> 6) * 1024;
#define STAGE_A0(P, kt) do { GLDS((A + (kt) * 64) + ao0, (P) + lo); GLDS((A + (kt) * 64) + ao1, (P) + lo + 8192); } while (0)
#define STAGE_A1(P, kt) do { GLDS((A + (kt) * 64) + ao2, (P) + lo); GLDS((A + (kt) * 64) + ao3, (P) + lo + 8192); } while (0)
#define STAGE_B0(P, kt) do { GLDS((Bt + (kt) * 64) + bo, (P) + lo); GLDS((Bt + 64 * ldb + (kt) * 64) + bo, (P) + lo + 8192); } while (0)
#define STAGE_B1(P, kt) do { GLDS((Bt + 128 * ldb + (kt) * 64) + bo, (P) + lo); GLDS((Bt + 192 * ldb + (kt) * 64) + bo, (P) + lo + 8192); } while (0)
#define LDA(dst, b, h) _Pragma("unroll") for (int m = 0; m < 4; ++m) _Pragma("unroll") for (int k = 0; k < 2; ++k) \
    dst[m][k] = *(LAS const bf16x8*)(G_SA(b, h) + lds_byte(wr * 64 + m * 16 + fr, k * 32 + fq * 8))
#define LDB(dst, b, h) _Pragma("unroll") for (int n = 0; n < 2; ++n) _Pragma("unroll") for (int k = 0; k < 2; ++k) \
    dst[n][k] = *(LAS const bf16x8*)(G_SB(b, h) + lds_byte(wc * 32 + n * 16 + fr, k * 32 + fq * 8))
#define MMA(ai, bj, At_, Bt_) do { __builtin_amdgcn_s_setprio(1); \
    _Pragma("unroll") for (int m = 0; m < 4; ++m) _Pragma("unroll") for (int n = 0; n < 2; ++n) _Pragma("unroll") for (int k = 0; k < 2; ++k) \
      acc[ai][bj][m][n] = __builtin_amdgcn_mfma_f32_16x16x32_bf16(Bt_[n][k], At_[m][k], acc[ai][bj][m][n], 0, 0, 0); \
    __builtin_amdgcn_s_setprio(0); } while (0)

  f32x4 acc[2][2][4][2] = {};
  bf16x8 At[4][2], B0[2][2], B1[2][2];
  const int nt = K / 64;
  STAGE_B0(G_SB(0, 0), 0); STAGE_A0(G_SA(0, 0), 0);
  STAGE_B1(G_SB(0, 1), 0); STAGE_A1(G_SA(0, 1), 0);
  if (wr == 1) BAR;
  WAIT_V(4); BAR;
  STAGE_B0(G_SB(1, 0), 1); STAGE_A0(G_SA(1, 0), 1); STAGE_B1(G_SB(1, 1), 1);
  WAIT_V(6); BAR;
  for (int t = 0; t < nt - 2; t += 2) {
    LDB(B0, 0, 0); SCHED; LDA(At, 0, 0); STAGE_A1(G_SA(1, 1), t + 1);
    WAIT_L(8); BAR; WAIT_L(0); MMA(0, 0, At, B0); BAR; SCHED;
    LDB(B1, 0, 1); STAGE_B0(G_SB(0, 0), t + 2);
    BAR; WAIT_L(0); MMA(0, 1, At, B1); BAR;
    LDA(At, 0, 1); STAGE_A0(G_SA(0, 0), t + 2);
    BAR; WAIT_L(0); MMA(1, 0, At, B0); BAR; SCHED;
    STAGE_B1(G_SB(0, 1), t + 2);
    WAIT_V(6); BAR; MMA(1, 1, At, B1); BAR;
    LDB(B0, 1, 0); SCHED; LDA(At, 1, 0); STAGE_A1(G_SA(0, 1), t + 2);
    WAIT_L(8); BAR; WAIT_L(0); MMA(0, 0, At, B0); BAR; SCHED;
    LDB(B1, 1, 1); STAGE_B0(G_SB(1, 0), t + 3);
    BAR; WAIT_L(0); MMA(0, 1, At, B1); BAR;
    LDA(At, 1, 1); STAGE_A0(G_SA(1, 0), t + 3);
    BAR; WAIT_L(0); MMA(1, 0, At, B0); BAR; SCHED;
    STAGE_B1(G_SB(1, 1), t + 3);
    WAIT_V(6); BAR; MMA(1, 1, At, B1); BAR;
  }
  { LDB(B0, 0, 0); WAIT_V(0); LDA(At, 0, 0); STAGE_A1(G_SA(1, 1), nt - 1);
    BAR; WAIT_L(0); MMA(0, 0, At, B0); BAR;
    LDB(B1, 0, 1); BAR; WAIT_L(0); MMA(0, 1, At, B1); BAR;
    LDA(At, 0, 1); WAIT_V(4); BAR; WAIT_L(0); MMA(1, 0, At, B0); MMA(1, 1, At, B1); BAR; }
  { LDB(B0, 1, 0); LDA(At, 1, 0); WAIT_V(2); BAR; WAIT_L(0); MMA(0, 0, At, B0); BAR;
    LDB(B1, 1, 1); WAIT_V(0); BAR; WAIT_L(0); MMA(0, 1, At, B1); BAR;
    LDA(At, 1, 1); BAR; WAIT_L(0); MMA(1, 0, At, B0); MMA(1, 1, At, B1); BAR; }
  if (wr == 0) BAR;
  int tz = threadIdx.x; asm volatile("" : "+v"(tz)); wid = tz >> 6; lane = tz & 63; wr = wid >> 2; wc = wid & 3; fr = lane & 15; fq = lane >> 4;
  epi(acc, brow, bcol, wr, wc, fr, fq);
#undef G_SA
#undef G_SB
#undef STAGE_A0
#undef SA0_1
#undef SA0_2
#undef SA1_1
#undef SA1_2
#undef SB0_1
#undef SB0_2
#undef SB1_1
#undef SB1_2
#undef MF1
#undef MMA_S
#undef STAGE_A1
#undef STAGE_B0
#undef STAGE_B1
#undef LDA
#undef LDB
#undef MMA
}

struct EpiPlain {     static constexpr int STAGE_ROWB = 0;
  bf16_t* C; int ldc; float sc;
  __device__ __forceinline__ void operator()(const f32x4 (&acc)[2][2][4][2], int brow, int bcol, int wr, int wc, int fr, int fq) const {
#pragma unroll
    for (int ai = 0; ai < 2; ++ai)
#pragma unroll
      for (int m = 0; m < 4; ++m) {
        bf16_t* rp = C + (size_t)(brow + ai * 128 + wr * 64 + m * 16 + fr) * ldc + bcol + wc * 32 + fq * 8;
#pragma unroll
        for (int bj = 0; bj < 2; ++bj) {
          u32x4 v = {cvtpk(acc[ai][bj][m][0][0] * sc, acc[ai][bj][m][0][1] * sc), cvtpk(acc[ai][bj][m][0][2] * sc, acc[ai][bj][m][0][3] * sc),
                     cvtpk(acc[ai][bj][m][1][0] * sc, acc[ai][bj][m][1][1] * sc), cvtpk(acc[ai][bj][m][1][2] * sc, acc[ai][bj][m][1][3] * sc)};
          *(u32x4*)(rp + bj * 128) = v;
        }
      }
  }
};
template <int MODE>
struct EpiPair {
  bf16_t* C; int ldc; int colbase; float sc;
  __device__ __forceinline__ void operator()(const f32x4 (&acc)[2][2][4][2], int brow, int bcol, int wr, int wc, int fr, int fq) const {
#pragma unroll
    for (int ai = 0; ai < 2; ++ai)
#pragma unroll
      for (int m = 0; m < 4; ++m) {
        bf16_t* rp = C + (size_t)(brow + ai * 128 + wr * 64 + m * 16 + fr) * ldc + ((bcol - colbase) >> 1) + wc * 16 + fq * 4;
#pragma unroll
        for (int bj = 0; bj < 2; ++bj) {
          float r[4];
#pragma unroll
          for (int j = 0; j < 4; ++j) {
            const float x0 = acc[ai][bj][m][0][j] * sc, x1 = acc[ai][bj][m][1][j] * sc;
            r[j] = MODE == 0 ? x0 * sigmoid_fast(x1) : x0 * sigmoid_fast(x0) * x1;
          }
          u32x2 v = {cvtpk(r[0], r[1]), cvtpk(r[2], r[3])};
          *(u32x2*)(rp + bj * 64) = v;
        }
      }
  }
};
struct EpiG1 {        static constexpr int STAGE_ROWB = 0;
  EpiPlain p; EpiPair<0> g; int nplain;
  __device__ __forceinline__ void operator()(const f32x4 (&acc)[2][2][4][2], int brow, int bcol, int wr, int wc, int fr, int fq) const {
    if (bcol < nplain) p(acc, brow, bcol, wr, wc, fr, fq); else g(acc, brow, bcol, wr, wc, fr, fq);
  }
};

typedef int v8i __attribute__((ext_vector_type(8)));
__device__ __forceinline__ int lds8(int r, int c) { return r * 128 + ((c ^ ((r >> 1) & 7)) << 4); }
#ifndef GEMM_VAR
#define GEMM_VAR 0
#endif
template <bool GATHER, int lda, int ldb, int K, int GV = 0, class Epi, class S>
__device__ __forceinline__ void gemm8_run(const unsigned char* __restrict__ A, const int* __restrict__ stok,
                                          LAS char* shm, const Epi& epi, const S& sched) {
#define G_SA(b, h) (shm + ((b) * 2 + (h)) * 16384)
#define G_SB(b, h) (shm + (4 + (b) * 2 + (h)) * 16384)
  int tid = threadIdx.x; asm volatile("" : "+v"(tid)); tid &= 511;
  int wid = tid >> 6, lane = tid & 63, wr = wid >> 2, wc = wid & 3, fr = lane & 15, fq = lane >> 4;
  unsigned ao0, ao1, ao2, ao3, bo;
  int R0 = 8 * wid + (lane >> 3), C0 = ((lane & 7) ^ ((R0 >> 1) & 7)) << 4;
  const int lo = __builtin_amdgcn_readfirstlane(tid >> 6) * 1024;
  int brow, bcol; const unsigned char* Bt;
  int ui = 0;
  if (!sched.unit(ui, brow, Bt, bcol)) return;
#define SETOFF(br, bc) do { if (GATHER) { const auto _g = sched.gather_tile(br); ao0 = (unsigned)(_g.tok(R0) * lda + C0); ao1 = (unsigned)(_g.tok(R0 + 64) * lda + C0); ao2 = (unsigned)(_g.tok(R0 + 128) * lda + C0); ao3 = (unsigned)(_g.tok(R0 + 192) * lda + C0); } \
    else { ao0 = (unsigned)(((br) + R0) * lda + C0); ao1 = ao0 + 64u * lda; ao2 = ao0 + 128u * lda; ao3 = ao0 + 192u * lda; } \
    bo = (unsigned)(((bc) + R0) * ldb + C0); } while (0)
#define SA0_1(P, kt) do { if (GV == 2) break; GLDS((A + (kt) * 128) + ao0, (P) + lo); } while (0)
#define SA0_2(P, kt) do { if (GV == 2) break; GLDS((A + (kt) * 128) + ao1, (P) + lo + 8192); } while (0)
#define SA1_1(P, kt) do { if (GV == 2) break; GLDS((A + (kt) * 128) + ao2, (P) + lo); } while (0)
#define SA1_2(P, kt) do { if (GV == 2) break; GLDS((A + (kt) * 128) + ao3, (P) + lo + 8192); } while (0)
#define SB0_1(P, kt) do { if (GV == 2) break; GLDS((Bt + (kt) * 128) + bo, (P) + lo); } while (0)
#define SB0_2(P, kt) do { if (GV == 2) break; GLDS((Bt + 64 * ldb + (kt) * 128) + bo, (P) + lo + 8192); } while (0)
#define SB1_1(P, kt) do { if (GV == 2) break; GLDS((Bt + 128 * ldb + (kt) * 128) + bo, (P) + lo); } while (0)
#define SB1_2(P, kt) do { if (GV == 2) break; GLDS((Bt + 192 * ldb + (kt) * 128) + bo, (P) + lo + 8192); } while (0)
#define STAGE_A0(P, kt) do { SA0_1(P, kt); SA0_2(P, kt); } while (0)
#define STAGE_A1(P, kt) do { SA1_1(P, kt); SA1_2(P, kt); } while (0)
#define STAGE_B0(P, kt) do { SB0_1(P, kt); SB0_2(P, kt); } while (0)
#define STAGE_B1(P, kt) do { SB1_1(P, kt); SB1_2(P, kt); } while (0)
#define PRO() do { STAGE_B0(G_SB(0, 0), 0); STAGE_A0(G_SA(0, 0), 0); STAGE_B1(G_SB(0, 1), 0); STAGE_A1(G_SA(0, 1), 0); } while (0)
  const int fx = (fq ^ ((fr >> 1) & 7)) << 4;
  const int fa0 = (wr * 64 + fr) * 128 + fx, fb0 = (wc * 32 + fr) * 128 + fx;
#define FRAG8(dst, p0, p1) do { const v4i _x = *(LAS const v4i*)(p0); const v4i _y = *(LAS const v4i*)(p1); \
    dst = (v8i){_x[0], _x[1], _x[2], _x[3], _y[0], _y[1], _y[2], _y[3]}; } while (0)
#define LDA(dst, b, h) do { int fa1 = fa0; asm volatile("v_xor_b32 %0, 64, %0" : "+v"(fa1)); \
    _Pragma("unroll") for (int m = 0; m < 4; ++m) FRAG8(dst[m], G_SA(b, h) + fa0 + m * 2048, G_SA(b, h) + fa1 + m * 2048); } while (0)
#define LDB(dst, b, h) do { int fb1 = fb0; asm volatile("v_xor_b32 %0, 64, %0" : "+v"(fb1)); \
    _Pragma("unroll") for (int n = 0; n < 2; ++n) FRAG8(dst[n], G_SB(b, h) + fb0 + n * 2048, G_SB(b, h) + fb1 + n * 2048); } while (0)
#define MF1(ai, bj, At_, Bt_, m, n) asm volatile("v_mfma_scale_f32_16x16x128_f8f6f4 %0, %1, %2, %0, %3, %3 op_sel_hi:[0,0,0]" : "+v"(acc[ai][bj][m][n]) : "v"(Bt_[n]), "v"(At_[m]), "v"(sc1))
#define MMA(ai, bj, At_, Bt_) do { __builtin_amdgcn_s_setprio(1); \
    _Pragma("unroll") for (int m = 0; m < 4; ++m) _Pragma("unroll") for (int n = 0; n < 2; ++n) MF1(ai, bj, At_, Bt_, m, n); \
    __builtin_amdgcn_s_setprio(0); } while (0)
#define MMA_S(ai, bj, At_, Bt_, ST1, ST2) do { __builtin_amdgcn_s_setprio(1); \
    MF1(ai, bj, At_, Bt_, 0, 0); MF1(ai, bj, At_, Bt_, 0, 1); SCHED; ST1; SCHED; \
    MF1(ai, bj, At_, Bt_, 1, 0); MF1(ai, bj, At_, Bt_, 1, 1); MF1(ai, bj, At_, Bt_, 2, 0); SCHED; ST2; SCHED; \
    MF1(ai, bj, At_, Bt_, 2, 1); MF1(ai, bj, At_, Bt_, 3, 0); MF1(ai, bj, At_, Bt_, 3, 1); \
    __builtin_amdgcn_s_setprio(0); } while (0)
  int sc1; asm volatile("v_mov_b32 %0, 0x7f7f7f7f" : "=v"(sc1));
  const int nt = K / 128;
  SETOFF(brow, bcol); PRO();
  bool first = true;
  for (;;) {
    f32x4 acc[2][2][4][2] = {};
    v8i At[4], B0[2], B1[2];
    if (wr == 1) BAR;
    constexpr int NST = (GV == 1 || GV == 2) ? 0 : (Epi::STAGE_ROWB == 256 ? 8 : (Epi::STAGE_ROWB == 128 ? 4 : 0));
    if (first) WAIT_V(4); else asm volatile("s_waitcnt vmcnt(%0)" :: "i"(NST) : "memory");
    BAR;
    STAGE_B0(G_SB(1, 0), 1); STAGE_A0(G_SA(1, 0), 1); STAGE_B1(G_SB(1, 1), 1);
    WAIT_V(6); BAR;
    static_assert(K >= 512, "the tail assumes the steady-state loop ran at least once");
    for (int t = 0; t < nt - 2; t += 2) {
      LDB(B0, 0, 0); SCHED; LDA(At, 0, 0);
      WAIT_L(8); BAR; WAIT_L(0); MMA_S(0, 0, At, B0, SA1_1(G_SA(1, 1), t + 1), SA1_2(G_SA(1, 1), t + 1)); BAR; SCHED;
      LDB(B1, 0, 1);
      BAR; WAIT_L(0); MMA_S(0, 1, At, B1, SB0_1(G_SB(0, 0), t + 2), SB0_2(G_SB(0, 0), t + 2)); BAR;
      LDA(At, 0, 1);
      BAR; WAIT_L(0); MMA_S(1, 0, At, B0, SA0_1(G_SA(0, 0), t + 2), SA0_2(G_SA(0, 0), t + 2)); BAR; SCHED;
      WAIT_V(4); BAR; MMA_S(1, 1, At, B1, SB1_1(G_SB(0, 1), t + 2), SB1_2(G_SB(0, 1), t + 2)); BAR;
      LDB(B0, 1, 0); SCHED; LDA(At, 1, 0);
      WAIT_L(8); BAR; WAIT_L(0); MMA_S(0, 0, At, B0, SA1_1(G_SA(0, 1), t + 2), SA1_2(G_SA(0, 1), t + 2)); BAR; SCHED;
      LDB(B1, 1, 1);
      BAR; WAIT_L(0); MMA_S(0, 1, At, B1, SB0_1(G_SB(1, 0), t + 3), SB0_2(G_SB(1, 0), t + 3)); BAR;
      LDA(At, 1, 1);
      BAR; WAIT_L(0); MMA_S(1, 0, At, B0, SA0_1(G_SA(1, 0), t + 3), SA0_2(G_SA(1, 0), t + 3)); BAR; SCHED;
      WAIT_V(4); BAR; MMA_S(1, 1, At, B1, SB1_1(G_SB(1, 1), t + 3), SB1_2(G_SB(1, 1), t + 3)); BAR;
    }
    { LDB(B0, 0, 0); LDA(At, 0, 0);
      BAR; WAIT_L(0); MMA_S(0, 0, At, B0, SA1_1(G_SA(1, 1), nt - 1), SA1_2(G_SA(1, 1), nt - 1)); BAR;
      LDB(B1, 0, 1); BAR; WAIT_L(0); MMA(0, 1, At, B1); BAR;
      LDA(At, 0, 1); WAIT_V(4); BAR; WAIT_L(0); MMA(1, 0, At, B0); MMA(1, 1, At, B1); BAR; }
    { LDB(B0, 1, 0); LDA(At, 1, 0); WAIT_V(2); BAR; WAIT_L(0); MMA(0, 0, At, B0); BAR;
      LDB(B1, 1, 1); WAIT_V(0); BAR; WAIT_L(0); MMA(0, 1, At, B1); BAR;
      LDA(At, 1, 1); BAR; WAIT_L(0); MMA(1, 0, At, B0); MMA(1, 1, At, B1); BAR; }
    if (wr == 0) BAR;
    const int cbrow = brow, cbcol = bcol;
    { int tz = threadIdx.x; asm volatile("" : "+v"(tz)); tz &= 511; wid = tz >> 6; lane = tz & 63; wr = wid >> 2; wc = wid & 3; fr = lane & 15; fq = lane >> 4;
      R0 = 8 * wid + (lane >> 3); C0 = ((lane & 7) ^ ((R0 >> 1) & 7)) << 4; }
    ++ui;
    const bool more = sched.unit(ui, brow, Bt, bcol);
    if (more) { SETOFF(brow, bcol); asm volatile("" ::: "memory"); PRO(); asm volatile("" ::: "memory"); }
    asm volatile("s_nop 15\n\ts_nop 15\n\ts_nop 7" ::: "memory");
#pragma unroll
    for (int i = 0; i < 32; ++i) asm volatile("" : "+v"((&acc[0][0][0][0])[i]));
    if (GV != 1 && GV != 2) {
      if constexpr (Epi::STAGE_ROWB == 256) {
#pragma unroll
        for (int ai = 0; ai < 2; ++ai)
#pragma unroll
          for (int m = 0; m < 4; ++m) { const int rloc = wr * 64 + m * 16 + fr;
#pragma unroll
            for (int bj = 0; bj < 2; ++bj) { const int c = wc * 2 + (fq >> 1) + bj * 8;
              *(LAS u32x2*)(shm + (ai ? 98304 : 32768) + rloc * 256 + ((c ^ (rloc & 15)) << 4) + (fq & 1) * 8) = epi.pack(acc, ai, m, bj); } }
        WAIT_L(0); BAR;
        unsigned char* Cb = epi.C + (size_t)cbrow * epi.ldc + epi.colbase(cbcol);
#pragma unroll
        for (int it = 0; it < 8; ++it) { const int row = it * 32 + wid * 4 + (lane >> 4), c = lane & 15, rloc = row & 127;
          const u32x4 v = *(LAS const u32x4*)(shm + (row & 128 ? 98304 : 32768) + rloc * 256 + ((c ^ (rloc & 15)) << 4));
          *(u32x4*)(Cb + (size_t)row * epi.ldc + c * 16) = v; }
      } else if constexpr (Epi::STAGE_ROWB == 128) {
#pragma unroll
        for (int ai = 0; ai < 2; ++ai)
#pragma unroll
          for (int m = 0; m < 4; ++m) { const int row = ai * 128 + wr * 64 + m * 16 + fr;
#pragma unroll
            for (int bj = 0; bj < 2; ++bj) { const int c = wc + 4 * bj;
              *(LAS unsigned*)(shm + 32768 + row * 128 + ((c ^ (row & 7)) << 4) + fq * 4) = epi.pack(acc, ai, m, bj); } }
        WAIT_L(0); BAR;
        unsigned char* Cb = epi.C + (size_t)cbrow * epi.ldc + epi.colbase(cbcol);
#pragma unroll
        for (int it = 0; it < 4; ++it) { const int row = it * 64 + wid * 8 + (lane >> 3), c = lane & 7;
          const u32x4 v = *(LAS const u32x4*)(shm + 32768 + row * 128 + ((c ^ (row & 7)) << 4));
          *(u32x4*)(Cb + (size_t)row * epi.ldc + c * 16) = v; }
      } else epi(acc, cbrow, cbcol, wr, wc, fr, fq);
    }
    if (!more) break;
    first = false;
  }
#undef G_SA
#undef G_SB
#undef SETOFF
#undef STAGE_A0
#undef STAGE_A1
#undef STAGE_B0
#undef STAGE_B1
#undef PRO
#undef FRAG8
#undef LDA
#undef LDB
#undef MMA
}
__device__ __forceinline__ float clamp8(float x) { return fminf(fmaxf(x, -448.f), 448.f); }
__device__ __forceinline__ unsigned pack_fp8x4(float a, float b, float c, float d) {
  int p = __builtin_amdgcn_cvt_pk_fp8_f32(clamp8(a), clamp8(b), 0, false); p = __builtin_amdgcn_cvt_pk_fp8_f32(clamp8(c), clamp8(d), p, true); return (unsigned)p; }
struct EpiSwiGLU8 {
  unsigned char* C; int ldc;
  static constexpr int STAGE_ROWB = 128;
  __device__ __forceinline__ int colbase(int bcol) const { return bcol >> 1; }
  __device__ __forceinline__ unsigned pack(const f32x4 (&acc)[2][2][4][2], int ai, int m, int bj) const {
    constexpr float S = 1.f / 256.f; float r[4];
#pragma unroll
    for (int j = 0; j < 4; ++j) { const float g = acc[ai][bj][m][0][j] * S, u = acc[ai][bj][m][1][j] * S; r[j] = g * sigmoid_fast(g) * u; }
    return pack_fp8x4(r[0], r[1], r[2], r[3]); }
  __device__ __forceinline__ void operator()(const f32x4 (&acc)[2][2][4][2], int brow, int bcol, int wr, int wc, int fr, int fq) const {
    constexpr float S = 1.f / 256.f;
#pragma unroll
    for (int ai = 0; ai < 2; ++ai)
#pragma unroll
      for (int m = 0; m < 4; ++m) {
        unsigned char* rp = C + (size_t)(brow + ai * 128 + wr * 64 + m * 16 + fr) * ldc + (bcol >> 1) + wc * 16 + fq * 4;
#pragma unroll
        for (int bj = 0; bj < 2; ++bj) {
          float r[4];
#pragma unroll
          for (int j = 0; j < 4; ++j) { const float g = acc[ai][bj][m][0][j] * S, u = acc[ai][bj][m][1][j] * S; r[j] = g * sigmoid_fast(g) * u; }
          *(unsigned*)(rp + bj * 64) = pack_fp8x4(r[0], r[1], r[2], r[3]);
        }
      }
  }
};
struct EpiPlain8 {
  unsigned char* C; int ldc; float sc;
  static constexpr int STAGE_ROWB = 256;
  __device__ __forceinline__ int colbase(int bcol) const { return bcol; }
  __device__ __forceinline__ u32x2 pack(const f32x4 (&acc)[2][2][4][2], int ai, int m, int bj) const {
    return (u32x2){pack_fp8x4(acc[ai][bj][m][0][0] * sc, acc[ai][bj][m][0][1] * sc, acc[ai][bj][m][0][2] * sc, acc[ai][bj][m][0][3] * sc),
                   pack_fp8x4(acc[ai][bj][m][1][0] * sc, acc[ai][bj][m][1][1] * sc, acc[ai][bj][m][1][2] * sc, acc[ai][bj][m][1][3] * sc)}; }
  __device__ __forceinline__ void operator()(const f32x4 (&acc)[2][2][4][2], int brow, int bcol, int wr, int wc, int fr, int fq) const {
#pragma unroll
    for (int ai = 0; ai < 2; ++ai)
#pragma unroll
      for (int m = 0; m < 4; ++m) {
        unsigned char* rp = C + (size_t)(brow + ai * 128 + wr * 64 + m * 16 + fr) * ldc + bcol + wc * 32 + fq * 8;
#pragma unroll
        for (int bj = 0; bj < 2; ++bj) {
          u32x2 v = {pack_fp8x4(acc[ai][bj][m][0][0] * sc, acc[ai][bj][m][0][1] * sc, acc[ai][bj][m][0][2] * sc, acc[ai][bj][m][0][3] * sc),
                     pack_fp8x4(acc[ai][bj][m][1][0] * sc, acc[ai][bj][m][1][1] * sc, acc[ai][bj][m][1][2] * sc, acc[ai][bj][m][1][3] * sc)};
          *(u32x2*)(rp + bj * 128) = v;
        }
      }
  }
};
struct EpiPlainS {
  bf16_t* C; int ldc; float sc;
  __device__ __forceinline__ void operator()(const f32x4 (&acc)[2][2][4][2], int brow, int bcol, int wr, int wc, int fr, int fq) const {
#pragma unroll
    for (int ai = 0; ai < 2; ++ai)
#pragma unroll
      for (int m = 0; m < 4; ++m) {
        bf16_t* rp = C + (size_t)(brow + ai * 128 + wr * 64 + m * 16 + fr) * ldc + bcol + wc * 32 + fq * 8;
#pragma unroll
        for (int bj = 0; bj < 2; ++bj) {
          u32x4 v = {cvtpk(acc[ai][bj][m][0][0] * sc, acc[ai][bj][m][0][1] * sc), cvtpk(acc[ai][bj][m][0][2] * sc, acc[ai][bj][m][0][3] * sc),
                     cvtpk(acc[ai][bj][m][1][0] * sc, acc[ai][bj][m][1][1] * sc), cvtpk(acc[ai][bj][m][1][2] * sc, acc[ai][bj][m][1][3] * sc)};
          *(u32x4*)(rp + bj * 128) = v;
        }
      }
  }
};

__device__ __forceinline__ void dense_unit(int u, int nM, int nN, int& pm, int& pn) {
  const int nwg = nM * nN, NX = 8, WGM = 8;
  int wgid = u;
  { const int q = nwg / NX, r = nwg % NX, xcd = wgid % NX, off = wgid / NX; wgid = (xcd < r ? xcd * (q + 1) : r * (q + 1) + (xcd - r) * q) + off; }
  const int nig = WGM * nN, gid = wgid / nig, fm = gid * WGM, gsz = min(nM - fm, WGM);
  pm = fm + ((wgid % nig) % gsz); pn = (wgid % nig) / gsz;
}

namespace at {
constexpr int DH = 128, NW = 8, QBLK = 32, KVBLK = 64;
constexpr float SCALE = 0.088388347648318440f;
constexpr float QC = SCALE * 1.4426950408889634f;
constexpr int SHM_V = KVBLK * DH * 2, SHM_K = KVBLK * DH * 2;
#define KSWZ(row, colB) ((row) * 256 + ((colB) ^ (((row) & 7) << 4)))
__device__ __forceinline__ int crow(int r, int hi) { return (r & 3) + 8 * (r >> 2) + 4 * hi; }
__device__ __forceinline__ unsigned cvtpkv(float lo, float hi) { unsigned r; asm volatile("v_cvt_pk_bf16_f32 %0, %1, %2" : "=v"(r) : "v"(lo), "v"(hi)); return r; }
#define PK4(P, BASE, OUT) do { unsigned a0 = cvtpkv(P[BASE + 0], P[BASE + 1]), a1 = cvtpkv(P[BASE + 2], P[BASE + 3]);   \
    unsigned b0 = cvtpkv(P[BASE + 4], P[BASE + 5]), b1 = cvtpkv(P[BASE + 6], P[BASE + 7]);                              \
    auto r0 = __builtin_amdgcn_permlane32_swap(a0, b0, false, false); auto r1 = __builtin_amdgcn_permlane32_swap(a1, b1, false, false); \
    u32x4 w = {r0[0], r1[0], r0[1], r1[1]}; OUT = *reinterpret_cast<bf16x8*>(&w); } while (0)
__device__ __forceinline__ float load_q(const bf16_t* __restrict__ Qw, bf16x8 (&qr)[8], float kmax2) {
  float ss = 0;
#pragma unroll
  for (int d0 = 0; d0 < 8; ++d0) {
    const u32x4 raw = *reinterpret_cast<const u32x4*>(Qw + d0 * 16); u32x4 o;
#pragma unroll
    for (int i = 0; i < 4; ++i) { const unsigned pk = cvtpk(bflo(raw[i]) * QC, bfhi(raw[i]) * QC); o[i] = pk; const float a = bflo(pk), b = bfhi(pk); ss += a * a + b * b; }
    qr[d0] = *reinterpret_cast<bf16x8*>(&o);
  }
  { auto rr = __builtin_amdgcn_permlane32_swap(__float_as_uint(ss), __float_as_uint(ss), false, false); ss = __uint_as_float(rr[0]) + __uint_as_float(rr[1]); }
  return -(sqrtf(ss * kmax2) * 1.01f + 1e-3f);
}
__device__ __forceinline__ void exp16(f32x16& p) {
#pragma unroll
  for (int r = 0; r < 16; ++r) p[r] = __builtin_amdgcn_exp2f(p[r]);
}
__device__ __forceinline__ float sum16(const f32x16& p) { float s = 0;
#pragma unroll
  for (int r = 0; r < 16; ++r) s += p[r];
  return s; }
__device__ __forceinline__ void qkt(f32x16& p0, f32x16& p1, LAS const char* Ks, const bf16x8* qr, int r32, int hi, float nmc) {
#pragma unroll
  for (int r = 0; r < 16; ++r) { p0[r] = nmc; p1[r] = nmc; }
#pragma unroll
  for (int d0 = 0; d0 < 8; ++d0) { int cb = (d0 * 16 + hi * 8) * 2;
    bf16x8 b0 = *(LAS const bf16x8*)(Ks + KSWZ(r32, cb));
    bf16x8 b1 = *(LAS const bf16x8*)(Ks + KSWZ(32 + r32, cb));
    p0 = __builtin_amdgcn_mfma_f32_32x32x16_bf16(b0, qr[d0], p0, 0, 0, 0);
    p1 = __builtin_amdgcn_mfma_f32_32x32x16_bf16(b1, qr[d0], p1, 0, 0, 0); }
}
__device__ __forceinline__ int v_st(int k, int c) { const int kk = (k & ~0xC) | ((k & 4) << 1) | ((k & 8) >> 1); return ((kk >> 3) * 4 + (c >> 5)) * 512 + ((kk & 7) * 32 + (c & 31)) * 2; }
__device__ __forceinline__ int v_st256(int k, int c) { const int kk = (k & ~0xC) | ((k & 4) << 1) | ((k & 8) >> 1); return ((kk >> 3) * 8 + (c >> 5)) * 512 + ((kk & 7) * 32 + (c & 31)) * 2; }
__device__ __forceinline__ int v_rd_base(int lane) { return ((lane & 3) << 3) | (((lane >> 2) & 3) << 6) | (((lane >> 4) & 1) << 5) | (((lane >> 5) & 1) << 8); }
template <int OFF> __device__ __forceinline__ s16x4 tr_read(int vb) {
  s16x4 r; asm volatile("ds_read_b64_tr_b16 %0, %1 offset:%2" : "=&v"(r) : "v"(vb), "i"(OFF) : "memory"); return r;
}
template <int BASE, int KS, int HS> __device__ __forceinline__ void pv_one(f32x16& od, int vb, bf16x8 pa0, bf16x8 pa1, bf16x8 pa2, bf16x8 pa3) {
  const s16x4 l0 = tr_read<BASE>(vb), h0 = tr_read<BASE + HS>(vb), l1 = tr_read<BASE + KS>(vb), h1 = tr_read<BASE + KS + HS>(vb);
  const s16x4 l2 = tr_read<BASE + 2 * KS>(vb), h2 = tr_read<BASE + 2 * KS + HS>(vb), l3 = tr_read<BASE + 3 * KS>(vb), h3 = tr_read<BASE + 3 * KS + HS>(vb);
  asm volatile("s_waitcnt lgkmcnt(0)" ::: "memory"); SCHED;
#define PK(L, H) (bf16x8){L[0], L[1], L[2], L[3], H[0], H[1], H[2], H[3]}
  od = __builtin_amdgcn_mfma_f32_32x32x16_bf16(pa0, PK(l0, h0), od, 0, 0, 0);
  od = __builtin_amdgcn_mfma_f32_32x32x16_bf16(pa1, PK(l1, h1), od, 0, 0, 0);
  od = __builtin_amdgcn_mfma_f32_32x32x16_bf16(pa2, PK(l2, h2), od, 0, 0, 0);
  od = __builtin_amdgcn_mfma_f32_32x32x16_bf16(pa3, PK(l3, h3), od, 0, 0, 0);
#undef PK
}
__device__ __forceinline__ void pv_d0(f32x16* o, int vb, bf16x8 pa0, bf16x8 pa1, bf16x8 pa2, bf16x8 pa3) {
  pv_one<0, 4096, 2048>(o[0], vb, pa0, pa1, pa2, pa3); pv_one<512, 4096, 2048>(o[1], vb, pa0, pa1, pa2, pa3);
  pv_one<1024, 4096, 2048>(o[2], vb, pa0, pa1, pa2, pa3); pv_one<1536, 4096, 2048>(o[3], vb, pa0, pa1, pa2, pa3);
}
__device__ __forceinline__ void pv_d0_256(f32x16* o, int vb, bf16x8 pa0, bf16x8 pa1, bf16x8 pa2, bf16x8 pa3) {
  pv_one<0, 8192, 4096>(o[0], vb, pa0, pa1, pa2, pa3); pv_one<512, 8192, 4096>(o[1], vb, pa0, pa1, pa2, pa3);
  pv_one<1024, 8192, 4096>(o[2], vb, pa0, pa1, pa2, pa3); pv_one<1536, 8192, 4096>(o[3], vb, pa0, pa1, pa2, pa3);
}
__device__ __forceinline__ void store_o8(const f32x16* o, float l_tot, LAS float* li, unsigned char* __restrict__ Ow, int ldo, int r32, int hi) {
  if (hi == 0) li[r32] = l_tot; asm volatile("s_waitcnt lgkmcnt(0)" ::: "memory");
  float rli[16];
#pragma unroll
  for (int r = 0; r < 16; ++r) rli[r] = 8.f * __builtin_amdgcn_rcpf(li[crow(r, hi)]);
#pragma unroll
  for (int r = 0; r < 16; ++r) { const int orow = crow(r, hi);
#pragma unroll
    for (int d0 = 0; d0 < 4; ++d0) Ow[(long)orow * ldo + d0 * 32 + r32] = (unsigned char)__builtin_amdgcn_cvt_pk_fp8_f32(o[d0][r] * rli[r], 0.f, 0, false); }
}
__device__ __forceinline__ void store_o(const f32x16* o, float l_tot, LAS float* li, bf16_t* __restrict__ Ow, int ldo, int r32, int hi) {
  if (hi == 0) li[r32] = l_tot; asm volatile("s_waitcnt lgkmcnt(0)" ::: "memory");
  float rli[16];
#pragma unroll
  for (int r = 0; r < 16; ++r) rli[r] = __builtin_amdgcn_rcpf(li[crow(r, hi)]);
#pragma unroll
  for (int r = 0; r < 16; ++r) { const int orow = crow(r, hi);
#pragma unroll
    for (int d0 = 0; d0 < 4; ++d0) Ow[(long)orow * ldo + d0 * 32 + r32] = f2bf(o[d0][r] * rli[r]); }
}

__device__ __forceinline__ int unswap23(int kk) { return (kk & ~0xC) | ((kk & 4) << 1) | ((kk & 8) >> 1); }
__device__ __forceinline__ int k_dma_voff(int wid, int lane, int ldk) {
  const int row = 4 * wid + (lane >> 4); return row * ldk * 2 + (((lane & 15) * 16) ^ ((row & 7) << 4)); }
#define DMA16(rs, ldsp, voff, soff) __builtin_amdgcn_raw_ptr_buffer_load_lds(rs, (LAS void*)(ldsp), 16, voff, soff, 0, 0)

constexpr int SHM_T = SHM_K + SHM_V;
__device__ __forceinline__ void attn_body(const bf16_t* __restrict__ Qb, const int ldq, const bf16_t* __restrict__ Kh, const bf16_t* __restrict__ Vh, const int ldk,
                                          bf16_t* __restrict__ Ob, const int ldo, const int seq, const float kmax2, LAS char* lds) {
  int tid = threadIdx.x; asm volatile("" : "+v"(tid)); tid &= 511;
  const int wid = tid >> 6, lane = tid & 63, r32 = lane & 31, hi = lane >> 5;
  LAS float* li_l = (LAS float*)(lds + 3 * SHM_T) + wid * 64;
  float l_reg = 0; f32x16 o[4] = {}; bf16x8 qr[8];
  const float nmc = load_q(Qb + (long)(wid * QBLK + r32) * ldq + hi * 8, qr, kmax2);
  const int vrb = v_rd_base(lane);
  const int kvo = k_dma_voff(wid, lane, ldk);
  const int vvo = unswap23(8 * (wid >> 1) + ((lane & 31) >> 2)) * ldk * 2 + ((2 * (wid & 1) + (lane >> 5)) * 32 + (lane & 3) * 8) * 2;
  const int l32 = 64 * ldk, pz = wid * 1024;
  const __amdgpu_buffer_rsrc_t krs = __builtin_amdgcn_make_buffer_rsrc((void*)Kh, 0, 0x7ffffff0, 0x00020000);
  const __amdgpu_buffer_rsrc_t vrs = __builtin_amdgcn_make_buffer_rsrc((void*)Vh, 0, 0x7ffffff0, 0x00020000);
#define TDMA(slot, k0) do { const int _o = (k0) * ldk * 2; LAS char* _b = lds + (slot) * SHM_T + pz; \
    DMA16(krs, _b, kvo, _o); DMA16(krs, _b + 8192, kvo, _o + l32); DMA16(vrs, _b + SHM_K, vvo, _o); DMA16(vrs, _b + SHM_K + 8192, vvo, _o + l32); } while (0)
#define VM0() asm volatile("s_waitcnt vmcnt(0)" ::: "memory")
#define FINISH(P0, P1) do { exp16(P1); l_reg += sum16(P0) + sum16(P1); PK4(P0, 0, pa0); PK4(P0, 8, pa1); PK4(P1, 0, pa2); PK4(P1, 8, pa3); } while (0)
  f32x16 pA0, pA1, pB0, pB1; bf16x8 pa0, pa1, pa2, pa3; const int NT = seq / KVBLK;
  TDMA(0, 0); VM0(); __syncthreads();
  TDMA(1, KVBLK);
  qkt(pA0, pA1, lds, qr, r32, hi, nmc); exp16(pA0);
  VM0(); __syncthreads();
  int sk = 1, sv = 0, sd = 2;
  for (int j = 1; j + 1 < NT; j += 2) {
    TDMA(sd, (j + 1) * KVBLK);
    SCHED; qkt(pB0, pB1, lds + sk * SHM_T, qr, r32, hi, nmc);
    FINISH(pA0, pA1); SCHED;
    pv_d0(o, (int)(uintptr_t)(lds + sv * SHM_T + SHM_K) + vrb, pa0, pa1, pa2, pa3); exp16(pB0);
    VM0(); __syncthreads();
    { const int t = sv; sv = sk; sk = sd; sd = t; }
    if (j + 2 < NT) TDMA(sd, (j + 2) * KVBLK);
    SCHED; qkt(pA0, pA1, lds + sk * SHM_T, qr, r32, hi, nmc);
    FINISH(pB0, pB1); SCHED;
    pv_d0(o, (int)(uintptr_t)(lds + sv * SHM_T + SHM_K) + vrb, pa0, pa1, pa2, pa3); exp16(pA0);
    VM0(); __syncthreads();
    { const int t = sv; sv = sk; sk = sd; sd = t; }
  }
  SCHED; qkt(pB0, pB1, lds + sk * SHM_T, qr, r32, hi, nmc);
  FINISH(pA0, pA1); SCHED;
  pv_d0(o, (int)(uintptr_t)(lds + sv * SHM_T + SHM_K) + vrb, pa0, pa1, pa2, pa3); exp16(pB0);
  FINISH(pB0, pB1); SCHED;
  pv_d0(o, (int)(uintptr_t)(lds + sk * SHM_T + SHM_K) + vrb, pa0, pa1, pa2, pa3);
  { auto rr = __builtin_amdgcn_permlane32_swap(__float_as_uint(l_reg), __float_as_uint(l_reg), false, false); l_reg = __uint_as_float(rr[0]) + __uint_as_float(rr[1]); }
  store_o(o, l_reg, li_l, Ob + (long)(wid * QBLK) * ldo, ldo, r32, hi);
  VM0();
  __syncthreads();
#undef TDMA
#undef FINISH
}

constexpr int SHM_V2 = KVBLK * 256 * 2;
__device__ __forceinline__ void attn_body_dv256(const bf16_t* __restrict__ Qb, const int ldq, const bf16_t* __restrict__ Kh, const bf16_t* __restrict__ Vh, const int ldk,
                                                bf16_t* __restrict__ Ob, const int ldo, const int seq, const float kmax2, LAS char* lds) {
  int tid = threadIdx.x; asm volatile("" : "+v"(tid)); tid &= 511;
  const int wid = tid >> 6, lane = tid & 63, r32 = lane & 31, hi = lane >> 5, rg = wid >> 1, kh = wid & 1;
  LAS char* K_lds = lds; LAS char* V_lds = lds + 2 * SHM_K; LAS char* X_lds = lds + 2 * SHM_K + 2 * SHM_V2;
  float l_reg = 0; f32x16 o[4] = {}; bf16x8 qr[8];
  const float nmc = load_q(Qb + (long)(rg * QBLK + r32) * ldq + hi * 8, qr, kmax2);
  const int vb0 = (int)(uintptr_t)V_lds + v_rd_base(lane) + kh * 2048;
  const int kvo = k_dma_voff(wid, lane, ldk);
  const int vvo = unswap23(8 * (wid >> 2) + ((lane & 31) >> 2)) * ldk * 2 + ((2 * (wid & 3) + (lane >> 5)) * 32 + (lane & 3) * 8) * 2;
  const int l32 = 64 * ldk, l16 = 32 * ldk, pz = wid * 1024;
  const int xw = (rg * 4 + kh * 2) * 1024 + lane * 16, xr = rg * 4096 + lane * 16;
  const __amdgpu_buffer_rsrc_t krs = __builtin_amdgcn_make_buffer_rsrc((void*)Kh, 0, 0x7ffffff0, 0x00020000);
  const __amdgpu_buffer_rsrc_t vrs = __builtin_amdgcn_make_buffer_rsrc((void*)Vh, 0, 0x7ffffff0, 0x00020000);
#define KDMA(b, k0) do { const int _o = (k0) * ldk * 2; LAS char* _b = K_lds + (b) * SHM_K + pz; DMA16(krs, _b, kvo, _o); DMA16(krs, _b + 8192, kvo, _o + l32); } while (0)
#define VDMA(b, k0) do { const int _o = (k0) * ldk * 2; LAS char* _b = V_lds + (b) * SHM_V2 + pz; DMA16(vrs, _b, vvo, _o); DMA16(vrs, _b + 8192, vvo, _o + l16); \
    DMA16(vrs, _b + 16384, vvo, _o + 2 * l16); DMA16(vrs, _b + 24576, vvo, _o + 3 * l16); } while (0)
  f32x16 pA, pB; bf16x8 pa0, pa1, pa2, pa3, own0, own1; const int NT = seq / KVBLK;
  const int kxor = ((32 * kh + r32) & 7) << 4, krb = (32 * kh + r32) * 256;
#define QKHALF(P, b) do { _Pragma("unroll") for (int r = 0; r < 16; ++r) P[r] = nmc; \
    _Pragma("unroll") for (int d0 = 0; d0 < 8; ++d0) { const bf16x8 bk = *(LAS const bf16x8*)(K_lds + (b) * SHM_K + krb + (((d0 * 16 + hi * 8) * 2) ^ kxor)); \
      P = __builtin_amdgcn_mfma_f32_32x32x16_bf16(bk, qr[d0], P, 0, 0, 0); } } while (0)
#define FINH(P) do { exp16(P); l_reg += sum16(P); PK4(P, 0, own0); PK4(P, 8, own1); } while (0)
#define XWRITE(b) do { *(LAS bf16x8*)(X_lds + (b) * 16384 + xw) = own0; *(LAS bf16x8*)(X_lds + (b) * 16384 + xw + 1024) = own1; } while (0)
#define XREAD(b) do { pa0 = *(LAS const bf16x8*)(X_lds + (b) * 16384 + xr); pa1 = *(LAS const bf16x8*)(X_lds + (b) * 16384 + xr + 1024); \
    pa2 = *(LAS const bf16x8*)(X_lds + (b) * 16384 + xr + 2048); pa3 = *(LAS const bf16x8*)(X_lds + (b) * 16384 + xr + 3072); } while (0)
#define STEP(PA, PB, b, j) do { \
    SCHED; if ((j) + 1 < NT) QKHALF(PB, (b) ^ 1); FINH(PA); SCHED; \
    XWRITE(b); VM0(); __syncthreads(); \
    if ((j) + 3 < NT) KDMA((b) ^ 1, ((j) + 3) * KVBLK); if ((j) + 1 < NT) VDMA((b) ^ 1, ((j) + 1) * KVBLK); \
    XREAD(b); \
    pv_d0_256(o, vb0 + (b) * SHM_V2, pa0, pa1, pa2, pa3); } while (0)
  KDMA(0, 0); KDMA(1, KVBLK); VDMA(0, 0); VM0(); __syncthreads();
  QKHALF(pA, 0);
  __syncthreads();
  if (2 < NT) KDMA(0, 2 * KVBLK);
  for (int j = 0; j < NT; j += 2) { STEP(pA, pB, 0, j); STEP(pB, pA, 1, j + 1); }
  __syncthreads();
  LAS float* lx = (LAS float*)X_lds;
  lx[wid * 64 + lane] = l_reg; __syncthreads();
  const float l_tot = lx[wid * 64 + r32] + lx[wid * 64 + 32 + r32] + lx[(wid ^ 1) * 64 + r32] + lx[(wid ^ 1) * 64 + 32 + r32];
  store_o(o, l_tot, lx + 512 + wid * 32, Ob + (long)(rg * QBLK) * ldo + kh * 128, ldo, r32, hi);
  VM0();
  __syncthreads();
#undef KDMA
#undef VDMA
#undef QKHALF
#undef FINH
#undef XWRITE
#undef XREAD
#undef STEP
#undef VM0
}

#define LGK(n) asm volatile("s_waitcnt lgkmcnt(" #n ")" ::: "memory")
template <int OFF> __device__ __forceinline__ bf16x8 k_read(int ka) { bf16x8 r; asm volatile("ds_read_b128 %0, %1 offset:%2" : "=&v"(r) : "v"(ka), "i"(OFF) : "memory"); return r; }
struct VSet { s16x4 l0, h0, l1, h1; };
template <int OFF> __device__ __forceinline__ void v_read(VSet& s, int vb) { s.l0 = tr_read<OFF>(vb); s.h0 = tr_read<OFF + 4096>(vb); s.l1 = tr_read<OFF + 8192>(vb); s.h1 = tr_read<OFF + 12288>(vb); }
__device__ __forceinline__ void pv2(f32x16& oa, const VSet& s, bf16x8 pa0, bf16x8 pa1) {
#define PK(L, H) (bf16x8){L[0], L[1], L[2], L[3], H[0], H[1], H[2], H[3]}
  oa = __builtin_amdgcn_mfma_f32_32x32x16_bf16(pa0, PK(s.l0, s.h0), oa, 0, 0, 0);
  oa = __builtin_amdgcn_mfma_f32_32x32x16_bf16(pa1, PK(s.l1, s.h1), oa, 0, 0, 0);
#undef PK
}
template <bool SHIFT>
__device__ __forceinline__ void attn_body_c256_t(const bf16_t* __restrict__ Qb, const int ldq, const bf16_t* __restrict__ Kh, const bf16_t* __restrict__ Vh, const int ldk,
                                                 bf16_t* __restrict__ Ob, const int ldo, const int seq, const float nmc, const bf16x8 (&qr)[8], LAS char* lds) {
  int tid = threadIdx.x; asm volatile("" : "+v"(tid)); tid &= 511;
  const int wid = __builtin_amdgcn_readfirstlane(tid >> 6), lane = tid & 63, r32 = lane & 31, hi = lane >> 5;
  LAS char* K_lds = lds; LAS char* V_lds = lds + 2 * SHM_K;
  LAS float* li_l = (LAS float*)(lds + 2 * SHM_K + 2 * SHM_V2) + wid * 64;
  float l_reg = 0; f32x16 o[8] = {};
  const int vb0 = (int)(uintptr_t)V_lds + v_rd_base(lane);
  const int kvo = k_dma_voff(wid, lane, ldk);
  const int vvo = unswap23(8 * (wid >> 2) + ((lane & 31) >> 2)) * ldk * 2 + ((2 * (wid & 3) + (lane >> 5)) * 32 + (lane & 3) * 8) * 2;
  const int l32 = 64 * ldk, l16 = 32 * ldk, pz = wid * 1024;
  const __amdgpu_buffer_rsrc_t krs = __builtin_amdgcn_make_buffer_rsrc((void*)Kh, 0, 0x7ffffff0, 0x00020000);
  const __amdgpu_buffer_rsrc_t vrs = __builtin_amdgcn_make_buffer_rsrc((void*)Vh, 0, 0x7ffffff0, 0x00020000);
#define VM0() asm volatile("s_waitcnt vmcnt(0)" ::: "memory")
#define KVDMA(b, k0) do { const int _o = (k0) * ldk * 2; LAS char* _k = K_lds + (b) * SHM_K + pz; LAS char* _v = V_lds + (b) * SHM_V2 + pz; \
    DMA16(krs, _k, kvo, _o); DMA16(krs, _k + 8192, kvo, _o + l32); DMA16(vrs, _v, vvo, _o); DMA16(vrs, _v + 8192, vvo, _o + l16); \
    DMA16(vrs, _v + 16384, vvo, _o + 2 * l16); DMA16(vrs, _v + 24576, vvo, _o + 3 * l16); } while (0)
  int ka[8];
  { const int kxor = (r32 & 7) << 4, krb = (int)(uintptr_t)K_lds + r32 * 256;
#pragma unroll
    for (int d0 = 0; d0 < 8; ++d0) ka[d0] = krb + (((d0 * 16 + hi * 8) * 2) ^ kxor); }
  f32x16 P; bf16x8 pa0, pa1, f0, f1, f2, f3; VSet va, vb_, vc;
  const int NT = seq / KVBLK;
#define PINIT() do { _Pragma("unroll") for (int r = 0; r < 16; ++r) { float _z; asm volatile("v_mov_b32 %0, %1" : "=v"(_z) : "v"(SHIFT ? nmc : 0.f)); P[r] = _z; } } while (0)
#define KOFF(b, h) ((b) * 16384 + (h) * 8192)
#define VOFF(b, h, d0) ((b) * 32768 + (h) * 16384 + (d0) * 512)
#define KPRO(b, h) do { f0 = k_read<KOFF(b, h)>(ka[0]); f1 = k_read<KOFF(b, h)>(ka[1]); f2 = k_read<KOFF(b, h)>(ka[2]); } while (0)
#define QKM(F, d0) do { SCHED; P = __builtin_amdgcn_mfma_f32_32x32x16_bf16(F, qr[d0], P, 0, 0, 0); SCHED; } while (0)
#define QKHALF(b, h) do { PINIT(); \
    LGK(2); QKM(f0, 0); f3 = k_read<KOFF(b, h)>(ka[3]); \
    LGK(2); QKM(f1, 1); f0 = k_read<KOFF(b, h)>(ka[4]); \
    LGK(2); QKM(f2, 2); f1 = k_read<KOFF(b, h)>(ka[5]); \
    LGK(2); QKM(f3, 3); f2 = k_read<KOFF(b, h)>(ka[6]); \
    LGK(2); QKM(f0, 4); f3 = k_read<KOFF(b, h)>(ka[7]); \
    LGK(2); QKM(f1, 5); v_read<VOFF(b, h, 0)>(va, vb0); \
    LGK(5); QKM(f2, 6); v_read<VOFF(b, h, 1)>(vb_, vb0); \
    LGK(8); QKM(f3, 7); } while (0)
#define SMH() do { exp16(P); l_reg += sum16(P); PK4(P, 0, pa0); PK4(P, 8, pa1); } while (0)
#define PVM(S, d0) do { SCHED; pv2(o[d0], S, pa0, pa1); SCHED; } while (0)
#define PVHALF(b, h, NEXTK, nb, nh) do { \
    LGK(4); PVM(va, 0); v_read<VOFF(b, h, 2)>(vc, vb0); \
    LGK(4); PVM(vb_, 1); v_read<VOFF(b, h, 3)>(va, vb0); \
    LGK(4); PVM(vc, 2); v_read<VOFF(b, h, 4)>(vb_, vb0); \
    LGK(4); PVM(va, 3); v_read<VOFF(b, h, 5)>(vc, vb0); \
    LGK(4); PVM(vb_, 4); v_read<VOFF(b, h, 6)>(va, vb0); \
    LGK(4); PVM(vc, 5); v_read<VOFF(b, h, 7)>(vb_, vb0); \
    LGK(4); PVM(va, 6); if (NEXTK) { f0 = k_read<KOFF(nb, nh)>(ka[0]); f1 = k_read<KOFF(nb, nh)>(ka[1]); } \
    if (NEXTK) { LGK(2); } else { LGK(0); } PVM(vb_, 7); if (NEXTK) { f2 = k_read<KOFF(nb, nh)>(ka[2]); } } while (0)
#define STEPC(b, j) do { if ((j) + 1 < NT) KVDMA((b) ^ 1, ((j) + 1) * KVBLK); \
    KPRO(b, 0); QKHALF(b, 0); SMH(); PVHALF(b, 0, true, b, 1); \
    QKHALF(b, 1); SMH(); PVHALF(b, 1, false, 0, 0); \
    VM0(); __syncthreads(); } while (0)
  KVDMA(0, 0); VM0(); __syncthreads();
  for (int j = 0; j < NT; j += 2) { STEPC(0, j); STEPC(1, j + 1); }
  { auto rr = __builtin_amdgcn_permlane32_swap(__float_as_uint(l_reg), __float_as_uint(l_reg), false, false); l_reg = __uint_as_float(rr[0]) + __uint_as_float(rr[1]); }
  if (hi == 0) li_l[r32] = l_reg; asm volatile("s_waitcnt lgkmcnt(0)" ::: "memory");
  bf16_t* Ow = Ob + (long)(wid * QBLK) * ldo;
#pragma unroll
  for (int r = 0; r < 16; ++r) { const int orow = crow(r, hi); const float rl = __builtin_amdgcn_rcpf(li_l[orow]);
#pragma unroll
    for (int d0 = 0; d0 < 8; ++d0) Ow[(long)orow * ldo + d0 * 32 + r32] = f2bf(o[d0][r] * rl); }
  VM0();
  __syncthreads();
#undef KVDMA
#undef PINIT
#undef KOFF
#undef VOFF
#undef KPRO
#undef QKM
#undef QKHALF
#undef SMH
#undef PVM
#undef PVHALF
#undef STEPC
#undef VM0
}
__device__ __forceinline__ void attn_body_c256(const bf16_t* __restrict__ Qb, const int ldq, const bf16_t* __restrict__ Kh, const bf16_t* __restrict__ Vh, const int ldk,
                                               bf16_t* __restrict__ Ob, const int ldo, const int seq, const float kmax2, LAS char* lds) {
  int tid = threadIdx.x; asm volatile("" : "+v"(tid)); tid &= 511;
  const int wid = tid >> 6, lane = tid & 63, r32 = lane & 31, hi = lane >> 5;
  bf16x8 qr[8];
  const float nmc = load_q(Qb + (long)(wid * QBLK + r32) * ldq + hi * 8, qr, kmax2);
  if (__all(nmc > -64.f)) attn_body_c256_t<false>(Qb, ldq, Kh, Vh, ldk, Ob, ldo, seq, 0.f, qr, lds);
  else attn_body_c256_t<true>(Qb, ldq, Kh, Vh, ldk, Ob, ldo, seq, nmc, qr, lds);
}

__device__ __forceinline__ float load_q8(const bf16_t* __restrict__ Qrow, int hi, v8i_ (&qf)[2], float kmax2) {
  float ss = 0;
#pragma unroll
  for (int st = 0; st < 2; ++st) {
    const bf16_t* p = Qrow + 64 * st + 32 * hi; v8i_ o;
#pragma unroll
    for (int c = 0; c < 4; ++c) { const u32x4 raw = *reinterpret_cast<const u32x4*>(p + 8 * c);
      const unsigned w0 = pack8x4(bflo(raw[0]) * QC, bfhi(raw[0]) * QC, bflo(raw[1]) * QC, bfhi(raw[1]) * QC);
      const unsigned w1 = pack8x4(bflo(raw[2]) * QC, bfhi(raw[2]) * QC, bflo(raw[3]) * QC, bfhi(raw[3]) * QC);
      o[2 * c] = (int)w0; o[2 * c + 1] = (int)w1; ss += sq8x4(w0) + sq8x4(w1); }
    qf[st] = o;
  }
  { auto rr = __builtin_amdgcn_permlane32_swap(__float_as_uint(ss), __float_as_uint(ss), false, false); ss = __uint_as_float(rr[0]) + __uint_as_float(rr[1]); }
  return -(sqrtf(ss * kmax2) * 1.01f + 1e-3f);
}
__device__ __forceinline__ int k8_dma_voff(int wid, int lane, int ldk8) {
  const int row = 8 * wid + (lane >> 3); return row * ldk8 + (((lane & 7) ^ ((row >> 1) & 7)) << 4); }
template <int OFF> __device__ __forceinline__ v4i k8_read(int ka) { v4i r; asm volatile("ds_read_b128 %0, %1 offset:%2" : "=&v"(r) : "v"(ka), "i"(OFF) : "memory"); return r; }

template <bool SHIFT>
__device__ __forceinline__ void attn_body_c256q8_t(const unsigned char* __restrict__ K8, const int ldk8, const bf16_t* __restrict__ Vh, const int ldk,
                                                   bf16_t* __restrict__ Ob, const int ldo, const int seq, const float nmc, const v8i_ (&qf)[2], LAS char* lds) {
  int tid = threadIdx.x; asm volatile("" : "+v"(tid)); tid &= 511;
  const int wid = __builtin_amdgcn_readfirstlane(tid >> 6), lane = tid & 63, r32 = lane & 31, hi = lane >> 5;
  constexpr int SHM_K8 = KVBLK * 128;
  LAS char* K_lds = lds; LAS char* V_lds = lds + 2 * SHM_K8;
  LAS float* li_l = (LAS float*)(lds + 2 * SHM_K8 + 2 * SHM_V2) + wid * 64;
  float l_reg = 0; f32x16 o[8] = {};
  const int vb0 = (int)(uintptr_t)V_lds + v_rd_base(lane);
  const int kvo = k8_dma_voff(wid, lane, ldk8);
  const int vvo = unswap23(8 * (wid >> 2) + ((lane & 31) >> 2)) * ldk * 2 + ((2 * (wid & 3) + (lane >> 5)) * 32 + (lane & 3) * 8) * 2;
  const int l16 = 32 * ldk, pz = wid * 1024;
  const __amdgpu_buffer_rsrc_t krs = __builtin_amdgcn_make_buffer_rsrc((void*)K8, 0, 0x7ffffff0, 0x00020000);
  const __amdgpu_buffer_rsrc_t vrs = __builtin_amdgcn_make_buffer_rsrc((void*)Vh, 0, 0x7ffffff0, 0x00020000);
#define VM0() asm volatile("s_waitcnt vmcnt(0)" ::: "memory")
#define KVDMA(b, k0) do { const int _o = (k0) * ldk * 2; LAS char* _v = V_lds + (b) * SHM_V2 + pz; \
    DMA16(krs, K_lds + (b) * SHM_K8 + pz, kvo, (k0) * ldk8); DMA16(vrs, _v, vvo, _o); DMA16(vrs, _v + 8192, vvo, _o + l16); \
    DMA16(vrs, _v + 16384, vvo, _o + 2 * l16); DMA16(vrs, _v + 24576, vvo, _o + 3 * l16); } while (0)
  const int ka0 = (int)(uintptr_t)K_lds + r32 * 128 + (((2 * hi) ^ ((r32 >> 1) & 7)) << 4);
  const int ka1 = ka0 ^ 16, ka2 = ka0 ^ 64, ka3 = ka0 ^ 80;
  int sc1; asm volatile("v_mov_b32 %0, 0x7f7f7f7f" : "=v"(sc1));
  f32x16 P; bf16x8 pa0, pa1; v4i k0a, k0b, k1a, k1b; VSet va, vb_, vc;
  const int NT = seq / KVBLK;
#define KOFF(b, h) ((b) * 8192 + (h) * 4096)
#define VOFF(b, h, d0) ((b) * 32768 + (h) * 16384 + (d0) * 512)
#define KPRO(b, h) do { k0a = k8_read<KOFF(b, h)>(ka0); k0b = k8_read<KOFF(b, h)>(ka1); k1a = k8_read<KOFF(b, h)>(ka2); k1b = k8_read<KOFF(b, h)>(ka3); } while (0)
#define V8(x, y) (v8i_){x[0], x[1], x[2], x[3], y[0], y[1], y[2], y[3]}
#define QKHALF(b, h) do { \
    if (SHIFT) { _Pragma("unroll") for (int r = 0; r < 16; ++r) { float _z; asm volatile("v_mov_b32 %0, %1" : "=v"(_z) : "v"(nmc)); P[r] = _z; } } \
    LGK(2); SCHED; { const v8i_ kf = V8(k0a, k0b); \
      if (SHIFT) asm volatile("s_nop 4\n\tv_mfma_scale_f32_32x32x64_f8f6f4 %0, %1, %2, %0, %3, %3 op_sel_hi:[0,0,0]" : "+v"(P) : "v"(kf), "v"(qf[0]), "v"(sc1)); \
      else       asm volatile("v_mfma_scale_f32_32x32x64_f8f6f4 %0, %1, %2, 0, %3, %3 op_sel_hi:[0,0,0]" : "=&v"(P) : "v"(kf), "v"(qf[0]), "v"(sc1)); } \
    SCHED; v_read<VOFF(b, h, 0)>(va, vb0); \
    LGK(4); SCHED; { const v8i_ kf = V8(k1a, k1b); \
      asm volatile("v_mfma_scale_f32_32x32x64_f8f6f4 %0, %1, %2, %0, %3, %3 op_sel_hi:[0,0,0]" : "+v"(P) : "v"(kf), "v"(qf[1]), "v"(sc1)); } \
    SCHED; v_read<VOFF(b, h, 1)>(vb_, vb0); \
    asm volatile("s_nop 15\n\ts_nop 7" : "+v"(P)); } while (0)
#define SMH() do { exp16(P); l_reg += sum16(P); PK4(P, 0, pa0); PK4(P, 8, pa1); } while (0)
#define PVM(S, d0) do { SCHED; pv2(o[d0], S, pa0, pa1); SCHED; } while (0)
#define PVHALF(b, h, NEXTK, nb, nh) do { \
    LGK(4); PVM(va, 0); v_read<VOFF(b, h, 2)>(vc, vb0); \
    LGK(4); PVM(vb_, 1); v_read<VOFF(b, h, 3)>(va, vb0); \
    LGK(4); PVM(vc, 2); v_read<VOFF(b, h, 4)>(vb_, vb0); \
    LGK(4); PVM(va, 3); v_read<VOFF(b, h, 5)>(vc, vb0); \
    LGK(4); PVM(vb_, 4); v_read<VOFF(b, h, 6)>(va, vb0); \
    LGK(4); PVM(vc, 5); v_read<VOFF(b, h, 7)>(vb_, vb0); \
    LGK(4); PVM(va, 6); if (NEXTK) { k0a = k8_read<KOFF(nb, nh)>(ka0); k0b = k8_read<KOFF(nb, nh)>(ka1); } \
    if (NEXTK) { LGK(2); } else { LGK(0); } PVM(vb_, 7); if (NEXTK) { k1a = k8_read<KOFF(nb, nh)>(ka2); k1b = k8_read<KOFF(nb, nh)>(ka3); } } while (0)
#define STEPC(b, j) do { if ((j) + 1 < NT) KVDMA((b) ^ 1, ((j) + 1) * KVBLK); \
    KPRO(b, 0); QKHALF(b, 0); SMH(); PVHALF(b, 0, true, b, 1); \
    QKHALF(b, 1); SMH(); PVHALF(b, 1, false, 0, 0); \
    VM0(); __syncthreads(); } while (0)
  KVDMA(0, 0); VM0(); __syncthreads();
  for (int j = 0; j < NT; j += 2) { STEPC(0, j); STEPC(1, j + 1); }
  { auto rr = __builtin_amdgcn_permlane32_swap(__float_as_uint(l_reg), __float_as_uint(l_reg), false, false); l_reg = __uint_as_float(rr[0]) + __uint_as_float(rr[1]); }
  if (hi == 0) li_l[r32] = l_reg; asm volatile("s_waitcnt lgkmcnt(0)" ::: "memory");
  bf16_t* Ow = Ob + (long)(wid * QBLK) * ldo;
#pragma unroll
  for (int r = 0; r < 16; ++r) { const int orow = crow(r, hi); const float rl = __builtin_amdgcn_rcpf(li_l[orow]);
#pragma unroll
    for (int d0 = 0; d0 < 8; ++d0) Ow[(long)orow * ldo + d0 * 32 + r32] = f2bf(o[d0][r] * rl); }
  VM0();
  __syncthreads();
#undef KVDMA
#undef KOFF
#undef VOFF
#undef KPRO
#undef V8
#undef QKHALF
#undef SMH
#undef PVM
#undef PVHALF
#undef STEPC
#undef VM0
}
__device__ __forceinline__ void attn_body_c256q8(const bf16_t* __restrict__ Qb, const int ldq, const unsigned char* __restrict__ K8, const int ldk8,
                                                 const bf16_t* __restrict__ Vh, const int ldk, bf16_t* __restrict__ Ob, const int ldo, const int seq, const float kmax2, LAS char* lds) {
  int tid = threadIdx.x; asm volatile("" : "+v"(tid)); tid &= 511;
  const int wid = tid >> 6, lane = tid & 63, r32 = lane & 31, hi = lane >> 5;
  v8i_ qf[2];
  const float nmc = load_q8(Qb + (long)(wid * QBLK + r32) * ldq, hi, qf, kmax2);
  if (__all(nmc > -64.f)) attn_body_c256q8_t<false>(K8, ldk8, Vh, ldk, Ob, ldo, seq, 0.f, qf, lds);
  else attn_body_c256q8_t<true>(K8, ldk8, Vh, ldk, Ob, ldo, seq, nmc, qf, lds);
}

template <bool SHIFT>
__device__ __forceinline__ void attn_body_q8_t(const unsigned char* __restrict__ K8, const int ldk8, const bf16_t* __restrict__ Vh, const int ldk,
                                               bf16_t* __restrict__ Ob, const int ldo, const int seq, const float nmc, const v8i_ (&qf)[2], LAS char* lds) {
  int tid = threadIdx.x; asm volatile("" : "+v"(tid)); tid &= 511;
  const int wid = __builtin_amdgcn_readfirstlane(tid >> 6), lane = tid & 63, r32 = lane & 31, hi = lane >> 5;
  constexpr int SK8 = KVBLK * 128, ST = SK8 + SHM_V;
  LAS float* li_l = (LAS float*)(lds + 3 * ST) + wid * 64;
  float l_reg = 0; f32x16 o[4] = {};
  const int vrb = v_rd_base(lane);
  const int kvo = k8_dma_voff(wid, lane, ldk8);
  const int vvo = unswap23(8 * (wid >> 1) + ((lane & 31) >> 2)) * ldk * 2 + ((2 * (wid & 1) + (lane >> 5)) * 32 + (lane & 3) * 8) * 2;
  const int l32 = 64 * ldk, pz = wid * 1024;
  const __amdgpu_buffer_rsrc_t krs = __builtin_amdgcn_make_buffer_rsrc((void*)K8, 0, 0x7ffffff0, 0x00020000);
  const __amdgpu_buffer_rsrc_t vrs = __builtin_amdgcn_make_buffer_rsrc((void*)Vh, 0, 0x7ffffff0, 0x00020000);
#define TDMA(slot, k0) do { const int _o = (k0) * ldk * 2; LAS char* _b = lds + (slot) * ST + pz; \
    DMA16(krs, _b, kvo, (k0) * ldk8); DMA16(vrs, _b + SK8, vvo, _o); DMA16(vrs, _b + SK8 + 8192, vvo, _o + l32); } while (0)
#define VM0() asm volatile("s_waitcnt vmcnt(0)" ::: "memory")
  int sc1; asm volatile("v_mov_b32 %0, 0x7f7f7f7f" : "=v"(sc1));
  const int kof = r32 * 128 + (((2 * hi) ^ ((r32 >> 1) & 7)) << 4);
#define QKT8(P0, P1, Ks) do { \
    const v4i a0 = *(LAS const v4i*)((Ks) + kof), a1 = *(LAS const v4i*)((Ks) + (kof ^ 16)), a2 = *(LAS const v4i*)((Ks) + (kof ^ 64)), a3 = *(LAS const v4i*)((Ks) + (kof ^ 80)); \
    const v4i b0 = *(LAS const v4i*)((Ks) + 4096 + kof), b1 = *(LAS const v4i*)((Ks) + 4096 + (kof ^ 16)), b2 = *(LAS const v4i*)((Ks) + 4096 + (kof ^ 64)), b3 = *(LAS const v4i*)((Ks) + 4096 + (kof ^ 80)); \
    v8i_ k00 = (v8i_){a0[0], a0[1], a0[2], a0[3], a1[0], a1[1], a1[2], a1[3]}, k01 = (v8i_){a2[0], a2[1], a2[2], a2[3], a3[0], a3[1], a3[2], a3[3]}; \
    v8i_ k10 = (v8i_){b0[0], b0[1], b0[2], b0[3], b1[0], b1[1], b1[2], b1[3]}, k11 = (v8i_){b2[0], b2[1], b2[2], b2[3], b3[0], b3[1], b3[2], b3[3]}; \
    if (SHIFT) { _Pragma("unroll") for (int r = 0; r < 16; ++r) { P0[r] = nmc; P1[r] = nmc; } \
      asm volatile("s_nop 4\n\tv_mfma_scale_f32_32x32x64_f8f6f4 %0, %1, %2, %0, %3, %3 op_sel_hi:[0,0,0]" : "+v"(P0) : "v"(k00), "v"(qf[0]), "v"(sc1)); \
      asm volatile("v_mfma_scale_f32_32x32x64_f8f6f4 %0, %1, %2, %0, %3, %3 op_sel_hi:[0,0,0]" : "+v"(P1) : "v"(k10), "v"(qf[0]), "v"(sc1)); } \
    else { asm volatile("v_mfma_scale_f32_32x32x64_f8f6f4 %0, %1, %2, 0, %3, %3 op_sel_hi:[0,0,0]" : "=&v"(P0) : "v"(k00), "v"(qf[0]), "v"(sc1)); \
      asm volatile("v_mfma_scale_f32_32x32x64_f8f6f4 %0, %1, %2, 0, %3, %3 op_sel_hi:[0,0,0]" : "=&v"(P1) : "v"(k10), "v"(qf[0]), "v"(sc1)); } \
    asm volatile("v_mfma_scale_f32_32x32x64_f8f6f4 %0, %1, %2, %0, %3, %3 op_sel_hi:[0,0,0]" : "+v"(P0) : "v"(k01), "v"(qf[1]), "v"(sc1)); \
    asm volatile("v_mfma_scale_f32_32x32x64_f8f6f4 %0, %1, %2, %0, %3, %3 op_sel_hi:[0,0,0]" : "+v"(P1) : "v"(k11), "v"(qf[1]), "v"(sc1)); \
      \
    asm volatile("s_nop 15" : "+v"(k00), "+v"(k01), "+v"(k10), "+v"(k11)); } while (0)
#define TIE(P0, P1) asm volatile("s_nop 15\n\ts_nop 7" : "+v"(P0), "+v"(P1))
#define TIE0(P0, P1) asm volatile("" : "+v"(P0), "+v"(P1))
#define FINISH(P0, P1) do { exp16(P1); l_reg += sum16(P0) + sum16(P1); PK4(P0, 0, pa0); PK4(P0, 8, pa1); PK4(P1, 0, pa2); PK4(P1, 8, pa3); } while (0)
  f32x16 pA0, pA1, pB0, pB1; bf16x8 pa0, pa1, pa2, pa3; const int NT = seq / KVBLK;
  TDMA(0, 0); VM0(); __syncthreads();
  TDMA(1, KVBLK);
  QKT8(pA0, pA1, lds); TIE(pA0, pA1); exp16(pA0);
  VM0(); __syncthreads();
  int sk = 1, sv = 0, sd = 2;
  for (int j = 1; j + 1 < NT; j += 2) {
    TDMA(sd, (j + 1) * KVBLK);
    SCHED; QKT8(pB0, pB1, lds + sk * ST);
    FINISH(pA0, pA1); SCHED;
    pv_d0(o, (int)(uintptr_t)(lds + sv * ST + SK8) + vrb, pa0, pa1, pa2, pa3); TIE0(pB0, pB1); exp16(pB0);
    VM0(); __syncthreads();
    { const int t = sv; sv = sk; sk = sd; sd = t; }
    if (j + 2 < NT) TDMA(sd, (j + 2) * KVBLK);
    SCHED; QKT8(pA0, pA1, lds + sk * ST);
    FINISH(pB0, pB1); SCHED;
    pv_d0(o, (int)(uintptr_t)(lds + sv * ST + SK8) + vrb, pa0, pa1, pa2, pa3); TIE0(pA0, pA1); exp16(pA0);
    VM0(); __syncthreads();
    { const int t = sv; sv = sk; sk = sd; sd = t; }
  }
  SCHED; QKT8(pB0, pB1, lds + sk * ST);
  FINISH(pA0, pA1); SCHED;
  pv_d0(o, (int)(uintptr_t)(lds + sv * ST + SK8) + vrb, pa0, pa1, pa2, pa3); TIE0(pB0, pB1); exp16(pB0);
  FINISH(pB0, pB1); SCHED;
  pv_d0(o, (int)(uintptr_t)(lds + sk * ST + SK8) + vrb, pa0, pa1, pa2, pa3);
  { auto rr = __builtin_amdgcn_permlane32_swap(__float_as_uint(l_reg), __float_as_uint(l_reg), false, false); l_reg = __uint_as_float(rr[0]) + __uint_as_float(rr[1]); }
#if DENSE8_G2
  store_o8(o, l_reg, li_l, (unsigned char*)Ob + (long)(wid * QBLK) * ldo, ldo, r32, hi);
#else
  store_o(o, l_reg, li_l, Ob + (long)(wid * QBLK) * ldo, ldo, r32, hi);
#endif
  VM0();
  __syncthreads();
#undef TDMA
#undef VM0
#undef QKT8
#undef TIE
#undef TIE0
#undef FINISH
}
__device__ __forceinline__ void attn_body_q8(const bf16_t* __restrict__ Qb, const int ldq, const unsigned char* __restrict__ K8, const int ldk8,
                                             const bf16_t* __restrict__ Vh, const int ldk, bf16_t* __restrict__ Ob, const int ldo, const int seq, const float kmax2, LAS char* lds) {
  int tid = threadIdx.x; asm volatile("" : "+v"(tid)); tid &= 511;
  const int wid = tid >> 6, lane = tid & 63, r32 = lane & 31, hi = lane >> 5;
  v8i_ qf[2];
  const float nmc = load_q8(Qb + (long)(wid * QBLK + r32) * ldq, hi, qf, kmax2);
  if (__all(nmc > -64.f)) attn_body_q8_t<false>(K8, ldk8, Vh, ldk, Ob, ldo, seq, 0.f, qf, lds);
  else attn_body_q8_t<true>(K8, ldk8, Vh, ldk, Ob, ldo, seq, nmc, qf, lds);
}

__device__ __forceinline__ unsigned pk8nc(float a, float b, float c, float d) {
  int p = __builtin_amdgcn_cvt_pk_fp8_f32(a, b, 0, false); p = __builtin_amdgcn_cvt_pk_fp8_f32(c, d, p, true); return (unsigned)p; }
__device__ __forceinline__ float max16(const f32x16& p) {
  float a = fmaxf(fmaxf(p[0], p[1]), fmaxf(p[2], p[3])), b = fmaxf(fmaxf(p[4], p[5]), fmaxf(p[6], p[7]));
  float c = fmaxf(fmaxf(p[8], p[9]), fmaxf(p[10], p[11])), d = fmaxf(fmaxf(p[12], p[13]), fmaxf(p[14], p[15]));
  return fmaxf(fmaxf(a, b), fmaxf(c, d)); }
template <int NCB>
__device__ __forceinline__ void attn_body_d(const bf16_t* __restrict__ Qb, const int ldq, const unsigned char* __restrict__ K8, const int ldk8,
                                               const unsigned char* __restrict__ V8T  ,
                                               bf16_t* __restrict__ Ob, const int ldo, const int seq, LAS char* lds) {
  int tid = threadIdx.x; asm volatile("" : "+v"(tid)); tid &= 511;
  const int wid = __builtin_amdgcn_readfirstlane(tid >> 6), lane = tid & 63, r32 = lane & 31, hi = lane >> 5;
  v8i_ qf[2];
  (void)load_q8(Qb + (long)(wid * QBLK + r32) * ldq, hi, qf, 0.f);
  constexpr int SK8 = KVBLK * 128, SV8 = NCB * 32 * 64;
  LAS char* K_lds = lds; LAS char* V_lds = lds + 2 * SK8;
  LAS float* li_l = (LAS float*)(lds + 2 * SK8 + 2 * SV8) + wid * 64;
  float l_reg = 0; f32x16 o[NCB] = {};
  const int kvo = k8_dma_voff(wid, lane, ldk8);
  const int vvo = lane * 16 + wid * 1024, pz = wid * 1024;
  const __amdgpu_buffer_rsrc_t krs = __builtin_amdgcn_make_buffer_rsrc((void*)K8, 0, 0x7ffffff0, 0x00020000);
  const __amdgpu_buffer_rsrc_t vrs = __builtin_amdgcn_make_buffer_rsrc((void*)V8T, 0, 0x7ffffff0, 0x00020000);
#define VM0() asm volatile("s_waitcnt vmcnt(0)" ::: "memory")
#define KVDMA(b, t) do { DMA16(krs, K_lds + (b) * SK8 + pz, kvo, (t) * KVBLK * ldk8); \
    DMA16(vrs, V_lds + (b) * SV8 + pz, vvo, (t) * SV8); if (NCB == 8) DMA16(vrs, V_lds + (b) * SV8 + pz + 8192, vvo, (t) * SV8 + 8192); } while (0)
  const int ka0 = (int)(uintptr_t)K_lds + r32 * 128 + (((2 * hi) ^ ((r32 >> 1) & 7)) << 4);
  const int ka1 = ka0 ^ 16, ka2 = ka0 ^ 64, ka3 = ka0 ^ 80;
  const int vf0 = (int)(uintptr_t)V_lds + r32 * 64 + (((2 * hi) ^ ((r32 >> 2) & 3)) << 4), vf1 = vf0 ^ 16;
  int sc1; asm volatile("v_mov_b32 %0, 0x7f7f7f7f" : "=v"(sc1));
  const int NT = seq / KVBLK;
#define RD128(dst, addr, OFF) asm volatile("ds_read_b128 %0, %1 offset:%2" : "=&v"(dst) : "v"(addr), "i"(OFF) : "memory")
#define V8(x, y) (v8i_){x[0], x[1], x[2], x[3], y[0], y[1], y[2], y[3]}
#define VFR(A_, B_, b, d0) do { RD128(A_, vf0, (b) * SV8 + (d0) * 2048); RD128(B_, vf1, (b) * SV8 + (d0) * 2048); } while (0)
#define PVM(A_, B_, d0) do { SCHED; { const v8i_ vfr = V8(A_, B_); \
    asm volatile("v_mfma_scale_f32_32x32x64_f8f6f4 %0, %1, %2, %0, %3, %4 op_sel_hi:[0,0,0]" : "+v"(o[(d0) < NCB ? (d0) : 0]) : "v"(pa8), "v"(vfr), "v"(sca), "v"(sc1)); } SCHED; } while (0)
#define STEPD(b, j) do { if ((j) + 1 < NT) KVDMA((b) ^ 1, (j) + 1); \
      \
    RD128(k0, ka0, (b) * 8192); RD128(k1, ka1, (b) * 8192); RD128(k2, ka2, (b) * 8192); RD128(k3, ka3, (b) * 8192); \
    RD128(k4, ka0, (b) * 8192 + 4096); RD128(k5, ka1, (b) * 8192 + 4096); RD128(k6, ka2, (b) * 8192 + 4096); RD128(k7, ka3, (b) * 8192 + 4096); \
    LGK(6); SCHED; { const v8i_ kf = V8(k0, k1); asm volatile("v_mfma_scale_f32_32x32x64_f8f6f4 %0, %1, %2, 0, %3, %3 op_sel_hi:[0,0,0]" : "=&v"(p0) : "v"(kf), "v"(qf[0]), "v"(sc1)); } \
    LGK(4); SCHED; { const v8i_ kf = V8(k2, k3); asm volatile("v_mfma_scale_f32_32x32x64_f8f6f4 %0, %1, %2, %0, %3, %3 op_sel_hi:[0,0,0]" : "+v"(p0) : "v"(kf), "v"(qf[1]), "v"(sc1)); } \
    LGK(2); SCHED; { const v8i_ kf = V8(k4, k5); asm volatile("v_mfma_scale_f32_32x32x64_f8f6f4 %0, %1, %2, 0, %3, %3 op_sel_hi:[0,0,0]" : "=&v"(p1) : "v"(kf), "v"(qf[0]), "v"(sc1)); } \
    LGK(0); SCHED; { const v8i_ kf = V8(k6, k7); asm volatile("v_mfma_scale_f32_32x32x64_f8f6f4 %0, %1, %2, %0, %3, %3 op_sel_hi:[0,0,0]" : "+v"(p1) : "v"(kf), "v"(qf[1]), "v"(sc1)); } \
    SCHED; VFR(va, vb, b, 0); VFR(vc, vd, b, 1); \
    asm volatile("s_nop 15\n\ts_nop 7" : "+v"(p0), "+v"(p1)); \
      \
    { const float mo = fmaxf(max16(p0), max16(p1)); \
      auto sA = __builtin_amdgcn_permlane32_swap(__float_as_uint(mo), __float_as_uint(mo), false, false); \
      const float e0 = fminf(fmaxf(ceilf(fmaxf(__uint_as_float(sA[0]), __uint_as_float(sA[1]))), -120.f), 120.f); \
      _Pragma("unroll") for (int r = 0; r < 16; ++r) { p0[r] = __builtin_amdgcn_exp2f(p0[r] - e0); p1[r] = __builtin_amdgcn_exp2f(p1[r] - e0); } \
      l_reg += __builtin_amdgcn_exp2f(e0) * (sum16(p0) + sum16(p1)); \
      sca = 127 + (int)e0; \
      _Pragma("unroll") for (int q = 0; q < 4; ++q) { \
        const unsigned x = pk8nc(p0[4 * q], p0[4 * q + 1], p0[4 * q + 2], p0[4 * q + 3]), y = pk8nc(p1[4 * q], p1[4 * q + 1], p1[4 * q + 2], p1[4 * q + 3]); \
        auto rr = __builtin_amdgcn_permlane32_swap(x, y, false, false); pa8[q] = (int)rr[0]; pa8[4 + q] = (int)rr[1]; } } \
      \
    asm volatile("s_nop 4" : "+v"(pa8), "+v"(sca));     \
    if (NCB == 8) { \
    LGK(2); PVM(va, vb, 0); VFR(ve, vf, b, 2); \
    LGK(2); PVM(vc, vd, 1); VFR(va, vb, b, 3); \
    LGK(2); PVM(ve, vf, 2); VFR(vc, vd, b, 4); \
    LGK(2); PVM(va, vb, 3); VFR(ve, vf, b, 5); \
    LGK(2); PVM(vc, vd, 4); VFR(va, vb, b, 6); \
    LGK(2); PVM(ve, vf, 5); VFR(vc, vd, b, 7); \
    LGK(2); PVM(va, vb, 6); \
    LGK(0); PVM(vc, vd, NCB - 1); } else { \
    LGK(2); PVM(va, vb, 0); VFR(ve, vf, b, 2); \
    LGK(2); PVM(vc, vd, 1); VFR(va, vb, b, 3); \
    LGK(2); PVM(ve, vf, 2); \
    LGK(0); PVM(va, vb, 3); } \
    VM0(); __syncthreads(); } while (0)
  f32x16 p0, p1; v8i_ pa8; int sca; v4i k0, k1, k2, k3, k4, k5, k6, k7, va, vb, vc, vd, ve, vf;
  KVDMA(0, 0); VM0(); __syncthreads();
  for (int j = 0; j < NT; j += 2) { STEPD(0, j); STEPD(1, j + 1); }
  asm volatile("s_nop 15\n\ts_nop 7" ::: "memory");
#pragma unroll
  for (int d0 = 0; d0 < NCB; ++d0) asm volatile("" : "+v"(o[d0]));
  { auto rr = __builtin_amdgcn_permlane32_swap(__float_as_uint(l_reg), __float_as_uint(l_reg), false, false); l_reg = __uint_as_float(rr[0]) + __uint_as_float(rr[1]); }
  if (hi == 0) li_l[r32] = l_reg; asm volatile("s_waitcnt lgkmcnt(0)" ::: "memory");
  bf16_t* Ow = Ob + (long)(wid * QBLK) * ldo;
#pragma unroll
  for (int r = 0; r < 16; ++r) { const int orow = crow(r, hi); const float rl = __builtin_amdgcn_rcpf(li_l[orow]);
#pragma unroll
    for (int d0 = 0; d0 < NCB; ++d0) Ow[(long)orow * ldo + d0 * 32 + r32] = f2bf(o[d0][r] * rl); }
  VM0();
  __syncthreads();
#undef VM0
#undef KVDMA
#undef RD128
#undef V8
#undef VFR
#undef PVM
#undef STEPD
}
__device__ __forceinline__ float max3a(float a, float b, float c) { float r; asm("v_max3_f32 %0, %1, %2, %3" : "=v"(r) : "v"(a), "v"(b), "v"(c)); return r; }
__device__ __forceinline__ float max2a(float a, float b) { float r; asm("v_max_f32 %0, %1, %2" : "=v"(r) : "v"(a), "v"(b)); return r; }
__device__ __forceinline__ float max32a(const f32x16& p, const f32x16& q) {
  const float a0 = max3a(p[0], p[1], p[2]), a1 = max3a(p[3], p[4], p[5]), a2 = max3a(p[6], p[7], p[8]), a3 = max3a(p[9], p[10], p[11]), a4 = max3a(p[12], p[13], p[14]);
  const float b0 = max3a(q[0], q[1], q[2]), b1 = max3a(q[3], q[4], q[5]), b2 = max3a(q[6], q[7], q[8]), b3 = max3a(q[9], q[10], q[11]), b4 = max3a(q[12], q[13], q[14]);
  const float c0 = max3a(a0, a1, a2), c1 = max3a(a3, a4, p[15]), c2 = max3a(b0, b1, b2), c3 = max3a(b3, b4, q[15]);
  return max2a(max3a(c0, c1, c2), c3); }
typedef short v2s_ __attribute__((ext_vector_type(2)));
struct DiffEpi { const bf16_t* O0; unsigned char* X2; float lam; const float* sg; };
template <int NCB, int VAR, bool FAST, int EM>
__device__ __forceinline__ void attn_body_e_t(const v8i_ (&qf)[2], const unsigned char* __restrict__ K8, const int ldk8,
                                            const unsigned char* __restrict__ V8T, bf16_t* __restrict__ Ob, const int ldo, const int seq, LAS char* lds, const DiffEpi de) {
  int tid = threadIdx.x; asm volatile("" : "+v"(tid)); tid &= 511;
  const int wid = __builtin_amdgcn_readfirstlane(tid >> 6), lane = tid & 63, r32 = lane & 31, hi = lane >> 5;
  constexpr int SK8 = KVBLK * 128, SV8 = NCB * 32 * 64;
  LAS char* K_lds = lds; LAS char* V_lds = lds + 2 * SK8;
  LAS float* li_l = (LAS float*)(lds + 2 * SK8 + 2 * SV8) + wid * 64;
  float l_reg = 0; f32x16 o[NCB] = {};
  const int kvo = ((wid & 3) * 16 + (lane >> 2)) * ldk8 + (((lane & 3) ^ ((lane >> 4) & 3)) << 4) + (wid >> 2) * 64;
  const int vvo = lane * 16 + wid * 1024, pz = wid * 1024;
  const __amdgpu_buffer_rsrc_t krs = __builtin_amdgcn_make_buffer_rsrc((void*)K8, 0, 0x7ffffff0, 0x00020000);
  const __amdgpu_buffer_rsrc_t vrs = __builtin_amdgcn_make_buffer_rsrc((void*)V8T, 0, 0x7ffffff0, 0x00020000);
#define VM0() asm volatile("s_waitcnt vmcnt(0)" ::: "memory")
#define KDMA(b, t) DMA16(krs, K_lds + (b) * SK8 + pz, kvo, (t) * KVBLK * ldk8)
#define VDMA(b, t) do { DMA16(vrs, V_lds + (b) * SV8 + pz, vvo, (t) * SV8); if (NCB == 8) DMA16(vrs, V_lds + (b) * SV8 + pz + 8192, vvo, (t) * SV8 + 8192); } while (0)
  const int ka0 = (int)(uintptr_t)K_lds + r32 * 64 + (((2 * hi) ^ ((r32 >> 2) & 3)) << 4), ka1 = ka0 ^ 16;
  constexpr int VOFF = 2 * SK8;
  int sc1; asm volatile("v_mov_b32 %0, 0x7f7f7f7f" : "=v"(sc1));
  const int NT = seq / KVBLK;
#define RD128(dst, addr, OFF) asm volatile("ds_read_b128 %0, %1 offset:%2" : "=&v"(dst) : "v"(addr), "i"(OFF) : "memory")
#define V8(x, y) (v8i_){x[0], x[1], x[2], x[3], y[0], y[1], y[2], y[3]}
#define VFR(A_, B_, b, d0) do { RD128(A_, ka0, VOFF + (b) * SV8 + (d0) * 2048); RD128(B_, ka1, VOFF + (b) * SV8 + (d0) * 2048); } while (0)
#define KFR(A_, B_, b, i) do { RD128(A_, ka0, (b) * 8192 + ((i) & 1) * 4096 + ((i) >> 1) * 2048); RD128(B_, ka1, (b) * 8192 + ((i) & 1) * 4096 + ((i) >> 1) * 2048); } while (0)
#define MF_ "v_mfma_scale_f32_32x32x64_f8f6f4 "
#define PVM(A_, B_, d0, PA, SC) do { SCHED; { const v8i_ vfr = V8(A_, B_); \
    if (VAR == 2) { asm volatile("s_nop 3" : "+v"(o[(d0) < NCB ? (d0) : 0]) : "v"(PA), "v"(vfr), "v"(SC), "v"(sc1)); } else { asm volatile(MF_ "%0, %1, %2, %0, %3, %4 op_sel_hi:[0,0,0]\n\ts_nop 3" : "+v"(o[(d0) < NCB ? (d0) : 0]) : "v"(PA), "v"(vfr), "v"(SC), "v"(sc1)); } } SCHED; } while (0)
#define QKZ(A_, B_, N_, qi) do { SCHED; { const v8i_ kf = V8(A_, B_); if (VAR == 2) { asm volatile("s_nop 3" : "=&v"(N_) : "v"(kf), "v"(qf[qi]), "v"(sc1)); } else { asm volatile(MF_ "%0, %1, %2, 0, %3, %3 op_sel_hi:[0,0,0]\n\ts_nop 3" : "=&v"(N_) : "v"(kf), "v"(qf[qi]), "v"(sc1)); } } SCHED; } while (0)
#define QKA(A_, B_, N_, qi) do { SCHED; { const v8i_ kf = V8(A_, B_); if (VAR == 2) { asm volatile("s_nop 3" : "+v"(N_) : "v"(kf), "v"(qf[qi]), "v"(sc1)); } else { asm volatile(MF_ "%0, %1, %2, %0, %3, %3 op_sel_hi:[0,0,0]\n\ts_nop 3" : "+v"(N_) : "v"(kf), "v"(qf[qi]), "v"(sc1)); } } SCHED; } while (0)
#define QKZ0(A_, B_, N_, qi) do { SCHED; { const v8i_ kf = V8(A_, B_); if (VAR == 2) { asm volatile("" : "=&v"(N_) : "v"(kf), "v"(qf[qi]), "v"(sc1)); } else { asm volatile(MF_ "%0, %1, %2, 0, %3, %3 op_sel_hi:[0,0,0]" : "=&v"(N_) : "v"(kf), "v"(qf[qi]), "v"(sc1)); } } SCHED; } while (0)
#define QKA0(A_, B_, N_, qi) do { SCHED; { const v8i_ kf = V8(A_, B_); if (VAR == 2) { asm volatile("" : "+v"(N_) : "v"(kf), "v"(qf[qi]), "v"(sc1)); } else { asm volatile(MF_ "%0, %1, %2, %0, %3, %3 op_sel_hi:[0,0,0]" : "+v"(N_) : "v"(kf), "v"(qf[qi]), "v"(sc1)); } } SCHED; } while (0)
#define PVR(A_, B_, d0, PA, SC, RA_, RB_, OFF) do { SCHED; { const v8i_ vfr = V8(A_, B_); \
    if (VAR == 2) { asm volatile("ds_read_b128 %1, %7 offset:%9\n\tds_read_b128 %2, %8 offset:%9" \
      : "+v"(o[(d0) < NCB ? (d0) : 0]), "=&v"(RA_), "=&v"(RB_) : "v"(PA), "v"(vfr), "v"(SC), "v"(sc1), "v"(ka0), "v"(ka1), "i"(OFF) : "memory"); } else { asm volatile(MF_ "%0, %3, %4, %0, %5, %6 op_sel_hi:[0,0,0]\n\tds_read_b128 %1, %7 offset:%9\n\tds_read_b128 %2, %8 offset:%9" \
      : "+v"(o[(d0) < NCB ? (d0) : 0]), "=&v"(RA_), "=&v"(RB_) : "v"(PA), "v"(vfr), "v"(SC), "v"(sc1), "v"(ka0), "v"(ka1), "i"(OFF) : "memory"); } } SCHED; } while (0)
#define QKZR(A_, B_, N_, qi, RA_, RB_, OFF) do { SCHED; { const v8i_ kf = V8(A_, B_); \
    if (VAR == 2) { asm volatile("ds_read_b128 %1, %6 offset:%8\n\tds_read_b128 %2, %7 offset:%8" \
      : "=&v"(N_), "=&v"(RA_), "=&v"(RB_) : "v"(kf), "v"(qf[qi]), "v"(sc1), "v"(ka0), "v"(ka1), "i"(OFF) : "memory"); } else { asm volatile(MF_ "%0, %3, %4, 0, %5, %5 op_sel_hi:[0,0,0]\n\tds_read_b128 %1, %6 offset:%8\n\tds_read_b128 %2, %7 offset:%8" \
      : "=&v"(N_), "=&v"(RA_), "=&v"(RB_) : "v"(kf), "v"(qf[qi]), "v"(sc1), "v"(ka0), "v"(ka1), "i"(OFF) : "memory"); } } SCHED; } while (0)
#define QKAR(A_, B_, N_, qi, RA_, RB_, OFF) do { SCHED; { const v8i_ kf = V8(A_, B_); \
    if (VAR == 2) { asm volatile("ds_read_b128 %1, %6 offset:%8\n\tds_read_b128 %2, %7 offset:%8" \
      : "+v"(N_), "=&v"(RA_), "=&v"(RB_) : "v"(kf), "v"(qf[qi]), "v"(sc1), "v"(ka0), "v"(ka1), "i"(OFF) : "memory"); } else { asm volatile(MF_ "%0, %3, %4, %0, %5, %5 op_sel_hi:[0,0,0]\n\tds_read_b128 %1, %6 offset:%8\n\tds_read_b128 %2, %7 offset:%8" \
      : "+v"(N_), "=&v"(RA_), "=&v"(RB_) : "v"(kf), "v"(qf[qi]), "v"(sc1), "v"(ka0), "v"(ka1), "i"(OFF) : "memory"); } } SCHED; } while (0)
#define VO(b, d0) (VOFF + (b) * SV8 + (d0) * 2048)
#define KO(b, i) ((b) * 8192 + ((i) & 1) * 4096 + ((i) >> 1) * 2048)
#define M1(P0, P1) do { if (VAR != 1) mo = max32a(P0, P1); } while (0)
#define M2(SCN) do { if (VAR == 1) { asm volatile("" : "=v"(SCN)); ls0 = 0.f; e0 = 0.f; break; } auto sA = __builtin_amdgcn_permlane32_swap(__float_as_uint(mo), __float_as_uint(mo), false, false); \
    e0 = fminf(fmaxf(ceilf(max2a(__uint_as_float(sA[0]), __uint_as_float(sA[1]))), -120.f), 120.f); SCN = 127 + (int)e0; if (FAST) scf = __int_as_float(SCN << 23); ls0 = 0.f; } while (0)
#define PEL(P0, P1, u, k) (((u) >> 1) & 1 ? P1 : P0)[4 * ((u) >> 2) + 2 * ((u) & 1) + (k)]
#define U(P0, P1, u) do { if (VAR == 1) break; \
    const float xa = __builtin_amdgcn_exp2f(FAST ? PEL(P0, P1, u, 0) : PEL(P0, P1, u, 0) - e0), xb = __builtin_amdgcn_exp2f(FAST ? PEL(P0, P1, u, 1) : PEL(P0, P1, u, 1) - e0); \
    ls0 += xa; ls0 += xb; \
    int wo_; if (((u) & 1) == 0) asm volatile("" : "=v"(wo_)); else wo_ = (((u) >> 1) & 1) ? wy : wx; \
    if (FAST) wo_ = __builtin_bit_cast(int, __builtin_amdgcn_cvt_scalef32_pk_fp8_f32(__builtin_bit_cast(v2s_, wo_), xa, xb, scf, ((u) & 1) != 0)); \
    else wo_ = __builtin_amdgcn_cvt_pk_fp8_f32(xa, xb, wo_, ((u) & 1) != 0); \
    if (((u) >> 1) & 1) wy = wo_; else wx = wo_; } while (0)
#define SW(PN, q) do { if (VAR == 1) { if ((q) == 3) asm volatile("" : "=v"(PN)); break; } auto rr = __builtin_amdgcn_permlane32_swap((unsigned)wx, (unsigned)wy, false, false); PN[q] = (int)rr[0]; PN[4 + (q)] = (int)rr[1]; } while (0)
#define HOLD(A_, B_) asm volatile("" :: "v"(A_), "v"(B_))
#define ITER_E(b, t, P0, P1, N0, N1, PA, PN, SCA, SCN) do { \
    if (VAR != 3) { if ((t) + 2 < NT) KDMA(b, (t) + 2); VDMA(b, t); } \
    VFR(va, vb, (b) ^ 1, 0); VFR(vc, vd, (b) ^ 1, 1); \
    asm volatile("s_nop 1" : "+v"(P0), "+v"(P1));     \
    SCHED; M1(P0, P1); SCHED; \
    if (NCB == 8) { \
    LGK(2); PVR(va, vb, 0, PA, SCA, ve, vf, VO((b) ^ 1, 2)); M2(SCN); HOLD(va, vb); \
    LGK(2); PVR(vc, vd, 1, PA, SCA, va, vb, VO((b) ^ 1, 3)); U(P0, P1, 0); U(P0, P1, 1); HOLD(vc, vd); \
    LGK(2); PVR(ve, vf, 2, PA, SCA, vc, vd, VO((b) ^ 1, 4)); U(P0, P1, 2); U(P0, P1, 3); SW(PN, 0); HOLD(ve, vf); \
    LGK(2); PVR(va, vb, 3, PA, SCA, ve, vf, VO((b) ^ 1, 5)); U(P0, P1, 4); HOLD(va, vb); \
    LGK(2); PVR(vc, vd, 4, PA, SCA, va, vb, VO((b) ^ 1, 6)); U(P0, P1, 5); U(P0, P1, 6); HOLD(vc, vd); \
    LGK(2); PVR(ve, vf, 5, PA, SCA, vc, vd, VO((b) ^ 1, 7)); U(P0, P1, 7); SW(PN, 1); HOLD(ve, vf); \
    LGK(2); PVR(va, vb, 6, PA, SCA, ve, vf, KO((b) ^ 1, 0)); U(P0, P1, 8); U(P0, P1, 9); HOLD(va, vb); \
    LGK(2); PVR(vc, vd, NCB - 1, PA, SCA, va, vb, KO((b) ^ 1, 1)); U(P0, P1, 10); HOLD(vc, vd); \
    LGK(2); QKZR(ve, vf, N0, 0, vc, vd, KO((b) ^ 1, 2)); U(P0, P1, 11); SW(PN, 2); U(P0, P1, 12); HOLD(ve, vf); \
    LGK(2); QKAR(va, vb, N0, 1, ve, vf, KO((b) ^ 1, 3)); U(P0, P1, 13); HOLD(va, vb); \
    LGK(2); QKZ0(vc, vd, N1, 0); U(P0, P1, 14); HOLD(vc, vd); \
    LGK(0); QKA0(ve, vf, N1, 1); U(P0, P1, 15); SW(PN, 3); HOLD(ve, vf); \
    } else { \
    LGK(2); PVR(va, vb, 0, PA, SCA, ve, vf, VO((b) ^ 1, 2)); M2(SCN); HOLD(va, vb); \
    LGK(2); PVR(vc, vd, 1, PA, SCA, va, vb, VO((b) ^ 1, 3)); U(P0, P1, 0); U(P0, P1, 1); HOLD(vc, vd); \
    LGK(2); PVR(ve, vf, 2, PA, SCA, vc, vd, KO((b) ^ 1, 0)); U(P0, P1, 2); U(P0, P1, 3); SW(PN, 0); U(P0, P1, 4); HOLD(ve, vf); \
    LGK(2); PVR(va, vb, 3, PA, SCA, ve, vf, KO((b) ^ 1, 1)); U(P0, P1, 5); U(P0, P1, 6); U(P0, P1, 7); SW(PN, 1); HOLD(va, vb); \
    LGK(2); QKZR(vc, vd, N0, 0, va, vb, KO((b) ^ 1, 2)); U(P0, P1, 8); U(P0, P1, 9); U(P0, P1, 10); HOLD(vc, vd); \
    LGK(2); QKAR(ve, vf, N0, 1, vc, vd, KO((b) ^ 1, 3)); U(P0, P1, 11); SW(PN, 2); U(P0, P1, 12); U(P0, P1, 13); HOLD(ve, vf); \
    LGK(2); QKZ0(va, vb, N1, 0); U(P0, P1, 14); HOLD(va, vb); \
    LGK(0); QKA0(vc, vd, N1, 1); U(P0, P1, 15); SW(PN, 3); HOLD(vc, vd); \
    } \
    asm volatile("" : "+v"(ls0));     \
    if (FAST) l_reg += ls0; else l_reg += __builtin_amdgcn_exp2f(e0) * ls0; \
    if (VAR != 3) { VM0(); __syncthreads(); } } while (0)
  f32x16 p0, p1, n0, n1; v8i_ pa8 = {}, pb8; int scaA = 127, scaB; v4i va, vb, vc, vd, ve, vf;
  float mo, e0, ls0, scf = 1.f; int wx = 0, wy = 0;
  KDMA(0, 0); if (NT > 1) KDMA(1, 1); VDMA(1, 0); VM0(); __syncthreads();
  KFR(va, vb, 0, 0); KFR(vc, vd, 0, 1); KFR(ve, vf, 0, 2);
  LGK(4); QKZ(va, vb, p0, 0); KFR(va, vb, 0, 3);
  LGK(4); QKA(vc, vd, p0, 1);
  LGK(2); QKZ(ve, vf, p1, 0);
  LGK(0); QKA(va, vb, p1, 1);
  asm volatile("s_nop 4" : "+v"(pa8), "+v"(scaA));
  __syncthreads();
  for (int j = 0; j < NT; j += 2) {
    ITER_E(0, j, p0, p1, n0, n1, pa8, pb8, scaA, scaB);
    ITER_E(1, j + 1, n0, n1, p0, p1, pb8, pa8, scaB, scaA);
  }
  VFR(va, vb, 1, 0); VFR(vc, vd, 1, 1);
  asm volatile("s_nop 4" : "+v"(pa8), "+v"(scaA));
  if (NCB == 8) {
    LGK(2); PVM(va, vb, 0, pa8, scaA); VFR(ve, vf, 1, 2);
    LGK(2); PVM(vc, vd, 1, pa8, scaA); VFR(va, vb, 1, 3);
    LGK(2); PVM(ve, vf, 2, pa8, scaA); VFR(vc, vd, 1, 4);
    LGK(2); PVM(va, vb, 3, pa8, scaA); VFR(ve, vf, 1, 5);
    LGK(2); PVM(vc, vd, 4, pa8, scaA); VFR(va, vb, 1, 6);
    LGK(2); PVM(ve, vf, 5, pa8, scaA); VFR(vc, vd, 1, 7);
    LGK(2); PVM(va, vb, 6, pa8, scaA);
    LGK(0); PVM(vc, vd, NCB - 1, pa8, scaA);
  } else {
    LGK(2); PVM(va, vb, 0, pa8, scaA); VFR(ve, vf, 1, 2);
    LGK(2); PVM(vc, vd, 1, pa8, scaA); VFR(va, vb, 1, 3);
    LGK(2); PVM(ve, vf, 2, pa8, scaA);
    LGK(0); PVM(va, vb, 3, pa8, scaA);
  }
  asm volatile("s_nop 15\n\ts_nop 7" ::: "memory");
#pragma unroll
  for (int d0 = 0; d0 < NCB; ++d0) asm volatile("" : "+v"(o[d0]));
  { auto rr = __builtin_amdgcn_permlane32_swap(__float_as_uint(l_reg), __float_as_uint(l_reg), false, false); l_reg = __uint_as_float(rr[0]) + __uint_as_float(rr[1]); }
  if (hi == 0) li_l[r32] = l_reg; asm volatile("s_waitcnt lgkmcnt(0)" ::: "memory");
  bf16_t* Ow = Ob + (long)(wid * QBLK) * ldo;
  if (EM == 2) {
    float sgv[NCB];
#pragma unroll
    for (int d0 = 0; d0 < NCB; ++d0) sgv[d0] = de.sg[d0 * 32 + r32];
#pragma unroll
    for (int r = 0; r < 16; ++r) { const int orow = crow(r, hi); const float rl = __builtin_amdgcn_rcpf(li_l[orow]);
      float dv[NCB], ssq = 0.f;
#pragma unroll
      for (int d0 = 0; d0 < NCB; ++d0) { const float o0 = bf2f(de.O0[(long)(wid * QBLK + orow) * ldo + d0 * 32 + r32]); dv[d0] = o0 - de.lam * (o[d0][r] * rl); ssq += dv[d0] * dv[d0]; }
      ssq += __shfl_xor(ssq, 1); ssq += __shfl_xor(ssq, 2); ssq += __shfl_xor(ssq, 4); ssq += __shfl_xor(ssq, 8); ssq += __shfl_xor(ssq, 16);
      const float rstd = rsqrtf(ssq * (1.f / 256) + EPS) * (1.f - LAM_INIT);
#pragma unroll
      for (int d0 = 0; d0 < NCB; ++d0) { const float y = dv[d0] * rstd * sgv[d0];
        if (DENSE8_G2) de.X2[(long)(wid * QBLK + orow) * D + d0 * 32 + r32] = (unsigned char)__builtin_amdgcn_cvt_pk_fp8_f32(clamp8(y * 8.f), 0.f, 0, false);
        else ((bf16_t*)de.X2)[(long)(wid * QBLK + orow) * D + d0 * 32 + r32] = f2bf(y); } }
  } else {
#pragma unroll
  for (int r = 0; r < 16; ++r) { const int orow = crow(r, hi); const float rl = __builtin_amdgcn_rcpf(li_l[orow]);
#pragma unroll
    for (int d0 = 0; d0 < NCB; ++d0) {
      if (EM == 1) ((unsigned char*)Ob)[(long)(wid * QBLK + orow) * ldo + d0 * 32 + r32] = (unsigned char)__builtin_amdgcn_cvt_pk_fp8_f32(clamp8(o[d0][r] * rl * 8.f), 0.f, 0, false);
      else Ow[(long)orow * ldo + d0 * 32 + r32] = f2bf(o[d0][r] * rl); } }
  }
  VM0();
  __syncthreads();
#undef VM0
#undef KDMA
#undef VDMA
#undef RD128
#undef V8
#undef VFR
#undef KFR
#undef PVM
#undef QKZ
#undef QKA
#undef QKZ0
#undef QKA0
#undef PVR
#undef QKZR
#undef QKAR
#undef VO
#undef KO
#undef MF_
#undef M1
#undef M2
#undef U
#undef PEL
#undef SW
#undef ITER_E
#undef HOLD
}
template <int NCB, int VAR = 0, int EM = 0>
__device__ __forceinline__ void attn_body_e(const bf16_t* __restrict__ Qb, const int ldq, const unsigned char* __restrict__ K8, const int ldk8,
                                            const unsigned char* __restrict__ V8T, bf16_t* __restrict__ Ob, const int ldo, const int seq, const float kmax2, LAS char* lds, const DiffEpi de = DiffEpi{}) {
  int tid = threadIdx.x; asm volatile("" : "+v"(tid)); tid &= 511;
  v8i_ qf[2];
  const float nmc = load_q8(Qb + (long)((tid >> 6) * QBLK + (tid & 31)) * ldq, (tid & 63) >> 5, qf, kmax2);
  if (__all(nmc > -100.f)) attn_body_e_t<NCB, VAR, true, EM>(qf, K8, ldk8, V8T, Ob, ldo, seq, lds, de);
  else attn_body_e_t<NCB, VAR, false, EM>(qf, K8, ldk8, V8T, Ob, ldo, seq, lds, de);
}
#undef PK4
}

__device__ __forceinline__ int perm_plain8(int n) { const int r = n & 31; return (n & ~31) + 16 * ((r >> 2) & 1) + 4 * (r >> 3) + (r & 3); }
__device__ __forceinline__ int perm_row(int kind, int n) {
  if (kind == 0) return perm_plain8(n);
  if (kind == 1) { if (n < N_QKV0) return perm_plain8(n); const int c = n - N_QKV0; const int ch = c & 1023; return N_QKV0 + 32 * (ch >> 4) + ((c >> 10) << 4) + (ch & 15); }
  return 32 * (n >> 4) + ((kind == 3) ? 16 : 0) + (n & 15);
}
__device__ __forceinline__ void cvt_tile(const float* __restrict__ src, int N, bf16_t* __restrict__ dst, int K, int kind, int k0, int n0, LAS unsigned* t32) {
  int tid = threadIdx.x; asm volatile("" : "+v"(tid)); tid &= 511;
#pragma unroll
  for (int j = 0; j < 2; ++j) {
    const int item = tid + 512 * j, kp = item >> 4, q = item & 15;
    const f32x4 v0 = *(const f32x4*)(src + (size_t)(k0 + 2 * kp) * N + n0 + 4 * q);
    const f32x4 v1 = *(const f32x4*)(src + (size_t)(k0 + 2 * kp + 1) * N + n0 + 4 * q);
#pragma unroll
    for (int i = 0; i < 4; ++i) t32[(4 * q + i) * 65 + kp] = cvtpk(v0[i], v1[i]);
  }
  __syncthreads();
#pragma unroll
  for (int j = 0; j < 2; ++j) {
    const int item = tid + 512 * j, n = item >> 4, ko = item & 15;
    u32x4 v;
#pragma unroll
    for (int i = 0; i < 4; ++i) v[i] = t32[n * 65 + 4 * ko + i];
    *(u32x4*)(dst + (size_t)perm_row(kind, n0 + n) * K + k0 + 8 * ko) = v;
  }
  __syncthreads();
}
__device__ __forceinline__ void cvt_matrix_units(const float* src, int K, int N, bf16_t* dst, int kind, int u0, int ustride, LAS unsigned* t32) {
  const int nN = N / 64, nK = K / 128;
  for (int u = u0; u < nN * nK; u += ustride) cvt_tile(src, N, dst, K, kind, (u / nN) * 128, (u % nN) * 64, t32);
}
constexpr size_t WMOE8_E = (size_t)1024 * D + (size_t)D * EFF;
__device__ __forceinline__ void cvt_tile8(const float* __restrict__ src, int N, unsigned char* __restrict__ dst, int K, int kind, int k0, int n0, float scale, LAS unsigned* t32) {
  int tid = threadIdx.x; asm volatile("" : "+v"(tid)); tid &= 511;
  { const int kq = tid >> 4, q = tid & 15;
    f32x4 v[4];
#pragma unroll
    for (int r = 0; r < 4; ++r) v[r] = *(const f32x4*)(src + (size_t)(k0 + 4 * kq + r) * N + n0 + 4 * q);
#pragma unroll
    for (int i = 0; i < 4; ++i) t32[(4 * q + i) * 33 + kq] = pack_fp8x4(v[0][i] * scale, v[1][i] * scale, v[2][i] * scale, v[3][i] * scale); }
  __syncthreads();
  { const int n = tid >> 3, kc = tid & 7;
    u32x4 v;
#pragma unroll
    for (int i = 0; i < 4; ++i) v[i] = t32[n * 33 + 4 * kc + i];
    *(u32x4*)(dst + (size_t)perm_row(kind, n0 + n) * K + k0 + 16 * kc) = v; }
  __syncthreads();
}
__device__ __forceinline__ void cvt_matrix_units8(const float* src, int K, int N, unsigned char* dst, int kind, float scale, LAS unsigned* t32) {
  const int nN = N / 64, nK = K / 128;
  for (int u = blockIdx.x; u < nN * nK; u += gridDim.x) cvt_tile8(src, N, dst, K, kind, (u / nN) * 128, (u % nN) * 64, scale, t32);
}
__device__ __forceinline__ void cvt_tile8w(const float* __restrict__ src, int N, unsigned char* __restrict__ dst, int K, int kind, int k0, int n0, float scale, LAS unsigned* t32) {
  int tid = threadIdx.x; asm volatile("" : "+v"(tid)); tid &= 511;
  { const int kq = tid >> 6, q = tid & 63;
    f32x4 v[16];
#pragma unroll
    for (int r = 0; r < 16; ++r) v[r] = *(const f32x4*)(src + (size_t)(k0 + 16 * kq + r) * N + n0 + 4 * q);
#pragma unroll
    for (int i = 0; i < 4; ++i)
#pragma unroll
      for (int h = 0; h < 4; ++h) t32[(4 * q + i) * 33 + 4 * kq + h] = pack_fp8x4(v[4 * h][i] * scale, v[4 * h + 1][i] * scale, v[4 * h + 2][i] * scale, v[4 * h + 3][i] * scale); }
  __syncthreads();
  { const int n = tid >> 1, kc = tid & 1;
    unsigned char* dp = dst + (size_t)perm_row(kind, n0 + n) * K + k0 + 64 * kc;
#pragma unroll
    for (int c = 0; c < 4; ++c) { u32x4 o;
#pragma unroll
      for (int i = 0; i < 4; ++i) o[i] = t32[n * 33 + 16 * kc + 4 * c + i];
      *(u32x4*)(dp + 16 * c) = o; } }
  __syncthreads();
}
__device__ __forceinline__ void cvt_moe_all8(const Args& a, LAS unsigned* t32) {
  unsigned char* W = (unsigned char*)(a.ws + WS_WMOE);
  for (int u = blockIdx.x; u < 2 * 65 * 96; u += gridDim.x) {
    const int le = u / 96, L = le / 65, e = le % 65, r = u % 96, mtx = r >> 5, lu = r & 31;
    const float* src; unsigned char* dst = W + (size_t)le * WMOE8_E; int K, N, kind; float sc;
    if (mtx == 0)      { src = e < 64 ? a.in[21] + ((size_t)L * 64 + e) * D * EFF : a.in[24] + (size_t)L * D * EFF; K = D; N = EFF; kind = 2; sc = 256.f; }
    else if (mtx == 1) { src = e < 64 ? a.in[22] + ((size_t)L * 64 + e) * D * EFF : a.in[25] + (size_t)L * D * EFF; K = D; N = EFF; kind = 3; sc = 256.f; }
    else               { src = e < 64 ? a.in[23] + ((size_t)L * 64 + e) * EFF * D : a.in[26] + (size_t)L * EFF * D; K = EFF; N = D; kind = 0; sc = 128.f; dst += (size_t)1024 * D; }
    const int nN = N / 256;
    cvt_tile8w(src, N, dst, K, kind, (lu / nN) * 128, (lu % nN) * 256, sc, t32);
  }
}

__device__ __forceinline__ void ld_row_f32(const float* __restrict__ p, int lane, float (&v)[32]) {
#pragma unroll
  for (int j = 0; j < 4; ++j) { const f32x4 t0 = *(const f32x4*)(p + 8 * lane + 512 * j), t1 = *(const f32x4*)(p + 8 * lane + 512 * j + 4);
#pragma unroll
    for (int i = 0; i < 4; ++i) { v[8 * j + i] = t0[i]; v[8 * j + 4 + i] = t1[i]; } }
}
__device__ __forceinline__ void ld_row_bf16(const bf16_t* __restrict__ p, int lane, float (&v)[32]) {
#pragma unroll
  for (int j = 0; j < 4; ++j) { const u32x4 t = *(const u32x4*)(p + 8 * lane + 512 * j);
#pragma unroll
    for (int i = 0; i < 4; ++i) { v[8 * j + 2 * i] = bflo(t[i]); v[8 * j + 2 * i + 1] = bfhi(t[i]); } }
}
__device__ __forceinline__ void ld_row_fp8(const unsigned char* __restrict__ p, int lane, float (&v)[32]) {
#pragma unroll
  for (int j = 0; j < 4; ++j) { const u32x2 t = *(const u32x2*)(p + 8 * lane + 512 * j);
#pragma unroll
    for (int i = 0; i < 2; ++i) { v[8 * j + 4 * i] = __builtin_amdgcn_cvt_f32_fp8((int)t[i], 0); v[8 * j + 4 * i + 1] = __builtin_amdgcn_cvt_f32_fp8((int)t[i], 1);
      v[8 * j + 4 * i + 2] = __builtin_amdgcn_cvt_f32_fp8((int)t[i], 2); v[8 * j + 4 * i + 3] = __builtin_amdgcn_cvt_f32_fp8((int)t[i], 3); } }
}
__device__ __forceinline__ void ld8f(const float* __restrict__ p, float (&x)[8]) { const f32x4 t0 = *(const f32x4*)p, t1 = *(const f32x4*)(p + 4);
#pragma unroll
  for (int i = 0; i < 4; ++i) { x[i] = t0[i]; x[4 + i] = t1[i]; } }
__device__ __forceinline__ void st8f(float* __restrict__ p, const float* x) { f32x4 t0 = {x[0], x[1], x[2], x[3]}, t1 = {x[4], x[5], x[6], x[7]}; *(f32x4*)p = t0; *(f32x4*)(p + 4) = t1; }
__device__ __forceinline__ void st8h(bf16_t* __restrict__ p, const float* x) { u32x4 t = {cvtpk(x[0], x[1]), cvtpk(x[2], x[3]), cvtpk(x[4], x[5]), cvtpk(x[6], x[7])}; *(u32x4*)p = t; }
__device__ __forceinline__ float sumsq32(const float (&v)[32]) { float s = 0;
#pragma unroll
  for (int i = 0; i < 32; ++i) s += v[i] * v[i];
  return wave_sum(s); }
template <bool COPY, bool OUT8 = false>
__device__ __forceinline__ void modulate_store(const float (&v)[32], float rstd, const float* __restrict__ g, const float* __restrict__ shift, const float* __restrict__ scale,
                                               bf16_t* __restrict__ dst, int lane, LAS float* f32copy, int trow = 0) {
#pragma unroll
  for (int j = 0; j < 4; ++j) {
    const int idx = 8 * lane + 512 * j;
    float gv[8], sh[8], sc[8], y[8]; ld8f(g + idx, gv); ld8f(shift + idx, sh); ld8f(scale + idx, sc);
#pragma unroll
    for (int i = 0; i < 8; ++i) y[i] = v[8 * j + i] * rstd * gv[i] * (1.f + sc[i]) + sh[i];
    if (OUT8) { u32x2 p8 = {pack_fp8x4(y[0], y[1], y[2], y[3]), pack_fp8x4(y[4], y[5], y[6], y[7])}; *(u32x2*)((unsigned char*)dst + idx) = p8; }
    else { u32x4 pk = {cvtpk(y[0], y[1]), cvtpk(y[2], y[3]), cvtpk(y[4], y[5]), cvtpk(y[6], y[7])}; *(u32x4*)(dst + idx) = pk; }
    if (COPY) {
      const u32x4 hi = {cvtpk(y[0], y[1]), cvtpk(y[2], y[3]), cvtpk(y[4], y[5]), cvtpk(y[6], y[7])};
      const u32x4 lo = {cvtpk(y[0] - bflo(hi[0]), y[1] - bfhi(hi[0])), cvtpk(y[2] - bflo(hi[1]), y[3] - bfhi(hi[1])), cvtpk(y[4] - bflo(hi[2]), y[5] - bfhi(hi[2])), cvtpk(y[6] - bflo(hi[3]), y[7] - bfhi(hi[3]))};
      LAS char* rowp = (LAS char*)f32copy + trow * 4096 + ((((idx >> 3)) ^ (4 * (trow & 3) + (trow >> 2))) << 4);
      *(LAS u32x4*)rowp = hi; *(LAS u32x4*)(rowp + 32768) = lo; }
  }
}

__device__ __forceinline__ void phase_prologue(const Args& a, LAS char* lds) {
  int tid = threadIdx.x; asm volatile("" : "+v"(tid)); tid &= 511; const int wave = tid >> 6, lane = tid & 63;
  {
    LAS float* sc = (LAS float*)lds;
    LAS float* part = sc + 4096;
    const float* c = a.in[1]; const float* cc = a.in[3];
    for (int i = tid; i < D; i += NTHREADS) { float v = c[i]; sc[i] = v * sigmoidf_(v); float u = cc[i]; sc[D + i] = u * sigmoidf_(u); }
    __syncthreads();
    float* MOD = (float*)(a.ws + WS_MOD);
    for (int u = blockIdx.x; u < 2 * 192; u += gridDim.x) {
      const int L = u / 192, chunk = u % 192;
      const float* W = a.in[4] + (size_t)L * D * 12288 + chunk * 64 + lane;
      float a0 = 0, a1 = 0; const int d0 = wave * 256;
#pragma unroll 8
      for (int dd = 0; dd < 256; ++dd) { const float w = W[(size_t)(d0 + dd) * 12288]; a0 += sc[d0 + dd] * w; a1 += sc[D + d0 + dd] * w; }
      part[(wave * 2 + 0) * 64 + lane] = a0; part[(wave * 2 + 1) * 64 + lane] = a1;
      __syncthreads();
      if (tid < 128) { const int which = tid >> 6; float s = 0;
#pragma unroll
        for (int w = 0; w < 8; ++w) s += part[(w * 2 + which) * 64 + lane];
        const int j = chunk * 64 + lane; MOD[(size_t)(L * 2 + which) * 12288 + j] = s + a.in[5][L * 12288 + j]; }
      __syncthreads();
    }
  }
  { const float* Wr = a.in[19]; bf16_t* RTo = (bf16_t*)(a.ws + WS_RT);
    for (int it = blockIdx.x * NTHREADS + tid; it < 2 * 16384; it += gridDim.x * NTHREADS) {
      const int ln = it & 63, ks = (it >> 6) & 63, nt = (it >> 12) & 3, L = it >> 14;
      const float* wp = Wr + (size_t)L * D * NE + (size_t)(ks * 32 + 8 * (ln >> 4)) * NE + nt * 16 + (ln & 15);
      float w[8];
#pragma unroll
      for (int i = 0; i < 8; ++i) w[i] = wp[(size_t)i * NE];
      const u32x4 hi = {cvtpk(w[0], w[1]), cvtpk(w[2], w[3]), cvtpk(w[4], w[5]), cvtpk(w[6], w[7])};
      const u32x4 lo = {cvtpk(w[0] - bflo(hi[0]), w[1] - bfhi(hi[0])), cvtpk(w[2] - bflo(hi[1]), w[3] - bfhi(hi[1])), cvtpk(w[4] - bflo(hi[2]), w[5] - bfhi(hi[2])), cvtpk(w[6] - bflo(hi[3]), w[7] - bfhi(hi[3]))};
      *(u32x4*)(RTo + ((size_t)(L * 2) * 16384 + (it & 16383)) * 8) = hi; *(u32x4*)(RTo + ((size_t)(L * 2 + 1) * 16384 + (it & 16383)) * 8) = lo; }
  }
  LAS unsigned* t32 = (LAS unsigned*)lds;
#if DENSE8_G1
  cvt_matrix_units8(a.in[7], D, N_IN0, (unsigned char*)(a.ws + WS_WIN0), 1, 256.f, t32);
  cvt_matrix_units8(a.in[15], D, N_IN1, (unsigned char*)(a.ws + WS_WIN1), 0, 256.f, t32);
#else
  cvt_matrix_units(a.in[7], D, N_IN0, (bf16_t*)(a.ws + WS_WIN0), 1, blockIdx.x, gridDim.x, t32);
  cvt_matrix_units(a.in[15], D, N_IN1, (bf16_t*)(a.ws + WS_WIN1), 0, blockIdx.x, gridDim.x, t32);
#endif
#if DENSE8_G2
  cvt_matrix_units8(a.in[8], D, D, (unsigned char*)(a.ws + WS_WOUT0), 0, 256.f, t32);
  cvt_matrix_units8(a.in[16], D, D, (unsigned char*)(a.ws + WS_WOUT1), 0, 256.f, t32);
#else
  cvt_matrix_units(a.in[8], D, D, (bf16_t*)(a.ws + WS_WOUT0), 0, blockIdx.x, gridDim.x, t32);
  cvt_matrix_units(a.in[16], D, D, (bf16_t*)(a.ws + WS_WOUT1), 0, blockIdx.x, gridDim.x, t32);
#endif
  cvt_moe_all8(a, t32);
}

__device__ __forceinline__ void phase_modulate0(const Args& a) {
  int tid = threadIdx.x; asm volatile("" : "+v"(tid)); tid &= 511; const int wave = tid >> 6, lane = tid & 63;
  const float* MOD = (const float*)(a.ws + WS_MOD);
  bf16_t* A = (bf16_t*)(a.ws + WS_ABUF);
  for (int it = blockIdx.x; it < MT / 8; it += gridDim.x) {
    const int r = it * 8 + wave;
    const float* src = r < CTXL ? a.in[2] + (size_t)r * D : a.in[0] + (size_t)(r - CTXL) * D;
    const float* mod = MOD + (r < CTXL ? 12288 : 0);
    float v[32]; ld_row_f32(src, lane, v);
    const float rstd = rsqrtf(sumsq32(v) * (1.f / D) + EPS);
#if DENSE8_G1
    modulate_store<false, true>(v, rstd, a.in[6], mod, mod + D, (bf16_t*)((unsigned char*)A + (size_t)r * D), lane, nullptr);
#else
    modulate_store<false>(v, rstd, a.in[6], mod, mod + D, A + (size_t)r * D, lane, nullptr);
#endif
  }
}

__device__ __forceinline__ void rope_cs4(int r, int lane, float (&cs)[4], float (&sn)[4]) {
#pragma unroll
  for (int q = 0; q < 4; ++q) { cs[q] = 1.f; sn[q] = 0.f; }
  if (r >= CTXL) { const int t = r - CTXL; const int l = lane & 15, a = l >> 3, i0 = 4 * (l & 7);
    const float pos = a ? (float)(t & 63) : (float)(t >> 6);
#pragma unroll
    for (int q = 0; q < 4; ++q) { const float inv = powf(10000.f, -(float)(i0 + q) / 32.f); sincosf(pos * inv, &sn[q], &cs[q]); } }
}
__device__ __forceinline__ float sum16lanes(float v) { v += __shfl_xor(v, 1); v += __shfl_xor(v, 2); v += __shfl_xor(v, 4); v += __shfl_xor(v, 8); return v; }
__device__ __forceinline__ void phase_rope_conv0(const Args& a, LAS char* lds, bool dry = false) {
  int tid = threadIdx.x; asm volatile("" : "+v"(tid)); tid &= 511; const int wave = tid >> 6, lane = tid & 63;
  bf16_t* Q = (bf16_t*)(a.ws + WS_QKVU);
  {
    const bf16_t* HG = (const bf16_t*)(a.ws + WS_HG);
    bf16_t* X2 = (bf16_t*)(a.ws + WS_X2);
    LAS char* lt = lds;
    LAS float* part = (LAS float*)(lds + 62 * 2048);
    LAS float* stats = part + 512;
    const float* dw_w = a.in[11]; const float* dw_b = a.in[12]; const float* ln_g = a.in[13]; const float* ln_b = a.in[14];
    const __amdgpu_buffer_rsrc_t wrs = __builtin_amdgcn_make_buffer_rsrc((void*)dw_w, 0, 31 * 1024 * 4, 0x00020000);
    for (int u = blockIdx.x; u < 520; u += gridDim.x) {
      int seg0, seg1, r0;
      if (u < 8) { seg0 = 0; seg1 = CTXL; r0 = u * 32; } else { seg0 = CTXL; seg1 = MT; r0 = CTXL + (u - 8) * 32; }
      for (int c = tid; c < 62 * 128; c += NTHREADS) { const int rr = c >> 7, cc = c & 127, gr = r0 - 15 + rr;
        u32x4 v = {0u, 0u, 0u, 0u}; if (gr >= seg0 && gr < seg1) v = *(const u32x4*)(HG + (size_t)gr * 1024 + cc * 8);
        *(LAS u32x4*)(lt + rr * 2048 + cc * 16) = v; }
      __syncthreads();
      float w0[31], w1[31];
#pragma unroll
      for (int j = 0; j < 31; ++j) { const u32x2 w = __builtin_amdgcn_raw_buffer_load_b64(wrs, tid * 8, j * 4096, 0); w0[j] = __uint_as_float(w[0]); w1[j] = __uint_as_float(w[1]); }
      const f32x2 bb = *(const f32x2*)(dw_b + 2 * tid);
      const f32x2 gg = *(const f32x2*)(ln_g + 2 * tid), gb = *(const f32x2*)(ln_b + 2 * tid);
#pragma unroll 1
      for (int hf = 0; hf < 4; ++hf) {
        float o0[8], o1[8];
        LAS const char* lth = lt + (hf * 8) * 2048 + tid * 4;
#pragma unroll
        for (int r = 0; r < 8; ++r) { o0[r] = bb[0]; o1[r] = bb[1]; }
#pragma unroll
        for (int i = 0; i < 38; ++i) {
          const unsigned p = *(LAS const unsigned*)(lth + i * 2048);
          const float x0 = bflo(p), x1 = bfhi(p);
#pragma unroll
          for (int r = 0; r < 8; ++r) { const int j = i - r; if (j >= 0 && j < 31) { o0[r] += x0 * w0[j]; o1[r] += x1 * w1[j]; } }
        }
#pragma unroll
        for (int r = 0; r < 8; ++r) {
          const float s = wave_sum(o0[r] + o1[r]), q = wave_sum(o0[r] * o0[r] + o1[r] * o1[r]);
          if (lane == 0) { part[(r * 8 + wave) * 2] = s; part[(r * 8 + wave) * 2 + 1] = q; }
        }
        __syncthreads();
        if (tid < 8) { float s = 0, q = 0;
#pragma unroll
          for (int w = 0; w < 8; ++w) { s += part[(tid * 8 + w) * 2]; q += part[(tid * 8 + w) * 2 + 1]; }
          const float mean = s * (1.f / 1024), var = q * (1.f / 1024) - mean * mean;
          stats[tid * 2] = mean; stats[tid * 2 + 1] = rsqrtf(fmaxf(var, 0.f) + EPS); }
        __syncthreads();
#pragma unroll
        for (int r = 0; r < 8; ++r) {
          const float mean = stats[r * 2], rstd = stats[r * 2 + 1];
          float y0 = (o0[r] - mean) * rstd * gg[0] + gb[0], y1 = (o1[r] - mean) * rstd * gg[1] + gb[1];
          y0 = y0 * sigmoid_fast(y0); y1 = y1 * sigmoid_fast(y1);
#if DENSE8_G2
          *(unsigned short*)((unsigned char*)X2 + (size_t)(r0 + hf * 8 + r) * D + 1024 + 2 * tid) = (unsigned short)__builtin_amdgcn_cvt_pk_fp8_f32(y0 * 8.f, y1 * 8.f, 0, false);
#else
          *(unsigned*)(X2 + (size_t)(r0 + hf * 8 + r) * D + 1024 + 2 * tid) = cvtpk(y0, y1);
#endif
        }
      }
      __syncthreads();
    }
  }
  const float* qn = a.in[9]; const float* kn = a.in[10];
  unsigned* kmx = (unsigned*)(a.ws + WS_CTL + CTL_KMAX);
  const int slot = lane >> 4, l16 = lane & 15, e1 = (l16 >> 3) * 64 + 4 * (l16 & 7), e2 = e1 + 32;
  float km0 = 0.f, km1 = 0.f;
  for (int it = blockIdx.x; it < MT / 8; it += gridDim.x) {
    const int r = it * 8 + wave;
    float cs[4], sn[4]; rope_cs4(r, lane, cs, sn);
    bf16_t* rowp = Q + (size_t)r * N_QKV0;
#pragma unroll
    for (int hb = 0; hb < 12; hb += 4) {
      const int hh = hb + slot;
      if (hh < 10) {
        const float* g = hh < 8 ? qn : kn;
        const u32x2 a1 = *(const u32x2*)(rowp + hh * 128 + e1), a2 = *(const u32x2*)(rowp + hh * 128 + e2);
        float x1[4] = {bflo(a1[0]), bfhi(a1[0]), bflo(a1[1]), bfhi(a1[1])}, x2[4] = {bflo(a2[0]), bfhi(a2[0]), bflo(a2[1]), bfhi(a2[1])};
        float ss = 0;
#pragma unroll
        for (int q = 0; q < 4; ++q) ss += x1[q] * x1[q] + x2[q] * x2[q];
        ss = sum16lanes(ss);
        const float rstd = rsqrtf(ss * (1.f / 128) + EPS);
        const f32x4 g1 = *(const f32x4*)(g + e1), g2 = *(const f32x4*)(g + e2);
        float o1[4], o2[4], so = 0;
#pragma unroll
        for (int q = 0; q < 4; ++q) { const float y1 = x1[q] * rstd * g1[q], y2 = x2[q] * rstd * g2[q]; o1[q] = y1 * cs[q] - y2 * sn[q]; o2[q] = y2 * cs[q] + y1 * sn[q]; }
        const u32x2 w1 = {cvtpk(o1[0], o1[1]), cvtpk(o1[2], o1[3])}, w2 = {cvtpk(o2[0], o2[1]), cvtpk(o2[2], o2[3])};
        if (!dry) { *(u32x2*)(rowp + hh * 128 + e1) = w1; *(u32x2*)(rowp + hh * 128 + e2) = w2; }
        if (hb == 8) {
          const unsigned q1 = pack8x4(o1[0], o1[1], o1[2], o1[3]), q2 = pack8x4(o2[0], o2[1], o2[2], o2[3]);
          unsigned char* k8p = (unsigned char*)(a.ws + WS_K8) + (size_t)r * 256 + (hh - 8) * 128;
          *(unsigned*)(k8p + e1) = q1; *(unsigned*)(k8p + e2) = q2;
          so = sum16lanes(sq8x4(q1) + sq8x4(q2)); if (slot == 0) km0 = fmaxf(km0, so); else km1 = fmaxf(km1, so);
        }
      }
    }
  }
  if (l16 == 0 && slot < 2) atomicMax(&kmx[slot], __float_as_uint(slot == 0 ? km0 : km1));
  __syncthreads();
  { unsigned char* V8T = (unsigned char*)(a.ws + WS_K8) + V8T0_OFF;
    LAS unsigned char* img = (LAS unsigned char*)lds;
    const int k = tid >> 3, cc = tid & 7, kb = k >> 5, kk = k & 31;
    const int j = (kk & 3) | (((kk >> 3) & 3) << 2) | (((kk >> 2) & 1) << 4);
    for (int u = blockIdx.x; u < 2 * (MT / 64); u += gridDim.x) {
      const int h = u / (MT / 64), t = u % (MT / 64);
      const bf16_t* vp = Q + (size_t)(t * 64 + k) * N_QKV0 + 1280 + h * 128 + cc * 16;
#pragma unroll
      for (int q = 0; q < 2; ++q) { const u32x4 raw = *(const u32x4*)(vp + 8 * q);
#pragma unroll
        for (int i = 0; i < 4; ++i) { const int p = __builtin_amdgcn_cvt_pk_fp8_f32(bflo(raw[i]), bfhi(raw[i]), 0, false);
#pragma unroll
          for (int hh = 0; hh < 2; ++hh) { const int col = cc * 16 + q * 8 + 2 * i + hh;
            img[col * 64 + (((2 * kb + (j >> 4)) ^ ((col >> 2) & 3)) << 4) + (j & 15)] = (unsigned char)(p >> (8 * hh)); } } }
      __syncthreads();
      *(u32x4*)(V8T + ((size_t)h * (MT / 64) + t) * 8192 + tid * 16) = *(LAS const u32x4*)(img + tid * 16);
      __syncthreads();
    }
  }
}
__device__ __forceinline__ void phase_rope1(const Args& a, LAS char* lds, bool dry = false) {
  int tid = threadIdx.x; asm volatile("" : "+v"(tid)); tid &= 511; const int wave = tid >> 6, lane = tid & 63;
  bf16_t* Q = (bf16_t*)(a.ws + WS_QKVU);
  unsigned* kmx = (unsigned*)(a.ws + WS_CTL + CTL_KMAX) + 16;
  unsigned char* K8 = (unsigned char*)(a.ws + WS_K8);
  LAS unsigned* lk = (LAS unsigned*)lds;
  if (tid < 16) lk[tid] = 0u;
  __syncthreads();
  const int slot = lane >> 4, l16 = lane & 15, e1 = (l16 >> 3) * 64 + 4 * (l16 & 7), e2 = e1 + 32;
  for (int it = blockIdx.x; it < MT / 8; it += gridDim.x) {
    const int r = it * 8 + wave;
    float cs[4], sn[4]; rope_cs4(r, lane, cs, sn);
    bf16_t* rowp = Q + (size_t)r * N_IN1;
#pragma unroll 2
    for (int hb = (r < CTXL ? 16 : 0); hb < 32; hb += 4) {
      const int hh = hb + slot;
      const u32x2 a1 = *(const u32x2*)(rowp + hh * 128 + e1), a2 = *(const u32x2*)(rowp + hh * 128 + e2);
      const float x1[4] = {bflo(a1[0]), bfhi(a1[0]), bflo(a1[1]), bfhi(a1[1])}, x2[4] = {bflo(a2[0]), bfhi(a2[0]), bflo(a2[1]), bfhi(a2[1])};
      float o1[4], o2[4];
#pragma unroll
      for (int q = 0; q < 4; ++q) { o1[q] = x1[q] * cs[q] - x2[q] * sn[q]; o2[q] = x2[q] * cs[q] + x1[q] * sn[q]; }
      const u32x2 w1 = {cvtpk(o1[0], o1[1]), cvtpk(o1[2], o1[3])}, w2 = {cvtpk(o2[0], o2[1]), cvtpk(o2[2], o2[3])};
      if (r >= CTXL && !dry) { *(u32x2*)(rowp + hh * 128 + e1) = w1; *(u32x2*)(rowp + hh * 128 + e2) = w2; }
      if (hb >= 16) {
        const unsigned q1 = pack8x4(o1[0], o1[1], o1[2], o1[3]), q2 = pack8x4(o2[0], o2[1], o2[2], o2[3]);
        unsigned char* k8p = K8 + (size_t)r * 2048 + (hh - 16) * 128;
        *(unsigned*)(k8p + e1) = q1; *(unsigned*)(k8p + e2) = q2;
        float so = sum16lanes(sq8x4(q1) + sq8x4(q2));
        if (l16 == 0) atomicMax((unsigned*)&lk[hh - 16], __float_as_uint(so));
      }
    }
  }
  __syncthreads();
  if (tid < 16) atomicMax(&kmx[tid], lk[tid]);
  __syncthreads();
  { unsigned char* V8T = (unsigned char*)(a.ws + WS_HG);
    LAS unsigned char* img = (LAS unsigned char*)lds;
    const int k = tid >> 3, cc = tid & 7, kb = k >> 5, kk = k & 31;
    const int j = (kk & 3) | (((kk >> 3) & 3) << 2) | (((kk >> 2) & 1) << 4);
    for (int u = blockIdx.x; u < 8 * (MT / 64); u += gridDim.x) {
      const int h = u / (MT / 64), t = u % (MT / 64);
      const bf16_t* vp = Q + (size_t)(t * 64 + k) * N_IN1 + 4096 + h * 256 + cc * 32;
#pragma unroll
      for (int q = 0; q < 4; ++q) { const u32x4 raw = *(const u32x4*)(vp + 8 * q);
#pragma unroll
        for (int i = 0; i < 4; ++i) { const int p = __builtin_amdgcn_cvt_pk_fp8_f32(bflo(raw[i]), bfhi(raw[i]), 0, false);
#pragma unroll
          for (int hh = 0; hh < 2; ++hh) { const int col = cc * 32 + q * 8 + 2 * i + hh;
            img[col * 64 + (((2 * kb + (j >> 4)) ^ ((col >> 2) & 3)) << 4) + (j & 15)] = (unsigned char)(p >> (8 * hh)); } } }
      __syncthreads();
      unsigned char* dst = V8T + ((size_t)h * (MT / 64) + t) * 16384;
      *(u32x4*)(dst + tid * 16) = *(LAS const u32x4*)(img + tid * 16);
      *(u32x4*)(dst + 8192 + tid * 16) = *(LAS const u32x4*)(img + 8192 + tid * 16);
      __syncthreads();
    }
  }
}

#ifndef ATT_VAR
#define ATT_VAR 0
#endif
template <int VAR = 0>
__device__ __forceinline__ void phase_attn(const Args& a, int L, LAS char* lds) {
  const bf16_t* Q = (const bf16_t*)(a.ws + WS_QKVU);
  const unsigned* kmx = (const unsigned*)(a.ws + WS_CTL + CTL_KMAX) + L * 16;
  if (L == 0) {
    bf16_t* X2 = (bf16_t*)(a.ws + WS_X2);
    for (int u = blockIdx.x; u < 520; u += gridDim.x) {
      const int head = u < 512 ? (u & 7) : (u - 512);
      const float kmax2 = __uint_as_float(kmx[head >> 2]);
      if (u < 512) { const int qb = u >> 3; const size_t q0 = (size_t)(CTXL + qb * 256);
        at::attn_body_e<4, VAR, (DENSE8_G2 ? 1 : 0)>(Q + q0 * N_QKV0 + head * 128, N_QKV0, (const unsigned char*)(a.ws + WS_K8) + (head >> 2) * 128, 256,
                           (const unsigned char*)(a.ws + WS_K8) + V8T0_OFF + (size_t)(head >> 2) * (MT / 64) * 8192, (DENSE8_G2 ? (bf16_t*)((unsigned char*)X2 + q0 * D + head * 128) : X2 + q0 * D + head * 128), D, MT, kmax2, lds);
      } else {
        at::attn_body_e<4, 0, (DENSE8_G2 ? 1 : 0)>(Q + head * 128, N_QKV0, (const unsigned char*)(a.ws + WS_K8) + (head >> 2) * 128, 256,
                           (const unsigned char*)(a.ws + WS_K8) + V8T0_OFF + (size_t)(head >> 2) * (MT / 64) * 8192, (DENSE8_G2 ? (bf16_t*)((unsigned char*)X2 + head * 128) : X2 + head * 128), D, CTXL, kmax2, lds); }
    }
  } else {
    bf16_t* O = (bf16_t*)(a.ws + WS_Y);
    int tid = threadIdx.x; asm volatile("" : "+v"(tid)); tid &= 511; const int lane = tid & 63;
    const float* lp = a.in[17];
    const float s1 = wave_sum(lp[lane] * lp[128 + lane] + lp[64 + lane] * lp[192 + lane]);
    const float s2 = wave_sum(lp[256 + lane] * lp[384 + lane] + lp[320 + lane] * lp[448 + lane]);
    const float lam = expf(s1) - expf(s2) + LAM_INIT;
    for (int u = blockIdx.x; u < 1024; u += gridDim.x) {
      const int b = u & 255, i = u >> 8, h = b & 7, qb = (b >> 3) + 32 * (i >> 1), cmp = i & 1, hc = 2 * h + cmp;
      const float kmax2 = __uint_as_float(kmx[hc]);
      const size_t q0 = (size_t)(CTXL + qb * 256);
      bf16_t* O0 = O + (size_t)(qb * 256) * 4096 + (2 * h) * 256;
      const unsigned char* k8 = (const unsigned char*)(a.ws + WS_K8) + hc * 128; const unsigned char* v8 = (const unsigned char*)(a.ws + WS_HG) + (size_t)h * (MT / 64) * 16384;
      if (cmp == 0) at::attn_body_e<8, VAR, 0>(Q + q0 * N_IN1 + hc * 128, N_IN1, k8, 2048, v8, O0, 4096, MT, kmax2, lds);
      else at::attn_body_e<8, VAR, 2>(Q + q0 * N_IN1 + hc * 128, N_IN1, k8, 2048, v8, O0, 4096, MT, kmax2, lds,
                                      at::DiffEpi{O0, (unsigned char*)(a.ws + WS_X2) + (q0 * D + h * 256) * (DENSE8_G2 ? 1 : 2), lam, a.in[18]});
    }
  }
}

__device__ __forceinline__ void phase_diff(const Args& a) {
  int tid = threadIdx.x; asm volatile("" : "+v"(tid)); tid &= 511; const int wave = tid >> 6, lane = tid & 63;
  const bf16_t* O = (const bf16_t*)(a.ws + WS_Y);
  bf16_t* X2 = (bf16_t*)(a.ws + WS_X2);
  const float* lp = a.in[17];
  const float s1 = wave_sum(lp[lane] * lp[128 + lane] + lp[64 + lane] * lp[192 + lane]);
  const float s2 = wave_sum(lp[256 + lane] * lp[384 + lane] + lp[320 + lane] * lp[448 + lane]);
  const float lam = expf(s1) - expf(s2) + LAM_INIT;
  const f32x4 sg = *(const f32x4*)(a.in[18] + 4 * lane);
  for (int it = blockIdx.x; it < SEQ / 8; it += gridDim.x) {
    const int t = it * 8 + wave;
    const bf16_t* op = O + (size_t)t * 4096;
    unsigned char* xp = (unsigned char*)X2 + (size_t)(CTXL + t) * D * (DENSE8_G2 ? 1 : 2);
#pragma unroll 2
    for (int h = 0; h < 8; ++h) {
      const u32x2 a0 = *(const u32x2*)(op + (2 * h) * 256 + 4 * lane), a1 = *(const u32x2*)(op + (2 * h + 1) * 256 + 4 * lane);
      float d[4] = {bflo(a0[0]) - lam * bflo(a1[0]), bfhi(a0[0]) - lam * bfhi(a1[0]), bflo(a0[1]) - lam * bflo(a1[1]), bfhi(a0[1]) - lam * bfhi(a1[1])};
      const float ss = wave_sum(d[0] * d[0] + d[1] * d[1] + d[2] * d[2] + d[3] * d[3]);
      const float rstd = rsqrtf(ss * (1.f / 256) + EPS) * (1.f - LAM_INIT);
#if DENSE8_G2
      const float r8 = rstd * 8.f;
      *(unsigned*)(xp + h * 256 + 4 * lane) = pack8x4(d[0] * r8 * sg[0], d[1] * r8 * sg[1], d[2] * r8 * sg[2], d[3] * r8 * sg[3]);
#else
      u32x2 pk = {cvtpk(d[0] * rstd * sg[0], d[1] * rstd * sg[1]), cvtpk(d[2] * rstd * sg[2], d[3] * rstd * sg[3])};
      *(u32x2*)((bf16_t*)xp + h * 256 + 4 * lane) = pk;
#endif
    }
  }
}

__device__ __forceinline__ void phase_G(const Args& a, int L, LAS char* lds, bool dry = false) {
  int tid = threadIdx.x; asm volatile("" : "+v"(tid)); tid &= 511; const int wave = tid >> 6, lane = tid & 63;
  const int NTOK = L == 0 ? MT : SEQ, ROW0 = L == 0 ? 0 : CTXL;
  const float* ng = a.in[6] + (size_t)L * 4 * D;
  const float* MODL = (const float*)(a.ws + WS_MOD) + (size_t)(L * 2) * 12288;
  const bf16_t* RT = (const bf16_t*)(a.ws + WS_RT) + (size_t)L * 2 * 131072; const float* rbias = a.in[20] + L * NE;
  const bf16_t* OUT = (const bf16_t*)(a.ws + WS_OUT);
  bf16_t* HRES = (bf16_t*)(a.ws + WS_HRES);
  bf16_t* F = (bf16_t*)(a.ws + WS_ABUF);
  int* counts = (int*)(a.ws + WS_CTL + CTL_CNT) + L * 64;
  int* top_e = (int*)(a.ws + WS_TOPE); float* top_w = (float*)(a.ws + WS_TOPW); int* top_p = (int*)(a.ws + WS_TOPP); int* elist = (int*)(a.ws + WS_ELIST);
  LAS float* ft = (LAS float*)lds;
  LAS float* part = ft + 8 * D;
  for (int it = blockIdx.x; it < NTOK / 8; it += gridDim.x) {
    const int r = ROW0 + it * 8 + wave;
    const float* mod = MODL + (r < CTXL ? 12288 : 0);
    {
      float o[32], h[32];
      ld_row_bf16(OUT + (size_t)r * D, lane, o);
      if (L == 0) ld_row_f32(r < CTXL ? a.in[2] + (size_t)r * D : a.in[0] + (size_t)(r - CTXL) * D, lane, h);
      else ld_row_bf16(HRES + (size_t)r * D, lane, h);
      const float rstd1 = rsqrtf(sumsq32(o) * (1.f / D) + EPS);
#pragma unroll
      for (int j = 0; j < 4; ++j) { const int idx = 8 * lane + 512 * j;
        float g1[8], gt[8]; ld8f(ng + D + idx, g1); ld8f(mod + 2 * D + idx, gt);
#pragma unroll
        for (int i = 0; i < 8; ++i) h[8 * j + i] += gt[i] * (o[8 * j + i] * rstd1 * g1[i]);
        if (!dry) st8h(HRES + (size_t)r * D + idx, &h[8 * j]); }
      const float rstd2 = rsqrtf(sumsq32(h) * (1.f / D) + EPS);
      modulate_store<true, true>(h, rstd2, ng + 2 * D, mod + 3 * D, mod + 4 * D, (bf16_t*)((unsigned char*)F + (size_t)r * D), lane, ft, wave);
    }
    __syncthreads();
    f32x4 acc[4];
#pragma unroll
    for (int nt = 0; nt < 4; ++nt) acc[nt] = (f32x4){0.f, 0.f, 0.f, 0.f};
    { const int trow = lane & 7, kg = lane >> 4, swz = 4 * (trow & 3) + (trow >> 2);
      const bf16_t* rth = RT + (size_t)lane * 8; const bf16_t* rtl = rth + 131072;
#pragma unroll 2
      for (int st = 0; st < 8; ++st) {
        const int ks = 8 * wave + st, c = ks * 4 + kg;
        LAS const char* ap = (LAS const char*)ft + trow * 4096 + ((c ^ swz) << 4);
        const bf16x8 ah = *(LAS const bf16x8*)ap, al = *(LAS const bf16x8*)(ap + 32768);
#pragma unroll
        for (int nt = 0; nt < 4; ++nt) {
          const bf16x8 bh = *(const bf16x8*)(rth + (size_t)((nt * 64 + ks) * 64) * 8), bl = *(const bf16x8*)(rtl + (size_t)((nt * 64 + ks) * 64) * 8);
          acc[nt] = __builtin_amdgcn_mfma_f32_16x16x32_bf16(ah, bh, acc[nt], 0, 0, 0);
          acc[nt] = __builtin_amdgcn_mfma_f32_16x16x32_bf16(ah, bl, acc[nt], 0, 0, 0);
          acc[nt] = __builtin_amdgcn_mfma_f32_16x16x32_bf16(al, bh, acc[nt], 0, 0, 0); }
      }
      if (kg < 2) {
#pragma unroll
        for (int rr = 0; rr < 4; ++rr)
#pragma unroll
          for (int nt = 0; nt < 4; ++nt) part[(wave * 8 + 4 * kg + rr) * 64 + nt * 16 + (lane & 15)] = acc[nt][rr]; }
    }
    __syncthreads();
    float logit = 0;
#pragma unroll
    for (int w = 0; w < 8; ++w) logit += part[(w * 8 + wave) * 64 + lane];
#if MK_DIAG
    ((float*)(a.ws + WS_Y))[(size_t)r * 64 + lane] = logit;
#endif
    const float score = sigmoidf_(logit);
    const float choice = score + rbias[lane];
    int rank = 0; const int gl = lane & 7;
#pragma unroll
    for (int j = 0; j < 8; ++j) { const float o = __shfl(choice, (lane & ~7) | j); rank += (o > choice || (o == choice && j < gl)) ? 1 : 0; }
    float gs = rank < 2 ? choice : 0.f;
    gs += __shfl_xor(gs, 1); gs += __shfl_xor(gs, 2); gs += __shfl_xor(gs, 4);
    int grank = 0; const int g = lane >> 3;
#pragma unroll
    for (int j = 0; j < 8; ++j) { const float o = __shfl(gs, j * 8); grank += (o > gs || (o == gs && j < g)) ? 1 : 0; }
    const bool gsel = grank < 4;
    const float mc = gsel ? choice : -INFINITY;
    int erank = 0;
#pragma unroll 4
    for (int j = 0; j < 64; ++j) { const float o = __int_as_float(__builtin_amdgcn_readlane(__float_as_int(mc), j)); erank += (o > mc || (o == mc && j < lane)) ? 1 : 0; }
    const bool sel = gsel && erank < 8;
    const unsigned long long bal = __ballot(sel);
    const int idx = __popcll(bal & ((1ull << lane) - 1ull));
    const float ssum = wave_sum(sel ? score : 0.f);
    if (sel && !dry) { const int pos = atomicAdd(&counts[lane], 1);
      top_e[r * 8 + idx] = lane; top_w[r * 8 + idx] = score / ssum * 2.5f; top_p[r * 8 + idx] = pos; elist[(size_t)lane * ECAP + pos] = r; }
  }
}

__device__ __forceinline__ void moe_tile_prefix(const int* counts, LAS int* ts) {
  if (threadIdx.x == 0) { int s = 0; for (int e = 0; e < 64; ++e) { ts[e] = s; s += (counts[e] + 255) >> 8; } ts[64] = s; }
  __syncthreads();
}
__device__ __forceinline__ void phase_H(const Args& a, int L, LAS char* lds) {
  const int NTOK = L == 0 ? MT : SEQ, ROW0 = L == 0 ? 0 : CTXL;
  const int* counts = (const int*)(a.ws + WS_CTL + CTL_CNT) + L * 64;
  const int* top_e = (const int*)(a.ws + WS_TOPE); const int* top_p = (const int*)(a.ws + WS_TOPP);
  int* tslot = (int*)(a.ws + WS_TSLOT); int* stok = (int*)(a.ws + WS_STOK);
  LAS int* ts = (LAS int*)lds;
  moe_tile_prefix(counts, ts);
  int tid = threadIdx.x; asm volatile("" : "+v"(tid)); tid &= 511;
  const int gt = blockIdx.x * NTHREADS + tid, gs = gridDim.x * NTHREADS;
  for (int i = gt; i < NTOK * 8; i += gs) { const int q = ROW0 * 8 + i; const int e = top_e[q]; const int slot = ts[e] * 256 + top_p[q]; stok[slot] = q >> 3; tslot[q] = slot; }
  for (int i = gt; i < 64 * 256; i += gs) { const int e = i >> 8, p = i & 255, cnt = counts[e], nt = (cnt + 255) >> 8; if (cnt + p < nt * 256) stok[ts[e] * 256 + cnt + p] = ROW0; }
  for (int i = gt; i < NTOK; i += gs) stok[SH_BASE + i] = ROW0 + i;
  __syncthreads();
}
struct GatherTile {
  const int* lp; int nv, idb;
  __device__ __forceinline__ int tok(int ri) const { return idb >= 0 ? idb + ri : (ri < nv ? lp[ri] : -idb - 1); }
};
struct DenseSched {
  int nM, nN, r0; const unsigned char* W;
  __device__ __forceinline__ GatherTile gather_tile(int) const { return GatherTile{nullptr, 0, 0}; }
  __device__ __forceinline__ bool unit(int i, int& brow, const unsigned char*& Bt, int& bcol) const {
    const int u = blockIdx.x + i * (int)gridDim.x; if (u >= nM * nN) return false;
    int pm, pn; dense_unit(u, nM, nN, pm, pn); brow = r0 + pm * 256; bcol = pn * 256; Bt = W; return true; }
};
struct MoeSched {
  LAS const int* ts; int TR, NN, total; const unsigned char* W; size_t woff; const int* counts; const int* elist; int row0;
  __device__ __forceinline__ GatherTile gather_tile(int slot0) const {
    if (slot0 >= SH_BASE) return GatherTile{nullptr, 0, row0 + (slot0 - SH_BASE)};
    const int m = slot0 >> 8, le = (int)__builtin_amdgcn_mbcnt_hi(~0u, __builtin_amdgcn_mbcnt_lo(~0u, 0u));
    const int e = __popcll(__ballot(ts[le + 1] <= m)), first = (m - ts[e]) * 256;
    return GatherTile{elist + (size_t)e * ECAP + first, counts[e] - first, -row0 - 1};
  }
  __device__ __forceinline__ bool unit(int i, int& slot0, const unsigned char*& Bt, int& bcol) const {
    for (int u = blockIdx.x + i * (int)gridDim.x; ; u += gridDim.x) {
      const int rnd = u >> 8, b = u & 255, v = rnd * 256 + (b & 7) * 32 + (b >> 3);
      if (rnd * 256 >= total) return false;
      if (v >= total) return false;
      const int m = v / NN, pn = v % NN;
      int e;
      if (m >= TR) { e = 64; slot0 = SH_BASE + 256 * (m - TR); }
      else { const int le = (int)__builtin_amdgcn_mbcnt_hi(~0u, __builtin_amdgcn_mbcnt_lo(~0u, 0u));
        e = __popcll(__ballot(ts[le + 1] <= m)); slot0 = 256 * m; }
      Bt = W + (size_t)e * WMOE8_E + woff; bcol = pn * 256;
      return true;
    }
  }
};
template <int GV = 0>
__device__ __forceinline__ void phase_moe_up(const Args& a, int L, LAS char* lds) {
  const int NSH = L == 0 ? MT / 256 : SEQ / 256;
  const int* counts = (const int*)(a.ws + WS_CTL + CTL_CNT) + L * 64;
  LAS int* ts = (LAS int*)(lds + LDS_CTL + 64);
  moe_tile_prefix(counts, ts);
  const int TR = ts[64], TM = TR + NSH;
  const unsigned char* F = (const unsigned char*)(a.ws + WS_ABUF); const unsigned char* W = (const unsigned char*)(a.ws + WS_WMOE) + (size_t)L * 65 * WMOE8_E;
  const int* stok = (const int*)(a.ws + WS_STOK);
  EpiSwiGLU8 epi{(unsigned char*)(a.ws + WS_ACT), EFF};
  MoeSched sc{ts, TR, 4, TM * 4, W, 0, counts, (const int*)(a.ws + WS_ELIST), L == 0 ? 0 : CTXL};
  gemm8_run<true, D, D, D, GV>(F, stok, lds, epi, sc);
}
template <int GV = 0>
__device__ __forceinline__ void phase_moe_down(const Args& a, int L, LAS char* lds) {
  const int NSH = L == 0 ? MT / 256 : SEQ / 256;
  const int* counts = (const int*)(a.ws + WS_CTL + CTL_CNT) + L * 64;
  LAS int* ts = (LAS int*)(lds + LDS_CTL + 64);
  moe_tile_prefix(counts, ts);
  const int TR = ts[64], TM = TR + NSH;
  const unsigned char* ACT = (const unsigned char*)(a.ws + WS_ACT); const unsigned char* W = (const unsigned char*)(a.ws + WS_WMOE) + (size_t)L * 65 * WMOE8_E;
  EpiPlain8 epi{(unsigned char*)(a.ws + WS_Y), D, 16.f / 128.f};
  MoeSched sc{ts, TR, 8, TM * 8, W, (size_t)1024 * D, counts, nullptr, 0};
  gemm8_run<false, EFF, EFF, EFF, GV>(ACT, nullptr, lds, epi, sc);
}
__device__ __forceinline__ void phase_combine(const Args& a, int L, LAS char* lds, bool dry = false) {
  int tid = threadIdx.x; asm volatile("" : "+v"(tid)); tid &= 511; const int wave = tid >> 6, lane = tid & 63;
  const int NTOK = L == 0 ? MT : SEQ, ROW0 = L == 0 ? 0 : CTXL;
  const float* ng = a.in[6] + (size_t)L * 4 * D;
  const float* MODL = (const float*)(a.ws + WS_MOD) + (size_t)(L * 2) * 12288;
  const unsigned char* Y = (const unsigned char*)(a.ws + WS_Y);
  bf16_t* HRES = (bf16_t*)(a.ws + WS_HRES);
  const int* top_e = (const int*)(a.ws + WS_TOPE); const int* top_p = (const int*)(a.ws + WS_TOPP); const float* top_w = (const float*)(a.ws + WS_TOPW);
  LAS int* ts = (LAS int*)(lds + LDS_CTL + 64);
  moe_tile_prefix((const int*)(a.ws + WS_CTL + CTL_CNT) + L * 64, ts);
  for (int it = blockIdx.x; it < NTOK / 8; it += gridDim.x) {
    const int r = ROW0 + it * 8 + wave;
    const float* mod = MODL + (r < CTXL ? 12288 : 0);
    float y[32];
    { float t[32]; ld_row_fp8(Y + (size_t)(SH_BASE + r - ROW0) * D, lane, t);
#pragma unroll
      for (int i = 0; i < 32; ++i) y[i] = t[i] * (1.f / 16.f); }
#pragma unroll 4
    for (int k = 0; k < 8; ++k) { const int slot = ts[top_e[r * 8 + k]] * 256 + top_p[r * 8 + k]; const float w = top_w[r * 8 + k] * (1.f / 16.f);
      float t[32]; ld_row_fp8(Y + (size_t)slot * D, lane, t);
#pragma unroll
      for (int i = 0; i < 32; ++i) y[i] += w * t[i]; }
    const float rstd = rsqrtf(sumsq32(y) * (1.f / D) + EPS);
    float h[32]; ld_row_bf16(HRES + (size_t)r * D, lane, h);
#pragma unroll
    for (int j = 0; j < 4; ++j) { const int idx = 8 * lane + 512 * j;
      float g3[8], gt[8]; ld8f(ng + 3 * D + idx, g3); ld8f(mod + 5 * D + idx, gt);
#pragma unroll
      for (int i = 0; i < 8; ++i) h[8 * j + i] += gt[i] * (y[8 * j + i] * rstd * g3[i]);
      if (L == 0) { if (!dry) st8h(HRES + (size_t)r * D + idx, &h[8 * j]); } else st8f(a.out + (size_t)(r - CTXL) * D + idx, &h[8 * j]); }
    if (L == 0) {
      const float* mod1 = MODL + 2 * 12288 + (r < CTXL ? 12288 : 0);
      const float rstd2 = rsqrtf(sumsq32(h) * (1.f / D) + EPS);
#if DENSE8_G1
      modulate_store<false, true>(h, rstd2, a.in[6] + (size_t)4 * D, mod1, mod1 + D, (bf16_t*)((unsigned char*)(a.ws + WS_ABUF) + (size_t)r * D), lane, nullptr);
#else
      modulate_store<false>(h, rstd2, a.in[6] + (size_t)4 * D, mod1, mod1 + D, (bf16_t*)(a.ws + WS_ABUF) + (size_t)r * D, lane, nullptr);
#endif
    }
  }
}

constexpr int NPH = 21;
typedef const __attribute__((address_space(4))) Args* ArgsP;
#if defined(__HIP_DEVICE_COMPILE__)
#define FRESH_ARGS() const Args a = *({ ArgsP _p = (ArgsP)__builtin_amdgcn_kernarg_segment_ptr(); asm volatile("" : "+s"(_p)); _p; })
#else
#define FRESH_ARGS() const Args a = kargs
#endif
__global__ void __launch_bounds__(NTHREADS, 2) fwd(Args kargs) {
  extern __shared__ __attribute__((aligned(16))) unsigned char lds_raw[];
  LAS char* lds = (LAS char*)lds_raw;
  const int lo = kargs.ph_lo, hi = kargs.ph_hi;
  if (threadIdx.x < 64) ((LAS unsigned*)(lds + LDS_CTL))[threadIdx.x] = 0u;
  __syncthreads();
  if (hi - lo > 1) (void)xcd_barrier_post((unsigned*)(kargs.ws + WS_CTL), (volatile LAS unsigned*)(lds + LDS_CTL));
#ifndef PHASE_MASK
#define PHASE_MASK 0xFFFFFFFFu
#endif
#define IN(k) (((PHASE_MASK >> (k)) & 1u) && lo <= (k) && (k) < hi)
#ifndef PH_REPEAT_MASK
#define PH_REPEAT_MASK 0u
#endif
#define REP(k) for (int _rep = 0; _rep < (((PH_REPEAT_MASK >> (k)) & 1u) ? 2 : 1); ++_rep)
#define SEAM(k) do { if ((k) + 1 < hi) { XcdBarrier _b; _b.bar = (unsigned*)(a.ws + WS_CTL); _b.x = xb_xcc_id(); _b.st = (volatile LAS unsigned*)(lds + LDS_CTL); xcd_barrier(_b); } } while (0)

  if (IN(0)) { FRESH_ARGS(); REP(0) phase_prologue(a, lds); SEAM(0); }
  if (IN(1)) { FRESH_ARGS(); REP(1) phase_modulate0(a); SEAM(1); }
#pragma unroll
  for (int L = 0; L < 2; ++L) {
    const int base = 2 + (L == 0 ? 0 : 9);
    if (IN(base + 0)) {
      FRESH_ARGS();
      const int nN = L == 0 ? N_IN0 / 256 : N_IN1 / 256, nM = MT / 256;
#if DENSE8_G1
      const unsigned char* A = (const unsigned char*)(a.ws + WS_ABUF);
      EpiG1 epi{EpiPlain{(bf16_t*)(a.ws + WS_QKVU), L == 0 ? N_QKV0 : N_IN1, 1.f / 256.f}, EpiPair<0>{(bf16_t*)(a.ws + WS_HG), 1024, N_QKV0, 1.f / 256.f}, L == 0 ? N_QKV0 : N_IN1};
      DenseSched sc{nM, nN, 0, (const unsigned char*)(a.ws + (L == 0 ? WS_WIN0 : WS_WIN1))};
      REP(2) gemm8_run<false, D, D, D>(A, nullptr, lds, epi, sc);
#else
      const bf16_t* A = (const bf16_t*)(a.ws + WS_ABUF);
      const bf16_t* Bt = (const bf16_t*)(a.ws + (L == 0 ? WS_WIN0 : WS_WIN1));
      EpiG1 epi{EpiPlain{(bf16_t*)(a.ws + WS_QKVU), L == 0 ? N_QKV0 : N_IN1, 1.f}, EpiPair<0>{(bf16_t*)(a.ws + WS_HG), 1024, N_QKV0, 1.f}, L == 0 ? N_QKV0 : N_IN1};
      REP(2) for (int u = blockIdx.x; u < nM * nN; u += gridDim.x) { int pm, pn; dense_unit(u, nM, nN, pm, pn);
        gemm_tile<false>(A, D, nullptr, pm * 256, Bt, D, pn * 256, D, lds, epi); }
#endif
      SEAM(base + 0);
    }
    if (L == 0) {
      if (IN(3)) { FRESH_ARGS(); if ((PH_REPEAT_MASK >> 3) & 1u) { phase_rope_conv0(a, lds, true); __syncthreads(); } phase_rope_conv0(a, lds); SEAM(3); }
      if (IN(4)) { FRESH_ARGS(); if ((PH_REPEAT_MASK >> 4) & 1u) { phase_attn<ATT_VAR>(a, 0, lds); __syncthreads(); } phase_attn<0>(a, 0, lds); SEAM(4); }
    } else {
      if (IN(12)) { FRESH_ARGS(); if ((PH_REPEAT_MASK >> 12) & 1u) { phase_rope1(a, lds, true); __syncthreads(); } phase_rope1(a, lds); SEAM(12); }
      if (IN(13)) { FRESH_ARGS(); if ((PH_REPEAT_MASK >> 13) & 1u) { phase_attn<ATT_VAR>(a, 1, lds); __syncthreads(); } phase_attn<0>(a, 1, lds); SEAM(13); }
    }
    const int b2 = L == 0 ? 5 : 15;
    if (IN(b2 + 0)) {
      FRESH_ARGS();
      const int nN = D / 256, nM = L == 0 ? MT / 256 : SEQ / 256, r0 = L == 0 ? 0 : CTXL;
#if DENSE8_G2
      const unsigned char* A = (const unsigned char*)(a.ws + WS_X2);
      EpiPlain epi{(bf16_t*)(a.ws + WS_OUT), D, 1.f / 2048.f};
      DenseSched sc{nM, nN, r0, (const unsigned char*)(a.ws + (L == 0 ? WS_WOUT0 : WS_WOUT1))};
      REP(5) gemm8_run<false, D, D, D>(A, nullptr, lds, epi, sc);
#else
      const bf16_t* A = (const bf16_t*)(a.ws + WS_X2);
      const bf16_t* Bt = (const bf16_t*)(a.ws + (L == 0 ? WS_WOUT0 : WS_WOUT1));
      EpiPlain epi{(bf16_t*)(a.ws + WS_OUT), D, 1.f};
      REP(5) for (int u = blockIdx.x; u < nM * nN; u += gridDim.x) { int pm, pn; dense_unit(u, nM, nN, pm, pn);
        gemm_tile<false>(A, D, nullptr, r0 + pm * 256, Bt, D, pn * 256, D, lds, epi); }
#endif
      SEAM(b2 + 0);
    }
    if (IN(b2 + 1)) { FRESH_ARGS(); if ((PH_REPEAT_MASK >> 6) & 1u) { phase_G(a, L, lds, true); __syncthreads(); } phase_G(a, L, lds); SEAM(b2 + 1); }
    if (IN(b2 + 3)) { FRESH_ARGS(); if ((PH_REPEAT_MASK >> 8) & 1u) { phase_moe_up<GEMM_VAR>(a, L, lds); __syncthreads(); } phase_moe_up<0>(a, L, lds); SEAM(b2 + 3); }
    if (IN(b2 + 4)) { FRESH_ARGS(); if ((PH_REPEAT_MASK >> 9) & 1u) { phase_moe_down<GEMM_VAR>(a, L, lds); __syncthreads(); } phase_moe_down<0>(a, L, lds); SEAM(b2 + 4); }
    if (IN(b2 + 5)) { FRESH_ARGS(); if ((PH_REPEAT_MASK >> 10) & 1u) phase_combine(a, L, lds, true); phase_combine(a, L, lds); SEAM(b2 + 5); }
  }
#undef IN
#undef SEAM
}

#ifndef MK_DIAG
#define MK_DIAG 0
#endif
#if MK_DIAG
__device__ __forceinline__ void rope_cs(int r, int lane, float& cs, float& sn) {
  cs = 1.f; sn = 0.f;
  if (r >= CTXL) { const int t = r - CTXL; const int a = lane >> 5, i = lane & 31;
    const float pos = a ? (float)(t & 63) : (float)(t >> 6);
    const float inv = powf(10000.f, -(float)i / 32.f);
    sincosf(pos * inv, &sn, &cs); }
}
__device__ __forceinline__ bool dclose(float got, float ref, float rtol, float atol) { return fabsf(got - ref) <= rtol * fabsf(ref) + atol; }
__device__ __forceinline__ unsigned dhash(unsigned x) { x ^= x >> 16; x *= 0x7feb352du; x ^= x >> 15; x *= 0x846ca68bu; x ^= x >> 16; return x; }
__device__ float wdot(const bf16_t* arow, const float* W, int ldw, int col, int K, int lane) {
  float s = 0; for (int k = lane; k < K; k += 64) s += bf2f(arow[k]) * W[(size_t)k * ldw + col]; return wave_sum(s); }
__device__ float dq8(const unsigned char* p, size_t i) { const unsigned w = ((const unsigned*)p)[i >> 2]; const int b = (int)(i & 3);
  return b == 0 ? __builtin_amdgcn_cvt_f32_fp8((int)w, 0) : b == 1 ? __builtin_amdgcn_cvt_f32_fp8((int)w, 1) : b == 2 ? __builtin_amdgcn_cvt_f32_fp8((int)w, 2) : __builtin_amdgcn_cvt_f32_fp8((int)w, 3); }
__device__ float wdot8(const unsigned char* arow8, const float* W, int ldw, int col, int K, int lane) {
  float s = 0; for (int k = lane; k < K; k += 64) s += dq8(arow8, k) * W[(size_t)k * ldw + col]; return wave_sum(s); }
__device__ void dflag(int* dg, int s, int bad, int lane) { if (lane == 0 && bad) atomicAdd(&dg[s], bad); }
__device__ const float* h0row(const Args& a, int r) { return r < CTXL ? a.in[2] + (size_t)r * D : a.in[0] + (size_t)(r - CTXL) * D; }
__device__ int pick_row(unsigned h, int lo, int n) { const unsigned m = h % 8; if (m == 0) return lo; if (m == 1) return lo + n - 1; if (m == 2) return lo + 255 < lo + n ? lo + 255 : lo; if (m == 3) return lo + 256 < lo + n ? lo + 256 : lo; return lo + (int)((h >> 3) % (unsigned)n); }
__device__ void naive_attn(const bf16_t* q, const bf16_t* K, const bf16_t* V, int ld, int nkeys, int lane, float& o0, float& o1) {
  const float q0 = bf2f(q[lane]), q1 = bf2f(q[lane + 64]);
  float m = -1e30f, l = 0; o0 = 0; o1 = 0;
  for (int k = 0; k < nkeys; ++k) {
    const float s = wave_sum(q0 * bf2f(K[(size_t)k * ld + lane]) + q1 * bf2f(K[(size_t)k * ld + lane + 64])) * 0.088388347648318440f;
    const float mn = fmaxf(m, s), al = expf(m - mn), p = expf(s - mn);
    l = l * al + p; o0 = o0 * al + p * bf2f(V[(size_t)k * ld + lane]); o1 = o1 * al + p * bf2f(V[(size_t)k * ld + lane + 64]); m = mn;
  }
  o0 /= l; o1 /= l;
}
__global__ void __launch_bounds__(256) diag(Args a, int k) {
  __shared__ float fsh[4][2048];
  __shared__ float csh[4][64];
  const int lane = threadIdx.x & 63, wv = threadIdx.x >> 6, gw = blockIdx.x * 4 + wv;
  int* dg = (int*)(a.ws + WS_CTL + CTL_CNT + 512);
  const float* MOD = (const float*)(a.ws + WS_MOD);
  const bf16_t* AB = (const bf16_t*)(a.ws + WS_ABUF);
  const bf16_t* QK = (const bf16_t*)(a.ws + WS_QKVU);
  const bf16_t* HG = (const bf16_t*)(a.ws + WS_HG);
  const bf16_t* X2 = (const bf16_t*)(a.ws + WS_X2);
  const bf16_t* OUT = (const bf16_t*)(a.ws + WS_OUT);
  const bf16_t* ACT = (const bf16_t*)(a.ws + WS_ACT);
  const bf16_t* Y = (const bf16_t*)(a.ws + WS_Y);
  const float* HRES = (const float*)(a.ws + WS_HRES);
  const int* top_e = (const int*)(a.ws + WS_TOPE); const float* top_w = (const float*)(a.ws + WS_TOPW); const int* top_p = (const int*)(a.ws + WS_TOPP);
  const int* tslot = (const int*)(a.ws + WS_TSLOT); const int* stok = (const int*)(a.ws + WS_STOK);
  const unsigned h = dhash(gw * 7919u + k * 104729u + 17u), h2 = dhash(h + 12345u);
  int bad = 0;
  const int L = k >= 11 ? 1 : 0;
  const int NTOK = L == 0 ? MT : SEQ, ROW0 = L == 0 ? 0 : CTXL;
  const int* counts = (const int*)(a.ws + WS_CTL + CTL_CNT) + L * 64;
  if (k == 0) {
    const int LL = gw & 1, which = (gw >> 1) & 1, j = h % 12288;
    const float* v = which ? a.in[3] : a.in[1];
    float s = 0; for (int d = lane; d < D; d += 64) { const float x = v[d]; s += x * sigmoidf_(x) * a.in[4][((size_t)LL * D + d) * 12288 + j]; }
    s = wave_sum(s) + a.in[5][LL * 12288 + j];
    bad = !dclose(MOD[(LL * 2 + which) * 12288 + j], s, 1e-3f, 1e-3f); dflag(dg, 1, bad, lane);
  } else if (k == 1) {
    const int r = pick_row(h, 0, MT); const float* x = h0row(a, r); const float* mod = MOD + (r < CTXL ? 12288 : 0);
    float ss = 0; for (int d = lane; d < D; d += 64) ss += x[d] * x[d]; ss = wave_sum(ss); const float rstd = rsqrtf(ss / D + EPS);
    for (int d = lane; d < D; d += 64) { const float ref = x[d] * rstd * a.in[6][d] * (1.f + mod[D + d]) + mod[d]; bad += !dclose(bf2f(AB[(size_t)r * D + d]), ref, 0.01f, 0.01f); }
    bad = (int)wave_sum((float)bad); dflag(dg, 2, bad, lane);
  } else if (k == 2 || k == 11) {
    const int r = pick_row(h, 0, MT);
    if (L == 0) {
      const int c = h2 % N_QKV0; const float ref = wdot(AB + (size_t)r * D, a.in[7], N_IN0, c, D, lane);
      bad = !dclose(bf2f(QK[(size_t)r * N_QKV0 + c]), ref, 0.02f, 0.05f); dflag(dg, 3, bad, lane);
      const int ch = (h2 >> 11) % 1024; const float av = wdot(AB + (size_t)r * D, a.in[7], N_IN0, N_QKV0 + ch, D, lane), gv = wdot(AB + (size_t)r * D, a.in[7], N_IN0, N_QKV0 + 1024 + ch, D, lane);
      bad = !dclose(bf2f(HG[(size_t)r * 1024 + ch]), av * sigmoidf_(gv), 0.03f, 0.05f); dflag(dg, 4, bad, lane);
    } else {
      const int c = h2 % N_IN1; const float ref = wdot(AB + (size_t)r * D, a.in[15], N_IN1, c, D, lane);
      bad = !dclose(bf2f(QK[(size_t)r * N_IN1 + c]), ref, 0.02f, 0.05f); dflag(dg, 15, bad, lane);
    }
  } else if (k == 3) {
    { const int r = pick_row(h, 0, MT), hh = h2 % 10; const float* g = hh < 8 ? a.in[9] : a.in[10];
      float raw0 = 0, raw1 = 0;
      for (int d = 0; d < 128; ++d) { const float v = wdot(AB + (size_t)r * D, a.in[7], N_IN0, hh * 128 + d, D, lane); if (d == lane) raw0 = v; if (d == lane + 64) raw1 = v; }
      const float rstd = rsqrtf(wave_sum(raw0 * raw0 + raw1 * raw1) / 128.f + EPS);
      const float y0 = raw0 * rstd * g[lane], y1 = raw1 * rstd * g[lane + 64];
      float cs, sn; rope_cs(r, lane, cs, sn);
      const float cs0 = __shfl(cs, lane & 31), sn0 = __shfl(sn, lane & 31), cs1 = __shfl(cs, 32 + (lane & 31)), sn1 = __shfl(sn, 32 + (lane & 31));
      const float p0 = __shfl_xor(y0, 32), p1 = __shfl_xor(y1, 32);
      const float o0 = (lane < 32) ? y0 * cs0 - p0 * sn0 : y0 * cs0 + p0 * sn0;
      const float o1 = (lane < 32) ? y1 * cs1 - p1 * sn1 : y1 * cs1 + p1 * sn1;
      bad = !dclose(bf2f(QK[(size_t)r * N_QKV0 + hh * 128 + lane]), o0, 0.03f, 0.05f) + !dclose(bf2f(QK[(size_t)r * N_QKV0 + hh * 128 + 64 + lane]), o1, 0.03f, 0.05f);
      bad = (int)wave_sum((float)bad); dflag(dg, 5, bad, lane); }
    { const int r = pick_row(h2, 0, MT); const int seg0 = r < CTXL ? 0 : CTXL, seg1 = r < CTXL ? CTXL : MT;
      float cv[16]; float s1 = 0, s2 = 0;
      for (int q = 0; q < 16; ++q) { const int c = lane + 64 * q; float acc = a.in[12][c];
        for (int j = 0; j < 31; ++j) { const int rr = r + j - 15; if (rr >= seg0 && rr < seg1) acc += bf2f(HG[(size_t)rr * 1024 + c]) * a.in[11][j * 1024 + c]; }
        cv[q] = acc; s1 += acc; s2 += acc * acc; }
      s1 = wave_sum(s1); s2 = wave_sum(s2); const float mean = s1 / 1024.f, rstd = rsqrtf(s2 / 1024.f - mean * mean + EPS);
      bad = 0;
      for (int q = 0; q < 16; ++q) { const int c = lane + 64 * q; float y = (cv[q] - mean) * rstd * a.in[13][c] + a.in[14][c]; y = y * sigmoidf_(y);
        bad += !dclose(bf2f(X2[(size_t)r * D + 1024 + c]), y, 0.03f, 0.03f); }
      bad = (int)wave_sum((float)bad); dflag(dg, 6, bad, lane); }
  } else if (k == 4) {
    if (gw < 64) { const int r = pick_row(h, 0, MT), head = h2 % 8; const int nkeys = r < CTXL ? CTXL : MT;
      float o0, o1; naive_attn(QK + (size_t)r * N_QKV0 + head * 128, QK + 1024 + (head >> 2) * 128, QK + 1280 + (head >> 2) * 128, N_QKV0, nkeys, lane, o0, o1);
      const float rt = r < CTXL ? 0.15f : 0.05f, at_ = r < CTXL ? 0.04f : 0.01f;
      bad = !dclose(bf2f(X2[(size_t)r * D + head * 128 + lane]), o0, rt, at_) + !dclose(bf2f(X2[(size_t)r * D + head * 128 + 64 + lane]), o1, rt, at_);
      bad = (int)wave_sum((float)bad); dflag(dg, r < CTXL ? 26 : 7, bad, lane); }
  } else if (k == 5 || k == 15) {
    const int r = pick_row(h, ROW0, NTOK), c = h2 % D; const float ref = wdot(X2 + (size_t)r * D, L == 0 ? a.in[8] : a.in[16], D, c, D, lane);
    bad = !dclose(bf2f(OUT[(size_t)r * D + c]), ref, 0.02f, 0.05f); dflag(dg, L == 0 ? 8 : 19, bad, lane);
  } else if (k == 6 || k == 16) {
    const int r = pick_row(h, ROW0, NTOK); const float* mod = MOD + (size_t)(L * 2) * 12288 + (r < CTXL ? 12288 : 0); const float* ng = a.in[6] + (size_t)L * 4 * D;
    float ss = 0; for (int d = lane; d < D; d += 64) { const float o = bf2f(OUT[(size_t)r * D + d]); ss += o * o; } ss = wave_sum(ss); const float rstd1 = rsqrtf(ss / D + EPS);
    bad = 0;
    if (L == 0) { const float* x = h0row(a, r); for (int d = lane; d < D; d += 64) { const float ref = x[d] + mod[2 * D + d] * (bf2f(OUT[(size_t)r * D + d]) * rstd1 * ng[D + d]); bad += !dclose(HRES[(size_t)r * D + d], ref, 1e-3f, 1e-3f); } }
    float s2 = 0; for (int d = lane; d < D; d += 64) { const float x = HRES[(size_t)r * D + d]; s2 += x * x; } s2 = wave_sum(s2); const float rstd2 = rsqrtf(s2 / D + EPS);
    for (int d = lane; d < D; d += 64) { const float f = HRES[(size_t)r * D + d] * rstd2 * ng[2 * D + d] * (1.f + mod[4 * D + d]) + mod[3 * D + d]; fsh[wv][d] = f; bad += !dclose(dq8((const unsigned char*)AB + (size_t)r * D, d), f, 0.07f, 0.01f); }
    bad = (int)wave_sum((float)bad); dflag(dg, L == 0 ? 9 : 20, bad, lane);
    __syncthreads();
    float lg = 0; for (int d = 0; d < D; ++d) lg += fsh[wv][d] * a.in[19][((size_t)L * D + d) * NE + lane];
    const float sc = sigmoidf_(lg); csh[wv][lane] = sc + a.in[20][L * NE + lane];
    __syncthreads();
    { const float plg = ((const float*)(a.ws + WS_Y))[(size_t)r * 64 + lane]; int lb = !dclose(plg, lg, 1e-3f, 1e-3f); lb = (int)wave_sum((float)lb); if (lane == 0 && lb) { atomicAdd(&dg[32 + (L == 0 ? 10 : 21) + 3], 1); atomicOr(&dg[60], 1 << (r & 7)); } }
    unsigned long long wsel;
    { const float choice = csh[wv][lane]; int rank = 0; const int gl = lane & 7;
      for (int j = 0; j < 8; ++j) { const float o = __shfl(choice, (lane & ~7) | j); rank += (o > choice || (o == choice && j < gl)) ? 1 : 0; }
      float gs = rank < 2 ? choice : 0.f; gs += __shfl_xor(gs, 1); gs += __shfl_xor(gs, 2); gs += __shfl_xor(gs, 4);
      int grank = 0; const int g = lane >> 3;
      for (int j = 0; j < 8; ++j) { const float o = __shfl(gs, j * 8); grank += (o > gs || (o == gs && j < g)) ? 1 : 0; }
      const bool gsel = grank < 4; const float mc = gsel ? choice : -INFINITY; int erank = 0;
      for (int j = 0; j < 64; ++j) { const float o = __shfl(mc, j); erank += (o > mc || (o == mc && j < lane)) ? 1 : 0; }
      wsel = __ballot(gsel && erank < 8); }
    int setbad = 0;
    if (lane == 0) {
      float gsc[8]; for (int g = 0; g < 8; ++g) { float m1 = -1e30f, m2 = -1e30f; for (int j = 0; j < 8; ++j) { const float v = csh[wv][g * 8 + j]; if (v > m1) { m2 = m1; m1 = v; } else if (v > m2) m2 = v; } gsc[g] = m1 + m2; }
      bool gs[8] = {false, false, false, false, false, false, false, false};
      for (int t = 0; t < 4; ++t) { int bi = 0; float bv = -1e30f; for (int g = 0; g < 8; ++g) if (!gs[g] && gsc[g] > bv) { bv = gsc[g]; bi = g; } gs[bi] = true; }
      unsigned long long selm = 0; for (int t = 0; t < 8; ++t) { int bi = 0; float bv = -1e30f; for (int e = 0; e < 64; ++e) if (gs[e >> 3] && !((selm >> e) & 1ull) && csh[wv][e] > bv) { bv = csh[wv][e]; bi = e; } selm |= 1ull << bi; }
      unsigned long long got = 0; for (int t = 0; t < 8; ++t) { const int e = top_e[r * 8 + t]; if (e < 0 || e > 63) setbad = 1000; else got |= 1ull << e; }
      if (setbad == 0 && got != selm) setbad = 1;
      if (wsel != selm) atomicAdd(&dg[32 + (L == 0 ? 10 : 21) + 4], 1);
    }
    setbad = __shfl(setbad, 0);
    { float wgot = -1.f; int mine = 0; for (int t = 0; t < 8; ++t) if (top_e[r * 8 + t] == lane) { mine = 1; wgot = top_w[r * 8 + t]; }
      const float ssum = wave_sum(mine ? sc : 0.f);
      int wbad = (mine && !dclose(wgot, sc / ssum * 2.5f, 0.01f, 1e-3f)) ? 1 : 0; wbad = (int)wave_sum((float)wbad);
      if (lane == 0) { int* q = &dg[32 + (L == 0 ? 10 : 21)]; if (setbad >= 1000) atomicAdd(q + 1, 1); else if (setbad) atomicAdd(q, 1); else if (wbad) atomicAdd(q + 2, 1); } }
  } else if (k == 7 || k == 17) {
    const int r = pick_row(h, ROW0, NTOK), t = h2 % 8, q = r * 8 + t; const int slot = tslot[q], e = top_e[q];
    int ts0 = 0; for (int j = 0; j < e; ++j) ts0 += (counts[j] + 255) >> 8;
    bad = (slot < ts0 * 256 || slot >= ts0 * 256 + counts[e] || stok[slot] != r || top_p[q] != slot - ts0 * 256) ? 1 : 0;
    bad += (stok[SH_BASE + r - ROW0] != r) ? 1 : 0;
    dflag(dg, L == 0 ? 11 : 22, bad, lane);
  } else if (k == 8 || k == 18 || k == 9 || k == 19) {
    int TR = 0; for (int j = 0; j < 64; ++j) TR += (counts[j] + 255) >> 8;
    int slot, e;
    if ((h & 3) == 0) { slot = SH_BASE + (int)((h >> 2) % (unsigned)NTOK); e = 64; }
    else { e = (h >> 2) % 64; int guard = 0; while (counts[e] == 0 && guard++ < 64) e = (e + 1) % 64; int ts0 = 0; for (int j = 0; j < e; ++j) ts0 += (counts[j] + 255) >> 8;
      const unsigned m = (h >> 8) % 4; const int cnt = counts[e]; const int p = m == 0 ? 0 : m == 1 ? cnt - 1 : (int)((h >> 10) % (unsigned)cnt); slot = ts0 * 256 + p; }
    const int tok = stok[slot];
    if (k == 8 || k == 18) {
      const int ch = h2 % EFF;
      const float* Wg = e < 64 ? a.in[21] + ((size_t)L * 64 + e) * D * EFF : a.in[24] + (size_t)L * D * EFF;
      const float* Wu = e < 64 ? a.in[22] + ((size_t)L * 64 + e) * D * EFF : a.in[25] + (size_t)L * D * EFF;
      const unsigned char* F8 = (const unsigned char*)AB + (size_t)tok * D;
      const float gv = wdot8(F8, Wg, EFF, ch, D, lane), uv = wdot8(F8, Wu, EFF, ch, D, lane);
      bad = !dclose(dq8((const unsigned char*)ACT + (size_t)slot * EFF, ch), gv * sigmoidf_(gv) * uv, 0.2f, 0.15f); dflag(dg, L == 0 ? 12 : 23, bad, lane);
    } else {
      const int c = h2 % D; const float* Wd = e < 64 ? a.in[23] + ((size_t)L * 64 + e) * EFF * D : a.in[26] + (size_t)L * EFF * D;
      const float ref = wdot8((const unsigned char*)ACT + (size_t)slot * EFF, Wd, D, c, EFF, lane);
      bad = !dclose(dq8((const unsigned char*)Y + (size_t)slot * D, c) * (1.f / 16.f), ref, 0.2f, 0.15f); dflag(dg, L == 0 ? 13 : 24, bad, lane);
    }
  } else if (k == 10 || k == 20) {
    const int r = pick_row(h, ROW0, NTOK); const float* mod = MOD + (size_t)(L * 2) * 12288 + (r < CTXL ? 12288 : 0); const float* ng = a.in[6] + (size_t)L * 4 * D;
    float ss = 0; for (int d = lane; d < D; d += 64) { const unsigned char* Y8 = (const unsigned char*)Y; float y = dq8(Y8 + (size_t)(SH_BASE + r - ROW0) * D, d) * (1.f / 16.f); for (int t = 0; t < 8; ++t) y += top_w[r * 8 + t] * dq8(Y8 + (size_t)tslot[r * 8 + t] * D, d) * (1.f / 16.f); fsh[wv][d] = y; ss += y * y; }
    ss = wave_sum(ss); const float rstd = rsqrtf(ss / D + EPS);
    bad = 0;
    if (L == 0) { float s2 = 0; for (int d = lane; d < D; d += 64) { const float x = HRES[(size_t)r * D + d]; s2 += x * x; } s2 = wave_sum(s2); const float rstd2 = rsqrtf(s2 / D + EPS);
      const float* mod1 = MOD + (size_t)2 * 12288 + (r < CTXL ? 12288 : 0);
      for (int d = lane; d < D; d += 64) { const float ref = HRES[(size_t)r * D + d] * rstd2 * a.in[6][4 * D + d] * (1.f + mod1[D + d]) + mod1[d]; bad += !dclose(bf2f(AB[(size_t)r * D + d]), ref, 0.01f, 0.01f); } }
    else { for (int d = lane; d < D; d += 64) { const float ref = HRES[(size_t)r * D + d] + mod[5 * D + d] * (fsh[wv][d] * rstd * ng[3 * D + d]); bad += !dclose(a.out[(size_t)(r - CTXL) * D + d], ref, 1e-3f, 1e-3f); } }
    bad = (int)wave_sum((float)bad); dflag(dg, L == 0 ? 14 : 25, bad, lane);
  } else if (k == 12) {
    const int r = pick_row(h, CTXL, SEQ), hh = h2 % 32;
    float raw0 = 0, raw1 = 0;
    for (int d = 0; d < 128; ++d) { const float v = wdot(AB + (size_t)r * D, a.in[15], N_IN1, hh * 128 + d, D, lane); if (d == lane) raw0 = v; if (d == lane + 64) raw1 = v; }
    float cs, sn; rope_cs(r, lane, cs, sn);
    const float cs0 = __shfl(cs, lane & 31), sn0 = __shfl(sn, lane & 31), cs1 = __shfl(cs, 32 + (lane & 31)), sn1 = __shfl(sn, 32 + (lane & 31));
    const float p0 = __shfl_xor(raw0, 32), p1 = __shfl_xor(raw1, 32);
    const float o0 = (lane < 32) ? raw0 * cs0 - p0 * sn0 : raw0 * cs0 + p0 * sn0;
    const float o1 = (lane < 32) ? raw1 * cs1 - p1 * sn1 : raw1 * cs1 + p1 * sn1;
    bad = !dclose(bf2f(QK[(size_t)r * N_IN1 + hh * 128 + lane]), o0, 0.03f, 0.05f) + !dclose(bf2f(QK[(size_t)r * N_IN1 + hh * 128 + 64 + lane]), o1, 0.03f, 0.05f);
    bad = (int)wave_sum((float)bad); dflag(dg, 16, bad, lane);
  } else if (k == 13) {
    if (gw < 64) { const int r = pick_row(h, CTXL, SEQ), hc = h2 % 16, vh = (h2 >> 4) & 1, hd = hc >> 1;
      float o0, o1; naive_attn(QK + (size_t)r * N_IN1 + hc * 128, QK + 2048 + hc * 128, QK + 4096 + hd * 256 + vh * 128, N_IN1, MT, lane, o0, o1);
      const bf16_t* O = Y + (size_t)(r - CTXL) * 4096 + hc * 256 + vh * 128;
      bad = !dclose(bf2f(O[lane]), o0, 0.05f, 0.01f) + !dclose(bf2f(O[64 + lane]), o1, 0.05f, 0.01f);
      bad = (int)wave_sum((float)bad); dflag(dg, 17, bad, lane); }
  } else if (k == 14) {
    const int r = pick_row(h, CTXL, SEQ), hd = h2 % 8; const float* lp = a.in[17];
    float s1 = 0, s2 = 0; for (int i = lane; i < 128; i += 64) { s1 += lp[i] * lp[128 + i]; s2 += lp[256 + i] * lp[384 + i]; } s1 = wave_sum(s1); s2 = wave_sum(s2);
    const float lam = expf(s1) - expf(s2) + LAM_INIT; const bf16_t* O = Y + (size_t)(r - CTXL) * 4096;
    float dv[4], ss = 0; for (int i = 0; i < 4; ++i) { const int d = lane + 64 * i; dv[i] = bf2f(O[(2 * hd) * 256 + d]) - lam * bf2f(O[(2 * hd + 1) * 256 + d]); ss += dv[i] * dv[i]; }
    ss = wave_sum(ss); const float rstd = rsqrtf(ss / 256.f + EPS) * (1.f - LAM_INIT); bad = 0;
    for (int i = 0; i < 4; ++i) { const int d = lane + 64 * i; bad += !dclose(bf2f(X2[(size_t)r * D + hd * 256 + d]), dv[i] * rstd * a.in[18][d], 0.02f, 0.01f); }
    bad = (int)wave_sum((float)bad); dflag(dg, 18, bad, lane);
  }
}
__global__ void diag_encode(Args a) {
  const int* dg = (const int*)(a.ws + WS_CTL + CTL_CNT + 512);
  int s = 0;
  int sub = 0;
  for (int i = 1; i < 32; ++i) { int v = dg[i]; if (i == 10 || i == 21) { v = (dg[32 + i] > 25 ? 1 : 0) + (dg[33 + i] > 0 ? 2 : 0) + (dg[34 + i] > 0 ? 4 : 0) + (dg[35 + i] > 0 ? 8 : 0) + (dg[36 + i] > 0 ? 16 : 0); sub = v; } if (v) { s = i; break; } }
  if (s == 0) return;
  const float c = sub ? 30.f + 8.f * sub : 10.f * s;
  for (size_t i = (size_t)blockIdx.x * blockDim.x + threadIdx.x; i < (size_t)SEQ * D; i += (size_t)gridDim.x * blockDim.x) a.out[i] = c;
}
#endif

extern "C" void kernel_launch(void* const* d_in, const int* in_sizes, int n_in, void* d_out, int out_size, void* d_ws, size_t ws_size, hipStream_t stream) {
  static int grid = 0;
  if (grid == 0) {
    if (n_in != 27 || out_size != SEQ * D || ws_size < WS_END) { fprintf(stderr, "kernel_launch: unexpected shapes (n_in %d out %d ws %zu need %zu)\n", n_in, out_size, ws_size, (size_t)WS_END); grid = -1; return; }
    if (hipFuncSetAttribute((const void*)fwd, hipFuncAttributeMaxDynamicSharedMemorySize, LDS_BYTES) != hipSuccess) { fprintf(stderr, "kernel_launch: hipFuncSetAttribute failed\n"); grid = -1; return; }
    int dev = 0, cus = 0, per_cu = 0;
    hipGetDevice(&dev); hipDeviceGetAttribute(&cus, hipDeviceAttributeMultiprocessorCount, dev);
    if (hipOccupancyMaxActiveBlocksPerMultiprocessor(&per_cu, (const void*)fwd, NTHREADS, LDS_BYTES) != hipSuccess || per_cu < 1) fprintf(stderr, "kernel_launch: occupancy query says %d\n", per_cu);
    (void)hipGetLastError();
    grid = cus < 256 ? cus : 256;
    if (grid != 256) fprintf(stderr, "kernel_launch: %d CUs (expected 256)\n", cus);
  }
  if (grid < 0) return;
  hipMemsetAsync((char*)d_ws + WS_CTL, 0, CTL_BYTES, stream);
  Args a{};
  for (int i = 0; i < 27; ++i) a.in[i] = (const float*)d_in[i];
  a.out = (float*)d_out; a.ws = (unsigned char*)d_ws;
#if MK_MULTI
  for (int k = 0; k < NPH; ++k) { a.ph_lo = k; a.ph_hi = k + 1; hipLaunchKernelGGL(fwd, dim3(grid), dim3(NTHREADS), LDS_BYTES, stream, a);
#if MK_DIAG
    hipLaunchKernelGGL(diag, dim3(64), dim3(256), 0, stream, a, k);
#endif
  }
#if MK_DIAG
  hipLaunchKernelGGL(diag_encode, dim3(1024), dim3(256), 0, stream, a);
#endif
#else
  a.ph_lo = 0; a.ph_hi = NPH;
  hipLaunchKernelGGL(fwd, dim3(grid), dim3(NTHREADS), LDS_BYTES, stream, a);
#endif
  const hipError_t le = hipPeekAtLastError();
  if (le != hipSuccess) fprintf(stderr, "kernel_launch: launch failed: %s\n", hipGetErrorName(le));
}
```

```cpp
#include <hip/hip_runtime.h>
#include <cstdio>
#include <cstdint>

#define MK_DIAG 0
#define ATT_VAR 0
#define GEMM_VAR 0
#ifndef DENSE8_G1
#define DENSE8_G1 1
#endif
#ifndef DENSE8_G2
#define DENSE8_G2 1
#endif
#ifndef MK_MULTI
#define MK_MULTI 0
#endif

#define LAS __attribute__((address_space(3)))
typedef unsigned short bf16_t;
typedef short bf16x8 __attribute__((ext_vector_type(8)));
typedef short s16x4 __attribute__((ext_vector_type(4)));
typedef float f32x4 __attribute__((ext_vector_type(4)));
typedef float f32x2 __attribute__((ext_vector_type(2)));
typedef float f32x16 __attribute__((ext_vector_type(16)));
typedef unsigned u32x4 __attribute__((ext_vector_type(4)));
typedef unsigned u32x2 __attribute__((ext_vector_type(2)));

constexpr int D = 2048, SEQ = 16384, CTXL = 256, MT = SEQ + CTXL;
constexpr int NE = 64, TOPK = 8, EFF = 512;
constexpr int N_IN0 = 3584, N_QKV0 = 1536, N_IN1 = 6144;
constexpr float EPS = 1e-6f;
constexpr float LAM_INIT = 0.35550907f;
constexpr int SH_BASE = SEQ * 0 + (MT * TOPK) + NE * 256;
constexpr int NSLOT = SH_BASE + MT;
constexpr int NTHREADS = 512;
constexpr int LDS_BYTES = 131072 + 1024;
constexpr int LDS_CTL = 131072;

constexpr size_t al256(size_t x) { return (x + 255) & ~(size_t)255; }
constexpr size_t WS_CTL   = 0;
constexpr size_t CTL_BYTES = 32768;
constexpr size_t CTL_CNT  = 16384;
constexpr size_t CTL_KMAX = 16384 + 2048;
constexpr size_t WS_MOD   = CTL_BYTES;
constexpr size_t WS_WIN0  = al256(WS_MOD + 2 * 2 * 12288 * 4);
constexpr size_t WS_WOUT0 = al256(WS_WIN0 + (size_t)N_IN0 * D * 2);
constexpr size_t WS_WIN1  = al256(WS_WOUT0 + (size_t)D * D * 2);
constexpr size_t WS_WOUT1 = al256(WS_WIN1 + (size_t)N_IN1 * D * 2);
constexpr size_t WMOE_E   = (size_t)1024 * D + (size_t)D * EFF;
constexpr size_t WS_WMOE  = al256(WS_WOUT1 + (size_t)D * D * 2);
constexpr size_t WS_HRES  = al256(WS_WMOE + 65 * WMOE_E * 2);
constexpr size_t WS_ABUF  = al256(WS_HRES + (size_t)MT * D * 4);
constexpr size_t WS_QKVU  = al256(WS_ABUF + (size_t)MT * D * 2);
constexpr size_t WS_HG    = al256(WS_QKVU + (size_t)MT * N_IN1 * 2);
constexpr size_t WS_X2    = al256(WS_HG + (size_t)MT * 1024 * 2);
constexpr size_t WS_OUT   = al256(WS_X2 + (size_t)MT * D * 2);
constexpr size_t WS_ACT   = al256(WS_OUT + (size_t)MT * D * 2);
constexpr size_t WS_K8    = WS_ACT + al256((size_t)NSLOT * EFF);
constexpr size_t V8T0_OFF = (size_t)8 << 20;
constexpr size_t WS_Y     = al256(WS_ACT + (size_t)NSLOT * EFF * 2);
constexpr int ECAP = MT;
constexpr size_t WS_ELIST = al256(WS_Y + (size_t)NSLOT * D);
constexpr size_t WS_RT    = al256(WS_ELIST + (size_t)64 * ECAP * 4);
constexpr size_t WS_TOPE  = al256(WS_Y + (size_t)NSLOT * D * 2);
constexpr size_t WS_TOPW  = al256(WS_TOPE + (size_t)MT * TOPK * 4);
constexpr size_t WS_TOPP  = al256(WS_TOPW + (size_t)MT * TOPK * 4);
constexpr size_t WS_TSLOT = al256(WS_TOPP + (size_t)MT * TOPK * 4);
constexpr size_t WS_STOK  = al256(WS_TSLOT + (size_t)MT * TOPK * 4);
constexpr size_t WS_END   = al256(WS_STOK + (size_t)NSLOT * 4);

struct Args { const float* in[27]; float* out; unsigned char* ws; int ph_lo, ph_hi; };

__device__ __forceinline__ float bflo(unsigned x) { return __uint_as_float(x << 16); }
__device__ __forceinline__ float bfhi(unsigned x) { return __uint_as_float(x & 0xffff0000u); }
__device__ __forceinline__ float bf2f(bf16_t b) { return __uint_as_float(((unsigned)b) << 16); }
__device__ __forceinline__ unsigned cvtpk(float lo, float hi) { unsigned r; asm("v_cvt_pk_bf16_f32 %0, %1, %2" : "=v"(r) : "v"(lo), "v"(hi)); return r; }
__device__ __forceinline__ bf16_t f2bf(float x) { return (bf16_t)(cvtpk(x, 0.f) & 0xffffu); }
__device__ __forceinline__ float wave_sum(float v) {
#pragma unroll
  for (int o = 32; o; o >>= 1) v += __shfl_xor(v, o);
  return v;
}
__device__ __forceinline__ float sigmoidf_(float x) { return 1.f / (1.f + expf(-x)); }
__device__ __forceinline__ float sigmoid_fast(float x) { return __builtin_amdgcn_rcpf(1.f + __builtin_amdgcn_exp2f(-1.4426950408889634f * x)); }

__device__ __forceinline__ float clamp8e(float x) { return fminf(fmaxf(x, -448.f), 448.f); }
__device__ __forceinline__ unsigned pack8x4(float a, float b, float c, float d) {
  int p = __builtin_amdgcn_cvt_pk_fp8_f32(clamp8e(a), clamp8e(b), 0, false); p = __builtin_amdgcn_cvt_pk_fp8_f32(clamp8e(c), clamp8e(d), p, true); return (unsigned)p; }
__device__ __forceinline__ float sq8x4(unsigned p) {
  const float a = __builtin_amdgcn_cvt_f32_fp8((int)p, 0), b = __builtin_amdgcn_cvt_f32_fp8((int)p, 1), c = __builtin_amdgcn_cvt_f32_fp8((int)p, 2), d = __builtin_amdgcn_cvt_f32_fp8((int)p, 3);
  return a * a + b * b + c * c + d * d; }
typedef int v8i_ __attribute__((ext_vector_type(8)));
typedef int v4i __attribute__((ext_vector_type(4)));
#define XB_TMO      128
#define XB_XCNT(j)  (256  + 64 * (j))
#define XB_XSUB(j)  (1280 + 64 * (j))
#define XB_XGEN(j)  (2304 + 64 * (j))
#define XB_TOP      3328
#define XB_TOPGEN   3392
#define XCD_BAR_WORDS 3456
#define XB_SPIN_CAP (1u << 22)
__device__ __forceinline__ unsigned xb_ld(unsigned* p)              { return __hip_atomic_load(p, __ATOMIC_RELAXED, __HIP_MEMORY_SCOPE_AGENT); }
__device__ __forceinline__ unsigned xb_add(unsigned* p, unsigned v) { return __hip_atomic_fetch_add(p, v, __ATOMIC_RELAXED, __HIP_MEMORY_SCOPE_AGENT); }
__device__ __forceinline__ unsigned xb_xcc_id() { return (unsigned)__builtin_amdgcn_s_getreg((3 << 11) | 20) & 0xFu; }
#define XB_SPIN(cond, bar) do { unsigned _sp = 0; while (cond) { __builtin_amdgcn_s_sleep(1); \
    if ((++_sp & 255u) == 0u) { if (xb_ld(&(bar)[XB_TMO])) break; if (_sp > XB_SPIN_CAP) { atomicAdd(&(bar)[XB_TMO], 1u); break; } } } } while (0)
struct XcdBarrier { unsigned* bar; unsigned x; volatile LAS unsigned* st; };
__device__ __forceinline__ XcdBarrier xcd_barrier_post(unsigned* bar, volatile LAS unsigned* st) {
    XcdBarrier b; b.bar = bar; b.x = xb_xcc_id(); b.st = st;
    if (threadIdx.x == 0) (void)xb_add(&bar[XB_XCNT(b.x)], 1u);
    return b;
}
__device__ __forceinline__ void xcd_barrier_complete(unsigned* bar, unsigned x, unsigned& nloc, unsigned& nx) {
    const unsigned G = gridDim.x * gridDim.y * gridDim.z;
    unsigned sum, cnt, mine, sp = 0u;
    for (;;) {
        sum = 0u; cnt = 0u; mine = 0u;
#pragma unroll
        for (unsigned j = 0; j < 16; ++j) { const unsigned c = xb_ld(&bar[XB_XCNT(j)]); sum += c; cnt += (c > 0u) ? 1u : 0u; mine = (j == x) ? c : mine; }
        if (sum == G) break;
        __builtin_amdgcn_s_sleep(1);
        if ((++sp & 255u) == 0u) { if (xb_ld(&bar[XB_TMO])) break; if (sp > XB_SPIN_CAP) { atomicAdd(&bar[XB_TMO], 1u); break; } }
    }
    nloc = mine > 0u ? mine : 1u; nx = cnt > 0u ? cnt : 1u;
}
__device__ __forceinline__ void xcd_barrier(const XcdBarrier& b) {
    asm volatile("s_waitcnt vmcnt(0)" ::: "memory");
    __syncthreads();
    if (threadIdx.x == 0) {
        unsigned* bar = b.bar;
        __builtin_amdgcn_s_waitcnt(0);
        unsigned nloc = b.st[0], nx = b.st[1];
        if (nloc == 0u) { xcd_barrier_complete(bar, b.x, nloc, nx); b.st[0] = nloc; b.st[1] = nx; }
        const unsigned old = xb_add(&bar[XB_XSUB(b.x)], 1u);
        const unsigned gen = old / nloc;
        if (old + 1u == (gen + 1u) * nloc) {
            __builtin_amdgcn_fence(__ATOMIC_RELEASE, "agent");
            asm volatile("s_waitcnt vmcnt(0)" ::: "memory");
            const unsigned og = xb_add(&bar[XB_TOP], 1u);
            const unsigned tg = og / nx;
            if (og + 1u == (tg + 1u) * nx) xb_add(&bar[XB_TOPGEN], 1u);
            else XB_SPIN(xb_ld(&bar[XB_TOPGEN]) == tg, bar);
            __builtin_amdgcn_fence(__ATOMIC_ACQUIRE, "agent");
            xb_add(&bar[XB_XGEN(b.x)], 1u);
            asm volatile("s_waitcnt vmcnt(0)" ::: "memory");
        } else {
            XB_SPIN(xb_ld(&bar[XB_XGEN(b.x)]) == gen, bar);
            __builtin_amdgcn_fence(__ATOMIC_ACQUIRE, "agent");
            asm volatile("s_waitcnt vmcnt(0)" ::: "memory");
        }
    }
    __syncthreads();
}

__device__ __forceinline__ int lds_byte(int r, int c) {
  int st = (r >> 4) * 2 + (c >> 5), rr = r & 15, cc = c & 31, ob = rr * 64 + cc * 2;
  return st * 1024 + (ob ^ (((ob >> 9) & 1) << 5));
}
#define GLDS(gp, lp) __builtin_amdgcn_global_load_lds((const unsigned*)(gp), (LAS unsigned*)(lp), 16, 0, 0)
#define WAIT_V(n) asm volatile("s_waitcnt vmcnt(" #n ")" ::: "memory")
#define WAIT_L(n) asm volatile("s_waitcnt lgkmcnt(" #n ")" ::: "memory")
#define BAR __builtin_amdgcn_s_barrier()
#define SCHED __builtin_amdgcn_sched_barrier(0)

template <bool GATHER, class Epi>
__device__ __forceinline__ void gemm_tile(const bf16_t* __restrict__ A, const int lda, const int* __restrict__ tok, const int brow,
                                          const bf16_t* __restrict__ Bt, const int ldb, const int bcol, const int K,
                                          LAS char* shm, const Epi& epi) {
#define G_SA(b, h) (shm + ((b) * 2 + (h)) * 16384)
#define G_SB(b, h) (shm + (4 + (b) * 2 + (h)) * 16384)
  int tid = threadIdx.x; asm volatile("" : "+v"(tid)); tid &= 511;
  int wid = tid >> 6, lane = tid & 63, wr = wid >> 2, wc = wid & 3, fr = lane & 15, fq = lane >> 4;
  unsigned ao0, ao1, ao2, ao3, bo;
  {
    const int sb = (tid & 63) * 16, swz = sb ^ (((sb >> 9) & 1) << 5);
    const int R0 = ((tid >> 6) >> 1) * 16 + (swz >> 6), C0 = ((tid >> 6) & 1) * 32 + ((swz & 63) >> 1);
    if (GATHER) { ao0 = (unsigned)(tok[R0] * lda + C0); ao1 = (unsigned)(tok[R0 + 64] * lda + C0); ao2 = (unsigned)(tok[R0 + 128] * lda + C0); ao3 = (unsigned)(tok[R0 + 192] * lda + C0); }
    else { ao0 = (unsigned)((brow + R0) * lda + C0); ao1 = ao0 + 64u * lda; ao2 = ao0 + 128u * lda; ao3 = ao0 + 192u * lda; }
    bo = (unsigned)((bcol + R0) * ldb + C0);
  }
  const int lo = __builtin_amdgcn_readfirstlane(tid >> 6) * 1024;
#define STAGE_A0(P, kt) do { GLDS((A + (kt) * 64) + ao0, (P) + lo); GLDS((A + (kt) * 64) + ao1, (P) + lo + 8192); } while (0)
#define STAGE_A1(P, kt) do { GLDS((A + (kt) * 64) + ao2, (P) + lo); GLDS((A + (kt) * 64) + ao3, (P) + lo + 8192); } while (0)
#define STAGE_B0(P, kt) do { GLDS((Bt + (kt) * 64) + bo, (P) + lo); GLDS((Bt + 64 * ldb + (kt) * 64) + bo, (P) + lo + 8192); } while (0)
#define STAGE_B1(P, kt) do { GLDS((Bt + 128 * ldb + (kt) * 64) + bo, (P) + lo); GLDS((Bt + 192 * ldb + (kt) * 64) + bo, (P) + lo + 8192); } while (0)
#define LDA(dst, b, h) _Pragma("unroll") for (int m = 0; m < 4; ++m) _Pragma("unroll") for (int k = 0; k < 2; ++k) \
    dst[m][k] = *(LAS const bf16x8*)(G_SA(b, h) + lds_byte(wr * 64 + m * 16 + fr, k * 32 + fq * 8))
#define LDB(dst, b, h) _Pragma("unroll") for (int n = 0; n < 2; ++n) _Pragma("unroll") for (int k = 0; k < 2; ++k) \
    dst[n][k] = *(LAS const bf16x8*)(G_SB(b, h) + lds_byte(wc * 32 + n * 16 + fr, k * 32 + fq * 8))
#define MMA(ai, bj, At_, Bt_) do { __builtin_amdgcn_s_setprio(1); \
    _Pragma("unroll") for (int m = 0; m < 4; ++m) _Pragma("unroll") for (int n = 0; n < 2; ++n) _Pragma("unroll") for (int k = 0; k < 2; ++k) \
      acc[ai][bj][m][n] = __builtin_amdgcn_mfma_f32_16x16x32_bf16(Bt_[n][k], At_[m][k], acc[ai][bj][m][n], 0, 0, 0); \
    __builtin_amdgcn_s_setprio(0); } while (0)

  f32x4 acc[2][2][4][2] = {};
  bf16x8 At[4][2], B0[2][2], B1[2][2];
  const int nt = K / 64;
  STAGE_B0(G_SB(0, 0), 0); STAGE_A0(G_SA(0, 0), 0);
  STAGE_B1(G_SB(0, 1), 0); STAGE_A1(G_SA(0, 1), 0);
  if (wr == 1) BAR;
  WAIT_V(4); BAR;
  STAGE_B0(G_SB(1, 0), 1); STAGE_A0(G_SA(1, 0), 1); STAGE_B1(G_SB(1, 1), 1);
  WAIT_V(6); BAR;
  for (int t = 0; t < nt - 2; t += 2) {
    LDB(B0, 0, 0); SCHED; LDA(At, 0, 0); STAGE_A1(G_SA(1, 1), t + 1);
    WAIT_L(8); BAR; WAIT_L(0); MMA(0, 0, At, B0); BAR; SCHED;
    LDB(B1, 0, 1); STAGE_B0(G_SB(0, 0), t + 2);
    BAR; WAIT_L(0); MMA(0, 1, At, B1); BAR;
    LDA(At, 0, 1); STAGE_A0(G_SA(0, 0), t + 2);
    BAR; WAIT_L(0); MMA(1, 0, At, B0); BAR; SCHED;
    STAGE_B1(G_SB(0, 1), t + 2);
    WAIT_V(6); BAR; MMA(1, 1, At, B1); BAR;
    LDB(B0, 1, 0); SCHED; LDA(At, 1, 0); STAGE_A1(G_SA(0, 1), t + 2);
    WAIT_L(8); BAR; WAIT_L(0); MMA(0, 0, At, B0); BAR; SCHED;
    LDB(B1, 1, 1); STAGE_B0(G_SB(1, 0), t + 3);
    BAR; WAIT_L(0); MMA(0, 1, At, B1); BAR;
    LDA(At, 1, 1); STAGE_A0(G_SA(1, 0), t + 3);
    BAR; WAIT_L(0); MMA(1, 0, At, B0); BAR; SCHED;
    STAGE_B1(G_SB(1, 1), t + 3);
    WAIT_V(6); BAR; MMA(1, 1, At, B1); BAR;
  }
  { LDB(B0, 0, 0); WAIT_V(0); LDA(At, 0, 0); STAGE_A1(G_SA(1, 1), nt - 1);
    BAR; WAIT_L(0); MMA(0, 0, At, B0); BAR;
    LDB(B1, 0, 1); BAR; WAIT_L(0); MMA(0, 1, At, B1); BAR;
    LDA(At, 0, 1); WAIT_V(4); BAR; WAIT_L(0); MMA(1, 0, At, B0); MMA(1, 1, At, B1); BAR; }
  { LDB(B0, 1, 0); LDA(At, 1, 0); WAIT_V(2); BAR; WAIT_L(0); MMA(0, 0, At, B0); BAR;
    LDB(B1, 1, 1); WAIT_V(0); BAR; WAIT_L(0); MMA(0, 1, At, B1); BAR;
    LDA(At, 1, 1); BAR; WAIT_L(0); MMA(1, 0, At, B0); MMA(1, 1, At, B1); BAR; }
  if (wr == 0) BAR;
  int tz = threadIdx.x; asm volatile("" : "+v"(tz)); wid = tz >> 6; lane = tz & 63; wr = wid >> 2; wc = wid & 3; fr = lane & 15; fq = lane >> 4;
  epi(acc, brow, bcol, wr, wc, fr, fq);
#undef G_SA
#undef G_SB
#undef STAGE_A0
#undef SA0_1
#undef SA0_2
#undef SA1_1
#undef SA1_2
#undef SB0_1
#undef SB0_2
#undef SB1_1
#undef SB1_2
#undef MF1
#undef MMA_S
#undef STAGE_A1
#undef STAGE_B0
#undef STAGE_B1
#undef LDA
#undef LDB
#undef MMA
}

struct EpiPlain {     static constexpr int STAGE_ROWB = 0;
  bf16_t* C; int ldc; float sc;
  __device__ __forceinline__ void operator()(const f32x4 (&acc)[2][2][4][2], int brow, int bcol, int wr, int wc, int fr, int fq) const {
#pragma unroll
    for (int ai = 0; ai < 2; ++ai)
#pragma unroll
      for (int m = 0; m < 4; ++m) {
        bf16_t* rp = C + (size_t)(brow + ai * 128 + wr * 64 + m * 16 + fr) * ldc + bcol + wc * 32 + fq * 8;
#pragma unroll
        for (int bj = 0; bj < 2; ++bj) {
          u32x4 v = {cvtpk(acc[ai][bj][m][0][0] * sc, acc[ai][bj][m][0][1] * sc), cvtpk(acc[ai][bj][m][0][2] * sc, acc[ai][bj][m][0][3] * sc),
                     cvtpk(acc[ai][bj][m][1][0] * sc, acc[ai][bj][m][1][1] * sc), cvtpk(acc[ai][bj][m][1][2] * sc, acc[ai][bj][m][1][3] * sc)};
          *(u32x4*)(rp + bj * 128) = v;
        }
      }
  }
};
template <int MODE>
struct EpiPair {
  bf16_t* C; int ldc; int colbase; float sc;
  __device__ __forceinline__ void operator()(const f32x4 (&acc)[2][2][4][2], int brow, int bcol, int wr, int wc, int fr, int fq) const {
#pragma unroll
    for (int ai = 0; ai < 2; ++ai)
#pragma unroll
      for (int m = 0; m < 4; ++m) {
        bf16_t* rp = C + (size_t)(brow + ai * 128 + wr * 64 + m * 16 + fr) * ldc + ((bcol - colbase) >> 1) + wc * 16 + fq * 4;
#pragma unroll
        for (int bj = 0; bj < 2; ++bj) {
          float r[4];
#pragma unroll
          for (int j = 0; j < 4; ++j) {
            const float x0 = acc[ai][bj][m][0][j] * sc, x1 = acc[ai][bj][m][1][j] * sc;
            r[j] = MODE == 0 ? x0 * sigmoid_fast(x1) : x0 * sigmoid_fast(x0) * x1;
          }
          u32x2 v = {cvtpk(r[0], r[1]), cvtpk(r[2], r[3])};
          *(u32x2*)(rp + bj * 64) = v;
        }
      }
  }
};
struct EpiG1 {        static constexpr int STAGE_ROWB = 0;
  EpiPlain p; EpiPair<0> g; int nplain;
  __device__ __forceinline__ void operator()(const f32x4 (&acc)[2][2][4][2], int brow, int bcol, int wr, int wc, int fr, int fq) const {
    if (bcol < nplain) p(acc, brow, bcol, wr, wc, fr, fq); else g(acc, brow, bcol, wr, wc, fr, fq);
  }
};

typedef int v8i __attribute__((ext_vector_type(8)));
__device__ __forceinline__ int lds8(int r, int c) { return r * 128 + ((c ^ ((r >> 1) & 7)) << 4); }
#ifndef GEMM_VAR
#define GEMM_VAR 0
#endif
template <bool GATHER, int lda, int ldb, int K, int GV = 0, class Epi, class S>
__device__ __forceinline__ void gemm8_run(const unsigned char* __restrict__ A, const int* __restrict__ stok,
                                          LAS char* shm, const Epi& epi, const S& sched) {
#define G_SA(b, h) (shm + ((b) * 2 + (h)) * 16384)
#define G_SB(b, h) (shm + (4 + (b) * 2 + (h)) * 16384)
  int tid = threadIdx.x; asm volatile("" : "+v"(tid)); tid &= 511;
  int wid = tid >> 6, lane = tid & 63, wr = wid >> 2, wc = wid & 3, fr = lane & 15, fq = lane >> 4;
  unsigned ao0, ao1, ao2, ao3, bo;
  int R0 = 8 * wid + (lane >> 3), C0 = ((lane & 7) ^ ((R0 >> 1) & 7)) << 4;
  const int lo = __builtin_amdgcn_readfirstlane(tid >> 6) * 1024;
  int brow, bcol; const unsigned char* Bt;
  int ui = 0;
  if (!sched.unit(ui, brow, Bt, bcol)) return;
#define SETOFF(br, bc) do { if (GATHER) { const auto _g = sched.gather_tile(br); ao0 = (unsigned)(_g.tok(R0) * lda + C0); ao1 = (unsigned)(_g.tok(R0 + 64) * lda + C0); ao2 = (unsigned)(_g.tok(R0 + 128) * lda + C0); ao3 = (unsigned)(_g.tok(R0 + 192) * lda + C0); } \
    else { ao0 = (unsigned)(((br) + R0) * lda + C0); ao1 = ao0 + 64u * lda; ao2 = ao0 + 128u * lda; ao3 = ao0 + 192u * lda; } \
    bo = (unsigned)(((bc) + R0) * ldb + C0); } while (0)
#define SA0_1(P, kt) do { if (GV == 2) break; GLDS((A + (kt) * 128) + ao0, (P) + lo); } while (0)
#define SA0_2(P, kt) do { if (GV == 2) break; GLDS((A + (kt) * 128) + ao1, (P) + lo + 8192); } while (0)
#define SA1_1(P, kt) do { if (GV == 2) break; GLDS((A + (kt) * 128) + ao2, (P) + lo); } while (0)
#define SA1_2(P, kt) do { if (GV == 2) break; GLDS((A + (kt) * 128) + ao3, (P) + lo + 8192); } while (0)
#define SB0_1(P, kt) do { if (GV == 2) break; GLDS((Bt + (kt) * 128) + bo, (P) + lo); } while (0)
#define SB0_2(P, kt) do { if (GV == 2) break; GLDS((Bt + 64 * ldb + (kt) * 128) + bo, (P) + lo + 8192); } while (0)
#define SB1_1(P, kt) do { if (GV == 2) break; GLDS((Bt + 128 * ldb + (kt) * 128) + bo, (P) + lo); } while (0)
#define SB1_2(P, kt) do { if (GV == 2) break; GLDS((Bt + 192 * ldb + (kt) * 128) + bo, (P) + lo + 8192); } while (0)
#define STAGE_A0(P, kt) do { SA0_1(P, kt); SA0_2(P, kt); } while (0)
#define STAGE_A1(P, kt) do { SA1_1(P, kt); SA1_2(P, kt); } while (0)
#define STAGE_B0(P, kt) do { SB0_1(P, kt); SB0_2(P, kt); } while (0)
#define STAGE_B1(P, kt) do { SB1_1(P, kt); SB1_2(P, kt); } while (0)
#define PRO() do { STAGE_B0(G_SB(0, 0), 0); STAGE_A0(G_SA(0, 0), 0); STAGE_B1(G_SB(0, 1), 0); STAGE_A1(G_SA(0, 1), 0); } while (0)
  const int fx = (fq ^ ((fr >> 1) & 7)) << 4;
  const int fa0 = (wr * 64 + fr) * 128 + fx, fb0 = (wc * 32 + fr) * 128 + fx;
#define FRAG8(dst, p0, p1) do { const v4i _x = *(LAS const v4i*)(p0); const v4i _y = *(LAS const v4i*)(p1); \
    dst = (v8i){_x[0], _x[1], _x[2], _x[3], _y[0], _y[1], _y[2], _y[3]}; } while (0)
#define LDA(dst, b, h) do { int fa1 = fa0; asm volatile("v_xor_b32 %0, 64, %0" : "+v"(fa1)); \
    _Pragma("unroll") for (int m = 0; m < 4; ++m) FRAG8(dst[m], G_SA(b, h) + fa0 + m * 2048, G_SA(b, h) + fa1 + m * 2048); } while (0)
#define LDB(dst, b, h) do { int fb1 = fb0; asm volatile("v_xor_b32 %0, 64, %0" : "+v"(fb1)); \
    _Pragma("unroll") for (int n = 0; n < 2; ++n) FRAG8(dst[n], G_SB(b, h) + fb0 + n * 2048, G_SB(b, h) + fb1 + n * 2048); } while (0)
#define MF1(ai, bj, At_, Bt_, m, n) asm volatile("v_mfma_scale_f32_16x16x128_f8f6f4 %0, %1, %2, %0, %3, %3 op_sel_hi:[0,0,0]" : "+v"(acc[ai][bj][m][n]) : "v"(Bt_[n]), "v"(At_[m]), "v"(sc1))
#define MMA(ai, bj, At_, Bt_) do { __builtin_amdgcn_s_setprio(1); \
    _Pragma("unroll") for (int m = 0; m < 4; ++m) _Pragma("unroll") for (int n = 0; n < 2; ++n) MF1(ai, bj, At_, Bt_, m, n); \
    __builtin_amdgcn_s_setprio(0); } while (0)
#define MMA_S(ai, bj, At_, Bt_, ST1, ST2) do { __builtin_amdgcn_s_setprio(1); \
    MF1(ai, bj, At_, Bt_, 0, 0); MF1(ai, bj, At_, Bt_, 0, 1); SCHED; ST1; SCHED; \
    MF1(ai, bj, At_, Bt_, 1, 0); MF1(ai, bj, At_, Bt_, 1, 1); MF1(ai, bj, At_, Bt_, 2, 0); SCHED; ST2; SCHED; \
    MF1(ai, bj, At_, Bt_, 2, 1); MF1(ai, bj, At_, Bt_, 3, 0); MF1(ai, bj, At_, Bt_, 3, 1); \
    __builtin_amdgcn_s_setprio(0); } while (0)
  int sc1; asm volatile("v_mov_b32 %0, 0x7f7f7f7f" : "=v"(sc1));
  const int nt = K / 128;
  SETOFF(brow, bcol); PRO();
  bool first = true;
  for (;;) {
    f32x4 acc[2][2][4][2] = {};
    v8i At[4], B0[2], B1[2];
    if (wr == 1) BAR;
    constexpr int NST = (GV == 1 || GV == 2) ? 0 : (Epi::STAGE_ROWB == 256 ? 8 : (Epi::STAGE_ROWB == 128 ? 4 : 0));
    if (first) WAIT_V(4); else asm volatile("s_waitcnt vmcnt(%0)" :: "i"(NST) : "memory");
    BAR;
    STAGE_B0(G_SB(1, 0), 1); STAGE_A0(G_SA(1, 0), 1); STAGE_B1(G_SB(1, 1), 1);
    WAIT_V(6); BAR;
    static_assert(K >= 512, "the tail assumes the steady-state loop ran at least once");
    for (int t = 0; t < nt - 2; t += 2) {
      LDB(B0, 0, 0); SCHED; LDA(At, 0, 0);
      WAIT_L(8); BAR; WAIT_L(0); MMA_S(0, 0, At, B0, SA1_1(G_SA(1, 1), t + 1), SA1_2(G_SA(1, 1), t + 1)); BAR; SCHED;
      LDB(B1, 0, 1);
      BAR; WAIT_L(0); MMA_S(0, 1, At, B1, SB0_1(G_SB(0, 0), t + 2), SB0_2(G_SB(0, 0), t + 2)); BAR;
      LDA(At, 0, 1);
      BAR; WAIT_L(0); MMA_S(1, 0, At, B0, SA0_1(G_SA(0, 0), t + 2), SA0_2(G_SA(0, 0), t + 2)); BAR; SCHED;
      WAIT_V(4); BAR; MMA_S(1, 1, At, B1, SB1_1(G_SB(0, 1), t + 2), SB1_2(G_SB(0, 1), t + 2)); BAR;
      LDB(B0, 1, 0); SCHED; LDA(At, 1, 0);
      WAIT_L(8); BAR; WAIT_L(0); MMA_S(0, 0, At, B0, SA1_1(G_SA(0, 1), t + 2), SA1_2(G_SA(0, 1), t + 2)); BAR; SCHED;
      LDB(B1, 1, 1);
      BAR; WAIT_L(0); MMA_S(0, 1, At, B1, SB0_1(G_SB(1, 0), t + 3), SB0_2(G_SB(1, 0), t + 3)); BAR;
      LDA(At, 1, 1);
      BAR; WAIT_L(0); MMA_S(1, 0, At, B0, SA0_1(G_SA(1, 0), t + 3), SA0_2(G_SA(1, 0), t + 3)); BAR; SCHED;
      WAIT_V(4); BAR; MMA_S(1, 1, At, B1, SB1_1(G_SB(1, 1), t + 3), SB1_2(G_SB(1, 1), t + 3)); BAR;
    }
    { LDB(B0, 0, 0); LDA(At, 0, 0);
      BAR; WAIT_L(0); MMA_S(0, 0, At, B0, SA1_1(G_SA(1, 1), nt - 1), SA1_2(G_SA(1, 1), nt - 1)); BAR;
      LDB(B1, 0, 1); BAR; WAIT_L(0); MMA(0, 1, At, B1); BAR;
      LDA(At, 0, 1); WAIT_V(4); BAR; WAIT_L(0); MMA(1, 0, At, B0); MMA(1, 1, At, B1); BAR; }
    { LDB(B0, 1, 0); LDA(At, 1, 0); WAIT_V(2); BAR; WAIT_L(0); MMA(0, 0, At, B0); BAR;
      LDB(B1, 1, 1); WAIT_V(0); BAR; WAIT_L(0); MMA(0, 1, At, B1); BAR;
      LDA(At, 1, 1); BAR; WAIT_L(0); MMA(1, 0, At, B0); MMA(1, 1, At, B1); BAR; }
    if (wr == 0) BAR;
    const int cbrow = brow, cbcol = bcol;
    { int tz = threadIdx.x; asm volatile("" : "+v"(tz)); tz &= 511; wid = tz >> 6; lane = tz & 63; wr = wid >> 2; wc = wid & 3; fr = lane & 15; fq = lane >> 4;
      R0 = 8 * wid + (lane >> 3); C0 = ((lane & 7) ^ ((R0 >> 1) & 7)) << 4; }
    ++ui;
    const bool more = sched.unit(ui, brow, Bt, bcol);
    if (more) { SETOFF(brow, bcol); asm volatile("" ::: "memory"); PRO(); asm volatile("" ::: "memory"); }
    asm volatile("s_nop 15\n\ts_nop 15\n\ts_nop 7" ::: "memory");
#pragma unroll
    for (int i = 0; i < 32; ++i) asm volatile("" : "+v"((&acc[0][0][0][0])[i]));
    if (GV != 1 && GV != 2) {
      if constexpr (Epi::STAGE_ROWB == 256) {
#pragma unroll
        for (int ai = 0; ai < 2; ++ai)
#pragma unroll
          for (int m = 0; m < 4; ++m) { const int rloc = wr * 64 + m * 16 + fr;
#pragma unroll
            for (int bj = 0; bj < 2; ++bj) { const int c = wc * 2 + (fq >> 1) + bj * 8;
              *(LAS u32x2*)(shm + (ai ? 98304 : 32768) + rloc * 256 + ((c ^ (rloc & 15)) << 4) + (fq & 1) * 8) = epi.pack(acc, ai, m, bj); } }
        WAIT_L(0); BAR;
        unsigned char* Cb = epi.C + (size_t)cbrow * epi.ldc + epi.colbase(cbcol);
#pragma unroll
        for (int it = 0; it < 8; ++it) { const int row = it * 32 + wid * 4 + (lane >> 4), c = lane & 15, rloc = row & 127;
          const u32x4 v = *(LAS const u32x4*)(shm + (row & 128 ? 98304 : 32768) + rloc * 256 + ((c ^ (rloc & 15)) << 4));
          *(u32x4*)(Cb + (size_t)row * epi.ldc + c * 16) = v; }
      } else if constexpr (Epi::STAGE_ROWB == 128) {
#pragma unroll
        for (int ai = 0; ai < 2; ++ai)
#pragma unroll
          for (int m = 0; m < 4; ++m) { const int row = ai * 128 + wr * 64 + m * 16 + fr;
#pragma unroll
            for (int bj = 0; bj < 2; ++bj) { const int c = wc + 4 * bj;
              *(LAS unsigned*)(shm + 32768 + row * 128 + ((c ^ (row & 7)) << 4) + fq * 4) = epi.pack(acc, ai, m, bj); } }
        WAIT_L(0); BAR;
        unsigned char* Cb = epi.C + (size_t)cbrow * epi.ldc + epi.colbase(cbcol);
#pragma unroll
        for (int it = 0; it < 4; ++it) { const int row = it * 64 + wid * 8 + (lane >> 3), c = lane & 7;
          const u32x4 v = *(LAS const u32x4*)(shm + 32768 + row * 128 + ((c ^ (row & 7)) << 4));
          *(u32x4*)(Cb + (size_t)row * epi.ldc + c * 16) = v; }
      } else epi(acc, cbrow, cbcol, wr, wc, fr, fq);
    }
    if (!more) break;
    first = false;
  }
#undef G_SA
#undef G_SB
#undef SETOFF
#undef STAGE_A0
#undef STAGE_A1
#undef STAGE_B0
#undef STAGE_B1
#undef PRO
#undef FRAG8
#undef LDA
#undef LDB
#undef MMA
}
__device__ __forceinline__ float clamp8(float x) { return fminf(fmaxf(x, -448.f), 448.f); }
__device__ __forceinline__ unsigned pack_fp8x4(float a, float b, float c, float d) {
  int p = __builtin_amdgcn_cvt_pk_fp8_f32(clamp8(a), clamp8(b), 0, false); p = __builtin_amdgcn_cvt_pk_fp8_f32(clamp8(c), clamp8(d), p, true); return (unsigned)p; }
struct EpiSwiGLU8 {
  unsigned char* C; int ldc;
  static constexpr int STAGE_ROWB = 128;
  __device__ __forceinline__ int colbase(int bcol) const { return bcol >> 1; }
  __device__ __forceinline__ unsigned pack(const f32x4 (&acc)[2][2][4][2], int ai, int m, int bj) const {
    constexpr float S = 1.f / 256.f; float r[4];
#pragma unroll
    for (int j = 0; j < 4; ++j) { const float g = acc[ai][bj][m][0][j] * S, u = acc[ai][bj][m][1][j] * S; r[j] = g * sigmoid_fast(g) * u; }
    return pack_fp8x4(r[0], r[1], r[2], r[3]); }
  __device__ __forceinline__ void operator()(const f32x4 (&acc)[2][2][4][2], int brow, int bcol, int wr, int wc, int fr, int fq) const {
    constexpr float S = 1.f / 256.f;
#pragma unroll
    for (int ai = 0; ai < 2; ++ai)
#pragma unroll
      for (int m = 0; m < 4; ++m) {
        unsigned char* rp = C + (size_t)(brow + ai * 128 + wr * 64 + m * 16 + fr) * ldc + (bcol >> 1) + wc * 16 + fq * 4;
#pragma unroll
        for (int bj = 0; bj < 2; ++bj) {
          float r[4];
#pragma unroll
          for (int j = 0; j < 4; ++j) { const float g = acc[ai][bj][m][0][j] * S, u = acc[ai][bj][m][1][j] * S; r[j] = g * sigmoid_fast(g) * u; }
          *(unsigned*)(rp + bj * 64) = pack_fp8x4(r[0], r[1], r[2], r[3]);
        }
      }
  }
};
struct EpiPlain8 {
  unsigned char* C; int ldc; float sc;
  static constexpr int STAGE_ROWB = 256;
  __device__ __forceinline__ int colbase(int bcol) const { return bcol; }
  __device__ __forceinline__ u32x2 pack(const f32x4 (&acc)[2][2][4][2], int ai, int m, int bj) const {
    return (u32x2){pack_fp8x4(acc[ai][bj][m][0][0] * sc, acc[ai][bj][m][0][1] * sc, acc[ai][bj][m][0][2] * sc, acc[ai][bj][m][0][3] * sc),
                   pack_fp8x4(acc[ai][bj][m][1][0] * sc, acc[ai][bj][m][1][1] * sc, acc[ai][bj][m][1][2] * sc, acc[ai][bj][m][1][3] * sc)}; }
  __device__ __forceinline__ void operator()(const f32x4 (&acc)[2][2][4][2], int brow, int bcol, int wr, int wc, int fr, int fq) const {
#pragma unroll
    for (int ai = 0; ai < 2; ++ai)
#pragma unroll
      for (int m = 0; m < 4; ++m) {
        unsigned char* rp = C + (size_t)(brow + ai * 128 + wr * 64 + m * 16 + fr) * ldc + bcol + wc * 32 + fq * 8;
#pragma unroll
        for (int bj = 0; bj < 2; ++bj) {
          u32x2 v = {pack_fp8x4(acc[ai][bj][m][0][0] * sc, acc[ai][bj][m][0][1] * sc, acc[ai][bj][m][0][2] * sc, acc[ai][bj][m][0][3] * sc),
                     pack_fp8x4(acc[ai][bj][m][1][0] * sc, acc[ai][bj][m][1][1] * sc, acc[ai][bj][m][1][2] * sc, acc[ai][bj][m][1][3] * sc)};
          *(u32x2*)(rp + bj * 128) = v;
        }
      }
  }
};
struct EpiPlainS {
  bf16_t* C; int ldc; float sc;
  __device__ __forceinline__ void operator()(const f32x4 (&acc)[2][2][4][2], int brow, int bcol, int wr, int wc, int fr, int fq) const {
#pragma unroll
    for (int ai = 0; ai < 2; ++ai)
#pragma unroll
      for (int m = 0; m < 4; ++m) {
        bf16_t* rp = C + (size_t)(brow + ai * 128 + wr * 64 + m * 16 + fr) * ldc + bcol + wc * 32 + fq * 8;
#pragma unroll
        for (int bj = 0; bj < 2; ++bj) {
          u32x4 v = {cvtpk(acc[ai][bj][m][0][0] * sc, acc[ai][bj][m][0][1] * sc), cvtpk(acc[ai][bj][m][0][2] * sc, acc[ai][bj][m][0][3] * sc),
                     cvtpk(acc[ai][bj][m][1][0] * sc, acc[ai][bj][m][1][1] * sc), cvtpk(acc[ai][bj][m][1][2] * sc, acc[ai][bj][m][1][3] * sc)};
          *(u32x4*)(rp + bj * 128) = v;
        }
      }
  }
};

__device__ __forceinline__ void dense_unit(int u, int nM, int nN, int& pm, int& pn) {
  const int nwg = nM * nN, NX = 8, WGM = 8;
  int wgid = u;
  { const int q = nwg / NX, r = nwg % NX, xcd = wgid % NX, off = wgid / NX; wgid = (xcd < r ? xcd * (q + 1) : r * (q + 1) + (xcd - r) * q) + off; }
  const int nig = WGM * nN, gid = wgid / nig, fm = gid * WGM, gsz = min(nM - fm, WGM);
  pm = fm + ((wgid % nig) % gsz); pn = (wgid % nig) / gsz;
}

namespace at {
constexpr int DH = 128, NW = 8, QBLK = 32, KVBLK = 64;
constexpr float SCALE = 0.088388347648318440f;
constexpr float QC = SCALE * 1.4426950408889634f;
constexpr int SHM_V = KVBLK * DH * 2, SHM_K = KVBLK * DH * 2;
#define KSWZ(row, colB) ((row) * 256 + ((colB) ^ (((row) & 7) << 4)))
__device__ __forceinline__ int crow(int r, int hi) { return (r & 3) + 8 * (r >> 2) + 4 * hi; }
__device__ __forceinline__ unsigned cvtpkv(float lo, float hi) { unsigned r; asm volatile("v_cvt_pk_bf16_f32 %0, %1, %2" : "=v"(r) : "v"(lo), "v"(hi)); return r; }
#define PK4(P, BASE, OUT) do { unsigned a0 = cvtpkv(P[BASE + 0], P[BASE + 1]), a1 = cvtpkv(P[BASE + 2], P[BASE + 3]);   \
    unsigned b0 = cvtpkv(P[BASE + 4], P[BASE + 5]), b1 = cvtpkv(P[BASE + 6], P[BASE + 7]);                              \
    auto r0 = __builtin_amdgcn_permlane32_swap(a0, b0, false, false); auto r1 = __builtin_amdgcn_permlane32_swap(a1, b1, false, false); \
    u32x4 w = {r0[0], r1[0], r0[1], r1[1]}; OUT = *reinterpret_cast<bf16x8*>(&w); } while (0)
__device__ __forceinline__ float load_q(const bf16_t* __restrict__ Qw, bf16x8 (&qr)[8], float kmax2) {
  float ss = 0;
#pragma unroll
  for (int d0 = 0; d0 < 8; ++d0) {
    const u32x4 raw = *reinterpret_cast<const u32x4*>(Qw + d0 * 16); u32x4 o;
#pragma unroll
    for (int i = 0; i < 4; ++i) { const unsigned pk = cvtpk(bflo(raw[i]) * QC, bfhi(raw[i]) * QC); o[i] = pk; const float a = bflo(pk), b = bfhi(pk); ss += a * a + b * b; }
    qr[d0] = *reinterpret_cast<bf16x8*>(&o);
  }
  { auto rr = __builtin_amdgcn_permlane32_swap(__float_as_uint(ss), __float_as_uint(ss), false, false); ss = __uint_as_float(rr[0]) + __uint_as_float(rr[1]); }
  return -(sqrtf(ss * kmax2) * 1.01f + 1e-3f);
}
__device__ __forceinline__ void exp16(f32x16& p) {
#pragma unroll
  for (int r = 0; r < 16; ++r) p[r] = __builtin_amdgcn_exp2f(p[r]);
}
__device__ __forceinline__ float sum16(const f32x16& p) { float s = 0;
#pragma unroll
  for (int r = 0; r < 16; ++r) s += p[r];
  return s; }
__device__ __forceinline__ void qkt(f32x16& p0, f32x16& p1, LAS const char* Ks, const bf16x8* qr, int r32, int hi, float nmc) {
#pragma unroll
  for (int r = 0; r < 16; ++r) { p0[r] = nmc; p1[r] = nmc; }
#pragma unroll
  for (int d0 = 0; d0 < 8; ++d0) { int cb = (d0 * 16 + hi * 8) * 2;
    bf16x8 b0 = *(LAS const bf16x8*)(Ks + KSWZ(r32, cb));
    bf16x8 b1 = *(LAS const bf16x8*)(Ks + KSWZ(32 + r32, cb));
    p0 = __builtin_amdgcn_mfma_f32_32x32x16_bf16(b0, qr[d0], p0, 0, 0, 0);
    p1 = __builtin_amdgcn_mfma_f32_32x32x16_bf16(b1, qr[d0], p1, 0, 0, 0); }
}
__device__ __forceinline__ int v_st(int k, int c) { const int kk = (k & ~0xC) | ((k & 4) << 1) | ((k & 8) >> 1); return ((kk >> 3) * 4 + (c >> 5)) * 512 + ((kk & 7) * 32 + (c & 31)) * 2; }
__device__ __forceinline__ int v_st256(int k, int c) { const int kk = (k & ~0xC) | ((k & 4) << 1) | ((k & 8) >> 1); return ((kk >> 3) * 8 + (c >> 5)) * 512 + ((kk & 7) * 32 + (c & 31)) * 2; }
__device__ __forceinline__ int v_rd_base(int lane) { return ((lane & 3) << 3) | (((lane >> 2) & 3) << 6) | (((lane >> 4) & 1) << 5) | (((lane >> 5) & 1) << 8); }
template <int OFF> __device__ __forceinline__ s16x4 tr_read(int vb) {
  s16x4 r; asm volatile("ds_read_b64_tr_b16 %0, %1 offset:%2" : "=&v"(r) : "v"(vb), "i"(OFF) : "memory"); return r;
}
template <int BASE, int KS, int HS> __device__ __forceinline__ void pv_one(f32x16& od, int vb, bf16x8 pa0, bf16x8 pa1, bf16x8 pa2, bf16x8 pa3) {
  const s16x4 l0 = tr_read<BASE>(vb), h0 = tr_read<BASE + HS>(vb), l1 = tr_read<BASE + KS>(vb), h1 = tr_read<BASE + KS + HS>(vb);
  const s16x4 l2 = tr_read<BASE + 2 * KS>(vb), h2 = tr_read<BASE + 2 * KS + HS>(vb), l3 = tr_read<BASE + 3 * KS>(vb), h3 = tr_read<BASE + 3 * KS + HS>(vb);
  asm volatile("s_waitcnt lgkmcnt(0)" ::: "memory"); SCHED;
#define PK(L, H) (bf16x8){L[0], L[1], L[2], L[3], H[0], H[1], H[2], H[3]}
  od = __builtin_amdgcn_mfma_f32_32x32x16_bf16(pa0, PK(l0, h0), od, 0, 0, 0);
  od = __builtin_amdgcn_mfma_f32_32x32x16_bf16(pa1, PK(l1, h1), od, 0, 0, 0);
  od = __builtin_amdgcn_mfma_f32_32x32x16_bf16(pa2, PK(l2, h2), od, 0, 0, 0);
  od = __builtin_amdgcn_mfma_f32_32x32x16_bf16(pa3, PK(l3, h3), od, 0, 0, 0);
#undef PK
}
__device__ __forceinline__ void pv_d0(f32x16* o, int vb, bf16x8 pa0, bf16x8 pa1, bf16x8 pa2, bf16x8 pa3) {
  pv_one<0, 4096, 2048>(o[0], vb, pa0, pa1, pa2, pa3); pv_one<512, 4096, 2048>(o[1], vb, pa0, pa1, pa2, pa3);
  pv_one<1024, 4096, 2048>(o[2], vb, pa0, pa1, pa2, pa3); pv_one<1536, 4096, 2048>(o[3], vb, pa0, pa1, pa2, pa3);
}
__device__ __forceinline__ void pv_d0_256(f32x16* o, int vb, bf16x8 pa0, bf16x8 pa1, bf16x8 pa2, bf16x8 pa3) {
  pv_one<0, 8192, 4096>(o[0], vb, pa0, pa1, pa2, pa3); pv_one<512, 8192, 4096>(o[1], vb, pa0, pa1, pa2, pa3);
  pv_one<1024, 8192, 4096>(o[2], vb, pa0, pa1, pa2, pa3); pv_one<1536, 8192, 4096>(o[3], vb, pa0, pa1, pa2, pa3);
}
__device__ __forceinline__ void store_o8(const f32x16* o, float l_tot, LAS float* li, unsigned char* __restrict__ Ow, int ldo, int r32, int hi) {
  if (hi == 0) li[r32] = l_tot; asm volatile("s_waitcnt lgkmcnt(0)" ::: "memory");
  float rli[16];
#pragma unroll
  for (int r = 0; r < 16; ++r) rli[r] = 8.f * __builtin_amdgcn_rcpf(li[crow(r, hi)]);
#pragma unroll
  for (int r = 0; r < 16; ++r) { const int orow = crow(r, hi);
#pragma unroll
    for (int d0 = 0; d0 < 4; ++d0) Ow[(long)orow * ldo + d0 * 32 + r32] = (unsigned char)__builtin_amdgcn_cvt_pk_fp8_f32(o[d0][r] * rli[r], 0.f, 0, false); }
}
__device__ __forceinline__ void store_o(const f32x16* o, float l_tot, LAS float* li, bf16_t* __restrict__ Ow, int ldo, int r32, int hi) {
  if (hi == 0) li[r32] = l_tot; asm volatile("s_waitcnt lgkmcnt(0)" ::: "memory");
  float rli[16];
#pragma unroll
  for (int r = 0; r < 16; ++r) rli[r] = __builtin_amdgcn_rcpf(li[crow(r, hi)]);
#pragma unroll
  for (int r = 0; r < 16; ++r) { const int orow = crow(r, hi);
#pragma unroll
    for (int d0 = 0; d0 < 4; ++d0) Ow[(long)orow * ldo + d0 * 32 + r32] = f2bf(o[d0][r] * rli[r]); }
}

__device__ __forceinline__ int unswap23(int kk) { return (kk & ~0xC) | ((kk & 4) << 1) | ((kk & 8) >> 1); }
__device__ __forceinline__ int k_dma_voff(int wid, int lane, int ldk) {
  const int row = 4 * wid + (lane >> 4); return row * ldk * 2 + (((lane & 15) * 16) ^ ((row & 7) << 4)); }
#define DMA16(rs, ldsp, voff, soff) __builtin_amdgcn_raw_ptr_buffer_load_lds(rs, (LAS void*)(ldsp), 16, voff, soff, 0, 0)

constexpr int SHM_T = SHM_K + SHM_V;
__device__ __forceinline__ void attn_body(const bf16_t* __restrict__ Qb, const int ldq, const bf16_t* __restrict__ Kh, const bf16_t* __restrict__ Vh, const int ldk,
                                          bf16_t* __restrict__ Ob, const int ldo, const int seq, const float kmax2, LAS char* lds) {
  int tid = threadIdx.x; asm volatile("" : "+v"(tid)); tid &= 511;
  const int wid = tid >> 6, lane = tid & 63, r32 = lane & 31, hi = lane >> 5;
  LAS float* li_l = (LAS float*)(lds + 3 * SHM_T) + wid * 64;
  float l_reg = 0; f32x16 o[4] = {}; bf16x8 qr[8];
  const float nmc = load_q(Qb + (long)(wid * QBLK + r32) * ldq + hi * 8, qr, kmax2);
  const int vrb = v_rd_base(lane);
  const int kvo = k_dma_voff(wid, lane, ldk);
  const int vvo = unswap23(8 * (wid >> 1) + ((lane & 31) >> 2)) * ldk * 2 + ((2 * (wid & 1) + (lane >> 5)) * 32 + (lane & 3) * 8) * 2;
  const int l32 = 64 * ldk, pz = wid * 1024;
  const __amdgpu_buffer_rsrc_t krs = __builtin_amdgcn_make_buffer_rsrc((void*)Kh, 0, 0x7ffffff0, 0x00020000);
  const __amdgpu_buffer_rsrc_t vrs = __builtin_amdgcn_make_buffer_rsrc((void*)Vh, 0, 0x7ffffff0, 0x00020000);
#define TDMA(slot, k0) do { const int _o = (k0) * ldk * 2; LAS char* _b = lds + (slot) * SHM_T + pz; \
    DMA16(krs, _b, kvo, _o); DMA16(krs, _b + 8192, kvo, _o + l32); DMA16(vrs, _b + SHM_K, vvo, _o); DMA16(vrs, _b + SHM_K + 8192, vvo, _o + l32); } while (0)
#define VM0() asm volatile("s_waitcnt vmcnt(0)" ::: "memory")
#define FINISH(P0, P1) do { exp16(P1); l_reg += sum16(P0) + sum16(P1); PK4(P0, 0, pa0); PK4(P0, 8, pa1); PK4(P1, 0, pa2); PK4(P1, 8, pa3); } while (0)
  f32x16 pA0, pA1, pB0, pB1; bf16x8 pa0, pa1, pa2, pa3; const int NT = seq / KVBLK;
  TDMA(0, 0); VM0(); __syncthreads();
  TDMA(1, KVBLK);
  qkt(pA0, pA1, lds, qr, r32, hi, nmc); exp16(pA0);
  VM0(); __syncthreads();
  int sk = 1, sv = 0, sd = 2;
  for (int j = 1; j + 1 < NT; j += 2) {
    TDMA(sd, (j + 1) * KVBLK);
    SCHED; qkt(pB0, pB1, lds + sk * SHM_T, qr, r32, hi, nmc);
    FINISH(pA0, pA1); SCHED;
    pv_d0(o, (int)(uintptr_t)(lds + sv * SHM_T + SHM_K) + vrb, pa0, pa1, pa2, pa3); exp16(pB0);
    VM0(); __syncthreads();
    { const int t = sv; sv = sk; sk = sd; sd = t; }
    if (j + 2 < NT) TDMA(sd, (j + 2) * KVBLK);
    SCHED; qkt(pA0, pA1, lds + sk * SHM_T, qr, r32, hi, nmc);
    FINISH(pB0, pB1); SCHED;
    pv_d0(o, (int)(uintptr_t)(lds + sv * SHM_T + SHM_K) + vrb, pa0, pa1, pa2, pa3); exp16(pA0);
    VM0(); __syncthreads();
    { const int t = sv; sv = sk; sk = sd; sd = t; }
  }
  SCHED; qkt(pB0, pB1, lds + sk * SHM_T, qr, r32, hi, nmc);
  FINISH(pA0, pA1); SCHED;
  pv_d0(o, (int)(uintptr_t)(lds + sv * SHM_T + SHM_K) + vrb, pa0, pa1, pa2, pa3); exp16(pB0);
  FINISH(pB0, pB1); SCHED;
  pv_d0(o, (int)(uintptr_t)(lds + sk * SHM_T + SHM_K) + vrb, pa0, pa1, pa2, pa3);
  { auto rr = __builtin_amdgcn_permlane32_swap(__float_as_uint(l_reg), __float_as_uint(l_reg), false, false); l_reg = __uint_as_float(rr[0]) + __uint_as_float(rr[1]); }
  store_o(o, l_reg, li_l, Ob + (long)(wid * QBLK) * ldo, ldo, r32, hi);
  VM0();
  __syncthreads();
#undef TDMA
#undef FINISH
}

constexpr int SHM_V2 = KVBLK * 256 * 2;
__device__ __forceinline__ void attn_body_dv256(const bf16_t* __restrict__ Qb, const int ldq, const bf16_t* __restrict__ Kh, const bf16_t* __restrict__ Vh, const int ldk,
                                                bf16_t* __restrict__ Ob, const int ldo, const int seq, const float kmax2, LAS char* lds) {
  int tid = threadIdx.x; asm volatile("" : "+v"(tid)); tid &= 511;
  const int wid = tid >> 6, lane = tid & 63, r32 = lane & 31, hi = lane >> 5, rg = wid >> 1, kh = wid & 1;
  LAS char* K_lds = lds; LAS char* V_lds = lds + 2 * SHM_K; LAS char* X_lds = lds + 2 * SHM_K + 2 * SHM_V2;
  float l_reg = 0; f32x16 o[4] = {}; bf16x8 qr[8];
  const float nmc = load_q(Qb + (long)(rg * QBLK + r32) * ldq + hi * 8, qr, kmax2);
  const int vb0 = (int)(uintptr_t)V_lds + v_rd_base(lane) + kh * 2048;
  const int kvo = k_dma_voff(wid, lane, ldk);
  const int vvo = unswap23(8 * (wid >> 2) + ((lane & 31) >> 2)) * ldk * 2 + ((2 * (wid & 3) + (lane >> 5)) * 32 + (lane & 3) * 8) * 2;
  const int l32 = 64 * ldk, l16 = 32 * ldk, pz = wid * 1024;
  const int xw = (rg * 4 + kh * 2) * 1024 + lane * 16, xr = rg * 4096 + lane * 16;
  const __amdgpu_buffer_rsrc_t krs = __builtin_amdgcn_make_buffer_rsrc((void*)Kh, 0, 0x7ffffff0, 0x00020000);
  const __amdgpu_buffer_rsrc_t vrs = __builtin_amdgcn_make_buffer_rsrc((void*)Vh, 0, 0x7ffffff0, 0x00020000);
#define KDMA(b, k0) do { const int _o = (k0) * ldk * 2; LAS char* _b = K_lds + (b) * SHM_K + pz; DMA16(krs, _b, kvo, _o); DMA16(krs, _b + 8192, kvo, _o + l32); } while (0)
#define VDMA(b, k0) do { const int _o = (k0) * ldk * 2; LAS char* _b = V_lds + (b) * SHM_V2 + pz; DMA16(vrs, _b, vvo, _o); DMA16(vrs, _b + 8192, vvo, _o + l16); \
    DMA16(vrs, _b + 16384, vvo, _o + 2 * l16); DMA16(vrs, _b + 24576, vvo, _o + 3 * l16); } while (0)
  f32x16 pA, pB; bf16x8 pa0, pa1, pa2, pa3, own0, own1; const int NT = seq / KVBLK;
  const int kxor = ((32 * kh + r32) & 7) << 4, krb = (32 * kh + r32) * 256;
#define QKHALF(P, b) do { _Pragma("unroll") for (int r = 0; r < 16; ++r) P[r] = nmc; \
    _Pragma("unroll") for (int d0 = 0; d0 < 8; ++d0) { const bf16x8 bk = *(LAS const bf16x8*)(K_lds + (b) * SHM_K + krb + (((d0 * 16 + hi * 8) * 2) ^ kxor)); \
      P = __builtin_amdgcn_mfma_f32_32x32x16_bf16(bk, qr[d0], P, 0, 0, 0); } } while (0)
#define FINH(P) do { exp16(P); l_reg += sum16(P); PK4(P, 0, own0); PK4(P, 8, own1); } while (0)
#define XWRITE(b) do { *(LAS bf16x8*)(X_lds + (b) * 16384 + xw) = own0; *(LAS bf16x8*)(X_lds + (b) * 16384 + xw + 1024) = own1; } while (0)
#define XREAD(b) do { pa0 = *(LAS const bf16x8*)(X_lds + (b) * 16384 + xr); pa1 = *(LAS const bf16x8*)(X_lds + (b) * 16384 + xr + 1024); \
    pa2 = *(LAS const bf16x8*)(X_lds + (b) * 16384 + xr + 2048); pa3 = *(LAS const bf16x8*)(X_lds + (b) * 16384 + xr + 3072); } while (0)
#define STEP(PA, PB, b, j) do { \
    SCHED; if ((j) + 1 < NT) QKHALF(PB, (b) ^ 1); FINH(PA); SCHED; \
    XWRITE(b); VM0(); __syncthreads(); \
    if ((j) + 3 < NT) KDMA((b) ^ 1, ((j) + 3) * KVBLK); if ((j) + 1 < NT) VDMA((b) ^ 1, ((j) + 1) * KVBLK); \
    XREAD(b); \
    pv_d0_256(o, vb0 + (b) * SHM_V2, pa0, pa1, pa2, pa3); } while (0)
  KDMA(0, 0); KDMA(1, KVBLK); VDMA(0, 0); VM0(); __syncthreads();
  QKHALF(pA, 0);
  __syncthreads();
  if (2 < NT) KDMA(0, 2 * KVBLK);
  for (int j = 0; j < NT; j += 2) { STEP(pA, pB, 0, j); STEP(pB, pA, 1, j + 1); }
  __syncthreads();
  LAS float* lx = (LAS float*)X_lds;
  lx[wid * 64 + lane] = l_reg; __syncthreads();
  const float l_tot = lx[wid * 64 + r32] + lx[wid * 64 + 32 + r32] + lx[(wid ^ 1) * 64 + r32] + lx[(wid ^ 1) * 64 + 32 + r32];
  store_o(o, l_tot, lx + 512 + wid * 32, Ob + (long)(rg * QBLK) * ldo + kh * 128, ldo, r32, hi);
  VM0();
  __syncthreads();
#undef KDMA
#undef VDMA
#undef QKHALF
#undef FINH
#undef XWRITE
#undef XREAD
#undef STEP
#undef VM0
}

#define LGK(n) asm volatile("s_waitcnt lgkmcnt(" #n ")" ::: "memory")
template <int OFF> __device__ __forceinline__ bf16x8 k_read(int ka) { bf16x8 r; asm volatile("ds_read_b128 %0, %1 offset:%2" : "=&v"(r) : "v"(ka), "i"(OFF) : "memory"); return r; }
struct VSet { s16x4 l0, h0, l1, h1; };
template <int OFF> __device__ __forceinline__ void v_read(VSet& s, int vb) { s.l0 = tr_read<OFF>(vb); s.h0 = tr_read<OFF + 4096>(vb); s.l1 = tr_read<OFF + 8192>(vb); s.h1 = tr_read<OFF + 12288>(vb); }
__device__ __forceinline__ void pv2(f32x16& oa, const VSet& s, bf16x8 pa0, bf16x8 pa1) {
#define PK(L, H) (bf16x8){L[0], L[1], L[2], L[3], H[0], H[1], H[2], H[3]}
  oa = __builtin_amdgcn_mfma_f32_32x32x16_bf16(pa0, PK(s.l0, s.h0), oa, 0, 0, 0);
  oa = __builtin_amdgcn_mfma_f32_32x32x16_bf16(pa1, PK(s.l1, s.h1), oa, 0, 0, 0);
#undef PK
}
template <bool SHIFT>
__device__ __forceinline__ void attn_body_c256_t(const bf16_t* __restrict__ Qb, const int ldq, const bf16_t* __restrict__ Kh, const bf16_t* __restrict__ Vh, const int ldk,
                                                 bf16_t* __restrict__ Ob, const int ldo, const int seq, const float nmc, const bf16x8 (&qr)[8], LAS char* lds) {
  int tid = threadIdx.x; asm volatile("" : "+v"(tid)); tid &= 511;
  const int wid = __builtin_amdgcn_readfirstlane(tid >> 6), lane = tid & 63, r32 = lane & 31, hi = lane >> 5;
  LAS char* K_lds = lds; LAS char* V_lds = lds + 2 * SHM_K;
  LAS float* li_l = (LAS float*)(lds + 2 * SHM_K + 2 * SHM_V2) + wid * 64;
  float l_reg = 0; f32x16 o[8] = {};
  const int vb0 = (int)(uintptr_t)V_lds + v_rd_base(lane);
  const int kvo = k_dma_voff(wid, lane, ldk);
  const int vvo = unswap23(8 * (wid >> 2) + ((lane & 31) >> 2)) * ldk * 2 + ((2 * (wid & 3) + (lane >> 5)) * 32 + (lane & 3) * 8) * 2;
  const int l32 = 64 * ldk, l16 = 32 * ldk, pz = wid * 1024;
  const __amdgpu_buffer_rsrc_t krs = __builtin_amdgcn_make_buffer_rsrc((void*)Kh, 0, 0x7ffffff0, 0x00020000);
  const __amdgpu_buffer_rsrc_t vrs = __builtin_amdgcn_make_buffer_rsrc((void*)Vh, 0, 0x7ffffff0, 0x00020000);
#define VM0() asm volatile("s_waitcnt vmcnt(0)" ::: "memory")
#define KVDMA(b, k0) do { const int _o = (k0) * ldk * 2; LAS char* _k = K_lds + (b) * SHM_K + pz; LAS char* _v = V_lds + (b) * SHM_V2 + pz; \
    DMA16(krs, _k, kvo, _o); DMA16(krs, _k + 8192, kvo, _o + l32); DMA16(vrs, _v, vvo, _o); DMA16(vrs, _v + 8192, vvo, _o + l16); \
    DMA16(vrs, _v + 16384, vvo, _o + 2 * l16); DMA16(vrs, _v + 24576, vvo, _o + 3 * l16); } while (0)
  int ka[8];
  { const int kxor = (r32 & 7) << 4, krb = (int)(uintptr_t)K_lds + r32 * 256;
#pragma unroll
    for (int d0 = 0; d0 < 8; ++d0) ka[d0] = krb + (((d0 * 16 + hi * 8) * 2) ^ kxor); }
  f32x16 P; bf16x8 pa0, pa1, f0, f1, f2, f3; VSet va, vb_, vc;
  const int NT = seq / KVBLK;
#define PINIT() do { _Pragma("unroll") for (int r = 0; r < 16; ++r) { float _z; asm volatile("v_mov_b32 %0, %1" : "=v"(_z) : "v"(SHIFT ? nmc : 0.f)); P[r] = _z; } } while (0)
#define KOFF(b, h) ((b) * 16384 + (h) * 8192)
#define VOFF(b, h, d0) ((b) * 32768 + (h) * 16384 + (d0) * 512)
#define KPRO(b, h) do { f0 = k_read<KOFF(b, h)>(ka[0]); f1 = k_read<KOFF(b, h)>(ka[1]); f2 = k_read<KOFF(b, h)>(ka[2]); } while (0)
#define QKM(F, d0) do { SCHED; P = __builtin_amdgcn_mfma_f32_32x32x16_bf16(F, qr[d0], P, 0, 0, 0); SCHED; } while (0)
#define QKHALF(b, h) do { PINIT(); \
    LGK(2); QKM(f0, 0); f3 = k_read<KOFF(b, h)>(ka[3]); \
    LGK(2); QKM(f1, 1); f0 = k_read<KOFF(b, h)>(ka[4]); \
    LGK(2); QKM(f2, 2); f1 = k_read<KOFF(b, h)>(ka[5]); \
    LGK(2); QKM(f3, 3); f2 = k_read<KOFF(b, h)>(ka[6]); \
    LGK(2); QKM(f0, 4); f3 = k_read<KOFF(b, h)>(ka[7]); \
    LGK(2); QKM(f1, 5); v_read<VOFF(b, h, 0)>(va, vb0); \
    LGK(5); QKM(f2, 6); v_read<VOFF(b, h, 1)>(vb_, vb0); \
    LGK(8); QKM(f3, 7); } while (0)
#define SMH() do { exp16(P); l_reg += sum16(P); PK4(P, 0, pa0); PK4(P, 8, pa1); } while (0)
#define PVM(S, d0) do { SCHED; pv2(o[d0], S, pa0, pa1); SCHED; } while (0)
#define PVHALF(b, h, NEXTK, nb, nh) do { \
    LGK(4); PVM(va, 0); v_read<VOFF(b, h, 2)>(vc, vb0); \
    LGK(4); PVM(vb_, 1); v_read<VOFF(b, h, 3)>(va, vb0); \
    LGK(4); PVM(vc, 2); v_read<VOFF(b, h, 4)>(vb_, vb0); \
    LGK(4); PVM(va, 3); v_read<VOFF(b, h, 5)>(vc, vb0); \
    LGK(4); PVM(vb_, 4); v_read<VOFF(b, h, 6)>(va, vb0); \
    LGK(4); PVM(vc, 5); v_read<VOFF(b, h, 7)>(vb_, vb0); \
    LGK(4); PVM(va, 6); if (NEXTK) { f0 = k_read<KOFF(nb, nh)>(ka[0]); f1 = k_read<KOFF(nb, nh)>(ka[1]); } \
    if (NEXTK) { LGK(2); } else { LGK(0); } PVM(vb_, 7); if (NEXTK) { f2 = k_read<KOFF(nb, nh)>(ka[2]); } } while (0)
#define STEPC(b, j) do { if ((j) + 1 < NT) KVDMA((b) ^ 1, ((j) + 1) * KVBLK); \
    KPRO(b, 0); QKHALF(b, 0); SMH(); PVHALF(b, 0, true, b, 1); \
    QKHALF(b, 1); SMH(); PVHALF(b, 1, false, 0, 0); \
    VM0(); __syncthreads(); } while (0)
  KVDMA(0, 0); VM0(); __syncthreads();
  for (int j = 0; j < NT; j += 2) { STEPC(0, j); STEPC(1, j + 1); }
  { auto rr = __builtin_amdgcn_permlane32_swap(__float_as_uint(l_reg), __float_as_uint(l_reg), false, false); l_reg = __uint_as_float(rr[0]) + __uint_as_float(rr[1]); }
  if (hi == 0) li_l[r32] = l_reg; asm volatile("s_waitcnt lgkmcnt(0)" ::: "memory");
  bf16_t* Ow = Ob + (long)(wid * QBLK) * ldo;
#pragma unroll
  for (int r = 0; r < 16; ++r) { const int orow = crow(r, hi); const float rl = __builtin_amdgcn_rcpf(li_l[orow]);
#pragma unroll
    for (int d0 = 0; d0 < 8; ++d0) Ow[(long)orow * ldo + d0 * 32 + r32] = f2bf(o[d0][r] * rl); }
  VM0();
  __syncthreads();
#undef KVDMA
#undef PINIT
#undef KOFF
#undef VOFF
#undef KPRO
#undef QKM
#undef QKHALF
#undef SMH
#undef PVM
#undef PVHALF
#undef STEPC
#undef VM0
}
__device__ __forceinline__ void attn_body_c256(const bf16_t* __restrict__ Qb, const int ldq, const bf16_t* __restrict__ Kh, const bf16_t* __restrict__ Vh, const int ldk,
                                               bf16_t* __restrict__ Ob, const int ldo, const int seq, const float kmax2, LAS char* lds) {
  int tid = threadIdx.x; asm volatile("" : "+v"(tid)); tid &= 511;
  const int wid = tid >> 6, lane = tid & 63, r32 = lane & 31, hi = lane >> 5;
  bf16x8 qr[8];
  const float nmc = load_q(Qb + (long)(wid * QBLK + r32) * ldq + hi * 8, qr, kmax2);
  if (__all(nmc > -64.f)) attn_body_c256_t<false>(Qb, ldq, Kh, Vh, ldk, Ob, ldo, seq, 0.f, qr, lds);
  else attn_body_c256_t<true>(Qb, ldq, Kh, Vh, ldk, Ob, ldo, seq, nmc, qr, lds);
}

__device__ __forceinline__ float load_q8(const bf16_t* __restrict__ Qrow, int hi, v8i_ (&qf)[2], float kmax2) {
  float ss = 0;
#pragma unroll
  for (int st = 0; st < 2; ++st) {
    const bf16_t* p = Qrow + 64 * st + 32 * hi; v8i_ o;
#pragma unroll
    for (int c = 0; c < 4; ++c) { const u32x4 raw = *reinterpret_cast<const u32x4*>(p + 8 * c);
      const unsigned w0 = pack8x4(bflo(raw[0]) * QC, bfhi(raw[0]) * QC, bflo(raw[1]) * QC, bfhi(raw[1]) * QC);
      const unsigned w1 = pack8x4(bflo(raw[2]) * QC, bfhi(raw[2]) * QC, bflo(raw[3]) * QC, bfhi(raw[3]) * QC);
      o[2 * c] = (int)w0; o[2 * c + 1] = (int)w1; ss += sq8x4(w0) + sq8x4(w1); }
    qf[st] = o;
  }
  { auto rr = __builtin_amdgcn_permlane32_swap(__float_as_uint(ss), __float_as_uint(ss), false, false); ss = __uint_as_float(rr[0]) + __uint_as_float(rr[1]); }
  return -(sqrtf(ss * kmax2) * 1.01f + 1e-3f);
}
__device__ __forceinline__ int k8_dma_voff(int wid, int lane, int ldk8) {
  const int row = 8 * wid + (lane >> 3); return row * ldk8 + (((lane & 7) ^ ((row >> 1) & 7)) << 4); }
template <int OFF> __device__ __forceinline__ v4i k8_read(int ka) { v4i r; asm volatile("ds_read_b128 %0, %1 offset:%2" : "=&v"(r) : "v"(ka), "i"(OFF) : "memory"); return r; }

template <bool SHIFT>
__device__ __forceinline__ void attn_body_c256q8_t(const unsigned char* __restrict__ K8, const int ldk8, const bf16_t* __restrict__ Vh, const int ldk,
                                                   bf16_t* __restrict__ Ob, const int ldo, const int seq, const float nmc, const v8i_ (&qf)[2], LAS char* lds) {
  int tid = threadIdx.x; asm volatile("" : "+v"(tid)); tid &= 511;
  const int wid = __builtin_amdgcn_readfirstlane(tid >> 6), lane = tid & 63, r32 = lane & 31, hi = lane >> 5;
  constexpr int SHM_K8 = KVBLK * 128;
  LAS char* K_lds = lds; LAS char* V_lds = lds + 2 * SHM_K8;
  LAS float* li_l = (LAS float*)(lds + 2 * SHM_K8 + 2 * SHM_V2) + wid * 64;
  float l_reg = 0; f32x16 o[8] = {};
  const int vb0 = (int)(uintptr_t)V_lds + v_rd_base(lane);
  const int kvo = k8_dma_voff(wid, lane, ldk8);
  const int vvo = unswap23(8 * (wid >> 2) + ((lane & 31) >> 2)) * ldk * 2 + ((2 * (wid & 3) + (lane >> 5)) * 32 + (lane & 3) * 8) * 2;
  const int l16 = 32 * ldk, pz = wid * 1024;
  const __amdgpu_buffer_rsrc_t krs = __builtin_amdgcn_make_buffer_rsrc((void*)K8, 0, 0x7ffffff0, 0x00020000);
  const __amdgpu_buffer_rsrc_t vrs = __builtin_amdgcn_make_buffer_rsrc((void*)Vh, 0, 0x7ffffff0, 0x00020000);
#define VM0() asm volatile("s_waitcnt vmcnt(0)" ::: "memory")
#define KVDMA(b, k0) do { const int _o = (k0) * ldk * 2; LAS char* _v = V_lds + (b) * SHM_V2 + pz; \
    DMA16(krs, K_lds + (b) * SHM_K8 + pz, kvo, (k0) * ldk8); DMA16(vrs, _v, vvo, _o); DMA16(vrs, _v + 8192, vvo, _o + l16); \
    DMA16(vrs, _v + 16384, vvo, _o + 2 * l16); DMA16(vrs, _v + 24576, vvo, _o + 3 * l16); } while (0)
  const int ka0 = (int)(uintptr_t)K_lds + r32 * 128 + (((2 * hi) ^ ((r32 >> 1) & 7)) << 4);
  const int ka1 = ka0 ^ 16, ka2 = ka0 ^ 64, ka3 = ka0 ^ 80;
  int sc1; asm volatile("v_mov_b32 %0, 0x7f7f7f7f" : "=v"(sc1));
  f32x16 P; bf16x8 pa0, pa1; v4i k0a, k0b, k1a, k1b; VSet va, vb_, vc;
  const int NT = seq / KVBLK;
#define KOFF(b, h) ((b) * 8192 + (h) * 4096)
#define VOFF(b, h, d0) ((b) * 32768 + (h) * 16384 + (d0) * 512)
#define KPRO(b, h) do { k0a = k8_read<KOFF(b, h)>(ka0); k0b = k8_read<KOFF(b, h)>(ka1); k1a = k8_read<KOFF(b, h)>(ka2); k1b = k8_read<KOFF(b, h)>(ka3); } while (0)
#define V8(x, y) (v8i_){x[0], x[1], x[2], x[3], y[0], y[1], y[2], y[3]}
#define QKHALF(b, h) do { \
    if (SHIFT) { _Pragma("unroll") for (int r = 0; r < 16; ++r) { float _z; asm volatile("v_mov_b32 %0, %1" : "=v"(_z) : "v"(nmc)); P[r] = _z; } } \
    LGK(2); SCHED; { const v8i_ kf = V8(k0a, k0b); \
      if (SHIFT) asm volatile("s_nop 4\n\tv_mfma_scale_f32_32x32x64_f8f6f4 %0, %1, %2, %0, %3, %3 op_sel_hi:[0,0,0]" : "+v"(P) : "v"(kf), "v"(qf[0]), "v"(sc1)); \
      else       asm volatile("v_mfma_scale_f32_32x32x64_f8f6f4 %0, %1, %2, 0, %3, %3 op_sel_hi:[0,0,0]" : "=&v"(P) : "v"(kf), "v"(qf[0]), "v"(sc1)); } \
    SCHED; v_read<VOFF(b, h, 0)>(va, vb0); \
    LGK(4); SCHED; { const v8i_ kf = V8(k1a, k1b); \
      asm volatile("v_mfma_scale_f32_32x32x64_f8f6f4 %0, %1, %2, %0, %3, %3 op_sel_hi:[0,0,0]" : "+v"(P) : "v"(kf), "v"(qf[1]), "v"(sc1)); } \
    SCHED; v_read<VOFF(b, h, 1)>(vb_, vb0); \
    asm volatile("s_nop 15\n\ts_nop 7" : "+v"(P)); } while (0)
#define SMH() do { exp16(P); l_reg += sum16(P); PK4(P, 0, pa0); PK4(P, 8, pa1); } while (0)
#define PVM(S, d0) do { SCHED; pv2(o[d0], S, pa0, pa1); SCHED; } while (0)
#define PVHALF(b, h, NEXTK, nb, nh) do { \
    LGK(4); PVM(va, 0); v_read<VOFF(b, h, 2)>(vc, vb0); \
    LGK(4); PVM(vb_, 1); v_read<VOFF(b, h, 3)>(va, vb0); \
    LGK(4); PVM(vc, 2); v_read<VOFF(b, h, 4)>(vb_, vb0); \
    LGK(4); PVM(va, 3); v_read<VOFF(b, h, 5)>(vc, vb0); \
    LGK(4); PVM(vb_, 4); v_read<VOFF(b, h, 6)>(va, vb0); \
    LGK(4); PVM(vc, 5); v_read<VOFF(b, h, 7)>(vb_, vb0); \
    LGK(4); PVM(va, 6); if (NEXTK) { k0a = k8_read<KOFF(nb, nh)>(ka0); k0b = k8_read<KOFF(nb, nh)>(ka1); } \
    if (NEXTK) { LGK(2); } else { LGK(0); } PVM(vb_, 7); if (NEXTK) { k1a = k8_read<KOFF(nb, nh)>(ka2); k1b = k8_read<KOFF(nb, nh)>(ka3); } } while (0)
#define STEPC(b, j) do { if ((j) + 1 < NT) KVDMA((b) ^ 1, ((j) + 1) * KVBLK); \
    KPRO(b, 0); QKHALF(b, 0); SMH(); PVHALF(b, 0, true, b, 1); \
    QKHALF(b, 1); SMH(); PVHALF(b, 1, false, 0, 0); \
    VM0(); __syncthreads(); } while (0)
  KVDMA(0, 0); VM0(); __syncthreads();
  for (int j = 0; j < NT; j += 2) { STEPC(0, j); STEPC(1, j + 1); }
  { auto rr = __builtin_amdgcn_permlane32_swap(__float_as_uint(l_reg), __float_as_uint(l_reg), false, false); l_reg = __uint_as_float(rr[0]) + __uint_as_float(rr[1]); }
  if (hi == 0) li_l[r32] = l_reg; asm volatile("s_waitcnt lgkmcnt(0)" ::: "memory");
  bf16_t* Ow = Ob + (long)(wid * QBLK) * ldo;
#pragma unroll
  for (int r = 0; r < 16; ++r) { const int orow = crow(r, hi); const float rl = __builtin_amdgcn_rcpf(li_l[orow]);
#pragma unroll
    for (int d0 = 0; d0 < 8; ++d0) Ow[(long)orow * ldo + d0 * 32 + r32] = f2bf(o[d0][r] * rl); }
  VM0();
  __syncthreads();
#undef KVDMA
#undef KOFF
#undef VOFF
#undef KPRO
#undef V8
#undef QKHALF
#undef SMH
#undef PVM
#undef PVHALF
#undef STEPC
#undef VM0
}
__device__ __forceinline__ void attn_body_c256q8(const bf16_t* __restrict__ Qb, const int ldq, const unsigned char* __restrict__ K8, const int ldk8,
                                                 const bf16_t* __restrict__ Vh, const int ldk, bf16_t* __restrict__ Ob, const int ldo, const int seq, const float kmax2, LAS char* lds) {
  int tid = threadIdx.x; asm volatile("" : "+v"(tid)); tid &= 511;
  const int wid = tid >> 6, lane = tid & 63, r32 = lane & 31, hi = lane >> 5;
  v8i_ qf[2];
  const float nmc = load_q8(Qb + (long)(wid * QBLK + r32) * ldq, hi, qf, kmax2);
  if (__all(nmc > -64.f)) attn_body_c256q8_t<false>(K8, ldk8, Vh, ldk, Ob, ldo, seq, 0.f, qf, lds);
  else attn_body_c256q8_t<true>(K8, ldk8, Vh, ldk, Ob, ldo, seq, nmc, qf, lds);
}

template <bool SHIFT>
__device__ __forceinline__ void attn_body_q8_t(const unsigned char* __restrict__ K8, const int ldk8, const bf16_t* __restrict__ Vh, const int ldk,
                                               bf16_t* __restrict__ Ob, const int ldo, const int seq, const float nmc, const v8i_ (&qf)[2], LAS char* lds) {
  int tid = threadIdx.x; asm volatile("" : "+v"(tid)); tid &= 511;
  const int wid = __builtin_amdgcn_readfirstlane(tid >> 6), lane = tid & 63, r32 = lane & 31, hi = lane >> 5;
  constexpr int SK8 = KVBLK * 128, ST = SK8 + SHM_V;
  LAS float* li_l = (LAS float*)(lds + 3 * ST) + wid * 64;
  float l_reg = 0; f32x16 o[4] = {};
  const int vrb = v_rd_base(lane);
  const int kvo = k8_dma_voff(wid, lane, ldk8);
  const int vvo = unswap23(8 * (wid >> 1) + ((lane & 31) >> 2)) * ldk * 2 + ((2 * (wid & 1) + (lane >> 5)) * 32 + (lane & 3) * 8) * 2;
  const int l32 = 64 * ldk, pz = wid * 1024;
  const __amdgpu_buffer_rsrc_t krs = __builtin_amdgcn_make_buffer_rsrc((void*)K8, 0, 0x7ffffff0, 0x00020000);
  const __amdgpu_buffer_rsrc_t vrs = __builtin_amdgcn_make_buffer_rsrc((void*)Vh, 0, 0x7ffffff0, 0x00020000);
#define TDMA(slot, k0) do { const int _o = (k0) * ldk * 2; LAS char* _b = lds + (slot) * ST + pz; \
    DMA16(krs, _b, kvo, (k0) * ldk8); DMA16(vrs, _b + SK8, vvo, _o); DMA16(vrs, _b + SK8 + 8192, vvo, _o + l32); } while (0)
#define VM0() asm volatile("s_waitcnt vmcnt(0)" ::: "memory")
  int sc1; asm volatile("v_mov_b32 %0, 0x7f7f7f7f" : "=v"(sc1));
  const int kof = r32 * 128 + (((2 * hi) ^ ((r32 >> 1) & 7)) << 4);
#define QKT8(P0, P1, Ks) do { \
    const v4i a0 = *(LAS const v4i*)((Ks) + kof), a1 = *(LAS const v4i*)((Ks) + (kof ^ 16)), a2 = *(LAS const v4i*)((Ks) + (kof ^ 64)), a3 = *(LAS const v4i*)((Ks) + (kof ^ 80)); \
    const v4i b0 = *(LAS const v4i*)((Ks) + 4096 + kof), b1 = *(LAS const v4i*)((Ks) + 4096 + (kof ^ 16)), b2 = *(LAS const v4i*)((Ks) + 4096 + (kof ^ 64)), b3 = *(LAS const v4i*)((Ks) + 4096 + (kof ^ 80)); \
    v8i_ k00 = (v8i_){a0[0], a0[1], a0[2], a0[3], a1[0], a1[1], a1[2], a1[3]}, k01 = (v8i_){a2[0], a2[1], a2[2], a2[3], a3[0], a3[1], a3[2], a3[3]}; \
    v8i_ k10 = (v8i_){b0[0], b0[1], b0[2], b0[3], b1[0], b1[1], b1[2], b1[3]}, k11 = (v8i_){b2[0], b2[1], b2[2], b2[3], b3[0], b3[1], b3[2], b3[3]}; \
    if (SHIFT) { _Pragma("unroll") for (int r = 0; r < 16; ++r) { P0[r] = nmc; P1[r] = nmc; } \
      asm volatile("s_nop 4\n\tv_mfma_scale_f32_32x32x64_f8f6f4 %0, %1, %2, %0, %3, %3 op_sel_hi:[0,0,0]" : "+v"(P0) : "v"(k00), "v"(qf[0]), "v"(sc1)); \
      asm volatile("v_mfma_scale_f32_32x32x64_f8f6f4 %0, %1, %2, %0, %3, %3 op_sel_hi:[0,0,0]" : "+v"(P1) : "v"(k10), "v"(qf[0]), "v"(sc1)); } \
    else { asm volatile("v_mfma_scale_f32_32x32x64_f8f6f4 %0, %1, %2, 0, %3, %3 op_sel_hi:[0,0,0]" : "=&v"(P0) : "v"(k00), "v"(qf[0]), "v"(sc1)); \
      asm volatile("v_mfma_scale_f32_32x32x64_f8f6f4 %0, %1, %2, 0, %3, %3 op_sel_hi:[0,0,0]" : "=&v"(P1) : "v"(k10), "v"(qf[0]), "v"(sc1)); } \
    asm volatile("v_mfma_scale_f32_32x32x64_f8f6f4 %0, %1, %2, %0, %3, %3 op_sel_hi:[0,0,0]" : "+v"(P0) : "v"(k01), "v"(qf[1]), "v"(sc1)); \
    asm volatile("v_mfma_scale_f32_32x32x64_f8f6f4 %0, %1, %2, %0, %3, %3 op_sel_hi:[0,0,0]" : "+v"(P1) : "v"(k11), "v"(qf[1]), "v"(sc1)); \
      \
    asm volatile("s_nop 15" : "+v"(k00), "+v"(k01), "+v"(k10), "+v"(k11)); } while (0)
#define TIE(P0, P1) asm volatile("s_nop 15\n\ts_nop 7" : "+v"(P0), "+v"(P1))
#define TIE0(P0, P1) asm volatile("" : "+v"(P0), "+v"(P1))
#define FINISH(P0, P1) do { exp16(P1); l_reg += sum16(P0) + sum16(P1); PK4(P0, 0, pa0); PK4(P0, 8, pa1); PK4(P1, 0, pa2); PK4(P1, 8, pa3); } while (0)
  f32x16 pA0, pA1, pB0, pB1; bf16x8 pa0, pa1, pa2, pa3; const int NT = seq / KVBLK;
  TDMA(0, 0); VM0(); __syncthreads();
  TDMA(1, KVBLK);
  QKT8(pA0, pA1, lds); TIE(pA0, pA1); exp16(pA0);
  VM0(); __syncthreads();
  int sk = 1, sv = 0, sd = 2;
  for (int j = 1; j + 1 < NT; j += 2) {
    TDMA(sd, (j + 1) * KVBLK);
    SCHED; QKT8(pB0, pB1, lds + sk * ST);
    FINISH(pA0, pA1); SCHED;
    pv_d0(o, (int)(uintptr_t)(lds + sv * ST + SK8) + vrb, pa0, pa1, pa2, pa3); TIE0(pB0, pB1); exp16(pB0);
    VM0(); __syncthreads();
    { const int t = sv; sv = sk; sk = sd; sd = t; }
    if (j + 2 < NT) TDMA(sd, (j + 2) * KVBLK);
    SCHED; QKT8(pA0, pA1, lds + sk * ST);
    FINISH(pB0, pB1); SCHED;
    pv_d0(o, (int)(uintptr_t)(lds + sv * ST + SK8) + vrb, pa0, pa1, pa2, pa3); TIE0(pA0, pA1); exp16(pA0);
    VM0(); __syncthreads();
    { const int t = sv; sv = sk; sk = sd; sd = t; }
  }
  SCHED; QKT8(pB0, pB1, lds + sk * ST);
  FINISH(pA0, pA1); SCHED;
  pv_d0(o, (int)(uintptr_t)(lds + sv * ST + SK8) + vrb, pa0, pa1, pa2, pa3); TIE0(pB0, pB1); exp16(pB0);
  FINISH(pB0, pB1); SCHED;
  pv_d0(o, (int)(uintptr_t)(lds + sk * ST + SK8) + vrb, pa0, pa1, pa2, pa3);
  { auto rr = __builtin_amdgcn_permlane32_swap(__float_as_uint(l_reg), __float_as_uint(l_reg), false, false); l_reg = __uint_as_float(rr[0]) + __uint_as_float(rr[1]); }
#if DENSE8_G2
  store_o8(o, l_reg, li_l, (unsigned char*)Ob + (long)(wid * QBLK) * ldo, ldo, r32, hi);
#else
  store_o(o, l_reg, li_l, Ob + (long)(wid * QBLK) * ldo, ldo, r32, hi);
#endif
  VM0();
  __syncthreads();
#undef TDMA
#undef VM0
#undef QKT8
#undef TIE
#undef TIE0
#undef FINISH
}
__device__ __forceinline__ void attn_body_q8(const bf16_t* __restrict__ Qb, const int ldq, const unsigned char* __restrict__ K8, const int ldk8,
                                             const bf16_t* __restrict__ Vh, const int ldk, bf16_t* __restrict__ Ob, const int ldo, const int seq, const float kmax2, LAS char* lds) {
  int tid = threadIdx.x; asm volatile("" : "+v"(tid)); tid &= 511;
  const int wid = tid >> 6, lane = tid & 63, r32 = lane & 31, hi = lane >> 5;
  v8i_ qf[2];
  const float nmc = load_q8(Qb + (long)(wid * QBLK + r32) * ldq, hi, qf, kmax2);
  if (__all(nmc > -64.f)) attn_body_q8_t<false>(K8, ldk8, Vh, ldk, Ob, ldo, seq, 0.f, qf, lds);
  else attn_body_q8_t<true>(K8, ldk8, Vh, ldk, Ob, ldo, seq, nmc, qf, lds);
}

__device__ __forceinline__ unsigned pk8nc(float a, float b, float c, float d) {
  int p = __builtin_amdgcn_cvt_pk_fp8_f32(a, b, 0, false); p = __builtin_amdgcn_cvt_pk_fp8_f32(c, d, p, true); return (unsigned)p; }
__device__ __forceinline__ float max16(const f32x16& p) {
  float a = fmaxf(fmaxf(p[0], p[1]), fmaxf(p[2], p[3])), b = fmaxf(fmaxf(p[4], p[5]), fmaxf(p[6], p[7]));
  float c = fmaxf(fmaxf(p[8], p[9]), fmaxf(p[10], p[11])), d = fmaxf(fmaxf(p[12], p[13]), fmaxf(p[14], p[15]));
  return fmaxf(fmaxf(a, b), fmaxf(c, d)); }
template <int NCB>
__device__ __forceinline__ void attn_body_d(const bf16_t* __restrict__ Qb, const int ldq, const unsigned char* __restrict__ K8, const int ldk8,
                                               const unsigned char* __restrict__ V8T  ,
                                               bf16_t* __restrict__ Ob, const int ldo, const int seq, LAS char* lds) {
  int tid = threadIdx.x; asm volatile("" : "+v"(tid)); tid &= 511;
  const int wid = __builtin_amdgcn_readfirstlane(tid >> 6), lane = tid & 63, r32 = lane & 31, hi = lane >> 5;
  v8i_ qf[2];
  (void)load_q8(Qb + (long)(wid * QBLK + r32) * ldq, hi, qf, 0.f);
  constexpr int SK8 = KVBLK * 128, SV8 = NCB * 32 * 64;
  LAS char* K_lds = lds; LAS char* V_lds = lds + 2 * SK8;
  LAS float* li_l = (LAS float*)(lds + 2 * SK8 + 2 * SV8) + wid * 64;
  float l_reg = 0; f32x16 o[NCB] = {};
  const int kvo = k8_dma_voff(wid, lane, ldk8);
  const int vvo = lane * 16 + wid * 1024, pz = wid * 1024;
  const __amdgpu_buffer_rsrc_t krs = __builtin_amdgcn_make_buffer_rsrc((void*)K8, 0, 0x7ffffff0, 0x00020000);
  const __amdgpu_buffer_rsrc_t vrs = __builtin_amdgcn_make_buffer_rsrc((void*)V8T, 0, 0x7ffffff0, 0x00020000);
#define VM0() asm volatile("s_waitcnt vmcnt(0)" ::: "memory")
#define KVDMA(b, t) do { DMA16(krs, K_lds + (b) * SK8 + pz, kvo, (t) * KVBLK * ldk8); \
    DMA16(vrs, V_lds + (b) * SV8 + pz, vvo, (t) * SV8); if (NCB == 8) DMA16(vrs, V_lds + (b) * SV8 + pz + 8192, vvo, (t) * SV8 + 8192); } while (0)
  const int ka0 = (int)(uintptr_t)K_lds + r32 * 128 + (((2 * hi) ^ ((r32 >> 1) & 7)) << 4);
  const int ka1 = ka0 ^ 16, ka2 = ka0 ^ 64, ka3 = ka0 ^ 80;
  const int vf0 = (int)(uintptr_t)V_lds + r32 * 64 + (((2 * hi) ^ ((r32 >> 2) & 3)) << 4), vf1 = vf0 ^ 16;
  int sc1; asm volatile("v_mov_b32 %0, 0x7f7f7f7f" : "=v"(sc1));
  const int NT = seq / KVBLK;
#define RD128(dst, addr, OFF) asm volatile("ds_read_b128 %0, %1 offset:%2" : "=&v"(dst) : "v"(addr), "i"(OFF) : "memory")
#define V8(x, y) (v8i_){x[0], x[1], x[2], x[3], y[0], y[1], y[2], y[3]}
#define VFR(A_, B_, b, d0) do { RD128(A_, vf0, (b) * SV8 + (d0) * 2048); RD128(B_, vf1, (b) * SV8 + (d0) * 2048); } while (0)
#define PVM(A_, B_, d0) do { SCHED; { const v8i_ vfr = V8(A_, B_); \
    asm volatile("v_mfma_scale_f32_32x32x64_f8f6f4 %0, %1, %2, %0, %3, %4 op_sel_hi:[0,0,0]" : "+v"(o[(d0) < NCB ? (d0) : 0]) : "v"(pa8), "v"(vfr), "v"(sca), "v"(sc1)); } SCHED; } while (0)
#define STEPD(b, j) do { if ((j) + 1 < NT) KVDMA((b) ^ 1, (j) + 1); \
      \
    RD128(k0, ka0, (b) * 8192); RD128(k1, ka1, (b) * 8192); RD128(k2, ka2, (b) * 8192); RD128(k3, ka3, (b) * 8192); \
    RD128(k4, ka0, (b) * 8192 + 4096); RD128(k5, ka1, (b) * 8192 + 4096); RD128(k6, ka2, (b) * 8192 + 4096); RD128(k7, ka3, (b) * 8192 + 4096); \
    LGK(6); SCHED; { const v8i_ kf = V8(k0, k1); asm volatile("v_mfma_scale_f32_32x32x64_f8f6f4 %0, %1, %2, 0, %3, %3 op_sel_hi:[0,0,0]" : "=&v"(p0) : "v"(kf), "v"(qf[0]), "v"(sc1)); } \
    LGK(4); SCHED; { const v8i_ kf = V8(k2, k3); asm volatile("v_mfma_scale_f32_32x32x64_f8f6f4 %0, %1, %2, %0, %3, %3 op_sel_hi:[0,0,0]" : "+v"(p0) : "v"(kf), "v"(qf[1]), "v"(sc1)); } \
    LGK(2); SCHED; { const v8i_ kf = V8(k4, k5); asm volatile("v_mfma_scale_f32_32x32x64_f8f6f4 %0, %1, %2, 0, %3, %3 op_sel_hi:[0,0,0]" : "=&v"(p1) : "v"(kf), "v"(qf[0]), "v"(sc1)); } \
    LGK(0); SCHED; { const v8i_ kf = V8(k6, k7); asm volatile("v_mfma_scale_f32_32x32x64_f8f6f4 %0, %1, %2, %0, %3, %3 op_sel_hi:[0,0,0]" : "+v"(p1) : "v"(kf), "v"(qf[1]), "v"(sc1)); } \
    SCHED; VFR(va, vb, b, 0); VFR(vc, vd, b, 1); \
    asm volatile("s_nop 15\n\ts_nop 7" : "+v"(p0), "+v"(p1)); \
      \
    { const float mo = fmaxf(max16(p0), max16(p1)); \
      auto sA = __builtin_amdgcn_permlane32_swap(__float_as_uint(mo), __float_as_uint(mo), false, false); \
      const float e0 = fminf(fmaxf(ceilf(fmaxf(__uint_as_float(sA[0]), __uint_as_float(sA[1]))), -120.f), 120.f); \
      _Pragma("unroll") for (int r = 0; r < 16; ++r) { p0[r] = __builtin_amdgcn_exp2f(p0[r] - e0); p1[r] = __builtin_amdgcn_exp2f(p1[r] - e0); } \
      l_reg += __builtin_amdgcn_exp2f(e0) * (sum16(p0) + sum16(p1)); \
      sca = 127 + (int)e0; \
      _Pragma("unroll") for (int q = 0; q < 4; ++q) { \
        const unsigned x = pk8nc(p0[4 * q], p0[4 * q + 1], p0[4 * q + 2], p0[4 * q + 3]), y = pk8nc(p1[4 * q], p1[4 * q + 1], p1[4 * q + 2], p1[4 * q + 3]); \
        auto rr = __builtin_amdgcn_permlane32_swap(x, y, false, false); pa8[q] = (int)rr[0]; pa8[4 + q] = (int)rr[1]; } } \
      \
    asm volatile("s_nop 4" : "+v"(pa8), "+v"(sca));     \
    if (NCB == 8) { \
    LGK(2); PVM(va, vb, 0); VFR(ve, vf, b, 2); \
    LGK(2); PVM(vc, vd, 1); VFR(va, vb, b, 3); \
    LGK(2); PVM(ve, vf, 2); VFR(vc, vd, b, 4); \
    LGK(2); PVM(va, vb, 3); VFR(ve, vf, b, 5); \
    LGK(2); PVM(vc, vd, 4); VFR(va, vb, b, 6); \
    LGK(2); PVM(ve, vf, 5); VFR(vc, vd, b, 7); \
    LGK(2); PVM(va, vb, 6); \
    LGK(0); PVM(vc, vd, NCB - 1); } else { \
    LGK(2); PVM(va, vb, 0); VFR(ve, vf, b, 2); \
    LGK(2); PVM(vc, vd, 1); VFR(va, vb, b, 3); \
    LGK(2); PVM(ve, vf, 2); \
    LGK(0); PVM(va, vb, 3); } \
    VM0(); __syncthreads(); } while (0)
  f32x16 p0, p1; v8i_ pa8; int sca; v4i k0, k1, k2, k3, k4, k5, k6, k7, va, vb, vc, vd, ve, vf;
  KVDMA(0, 0); VM0(); __syncthreads();
  for (int j = 0; j < NT; j += 2) { STEPD(0, j); STEPD(1, j + 1); }
  asm volatile("s_nop 15\n\ts_nop 7" ::: "memory");
#pragma unroll
  for (int d0 = 0; d0 < NCB; ++d0) asm volatile("" : "+v"(o[d0]));
  { auto rr = __builtin_amdgcn_permlane32_swap(__float_as_uint(l_reg), __float_as_uint(l_reg), false, false); l_reg = __uint_as_float(rr[0]) + __uint_as_float(rr[1]); }
  if (hi == 0) li_l[r32] = l_reg; asm volatile("s_waitcnt lgkmcnt(0)" ::: "memory");
  bf16_t* Ow = Ob + (long)(wid * QBLK) * ldo;
#pragma unroll
  for (int r = 0; r < 16; ++r) { const int orow = crow(r, hi); const float rl = __builtin_amdgcn_rcpf(li_l[orow]);
#pragma unroll
    for (int d0 = 0; d0 < NCB; ++d0) Ow[(long)orow * ldo + d0 * 32 + r32] = f2bf(o[d0][r] * rl); }
  VM0();
  __syncthreads();
#undef VM0
#undef KVDMA
#undef RD128
#undef V8
#undef VFR
#undef PVM
#undef STEPD
}
__device__ __forceinline__ float max3a(float a, float b, float c) { float r; asm("v_max3_f32 %0, %1, %2, %3" : "=v"(r) : "v"(a), "v"(b), "v"(c)); return r; }
__device__ __forceinline__ float max2a(float a, float b) { float r; asm("v_max_f32 %0, %1, %2" : "=v"(r) : "v"(a), "v"(b)); return r; }
__device__ __forceinline__ float max32a(const f32x16& p, const f32x16& q) {
  const float a0 = max3a(p[0], p[1], p[2]), a1 = max3a(p[3], p[4], p[5]), a2 = max3a(p[6], p[7], p[8]), a3 = max3a(p[9], p[10], p[11]), a4 = max3a(p[12], p[13], p[14]);
  const float b0 = max3a(q[0], q[1], q[2]), b1 = max3a(q[3], q[4], q[5]), b2 = max3a(q[6], q[7], q[8]), b3 = max3a(q[9], q[10], q[11]), b4 = max3a(q[12], q[13], q[14]);
  const float c0 = max3a(a0, a1, a2), c1 = max3a(a3, a4, p[15]), c2 = max3a(b0, b1, b2), c3 = max3a(b3, b4, q[15]);
  return max2a(max3a(c0, c1, c2), c3); }
typedef short v2s_ __attribute__((ext_vector_type(2)));
struct DiffEpi { const bf16_t* O0; unsigned char* X2; float lam; const float* sg; };
template <int NCB, int VAR, bool FAST, int EM>
__device__ __forceinline__ void attn_body_e_t(const v8i_ (&qf)[2], const unsigned char* __restrict__ K8, const int ldk8,
                                            const unsigned char* __restrict__ V8T, bf16_t* __restrict__ Ob, const int ldo, const int seq, LAS char* lds, const DiffEpi de) {
  int tid = threadIdx.x; asm volatile("" : "+v"(tid)); tid &= 511;
  const int wid = __builtin_amdgcn_readfirstlane(tid >> 6), lane = tid & 63, r32 = lane & 31, hi = lane >> 5;
  constexpr int SK8 = KVBLK * 128, SV8 = NCB * 32 * 64;
  LAS char* K_lds = lds; LAS char* V_lds = lds + 2 * SK8;
  LAS float* li_l = (LAS float*)(lds + 2 * SK8 + 2 * SV8) + wid * 64;
  float l_reg = 0; f32x16 o[NCB] = {};
  const int kvo = ((wid & 3) * 16 + (lane >> 2)) * ldk8 + (((lane & 3) ^ ((lane >> 4) & 3)) << 4) + (wid >> 2) * 64;
  const int vvo = lane * 16 + wid * 1024, pz = wid * 1024;
  const __amdgpu_buffer_rsrc_t krs = __builtin_amdgcn_make_buffer_rsrc((void*)K8, 0, 0x7ffffff0, 0x00020000);
  const __amdgpu_buffer_rsrc_t vrs = __builtin_amdgcn_make_buffer_rsrc((void*)V8T, 0, 0x7ffffff0, 0x00020000);
#define VM0() asm volatile("s_waitcnt vmcnt(0)" ::: "memory")
#define KDMA(b, t) DMA16(krs, K_lds + (b) * SK8 + pz, kvo, (t) * KVBLK * ldk8)
#define VDMA(b, t) do { DMA16(vrs, V_lds + (b) * SV8 + pz, vvo, (t) * SV8); if (NCB == 8) DMA16(vrs, V_lds + (b) * SV8 + pz + 8192, vvo, (t) * SV8 + 8192); } while (0)
  const int ka0 = (int)(uintptr_t)K_lds + r32 * 64 + (((2 * hi) ^ ((r32 >> 2) & 3)) << 4), ka1 = ka0 ^ 16;
  constexpr int VOFF = 2 * SK8;
  int sc1; asm volatile("v_mov_b32 %0, 0x7f7f7f7f" : "=v"(sc1));
  const int NT = seq / KVBLK;
#define RD128(dst, addr, OFF) asm volatile("ds_read_b128 %0, %1 offset:%2" : "=&v"(dst) : "v"(addr), "i"(OFF) : "memory")
#define V8(x, y) (v8i_){x[0], x[1], x[2], x[3], y[0], y[1], y[2], y[3]}
#define VFR(A_, B_, b, d0) do { RD128(A_, ka0, VOFF + (b) * SV8 + (d0) * 2048); RD128(B_, ka1, VOFF + (b) * SV8 + (d0) * 2048); } while (0)
#define KFR(A_, B_, b, i) do { RD128(A_, ka0, (b) * 8192 + ((i) & 1) * 4096 + ((i) >> 1) * 2048); RD128(B_, ka1, (b) * 8192 + ((i) & 1) * 4096 + ((i) >> 1) * 2048); } while (0)
#define MF_ "v_mfma_scale_f32_32x32x64_f8f6f4 "
#define PVM(A_, B_, d0, PA, SC) do { SCHED; { const v8i_ vfr = V8(A_, B_); \
    if (VAR == 2) { asm volatile("s_nop 3" : "+v"(o[(d0) < NCB ? (d0) : 0]) : "v"(PA), "v"(vfr), "v"(SC), "v"(sc1)); } else { asm volatile(MF_ "%0, %1, %2, %0, %3, %4 op_sel_hi:[0,0,0]\n\ts_nop 3" : "+v"(o[(d0) < NCB ? (d0) : 0]) : "v"(PA), "v"(vfr), "v"(SC), "v"(sc1)); } } SCHED; } while (0)
#define QKZ(A_, B_, N_, qi) do { SCHED; { const v8i_ kf = V8(A_, B_); if (VAR == 2) { asm volatile("s_nop 3" : "=&v"(N_) : "v"(kf), "v"(qf[qi]), "v"(sc1)); } else { asm volatile(MF_ "%0, %1, %2, 0, %3, %3 op_sel_hi:[0,0,0]\n\ts_nop 3" : "=&v"(N_) : "v"(kf), "v"(qf[qi]), "v"(sc1)); } } SCHED; } while (0)
#define QKA(A_, B_, N_, qi) do { SCHED; { const v8i_ kf = V8(A_, B_); if (VAR == 2) { asm volatile("s_nop 3" : "+v"(N_) : "v"(kf), "v"(qf[qi]), "v"(sc1)); } else { asm volatile(MF_ "%0, %1, %2, %0, %3, %3 op_sel_hi:[0,0,0]\n\ts_nop 3" : "+v"(N_) : "v"(kf), "v"(qf[qi]), "v"(sc1)); } } SCHED; } while (0)
#define QKZ0(A_, B_, N_, qi) do { SCHED; { const v8i_ kf = V8(A_, B_); if (VAR == 2) { asm volatile("" : "=&v"(N_) : "v"(kf), "v"(qf[qi]), "v"(sc1)); } else { asm volatile(MF_ "%0, %1, %2, 0, %3, %3 op_sel_hi:[0,0,0]" : "=&v"(N_) : "v"(kf), "v"(qf[qi]), "v"(sc1)); } } SCHED; } while (0)
#define QKA0(A_, B_, N_, qi) do { SCHED; { const v8i_ kf = V8(A_, B_); if (VAR == 2) { asm volatile("" : "+v"(N_) : "v"(kf), "v"(qf[qi]), "v"(sc1)); } else { asm volatile(MF_ "%0, %1, %2, %0, %3, %3 op_sel_hi:[0,0,0]" : "+v"(N_) : "v"(kf), "v"(qf[qi]), "v"(sc1)); } } SCHED; } while (0)
#define PVR(A_, B_, d0, PA, SC, RA_, RB_, OFF) do { SCHED; { const v8i_ vfr = V8(A_, B_); \
    if (VAR == 2) { asm volatile("ds_read_b128 %1, %7 offset:%9\n\tds_read_b128 %2, %8 offset:%9" \
      : "+v"(o[(d0) < NCB ? (d0) : 0]), "=&v"(RA_), "=&v"(RB_) : "v"(PA), "v"(vfr), "v"(SC), "v"(sc1), "v"(ka0), "v"(ka1), "i"(OFF) : "memory"); } else { asm volatile(MF_ "%0, %3, %4, %0, %5, %6 op_sel_hi:[0,0,0]\n\tds_read_b128 %1, %7 offset:%9\n\tds_read_b128 %2, %8 offset:%9" \
      : "+v"(o[(d0) < NCB ? (d0) : 0]), "=&v"(RA_), "=&v"(RB_) : "v"(PA), "v"(vfr), "v"(SC), "v"(sc1), "v"(ka0), "v"(ka1), "i"(OFF) : "memory"); } } SCHED; } while (0)
#define QKZR(A_, B_, N_, qi, RA_, RB_, OFF) do { SCHED; { const v8i_ kf = V8(A_, B_); \
    if (VAR == 2) { asm volatile("ds_read_b128 %1, %6 offset:%8\n\tds_read_b128 %2, %7 offset:%8" \
      : "=&v"(N_), "=&v"(RA_), "=&v"(RB_) : "v"(kf), "v"(qf[qi]), "v"(sc1), "v"(ka0), "v"(ka1), "i"(OFF) : "memory"); } else { asm volatile(MF_ "%0, %3, %4, 0, %5, %5 op_sel_hi:[0,0,0]\n\tds_read_b128 %1, %6 offset:%8\n\tds_read_b128 %2, %7 offset:%8" \
      : "=&v"(N_), "=&v"(RA_), "=&v"(RB_) : "v"(kf), "v"(qf[qi]), "v"(sc1), "v"(ka0), "v"(ka1), "i"(OFF) : "memory"); } } SCHED; } while (0)
#define QKAR(A_, B_, N_, qi, RA_, RB_, OFF) do { SCHED; { const v8i_ kf = V8(A_, B_); \
    if (VAR == 2) { asm volatile("ds_read_b128 %1, %6 offset:%8\n\tds_read_b128 %2, %7 offset:%8" \
      : "+v"(N_), "=&v"(RA_), "=&v"(RB_) : "v"(kf), "v"(qf[qi]), "v"(sc1), "v"(ka0), "v"(ka1), "i"(OFF) : "memory"); } else { asm volatile(MF_ "%0, %3, %4, %0, %5, %5 op_sel_hi:[0,0,0]\n\tds_read_b128 %1, %6 offset:%8\n\tds_read_b128 %2, %7 offset:%8" \
      : "+v"(N_), "=&v"(RA_), "=&v"(RB_) : "v"(kf), "v"(qf[qi]), "v"(sc1), "v"(ka0), "v"(ka1), "i"(OFF) : "memory"); } } SCHED; } while (0)
#define VO(b, d0) (VOFF + (b) * SV8 + (d0) * 2048)
#define KO(b, i) ((b) * 8192 + ((i) & 1) * 4096 + ((i) >> 1) * 2048)
#define M1(P0, P1) do { if (VAR != 1) mo = max32a(P0, P1); } while (0)
#define M2(SCN) do { if (VAR == 1) { asm volatile("" : "=v"(SCN)); ls0 = 0.f; e0 = 0.f; break; } auto sA = __builtin_amdgcn_permlane32_swap(__float_as_uint(mo), __float_as_uint(mo), false, false); \
    e0 = fminf(fmaxf(ceilf(max2a(__uint_as_float(sA[0]), __uint_as_float(sA[1]))), -120.f), 120.f); SCN = 127 + (int)e0; if (FAST) scf = __int_as_float(SCN << 23); ls0 = 0.f; } while (0)
#define PEL(P0, P1, u, k) (((u) >> 1) & 1 ? P1 : P0)[4 * ((u) >> 2) + 2 * ((u) & 1) + (k)]
#define U(P0, P1, u) do { if (VAR == 1) break; \
    const float xa = __builtin_amdgcn_exp2f(FAST ? PEL(P0, P1, u, 0) : PEL(P0, P1, u, 0) - e0), xb = __builtin_amdgcn_exp2f(FAST ? PEL(P0, P1, u, 1) : PEL(P0, P1, u, 1) - e0); \
    ls0 += xa; ls0 += xb; \
    int wo_; if (((u) & 1) == 0) asm volatile("" : "=v"(wo_)); else wo_ = (((u) >> 1) & 1) ? wy : wx; \
    if (FAST) wo_ = __builtin_bit_cast(int, __builtin_amdgcn_cvt_scalef32_pk_fp8_f32(__builtin_bit_cast(v2s_, wo_), xa, xb, scf, ((u) & 1) != 0)); \
    else wo_ = __builtin_amdgcn_cvt_pk_fp8_f32(xa, xb, wo_, ((u) & 1) != 0); \
    if (((u) >> 1) & 1) wy = wo_; else wx = wo_; } while (0)
#define SW(PN, q) do { if (VAR == 1) { if ((q) == 3) asm volatile("" : "=v"(PN)); break; } auto rr = __builtin_amdgcn_permlane32_swap((unsigned)wx, (unsigned)wy, false, false); PN[q] = (int)rr[0]; PN[4 + (q)] = (int)rr[1]; } while (0)
#define HOLD(A_, B_) asm volatile("" :: "v"(A_), "v"(B_))
#define ITER_E(b, t, P0, P1, N0, N1, PA, PN, SCA, SCN) do { \
    if (VAR != 3) { if ((t) + 2 < NT) KDMA(b, (t) + 2); VDMA(b, t); } \
    VFR(va, vb, (b) ^ 1, 0); VFR(vc, vd, (b) ^ 1, 1); \
    asm volatile("s_nop 1" : "+v"(P0), "+v"(P1));     \
    SCHED; M1(P0, P1); SCHED; \
    if (NCB == 8) { \
    LGK(2); PVR(va, vb, 0, PA, SCA, ve, vf, VO((b) ^ 1, 2)); M2(SCN); HOLD(va, vb); \
    LGK(2); PVR(vc, vd, 1, PA, SCA, va, vb, VO((b) ^ 1, 3)); U(P0, P1, 0); U(P0, P1, 1); HOLD(vc, vd); \
    LGK(2); PVR(ve, vf, 2, PA, SCA, vc, vd, VO((b) ^ 1, 4)); U(P0, P1, 2); U(P0, P1, 3); SW(PN, 0); HOLD(ve, vf); \
    LGK(2); PVR(va, vb, 3, PA, SCA, ve, vf, VO((b) ^ 1, 5)); U(P0, P1, 4); HOLD(va, vb); \
    LGK(2); PVR(vc, vd, 4, PA, SCA, va, vb, VO((b) ^ 1, 6)); U(P0, P1, 5); U(P0, P1, 6); HOLD(vc, vd); \
    LGK(2); PVR(ve, vf, 5, PA, SCA, vc, vd, VO((b) ^ 1, 7)); U(P0, P1, 7); SW(PN, 1); HOLD(ve, vf); \
    LGK(2); PVR(va, vb, 6, PA, SCA, ve, vf, KO((b) ^ 1, 0)); U(P0, P1, 8); U(P0, P1, 9); HOLD(va, vb); \
    LGK(2); PVR(vc, vd, NCB - 1, PA, SCA, va, vb, KO((b) ^ 1, 1)); U(P0, P1, 10); HOLD(vc, vd); \
    LGK(2); QKZR(ve, vf, N0, 0, vc, vd, KO((b) ^ 1, 2)); U(P0, P1, 11); SW(PN, 2); U(P0, P1, 12); HOLD(ve, vf); \
    LGK(2); QKAR(va, vb, N0, 1, ve, vf, KO((b) ^ 1, 3)); U(P0, P1, 13); HOLD(va, vb); \
    LGK(2); QKZ0(vc, vd, N1, 0); U(P0, P1, 14); HOLD(vc, vd); \
    LGK(0); QKA0(ve, vf, N1, 1); U(P0, P1, 15); SW(PN, 3); HOLD(ve, vf); \
    } else { \
    LGK(2); PVR(va, vb, 0, PA, SCA, ve, vf, VO((b) ^ 1, 2)); M2(SCN); HOLD(va, vb); \
    LGK(2); PVR(vc, vd, 1, PA, SCA, va, vb, VO((b) ^ 1, 3)); U(P0, P1, 0); U(P0, P1, 1); HOLD(vc, vd); \
    LGK(2); PVR(ve, vf, 2, PA, SCA, vc, vd, KO((b) ^ 1, 0)); U(P0, P1, 2); U(P0, P1, 3); SW(PN, 0); U(P0, P1, 4); HOLD(ve, vf); \
    LGK(2); PVR(va, vb, 3, PA, SCA, ve, vf, KO((b) ^ 1, 1)); U(P0, P1, 5); U(P0, P1, 6); U(P0, P1, 7); SW(PN, 1); HOLD(va, vb); \
    LGK(2); QKZR(vc, vd, N0, 0, va, vb, KO((b) ^ 1, 2)); U(P0, P1, 8); U(P0, P1, 9); U(P0, P1, 10); HOLD(vc, vd); \
    LGK(2); QKAR(ve, vf, N0, 1, vc, vd, KO((b) ^ 1, 3)); U(P0, P1, 11); SW(PN, 2); U(P0, P1, 12); U(P0, P1, 13); HOLD(ve, vf); \
    LGK(2); QKZ0(va, vb, N1, 0); U(P0, P1, 14); HOLD(va, vb); \
    LGK(0); QKA0(vc, vd, N1, 1); U(P0, P1, 15); SW(PN, 3); HOLD(vc, vd); \
    } \
    asm volatile("" : "+v"(ls0));     \
    if (FAST) l_reg += ls0; else l_reg += __builtin_amdgcn_exp2f(e0) * ls0; \
    if (VAR != 3) { VM0(); __syncthreads(); } } while (0)
  f32x16 p0, p1, n0, n1; v8i_ pa8 = {}, pb8; int scaA = 127, scaB; v4i va, vb, vc, vd, ve, vf;
  float mo, e0, ls0, scf = 1.f; int wx = 0, wy = 0;
  KDMA(0, 0); if (NT > 1) KDMA(1, 1); VDMA(1, 0); VM0(); __syncthreads();
  KFR(va, vb, 0, 0); KFR(vc, vd, 0, 1); KFR(ve, vf, 0, 2);
  LGK(4); QKZ(va, vb, p0, 0); KFR(va, vb, 0, 3);
  LGK(4); QKA(vc, vd, p0, 1);
  LGK(2); QKZ(ve, vf, p1, 0);
  LGK(0); QKA(va, vb, p1, 1);
  asm volatile("s_nop 4" : "+v"(pa8), "+v"(scaA));
  __syncthreads();
  for (int j = 0; j < NT; j += 2) {
    ITER_E(0, j, p0, p1, n0, n1, pa8, pb8, scaA, scaB);
    ITER_E(1, j + 1, n0, n1, p0, p1, pb8, pa8, scaB, scaA);
  }
  VFR(va, vb, 1, 0); VFR(vc, vd, 1, 1);
  asm volatile("s_nop 4" : "+v"(pa8), "+v"(scaA));
  if (NCB == 8) {
    LGK(2); PVM(va, vb, 0, pa8, scaA); VFR(ve, vf, 1, 2);
    LGK(2); PVM(vc, vd, 1, pa8, scaA); VFR(va, vb, 1, 3);
    LGK(2); PVM(ve, vf, 2, pa8, scaA); VFR(vc, vd, 1, 4);
    LGK(2); PVM(va, vb, 3, pa8, scaA); VFR(ve, vf, 1, 5);
    LGK(2); PVM(vc, vd, 4, pa8, scaA); VFR(va, vb, 1, 6);
    LGK(2); PVM(ve, vf, 5, pa8, scaA); VFR(vc, vd, 1, 7);
    LGK(2); PVM(va, vb, 6, pa8, scaA);
    LGK(0); PVM(vc, vd, NCB - 1, pa8, scaA);
  } else {
    LGK(2); PVM(va, vb, 0, pa8, scaA); VFR(ve, vf, 1, 2);
    LGK(2); PVM(vc, vd, 1, pa8, scaA); VFR(va, vb, 1, 3);
    LGK(2); PVM(ve, vf, 2, pa8, scaA);
    LGK(0); PVM(va, vb, 3, pa8, scaA);
  }
  asm volatile("s_nop 15\n\ts_nop 7" ::: "memory");
#pragma unroll
  for (int d0 = 0; d0 < NCB; ++d0) asm volatile("" : "+v"(o[d0]));
  { auto rr = __builtin_amdgcn_permlane32_swap(__float_as_uint(l_reg), __float_as_uint(l_reg), false, false); l_reg = __uint_as_float(rr[0]) + __uint_as_float(rr[1]); }
  if (hi == 0) li_l[r32] = l_reg; asm volatile("s_waitcnt lgkmcnt(0)" ::: "memory");
  bf16_t* Ow = Ob + (long)(wid * QBLK) * ldo;
  if (EM == 2) {
    float sgv[NCB];
#pragma unroll
    for (int d0 = 0; d0 < NCB; ++d0) sgv[d0] = de.sg[d0 * 32 + r32];
#pragma unroll
    for (int r = 0; r < 16; ++r) { const int orow = crow(r, hi); const float rl = __builtin_amdgcn_rcpf(li_l[orow]);
      float dv[NCB], ssq = 0.f;
#pragma unroll
      for (int d0 = 0; d0 < NCB; ++d0) { const float o0 = bf2f(de.O0[(long)(wid * QBLK + orow) * ldo + d0 * 32 + r32]); dv[d0] = o0 - de.lam * (o[d0][r] * rl); ssq += dv[d0] * dv[d0]; }
      ssq += __shfl_xor(ssq, 1); ssq += __shfl_xor(ssq, 2); ssq += __shfl_xor(ssq, 4); ssq += __shfl_xor(ssq, 8); ssq += __shfl_xor(ssq, 16);
      const float rstd = rsqrtf(ssq * (1.f / 256) + EPS) * (1.f - LAM_INIT);
#pragma unroll
      for (int d0 = 0; d0 < NCB; ++d0) { const float y = dv[d0] * rstd * sgv[d0];
        if (DENSE8_G2) de.X2[(long)(wid * QBLK + orow) * D + d0 * 32 + r32] = (unsigned char)__builtin_amdgcn_cvt_pk_fp8_f32(clamp8(y * 8.f), 0.f, 0, false);
        else ((bf16_t*)de.X2)[(long)(wid * QBLK + orow) * D + d0 * 32 + r32] = f2bf(y); } }
  } else {
#pragma unroll
  for (int r = 0; r < 16; ++r) { const int orow = crow(r, hi); const float rl = __builtin_amdgcn_rcpf(li_l[orow]);
#pragma unroll
    for (int d0 = 0; d0 < NCB; ++d0) {
      if (EM == 1) ((unsigned char*)Ob)[(long)(wid * QBLK + orow) * ldo + d0 * 32 + r32] = (unsigned char)__builtin_amdgcn_cvt_pk_fp8_f32(clamp8(o[d0][r] * rl * 8.f), 0.f, 0, false);
      else Ow[(long)orow * ldo + d0 * 32 + r32] = f2bf(o[d0][r] * rl); } }
  }
  VM0();
  __syncthreads();
#undef VM0
#undef KDMA
#undef VDMA
#undef RD128
#undef V8
#undef VFR
#undef KFR
#undef PVM
#undef QKZ
#undef QKA
#undef QKZ0
#undef QKA0
#undef PVR
#undef QKZR
#undef QKAR
#undef VO
#undef KO
#undef MF_
#undef M1
#undef M2
#undef U
#undef PEL
#undef SW
#undef ITER_E
#undef HOLD
}
template <int NCB, int VAR = 0, int EM = 0>
__device__ __forceinline__ void attn_body_e(const bf16_t* __restrict__ Qb, const int ldq, const unsigned char* __restrict__ K8, const int ldk8,
                                            const unsigned char* __restrict__ V8T, bf16_t* __restrict__ Ob, const int ldo, const int seq, const float kmax2, LAS char* lds, const DiffEpi de = DiffEpi{}) {
  int tid = threadIdx.x; asm volatile("" : "+v"(tid)); tid &= 511;
  v8i_ qf[2];
  const float nmc = load_q8(Qb + (long)((tid >> 6) * QBLK + (tid & 31)) * ldq, (tid & 63) >> 5, qf, kmax2);
  if (__all(nmc > -100.f)) attn_body_e_t<NCB, VAR, true, EM>(qf, K8, ldk8, V8T, Ob, ldo, seq, lds, de);
  else attn_body_e_t<NCB, VAR, false, EM>(qf, K8, ldk8, V8T, Ob, ldo, seq, lds, de);
}
#undef PK4
}

__device__ __forceinline__ int perm_plain8(int n) { const int r = n & 31; return (n & ~31) + 16 * ((r >> 2) & 1) + 4 * (r >> 3) + (r & 3); }
__device__ __forceinline__ int perm_row(int kind, int n) {
  if (kind == 0) return perm_plain8(n);
  if (kind == 1) { if (n < N_QKV0) return perm_plain8(n); const int c = n - N_QKV0; const int ch = c & 1023; return N_QKV0 + 32 * (ch >> 4) + ((c >> 10) << 4) + (ch & 15); }
  return 32 * (n >> 4) + ((kind == 3) ? 16 : 0) + (n & 15);
}
__device__ __forceinline__ void cvt_tile(const float* __restrict__ src, int N, bf16_t* __restrict__ dst, int K, int kind, int k0, int n0, LAS unsigned* t32) {
  int tid = threadIdx.x; asm volatile("" : "+v"(tid)); tid &= 511;
#pragma unroll
  for (int j = 0; j < 2; ++j) {
    const int item = tid + 512 * j, kp = item >> 4, q = item & 15;
    const f32x4 v0 = *(const f32x4*)(src + (size_t)(k0 + 2 * kp) * N + n0 + 4 * q);
    const f32x4 v1 = *(const f32x4*)(src + (size_t)(k0 + 2 * kp + 1) * N + n0 + 4 * q);
#pragma unroll
    for (int i = 0; i < 4; ++i) t32[(4 * q + i) * 65 + kp] = cvtpk(v0[i], v1[i]);
  }
  __syncthreads();
#pragma unroll
  for (int j = 0; j < 2; ++j) {
    const int item = tid + 512 * j, n = item >> 4, ko = item & 15;
    u32x4 v;
#pragma unroll
    for (int i = 0; i < 4; ++i) v[i] = t32[n * 65 + 4 * ko + i];
    *(u32x4*)(dst + (size_t)perm_row(kind, n0 + n) * K + k0 + 8 * ko) = v;
  }
  __syncthreads();
}
__device__ __forceinline__ void cvt_matrix_units(const float* src, int K, int N, bf16_t* dst, int kind, int u0, int ustride, LAS unsigned* t32) {
  const int nN = N / 64, nK = K / 128;
  for (int u = u0; u < nN * nK; u += ustride) cvt_tile(src, N, dst, K, kind, (u / nN) * 128, (u % nN) * 64, t32);
}
constexpr size_t WMOE8_E = (size_t)1024 * D + (size_t)D * EFF;
__device__ __forceinline__ void cvt_tile8(const float* __restrict__ src, int N, unsigned char* __restrict__ dst, int K, int kind, int k0, int n0, float scale, LAS unsigned* t32) {
  int tid = threadIdx.x; asm volatile("" : "+v"(tid)); tid &= 511;
  { const int kq = tid >> 4, q = tid & 15;
    f32x4 v[4];
#pragma unroll
    for (int r = 0; r < 4; ++r) v[r] = *(const f32x4*)(src + (size_t)(k0 + 4 * kq + r) * N + n0 + 4 * q);
#pragma unroll
    for (int i = 0; i < 4; ++i) t32[(4 * q + i) * 33 + kq] = pack_fp8x4(v[0][i] * scale, v[1][i] * scale, v[2][i] * scale, v[3][i] * scale); }
  __syncthreads();
  { const int n = tid >> 3, kc = tid & 7;
    u32x4 v;
#pragma unroll
    for (int i = 0; i < 4; ++i) v[i] = t32[n * 33 + 4 * kc + i];
    *(u32x4*)(dst + (size_t)perm_row(kind, n0 + n) * K + k0 + 16 * kc) = v; }
  __syncthreads();
}
__device__ __forceinline__ void cvt_matrix_units8(const float* src, int K, int N, unsigned char* dst, int kind, float scale, LAS unsigned* t32) {
  const int nN = N / 64, nK = K / 128;
  for (int u = blockIdx.x; u < nN * nK; u += gridDim.x) cvt_tile8(src, N, dst, K, kind, (u / nN) * 128, (u % nN) * 64, scale, t32);
}
__device__ __forceinline__ void cvt_tile8w(const float* __restrict__ src, int N, unsigned char* __restrict__ dst, int K, int kind, int k0, int n0, float scale, LAS unsigned* t32) {
  int tid = threadIdx.x; asm volatile("" : "+v"(tid)); tid &= 511;
  { const int kq = tid >> 6, q = tid & 63;
    f32x4 v[16];
#pragma unroll
    for (int r = 0; r < 16; ++r) v[r] = *(const f32x4*)(src + (size_t)(k0 + 16 * kq + r) * N + n0 + 4 * q);
#pragma unroll
    for (int i = 0; i < 4; ++i)
#pragma unroll
      for (int h = 0; h < 4; ++h) t32[(4 * q + i) * 33 + 4 * kq + h] = pack_fp8x4(v[4 * h][i] * scale, v[4 * h + 1][i] * scale, v[4 * h + 2][i] * scale, v[4 * h + 3][i] * scale); }
  __syncthreads();
  { const int n = tid >> 1, kc = tid & 1;
    unsigned char* dp = dst + (size_t)perm_row(kind, n0 + n) * K + k0 + 64 * kc;
#pragma unroll
    for (int c = 0; c < 4; ++c) { u32x4 o;
#pragma unroll
      for (int i = 0; i < 4; ++i) o[i] = t32[n * 33 + 16 * kc + 4 * c + i];
      *(u32x4*)(dp + 16 * c) = o; } }
  __syncthreads();
}
__device__ __forceinline__ void cvt_moe_all8(const Args& a, LAS unsigned* t32) {
  unsigned char* W = (unsigned char*)(a.ws + WS_WMOE);
  for (int u = blockIdx.x; u < 2 * 65 * 96; u += gridDim.x) {
    const int le = u / 96, L = le / 65, e = le % 65, r = u % 96, mtx = r >> 5, lu = r & 31;
    const float* src; unsigned char* dst = W + (size_t)le * WMOE8_E; int K, N, kind; float sc;
    if (mtx == 0)      { src = e < 64 ? a.in[21] + ((size_t)L * 64 + e) * D * EFF : a.in[24] + (size_t)L * D * EFF; K = D; N = EFF; kind = 2; sc = 256.f; }
    else if (mtx == 1) { src = e < 64 ? a.in[22] + ((size_t)L * 64 + e) * D * EFF : a.in[25] + (size_t)L * D * EFF; K = D; N = EFF; kind = 3; sc = 256.f; }
    else               { src = e < 64 ? a.in[23] + ((size_t)L * 64 + e) * EFF * D : a.in[26] + (size_t)L * EFF * D; K = EFF; N = D; kind = 0; sc = 128.f; dst += (size_t)1024 * D; }
    const int nN = N / 256;
    cvt_tile8w(src, N, dst, K, kind, (lu / nN) * 128, (lu % nN) * 256, sc, t32);
  }
}

__device__ __forceinline__ void ld_row_f32(const float* __restrict__ p, int lane, float (&v)[32]) {
#pragma unroll
  for (int j = 0; j < 4; ++j) { const f32x4 t0 = *(const f32x4*)(p + 8 * lane + 512 * j), t1 = *(const f32x4*)(p + 8 * lane + 512 * j + 4);
#pragma unroll
    for (int i = 0; i < 4; ++i) { v[8 * j + i] = t0[i]; v[8 * j + 4 + i] = t1[i]; } }
}
__device__ __forceinline__ void ld_row_bf16(const bf16_t* __restrict__ p, int lane, float (&v)[32]) {
#pragma unroll
  for (int j = 0; j < 4; ++j) { const u32x4 t = *(const u32x4*)(p + 8 * lane + 512 * j);
#pragma unroll
    for (int i = 0; i < 4; ++i) { v[8 * j + 2 * i] = bflo(t[i]); v[8 * j + 2 * i + 1] = bfhi(t[i]); } }
}
__device__ __forceinline__ void ld_row_fp8(const unsigned char* __restrict__ p, int lane, float (&v)[32]) {
#pragma unroll
  for (int j = 0; j < 4; ++j) { const u32x2 t = *(const u32x2*)(p + 8 * lane + 512 * j);
#pragma unroll
    for (int i = 0; i < 2; ++i) { v[8 * j + 4 * i] = __builtin_amdgcn_cvt_f32_fp8((int)t[i], 0); v[8 * j + 4 * i + 1] = __builtin_amdgcn_cvt_f32_fp8((int)t[i], 1);
      v[8 * j + 4 * i + 2] = __builtin_amdgcn_cvt_f32_fp8((int)t[i], 2); v[8 * j + 4 * i + 3] = __builtin_amdgcn_cvt_f32_fp8((int)t[i], 3); } }
}
__device__ __forceinline__ void ld8f(const float* __restrict__ p, float (&x)[8]) { const f32x4 t0 = *(const f32x4*)p, t1 = *(const f32x4*)(p + 4);
#pragma unroll
  for (int i = 0; i < 4; ++i) { x[i] = t0[i]; x[4 + i] = t1[i]; } }
__device__ __forceinline__ void st8f(float* __restrict__ p, const float* x) { f32x4 t0 = {x[0], x[1], x[2], x[3]}, t1 = {x[4], x[5], x[6], x[7]}; *(f32x4*)p = t0; *(f32x4*)(p + 4) = t1; }
__device__ __forceinline__ void st8h(bf16_t* __restrict__ p, const float* x) { u32x4 t = {cvtpk(x[0], x[1]), cvtpk(x[2], x[3]), cvtpk(x[4], x[5]), cvtpk(x[6], x[7])}; *(u32x4*)p = t; }
__device__ __forceinline__ float sumsq32(const float (&v)[32]) { float s = 0;
#pragma unroll
  for (int i = 0; i < 32; ++i) s += v[i] * v[i];
  return wave_sum(s); }
template <bool COPY, bool OUT8 = false>
__device__ __forceinline__ void modulate_store(const float (&v)[32], float rstd, const float* __restrict__ g, const float* __restrict__ shift, const float* __restrict__ scale,
                                               bf16_t* __restrict__ dst, int lane, LAS float* f32copy, int trow = 0) {
#pragma unroll
  for (int j = 0; j < 4; ++j) {
    const int idx = 8 * lane + 512 * j;
    float gv[8], sh[8], sc[8], y[8]; ld8f(g + idx, gv); ld8f(shift + idx, sh); ld8f(scale + idx, sc);
#pragma unroll
    for (int i = 0; i < 8; ++i) y[i] = v[8 * j + i] * rstd * gv[i] * (1.f + sc[i]) + sh[i];
    if (OUT8) { u32x2 p8 = {pack_fp8x4(y[0], y[1], y[2], y[3]), pack_fp8x4(y[4], y[5], y[6], y[7])}; *(u32x2*)((unsigned char*)dst + idx) = p8; }
    else { u32x4 pk = {cvtpk(y[0], y[1]), cvtpk(y[2], y[3]), cvtpk(y[4], y[5]), cvtpk(y[6], y[7])}; *(u32x4*)(dst + idx) = pk; }
    if (COPY) {
      const u32x4 hi = {cvtpk(y[0], y[1]), cvtpk(y[2], y[3]), cvtpk(y[4], y[5]), cvtpk(y[6], y[7])};
      const u32x4 lo = {cvtpk(y[0] - bflo(hi[0]), y[1] - bfhi(hi[0])), cvtpk(y[2] - bflo(hi[1]), y[3] - bfhi(hi[1])), cvtpk(y[4] - bflo(hi[2]), y[5] - bfhi(hi[2])), cvtpk(y[6] - bflo(hi[3]), y[7] - bfhi(hi[3]))};
      LAS char* rowp = (LAS char*)f32copy + trow * 4096 + ((((idx >> 3)) ^ (4 * (trow & 3) + (trow >> 2))) << 4);
      *(LAS u32x4*)rowp = hi; *(LAS u32x4*)(rowp + 32768) = lo; }
  }
}

__device__ __forceinline__ void phase_prologue(const Args& a, LAS char* lds) {
  int tid = threadIdx.x; asm volatile("" : "+v"(tid)); tid &= 511; const int wave = tid >> 6, lane = tid & 63;
  {
    LAS float* sc = (LAS float*)lds;
    LAS float* part = sc + 4096;
    const float* c = a.in[1]; const float* cc = a.in[3];
    for (int i = tid; i < D; i += NTHREADS) { float v = c[i]; sc[i] = v * sigmoidf_(v); float u = cc[i]; sc[D + i] = u * sigmoidf_(u); }
    __syncthreads();
    float* MOD = (float*)(a.ws + WS_MOD);
    for (int u = blockIdx.x; u < 2 * 192; u += gridDim.x) {
      const int L = u / 192, chunk = u % 192;
      const float* W = a.in[4] + (size_t)L * D * 12288 + chunk * 64 + lane;
      float a0 = 0, a1 = 0; const int d0 = wave * 256;
#pragma unroll 8
      for (int dd = 0; dd < 256; ++dd) { const float w = W[(size_t)(d0 + dd) * 12288]; a0 += sc[d0 + dd] * w; a1 += sc[D + d0 + dd] * w; }
      part[(wave * 2 + 0) * 64 + lane] = a0; part[(wave * 2 + 1) * 64 + lane] = a1;
      __syncthreads();
      if (tid < 128) { const int which = tid >> 6; float s = 0;
#pragma unroll
        for (int w = 0; w < 8; ++w) s += part[(w * 2 + which) * 64 + lane];
        const int j = chunk * 64 + lane; MOD[(size_t)(L * 2 + which) * 12288 + j] = s + a.in[5][L * 12288 + j]; }
      __syncthreads();
    }
  }
  { const float* Wr = a.in[19]; bf16_t* RTo = (bf16_t*)(a.ws + WS_RT);
    for (int it = blockIdx.x * NTHREADS + tid; it < 2 * 16384; it += gridDim.x * NTHREADS) {
      const int ln = it & 63, ks = (it >> 6) & 63, nt = (it >> 12) & 3, L = it >> 14;
      const float* wp = Wr + (size_t)L * D * NE + (size_t)(ks * 32 + 8 * (ln >> 4)) * NE + nt * 16 + (ln & 15);
      float w[8];
#pragma unroll
      for (int i = 0; i < 8; ++i) w[i] = wp[(size_t)i * NE];
      const u32x4 hi = {cvtpk(w[0], w[1]), cvtpk(w[2], w[3]), cvtpk(w[4], w[5]), cvtpk(w[6], w[7])};
      const u32x4 lo = {cvtpk(w[0] - bflo(hi[0]), w[1] - bfhi(hi[0])), cvtpk(w[2] - bflo(hi[1]), w[3] - bfhi(hi[1])), cvtpk(w[4] - bflo(hi[2]), w[5] - bfhi(hi[2])), cvtpk(w[6] - bflo(hi[3]), w[7] - bfhi(hi[3]))};
      *(u32x4*)(RTo + ((size_t)(L * 2) * 16384 + (it & 16383)) * 8) = hi; *(u32x4*)(RTo + ((size_t)(L * 2 + 1) * 16384 + (it & 16383)) * 8) = lo; }
  }
  LAS unsigned* t32 = (LAS unsigned*)lds;
#if DENSE8_G1
  cvt_matrix_units8(a.in[7], D, N_IN0, (unsigned char*)(a.ws + WS_WIN0), 1, 256.f, t32);
  cvt_matrix_units8(a.in[15], D, N_IN1, (unsigned char*)(a.ws + WS_WIN1), 0, 256.f, t32);
#else
  cvt_matrix_units(a.in[7], D, N_IN0, (bf16_t*)(a.ws + WS_WIN0), 1, blockIdx.x, gridDim.x, t32);
  cvt_matrix_units(a.in[15], D, N_IN1, (bf16_t*)(a.ws + WS_WIN1), 0, blockIdx.x, gridDim.x, t32);
#endif
#if DENSE8_G2
  cvt_matrix_units8(a.in[8], D, D, (unsigned char*)(a.ws + WS_WOUT0), 0, 256.f, t32);
  cvt_matrix_units8(a.in[16], D, D, (unsigned char*)(a.ws + WS_WOUT1), 0, 256.f, t32);
#else
  cvt_matrix_units(a.in[8], D, D, (bf16_t*)(a.ws + WS_WOUT0), 0, blockIdx.x, gridDim.x, t32);
  cvt_matrix_units(a.in[16], D, D, (bf16_t*)(a.ws + WS_WOUT1), 0, blockIdx.x, gridDim.x, t32);
#endif
  cvt_moe_all8(a, t32);
}

__device__ __forceinline__ void phase_modulate0(const Args& a) {
  int tid = threadIdx.x; asm volatile("" : "+v"(tid)); tid &= 511; const int wave = tid >> 6, lane = tid & 63;
  const float* MOD = (const float*)(a.ws + WS_MOD);
  bf16_t* A = (bf16_t*)(a.ws + WS_ABUF);
  for (int it = blockIdx.x; it < MT / 8; it += gridDim.x) {
    const int r = it * 8 + wave;
    const float* src = r < CTXL ? a.in[2] + (size_t)r * D : a.in[0] + (size_t)(r - CTXL) * D;
    const float* mod = MOD + (r < CTXL ? 12288 : 0);
    float v[32]; ld_row_f32(src, lane, v);
    const float rstd = rsqrtf(sumsq32(v) * (1.f / D) + EPS);
#if DENSE8_G1
    modulate_store<false, true>(v, rstd, a.in[6], mod, mod + D, (bf16_t*)((unsigned char*)A + (size_t)r * D), lane, nullptr);
#else
    modulate_store<false>(v, rstd, a.in[6], mod, mod + D, A + (size_t)r * D, lane, nullptr);
#endif
  }
}

__device__ __forceinline__ void rope_cs4(int r, int lane, float (&cs)[4], float (&sn)[4]) {
#pragma unroll
  for (int q = 0; q < 4; ++q) { cs[q] = 1.f; sn[q] = 0.f; }
  if (r >= CTXL) { const int t = r - CTXL; const int l = lane & 15, a = l >> 3, i0 = 4 * (l & 7);
    const float pos = a ? (float)(t & 63) : (float)(t >> 6);
#pragma unroll
    for (int q = 0; q < 4; ++q) { const float inv = powf(10000.f, -(float)(i0 + q) / 32.f); sincosf(pos * inv, &sn[q], &cs[q]); } }
}
__device__ __forceinline__ float sum16lanes(float v) { v += __shfl_xor(v, 1); v += __shfl_xor(v, 2); v += __shfl_xor(v, 4); v += __shfl_xor(v, 8); return v; }
__device__ __forceinline__ void phase_rope_conv0(const Args& a, LAS char* lds, bool dry = false) {
  int tid = threadIdx.x; asm volatile("" : "+v"(tid)); tid &= 511; const int wave = tid >> 6, lane = tid & 63;
  bf16_t* Q = (bf16_t*)(a.ws + WS_QKVU);
  {
    const bf16_t* HG = (const bf16_t*)(a.ws + WS_HG);
    bf16_t* X2 = (bf16_t*)(a.ws + WS_X2);
    LAS char* lt = lds;
    LAS float* part = (LAS float*)(lds + 62 * 2048);
    LAS float* stats = part + 512;
    const float* dw_w = a.in[11]; const float* dw_b = a.in[12]; const float* ln_g = a.in[13]; const float* ln_b = a.in[14];
    const __amdgpu_buffer_rsrc_t wrs = __builtin_amdgcn_make_buffer_rsrc((void*)dw_w, 0, 31 * 1024 * 4, 0x00020000);
    for (int u = blockIdx.x; u < 520; u += gridDim.x) {
      int seg0, seg1, r0;
      if (u < 8) { seg0 = 0; seg1 = CTXL; r0 = u * 32; } else { seg0 = CTXL; seg1 = MT; r0 = CTXL + (u - 8) * 32; }
      for (int c = tid; c < 62 * 128; c += NTHREADS) { const int rr = c >> 7, cc = c & 127, gr = r0 - 15 + rr;
        u32x4 v = {0u, 0u, 0u, 0u}; if (gr >= seg0 && gr < seg1) v = *(const u32x4*)(HG + (size_t)gr * 1024 + cc * 8);
        *(LAS u32x4*)(lt + rr * 2048 + cc * 16) = v; }
      __syncthreads();
      float w0[31], w1[31];
#pragma unroll
      for (int j = 0; j < 31; ++j) { const u32x2 w = __builtin_amdgcn_raw_buffer_load_b64(wrs, tid * 8, j * 4096, 0); w0[j] = __uint_as_float(w[0]); w1[j] = __uint_as_float(w[1]); }
      const f32x2 bb = *(const f32x2*)(dw_b + 2 * tid);
      const f32x2 gg = *(const f32x2*)(ln_g + 2 * tid), gb = *(const f32x2*)(ln_b + 2 * tid);
#pragma unroll 1
      for (int hf = 0; hf < 4; ++hf) {
        float o0[8], o1[8];
        LAS const char* lth = lt + (hf * 8) * 2048 + tid * 4;
#pragma unroll
        for (int r = 0; r < 8; ++r) { o0[r] = bb[0]; o1[r] = bb[1]; }
#pragma unroll
        for (int i = 0; i < 38; ++i) {
          const unsigned p = *(LAS const unsigned*)(lth + i * 2048);
          const float x0 = bflo(p), x1 = bfhi(p);
#pragma unroll
          for (int r = 0; r < 8; ++r) { const int j = i - r; if (j >= 0 && j < 31) { o0[r] += x0 * w0[j]; o1[r] += x1 * w1[j]; } }
        }
#pragma unroll
        for (int r = 0; r < 8; ++r) {
          const float s = wave_sum(o0[r] + o1[r]), q = wave_sum(o0[r] * o0[r] + o1[r] * o1[r]);
          if (lane == 0) { part[(r * 8 + wave) * 2] = s; part[(r * 8 + wave) * 2 + 1] = q; }
        }
        __syncthreads();
        if (tid < 8) { float s = 0, q = 0;
#pragma unroll
          for (int w = 0; w < 8; ++w) { s += part[(tid * 8 + w) * 2]; q += part[(tid * 8 + w) * 2 + 1]; }
          const float mean = s * (1.f / 1024), var = q * (1.f / 1024) - mean * mean;
          stats[tid * 2] = mean; stats[tid * 2 + 1] = rsqrtf(fmaxf(var, 0.f) + EPS); }
        __syncthreads();
#pragma unroll
        for (int r = 0; r < 8; ++r) {
          const float mean = stats[r * 2], rstd = stats[r * 2 + 1];
          float y0 = (o0[r] - mean) * rstd * gg[0] + gb[0], y1 = (o1[r] - mean) * rstd * gg[1] + gb[1];
          y0 = y0 * sigmoid_fast(y0); y1 = y1 * sigmoid_fast(y1);
#if DENSE8_G2
          *(unsigned short*)((unsigned char*)X2 + (size_t)(r0 + hf * 8 + r) * D + 1024 + 2 * tid) = (unsigned short)__builtin_amdgcn_cvt_pk_fp8_f32(y0 * 8.f, y1 * 8.f, 0, false);
#else
          *(unsigned*)(X2 + (size_t)(r0 + hf * 8 + r) * D + 1024 + 2 * tid) = cvtpk(y0, y1);
#endif
        }
      }
      __syncthreads();
    }
  }
  const float* qn = a.in[9]; const float* kn = a.in[10];
  unsigned* kmx = (unsigned*)(a.ws + WS_CTL + CTL_KMAX);
  const int slot = lane >> 4, l16 = lane & 15, e1 = (l16 >> 3) * 64 + 4 * (l16 & 7), e2 = e1 + 32;
  float km0 = 0.f, km1 = 0.f;
  for (int it = blockIdx.x; it < MT / 8; it += gridDim.x) {
    const int r = it * 8 + wave;
    float cs[4], sn[4]; rope_cs4(r, lane, cs, sn);
    bf16_t* rowp = Q + (size_t)r * N_QKV0;
#pragma unroll
    for (int hb = 0; hb < 12; hb += 4) {
      const int hh = hb + slot;
      if (hh < 10) {
        const float* g = hh < 8 ? qn : kn;
        const u32x2 a1 = *(const u32x2*)(rowp + hh * 128 + e1), a2 = *(const u32x2*)(rowp + hh * 128 + e2);
        float x1[4] = {bflo(a1[0]), bfhi(a1[0]), bflo(a1[1]), bfhi(a1[1])}, x2[4] = {bflo(a2[0]), bfhi(a2[0]), bflo(a2[1]), bfhi(a2[1])};
        float ss = 0;
#pragma unroll
        for (int q = 0; q < 4; ++q) ss += x1[q] * x1[q] + x2[q] * x2[q];
        ss = sum16lanes(ss);
        const float rstd = rsqrtf(ss * (1.f / 128) + EPS);
        const f32x4 g1 = *(const f32x4*)(g + e1), g2 = *(const f32x4*)(g + e2);
        float o1[4], o2[4], so = 0;
#pragma unroll
        for (int q = 0; q < 4; ++q) { const float y1 = x1[q] * rstd * g1[q], y2 = x2[q] * rstd * g2[q]; o1[q] = y1 * cs[q] - y2 * sn[q]; o2[q] = y2 * cs[q] + y1 * sn[q]; }
        const u32x2 w1 = {cvtpk(o1[0], o1[1]), cvtpk(o1[2], o1[3])}, w2 = {cvtpk(o2[0], o2[1]), cvtpk(o2[2], o2[3])};
        if (!dry) { *(u32x2*)(rowp + hh * 128 + e1) = w1; *(u32x2*)(rowp + hh * 128 + e2) = w2; }
        if (hb == 8) {
          const unsigned q1 = pack8x4(o1[0], o1[1], o1[2], o1[3]), q2 = pack8x4(o2[0], o2[1], o2[2], o2[3]);
          unsigned char* k8p = (unsigned char*)(a.ws + WS_K8) + (size_t)r * 256 + (hh - 8) * 128;
          *(unsigned*)(k8p + e1) = q1; *(unsigned*)(k8p + e2) = q2;
          so = sum16lanes(sq8x4(q1) + sq8x4(q2)); if (slot == 0) km0 = fmaxf(km0, so); else km1 = fmaxf(km1, so);
        }
      }
    }
  }
  if (l16 == 0 && slot < 2) atomicMax(&kmx[slot], __float_as_uint(slot == 0 ? km0 : km1));
  __syncthreads();
  { unsigned char* V8T = (unsigned char*)(a.ws + WS_K8) + V8T0_OFF;
    LAS unsigned char* img = (LAS unsigned char*)lds;
    const int k = tid >> 3, cc = tid & 7, kb = k >> 5, kk = k & 31;
    const int j = (kk & 3) | (((kk >> 3) & 3) << 2) | (((kk >> 2) & 1) << 4);
    for (int u = blockIdx.x; u < 2 * (MT / 64); u += gridDim.x) {
      const int h = u / (MT / 64), t = u % (MT / 64);
      const bf16_t* vp = Q + (size_t)(t * 64 + k) * N_QKV0 + 1280 + h * 128 + cc * 16;
#pragma unroll
      for (int q = 0; q < 2; ++q) { const u32x4 raw = *(const u32x4*)(vp + 8 * q);
#pragma unroll
        for (int i = 0; i < 4; ++i) { const int p = __builtin_amdgcn_cvt_pk_fp8_f32(bflo(raw[i]), bfhi(raw[i]), 0, false);
#pragma unroll
          for (int hh = 0; hh < 2; ++hh) { const int col = cc * 16 + q * 8 + 2 * i + hh;
            img[col * 64 + (((2 * kb + (j >> 4)) ^ ((col >> 2) & 3)) << 4) + (j & 15)] = (unsigned char)(p >> (8 * hh)); } } }
      __syncthreads();
      *(u32x4*)(V8T + ((size_t)h * (MT / 64) + t) * 8192 + tid * 16) = *(LAS const u32x4*)(img + tid * 16);
      __syncthreads();
    }
  }
}
__device__ __forceinline__ void phase_rope1(const Args& a, LAS char* lds, bool dry = false) {
  int tid = threadIdx.x; asm volatile("" : "+v"(tid)); tid &= 511; const int wave = tid >> 6, lane = tid & 63;
  bf16_t* Q = (bf16_t*)(a.ws + WS_QKVU);
  unsigned* kmx = (unsigned*)(a.ws + WS_CTL + CTL_KMAX) + 16;
  unsigned char* K8 = (unsigned char*)(a.ws + WS_K8);
  LAS unsigned* lk = (LAS unsigned*)lds;
  if (tid < 16) lk[tid] = 0u;
  __syncthreads();
  const int slot = lane >> 4, l16 = lane & 15, e1 = (l16 >> 3) * 64 + 4 * (l16 & 7), e2 = e1 + 32;
  for (int it = blockIdx.x; it < MT / 8; it += gridDim.x) {
    const int r = it * 8 + wave;
    float cs[4], sn[4]; rope_cs4(r, lane, cs, sn);
    bf16_t* rowp = Q + (size_t)r * N_IN1;
#pragma unroll 2
    for (int hb = (r < CTXL ? 16 : 0); hb < 32; hb += 4) {
      const int hh = hb + slot;
      const u32x2 a1 = *(const u32x2*)(rowp + hh * 128 + e1), a2 = *(const u32x2*)(rowp + hh * 128 + e2);
      const float x1[4] = {bflo(a1[0]), bfhi(a1[0]), bflo(a1[1]), bfhi(a1[1])}, x2[4] = {bflo(a2[0]), bfhi(a2[0]), bflo(a2[1]), bfhi(a2[1])};
      float o1[4], o2[4];
#pragma unroll
      for (int q = 0; q < 4; ++q) { o1[q] = x1[q] * cs[q] - x2[q] * sn[q]; o2[q] = x2[q] * cs[q] + x1[q] * sn[q]; }
      const u32x2 w1 = {cvtpk(o1[0], o1[1]), cvtpk(o1[2], o1[3])}, w2 = {cvtpk(o2[0], o2[1]), cvtpk(o2[2], o2[3])};
      if (r >= CTXL && !dry) { *(u32x2*)(rowp + hh * 128 + e1) = w1; *(u32x2*)(rowp + hh * 128 + e2) = w2; }
      if (hb >= 16) {
        const unsigned q1 = pack8x4(o1[0], o1[1], o1[2], o1[3]), q2 = pack8x4(o2[0], o2[1], o2[2], o2[3]);
        unsigned char* k8p = K8 + (size_t)r * 2048 + (hh - 16) * 128;
        *(unsigned*)(k8p + e1) = q1; *(unsigned*)(k8p + e2) = q2;
        float so = sum16lanes(sq8x4(q1) + sq8x4(q2));
        if (l16 == 0) atomicMax((unsigned*)&lk[hh - 16], __float_as_uint(so));
      }
    }
  }
  __syncthreads();
  if (tid < 16) atomicMax(&kmx[tid], lk[tid]);
  __syncthreads();
  { unsigned char* V8T = (unsigned char*)(a.ws + WS_HG);
    LAS unsigned char* img = (LAS unsigned char*)lds;
    const int k = tid >> 3, cc = tid & 7, kb = k >> 5, kk = k & 31;
    const int j = (kk & 3) | (((kk >> 3) & 3) << 2) | (((kk >> 2) & 1) << 4);
    for (int u = blockIdx.x; u < 8 * (MT / 64); u += gridDim.x) {
      const int h = u / (MT / 64), t = u % (MT / 64);
      const bf16_t* vp = Q + (size_t)(t * 64 + k) * N_IN1 + 4096 + h * 256 + cc * 32;
#pragma unroll
      for (int q = 0; q < 4; ++q) { const u32x4 raw = *(const u32x4*)(vp + 8 * q);
#pragma unroll
        for (int i = 0; i < 4; ++i) { const int p = __builtin_amdgcn_cvt_pk_fp8_f32(bflo(raw[i]), bfhi(raw[i]), 0, false);
#pragma unroll
          for (int hh = 0; hh < 2; ++hh) { const int col = cc * 32 + q * 8 + 2 * i + hh;
            img[col * 64 + (((2 * kb + (j >> 4)) ^ ((col >> 2) & 3)) << 4) + (j & 15)] = (unsigned char)(p >> (8 * hh)); } } }
      __syncthreads();
      unsigned char* dst = V8T + ((size_t)h * (MT / 64) + t) * 16384;
      *(u32x4*)(dst + tid * 16) = *(LAS const u32x4*)(img + tid * 16);
      *(u32x4*)(dst + 8192 + tid * 16) = *(LAS const u32x4*)(img + 8192 + tid * 16);
      __syncthreads();
    }
  }
}

#ifndef ATT_VAR
#define ATT_VAR 0
#endif
template <int VAR = 0>
__device__ __forceinline__ void phase_attn(const Args& a, int L, LAS char* lds) {
  const bf16_t* Q = (const bf16_t*)(a.ws + WS_QKVU);
  const unsigned* kmx = (const unsigned*)(a.ws + WS_CTL + CTL_KMAX) + L * 16;
  if (L == 0) {
    bf16_t* X2 = (bf16_t*)(a.ws + WS_X2);
    for (int u = blockIdx.x; u < 520; u += gridDim.x) {
      const int head = u < 512 ? (u & 7) : (u - 512);
      const float kmax2 = __uint_as_float(kmx[head >> 2]);
      if (u < 512) { const int qb = u >> 3; const size_t q0 = (size_t)(CTXL + qb * 256);
        at::attn_body_e<4, VAR, (DENSE8_G2 ? 1 : 0)>(Q + q0 * N_QKV0 + head * 128, N_QKV0, (const unsigned char*)(a.ws + WS_K8) + (head >> 2) * 128, 256,
                           (const unsigned char*)(a.ws + WS_K8) + V8T0_OFF + (size_t)(head >> 2) * (MT / 64) * 8192, (DENSE8_G2 ? (bf16_t*)((unsigned char*)X2 + q0 * D + head * 128) : X2 + q0 * D + head * 128), D, MT, kmax2, lds);
      } else {
        at::attn_body_e<4, 0, (DENSE8_G2 ? 1 : 0)>(Q + head * 128, N_QKV0, (const unsigned char*)(a.ws + WS_K8) + (head >> 2) * 128, 256,
                           (const unsigned char*)(a.ws + WS_K8) + V8T0_OFF + (size_t)(head >> 2) * (MT / 64) * 8192, (DENSE8_G2 ? (bf16_t*)((unsigned char*)X2 + head * 128) : X2 + head * 128), D, CTXL, kmax2, lds); }
    }
  } else {
    bf16_t* O = (bf16_t*)(a.ws + WS_Y);
    int tid = threadIdx.x; asm volatile("" : "+v"(tid)); tid &= 511; const int lane = tid & 63;
    const float* lp = a.in[17];
    const float s1 = wave_sum(lp[lane] * lp[128 + lane] + lp[64 + lane] * lp[192 + lane]);
    const float s2 = wave_sum(lp[256 + lane] * lp[384 + lane] + lp[320 + lane] * lp[448 + lane]);
    const float lam = expf(s1) - expf(s2) + LAM_INIT;
    for (int u = blockIdx.x; u < 1024; u += gridDim.x) {
      const int b = u & 255, i = u >> 8, h = b & 7, qb = (b >> 3) + 32 * (i >> 1), cmp = i & 1, hc = 2 * h + cmp;
      const float kmax2 = __uint_as_float(kmx[hc]);
      const size_t q0 = (size_t)(CTXL + qb * 256);
      bf16_t* O0 = O + (size_t)(qb * 256) * 4096 + (2 * h) * 256;
      const unsigned char* k8 = (const unsigned char*)(a.ws + WS_K8) + hc * 128; const unsigned char* v8 = (const unsigned char*)(a.ws + WS_HG) + (size_t)h * (MT / 64) * 16384;
      if (cmp == 0) at::attn_body_e<8, VAR, 0>(Q + q0 * N_IN1 + hc * 128, N_IN1, k8, 2048, v8, O0, 4096, MT, kmax2, lds);
      else at::attn_body_e<8, VAR, 2>(Q + q0 * N_IN1 + hc * 128, N_IN1, k8, 2048, v8, O0, 4096, MT, kmax2, lds,
                                      at::DiffEpi{O0, (unsigned char*)(a.ws + WS_X2) + (q0 * D + h * 256) * (DENSE8_G2 ? 1 : 2), lam, a.in[18]});
    }
  }
}

__device__ __forceinline__ void phase_diff(const Args& a) {
  int tid = threadIdx.x; asm volatile("" : "+v"(tid)); tid &= 511; const int wave = tid >> 6, lane = tid & 63;
  const bf16_t* O = (const bf16_t*)(a.ws + WS_Y);
  bf16_t* X2 = (bf16_t*)(a.ws + WS_X2);
  const float* lp = a.in[17];
  const float s1 = wave_sum(lp[lane] * lp[128 + lane] + lp[64 + lane] * lp[192 + lane]);
  const float s2 = wave_sum(lp[256 + lane] * lp[384 + lane] + lp[320 + lane] * lp[448 + lane]);
  const float lam = expf(s1) - expf(s2) + LAM_INIT;
  const f32x4 sg = *(const f32x4*)(a.in[18] + 4 * lane);
  for (int it = blockIdx.x; it < SEQ / 8; it += gridDim.x) {
    const int t = it * 8 + wave;
    const bf16_t* op = O + (size_t)t * 4096;
    unsigned char* xp = (unsigned char*)X2 + (size_t)(CTXL + t) * D * (DENSE8_G2 ? 1 : 2);
#pragma unroll 2
    for (int h = 0; h < 8; ++h) {
      const u32x2 a0 = *(const u32x2*)(op + (2 * h) * 256 + 4 * lane), a1 = *(const u32x2*)(op + (2 * h + 1) * 256 + 4 * lane);
      float d[4] = {bflo(a0[0]) - lam * bflo(a1[0]), bfhi(a0[0]) - lam * bfhi(a1[0]), bflo(a0[1]) - lam * bflo(a1[1]), bfhi(a0[1]) - lam * bfhi(a1[1])};
      const float ss = wave_sum(d[0] * d[0] + d[1] * d[1] + d[2] * d[2] + d[3] * d[3]);
      const float rstd = rsqrtf(ss * (1.f / 256) + EPS) * (1.f - LAM_INIT);
#if DENSE8_G2
      const float r8 = rstd * 8.f;
      *(unsigned*)(xp + h * 256 + 4 * lane) = pack8x4(d[0] * r8 * sg[0], d[1] * r8 * sg[1], d[2] * r8 * sg[2], d[3] * r8 * sg[3]);
#else
      u32x2 pk = {cvtpk(d[0] * rstd * sg[0], d[1] * rstd * sg[1]), cvtpk(d[2] * rstd * sg[2], d[3] * rstd * sg[3])};
      *(u32x2*)((bf16_t*)xp + h * 256 + 4 * lane) = pk;
#endif
    }
  }
}

__device__ __forceinline__ void phase_G(const Args& a, int L, LAS char* lds, bool dry = false) {
  int tid = threadIdx.x; asm volatile("" : "+v"(tid)); tid &= 511; const int wave = tid >> 6, lane = tid & 63;
  const int NTOK = L == 0 ? MT : SEQ, ROW0 = L == 0 ? 0 : CTXL;
  const float* ng = a.in[6] + (size_t)L * 4 * D;
  const float* MODL = (const float*)(a.ws + WS_MOD) + (size_t)(L * 2) * 12288;
  const bf16_t* RT = (const bf16_t*)(a.ws + WS_RT) + (size_t)L * 2 * 131072; const float* rbias = a.in[20] + L * NE;
  const bf16_t* OUT = (const bf16_t*)(a.ws + WS_OUT);
  bf16_t* HRES = (bf16_t*)(a.ws + WS_HRES);
  bf16_t* F = (bf16_t*)(a.ws + WS_ABUF);
  int* counts = (int*)(a.ws + WS_CTL + CTL_CNT) + L * 64;
  int* top_e = (int*)(a.ws + WS_TOPE); float* top_w = (float*)(a.ws + WS_TOPW); int* top_p = (int*)(a.ws + WS_TOPP); int* elist = (int*)(a.ws + WS_ELIST);
  LAS float* ft = (LAS float*)lds;
  LAS float* part = ft + 8 * D;
  for (int it = blockIdx.x; it < NTOK / 8; it += gridDim.x) {
    const int r = ROW0 + it * 8 + wave;
    const float* mod = MODL + (r < CTXL ? 12288 : 0);
    {
      float o[32], h[32];
      ld_row_bf16(OUT + (size_t)r * D, lane, o);
      if (L == 0) ld_row_f32(r < CTXL ? a.in[2] + (size_t)r * D : a.in[0] + (size_t)(r - CTXL) * D, lane, h);
      else ld_row_bf16(HRES + (size_t)r * D, lane, h);
      const float rstd1 = rsqrtf(sumsq32(o) * (1.f / D) + EPS);
#pragma unroll
      for (int j = 0; j < 4; ++j) { const int idx = 8 * lane + 512 * j;
        float g1[8], gt[8]; ld8f(ng + D + idx, g1); ld8f(mod + 2 * D + idx, gt);
#pragma unroll
        for (int i = 0; i < 8; ++i) h[8 * j + i] += gt[i] * (o[8 * j + i] * rstd1 * g1[i]);
        if (!dry) st8h(HRES + (size_t)r * D + idx, &h[8 * j]); }
      const float rstd2 = rsqrtf(sumsq32(h) * (1.f / D) + EPS);
      modulate_store<true, true>(h, rstd2, ng + 2 * D, mod + 3 * D, mod + 4 * D, (bf16_t*)((unsigned char*)F + (size_t)r * D), lane, ft, wave);
    }
    __syncthreads();
    f32x4 acc[4];
#pragma unroll
    for (int nt = 0; nt < 4; ++nt) acc[nt] = (f32x4){0.f, 0.f, 0.f, 0.f};
    { const int trow = lane & 7, kg = lane >> 4, swz = 4 * (trow & 3) + (trow >> 2);
      const bf16_t* rth = RT + (size_t)lane * 8; const bf16_t* rtl = rth + 131072;
#pragma unroll 2
      for (int st = 0; st < 8; ++st) {
        const int ks = 8 * wave + st, c = ks * 4 + kg;
        LAS const char* ap = (LAS const char*)ft + trow * 4096 + ((c ^ swz) << 4);
        const bf16x8 ah = *(LAS const bf16x8*)ap, al = *(LAS const bf16x8*)(ap + 32768);
#pragma unroll
        for (int nt = 0; nt < 4; ++nt) {
          const bf16x8 bh = *(const bf16x8*)(rth + (size_t)((nt * 64 + ks) * 64) * 8), bl = *(const bf16x8*)(rtl + (size_t)((nt * 64 + ks) * 64) * 8);
          acc[nt] = __builtin_amdgcn_mfma_f32_16x16x32_bf16(ah, bh, acc[nt], 0, 0, 0);
          acc[nt] = __builtin_amdgcn_mfma_f32_16x16x32_bf16(ah, bl, acc[nt], 0, 0, 0);
          acc[nt] = __builtin_amdgcn_mfma_f32_16x16x32_bf16(al, bh, acc[nt], 0, 0, 0); }
      }
      if (kg < 2) {
#pragma unroll
        for (int rr = 0; rr < 4; ++rr)
#pragma unroll
          for (int nt = 0; nt < 4; ++nt) part[(wave * 8 + 4 * kg + rr) * 64 + nt * 16 + (lane & 15)] = acc[nt][rr]; }
    }
    __syncthreads();
    float logit = 0;
#pragma unroll
    for (int w = 0; w < 8; ++w) logit += part[(w * 8 + wave) * 64 + lane];
#if MK_DIAG
    ((float*)(a.ws + WS_Y))[(size_t)r * 64 + lane] = logit;
#endif
    const float score = sigmoidf_(logit);
    const float choice = score + rbias[lane];
    int rank = 0; const int gl = lane & 7;
#pragma unroll
    for (int j = 0; j < 8; ++j) { const float o = __shfl(choice, (lane & ~7) | j); rank += (o > choice || (o == choice && j < gl)) ? 1 : 0; }
    float gs = rank < 2 ? choice : 0.f;
    gs += __shfl_xor(gs, 1); gs += __shfl_xor(gs, 2); gs += __shfl_xor(gs, 4);
    int grank = 0; const int g = lane >> 3;
#pragma unroll
    for (int j = 0; j < 8; ++j) { const float o = __shfl(gs, j * 8); grank += (o > gs || (o == gs && j < g)) ? 1 : 0; }
    const bool gsel = grank < 4;
    const float mc = gsel ? choice : -INFINITY;
    int erank = 0;
#pragma unroll 4
    for (int j = 0; j < 64; ++j) { const float o = __int_as_float(__builtin_amdgcn_readlane(__float_as_int(mc), j)); erank += (o > mc || (o == mc && j < lane)) ? 1 : 0; }
    const bool sel = gsel && erank < 8;
    const unsigned long long bal = __ballot(sel);
    const int idx = __popcll(bal & ((1ull << lane) - 1ull));
    const float ssum = wave_sum(sel ? score : 0.f);
    if (sel && !dry) { const int pos = atomicAdd(&counts[lane], 1);
      top_e[r * 8 + idx] = lane; top_w[r * 8 + idx] = score / ssum * 2.5f; top_p[r * 8 + idx] = pos; elist[(size_t)lane * ECAP + pos] = r; }
  }
}

__device__ __forceinline__ void moe_tile_prefix(const int* counts, LAS int* ts) {
  if (threadIdx.x == 0) { int s = 0; for (int e = 0; e < 64; ++e) { ts[e] = s; s += (counts[e] + 255) >> 8; } ts[64] = s; }
  __syncthreads();
}
__device__ __forceinline__ void phase_H(const Args& a, int L, LAS char* lds) {
  const int NTOK = L == 0 ? MT : SEQ, ROW0 = L == 0 ? 0 : CTXL;
  const int* counts = (const int*)(a.ws + WS_CTL + CTL_CNT) + L * 64;
  const int* top_e = (const int*)(a.ws + WS_TOPE); const int* top_p = (const int*)(a.ws + WS_TOPP);
  int* tslot = (int*)(a.ws + WS_TSLOT); int* stok = (int*)(a.ws + WS_STOK);
  LAS int* ts = (LAS int*)lds;
  moe_tile_prefix(counts, ts);
  int tid = threadIdx.x; asm volatile("" : "+v"(tid)); tid &= 511;
  const int gt = blockIdx.x * NTHREADS + tid, gs = gridDim.x * NTHREADS;
  for (int i = gt; i < NTOK * 8; i += gs) { const int q = ROW0 * 8 + i; const int e = top_e[q]; const int slot = ts[e] * 256 + top_p[q]; stok[slot] = q >> 3; tslot[q] = slot; }
  for (int i = gt; i < 64 * 256; i += gs) { const int e = i >> 8, p = i & 255, cnt = counts[e], nt = (cnt + 255) >> 8; if (cnt + p < nt * 256) stok[ts[e] * 256 + cnt + p] = ROW0; }
  for (int i = gt; i < NTOK; i += gs) stok[SH_BASE + i] = ROW0 + i;
  __syncthreads();
}
struct GatherTile {
  const int* lp; int nv, idb;
  __device__ __forceinline__ int tok(int ri) const { return idb >= 0 ? idb + ri : (ri < nv ? lp[ri] : -idb - 1); }
};
struct DenseSched {
  int nM, nN, r0; const unsigned char* W;
  __device__ __forceinline__ GatherTile gather_tile(int) const { return GatherTile{nullptr, 0, 0}; }
  __device__ __forceinline__ bool unit(int i, int& brow, const unsigned char*& Bt, int& bcol) const {
    const int u = blockIdx.x + i * (int)gridDim.x; if (u >= nM * nN) return false;
    int pm, pn; dense_unit(u, nM, nN, pm, pn); brow = r0 + pm * 256; bcol = pn * 256; Bt = W; return true; }
};
struct MoeSched {
  LAS const int* ts; int TR, NN, total; const unsigned char* W; size_t woff; const int* counts; const int* elist; int row0;
  __device__ __forceinline__ GatherTile gather_tile(int slot0) const {
    if (slot0 >= SH_BASE) return GatherTile{nullptr, 0, row0 + (slot0 - SH_BASE)};
    const int m = slot0 >> 8, le = (int)__builtin_amdgcn_mbcnt_hi(~0u, __builtin_amdgcn_mbcnt_lo(~0u, 0u));
    const int e = __popcll(__ballot(ts[le + 1] <= m)), first = (m - ts[e]) * 256;
    return GatherTile{elist + (size_t)e * ECAP + first, counts[e] - first, -row0 - 1};
  }
  __device__ __forceinline__ bool unit(int i, int& slot0, const unsigned char*& Bt, int& bcol) const {
    for (int u = blockIdx.x + i * (int)gridDim.x; ; u += gridDim.x) {
      const int rnd = u >> 8, b = u & 255, v = rnd * 256 + (b & 7) * 32 + (b >> 3);
      if (rnd * 256 >= total) return false;
      if (v >= total) return false;
      const int m = v / NN, pn = v % NN;
      int e;
      if (m >= TR) { e = 64; slot0 = SH_BASE + 256 * (m - TR); }
      else { const int le = (int)__builtin_amdgcn_mbcnt_hi(~0u, __builtin_amdgcn_mbcnt_lo(~0u, 0u));
        e = __popcll(__ballot(ts[le + 1] <= m)); slot0 = 256 * m; }
      Bt = W + (size_t)e * WMOE8_E + woff; bcol = pn * 256;
      return true;
    }
  }
};
template <int GV = 0>
__device__ __forceinline__ void phase_moe_up(const Args& a, int L, LAS char* lds) {
  const int NSH = L == 0 ? MT / 256 : SEQ / 256;
  const int* counts = (const int*)(a.ws + WS_CTL + CTL_CNT) + L * 64;
  LAS int* ts = (LAS int*)(lds + LDS_CTL + 64);
  moe_tile_prefix(counts, ts);
  const int TR = ts[64], TM = TR + NSH;
  const unsigned char* F = (const unsigned char*)(a.ws + WS_ABUF); const unsigned char* W = (const unsigned char*)(a.ws + WS_WMOE) + (size_t)L * 65 * WMOE8_E;
  const int* stok = (const int*)(a.ws + WS_STOK);
  EpiSwiGLU8 epi{(unsigned char*)(a.ws + WS_ACT), EFF};
  MoeSched sc{ts, TR, 4, TM * 4, W, 0, counts, (const int*)(a.ws + WS_ELIST), L == 0 ? 0 : CTXL};
  gemm8_run<true, D, D, D, GV>(F, stok, lds, epi, sc);
}
template <int GV = 0>
__device__ __forceinline__ void phase_moe_down(const Args& a, int L, LAS char* lds) {
  const int NSH = L == 0 ? MT / 256 : SEQ / 256;
  const int* counts = (const int*)(a.ws + WS_CTL + CTL_CNT) + L * 64;
  LAS int* ts = (LAS int*)(lds + LDS_CTL + 64);
  moe_tile_prefix(counts, ts);
  const int TR = ts[64], TM = TR + NSH;
  const unsigned char* ACT = (const unsigned char*)(a.ws + WS_ACT); const unsigned char* W = (const unsigned char*)(a.ws + WS_WMOE) + (size_t)L * 65 * WMOE8_E;
  EpiPlain8 epi{(unsigned char*)(a.ws + WS_Y), D, 16.f / 128.f};
  MoeSched sc{ts, TR, 8, TM * 8, W, (size_t)1024 * D, counts, nullptr, 0};
  gemm8_run<false, EFF, EFF, EFF, GV>(ACT, nullptr, lds, epi, sc);
}
__device__ __forceinline__ void phase_combine(const Args& a, int L, LAS char* lds, bool dry = false) {
  int tid = threadIdx.x; asm volatile("" : "+v"(tid)); tid &= 511; const int wave = tid >> 6, lane = tid & 63;
  const int NTOK = L == 0 ? MT : SEQ, ROW0 = L == 0 ? 0 : CTXL;
  const float* ng = a.in[6] + (size_t)L * 4 * D;
  const float* MODL = (const float*)(a.ws + WS_MOD) + (size_t)(L * 2) * 12288;
  const unsigned char* Y = (const unsigned char*)(a.ws + WS_Y);
  bf16_t* HRES = (bf16_t*)(a.ws + WS_HRES);
  const int* top_e = (const int*)(a.ws + WS_TOPE); const int* top_p = (const int*)(a.ws + WS_TOPP); const float* top_w = (const float*)(a.ws + WS_TOPW);
  LAS int* ts = (LAS int*)(lds + LDS_CTL + 64);
  moe_tile_prefix((const int*)(a.ws + WS_CTL + CTL_CNT) + L * 64, ts);
  for (int it = blockIdx.x; it < NTOK / 8; it += gridDim.x) {
    const int r = ROW0 + it * 8 + wave;
    const float* mod = MODL + (r < CTXL ? 12288 : 0);
    float y[32];
    { float t[32]; ld_row_fp8(Y + (size_t)(SH_BASE + r - ROW0) * D, lane, t);
#pragma unroll
      for (int i = 0; i < 32; ++i) y[i] = t[i] * (1.f / 16.f); }
#pragma unroll 4
    for (int k = 0; k < 8; ++k) { const int slot = ts[top_e[r * 8 + k]] * 256 + top_p[r * 8 + k]; const float w = top_w[r * 8 + k] * (1.f / 16.f);
      float t[32]; ld_row_fp8(Y + (size_t)slot * D, lane, t);
#pragma unroll
      for (int i = 0; i < 32; ++i) y[i] += w * t[i]; }
    const float rstd = rsqrtf(sumsq32(y) * (1.f / D) + EPS);
    float h[32]; ld_row_bf16(HRES + (size_t)r * D, lane, h);
#pragma unroll
    for (int j = 0; j < 4; ++j) { const int idx = 8 * lane + 512 * j;
      float g3[8], gt[8]; ld8f(ng + 3 * D + idx, g3); ld8f(mod + 5 * D + idx, gt);
#pragma unroll
      for (int i = 0; i < 8; ++i) h[8 * j + i] += gt[i] * (y[8 * j + i] * rstd * g3[i]);
      if (L == 0) { if (!dry) st8h(HRES + (size_t)r * D + idx, &h[8 * j]); } else st8f(a.out + (size_t)(r - CTXL) * D + idx, &h[8 * j]); }
    if (L == 0) {
      const float* mod1 = MODL + 2 * 12288 + (r < CTXL ? 12288 : 0);
      const float rstd2 = rsqrtf(sumsq32(h) * (1.f / D) + EPS);
#if DENSE8_G1
      modulate_store<false, true>(h, rstd2, a.in[6] + (size_t)4 * D, mod1, mod1 + D, (bf16_t*)((unsigned char*)(a.ws + WS_ABUF) + (size_t)r * D), lane, nullptr);
#else
      modulate_store<false>(h, rstd2, a.in[6] + (size_t)4 * D, mod1, mod1 + D, (bf16_t*)(a.ws + WS_ABUF) + (size_t)r * D, lane, nullptr);
#endif
    }
  }
}

constexpr int NPH = 21;
typedef const __attribute__((address_space(4))) Args* ArgsP;
#if defined(__HIP_DEVICE_COMPILE__)
#define FRESH_ARGS() const Args a = *({ ArgsP _p = (ArgsP)__builtin_amdgcn_kernarg_segment_ptr(); asm volatile("" : "+s"(_p)); _p; })
#else
#define FRESH_ARGS() const Args a = kargs
#endif
__global__ void __launch_bounds__(NTHREADS, 2) fwd(Args kargs) {
  extern __shared__ __attribute__((aligned(16))) unsigned char lds_raw[];
  LAS char* lds = (LAS char*)lds_raw;
  const int lo = kargs.ph_lo, hi = kargs.ph_hi;
  if (threadIdx.x < 64) ((LAS unsigned*)(lds + LDS_CTL))[threadIdx.x] = 0u;
  __syncthreads();
  if (hi - lo > 1) (void)xcd_barrier_post((unsigned*)(kargs.ws + WS_CTL), (volatile LAS unsigned*)(lds + LDS_CTL));
#ifndef PHASE_MASK
#define PHASE_MASK 0xFFFFFFFFu
#endif
#define IN(k) (((PHASE_MASK >> (k)) & 1u) && lo <= (k) && (k) < hi)
#ifndef PH_REPEAT_MASK
#define PH_REPEAT_MASK 0u
#endif
#define REP(k) for (int _rep = 0; _rep < (((PH_REPEAT_MASK >> (k)) & 1u) ? 2 : 1); ++_rep)
#define SEAM(k) do { if ((k) + 1 < hi) { XcdBarrier _b; _b.bar = (unsigned*)(a.ws + WS_CTL); _b.x = xb_xcc_id(); _b.st = (volatile LAS unsigned*)(lds + LDS_CTL); xcd_barrier(_b); } } while (0)

  if (IN(0)) { FRESH_ARGS(); REP(0) phase_prologue(a, lds); SEAM(0); }
  if (IN(1)) { FRESH_ARGS(); REP(1) phase_modulate0(a); SEAM(1); }
#pragma unroll
  for (int L = 0; L < 2; ++L) {
    const int base = 2 + (L == 0 ? 0 : 9);
    if (IN(base + 0)) {
      FRESH_ARGS();
      const int nN = L == 0 ? N_IN0 / 256 : N_IN1 / 256, nM = MT / 256;
#if DENSE8_G1
      const unsigned char* A = (const unsigned char*)(a.ws + WS_ABUF);
      EpiG1 epi{EpiPlain{(bf16_t*)(a.ws + WS_QKVU), L == 0 ? N_QKV0 : N_IN1, 1.f / 256.f}, EpiPair<0>{(bf16_t*)(a.ws + WS_HG), 1024, N_QKV0, 1.f / 256.f}, L == 0 ? N_QKV0 : N_IN1};
      DenseSched sc{nM, nN, 0, (const unsigned char*)(a.ws + (L == 0 ? WS_WIN0 : WS_WIN1))};
      REP(2) gemm8_run<false, D, D, D>(A, nullptr, lds, epi, sc);
#else
      const bf16_t* A = (const bf16_t*)(a.ws + WS_ABUF);
      const bf16_t* Bt = (const bf16_t*)(a.ws + (L == 0 ? WS_WIN0 : WS_WIN1));
      EpiG1 epi{EpiPlain{(bf16_t*)(a.ws + WS_QKVU), L == 0 ? N_QKV0 : N_IN1, 1.f}, EpiPair<0>{(bf16_t*)(a.ws + WS_HG), 1024, N_QKV0, 1.f}, L == 0 ? N_QKV0 : N_IN1};
      REP(2) for (int u = blockIdx.x; u < nM * nN; u += gridDim.x) { int pm, pn; dense_unit(u, nM, nN, pm, pn);
        gemm_tile<false>(A, D, nullptr, pm * 256, Bt, D, pn * 256, D, lds, epi); }
#endif
      SEAM(base + 0);
    }
    if (L == 0) {
      if (IN(3)) { FRESH_ARGS(); if ((PH_REPEAT_MASK >> 3) & 1u) { phase_rope_conv0(a, lds, true); __syncthreads(); } phase_rope_conv0(a, lds); SEAM(3); }
      if (IN(4)) { FRESH_ARGS(); if ((PH_REPEAT_MASK >> 4) & 1u) { phase_attn<ATT_VAR>(a, 0, lds); __syncthreads(); } phase_attn<0>(a, 0, lds); SEAM(4); }
    } else {
      if (IN(12)) { FRESH_ARGS(); if ((PH_REPEAT_MASK >> 12) & 1u) { phase_rope1(a, lds, true); __syncthreads(); } phase_rope1(a, lds); SEAM(12); }
      if (IN(13)) { FRESH_ARGS(); if ((PH_REPEAT_MASK >> 13) & 1u) { phase_attn<ATT_VAR>(a, 1, lds); __syncthreads(); } phase_attn<0>(a, 1, lds); SEAM(13); }
    }
    const int b2 = L == 0 ? 5 : 15;
    if (IN(b2 + 0)) {
      FRESH_ARGS();
      const int nN = D / 256, nM = L == 0 ? MT / 256 : SEQ / 256, r0 = L == 0 ? 0 : CTXL;
#if DENSE8_G2
      const unsigned char* A = (const unsigned char*)(a.ws + WS_X2);
      EpiPlain epi{(bf16_t*)(a.ws + WS_OUT), D, 1.f / 2048.f};
      DenseSched sc{nM, nN, r0, (const unsigned char*)(a.ws + (L == 0 ? WS_WOUT0 : WS_WOUT1))};
      REP(5) gemm8_run<false, D, D, D>(A, nullptr, lds, epi, sc);
#else
      const bf16_t* A = (const bf16_t*)(a.ws + WS_X2);
      const bf16_t* Bt = (const bf16_t*)(a.ws + (L == 0 ? WS_WOUT0 : WS_WOUT1));
      EpiPlain epi{(bf16_t*)(a.ws + WS_OUT), D, 1.f};
      REP(5) for (int u = blockIdx.x; u < nM * nN; u += gridDim.x) { int pm, pn; dense_unit(u, nM, nN, pm, pn);
        gemm_tile<false>(A, D, nullptr, r0 + pm * 256, Bt, D, pn * 256, D, lds, epi); }
#endif
      SEAM(b2 + 0);
    }
    if (IN(b2 + 1)) { FRESH_ARGS(); if ((PH_REPEAT_MASK >> 6) & 1u) { phase_G(a, L, lds, true); __syncthreads(); } phase_G(a, L, lds); SEAM(b2 + 1); }
    if (IN(b2 + 3)) { FRESH_ARGS(); if ((PH_REPEAT_MASK >> 8) & 1u) { phase_moe_up<GEMM_VAR>(a, L, lds); __syncthreads(); } phase_moe_up<0>(a, L, lds); SEAM(b2 + 3); }
    if (IN(b2 + 4)) { FRESH_ARGS(); if ((PH_REPEAT_MASK >> 9) & 1u) { phase_moe_down<GEMM_VAR>(a, L, lds); __syncthreads(); } phase_moe_down<0>(a, L, lds); SEAM(b2 + 4); }
    if (IN(b2 + 5)) { FRESH_ARGS(); if ((PH_REPEAT_MASK >> 10) & 1u) phase_combine(a, L, lds, true); phase_combine(a, L, lds); SEAM(b2 + 5); }
  }
#undef IN
#undef SEAM
}

#ifndef MK_DIAG
#define MK_DIAG 0
#endif
#if MK_DIAG
__device__ __forceinline__ void rope_cs(int r, int lane, float& cs, float& sn) {
  cs = 1.f; sn = 0.f;
  if (r >= CTXL) { const int t = r - CTXL; const int a = lane >> 5, i = lane & 31;
    const float pos = a ? (float)(t & 63) : (float)(t >> 6);
    const float inv = powf(10000.f, -(float)i / 32.f);
    sincosf(pos * inv, &sn, &cs); }
}
__device__ __forceinline__ bool dclose(float got, float ref, float rtol, float atol) { return fabsf(got - ref) <= rtol * fabsf(ref) + atol; }
__device__ __forceinline__ unsigned dhash(unsigned x) { x ^= x >> 16; x *= 0x7feb352du; x ^= x >> 15; x *= 0x846ca68bu; x ^= x >> 16; return x; }
__device__ float wdot(const bf16_t* arow, const float* W, int ldw, int col, int K, int lane) {
  float s = 0; for (int k = lane; k < K; k += 64) s += bf2f(arow[k]) * W[(size_t)k * ldw + col]; return wave_sum(s); }
__device__ float dq8(const unsigned char* p, size_t i) { const unsigned w = ((const unsigned*)p)[i >> 2]; const int b = (int)(i & 3);
  return b == 0 ? __builtin_amdgcn_cvt_f32_fp8((int)w, 0) : b == 1 ? __builtin_amdgcn_cvt_f32_fp8((int)w, 1) : b == 2 ? __builtin_amdgcn_cvt_f32_fp8((int)w, 2) : __builtin_amdgcn_cvt_f32_fp8((int)w, 3); }
__device__ float wdot8(const unsigned char* arow8, const float* W, int ldw, int col, int K, int lane) {
  float s = 0; for (int k = lane; k < K; k += 64) s += dq8(arow8, k) * W[(size_t)k * ldw + col]; return wave_sum(s); }
__device__ void dflag(int* dg, int s, int bad, int lane) { if (lane == 0 && bad) atomicAdd(&dg[s], bad); }
__device__ const float* h0row(const Args& a, int r) { return r < CTXL ? a.in[2] + (size_t)r * D : a.in[0] + (size_t)(r - CTXL) * D; }
__device__ int pick_row(unsigned h, int lo, int n) { const unsigned m = h % 8; if (m == 0) return lo; if (m == 1) return lo + n - 1; if (m == 2) return lo + 255 < lo + n ? lo + 255 : lo; if (m == 3) return lo + 256 < lo + n ? lo + 256 : lo; return lo + (int)((h >> 3) % (unsigned)n); }
__device__ void naive_attn(const bf16_t* q, const bf16_t* K, const bf16_t* V, int ld, int nkeys, int lane, float& o0, float& o1) {
  const float q0 = bf2f(q[lane]), q1 = bf2f(q[lane + 64]);
  float m = -1e30f, l = 0; o0 = 0; o1 = 0;
  for (int k = 0; k < nkeys; ++k) {
    const float s = wave_sum(q0 * bf2f(K[(size_t)k * ld + lane]) + q1 * bf2f(K[(size_t)k * ld + lane + 64])) * 0.088388347648318440f;
    const float mn = fmaxf(m, s), al = expf(m - mn), p = expf(s - mn);
    l = l * al + p; o0 = o0 * al + p * bf2f(V[(size_t)k * ld + lane]); o1 = o1 * al + p * bf2f(V[(size_t)k * ld + lane + 64]); m = mn;
  }
  o0 /= l; o1 /= l;
}
__global__ void __launch_bounds__(256) diag(Args a, int k) {
  __shared__ float fsh[4][2048];
  __shared__ float csh[4][64];
  const int lane = threadIdx.x & 63, wv = threadIdx.x >> 6, gw = blockIdx.x * 4 + wv;
  int* dg = (int*)(a.ws + WS_CTL + CTL_CNT + 512);
  const float* MOD = (const float*)(a.ws + WS_MOD);
  const bf16_t* AB = (const bf16_t*)(a.ws + WS_ABUF);
  const bf16_t* QK = (const bf16_t*)(a.ws + WS_QKVU);
  const bf16_t* HG = (const bf16_t*)(a.ws + WS_HG);
  const bf16_t* X2 = (const bf16_t*)(a.ws + WS_X2);
  const bf16_t* OUT = (const bf16_t*)(a.ws + WS_OUT);
  const bf16_t* ACT = (const bf16_t*)(a.ws + WS_ACT);
  const bf16_t* Y = (const bf16_t*)(a.ws + WS_Y);
  const float* HRES = (const float*)(a.ws + WS_HRES);
  const int* top_e = (const int*)(a.ws + WS_TOPE); const float* top_w = (const float*)(a.ws + WS_TOPW); const int* top_p = (const int*)(a.ws + WS_TOPP);
  const int* tslot = (const int*)(a.ws + WS_TSLOT); const int* stok = (const int*)(a.ws + WS_STOK);
  const unsigned h = dhash(gw * 7919u + k * 104729u + 17u), h2 = dhash(h + 12345u);
  int bad = 0;
  const int L = k >= 11 ? 1 : 0;
  const int NTOK = L == 0 ? MT : SEQ, ROW0 = L == 0 ? 0 : CTXL;
  const int* counts = (const int*)(a.ws + WS_CTL + CTL_CNT) + L * 64;
  if (k == 0) {
    const int LL = gw & 1, which = (gw >> 1) & 1, j = h % 12288;
    const float* v = which ? a.in[3] : a.in[1];
    float s = 0; for (int d = lane; d < D; d += 64) { const float x = v[d]; s += x * sigmoidf_(x) * a.in[4][((size_t)LL * D + d) * 12288 + j]; }
    s = wave_sum(s) + a.in[5][LL * 12288 + j];
    bad = !dclose(MOD[(LL * 2 + which) * 12288 + j], s, 1e-3f, 1e-3f); dflag(dg, 1, bad, lane);
  } else if (k == 1) {
    const int r = pick_row(h, 0, MT); const float* x = h0row(a, r); const float* mod = MOD + (r < CTXL ? 12288 : 0);
    float ss = 0; for (int d = lane; d < D; d += 64) ss += x[d] * x[d]; ss = wave_sum(ss); const float rstd = rsqrtf(ss / D + EPS);
    for (int d = lane; d < D; d += 64) { const float ref = x[d] * rstd * a.in[6][d] * (1.f + mod[D + d]) + mod[d]; bad += !dclose(bf2f(AB[(size_t)r * D + d]), ref, 0.01f, 0.01f); }
    bad = (int)wave_sum((float)bad); dflag(dg, 2, bad, lane);
  } else if (k == 2 || k == 11) {
    const int r = pick_row(h, 0, MT);
    if (L == 0) {
      const int c = h2 % N_QKV0; const float ref = wdot(AB + (size_t)r * D, a.in[7], N_IN0, c, D, lane);
      bad = !dclose(bf2f(QK[(size_t)r * N_QKV0 + c]), ref, 0.02f, 0.05f); dflag(dg, 3, bad, lane);
      const int ch = (h2 >> 11) % 1024; const float av = wdot(AB + (size_t)r * D, a.in[7], N_IN0, N_QKV0 + ch, D, lane), gv = wdot(AB + (size_t)r * D, a.in[7], N_IN0, N_QKV0 + 1024 + ch, D, lane);
      bad = !dclose(bf2f(HG[(size_t)r * 1024 + ch]), av * sigmoidf_(gv), 0.03f, 0.05f); dflag(dg, 4, bad, lane);
    } else {
      const int c = h2 % N_IN1; const float ref = wdot(AB + (size_t)r * D, a.in[15], N_IN1, c, D, lane);
      bad = !dclose(bf2f(QK[(size_t)r * N_IN1 + c]), ref, 0.02f, 0.05f); dflag(dg, 15, bad, lane);
    }
  } else if (k == 3) {
    { const int r = pick_row(h, 0, MT), hh = h2 % 10; const float* g = hh < 8 ? a.in[9] : a.in[10];
      float raw0 = 0, raw1 = 0;
      for (int d = 0; d < 128; ++d) { const float v = wdot(AB + (size_t)r * D, a.in[7], N_IN0, hh * 128 + d, D, lane); if (d == lane) raw0 = v; if (d == lane + 64) raw1 = v; }
      const float rstd = rsqrtf(wave_sum(raw0 * raw0 + raw1 * raw1) / 128.f + EPS);
      const float y0 = raw0 * rstd * g[lane], y1 = raw1 * rstd * g[lane + 64];
      float cs, sn; rope_cs(r, lane, cs, sn);
      const float cs0 = __shfl(cs, lane & 31), sn0 = __shfl(sn, lane & 31), cs1 = __shfl(cs, 32 + (lane & 31)), sn1 = __shfl(sn, 32 + (lane & 31));
      const float p0 = __shfl_xor(y0, 32), p1 = __shfl_xor(y1, 32);
      const float o0 = (lane < 32) ? y0 * cs0 - p0 * sn0 : y0 * cs0 + p0 * sn0;
      const float o1 = (lane < 32) ? y1 * cs1 - p1 * sn1 : y1 * cs1 + p1 * sn1;
      bad = !dclose(bf2f(QK[(size_t)r * N_QKV0 + hh * 128 + lane]), o0, 0.03f, 0.05f) + !dclose(bf2f(QK[(size_t)r * N_QKV0 + hh * 128 + 64 + lane]), o1, 0.03f, 0.05f);
      bad = (int)wave_sum((float)bad); dflag(dg, 5, bad, lane); }
    { const int r = pick_row(h2, 0, MT); const int seg0 = r < CTXL ? 0 : CTXL, seg1 = r < CTXL ? CTXL : MT;
      float cv[16]; float s1 = 0, s2 = 0;
      for (int q = 0; q < 16; ++q) { const int c = lane + 64 * q; float acc = a.in[12][c];
        for (int j = 0; j < 31; ++j) { const int rr = r + j - 15; if (rr >= seg0 && rr < seg1) acc += bf2f(HG[(size_t)rr * 1024 + c]) * a.in[11][j * 1024 + c]; }
        cv[q] = acc; s1 += acc; s2 += acc * acc; }
      s1 = wave_sum(s1); s2 = wave_sum(s2); const float mean = s1 / 1024.f, rstd = rsqrtf(s2 / 1024.f - mean * mean + EPS);
      bad = 0;
      for (int q = 0; q < 16; ++q) { const int c = lane + 64 * q; float y = (cv[q] - mean) * rstd * a.in[13][c] + a.in[14][c]; y = y * sigmoidf_(y);
        bad += !dclose(bf2f(X2[(size_t)r * D + 1024 + c]), y, 0.03f, 0.03f); }
      bad = (int)wave_sum((float)bad); dflag(dg, 6, bad, lane); }
  } else if (k == 4) {
    if (gw < 64) { const int r = pick_row(h, 0, MT), head = h2 % 8; const int nkeys = r < CTXL ? CTXL : MT;
      float o0, o1; naive_attn(QK + (size_t)r * N_QKV0 + head * 128, QK + 1024 + (head >> 2) * 128, QK + 1280 + (head >> 2) * 128, N_QKV0, nkeys, lane, o0, o1);
      const float rt = r < CTXL ? 0.15f : 0.05f, at_ = r < CTXL ? 0.04f : 0.01f;
      bad = !dclose(bf2f(X2[(size_t)r * D + head * 128 + lane]), o0, rt, at_) + !dclose(bf2f(X2[(size_t)r * D + head * 128 + 64 + lane]), o1, rt, at_);
      bad = (int)wave_sum((float)bad); dflag(dg, r < CTXL ? 26 : 7, bad, lane); }
  } else if (k == 5 || k == 15) {
    const int r = pick_row(h, ROW0, NTOK), c = h2 % D; const float ref = wdot(X2 + (size_t)r * D, L == 0 ? a.in[8] : a.in[16], D, c, D, lane);
    bad = !dclose(bf2f(OUT[(size_t)r * D + c]), ref, 0.02f, 0.05f); dflag(dg, L == 0 ? 8 : 19, bad, lane);
  } else if (k == 6 || k == 16) {
    const int r = pick_row(h, ROW0, NTOK); const float* mod = MOD + (size_t)(L * 2) * 12288 + (r < CTXL ? 12288 : 0); const float* ng = a.in[6] + (size_t)L * 4 * D;
    float ss = 0; for (int d = lane; d < D; d += 64) { const float o = bf2f(OUT[(size_t)r * D + d]); ss += o * o; } ss = wave_sum(ss); const float rstd1 = rsqrtf(ss / D + EPS);
    bad = 0;
    if (L == 0) { const float* x = h0row(a, r); for (int d = lane; d < D; d += 64) { const float ref = x[d] + mod[2 * D + d] * (bf2f(OUT[(size_t)r * D + d]) * rstd1 * ng[D + d]); bad += !dclose(HRES[(size_t)r * D + d], ref, 1e-3f, 1e-3f); } }
    float s2 = 0; for (int d = lane; d < D; d += 64) { const float x = HRES[(size_t)r * D + d]; s2 += x * x; } s2 = wave_sum(s2); const float rstd2 = rsqrtf(s2 / D + EPS);
    for (int d = lane; d < D; d += 64) { const float f = HRES[(size_t)r * D + d] * rstd2 * ng[2 * D + d] * (1.f + mod[4 * D + d]) + mod[3 * D + d]; fsh[wv][d] = f; bad += !dclose(dq8((const unsigned char*)AB + (size_t)r * D, d), f, 0.07f, 0.01f); }
    bad = (int)wave_sum((float)bad); dflag(dg, L == 0 ? 9 : 20, bad, lane);
    __syncthreads();
    float lg = 0; for (int d = 0; d < D; ++d) lg += fsh[wv][d] * a.in[19][((size_t)L * D + d) * NE + lane];
    const float sc = sigmoidf_(lg); csh[wv][lane] = sc + a.in[20][L * NE + lane];
    __syncthreads();
    { const float plg = ((const float*)(a.ws + WS_Y))[(size_t)r * 64 + lane]; int lb = !dclose(plg, lg, 1e-3f, 1e-3f); lb = (int)wave_sum((float)lb); if (lane == 0 && lb) { atomicAdd(&dg[32 + (L == 0 ? 10 : 21) + 3], 1); atomicOr(&dg[60], 1 << (r & 7)); } }
    unsigned long long wsel;
    { const float choice = csh[wv][lane]; int rank = 0; const int gl = lane & 7;
      for (int j = 0; j < 8; ++j) { const float o = __shfl(choice, (lane & ~7) | j); rank += (o > choice || (o == choice && j < gl)) ? 1 : 0; }
      float gs = rank < 2 ? choice : 0.f; gs += __shfl_xor(gs, 1); gs += __shfl_xor(gs, 2); gs += __shfl_xor(gs, 4);
      int grank = 0; const int g = lane >> 3;
      for (int j = 0; j < 8; ++j) { const float o = __shfl(gs, j * 8); grank += (o > gs || (o == gs && j < g)) ? 1 : 0; }
      const bool gsel = grank < 4; const float mc = gsel ? choice : -INFINITY; int erank = 0;
      for (int j = 0; j < 64; ++j) { const float o = __shfl(mc, j); erank += (o > mc || (o == mc && j < lane)) ? 1 : 0; }
      wsel = __ballot(gsel && erank < 8); }
    int setbad = 0;
    if (lane == 0) {
      float gsc[8]; for (int g = 0; g < 8; ++g) { float m1 = -1e30f, m2 = -1e30f; for (int j = 0; j < 8; ++j) { const float v = csh[wv][g * 8 + j]; if (v > m1) { m2 = m1; m1 = v; } else if (v > m2) m2 = v; } gsc[g] = m1 + m2; }
      bool gs[8] = {false, false, false, false, false, false, false, false};
      for (int t = 0; t < 4; ++t) { int bi = 0; float bv = -1e30f; for (int g = 0; g < 8; ++g) if (!gs[g] && gsc[g] > bv) { bv = gsc[g]; bi = g; } gs[bi] = true; }
      unsigned long long selm = 0; for (int t = 0; t < 8; ++t) { int bi = 0; float bv = -1e30f; for (int e = 0; e < 64; ++e) if (gs[e >> 3] && !((selm >> e) & 1ull) && csh[wv][e] > bv) { bv = csh[wv][e]; bi = e; } selm |= 1ull << bi; }
      unsigned long long got = 0; for (int t = 0; t < 8; ++t) { const int e = top_e[r * 8 + t]; if (e < 0 || e > 63) setbad = 1000; else got |= 1ull << e; }
      if (setbad == 0 && got != selm) setbad = 1;
      if (wsel != selm) atomicAdd(&dg[32 + (L == 0 ? 10 : 21) + 4], 1);
    }
    setbad = __shfl(setbad, 0);
    { float wgot = -1.f; int mine = 0; for (int t = 0; t < 8; ++t) if (top_e[r * 8 + t] == lane) { mine = 1; wgot = top_w[r * 8 + t]; }
      const float ssum = wave_sum(mine ? sc : 0.f);
      int wbad = (mine && !dclose(wgot, sc / ssum * 2.5f, 0.01f, 1e-3f)) ? 1 : 0; wbad = (int)wave_sum((float)wbad);
      if (lane == 0) { int* q = &dg[32 + (L == 0 ? 10 : 21)]; if (setbad >= 1000) atomicAdd(q + 1, 1); else if (setbad) atomicAdd(q, 1); else if (wbad) atomicAdd(q + 2, 1); } }
  } else if (k == 7 || k == 17) {
    const int r = pick_row(h, ROW0, NTOK), t = h2 % 8, q = r * 8 + t; const int slot = tslot[q], e = top_e[q];
    int ts0 = 0; for (int j = 0; j < e; ++j) ts0 += (counts[j] + 255) >> 8;
    bad = (slot < ts0 * 256 || slot >= ts0 * 256 + counts[e] || stok[slot] != r || top_p[q] != slot - ts0 * 256) ? 1 : 0;
    bad += (stok[SH_BASE + r - ROW0] != r) ? 1 : 0;
    dflag(dg, L == 0 ? 11 : 22, bad, lane);
  } else if (k == 8 || k == 18 || k == 9 || k == 19) {
    int TR = 0; for (int j = 0; j < 64; ++j) TR += (counts[j] + 255) >> 8;
    int slot, e;
    if ((h & 3) == 0) { slot = SH_BASE + (int)((h >> 2) % (unsigned)NTOK); e = 64; }
    else { e = (h >> 2) % 64; int guard = 0; while (counts[e] == 0 && guard++ < 64) e = (e + 1) % 64; int ts0 = 0; for (int j = 0; j < e; ++j) ts0 += (counts[j] + 255) >> 8;
      const unsigned m = (h >> 8) % 4; const int cnt = counts[e]; const int p = m == 0 ? 0 : m == 1 ? cnt - 1 : (int)((h >> 10) % (unsigned)cnt); slot = ts0 * 256 + p; }
    const int tok = stok[slot];
    if (k == 8 || k == 18) {
      const int ch = h2 % EFF;
      const float* Wg = e < 64 ? a.in[21] + ((size_t)L * 64 + e) * D * EFF : a.in[24] + (size_t)L * D * EFF;
      const float* Wu = e < 64 ? a.in[22] + ((size_t)L * 64 + e) * D * EFF : a.in[25] + (size_t)L * D * EFF;
      const unsigned char* F8 = (const unsigned char*)AB + (size_t)tok * D;
      const float gv = wdot8(F8, Wg, EFF, ch, D, lane), uv = wdot8(F8, Wu, EFF, ch, D, lane);
      bad = !dclose(dq8((const unsigned char*)ACT + (size_t)slot * EFF, ch), gv * sigmoidf_(gv) * uv, 0.2f, 0.15f); dflag(dg, L == 0 ? 12 : 23, bad, lane);
    } else {
      const int c = h2 % D; const float* Wd = e < 64 ? a.in[23] + ((size_t)L * 64 + e) * EFF * D : a.in[26] + (size_t)L * EFF * D;
      const float ref = wdot8((const unsigned char*)ACT + (size_t)slot * EFF, Wd, D, c, EFF, lane);
      bad = !dclose(dq8((const unsigned char*)Y + (size_t)slot * D, c) * (1.f / 16.f), ref, 0.2f, 0.15f); dflag(dg, L == 0 ? 13 : 24, bad, lane);
    }
  } else if (k == 10 || k == 20) {
    const int r = pick_row(h, ROW0, NTOK); const float* mod = MOD + (size_t)(L * 2) * 12288 + (r < CTXL ? 12288 : 0); const float* ng = a.in[6] + (size_t)L * 4 * D;
    float ss = 0; for (int d = lane; d < D; d += 64) { const unsigned char* Y8 = (const unsigned char*)Y; float y = dq8(Y8 + (size_t)(SH_BASE + r - ROW0) * D, d) * (1.f / 16.f); for (int t = 0; t < 8; ++t) y += top_w[r * 8 + t] * dq8(Y8 + (size_t)tslot[r * 8 + t] * D, d) * (1.f / 16.f); fsh[wv][d] = y; ss += y * y; }
    ss = wave_sum(ss); const float rstd = rsqrtf(ss / D + EPS);
    bad = 0;
    if (L == 0) { float s2 = 0; for (int d = lane; d < D; d += 64) { const float x = HRES[(size_t)r * D + d]; s2 += x * x; } s2 = wave_sum(s2); const float rstd2 = rsqrtf(s2 / D + EPS);
      const float* mod1 = MOD + (size_t)2 * 12288 + (r < CTXL ? 12288 : 0);
      for (int d = lane; d < D; d += 64) { const float ref = HRES[(size_t)r * D + d] * rstd2 * a.in[6][4 * D + d] * (1.f + mod1[D + d]) + mod1[d]; bad += !dclose(bf2f(AB[(size_t)r * D + d]), ref, 0.01f, 0.01f); } }
    else { for (int d = lane; d < D; d += 64) { const float ref = HRES[(size_t)r * D + d] + mod[5 * D + d] * (fsh[wv][d] * rstd * ng[3 * D + d]); bad += !dclose(a.out[(size_t)(r - CTXL) * D + d], ref, 1e-3f, 1e-3f); } }
    bad = (int)wave_sum((float)bad); dflag(dg, L == 0 ? 14 : 25, bad, lane);
  } else if (k == 12) {
    const int r = pick_row(h, CTXL, SEQ), hh = h2 % 32;
    float raw0 = 0, raw1 = 0;
    for (int d = 0; d < 128; ++d) { const float v = wdot(AB + (size_t)r * D, a.in[15], N_IN1, hh * 128 + d, D, lane); if (d == lane) raw0 = v; if (d == lane + 64) raw1 = v; }
    float cs, sn; rope_cs(r, lane, cs, sn);
    const float cs0 = __shfl(cs, lane & 31), sn0 = __shfl(sn, lane & 31), cs1 = __shfl(cs, 32 + (lane & 31)), sn1 = __shfl(sn, 32 + (lane & 31));
    const float p0 = __shfl_xor(raw0, 32), p1 = __shfl_xor(raw1, 32);
    const float o0 = (lane < 32) ? raw0 * cs0 - p0 * sn0 : raw0 * cs0 + p0 * sn0;
    const float o1 = (lane < 32) ? raw1 * cs1 - p1 * sn1 : raw1 * cs1 + p1 * sn1;
    bad = !dclose(bf2f(QK[(size_t)r * N_IN1 + hh * 128 + lane]), o0, 0.03f, 0.05f) + !dclose(bf2f(QK[(size_t)r * N_IN1 + hh * 128 + 64 + lane]), o1, 0.03f, 0.05f);
    bad = (int)wave_sum((float)bad); dflag(dg, 16, bad, lane);
  } else if (k == 13) {
    if (gw < 64) { const int r = pick_row(h, CTXL, SEQ), hc = h2 % 16, vh = (h2 >> 4) & 1, hd = hc >> 1;
      float o0, o1; naive_attn(QK + (size_t)r * N_IN1 + hc * 128, QK + 2048 + hc * 128, QK + 4096 + hd * 256 + vh * 128, N_IN1, MT, lane, o0, o1);
      const bf16_t* O = Y + (size_t)(r - CTXL) * 4096 + hc * 256 + vh * 128;
      bad = !dclose(bf2f(O[lane]), o0, 0.05f, 0.01f) + !dclose(bf2f(O[64 + lane]), o1, 0.05f, 0.01f);
      bad = (int)wave_sum((float)bad); dflag(dg, 17, bad, lane); }
  } else if (k == 14) {
    const int r = pick_row(h, CTXL, SEQ), hd = h2 % 8; const float* lp = a.in[17];
    float s1 = 0, s2 = 0; for (int i = lane; i < 128; i += 64) { s1 += lp[i] * lp[128 + i]; s2 += lp[256 + i] * lp[384 + i]; } s1 = wave_sum(s1); s2 = wave_sum(s2);
    const float lam = expf(s1) - expf(s2) + LAM_INIT; const bf16_t* O = Y + (size_t)(r - CTXL) * 4096;
    float dv[4], ss = 0; for (int i = 0; i < 4; ++i) { const int d = lane + 64 * i; dv[i] = bf2f(O[(2 * hd) * 256 + d]) - lam * bf2f(O[(2 * hd + 1) * 256 + d]); ss += dv[i] * dv[i]; }
    ss = wave_sum(ss); const float rstd = rsqrtf(ss / 256.f + EPS) * (1.f - LAM_INIT); bad = 0;
    for (int i = 0; i < 4; ++i) { const int d = lane + 64 * i; bad += !dclose(bf2f(X2[(size_t)r * D + hd * 256 + d]), dv[i] * rstd * a.in[18][d], 0.02f, 0.01f); }
    bad = (int)wave_sum((float)bad); dflag(dg, 18, bad, lane);
  }
}
__global__ void diag_encode(Args a) {
  const int* dg = (const int*)(a.ws + WS_CTL + CTL_CNT + 512);
  int s = 0;
  int sub = 0;
  for (int i = 1; i < 32; ++i) { int v = dg[i]; if (i == 10 || i == 21) { v = (dg[32 + i] > 25 ? 1 : 0) + (dg[33 + i] > 0 ? 2 : 0) + (dg[34 + i] > 0 ? 4 : 0) + (dg[35 + i] > 0 ? 8 : 0) + (dg[36 + i] > 0 ? 16 : 0); sub = v; } if (v) { s = i; break; } }
  if (s == 0) return;
  const float c = sub ? 30.f + 8.f * sub : 10.f * s;
  for (size_t i = (size_t)blockIdx.x * blockDim.x + threadIdx.x; i < (size_t)SEQ * D; i += (size_t)gridDim.x * blockDim.x) a.out[i] = c;
}
#endif

extern "C" void kernel_launch(void* const* d_in, const int* in_sizes, int n_in, void* d_out, int out_size, void* d_ws, size_t ws_size, hipStream_t stream) {
  static int grid = 0;
  if (grid == 0) {
    if (n_in != 27 || out_size != SEQ * D || ws_size < WS_END) { fprintf(stderr, "kernel_launch: unexpected shapes (n_in %d out %d ws %zu need %zu)\n", n_in, out_size, ws_size, (size_t)WS_END); grid = -1; return; }
    if (hipFuncSetAttribute((const void*)fwd, hipFuncAttributeMaxDynamicSharedMemorySize, LDS_BYTES) != hipSuccess) { fprintf(stderr, "kernel_launch: hipFuncSetAttribute failed\n"); grid = -1; return; }
    int dev = 0, cus = 0, per_cu = 0;
    hipGetDevice(&dev); hipDeviceGetAttribute(&cus, hipDeviceAttributeMultiprocessorCount, dev);
    if (hipOccupancyMaxActiveBlocksPerMultiprocessor(&per_cu, (const void*)fwd, NTHREADS, LDS_BYTES) != hipSuccess || per_cu < 1) fprintf(stderr, "kernel_launch: occupancy query says %d\n", per_cu);
    (void)hipGetLastError();
    grid = cus < 256 ? cus : 256;
    if (grid != 256) fprintf(stderr, "kernel_launch: %d CUs (expected 256)\n", cus);
  }
  if (grid < 0) return;
  hipMemsetAsync((char*)d_ws + WS_CTL, 0, CTL_BYTES, stream);
  Args a{};
  for (int i = 0; i < 27; ++i) a.in[i] = (const float*)d_in[i];
  a.out = (float*)d_out; a.ws = (unsigned char*)d_ws;
#if MK_MULTI
  for (int k = 0; k < NPH; ++k) { a.ph_lo = k; a.ph_hi = k + 1; hipLaunchKernelGGL(fwd, dim3(grid), dim3(NTHREADS), LDS_BYTES, stream, a);
#if MK_DIAG
    hipLaunchKernelGGL(diag, dim3(64), dim3(256), 0, stream, a, k);
#endif
  }
#if MK_DIAG
  hipLaunchKernelGGL(diag_encode, dim3(1024), dim3(256), 0, stream, a);
#endif
#else
  a.ph_lo = 0; a.ph_hi = NPH;
  hipLaunchKernelGGL(fwd, dim3(grid), dim3(NTHREADS), LDS_BYTES, stream, a);
#endif
  const hipError_t le = hipPeekAtLastError();
  if (le != hipSuccess) fprintf(stderr, "kernel_launch: launch failed: %s\n", hipGetErrorName(le));
}
```
